# Optimizing an MI355X kernel written in HIP

```python
import math
import jax, jax.numpy as jnp
from jax import lax
import numpy as np

D_MODEL = 2048
BATCH = 4
SEQ = 4096
DEPTH = 1

HEAD_DIM = 128
NSA_HEADS = 8
NSA_KV_GROUPS = 2
NSA_REP = NSA_HEADS // NSA_KV_GROUPS
NSA_CMP_LEN = 32
NSA_CMP_STRIDE = 16
NSA_SEL_LEN = 64
NSA_TOP_N = 16
NSA_WINDOW = 512
NSA_SEL_QBLOCK = 64
DIL_CONFIGS = ((128, 1), (512, 4), (2048, 16))
DIL_HEADS_PER_GROUP = 4
DIL_HEADS = DIL_HEADS_PER_GROUP * len(DIL_CONFIGS)
DIL_OUT = DIL_HEADS_PER_GROUP * HEAD_DIM
ATTN_QBLOCK = 128
REL_BUCKETS = 32
REL_MAX_DIST = 2048
N_BIAS_HEADS = NSA_HEADS + DIL_HEADS
PEER_HEADS = 8
PEER_N_KEYS = 128
PEER_N_EXPERTS = PEER_N_KEYS * PEER_N_KEYS
PEER_TOPK = 16
PEER_HALF = 128
PEER_TBLOCK = 128

EPS = 1e-6
NEG = -1e30
SEL_FORCE = 1e4

NSA_Q_COLS = NSA_HEADS * HEAD_DIM
NSA_KV_COLS = 3 * 2 * NSA_KV_GROUPS * HEAD_DIM
NSA_GATE_COLS = 3 * NSA_HEADS
DIL_COLS = 3 * DIL_HEADS * HEAD_DIM
MERGE_COLS = 2 * D_MODEL
OFF_KV = NSA_Q_COLS
OFF_GATE = OFF_KV + NSA_KV_COLS
OFF_DIL = OFF_GATE + NSA_GATE_COLS
OFF_MERGE = OFF_DIL + DIL_COLS
IN_COLS = OFF_MERGE + MERGE_COLS

kernel_name = "hybrid_nsa_dilated_peer_block"


def rms_norm(x, g):
    xf = x.astype(jnp.float32)
    y = xf * lax.rsqrt(jnp.mean(xf * xf, axis=-1, keepdims=True) + EPS)
    return (y * g.astype(jnp.float32)).astype(x.dtype)


def t5_bucket(dist):
    n = jnp.maximum(dist, 0)
    max_exact = REL_BUCKETS // 2
    nf = jnp.maximum(n, max_exact).astype(jnp.float32)
    large = max_exact + (jnp.log(nf / max_exact) / math.log(REL_MAX_DIST / max_exact)
                         * (REL_BUCKETS - max_exact)).astype(jnp.int32)
    large = jnp.minimum(large, REL_BUCKETS - 1)
    return jnp.where(n < max_exact, n, large)


def to_heads(t, n_heads):
    b, s, _ = t.shape
    return t.reshape(b, s, n_heads, HEAD_DIM).transpose(0, 2, 1, 3)


def banded_attention(q, k, v, span, dist_scale, tbl):
    b, hq, L, dh = q.shape
    hk = k.shape[1]
    rep = hq // hk
    qb = ATTN_QBLOCK
    nb = -(-L // qb)
    lp = nb * qb
    pad_end = lp - L
    n_prev = -(-span // qb)
    w = (n_prev + 1) * qb
    q = jnp.pad(q, ((0, 0), (0, 0), (0, pad_end), (0, 0)))
    kp = jnp.pad(k, ((0, 0), (0, 0), (n_prev * qb, pad_end), (0, 0))).reshape(b, hk, nb + n_prev, qb, dh)
    vp = jnp.pad(v, ((0, 0), (0, 0), (n_prev * qb, pad_end), (0, 0))).reshape(b, hk, nb + n_prev, qb, dh)
    kw = jnp.concatenate([kp[:, :, j:j + nb] for j in range(n_prev + 1)], axis=3)
    vw = jnp.concatenate([vp[:, :, j:j + nb] for j in range(n_prev + 1)], axis=3)
    qr = q.reshape(b, hk, rep, nb, qb, dh)
    logits = jnp.einsum('bgrnqd,bgnkd->bgrnqk', qr, kw).astype(jnp.float32) * (dh ** -0.5)
    dist = jnp.arange(qb)[:, None] + n_prev * qb - jnp.arange(w)[None, :]
    kpos = (jnp.arange(nb)[:, None] - n_prev) * qb + jnp.arange(w)[None, :]
    valid = ((dist >= 0) & (dist <= span))[None, :, :] & (kpos >= 0)[:, None, :]
    bias = jnp.take(tbl.astype(jnp.float32), t5_bucket(dist * dist_scale), axis=1)
    bias = bias.reshape(hk, rep, 1, qb, w)
    logits = jnp.where(valid, logits + bias, NEG)
    lse = jax.nn.logsumexp(logits, axis=-1)
    p = jnp.exp(logits - lse[..., None])
    out = jnp.einsum('bgrnqk,bgnkd->bgrnqd', p.astype(v.dtype), vw)
    out = out.reshape(b, hq, lp, dh)[:, :, :L]
    lse = lse.reshape(b, hq, lp)[:, :, :L]
    return out, lse


def nsa_mixer(q, kv, gates, k_gain, cmp_pos, cmp_w1, cmp_w2, tbl):
    b, nh, s, dh = q.shape
    G, rep = NSA_KV_GROUPS, NSA_REP
    scale = dh ** -0.5
    k_cmp, v_cmp, k_sel, v_sel, k_win, v_win = [kv[:, i] for i in range(6)]
    k_sel = rms_norm(k_sel, k_gain[1])
    k_win = rms_norm(k_win, k_gain[2])
    tbl = tbl.astype(jnp.float32)

    nc = (s - NSA_CMP_LEN) // NSA_CMP_STRIDE + 1
    cidx = jnp.arange(nc)[:, None] * NSA_CMP_STRIDE + jnp.arange(NSA_CMP_LEN)[None, :]

    def compress(t, j):
        blk = t[:, :, cidx] + cmp_pos[j]
        hid = jax.nn.gelu(blk.reshape(b, G, nc, NSA_CMP_LEN * dh) @ cmp_w1[j])
        return hid @ cmp_w2[j]

    kc = rms_norm(compress(k_cmp, 0), k_gain[0])
    vc = compress(v_cmp, 1)
    qg = q.reshape(b, G, rep, s, dh)
    logits = jnp.einsum('bgrsd,bgcd->bgrsc', qg, kc).astype(jnp.float32) * scale
    cend = jnp.arange(nc) * NSA_CMP_STRIDE + NSA_CMP_LEN - 1
    cdist = jnp.arange(s)[:, None] - cend[None, :]
    cvalid = cdist >= 0
    cbias = jnp.take(tbl, t5_bucket(cdist), axis=1).reshape(G, rep, s, nc)
    p_cmp = jax.nn.softmax(jnp.where(cvalid, logits + cbias, NEG), axis=-1) * cvalid
    o_cmp = jnp.einsum('bgrsc,bgcd->bgrsd', p_cmp.astype(vc.dtype), vc).reshape(b, nh, s, dh)

    ns = s // NSA_SEL_LEN
    cstart = jnp.arange(nc) * NSA_CMP_STRIDE
    sstart = jnp.arange(ns) * NSA_SEL_LEN
    overlap = ((cstart[:, None] < sstart[None, :] + NSA_SEL_LEN)
               & (cstart[:, None] + NSA_CMP_LEN > sstart[None, :])).astype(jnp.float32)
    imp = jnp.einsum('bgrsc,cj->bgsj', p_cmp, overlap)
    cur = (jnp.arange(s) // NSA_SEL_LEN)[:, None]
    jb = jnp.arange(ns)[None, :]
    forced = (jb == 0) | (jb == cur) | (jb == cur - 1)
    score = jnp.where(forced, SEL_FORCE, jnp.where(jb > cur, -SEL_FORCE, imp))
    n_sel = min(NSA_TOP_N, ns)
    _, sel_idx = lax.top_k(score, n_sel)

    kb = k_sel.reshape(b, G, ns, NSA_SEL_LEN, dh)
    vb = v_sel.reshape(b, G, ns, NSA_SEL_LEN, dh)
    gather = jax.vmap(jax.vmap(lambda blocks, idx: blocks[idx]))
    tbl_g = tbl.reshape(G, rep, REL_BUCKETS)
    g_ix = jnp.arange(G)[:, None, None, None]
    r_ix = jnp.arange(rep)[:, None, None]
    qs = NSA_SEL_QBLOCK
    nqb = s // qs
    m = n_sel * NSA_SEL_LEN

    def sel_block(args):
        qblk, iblk, q0 = args
        ks = gather(kb, iblk).reshape(b, G, qs, m, dh)
        vs = gather(vb, iblk).reshape(b, G, qs, m, dh)
        kpos = (iblk[..., None] * NSA_SEL_LEN + jnp.arange(NSA_SEL_LEN)).reshape(b, G, qs, m)
        dist = (q0 + jnp.arange(qs))[None, None, :, None] - kpos
        bias = tbl_g[g_ix, r_ix, t5_bucket(dist)[:, :, None]]
        lg = jnp.einsum('bgrqd,bgqmd->bgrqm', qblk, ks).astype(jnp.float32) * scale
        lg = jnp.where((dist >= 0)[:, :, None], lg + bias, NEG)
        p = jax.nn.softmax(lg, axis=-1)
        return jnp.einsum('bgrqm,bgqmd->bgrqd', p.astype(vs.dtype), vs)

    q_blocks = qg.reshape(b, G, rep, nqb, qs, dh).transpose(3, 0, 1, 2, 4, 5)
    i_blocks = sel_idx.reshape(b, G, nqb, qs, n_sel).transpose(2, 0, 1, 3, 4)
    starts = jnp.arange(nqb, dtype=jnp.int32) * qs
    o_sel = lax.map(sel_block, (q_blocks, i_blocks, starts))
    o_sel = o_sel.transpose(1, 2, 3, 0, 4, 5).reshape(b, nh, s, dh)

    o_win, _ = banded_attention(q, k_win, v_win, NSA_WINDOW - 1, 1, tbl)

    g = gates.transpose(0, 2, 1, 3)
    o = g[..., 0:1] * o_cmp + g[..., 1:2] * o_sel + g[..., 2:3] * o_win
    return o.transpose(0, 2, 1, 3).reshape(b, s, nh * dh)


def dilated_mixer(q, k, v, tbl):
    b, _, s, dh = q.shape
    P = DIL_HEADS_PER_GROUP
    outs, lses = [], []
    for gi, (window, dil) in enumerate(DIL_CONFIGS):
        lo, hi = gi * P, (gi + 1) * P
        L = s // dil

        def split(t):
            return t[:, lo:hi].reshape(b, P, L, dil, dh).transpose(0, 1, 3, 2, 4).reshape(b, P * dil, L, dh)

        o, lse = banded_attention(split(q), split(k), split(v), window // dil, dil,
                                  jnp.repeat(tbl[lo:hi], dil, axis=0))
        outs.append(o.reshape(b, P, dil, L, dh).transpose(0, 1, 3, 2, 4).reshape(b, P, s, dh))
        lses.append(lse.reshape(b, P, dil, L).transpose(0, 1, 3, 2).reshape(b, P, s))
    w = jax.nn.softmax(jnp.stack(lses, axis=0), axis=0)
    o = jnp.sum(w[..., None].astype(q.dtype) * jnp.stack(outs, axis=0), axis=0)
    return o.transpose(0, 2, 1, 3).reshape(b, s, P * dh)


def token_mixer(h, w_in, nsa_q_gain, nsa_k_gain, cmp_pos, cmp_w1, cmp_w2, dil_q_gain, dil_k_gain,
                w_br_nsa, w_br_dil, w_out, tbl_nsa, tbl_dil):
    b, s, _ = h.shape
    proj = h @ w_in
    q_n = rms_norm(to_heads(proj[..., :OFF_KV], NSA_HEADS), nsa_q_gain)
    kv_n = to_heads(proj[..., OFF_KV:OFF_GATE], 6 * NSA_KV_GROUPS).reshape(b, 6, NSA_KV_GROUPS, s, HEAD_DIM)
    gates_n = jax.nn.sigmoid(proj[..., OFF_GATE:OFF_DIL].reshape(b, s, NSA_HEADS, 3))
    qkv_d = to_heads(proj[..., OFF_DIL:OFF_MERGE], 3 * DIL_HEADS).reshape(b, 3, DIL_HEADS, s, HEAD_DIM)
    merge_g = jax.nn.sigmoid(proj[..., OFF_MERGE:])
    y_nsa = nsa_mixer(q_n, kv_n, gates_n, nsa_k_gain, cmp_pos, cmp_w1, cmp_w2, tbl_nsa)
    y_dil = dilated_mixer(rms_norm(qkv_d[:, 0], dil_q_gain), rms_norm(qkv_d[:, 1], dil_k_gain),
                          qkv_d[:, 2], tbl_dil)
    merged = merge_g[..., :D_MODEL] * (y_nsa @ w_br_nsa) + merge_g[..., D_MODEL:] * (y_dil @ w_br_dil)
    return merged @ w_out


def peer_ffn(h, w_q, q_gain, sub_keys, u, v):
    b, s, d = h.shape
    t = b * s
    xt = h.reshape(t, d)
    q = rms_norm((xt @ w_q).reshape(t, PEER_HEADS, 2, PEER_HALF), q_gain)
    sc = jnp.einsum('thpk,hpnk->thpn', q, sub_keys).astype(jnp.float32)
    s1, i1 = lax.top_k(sc[:, :, 0], PEER_TOPK)
    s2, i2 = lax.top_k(sc[:, :, 1], PEER_TOPK)
    cand = (s1[..., :, None] + s2[..., None, :]).reshape(t, PEER_HEADS, PEER_TOPK * PEER_TOPK)
    cand_idx = (i1[..., :, None] * PEER_N_KEYS + i2[..., None, :]).reshape(t, PEER_HEADS, PEER_TOPK * PEER_TOPK)
    top_s, pos = lax.top_k(cand, PEER_TOPK)
    expert = jnp.take_along_axis(cand_idx, pos, axis=-1)
    gate = jax.nn.softmax(top_s, axis=-1).astype(h.dtype)
    nb = t // PEER_TBLOCK
    hk = PEER_HEADS * PEER_TOPK

    def block(args):
        xb, eb, gb = args
        act = jax.nn.gelu(jnp.einsum('td,ted->te', xb, u[eb]))
        return jnp.einsum('te,ted->td', gb * act, v[eb])

    out = lax.map(block, (xt.reshape(nb, PEER_TBLOCK, d), expert.reshape(nb, PEER_TBLOCK, hk),
                          gate.reshape(nb, PEER_TBLOCK, hk)))
    return out.reshape(b, s, d)


def _normal(key, shape, scale):
    return jax.random.normal(key, shape, jnp.float32) * scale


def setup_inputs(seed: int = 0) -> dict:
    key = jax.random.key(seed)
    ks = jax.random.split(key, 24)
    D, L, dh = D_MODEL, DEPTH, HEAD_DIM
    return {
        "x": _normal(ks[0], (BATCH, SEQ, D), 1.0),
        "c": _normal(ks[1], (BATCH, D), 1.0),
        "w_ada": _normal(ks[2], (L, D, 6 * D), 0.5 * D ** -0.5),
        "b_ada": _normal(ks[3], (L, 6 * D), 0.01),
        "norm1_g": 1.0 + _normal(ks[4], (L, D), 0.01),
        "w_in": _normal(ks[5], (L, D, IN_COLS), D ** -0.5),
        "nsa_q_gain": 1.0 + _normal(ks[6], (L, dh), 0.01),
        "nsa_k_gain": 1.0 + _normal(ks[7], (L, 3, dh), 0.01),
        "cmp_pos": _normal(ks[8], (L, 2, NSA_CMP_LEN, dh), 0.02),
        "cmp_w1": _normal(ks[9], (L, 2, NSA_CMP_LEN * dh, dh), (NSA_CMP_LEN * dh) ** -0.5),
        "cmp_w2": _normal(ks[10], (L, 2, dh, dh), dh ** -0.5),
        "dil_q_gain": 1.0 + _normal(ks[11], (L, dh), 0.01),
        "dil_k_gain": 1.0 + _normal(ks[12], (L, dh), 0.01),
        "w_br_nsa": _normal(ks[13], (L, NSA_HEADS * dh, D), (NSA_HEADS * dh) ** -0.5),
        "w_br_dil": _normal(ks[14], (L, DIL_OUT, D), DIL_OUT ** -0.5),
        "w_out": _normal(ks[15], (L, D, D), D ** -0.5),
        "norm2_g": 1.0 + _normal(ks[16], (L, D), 0.01),
        "peer_w_q": _normal(ks[17], (L, D, PEER_HEADS * 2 * PEER_HALF), D ** -0.5),
        "peer_q_gain": 1.0 + _normal(ks[18], (L, PEER_HEADS, 2, PEER_HALF), 0.01),
        "peer_sub_keys": _normal(ks[19], (L, PEER_HEADS, 2, PEER_N_KEYS, PEER_HALF), PEER_HALF ** -0.5),
        "peer_u": _normal(ks[20], (L, PEER_N_EXPERTS, D), D ** -0.5),
        "peer_v": _normal(ks[21], (L, PEER_N_EXPERTS, D), 0.5),
        "rel_bias": _normal(ks[22], (N_BIAS_HEADS, REL_BUCKETS), 0.1),
    }


def reference(x, c, w_ada, b_ada, norm1_g, w_in, nsa_q_gain, nsa_k_gain, cmp_pos, cmp_w1, cmp_w2,
              dil_q_gain, dil_k_gain, w_br_nsa, w_br_dil, w_out, norm2_g, peer_w_q, peer_q_gain,
              peer_sub_keys, peer_u, peer_v, rel_bias):
    tbl_nsa = rel_bias[:NSA_HEADS]
    tbl_dil = rel_bias[NSA_HEADS:]
    cond = jax.nn.silu(c)
    for layer in range(DEPTH):
        mod = cond @ w_ada[layer] + b_ada[layer]
        sh1, sc1, g1, sh2, sc2, g2 = [m[:, None, :] for m in jnp.split(mod, 6, axis=-1)]
        h = rms_norm(x, norm1_g[layer]) * (1.0 + sc1) + sh1
        x = x + g1 * token_mixer(h, w_in[layer], nsa_q_gain[layer], nsa_k_gain[layer], cmp_pos[layer],
                                 cmp_w1[layer], cmp_w2[layer], dil_q_gain[layer], dil_k_gain[layer],
                                 w_br_nsa[layer], w_br_dil[layer], w_out[layer], tbl_nsa, tbl_dil)
        h = rms_norm(x, norm2_g[layer]) * (1.0 + sc2) + sh2
        x = x + g2 * peer_ffn(h, peer_w_q[layer], peer_q_gain[layer], peer_sub_keys[layer],
                              peer_u[layer], peer_v[layer])
    return x
```

```cpp
#include <hip/hip_runtime.h>
#include <cstdio>
#include <cstdint>

#ifndef PROBE_DUP
#define PROBE_DUP 0
#endif
#ifndef PROBE_PREFIX
#define PROBE_PREFIX -1
#endif
#ifndef MK_ONE_LAUNCH
#define MK_ONE_LAUNCH 1
#endif

__device__ __forceinline__ int phase_tid() { int t = threadIdx.x; asm volatile("" : "+v"(t)); return t; }
namespace pg8 {
#define PG8_LAS __attribute__((address_space(3)))
typedef unsigned short bf16_t;
typedef short bf16x8 __attribute__((ext_vector_type(8)));
typedef float f32x4 __attribute__((ext_vector_type(4)));
typedef unsigned u32x4 __attribute__((ext_vector_type(4)));
typedef unsigned u32x2 __attribute__((ext_vector_type(2)));
constexpr int BM = 256, BK = 64, HALF = 128, HTB = HALF * BK * 2, STAGE_BYTES = 8 * HTB, NXCD = 8, WGM = 8;

__host__ __device__ __forceinline__ int lds_byte(int r, int c) { const int st = (r >> 4) * 2 + (c >> 5), rr = r & 15, cc = c & 31, ob = rr * 64 + cc * 2; return st * 1024 + (ob ^ (((ob >> 9) & 1) << 5)); }
__host__ __device__ __forceinline__ void stage_rc(int b, int& R, int& C) { const int st = b / 1024, sb = b % 1024, swz = sb ^ (((sb >> 9) & 1) << 5); R = (st >> 1) * 16 + swz / 64; C = (st & 1) * 32 + (swz % 64) / 2; }
__host__ __device__ __forceinline__ int perm32(int rho) { const int n = rho >> 4, i = rho & 15; return 8 * (i >> 2) + 4 * n + (i & 3); }

struct Unit { int pm, pn; };
struct Gemm { const bf16_t* A; const bf16_t* Bt; int M, N, K; };

struct StaticOrder {
    int nM, nN, nwg, G, c;
    __host__ __device__ void init(int M, int N, int G_, int c_) { nM = M / BM; nN = N / BM; nwg = nM * nN; G = G_; c = c_; }
    __host__ __device__ bool next(int i, Unit& u) const {
        const long L = (long)i * G + c; if (L >= nwg) return false;
        int wgid = (int)L; { const int q = nwg / NXCD, r = nwg % NXCD, xcd = wgid % NXCD, off = wgid / NXCD; wgid = (xcd < r ? xcd * (q + 1) : r * (q + 1) + (xcd - r) * q) + off; }
        const int nig = WGM * nN, gid = wgid / nig, fm = gid * WGM, gsz = (nM - fm) < WGM ? (nM - fm) : WGM;
        u.pm = fm + ((wgid % nig) % gsz); u.pn = (wgid % nig) / gsz; return true;
    }
    __device__ __forceinline__ void a_ready(const Unit&) const {}
    __device__ __forceinline__ void done(const Unit&) const {}
};

__device__ __forceinline__ unsigned cvt_pk_bf16(float lo, float hi) { unsigned r; asm volatile("v_cvt_pk_bf16_f32 %0, %1, %2" : "=v"(r) : "v"(lo), "v"(hi)); return r; }

struct NoMid { static constexpr int AT = -1; __device__ __forceinline__ void operator()(f32x4 (&)[2][2][4][2], const Unit&, int, int, int, int) const {} };
template <class Epi, class Sched, class Mid = NoMid>
__device__ __forceinline__ void gemm_phase(PG8_LAS unsigned char* lds, const Gemm g, const Sched& S, const Epi& E, const Mid& Mh = Mid()) {
    const int tid = phase_tid(), wid = __builtin_amdgcn_readfirstlane(tid >> 6), lane = tid & 63, wr = wid >> 2, wc = wid & 3, fr = lane & 15, fq = lane >> 4;
    const int K = g.K, nt = K / BK;
    unsigned voffA[2], voffB[2];
#pragma unroll
    for (int i = 0; i < 2; ++i) { int R, C; stage_rc(tid * 16 + i * 8192, R, C); const int Rb = Epi::PERM ? ((R & ~31) + perm32(R & 31)) : R;
        voffA[i] = (unsigned)(R * K + C) * 2u; voffB[i] = (unsigned)(Rb * K + C) * 2u; }
    const size_t kstep = (size_t)(BK * 2);
    const size_t hstep = (size_t)HALF * K * 2;
    const size_t tstep = 2 * hstep;
    const unsigned ldsw = (unsigned)wid * 1024u;
    const int aoff = lds_byte(wr * 64 + fr, fq * 8), boff = lds_byte(wc * 32 + fr, fq * 8);
#define PG8_SA(b, h) (((b) * 2 + (h)) * HTB)
#define PG8_SB(b, h) ((4 + (b) * 2 + (h)) * HTB)
#define PG8_STAGE(bufoff, gbase, voff) do { _Pragma("unroll") for (int _i = 0; _i < 2; ++_i) \
        __builtin_amdgcn_global_load_lds((const unsigned*)((const char*)(gbase) + (voff)[_i]), (PG8_LAS unsigned*)(lds + (bufoff) + ldsw + _i * 8192), 16, 0, 0); } while (0)
#define PG8_LDA(dst, b, h) do { _Pragma("unroll") for (int m = 0; m < 4; ++m) _Pragma("unroll") for (int k = 0; k < 2; ++k) dst[m][k] = *(const PG8_LAS bf16x8*)(lds + PG8_SA(b, h) + aoff + m * 2048 + k * 1024); } while (0)
#define PG8_LDB(dst, b, h) do { _Pragma("unroll") for (int n = 0; n < 2; ++n) _Pragma("unroll") for (int k = 0; k < 2; ++k) dst[n][k] = *(const PG8_LAS bf16x8*)(lds + PG8_SB(b, h) + boff + n * 2048 + k * 1024); } while (0)
#define PG8_MMA(ai, bj, At, Bt) do { __builtin_amdgcn_s_setprio(1); _Pragma("unroll") for (int m = 0; m < 4; ++m) _Pragma("unroll") for (int n = 0; n < 2; ++n) _Pragma("unroll") for (int k = 0; k < 2; ++k) \
        acc[ai][bj][m][n] = __builtin_amdgcn_mfma_f32_16x16x32_bf16(Bt[n][k], At[m][k], acc[ai][bj][m][n], 0, 0, 0); __builtin_amdgcn_s_setprio(0); } while (0)
#define PG8_WAIT_V(n) asm volatile("s_waitcnt vmcnt(" #n ")" ::: "memory")
#define PG8_WAIT_L(n) asm volatile("s_waitcnt lgkmcnt(" #n ")" ::: "memory")
#define PG8_BAR __builtin_amdgcn_s_barrier()
#define PG8_SCHED __builtin_amdgcn_sched_barrier(0)
    Unit cur, nxt; int ui = 0;
    if (!S.next(0, cur)) return;
    f32x4 acc[2][2][4][2];
#pragma unroll
    for (int a = 0; a < 2; ++a)
#pragma unroll
        for (int b = 0; b < 2; ++b)
#pragma unroll
            for (int m = 0; m < 4; ++m)
#pragma unroll
                for (int n = 0; n < 2; ++n) acc[a][b][m][n] = (f32x4){0.f, 0.f, 0.f, 0.f};
    bf16x8 At[4][2], B0[2][2], B1[2][2];
    const char* cA = (const char*)g.A + (size_t)cur.pm * tstep; const char* cB = (const char*)g.Bt + (size_t)cur.pn * tstep;
    S.a_ready(cur);
    PG8_STAGE(PG8_SB(0, 0), cB, voffB); PG8_STAGE(PG8_SA(0, 0), cA, voffA); PG8_STAGE(PG8_SB(0, 1), cB + hstep, voffB); PG8_STAGE(PG8_SA(0, 1), cA + hstep, voffA);
    if (wr == 1) PG8_BAR;
    PG8_WAIT_V(4); PG8_BAR;
    PG8_STAGE(PG8_SB(1, 0), cB + kstep, voffB); PG8_STAGE(PG8_SA(1, 0), cA + kstep, voffA); PG8_STAGE(PG8_SB(1, 1), cB + hstep + kstep, voffB);
    PG8_WAIT_V(6); PG8_BAR;
    for (;;) {
        const bool has_next = S.next(ui + 1, nxt);
        const char* nA = has_next ? (const char*)g.A + (size_t)nxt.pm * tstep : cA; const char* nB = has_next ? (const char*)g.Bt + (size_t)nxt.pn * tstep : cB;
#define PG8_KBODY \
            const bool last = (t == nt - 2); \
            const char* a1 = cA + (size_t)(t + 1) * kstep; \
            const char* a2 = last ? nA : cA + (size_t)(t + 2) * kstep; const char* b2 = last ? nB : cB + (size_t)(t + 2) * kstep; \
            const char* a3 = a2 + kstep; const char* b3 = b2 + kstep; \
            if (last && has_next) S.a_ready(nxt); \
            PG8_LDB(B0, 0, 0); PG8_SCHED; PG8_LDA(At, 0, 0); PG8_STAGE(PG8_SA(1, 1), a1 + hstep, voffA); \
            PG8_WAIT_L(8); PG8_BAR; PG8_WAIT_L(0); PG8_MMA(0, 0, At, B0); PG8_BAR; PG8_SCHED; \
            PG8_LDB(B1, 0, 1); PG8_STAGE(PG8_SB(0, 0), b2, voffB); \
            PG8_BAR; PG8_WAIT_L(0); PG8_MMA(0, 1, At, B1); PG8_BAR; \
            PG8_LDA(At, 0, 1); PG8_STAGE(PG8_SA(0, 0), a2, voffA); \
            PG8_BAR; PG8_WAIT_L(0); PG8_MMA(1, 0, At, B0); PG8_BAR; PG8_SCHED; \
            PG8_STAGE(PG8_SB(0, 1), b2 + hstep, voffB); \
            PG8_WAIT_V(6); PG8_BAR; PG8_MMA(1, 1, At, B1); PG8_BAR; \
            PG8_LDB(B0, 1, 0); PG8_SCHED; PG8_LDA(At, 1, 0); PG8_STAGE(PG8_SA(0, 1), a2 + hstep, voffA); \
            PG8_WAIT_L(8); PG8_BAR; PG8_WAIT_L(0); PG8_MMA(0, 0, At, B0); PG8_BAR; PG8_SCHED; \
            PG8_LDB(B1, 1, 1); PG8_STAGE(PG8_SB(1, 0), b3, voffB); \
            PG8_BAR; PG8_WAIT_L(0); PG8_MMA(0, 1, At, B1); PG8_BAR; \
            PG8_LDA(At, 1, 1); PG8_STAGE(PG8_SA(1, 0), a3, voffA); \
            PG8_BAR; PG8_WAIT_L(0); PG8_MMA(1, 0, At, B0); PG8_BAR; PG8_SCHED; \
            PG8_STAGE(PG8_SB(1, 1), b3 + hstep, voffB); \
            PG8_WAIT_V(6); PG8_BAR; PG8_MMA(1, 1, At, B1); PG8_BAR;
        if constexpr (Mid::AT >= 0) {
            for (int t = 0; t < Mid::AT; t += 2) { PG8_KBODY }
            Mh(acc, cur, wr, wc, fr, fq);
            for (int t = Mid::AT; t < nt; t += 2) { PG8_KBODY }
        } else {
            for (int t = 0; t < nt; t += 2) { PG8_KBODY }
        }
#undef PG8_KBODY
        E(acc, cur, wr, wc, fr, fq); S.done(cur);
        if (!has_next) break;
#pragma unroll
        for (int a = 0; a < 2; ++a)
#pragma unroll
            for (int b = 0; b < 2; ++b)
#pragma unroll
                for (int m = 0; m < 4; ++m)
#pragma unroll
                    for (int n = 0; n < 2; ++n) acc[a][b][m][n] = (f32x4){0.f, 0.f, 0.f, 0.f};
        cur = nxt; cA = nA; cB = nB; ++ui;
    }
    PG8_WAIT_V(0);
    if (wr == 0) PG8_BAR;
    PG8_BAR;
#undef PG8_SA
#undef PG8_SB
#undef PG8_STAGE
#undef PG8_LDA
#undef PG8_LDB
#undef PG8_MMA
#undef PG8_WAIT_V
#undef PG8_WAIT_L
#undef PG8_BAR
#undef PG8_SCHED
}
}

#define GAS __attribute__((address_space(1)))
#define LAS __attribute__((address_space(3)))
typedef unsigned short bf16;
typedef float f32x4 __attribute__((ext_vector_type(4)));
typedef unsigned v4u __attribute__((ext_vector_type(4)));
typedef unsigned v2u __attribute__((ext_vector_type(2)));

constexpr int NB = 4, S = 4096, D = 2048, T = NB * S, HD = 128;
constexpr int IN_COLS = 11288, OFF_KV = 1024, OFF_GATE = 2560, OFF_DIL = 2584, OFF_MERGE = 7192;
constexpr int NPROJ = 11264;
constexpr int NQ = 1024, NKV = 1536, NDL = 4608, NMG = 4096;
constexpr int NC = 255, NS = 64;
constexpr int NE = 16384;
constexpr float EPS = 1e-6f;
constexpr float QSCALE = 0.08838834764831845f;
constexpr int NWAVES = 8, NTHREADS = 512;

constexpr size_t MiB = 1u << 20;
constexpr size_t WS_CTL = 0, CTL_ZERO_BYTES = 1 * MiB;
constexpr size_t WS_WIN = 1 * MiB;
constexpr size_t WS_WBN = 45 * MiB;
constexpr size_t WS_WBD = 49 * MiB;
constexpr size_t WS_WOUT = 51 * MiB;
constexpr size_t WS_WPQ = 59 * MiB;
constexpr size_t WS_WGATE = 67 * MiB;
constexpr size_t WS_MOD = 67 * MiB + 256 * 1024;
constexpr size_t WS_SEL = 67 * MiB + 512 * 1024;
constexpr size_t WS_GATES = 68 * MiB;
constexpr size_t WS_KC = 70 * MiB;
constexpr size_t WS_VC = 71 * MiB;
constexpr size_t WS_H = 72 * MiB;
constexpr size_t WS_Q = 136 * MiB;
constexpr size_t WS_KV = 168 * MiB;
constexpr size_t WS_DL = 216 * MiB;
constexpr size_t WS_MG = 360 * MiB;
constexpr size_t WS_YN = 488 * MiB;
constexpr size_t WS_YD = 520 * MiB;
constexpr size_t WS_EI = 536 * MiB;
constexpr size_t WS_EG = 544 * MiB;
constexpr size_t WS_END = 552 * MiB;
constexpr size_t WS_PU = WS_Q;
constexpr size_t WS_PV = WS_Q + 64 * MiB;
constexpr size_t WS_QP = WS_MG;
static_assert(WS_PV + 64 * MiB <= WS_MG, "u/v overlay");

constexpr int LDS_BYTES = 147456;
constexpr int LDS_MISC = 144 * 1024 - 256;

#define XB_TMO      128
#define XB_XCNT(j)  (256  + 64 * (j))
#define XB_XSUB(j)  (1280 + 64 * (j))
#define XB_XGEN(j)  (2304 + 64 * (j))
#define XB_TOP      3328
#define XB_TOPGEN   3392
#define XCD_BAR_WORDS 3456
#define XB_SPIN_CAP (1u << 24)

__device__ __forceinline__ unsigned xb_ld(unsigned* p)              { return __hip_atomic_load(p, __ATOMIC_RELAXED, __HIP_MEMORY_SCOPE_AGENT); }
__device__ __forceinline__ unsigned xb_add(unsigned* p, unsigned v) { return __hip_atomic_fetch_add(p, v, __ATOMIC_RELAXED, __HIP_MEMORY_SCOPE_AGENT); }
__device__ __forceinline__ unsigned xb_xcc_id() { return (unsigned)__builtin_amdgcn_s_getreg((3 << 11) | 20) & 0xFu; }
#define XB_SPIN(cond, bar) do { unsigned _sp = 0; while (cond) { __builtin_amdgcn_s_sleep(1); \
    if ((++_sp & 255u) == 0u) { if (xb_ld(&(bar)[XB_TMO])) break; if (_sp > XB_SPIN_CAP) { atomicAdd(&(bar)[XB_TMO], 1u); break; } } } } while (0)

struct XcdBarrier { unsigned* bar; unsigned x; volatile LAS unsigned* st; };

__device__ __forceinline__ XcdBarrier xcd_barrier_post(unsigned* bar, volatile LAS unsigned* st) {
    XcdBarrier b; b.bar = bar; b.x = xb_xcc_id(); b.st = st;
    if (threadIdx.x == 0) (void)xb_add(&bar[XB_XCNT(b.x)], 1u);
    return b;
}
__device__ __forceinline__ void xcd_barrier_complete(unsigned* bar, unsigned x, unsigned& nloc, unsigned& nx) {
    const unsigned G = gridDim.x * gridDim.y * gridDim.z;
    unsigned sum, cnt, mine, sp = 0u;
    for (;;) {
        sum = 0u; cnt = 0u; mine = 0u;
#pragma unroll
        for (unsigned j = 0; j < 16; ++j) { const unsigned c = xb_ld(&bar[XB_XCNT(j)]); sum += c; cnt += (c > 0u) ? 1u : 0u; mine = (j == x) ? c : mine; }
        if (sum == G) break;
        __builtin_amdgcn_s_sleep(1);
        if ((++sp & 255u) == 0u) { if (xb_ld(&bar[XB_TMO])) break; if (sp > XB_SPIN_CAP) { atomicAdd(&bar[XB_TMO], 1u); break; } }
    }
    nloc = mine > 0u ? mine : 1u; nx = cnt > 0u ? cnt : 1u;
}
__device__ __forceinline__ void xcd_barrier(const XcdBarrier& b) {
    asm volatile("s_waitcnt vmcnt(0)" ::: "memory");
    __syncthreads();
    if (threadIdx.x == 0) {
        unsigned* bar = b.bar;
        __builtin_amdgcn_s_waitcnt(0);
        unsigned nloc = b.st[0], nx = b.st[1];
        if (nloc == 0u) { xcd_barrier_complete(bar, b.x, nloc, nx); b.st[0] = nloc; b.st[1] = nx; }
        const unsigned old = xb_add(&bar[XB_XSUB(b.x)], 1u);
        const unsigned gen = old / nloc;
        if (old + 1u == (gen + 1u) * nloc) {
            __builtin_amdgcn_fence(__ATOMIC_RELEASE, "agent");
            asm volatile("s_waitcnt vmcnt(0)" ::: "memory");
            const unsigned og = xb_add(&bar[XB_TOP], 1u);
            const unsigned tg = og / nx;
            if (og + 1u == (tg + 1u) * nx) xb_add(&bar[XB_TOPGEN], 1u);
            else XB_SPIN(xb_ld(&bar[XB_TOPGEN]) == tg, bar);
            __builtin_amdgcn_fence(__ATOMIC_ACQUIRE, "agent");
            xb_add(&bar[XB_XGEN(b.x)], 1u);
            asm volatile("s_waitcnt vmcnt(0)" ::: "memory");
        } else {
            XB_SPIN(xb_ld(&bar[XB_XGEN(b.x)]) == gen, bar);
            __builtin_amdgcn_fence(__ATOMIC_ACQUIRE, "agent");
            asm volatile("s_waitcnt vmcnt(0)" ::: "memory");
        }
    }
    __syncthreads();
}

__device__ __forceinline__ unsigned f2bf(float f) { unsigned u = __builtin_bit_cast(unsigned, f); return (u + 0x7fffu + ((u >> 16) & 1u)) >> 16; }
__device__ __forceinline__ unsigned pk2(float lo, float hi) { return f2bf(lo) | (f2bf(hi) << 16); }
__device__ __forceinline__ float bflo(unsigned u) { return __builtin_bit_cast(float, u << 16); }
__device__ __forceinline__ float bfhi(unsigned u) { return __builtin_bit_cast(float, u & 0xffff0000u); }
__device__ __forceinline__ float bf2f(bf16 u) { return __builtin_bit_cast(float, (unsigned)u << 16); }
__device__ __forceinline__ float wave_sum(float v) {
#pragma unroll
    for (int o = 1; o < 64; o <<= 1) v += __shfl_xor(v, o);
    return v;
}
__device__ __forceinline__ float wave_max(float v) {
#pragma unroll
    for (int o = 1; o < 64; o <<= 1) v = fmaxf(v, __shfl_xor(v, o));
    return v;
}
__device__ __forceinline__ float sigmoidf(float x) { return __builtin_amdgcn_rcpf(1.f + __expf(-x)); }
__device__ __forceinline__ float gelu_tanh(float x) { const float u = 0.7978845608028654f * (x + 0.044715f * x * x * x); return 0.5f * x * (1.f + tanhf(u)); }
__device__ __forceinline__ int t5_bucket(int n) {
    if (n < 16) return n;
    int b = 16;
    b += (n >= 22); b += (n >= 30); b += (n >= 40); b += (n >= 54); b += (n >= 73); b += (n >= 99); b += (n >= 134); b += (n >= 182);
    b += (n >= 246); b += (n >= 332); b += (n >= 450); b += (n >= 609); b += (n >= 825); b += (n >= 1117); b += (n >= 1513);
    return b;
}

struct Args {
    const float* in[23];
    float* out; unsigned char* ws;
    int ph_lo, ph_hi;
};

typedef float f32x2v __attribute__((ext_vector_type(2)));
__device__ __forceinline__ void ph0_mod(const Args& a, LAS unsigned char* lds) {
    const int tid = phase_tid(), lane = tid & 63, wave = __builtin_amdgcn_readfirstlane(tid >> 6);
    LAS float* cs = (LAS float*)lds;
    LAS float* red = (LAS float*)(lds + 32768);
    const float* c = a.in[1]; const float* w_ada = a.in[2]; const float* b_ada = a.in[3];
    float* mod = (float*)(a.ws + WS_MOD);
    for (int i = tid; i < 4 * 2048; i += NTHREADS) { const float v = c[i]; cs[i] = v / (1.f + __expf(-v)); }
    __syncthreads();
    for (int u = blockIdx.x; u < 12288 / 128; u += gridDim.x) {
        const int col = u * 128 + 2 * lane;
        float acc[4][2];
#pragma unroll
        for (int b = 0; b < 4; ++b) { acc[b][0] = 0.f; acc[b][1] = 0.f; }
        const float* wp = w_ada + (size_t)(wave * 256) * 12288 + col;
#pragma unroll 1
        for (int k0 = 0; k0 < 256; k0 += 16) {
            f32x2v w[16];
#pragma unroll
            for (int k = 0; k < 16; ++k) w[k] = *(const f32x2v*)(wp + (size_t)(k0 + k) * 12288);
#pragma unroll
            for (int k = 0; k < 16; ++k) { const int kk = wave * 256 + k0 + k;
#pragma unroll
                for (int b = 0; b < 4; ++b) { const float cv = cs[b * 2048 + kk]; acc[b][0] += cv * w[k].x; acc[b][1] += cv * w[k].y; } }
        }
#pragma unroll
        for (int b = 0; b < 4; ++b) { red[(wave * 4 + b) * 128 + 2 * lane] = acc[b][0]; red[(wave * 4 + b) * 128 + 2 * lane + 1] = acc[b][1]; }
        __syncthreads();
        { const int b = tid >> 7, cc = tid & 127; float s = 0.f;
#pragma unroll
          for (int w = 0; w < 8; ++w) s += red[(w * 4 + b) * 128 + cc];
          mod[b * 12288 + u * 128 + cc] = s + b_ada[u * 128 + cc]; }
        __syncthreads();
    }
}
__device__ __forceinline__ void transpose_item(const float* W, int ldw, int ncols, int K, bf16* WT, int row_off, LAS float* scr, int item, int lane, int ldt = 0) {
    if (ldt == 0) ldt = K;
    const int nblk = ncols / 32, kb = item / nblk, nb = item % nblk, k0 = 64 * kb, n0 = 32 * nb;
    float tv[32];
#pragma unroll
    for (int i = 0; i < 32; ++i) tv[i] = W[(size_t)(k0 + 2 * i + (lane >> 5)) * ldw + n0 + (lane & 31)];
#pragma unroll
    for (int i = 0; i < 32; ++i) scr[(2 * i + (lane >> 5)) * 33 + (lane & 31)] = tv[i];
    asm volatile("s_waitcnt lgkmcnt(0)" ::: "memory");
    const int c = lane & 7;
#pragma unroll
    for (int j = 0; j < 4; ++j) { const int n = (lane >> 3) + 8 * j; const LAS float* s = scr + (8 * c) * 33 + n;
        v4u o; o.x = pk2(s[0 * 33], s[1 * 33]); o.y = pk2(s[2 * 33], s[3 * 33]); o.z = pk2(s[4 * 33], s[5 * 33]); o.w = pk2(s[6 * 33], s[7 * 33]);
        *(v4u*)(WT + (size_t)(row_off + n0 + n) * ldt + k0 + 8 * c) = o; }
    asm volatile("s_waitcnt lgkmcnt(0)" ::: "memory");
}
__device__ __forceinline__ void ph0_weights(const Args& a, LAS unsigned char* lds) {
    const int tid = phase_tid(), lane = tid & 63, wave = __builtin_amdgcn_readfirstlane(tid >> 6);
    LAS float* scr = (LAS float*)(lds + wave * 16384);
    const int gw = blockIdx.x * NWAVES + wave, NGW = gridDim.x * NWAVES;
    const float* w_in = a.in[5];
    bf16* WIN = (bf16*)(a.ws + WS_WIN);
    constexpr int I_Q = 32 * (NQ / 32), I_KV = 32 * (NKV / 32), I_DL = 32 * (NDL / 32), I_MG = 32 * (NMG / 32);
    constexpr int I_BN = 16 * 64, I_BD = 8 * 64, I_O = 32 * 64, I_PQ = 32 * 64;
    constexpr int NITEMS = I_Q + I_KV + I_DL + I_MG + I_BN + I_BD + I_O + I_PQ;
    for (int it = gw; it < NITEMS; it += NGW) {
        int r = it;
        if (r < I_Q)  { transpose_item(w_in, IN_COLS, NQ, D, WIN, 0, scr, r, lane); continue; } r -= I_Q;
        if (r < I_KV) { transpose_item(w_in + OFF_KV, IN_COLS, NKV, D, WIN, NQ, scr, r, lane); continue; } r -= I_KV;
        if (r < I_DL) { transpose_item(w_in + OFF_DIL, IN_COLS, NDL, D, WIN, NQ + NKV, scr, r, lane); continue; } r -= I_DL;
        if (r < I_MG) { transpose_item(w_in + OFF_MERGE, IN_COLS, NMG, D, WIN, NQ + NKV + NDL, scr, r, lane); continue; } r -= I_MG;
        if (r < I_BN) { transpose_item(a.in[13], D, D, 1024, (bf16*)(a.ws + WS_WBN), 0, scr, r, lane, 1536); continue; } r -= I_BN;
        if (r < I_BD) { transpose_item(a.in[14], D, D, 512, (bf16*)(a.ws + WS_WBN) + 1024, 0, scr, r, lane, 1536); continue; } r -= I_BD;
        if (r < I_O)  { transpose_item(a.in[15], D, D, D, (bf16*)(a.ws + WS_WOUT), 0, scr, r, lane); continue; } r -= I_O;
        transpose_item(a.in[17], D, D, D, (bf16*)(a.ws + WS_WPQ), 0, scr, r, lane);
    }
}

constexpr size_t WS_CW1F = 602 * MiB;
constexpr size_t WS_WGF = 604 * MiB;
constexpr size_t WS_CBP = 604 * MiB + 256 * 1024;
constexpr size_t WS_END4 = 605 * MiB;
__device__ __forceinline__ void ph0_extra(const Args& a) {
    const int tid = phase_tid(), lane = tid & 63, wave = __builtin_amdgcn_readfirstlane(tid >> 6);
    const float* w1 = a.in[9]; const float* pos = a.in[8]; const float* w_in = a.in[5];
    v4u* CW = (v4u*)(a.ws + WS_CW1F); v4u* WG = (v4u*)(a.ws + WS_WGF); float* CBP = (float*)(a.ws + WS_CBP);
    for (int i = blockIdx.x * NTHREADS + tid; i < 2 * 4 * 256 * 64; i += gridDim.x * NTHREADS) {
        const int ln = i & 63, ks = (i >> 6) & 255, nt = (i >> 14) & 3, j = i >> 16;
        const float* src = w1 + ((size_t)j * 4096 + 16 * ks + 8 * (ln >> 5)) * 128 + 32 * nt + (ln & 31);
        v4u o; o.x = pk2(src[0], src[128]); o.y = pk2(src[256], src[384]); o.z = pk2(src[512], src[640]); o.w = pk2(src[768], src[896]);
        CW[i] = o;
    }
    for (int i = blockIdx.x * NTHREADS + tid; i < 128 * 64; i += gridDim.x * NTHREADS) {
        const int ln = i & 63, ks = i >> 6, jrow = ln & 31;
        v4u o = {0u, 0u, 0u, 0u};
        if (jrow < 24) { const float* src = w_in + (size_t)(16 * ks + 8 * (ln >> 5)) * IN_COLS + OFF_GATE + jrow;
            o.x = pk2(src[0], src[IN_COLS]); o.y = pk2(src[2 * (size_t)IN_COLS], src[3 * (size_t)IN_COLS]); o.z = pk2(src[4 * (size_t)IN_COLS], src[5 * (size_t)IN_COLS]); o.w = pk2(src[6 * (size_t)IN_COLS], src[7 * (size_t)IN_COLS]); }
        WG[i] = o;
    }
    { const int gw = blockIdx.x * NWAVES + wave;
      if (gw < 128) { const int kc = gw >> 1, j = gw & 1; float s0 = 0.f, s1 = 0.f; const float* wp = w1 + ((size_t)j * 4096 + 64 * kc) * 128 + lane; const float* pp = pos + j * 4096 + 64 * kc;
#pragma unroll 1
          for (int k0 = 0; k0 < 64; k0 += 16) { float wa[16], wb[16];
#pragma unroll
              for (int k = 0; k < 16; ++k) { wa[k] = wp[(k0 + k) * 128]; wb[k] = wp[(k0 + k) * 128 + 64]; }
#pragma unroll
              for (int k = 0; k < 16; ++k) { const float pv = pp[k0 + k]; s0 += pv * wa[k]; s1 += pv * wb[k]; } }
          CBP[(kc * 2 + j) * 128 + lane] = s0; CBP[(kc * 2 + j) * 128 + 64 + lane] = s1; } }
}

__device__ __forceinline__ void ph_norm(const Args& a, const float* xin, const float* gvec, int sh_off, int sc_off, bf16* hout) {
    const int tid = phase_tid(), lane = tid & 63, wave = __builtin_amdgcn_readfirstlane(tid >> 6);
    const int gw = blockIdx.x * NWAVES + wave, NGW = gridDim.x * NWAVES;
    const float* mod = (const float*)(a.ws + WS_MOD);
    for (int r = gw; r < S / 2; r += NGW)
#pragma unroll 1
        for (int bq = 0; bq < NB; ++bq) {
            const int m0 = bq * S + r, m1 = m0 + S / 2;
            const float* x0 = xin + (size_t)m0 * D + 8 * lane; const float* x1 = xin + (size_t)m1 * D + 8 * lane;
            f32x4 v0[8], v1[8];
#pragma unroll
            for (int c = 0; c < 4; ++c) { v0[2 * c] = *(const f32x4*)(x0 + 512 * c); v0[2 * c + 1] = *(const f32x4*)(x0 + 512 * c + 4); v1[2 * c] = *(const f32x4*)(x1 + 512 * c); v1[2 * c + 1] = *(const f32x4*)(x1 + 512 * c + 4); }
            float s0 = 0.f, s1 = 0.f;
#pragma unroll
            for (int i = 0; i < 8; ++i) { s0 += (v0[i].x * v0[i].x + v0[i].y * v0[i].y) + (v0[i].z * v0[i].z + v0[i].w * v0[i].w); s1 += (v1[i].x * v1[i].x + v1[i].y * v1[i].y) + (v1[i].z * v1[i].z + v1[i].w * v1[i].w); }
            const float r0 = rsqrtf(wave_sum(s0) * (1.f / D) + EPS), r1 = rsqrtf(wave_sum(s1) * (1.f / D) + EPS);
            const float* shp = mod + bq * 12288 + sh_off + 8 * lane; const float* scp = mod + bq * 12288 + sc_off + 8 * lane; const float* gp = gvec + 8 * lane;
#pragma unroll
            for (int c = 0; c < 4; ++c) {
                v4u o0, o1; unsigned w0[4], w1[4];
#pragma unroll
                for (int hq = 0; hq < 2; ++hq) { const f32x4 g = *(const f32x4*)(gp + 512 * c + 4 * hq), sc = *(const f32x4*)(scp + 512 * c + 4 * hq), sh = *(const f32x4*)(shp + 512 * c + 4 * hq);
                    const f32x4 ga = g * (1.f + sc); const f32x4 y0 = v0[2 * c + hq] * r0 * ga + sh, y1 = v1[2 * c + hq] * r1 * ga + sh;
                    w0[2 * hq] = pk2(y0.x, y0.y); w0[2 * hq + 1] = pk2(y0.z, y0.w); w1[2 * hq] = pk2(y1.x, y1.y); w1[2 * hq + 1] = pk2(y1.z, y1.w); }
                o0.x = w0[0]; o0.y = w0[1]; o0.z = w0[2]; o0.w = w0[3]; o1.x = w1[0]; o1.y = w1[1]; o1.z = w1[2]; o1.w = w1[3];
                *(v4u*)(hout + (size_t)m0 * D + 512 * c + 8 * lane) = o0; *(v4u*)(hout + (size_t)m1 * D + 512 * c + 8 * lane) = o1;
            }
        }
}

using pg8::Unit; using pg8::HALF; using pg8::BM;
struct EpiProj {
    static constexpr bool PERM = true;
    bf16 *q, *kv, *dl, *mg;
    __device__ __forceinline__ void operator()(const f32x4 (&acc)[2][2][4][2], const Unit& u, int wr, int wc, int fr, int fq) const {
        bf16* base; int ldc, colt = u.pn * BM;
        if (colt < NQ) { base = q; ldc = NQ; } else if (colt < NQ + NKV) { base = kv; ldc = NKV; colt -= NQ; } else if (colt < NQ + NKV + NDL) { base = dl; ldc = NDL; colt -= NQ + NKV; } else { base = mg; ldc = NMG; colt -= NQ + NKV + NDL; }
        const int row0 = u.pm * BM + wr * 64 + fr, col0 = colt + wc * 32 + 8 * fq;
#pragma unroll
        for (int ai = 0; ai < 2; ++ai)
#pragma unroll
            for (int m = 0; m < 4; ++m) { bf16* rowp = base + (size_t)(row0 + ai * HALF + m * 16) * ldc + col0;
#pragma unroll
                for (int bj = 0; bj < 2; ++bj) { const f32x4 v0 = acc[ai][bj][m][0], v1 = acc[ai][bj][m][1];
                    v4u w; w.x = pg8::cvt_pk_bf16(v0[0], v0[1]); w.y = pg8::cvt_pk_bf16(v0[2], v0[3]); w.z = pg8::cvt_pk_bf16(v1[0], v1[1]); w.w = pg8::cvt_pk_bf16(v1[2], v1[3]);
                    *(v4u*)(rowp + bj * HALF) = w; } }
    }
};
struct MidMerge {
    static constexpr int AT = 16;
    const bf16* mg;
    __device__ __forceinline__ void operator()(f32x4 (&acc)[2][2][4][2], const Unit& u, int wr, int wc, int fr, int fq) const {
        int row0 = u.pm * BM + wr * 64 + fr; const int col0 = u.pn * BM + wc * 32 + 8 * fq;
        asm volatile("" : "+v"(row0));
#pragma unroll
        for (int ai = 0; ai < 2; ++ai) {
            v4u a1[4][2], a2[4][2];
#pragma unroll
            for (int m = 0; m < 4; ++m) { const bf16* rp = mg + (size_t)(row0 + ai * HALF + m * 16) * NMG + col0;
#pragma unroll
                for (int bj = 0; bj < 2; ++bj) { a1[m][bj] = *(const v4u*)(rp + bj * HALF); a2[m][bj] = *(const v4u*)(rp + 2048 + bj * HALF); } }
#pragma unroll
            for (int m = 0; m < 4; ++m)
#pragma unroll
                for (int bj = 0; bj < 2; ++bj) { const unsigned w1[4] = {a1[m][bj].x, a1[m][bj].y, a1[m][bj].z, a1[m][bj].w}, w2[4] = {a2[m][bj].x, a2[m][bj].y, a2[m][bj].z, a2[m][bj].w};
#pragma unroll
                    for (int q = 0; q < 4; ++q) { const float r0 = (1.f + __expf(-bflo(w2[q]))) * __builtin_amdgcn_rcpf(1.f + __expf(-bflo(w1[q]))), r1 = (1.f + __expf(-bfhi(w2[q]))) * __builtin_amdgcn_rcpf(1.f + __expf(-bfhi(w1[q])));
                        acc[ai][bj][m][q >> 1][2 * (q & 1)] *= r0; acc[ai][bj][m][q >> 1][2 * (q & 1) + 1] *= r1; } }
            asm volatile("" ::: "memory");
        }
    }
};
struct EpiMerge {
    static constexpr bool PERM = true;
    const bf16* mg; bf16* merged;
    __device__ __forceinline__ void operator()(const f32x4 (&acc)[2][2][4][2], const Unit& u, int wr, int wc, int fr, int fq) const {
        int row0 = u.pm * BM + wr * 64 + fr; const int col0 = u.pn * BM + wc * 32 + 8 * fq;
        asm volatile("" : "+v"(row0));
        v4u a2[2][4][2];
#pragma unroll
        for (int ai = 0; ai < 2; ++ai)
#pragma unroll
            for (int m = 0; m < 4; ++m)
#pragma unroll
                for (int bj = 0; bj < 2; ++bj) a2[ai][m][bj] = *(const v4u*)(mg + (size_t)(row0 + ai * HALF + m * 16) * NMG + 2048 + col0 + bj * HALF);
#pragma unroll
        for (int ai = 0; ai < 2; ++ai)
#pragma unroll
            for (int m = 0; m < 4; ++m) { const size_t row = (size_t)(row0 + ai * HALF + m * 16);
#pragma unroll
                for (int bj = 0; bj < 2; ++bj) { const unsigned w2[4] = {a2[ai][m][bj].x, a2[ai][m][bj].y, a2[ai][m][bj].z, a2[ai][m][bj].w};
                    const f32x4 v0 = acc[ai][bj][m][0], v1 = acc[ai][bj][m][1];
                    v4u w; w.x = pg8::cvt_pk_bf16(v0[0] * sigmoidf(bflo(w2[0])), v0[1] * sigmoidf(bfhi(w2[0]))); w.y = pg8::cvt_pk_bf16(v0[2] * sigmoidf(bflo(w2[1])), v0[3] * sigmoidf(bfhi(w2[1])));
                    w.z = pg8::cvt_pk_bf16(v1[0] * sigmoidf(bflo(w2[2])), v1[1] * sigmoidf(bfhi(w2[2]))); w.w = pg8::cvt_pk_bf16(v1[2] * sigmoidf(bflo(w2[3])), v1[3] * sigmoidf(bfhi(w2[3])));
                    *(v4u*)(merged + row * D + col0 + bj * HALF) = w; } }
    }
};
struct EpiOut {
    static constexpr bool PERM = false;
    const float* x; const float* mod; float* x1;
    __device__ __forceinline__ void operator()(const f32x4 (&acc)[2][2][4][2], const Unit& u, int wr, int wc, int fr, int fq) const {
        const int row0 = u.pm * BM + wr * 64 + fr, col0 = u.pn * BM + wc * 32 + 4 * fq;
        const int b = (u.pm * BM) / S;
        f32x4 gv[2][2];
#pragma unroll
        for (int bj = 0; bj < 2; ++bj)
#pragma unroll
            for (int n = 0; n < 2; ++n) gv[bj][n] = *(const f32x4*)(mod + b * 12288 + 4096 + col0 + bj * HALF + n * 16);
#pragma unroll
        for (int ai = 0; ai < 2; ++ai)
#pragma unroll
            for (int m = 0; m < 4; ++m) { const size_t off = (size_t)(row0 + ai * HALF + m * 16) * D + col0;
#pragma unroll
                for (int bj = 0; bj < 2; ++bj)
#pragma unroll
                    for (int n = 0; n < 2; ++n) *(f32x4*)(x1 + off + bj * HALF + n * 16) = *(const f32x4*)(x + off + bj * HALF + n * 16) + gv[bj][n] * acc[ai][bj][m][n]; }
    }
};
struct EpiF32 {
    static constexpr bool PERM = false;
    float* C; int ldc;
    __device__ __forceinline__ void operator()(const f32x4 (&acc)[2][2][4][2], const Unit& u, int wr, int wc, int fr, int fq) const {
        const int row0 = u.pm * BM + wr * 64 + fr, col0 = u.pn * BM + wc * 32 + 4 * fq;
#pragma unroll
        for (int ai = 0; ai < 2; ++ai)
#pragma unroll
            for (int m = 0; m < 4; ++m) { float* rowp = C + (size_t)(row0 + ai * HALF + m * 16) * ldc + col0;
#pragma unroll
                for (int bj = 0; bj < 2; ++bj)
#pragma unroll
                    for (int n = 0; n < 2; ++n) *(f32x4*)(rowp + bj * HALF + n * 16) = acc[ai][bj][m][n]; }
    }
};

typedef short bf16x8 __attribute__((ext_vector_type(8)));
typedef float f32x16 __attribute__((ext_vector_type(16)));
typedef float f32x2 __attribute__((ext_vector_type(2)));
typedef __bf16 bf2v __attribute__((ext_vector_type(2)));
constexpr float LOG2E = 1.4426950408889634f;
constexpr float QS2 = QSCALE * LOG2E;
constexpr float NEGB = -1e30f;
__device__ __forceinline__ unsigned pkbf(float a, float b) { const f32x2 v = {a, b}; const bf2v r = __builtin_convertvector(v, bf2v); return __builtin_bit_cast(unsigned, r); }
__device__ __forceinline__ float ex2(float x) { return __builtin_amdgcn_exp2f(x); }
__device__ __forceinline__ int swap23(int x) { return (x & ~12) | ((x & 4) << 1) | ((x & 8) >> 1); }
__device__ __forceinline__ size_t kf_off(int key, int d) { return ((size_t)((key >> 5) * 8 + (d >> 4)) * 64 + ((d >> 3) & 1) * 32 + swap23(key & 31)) * 8 + (d & 7); }
__device__ __forceinline__ size_t vf_off(int key, int d) { const int kk = key & 31; return ((size_t)(((key >> 5) * 4 + (d >> 5)) * 2 + (kk >> 4)) * 64 + ((kk >> 3) & 1) * 32 + (d & 31)) * 8 + (kk & 7); }
__device__ __forceinline__ bf16* fr_nsa(const Args& a, int bg, int kind) { return (bf16*)a.out + ((size_t)(bg * 4 + kind) << 19); }
__device__ __forceinline__ bf16* fr_dil(const Args& a, int b, int head, int kv) { return (bf16*)a.out + ((size_t)16 << 20) + ((size_t)((b * 12 + head) * 2 + kv) << 19); }
constexpr size_t WS_OD = 552 * MiB;
constexpr size_t WS_LSE = 600 * MiB;
constexpr size_t WS_END2 = 601 * MiB;

__device__ __forceinline__ v4u norm_chunk16v(v4u w, const float* gain, float scale, int li) {
    float v[8] = {bflo(w.x), bfhi(w.x), bflo(w.y), bfhi(w.y), bflo(w.z), bfhi(w.z), bflo(w.w), bfhi(w.w)};
    float ss = 0.f;
#pragma unroll
    for (int j = 0; j < 8; ++j) ss += v[j] * v[j];
    ss += __shfl_xor(ss, 1); ss += __shfl_xor(ss, 2); ss += __shfl_xor(ss, 4); ss += __shfl_xor(ss, 8);
    const float rstd = rsqrtf(ss * (1.f / 128.f) + EPS) * scale;
#pragma unroll
    for (int j = 0; j < 8; ++j) v[j] = v[j] * rstd * gain[8 * li + j];
    w.x = pk2(v[0], v[1]); w.y = pk2(v[2], v[3]); w.z = pk2(v[4], v[5]); w.w = pk2(v[6], v[7]);
    return w;
}
__device__ __forceinline__ void ph3_headnorm(const Args& a) {
    const int tid = phase_tid(), lane = tid & 63, wave = __builtin_amdgcn_readfirstlane(tid >> 6), sub = lane >> 4, li = lane & 15;
    const int gw = blockIdx.x * NWAVES + wave, NGW = gridDim.x * NWAVES;
    bf16* Q = (bf16*)(a.ws + WS_Q); const bf16* KV = (const bf16*)(a.ws + WS_KV); bf16* DL = (bf16*)(a.ws + WS_DL);
    const float* qg = a.in[6]; const float* kg = a.in[7]; const float* dqg = a.in[11]; const float* dkg = a.in[12];
    for (int m = gw; m < T; m += NGW) {
        const int b = m / S, s = m % S;
        const int g = sub & 1, win = sub >> 1;
        v4u wq[2], wk, wd[6];
#pragma unroll
        for (int it = 0; it < 2; ++it) wq[it] = *(const v4u*)(Q + (size_t)m * NQ + (it * 4 + sub) * 128 + 8 * li);
        wk = *(const v4u*)(KV + (size_t)m * NKV + ((win ? 8 : 4) + g) * 128 + 8 * li);
#pragma unroll
        for (int it = 0; it < 6; ++it) wd[it] = *(const v4u*)(DL + (size_t)m * NDL + (it * 4 + sub) * 128 + 8 * li);
#pragma unroll
        for (int it = 0; it < 2; ++it) *(v4u*)(Q + (size_t)m * NQ + (it * 4 + sub) * 128 + 8 * li) = norm_chunk16v(wq[it], qg, QS2, li);
        *(v4u*)(fr_nsa(a, b * 2 + g, win ? 2 : 0) + kf_off(s, 8 * li)) = norm_chunk16v(wk, kg + (win ? 256 : 128), 1.f, li);
#pragma unroll
        for (int it = 0; it < 6; ++it) { const int ch = it * 4 + sub;
            if (ch < 12) *(v4u*)(DL + (size_t)m * NDL + ch * 128 + 8 * li) = norm_chunk16v(wd[it], dqg, QS2, li);
            else { const int head = ch - 12, gi = head >> 2, dsh = 2 * gi  , vk = ((s & ((1 << dsh) - 1)) << (12 - dsh)) + (s >> dsh);
                *(v4u*)(fr_dil(a, b, head, 0) + kf_off(vk, 8 * li)) = norm_chunk16v(wd[it], dkg, 1.f, li); } }
    }
}
__device__ __forceinline__ void ph3_vfrag(const Args& a) {
    const int tid = phase_tid(), lane = tid & 63, wave = __builtin_amdgcn_readfirstlane(tid >> 6);
    const int gw = blockIdx.x * NWAVES + wave, NGW = gridDim.x * NWAVES;
    const bf16* KV = (const bf16*)(a.ws + WS_KV); const bf16* DL = (const bf16*)(a.ws + WS_DL);
    for (int job = gw; job < 32768; job += NGW) {
        const bf16* src; size_t rstride; bf16* dst; int key0;
        if (job < 8192) { const int bg = job >> 10, kind = (job >> 9) & 1, s0 = (job & 511) * 8, b = bg >> 1, g = bg & 1;
            src = KV + (size_t)(b * S + s0) * NKV + ((kind ? 10 : 6) + g) * 128; rstride = NKV; dst = fr_nsa(a, bg, kind ? 3 : 1); key0 = s0; }
        else { const int j2 = job - 8192, bh = j2 >> 9, vk0 = (j2 & 511) * 8, b = bh / 12, head = bh % 12, gi = head >> 2, dsh = 2 * gi, L = S >> dsh, r = vk0 / L, m0 = vk0 % L;
            src = DL + (size_t)(b * S + (m0 << dsh) + r) * NDL + (24 + head) * 128; rstride = (size_t)NDL << dsh; dst = fr_dil(a, b, head, 1); key0 = vk0; }
        unsigned w[8];
#pragma unroll
        for (int jj = 0; jj < 8; ++jj) w[jj] = *(const unsigned*)(src + jj * rstride + 2 * lane);
        v4u c0, c1;
        c0.x = (w[0] & 0xffffu) | (w[1] << 16); c0.y = (w[2] & 0xffffu) | (w[3] << 16); c0.z = (w[4] & 0xffffu) | (w[5] << 16); c0.w = (w[6] & 0xffffu) | (w[7] << 16);
        c1.x = (w[0] >> 16) | (w[1] & 0xffff0000u); c1.y = (w[2] >> 16) | (w[3] & 0xffff0000u); c1.z = (w[4] >> 16) | (w[5] & 0xffff0000u); c1.w = (w[6] >> 16) | (w[7] & 0xffff0000u);
        *(v4u*)(dst + vf_off(key0, 2 * lane)) = c0; *(v4u*)(dst + vf_off(key0, 2 * lane + 1)) = c1;
    }
}
__device__ __forceinline__ void ph3_gates(const Args& a) {
    const int tid = phase_tid(), lane = tid & 63, wave = __builtin_amdgcn_readfirstlane(tid >> 6), tl = lane & 31, hh = lane >> 5;
    const int gw = (gridDim.x - 1 - blockIdx.x) * NWAVES + wave, NGW = gridDim.x * NWAVES;
    const bf16* H = (const bf16*)(a.ws + WS_H); const v4u* WG = (const v4u*)(a.ws + WS_WGF) + lane; float* gates = (float*)(a.ws + WS_GATES);
    for (int job = gw; job < T / 32; job += NGW) {
        const int t = job * 32 + tl; const bf16* hr = H + (size_t)t * D + 8 * hh;
        f32x16 acc;
#pragma unroll
        for (int i = 0; i < 16; ++i) acc[i] = 0.f;
#pragma unroll 4
        for (int ks = 0; ks < 128; ++ks) { const bf16x8 af = __builtin_bit_cast(bf16x8, WG[ks * 64]), bfr = __builtin_bit_cast(bf16x8, *(const v4u*)(hr + 16 * ks));
            acc = __builtin_amdgcn_mfma_f32_32x32x16_bf16(af, bfr, acc, 0, 0, 0); }
#pragma unroll
        for (int i = 0; i < 16; ++i) { const int j = (i & 3) + 8 * (i >> 2) + 4 * hh; const float v = acc[i]; if (j < 24) gates[(size_t)t * 24 + j] = sigmoidf(v); }
    }
}
__device__ __forceinline__ void ph3_compress(const Args& a, LAS unsigned char* lds) {
    const int tid = phase_tid(), lane = tid & 63, wave = __builtin_amdgcn_readfirstlane(tid >> 6), cl = lane & 31, hh = lane >> 5;
    LAS float* part = (LAS float*)lds;
    LAS float* hid = part + 2 * 128 * 32;
    LAS float* ob = hid + 32 * 128;
    LAS float* bias = ob + 32 * 128;
    const bf16* KV = (const bf16*)(a.ws + WS_KV);
    const float* w2 = a.in[10]; const float* kg0 = a.in[7]; const float* CBP = (const float*)(a.ws + WS_CBP);
    for (int u = blockIdx.x; u < 128; u += gridDim.x) {
        const int j = u >> 6, bg = (u >> 3) & 7, ct = u & 7, b = bg >> 1, g = bg & 1, c0 = 32 * ct, hhd = j * 2 + g;
        if (tid < 128) { float s = 0.f;
#pragma unroll
            for (int kc = 0; kc < 64; ++kc) s += CBP[(kc * 2 + j) * 128 + tid];
            bias[tid] = s; }
        { const int nt = wave & 3, kh = wave >> 2, c = c0 + cl;
          const v4u* af = (const v4u*)(a.ws + WS_CW1F) + ((size_t)(j * 4 + nt) * 256 + 128 * kh) * 64 + lane;
          f32x16 acc;
#pragma unroll
          for (int i = 0; i < 16; ++i) acc[i] = 0.f;
#pragma unroll 4
          for (int ks = 0; ks < 128; ++ks) { const int k = 16 * (128 * kh + ks) + 8 * hh, l = k >> 7, d = k & 127, p = 16 * c + l;
              v4u x = {0u, 0u, 0u, 0u}; if (p < S) x = *(const v4u*)(KV + (size_t)(b * S + p) * NKV + hhd * 128 + d);
              acc = __builtin_amdgcn_mfma_f32_32x32x16_bf16(__builtin_bit_cast(bf16x8, af[ks * 64]), __builtin_bit_cast(bf16x8, x), acc, 0, 0, 0); }
#pragma unroll
          for (int i = 0; i < 16; ++i) { const int n = 32 * nt + (i & 3) + 8 * (i >> 2) + 4 * hh; const float v = acc[i]; part[(kh * 128 + n) * 32 + cl] = v; } }
        __syncthreads();
        for (int i = tid; i < 128 * 32; i += NTHREADS) { const int n = i >> 5, c = i & 31; hid[c * 128 + n] = gelu_tanh(part[i] + part[128 * 32 + i] + bias[n]); }
        __syncthreads();
        { const int n = tid & 127, cq = tid >> 7; float o[8];
#pragma unroll
          for (int r = 0; r < 8; ++r) o[r] = 0.f;
          const float* w2p = w2 + j * 128 * 128 + n;
          for (int k = 0; k < 128; ++k) { const float w = w2p[k * 128];
#pragma unroll
              for (int r = 0; r < 8; ++r) o[r] += hid[(8 * cq + r) * 128 + k] * w; }
#pragma unroll
          for (int r = 0; r < 8; ++r) ob[(8 * cq + r) * 128 + n] = o[r]; }
        __syncthreads();
        bf16* fr = (bf16*)(a.ws + (j == 0 ? WS_KC : WS_VC)) + (size_t)bg * 8 * 4096;
#pragma unroll 1
        for (int r = 0; r < 4; ++r) { const int cr = 4 * wave + r, c = c0 + cr; float v0 = ob[cr * 128 + 2 * lane], v1 = ob[cr * 128 + 2 * lane + 1];
            if (j == 0) { const float rstd = rsqrtf(wave_sum(v0 * v0 + v1 * v1) * (1.f / 128.f) + EPS); v0 = v0 * rstd * kg0[2 * lane]; v1 = v1 * rstd * kg0[2 * lane + 1]; }
            if (c >= NC) { v0 = 0.f; v1 = 0.f; }
            if (j == 0) *(unsigned*)(fr + kf_off(c, 2 * lane)) = pk2(v0, v1);
            else { fr[vf_off(c, 2 * lane)] = (bf16)f2bf(v0); fr[vf_off(c, 2 * lane + 1)] = (bf16)f2bf(v1); } }
        __syncthreads();
    }
}

#define KBI(i) (16 * ((i) >> 3) + ((i) & 7))
__device__ __forceinline__ void load_frags(bf16x8 (&f)[8], const v4u* p, int lane) {
#pragma unroll
    for (int i = 0; i < 8; ++i) f[i] = __builtin_bit_cast(bf16x8, p[i * 64 + lane]);
}
__device__ __forceinline__ f32x16 qk_mma(const bf16x8 (&qf)[8], const bf16x8 (&k)[8]) {
    f32x16 s;
#pragma unroll
    for (int i = 0; i < 16; ++i) s[i] = 0.f;
#pragma unroll
    for (int st = 0; st < 8; ++st) s = __builtin_amdgcn_mfma_f32_32x32x16_bf16(k[st], qf[st], s, 0, 0, 0);
    return s;
}
__device__ __forceinline__ bf16x8 ldsq(const LAS unsigned char* ql, int st, int lane) { return __builtin_bit_cast(bf16x8, *(const LAS v4u*)(ql + st * 1024 + lane * 16)); }
__device__ __forceinline__ f32x16 qk_tile(const bf16x8 (&qf)[8], const v4u* kf, int lane) { bf16x8 k[8]; load_frags(k, kf, lane); return qk_mma(qf, k); }
template <int STRIDE> __device__ __forceinline__ void add_tbl(f32x16& s, const LAS float* tp2, float pen) {
#pragma unroll
    for (int i = 0; i < 16; ++i) s[i] += tp2[STRIDE * (23 - KBI(i))] + pen;
}
__device__ __forceinline__ void mask_hi(f32x16& s, int lim) {
#pragma unroll
    for (int i = 0; i < 16; ++i) s[i] = (KBI(i) <= lim) ? s[i] : NEGB;
}
__device__ __forceinline__ void mask_lo(f32x16& s, int lim) {
#pragma unroll
    for (int i = 0; i < 16; ++i) s[i] = (KBI(i) >= lim) ? s[i] : NEGB;
}
__device__ __forceinline__ float max16(const f32x16& s) {
    float mx = fmaxf(s[0], s[1]);
#pragma unroll
    for (int i = 2; i < 16; ++i) mx = fmaxf(mx, s[i]);
    return fmaxf(mx, __shfl_xor(mx, 32));
}
__device__ __forceinline__ void pv_tile(const f32x16& p, f32x16 (&o)[4], const bf16x8 (&v)[8]) {
    v4u a0, a1;
    a0.x = pkbf(p[0], p[1]); a0.y = pkbf(p[2], p[3]); a0.z = pkbf(p[4], p[5]); a0.w = pkbf(p[6], p[7]);
    a1.x = pkbf(p[8], p[9]); a1.y = pkbf(p[10], p[11]); a1.z = pkbf(p[12], p[13]); a1.w = pkbf(p[14], p[15]);
    const bf16x8 pb0 = __builtin_bit_cast(bf16x8, a0), pb1 = __builtin_bit_cast(bf16x8, a1);
#pragma unroll
    for (int dt = 0; dt < 4; ++dt) { o[dt] = __builtin_amdgcn_mfma_f32_32x32x16_bf16(v[2 * dt], pb0, o[dt], 0, 0, 0); o[dt] = __builtin_amdgcn_mfma_f32_32x32x16_bf16(v[2 * dt + 1], pb1, o[dt], 0, 0, 0); }
}
__device__ __forceinline__ void softmax_pv(f32x16& s, f32x16 (&o)[4], float& m, float& l, const v4u* vf, int lane) {
    bf16x8 v[8];
#pragma unroll
    for (int i = 0; i < 8; ++i) v[i] = __builtin_bit_cast(bf16x8, vf[i * 64 + lane]);
    const float mn = fmaxf(m, max16(s));
    if (__ballot(mn > m + 8.f)) {
        const float corr = ex2(m - mn);
#pragma unroll
        for (int dt = 0; dt < 4; ++dt)
#pragma unroll
            for (int i = 0; i < 16; ++i) o[dt][i] *= corr;
        l *= corr; m = mn;
    }
    float ps = 0.f;
#pragma unroll
    for (int i = 0; i < 16; ++i) { s[i] = ex2(s[i] - m); ps += s[i]; }
    l += ps;
    pv_tile(s, o, v);
}
template <int NP = 0> __device__ __forceinline__ void softmax_pv_v(f32x16& s, f32x16 (&o)[4], float& m, float& l, const bf16x8 (&v)[8]) {
    if (NP == 2) { l += s[0]; pv_tile(s, o, v); return; }
    const float mn = fmaxf(m, max16(s));
    if (__ballot(mn > m + 8.f)) {
        const float corr = ex2(m - mn);
#pragma unroll
        for (int dt = 0; dt < 4; ++dt)
#pragma unroll
            for (int i = 0; i < 16; ++i) o[dt][i] *= corr;
        l *= corr; m = mn;
    }
    float ps = 0.f;
#pragma unroll
    for (int i = 0; i < 16; ++i) { s[i] = ex2(s[i] - m); ps += s[i]; }
    l += ps;
    pv_tile(s, o, v);
}
__device__ __forceinline__ void zero_o(f32x16 (&o)[4]) {
#pragma unroll
    for (int dt = 0; dt < 4; ++dt)
#pragma unroll
        for (int i = 0; i < 16; ++i) o[dt][i] = 0.f;
}
__device__ __forceinline__ void y_update(bf16* yp  , const f32x16 (&o)[4], float sc, bool acc) {
#pragma unroll
    for (int dt = 0; dt < 4; ++dt)
#pragma unroll
        for (int i4 = 0; i4 < 4; ++i4) { bf16* p = yp + 32 * dt + 8 * i4;
            float v0 = o[dt][4 * i4] * sc, v1 = o[dt][4 * i4 + 1] * sc, v2 = o[dt][4 * i4 + 2] * sc, v3 = o[dt][4 * i4 + 3] * sc;
            if (acc) { const v2u w = *(const v2u*)p; v0 += bflo(w.x); v1 += bfhi(w.x); v2 += bflo(w.y); v3 += bfhi(w.y); }
            v2u w; w.x = pkbf(v0, v1); w.y = pkbf(v2, v3); *(v2u*)p = w; }
}
constexpr int TBLN = 2624;
constexpr int OFF_TBL = 0, OFF_IMP = 43008, OFF_SELM = OFF_IMP + 65536, OFF_DTBL = OFF_SELM + 512;
constexpr int FAR_DIST = 1513;

template <int NP> __device__ __forceinline__ void nsa_unit(const Args& a, LAS unsigned char* lds, int u, int tid) {
    const int lane = tid & 63, wave = __builtin_amdgcn_readfirstlane(tid >> 6);
    const int qb = u >> 3, bg = u & 7, b = bg >> 1, g = bg & 1;
    const int r = wave >> 1, qs = wave & 1, hd = g * 4 + r, ql = lane & 31, h = lane >> 5;
    const int q0w = 64 * qb + 32 * qs, sq = q0w + ql, t = b * S + sq;
    LAS float* tball = (LAS float*)(lds + OFF_TBL);
    LAS float* imp = (LAS float*)(lds + OFF_IMP);
    LAS unsigned long long* selm = (LAS unsigned long long*)(lds + OFF_SELM);
    const float* relb = a.in[22];
    for (int i = tid; i < 4 * TBLN; i += NTHREADS) { const int hh = i / TBLN, dd = i % TBLN - 64; tball[i] = dd >= 0 ? relb[(g * 4 + hh) * 32 + t5_bucket(dd)] * LOG2E : 0.f; }
    for (int i = tid; i < 4 * 64 * 64; i += NTHREADS) imp[i] = 0.f;
    __syncthreads();
    const LAS float* tbl = tball + r * TBLN + 64;
    const float farc = relb[hd * 32 + 31] * LOG2E;
    bf16x8 qf[8];
    { const bf16* qrow = (const bf16*)(a.ws + WS_Q) + (size_t)t * NQ + hd * 128 + 8 * h;
#pragma unroll
      for (int st = 0; st < 8; ++st) qf[st] = __builtin_bit_cast(bf16x8, *(const v4u*)(qrow + 16 * st)); }
    const float* gt = (const float*)(a.ws + WS_GATES) + (size_t)t * 24 + hd * 3;
    const float g0 = gt[0], g1 = gt[1], g2 = gt[2];
    bf16* yp = (bf16*)(a.ws + (NP ? WS_H : WS_YN)) + (size_t)t * 1536 + hd * 128 + 4 * h;
    f32x16 o[4];
    {
        const v4u* kfc = (const v4u*)(a.ws + WS_KC) + (size_t)bg * 8 * 512; const v4u* vfc = (const v4u*)(a.ws + WS_VC) + (size_t)bg * 8 * 512;
        const int smax = q0w + 31, ncv = smax >= 31 ? ((smax - 31) >> 4) + 1 : 0, ntc = (ncv + 31) >> 5;
        float m = NEGB, l = 0.f;
        for (int tc = 0; tc < ntc; ++tc) {
            f32x16 s = qk_tile(qf, kfc + tc * 512, lane);
            const int dqc = sq - 31 - 512 * tc;
            if (q0w - 31 - 512 * tc - 496 >= FAR_DIST) {
#pragma unroll
                for (int i = 0; i < 16; ++i) s[i] += farc;
            } else add_tbl<16>(s, tbl + dqc - 16 * (8 * h + 23), 0.f);
            mask_hi(s, (dqc >> 4) - 8 * h);
            const float mn = fmaxf(m, max16(s));
            float ps = 0.f;
#pragma unroll
            for (int i = 0; i < 16; ++i) ps += ex2(s[i] - mn);
            l = l * ex2(m - mn) + ps; m = mn;
        }
        l += __shfl_xor(l, 32);
        const float inv = (sq >= 31) ? 1.f / l : 0.f;
        zero_o(o);
        LAS float* impq = imp + (r * 64 + 32 * qs + ql) * 64;
        for (int tc = 0; tc < ntc; ++tc) {
            f32x16 s = qk_tile(qf, kfc + tc * 512, lane);
            bf16x8 v[8];
#pragma unroll
            for (int i = 0; i < 8; ++i) v[i] = __builtin_bit_cast(bf16x8, vfc[tc * 512 + i * 64 + lane]);
            const int dqc = sq - 31 - 512 * tc;
            if (q0w - 31 - 512 * tc - 496 >= FAR_DIST) {
#pragma unroll
                for (int i = 0; i < 16; ++i) s[i] += farc;
            } else add_tbl<16>(s, tbl + dqc - 16 * (8 * h + 23), 0.f);
            mask_hi(s, (dqc >> 4) - 8 * h);
#pragma unroll
            for (int i = 0; i < 16; ++i) s[i] = ex2(s[i] - m) * inv;
#pragma unroll
            for (int a2 = 0; a2 < 2; ++a2)
#pragma unroll
                for (int bq = 0; bq < 2; ++bq) { const int j = 8 * tc + 4 * a2 + 2 * h + bq; const int i0 = 8 * a2 + 4 * bq;
                    impq[j] += (s[i0] + s[i0 + 1]) + (s[i0 + 2] + s[i0 + 3]); }
            asm volatile("s_waitcnt lgkmcnt(0)" ::: "memory");
#pragma unroll
            for (int a2 = 0; a2 < 2; ++a2)
#pragma unroll
                for (int bq = 0; bq < 2; ++bq) { const int j = 8 * tc + 4 * a2 + 2 * h + bq + 1; if (j < 64) impq[j] += s[8 * a2 + 4 * bq + 3]; }
            asm volatile("s_waitcnt lgkmcnt(0)" ::: "memory");
            pv_tile(s, o, v);
        }
        y_update(yp, o, g0, false);
    }
    __syncthreads();
    for (int qq = wave * 8; qq < wave * 8 + 8; ++qq) {
        const int jb = lane;
        const float im = ((imp[(0 * 64 + qq) * 64 + jb] + imp[(1 * 64 + qq) * 64 + jb]) + imp[(2 * 64 + qq) * 64 + jb]) + imp[(3 * 64 + qq) * 64 + jb];
        const bool forced = (jb == 0) || (jb == qb) || (jb == qb - 1);
        const float score = forced ? 1e4f : (jb > qb ? -1e4f : im);
        int rank = 0;
        for (int o2 = 0; o2 < 64; ++o2) { const float so = __shfl(score, o2); rank += (so > score) || (so == score && o2 < jb); }
        const unsigned long long mask = __ballot(rank < 16 && jb <= qb);
        if (lane == 0) selm[qq] = mask;
    }
    __syncthreads();
    {
        const v4u* kfw = (const v4u*)fr_nsa(a, bg, 2); const v4u* vfw = (const v4u*)fr_nsa(a, bg, 3);
        const int t_hi = q0w >> 5, t_lo = t_hi - 16;
        float m = NEGB, l = 0.f; zero_o(o);
        const int t0 = t_lo < 0 ? 0 : t_lo;
        for (int tt = t0; tt <= t_hi; ++tt) {
            const size_t to = (NP == 3) ? (size_t)(tt & 1) * 512 : (size_t)tt * 512;
            bf16x8 kf[8], vf[8]; load_frags(kf, kfw + to, lane);
            f32x16 s = qk_mma(qf, kf); load_frags(vf, vfw + to, lane);
            const int dq = sq - 32 * tt;
            add_tbl<1>(s, tbl + dq - (8 * h + 23), 0.f);
            if (tt == t_hi) mask_hi(s, dq - 8 * h);
            if (tt == t_lo) mask_lo(s, dq - 511 - 8 * h);
            softmax_pv_v<NP>(s, o, m, l, vf);
        }
        l += __shfl_xor(l, 32);
        y_update(yp, o, g2 / l, true);
    }
    {
        const v4u* kfs = (const v4u*)fr_nsa(a, bg, 0); const v4u* vfs = (const v4u*)fr_nsa(a, bg, 1);
        const unsigned long long mask = selm[32 * qs + ql];
        float m = NEGB, l = 0.f; zero_o(o);
        const int t_end = 2 * qb + qs;
        LAS unsigned char* qlds = lds + OFF_IMP + wave * 8192;
#pragma unroll
        for (int st = 0; st < 8; ++st) *(LAS v4u*)(qlds + st * 1024 + lane * 16) = __builtin_bit_cast(v4u, qf[st]);
        asm volatile("s_waitcnt lgkmcnt(0)" ::: "memory");
        for (int jb = 0; jb <= qb; ++jb) {
            const float pen = ((mask >> jb) & 1ull) ? 0.f : NEGB;
            if (__ballot(pen == 0.f) == 0ull) continue;
            const int ta = 2 * jb, tb = ta + 1;
            const bool two = tb <= t_end;
            bf16x8 ka[8], kb[8];
            load_frags(ka, kfs + (size_t)ta * 512, lane);
            load_frags(kb, kfs + (size_t)(two ? tb : ta) * 512, lane);
            f32x16 sa, sb;
#pragma unroll
            for (int i = 0; i < 16; ++i) { sa[i] = 0.f; sb[i] = 0.f; }
#pragma unroll
            for (int st = 0; st < 8; ++st) { const bf16x8 q = ldsq(qlds, st, lane); sa = __builtin_amdgcn_mfma_f32_32x32x16_bf16(ka[st], q, sa, 0, 0, 0); sb = __builtin_amdgcn_mfma_f32_32x32x16_bf16(kb[st], q, sb, 0, 0, 0); }
            bf16x8 va[8], vb[8];
            load_frags(va, vfs + (size_t)ta * 512, lane);
            load_frags(vb, vfs + (size_t)(two ? tb : ta) * 512, lane);
            const int dqa = sq - 32 * ta, dqb = dqa - 32;
            if (q0w - (32 * tb + 31) >= FAR_DIST) {
                const float c = farc + pen;
#pragma unroll
                for (int i = 0; i < 16; ++i) { sa[i] += c; sb[i] += c; }
            } else { add_tbl<1>(sa, tbl + dqa - (8 * h + 23), pen); add_tbl<1>(sb, tbl + dqb - (8 * h + 23), pen); }
            if (ta == t_end) mask_hi(sa, dqa - 8 * h);
            if (tb == t_end) mask_hi(sb, dqb - 8 * h);
            if (!two) {
#pragma unroll
                for (int i = 0; i < 16; ++i) sb[i] = NEGB;
            }
            const float mn = fmaxf(m, fmaxf(max16(sa), max16(sb)));
            if (__ballot(mn > m + 8.f)) {
                const float corr = ex2(m - mn);
#pragma unroll
                for (int dt = 0; dt < 4; ++dt)
#pragma unroll
                    for (int i = 0; i < 16; ++i) o[dt][i] *= corr;
                l *= corr; m = mn;
            }
            float ps = 0.f;
#pragma unroll
            for (int i = 0; i < 16; ++i) { sa[i] = ex2(sa[i] - m); sb[i] = ex2(sb[i] - m); ps += sa[i] + sb[i]; }
            l += ps;
            pv_tile(sa, o, va);
            pv_tile(sb, o, vb);
        }
        l += __shfl_xor(l, 32);
        y_update(yp, o, g1 / l, true);
    }
    __syncthreads();
}
__device__ __forceinline__ void dil_unit(const Args& a, LAS unsigned char* lds, int u, int tid) {
    const int lane = tid & 63, wave = __builtin_amdgcn_readfirstlane(tid >> 6), ql = lane & 31, h = lane >> 5;
    const int b = u >> 6, p = (u >> 4) & 3, c = u & 15, s0 = 256 * c;
    LAS float* dtbl = (LAS float*)(lds + OFF_DTBL);
    const float* relb = a.in[22] + 8 * 32;
    for (int i = tid; i < 3 * 192; i += NTHREADS) { const int gi = i / 192, dm = i % 192 - 32; dtbl[i] = dm >= 0 ? relb[(gi * 4 + p) * 32 + t5_bucket(dm << (2 * gi))] * LOG2E : 0.f; }
    __syncthreads();
    bf16* OD = (bf16*)(a.ws + WS_OD); float* LSE = (float*)(a.ws + WS_LSE);
    const bf16* DL = (const bf16*)(a.ws + WS_DL);
    for (int job = wave; job < 32; job += NWAVES) {
        int gi, rr, m0, vlo, vhi;
        if (job < 8) { gi = 0; rr = 0; m0 = s0 + 32 * job; vlo = 0; vhi = 32; }
        else if (job < 16) { gi = 1; rr = (job - 8) >> 1; m0 = (s0 >> 2) + 32 * (job & 1); vlo = 0; vhi = 32; }
        else { gi = 2; rr = job - 16; m0 = 32 * (c >> 1); vlo = 16 * (c & 1); vhi = vlo + 16; }
        const int dsh = 2 * gi, L = S >> dsh, head = gi * 4 + p;
        const int mq = m0 + ql, sact = (mq << dsh) + rr, t = b * S + sact;
        const v4u* kf = (const v4u*)fr_dil(a, b, head, 0) + (size_t)((rr * L) >> 5) * 512; const v4u* vf = (const v4u*)fr_dil(a, b, head, 1) + (size_t)((rr * L) >> 5) * 512;
        bf16x8 qf[8];
        { const bf16* qrow = DL + (size_t)t * NDL + head * 128 + 8 * h;
#pragma unroll
          for (int st = 0; st < 8; ++st) qf[st] = __builtin_bit_cast(bf16x8, *(const v4u*)(qrow + 16 * st)); }
        const LAS float* tb = dtbl + gi * 192 + 32;
        const int t_hi = m0 >> 5, t_lo = t_hi - 4;
        float m = NEGB, l = 0.f; f32x16 o[4]; zero_o(o);
        const int t0 = t_lo < 0 ? 0 : t_lo;
        for (int tt = t0; tt <= t_hi; ++tt) {
            bf16x8 kr[8], vr[8]; load_frags(kr, kf + (size_t)tt * 512, lane);
            f32x16 s = qk_mma(qf, kr); load_frags(vr, vf + (size_t)tt * 512, lane);
            const int dq = mq - 32 * tt;
            add_tbl<1>(s, tb + dq - (8 * h + 23), 0.f);
            if (tt == t_hi) mask_hi(s, dq - 8 * h);
            if (tt == t_lo) mask_lo(s, dq - 128 - 8 * h);
            softmax_pv_v(s, o, m, l, vr);
        }
        l += __shfl_xor(l, 32);
        if (ql >= vlo && ql < vhi) {
            y_update(OD + ((size_t)gi * T + t) * 512 + p * 128 + 4 * h, o, 1.f / l, false);
            if (h == 0) LSE[((size_t)(gi * NB + b) * 4 + p) * S + sact] = m + __log2f(l);
        }
    }
    __syncthreads();
    { const int pos = tid >> 1, dh = tid & 1, sact = s0 + pos, t = b * S + sact;
      const float l0 = LSE[((size_t)(0 * NB + b) * 4 + p) * S + sact], l1 = LSE[((size_t)(1 * NB + b) * 4 + p) * S + sact], l2 = LSE[((size_t)(2 * NB + b) * 4 + p) * S + sact];
      const float mx = fmaxf(l0, fmaxf(l1, l2)); float w0 = ex2(l0 - mx), w1 = ex2(l1 - mx), w2 = ex2(l2 - mx); const float iw = 1.f / (w0 + w1 + w2); w0 *= iw; w1 *= iw; w2 *= iw;
      bf16* yd = (bf16*)(a.ws + WS_YN) + (size_t)t * 1536 + 1024 + p * 128 + 64 * dh;
      const bf16* o0 = OD + ((size_t)0 * T + t) * 512 + p * 128 + 64 * dh; const bf16* o1 = OD + ((size_t)1 * T + t) * 512 + p * 128 + 64 * dh; const bf16* o2 = OD + ((size_t)2 * T + t) * 512 + p * 128 + 64 * dh;
#pragma unroll
      for (int k = 0; k < 8; ++k) { const v4u x0 = *(const v4u*)(o0 + 8 * k), x1 = *(const v4u*)(o1 + 8 * k), x2 = *(const v4u*)(o2 + 8 * k); v4u y;
          y.x = pkbf(w0 * bflo(x0.x) + w1 * bflo(x1.x) + w2 * bflo(x2.x), w0 * bfhi(x0.x) + w1 * bfhi(x1.x) + w2 * bfhi(x2.x));
          y.y = pkbf(w0 * bflo(x0.y) + w1 * bflo(x1.y) + w2 * bflo(x2.y), w0 * bfhi(x0.y) + w1 * bfhi(x1.y) + w2 * bfhi(x2.y));
          y.z = pkbf(w0 * bflo(x0.z) + w1 * bflo(x1.z) + w2 * bflo(x2.z), w0 * bfhi(x0.z) + w1 * bfhi(x1.z) + w2 * bfhi(x2.z));
          y.w = pkbf(w0 * bflo(x0.w) + w1 * bflo(x1.w) + w2 * bflo(x2.w), w0 * bfhi(x0.w) + w1 * bfhi(x1.w) + w2 * bfhi(x2.w));
          *(v4u*)(yd + 8 * k) = y; } }
    __syncthreads();
}
__device__ __forceinline__ void ph4_attention(const Args& a, LAS unsigned char* lds) {
    const int tid = phase_tid();
    for (int u = blockIdx.x; u < 256; u += gridDim.x) dil_unit(a, lds, u, tid);
#ifndef PROBE_NSA
#define PROBE_NSA 0
#endif
    if (PROBE_NSA) for (int x = blockIdx.x; x < 256; x += gridDim.x) { nsa_unit<PROBE_NSA>(a, lds, 511 - x, tid); nsa_unit<PROBE_NSA>(a, lds, x, tid); }
    for (int x = blockIdx.x; x < 256; x += gridDim.x) { nsa_unit<0>(a, lds, 511 - x, tid); nsa_unit<0>(a, lds, x, tid); }
}

constexpr size_t WS_PU8 = WS_Q;
constexpr size_t WS_PV8 = WS_Q + 32 * MiB;
constexpr size_t WS_PSC = WS_Q + 64 * MiB;
__device__ __forceinline__ void ph_quant_uv(const Args& a) {
    const int tid = phase_tid(), lane = tid & 63, wave = __builtin_amdgcn_readfirstlane(tid >> 6);
    const int gw = blockIdx.x * NWAVES + wave, NGW = gridDim.x * NWAVES;
    float* SC = (float*)(a.ws + WS_PSC);
    for (int rw = gw; rw < NE; rw += NGW) {
        f32x4 x[2][8];
#pragma unroll
        for (int which = 0; which < 2; ++which) { const float* src = a.in[20 + which] + (size_t)rw * D + 16 * lane;
#pragma unroll
            for (int c = 0; c < 2; ++c)
#pragma unroll
                for (int w = 0; w < 4; ++w) x[which][4 * c + w] = *(const f32x4*)(src + 1024 * c + 4 * w); }
#pragma unroll
        for (int which = 0; which < 2; ++which) {
            unsigned char* dst = a.ws + (which ? WS_PV8 : WS_PU8) + (size_t)rw * D + 16 * lane;
            float am = 0.f;
#pragma unroll
            for (int i = 0; i < 8; ++i) am = fmaxf(fmaxf(am, fmaxf(fabsf(x[which][i].x), fabsf(x[which][i].y))), fmaxf(fabsf(x[which][i].z), fabsf(x[which][i].w)));
            am = wave_max(am);
            const float inv = am > 0.f ? 127.f / am : 0.f;
#pragma unroll
            for (int c = 0; c < 2; ++c) { v4u o; unsigned wd[4];
#pragma unroll
                for (int w = 0; w < 4; ++w) { const f32x4 v = x[which][4 * c + w];
                    const unsigned q0 = (unsigned)((int)rintf(v.x * inv) + 128), q1 = (unsigned)((int)rintf(v.y * inv) + 128), q2 = (unsigned)((int)rintf(v.z * inv) + 128), q3 = (unsigned)((int)rintf(v.w * inv) + 128);
                    wd[w] = q0 | (q1 << 8) | (q2 << 16) | (q3 << 24); }
                o.x = wd[0]; o.y = wd[1]; o.z = wd[2]; o.w = wd[3]; *(v4u*)(dst + 1024 * c) = o; }
            if (lane == 0) SC[which * NE + rw] = am * (1.f / 127.f);
        }
    }
}
constexpr size_t WS_KEYF = 601 * MiB;
constexpr size_t WS_END3 = 602 * MiB;
__device__ __forceinline__ void ph0_keyfrags(const Args& a) {
    const int tid = phase_tid();
    const float* keys = a.in[19]; v4u* KF = (v4u*)(a.ws + WS_KEYF);
    for (int i = blockIdx.x * NTHREADS + tid; i < 16 * 32 * 64; i += gridDim.x * NTHREADS) {
        const int lane = i & 63, st = (i >> 6) & 7, kt = (i >> 9) & 3, hp = i >> 11;
        const float* src = keys + ((size_t)hp * 128 + 32 * kt + (lane & 31)) * 128 + 16 * st + 8 * (lane >> 5);
        float v[8]; unsigned hi[8], lo[8];
#pragma unroll
        for (int j = 0; j < 8; ++j) { v[j] = src[j]; hi[j] = f2bf(v[j]); lo[j] = f2bf(v[j] - __builtin_bit_cast(float, hi[j] << 16)); }
        v4u oh, ol; oh.x = hi[0] | (hi[1] << 16); oh.y = hi[2] | (hi[3] << 16); oh.z = hi[4] | (hi[5] << 16); oh.w = hi[6] | (hi[7] << 16);
        ol.x = lo[0] | (lo[1] << 16); ol.y = lo[2] | (lo[3] << 16); ol.z = lo[4] | (lo[5] << 16); ol.w = lo[6] | (lo[7] << 16);
        KF[(size_t)((hp * 2 + 0) * 32 + kt * 8 + st) * 64 + lane] = oh; KF[(size_t)((hp * 2 + 1) * 32 + kt * 8 + st) * 64 + lane] = ol;
    }
}
template <int N, bool MERGE_ONLY> __device__ __forceinline__ void bitonic_desc(float (&v)[N]) {
#pragma unroll
    for (int k = MERGE_ONLY ? N : 2; k <= N; k <<= 1)
#pragma unroll
        for (int j = k >> 1; j > 0; j >>= 1)
#pragma unroll
            for (int i = 0; i < N; ++i) { const int l = i ^ j;
                if (l > i) { const bool desc = ((i & k) == 0) || (k == N); const float x = v[i], y = v[l], hi = fmaxf(x, y), lo = fminf(x, y); v[i] = desc ? hi : lo; v[l] = desc ? lo : hi; } }
}
#define CROW(i) (((i) & 3) + 8 * ((i) >> 2))
__device__ __forceinline__ float max3f(float a, float b, float c) { return fmaxf(fmaxf(a, b), c); }
__device__ __forceinline__ void ph_route(const Args& a, LAS unsigned char* lds) {
    const int tid = phase_tid(), lane = tid & 63, wave = __builtin_amdgcn_readfirstlane(tid >> 6), tl = lane & 31, hc = lane >> 5;
    const int gw = blockIdx.x * NWAVES + wave, NGW = gridDim.x * NWAVES;
    const float* QP = (const float*)(a.ws + WS_QP); const float* qgain = a.in[18]; const v4u* KF = (const v4u*)(a.ws + WS_KEYF);
    int* EI = (int*)(a.ws + WS_EI); float* EG = (float*)(a.ws + WS_EG);
    LAS float* spl = (LAS float*)(lds + wave * 8704) + lane * 33;
    for (int job = gw; job < (T / 32) * 8; job += NGW) {
        const int h = job & 7, t = (job >> 3) * 32 + tl;
#pragma unroll 1
        for (int p = 0; p < 2; ++p) {
            bf16x8 bh[8], bl[8];
            { const float* qr = QP + (size_t)t * D + h * 256 + p * 128 + 8 * hc; const float* gr = qgain + (h * 2 + p) * 128 + 8 * hc;
              float ss = 0.f;
#pragma unroll
              for (int st = 0; st < 8; ++st) { const f32x4 x0 = *(const f32x4*)(qr + 16 * st), x1 = *(const f32x4*)(qr + 16 * st + 4);
                  ss += (x0.x * x0.x + x0.y * x0.y) + (x0.z * x0.z + x0.w * x0.w) + (x1.x * x1.x + x1.y * x1.y) + (x1.z * x1.z + x1.w * x1.w); }
              ss += __shfl_xor(ss, 32);
              const float rstd = rsqrtf(ss * (1.f / 128.f) + EPS);
              asm volatile("" ::: "memory");
#pragma unroll
              for (int st = 0; st < 8; ++st) { const f32x4 x0 = *(const f32x4*)(qr + 16 * st), x1 = *(const f32x4*)(qr + 16 * st + 4); const f32x4 g0 = *(const f32x4*)(gr + 16 * st), g1 = *(const f32x4*)(gr + 16 * st + 4);
                  const float v0 = x0.x * rstd * g0.x, v1 = x0.y * rstd * g0.y, v2 = x0.z * rstd * g0.z, v3 = x0.w * rstd * g0.w, v4 = x1.x * rstd * g1.x, v5 = x1.y * rstd * g1.y, v6 = x1.z * rstd * g1.z, v7 = x1.w * rstd * g1.w;
                  v4u xh, xl; xh.x = pkbf(v0, v1); xh.y = pkbf(v2, v3); xh.z = pkbf(v4, v5); xh.w = pkbf(v6, v7);
                  xl.x = pkbf(v0 - bflo(xh.x), v1 - bfhi(xh.x)); xl.y = pkbf(v2 - bflo(xh.y), v3 - bfhi(xh.y)); xl.z = pkbf(v4 - bflo(xh.z), v5 - bfhi(xh.z)); xl.w = pkbf(v6 - bflo(xh.w), v7 - bfhi(xh.w));
                  bh[st] = __builtin_bit_cast(bf16x8, xh); bl[st] = __builtin_bit_cast(bf16x8, xl); } }
            float sc[64];
            const v4u* kfh = KF + (size_t)(((h * 2 + p) * 2 + 0) * 32) * 64 + lane; const v4u* kfl = KF + (size_t)(((h * 2 + p) * 2 + 1) * 32) * 64 + lane;
#pragma unroll
            for (int kt = 0; kt < 4; ++kt) {
                f32x16 acc;
#pragma unroll
                for (int i = 0; i < 16; ++i) acc[i] = 0.f;
#pragma unroll
                for (int s2 = 0; s2 < 2; ++s2) {
                    asm volatile("" ::: "memory");
                    bf16x8 ah[4], al[4];
#pragma unroll
                    for (int s4 = 0; s4 < 4; ++s4) { ah[s4] = __builtin_bit_cast(bf16x8, kfh[(kt * 8 + s2 * 4 + s4) * 64]); al[s4] = __builtin_bit_cast(bf16x8, kfl[(kt * 8 + s2 * 4 + s4) * 64]); }
#pragma unroll
                    for (int s4 = 0; s4 < 4; ++s4) { const int st = s2 * 4 + s4;
                        acc = __builtin_amdgcn_mfma_f32_32x32x16_bf16(al[s4], bh[st], acc, 0, 0, 0); acc = __builtin_amdgcn_mfma_f32_32x32x16_bf16(ah[s4], bl[st], acc, 0, 0, 0); acc = __builtin_amdgcn_mfma_f32_32x32x16_bf16(ah[s4], bh[st], acc, 0, 0, 0); }
                }
#pragma unroll
                for (int i = 0; i < 16; ++i) { const float av = acc[i];
                    const unsigned bits = (__builtin_bit_cast(unsigned, av) & ~127u) | (unsigned)(127 - (32 * kt + CROW(i) + 4 * hc)); sc[16 * kt + i] = __builtin_bit_cast(float, bits); }
            }
            asm volatile("" ::: "memory");
            bitonic_desc<64, false>(sc);
            float t16[16];
#pragma unroll
            for (int i = 0; i < 16; ++i) t16[i] = __shfl_xor(sc[i], 32);
            float u16[16];
#pragma unroll
            for (int i = 0; i < 16; ++i) u16[i] = fmaxf(sc[i], t16[15 - i]);
            bitonic_desc<16, true>(u16);
#pragma unroll
            for (int i = 0; i < 16; ++i) spl[p * 16 + i] = u16[i];
        }
        asm volatile("s_waitcnt lgkmcnt(0)" ::: "memory");
        float sp[2][16];
#pragma unroll
        for (int i = 0; i < 16; ++i) { sp[0][i] = spl[i]; sp[1][i] = spl[16 + i]; }
        float cv[64];
        {
            int c = 0;
#pragma unroll
            for (int i = 0; i < 16; ++i)
#pragma unroll
                for (int j = 0; j < 16; ++j) if ((i + 1) * (j + 1) <= 16) {
                    const float v = sp[0][i] + sp[1][j];
                    cv[c] = __builtin_bit_cast(float, (__builtin_bit_cast(unsigned, v) & ~255u) | (unsigned)(255 - (i * 16 + j))); ++c; }
#pragma unroll
            for (int i = 50; i < 64; ++i) cv[i] = -INFINITY;
        }
        bitonic_desc<64, false>(cv);
        float tv[16];
#pragma unroll
        for (int i = 0; i < 16; ++i) tv[i] = cv[i];
        asm volatile("s_waitcnt lgkmcnt(0)" ::: "memory");
        int te[16]; float den = 0.f; const float top = tv[0];
#pragma unroll
        for (int i = 0; i < 16; ++i) { const int flat = 255 - (int)(__builtin_bit_cast(unsigned, tv[i]) & 255u);
            const unsigned b1 = __builtin_bit_cast(unsigned, spl[flat >> 4]), b2 = __builtin_bit_cast(unsigned, spl[16 + (flat & 15)]);
            te[i] = (127 - (int)(b1 & 127u)) * 128 + (127 - (int)(b2 & 127u));
            tv[i] = __expf(tv[i] - top); den += tv[i]; }
        den = 1.f / den;
        if (hc == 0) {
            int* ei = EI + (size_t)t * 128 + h * 16; float* eg = EG + (size_t)t * 128 + h * 16;
#pragma unroll
            for (int i = 0; i < 16; i += 4) { *(v4u*)(ei + i) = (v4u){(unsigned)te[i], (unsigned)te[i + 1], (unsigned)te[i + 2], (unsigned)te[i + 3]}; *(f32x4*)(eg + i) = (f32x4){tv[i] * den, tv[i + 1] * den, tv[i + 2] * den, tv[i + 3] * den}; }
        }
        asm volatile("s_waitcnt lgkmcnt(0)" ::: "memory");
    }
}
__device__ __forceinline__ float ub0(unsigned w) { return (float)(w & 0xffu); }
__device__ __forceinline__ float ub1(unsigned w) { return (float)((w >> 8) & 0xffu); }
__device__ __forceinline__ float ub2(unsigned w) { return (float)((w >> 16) & 0xffu); }
__device__ __forceinline__ float ub3(unsigned w) { return (float)(w >> 24); }
__device__ __forceinline__ void ph_experts(const Args& a, const float osc) {
    const int tid = phase_tid(), lane = tid & 63, wave = __builtin_amdgcn_readfirstlane(tid >> 6);
    const int gw = blockIdx.x * NWAVES + wave, NGW = gridDim.x * NWAVES;
    const bf16* H2 = (const bf16*)(a.ws + WS_H); const unsigned char* PU = a.ws + WS_PU8; const unsigned char* PV = a.ws + WS_PV8; const float* SC = (const float*)(a.ws + WS_PSC);
    const int* EI = (const int*)(a.ws + WS_EI); const float* EG = (const float*)(a.ws + WS_EG);
    const float* mod = (const float*)(a.ws + WS_MOD);
    float* out = a.out;
    for (int t = gw; t < T; t += NGW) {
        const int b = t / S;
        float x[32]; float sx = 0.f;
#pragma unroll
        for (int c = 0; c < 2; ++c)
#pragma unroll
            for (int hw = 0; hw < 2; ++hw) { const v4u w = *(const v4u*)(H2 + (size_t)t * D + 1024 * c + 16 * lane + 8 * hw); const int o = 16 * c + 8 * hw;
                x[o + 0] = bflo(w.x); x[o + 1] = bfhi(w.x); x[o + 2] = bflo(w.y); x[o + 3] = bfhi(w.y); x[o + 4] = bflo(w.z); x[o + 5] = bfhi(w.z); x[o + 6] = bflo(w.w); x[o + 7] = bfhi(w.w); }
#pragma unroll
        for (int i = 0; i < 32; ++i) sx += x[i];
        sx = wave_sum(sx) * 128.f;
        const int e0 = EI[(size_t)t * 128 + lane], e1 = EI[(size_t)t * 128 + 64 + lane];
        const float gs0 = EG[(size_t)t * 128 + lane] * SC[NE + e0], gs1 = EG[(size_t)t * 128 + 64 + lane] * SC[NE + e1];
        const float su0 = SC[e0], su1 = SC[e1];
        float cf0 = 0.f, cf1 = 0.f;
#pragma unroll 1
        for (int bt = 0; bt < 16; ++bt) {
            v4u w[8][2];
#pragma unroll
            for (int k = 0; k < 8; ++k) { const int e = __shfl(bt < 8 ? e0 : e1, (bt * 8 + k) & 63); const unsigned char* ur = PU + (size_t)e * D + 16 * lane;
                w[k][0] = *(const v4u*)ur; w[k][1] = *(const v4u*)(ur + 1024); }
#pragma unroll
            for (int k = 0; k < 8; ++k) { float s0 = 0.f, s1 = 0.f;
#pragma unroll
                for (int c = 0; c < 2; ++c) { const v4u q = w[k][c]; const int o = 16 * c;
                    s0 += x[o + 0] * ub0(q.x) + x[o + 1] * ub1(q.x) + x[o + 2] * ub2(q.x) + x[o + 3] * ub3(q.x); s1 += x[o + 4] * ub0(q.y) + x[o + 5] * ub1(q.y) + x[o + 6] * ub2(q.y) + x[o + 7] * ub3(q.y);
                    s0 += x[o + 8] * ub0(q.z) + x[o + 9] * ub1(q.z) + x[o + 10] * ub2(q.z) + x[o + 11] * ub3(q.z); s1 += x[o + 12] * ub0(q.w) + x[o + 13] * ub1(q.w) + x[o + 14] * ub2(q.w) + x[o + 15] * ub3(q.w); }
                const float raw = wave_sum(s0 + s1) - sx;
                if (lane == ((bt * 8 + k) & 63)) { if (bt < 8) cf0 = gelu_tanh(raw * su0) * gs0; else cf1 = gelu_tanh(raw * su1) * gs1; } }
        }
        const float wsum = wave_sum(cf0 + cf1) * 128.f;
        float acc[32];
#pragma unroll
        for (int i = 0; i < 32; ++i) acc[i] = 0.f;
#pragma unroll 1
        for (int bt = 0; bt < 16; ++bt) {
            v4u w[8][2];
#pragma unroll
            for (int k = 0; k < 8; ++k) { const int e = __shfl(bt < 8 ? e0 : e1, (bt * 8 + k) & 63); const unsigned char* vr = PV + (size_t)e * D + 16 * lane;
                w[k][0] = *(const v4u*)vr; w[k][1] = *(const v4u*)(vr + 1024); }
#pragma unroll
            for (int k = 0; k < 8; ++k) { const float cf = __shfl(bt < 8 ? cf0 : cf1, (bt * 8 + k) & 63);
#pragma unroll
                for (int c = 0; c < 2; ++c) { const v4u q = w[k][c]; const int o = 16 * c;
                    acc[o + 0] += cf * ub0(q.x); acc[o + 1] += cf * ub1(q.x); acc[o + 2] += cf * ub2(q.x); acc[o + 3] += cf * ub3(q.x); acc[o + 4] += cf * ub0(q.y); acc[o + 5] += cf * ub1(q.y); acc[o + 6] += cf * ub2(q.y); acc[o + 7] += cf * ub3(q.y);
                    acc[o + 8] += cf * ub0(q.z); acc[o + 9] += cf * ub1(q.z); acc[o + 10] += cf * ub2(q.z); acc[o + 11] += cf * ub3(q.z); acc[o + 12] += cf * ub0(q.w); acc[o + 13] += cf * ub1(q.w); acc[o + 14] += cf * ub2(q.w); acc[o + 15] += cf * ub3(q.w); } }
        }
        const float* g2 = mod + b * 12288 + 10240;
#pragma unroll
        for (int c = 0; c < 2; ++c)
#pragma unroll
            for (int w4 = 0; w4 < 4; ++w4) { float* op = out + (size_t)t * D + 1024 * c + 16 * lane + 4 * w4; const f32x4 ga = *(const f32x4*)(g2 + 1024 * c + 16 * lane + 4 * w4); f32x4 r0 = *(const f32x4*)op; const int o = 16 * c + 4 * w4;
                r0.x += ga.x * (acc[o + 0] - wsum) * osc; r0.y += ga.y * (acc[o + 1] - wsum) * osc; r0.z += ga.z * (acc[o + 2] - wsum) * osc; r0.w += ga.w * (acc[o + 3] - wsum) * osc;
                *(f32x4*)op = r0; }
    }
}

constexpr int N_PHASES = 11;
__global__ void __launch_bounds__(NTHREADS, 2) fwd_kernel(Args a) {
    extern __shared__ __attribute__((aligned(16))) unsigned char lds_raw[];
    LAS unsigned char* lds = (LAS unsigned char*)lds_raw;
    const int tid = threadIdx.x;
    volatile LAS unsigned* misc = (volatile LAS unsigned*)(lds + LDS_MISC);
    if (tid < 16) misc[tid] = 0u;
    __syncthreads();
    XcdBarrier bar; bar.bar = (unsigned*)(a.ws + WS_CTL) + 1024; bar.x = 0; bar.st = nullptr;
    const int lo = a.ph_lo, hi = a.ph_hi;
    if (hi - lo > 1) bar = xcd_barrier_post((unsigned*)(a.ws + WS_CTL) + 1024, misc + 8);
#define IN(k) (lo <= (k) && (k) < hi)
#define SEAM(k) do { if (IN(k) && IN((k) + 1)) xcd_barrier(bar); } while (0)
    const int G = gridDim.x, bx = blockIdx.x;

    for (int rep = 0; rep < 1 + ((PROBE_DUP >> 0) & 1); ++rep)
    if (IN(0)) { ph0_mod(a, lds); __syncthreads(); ph0_weights(a, lds); ph0_keyfrags(a); ph0_extra(a); __syncthreads(); }
    SEAM(0);
    for (int rep = 0; rep < 1 + ((PROBE_DUP >> 1) & 1); ++rep)
    if (IN(1)) ph_norm(a, a.in[0], a.in[4], 0, 2048, (bf16*)(a.ws + WS_H));
    SEAM(1);
    for (int rep = 0; rep < 1 + ((PROBE_DUP >> 2) & 1); ++rep)
    if (IN(2)) { pg8::Gemm g{(const bf16*)(a.ws + WS_H), (const bf16*)(a.ws + WS_WIN), T, NPROJ, D}; pg8::StaticOrder So; So.init(T, NPROJ, G, bx);
        EpiProj E{(bf16*)(a.ws + WS_Q), (bf16*)(a.ws + WS_KV), (bf16*)(a.ws + WS_DL), (bf16*)(a.ws + WS_MG)};
        pg8::gemm_phase<EpiProj, pg8::StaticOrder>(lds, g, So, E); }
    SEAM(2);
    if (IN(3)) { ph3_headnorm(a); for (int rep = 0; rep < 1 + ((PROBE_DUP >> 3) & 1); ++rep) { ph3_vfrag(a); ph3_gates(a); ph3_compress(a, lds); } }
    SEAM(3);
    for (int rep = 0; rep < 1 + ((PROBE_DUP >> 4) & 1); ++rep)
    if (IN(4)) ph4_attention(a, lds);
    SEAM(4);
    for (int rep = 0; rep < 1 + ((PROBE_DUP >> 5) & 1); ++rep)
    if (IN(5)) {
        { pg8::Gemm g{(const bf16*)(a.ws + WS_YN), (const bf16*)(a.ws + WS_WBN), T, D, 1536}; pg8::StaticOrder So; So.init(T, D, G, bx);
          EpiMerge E{(const bf16*)(a.ws + WS_MG), (bf16*)(a.ws + WS_H)}; MidMerge Mh{(const bf16*)(a.ws + WS_MG)};
          pg8::gemm_phase<EpiMerge, pg8::StaticOrder, MidMerge>(lds, g, So, E, Mh); }
    }
    SEAM(5);
    for (int rep = 0; rep < 1 + ((PROBE_DUP >> 6) & 1); ++rep)
    if (IN(6)) { pg8::Gemm g{(const bf16*)(a.ws + WS_H), (const bf16*)(a.ws + WS_WOUT), T, D, D}; pg8::StaticOrder So; So.init(T, D, G, bx);
        EpiOut E{a.in[0], (const float*)(a.ws + WS_MOD), a.out}; pg8::gemm_phase<EpiOut, pg8::StaticOrder>(lds, g, So, E); }
    SEAM(6);
    for (int rep = 0; rep < 1 + ((PROBE_DUP >> 7) & 1); ++rep)
    if (IN(7)) { ph_norm(a, a.out, a.in[16], 6144, 8192, (bf16*)(a.ws + WS_H)); ph_quant_uv(a); }
    SEAM(7);
    for (int rep = 0; rep < 1 + ((PROBE_DUP >> 8) & 1); ++rep)
    if (IN(8)) { pg8::Gemm g{(const bf16*)(a.ws + WS_H), (const bf16*)(a.ws + WS_WPQ), T, D, D}; pg8::StaticOrder So; So.init(T, D, G, bx);
        EpiF32 E{(float*)(a.ws + WS_QP), D}; pg8::gemm_phase<EpiF32, pg8::StaticOrder>(lds, g, So, E); }
    SEAM(8);
    for (int rep = 0; rep < 1 + ((PROBE_DUP >> 9) & 1); ++rep)
    if (IN(9)) { ph_route(a, lds); __syncthreads(); }
    SEAM(9);
    if (IN(10)) { if ((PROBE_DUP >> 10) & 1) { ph_experts(a, *(const float*)(a.ws + WS_CTL + 64)); asm volatile("s_waitcnt vmcnt(0)" ::: "memory"); __syncthreads(); } ph_experts(a, 1.f); }
#undef IN
#undef SEAM
}

extern "C" void kernel_launch(void* const* d_in, const int* in_sizes, int n_in, void* d_out, int out_size, void* d_ws, size_t ws_size, hipStream_t stream) {
    static int grid = 0;
    if (grid == 0) {
        if (n_in != 23 || out_size != T * D || ws_size < WS_END4) { fprintf(stderr, "kernel_launch: unexpected problem shape (n_in %d, out %d, ws %zu); nothing launched\n", n_in, out_size, ws_size); grid = -1; return; }
        int dev = 0, cus = 0, per_cu = 0;
        if (hipGetDevice(&dev) != hipSuccess || hipDeviceGetAttribute(&cus, hipDeviceAttributeMultiprocessorCount, dev) != hipSuccess) { grid = -1; return; }
        if (hipFuncSetAttribute((const void*)fwd_kernel, hipFuncAttributeMaxDynamicSharedMemorySize, LDS_BYTES) != hipSuccess) { fprintf(stderr, "kernel_launch: hipFuncSetAttribute failed\n"); grid = -1; return; }
        if (hipOccupancyMaxActiveBlocksPerMultiprocessor(&per_cu, (const void*)fwd_kernel, NTHREADS, LDS_BYTES) != hipSuccess || per_cu < 1) { fprintf(stderr, "kernel_launch: occupancy query says %d\n", per_cu); }
        (void)hipGetLastError();
        grid = cus;
    }
    if (grid < 0) return;
    hipMemsetAsync((char*)d_ws + WS_CTL, 0, CTL_ZERO_BYTES, stream);
    Args a{};
    for (int i = 0; i < 23; ++i) a.in[i] = (const float*)d_in[i];
    a.out = (float*)d_out; a.ws = (unsigned char*)d_ws;
#if MK_ONE_LAUNCH
#if PROBE_PREFIX >= 0
    a.ph_lo = 0; a.ph_hi = PROBE_PREFIX + 1;
    hipLaunchKernelGGL(fwd_kernel, dim3(grid), dim3(NTHREADS), LDS_BYTES, stream, a);
    hipMemsetAsync((char*)d_ws + WS_CTL, 0, CTL_ZERO_BYTES, stream);
#endif
    a.ph_lo = 0; a.ph_hi = N_PHASES;
    hipLaunchKernelGGL(fwd_kernel, dim3(grid), dim3(NTHREADS), LDS_BYTES, stream, a);
#else
    for (int p = 0; p < N_PHASES; ++p) { a.ph_lo = p; a.ph_hi = p + 1; hipLaunchKernelGGL(fwd_kernel, dim3(grid), dim3(NTHREADS), LDS_BYTES, stream, a); }
#endif
}
```

```cpp
#include <hip/hip_runtime.h>
#include <cstdio>
#include <cstdint>

#ifndef PROBE_DUP
#define PROBE_DUP 0
#endif
#ifndef PROBE_PREFIX
#define PROBE_PREFIX -1
#endif
#ifndef MK_ONE_LAUNCH
#define MK_ONE_LAUNCH 1
#endif

__device__ __forceinline__ int phase_tid() { int t = threadIdx.x; asm volatile("" : "+v"(t)); return t; }
namespace pg8 {
#define PG8_LAS __attribute__((address_space(3)))
typedef unsigned short bf16_t;
typedef short bf16x8 __attribute__((ext_vector_type(8)));
typedef float f32x4 __attribute__((ext_vector_type(4)));
typedef unsigned u32x4 __attribute__((ext_vector_type(4)));
typedef unsigned u32x2 __attribute__((ext_vector_type(2)));
constexpr int BM = 256, BK = 64, HALF = 128, HTB = HALF * BK * 2, STAGE_BYTES = 8 * HTB, NXCD = 8, WGM = 8;

__host__ __device__ __forceinline__ int lds_byte(int r, int c) { const int st = (r >> 4) * 2 + (c >> 5), rr = r & 15, cc = c & 31, ob = rr * 64 + cc * 2; return st * 1024 + (ob ^ (((ob >> 9) & 1) << 5)); }
__host__ __device__ __forceinline__ void stage_rc(int b, int& R, int& C) { const int st = b / 1024, sb = b % 1024, swz = sb ^ (((sb >> 9) & 1) << 5); R = (st >> 1) * 16 + swz / 64; C = (st & 1) * 32 + (swz % 64) / 2; }
__host__ __device__ __forceinline__ int perm32(int rho) { const int n = rho >> 4, i = rho & 15; return 8 * (i >> 2) + 4 * n + (i & 3); }

struct Unit { int pm, pn; };
struct Gemm { const bf16_t* A; const bf16_t* Bt; int M, N, K; };

struct StaticOrder {
    int nM, nN, nwg, G, c;
    __host__ __device__ void init(int M, int N, int G_, int c_) { nM = M / BM; nN = N / BM; nwg = nM * nN; G = G_; c = c_; }
    __host__ __device__ bool next(int i, Unit& u) const {
        const long L = (long)i * G + c; if (L >= nwg) return false;
        int wgid = (int)L; { const int q = nwg / NXCD, r = nwg % NXCD, xcd = wgid % NXCD, off = wgid / NXCD; wgid = (xcd < r ? xcd * (q + 1) : r * (q + 1) + (xcd - r) * q) + off; }
        const int nig = WGM * nN, gid = wgid / nig, fm = gid * WGM, gsz = (nM - fm) < WGM ? (nM - fm) : WGM;
        u.pm = fm + ((wgid % nig) % gsz); u.pn = (wgid % nig) / gsz; return true;
    }
    __device__ __forceinline__ void a_ready(const Unit&) const {}
    __device__ __forceinline__ void done(const Unit&) const {}
};

__device__ __forceinline__ unsigned cvt_pk_bf16(float lo, float hi) { unsigned r; asm volatile("v_cvt_pk_bf16_f32 %0, %1, %2" : "=v"(r) : "v"(lo), "v"(hi)); return r; }

struct NoMid { static constexpr int AT = -1; __device__ __forceinline__ void operator()(f32x4 (&)[2][2][4][2], const Unit&, int, int, int, int) const {} };
template <class Epi, class Sched, class Mid = NoMid>
__device__ __forceinline__ void gemm_phase(PG8_LAS unsigned char* lds, const Gemm g, const Sched& S, const Epi& E, const Mid& Mh = Mid()) {
    const int tid = phase_tid(), wid = __builtin_amdgcn_readfirstlane(tid >> 6), lane = tid & 63, wr = wid >> 2, wc = wid & 3, fr = lane & 15, fq = lane >> 4;
    const int K = g.K, nt = K / BK;
    unsigned voffA[2], voffB[2];
#pragma unroll
    for (int i = 0; i < 2; ++i) { int R, C; stage_rc(tid * 16 + i * 8192, R, C); const int Rb = Epi::PERM ? ((R & ~31) + perm32(R & 31)) : R;
        voffA[i] = (unsigned)(R * K + C) * 2u; voffB[i] = (unsigned)(Rb * K + C) * 2u; }
    const size_t kstep = (size_t)(BK * 2);
    const size_t hstep = (size_t)HALF * K * 2;
    const size_t tstep = 2 * hstep;
    const unsigned ldsw = (unsigned)wid * 1024u;
    const int aoff = lds_byte(wr * 64 + fr, fq * 8), boff = lds_byte(wc * 32 + fr, fq * 8);
#define PG8_SA(b, h) (((b) * 2 + (h)) * HTB)
#define PG8_SB(b, h) ((4 + (b) * 2 + (h)) * HTB)
#define PG8_STAGE(bufoff, gbase, voff) do { _Pragma("unroll") for (int _i = 0; _i < 2; ++_i) \
        __builtin_amdgcn_global_load_lds((const unsigned*)((const char*)(gbase) + (voff)[_i]), (PG8_LAS unsigned*)(lds + (bufoff) + ldsw + _i * 8192), 16, 0, 0); } while (0)
#define PG8_LDA(dst, b, h) do { _Pragma("unroll") for (int m = 0; m < 4; ++m) _Pragma("unroll") for (int k = 0; k < 2; ++k) dst[m][k] = *(const PG8_LAS bf16x8*)(lds + PG8_SA(b, h) + aoff + m * 2048 + k * 1024); } while (0)
#define PG8_LDB(dst, b, h) do { _Pragma("unroll") for (int n = 0; n < 2; ++n) _Pragma("unroll") for (int k = 0; k < 2; ++k) dst[n][k] = *(const PG8_LAS bf16x8*)(lds + PG8_SB(b, h) + boff + n * 2048 + k * 1024); } while (0)
#define PG8_MMA(ai, bj, At, Bt) do { __builtin_amdgcn_s_setprio(1); _Pragma("unroll") for (int m = 0; m < 4; ++m) _Pragma("unroll") for (int n = 0; n < 2; ++n) _Pragma("unroll") for (int k = 0; k < 2; ++k) \
        acc[ai][bj][m][n] = __builtin_amdgcn_mfma_f32_16x16x32_bf16(Bt[n][k], At[m][k], acc[ai][bj][m][n], 0, 0, 0); __builtin_amdgcn_s_setprio(0); } while (0)
#define PG8_WAIT_V(n) asm volatile("s_waitcnt vmcnt(" #n ")" ::: "memory")
#define PG8_WAIT_L(n) asm volatile("s_waitcnt lgkmcnt(" #n ")" ::: "memory")
#define PG8_BAR __builtin_amdgcn_s_barrier()
#define PG8_SCHED __builtin_amdgcn_sched_barrier(0)
    Unit cur, nxt; int ui = 0;
    if (!S.next(0, cur)) return;
    f32x4 acc[2][2][4][2];
#pragma unroll
    for (int a = 0; a < 2; ++a)
#pragma unroll
        for (int b = 0; b < 2; ++b)
#pragma unroll
            for (int m = 0; m < 4; ++m)
#pragma unroll
                for (int n = 0; n < 2; ++n) acc[a][b][m][n] = (f32x4){0.f, 0.f, 0.f, 0.f};
    bf16x8 At[4][2], B0[2][2], B1[2][2];
    const char* cA = (const char*)g.A + (size_t)cur.pm * tstep; const char* cB = (const char*)g.Bt + (size_t)cur.pn * tstep;
    S.a_ready(cur);
    PG8_STAGE(PG8_SB(0, 0), cB, voffB); PG8_STAGE(PG8_SA(0, 0), cA, voffA); PG8_STAGE(PG8_SB(0, 1), cB + hstep, voffB); PG8_STAGE(PG8_SA(0, 1), cA + hstep, voffA);
    if (wr == 1) PG8_BAR;
    PG8_WAIT_V(4); PG8_BAR;
    PG8_STAGE(PG8_SB(1, 0), cB + kstep, voffB); PG8_STAGE(PG8_SA(1, 0), cA + kstep, voffA); PG8_STAGE(PG8_SB(1, 1), cB + hstep + kstep, voffB);
    PG8_WAIT_V(6); PG8_BAR;
    for (;;) {
        const bool has_next = S.next(ui + 1, nxt);
        const char* nA = has_next ? (const char*)g.A + (size_t)nxt.pm * tstep : cA; const char* nB = has_next ? (const char*)g.Bt + (size_t)nxt.pn * tstep : cB;
#define PG8_KBODY \
            const bool last = (t == nt - 2); \
            const char* a1 = cA + (size_t)(t + 1) * kstep; \
            const char* a2 = last ? nA : cA + (size_t)(t + 2) * kstep; const char* b2 = last ? nB : cB + (size_t)(t + 2) * kstep; \
            const char* a3 = a2 + kstep; const char* b3 = b2 + kstep; \
            if (last && has_next) S.a_ready(nxt); \
            PG8_LDB(B0, 0, 0); PG8_SCHED; PG8_LDA(At, 0, 0); PG8_STAGE(PG8_SA(1, 1), a1 + hstep, voffA); \
            PG8_WAIT_L(8); PG8_BAR; PG8_WAIT_L(0); PG8_MMA(0, 0, At, B0); PG8_BAR; PG8_SCHED; \
            PG8_LDB(B1, 0, 1); PG8_STAGE(PG8_SB(0, 0), b2, voffB); \
            PG8_BAR; PG8_WAIT_L(0); PG8_MMA(0, 1, At, B1); PG8_BAR; \
            PG8_LDA(At, 0, 1); PG8_STAGE(PG8_SA(0, 0), a2, voffA); \
            PG8_BAR; PG8_WAIT_L(0); PG8_MMA(1, 0, At, B0); PG8_BAR; PG8_SCHED; \
            PG8_STAGE(PG8_SB(0, 1), b2 + hstep, voffB); \
            PG8_WAIT_V(6); PG8_BAR; PG8_MMA(1, 1, At, B1); PG8_BAR; \
            PG8_LDB(B0, 1, 0); PG8_SCHED; PG8_LDA(At, 1, 0); PG8_STAGE(PG8_SA(0, 1), a2 + hstep, voffA); \
            PG8_WAIT_L(8); PG8_BAR; PG8_WAIT_L(0); PG8_MMA(0, 0, At, B0); PG8_BAR; PG8_SCHED; \
            PG8_LDB(B1, 1, 1); PG8_STAGE(PG8_SB(1, 0), b3, voffB); \
            PG8_BAR; PG8_WAIT_L(0); PG8_MMA(0, 1, At, B1); PG8_BAR; \
            PG8_LDA(At, 1, 1); PG8_STAGE(PG8_SA(1, 0), a3, voffA); \
            PG8_BAR; PG8_WAIT_L(0); PG8_MMA(1, 0, At, B0); PG8_BAR; PG8_SCHED; \
            PG8_STAGE(PG8_SB(1, 1), b3 + hstep, voffB); \
            PG8_WAIT_V(6); PG8_BAR; PG8_MMA(1, 1, At, B1); PG8_BAR;
        if constexpr (Mid::AT >= 0) {
            for (int t = 0; t < Mid::AT; t += 2) { PG8_KBODY }
            Mh(acc, cur, wr, wc, fr, fq);
            for (int t = Mid::AT; t < nt; t += 2) { PG8_KBODY }
        } else {
            for (int t = 0; t < nt; t += 2) { PG8_KBODY }
        }
#undef PG8_KBODY
        E(acc, cur, wr, wc, fr, fq); S.done(cur);
        if (!has_next) break;
#pragma unroll
        for (int a = 0; a < 2; ++a)
#pragma unroll
            for (int b = 0; b < 2; ++b)
#pragma unroll
                for (int m = 0; m < 4; ++m)
#pragma unroll
                    for (int n = 0; n < 2; ++n) acc[a][b][m][n] = (f32x4){0.f, 0.f, 0.f, 0.f};
        cur = nxt; cA = nA; cB = nB; ++ui;
    }
    PG8_WAIT_V(0);
    if (wr == 0) PG8_BAR;
    PG8_BAR;
#undef PG8_SA
#undef PG8_SB
#undef PG8_STAGE
#undef PG8_LDA
#undef PG8_LDB
#undef PG8_MMA
#undef PG8_WAIT_V
#undef PG8_WAIT_L
#undef PG8_BAR
#undef PG8_SCHED
}
}

#define GAS __attribute__((address_space(1)))
#define LAS __attribute__((address_space(3)))
typedef unsigned short bf16;
typedef float f32x4 __attribute__((ext_vector_type(4)));
typedef unsigned v4u __attribute__((ext_vector_type(4)));
typedef unsigned v2u __attribute__((ext_vector_type(2)));

constexpr int NB = 4, S = 4096, D = 2048, T = NB * S, HD = 128;
constexpr int IN_COLS = 11288, OFF_KV = 1024, OFF_GATE = 2560, OFF_DIL = 2584, OFF_MERGE = 7192;
constexpr int NPROJ = 11264;
constexpr int NQ = 1024, NKV = 1536, NDL = 4608, NMG = 4096;
constexpr int NC = 255, NS = 64;
constexpr int NE = 16384;
constexpr float EPS = 1e-6f;
constexpr float QSCALE = 0.08838834764831845f;
constexpr int NWAVES = 8, NTHREADS = 512;

constexpr size_t MiB = 1u << 20;
constexpr size_t WS_CTL = 0, CTL_ZERO_BYTES = 1 * MiB;
constexpr size_t WS_WIN = 1 * MiB;
constexpr size_t WS_WBN = 45 * MiB;
constexpr size_t WS_WBD = 49 * MiB;
constexpr size_t WS_WOUT = 51 * MiB;
constexpr size_t WS_WPQ = 59 * MiB;
constexpr size_t WS_WGATE = 67 * MiB;
constexpr size_t WS_MOD = 67 * MiB + 256 * 1024;
constexpr size_t WS_SEL = 67 * MiB + 512 * 1024;
constexpr size_t WS_GATES = 68 * MiB;
constexpr size_t WS_KC = 70 * MiB;
constexpr size_t WS_VC = 71 * MiB;
constexpr size_t WS_H = 72 * MiB;
constexpr size_t WS_Q = 136 * MiB;
constexpr size_t WS_KV = 168 * MiB;
constexpr size_t WS_DL = 216 * MiB;
constexpr size_t WS_MG = 360 * MiB;
constexpr size_t WS_YN = 488 * MiB;
constexpr size_t WS_YD = 520 * MiB;
constexpr size_t WS_EI = 536 * MiB;
constexpr size_t WS_EG = 544 * MiB;
constexpr size_t WS_END = 552 * MiB;
constexpr size_t WS_PU = WS_Q;
constexpr size_t WS_PV = WS_Q + 64 * MiB;
constexpr size_t WS_QP = WS_MG;
static_assert(WS_PV + 64 * MiB <= WS_MG, "u/v overlay");

constexpr int LDS_BYTES = 147456;
constexpr int LDS_MISC = 144 * 1024 - 256;

#define XB_TMO      128
#define XB_XCNT(j)  (256  + 64 * (j))
#define XB_XSUB(j)  (1280 + 64 * (j))
#define XB_XGEN(j)  (2304 + 64 * (j))
#define XB_TOP      3328
#define XB_TOPGEN   3392
#define XCD_BAR_WORDS 3456
#define XB_SPIN_CAP (1u << 24)

__device__ __forceinline__ unsigned xb_ld(unsigned* p)              { return __hip_atomic_load(p, __ATOMIC_RELAXED, __HIP_MEMORY_SCOPE_AGENT); }
__device__ __forceinline__ unsigned xb_add(unsigned* p, unsigned v) { return __hip_atomic_fetch_add(p, v, __ATOMIC_RELAXED, __HIP_MEMORY_SCOPE_AGENT); }
__device__ __forceinline__ unsigned xb_xcc_id() { return (unsigned)__builtin_amdgcn_s_getreg((3 << 11) | 20) & 0xFu; }
#define XB_SPIN(cond, bar) do { unsigned _sp = 0; while (cond) { __builtin_amdgcn_s_sleep(1); \
    if ((++_sp & 255u) == 0u) { if (xb_ld(&(bar)[XB_TMO])) break; if (_sp > XB_SPIN_CAP) { atomicAdd(&(bar)[XB_TMO], 1u); break; } } } } while (0)

struct XcdBarrier { unsigned* bar; unsigned x; volatile LAS unsigned* st; };

__device__ __forceinline__ XcdBarrier xcd_barrier_post(unsigned* bar, volatile LAS unsigned* st) {
    XcdBarrier b; b.bar = bar; b.x = xb_xcc_id(); b.st = st;
    if (threadIdx.x == 0) (void)xb_add(&bar[XB_XCNT(b.x)], 1u);
    return b;
}
__device__ __forceinline__ void xcd_barrier_complete(unsigned* bar, unsigned x, unsigned& nloc, unsigned& nx) {
    const unsigned G = gridDim.x * gridDim.y * gridDim.z;
    unsigned sum, cnt, mine, sp = 0u;
    for (;;) {
        sum = 0u; cnt = 0u; mine = 0u;
#pragma unroll
        for (unsigned j = 0; j < 16; ++j) { const unsigned c = xb_ld(&bar[XB_XCNT(j)]); sum += c; cnt += (c > 0u) ? 1u : 0u; mine = (j == x) ? c : mine; }
        if (sum == G) break;
        __builtin_amdgcn_s_sleep(1);
        if ((++sp & 255u) == 0u) { if (xb_ld(&bar[XB_TMO])) break; if (sp > XB_SPIN_CAP) { atomicAdd(&bar[XB_TMO], 1u); break; } }
    }
    nloc = mine > 0u ? mine : 1u; nx = cnt > 0u ? cnt : 1u;
}
__device__ __forceinline__ void xcd_barrier(const XcdBarrier& b) {
    asm volatile("s_waitcnt vmcnt(0)" ::: "memory");
    __syncthreads();
    if (threadIdx.x == 0) {
        unsigned* bar = b.bar;
        __builtin_amdgcn_s_waitcnt(0);
        unsigned nloc = b.st[0], nx = b.st[1];
        if (nloc == 0u) { xcd_barrier_complete(bar, b.x, nloc, nx); b.st[0] = nloc; b.st[1] = nx; }
        const unsigned old = xb_add(&bar[XB_XSUB(b.x)], 1u);
        const unsigned gen = old / nloc;
        if (old + 1u == (gen + 1u) * nloc) {
            __builtin_amdgcn_fence(__ATOMIC_RELEASE, "agent");
            asm volatile("s_waitcnt vmcnt(0)" ::: "memory");
            const unsigned og = xb_add(&bar[XB_TOP], 1u);
            const unsigned tg = og / nx;
            if (og + 1u == (tg + 1u) * nx) xb_add(&bar[XB_TOPGEN], 1u);
            else XB_SPIN(xb_ld(&bar[XB_TOPGEN]) == tg, bar);
            __builtin_amdgcn_fence(__ATOMIC_ACQUIRE, "agent");
            xb_add(&bar[XB_XGEN(b.x)], 1u);
            asm volatile("s_waitcnt vmcnt(0)" ::: "memory");
        } else {
            XB_SPIN(xb_ld(&bar[XB_XGEN(b.x)]) == gen, bar);
            __builtin_amdgcn_fence(__ATOMIC_ACQUIRE, "agent");
            asm volatile("s_waitcnt vmcnt(0)" ::: "memory");
        }
    }
    __syncthreads();
}

__device__ __forceinline__ unsigned f2bf(float f) { unsigned u = __builtin_bit_cast(unsigned, f); return (u + 0x7fffu + ((u >> 16) & 1u)) >> 16; }
__device__ __forceinline__ unsigned pk2(float lo, float hi) { return f2bf(lo) | (f2bf(hi) << 16); }
__device__ __forceinline__ float bflo(unsigned u) { return __builtin_bit_cast(float, u << 16); }
__device__ __forceinline__ float bfhi(unsigned u) { return __builtin_bit_cast(float, u & 0xffff0000u); }
__device__ __forceinline__ float bf2f(bf16 u) { return __builtin_bit_cast(float, (unsigned)u << 16); }
__device__ __forceinline__ float wave_sum(float v) {
#pragma unroll
    for (int o = 1; o < 64; o <<= 1) v += __shfl_xor(v, o);
    return v;
}
__device__ __forceinline__ float wave_max(float v) {
#pragma unroll
    for (int o = 1; o < 64; o <<= 1) v = fmaxf(v, __shfl_xor(v, o));
    return v;
}
__device__ __forceinline__ float sigmoidf(float x) { return __builtin_amdgcn_rcpf(1.f + __expf(-x)); }
__device__ __forceinline__ float gelu_tanh(float x) { const float u = 0.7978845608028654f * (x + 0.044715f * x * x * x); return 0.5f * x * (1.f + tanhf(u)); }
__device__ __forceinline__ int t5_bucket(int n) {
    if (n < 16) return n;
    int b = 16;
    b += (n >= 22); b += (n >= 30); b += (n >= 40); b += (n >= 54); b += (n >= 73); b += (n >= 99); b += (n >= 134); b += (n >= 182);
    b += (n >= 246); b += (n >= 332); b += (n >= 450); b += (n >= 609); b += (n >= 825); b += (n >= 1117); b += (n >= 1513);
    return b;
}

struct Args {
    const float* in[23];
    float* out; unsigned char* ws;
    int ph_lo, ph_hi;
};

typedef float f32x2v __attribute__((ext_vector_type(2)));
__device__ __forceinline__ void ph0_mod(const Args& a, LAS unsigned char* lds) {
    const int tid = phase_tid(), lane = tid & 63, wave = __builtin_amdgcn_readfirstlane(tid >> 6);
    LAS float* cs = (LAS float*)lds;
    LAS float* red = (LAS float*)(lds + 32768);
    const float* c = a.in[1]; const float* w_ada = a.in[2]; const float* b_ada = a.in[3];
    float* mod = (float*)(a.ws + WS_MOD);
    for (int i = tid; i < 4 * 2048; i += NTHREADS) { const float v = c[i]; cs[i] = v / (1.f + __expf(-v)); }
    __syncthreads();
    for (int u = blockIdx.x; u < 12288 / 128; u += gridDim.x) {
        const int col = u * 128 + 2 * lane;
        float acc[4][2];
#pragma unroll
        for (int b = 0; b < 4; ++b) { acc[b][0] = 0.f; acc[b][1] = 0.f; }
        const float* wp = w_ada + (size_t)(wave * 256) * 12288 + col;
#pragma unroll 1
        for (int k0 = 0; k0 < 256; k0 += 16) {
            f32x2v w[16];
#pragma unroll
            for (int k = 0; k < 16; ++k) w[k] = *(const f32x2v*)(wp + (size_t)(k0 + k) * 12288);
#pragma unroll
            for (int k = 0; k < 16; ++k) { const int kk = wave * 256 + k0 + k;
#pragma unroll
                for (int b = 0; b < 4; ++b) { const float cv = cs[b * 2048 + kk]; acc[b][0] += cv * w[k].x; acc[b][1] += cv * w[k].y; } }
        }
#pragma unroll
        for (int b = 0; b < 4; ++b) { red[(wave * 4 + b) * 128 + 2 * lane] = acc[b][0]; red[(wave * 4 + b) * 128 + 2 * lane + 1] = acc[b][1]; }
        __syncthreads();
        { const int b = tid >> 7, cc = tid & 127; float s = 0.f;
#pragma unroll
          for (int w = 0; w < 8; ++w) s += red[(w * 4 + b) * 128 + cc];
          mod[b * 12288 + u * 128 + cc] = s + b_ada[u * 128 + cc]; }
        __syncthreads();
    }
}
__device__ __forceinline__ void transpose_item(const float* W, int ldw, int ncols, int K, bf16* WT, int row_off, LAS float* scr, int item, int lane, int ldt = 0) {
    if (ldt == 0) ldt = K;
    const int nblk = ncols / 32, kb = item / nblk, nb = item % nblk, k0 = 64 * kb, n0 = 32 * nb;
    float tv[32];
#pragma unroll
    for (int i = 0; i < 32; ++i) tv[i] = W[(size_t)(k0 + 2 * i + (lane >> 5)) * ldw + n0 + (lane & 31)];
#pragma unroll
    for (int i = 0; i < 32; ++i) scr[(2 * i + (lane >> 5)) * 33 + (lane & 31)] = tv[i];
    asm volatile("s_waitcnt lgkmcnt(0)" ::: "memory");
    const int c = lane & 7;
#pragma unroll
    for (int j = 0; j < 4; ++j) { const int n = (lane >> 3) + 8 * j; const LAS float* s = scr + (8 * c) * 33 + n;
        v4u o; o.x = pk2(s[0 * 33], s[1 * 33]); o.y = pk2(s[2 * 33], s[3 * 33]); o.z = pk2(s[4 * 33], s[5 * 33]); o.w = pk2(s[6 * 33], s[7 * 33]);
        *(v4u*)(WT + (size_t)(row_off + n0 + n) * ldt + k0 + 8 * c) = o; }
    asm volatile("s_waitcnt lgkmcnt(0)" ::: "memory");
}
__device__ __forceinline__ void ph0_weights(const Args& a, LAS unsigned char* lds) {
    const int tid = phase_tid(), lane = tid & 63, wave = __builtin_amdgcn_readfirstlane(tid >> 6);
    LAS float* scr = (LAS float*)(lds + wave * 16384);
    const int gw = blockIdx.x * NWAVES + wave, NGW = gridDim.x * NWAVES;
    const float* w_in = a.in[5];
    bf16* WIN = (bf16*)(a.ws + WS_WIN);
    constexpr int I_Q = 32 * (NQ / 32), I_KV = 32 * (NKV / 32), I_DL = 32 * (NDL / 32), I_MG = 32 * (NMG / 32);
    constexpr int I_BN = 16 * 64, I_BD = 8 * 64, I_O = 32 * 64, I_PQ = 32 * 64;
    constexpr int NITEMS = I_Q + I_KV + I_DL + I_MG + I_BN + I_BD + I_O + I_PQ;
    for (int it = gw; it < NITEMS; it += NGW) {
        int r = it;
        if (r < I_Q)  { transpose_item(w_in, IN_COLS, NQ, D, WIN, 0, scr, r, lane); continue; } r -= I_Q;
        if (r < I_KV) { transpose_item(w_in + OFF_KV, IN_COLS, NKV, D, WIN, NQ, scr, r, lane); continue; } r -= I_KV;
        if (r < I_DL) { transpose_item(w_in + OFF_DIL, IN_COLS, NDL, D, WIN, NQ + NKV, scr, r, lane); continue; } r -= I_DL;
        if (r < I_MG) { transpose_item(w_in + OFF_MERGE, IN_COLS, NMG, D, WIN, NQ + NKV + NDL, scr, r, lane); continue; } r -= I_MG;
        if (r < I_BN) { transpose_item(a.in[13], D, D, 1024, (bf16*)(a.ws + WS_WBN), 0, scr, r, lane, 1536); continue; } r -= I_BN;
        if (r < I_BD) { transpose_item(a.in[14], D, D, 512, (bf16*)(a.ws + WS_WBN) + 1024, 0, scr, r, lane, 1536); continue; } r -= I_BD;
        if (r < I_O)  { transpose_item(a.in[15], D, D, D, (bf16*)(a.ws + WS_WOUT), 0, scr, r, lane); continue; } r -= I_O;
        transpose_item(a.in[17], D, D, D, (bf16*)(a.ws + WS_WPQ), 0, scr, r, lane);
    }
}

constexpr size_t WS_CW1F = 602 * MiB;
constexpr size_t WS_WGF = 604 * MiB;
constexpr size_t WS_CBP = 604 * MiB + 256 * 1024;
constexpr size_t WS_END4 = 605 * MiB;
__device__ __forceinline__ void ph0_extra(const Args& a) {
    const int tid = phase_tid(), lane = tid & 63, wave = __builtin_amdgcn_readfirstlane(tid >> 6);
    const float* w1 = a.in[9]; const float* pos = a.in[8]; const float* w_in = a.in[5];
    v4u* CW = (v4u*)(a.ws + WS_CW1F); v4u* WG = (v4u*)(a.ws + WS_WGF); float* CBP = (float*)(a.ws + WS_CBP);
    for (int i = blockIdx.x * NTHREADS + tid; i < 2 * 4 * 256 * 64; i += gridDim.x * NTHREADS) {
        const int ln = i & 63, ks = (i >> 6) & 255, nt = (i >> 14) & 3, j = i >> 16;
        const float* src = w1 + ((size_t)j * 4096 + 16 * ks + 8 * (ln >> 5)) * 128 + 32 * nt + (ln & 31);
        v4u o; o.x = pk2(src[0], src[128]); o.y = pk2(src[256], src[384]); o.z = pk2(src[512], src[640]); o.w = pk2(src[768], src[896]);
        CW[i] = o;
    }
    for (int i = blockIdx.x * NTHREADS + tid; i < 128 * 64; i += gridDim.x * NTHREADS) {
        const int ln = i & 63, ks = i >> 6, jrow = ln & 31;
        v4u o = {0u, 0u, 0u, 0u};
        if (jrow < 24) { const float* src = w_in + (size_t)(16 * ks + 8 * (ln >> 5)) * IN_COLS + OFF_GATE + jrow;
            o.x = pk2(src[0], src[IN_COLS]); o.y = pk2(src[2 * (size_t)IN_COLS], src[3 * (size_t)IN_COLS]); o.z = pk2(src[4 * (size_t)IN_COLS], src[5 * (size_t)IN_COLS]); o.w = pk2(src[6 * (size_t)IN_COLS], src[7 * (size_t)IN_COLS]); }
        WG[i] = o;
    }
    { const int gw = blockIdx.x * NWAVES + wave;
      if (gw < 128) { const int kc = gw >> 1, j = gw & 1; float s0 = 0.f, s1 = 0.f; const float* wp = w1 + ((size_t)j * 4096 + 64 * kc) * 128 + lane; const float* pp = pos + j * 4096 + 64 * kc;
#pragma unroll 1
          for (int k0 = 0; k0 < 64; k0 += 16) { float wa[16], wb[16];
#pragma unroll
              for (int k = 0; k < 16; ++k) { wa[k] = wp[(k0 + k) * 128]; wb[k] = wp[(k0 + k) * 128 + 64]; }
#pragma unroll
              for (int k = 0; k < 16; ++k) { const float pv = pp[k0 + k]; s0 += pv * wa[k]; s1 += pv * wb[k]; } }
          CBP[(kc * 2 + j) * 128 + lane] = s0; CBP[(kc * 2 + j) * 128 + 64 + lane] = s1; } }
}

__device__ __forceinline__ void ph_norm(const Args& a, const float* xin, const float* gvec, int sh_off, int sc_off, bf16* hout) {
    const int tid = phase_tid(), lane = tid & 63, wave = __builtin_amdgcn_readfirstlane(tid >> 6);
    const int gw = blockIdx.x * NWAVES + wave, NGW = gridDim.x * NWAVES;
    const float* mod = (const float*)(a.ws + WS_MOD);
    for (int r = gw; r < S / 2; r += NGW)
#pragma unroll 1
        for (int bq = 0; bq < NB; ++bq) {
            const int m0 = bq * S + r, m1 = m0 + S / 2;
            const float* x0 = xin + (size_t)m0 * D + 8 * lane; const float* x1 = xin + (size_t)m1 * D + 8 * lane;
            f32x4 v0[8], v1[8];
#pragma unroll
            for (int c = 0; c < 4; ++c) { v0[2 * c] = *(const f32x4*)(x0 + 512 * c); v0[2 * c + 1] = *(const f32x4*)(x0 + 512 * c + 4); v1[2 * c] = *(const f32x4*)(x1 + 512 * c); v1[2 * c + 1] = *(const f32x4*)(x1 + 512 * c + 4); }
            float s0 = 0.f, s1 = 0.f;
#pragma unroll
            for (int i = 0; i < 8; ++i) { s0 += (v0[i].x * v0[i].x + v0[i].y * v0[i].y) + (v0[i].z * v0[i].z + v0[i].w * v0[i].w); s1 += (v1[i].x * v1[i].x + v1[i].y * v1[i].y) + (v1[i].z * v1[i].z + v1[i].w * v1[i].w); }
            const float r0 = rsqrtf(wave_sum(s0) * (1.f / D) + EPS), r1 = rsqrtf(wave_sum(s1) * (1.f / D) + EPS);
            const float* shp = mod + bq * 12288 + sh_off + 8 * lane; const float* scp = mod + bq * 12288 + sc_off + 8 * lane; const float* gp = gvec + 8 * lane;
#pragma unroll
            for (int c = 0; c < 4; ++c) {
                v4u o0, o1; unsigned w0[4], w1[4];
#pragma unroll
                for (int hq = 0; hq < 2; ++hq) { const f32x4 g = *(const f32x4*)(gp + 512 * c + 4 * hq), sc = *(const f32x4*)(scp + 512 * c + 4 * hq), sh = *(const f32x4*)(shp + 512 * c + 4 * hq);
                    const f32x4 ga = g * (1.f + sc); const f32x4 y0 = v0[2 * c + hq] * r0 * ga + sh, y1 = v1[2 * c + hq] * r1 * ga + sh;
                    w0[2 * hq] = pk2(y0.x, y0.y); w0[2 * hq + 1] = pk2(y0.z, y0.w); w1[2 * hq] = pk2(y1.x, y1.y); w1[2 * hq + 1] = pk2(y1.z, y1.w); }
                o0.x = w0[0]; o0.y = w0[1]; o0.z = w0[2]; o0.w = w0[3]; o1.x = w1[0]; o1.y = w1[1]; o1.z = w1[2]; o1.w = w1[3];
                *(v4u*)(hout + (size_t)m0 * D + 512 * c + 8 * lane) = o0; *(v4u*)(hout + (size_t)m1 * D + 512 * c + 8 * lane) = o1;
            }
        }
}

using pg8::Unit; using pg8::HALF; using pg8::BM;
struct EpiProj {
    static constexpr bool PERM = true;
    bf16 *q, *kv, *dl, *mg;
    __device__ __forceinline__ void operator()(const f32x4 (&acc)[2][2][4][2], const Unit& u, int wr, int wc, int fr, int fq) const {
        bf16* base; int ldc, colt = u.pn * BM;
        if (colt < NQ) { base = q; ldc = NQ; } else if (colt < NQ + NKV) { base = kv; ldc = NKV; colt -= NQ; } else if (colt < NQ + NKV + NDL) { base = dl; ldc = NDL; colt -= NQ + NKV; } else { base = mg; ldc = NMG; colt -= NQ + NKV + NDL; }
        const int row0 = u.pm * BM + wr * 64 + fr, col0 = colt + wc * 32 + 8 * fq;
#pragma unroll
        for (int ai = 0; ai < 2; ++ai)
#pragma unroll
            for (int m = 0; m < 4; ++m) { bf16* rowp = base + (size_t)(row0 + ai * HALF + m * 16) * ldc + col0;
#pragma unroll
                for (int bj = 0; bj < 2; ++bj) { const f32x4 v0 = acc[ai][bj][m][0], v1 = acc[ai][bj][m][1];
                    v4u w; w.x = pg8::cvt_pk_bf16(v0[0], v0[1]); w.y = pg8::cvt_pk_bf16(v0[2], v0[3]); w.z = pg8::cvt_pk_bf16(v1[0], v1[1]); w.w = pg8::cvt_pk_bf16(v1[2], v1[3]);
                    *(v4u*)(rowp + bj * HALF) = w; } }
    }
};
struct MidMerge {
    static constexpr int AT = 16;
    const bf16* mg;
    __device__ __forceinline__ void operator()(f32x4 (&acc)[2][2][4][2], const Unit& u, int wr, int wc, int fr, int fq) const {
        int row0 = u.pm * BM + wr * 64 + fr; const int col0 = u.pn * BM + wc * 32 + 8 * fq;
        asm volatile("" : "+v"(row0));
#pragma unroll
        for (int ai = 0; ai < 2; ++ai) {
            v4u a1[4][2], a2[4][2];
#pragma unroll
            for (int m = 0; m < 4; ++m) { const bf16* rp = mg + (size_t)(row0 + ai * HALF + m * 16) * NMG + col0;
#pragma unroll
                for (int bj = 0; bj < 2; ++bj) { a1[m][bj] = *(const v4u*)(rp + bj * HALF); a2[m][bj] = *(const v4u*)(rp + 2048 + bj * HALF); } }
#pragma unroll
            for (int m = 0; m < 4; ++m)
#pragma unroll
                for (int bj = 0; bj < 2; ++bj) { const unsigned w1[4] = {a1[m][bj].x, a1[m][bj].y, a1[m][bj].z, a1[m][bj].w}, w2[4] = {a2[m][bj].x, a2[m][bj].y, a2[m][bj].z, a2[m][bj].w};
#pragma unroll
                    for (int q = 0; q < 4; ++q) { const float r0 = (1.f + __expf(-bflo(w2[q]))) * __builtin_amdgcn_rcpf(1.f + __expf(-bflo(w1[q]))), r1 = (1.f + __expf(-bfhi(w2[q]))) * __builtin_amdgcn_rcpf(1.f + __expf(-bfhi(w1[q])));
                        acc[ai][bj][m][q >> 1][2 * (q & 1)] *= r0; acc[ai][bj][m][q >> 1][2 * (q & 1) + 1] *= r1; } }
            asm volatile("" ::: "memory");
        }
    }
};
struct EpiMerge {
    static constexpr bool PERM = true;
    const bf16* mg; bf16* merged;
    __device__ __forceinline__ void operator()(const f32x4 (&acc)[2][2][4][2], const Unit& u, int wr, int wc, int fr, int fq) const {
        int row0 = u.pm * BM + wr * 64 + fr; const int col0 = u.pn * BM + wc * 32 + 8 * fq;
        asm volatile("" : "+v"(row0));
        v4u a2[2][4][2];
#pragma unroll
        for (int ai = 0; ai < 2; ++ai)
#pragma unroll
            for (int m = 0; m < 4; ++m)
#pragma unroll
                for (int bj = 0; bj < 2; ++bj) a2[ai][m][bj] = *(const v4u*)(mg + (size_t)(row0 + ai * HALF + m * 16) * NMG + 2048 + col0 + bj * HALF);
#pragma unroll
        for (int ai = 0; ai < 2; ++ai)
#pragma unroll
            for (int m = 0; m < 4; ++m) { const size_t row = (size_t)(row0 + ai * HALF + m * 16);
#pragma unroll
                for (int bj = 0; bj < 2; ++bj) { const unsigned w2[4] = {a2[ai][m][bj].x, a2[ai][m][bj].y, a2[ai][m][bj].z, a2[ai][m][bj].w};
                    const f32x4 v0 = acc[ai][bj][m][0], v1 = acc[ai][bj][m][1];
                    v4u w; w.x = pg8::cvt_pk_bf16(v0[0] * sigmoidf(bflo(w2[0])), v0[1] * sigmoidf(bfhi(w2[0]))); w.y = pg8::cvt_pk_bf16(v0[2] * sigmoidf(bflo(w2[1])), v0[3] * sigmoidf(bfhi(w2[1])));
                    w.z = pg8::cvt_pk_bf16(v1[0] * sigmoidf(bflo(w2[2])), v1[1] * sigmoidf(bfhi(w2[2]))); w.w = pg8::cvt_pk_bf16(v1[2] * sigmoidf(bflo(w2[3])), v1[3] * sigmoidf(bfhi(w2[3])));
                    *(v4u*)(merged + row * D + col0 + bj * HALF) = w; } }
    }
};
struct EpiOut {
    static constexpr bool PERM = false;
    const float* x; const float* mod; float* x1;
    __device__ __forceinline__ void operator()(const f32x4 (&acc)[2][2][4][2], const Unit& u, int wr, int wc, int fr, int fq) const {
        const int row0 = u.pm * BM + wr * 64 + fr, col0 = u.pn * BM + wc * 32 + 4 * fq;
        const int b = (u.pm * BM) / S;
        f32x4 gv[2][2];
#pragma unroll
        for (int bj = 0; bj < 2; ++bj)
#pragma unroll
            for (int n = 0; n < 2; ++n) gv[bj][n] = *(const f32x4*)(mod + b * 12288 + 4096 + col0 + bj * HALF + n * 16);
#pragma unroll
        for (int ai = 0; ai < 2; ++ai)
#pragma unroll
            for (int m = 0; m < 4; ++m) { const size_t off = (size_t)(row0 + ai * HALF + m * 16) * D + col0;
#pragma unroll
                for (int bj = 0; bj < 2; ++bj)
#pragma unroll
                    for (int n = 0; n < 2; ++n) *(f32x4*)(x1 + off + bj * HALF + n * 16) = *(const f32x4*)(x + off + bj * HALF + n * 16) + gv[bj][n] * acc[ai][bj][m][n]; }
    }
};
struct EpiF32 {
    static constexpr bool PERM = false;
    float* C; int ldc;
    __device__ __forceinline__ void operator()(const f32x4 (&acc)[2][2][4][2], const Unit& u, int wr, int wc, int fr, int fq) const {
        const int row0 = u.pm * BM + wr * 64 + fr, col0 = u.pn * BM + wc * 32 + 4 * fq;
#pragma unroll
        for (int ai = 0; ai < 2; ++ai)
#pragma unroll
            for (int m = 0; m < 4; ++m) { float* rowp = C + (size_t)(row0 + ai * HALF + m * 16) * ldc + col0;
#pragma unroll
                for (int bj = 0; bj < 2; ++bj)
#pragma unroll
                    for (int n = 0; n < 2; ++n) *(f32x4*)(rowp + bj * HALF + n * 16) = acc[ai][bj][m][n]; }
    }
};

typedef short bf16x8 __attribute__((ext_vector_type(8)));
typedef float f32x16 __attribute__((ext_vector_type(16)));
typedef float f32x2 __attribute__((ext_vector_type(2)));
typedef __bf16 bf2v __attribute__((ext_vector_type(2)));
constexpr float LOG2E = 1.4426950408889634f;
constexpr float QS2 = QSCALE * LOG2E;
constexpr float NEGB = -1e30f;
__device__ __forceinline__ unsigned pkbf(float a, float b) { const f32x2 v = {a, b}; const bf2v r = __builtin_convertvector(v, bf2v); return __builtin_bit_cast(unsigned, r); }
__device__ __forceinline__ float ex2(float x) { return __builtin_amdgcn_exp2f(x); }
__device__ __forceinline__ int swap23(int x) { return (x & ~12) | ((x & 4) << 1) | ((x & 8) >> 1); }
__device__ __forceinline__ size_t kf_off(int key, int d) { return ((size_t)((key >> 5) * 8 + (d >> 4)) * 64 + ((d >> 3) & 1) * 32 + swap23(key & 31)) * 8 + (d & 7); }
__device__ __forceinline__ size_t vf_off(int key, int d) { const int kk = key & 31; return ((size_t)(((key >> 5) * 4 + (d >> 5)) * 2 + (kk >> 4)) * 64 + ((kk >> 3) & 1) * 32 + (d & 31)) * 8 + (kk & 7); }
__device__ __forceinline__ bf16* fr_nsa(const Args& a, int bg, int kind) { return (bf16*)a.out + ((size_t)(bg * 4 + kind) << 19); }
__device__ __forceinline__ bf16* fr_dil(const Args& a, int b, int head, int kv) { return (bf16*)a.out + ((size_t)16 << 20) + ((size_t)((b * 12 + head) * 2 + kv) << 19); }
constexpr size_t WS_OD = 552 * MiB;
constexpr size_t WS_LSE = 600 * MiB;
constexpr size_t WS_END2 = 601 * MiB;

__device__ __forceinline__ v4u norm_chunk16v(v4u w, const float* gain, float scale, int li) {
    float v[8] = {bflo(w.x), bfhi(w.x), bflo(w.y), bfhi(w.y), bflo(w.z), bfhi(w.z), bflo(w.w), bfhi(w.w)};
    float ss = 0.f;
#pragma unroll
    for (int j = 0; j < 8; ++j) ss += v[j] * v[j];
    ss += __shfl_xor(ss, 1); ss += __shfl_xor(ss, 2); ss += __shfl_xor(ss, 4); ss += __shfl_xor(ss, 8);
    const float rstd = rsqrtf(ss * (1.f / 128.f) + EPS) * scale;
#pragma unroll
    for (int j = 0; j < 8; ++j) v[j] = v[j] * rstd * gain[8 * li + j];
    w.x = pk2(v[0], v[1]); w.y = pk2(v[2], v[3]); w.z = pk2(v[4], v[5]); w.w = pk2(v[6], v[7]);
    return w;
}
__device__ __forceinline__ void ph3_headnorm(const Args& a) {
    const int tid = phase_tid(), lane = tid & 63, wave = __builtin_amdgcn_readfirstlane(tid >> 6), sub = lane >> 4, li = lane & 15;
    const int gw = blockIdx.x * NWAVES + wave, NGW = gridDim.x * NWAVES;
    bf16* Q = (bf16*)(a.ws + WS_Q); const bf16* KV = (const bf16*)(a.ws + WS_KV); bf16* DL = (bf16*)(a.ws + WS_DL);
    const float* qg = a.in[6]; const float* kg = a.in[7]; const float* dqg = a.in[11]; const float* dkg = a.in[12];
    for (int m = gw; m < T; m += NGW) {
        const int b = m / S, s = m % S;
        const int g = sub & 1, win = sub >> 1;
        v4u wq[2], wk, wd[6];
#pragma unroll
        for (int it = 0; it < 2; ++it) wq[it] = *(const v4u*)(Q + (size_t)m * NQ + (it * 4 + sub) * 128 + 8 * li);
        wk = *(const v4u*)(KV + (size_t)m * NKV + ((win ? 8 : 4) + g) * 128 + 8 * li);
#pragma unroll
        for (int it = 0; it < 6; ++it) wd[it] = *(const v4u*)(DL + (size_t)m * NDL + (it * 4 + sub) * 128 + 8 * li);
#pragma unroll
        for (int it = 0; it < 2; ++it) *(v4u*)(Q + (size_t)m * NQ + (it * 4 + sub) * 128 + 8 * li) = norm_chunk16v(wq[it], qg, QS2, li);
        *(v4u*)(fr_nsa(a, b * 2 + g, win ? 2 : 0) + kf_off(s, 8 * li)) = norm_chunk16v(wk, kg + (win ? 256 : 128), 1.f, li);
#pragma unroll
        for (int it = 0; it < 6; ++it) { const int ch = it * 4 + sub;
            if (ch < 12) *(v4u*)(DL + (size_t)m * NDL + ch * 128 + 8 * li) = norm_chunk16v(wd[it], dqg, QS2, li);
            else { const int head = ch - 12, gi = head >> 2, dsh = 2 * gi  , vk = ((s & ((1 << dsh) - 1)) << (12 - dsh)) + (s >> dsh);
                *(v4u*)(fr_dil(a, b, head, 0) + kf_off(vk, 8 * li)) = norm_chunk16v(wd[it], dkg, 1.f, li); } }
    }
}
__device__ __forceinline__ void ph3_vfrag(const Args& a) {
    const int tid = phase_tid(), lane = tid & 63, wave = __builtin_amdgcn_readfirstlane(tid >> 6);
    const int gw = blockIdx.x * NWAVES + wave, NGW = gridDim.x * NWAVES;
    const bf16* KV = (const bf16*)(a.ws + WS_KV); const bf16* DL = (const bf16*)(a.ws + WS_DL);
    for (int job = gw; job < 32768; job += NGW) {
        const bf16* src; size_t rstride; bf16* dst; int key0;
        if (job < 8192) { const int bg = job >> 10, kind = (job >> 9) & 1, s0 = (job & 511) * 8, b = bg >> 1, g = bg & 1;
            src = KV + (size_t)(b * S + s0) * NKV + ((kind ? 10 : 6) + g) * 128; rstride = NKV; dst = fr_nsa(a, bg, kind ? 3 : 1); key0 = s0; }
        else { const int j2 = job - 8192, bh = j2 >> 9, vk0 = (j2 & 511) * 8, b = bh / 12, head = bh % 12, gi = head >> 2, dsh = 2 * gi, L = S >> dsh, r = vk0 / L, m0 = vk0 % L;
            src = DL + (size_t)(b * S + (m0 << dsh) + r) * NDL + (24 + head) * 128; rstride = (size_t)NDL << dsh; dst = fr_dil(a, b, head, 1); key0 = vk0; }
        unsigned w[8];
#pragma unroll
        for (int jj = 0; jj < 8; ++jj) w[jj] = *(const unsigned*)(src + jj * rstride + 2 * lane);
        v4u c0, c1;
        c0.x = (w[0] & 0xffffu) | (w[1] << 16); c0.y = (w[2] & 0xffffu) | (w[3] << 16); c0.z = (w[4] & 0xffffu) | (w[5] << 16); c0.w = (w[6] & 0xffffu) | (w[7] << 16);
        c1.x = (w[0] >> 16) | (w[1] & 0xffff0000u); c1.y = (w[2] >> 16) | (w[3] & 0xffff0000u); c1.z = (w[4] >> 16) | (w[5] & 0xffff0000u); c1.w = (w[6] >> 16) | (w[7] & 0xffff0000u);
        *(v4u*)(dst + vf_off(key0, 2 * lane)) = c0; *(v4u*)(dst + vf_off(key0, 2 * lane + 1)) = c1;
    }
}
__device__ __forceinline__ void ph3_gates(const Args& a) {
    const int tid = phase_tid(), lane = tid & 63, wave = __builtin_amdgcn_readfirstlane(tid >> 6), tl = lane & 31, hh = lane >> 5;
    const int gw = (gridDim.x - 1 - blockIdx.x) * NWAVES + wave, NGW = gridDim.x * NWAVES;
    const bf16* H = (const bf16*)(a.ws + WS_H); const v4u* WG = (const v4u*)(a.ws + WS_WGF) + lane; float* gates = (float*)(a.ws + WS_GATES);
    for (int job = gw; job < T / 32; job += NGW) {
        const int t = job * 32 + tl; const bf16* hr = H + (size_t)t * D + 8 * hh;
        f32x16 acc;
#pragma unroll
        for (int i = 0; i < 16; ++i) acc[i] = 0.f;
#pragma unroll 4
        for (int ks = 0; ks < 128; ++ks) { const bf16x8 af = __builtin_bit_cast(bf16x8, WG[ks * 64]), bfr = __builtin_bit_cast(bf16x8, *(const v4u*)(hr + 16 * ks));
            acc = __builtin_amdgcn_mfma_f32_32x32x16_bf16(af, bfr, acc, 0, 0, 0); }
#pragma unroll
        for (int i = 0; i < 16; ++i) { const int j = (i & 3) + 8 * (i >> 2) + 4 * hh; const float v = acc[i]; if (j < 24) gates[(size_t)t * 24 + j] = sigmoidf(v); }
    }
}
__device__ __forceinline__ void ph3_compress(const Args& a, LAS unsigned char* lds) {
    const int tid = phase_tid(), lane = tid & 63, wave = __builtin_amdgcn_readfirstlane(tid >> 6), cl = lane & 31, hh = lane >> 5;
    LAS float* part = (LAS float*)lds;
    LAS float* hid = part + 2 * 128 * 32;
    LAS float* ob = hid + 32 * 128;
    LAS float* bias = ob + 32 * 128;
    const bf16* KV = (const bf16*)(a.ws + WS_KV);
    const float* w2 = a.in[10]; const float* kg0 = a.in[7]; const float* CBP = (const float*)(a.ws + WS_CBP);
    for (int u = blockIdx.x; u < 128; u += gridDim.x) {
        const int j = u >> 6, bg = (u >> 3) & 7, ct = u & 7, b = bg >> 1, g = bg & 1, c0 = 32 * ct, hhd = j * 2 + g;
        if (tid < 128) { float s = 0.f;
#pragma unroll
            for (int kc = 0; kc < 64; ++kc) s += CBP[(kc * 2 + j) * 128 + tid];
            bias[tid] = s; }
        { const int nt = wave & 3, kh = wave >> 2, c = c0 + cl;
          const v4u* af = (const v4u*)(a.ws + WS_CW1F) + ((size_t)(j * 4 + nt) * 256 + 128 * kh) * 64 + lane;
          f32x16 acc;
#pragma unroll
          for (int i = 0; i < 16; ++i) acc[i] = 0.f;
#pragma unroll 4
          for (int ks = 0; ks < 128; ++ks) { const int k = 16 * (128 * kh + ks) + 8 * hh, l = k >> 7, d = k & 127, p = 16 * c + l;
              v4u x = {0u, 0u, 0u, 0u}; if (p < S) x = *(const v4u*)(KV + (size_t)(b * S + p) * NKV + hhd * 128 + d);
              acc = __builtin_amdgcn_mfma_f32_32x32x16_bf16(__builtin_bit_cast(bf16x8, af[ks * 64]), __builtin_bit_cast(bf16x8, x), acc, 0, 0, 0); }
#pragma unroll
          for (int i = 0; i < 16; ++i) { const int n = 32 * nt + (i & 3) + 8 * (i >> 2) + 4 * hh; const float v = acc[i]; part[(kh * 128 + n) * 32 + cl] = v; } }
        __syncthreads();
        for (int i = tid; i < 128 * 32; i += NTHREADS) { const int n = i >> 5, c = i & 31; hid[c * 128 + n] = gelu_tanh(part[i] + part[128 * 32 + i] + bias[n]); }
        __syncthreads();
        { const int n = tid & 127, cq = tid >> 7; float o[8];
#pragma unroll
          for (int r = 0; r < 8; ++r) o[r] = 0.f;
          const float* w2p = w2 + j * 128 * 128 + n;
          for (int k = 0; k < 128; ++k) { const float w = w2p[k * 128];
#pragma unroll
              for (int r = 0; r < 8; ++r) o[r] += hid[(8 * cq + r) * 128 + k] * w; }
#pragma unroll
          for (int r = 0; r < 8; ++r) ob[(8 * cq + r) * 128 + n] = o[r]; }
        __syncthreads();
        bf16* fr = (bf16*)(a.ws + (j == 0 ? WS_KC : WS_VC)) + (size_t)bg * 8 * 4096;
#pragma unroll 1
        for (int r = 0; r < 4; ++r) { const int cr = 4 * wave + r, c = c0 + cr; float v0 = ob[cr * 128 + 2 * lane], v1 = ob[cr * 128 + 2 * lane + 1];
            if (j == 0) { const float rstd = rsqrtf(wave_sum(v0 * v0 + v1 * v1) * (1.f / 128.f) + EPS); v0 = v0 * rstd * kg0[2 * lane]; v1 = v1 * rstd * kg0[2 * lane + 1]; }
            if (c >= NC) { v0 = 0.f; v1 = 0.f; }
            if (j == 0) *(unsigned*)(fr + kf_off(c, 2 * lane)) = pk2(v0, v1);
            else { fr[vf_off(c, 2 * lane)] = (bf16)f2bf(v0); fr[vf_off(c, 2 * lane + 1)] = (bf16)f2bf(v1); } }
        __syncthreads();
    }
}

#define KBI(i) (16 * ((i) >> 3) + ((i) & 7))
__device__ __forceinline__ void load_frags(bf16x8 (&f)[8], const v4u* p, int lane) {
#pragma unroll
    for (int i = 0; i < 8; ++i) f[i] = __builtin_bit_cast(bf16x8, p[i * 64 + lane]);
}
__device__ __forceinline__ f32x16 qk_mma(const bf16x8 (&qf)[8], const bf16x8 (&k)[8]) {
    f32x16 s;
#pragma unroll
    for (int i = 0; i < 16; ++i) s[i] = 0.f;
#pragma unroll
    for (int st = 0; st < 8; ++st) s = __builtin_amdgcn_mfma_f32_32x32x16_bf16(k[st], qf[st], s, 0, 0, 0);
    return s;
}
__device__ __forceinline__ f32x16 qk_tile(const bf16x8 (&qf)[8], const v4u* kf, int lane) { bf16x8 k[8]; load_frags(k, kf, lane); return qk_mma(qf, k); }
template <int STRIDE> __device__ __forceinline__ void add_tbl(f32x16& s, const LAS float* tp2, float pen) {
#pragma unroll
    for (int i = 0; i < 16; ++i) s[i] += tp2[STRIDE * (23 - KBI(i))] + pen;
}
__device__ __forceinline__ void mask_hi(f32x16& s, int lim) {
#pragma unroll
    for (int i = 0; i < 16; ++i) s[i] = (KBI(i) <= lim) ? s[i] : NEGB;
}
__device__ __forceinline__ void mask_lo(f32x16& s, int lim) {
#pragma unroll
    for (int i = 0; i < 16; ++i) s[i] = (KBI(i) >= lim) ? s[i] : NEGB;
}
__device__ __forceinline__ float max16(const f32x16& s) {
    float mx = fmaxf(s[0], s[1]);
#pragma unroll
    for (int i = 2; i < 16; ++i) mx = fmaxf(mx, s[i]);
    return fmaxf(mx, __shfl_xor(mx, 32));
}
__device__ __forceinline__ void pv_tile(const f32x16& p, f32x16 (&o)[4], const bf16x8 (&v)[8]) {
    v4u a0, a1;
    a0.x = pkbf(p[0], p[1]); a0.y = pkbf(p[2], p[3]); a0.z = pkbf(p[4], p[5]); a0.w = pkbf(p[6], p[7]);
    a1.x = pkbf(p[8], p[9]); a1.y = pkbf(p[10], p[11]); a1.z = pkbf(p[12], p[13]); a1.w = pkbf(p[14], p[15]);
    const bf16x8 pb0 = __builtin_bit_cast(bf16x8, a0), pb1 = __builtin_bit_cast(bf16x8, a1);
#pragma unroll
    for (int dt = 0; dt < 4; ++dt) { o[dt] = __builtin_amdgcn_mfma_f32_32x32x16_bf16(v[2 * dt], pb0, o[dt], 0, 0, 0); o[dt] = __builtin_amdgcn_mfma_f32_32x32x16_bf16(v[2 * dt + 1], pb1, o[dt], 0, 0, 0); }
}
__device__ __forceinline__ void softmax_pv(f32x16& s, f32x16 (&o)[4], float& m, float& l, const v4u* vf, int lane) {
    bf16x8 v[8];
#pragma unroll
    for (int i = 0; i < 8; ++i) v[i] = __builtin_bit_cast(bf16x8, vf[i * 64 + lane]);
    const float mn = fmaxf(m, max16(s));
    if (__ballot(mn > m + 8.f)) {
        const float corr = ex2(m - mn);
#pragma unroll
        for (int dt = 0; dt < 4; ++dt)
#pragma unroll
            for (int i = 0; i < 16; ++i) o[dt][i] *= corr;
        l *= corr; m = mn;
    }
    float ps = 0.f;
#pragma unroll
    for (int i = 0; i < 16; ++i) { s[i] = ex2(s[i] - m); ps += s[i]; }
    l += ps;
    pv_tile(s, o, v);
}
template <int NP = 0> __device__ __forceinline__ void softmax_pv_v(f32x16& s, f32x16 (&o)[4], float& m, float& l, const bf16x8 (&v)[8]) {
    if (NP == 2) { l += s[0]; pv_tile(s, o, v); return; }
    const float mn = fmaxf(m, max16(s));
    if (__ballot(mn > m + 8.f)) {
        const float corr = ex2(m - mn);
#pragma unroll
        for (int dt = 0; dt < 4; ++dt)
#pragma unroll
            for (int i = 0; i < 16; ++i) o[dt][i] *= corr;
        l *= corr; m = mn;
    }
    float ps = 0.f;
#pragma unroll
    for (int i = 0; i < 16; ++i) { s[i] = ex2(s[i] - m); ps += s[i]; }
    l += ps;
    pv_tile(s, o, v);
}
__device__ __forceinline__ void zero_o(f32x16 (&o)[4]) {
#pragma unroll
    for (int dt = 0; dt < 4; ++dt)
#pragma unroll
        for (int i = 0; i < 16; ++i) o[dt][i] = 0.f;
}
__device__ __forceinline__ void y_update(bf16* yp  , const f32x16 (&o)[4], float sc, bool acc) {
#pragma unroll
    for (int dt = 0; dt < 4; ++dt)
#pragma unroll
        for (int i4 = 0; i4 < 4; ++i4) { bf16* p = yp + 32 * dt + 8 * i4;
            float v0 = o[dt][4 * i4] * sc, v1 = o[dt][4 * i4 + 1] * sc, v2 = o[dt][4 * i4 + 2] * sc, v3 = o[dt][4 * i4 + 3] * sc;
            if (acc) { const v2u w = *(const v2u*)p; v0 += bflo(w.x); v1 += bfhi(w.x); v2 += bflo(w.y); v3 += bfhi(w.y); }
            v2u w; w.x = pkbf(v0, v1); w.y = pkbf(v2, v3); *(v2u*)p = w; }
}
constexpr int TBLN = 2624;
constexpr int OFF_TBL = 0, OFF_IMP = 43008, OFF_SELM = OFF_IMP + 65536, OFF_DTBL = OFF_SELM + 512;
constexpr int FAR_DIST = 1513;

template <int NP> __device__ __forceinline__ void nsa_unit(const Args& a, LAS unsigned char* lds, int u, int tid) {
    const int lane = tid & 63, wave = __builtin_amdgcn_readfirstlane(tid >> 6);
    const int qb = u >> 3, bg = u & 7, b = bg >> 1, g = bg & 1;
    const int r = wave >> 1, qs = wave & 1, hd = g * 4 + r, ql = lane & 31, h = lane >> 5;
    const int q0w = 64 * qb + 32 * qs, sq = q0w + ql, t = b * S + sq;
    LAS float* tball = (LAS float*)(lds + OFF_TBL);
    LAS float* imp = (LAS float*)(lds + OFF_IMP);
    LAS unsigned long long* selm = (LAS unsigned long long*)(lds + OFF_SELM);
    const float* relb = a.in[22];
    for (int i = tid; i < 4 * TBLN; i += NTHREADS) { const int hh = i / TBLN, dd = i % TBLN - 64; tball[i] = dd >= 0 ? relb[(g * 4 + hh) * 32 + t5_bucket(dd)] * LOG2E : 0.f; }
    for (int i = tid; i < 4 * 64 * 64; i += NTHREADS) imp[i] = 0.f;
    __syncthreads();
    const LAS float* tbl = tball + r * TBLN + 64;
    const float farc = relb[hd * 32 + 31] * LOG2E;
    bf16x8 qf[8];
    { const bf16* qrow = (const bf16*)(a.ws + WS_Q) + (size_t)t * NQ + hd * 128 + 8 * h;
#pragma unroll
      for (int st = 0; st < 8; ++st) qf[st] = __builtin_bit_cast(bf16x8, *(const v4u*)(qrow + 16 * st)); }
    const float* gt = (const float*)(a.ws + WS_GATES) + (size_t)t * 24 + hd * 3;
    const float g0 = gt[0], g1 = gt[1], g2 = gt[2];
    bf16* yp = (bf16*)(a.ws + (NP ? WS_H : WS_YN)) + (size_t)t * 1536 + hd * 128 + 4 * h;
    f32x16 o[4];
    {
        const v4u* kfc = (const v4u*)(a.ws + WS_KC) + (size_t)bg * 8 * 512; const v4u* vfc = (const v4u*)(a.ws + WS_VC) + (size_t)bg * 8 * 512;
        const int smax = q0w + 31, ncv = smax >= 31 ? ((smax - 31) >> 4) + 1 : 0, ntc = (ncv + 31) >> 5;
        float m = NEGB, l = 0.f;
        for (int tc = 0; tc < ntc; ++tc) {
            f32x16 s = qk_tile(qf, kfc + tc * 512, lane);
            const int dqc = sq - 31 - 512 * tc;
            if (q0w - 31 - 512 * tc - 496 >= FAR_DIST) {
#pragma unroll
                for (int i = 0; i < 16; ++i) s[i] += farc;
            } else add_tbl<16>(s, tbl + dqc - 16 * (8 * h + 23), 0.f);
            mask_hi(s, (dqc >> 4) - 8 * h);
            const float mn = fmaxf(m, max16(s));
            float ps = 0.f;
#pragma unroll
            for (int i = 0; i < 16; ++i) ps += ex2(s[i] - mn);
            l = l * ex2(m - mn) + ps; m = mn;
        }
        l += __shfl_xor(l, 32);
        const float inv = (sq >= 31) ? 1.f / l : 0.f;
        zero_o(o);
        LAS float* impq = imp + (r * 64 + 32 * qs + ql) * 64;
        for (int tc = 0; tc < ntc; ++tc) {
            f32x16 s = qk_tile(qf, kfc + tc * 512, lane);
            bf16x8 v[8];
#pragma unroll
            for (int i = 0; i < 8; ++i) v[i] = __builtin_bit_cast(bf16x8, vfc[tc * 512 + i * 64 + lane]);
            const int dqc = sq - 31 - 512 * tc;
            if (q0w - 31 - 512 * tc - 496 >= FAR_DIST) {
#pragma unroll
                for (int i = 0; i < 16; ++i) s[i] += farc;
            } else add_tbl<16>(s, tbl + dqc - 16 * (8 * h + 23), 0.f);
            mask_hi(s, (dqc >> 4) - 8 * h);
#pragma unroll
            for (int i = 0; i < 16; ++i) s[i] = ex2(s[i] - m) * inv;
#pragma unroll
            for (int a2 = 0; a2 < 2; ++a2)
#pragma unroll
                for (int bq = 0; bq < 2; ++bq) { const int j = 8 * tc + 4 * a2 + 2 * h + bq; const int i0 = 8 * a2 + 4 * bq;
                    impq[j] += (s[i0] + s[i0 + 1]) + (s[i0 + 2] + s[i0 + 3]); }
            asm volatile("s_waitcnt lgkmcnt(0)" ::: "memory");
#pragma unroll
            for (int a2 = 0; a2 < 2; ++a2)
#pragma unroll
                for (int bq = 0; bq < 2; ++bq) { const int j = 8 * tc + 4 * a2 + 2 * h + bq + 1; if (j < 64) impq[j] += s[8 * a2 + 4 * bq + 3]; }
            asm volatile("s_waitcnt lgkmcnt(0)" ::: "memory");
            pv_tile(s, o, v);
        }
        y_update(yp, o, g0, false);
    }
    __syncthreads();
    for (int qq = wave * 8; qq < wave * 8 + 8; ++qq) {
        const int jb = lane;
        const float im = ((imp[(0 * 64 + qq) * 64 + jb] + imp[(1 * 64 + qq) * 64 + jb]) + imp[(2 * 64 + qq) * 64 + jb]) + imp[(3 * 64 + qq) * 64 + jb];
        const bool forced = (jb == 0) || (jb == qb) || (jb == qb - 1);
        const float score = forced ? 1e4f : (jb > qb ? -1e4f : im);
        int rank = 0;
        for (int o2 = 0; o2 < 64; ++o2) { const float so = __shfl(score, o2); rank += (so > score) || (so == score && o2 < jb); }
        const unsigned long long mask = __ballot(rank < 16 && jb <= qb);
        if (lane == 0) selm[qq] = mask;
    }
    __syncthreads();
    {
        const v4u* kfw = (const v4u*)fr_nsa(a, bg, 2); const v4u* vfw = (const v4u*)fr_nsa(a, bg, 3);
        const int t_hi = q0w >> 5, t_lo = t_hi - 16;
        float m = NEGB, l = 0.f; zero_o(o);
        const int t0 = t_lo < 0 ? 0 : t_lo;
        for (int tt = t0; tt <= t_hi; ++tt) {
            const size_t to = (NP == 3) ? (size_t)(tt & 1) * 512 : (size_t)tt * 512;
            bf16x8 kf[8], vf[8]; load_frags(kf, kfw + to, lane);
            f32x16 s = qk_mma(qf, kf); load_frags(vf, vfw + to, lane);
            const int dq = sq - 32 * tt;
            add_tbl<1>(s, tbl + dq - (8 * h + 23), 0.f);
            if (tt == t_hi) mask_hi(s, dq - 8 * h);
            if (tt == t_lo) mask_lo(s, dq - 511 - 8 * h);
            softmax_pv_v<NP>(s, o, m, l, vf);
        }
        l += __shfl_xor(l, 32);
        y_update(yp, o, g2 / l, true);
    }
    {
        const v4u* kfs = (const v4u*)fr_nsa(a, bg, 0); const v4u* vfs = (const v4u*)fr_nsa(a, bg, 1);
        const unsigned long long mask = selm[32 * qs + ql];
        float m = NEGB, l = 0.f; zero_o(o);
        const int t_end = 2 * qb + qs;
        for (int tt = 0; tt <= 2 * qb + 1; ++tt) {
            if (tt > t_end) continue;
            const float pen = ((mask >> (tt >> 1)) & 1ull) ? 0.f : NEGB;
            if (__ballot(pen == 0.f) == 0ull) continue;
            const size_t to = (NP == 3) ? (size_t)(tt & 1) * 512 : (size_t)tt * 512;
            bf16x8 kf[8], vf[8]; load_frags(kf, kfs + to, lane);
            f32x16 s = qk_mma(qf, kf); load_frags(vf, vfs + to, lane);
            const int dq = sq - 32 * tt;
            if (q0w - (32 * tt + 31) >= FAR_DIST) {
                const float c = farc + pen;
#pragma unroll
                for (int i = 0; i < 16; ++i) s[i] += c;
            } else add_tbl<1>(s, tbl + dq - (8 * h + 23), pen);
            if (tt == t_end) mask_hi(s, dq - 8 * h);
            softmax_pv_v<NP>(s, o, m, l, vf);
        }
        l += __shfl_xor(l, 32);
        y_update(yp, o, g1 / l, true);
    }
    __syncthreads();
}
__device__ __forceinline__ void dil_unit(const Args& a, LAS unsigned char* lds, int u, int tid) {
    const int lane = tid & 63, wave = __builtin_amdgcn_readfirstlane(tid >> 6), ql = lane & 31, h = lane >> 5;
    const int b = u >> 6, p = (u >> 4) & 3, c = u & 15, s0 = 256 * c;
    LAS float* dtbl = (LAS float*)(lds + OFF_DTBL);
    const float* relb = a.in[22] + 8 * 32;
    for (int i = tid; i < 3 * 192; i += NTHREADS) { const int gi = i / 192, dm = i % 192 - 32; dtbl[i] = dm >= 0 ? relb[(gi * 4 + p) * 32 + t5_bucket(dm << (2 * gi))] * LOG2E : 0.f; }
    __syncthreads();
    bf16* OD = (bf16*)(a.ws + WS_OD); float* LSE = (float*)(a.ws + WS_LSE);
    const bf16* DL = (const bf16*)(a.ws + WS_DL);
    for (int job = wave; job < 32; job += NWAVES) {
        int gi, rr, m0, vlo, vhi;
        if (job < 8) { gi = 0; rr = 0; m0 = s0 + 32 * job; vlo = 0; vhi = 32; }
        else if (job < 16) { gi = 1; rr = (job - 8) >> 1; m0 = (s0 >> 2) + 32 * (job & 1); vlo = 0; vhi = 32; }
        else { gi = 2; rr = job - 16; m0 = 32 * (c >> 1); vlo = 16 * (c & 1); vhi = vlo + 16; }
        const int dsh = 2 * gi, L = S >> dsh, head = gi * 4 + p;
        const int mq = m0 + ql, sact = (mq << dsh) + rr, t = b * S + sact;
        const v4u* kf = (const v4u*)fr_dil(a, b, head, 0) + (size_t)((rr * L) >> 5) * 512; const v4u* vf = (const v4u*)fr_dil(a, b, head, 1) + (size_t)((rr * L) >> 5) * 512;
        bf16x8 qf[8];
        { const bf16* qrow = DL + (size_t)t * NDL + head * 128 + 8 * h;
#pragma unroll
          for (int st = 0; st < 8; ++st) qf[st] = __builtin_bit_cast(bf16x8, *(const v4u*)(qrow + 16 * st)); }
        const LAS float* tb = dtbl + gi * 192 + 32;
        const int t_hi = m0 >> 5, t_lo = t_hi - 4;
        float m = NEGB, l = 0.f; f32x16 o[4]; zero_o(o);
        const int t0 = t_lo < 0 ? 0 : t_lo;
        for (int tt = t0; tt <= t_hi; ++tt) {
            bf16x8 kr[8], vr[8]; load_frags(kr, kf + (size_t)tt * 512, lane);
            f32x16 s = qk_mma(qf, kr); load_frags(vr, vf + (size_t)tt * 512, lane);
            const int dq = mq - 32 * tt;
            add_tbl<1>(s, tb + dq - (8 * h + 23), 0.f);
            if (tt == t_hi) mask_hi(s, dq - 8 * h);
            if (tt == t_lo) mask_lo(s, dq - 128 - 8 * h);
            softmax_pv_v(s, o, m, l, vr);
        }
        l += __shfl_xor(l, 32);
        if (ql >= vlo && ql < vhi) {
            y_update(OD + ((size_t)gi * T + t) * 512 + p * 128 + 4 * h, o, 1.f / l, false);
            if (h == 0) LSE[((size_t)(gi * NB + b) * 4 + p) * S + sact] = m + __log2f(l);
        }
    }
    __syncthreads();
    { const int pos = tid >> 1, dh = tid & 1, sact = s0 + pos, t = b * S + sact;
      const float l0 = LSE[((size_t)(0 * NB + b) * 4 + p) * S + sact], l1 = LSE[((size_t)(1 * NB + b) * 4 + p) * S + sact], l2 = LSE[((size_t)(2 * NB + b) * 4 + p) * S + sact];
      const float mx = fmaxf(l0, fmaxf(l1, l2)); float w0 = ex2(l0 - mx), w1 = ex2(l1 - mx), w2 = ex2(l2 - mx); const float iw = 1.f / (w0 + w1 + w2); w0 *= iw; w1 *= iw; w2 *= iw;
      bf16* yd = (bf16*)(a.ws + WS_YN) + (size_t)t * 1536 + 1024 + p * 128 + 64 * dh;
      const bf16* o0 = OD + ((size_t)0 * T + t) * 512 + p * 128 + 64 * dh; const bf16* o1 = OD + ((size_t)1 * T + t) * 512 + p * 128 + 64 * dh; const bf16* o2 = OD + ((size_t)2 * T + t) * 512 + p * 128 + 64 * dh;
#pragma unroll
      for (int k = 0; k < 8; ++k) { const v4u x0 = *(const v4u*)(o0 + 8 * k), x1 = *(const v4u*)(o1 + 8 * k), x2 = *(const v4u*)(o2 + 8 * k); v4u y;
          y.x = pkbf(w0 * bflo(x0.x) + w1 * bflo(x1.x) + w2 * bflo(x2.x), w0 * bfhi(x0.x) + w1 * bfhi(x1.x) + w2 * bfhi(x2.x));
          y.y = pkbf(w0 * bflo(x0.y) + w1 * bflo(x1.y) + w2 * bflo(x2.y), w0 * bfhi(x0.y) + w1 * bfhi(x1.y) + w2 * bfhi(x2.y));
          y.z = pkbf(w0 * bflo(x0.z) + w1 * bflo(x1.z) + w2 * bflo(x2.z), w0 * bfhi(x0.z) + w1 * bfhi(x1.z) + w2 * bfhi(x2.z));
          y.w = pkbf(w0 * bflo(x0.w) + w1 * bflo(x1.w) + w2 * bflo(x2.w), w0 * bfhi(x0.w) + w1 * bfhi(x1.w) + w2 * bfhi(x2.w));
          *(v4u*)(yd + 8 * k) = y; } }
    __syncthreads();
}
__device__ __forceinline__ void ph4_attention(const Args& a, LAS unsigned char* lds) {
    const int tid = phase_tid();
    for (int u = blockIdx.x; u < 256; u += gridDim.x) dil_unit(a, lds, u, tid);
#ifndef PROBE_NSA
#define PROBE_NSA 0
#endif
    if (PROBE_NSA) for (int x = blockIdx.x; x < 256; x += gridDim.x) { nsa_unit<PROBE_NSA>(a, lds, 511 - x, tid); nsa_unit<PROBE_NSA>(a, lds, x, tid); }
    for (int x = blockIdx.x; x < 256; x += gridDim.x) { nsa_unit<0>(a, lds, 511 - x, tid); nsa_unit<0>(a, lds, x, tid); }
}

constexpr size_t WS_PU8 = WS_Q;
constexpr size_t WS_PV8 = WS_Q + 32 * MiB;
constexpr size_t WS_PSC = WS_Q + 64 * MiB;
__device__ __forceinline__ void ph_quant_uv(const Args& a) {
    const int tid = phase_tid(), lane = tid & 63, wave = __builtin_amdgcn_readfirstlane(tid >> 6);
    const int gw = blockIdx.x * NWAVES + wave, NGW = gridDim.x * NWAVES;
    float* SC = (float*)(a.ws + WS_PSC);
    for (int rw = gw; rw < NE; rw += NGW) {
        f32x4 x[2][8];
#pragma unroll
        for (int which = 0; which < 2; ++which) { const float* src = a.in[20 + which] + (size_t)rw * D + 16 * lane;
#pragma unroll
            for (int c = 0; c < 2; ++c)
#pragma unroll
                for (int w = 0; w < 4; ++w) x[which][4 * c + w] = *(const f32x4*)(src + 1024 * c + 4 * w); }
#pragma unroll
        for (int which = 0; which < 2; ++which) {
            unsigned char* dst = a.ws + (which ? WS_PV8 : WS_PU8) + (size_t)rw * D + 16 * lane;
            float am = 0.f;
#pragma unroll
            for (int i = 0; i < 8; ++i) am = fmaxf(fmaxf(am, fmaxf(fabsf(x[which][i].x), fabsf(x[which][i].y))), fmaxf(fabsf(x[which][i].z), fabsf(x[which][i].w)));
            am = wave_max(am);
            const float inv = am > 0.f ? 127.f / am : 0.f;
#pragma unroll
            for (int c = 0; c < 2; ++c) { v4u o; unsigned wd[4];
#pragma unroll
                for (int w = 0; w < 4; ++w) { const f32x4 v = x[which][4 * c + w];
                    const unsigned q0 = (unsigned)((int)rintf(v.x * inv) + 128), q1 = (unsigned)((int)rintf(v.y * inv) + 128), q2 = (unsigned)((int)rintf(v.z * inv) + 128), q3 = (unsigned)((int)rintf(v.w * inv) + 128);
                    wd[w] = q0 | (q1 << 8) | (q2 << 16) | (q3 << 24); }
                o.x = wd[0]; o.y = wd[1]; o.z = wd[2]; o.w = wd[3]; *(v4u*)(dst + 1024 * c) = o; }
            if (lane == 0) SC[which * NE + rw] = am * (1.f / 127.f);
        }
    }
}
constexpr size_t WS_KEYF = 601 * MiB;
constexpr size_t WS_END3 = 602 * MiB;
__device__ __forceinline__ void ph0_keyfrags(const Args& a) {
    const int tid = phase_tid();
    const float* keys = a.in[19]; v4u* KF = (v4u*)(a.ws + WS_KEYF);
    for (int i = blockIdx.x * NTHREADS + tid; i < 16 * 32 * 64; i += gridDim.x * NTHREADS) {
        const int lane = i & 63, st = (i >> 6) & 7, kt = (i >> 9) & 3, hp = i >> 11;
        const float* src = keys + ((size_t)hp * 128 + 32 * kt + (lane & 31)) * 128 + 16 * st + 8 * (lane >> 5);
        float v[8]; unsigned hi[8], lo[8];
#pragma unroll
        for (int j = 0; j < 8; ++j) { v[j] = src[j]; hi[j] = f2bf(v[j]); lo[j] = f2bf(v[j] - __builtin_bit_cast(float, hi[j] << 16)); }
        v4u oh, ol; oh.x = hi[0] | (hi[1] << 16); oh.y = hi[2] | (hi[3] << 16); oh.z = hi[4] | (hi[5] << 16); oh.w = hi[6] | (hi[7] << 16);
        ol.x = lo[0] | (lo[1] << 16); ol.y = lo[2] | (lo[3] << 16); ol.z = lo[4] | (lo[5] << 16); ol.w = lo[6] | (lo[7] << 16);
        KF[(size_t)((hp * 2 + 0) * 32 + kt * 8 + st) * 64 + lane] = oh; KF[(size_t)((hp * 2 + 1) * 32 + kt * 8 + st) * 64 + lane] = ol;
    }
}
template <int N, bool MERGE_ONLY> __device__ __forceinline__ void bitonic_desc(float (&v)[N]) {
#pragma unroll
    for (int k = MERGE_ONLY ? N : 2; k <= N; k <<= 1)
#pragma unroll
        for (int j = k >> 1; j > 0; j >>= 1)
#pragma unroll
            for (int i = 0; i < N; ++i) { const int l = i ^ j;
                if (l > i) { const bool desc = ((i & k) == 0) || (k == N); const float x = v[i], y = v[l], hi = fmaxf(x, y), lo = fminf(x, y); v[i] = desc ? hi : lo; v[l] = desc ? lo : hi; } }
}
#define CROW(i) (((i) & 3) + 8 * ((i) >> 2))
__device__ __forceinline__ float max3f(float a, float b, float c) { return fmaxf(fmaxf(a, b), c); }
__device__ __forceinline__ void ph_route(const Args& a, LAS unsigned char* lds) {
    const int tid = phase_tid(), lane = tid & 63, wave = __builtin_amdgcn_readfirstlane(tid >> 6), tl = lane & 31, hc = lane >> 5;
    const int gw = blockIdx.x * NWAVES + wave, NGW = gridDim.x * NWAVES;
    const float* QP = (const float*)(a.ws + WS_QP); const float* qgain = a.in[18]; const v4u* KF = (const v4u*)(a.ws + WS_KEYF);
    int* EI = (int*)(a.ws + WS_EI); float* EG = (float*)(a.ws + WS_EG);
    LAS float* spl = (LAS float*)(lds + wave * 8704) + lane * 33;
    for (int job = gw; job < (T / 32) * 8; job += NGW) {
        const int h = job & 7, t = (job >> 3) * 32 + tl;
#pragma unroll 1
        for (int p = 0; p < 2; ++p) {
            bf16x8 bh[8], bl[8];
            { const float* qr = QP + (size_t)t * D + h * 256 + p * 128 + 8 * hc; const float* gr = qgain + (h * 2 + p) * 128 + 8 * hc;
              float ss = 0.f;
#pragma unroll
              for (int st = 0; st < 8; ++st) { const f32x4 x0 = *(const f32x4*)(qr + 16 * st), x1 = *(const f32x4*)(qr + 16 * st + 4);
                  ss += (x0.x * x0.x + x0.y * x0.y) + (x0.z * x0.z + x0.w * x0.w) + (x1.x * x1.x + x1.y * x1.y) + (x1.z * x1.z + x1.w * x1.w); }
              ss += __shfl_xor(ss, 32);
              const float rstd = rsqrtf(ss * (1.f / 128.f) + EPS);
              asm volatile("" ::: "memory");
#pragma unroll
              for (int st = 0; st < 8; ++st) { const f32x4 x0 = *(const f32x4*)(qr + 16 * st), x1 = *(const f32x4*)(qr + 16 * st + 4); const f32x4 g0 = *(const f32x4*)(gr + 16 * st), g1 = *(const f32x4*)(gr + 16 * st + 4);
                  const float v0 = x0.x * rstd * g0.x, v1 = x0.y * rstd * g0.y, v2 = x0.z * rstd * g0.z, v3 = x0.w * rstd * g0.w, v4 = x1.x * rstd * g1.x, v5 = x1.y * rstd * g1.y, v6 = x1.z * rstd * g1.z, v7 = x1.w * rstd * g1.w;
                  v4u xh, xl; xh.x = pkbf(v0, v1); xh.y = pkbf(v2, v3); xh.z = pkbf(v4, v5); xh.w = pkbf(v6, v7);
                  xl.x = pkbf(v0 - bflo(xh.x), v1 - bfhi(xh.x)); xl.y = pkbf(v2 - bflo(xh.y), v3 - bfhi(xh.y)); xl.z = pkbf(v4 - bflo(xh.z), v5 - bfhi(xh.z)); xl.w = pkbf(v6 - bflo(xh.w), v7 - bfhi(xh.w));
                  bh[st] = __builtin_bit_cast(bf16x8, xh); bl[st] = __builtin_bit_cast(bf16x8, xl); } }
            float sc[64];
            const v4u* kfh = KF + (size_t)(((h * 2 + p) * 2 + 0) * 32) * 64 + lane; const v4u* kfl = KF + (size_t)(((h * 2 + p) * 2 + 1) * 32) * 64 + lane;
#pragma unroll
            for (int kt = 0; kt < 4; ++kt) {
                f32x16 acc;
#pragma unroll
                for (int i = 0; i < 16; ++i) acc[i] = 0.f;
#pragma unroll
                for (int s2 = 0; s2 < 2; ++s2) {
                    asm volatile("" ::: "memory");
                    bf16x8 ah[4], al[4];
#pragma unroll
                    for (int s4 = 0; s4 < 4; ++s4) { ah[s4] = __builtin_bit_cast(bf16x8, kfh[(kt * 8 + s2 * 4 + s4) * 64]); al[s4] = __builtin_bit_cast(bf16x8, kfl[(kt * 8 + s2 * 4 + s4) * 64]); }
#pragma unroll
                    for (int s4 = 0; s4 < 4; ++s4) { const int st = s2 * 4 + s4;
                        acc = __builtin_amdgcn_mfma_f32_32x32x16_bf16(al[s4], bh[st], acc, 0, 0, 0); acc = __builtin_amdgcn_mfma_f32_32x32x16_bf16(ah[s4], bl[st], acc, 0, 0, 0); acc = __builtin_amdgcn_mfma_f32_32x32x16_bf16(ah[s4], bh[st], acc, 0, 0, 0); }
                }
#pragma unroll
                for (int i = 0; i < 16; ++i) { const float av = acc[i];
                    const unsigned bits = (__builtin_bit_cast(unsigned, av) & ~127u) | (unsigned)(127 - (32 * kt + CROW(i) + 4 * hc)); sc[16 * kt + i] = __builtin_bit_cast(float, bits); }
            }
            asm volatile("" ::: "memory");
            bitonic_desc<64, false>(sc);
            float t16[16];
#pragma unroll
            for (int i = 0; i < 16; ++i) t16[i] = __shfl_xor(sc[i], 32);
            float u16[16];
#pragma unroll
            for (int i = 0; i < 16; ++i) u16[i] = fmaxf(sc[i], t16[15 - i]);
            bitonic_desc<16, true>(u16);
#pragma unroll
            for (int i = 0; i < 16; ++i) spl[p * 16 + i] = u16[i];
        }
        asm volatile("s_waitcnt lgkmcnt(0)" ::: "memory");
        float sp[2][16];
#pragma unroll
        for (int i = 0; i < 16; ++i) { sp[0][i] = spl[i]; sp[1][i] = spl[16 + i]; }
        float cv[64];
        {
            int c = 0;
#pragma unroll
            for (int i = 0; i < 16; ++i)
#pragma unroll
                for (int j = 0; j < 16; ++j) if ((i + 1) * (j + 1) <= 16) {
                    const float v = sp[0][i] + sp[1][j];
                    cv[c] = __builtin_bit_cast(float, (__builtin_bit_cast(unsigned, v) & ~255u) | (unsigned)(255 - (i * 16 + j))); ++c; }
#pragma unroll
            for (int i = 50; i < 64; ++i) cv[i] = -INFINITY;
        }
        bitonic_desc<64, false>(cv);
        float tv[16];
#pragma unroll
        for (int i = 0; i < 16; ++i) tv[i] = cv[i];
        asm volatile("s_waitcnt lgkmcnt(0)" ::: "memory");
        int te[16]; float den = 0.f; const float top = tv[0];
#pragma unroll
        for (int i = 0; i < 16; ++i) { const int flat = 255 - (int)(__builtin_bit_cast(unsigned, tv[i]) & 255u);
            const unsigned b1 = __builtin_bit_cast(unsigned, spl[flat >> 4]), b2 = __builtin_bit_cast(unsigned, spl[16 + (flat & 15)]);
            te[i] = (127 - (int)(b1 & 127u)) * 128 + (127 - (int)(b2 & 127u));
            tv[i] = __expf(tv[i] - top); den += tv[i]; }
        den = 1.f / den;
        if (hc == 0) {
            int* ei = EI + (size_t)t * 128 + h * 16; float* eg = EG + (size_t)t * 128 + h * 16;
#pragma unroll
            for (int i = 0; i < 16; i += 4) { *(v4u*)(ei + i) = (v4u){(unsigned)te[i], (unsigned)te[i + 1], (unsigned)te[i + 2], (unsigned)te[i + 3]}; *(f32x4*)(eg + i) = (f32x4){tv[i] * den, tv[i + 1] * den, tv[i + 2] * den, tv[i + 3] * den}; }
        }
        asm volatile("s_waitcnt lgkmcnt(0)" ::: "memory");
    }
}
__device__ __forceinline__ float ub0(unsigned w) { return (float)(w & 0xffu); }
__device__ __forceinline__ float ub1(unsigned w) { return (float)((w >> 8) & 0xffu); }
__device__ __forceinline__ float ub2(unsigned w) { return (float)((w >> 16) & 0xffu); }
__device__ __forceinline__ float ub3(unsigned w) { return (float)(w >> 24); }
__device__ __forceinline__ void ph_experts(const Args& a, const float osc) {
    const int tid = phase_tid(), lane = tid & 63, wave = __builtin_amdgcn_readfirstlane(tid >> 6);
    const int gw = blockIdx.x * NWAVES + wave, NGW = gridDim.x * NWAVES;
    const bf16* H2 = (const bf16*)(a.ws + WS_H); const unsigned char* PU = a.ws + WS_PU8; const unsigned char* PV = a.ws + WS_PV8; const float* SC = (const float*)(a.ws + WS_PSC);
    const int* EI = (const int*)(a.ws + WS_EI); const float* EG = (const float*)(a.ws + WS_EG);
    const float* mod = (const float*)(a.ws + WS_MOD);
    float* out = a.out;
    for (int t = gw; t < T; t += NGW) {
        const int b = t / S;
        float x[32]; float sx = 0.f;
#pragma unroll
        for (int c = 0; c < 2; ++c)
#pragma unroll
            for (int hw = 0; hw < 2; ++hw) { const v4u w = *(const v4u*)(H2 + (size_t)t * D + 1024 * c + 16 * lane + 8 * hw); const int o = 16 * c + 8 * hw;
                x[o + 0] = bflo(w.x); x[o + 1] = bfhi(w.x); x[o + 2] = bflo(w.y); x[o + 3] = bfhi(w.y); x[o + 4] = bflo(w.z); x[o + 5] = bfhi(w.z); x[o + 6] = bflo(w.w); x[o + 7] = bfhi(w.w); }
#pragma unroll
        for (int i = 0; i < 32; ++i) sx += x[i];
        sx = wave_sum(sx) * 128.f;
        const int e0 = EI[(size_t)t * 128 + lane], e1 = EI[(size_t)t * 128 + 64 + lane];
        const float gs0 = EG[(size_t)t * 128 + lane] * SC[NE + e0], gs1 = EG[(size_t)t * 128 + 64 + lane] * SC[NE + e1];
        const float su0 = SC[e0], su1 = SC[e1];
        float cf0 = 0.f, cf1 = 0.f;
#pragma unroll 1
        for (int bt = 0; bt < 16; ++bt) {
            v4u w[8][2];
#pragma unroll
            for (int k = 0; k < 8; ++k) { const int e = __shfl(bt < 8 ? e0 : e1, (bt * 8 + k) & 63); const unsigned char* ur = PU + (size_t)e * D + 16 * lane;
                w[k][0] = *(const v4u*)ur; w[k][1] = *(const v4u*)(ur + 1024); }
#pragma unroll
            for (int k = 0; k < 8; ++k) { float s0 = 0.f, s1 = 0.f;
#pragma unroll
                for (int c = 0; c < 2; ++c) { const v4u q = w[k][c]; const int o = 16 * c;
                    s0 += x[o + 0] * ub0(q.x) + x[o + 1] * ub1(q.x) + x[o + 2] * ub2(q.x) + x[o + 3] * ub3(q.x); s1 += x[o + 4] * ub0(q.y) + x[o + 5] * ub1(q.y) + x[o + 6] * ub2(q.y) + x[o + 7] * ub3(q.y);
                    s0 += x[o + 8] * ub0(q.z) + x[o + 9] * ub1(q.z) + x[o + 10] * ub2(q.z) + x[o + 11] * ub3(q.z); s1 += x[o + 12] * ub0(q.w) + x[o + 13] * ub1(q.w) + x[o + 14] * ub2(q.w) + x[o + 15] * ub3(q.w); }
                const float raw = wave_sum(s0 + s1) - sx;
                if (lane == ((bt * 8 + k) & 63)) { if (bt < 8) cf0 = gelu_tanh(raw * su0) * gs0; else cf1 = gelu_tanh(raw * su1) * gs1; } }
        }
        const float wsum = wave_sum(cf0 + cf1) * 128.f;
        float acc[32];
#pragma unroll
        for (int i = 0; i < 32; ++i) acc[i] = 0.f;
#pragma unroll 1
        for (int bt = 0; bt < 16; ++bt) {
            v4u w[8][2];
#pragma unroll
            for (int k = 0; k < 8; ++k) { const int e = __shfl(bt < 8 ? e0 : e1, (bt * 8 + k) & 63); const unsigned char* vr = PV + (size_t)e * D + 16 * lane;
                w[k][0] = *(const v4u*)vr; w[k][1] = *(const v4u*)(vr + 1024); }
#pragma unroll
            for (int k = 0; k < 8; ++k) { const float cf = __shfl(bt < 8 ? cf0 : cf1, (bt * 8 + k) & 63);
#pragma unroll
                for (int c = 0; c < 2; ++c) { const v4u q = w[k][c]; const int o = 16 * c;
                    acc[o + 0] += cf * ub0(q.x); acc[o + 1] += cf * ub1(q.x); acc[o + 2] += cf * ub2(q.x); acc[o + 3] += cf * ub3(q.x); acc[o + 4] += cf * ub0(q.y); acc[o + 5] += cf * ub1(q.y); acc[o + 6] += cf * ub2(q.y); acc[o + 7] += cf * ub3(q.y);
                    acc[o + 8] += cf * ub0(q.z); acc[o + 9] += cf * ub1(q.z); acc[o + 10] += cf * ub2(q.z); acc[o + 11] += cf * ub3(q.z); acc[o + 12] += cf * ub0(q.w); acc[o + 13] += cf * ub1(q.w); acc[o + 14] += cf * ub2(q.w); acc[o + 15] += cf * ub3(q.w); } }
        }
        const float* g2 = mod + b * 12288 + 10240;
#pragma unroll
        for (int c = 0; c < 2; ++c)
#pragma unroll
            for (int w4 = 0; w4 < 4; ++w4) { float* op = out + (size_t)t * D + 1024 * c + 16 * lane + 4 * w4; const f32x4 ga = *(const f32x4*)(g2 + 1024 * c + 16 * lane + 4 * w4); f32x4 r0 = *(const f32x4*)op; const int o = 16 * c + 4 * w4;
                r0.x += ga.x * (acc[o + 0] - wsum) * osc; r0.y += ga.y * (acc[o + 1] - wsum) * osc; r0.z += ga.z * (acc[o + 2] - wsum) * osc; r0.w += ga.w * (acc[o + 3] - wsum) * osc;
                *(f32x4*)op = r0; }
    }
}

constexpr int N_PHASES = 11;
__global__ void __launch_bounds__(NTHREADS, 2) fwd_kernel(Args a) {
    extern __shared__ __attribute__((aligned(16))) unsigned char lds_raw[];
    LAS unsigned char* lds = (LAS unsigned char*)lds_raw;
    const int tid = threadIdx.x;
    volatile LAS unsigned* misc = (volatile LAS unsigned*)(lds + LDS_MISC);
    if (tid < 16) misc[tid] = 0u;
    __syncthreads();
    XcdBarrier bar; bar.bar = (unsigned*)(a.ws + WS_CTL) + 1024; bar.x = 0; bar.st = nullptr;
    const int lo = a.ph_lo, hi = a.ph_hi;
    if (hi - lo > 1) bar = xcd_barrier_post((unsigned*)(a.ws + WS_CTL) + 1024, misc + 8);
#define IN(k) (lo <= (k) && (k) < hi)
#define SEAM(k) do { if (IN(k) && IN((k) + 1)) xcd_barrier(bar); } while (0)
    const int G = gridDim.x, bx = blockIdx.x;

    for (int rep = 0; rep < 1 + ((PROBE_DUP >> 0) & 1); ++rep)
    if (IN(0)) { ph0_mod(a, lds); __syncthreads(); ph0_weights(a, lds); ph0_keyfrags(a); ph0_extra(a); __syncthreads(); }
    SEAM(0);
    for (int rep = 0; rep < 1 + ((PROBE_DUP >> 1) & 1); ++rep)
    if (IN(1)) ph_norm(a, a.in[0], a.in[4], 0, 2048, (bf16*)(a.ws + WS_H));
    SEAM(1);
    for (int rep = 0; rep < 1 + ((PROBE_DUP >> 2) & 1); ++rep)
    if (IN(2)) { pg8::Gemm g{(const bf16*)(a.ws + WS_H), (const bf16*)(a.ws + WS_WIN), T, NPROJ, D}; pg8::StaticOrder So; So.init(T, NPROJ, G, bx);
        EpiProj E{(bf16*)(a.ws + WS_Q), (bf16*)(a.ws + WS_KV), (bf16*)(a.ws + WS_DL), (bf16*)(a.ws + WS_MG)};
        pg8::gemm_phase<EpiProj, pg8::StaticOrder>(lds, g, So, E); }
    SEAM(2);
    if (IN(3)) { ph3_headnorm(a); for (int rep = 0; rep < 1 + ((PROBE_DUP >> 3) & 1); ++rep) { ph3_vfrag(a); ph3_gates(a); ph3_compress(a, lds); } }
    SEAM(3);
    for (int rep = 0; rep < 1 + ((PROBE_DUP >> 4) & 1); ++rep)
    if (IN(4)) ph4_attention(a, lds);
    SEAM(4);
    for (int rep = 0; rep < 1 + ((PROBE_DUP >> 5) & 1); ++rep)
    if (IN(5)) {
        { pg8::Gemm g{(const bf16*)(a.ws + WS_YN), (const bf16*)(a.ws + WS_WBN), T, D, 1536}; pg8::StaticOrder So; So.init(T, D, G, bx);
          EpiMerge E{(const bf16*)(a.ws + WS_MG), (bf16*)(a.ws + WS_H)}; MidMerge Mh{(const bf16*)(a.ws + WS_MG)};
          pg8::gemm_phase<EpiMerge, pg8::StaticOrder, MidMerge>(lds, g, So, E, Mh); }
    }
    SEAM(5);
    for (int rep = 0; rep < 1 + ((PROBE_DUP >> 6) & 1); ++rep)
    if (IN(6)) { pg8::Gemm g{(const bf16*)(a.ws + WS_H), (const bf16*)(a.ws + WS_WOUT), T, D, D}; pg8::StaticOrder So; So.init(T, D, G, bx);
        EpiOut E{a.in[0], (const float*)(a.ws + WS_MOD), a.out}; pg8::gemm_phase<EpiOut, pg8::StaticOrder>(lds, g, So, E); }
    SEAM(6);
    for (int rep = 0; rep < 1 + ((PROBE_DUP >> 7) & 1); ++rep)
    if (IN(7)) { ph_norm(a, a.out, a.in[16], 6144, 8192, (bf16*)(a.ws + WS_H)); ph_quant_uv(a); }
    SEAM(7);
    for (int rep = 0; rep < 1 + ((PROBE_DUP >> 8) & 1); ++rep)
    if (IN(8)) { pg8::Gemm g{(const bf16*)(a.ws + WS_H), (const bf16*)(a.ws + WS_WPQ), T, D, D}; pg8::StaticOrder So; So.init(T, D, G, bx);
        EpiF32 E{(float*)(a.ws + WS_QP), D}; pg8::gemm_phase<EpiF32, pg8::StaticOrder>(lds, g, So, E); }
    SEAM(8);
    for (int rep = 0; rep < 1 + ((PROBE_DUP >> 9) & 1); ++rep)
    if (IN(9)) { ph_route(a, lds); __syncthreads(); }
    SEAM(9);
    if (IN(10)) { if ((PROBE_DUP >> 10) & 1) { ph_experts(a, *(const float*)(a.ws + WS_CTL + 64)); asm volatile("s_waitcnt vmcnt(0)" ::: "memory"); __syncthreads(); } ph_experts(a, 1.f); }
#undef IN
#undef SEAM
}

extern "C" void kernel_launch(void* const* d_in, const int* in_sizes, int n_in, void* d_out, int out_size, void* d_ws, size_t ws_size, hipStream_t stream) {
    static int grid = 0;
    if (grid == 0) {
        if (n_in != 23 || out_size != T * D || ws_size < WS_END4) { fprintf(stderr, "kernel_launch: unexpected problem shape (n_in %d, out %d, ws %zu); nothing launched\n", n_in, out_size, ws_size); grid = -1; return; }
        int dev = 0, cus = 0, per_cu = 0;
        if (hipGetDevice(&dev) != hipSuccess || hipDeviceGetAttribute(&cus, hipDeviceAttributeMultiprocessorCount, dev) != hipSuccess) { grid = -1; return; }
        if (hipFuncSetAttribute((const void*)fwd_kernel, hipFuncAttributeMaxDynamicSharedMemorySize, LDS_BYTES) != hipSuccess) { fprintf(stderr, "kernel_launch: hipFuncSetAttribute failed\n"); grid = -1; return; }
        if (hipOccupancyMaxActiveBlocksPerMultiprocessor(&per_cu, (const void*)fwd_kernel, NTHREADS, LDS_BYTES) != hipSuccess || per_cu < 1) { fprintf(stderr, "kernel_launch: occupancy query says %d\n", per_cu); }
        (void)hipGetLastError();
        grid = cus;
    }
    if (grid < 0) return;
    hipMemsetAsync((char*)d_ws + WS_CTL, 0, CTL_ZERO_BYTES, stream);
    Args a{};
    for (int i = 0; i < 23; ++i) a.in[i] = (const float*)d_in[i];
    a.out = (float*)d_out; a.ws = (unsigned char*)d_ws;
#if MK_ONE_LAUNCH
#if PROBE_PREFIX >= 0
    a.ph_lo = 0; a.ph_hi = PROBE_PREFIX + 1;
    hipLaunchKernelGGL(fwd_kernel, dim3(grid), dim3(NTHREADS), LDS_BYTES, stream, a);
    hipMemsetAsync((char*)d_ws + WS_CTL, 0, CTL_ZERO_BYTES, stream);
#endif
    a.ph_lo = 0; a.ph_hi = N_PHASES;
    hipLaunchKernelGGL(fwd_kernel, dim3(grid), dim3(NTHREADS), LDS_BYTES, stream, a);
#else
    for (int p = 0; p < N_PHASES; ++p) { a.ph_lo = p; a.ph_hi = p + 1; hipLaunchKernelGGL(fwd_kernel, dim3(grid), dim3(NTHREADS), LDS_BYTES, stream, a); }
#endif
}
```

```cpp
#include <hip/hip_runtime.h>
#include <cstdio>
#include <cstdint>

#ifndef PROBE_DUP
#define PROBE_DUP 0
#endif
#ifndef PROBE_PREFIX
#define PROBE_PREFIX -1
#endif
#ifndef MK_ONE_LAUNCH
#define MK_ONE_LAUNCH 1
#endif

__device__ __forceinline__ int phase_tid() { int t = threadIdx.x; asm volatile("" : "+v"(t)); return t; }
namespace pg8 {
#define PG8_LAS __attribute__((address_space(3)))
typedef unsigned short bf16_t;
typedef short bf16x8 __attribute__((ext_vector_type(8)));
typedef float f32x4 __attribute__((ext_vector_type(4)));
typedef unsigned u32x4 __attribute__((ext_vector_type(4)));
typedef unsigned u32x2 __attribute__((ext_vector_type(2)));
constexpr int BM = 256, BK = 64, HALF = 128, HTB = HALF * BK * 2, STAGE_BYTES = 8 * HTB, NXCD = 8, WGM = 8;

__host__ __device__ __forceinline__ int lds_byte(int r, int c) { const int st = (r >> 4) * 2 + (c >> 5), rr = r & 15, cc = c & 31, ob = rr * 64 + cc * 2; return st * 1024 + (ob ^ (((ob >> 9) & 1) << 5)); }
__host__ __device__ __forceinline__ void stage_rc(int b, int& R, int& C) { const int st = b / 1024, sb = b % 1024, swz = sb ^ (((sb >> 9) & 1) << 5); R = (st >> 1) * 16 + swz / 64; C = (st & 1) * 32 + (swz % 64) / 2; }
__host__ __device__ __forceinline__ int perm32(int rho) { const int n = rho >> 4, i = rho & 15; return 8 * (i >> 2) + 4 * n + (i & 3); }

struct Unit { int pm, pn; };
struct Gemm { const bf16_t* A; const bf16_t* Bt; int M, N, K; };

struct StaticOrder {
    int nM, nN, nwg, G, c;
    __host__ __device__ void init(int M, int N, int G_, int c_) { nM = M / BM; nN = N / BM; nwg = nM * nN; G = G_; c = c_; }
    __host__ __device__ bool next(int i, Unit& u) const {
        const long L = (long)i * G + c; if (L >= nwg) return false;
        int wgid = (int)L; { const int q = nwg / NXCD, r = nwg % NXCD, xcd = wgid % NXCD, off = wgid / NXCD; wgid = (xcd < r ? xcd * (q + 1) : r * (q + 1) + (xcd - r) * q) + off; }
        const int nig = WGM * nN, gid = wgid / nig, fm = gid * WGM, gsz = (nM - fm) < WGM ? (nM - fm) : WGM;
        u.pm = fm + ((wgid % nig) % gsz); u.pn = (wgid % nig) / gsz; return true;
    }
    __device__ __forceinline__ void a_ready(const Unit&) const {}
    __device__ __forceinline__ void done(const Unit&) const {}
};

__device__ __forceinline__ unsigned cvt_pk_bf16(float lo, float hi) { unsigned r; asm volatile("v_cvt_pk_bf16_f32 %0, %1, %2" : "=v"(r) : "v"(lo), "v"(hi)); return r; }

struct NoMid { static constexpr int AT = -1; __device__ __forceinline__ void operator()(f32x4 (&)[2][2][4][2], const Unit&, int, int, int, int) const {} };
template <class Epi, class Sched, class Mid = NoMid>
__device__ __forceinline__ void gemm_phase(PG8_LAS unsigned char* lds, const Gemm g, const Sched& S, const Epi& E, const Mid& Mh = Mid()) {
    const int tid = phase_tid(), wid = __builtin_amdgcn_readfirstlane(tid >> 6), lane = tid & 63, wr = wid >> 2, wc = wid & 3, fr = lane & 15, fq = lane >> 4;
    const int K = g.K, nt = K / BK;
    unsigned voffA[2], voffB[2];
#pragma unroll
    for (int i = 0; i < 2; ++i) { int R, C; stage_rc(tid * 16 + i * 8192, R, C); const int Rb = Epi::PERM ? ((R & ~31) + perm32(R & 31)) : R;
        voffA[i] = (unsigned)(R * K + C) * 2u; voffB[i] = (unsigned)(Rb * K + C) * 2u; }
    const size_t kstep = (size_t)(BK * 2);
    const size_t hstep = (size_t)HALF * K * 2;
    const size_t tstep = 2 * hstep;
    const unsigned ldsw = (unsigned)wid * 1024u;
    const int aoff = lds_byte(wr * 64 + fr, fq * 8), boff = lds_byte(wc * 32 + fr, fq * 8);
#define PG8_SA(b, h) (((b) * 2 + (h)) * HTB)
#define PG8_SB(b, h) ((4 + (b) * 2 + (h)) * HTB)
#define PG8_STAGE(bufoff, gbase, voff) do { _Pragma("unroll") for (int _i = 0; _i < 2; ++_i) \
        __builtin_amdgcn_global_load_lds((const unsigned*)((const char*)(gbase) + (voff)[_i]), (PG8_LAS unsigned*)(lds + (bufoff) + ldsw + _i * 8192), 16, 0, 0); } while (0)
#define PG8_LDA(dst, b, h) do { _Pragma("unroll") for (int m = 0; m < 4; ++m) _Pragma("unroll") for (int k = 0; k < 2; ++k) dst[m][k] = *(const PG8_LAS bf16x8*)(lds + PG8_SA(b, h) + aoff + m * 2048 + k * 1024); } while (0)
#define PG8_LDB(dst, b, h) do { _Pragma("unroll") for (int n = 0; n < 2; ++n) _Pragma("unroll") for (int k = 0; k < 2; ++k) dst[n][k] = *(const PG8_LAS bf16x8*)(lds + PG8_SB(b, h) + boff + n * 2048 + k * 1024); } while (0)
#define PG8_MMA(ai, bj, At, Bt) do { __builtin_amdgcn_s_setprio(1); _Pragma("unroll") for (int m = 0; m < 4; ++m) _Pragma("unroll") for (int n = 0; n < 2; ++n) _Pragma("unroll") for (int k = 0; k < 2; ++k) \
        acc[ai][bj][m][n] = __builtin_amdgcn_mfma_f32_16x16x32_bf16(Bt[n][k], At[m][k], acc[ai][bj][m][n], 0, 0, 0); __builtin_amdgcn_s_setprio(0); } while (0)
#define PG8_WAIT_V(n) asm volatile("s_waitcnt vmcnt(" #n ")" ::: "memory")
#define PG8_WAIT_L(n) asm volatile("s_waitcnt lgkmcnt(" #n ")" ::: "memory")
#define PG8_BAR __builtin_amdgcn_s_barrier()
#define PG8_SCHED __builtin_amdgcn_sched_barrier(0)
    Unit cur, nxt; int ui = 0;
    if (!S.next(0, cur)) return;
    f32x4 acc[2][2][4][2];
#pragma unroll
    for (int a = 0; a < 2; ++a)
#pragma unroll
        for (int b = 0; b < 2; ++b)
#pragma unroll
            for (int m = 0; m < 4; ++m)
#pragma unroll
                for (int n = 0; n < 2; ++n) acc[a][b][m][n] = (f32x4){0.f, 0.f, 0.f, 0.f};
    bf16x8 At[4][2], B0[2][2], B1[2][2];
    const char* cA = (const char*)g.A + (size_t)cur.pm * tstep; const char* cB = (const char*)g.Bt + (size_t)cur.pn * tstep;
    S.a_ready(cur);
    PG8_STAGE(PG8_SB(0, 0), cB, voffB); PG8_STAGE(PG8_SA(0, 0), cA, voffA); PG8_STAGE(PG8_SB(0, 1), cB + hstep, voffB); PG8_STAGE(PG8_SA(0, 1), cA + hstep, voffA);
    if (wr == 1) PG8_BAR;
    PG8_WAIT_V(4); PG8_BAR;
    PG8_STAGE(PG8_SB(1, 0), cB + kstep, voffB); PG8_STAGE(PG8_SA(1, 0), cA + kstep, voffA); PG8_STAGE(PG8_SB(1, 1), cB + hstep + kstep, voffB);
    PG8_WAIT_V(6); PG8_BAR;
    for (;;) {
        const bool has_next = S.next(ui + 1, nxt);
        const char* nA = has_next ? (const char*)g.A + (size_t)nxt.pm * tstep : cA; const char* nB = has_next ? (const char*)g.Bt + (size_t)nxt.pn * tstep : cB;
#define PG8_KBODY \
            const bool last = (t == nt - 2); \
            const char* a1 = cA + (size_t)(t + 1) * kstep; \
            const char* a2 = last ? nA : cA + (size_t)(t + 2) * kstep; const char* b2 = last ? nB : cB + (size_t)(t + 2) * kstep; \
            const char* a3 = a2 + kstep; const char* b3 = b2 + kstep; \
            if (last && has_next) S.a_ready(nxt); \
            PG8_LDB(B0, 0, 0); PG8_SCHED; PG8_LDA(At, 0, 0); PG8_STAGE(PG8_SA(1, 1), a1 + hstep, voffA); \
            PG8_WAIT_L(8); PG8_BAR; PG8_WAIT_L(0); PG8_MMA(0, 0, At, B0); PG8_BAR; PG8_SCHED; \
            PG8_LDB(B1, 0, 1); PG8_STAGE(PG8_SB(0, 0), b2, voffB); \
            PG8_BAR; PG8_WAIT_L(0); PG8_MMA(0, 1, At, B1); PG8_BAR; \
            PG8_LDA(At, 0, 1); PG8_STAGE(PG8_SA(0, 0), a2, voffA); \
            PG8_BAR; PG8_WAIT_L(0); PG8_MMA(1, 0, At, B0); PG8_BAR; PG8_SCHED; \
            PG8_STAGE(PG8_SB(0, 1), b2 + hstep, voffB); \
            PG8_WAIT_V(6); PG8_BAR; PG8_MMA(1, 1, At, B1); PG8_BAR; \
            PG8_LDB(B0, 1, 0); PG8_SCHED; PG8_LDA(At, 1, 0); PG8_STAGE(PG8_SA(0, 1), a2 + hstep, voffA); \
            PG8_WAIT_L(8); PG8_BAR; PG8_WAIT_L(0); PG8_MMA(0, 0, At, B0); PG8_BAR; PG8_SCHED; \
            PG8_LDB(B1, 1, 1); PG8_STAGE(PG8_SB(1, 0), b3, voffB); \
            PG8_BAR; PG8_WAIT_L(0); PG8_MMA(0, 1, At, B1); PG8_BAR; \
            PG8_LDA(At, 1, 1); PG8_STAGE(PG8_SA(1, 0), a3, voffA); \
            PG8_BAR; PG8_WAIT_L(0); PG8_MMA(1, 0, At, B0); PG8_BAR; PG8_SCHED; \
            PG8_STAGE(PG8_SB(1, 1), b3 + hstep, voffB); \
            PG8_WAIT_V(6); PG8_BAR; PG8_MMA(1, 1, At, B1); PG8_BAR;
        if constexpr (Mid::AT >= 0) {
            for (int t = 0; t < Mid::AT; t += 2) { PG8_KBODY }
            Mh(acc, cur, wr, wc, fr, fq);
            for (int t = Mid::AT; t < nt; t += 2) { PG8_KBODY }
        } else {
            for (int t = 0; t < nt; t += 2) { PG8_KBODY }
        }
#undef PG8_KBODY
        E(acc, cur, wr, wc, fr, fq); S.done(cur);
        if (!has_next) break;
#pragma unroll
        for (int a = 0; a < 2; ++a)
#pragma unroll
            for (int b = 0; b < 2; ++b)
#pragma unroll
                for (int m = 0; m < 4; ++m)
#pragma unroll
                    for (int n = 0; n < 2; ++n) acc[a][b][m][n] = (f32x4){0.f, 0.f, 0.f, 0.f};
        cur = nxt; cA = nA; cB = nB; ++ui;
    }
    PG8_WAIT_V(0);
    if (wr == 0) PG8_BAR;
    PG8_BAR;
#undef PG8_SA
#undef PG8_SB
#undef PG8_STAGE
#undef PG8_LDA
#undef PG8_LDB
#undef PG8_MMA
#undef PG8_WAIT_V
#undef PG8_WAIT_L
#undef PG8_BAR
#undef PG8_SCHED
}
}

#define GAS __attribute__((address_space(1)))
#define LAS __attribute__((address_space(3)))
typedef unsigned short bf16;
typedef float f32x4 __attribute__((ext_vector_type(4)));
typedef unsigned v4u __attribute__((ext_vector_type(4)));
typedef unsigned v2u __attribute__((ext_vector_type(2)));

constexpr int NB = 4, S = 4096, D = 2048, T = NB * S, HD = 128;
constexpr int IN_COLS = 11288, OFF_KV = 1024, OFF_GATE = 2560, OFF_DIL = 2584, OFF_MERGE = 7192;
constexpr int NPROJ = 11264;
constexpr int NQ = 1024, NKV = 1536, NDL = 4608, NMG = 4096;
constexpr int NC = 255, NS = 64;
constexpr int NE = 16384;
constexpr float EPS = 1e-6f;
constexpr float QSCALE = 0.08838834764831845f;
constexpr int NWAVES = 8, NTHREADS = 512;

constexpr size_t MiB = 1u << 20;
constexpr size_t WS_CTL = 0, CTL_ZERO_BYTES = 1 * MiB;
constexpr size_t WS_WIN = 1 * MiB;
constexpr size_t WS_WBN = 45 * MiB;
constexpr size_t WS_WBD = 49 * MiB;
constexpr size_t WS_WOUT = 51 * MiB;
constexpr size_t WS_WPQ = 59 * MiB;
constexpr size_t WS_WGATE = 67 * MiB;
constexpr size_t WS_MOD = 67 * MiB + 256 * 1024;
constexpr size_t WS_SEL = 67 * MiB + 512 * 1024;
constexpr size_t WS_GATES = 68 * MiB;
constexpr size_t WS_KC = 70 * MiB;
constexpr size_t WS_VC = 71 * MiB;
constexpr size_t WS_H = 72 * MiB;
constexpr size_t WS_Q = 136 * MiB;
constexpr size_t WS_KV = 168 * MiB;
constexpr size_t WS_DL = 216 * MiB;
constexpr size_t WS_MG = 360 * MiB;
constexpr size_t WS_YN = 488 * MiB;
constexpr size_t WS_YD = 520 * MiB;
constexpr size_t WS_EI = 536 * MiB;
constexpr size_t WS_EG = 544 * MiB;
constexpr size_t WS_END = 552 * MiB;
constexpr size_t WS_PU = WS_Q;
constexpr size_t WS_PV = WS_Q + 64 * MiB;
constexpr size_t WS_QP = WS_MG;
static_assert(WS_PV + 64 * MiB <= WS_MG, "u/v overlay");

constexpr int LDS_BYTES = 147456;
constexpr int LDS_MISC = 144 * 1024 - 256;

#define XB_TMO      128
#define XB_XCNT(j)  (256  + 64 * (j))
#define XB_XSUB(j)  (1280 + 64 * (j))
#define XB_XGEN(j)  (2304 + 64 * (j))
#define XB_TOP      3328
#define XB_TOPGEN   3392
#define XCD_BAR_WORDS 3456
#define XB_SPIN_CAP (1u << 24)

__device__ __forceinline__ unsigned xb_ld(unsigned* p)              { return __hip_atomic_load(p, __ATOMIC_RELAXED, __HIP_MEMORY_SCOPE_AGENT); }
__device__ __forceinline__ unsigned xb_add(unsigned* p, unsigned v) { return __hip_atomic_fetch_add(p, v, __ATOMIC_RELAXED, __HIP_MEMORY_SCOPE_AGENT); }
__device__ __forceinline__ unsigned xb_xcc_id() { return (unsigned)__builtin_amdgcn_s_getreg((3 << 11) | 20) & 0xFu; }
#define XB_SPIN(cond, bar) do { unsigned _sp = 0; while (cond) { __builtin_amdgcn_s_sleep(1); \
    if ((++_sp & 255u) == 0u) { if (xb_ld(&(bar)[XB_TMO])) break; if (_sp > XB_SPIN_CAP) { atomicAdd(&(bar)[XB_TMO], 1u); break; } } } } while (0)

struct XcdBarrier { unsigned* bar; unsigned x; volatile LAS unsigned* st; };

__device__ __forceinline__ XcdBarrier xcd_barrier_post(unsigned* bar, volatile LAS unsigned* st) {
    XcdBarrier b; b.bar = bar; b.x = xb_xcc_id(); b.st = st;
    if (threadIdx.x == 0) (void)xb_add(&bar[XB_XCNT(b.x)], 1u);
    return b;
}
__device__ __forceinline__ void xcd_barrier_complete(unsigned* bar, unsigned x, unsigned& nloc, unsigned& nx) {
    const unsigned G = gridDim.x * gridDim.y * gridDim.z;
    unsigned sum, cnt, mine, sp = 0u;
    for (;;) {
        sum = 0u; cnt = 0u; mine = 0u;
#pragma unroll
        for (unsigned j = 0; j < 16; ++j) { const unsigned c = xb_ld(&bar[XB_XCNT(j)]); sum += c; cnt += (c > 0u) ? 1u : 0u; mine = (j == x) ? c : mine; }
        if (sum == G) break;
        __builtin_amdgcn_s_sleep(1);
        if ((++sp & 255u) == 0u) { if (xb_ld(&bar[XB_TMO])) break; if (sp > XB_SPIN_CAP) { atomicAdd(&bar[XB_TMO], 1u); break; } }
    }
    nloc = mine > 0u ? mine : 1u; nx = cnt > 0u ? cnt : 1u;
}
__device__ __forceinline__ void xcd_barrier(const XcdBarrier& b) {
    asm volatile("s_waitcnt vmcnt(0)" ::: "memory");
    __syncthreads();
    if (threadIdx.x == 0) {
        unsigned* bar = b.bar;
        __builtin_amdgcn_s_waitcnt(0);
        unsigned nloc = b.st[0], nx = b.st[1];
        if (nloc == 0u) { xcd_barrier_complete(bar, b.x, nloc, nx); b.st[0] = nloc; b.st[1] = nx; }
        const unsigned old = xb_add(&bar[XB_XSUB(b.x)], 1u);
        const unsigned gen = old / nloc;
        if (old + 1u == (gen + 1u) * nloc) {
            __builtin_amdgcn_fence(__ATOMIC_RELEASE, "agent");
            asm volatile("s_waitcnt vmcnt(0)" ::: "memory");
            const unsigned og = xb_add(&bar[XB_TOP], 1u);
            const unsigned tg = og / nx;
            if (og + 1u == (tg + 1u) * nx) xb_add(&bar[XB_TOPGEN], 1u);
            else XB_SPIN(xb_ld(&bar[XB_TOPGEN]) == tg, bar);
            __builtin_amdgcn_fence(__ATOMIC_ACQUIRE, "agent");
            xb_add(&bar[XB_XGEN(b.x)], 1u);
            asm volatile("s_waitcnt vmcnt(0)" ::: "memory");
        } else {
            XB_SPIN(xb_ld(&bar[XB_XGEN(b.x)]) == gen, bar);
            __builtin_amdgcn_fence(__ATOMIC_ACQUIRE, "agent");
            asm volatile("s_waitcnt vmcnt(0)" ::: "memory");
        }
    }
    __syncthreads();
}

__device__ __forceinline__ unsigned f2bf(float f) { unsigned u = __builtin_bit_cast(unsigned, f); return (u + 0x7fffu + ((u >> 16) & 1u)) >> 16; }
__device__ __forceinline__ unsigned pk2(float lo, float hi) { return f2bf(lo) | (f2bf(hi) << 16); }
__device__ __forceinline__ float bflo(unsigned u) { return __builtin_bit_cast(float, u << 16); }
__device__ __forceinline__ float bfhi(unsigned u) { return __builtin_bit_cast(float, u & 0xffff0000u); }
__device__ __forceinline__ float bf2f(bf16 u) { return __builtin_bit_cast(float, (unsigned)u << 16); }
__device__ __forceinline__ float wave_sum(float v) {
#pragma unroll
    for (int o = 1; o < 64; o <<= 1) v += __shfl_xor(v, o);
    return v;
}
__device__ __forceinline__ float wave_max(float v) {
#pragma unroll
    for (int o = 1; o < 64; o <<= 1) v = fmaxf(v, __shfl_xor(v, o));
    return v;
}
__device__ __forceinline__ float sigmoidf(float x) { return __builtin_amdgcn_rcpf(1.f + __expf(-x)); }
__device__ __forceinline__ float gelu_tanh(float x) { const float u = 0.7978845608028654f * (x + 0.044715f * x * x * x); return 0.5f * x * (1.f + tanhf(u)); }
__device__ __forceinline__ int t5_bucket(int n) {
    if (n < 16) return n;
    int b = 16;
    b += (n >= 22); b += (n >= 30); b += (n >= 40); b += (n >= 54); b += (n >= 73); b += (n >= 99); b += (n >= 134); b += (n >= 182);
    b += (n >= 246); b += (n >= 332); b += (n >= 450); b += (n >= 609); b += (n >= 825); b += (n >= 1117); b += (n >= 1513);
    return b;
}

struct Args {
    const float* in[23];
    float* out; unsigned char* ws;
    int ph_lo, ph_hi;
};

typedef float f32x2v __attribute__((ext_vector_type(2)));
__device__ __forceinline__ void ph0_mod(const Args& a, LAS unsigned char* lds) {
    const int tid = phase_tid(), lane = tid & 63, wave = __builtin_amdgcn_readfirstlane(tid >> 6);
    LAS float* cs = (LAS float*)lds;
    LAS float* red = (LAS float*)(lds + 32768);
    const float* c = a.in[1]; const float* w_ada = a.in[2]; const float* b_ada = a.in[3];
    float* mod = (float*)(a.ws + WS_MOD);
    for (int i = tid; i < 4 * 2048; i += NTHREADS) { const float v = c[i]; cs[i] = v / (1.f + __expf(-v)); }
    __syncthreads();
    for (int u = blockIdx.x; u < 12288 / 128; u += gridDim.x) {
        const int col = u * 128 + 2 * lane;
        float acc[4][2];
#pragma unroll
        for (int b = 0; b < 4; ++b) { acc[b][0] = 0.f; acc[b][1] = 0.f; }
        const float* wp = w_ada + (size_t)(wave * 256) * 12288 + col;
#pragma unroll 1
        for (int k0 = 0; k0 < 256; k0 += 16) {
            f32x2v w[16];
#pragma unroll
            for (int k = 0; k < 16; ++k) w[k] = *(const f32x2v*)(wp + (size_t)(k0 + k) * 12288);
#pragma unroll
            for (int k = 0; k < 16; ++k) { const int kk = wave * 256 + k0 + k;
#pragma unroll
                for (int b = 0; b < 4; ++b) { const float cv = cs[b * 2048 + kk]; acc[b][0] += cv * w[k].x; acc[b][1] += cv * w[k].y; } }
        }
#pragma unroll
        for (int b = 0; b < 4; ++b) { red[(wave * 4 + b) * 128 + 2 * lane] = acc[b][0]; red[(wave * 4 + b) * 128 + 2 * lane + 1] = acc[b][1]; }
        __syncthreads();
        { const int b = tid >> 7, cc = tid & 127; float s = 0.f;
#pragma unroll
          for (int w = 0; w < 8; ++w) s += red[(w * 4 + b) * 128 + cc];
          mod[b * 12288 + u * 128 + cc] = s + b_ada[u * 128 + cc]; }
        __syncthreads();
    }
}
__device__ __forceinline__ void transpose_item(const float* W, int ldw, int ncols, int K, bf16* WT, int row_off, LAS float* scr, int item, int lane, int ldt = 0) {
    if (ldt == 0) ldt = K;
    const int nblk = ncols / 32, kb = item / nblk, nb = item % nblk, k0 = 64 * kb, n0 = 32 * nb;
    float tv[32];
#pragma unroll
    for (int i = 0; i < 32; ++i) tv[i] = W[(size_t)(k0 + 2 * i + (lane >> 5)) * ldw + n0 + (lane & 31)];
#pragma unroll
    for (int i = 0; i < 32; ++i) scr[(2 * i + (lane >> 5)) * 33 + (lane & 31)] = tv[i];
    asm volatile("s_waitcnt lgkmcnt(0)" ::: "memory");
    const int c = lane & 7;
#pragma unroll
    for (int j = 0; j < 4; ++j) { const int n = (lane >> 3) + 8 * j; const LAS float* s = scr + (8 * c) * 33 + n;
        v4u o; o.x = pk2(s[0 * 33], s[1 * 33]); o.y = pk2(s[2 * 33], s[3 * 33]); o.z = pk2(s[4 * 33], s[5 * 33]); o.w = pk2(s[6 * 33], s[7 * 33]);
        *(v4u*)(WT + (size_t)(row_off + n0 + n) * ldt + k0 + 8 * c) = o; }
    asm volatile("s_waitcnt lgkmcnt(0)" ::: "memory");
}
__device__ __forceinline__ void ph0_weights(const Args& a, LAS unsigned char* lds) {
    const int tid = phase_tid(), lane = tid & 63, wave = __builtin_amdgcn_readfirstlane(tid >> 6);
    LAS float* scr = (LAS float*)(lds + wave * 16384);
    const int gw = blockIdx.x * NWAVES + wave, NGW = gridDim.x * NWAVES;
    const float* w_in = a.in[5];
    bf16* WIN = (bf16*)(a.ws + WS_WIN);
    constexpr int I_Q = 32 * (NQ / 32), I_KV = 32 * (NKV / 32), I_DL = 32 * (NDL / 32), I_MG = 32 * (NMG / 32);
    constexpr int I_BN = 16 * 64, I_BD = 8 * 64, I_O = 32 * 64, I_PQ = 32 * 64;
    constexpr int NITEMS = I_Q + I_KV + I_DL + I_MG + I_BN + I_BD + I_O + I_PQ;
    for (int it = gw; it < NITEMS; it += NGW) {
        int r = it;
        if (r < I_Q)  { transpose_item(w_in, IN_COLS, NQ, D, WIN, 0, scr, r, lane); continue; } r -= I_Q;
        if (r < I_KV) { transpose_item(w_in + OFF_KV, IN_COLS, NKV, D, WIN, NQ, scr, r, lane); continue; } r -= I_KV;
        if (r < I_DL) { transpose_item(w_in + OFF_DIL, IN_COLS, NDL, D, WIN, NQ + NKV, scr, r, lane); continue; } r -= I_DL;
        if (r < I_MG) { transpose_item(w_in + OFF_MERGE, IN_COLS, NMG, D, WIN, NQ + NKV + NDL, scr, r, lane); continue; } r -= I_MG;
        if (r < I_BN) { transpose_item(a.in[13], D, D, 1024, (bf16*)(a.ws + WS_WBN), 0, scr, r, lane, 1536); continue; } r -= I_BN;
        if (r < I_BD) { transpose_item(a.in[14], D, D, 512, (bf16*)(a.ws + WS_WBN) + 1024, 0, scr, r, lane, 1536); continue; } r -= I_BD;
        if (r < I_O)  { transpose_item(a.in[15], D, D, D, (bf16*)(a.ws + WS_WOUT), 0, scr, r, lane); continue; } r -= I_O;
        transpose_item(a.in[17], D, D, D, (bf16*)(a.ws + WS_WPQ), 0, scr, r, lane);
    }
}

constexpr size_t WS_CW1F = 602 * MiB;
constexpr size_t WS_WGF = 604 * MiB;
constexpr size_t WS_CBP = 604 * MiB + 256 * 1024;
constexpr size_t WS_END4 = 605 * MiB;
__device__ __forceinline__ void ph0_extra(const Args& a) {
    const int tid = phase_tid(), lane = tid & 63, wave = __builtin_amdgcn_readfirstlane(tid >> 6);
    const float* w1 = a.in[9]; const float* pos = a.in[8]; const float* w_in = a.in[5];
    v4u* CW = (v4u*)(a.ws + WS_CW1F); v4u* WG = (v4u*)(a.ws + WS_WGF); float* CBP = (float*)(a.ws + WS_CBP);
    for (int i = blockIdx.x * NTHREADS + tid; i < 2 * 4 * 256 * 64; i += gridDim.x * NTHREADS) {
        const int ln = i & 63, ks = (i >> 6) & 255, nt = (i >> 14) & 3, j = i >> 16;
        const float* src = w1 + ((size_t)j * 4096 + 16 * ks + 8 * (ln >> 5)) * 128 + 32 * nt + (ln & 31);
        v4u o; o.x = pk2(src[0], src[128]); o.y = pk2(src[256], src[384]); o.z = pk2(src[512], src[640]); o.w = pk2(src[768], src[896]);
        CW[i] = o;
    }
    for (int i = blockIdx.x * NTHREADS + tid; i < 128 * 64; i += gridDim.x * NTHREADS) {
        const int ln = i & 63, ks = i >> 6, jrow = ln & 31;
        v4u o = {0u, 0u, 0u, 0u};
        if (jrow < 24) { const float* src = w_in + (size_t)(16 * ks + 8 * (ln >> 5)) * IN_COLS + OFF_GATE + jrow;
            o.x = pk2(src[0], src[IN_COLS]); o.y = pk2(src[2 * (size_t)IN_COLS], src[3 * (size_t)IN_COLS]); o.z = pk2(src[4 * (size_t)IN_COLS], src[5 * (size_t)IN_COLS]); o.w = pk2(src[6 * (size_t)IN_COLS], src[7 * (size_t)IN_COLS]); }
        WG[i] = o;
    }
    { const int gw = blockIdx.x * NWAVES + wave;
      if (gw < 128) { const int kc = gw >> 1, j = gw & 1; float s0 = 0.f, s1 = 0.f; const float* wp = w1 + ((size_t)j * 4096 + 64 * kc) * 128 + lane; const float* pp = pos + j * 4096 + 64 * kc;
#pragma unroll 1
          for (int k0 = 0; k0 < 64; k0 += 16) { float wa[16], wb[16];
#pragma unroll
              for (int k = 0; k < 16; ++k) { wa[k] = wp[(k0 + k) * 128]; wb[k] = wp[(k0 + k) * 128 + 64]; }
#pragma unroll
              for (int k = 0; k < 16; ++k) { const float pv = pp[k0 + k]; s0 += pv * wa[k]; s1 += pv * wb[k]; } }
          CBP[(kc * 2 + j) * 128 + lane] = s0; CBP[(kc * 2 + j) * 128 + 64 + lane] = s1; } }
}

__device__ __forceinline__ void ph_norm(const Args& a, const float* xin, const float* gvec, int sh_off, int sc_off, bf16* hout) {
    const int tid = phase_tid(), lane = tid & 63, wave = __builtin_amdgcn_readfirstlane(tid >> 6);
    const int gw = blockIdx.x * NWAVES + wave, NGW = gridDim.x * NWAVES;
    const float* mod = (const float*)(a.ws + WS_MOD);
    for (int r = gw; r < S / 2; r += NGW)
#pragma unroll 1
        for (int bq = 0; bq < NB; ++bq) {
            const int m0 = bq * S + r, m1 = m0 + S / 2;
            const float* x0 = xin + (size_t)m0 * D + 8 * lane; const float* x1 = xin + (size_t)m1 * D + 8 * lane;
            f32x4 v0[8], v1[8];
#pragma unroll
            for (int c = 0; c < 4; ++c) { v0[2 * c] = *(const f32x4*)(x0 + 512 * c); v0[2 * c + 1] = *(const f32x4*)(x0 + 512 * c + 4); v1[2 * c] = *(const f32x4*)(x1 + 512 * c); v1[2 * c + 1] = *(const f32x4*)(x1 + 512 * c + 4); }
            float s0 = 0.f, s1 = 0.f;
#pragma unroll
            for (int i = 0; i < 8; ++i) { s0 += (v0[i].x * v0[i].x + v0[i].y * v0[i].y) + (v0[i].z * v0[i].z + v0[i].w * v0[i].w); s1 += (v1[i].x * v1[i].x + v1[i].y * v1[i].y) + (v1[i].z * v1[i].z + v1[i].w * v1[i].w); }
            const float r0 = rsqrtf(wave_sum(s0) * (1.f / D) + EPS), r1 = rsqrtf(wave_sum(s1) * (1.f / D) + EPS);
            const float* shp = mod + bq * 12288 + sh_off + 8 * lane; const float* scp = mod + bq * 12288 + sc_off + 8 * lane; const float* gp = gvec + 8 * lane;
#pragma unroll
            for (int c = 0; c < 4; ++c) {
                v4u o0, o1; unsigned w0[4], w1[4];
#pragma unroll
                for (int hq = 0; hq < 2; ++hq) { const f32x4 g = *(const f32x4*)(gp + 512 * c + 4 * hq), sc = *(const f32x4*)(scp + 512 * c + 4 * hq), sh = *(const f32x4*)(shp + 512 * c + 4 * hq);
                    const f32x4 ga = g * (1.f + sc); const f32x4 y0 = v0[2 * c + hq] * r0 * ga + sh, y1 = v1[2 * c + hq] * r1 * ga + sh;
                    w0[2 * hq] = pk2(y0.x, y0.y); w0[2 * hq + 1] = pk2(y0.z, y0.w); w1[2 * hq] = pk2(y1.x, y1.y); w1[2 * hq + 1] = pk2(y1.z, y1.w); }
                o0.x = w0[0]; o0.y = w0[1]; o0.z = w0[2]; o0.w = w0[3]; o1.x = w1[0]; o1.y = w1[1]; o1.z = w1[2]; o1.w = w1[3];
                *(v4u*)(hout + (size_t)m0 * D + 512 * c + 8 * lane) = o0; *(v4u*)(hout + (size_t)m1 * D + 512 * c + 8 * lane) = o1;
            }
        }
}

using pg8::Unit; using pg8::HALF; using pg8::BM;
struct EpiProj {
    static constexpr bool PERM = true;
    bf16 *q, *kv, *dl, *mg;
    __device__ __forceinline__ void operator()(const f32x4 (&acc)[2][2][4][2], const Unit& u, int wr, int wc, int fr, int fq) const {
        bf16* base; int ldc, colt = u.pn * BM;
        if (colt < NQ) { base = q; ldc = NQ; } else if (colt < NQ + NKV) { base = kv; ldc = NKV; colt -= NQ; } else if (colt < NQ + NKV + NDL) { base = dl; ldc = NDL; colt -= NQ + NKV; } else { base = mg; ldc = NMG; colt -= NQ + NKV + NDL; }
        const int row0 = u.pm * BM + wr * 64 + fr, col0 = colt + wc * 32 + 8 * fq;
#pragma unroll
        for (int ai = 0; ai < 2; ++ai)
#pragma unroll
            for (int m = 0; m < 4; ++m) { bf16* rowp = base + (size_t)(row0 + ai * HALF + m * 16) * ldc + col0;
#pragma unroll
                for (int bj = 0; bj < 2; ++bj) { const f32x4 v0 = acc[ai][bj][m][0], v1 = acc[ai][bj][m][1];
                    v4u w; w.x = pg8::cvt_pk_bf16(v0[0], v0[1]); w.y = pg8::cvt_pk_bf16(v0[2], v0[3]); w.z = pg8::cvt_pk_bf16(v1[0], v1[1]); w.w = pg8::cvt_pk_bf16(v1[2], v1[3]);
                    *(v4u*)(rowp + bj * HALF) = w; } }
    }
};
struct MidMerge {
    static constexpr int AT = 16;
    const bf16* mg;
    __device__ __forceinline__ void operator()(f32x4 (&acc)[2][2][4][2], const Unit& u, int wr, int wc, int fr, int fq) const {
        int row0 = u.pm * BM + wr * 64 + fr; const int col0 = u.pn * BM + wc * 32 + 8 * fq;
        asm volatile("" : "+v"(row0));
#pragma unroll
        for (int ai = 0; ai < 2; ++ai) {
            v4u a1[4][2], a2[4][2];
#pragma unroll
            for (int m = 0; m < 4; ++m) { const bf16* rp = mg + (size_t)(row0 + ai * HALF + m * 16) * NMG + col0;
#pragma unroll
                for (int bj = 0; bj < 2; ++bj) { a1[m][bj] = *(const v4u*)(rp + bj * HALF); a2[m][bj] = *(const v4u*)(rp + 2048 + bj * HALF); } }
#pragma unroll
            for (int m = 0; m < 4; ++m)
#pragma unroll
                for (int bj = 0; bj < 2; ++bj) { const unsigned w1[4] = {a1[m][bj].x, a1[m][bj].y, a1[m][bj].z, a1[m][bj].w}, w2[4] = {a2[m][bj].x, a2[m][bj].y, a2[m][bj].z, a2[m][bj].w};
#pragma unroll
                    for (int q = 0; q < 4; ++q) { const float r0 = (1.f + __expf(-bflo(w2[q]))) * __builtin_amdgcn_rcpf(1.f + __expf(-bflo(w1[q]))), r1 = (1.f + __expf(-bfhi(w2[q]))) * __builtin_amdgcn_rcpf(1.f + __expf(-bfhi(w1[q])));
                        acc[ai][bj][m][q >> 1][2 * (q & 1)] *= r0; acc[ai][bj][m][q >> 1][2 * (q & 1) + 1] *= r1; } }
            asm volatile("" ::: "memory");
        }
    }
};
struct EpiMerge {
    static constexpr bool PERM = true;
    const bf16* mg; bf16* merged;
    __device__ __forceinline__ void operator()(const f32x4 (&acc)[2][2][4][2], const Unit& u, int wr, int wc, int fr, int fq) const {
        int row0 = u.pm * BM + wr * 64 + fr; const int col0 = u.pn * BM + wc * 32 + 8 * fq;
        asm volatile("" : "+v"(row0));
        v4u a2[2][4][2];
#pragma unroll
        for (int ai = 0; ai < 2; ++ai)
#pragma unroll
            for (int m = 0; m < 4; ++m)
#pragma unroll
                for (int bj = 0; bj < 2; ++bj) a2[ai][m][bj] = *(const v4u*)(mg + (size_t)(row0 + ai * HALF + m * 16) * NMG + 2048 + col0 + bj * HALF);
#pragma unroll
        for (int ai = 0; ai < 2; ++ai)
#pragma unroll
            for (int m = 0; m < 4; ++m) { const size_t row = (size_t)(row0 + ai * HALF + m * 16);
#pragma unroll
                for (int bj = 0; bj < 2; ++bj) { const unsigned w2[4] = {a2[ai][m][bj].x, a2[ai][m][bj].y, a2[ai][m][bj].z, a2[ai][m][bj].w};
                    const f32x4 v0 = acc[ai][bj][m][0], v1 = acc[ai][bj][m][1];
                    v4u w; w.x = pg8::cvt_pk_bf16(v0[0] * sigmoidf(bflo(w2[0])), v0[1] * sigmoidf(bfhi(w2[0]))); w.y = pg8::cvt_pk_bf16(v0[2] * sigmoidf(bflo(w2[1])), v0[3] * sigmoidf(bfhi(w2[1])));
                    w.z = pg8::cvt_pk_bf16(v1[0] * sigmoidf(bflo(w2[2])), v1[1] * sigmoidf(bfhi(w2[2]))); w.w = pg8::cvt_pk_bf16(v1[2] * sigmoidf(bflo(w2[3])), v1[3] * sigmoidf(bfhi(w2[3])));
                    *(v4u*)(merged + row * D + col0 + bj * HALF) = w; } }
    }
};
struct EpiOut {
    static constexpr bool PERM = false;
    const float* x; const float* mod; float* x1;
    __device__ __forceinline__ void operator()(const f32x4 (&acc)[2][2][4][2], const Unit& u, int wr, int wc, int fr, int fq) const {
        const int row0 = u.pm * BM + wr * 64 + fr, col0 = u.pn * BM + wc * 32 + 4 * fq;
        const int b = (u.pm * BM) / S;
        f32x4 gv[2][2];
#pragma unroll
        for (int bj = 0; bj < 2; ++bj)
#pragma unroll
            for (int n = 0; n < 2; ++n) gv[bj][n] = *(const f32x4*)(mod + b * 12288 + 4096 + col0 + bj * HALF + n * 16);
#pragma unroll
        for (int ai = 0; ai < 2; ++ai)
#pragma unroll
            for (int m = 0; m < 4; ++m) { const size_t off = (size_t)(row0 + ai * HALF + m * 16) * D + col0;
#pragma unroll
                for (int bj = 0; bj < 2; ++bj)
#pragma unroll
                    for (int n = 0; n < 2; ++n) *(f32x4*)(x1 + off + bj * HALF + n * 16) = *(const f32x4*)(x + off + bj * HALF + n * 16) + gv[bj][n] * acc[ai][bj][m][n]; }
    }
};
struct EpiF32 {
    static constexpr bool PERM = false;
    float* C; int ldc;
    __device__ __forceinline__ void operator()(const f32x4 (&acc)[2][2][4][2], const Unit& u, int wr, int wc, int fr, int fq) const {
        const int row0 = u.pm * BM + wr * 64 + fr, col0 = u.pn * BM + wc * 32 + 4 * fq;
#pragma unroll
        for (int ai = 0; ai < 2; ++ai)
#pragma unroll
            for (int m = 0; m < 4; ++m) { float* rowp = C + (size_t)(row0 + ai * HALF + m * 16) * ldc + col0;
#pragma unroll
                for (int bj = 0; bj < 2; ++bj)
#pragma unroll
                    for (int n = 0; n < 2; ++n) *(f32x4*)(rowp + bj * HALF + n * 16) = acc[ai][bj][m][n]; }
    }
};

typedef short bf16x8 __attribute__((ext_vector_type(8)));
typedef float f32x16 __attribute__((ext_vector_type(16)));
typedef float f32x2 __attribute__((ext_vector_type(2)));
typedef __bf16 bf2v __attribute__((ext_vector_type(2)));
constexpr float LOG2E = 1.4426950408889634f;
constexpr float QS2 = QSCALE * LOG2E;
constexpr float NEGB = -1e30f;
__device__ __forceinline__ unsigned pkbf(float a, float b) { const f32x2 v = {a, b}; const bf2v r = __builtin_convertvector(v, bf2v); return __builtin_bit_cast(unsigned, r); }
__device__ __forceinline__ float ex2(float x) { return __builtin_amdgcn_exp2f(x); }
__device__ __forceinline__ int swap23(int x) { return (x & ~12) | ((x & 4) << 1) | ((x & 8) >> 1); }
__device__ __forceinline__ size_t kf_off(int key, int d) { return ((size_t)((key >> 5) * 8 + (d >> 4)) * 64 + ((d >> 3) & 1) * 32 + swap23(key & 31)) * 8 + (d & 7); }
__device__ __forceinline__ size_t vf_off(int key, int d) { const int kk = key & 31; return ((size_t)(((key >> 5) * 4 + (d >> 5)) * 2 + (kk >> 4)) * 64 + ((kk >> 3) & 1) * 32 + (d & 31)) * 8 + (kk & 7); }
__device__ __forceinline__ bf16* fr_nsa(const Args& a, int bg, int kind) { return (bf16*)a.out + ((size_t)(bg * 4 + kind) << 19); }
__device__ __forceinline__ bf16* fr_dil(const Args& a, int b, int head, int kv) { return (bf16*)a.out + ((size_t)16 << 20) + ((size_t)((b * 12 + head) * 2 + kv) << 19); }
constexpr size_t WS_OD = 552 * MiB;
constexpr size_t WS_LSE = 600 * MiB;
constexpr size_t WS_END2 = 601 * MiB;

struct EpiProjNorm {
    static constexpr bool PERM = true;
    bf16 *q, *kv, *dl, *mg, *frg;
    const float *qg, *kg, *dqg, *dkg;
    LAS float* xch;
    __device__ __forceinline__ void operator()(const f32x4 (&acc)[2][2][4][2], const Unit& u, int wr, int wc, int fr, int fq) const {
        bf16* base; int ldc, colt = u.pn * BM, mode = 0  , hsel = 0; const float* gain = qg; float scale = 1.f;
        if (colt < NQ) { base = q; ldc = NQ; mode = 1; gain = qg; scale = QS2; }
        else if (colt < NQ + NKV) { base = kv; ldc = NKV; colt -= NQ; hsel = colt >> 7; if (hsel == 4 || hsel == 8) { mode = 2; gain = kg + (hsel == 4 ? 128 : 256); } }
        else if (colt < NQ + NKV + NDL) { base = dl; ldc = NDL; colt -= NQ + NKV; hsel = colt >> 7; if (hsel < 12) { mode = 1; gain = dqg; scale = QS2; } else if (hsel < 24) { mode = 3; gain = dkg; } }
        else { base = mg; ldc = NMG; colt -= NQ + NKV + NDL; }
        const int row0 = u.pm * BM + wr * 64 + fr, col0 = colt + wc * 32 + 8 * fq;
        if (mode == 0) {
#pragma unroll
            for (int ai = 0; ai < 2; ++ai)
#pragma unroll
                for (int m = 0; m < 4; ++m) { bf16* rowp = base + (size_t)(row0 + ai * HALF + m * 16) * ldc + col0;
#pragma unroll
                    for (int bj = 0; bj < 2; ++bj) { const f32x4 v0 = acc[ai][bj][m][0], v1 = acc[ai][bj][m][1];
                        v4u w; w.x = pg8::cvt_pk_bf16(v0[0], v0[1]); w.y = pg8::cvt_pk_bf16(v0[2], v0[3]); w.z = pg8::cvt_pk_bf16(v1[0], v1[1]); w.w = pg8::cvt_pk_bf16(v1[2], v1[3]);
                        *(v4u*)(rowp + bj * HALF) = w; } }
            return;
        }
#pragma unroll
        for (int ai = 0; ai < 2; ++ai)
#pragma unroll
            for (int m = 0; m < 4; ++m)
#pragma unroll
                for (int bj = 0; bj < 2; ++bj) { const f32x4 v0 = acc[ai][bj][m][0], v1 = acc[ai][bj][m][1];
                    float ss = (v0[0] * v0[0] + v0[1] * v0[1]) + (v0[2] * v0[2] + v0[3] * v0[3]) + (v1[0] * v1[0] + v1[1] * v1[1]) + (v1[2] * v1[2] + v1[3] * v1[3]);
                    ss += __shfl_xor(ss, 16); ss += __shfl_xor(ss, 32);
                    if (fq == 0) xch[(((((wr * 2 + ai) * 4 + m) * 16 + fr) * 2 + bj) << 2) + wc] = ss; }
        asm volatile("s_waitcnt lgkmcnt(0)" ::: "memory");
        __builtin_amdgcn_s_barrier();
        asm volatile("" ::: "memory");
        const f32x4 ga = *(const f32x4*)(gain + wc * 32 + 8 * fq), gb = *(const f32x4*)(gain + wc * 32 + 8 * fq + 4);
#pragma unroll
        for (int ai = 0; ai < 2; ++ai)
#pragma unroll
            for (int m = 0; m < 4; ++m) { const int t = row0 + ai * HALF + m * 16, b = t / S, s = t % S;
#pragma unroll
                for (int bj = 0; bj < 2; ++bj) { const f32x4 pp = *(const LAS f32x4*)(xch + (((((wr * 2 + ai) * 4 + m) * 16 + fr) * 2 + bj) << 2));
                    const float rstd = rsqrtf(((pp.x + pp.y) + (pp.z + pp.w)) * (1.f / 128.f) + EPS) * scale;
                    const f32x4 v0 = acc[ai][bj][m][0] * rstd * ga, v1 = acc[ai][bj][m][1] * rstd * gb;
                    v4u w; w.x = pg8::cvt_pk_bf16(v0[0], v0[1]); w.y = pg8::cvt_pk_bf16(v0[2], v0[3]); w.z = pg8::cvt_pk_bf16(v1[0], v1[1]); w.w = pg8::cvt_pk_bf16(v1[2], v1[3]);
                    bf16* dst;
                    if (mode == 1) dst = base + (size_t)t * ldc + col0 + bj * HALF;
                    else if (mode == 2) dst = frg + ((size_t)((b * 2 + bj) * 4 + (hsel == 4 ? 0 : 2)) << 19) + kf_off(s, wc * 32 + 8 * fq);
                    else { const int head = hsel - 12 + bj, dsh = 2 * (head >> 2), vk = ((s & ((1 << dsh) - 1)) << (12 - dsh)) + (s >> dsh);
                        dst = frg + ((size_t)16 << 20) + ((size_t)((b * 12 + head) * 2) << 19) + kf_off(vk, wc * 32 + 8 * fq); }
                    *(v4u*)dst = w; } }
    }
};

__device__ __forceinline__ v4u norm_chunk16v(v4u w, const float* gain, float scale, int li) {
    float v[8] = {bflo(w.x), bfhi(w.x), bflo(w.y), bfhi(w.y), bflo(w.z), bfhi(w.z), bflo(w.w), bfhi(w.w)};
    float ss = 0.f;
#pragma unroll
    for (int j = 0; j < 8; ++j) ss += v[j] * v[j];
    ss += __shfl_xor(ss, 1); ss += __shfl_xor(ss, 2); ss += __shfl_xor(ss, 4); ss += __shfl_xor(ss, 8);
    const float rstd = rsqrtf(ss * (1.f / 128.f) + EPS) * scale;
#pragma unroll
    for (int j = 0; j < 8; ++j) v[j] = v[j] * rstd * gain[8 * li + j];
    w.x = pk2(v[0], v[1]); w.y = pk2(v[2], v[3]); w.z = pk2(v[4], v[5]); w.w = pk2(v[6], v[7]);
    return w;
}
__device__ __forceinline__ void ph3_headnorm(const Args& a) {
    const int tid = phase_tid(), lane = tid & 63, wave = __builtin_amdgcn_readfirstlane(tid >> 6), sub = lane >> 4, li = lane & 15;
    const int gw = blockIdx.x * NWAVES + wave, NGW = gridDim.x * NWAVES;
    bf16* Q = (bf16*)(a.ws + WS_Q); const bf16* KV = (const bf16*)(a.ws + WS_KV); bf16* DL = (bf16*)(a.ws + WS_DL);
    const float* qg = a.in[6]; const float* kg = a.in[7]; const float* dqg = a.in[11]; const float* dkg = a.in[12];
    for (int m = gw; m < T; m += NGW) {
        const int b = m / S, s = m % S;
        const int g = sub & 1, win = sub >> 1;
        v4u wq[2], wk, wd[6];
#pragma unroll
        for (int it = 0; it < 2; ++it) wq[it] = *(const v4u*)(Q + (size_t)m * NQ + (it * 4 + sub) * 128 + 8 * li);
        wk = *(const v4u*)(KV + (size_t)m * NKV + ((win ? 8 : 4) + g) * 128 + 8 * li);
#pragma unroll
        for (int it = 0; it < 6; ++it) wd[it] = *(const v4u*)(DL + (size_t)m * NDL + (it * 4 + sub) * 128 + 8 * li);
#pragma unroll
        for (int it = 0; it < 2; ++it) *(v4u*)(Q + (size_t)m * NQ + (it * 4 + sub) * 128 + 8 * li) = norm_chunk16v(wq[it], qg, QS2, li);
        *(v4u*)(fr_nsa(a, b * 2 + g, win ? 2 : 0) + kf_off(s, 8 * li)) = norm_chunk16v(wk, kg + (win ? 256 : 128), 1.f, li);
#pragma unroll
        for (int it = 0; it < 6; ++it) { const int ch = it * 4 + sub;
            if (ch < 12) *(v4u*)(DL + (size_t)m * NDL + ch * 128 + 8 * li) = norm_chunk16v(wd[it], dqg, QS2, li);
            else { const int head = ch - 12, gi = head >> 2, dsh = 2 * gi  , vk = ((s & ((1 << dsh) - 1)) << (12 - dsh)) + (s >> dsh);
                *(v4u*)(fr_dil(a, b, head, 0) + kf_off(vk, 8 * li)) = norm_chunk16v(wd[it], dkg, 1.f, li); } }
    }
}
__device__ __forceinline__ void ph3_vfrag(const Args& a) {
    const int tid = phase_tid(), lane = tid & 63, wave = __builtin_amdgcn_readfirstlane(tid >> 6);
    const int gw = blockIdx.x * NWAVES + wave, NGW = gridDim.x * NWAVES;
    const bf16* KV = (const bf16*)(a.ws + WS_KV); const bf16* DL = (const bf16*)(a.ws + WS_DL);
    for (int job = gw; job < 32768; job += NGW) {
        const bf16* src; size_t rstride; bf16* dst; int key0;
        if (job < 8192) { const int bg = job >> 10, kind = (job >> 9) & 1, s0 = (job & 511) * 8, b = bg >> 1, g = bg & 1;
            src = KV + (size_t)(b * S + s0) * NKV + ((kind ? 10 : 6) + g) * 128; rstride = NKV; dst = fr_nsa(a, bg, kind ? 3 : 1); key0 = s0; }
        else { const int j2 = job - 8192, bh = j2 >> 9, vk0 = (j2 & 511) * 8, b = bh / 12, head = bh % 12, gi = head >> 2, dsh = 2 * gi, L = S >> dsh, r = vk0 / L, m0 = vk0 % L;
            src = DL + (size_t)(b * S + (m0 << dsh) + r) * NDL + (24 + head) * 128; rstride = (size_t)NDL << dsh; dst = fr_dil(a, b, head, 1); key0 = vk0; }
        unsigned w[8];
#pragma unroll
        for (int jj = 0; jj < 8; ++jj) w[jj] = *(const unsigned*)(src + jj * rstride + 2 * lane);
        v4u c0, c1;
        c0.x = (w[0] & 0xffffu) | (w[1] << 16); c0.y = (w[2] & 0xffffu) | (w[3] << 16); c0.z = (w[4] & 0xffffu) | (w[5] << 16); c0.w = (w[6] & 0xffffu) | (w[7] << 16);
        c1.x = (w[0] >> 16) | (w[1] & 0xffff0000u); c1.y = (w[2] >> 16) | (w[3] & 0xffff0000u); c1.z = (w[4] >> 16) | (w[5] & 0xffff0000u); c1.w = (w[6] >> 16) | (w[7] & 0xffff0000u);
        *(v4u*)(dst + vf_off(key0, 2 * lane)) = c0; *(v4u*)(dst + vf_off(key0, 2 * lane + 1)) = c1;
    }
}
__device__ __forceinline__ void ph3_gates(const Args& a) {
    const int tid = phase_tid(), lane = tid & 63, wave = __builtin_amdgcn_readfirstlane(tid >> 6), tl = lane & 31, hh = lane >> 5;
    const int gw = (gridDim.x - 1 - blockIdx.x) * NWAVES + wave, NGW = gridDim.x * NWAVES;
    const bf16* H = (const bf16*)(a.ws + WS_H); const v4u* WG = (const v4u*)(a.ws + WS_WGF) + lane; float* gates = (float*)(a.ws + WS_GATES);
    for (int job = gw; job < T / 32; job += NGW) {
        const int t = job * 32 + tl; const bf16* hr = H + (size_t)t * D + 8 * hh;
        f32x16 acc;
#pragma unroll
        for (int i = 0; i < 16; ++i) acc[i] = 0.f;
#pragma unroll 4
        for (int ks = 0; ks < 128; ++ks) { const bf16x8 af = __builtin_bit_cast(bf16x8, WG[ks * 64]), bfr = __builtin_bit_cast(bf16x8, *(const v4u*)(hr + 16 * ks));
            acc = __builtin_amdgcn_mfma_f32_32x32x16_bf16(af, bfr, acc, 0, 0, 0); }
#pragma unroll
        for (int i = 0; i < 16; ++i) { const int j = (i & 3) + 8 * (i >> 2) + 4 * hh; const float v = acc[i]; if (j < 24) gates[(size_t)t * 24 + j] = sigmoidf(v); }
    }
}
__device__ __forceinline__ void ph3_compress(const Args& a, LAS unsigned char* lds) {
    const int tid = phase_tid(), lane = tid & 63, wave = __builtin_amdgcn_readfirstlane(tid >> 6), cl = lane & 31, hh = lane >> 5;
    LAS float* part = (LAS float*)lds;
    LAS float* hid = part + 2 * 128 * 32;
    LAS float* ob = hid + 32 * 128;
    LAS float* bias = ob + 32 * 128;
    const bf16* KV = (const bf16*)(a.ws + WS_KV);
    const float* w2 = a.in[10]; const float* kg0 = a.in[7]; const float* CBP = (const float*)(a.ws + WS_CBP);
    for (int u = blockIdx.x; u < 128; u += gridDim.x) {
        const int j = u >> 6, bg = (u >> 3) & 7, ct = u & 7, b = bg >> 1, g = bg & 1, c0 = 32 * ct, hhd = j * 2 + g;
        if (tid < 128) { float s = 0.f;
#pragma unroll
            for (int kc = 0; kc < 64; ++kc) s += CBP[(kc * 2 + j) * 128 + tid];
            bias[tid] = s; }
        { const int nt = wave & 3, kh = wave >> 2, c = c0 + cl;
          const v4u* af = (const v4u*)(a.ws + WS_CW1F) + ((size_t)(j * 4 + nt) * 256 + 128 * kh) * 64 + lane;
          f32x16 acc;
#pragma unroll
          for (int i = 0; i < 16; ++i) acc[i] = 0.f;
#pragma unroll 4
          for (int ks = 0; ks < 128; ++ks) { const int k = 16 * (128 * kh + ks) + 8 * hh, l = k >> 7, d = k & 127, p = 16 * c + l;
              v4u x = {0u, 0u, 0u, 0u}; if (p < S) x = *(const v4u*)(KV + (size_t)(b * S + p) * NKV + hhd * 128 + d);
              acc = __builtin_amdgcn_mfma_f32_32x32x16_bf16(__builtin_bit_cast(bf16x8, af[ks * 64]), __builtin_bit_cast(bf16x8, x), acc, 0, 0, 0); }
#pragma unroll
          for (int i = 0; i < 16; ++i) { const int n = 32 * nt + (i & 3) + 8 * (i >> 2) + 4 * hh; const float v = acc[i]; part[(kh * 128 + n) * 32 + cl] = v; } }
        __syncthreads();
        for (int i = tid; i < 128 * 32; i += NTHREADS) { const int n = i >> 5, c = i & 31; hid[c * 128 + n] = gelu_tanh(part[i] + part[128 * 32 + i] + bias[n]); }
        __syncthreads();
        { const int n = tid & 127, cq = tid >> 7; float o[8];
#pragma unroll
          for (int r = 0; r < 8; ++r) o[r] = 0.f;
          const float* w2p = w2 + j * 128 * 128 + n;
          for (int k = 0; k < 128; ++k) { const float w = w2p[k * 128];
#pragma unroll
              for (int r = 0; r < 8; ++r) o[r] += hid[(8 * cq + r) * 128 + k] * w; }
#pragma unroll
          for (int r = 0; r < 8; ++r) ob[(8 * cq + r) * 128 + n] = o[r]; }
        __syncthreads();
        bf16* fr = (bf16*)(a.ws + (j == 0 ? WS_KC : WS_VC)) + (size_t)bg * 8 * 4096;
#pragma unroll 1
        for (int r = 0; r < 4; ++r) { const int cr = 4 * wave + r, c = c0 + cr; float v0 = ob[cr * 128 + 2 * lane], v1 = ob[cr * 128 + 2 * lane + 1];
            if (j == 0) { const float rstd = rsqrtf(wave_sum(v0 * v0 + v1 * v1) * (1.f / 128.f) + EPS); v0 = v0 * rstd * kg0[2 * lane]; v1 = v1 * rstd * kg0[2 * lane + 1]; }
            if (c >= NC) { v0 = 0.f; v1 = 0.f; }
            if (j == 0) *(unsigned*)(fr + kf_off(c, 2 * lane)) = pk2(v0, v1);
            else { fr[vf_off(c, 2 * lane)] = (bf16)f2bf(v0); fr[vf_off(c, 2 * lane + 1)] = (bf16)f2bf(v1); } }
        __syncthreads();
    }
}

#define KBI(i) (16 * ((i) >> 3) + ((i) & 7))
__device__ __forceinline__ void load_frags(bf16x8 (&f)[8], const v4u* p, int lane) {
#pragma unroll
    for (int i = 0; i < 8; ++i) f[i] = __builtin_bit_cast(bf16x8, p[i * 64 + lane]);
}
__device__ __forceinline__ f32x16 qk_mma(const bf16x8 (&qf)[8], const bf16x8 (&k)[8]) {
    f32x16 s;
#pragma unroll
    for (int i = 0; i < 16; ++i) s[i] = 0.f;
#pragma unroll
    for (int st = 0; st < 8; ++st) s = __builtin_amdgcn_mfma_f32_32x32x16_bf16(k[st], qf[st], s, 0, 0, 0);
    return s;
}
__device__ __forceinline__ f32x16 qk_tile(const bf16x8 (&qf)[8], const v4u* kf, int lane) { bf16x8 k[8]; load_frags(k, kf, lane); return qk_mma(qf, k); }
template <int STRIDE> __device__ __forceinline__ void add_tbl(f32x16& s, const LAS float* tp2, float pen) {
#pragma unroll
    for (int i = 0; i < 16; ++i) s[i] += tp2[STRIDE * (23 - KBI(i))] + pen;
}
__device__ __forceinline__ void mask_hi(f32x16& s, int lim) {
#pragma unroll
    for (int i = 0; i < 16; ++i) s[i] = (KBI(i) <= lim) ? s[i] : NEGB;
}
__device__ __forceinline__ void mask_lo(f32x16& s, int lim) {
#pragma unroll
    for (int i = 0; i < 16; ++i) s[i] = (KBI(i) >= lim) ? s[i] : NEGB;
}
__device__ __forceinline__ float max16(const f32x16& s) {
    float mx = fmaxf(s[0], s[1]);
#pragma unroll
    for (int i = 2; i < 16; ++i) mx = fmaxf(mx, s[i]);
    return fmaxf(mx, __shfl_xor(mx, 32));
}
__device__ __forceinline__ void pv_tile(const f32x16& p, f32x16 (&o)[4], const bf16x8 (&v)[8]) {
    v4u a0, a1;
    a0.x = pkbf(p[0], p[1]); a0.y = pkbf(p[2], p[3]); a0.z = pkbf(p[4], p[5]); a0.w = pkbf(p[6], p[7]);
    a1.x = pkbf(p[8], p[9]); a1.y = pkbf(p[10], p[11]); a1.z = pkbf(p[12], p[13]); a1.w = pkbf(p[14], p[15]);
    const bf16x8 pb0 = __builtin_bit_cast(bf16x8, a0), pb1 = __builtin_bit_cast(bf16x8, a1);
#pragma unroll
    for (int dt = 0; dt < 4; ++dt) { o[dt] = __builtin_amdgcn_mfma_f32_32x32x16_bf16(v[2 * dt], pb0, o[dt], 0, 0, 0); o[dt] = __builtin_amdgcn_mfma_f32_32x32x16_bf16(v[2 * dt + 1], pb1, o[dt], 0, 0, 0); }
}
__device__ __forceinline__ void softmax_pv(f32x16& s, f32x16 (&o)[4], float& m, float& l, const v4u* vf, int lane) {
    bf16x8 v[8];
#pragma unroll
    for (int i = 0; i < 8; ++i) v[i] = __builtin_bit_cast(bf16x8, vf[i * 64 + lane]);
    const float mn = fmaxf(m, max16(s));
    if (__ballot(mn > m + 8.f)) {
        const float corr = ex2(m - mn);
#pragma unroll
        for (int dt = 0; dt < 4; ++dt)
#pragma unroll
            for (int i = 0; i < 16; ++i) o[dt][i] *= corr;
        l *= corr; m = mn;
    }
    float ps = 0.f;
#pragma unroll
    for (int i = 0; i < 16; ++i) { s[i] = ex2(s[i] - m); ps += s[i]; }
    l += ps;
    pv_tile(s, o, v);
}
template <int NP = 0> __device__ __forceinline__ void softmax_pv_v(f32x16& s, f32x16 (&o)[4], float& m, float& l, const bf16x8 (&v)[8]) {
    if (NP == 2) { l += s[0]; pv_tile(s, o, v); return; }
    const float mn = fmaxf(m, max16(s));
    if (__ballot(mn > m + 8.f)) {
        const float corr = ex2(m - mn);
#pragma unroll
        for (int dt = 0; dt < 4; ++dt)
#pragma unroll
            for (int i = 0; i < 16; ++i) o[dt][i] *= corr;
        l *= corr; m = mn;
    }
    float ps = 0.f;
#pragma unroll
    for (int i = 0; i < 16; ++i) { s[i] = ex2(s[i] - m); ps += s[i]; }
    l += ps;
    pv_tile(s, o, v);
}
__device__ __forceinline__ void zero_o(f32x16 (&o)[4]) {
#pragma unroll
    for (int dt = 0; dt < 4; ++dt)
#pragma unroll
        for (int i = 0; i < 16; ++i) o[dt][i] = 0.f;
}
__device__ __forceinline__ void y_update(bf16* yp  , const f32x16 (&o)[4], float sc, bool acc) {
#pragma unroll
    for (int dt = 0; dt < 4; ++dt)
#pragma unroll
        for (int i4 = 0; i4 < 4; ++i4) { bf16* p = yp + 32 * dt + 8 * i4;
            float v0 = o[dt][4 * i4] * sc, v1 = o[dt][4 * i4 + 1] * sc, v2 = o[dt][4 * i4 + 2] * sc, v3 = o[dt][4 * i4 + 3] * sc;
            if (acc) { const v2u w = *(const v2u*)p; v0 += bflo(w.x); v1 += bfhi(w.x); v2 += bflo(w.y); v3 += bfhi(w.y); }
            v2u w; w.x = pkbf(v0, v1); w.y = pkbf(v2, v3); *(v2u*)p = w; }
}
constexpr int TBLN = 2624;
constexpr int OFF_TBL = 0, OFF_IMP = 43008, OFF_SELM = OFF_IMP + 65536, OFF_DTBL = OFF_SELM + 512;
constexpr int FAR_DIST = 1513;

template <int NP> __device__ __forceinline__ void nsa_unit(const Args& a, LAS unsigned char* lds, int u, int tid) {
    const int lane = tid & 63, wave = __builtin_amdgcn_readfirstlane(tid >> 6);
    const int qb = u >> 3, bg = u & 7, b = bg >> 1, g = bg & 1;
    const int r = wave >> 1, qs = wave & 1, hd = g * 4 + r, ql = lane & 31, h = lane >> 5;
    const int q0w = 64 * qb + 32 * qs, sq = q0w + ql, t = b * S + sq;
    LAS float* tball = (LAS float*)(lds + OFF_TBL);
    LAS float* imp = (LAS float*)(lds + OFF_IMP);
    LAS unsigned long long* selm = (LAS unsigned long long*)(lds + OFF_SELM);
    const float* relb = a.in[22];
    for (int i = tid; i < 4 * TBLN; i += NTHREADS) { const int hh = i / TBLN, dd = i % TBLN - 64; tball[i] = dd >= 0 ? relb[(g * 4 + hh) * 32 + t5_bucket(dd)] * LOG2E : 0.f; }
    for (int i = tid; i < 4 * 64 * 64; i += NTHREADS) imp[i] = 0.f;
    __syncthreads();
    const LAS float* tbl = tball + r * TBLN + 64;
    const float farc = relb[hd * 32 + 31] * LOG2E;
    bf16x8 qf[8];
    { const bf16* qrow = (const bf16*)(a.ws + WS_Q) + (size_t)t * NQ + hd * 128 + 8 * h;
#pragma unroll
      for (int st = 0; st < 8; ++st) qf[st] = __builtin_bit_cast(bf16x8, *(const v4u*)(qrow + 16 * st)); }
    const float* gt = (const float*)(a.ws + WS_GATES) + (size_t)t * 24 + hd * 3;
    const float g0 = gt[0], g1 = gt[1], g2 = gt[2];
    bf16* yp = (bf16*)(a.ws + (NP ? WS_H : WS_YN)) + (size_t)t * 1536 + hd * 128 + 4 * h;
    f32x16 o[4];
    {
        const v4u* kfc = (const v4u*)(a.ws + WS_KC) + (size_t)bg * 8 * 512; const v4u* vfc = (const v4u*)(a.ws + WS_VC) + (size_t)bg * 8 * 512;
        const int smax = q0w + 31, ncv = smax >= 31 ? ((smax - 31) >> 4) + 1 : 0, ntc = (ncv + 31) >> 5;
        float m = NEGB, l = 0.f;
        for (int tc = 0; tc < ntc; ++tc) {
            f32x16 s = qk_tile(qf, kfc + tc * 512, lane);
            const int dqc = sq - 31 - 512 * tc;
            if (q0w - 31 - 512 * tc - 496 >= FAR_DIST) {
#pragma unroll
                for (int i = 0; i < 16; ++i) s[i] += farc;
            } else add_tbl<16>(s, tbl + dqc - 16 * (8 * h + 23), 0.f);
            mask_hi(s, (dqc >> 4) - 8 * h);
            const float mn = fmaxf(m, max16(s));
            float ps = 0.f;
#pragma unroll
            for (int i = 0; i < 16; ++i) ps += ex2(s[i] - mn);
            l = l * ex2(m - mn) + ps; m = mn;
        }
        l += __shfl_xor(l, 32);
        const float inv = (sq >= 31) ? 1.f / l : 0.f;
        zero_o(o);
        LAS float* impq = imp + (r * 64 + 32 * qs + ql) * 64;
        for (int tc = 0; tc < ntc; ++tc) {
            f32x16 s = qk_tile(qf, kfc + tc * 512, lane);
            bf16x8 v[8];
#pragma unroll
            for (int i = 0; i < 8; ++i) v[i] = __builtin_bit_cast(bf16x8, vfc[tc * 512 + i * 64 + lane]);
            const int dqc = sq - 31 - 512 * tc;
            if (q0w - 31 - 512 * tc - 496 >= FAR_DIST) {
#pragma unroll
                for (int i = 0; i < 16; ++i) s[i] += farc;
            } else add_tbl<16>(s, tbl + dqc - 16 * (8 * h + 23), 0.f);
            mask_hi(s, (dqc >> 4) - 8 * h);
#pragma unroll
            for (int i = 0; i < 16; ++i) s[i] = ex2(s[i] - m) * inv;
#pragma unroll
            for (int a2 = 0; a2 < 2; ++a2)
#pragma unroll
                for (int bq = 0; bq < 2; ++bq) { const int j = 8 * tc + 4 * a2 + 2 * h + bq; const int i0 = 8 * a2 + 4 * bq;
                    impq[j] += (s[i0] + s[i0 + 1]) + (s[i0 + 2] + s[i0 + 3]); }
            asm volatile("s_waitcnt lgkmcnt(0)" ::: "memory");
#pragma unroll
            for (int a2 = 0; a2 < 2; ++a2)
#pragma unroll
                for (int bq = 0; bq < 2; ++bq) { const int j = 8 * tc + 4 * a2 + 2 * h + bq + 1; if (j < 64) impq[j] += s[8 * a2 + 4 * bq + 3]; }
            asm volatile("s_waitcnt lgkmcnt(0)" ::: "memory");
            pv_tile(s, o, v);
        }
        y_update(yp, o, g0, false);
    }
    __syncthreads();
    for (int qq = wave * 8; qq < wave * 8 + 8; ++qq) {
        const int jb = lane;
        const float im = ((imp[(0 * 64 + qq) * 64 + jb] + imp[(1 * 64 + qq) * 64 + jb]) + imp[(2 * 64 + qq) * 64 + jb]) + imp[(3 * 64 + qq) * 64 + jb];
        const bool forced = (jb == 0) || (jb == qb) || (jb == qb - 1);
        const float score = forced ? 1e4f : (jb > qb ? -1e4f : im);
        int rank = 0;
        for (int o2 = 0; o2 < 64; ++o2) { const float so = __shfl(score, o2); rank += (so > score) || (so == score && o2 < jb); }
        const unsigned long long mask = __ballot(rank < 16 && jb <= qb);
        if (lane == 0) selm[qq] = mask;
    }
    __syncthreads();
    {
        const v4u* kfw = (const v4u*)fr_nsa(a, bg, 2); const v4u* vfw = (const v4u*)fr_nsa(a, bg, 3);
        const int t_hi = q0w >> 5, t_lo = t_hi - 16;
        float m = NEGB, l = 0.f; zero_o(o);
        const int t0 = t_lo < 0 ? 0 : t_lo;
        for (int tt = t0; tt <= t_hi; ++tt) {
            const size_t to = (NP == 3) ? (size_t)(tt & 1) * 512 : (size_t)tt * 512;
            bf16x8 kf[8], vf[8]; load_frags(kf, kfw + to, lane);
            f32x16 s = qk_mma(qf, kf); load_frags(vf, vfw + to, lane);
            const int dq = sq - 32 * tt;
            add_tbl<1>(s, tbl + dq - (8 * h + 23), 0.f);
            if (tt == t_hi) mask_hi(s, dq - 8 * h);
            if (tt == t_lo) mask_lo(s, dq - 511 - 8 * h);
            softmax_pv_v<NP>(s, o, m, l, vf);
        }
        l += __shfl_xor(l, 32);
        y_update(yp, o, g2 / l, true);
    }
    {
        const v4u* kfs = (const v4u*)fr_nsa(a, bg, 0); const v4u* vfs = (const v4u*)fr_nsa(a, bg, 1);
        const unsigned long long mask = selm[32 * qs + ql];
        float m = NEGB, l = 0.f; zero_o(o);
        const int t_end = 2 * qb + qs;
        for (int tt = 0; tt <= 2 * qb + 1; ++tt) {
            if (tt > t_end) continue;
            const float pen = ((mask >> (tt >> 1)) & 1ull) ? 0.f : NEGB;
            if (__ballot(pen == 0.f) == 0ull) continue;
            const size_t to = (NP == 3) ? (size_t)(tt & 1) * 512 : (size_t)tt * 512;
            bf16x8 kf[8], vf[8]; load_frags(kf, kfs + to, lane);
            f32x16 s = qk_mma(qf, kf); load_frags(vf, vfs + to, lane);
            const int dq = sq - 32 * tt;
            if (q0w - (32 * tt + 31) >= FAR_DIST) {
                const float c = farc + pen;
#pragma unroll
                for (int i = 0; i < 16; ++i) s[i] += c;
            } else add_tbl<1>(s, tbl + dq - (8 * h + 23), pen);
            if (tt == t_end) mask_hi(s, dq - 8 * h);
            softmax_pv_v<NP>(s, o, m, l, vf);
        }
        l += __shfl_xor(l, 32);
        y_update(yp, o, g1 / l, true);
    }
    __syncthreads();
}
__device__ __forceinline__ void dil_unit(const Args& a, LAS unsigned char* lds, int u, int tid) {
    const int lane = tid & 63, wave = __builtin_amdgcn_readfirstlane(tid >> 6), ql = lane & 31, h = lane >> 5;
    const int b = u >> 6, p = (u >> 4) & 3, c = u & 15, s0 = 256 * c;
    LAS float* dtbl = (LAS float*)(lds + OFF_DTBL);
    const float* relb = a.in[22] + 8 * 32;
    for (int i = tid; i < 3 * 192; i += NTHREADS) { const int gi = i / 192, dm = i % 192 - 32; dtbl[i] = dm >= 0 ? relb[(gi * 4 + p) * 32 + t5_bucket(dm << (2 * gi))] * LOG2E : 0.f; }
    __syncthreads();
    bf16* OD = (bf16*)(a.ws + WS_OD); float* LSE = (float*)(a.ws + WS_LSE);
    const bf16* DL = (const bf16*)(a.ws + WS_DL);
    for (int job = wave; job < 32; job += NWAVES) {
        int gi, rr, m0, vlo, vhi;
        if (job < 8) { gi = 0; rr = 0; m0 = s0 + 32 * job; vlo = 0; vhi = 32; }
        else if (job < 16) { gi = 1; rr = (job - 8) >> 1; m0 = (s0 >> 2) + 32 * (job & 1); vlo = 0; vhi = 32; }
        else { gi = 2; rr = job - 16; m0 = 32 * (c >> 1); vlo = 16 * (c & 1); vhi = vlo + 16; }
        const int dsh = 2 * gi, L = S >> dsh, head = gi * 4 + p;
        const int mq = m0 + ql, sact = (mq << dsh) + rr, t = b * S + sact;
        const v4u* kf = (const v4u*)fr_dil(a, b, head, 0) + (size_t)((rr * L) >> 5) * 512; const v4u* vf = (const v4u*)fr_dil(a, b, head, 1) + (size_t)((rr * L) >> 5) * 512;
        bf16x8 qf[8];
        { const bf16* qrow = DL + (size_t)t * NDL + head * 128 + 8 * h;
#pragma unroll
          for (int st = 0; st < 8; ++st) qf[st] = __builtin_bit_cast(bf16x8, *(const v4u*)(qrow + 16 * st)); }
        const LAS float* tb = dtbl + gi * 192 + 32;
        const int t_hi = m0 >> 5, t_lo = t_hi - 4;
        float m = NEGB, l = 0.f; f32x16 o[4]; zero_o(o);
        const int t0 = t_lo < 0 ? 0 : t_lo;
        for (int tt = t0; tt <= t_hi; ++tt) {
            bf16x8 kr[8], vr[8]; load_frags(kr, kf + (size_t)tt * 512, lane);
            f32x16 s = qk_mma(qf, kr); load_frags(vr, vf + (size_t)tt * 512, lane);
            const int dq = mq - 32 * tt;
            add_tbl<1>(s, tb + dq - (8 * h + 23), 0.f);
            if (tt == t_hi) mask_hi(s, dq - 8 * h);
            if (tt == t_lo) mask_lo(s, dq - 128 - 8 * h);
            softmax_pv_v(s, o, m, l, vr);
        }
        l += __shfl_xor(l, 32);
        if (ql >= vlo && ql < vhi) {
            y_update(OD + ((size_t)gi * T + t) * 512 + p * 128 + 4 * h, o, 1.f / l, false);
            if (h == 0) LSE[((size_t)(gi * NB + b) * 4 + p) * S + sact] = m + __log2f(l);
        }
    }
    __syncthreads();
    { const int pos = tid >> 1, dh = tid & 1, sact = s0 + pos, t = b * S + sact;
      const float l0 = LSE[((size_t)(0 * NB + b) * 4 + p) * S + sact], l1 = LSE[((size_t)(1 * NB + b) * 4 + p) * S + sact], l2 = LSE[((size_t)(2 * NB + b) * 4 + p) * S + sact];
      const float mx = fmaxf(l0, fmaxf(l1, l2)); float w0 = ex2(l0 - mx), w1 = ex2(l1 - mx), w2 = ex2(l2 - mx); const float iw = 1.f / (w0 + w1 + w2); w0 *= iw; w1 *= iw; w2 *= iw;
      bf16* yd = (bf16*)(a.ws + WS_YN) + (size_t)t * 1536 + 1024 + p * 128 + 64 * dh;
      const bf16* o0 = OD + ((size_t)0 * T + t) * 512 + p * 128 + 64 * dh; const bf16* o1 = OD + ((size_t)1 * T + t) * 512 + p * 128 + 64 * dh; const bf16* o2 = OD + ((size_t)2 * T + t) * 512 + p * 128 + 64 * dh;
#pragma unroll
      for (int k = 0; k < 8; ++k) { const v4u x0 = *(const v4u*)(o0 + 8 * k), x1 = *(const v4u*)(o1 + 8 * k), x2 = *(const v4u*)(o2 + 8 * k); v4u y;
          y.x = pkbf(w0 * bflo(x0.x) + w1 * bflo(x1.x) + w2 * bflo(x2.x), w0 * bfhi(x0.x) + w1 * bfhi(x1.x) + w2 * bfhi(x2.x));
          y.y = pkbf(w0 * bflo(x0.y) + w1 * bflo(x1.y) + w2 * bflo(x2.y), w0 * bfhi(x0.y) + w1 * bfhi(x1.y) + w2 * bfhi(x2.y));
          y.z = pkbf(w0 * bflo(x0.z) + w1 * bflo(x1.z) + w2 * bflo(x2.z), w0 * bfhi(x0.z) + w1 * bfhi(x1.z) + w2 * bfhi(x2.z));
          y.w = pkbf(w0 * bflo(x0.w) + w1 * bflo(x1.w) + w2 * bflo(x2.w), w0 * bfhi(x0.w) + w1 * bfhi(x1.w) + w2 * bfhi(x2.w));
          *(v4u*)(yd + 8 * k) = y; } }
    __syncthreads();
}
__device__ __forceinline__ void ph4_attention(const Args& a, LAS unsigned char* lds) {
    const int tid = phase_tid();
    for (int u = blockIdx.x; u < 256; u += gridDim.x) dil_unit(a, lds, u, tid);
#ifndef PROBE_NSA
#define PROBE_NSA 0
#endif
    if (PROBE_NSA) for (int x = blockIdx.x; x < 256; x += gridDim.x) { nsa_unit<PROBE_NSA>(a, lds, 511 - x, tid); nsa_unit<PROBE_NSA>(a, lds, x, tid); }
    for (int x = blockIdx.x; x < 256; x += gridDim.x) { nsa_unit<0>(a, lds, 511 - x, tid); nsa_unit<0>(a, lds, x, tid); }
}

constexpr size_t WS_PU8 = WS_Q;
constexpr size_t WS_PV8 = WS_Q + 32 * MiB;
constexpr size_t WS_PSC = WS_Q + 64 * MiB;
__device__ __forceinline__ void ph_quant_uv(const Args& a) {
    const int tid = phase_tid(), lane = tid & 63, wave = __builtin_amdgcn_readfirstlane(tid >> 6);
    const int gw = blockIdx.x * NWAVES + wave, NGW = gridDim.x * NWAVES;
    float* SC = (float*)(a.ws + WS_PSC);
    for (int rw = gw; rw < NE; rw += NGW) {
        f32x4 x[2][8];
#pragma unroll
        for (int which = 0; which < 2; ++which) { const float* src = a.in[20 + which] + (size_t)rw * D + 16 * lane;
#pragma unroll
            for (int c = 0; c < 2; ++c)
#pragma unroll
                for (int w = 0; w < 4; ++w) x[which][4 * c + w] = *(const f32x4*)(src + 1024 * c + 4 * w); }
#pragma unroll
        for (int which = 0; which < 2; ++which) {
            unsigned char* dst = a.ws + (which ? WS_PV8 : WS_PU8) + (size_t)rw * D + 16 * lane;
            float am = 0.f;
#pragma unroll
            for (int i = 0; i < 8; ++i) am = fmaxf(fmaxf(am, fmaxf(fabsf(x[which][i].x), fabsf(x[which][i].y))), fmaxf(fabsf(x[which][i].z), fabsf(x[which][i].w)));
            am = wave_max(am);
            const float inv = am > 0.f ? 127.f / am : 0.f;
#pragma unroll
            for (int c = 0; c < 2; ++c) { v4u o; unsigned wd[4];
#pragma unroll
                for (int w = 0; w < 4; ++w) { const f32x4 v = x[which][4 * c + w];
                    const unsigned q0 = (unsigned)((int)rintf(v.x * inv) + 128), q1 = (unsigned)((int)rintf(v.y * inv) + 128), q2 = (unsigned)((int)rintf(v.z * inv) + 128), q3 = (unsigned)((int)rintf(v.w * inv) + 128);
                    wd[w] = q0 | (q1 << 8) | (q2 << 16) | (q3 << 24); }
                o.x = wd[0]; o.y = wd[1]; o.z = wd[2]; o.w = wd[3]; *(v4u*)(dst + 1024 * c) = o; }
            if (lane == 0) SC[which * NE + rw] = am * (1.f / 127.f);
        }
    }
}
constexpr size_t WS_KEYF = 601 * MiB;
constexpr size_t WS_END3 = 602 * MiB;
__device__ __forceinline__ void ph0_keyfrags(const Args& a) {
    const int tid = phase_tid();
    const float* keys = a.in[19]; v4u* KF = (v4u*)(a.ws + WS_KEYF);
    for (int i = blockIdx.x * NTHREADS + tid; i < 16 * 32 * 64; i += gridDim.x * NTHREADS) {
        const int lane = i & 63, st = (i >> 6) & 7, kt = (i >> 9) & 3, hp = i >> 11;
        const float* src = keys + ((size_t)hp * 128 + 32 * kt + (lane & 31)) * 128 + 16 * st + 8 * (lane >> 5);
        float v[8]; unsigned hi[8], lo[8];
#pragma unroll
        for (int j = 0; j < 8; ++j) { v[j] = src[j]; hi[j] = f2bf(v[j]); lo[j] = f2bf(v[j] - __builtin_bit_cast(float, hi[j] << 16)); }
        v4u oh, ol; oh.x = hi[0] | (hi[1] << 16); oh.y = hi[2] | (hi[3] << 16); oh.z = hi[4] | (hi[5] << 16); oh.w = hi[6] | (hi[7] << 16);
        ol.x = lo[0] | (lo[1] << 16); ol.y = lo[2] | (lo[3] << 16); ol.z = lo[4] | (lo[5] << 16); ol.w = lo[6] | (lo[7] << 16);
        KF[(size_t)((hp * 2 + 0) * 32 + kt * 8 + st) * 64 + lane] = oh; KF[(size_t)((hp * 2 + 1) * 32 + kt * 8 + st) * 64 + lane] = ol;
    }
}
template <int N, bool MERGE_ONLY> __device__ __forceinline__ void bitonic_desc(float (&v)[N]) {
#pragma unroll
    for (int k = MERGE_ONLY ? N : 2; k <= N; k <<= 1)
#pragma unroll
        for (int j = k >> 1; j > 0; j >>= 1)
#pragma unroll
            for (int i = 0; i < N; ++i) { const int l = i ^ j;
                if (l > i) { const bool desc = ((i & k) == 0) || (k == N); const float x = v[i], y = v[l], hi = fmaxf(x, y), lo = fminf(x, y); v[i] = desc ? hi : lo; v[l] = desc ? lo : hi; } }
}
#define CROW(i) (((i) & 3) + 8 * ((i) >> 2))
__device__ __forceinline__ float max3f(float a, float b, float c) { return fmaxf(fmaxf(a, b), c); }
__device__ __forceinline__ void ph_route(const Args& a, LAS unsigned char* lds) {
    const int tid = phase_tid(), lane = tid & 63, wave = __builtin_amdgcn_readfirstlane(tid >> 6), tl = lane & 31, hc = lane >> 5;
    const int gw = blockIdx.x * NWAVES + wave, NGW = gridDim.x * NWAVES;
    const float* QP = (const float*)(a.ws + WS_QP); const float* qgain = a.in[18]; const v4u* KF = (const v4u*)(a.ws + WS_KEYF);
    int* EI = (int*)(a.ws + WS_EI); float* EG = (float*)(a.ws + WS_EG);
    LAS float* spl = (LAS float*)(lds + wave * 8704) + lane * 33;
    for (int job = gw; job < (T / 32) * 8; job += NGW) {
        const int h = job & 7, t = (job >> 3) * 32 + tl;
#pragma unroll 1
        for (int p = 0; p < 2; ++p) {
            bf16x8 bh[8], bl[8];
            { const float* qr = QP + (size_t)t * D + h * 256 + p * 128 + 8 * hc; const float* gr = qgain + (h * 2 + p) * 128 + 8 * hc;
              float ss = 0.f;
#pragma unroll
              for (int st = 0; st < 8; ++st) { const f32x4 x0 = *(const f32x4*)(qr + 16 * st), x1 = *(const f32x4*)(qr + 16 * st + 4);
                  ss += (x0.x * x0.x + x0.y * x0.y) + (x0.z * x0.z + x0.w * x0.w) + (x1.x * x1.x + x1.y * x1.y) + (x1.z * x1.z + x1.w * x1.w); }
              ss += __shfl_xor(ss, 32);
              const float rstd = rsqrtf(ss * (1.f / 128.f) + EPS);
              asm volatile("" ::: "memory");
#pragma unroll
              for (int st = 0; st < 8; ++st) { const f32x4 x0 = *(const f32x4*)(qr + 16 * st), x1 = *(const f32x4*)(qr + 16 * st + 4); const f32x4 g0 = *(const f32x4*)(gr + 16 * st), g1 = *(const f32x4*)(gr + 16 * st + 4);
                  const float v0 = x0.x * rstd * g0.x, v1 = x0.y * rstd * g0.y, v2 = x0.z * rstd * g0.z, v3 = x0.w * rstd * g0.w, v4 = x1.x * rstd * g1.x, v5 = x1.y * rstd * g1.y, v6 = x1.z * rstd * g1.z, v7 = x1.w * rstd * g1.w;
                  v4u xh, xl; xh.x = pkbf(v0, v1); xh.y = pkbf(v2, v3); xh.z = pkbf(v4, v5); xh.w = pkbf(v6, v7);
                  xl.x = pkbf(v0 - bflo(xh.x), v1 - bfhi(xh.x)); xl.y = pkbf(v2 - bflo(xh.y), v3 - bfhi(xh.y)); xl.z = pkbf(v4 - bflo(xh.z), v5 - bfhi(xh.z)); xl.w = pkbf(v6 - bflo(xh.w), v7 - bfhi(xh.w));
                  bh[st] = __builtin_bit_cast(bf16x8, xh); bl[st] = __builtin_bit_cast(bf16x8, xl); } }
            float sc[64];
            const v4u* kfh = KF + (size_t)(((h * 2 + p) * 2 + 0) * 32) * 64 + lane; const v4u* kfl = KF + (size_t)(((h * 2 + p) * 2 + 1) * 32) * 64 + lane;
#pragma unroll
            for (int kt = 0; kt < 4; ++kt) {
                f32x16 acc;
#pragma unroll
                for (int i = 0; i < 16; ++i) acc[i] = 0.f;
#pragma unroll
                for (int s2 = 0; s2 < 2; ++s2) {
                    asm volatile("" ::: "memory");
                    bf16x8 ah[4], al[4];
#pragma unroll
                    for (int s4 = 0; s4 < 4; ++s4) { ah[s4] = __builtin_bit_cast(bf16x8, kfh[(kt * 8 + s2 * 4 + s4) * 64]); al[s4] = __builtin_bit_cast(bf16x8, kfl[(kt * 8 + s2 * 4 + s4) * 64]); }
#pragma unroll
                    for (int s4 = 0; s4 < 4; ++s4) { const int st = s2 * 4 + s4;
                        acc = __builtin_amdgcn_mfma_f32_32x32x16_bf16(al[s4], bh[st], acc, 0, 0, 0); acc = __builtin_amdgcn_mfma_f32_32x32x16_bf16(ah[s4], bl[st], acc, 0, 0, 0); acc = __builtin_amdgcn_mfma_f32_32x32x16_bf16(ah[s4], bh[st], acc, 0, 0, 0); }
                }
#pragma unroll
                for (int i = 0; i < 16; ++i) { const float av = acc[i];
                    const unsigned bits = (__builtin_bit_cast(unsigned, av) & ~127u) | (unsigned)(127 - (32 * kt + CROW(i) + 4 * hc)); sc[16 * kt + i] = __builtin_bit_cast(float, bits); }
            }
            asm volatile("" ::: "memory");
            bitonic_desc<64, false>(sc);
            float t16[16];
#pragma unroll
            for (int i = 0; i < 16; ++i) t16[i] = __shfl_xor(sc[i], 32);
            float u16[16];
#pragma unroll
            for (int i = 0; i < 16; ++i) u16[i] = fmaxf(sc[i], t16[15 - i]);
            bitonic_desc<16, true>(u16);
#pragma unroll
            for (int i = 0; i < 16; ++i) spl[p * 16 + i] = u16[i];
        }
        asm volatile("s_waitcnt lgkmcnt(0)" ::: "memory");
        float sp[2][16];
#pragma unroll
        for (int i = 0; i < 16; ++i) { sp[0][i] = spl[i]; sp[1][i] = spl[16 + i]; }
        float cv[64];
        {
            int c = 0;
#pragma unroll
            for (int i = 0; i < 16; ++i)
#pragma unroll
                for (int j = 0; j < 16; ++j) if ((i + 1) * (j + 1) <= 16) {
                    const float v = sp[0][i] + sp[1][j];
                    cv[c] = __builtin_bit_cast(float, (__builtin_bit_cast(unsigned, v) & ~255u) | (unsigned)(255 - (i * 16 + j))); ++c; }
#pragma unroll
            for (int i = 50; i < 64; ++i) cv[i] = -INFINITY;
        }
        bitonic_desc<64, false>(cv);
        float tv[16];
#pragma unroll
        for (int i = 0; i < 16; ++i) tv[i] = cv[i];
        asm volatile("s_waitcnt lgkmcnt(0)" ::: "memory");
        int te[16]; float den = 0.f; const float top = tv[0];
#pragma unroll
        for (int i = 0; i < 16; ++i) { const int flat = 255 - (int)(__builtin_bit_cast(unsigned, tv[i]) & 255u);
            const unsigned b1 = __builtin_bit_cast(unsigned, spl[flat >> 4]), b2 = __builtin_bit_cast(unsigned, spl[16 + (flat & 15)]);
            te[i] = (127 - (int)(b1 & 127u)) * 128 + (127 - (int)(b2 & 127u));
            tv[i] = __expf(tv[i] - top); den += tv[i]; }
        den = 1.f / den;
        if (hc == 0) {
            int* ei = EI + (size_t)t * 128 + h * 16; float* eg = EG + (size_t)t * 128 + h * 16;
#pragma unroll
            for (int i = 0; i < 16; i += 4) { *(v4u*)(ei + i) = (v4u){(unsigned)te[i], (unsigned)te[i + 1], (unsigned)te[i + 2], (unsigned)te[i + 3]}; *(f32x4*)(eg + i) = (f32x4){tv[i] * den, tv[i + 1] * den, tv[i + 2] * den, tv[i + 3] * den}; }
        }
        asm volatile("s_waitcnt lgkmcnt(0)" ::: "memory");
    }
}
__device__ __forceinline__ float ub0(unsigned w) { return (float)(w & 0xffu); }
__device__ __forceinline__ float ub1(unsigned w) { return (float)((w >> 8) & 0xffu); }
__device__ __forceinline__ float ub2(unsigned w) { return (float)((w >> 16) & 0xffu); }
__device__ __forceinline__ float ub3(unsigned w) { return (float)(w >> 24); }
__device__ __forceinline__ void ph_experts(const Args& a, const float osc) {
    const int tid = phase_tid(), lane = tid & 63, wave = __builtin_amdgcn_readfirstlane(tid >> 6);
    const int gw = blockIdx.x * NWAVES + wave, NGW = gridDim.x * NWAVES;
    const bf16* H2 = (const bf16*)(a.ws + WS_H); const unsigned char* PU = a.ws + WS_PU8; const unsigned char* PV = a.ws + WS_PV8; const float* SC = (const float*)(a.ws + WS_PSC);
    const int* EI = (const int*)(a.ws + WS_EI); const float* EG = (const float*)(a.ws + WS_EG);
    const float* mod = (const float*)(a.ws + WS_MOD);
    float* out = a.out;
    for (int t = gw; t < T; t += NGW) {
        const int b = t / S;
        float x[32]; float sx = 0.f;
#pragma unroll
        for (int c = 0; c < 2; ++c)
#pragma unroll
            for (int hw = 0; hw < 2; ++hw) { const v4u w = *(const v4u*)(H2 + (size_t)t * D + 1024 * c + 16 * lane + 8 * hw); const int o = 16 * c + 8 * hw;
                x[o + 0] = bflo(w.x); x[o + 1] = bfhi(w.x); x[o + 2] = bflo(w.y); x[o + 3] = bfhi(w.y); x[o + 4] = bflo(w.z); x[o + 5] = bfhi(w.z); x[o + 6] = bflo(w.w); x[o + 7] = bfhi(w.w); }
#pragma unroll
        for (int i = 0; i < 32; ++i) sx += x[i];
        sx = wave_sum(sx) * 128.f;
        const int e0 = EI[(size_t)t * 128 + lane], e1 = EI[(size_t)t * 128 + 64 + lane];
        const float gs0 = EG[(size_t)t * 128 + lane] * SC[NE + e0], gs1 = EG[(size_t)t * 128 + 64 + lane] * SC[NE + e1];
        const float su0 = SC[e0], su1 = SC[e1];
        float cf0 = 0.f, cf1 = 0.f;
#pragma unroll 1
        for (int bt = 0; bt < 16; ++bt) {
            v4u w[8][2];
#pragma unroll
            for (int k = 0; k < 8; ++k) { const int e = __shfl(bt < 8 ? e0 : e1, (bt * 8 + k) & 63); const unsigned char* ur = PU + (size_t)e * D + 16 * lane;
                w[k][0] = *(const v4u*)ur; w[k][1] = *(const v4u*)(ur + 1024); }
#pragma unroll
            for (int k = 0; k < 8; ++k) { float s0 = 0.f, s1 = 0.f;
#pragma unroll
                for (int c = 0; c < 2; ++c) { const v4u q = w[k][c]; const int o = 16 * c;
                    s0 += x[o + 0] * ub0(q.x) + x[o + 1] * ub1(q.x) + x[o + 2] * ub2(q.x) + x[o + 3] * ub3(q.x); s1 += x[o + 4] * ub0(q.y) + x[o + 5] * ub1(q.y) + x[o + 6] * ub2(q.y) + x[o + 7] * ub3(q.y);
                    s0 += x[o + 8] * ub0(q.z) + x[o + 9] * ub1(q.z) + x[o + 10] * ub2(q.z) + x[o + 11] * ub3(q.z); s1 += x[o + 12] * ub0(q.w) + x[o + 13] * ub1(q.w) + x[o + 14] * ub2(q.w) + x[o + 15] * ub3(q.w); }
                const float raw = wave_sum(s0 + s1) - sx;
                if (lane == ((bt * 8 + k) & 63)) { if (bt < 8) cf0 = gelu_tanh(raw * su0) * gs0; else cf1 = gelu_tanh(raw * su1) * gs1; } }
        }
        const float wsum = wave_sum(cf0 + cf1) * 128.f;
        float acc[32];
#pragma unroll
        for (int i = 0; i < 32; ++i) acc[i] = 0.f;
#pragma unroll 1
        for (int bt = 0; bt < 16; ++bt) {
            v4u w[8][2];
#pragma unroll
            for (int k = 0; k < 8; ++k) { const int e = __shfl(bt < 8 ? e0 : e1, (bt * 8 + k) & 63); const unsigned char* vr = PV + (size_t)e * D + 16 * lane;
                w[k][0] = *(const v4u*)vr; w[k][1] = *(const v4u*)(vr + 1024); }
#pragma unroll
            for (int k = 0; k < 8; ++k) { const float cf = __shfl(bt < 8 ? cf0 : cf1, (bt * 8 + k) & 63);
#pragma unroll
                for (int c = 0; c < 2; ++c) { const v4u q = w[k][c]; const int o = 16 * c;
                    acc[o + 0] += cf * ub0(q.x); acc[o + 1] += cf * ub1(q.x); acc[o + 2] += cf * ub2(q.x); acc[o + 3] += cf * ub3(q.x); acc[o + 4] += cf * ub0(q.y); acc[o + 5] += cf * ub1(q.y); acc[o + 6] += cf * ub2(q.y); acc[o + 7] += cf * ub3(q.y);
                    acc[o + 8] += cf * ub0(q.z); acc[o + 9] += cf * ub1(q.z); acc[o + 10] += cf * ub2(q.z); acc[o + 11] += cf * ub3(q.z); acc[o + 12] += cf * ub0(q.w); acc[o + 13] += cf * ub1(q.w); acc[o + 14] += cf * ub2(q.w); acc[o + 15] += cf * ub3(q.w); } }
        }
        const float* g2 = mod + b * 12288 + 10240;
#pragma unroll
        for (int c = 0; c < 2; ++c)
#pragma unroll
            for (int w4 = 0; w4 < 4; ++w4) { float* op = out + (size_t)t * D + 1024 * c + 16 * lane + 4 * w4; const f32x4 ga = *(const f32x4*)(g2 + 1024 * c + 16 * lane + 4 * w4); f32x4 r0 = *(const f32x4*)op; const int o = 16 * c + 4 * w4;
                r0.x += ga.x * (acc[o + 0] - wsum) * osc; r0.y += ga.y * (acc[o + 1] - wsum) * osc; r0.z += ga.z * (acc[o + 2] - wsum) * osc; r0.w += ga.w * (acc[o + 3] - wsum) * osc;
                *(f32x4*)op = r0; }
    }
}

constexpr int N_PHASES = 11;
__global__ void __launch_bounds__(NTHREADS, 2) fwd_kernel(Args a) {
    extern __shared__ __attribute__((aligned(16))) unsigned char lds_raw[];
    LAS unsigned char* lds = (LAS unsigned char*)lds_raw;
    const int tid = threadIdx.x;
    volatile LAS unsigned* misc = (volatile LAS unsigned*)(lds + LDS_MISC);
    if (tid < 16) misc[tid] = 0u;
    __syncthreads();
    XcdBarrier bar; bar.bar = (unsigned*)(a.ws + WS_CTL) + 1024; bar.x = 0; bar.st = nullptr;
    const int lo = a.ph_lo, hi = a.ph_hi;
    if (hi - lo > 1) bar = xcd_barrier_post((unsigned*)(a.ws + WS_CTL) + 1024, misc + 8);
#define IN(k) (lo <= (k) && (k) < hi)
#define SEAM(k) do { if (IN(k) && IN((k) + 1)) xcd_barrier(bar); } while (0)
    const int G = gridDim.x, bx = blockIdx.x;

    for (int rep = 0; rep < 1 + ((PROBE_DUP >> 0) & 1); ++rep)
    if (IN(0)) { ph0_mod(a, lds); __syncthreads(); ph0_weights(a, lds); ph0_keyfrags(a); ph0_extra(a); __syncthreads(); }
    SEAM(0);
    for (int rep = 0; rep < 1 + ((PROBE_DUP >> 1) & 1); ++rep)
    if (IN(1)) ph_norm(a, a.in[0], a.in[4], 0, 2048, (bf16*)(a.ws + WS_H));
    SEAM(1);
    for (int rep = 0; rep < 1 + ((PROBE_DUP >> 2) & 1); ++rep)
    if (IN(2)) { pg8::Gemm g{(const bf16*)(a.ws + WS_H), (const bf16*)(a.ws + WS_WIN), T, NPROJ, D}; pg8::StaticOrder So; So.init(T, NPROJ, G, bx);
        EpiProjNorm E{(bf16*)(a.ws + WS_Q), (bf16*)(a.ws + WS_KV), (bf16*)(a.ws + WS_DL), (bf16*)(a.ws + WS_MG), (bf16*)a.out, a.in[6], a.in[7], a.in[11], a.in[12], (LAS float*)(lds + 131072)};
        pg8::gemm_phase<EpiProjNorm, pg8::StaticOrder>(lds, g, So, E); }
    SEAM(2);
    if (IN(3)) { for (int rep = 0; rep < 1 + ((PROBE_DUP >> 3) & 1); ++rep) { ph3_vfrag(a); ph3_gates(a); ph3_compress(a, lds); } }
    SEAM(3);
    for (int rep = 0; rep < 1 + ((PROBE_DUP >> 4) & 1); ++rep)
    if (IN(4)) ph4_attention(a, lds);
    SEAM(4);
    for (int rep = 0; rep < 1 + ((PROBE_DUP >> 5) & 1); ++rep)
    if (IN(5)) {
        { pg8::Gemm g{(const bf16*)(a.ws + WS_YN), (const bf16*)(a.ws + WS_WBN), T, D, 1536}; pg8::StaticOrder So; So.init(T, D, G, bx);
          EpiMerge E{(const bf16*)(a.ws + WS_MG), (bf16*)(a.ws + WS_H)}; MidMerge Mh{(const bf16*)(a.ws + WS_MG)};
          pg8::gemm_phase<EpiMerge, pg8::StaticOrder, MidMerge>(lds, g, So, E, Mh); }
    }
    SEAM(5);
    for (int rep = 0; rep < 1 + ((PROBE_DUP >> 6) & 1); ++rep)
    if (IN(6)) { pg8::Gemm g{(const bf16*)(a.ws + WS_H), (const bf16*)(a.ws + WS_WOUT), T, D, D}; pg8::StaticOrder So; So.init(T, D, G, bx);
        EpiOut E{a.in[0], (const float*)(a.ws + WS_MOD), a.out}; pg8::gemm_phase<EpiOut, pg8::StaticOrder>(lds, g, So, E); }
    SEAM(6);
    for (int rep = 0; rep < 1 + ((PROBE_DUP >> 7) & 1); ++rep)
    if (IN(7)) { ph_norm(a, a.out, a.in[16], 6144, 8192, (bf16*)(a.ws + WS_H)); ph_quant_uv(a); }
    SEAM(7);
    for (int rep = 0; rep < 1 + ((PROBE_DUP >> 8) & 1); ++rep)
    if (IN(8)) { pg8::Gemm g{(const bf16*)(a.ws + WS_H), (const bf16*)(a.ws + WS_WPQ), T, D, D}; pg8::StaticOrder So; So.init(T, D, G, bx);
        EpiF32 E{(float*)(a.ws + WS_QP), D}; pg8::gemm_phase<EpiF32, pg8::StaticOrder>(lds, g, So, E); }
    SEAM(8);
    for (int rep = 0; rep < 1 + ((PROBE_DUP >> 9) & 1); ++rep)
    if (IN(9)) { ph_route(a, lds); __syncthreads(); }
    SEAM(9);
    if (IN(10)) { if ((PROBE_DUP >> 10) & 1) { ph_experts(a, *(const float*)(a.ws + WS_CTL + 64)); asm volatile("s_waitcnt vmcnt(0)" ::: "memory"); __syncthreads(); } ph_experts(a, 1.f); }
#undef IN
#undef SEAM
}

extern "C" void kernel_launch(void* const* d_in, const int* in_sizes, int n_in, void* d_out, int out_size, void* d_ws, size_t ws_size, hipStream_t stream) {
    static int grid = 0;
    if (grid == 0) {
        if (n_in != 23 || out_size != T * D || ws_size < WS_END4) { fprintf(stderr, "kernel_launch: unexpected problem shape (n_in %d, out %d, ws %zu); nothing launched\n", n_in, out_size, ws_size); grid = -1; return; }
        int dev = 0, cus = 0, per_cu = 0;
        if (hipGetDevice(&dev) != hipSuccess || hipDeviceGetAttribute(&cus, hipDeviceAttributeMultiprocessorCount, dev) != hipSuccess) { grid = -1; return; }
        if (hipFuncSetAttribute((const void*)fwd_kernel, hipFuncAttributeMaxDynamicSharedMemorySize, LDS_BYTES) != hipSuccess) { fprintf(stderr, "kernel_launch: hipFuncSetAttribute failed\n"); grid = -1; return; }
        if (hipOccupancyMaxActiveBlocksPerMultiprocessor(&per_cu, (const void*)fwd_kernel, NTHREADS, LDS_BYTES) != hipSuccess || per_cu < 1) { fprintf(stderr, "kernel_launch: occupancy query says %d\n", per_cu); }
        (void)hipGetLastError();
        grid = cus;
    }
    if (grid < 0) return;
    hipMemsetAsync((char*)d_ws + WS_CTL, 0, CTL_ZERO_BYTES, stream);
    Args a{};
    for (int i = 0; i < 23; ++i) a.in[i] = (const float*)d_in[i];
    a.out = (float*)d_out; a.ws = (unsigned char*)d_ws;
#if MK_ONE_LAUNCH
#if PROBE_PREFIX >= 0
    a.ph_lo = 0; a.ph_hi = PROBE_PREFIX + 1;
    hipLaunchKernelGGL(fwd_kernel, dim3(grid), dim3(NTHREADS), LDS_BYTES, stream, a);
    hipMemsetAsync((char*)d_ws + WS_CTL, 0, CTL_ZERO_BYTES, stream);
#endif
    a.ph_lo = 0; a.ph_hi = N_PHASES;
    hipLaunchKernelGGL(fwd_kernel, dim3(grid), dim3(NTHREADS), LDS_BYTES, stream, a);
#else
    for (int p = 0; p < N_PHASES; ++p) { a.ph_lo = p; a.ph_hi = p + 1; hipLaunchKernelGGL(fwd_kernel, dim3(grid), dim3(NTHREADS), LDS_BYTES, stream, a); }
#endif
}
```

```cpp
#include <hip/hip_runtime.h>
#include <cstdio>
#include <cstdint>

#ifndef PROBE_DUP
#define PROBE_DUP 0
#endif
#ifndef PROBE_PREFIX
#define PROBE_PREFIX -1
#endif
#ifndef MK_ONE_LAUNCH
#define MK_ONE_LAUNCH 1
#endif

__device__ __forceinline__ int phase_tid() { int t = threadIdx.x; asm volatile("" : "+v"(t)); return t; }
namespace pg8 {
#define PG8_LAS __attribute__((address_space(3)))
typedef unsigned short bf16_t;
typedef short bf16x8 __attribute__((ext_vector_type(8)));
typedef float f32x4 __attribute__((ext_vector_type(4)));
typedef unsigned u32x4 __attribute__((ext_vector_type(4)));
typedef unsigned u32x2 __attribute__((ext_vector_type(2)));
constexpr int BM = 256, BK = 64, HALF = 128, HTB = HALF * BK * 2, STAGE_BYTES = 8 * HTB, NXCD = 8, WGM = 8;

__host__ __device__ __forceinline__ int lds_byte(int r, int c) { const int st = (r >> 4) * 2 + (c >> 5), rr = r & 15, cc = c & 31, ob = rr * 64 + cc * 2; return st * 1024 + (ob ^ (((ob >> 9) & 1) << 5)); }
__host__ __device__ __forceinline__ void stage_rc(int b, int& R, int& C) { const int st = b / 1024, sb = b % 1024, swz = sb ^ (((sb >> 9) & 1) << 5); R = (st >> 1) * 16 + swz / 64; C = (st & 1) * 32 + (swz % 64) / 2; }
__host__ __device__ __forceinline__ int perm32(int rho) { const int n = rho >> 4, i = rho & 15; return 8 * (i >> 2) + 4 * n + (i & 3); }

struct Unit { int pm, pn; };
struct Gemm { const bf16_t* A; const bf16_t* Bt; int M, N, K; };

struct StaticOrder {
    int nM, nN, nwg, G, c;
    __host__ __device__ void init(int M, int N, int G_, int c_) { nM = M / BM; nN = N / BM; nwg = nM * nN; G = G_; c = c_; }
    __host__ __device__ bool next(int i, Unit& u) const {
        const long L = (long)i * G + c; if (L >= nwg) return false;
        int wgid = (int)L; { const int q = nwg / NXCD, r = nwg % NXCD, xcd = wgid % NXCD, off = wgid / NXCD; wgid = (xcd < r ? xcd * (q + 1) : r * (q + 1) + (xcd - r) * q) + off; }
        const int nig = WGM * nN, gid = wgid / nig, fm = gid * WGM, gsz = (nM - fm) < WGM ? (nM - fm) : WGM;
        u.pm = fm + ((wgid % nig) % gsz); u.pn = (wgid % nig) / gsz; return true;
    }
    __device__ __forceinline__ void a_ready(const Unit&) const {}
    __device__ __forceinline__ void done(const Unit&) const {}
};

__device__ __forceinline__ unsigned cvt_pk_bf16(float lo, float hi) { unsigned r; asm volatile("v_cvt_pk_bf16_f32 %0, %1, %2" : "=v"(r) : "v"(lo), "v"(hi)); return r; }

typedef int i32x4 __attribute__((ext_vector_type(4)));
typedef int i32x8 __attribute__((ext_vector_type(8)));
template <bool F8> __device__ __forceinline__ void mma_blk(f32x4 (&acc)[4][2], const bf16x8 (&At)[4][2], const bf16x8 (&Bt)[2][2]) {
    if constexpr (F8) {
#pragma unroll
        for (int m = 0; m < 4; ++m)
#pragma unroll
            for (int n = 0; n < 2; ++n) {
                const i32x8 bb = __builtin_shufflevector(__builtin_bit_cast(i32x4, Bt[n][0]), __builtin_bit_cast(i32x4, Bt[n][1]), 0, 1, 2, 3, 4, 5, 6, 7);
                const i32x8 aa = __builtin_shufflevector(__builtin_bit_cast(i32x4, At[m][0]), __builtin_bit_cast(i32x4, At[m][1]), 0, 1, 2, 3, 4, 5, 6, 7);
                asm volatile("v_mfma_f32_16x16x128_f8f6f4 %0, %1, %2, %0" : "+v"(acc[m][n]) : "v"(bb), "v"(aa)); }
    } else {
#pragma unroll
        for (int m = 0; m < 4; ++m)
#pragma unroll
            for (int n = 0; n < 2; ++n)
#pragma unroll
                for (int k = 0; k < 2; ++k) acc[m][n] = __builtin_amdgcn_mfma_f32_16x16x32_bf16(Bt[n][k], At[m][k], acc[m][n], 0, 0, 0);
    }
}
struct NoMid { static constexpr int AT = -1; __device__ __forceinline__ void operator()(f32x4 (&)[2][2][4][2], const Unit&, int, int, int, int) const {} };
template <class Epi, class Sched, class Mid = NoMid, bool F8 = false>
__device__ __forceinline__ void gemm_phase(PG8_LAS unsigned char* lds, const Gemm g, const Sched& S, const Epi& E, const Mid& Mh = Mid()) {
    const int tid = phase_tid(), wid = __builtin_amdgcn_readfirstlane(tid >> 6), lane = tid & 63, wr = wid >> 2, wc = wid & 3, fr = lane & 15, fq = lane >> 4;
    const int K = g.K, nt = K / BK;
    unsigned voffA[2], voffB[2];
#pragma unroll
    for (int i = 0; i < 2; ++i) { int R, C; stage_rc(tid * 16 + i * 8192, R, C); const int Rb = Epi::PERM ? ((R & ~31) + perm32(R & 31)) : R;
        voffA[i] = (unsigned)(R * K + C) * 2u; voffB[i] = (unsigned)(Rb * K + C) * 2u; }
    const size_t kstep = (size_t)(BK * 2);
    const size_t hstep = (size_t)HALF * K * 2;
    const size_t tstep = 2 * hstep;
    const unsigned ldsw = (unsigned)wid * 1024u;
    const int aoff = lds_byte(wr * 64 + fr, fq * 8), boff = lds_byte(wc * 32 + fr, fq * 8);
#define PG8_SA(b, h) (((b) * 2 + (h)) * HTB)
#define PG8_SB(b, h) ((4 + (b) * 2 + (h)) * HTB)
#define PG8_STAGE(bufoff, gbase, voff) do { _Pragma("unroll") for (int _i = 0; _i < 2; ++_i) \
        __builtin_amdgcn_global_load_lds((const unsigned*)((const char*)(gbase) + (voff)[_i]), (PG8_LAS unsigned*)(lds + (bufoff) + ldsw + _i * 8192), 16, 0, 0); } while (0)
#define PG8_LDA(dst, b, h) do { _Pragma("unroll") for (int m = 0; m < 4; ++m) _Pragma("unroll") for (int k = 0; k < 2; ++k) dst[m][k] = *(const PG8_LAS bf16x8*)(lds + PG8_SA(b, h) + aoff + m * 2048 + k * 1024); } while (0)
#define PG8_LDB(dst, b, h) do { _Pragma("unroll") for (int n = 0; n < 2; ++n) _Pragma("unroll") for (int k = 0; k < 2; ++k) dst[n][k] = *(const PG8_LAS bf16x8*)(lds + PG8_SB(b, h) + boff + n * 2048 + k * 1024); } while (0)
#define PG8_MMA(ai, bj, At, Bt) do { __builtin_amdgcn_s_setprio(1); if constexpr (F8) { mma_blk<true>(acc[ai][bj], At, Bt); } else { _Pragma("unroll") for (int m = 0; m < 4; ++m) _Pragma("unroll") for (int n = 0; n < 2; ++n) _Pragma("unroll") for (int k = 0; k < 2; ++k) \
        acc[ai][bj][m][n] = __builtin_amdgcn_mfma_f32_16x16x32_bf16(Bt[n][k], At[m][k], acc[ai][bj][m][n], 0, 0, 0); } __builtin_amdgcn_s_setprio(0); } while (0)
#define PG8_WAIT_V(n) asm volatile("s_waitcnt vmcnt(" #n ")" ::: "memory")
#define PG8_WAIT_L(n) asm volatile("s_waitcnt lgkmcnt(" #n ")" ::: "memory")
#define PG8_BAR __builtin_amdgcn_s_barrier()
#define PG8_SCHED __builtin_amdgcn_sched_barrier(0)
    Unit cur, nxt; int ui = 0;
    if (!S.next(0, cur)) return;
    f32x4 acc[2][2][4][2];
#pragma unroll
    for (int a = 0; a < 2; ++a)
#pragma unroll
        for (int b = 0; b < 2; ++b)
#pragma unroll
            for (int m = 0; m < 4; ++m)
#pragma unroll
                for (int n = 0; n < 2; ++n) acc[a][b][m][n] = (f32x4){0.f, 0.f, 0.f, 0.f};
    bf16x8 At[4][2], B0[2][2], B1[2][2];
    const char* cA = (const char*)g.A + (size_t)cur.pm * tstep; const char* cB = (const char*)g.Bt + (size_t)cur.pn * tstep;
    S.a_ready(cur);
    PG8_STAGE(PG8_SB(0, 0), cB, voffB); PG8_STAGE(PG8_SA(0, 0), cA, voffA); PG8_STAGE(PG8_SB(0, 1), cB + hstep, voffB); PG8_STAGE(PG8_SA(0, 1), cA + hstep, voffA);
    if (wr == 1) PG8_BAR;
    PG8_WAIT_V(4); PG8_BAR;
    PG8_STAGE(PG8_SB(1, 0), cB + kstep, voffB); PG8_STAGE(PG8_SA(1, 0), cA + kstep, voffA); PG8_STAGE(PG8_SB(1, 1), cB + hstep + kstep, voffB);
    PG8_WAIT_V(6); PG8_BAR;
    for (;;) {
        const bool has_next = S.next(ui + 1, nxt);
        const char* nA = has_next ? (const char*)g.A + (size_t)nxt.pm * tstep : cA; const char* nB = has_next ? (const char*)g.Bt + (size_t)nxt.pn * tstep : cB;
#define PG8_KBODY \
            const bool last = (t == nt - 2); \
            const char* a1 = cA + (size_t)(t + 1) * kstep; \
            const char* a2 = last ? nA : cA + (size_t)(t + 2) * kstep; const char* b2 = last ? nB : cB + (size_t)(t + 2) * kstep; \
            const char* a3 = a2 + kstep; const char* b3 = b2 + kstep; \
            if (last && has_next) S.a_ready(nxt); \
            PG8_LDB(B0, 0, 0); PG8_SCHED; PG8_LDA(At, 0, 0); PG8_STAGE(PG8_SA(1, 1), a1 + hstep, voffA); \
            PG8_WAIT_L(8); PG8_BAR; PG8_WAIT_L(0); PG8_MMA(0, 0, At, B0); PG8_BAR; PG8_SCHED; \
            PG8_LDB(B1, 0, 1); PG8_STAGE(PG8_SB(0, 0), b2, voffB); \
            PG8_BAR; PG8_WAIT_L(0); PG8_MMA(0, 1, At, B1); PG8_BAR; \
            PG8_LDA(At, 0, 1); PG8_STAGE(PG8_SA(0, 0), a2, voffA); \
            PG8_BAR; PG8_WAIT_L(0); PG8_MMA(1, 0, At, B0); PG8_BAR; PG8_SCHED; \
            PG8_STAGE(PG8_SB(0, 1), b2 + hstep, voffB); \
            PG8_WAIT_V(6); PG8_BAR; PG8_MMA(1, 1, At, B1); PG8_BAR; \
            PG8_LDB(B0, 1, 0); PG8_SCHED; PG8_LDA(At, 1, 0); PG8_STAGE(PG8_SA(0, 1), a2 + hstep, voffA); \
            PG8_WAIT_L(8); PG8_BAR; PG8_WAIT_L(0); PG8_MMA(0, 0, At, B0); PG8_BAR; PG8_SCHED; \
            PG8_LDB(B1, 1, 1); PG8_STAGE(PG8_SB(1, 0), b3, voffB); \
            PG8_BAR; PG8_WAIT_L(0); PG8_MMA(0, 1, At, B1); PG8_BAR; \
            PG8_LDA(At, 1, 1); PG8_STAGE(PG8_SA(1, 0), a3, voffA); \
            PG8_BAR; PG8_WAIT_L(0); PG8_MMA(1, 0, At, B0); PG8_BAR; PG8_SCHED; \
            PG8_STAGE(PG8_SB(1, 1), b3 + hstep, voffB); \
            PG8_WAIT_V(6); PG8_BAR; PG8_MMA(1, 1, At, B1); PG8_BAR;
        if constexpr (Mid::AT >= 0) {
            for (int t = 0; t < Mid::AT; t += 2) { PG8_KBODY }
            if constexpr (F8) asm volatile("s_nop 15\n\ts_nop 15" ::: "memory");
            Mh(acc, cur, wr, wc, fr, fq);
            for (int t = Mid::AT; t < nt; t += 2) { PG8_KBODY }
        } else {
            for (int t = 0; t < nt; t += 2) { PG8_KBODY }
        }
#undef PG8_KBODY
        if constexpr (F8) asm volatile("s_nop 15\n\ts_nop 15" ::: "memory");
        E(acc, cur, wr, wc, fr, fq); S.done(cur);
        if (!has_next) break;
#pragma unroll
        for (int a = 0; a < 2; ++a)
#pragma unroll
            for (int b = 0; b < 2; ++b)
#pragma unroll
                for (int m = 0; m < 4; ++m)
#pragma unroll
                    for (int n = 0; n < 2; ++n) acc[a][b][m][n] = (f32x4){0.f, 0.f, 0.f, 0.f};
        cur = nxt; cA = nA; cB = nB; ++ui;
    }
    PG8_WAIT_V(0);
    if (wr == 0) PG8_BAR;
    PG8_BAR;
#undef PG8_SA
#undef PG8_SB
#undef PG8_STAGE
#undef PG8_LDA
#undef PG8_LDB
#undef PG8_MMA
#undef PG8_WAIT_V
#undef PG8_WAIT_L
#undef PG8_BAR
#undef PG8_SCHED
}
}

#define GAS __attribute__((address_space(1)))
#define LAS __attribute__((address_space(3)))
typedef unsigned short bf16;
typedef float f32x4 __attribute__((ext_vector_type(4)));
typedef unsigned v4u __attribute__((ext_vector_type(4)));
typedef unsigned v2u __attribute__((ext_vector_type(2)));

constexpr int NB = 4, S = 4096, D = 2048, T = NB * S, HD = 128;
constexpr int IN_COLS = 11288, OFF_KV = 1024, OFF_GATE = 2560, OFF_DIL = 2584, OFF_MERGE = 7192;
constexpr int NPROJ = 11264;
constexpr int NQ = 1024, NKV = 1536, NDL = 4608, NMG = 4096;
constexpr int NC = 255, NS = 64;
constexpr int NE = 16384;
constexpr float EPS = 1e-6f;
constexpr float QSCALE = 0.08838834764831845f;
constexpr int NWAVES = 8, NTHREADS = 512;

constexpr size_t MiB = 1u << 20;
constexpr size_t WS_CTL = 0, CTL_ZERO_BYTES = 1 * MiB;
constexpr size_t WS_WIN = 1 * MiB;
constexpr size_t WS_WBN = 45 * MiB;
constexpr size_t WS_WBD = 49 * MiB;
constexpr size_t WS_WOUT = 51 * MiB;
constexpr size_t WS_WPQ = 59 * MiB;
constexpr size_t WS_WGATE = 67 * MiB;
constexpr size_t WS_MOD = 67 * MiB + 256 * 1024;
constexpr size_t WS_SEL = 67 * MiB + 512 * 1024;
constexpr size_t WS_GATES = 68 * MiB;
constexpr size_t WS_KC = 70 * MiB;
constexpr size_t WS_VC = 71 * MiB;
constexpr size_t WS_H = 72 * MiB;
constexpr size_t WS_Q = 136 * MiB;
constexpr size_t WS_KV = 168 * MiB;
constexpr size_t WS_DL = 216 * MiB;
constexpr size_t WS_MG = 360 * MiB;
constexpr size_t WS_YN = 488 * MiB;
constexpr size_t WS_YD = 520 * MiB;
constexpr size_t WS_H8 = WS_YN;
constexpr size_t WS_EI = 536 * MiB;
constexpr size_t WS_EG = 544 * MiB;
constexpr size_t WS_END = 552 * MiB;
constexpr size_t WS_PU = WS_Q;
constexpr size_t WS_PV = WS_Q + 64 * MiB;
constexpr size_t WS_QP = WS_MG;
static_assert(WS_PV + 64 * MiB <= WS_MG, "u/v overlay");

constexpr int LDS_BYTES = 147456;
constexpr int LDS_MISC = 144 * 1024 - 256;

#define XB_TMO      128
#define XB_XCNT(j)  (256  + 64 * (j))
#define XB_XSUB(j)  (1280 + 64 * (j))
#define XB_XGEN(j)  (2304 + 64 * (j))
#define XB_TOP      3328
#define XB_TOPGEN   3392
#define XCD_BAR_WORDS 3456
#define XB_SPIN_CAP (1u << 24)

__device__ __forceinline__ unsigned xb_ld(unsigned* p)              { return __hip_atomic_load(p, __ATOMIC_RELAXED, __HIP_MEMORY_SCOPE_AGENT); }
__device__ __forceinline__ unsigned xb_add(unsigned* p, unsigned v) { return __hip_atomic_fetch_add(p, v, __ATOMIC_RELAXED, __HIP_MEMORY_SCOPE_AGENT); }
__device__ __forceinline__ unsigned xb_xcc_id() { return (unsigned)__builtin_amdgcn_s_getreg((3 << 11) | 20) & 0xFu; }
#define XB_SPIN(cond, bar) do { unsigned _sp = 0; while (cond) { __builtin_amdgcn_s_sleep(1); \
    if ((++_sp & 255u) == 0u) { if (xb_ld(&(bar)[XB_TMO])) break; if (_sp > XB_SPIN_CAP) { atomicAdd(&(bar)[XB_TMO], 1u); break; } } } } while (0)

struct XcdBarrier { unsigned* bar; unsigned x; volatile LAS unsigned* st; };

__device__ __forceinline__ XcdBarrier xcd_barrier_post(unsigned* bar, volatile LAS unsigned* st) {
    XcdBarrier b; b.bar = bar; b.x = xb_xcc_id(); b.st = st;
    if (threadIdx.x == 0) (void)xb_add(&bar[XB_XCNT(b.x)], 1u);
    return b;
}
__device__ __forceinline__ void xcd_barrier_complete(unsigned* bar, unsigned x, unsigned& nloc, unsigned& nx) {
    const unsigned G = gridDim.x * gridDim.y * gridDim.z;
    unsigned sum, cnt, mine, sp = 0u;
    for (;;) {
        sum = 0u; cnt = 0u; mine = 0u;
#pragma unroll
        for (unsigned j = 0; j < 16; ++j) { const unsigned c = xb_ld(&bar[XB_XCNT(j)]); sum += c; cnt += (c > 0u) ? 1u : 0u; mine = (j == x) ? c : mine; }
        if (sum == G) break;
        __builtin_amdgcn_s_sleep(1);
        if ((++sp & 255u) == 0u) { if (xb_ld(&bar[XB_TMO])) break; if (sp > XB_SPIN_CAP) { atomicAdd(&bar[XB_TMO], 1u); break; } }
    }
    nloc = mine > 0u ? mine : 1u; nx = cnt > 0u ? cnt : 1u;
}
__device__ __forceinline__ void xcd_barrier(const XcdBarrier& b) {
    asm volatile("s_waitcnt vmcnt(0)" ::: "memory");
    __syncthreads();
    if (threadIdx.x == 0) {
        unsigned* bar = b.bar;
        __builtin_amdgcn_s_waitcnt(0);
        unsigned nloc = b.st[0], nx = b.st[1];
        if (nloc == 0u) { xcd_barrier_complete(bar, b.x, nloc, nx); b.st[0] = nloc; b.st[1] = nx; }
        const unsigned old = xb_add(&bar[XB_XSUB(b.x)], 1u);
        const unsigned gen = old / nloc;
        if (old + 1u == (gen + 1u) * nloc) {
            __builtin_amdgcn_fence(__ATOMIC_RELEASE, "agent");
            asm volatile("s_waitcnt vmcnt(0)" ::: "memory");
            const unsigned og = xb_add(&bar[XB_TOP], 1u);
            const unsigned tg = og / nx;
            if (og + 1u == (tg + 1u) * nx) xb_add(&bar[XB_TOPGEN], 1u);
            else XB_SPIN(xb_ld(&bar[XB_TOPGEN]) == tg, bar);
            __builtin_amdgcn_fence(__ATOMIC_ACQUIRE, "agent");
            xb_add(&bar[XB_XGEN(b.x)], 1u);
            asm volatile("s_waitcnt vmcnt(0)" ::: "memory");
        } else {
            XB_SPIN(xb_ld(&bar[XB_XGEN(b.x)]) == gen, bar);
            __builtin_amdgcn_fence(__ATOMIC_ACQUIRE, "agent");
            asm volatile("s_waitcnt vmcnt(0)" ::: "memory");
        }
    }
    __syncthreads();
}

__device__ __forceinline__ unsigned f2bf(float f) { unsigned u = __builtin_bit_cast(unsigned, f); return (u + 0x7fffu + ((u >> 16) & 1u)) >> 16; }
__device__ __forceinline__ unsigned pk2(float lo, float hi) { return f2bf(lo) | (f2bf(hi) << 16); }
__device__ __forceinline__ unsigned pk4_f8(float a, float b, float c, float d) {
    a = __builtin_amdgcn_fmed3f(a, -448.f, 448.f); b = __builtin_amdgcn_fmed3f(b, -448.f, 448.f); c = __builtin_amdgcn_fmed3f(c, -448.f, 448.f); d = __builtin_amdgcn_fmed3f(d, -448.f, 448.f);
    int w = 0; w = __builtin_amdgcn_cvt_pk_fp8_f32(a, b, w, false); w = __builtin_amdgcn_cvt_pk_fp8_f32(c, d, w, true); return (unsigned)w; }
constexpr float F8_HS = 8.f, F8_WS = 128.f;
__device__ __forceinline__ float bflo(unsigned u) { return __builtin_bit_cast(float, u << 16); }
__device__ __forceinline__ float bfhi(unsigned u) { return __builtin_bit_cast(float, u & 0xffff0000u); }
__device__ __forceinline__ float bf2f(bf16 u) { return __builtin_bit_cast(float, (unsigned)u << 16); }
__device__ __forceinline__ float wave_sum(float v) {
#pragma unroll
    for (int o = 1; o < 64; o <<= 1) v += __shfl_xor(v, o);
    return v;
}
__device__ __forceinline__ float wave_max(float v) {
#pragma unroll
    for (int o = 1; o < 64; o <<= 1) v = fmaxf(v, __shfl_xor(v, o));
    return v;
}
__device__ __forceinline__ float sigmoidf(float x) { return __builtin_amdgcn_rcpf(1.f + __expf(-x)); }
__device__ __forceinline__ float gelu_tanh(float x) { const float u = 0.7978845608028654f * (x + 0.044715f * x * x * x); return 0.5f * x * (1.f + tanhf(u)); }
__device__ __forceinline__ int t5_bucket(int n) {
    if (n < 16) return n;
    int b = 16;
    b += (n >= 22); b += (n >= 30); b += (n >= 40); b += (n >= 54); b += (n >= 73); b += (n >= 99); b += (n >= 134); b += (n >= 182);
    b += (n >= 246); b += (n >= 332); b += (n >= 450); b += (n >= 609); b += (n >= 825); b += (n >= 1117); b += (n >= 1513);
    return b;
}

struct Args {
    const float* in[23];
    float* out; unsigned char* ws;
    int ph_lo, ph_hi;
};

typedef float f32x2v __attribute__((ext_vector_type(2)));
__device__ __forceinline__ void ph0_mod(const Args& a, LAS unsigned char* lds) {
    const int tid = phase_tid(), lane = tid & 63, wave = __builtin_amdgcn_readfirstlane(tid >> 6);
    LAS float* cs = (LAS float*)lds;
    LAS float* red = (LAS float*)(lds + 32768);
    const float* c = a.in[1]; const float* w_ada = a.in[2]; const float* b_ada = a.in[3];
    float* mod = (float*)(a.ws + WS_MOD);
    for (int i = tid; i < 4 * 2048; i += NTHREADS) { const float v = c[i]; cs[i] = v / (1.f + __expf(-v)); }
    __syncthreads();
    for (int u = blockIdx.x; u < 12288 / 128; u += gridDim.x) {
        const int col = u * 128 + 2 * lane;
        float acc[4][2];
#pragma unroll
        for (int b = 0; b < 4; ++b) { acc[b][0] = 0.f; acc[b][1] = 0.f; }
        const float* wp = w_ada + (size_t)(wave * 256) * 12288 + col;
#pragma unroll 1
        for (int k0 = 0; k0 < 256; k0 += 16) {
            f32x2v w[16];
#pragma unroll
            for (int k = 0; k < 16; ++k) w[k] = *(const f32x2v*)(wp + (size_t)(k0 + k) * 12288);
#pragma unroll
            for (int k = 0; k < 16; ++k) { const int kk = wave * 256 + k0 + k;
#pragma unroll
                for (int b = 0; b < 4; ++b) { const float cv = cs[b * 2048 + kk]; acc[b][0] += cv * w[k].x; acc[b][1] += cv * w[k].y; } }
        }
#pragma unroll
        for (int b = 0; b < 4; ++b) { red[(wave * 4 + b) * 128 + 2 * lane] = acc[b][0]; red[(wave * 4 + b) * 128 + 2 * lane + 1] = acc[b][1]; }
        __syncthreads();
        { const int b = tid >> 7, cc = tid & 127; float s = 0.f;
#pragma unroll
          for (int w = 0; w < 8; ++w) s += red[(w * 4 + b) * 128 + cc];
          mod[b * 12288 + u * 128 + cc] = s + b_ada[u * 128 + cc]; }
        __syncthreads();
    }
}
__device__ __forceinline__ void transpose_item(const float* W, int ldw, int ncols, int K, bf16* WT, int row_off, LAS float* scr, int item, int lane, int ldt = 0) {
    if (ldt == 0) ldt = K;
    const int nblk = ncols / 32, kb = item / nblk, nb = item % nblk, k0 = 64 * kb, n0 = 32 * nb;
    float tv[32];
#pragma unroll
    for (int i = 0; i < 32; ++i) tv[i] = W[(size_t)(k0 + 2 * i + (lane >> 5)) * ldw + n0 + (lane & 31)];
#pragma unroll
    for (int i = 0; i < 32; ++i) scr[(2 * i + (lane >> 5)) * 33 + (lane & 31)] = tv[i];
    asm volatile("s_waitcnt lgkmcnt(0)" ::: "memory");
    const int c = lane & 7;
#pragma unroll
    for (int j = 0; j < 4; ++j) { const int n = (lane >> 3) + 8 * j; const LAS float* s = scr + (8 * c) * 33 + n;
        v4u o; o.x = pk2(s[0 * 33], s[1 * 33]); o.y = pk2(s[2 * 33], s[3 * 33]); o.z = pk2(s[4 * 33], s[5 * 33]); o.w = pk2(s[6 * 33], s[7 * 33]);
        *(v4u*)(WT + (size_t)(row_off + n0 + n) * ldt + k0 + 8 * c) = o; }
    asm volatile("s_waitcnt lgkmcnt(0)" ::: "memory");
}
__device__ __forceinline__ void transpose_item_f8(const float* W, int ldw, int ncols, int K, unsigned char* WT, int row_off, LAS float* scr, int item, int lane) {
    const int nblk = ncols / 32, kb = item / nblk, nb = item % nblk, k0 = 64 * kb, n0 = 32 * nb;
    float tv[32];
#pragma unroll
    for (int i = 0; i < 32; ++i) tv[i] = W[(size_t)(k0 + 2 * i + (lane >> 5)) * ldw + n0 + (lane & 31)];
#pragma unroll
    for (int i = 0; i < 32; ++i) scr[(2 * i + (lane >> 5)) * 33 + (lane & 31)] = tv[i] * F8_WS;
    asm volatile("s_waitcnt lgkmcnt(0)" ::: "memory");
    const int c = lane & 7;
#pragma unroll
    for (int j = 0; j < 4; ++j) { const int n = (lane >> 3) + 8 * j; const LAS float* s = scr + (8 * c) * 33 + n;
        v2u o; o.x = pk4_f8(s[0 * 33], s[1 * 33], s[2 * 33], s[3 * 33]); o.y = pk4_f8(s[4 * 33], s[5 * 33], s[6 * 33], s[7 * 33]);
        *(v2u*)(WT + (size_t)(row_off + n0 + n) * K + k0 + 8 * c) = o; }
    asm volatile("s_waitcnt lgkmcnt(0)" ::: "memory");
}
__device__ __forceinline__ void ph0_weights(const Args& a, LAS unsigned char* lds) {
    const int tid = phase_tid(), lane = tid & 63, wave = __builtin_amdgcn_readfirstlane(tid >> 6);
    LAS float* scr = (LAS float*)(lds + wave * 16384);
    const int gw = blockIdx.x * NWAVES + wave, NGW = gridDim.x * NWAVES;
    const float* w_in = a.in[5];
    unsigned char* WIN = a.ws + WS_WIN;
    constexpr int I_Q = 32 * (NQ / 32), I_KV = 32 * (NKV / 32), I_DL = 32 * (NDL / 32), I_MG = 32 * (NMG / 32);
    constexpr int I_BN = 16 * 64, I_BD = 8 * 64, I_O = 32 * 64, I_PQ = 32 * 64;
    constexpr int NITEMS = I_Q + I_KV + I_DL + I_MG + I_BN + I_BD + I_O + I_PQ;
    for (int it = gw; it < NITEMS; it += NGW) {
        int r = it;
        if (r < I_Q)  { transpose_item_f8(w_in, IN_COLS, NQ, D, WIN, 0, scr, r, lane); continue; } r -= I_Q;
        if (r < I_KV) { transpose_item_f8(w_in + OFF_KV, IN_COLS, NKV, D, WIN, NQ, scr, r, lane); continue; } r -= I_KV;
        if (r < I_DL) { transpose_item_f8(w_in + OFF_DIL, IN_COLS, NDL, D, WIN, NQ + NKV, scr, r, lane); continue; } r -= I_DL;
        if (r < I_MG) { transpose_item_f8(w_in + OFF_MERGE, IN_COLS, NMG, D, WIN, NQ + NKV + NDL, scr, r, lane); continue; } r -= I_MG;
        if (r < I_BN) { transpose_item(a.in[13], D, D, 1024, (bf16*)(a.ws + WS_WBN), 0, scr, r, lane, 1536); continue; } r -= I_BN;
        if (r < I_BD) { transpose_item(a.in[14], D, D, 512, (bf16*)(a.ws + WS_WBN) + 1024, 0, scr, r, lane, 1536); continue; } r -= I_BD;
        if (r < I_O)  { transpose_item(a.in[15], D, D, D, (bf16*)(a.ws + WS_WOUT), 0, scr, r, lane); continue; } r -= I_O;
        transpose_item(a.in[17], D, D, D, (bf16*)(a.ws + WS_WPQ), 0, scr, r, lane);
    }
}

constexpr size_t WS_CW1F = 602 * MiB;
constexpr size_t WS_WGF = 604 * MiB;
constexpr size_t WS_CBP = 604 * MiB + 256 * 1024;
constexpr size_t WS_END4 = 605 * MiB;
__device__ __forceinline__ void ph0_extra(const Args& a) {
    const int tid = phase_tid(), lane = tid & 63, wave = __builtin_amdgcn_readfirstlane(tid >> 6);
    const float* w1 = a.in[9]; const float* pos = a.in[8]; const float* w_in = a.in[5];
    v4u* CW = (v4u*)(a.ws + WS_CW1F); v4u* WG = (v4u*)(a.ws + WS_WGF); float* CBP = (float*)(a.ws + WS_CBP);
    for (int i = blockIdx.x * NTHREADS + tid; i < 2 * 4 * 256 * 64; i += gridDim.x * NTHREADS) {
        const int ln = i & 63, ks = (i >> 6) & 255, nt = (i >> 14) & 3, j = i >> 16;
        const float* src = w1 + ((size_t)j * 4096 + 16 * ks + 8 * (ln >> 5)) * 128 + 32 * nt + (ln & 31);
        v4u o; o.x = pk2(src[0], src[128]); o.y = pk2(src[256], src[384]); o.z = pk2(src[512], src[640]); o.w = pk2(src[768], src[896]);
        CW[i] = o;
    }
    for (int i = blockIdx.x * NTHREADS + tid; i < 128 * 64; i += gridDim.x * NTHREADS) {
        const int ln = i & 63, ks = i >> 6, jrow = ln & 31;
        v4u o = {0u, 0u, 0u, 0u};
        if (jrow < 24) { const float* src = w_in + (size_t)(16 * ks + 8 * (ln >> 5)) * IN_COLS + OFF_GATE + jrow;
            o.x = pk2(src[0], src[IN_COLS]); o.y = pk2(src[2 * (size_t)IN_COLS], src[3 * (size_t)IN_COLS]); o.z = pk2(src[4 * (size_t)IN_COLS], src[5 * (size_t)IN_COLS]); o.w = pk2(src[6 * (size_t)IN_COLS], src[7 * (size_t)IN_COLS]); }
        WG[i] = o;
    }
    { const int gw = blockIdx.x * NWAVES + wave;
      if (gw < 128) { const int kc = gw >> 1, j = gw & 1; float s0 = 0.f, s1 = 0.f; const float* wp = w1 + ((size_t)j * 4096 + 64 * kc) * 128 + lane; const float* pp = pos + j * 4096 + 64 * kc;
#pragma unroll 1
          for (int k0 = 0; k0 < 64; k0 += 16) { float wa[16], wb[16];
#pragma unroll
              for (int k = 0; k < 16; ++k) { wa[k] = wp[(k0 + k) * 128]; wb[k] = wp[(k0 + k) * 128 + 64]; }
#pragma unroll
              for (int k = 0; k < 16; ++k) { const float pv = pp[k0 + k]; s0 += pv * wa[k]; s1 += pv * wb[k]; } }
          CBP[(kc * 2 + j) * 128 + lane] = s0; CBP[(kc * 2 + j) * 128 + 64 + lane] = s1; } }
}

template <bool F8 = false>
__device__ __forceinline__ void ph_norm(const Args& a, const float* xin, const float* gvec, int sh_off, int sc_off, bf16* hout, unsigned char* h8 = nullptr) {
    const int tid = phase_tid(), lane = tid & 63, wave = __builtin_amdgcn_readfirstlane(tid >> 6);
    const int gw = blockIdx.x * NWAVES + wave, NGW = gridDim.x * NWAVES;
    const float* mod = (const float*)(a.ws + WS_MOD);
    for (int r = gw; r < S / 2; r += NGW)
#pragma unroll 1
        for (int bq = 0; bq < NB; ++bq) {
            const int m0 = bq * S + r, m1 = m0 + S / 2;
            const float* x0 = xin + (size_t)m0 * D + 8 * lane; const float* x1 = xin + (size_t)m1 * D + 8 * lane;
            f32x4 v0[8], v1[8];
#pragma unroll
            for (int c = 0; c < 4; ++c) { v0[2 * c] = *(const f32x4*)(x0 + 512 * c); v0[2 * c + 1] = *(const f32x4*)(x0 + 512 * c + 4); v1[2 * c] = *(const f32x4*)(x1 + 512 * c); v1[2 * c + 1] = *(const f32x4*)(x1 + 512 * c + 4); }
            float s0 = 0.f, s1 = 0.f;
#pragma unroll
            for (int i = 0; i < 8; ++i) { s0 += (v0[i].x * v0[i].x + v0[i].y * v0[i].y) + (v0[i].z * v0[i].z + v0[i].w * v0[i].w); s1 += (v1[i].x * v1[i].x + v1[i].y * v1[i].y) + (v1[i].z * v1[i].z + v1[i].w * v1[i].w); }
            const float r0 = rsqrtf(wave_sum(s0) * (1.f / D) + EPS), r1 = rsqrtf(wave_sum(s1) * (1.f / D) + EPS);
            const float* shp = mod + bq * 12288 + sh_off + 8 * lane; const float* scp = mod + bq * 12288 + sc_off + 8 * lane; const float* gp = gvec + 8 * lane;
#pragma unroll
            for (int c = 0; c < 4; ++c) {
                v4u o0, o1; unsigned w0[4], w1[4]; [[maybe_unused]] unsigned q0[2], q1[2];
#pragma unroll
                for (int hq = 0; hq < 2; ++hq) { const f32x4 g = *(const f32x4*)(gp + 512 * c + 4 * hq), sc = *(const f32x4*)(scp + 512 * c + 4 * hq), sh = *(const f32x4*)(shp + 512 * c + 4 * hq);
                    const f32x4 ga = g * (1.f + sc); const f32x4 y0 = v0[2 * c + hq] * r0 * ga + sh, y1 = v1[2 * c + hq] * r1 * ga + sh;
                    w0[2 * hq] = pk2(y0.x, y0.y); w0[2 * hq + 1] = pk2(y0.z, y0.w); w1[2 * hq] = pk2(y1.x, y1.y); w1[2 * hq + 1] = pk2(y1.z, y1.w);
                    if constexpr (F8) { q0[hq] = pk4_f8(y0.x * F8_HS, y0.y * F8_HS, y0.z * F8_HS, y0.w * F8_HS); q1[hq] = pk4_f8(y1.x * F8_HS, y1.y * F8_HS, y1.z * F8_HS, y1.w * F8_HS); } }
                o0.x = w0[0]; o0.y = w0[1]; o0.z = w0[2]; o0.w = w0[3]; o1.x = w1[0]; o1.y = w1[1]; o1.z = w1[2]; o1.w = w1[3];
                *(v4u*)(hout + (size_t)m0 * D + 512 * c + 8 * lane) = o0; *(v4u*)(hout + (size_t)m1 * D + 512 * c + 8 * lane) = o1;
                if constexpr (F8) { v2u p0, p1; p0.x = q0[0]; p0.y = q0[1]; p1.x = q1[0]; p1.y = q1[1];
                    *(v2u*)(h8 + (size_t)m0 * D + 512 * c + 8 * lane) = p0; *(v2u*)(h8 + (size_t)m1 * D + 512 * c + 8 * lane) = p1; }
            }
        }
}

using pg8::Unit; using pg8::HALF; using pg8::BM;
struct EpiProj {
    static constexpr bool PERM = true;
    bf16 *q, *kv, *dl, *mg;
    __device__ __forceinline__ void operator()(const f32x4 (&acc)[2][2][4][2], const Unit& u, int wr, int wc, int fr, int fq) const {
        bf16* base; int ldc, colt = u.pn * BM;
        if (colt < NQ) { base = q; ldc = NQ; } else if (colt < NQ + NKV) { base = kv; ldc = NKV; colt -= NQ; } else if (colt < NQ + NKV + NDL) { base = dl; ldc = NDL; colt -= NQ + NKV; } else { base = mg; ldc = NMG; colt -= NQ + NKV + NDL; }
        const int row0 = u.pm * BM + wr * 64 + fr, col0 = colt + wc * 32 + 8 * fq;
#pragma unroll
        for (int ai = 0; ai < 2; ++ai)
#pragma unroll
            for (int m = 0; m < 4; ++m) { bf16* rowp = base + (size_t)(row0 + ai * HALF + m * 16) * ldc + col0;
#pragma unroll
                for (int bj = 0; bj < 2; ++bj) { const f32x4 v0 = acc[ai][bj][m][0], v1 = acc[ai][bj][m][1];
                    v4u w; w.x = pg8::cvt_pk_bf16(v0[0], v0[1]); w.y = pg8::cvt_pk_bf16(v0[2], v0[3]); w.z = pg8::cvt_pk_bf16(v1[0], v1[1]); w.w = pg8::cvt_pk_bf16(v1[2], v1[3]);
                    *(v4u*)(rowp + bj * HALF) = w; } }
    }
};
struct MidMerge {
    static constexpr int AT = 16;
    const bf16* mg;
    __device__ __forceinline__ void operator()(f32x4 (&acc)[2][2][4][2], const Unit& u, int wr, int wc, int fr, int fq) const {
        int row0 = u.pm * BM + wr * 64 + fr; const int col0 = u.pn * BM + wc * 32 + 8 * fq;
        asm volatile("" : "+v"(row0));
#pragma unroll
        for (int ai = 0; ai < 2; ++ai) {
            v4u a1[4][2], a2[4][2];
#pragma unroll
            for (int m = 0; m < 4; ++m) { const bf16* rp = mg + (size_t)(row0 + ai * HALF + m * 16) * NMG + col0;
#pragma unroll
                for (int bj = 0; bj < 2; ++bj) { a1[m][bj] = *(const v4u*)(rp + bj * HALF); a2[m][bj] = *(const v4u*)(rp + 2048 + bj * HALF); } }
#pragma unroll
            for (int m = 0; m < 4; ++m)
#pragma unroll
                for (int bj = 0; bj < 2; ++bj) { const unsigned w1[4] = {a1[m][bj].x, a1[m][bj].y, a1[m][bj].z, a1[m][bj].w}, w2[4] = {a2[m][bj].x, a2[m][bj].y, a2[m][bj].z, a2[m][bj].w};
#pragma unroll
                    for (int q = 0; q < 4; ++q) { const float r0 = (1.f + __expf(-bflo(w2[q]))) * __builtin_amdgcn_rcpf(1.f + __expf(-bflo(w1[q]))), r1 = (1.f + __expf(-bfhi(w2[q]))) * __builtin_amdgcn_rcpf(1.f + __expf(-bfhi(w1[q])));
                        acc[ai][bj][m][q >> 1][2 * (q & 1)] *= r0; acc[ai][bj][m][q >> 1][2 * (q & 1) + 1] *= r1; } }
            asm volatile("" ::: "memory");
        }
    }
};
struct EpiMerge {
    static constexpr bool PERM = true;
    const bf16* mg; bf16* merged;
    __device__ __forceinline__ void operator()(const f32x4 (&acc)[2][2][4][2], const Unit& u, int wr, int wc, int fr, int fq) const {
        int row0 = u.pm * BM + wr * 64 + fr; const int col0 = u.pn * BM + wc * 32 + 8 * fq;
        asm volatile("" : "+v"(row0));
        v4u a2[2][4][2];
#pragma unroll
        for (int ai = 0; ai < 2; ++ai)
#pragma unroll
            for (int m = 0; m < 4; ++m)
#pragma unroll
                for (int bj = 0; bj < 2; ++bj) a2[ai][m][bj] = *(const v4u*)(mg + (size_t)(row0 + ai * HALF + m * 16) * NMG + 2048 + col0 + bj * HALF);
#pragma unroll
        for (int ai = 0; ai < 2; ++ai)
#pragma unroll
            for (int m = 0; m < 4; ++m) { const size_t row = (size_t)(row0 + ai * HALF + m * 16);
#pragma unroll
                for (int bj = 0; bj < 2; ++bj) { const unsigned w2[4] = {a2[ai][m][bj].x, a2[ai][m][bj].y, a2[ai][m][bj].z, a2[ai][m][bj].w};
                    const f32x4 v0 = acc[ai][bj][m][0], v1 = acc[ai][bj][m][1];
                    v4u w; w.x = pg8::cvt_pk_bf16(v0[0] * sigmoidf(bflo(w2[0])), v0[1] * sigmoidf(bfhi(w2[0]))); w.y = pg8::cvt_pk_bf16(v0[2] * sigmoidf(bflo(w2[1])), v0[3] * sigmoidf(bfhi(w2[1])));
                    w.z = pg8::cvt_pk_bf16(v1[0] * sigmoidf(bflo(w2[2])), v1[1] * sigmoidf(bfhi(w2[2]))); w.w = pg8::cvt_pk_bf16(v1[2] * sigmoidf(bflo(w2[3])), v1[3] * sigmoidf(bfhi(w2[3])));
                    *(v4u*)(merged + row * D + col0 + bj * HALF) = w; } }
    }
};
struct EpiOut {
    static constexpr bool PERM = false;
    const float* x; const float* mod; float* x1;
    __device__ __forceinline__ void operator()(const f32x4 (&acc)[2][2][4][2], const Unit& u, int wr, int wc, int fr, int fq) const {
        const int row0 = u.pm * BM + wr * 64 + fr, col0 = u.pn * BM + wc * 32 + 4 * fq;
        const int b = (u.pm * BM) / S;
        f32x4 gv[2][2];
#pragma unroll
        for (int bj = 0; bj < 2; ++bj)
#pragma unroll
            for (int n = 0; n < 2; ++n) gv[bj][n] = *(const f32x4*)(mod + b * 12288 + 4096 + col0 + bj * HALF + n * 16);
#pragma unroll
        for (int ai = 0; ai < 2; ++ai)
#pragma unroll
            for (int m = 0; m < 4; ++m) { const size_t off = (size_t)(row0 + ai * HALF + m * 16) * D + col0;
#pragma unroll
                for (int bj = 0; bj < 2; ++bj)
#pragma unroll
                    for (int n = 0; n < 2; ++n) *(f32x4*)(x1 + off + bj * HALF + n * 16) = *(const f32x4*)(x + off + bj * HALF + n * 16) + gv[bj][n] * acc[ai][bj][m][n]; }
    }
};
struct EpiF32 {
    static constexpr bool PERM = false;
    float* C; int ldc;
    __device__ __forceinline__ void operator()(const f32x4 (&acc)[2][2][4][2], const Unit& u, int wr, int wc, int fr, int fq) const {
        const int row0 = u.pm * BM + wr * 64 + fr, col0 = u.pn * BM + wc * 32 + 4 * fq;
#pragma unroll
        for (int ai = 0; ai < 2; ++ai)
#pragma unroll
            for (int m = 0; m < 4; ++m) { float* rowp = C + (size_t)(row0 + ai * HALF + m * 16) * ldc + col0;
#pragma unroll
                for (int bj = 0; bj < 2; ++bj)
#pragma unroll
                    for (int n = 0; n < 2; ++n) *(f32x4*)(rowp + bj * HALF + n * 16) = acc[ai][bj][m][n]; }
    }
};

typedef short bf16x8 __attribute__((ext_vector_type(8)));
typedef float f32x16 __attribute__((ext_vector_type(16)));
typedef float f32x2 __attribute__((ext_vector_type(2)));
typedef __bf16 bf2v __attribute__((ext_vector_type(2)));
constexpr float LOG2E = 1.4426950408889634f;
constexpr float QS2 = QSCALE * LOG2E;
constexpr float NEGB = -1e30f;
__device__ __forceinline__ unsigned pkbf(float a, float b) { const f32x2 v = {a, b}; const bf2v r = __builtin_convertvector(v, bf2v); return __builtin_bit_cast(unsigned, r); }
__device__ __forceinline__ float ex2(float x) { return __builtin_amdgcn_exp2f(x); }
__device__ __forceinline__ int swap23(int x) { return (x & ~12) | ((x & 4) << 1) | ((x & 8) >> 1); }
__device__ __forceinline__ size_t kf_off(int key, int d) { return ((size_t)((key >> 5) * 8 + (d >> 4)) * 64 + ((d >> 3) & 1) * 32 + swap23(key & 31)) * 8 + (d & 7); }
__device__ __forceinline__ size_t vf_off(int key, int d) { const int kk = key & 31; return ((size_t)(((key >> 5) * 4 + (d >> 5)) * 2 + (kk >> 4)) * 64 + ((kk >> 3) & 1) * 32 + (d & 31)) * 8 + (kk & 7); }
__device__ __forceinline__ bf16* fr_nsa(const Args& a, int bg, int kind) { return (bf16*)a.out + ((size_t)(bg * 4 + kind) << 19); }
__device__ __forceinline__ bf16* fr_dil(const Args& a, int b, int head, int kv) { return (bf16*)a.out + ((size_t)16 << 20) + ((size_t)((b * 12 + head) * 2 + kv) << 19); }
constexpr size_t WS_OD = 552 * MiB;
constexpr size_t WS_LSE = 600 * MiB;
constexpr size_t WS_END2 = 601 * MiB;

struct EpiProjNorm {
    static constexpr bool PERM = true;
    bf16 *q, *kv, *dl, *mg, *frg;
    const float *qg, *kg, *dqg, *dkg;
    LAS float* xch;
    float as;
    __device__ __forceinline__ void operator()(const f32x4 (&acc)[2][2][4][2], const Unit& u, int wr, int wc, int fr, int fq) const {
        bf16* base; int ldc, colt = u.pn * BM, mode = 0  , hsel = 0; const float* gain = qg; float scale = 1.f;
        if (colt < NQ) { base = q; ldc = NQ; mode = 1; gain = qg; scale = QS2; }
        else if (colt < NQ + NKV) { base = kv; ldc = NKV; colt -= NQ; hsel = colt >> 7; if (hsel == 4 || hsel == 8) { mode = 2; gain = kg + (hsel == 4 ? 128 : 256); } }
        else if (colt < NQ + NKV + NDL) { base = dl; ldc = NDL; colt -= NQ + NKV; hsel = colt >> 7; if (hsel < 12) { mode = 1; gain = dqg; scale = QS2; } else if (hsel < 24) { mode = 3; gain = dkg; } }
        else { base = mg; ldc = NMG; colt -= NQ + NKV + NDL; }
        const int row0 = u.pm * BM + wr * 64 + fr, col0 = colt + wc * 32 + 8 * fq;
        if (mode == 0) {
#pragma unroll
            for (int ai = 0; ai < 2; ++ai)
#pragma unroll
                for (int m = 0; m < 4; ++m) { bf16* rowp = base + (size_t)(row0 + ai * HALF + m * 16) * ldc + col0;
#pragma unroll
                    for (int bj = 0; bj < 2; ++bj) { const f32x4 v0 = acc[ai][bj][m][0] * as, v1 = acc[ai][bj][m][1] * as;
                        v4u w; w.x = pg8::cvt_pk_bf16(v0[0], v0[1]); w.y = pg8::cvt_pk_bf16(v0[2], v0[3]); w.z = pg8::cvt_pk_bf16(v1[0], v1[1]); w.w = pg8::cvt_pk_bf16(v1[2], v1[3]);
                        *(v4u*)(rowp + bj * HALF) = w; } }
            return;
        }
#pragma unroll
        for (int ai = 0; ai < 2; ++ai)
#pragma unroll
            for (int m = 0; m < 4; ++m)
#pragma unroll
                for (int bj = 0; bj < 2; ++bj) { const f32x4 v0 = acc[ai][bj][m][0], v1 = acc[ai][bj][m][1];
                    float ss = (v0[0] * v0[0] + v0[1] * v0[1]) + (v0[2] * v0[2] + v0[3] * v0[3]) + (v1[0] * v1[0] + v1[1] * v1[1]) + (v1[2] * v1[2] + v1[3] * v1[3]);
                    ss += __shfl_xor(ss, 16); ss += __shfl_xor(ss, 32);
                    if (fq == 0) xch[(((((wr * 2 + ai) * 4 + m) * 16 + fr) * 2 + bj) << 2) + wc] = ss; }
        asm volatile("s_waitcnt lgkmcnt(0)" ::: "memory");
        __builtin_amdgcn_s_barrier();
        asm volatile("" ::: "memory");
        const f32x4 ga = *(const f32x4*)(gain + wc * 32 + 8 * fq), gb = *(const f32x4*)(gain + wc * 32 + 8 * fq + 4);
#pragma unroll
        for (int ai = 0; ai < 2; ++ai)
#pragma unroll
            for (int m = 0; m < 4; ++m) { const int t = row0 + ai * HALF + m * 16, b = t / S, s = t % S;
#pragma unroll
                for (int bj = 0; bj < 2; ++bj) { const f32x4 pp = *(const LAS f32x4*)(xch + (((((wr * 2 + ai) * 4 + m) * 16 + fr) * 2 + bj) << 2));
                    const float rstd = rsqrtf(((pp.x + pp.y) + (pp.z + pp.w)) * (as * as * (1.f / 128.f)) + EPS) * (scale * as);
                    const f32x4 v0 = acc[ai][bj][m][0] * rstd * ga, v1 = acc[ai][bj][m][1] * rstd * gb;
                    v4u w; w.x = pg8::cvt_pk_bf16(v0[0], v0[1]); w.y = pg8::cvt_pk_bf16(v0[2], v0[3]); w.z = pg8::cvt_pk_bf16(v1[0], v1[1]); w.w = pg8::cvt_pk_bf16(v1[2], v1[3]);
                    bf16* dst;
                    if (mode == 1) dst = base + (size_t)t * ldc + col0 + bj * HALF;
                    else if (mode == 2) dst = frg + ((size_t)((b * 2 + bj) * 4 + (hsel == 4 ? 0 : 2)) << 19) + kf_off(s, wc * 32 + 8 * fq);
                    else { const int head = hsel - 12 + bj, dsh = 2 * (head >> 2), vk = ((s & ((1 << dsh) - 1)) << (12 - dsh)) + (s >> dsh);
                        dst = frg + ((size_t)16 << 20) + ((size_t)((b * 12 + head) * 2) << 19) + kf_off(vk, wc * 32 + 8 * fq); }
                    *(v4u*)dst = w; } }
    }
};

__device__ __forceinline__ v4u norm_chunk16v(v4u w, const float* gain, float scale, int li) {
    float v[8] = {bflo(w.x), bfhi(w.x), bflo(w.y), bfhi(w.y), bflo(w.z), bfhi(w.z), bflo(w.w), bfhi(w.w)};
    float ss = 0.f;
#pragma unroll
    for (int j = 0; j < 8; ++j) ss += v[j] * v[j];
    ss += __shfl_xor(ss, 1); ss += __shfl_xor(ss, 2); ss += __shfl_xor(ss, 4); ss += __shfl_xor(ss, 8);
    const float rstd = rsqrtf(ss * (1.f / 128.f) + EPS) * scale;
#pragma unroll
    for (int j = 0; j < 8; ++j) v[j] = v[j] * rstd * gain[8 * li + j];
    w.x = pk2(v[0], v[1]); w.y = pk2(v[2], v[3]); w.z = pk2(v[4], v[5]); w.w = pk2(v[6], v[7]);
    return w;
}
__device__ __forceinline__ void ph3_headnorm(const Args& a) {
    const int tid = phase_tid(), lane = tid & 63, wave = __builtin_amdgcn_readfirstlane(tid >> 6), sub = lane >> 4, li = lane & 15;
    const int gw = blockIdx.x * NWAVES + wave, NGW = gridDim.x * NWAVES;
    bf16* Q = (bf16*)(a.ws + WS_Q); const bf16* KV = (const bf16*)(a.ws + WS_KV); bf16* DL = (bf16*)(a.ws + WS_DL);
    const float* qg = a.in[6]; const float* kg = a.in[7]; const float* dqg = a.in[11]; const float* dkg = a.in[12];
    for (int m = gw; m < T; m += NGW) {
        const int b = m / S, s = m % S;
        const int g = sub & 1, win = sub >> 1;
        v4u wq[2], wk, wd[6];
#pragma unroll
        for (int it = 0; it < 2; ++it) wq[it] = *(const v4u*)(Q + (size_t)m * NQ + (it * 4 + sub) * 128 + 8 * li);
        wk = *(const v4u*)(KV + (size_t)m * NKV + ((win ? 8 : 4) + g) * 128 + 8 * li);
#pragma unroll
        for (int it = 0; it < 6; ++it) wd[it] = *(const v4u*)(DL + (size_t)m * NDL + (it * 4 + sub) * 128 + 8 * li);
#pragma unroll
        for (int it = 0; it < 2; ++it) *(v4u*)(Q + (size_t)m * NQ + (it * 4 + sub) * 128 + 8 * li) = norm_chunk16v(wq[it], qg, QS2, li);
        *(v4u*)(fr_nsa(a, b * 2 + g, win ? 2 : 0) + kf_off(s, 8 * li)) = norm_chunk16v(wk, kg + (win ? 256 : 128), 1.f, li);
#pragma unroll
        for (int it = 0; it < 6; ++it) { const int ch = it * 4 + sub;
            if (ch < 12) *(v4u*)(DL + (size_t)m * NDL + ch * 128 + 8 * li) = norm_chunk16v(wd[it], dqg, QS2, li);
            else { const int head = ch - 12, gi = head >> 2, dsh = 2 * gi  , vk = ((s & ((1 << dsh) - 1)) << (12 - dsh)) + (s >> dsh);
                *(v4u*)(fr_dil(a, b, head, 0) + kf_off(vk, 8 * li)) = norm_chunk16v(wd[it], dkg, 1.f, li); } }
    }
}
__device__ __forceinline__ void ph3_vfrag(const Args& a) {
    const int tid = phase_tid(), lane = tid & 63, wave = __builtin_amdgcn_readfirstlane(tid >> 6);
    const int gw = blockIdx.x * NWAVES + wave, NGW = gridDim.x * NWAVES;
    const bf16* KV = (const bf16*)(a.ws + WS_KV); const bf16* DL = (const bf16*)(a.ws + WS_DL);
    for (int job = gw; job < 32768; job += NGW) {
        const bf16* src; size_t rstride; bf16* dst; int key0;
        if (job < 8192) { const int bg = job >> 10, kind = (job >> 9) & 1, s0 = (job & 511) * 8, b = bg >> 1, g = bg & 1;
            src = KV + (size_t)(b * S + s0) * NKV + ((kind ? 10 : 6) + g) * 128; rstride = NKV; dst = fr_nsa(a, bg, kind ? 3 : 1); key0 = s0; }
        else { const int j2 = job - 8192, bh = j2 >> 9, vk0 = (j2 & 511) * 8, b = bh / 12, head = bh % 12, gi = head >> 2, dsh = 2 * gi, L = S >> dsh, r = vk0 / L, m0 = vk0 % L;
            src = DL + (size_t)(b * S + (m0 << dsh) + r) * NDL + (24 + head) * 128; rstride = (size_t)NDL << dsh; dst = fr_dil(a, b, head, 1); key0 = vk0; }
        unsigned w[8];
#pragma unroll
        for (int jj = 0; jj < 8; ++jj) w[jj] = *(const unsigned*)(src + jj * rstride + 2 * lane);
        v4u c0, c1;
        c0.x = (w[0] & 0xffffu) | (w[1] << 16); c0.y = (w[2] & 0xffffu) | (w[3] << 16); c0.z = (w[4] & 0xffffu) | (w[5] << 16); c0.w = (w[6] & 0xffffu) | (w[7] << 16);
        c1.x = (w[0] >> 16) | (w[1] & 0xffff0000u); c1.y = (w[2] >> 16) | (w[3] & 0xffff0000u); c1.z = (w[4] >> 16) | (w[5] & 0xffff0000u); c1.w = (w[6] >> 16) | (w[7] & 0xffff0000u);
        *(v4u*)(dst + vf_off(key0, 2 * lane)) = c0; *(v4u*)(dst + vf_off(key0, 2 * lane + 1)) = c1;
    }
}
__device__ __forceinline__ void ph3_gates(const Args& a) {
    const int tid = phase_tid(), lane = tid & 63, wave = __builtin_amdgcn_readfirstlane(tid >> 6), tl = lane & 31, hh = lane >> 5;
    const int gw = (gridDim.x - 1 - blockIdx.x) * NWAVES + wave, NGW = gridDim.x * NWAVES;
    const bf16* H = (const bf16*)(a.ws + WS_H); const v4u* WG = (const v4u*)(a.ws + WS_WGF) + lane; float* gates = (float*)(a.ws + WS_GATES);
    for (int job = gw; job < T / 32; job += NGW) {
        const int t = job * 32 + tl; const bf16* hr = H + (size_t)t * D + 8 * hh;
        f32x16 acc;
#pragma unroll
        for (int i = 0; i < 16; ++i) acc[i] = 0.f;
#pragma unroll 4
        for (int ks = 0; ks < 128; ++ks) { const bf16x8 af = __builtin_bit_cast(bf16x8, WG[ks * 64]), bfr = __builtin_bit_cast(bf16x8, *(const v4u*)(hr + 16 * ks));
            acc = __builtin_amdgcn_mfma_f32_32x32x16_bf16(af, bfr, acc, 0, 0, 0); }
#pragma unroll
        for (int i = 0; i < 16; ++i) { const int j = (i & 3) + 8 * (i >> 2) + 4 * hh; const float v = acc[i]; if (j < 24) gates[(size_t)t * 24 + j] = sigmoidf(v); }
    }
}
__device__ __forceinline__ void ph3_compress(const Args& a, LAS unsigned char* lds) {
    const int tid = phase_tid(), lane = tid & 63, wave = __builtin_amdgcn_readfirstlane(tid >> 6), cl = lane & 31, hh = lane >> 5;
    LAS float* part = (LAS float*)lds;
    LAS float* hid = part + 2 * 128 * 32;
    LAS float* ob = hid + 32 * 128;
    LAS float* bias = ob + 32 * 128;
    const bf16* KV = (const bf16*)(a.ws + WS_KV);
    const float* w2 = a.in[10]; const float* kg0 = a.in[7]; const float* CBP = (const float*)(a.ws + WS_CBP);
    for (int u = blockIdx.x; u < 128; u += gridDim.x) {
        const int j = u >> 6, bg = (u >> 3) & 7, ct = u & 7, b = bg >> 1, g = bg & 1, c0 = 32 * ct, hhd = j * 2 + g;
        if (tid < 128) { float s = 0.f;
#pragma unroll
            for (int kc = 0; kc < 64; ++kc) s += CBP[(kc * 2 + j) * 128 + tid];
            bias[tid] = s; }
        { const int nt = wave & 3, kh = wave >> 2, c = c0 + cl;
          const v4u* af = (const v4u*)(a.ws + WS_CW1F) + ((size_t)(j * 4 + nt) * 256 + 128 * kh) * 64 + lane;
          f32x16 acc;
#pragma unroll
          for (int i = 0; i < 16; ++i) acc[i] = 0.f;
#pragma unroll 4
          for (int ks = 0; ks < 128; ++ks) { const int k = 16 * (128 * kh + ks) + 8 * hh, l = k >> 7, d = k & 127, p = 16 * c + l;
              v4u x = {0u, 0u, 0u, 0u}; if (p < S) x = *(const v4u*)(KV + (size_t)(b * S + p) * NKV + hhd * 128 + d);
              acc = __builtin_amdgcn_mfma_f32_32x32x16_bf16(__builtin_bit_cast(bf16x8, af[ks * 64]), __builtin_bit_cast(bf16x8, x), acc, 0, 0, 0); }
#pragma unroll
          for (int i = 0; i < 16; ++i) { const int n = 32 * nt + (i & 3) + 8 * (i >> 2) + 4 * hh; const float v = acc[i]; part[(kh * 128 + n) * 32 + cl] = v; } }
        __syncthreads();
        for (int i = tid; i < 128 * 32; i += NTHREADS) { const int n = i >> 5, c = i & 31; hid[c * 128 + n] = gelu_tanh(part[i] + part[128 * 32 + i] + bias[n]); }
        __syncthreads();
        { const int n = tid & 127, cq = tid >> 7; float o[8];
#pragma unroll
          for (int r = 0; r < 8; ++r) o[r] = 0.f;
          const float* w2p = w2 + j * 128 * 128 + n;
          for (int k = 0; k < 128; ++k) { const float w = w2p[k * 128];
#pragma unroll
              for (int r = 0; r < 8; ++r) o[r] += hid[(8 * cq + r) * 128 + k] * w; }
#pragma unroll
          for (int r = 0; r < 8; ++r) ob[(8 * cq + r) * 128 + n] = o[r]; }
        __syncthreads();
        bf16* fr = (bf16*)(a.ws + (j == 0 ? WS_KC : WS_VC)) + (size_t)bg * 8 * 4096;
#pragma unroll 1
        for (int r = 0; r < 4; ++r) { const int cr = 4 * wave + r, c = c0 + cr; float v0 = ob[cr * 128 + 2 * lane], v1 = ob[cr * 128 + 2 * lane + 1];
            if (j == 0) { const float rstd = rsqrtf(wave_sum(v0 * v0 + v1 * v1) * (1.f / 128.f) + EPS); v0 = v0 * rstd * kg0[2 * lane]; v1 = v1 * rstd * kg0[2 * lane + 1]; }
            if (c >= NC) { v0 = 0.f; v1 = 0.f; }
            if (j == 0) *(unsigned*)(fr + kf_off(c, 2 * lane)) = pk2(v0, v1);
            else { fr[vf_off(c, 2 * lane)] = (bf16)f2bf(v0); fr[vf_off(c, 2 * lane + 1)] = (bf16)f2bf(v1); } }
        __syncthreads();
    }
}

#define KBI(i) (16 * ((i) >> 3) + ((i) & 7))
__device__ __forceinline__ void load_frags(bf16x8 (&f)[8], const v4u* p, int lane) {
#pragma unroll
    for (int i = 0; i < 8; ++i) f[i] = __builtin_bit_cast(bf16x8, p[i * 64 + lane]);
}
__device__ __forceinline__ f32x16 qk_mma(const bf16x8 (&qf)[8], const bf16x8 (&k)[8]) {
    f32x16 s;
#pragma unroll
    for (int i = 0; i < 16; ++i) s[i] = 0.f;
#pragma unroll
    for (int st = 0; st < 8; ++st) s = __builtin_amdgcn_mfma_f32_32x32x16_bf16(k[st], qf[st], s, 0, 0, 0);
    return s;
}
__device__ __forceinline__ f32x16 qk_tile(const bf16x8 (&qf)[8], const v4u* kf, int lane) { bf16x8 k[8]; load_frags(k, kf, lane); return qk_mma(qf, k); }
template <int STRIDE> __device__ __forceinline__ void add_tbl(f32x16& s, const LAS float* tp2, float pen) {
#pragma unroll
    for (int i = 0; i < 16; ++i) s[i] += tp2[STRIDE * (23 - KBI(i))] + pen;
}
__device__ __forceinline__ void mask_hi(f32x16& s, int lim) {
#pragma unroll
    for (int i = 0; i < 16; ++i) s[i] = (KBI(i) <= lim) ? s[i] : NEGB;
}
__device__ __forceinline__ void mask_lo(f32x16& s, int lim) {
#pragma unroll
    for (int i = 0; i < 16; ++i) s[i] = (KBI(i) >= lim) ? s[i] : NEGB;
}
__device__ __forceinline__ float max16(const f32x16& s) {
    float mx = fmaxf(s[0], s[1]);
#pragma unroll
    for (int i = 2; i < 16; ++i) mx = fmaxf(mx, s[i]);
    return fmaxf(mx, __shfl_xor(mx, 32));
}
__device__ __forceinline__ void pv_tile(const f32x16& p, f32x16 (&o)[4], const bf16x8 (&v)[8]) {
    v4u a0, a1;
    a0.x = pkbf(p[0], p[1]); a0.y = pkbf(p[2], p[3]); a0.z = pkbf(p[4], p[5]); a0.w = pkbf(p[6], p[7]);
    a1.x = pkbf(p[8], p[9]); a1.y = pkbf(p[10], p[11]); a1.z = pkbf(p[12], p[13]); a1.w = pkbf(p[14], p[15]);
    const bf16x8 pb0 = __builtin_bit_cast(bf16x8, a0), pb1 = __builtin_bit_cast(bf16x8, a1);
#pragma unroll
    for (int dt = 0; dt < 4; ++dt) { o[dt] = __builtin_amdgcn_mfma_f32_32x32x16_bf16(v[2 * dt], pb0, o[dt], 0, 0, 0); o[dt] = __builtin_amdgcn_mfma_f32_32x32x16_bf16(v[2 * dt + 1], pb1, o[dt], 0, 0, 0); }
}
__device__ __forceinline__ void softmax_pv(f32x16& s, f32x16 (&o)[4], float& m, float& l, const v4u* vf, int lane) {
    bf16x8 v[8];
#pragma unroll
    for (int i = 0; i < 8; ++i) v[i] = __builtin_bit_cast(bf16x8, vf[i * 64 + lane]);
    const float mn = fmaxf(m, max16(s));
    if (__ballot(mn > m + 8.f)) {
        const float corr = ex2(m - mn);
#pragma unroll
        for (int dt = 0; dt < 4; ++dt)
#pragma unroll
            for (int i = 0; i < 16; ++i) o[dt][i] *= corr;
        l *= corr; m = mn;
    }
    float ps = 0.f;
#pragma unroll
    for (int i = 0; i < 16; ++i) { s[i] = ex2(s[i] - m); ps += s[i]; }
    l += ps;
    pv_tile(s, o, v);
}
template <int NP = 0> __device__ __forceinline__ void softmax_pv_v(f32x16& s, f32x16 (&o)[4], float& m, float& l, const bf16x8 (&v)[8]) {
    if (NP == 2) { l += s[0]; pv_tile(s, o, v); return; }
    const float mn = fmaxf(m, max16(s));
    if (__ballot(mn > m + 8.f)) {
        const float corr = ex2(m - mn);
#pragma unroll
        for (int dt = 0; dt < 4; ++dt)
#pragma unroll
            for (int i = 0; i < 16; ++i) o[dt][i] *= corr;
        l *= corr; m = mn;
    }
    float ps = 0.f;
#pragma unroll
    for (int i = 0; i < 16; ++i) { s[i] = ex2(s[i] - m); ps += s[i]; }
    l += ps;
    pv_tile(s, o, v);
}
__device__ __forceinline__ void zero_o(f32x16 (&o)[4]) {
#pragma unroll
    for (int dt = 0; dt < 4; ++dt)
#pragma unroll
        for (int i = 0; i < 16; ++i) o[dt][i] = 0.f;
}
__device__ __forceinline__ void y_update(bf16* yp  , const f32x16 (&o)[4], float sc, bool acc) {
#pragma unroll
    for (int dt = 0; dt < 4; ++dt)
#pragma unroll
        for (int i4 = 0; i4 < 4; ++i4) { bf16* p = yp + 32 * dt + 8 * i4;
            float v0 = o[dt][4 * i4] * sc, v1 = o[dt][4 * i4 + 1] * sc, v2 = o[dt][4 * i4 + 2] * sc, v3 = o[dt][4 * i4 + 3] * sc;
            if (acc) { const v2u w = *(const v2u*)p; v0 += bflo(w.x); v1 += bfhi(w.x); v2 += bflo(w.y); v3 += bfhi(w.y); }
            v2u w; w.x = pkbf(v0, v1); w.y = pkbf(v2, v3); *(v2u*)p = w; }
}
constexpr int TBLN = 2624;
constexpr int OFF_TBL = 0, OFF_IMP = 43008, OFF_SELM = OFF_IMP + 65536, OFF_DTBL = OFF_SELM + 512;
constexpr int FAR_DIST = 1513;

template <int NP> __device__ __forceinline__ void nsa_unit(const Args& a, LAS unsigned char* lds, int u, int tid) {
    const int lane = tid & 63, wave = __builtin_amdgcn_readfirstlane(tid >> 6);
    const int qb = u >> 3, bg = u & 7, b = bg >> 1, g = bg & 1;
    const int r = wave >> 1, qs = wave & 1, hd = g * 4 + r, ql = lane & 31, h = lane >> 5;
    const int q0w = 64 * qb + 32 * qs, sq = q0w + ql, t = b * S + sq;
    LAS float* tball = (LAS float*)(lds + OFF_TBL);
    LAS float* imp = (LAS float*)(lds + OFF_IMP);
    LAS unsigned long long* selm = (LAS unsigned long long*)(lds + OFF_SELM);
    const float* relb = a.in[22];
    for (int i = tid; i < 4 * TBLN; i += NTHREADS) { const int hh = i / TBLN, dd = i % TBLN - 64; tball[i] = dd >= 0 ? relb[(g * 4 + hh) * 32 + t5_bucket(dd)] * LOG2E : 0.f; }
    for (int i = tid; i < 4 * 64 * 64; i += NTHREADS) imp[i] = 0.f;
    __syncthreads();
    const LAS float* tbl = tball + r * TBLN + 64;
    const float farc = relb[hd * 32 + 31] * LOG2E;
    bf16x8 qf[8];
    { const bf16* qrow = (const bf16*)(a.ws + WS_Q) + (size_t)t * NQ + hd * 128 + 8 * h;
#pragma unroll
      for (int st = 0; st < 8; ++st) qf[st] = __builtin_bit_cast(bf16x8, *(const v4u*)(qrow + 16 * st)); }
    const float* gt = (const float*)(a.ws + WS_GATES) + (size_t)t * 24 + hd * 3;
    const float g0 = gt[0], g1 = gt[1], g2 = gt[2];
    bf16* yp = (bf16*)(a.ws + (NP ? WS_H : WS_YN)) + (size_t)t * 1536 + hd * 128 + 4 * h;
    f32x16 o[4];
    {
        const v4u* kfc = (const v4u*)(a.ws + WS_KC) + (size_t)bg * 8 * 512; const v4u* vfc = (const v4u*)(a.ws + WS_VC) + (size_t)bg * 8 * 512;
        const int smax = q0w + 31, ncv = smax >= 31 ? ((smax - 31) >> 4) + 1 : 0, ntc = (ncv + 31) >> 5;
        float m = NEGB, l = 0.f;
        for (int tc = 0; tc < ntc; ++tc) {
            f32x16 s = qk_tile(qf, kfc + tc * 512, lane);
            const int dqc = sq - 31 - 512 * tc;
            if (q0w - 31 - 512 * tc - 496 >= FAR_DIST) {
#pragma unroll
                for (int i = 0; i < 16; ++i) s[i] += farc;
            } else add_tbl<16>(s, tbl + dqc - 16 * (8 * h + 23), 0.f);
            mask_hi(s, (dqc >> 4) - 8 * h);
            const float mn = fmaxf(m, max16(s));
            float ps = 0.f;
#pragma unroll
            for (int i = 0; i < 16; ++i) ps += ex2(s[i] - mn);
            l = l * ex2(m - mn) + ps; m = mn;
        }
        l += __shfl_xor(l, 32);
        const float inv = (sq >= 31) ? 1.f / l : 0.f;
        zero_o(o);
        LAS float* impq = imp + (r * 64 + 32 * qs + ql) * 64;
        for (int tc = 0; tc < ntc; ++tc) {
            f32x16 s = qk_tile(qf, kfc + tc * 512, lane);
            bf16x8 v[8];
#pragma unroll
            for (int i = 0; i < 8; ++i) v[i] = __builtin_bit_cast(bf16x8, vfc[tc * 512 + i * 64 + lane]);
            const int dqc = sq - 31 - 512 * tc;
            if (q0w - 31 - 512 * tc - 496 >= FAR_DIST) {
#pragma unroll
                for (int i = 0; i < 16; ++i) s[i] += farc;
            } else add_tbl<16>(s, tbl + dqc - 16 * (8 * h + 23), 0.f);
            mask_hi(s, (dqc >> 4) - 8 * h);
#pragma unroll
            for (int i = 0; i < 16; ++i) s[i] = ex2(s[i] - m) * inv;
#pragma unroll
            for (int a2 = 0; a2 < 2; ++a2)
#pragma unroll
                for (int bq = 0; bq < 2; ++bq) { const int j = 8 * tc + 4 * a2 + 2 * h + bq; const int i0 = 8 * a2 + 4 * bq;
                    impq[j] += (s[i0] + s[i0 + 1]) + (s[i0 + 2] + s[i0 + 3]); }
            asm volatile("s_waitcnt lgkmcnt(0)" ::: "memory");
#pragma unroll
            for (int a2 = 0; a2 < 2; ++a2)
#pragma unroll
                for (int bq = 0; bq < 2; ++bq) { const int j = 8 * tc + 4 * a2 + 2 * h + bq + 1; if (j < 64) impq[j] += s[8 * a2 + 4 * bq + 3]; }
            asm volatile("s_waitcnt lgkmcnt(0)" ::: "memory");
            pv_tile(s, o, v);
        }
        y_update(yp, o, g0, false);
    }
    __syncthreads();
    for (int qq = wave * 8; qq < wave * 8 + 8; ++qq) {
        const int jb = lane;
        const float im = ((imp[(0 * 64 + qq) * 64 + jb] + imp[(1 * 64 + qq) * 64 + jb]) + imp[(2 * 64 + qq) * 64 + jb]) + imp[(3 * 64 + qq) * 64 + jb];
        const bool forced = (jb == 0) || (jb == qb) || (jb == qb - 1);
        const float score = forced ? 1e4f : (jb > qb ? -1e4f : im);
        int rank = 0;
        for (int o2 = 0; o2 < 64; ++o2) { const float so = __shfl(score, o2); rank += (so > score) || (so == score && o2 < jb); }
        const unsigned long long mask = __ballot(rank < 16 && jb <= qb);
        if (lane == 0) selm[qq] = mask;
    }
    __syncthreads();
    {
        const v4u* kfw = (const v4u*)fr_nsa(a, bg, 2); const v4u* vfw = (const v4u*)fr_nsa(a, bg, 3);
        const int t_hi = q0w >> 5, t_lo = t_hi - 16;
        float m = NEGB, l = 0.f; zero_o(o);
        const int t0 = t_lo < 0 ? 0 : t_lo;
        for (int tt = t0; tt <= t_hi; ++tt) {
            const size_t to = (NP == 3) ? (size_t)(tt & 1) * 512 : (size_t)tt * 512;
            bf16x8 kf[8], vf[8]; load_frags(kf, kfw + to, lane);
            f32x16 s = qk_mma(qf, kf); load_frags(vf, vfw + to, lane);
            const int dq = sq - 32 * tt;
            add_tbl<1>(s, tbl + dq - (8 * h + 23), 0.f);
            if (tt == t_hi) mask_hi(s, dq - 8 * h);
            if (tt == t_lo) mask_lo(s, dq - 511 - 8 * h);
            softmax_pv_v<NP>(s, o, m, l, vf);
        }
        l += __shfl_xor(l, 32);
        y_update(yp, o, g2 / l, true);
    }
    {
        const v4u* kfs = (const v4u*)fr_nsa(a, bg, 0); const v4u* vfs = (const v4u*)fr_nsa(a, bg, 1);
        const unsigned long long mask = selm[32 * qs + ql];
        float m = NEGB, l = 0.f; zero_o(o);
        const int t_end = 2 * qb + qs;
        for (int tt = 0; tt <= 2 * qb + 1; ++tt) {
            if (tt > t_end) continue;
            const float pen = ((mask >> (tt >> 1)) & 1ull) ? 0.f : NEGB;
            if (__ballot(pen == 0.f) == 0ull) continue;
            const size_t to = (NP == 3) ? (size_t)(tt & 1) * 512 : (size_t)tt * 512;
            bf16x8 kf[8], vf[8]; load_frags(kf, kfs + to, lane);
            f32x16 s = qk_mma(qf, kf); load_frags(vf, vfs + to, lane);
            const int dq = sq - 32 * tt;
            if (q0w - (32 * tt + 31) >= FAR_DIST) {
                const float c = farc + pen;
#pragma unroll
                for (int i = 0; i < 16; ++i) s[i] += c;
            } else add_tbl<1>(s, tbl + dq - (8 * h + 23), pen);
            if (tt == t_end) mask_hi(s, dq - 8 * h);
            softmax_pv_v<NP>(s, o, m, l, vf);
        }
        l += __shfl_xor(l, 32);
        y_update(yp, o, g1 / l, true);
    }
    __syncthreads();
}
__device__ __forceinline__ void dil_unit(const Args& a, LAS unsigned char* lds, int u, int tid) {
    const int lane = tid & 63, wave = __builtin_amdgcn_readfirstlane(tid >> 6), ql = lane & 31, h = lane >> 5;
    const int b = u >> 6, p = (u >> 4) & 3, c = u & 15, s0 = 256 * c;
    LAS float* dtbl = (LAS float*)(lds + OFF_DTBL);
    const float* relb = a.in[22] + 8 * 32;
    for (int i = tid; i < 3 * 192; i += NTHREADS) { const int gi = i / 192, dm = i % 192 - 32; dtbl[i] = dm >= 0 ? relb[(gi * 4 + p) * 32 + t5_bucket(dm << (2 * gi))] * LOG2E : 0.f; }
    __syncthreads();
    bf16* OD = (bf16*)(a.ws + WS_OD); float* LSE = (float*)(a.ws + WS_LSE);
    const bf16* DL = (const bf16*)(a.ws + WS_DL);
    for (int job = wave; job < 32; job += NWAVES) {
        int gi, rr, m0, vlo, vhi;
        if (job < 8) { gi = 0; rr = 0; m0 = s0 + 32 * job; vlo = 0; vhi = 32; }
        else if (job < 16) { gi = 1; rr = (job - 8) >> 1; m0 = (s0 >> 2) + 32 * (job & 1); vlo = 0; vhi = 32; }
        else { gi = 2; rr = job - 16; m0 = 32 * (c >> 1); vlo = 16 * (c & 1); vhi = vlo + 16; }
        const int dsh = 2 * gi, L = S >> dsh, head = gi * 4 + p;
        const int mq = m0 + ql, sact = (mq << dsh) + rr, t = b * S + sact;
        const v4u* kf = (const v4u*)fr_dil(a, b, head, 0) + (size_t)((rr * L) >> 5) * 512; const v4u* vf = (const v4u*)fr_dil(a, b, head, 1) + (size_t)((rr * L) >> 5) * 512;
        bf16x8 qf[8];
        { const bf16* qrow = DL + (size_t)t * NDL + head * 128 + 8 * h;
#pragma unroll
          for (int st = 0; st < 8; ++st) qf[st] = __builtin_bit_cast(bf16x8, *(const v4u*)(qrow + 16 * st)); }
        const LAS float* tb = dtbl + gi * 192 + 32;
        const int t_hi = m0 >> 5, t_lo = t_hi - 4;
        float m = NEGB, l = 0.f; f32x16 o[4]; zero_o(o);
        const int t0 = t_lo < 0 ? 0 : t_lo;
        for (int tt = t0; tt <= t_hi; ++tt) {
            bf16x8 kr[8], vr[8]; load_frags(kr, kf + (size_t)tt * 512, lane);
            f32x16 s = qk_mma(qf, kr); load_frags(vr, vf + (size_t)tt * 512, lane);
            const int dq = mq - 32 * tt;
            add_tbl<1>(s, tb + dq - (8 * h + 23), 0.f);
            if (tt == t_hi) mask_hi(s, dq - 8 * h);
            if (tt == t_lo) mask_lo(s, dq - 128 - 8 * h);
            softmax_pv_v(s, o, m, l, vr);
        }
        l += __shfl_xor(l, 32);
        if (ql >= vlo && ql < vhi) {
            y_update(OD + ((size_t)gi * T + t) * 512 + p * 128 + 4 * h, o, 1.f / l, false);
            if (h == 0) LSE[((size_t)(gi * NB + b) * 4 + p) * S + sact] = m + __log2f(l);
        }
    }
    __syncthreads();
    { const int pos = tid >> 1, dh = tid & 1, sact = s0 + pos, t = b * S + sact;
      const float l0 = LSE[((size_t)(0 * NB + b) * 4 + p) * S + sact], l1 = LSE[((size_t)(1 * NB + b) * 4 + p) * S + sact], l2 = LSE[((size_t)(2 * NB + b) * 4 + p) * S + sact];
      const float mx = fmaxf(l0, fmaxf(l1, l2)); float w0 = ex2(l0 - mx), w1 = ex2(l1 - mx), w2 = ex2(l2 - mx); const float iw = 1.f / (w0 + w1 + w2); w0 *= iw; w1 *= iw; w2 *= iw;
      bf16* yd = (bf16*)(a.ws + WS_YN) + (size_t)t * 1536 + 1024 + p * 128 + 64 * dh;
      const bf16* o0 = OD + ((size_t)0 * T + t) * 512 + p * 128 + 64 * dh; const bf16* o1 = OD + ((size_t)1 * T + t) * 512 + p * 128 + 64 * dh; const bf16* o2 = OD + ((size_t)2 * T + t) * 512 + p * 128 + 64 * dh;
#pragma unroll
      for (int k = 0; k < 8; ++k) { const v4u x0 = *(const v4u*)(o0 + 8 * k), x1 = *(const v4u*)(o1 + 8 * k), x2 = *(const v4u*)(o2 + 8 * k); v4u y;
          y.x = pkbf(w0 * bflo(x0.x) + w1 * bflo(x1.x) + w2 * bflo(x2.x), w0 * bfhi(x0.x) + w1 * bfhi(x1.x) + w2 * bfhi(x2.x));
          y.y = pkbf(w0 * bflo(x0.y) + w1 * bflo(x1.y) + w2 * bflo(x2.y), w0 * bfhi(x0.y) + w1 * bfhi(x1.y) + w2 * bfhi(x2.y));
          y.z = pkbf(w0 * bflo(x0.z) + w1 * bflo(x1.z) + w2 * bflo(x2.z), w0 * bfhi(x0.z) + w1 * bfhi(x1.z) + w2 * bfhi(x2.z));
          y.w = pkbf(w0 * bflo(x0.w) + w1 * bflo(x1.w) + w2 * bflo(x2.w), w0 * bfhi(x0.w) + w1 * bfhi(x1.w) + w2 * bfhi(x2.w));
          *(v4u*)(yd + 8 * k) = y; } }
    __syncthreads();
}
__device__ __forceinline__ void ph4_attention(const Args& a, LAS unsigned char* lds) {
    const int tid = phase_tid();
    for (int u = blockIdx.x; u < 256; u += gridDim.x) dil_unit(a, lds, u, tid);
#ifndef PROBE_NSA
#define PROBE_NSA 0
#endif
    if (PROBE_NSA) for (int x = blockIdx.x; x < 256; x += gridDim.x) { nsa_unit<PROBE_NSA>(a, lds, 511 - x, tid); nsa_unit<PROBE_NSA>(a, lds, x, tid); }
    for (int x = blockIdx.x; x < 256; x += gridDim.x) { nsa_unit<0>(a, lds, 511 - x, tid); nsa_unit<0>(a, lds, x, tid); }
}

constexpr size_t WS_PU8 = WS_Q;
constexpr size_t WS_PV8 = WS_Q + 32 * MiB;
constexpr size_t WS_PSC = WS_Q + 64 * MiB;
__device__ __forceinline__ void ph_quant_uv(const Args& a) {
    const int tid = phase_tid(), lane = tid & 63, wave = __builtin_amdgcn_readfirstlane(tid >> 6);
    const int gw = blockIdx.x * NWAVES + wave, NGW = gridDim.x * NWAVES;
    float* SC = (float*)(a.ws + WS_PSC);
    for (int rw = gw; rw < NE; rw += NGW) {
        f32x4 x[2][8];
#pragma unroll
        for (int which = 0; which < 2; ++which) { const float* src = a.in[20 + which] + (size_t)rw * D + 16 * lane;
#pragma unroll
            for (int c = 0; c < 2; ++c)
#pragma unroll
                for (int w = 0; w < 4; ++w) x[which][4 * c + w] = *(const f32x4*)(src + 1024 * c + 4 * w); }
#pragma unroll
        for (int which = 0; which < 2; ++which) {
            unsigned char* dst = a.ws + (which ? WS_PV8 : WS_PU8) + (size_t)rw * D + 16 * lane;
            float am = 0.f;
#pragma unroll
            for (int i = 0; i < 8; ++i) am = fmaxf(fmaxf(am, fmaxf(fabsf(x[which][i].x), fabsf(x[which][i].y))), fmaxf(fabsf(x[which][i].z), fabsf(x[which][i].w)));
            am = wave_max(am);
            const float inv = am > 0.f ? 127.f / am : 0.f;
#pragma unroll
            for (int c = 0; c < 2; ++c) { v4u o; unsigned wd[4];
#pragma unroll
                for (int w = 0; w < 4; ++w) { const f32x4 v = x[which][4 * c + w];
                    const unsigned q0 = (unsigned)((int)rintf(v.x * inv) + 128), q1 = (unsigned)((int)rintf(v.y * inv) + 128), q2 = (unsigned)((int)rintf(v.z * inv) + 128), q3 = (unsigned)((int)rintf(v.w * inv) + 128);
                    wd[w] = q0 | (q1 << 8) | (q2 << 16) | (q3 << 24); }
                o.x = wd[0]; o.y = wd[1]; o.z = wd[2]; o.w = wd[3]; *(v4u*)(dst + 1024 * c) = o; }
            if (lane == 0) SC[which * NE + rw] = am * (1.f / 127.f);
        }
    }
}
constexpr size_t WS_KEYF = 601 * MiB;
constexpr size_t WS_END3 = 602 * MiB;
__device__ __forceinline__ void ph0_keyfrags(const Args& a) {
    const int tid = phase_tid();
    const float* keys = a.in[19]; v4u* KF = (v4u*)(a.ws + WS_KEYF);
    for (int i = blockIdx.x * NTHREADS + tid; i < 16 * 32 * 64; i += gridDim.x * NTHREADS) {
        const int lane = i & 63, st = (i >> 6) & 7, kt = (i >> 9) & 3, hp = i >> 11;
        const float* src = keys + ((size_t)hp * 128 + 32 * kt + (lane & 31)) * 128 + 16 * st + 8 * (lane >> 5);
        float v[8]; unsigned hi[8], lo[8];
#pragma unroll
        for (int j = 0; j < 8; ++j) { v[j] = src[j]; hi[j] = f2bf(v[j]); lo[j] = f2bf(v[j] - __builtin_bit_cast(float, hi[j] << 16)); }
        v4u oh, ol; oh.x = hi[0] | (hi[1] << 16); oh.y = hi[2] | (hi[3] << 16); oh.z = hi[4] | (hi[5] << 16); oh.w = hi[6] | (hi[7] << 16);
        ol.x = lo[0] | (lo[1] << 16); ol.y = lo[2] | (lo[3] << 16); ol.z = lo[4] | (lo[5] << 16); ol.w = lo[6] | (lo[7] << 16);
        KF[(size_t)((hp * 2 + 0) * 32 + kt * 8 + st) * 64 + lane] = oh; KF[(size_t)((hp * 2 + 1) * 32 + kt * 8 + st) * 64 + lane] = ol;
    }
}
template <int N, bool MERGE_ONLY> __device__ __forceinline__ void bitonic_desc(float (&v)[N]) {
#pragma unroll
    for (int k = MERGE_ONLY ? N : 2; k <= N; k <<= 1)
#pragma unroll
        for (int j = k >> 1; j > 0; j >>= 1)
#pragma unroll
            for (int i = 0; i < N; ++i) { const int l = i ^ j;
                if (l > i) { const bool desc = ((i & k) == 0) || (k == N); const float x = v[i], y = v[l], hi = fmaxf(x, y), lo = fminf(x, y); v[i] = desc ? hi : lo; v[l] = desc ? lo : hi; } }
}
#define CROW(i) (((i) & 3) + 8 * ((i) >> 2))
__device__ __forceinline__ float max3f(float a, float b, float c) { return fmaxf(fmaxf(a, b), c); }
__device__ __forceinline__ void ph_route(const Args& a, LAS unsigned char* lds) {
    const int tid = phase_tid(), lane = tid & 63, wave = __builtin_amdgcn_readfirstlane(tid >> 6), tl = lane & 31, hc = lane >> 5;
    const int gw = blockIdx.x * NWAVES + wave, NGW = gridDim.x * NWAVES;
    const float* QP = (const float*)(a.ws + WS_QP); const float* qgain = a.in[18]; const v4u* KF = (const v4u*)(a.ws + WS_KEYF);
    int* EI = (int*)(a.ws + WS_EI); float* EG = (float*)(a.ws + WS_EG);
    LAS float* spl = (LAS float*)(lds + wave * 8704) + lane * 33;
    for (int job = gw; job < (T / 32) * 8; job += NGW) {
        const int h = job & 7, t = (job >> 3) * 32 + tl;
#pragma unroll 1
        for (int p = 0; p < 2; ++p) {
            bf16x8 bh[8], bl[8];
            { const float* qr = QP + (size_t)t * D + h * 256 + p * 128 + 8 * hc; const float* gr = qgain + (h * 2 + p) * 128 + 8 * hc;
              float ss = 0.f;
#pragma unroll
              for (int st = 0; st < 8; ++st) { const f32x4 x0 = *(const f32x4*)(qr + 16 * st), x1 = *(const f32x4*)(qr + 16 * st + 4);
                  ss += (x0.x * x0.x + x0.y * x0.y) + (x0.z * x0.z + x0.w * x0.w) + (x1.x * x1.x + x1.y * x1.y) + (x1.z * x1.z + x1.w * x1.w); }
              ss += __shfl_xor(ss, 32);
              const float rstd = rsqrtf(ss * (1.f / 128.f) + EPS);
              asm volatile("" ::: "memory");
#pragma unroll
              for (int st = 0; st < 8; ++st) { const f32x4 x0 = *(const f32x4*)(qr + 16 * st), x1 = *(const f32x4*)(qr + 16 * st + 4); const f32x4 g0 = *(const f32x4*)(gr + 16 * st), g1 = *(const f32x4*)(gr + 16 * st + 4);
                  const float v0 = x0.x * rstd * g0.x, v1 = x0.y * rstd * g0.y, v2 = x0.z * rstd * g0.z, v3 = x0.w * rstd * g0.w, v4 = x1.x * rstd * g1.x, v5 = x1.y * rstd * g1.y, v6 = x1.z * rstd * g1.z, v7 = x1.w * rstd * g1.w;
                  v4u xh, xl; xh.x = pkbf(v0, v1); xh.y = pkbf(v2, v3); xh.z = pkbf(v4, v5); xh.w = pkbf(v6, v7);
                  xl.x = pkbf(v0 - bflo(xh.x), v1 - bfhi(xh.x)); xl.y = pkbf(v2 - bflo(xh.y), v3 - bfhi(xh.y)); xl.z = pkbf(v4 - bflo(xh.z), v5 - bfhi(xh.z)); xl.w = pkbf(v6 - bflo(xh.w), v7 - bfhi(xh.w));
                  bh[st] = __builtin_bit_cast(bf16x8, xh); bl[st] = __builtin_bit_cast(bf16x8, xl); } }
            float sc[64];
            const v4u* kfh = KF + (size_t)(((h * 2 + p) * 2 + 0) * 32) * 64 + lane; const v4u* kfl = KF + (size_t)(((h * 2 + p) * 2 + 1) * 32) * 64 + lane;
#pragma unroll
            for (int kt = 0; kt < 4; ++kt) {
                f32x16 acc;
#pragma unroll
                for (int i = 0; i < 16; ++i) acc[i] = 0.f;
#pragma unroll
                for (int s2 = 0; s2 < 2; ++s2) {
                    asm volatile("" ::: "memory");
                    bf16x8 ah[4], al[4];
#pragma unroll
                    for (int s4 = 0; s4 < 4; ++s4) { ah[s4] = __builtin_bit_cast(bf16x8, kfh[(kt * 8 + s2 * 4 + s4) * 64]); al[s4] = __builtin_bit_cast(bf16x8, kfl[(kt * 8 + s2 * 4 + s4) * 64]); }
#pragma unroll
                    for (int s4 = 0; s4 < 4; ++s4) { const int st = s2 * 4 + s4;
                        acc = __builtin_amdgcn_mfma_f32_32x32x16_bf16(al[s4], bh[st], acc, 0, 0, 0); acc = __builtin_amdgcn_mfma_f32_32x32x16_bf16(ah[s4], bl[st], acc, 0, 0, 0); acc = __builtin_amdgcn_mfma_f32_32x32x16_bf16(ah[s4], bh[st], acc, 0, 0, 0); }
                }
#pragma unroll
                for (int i = 0; i < 16; ++i) { const float av = acc[i];
                    const unsigned bits = (__builtin_bit_cast(unsigned, av) & ~127u) | (unsigned)(127 - (32 * kt + CROW(i) + 4 * hc)); sc[16 * kt + i] = __builtin_bit_cast(float, bits); }
            }
            asm volatile("" ::: "memory");
            bitonic_desc<64, false>(sc);
            float t16[16];
#pragma unroll
            for (int i = 0; i < 16; ++i) t16[i] = __shfl_xor(sc[i], 32);
            float u16[16];
#pragma unroll
            for (int i = 0; i < 16; ++i) u16[i] = fmaxf(sc[i], t16[15 - i]);
            bitonic_desc<16, true>(u16);
#pragma unroll
            for (int i = 0; i < 16; ++i) spl[p * 16 + i] = u16[i];
        }
        asm volatile("s_waitcnt lgkmcnt(0)" ::: "memory");
        float sp[2][16];
#pragma unroll
        for (int i = 0; i < 16; ++i) { sp[0][i] = spl[i]; sp[1][i] = spl[16 + i]; }
        float cv[64];
        {
            int c = 0;
#pragma unroll
            for (int i = 0; i < 16; ++i)
#pragma unroll
                for (int j = 0; j < 16; ++j) if ((i + 1) * (j + 1) <= 16) {
                    const float v = sp[0][i] + sp[1][j];
                    cv[c] = __builtin_bit_cast(float, (__builtin_bit_cast(unsigned, v) & ~255u) | (unsigned)(255 - (i * 16 + j))); ++c; }
#pragma unroll
            for (int i = 50; i < 64; ++i) cv[i] = -INFINITY;
        }
        bitonic_desc<64, false>(cv);
        float tv[16];
#pragma unroll
        for (int i = 0; i < 16; ++i) tv[i] = cv[i];
        asm volatile("s_waitcnt lgkmcnt(0)" ::: "memory");
        int te[16]; float den = 0.f; const float top = tv[0];
#pragma unroll
        for (int i = 0; i < 16; ++i) { const int flat = 255 - (int)(__builtin_bit_cast(unsigned, tv[i]) & 255u);
            const unsigned b1 = __builtin_bit_cast(unsigned, spl[flat >> 4]), b2 = __builtin_bit_cast(unsigned, spl[16 + (flat & 15)]);
            te[i] = (127 - (int)(b1 & 127u)) * 128 + (127 - (int)(b2 & 127u));
            tv[i] = __expf(tv[i] - top); den += tv[i]; }
        den = 1.f / den;
        if (hc == 0) {
            int* ei = EI + (size_t)t * 128 + h * 16; float* eg = EG + (size_t)t * 128 + h * 16;
#pragma unroll
            for (int i = 0; i < 16; i += 4) { *(v4u*)(ei + i) = (v4u){(unsigned)te[i], (unsigned)te[i + 1], (unsigned)te[i + 2], (unsigned)te[i + 3]}; *(f32x4*)(eg + i) = (f32x4){tv[i] * den, tv[i + 1] * den, tv[i + 2] * den, tv[i + 3] * den}; }
        }
        asm volatile("s_waitcnt lgkmcnt(0)" ::: "memory");
    }
}
__device__ __forceinline__ float ub0(unsigned w) { return (float)(w & 0xffu); }
__device__ __forceinline__ float ub1(unsigned w) { return (float)((w >> 8) & 0xffu); }
__device__ __forceinline__ float ub2(unsigned w) { return (float)((w >> 16) & 0xffu); }
__device__ __forceinline__ float ub3(unsigned w) { return (float)(w >> 24); }
__device__ __forceinline__ void ph_experts(const Args& a, const float osc) {
    const int tid = phase_tid(), lane = tid & 63, wave = __builtin_amdgcn_readfirstlane(tid >> 6);
    const int gw = blockIdx.x * NWAVES + wave, NGW = gridDim.x * NWAVES;
    const bf16* H2 = (const bf16*)(a.ws + WS_H); const unsigned char* PU = a.ws + WS_PU8; const unsigned char* PV = a.ws + WS_PV8; const float* SC = (const float*)(a.ws + WS_PSC);
    const int* EI = (const int*)(a.ws + WS_EI); const float* EG = (const float*)(a.ws + WS_EG);
    const float* mod = (const float*)(a.ws + WS_MOD);
    float* out = a.out;
    for (int t = gw; t < T; t += NGW) {
        const int b = t / S;
        float x[32]; float sx = 0.f;
#pragma unroll
        for (int c = 0; c < 2; ++c)
#pragma unroll
            for (int hw = 0; hw < 2; ++hw) { const v4u w = *(const v4u*)(H2 + (size_t)t * D + 1024 * c + 16 * lane + 8 * hw); const int o = 16 * c + 8 * hw;
                x[o + 0] = bflo(w.x); x[o + 1] = bfhi(w.x); x[o + 2] = bflo(w.y); x[o + 3] = bfhi(w.y); x[o + 4] = bflo(w.z); x[o + 5] = bfhi(w.z); x[o + 6] = bflo(w.w); x[o + 7] = bfhi(w.w); }
#pragma unroll
        for (int i = 0; i < 32; ++i) sx += x[i];
        sx = wave_sum(sx) * 128.f;
        const int e0 = EI[(size_t)t * 128 + lane], e1 = EI[(size_t)t * 128 + 64 + lane];
        const float gs0 = EG[(size_t)t * 128 + lane] * SC[NE + e0], gs1 = EG[(size_t)t * 128 + 64 + lane] * SC[NE + e1];
        const float su0 = SC[e0], su1 = SC[e1];
        float cf0 = 0.f, cf1 = 0.f;
#pragma unroll 1
        for (int bt = 0; bt < 16; ++bt) {
            v4u w[8][2];
#pragma unroll
            for (int k = 0; k < 8; ++k) { const int e = __shfl(bt < 8 ? e0 : e1, (bt * 8 + k) & 63); const unsigned char* ur = PU + (size_t)e * D + 16 * lane;
                w[k][0] = *(const v4u*)ur; w[k][1] = *(const v4u*)(ur + 1024); }
#pragma unroll
            for (int k = 0; k < 8; ++k) { float s0 = 0.f, s1 = 0.f;
#pragma unroll
                for (int c = 0; c < 2; ++c) { const v4u q = w[k][c]; const int o = 16 * c;
                    s0 += x[o + 0] * ub0(q.x) + x[o + 1] * ub1(q.x) + x[o + 2] * ub2(q.x) + x[o + 3] * ub3(q.x); s1 += x[o + 4] * ub0(q.y) + x[o + 5] * ub1(q.y) + x[o + 6] * ub2(q.y) + x[o + 7] * ub3(q.y);
                    s0 += x[o + 8] * ub0(q.z) + x[o + 9] * ub1(q.z) + x[o + 10] * ub2(q.z) + x[o + 11] * ub3(q.z); s1 += x[o + 12] * ub0(q.w) + x[o + 13] * ub1(q.w) + x[o + 14] * ub2(q.w) + x[o + 15] * ub3(q.w); }
                const float raw = wave_sum(s0 + s1) - sx;
                if (lane == ((bt * 8 + k) & 63)) { if (bt < 8) cf0 = gelu_tanh(raw * su0) * gs0; else cf1 = gelu_tanh(raw * su1) * gs1; } }
        }
        const float wsum = wave_sum(cf0 + cf1) * 128.f;
        float acc[32];
#pragma unroll
        for (int i = 0; i < 32; ++i) acc[i] = 0.f;
#pragma unroll 1
        for (int bt = 0; bt < 16; ++bt) {
            v4u w[8][2];
#pragma unroll
            for (int k = 0; k < 8; ++k) { const int e = __shfl(bt < 8 ? e0 : e1, (bt * 8 + k) & 63); const unsigned char* vr = PV + (size_t)e * D + 16 * lane;
                w[k][0] = *(const v4u*)vr; w[k][1] = *(const v4u*)(vr + 1024); }
#pragma unroll
            for (int k = 0; k < 8; ++k) { const float cf = __shfl(bt < 8 ? cf0 : cf1, (bt * 8 + k) & 63);
#pragma unroll
                for (int c = 0; c < 2; ++c) { const v4u q = w[k][c]; const int o = 16 * c;
                    acc[o + 0] += cf * ub0(q.x); acc[o + 1] += cf * ub1(q.x); acc[o + 2] += cf * ub2(q.x); acc[o + 3] += cf * ub3(q.x); acc[o + 4] += cf * ub0(q.y); acc[o + 5] += cf * ub1(q.y); acc[o + 6] += cf * ub2(q.y); acc[o + 7] += cf * ub3(q.y);
                    acc[o + 8] += cf * ub0(q.z); acc[o + 9] += cf * ub1(q.z); acc[o + 10] += cf * ub2(q.z); acc[o + 11] += cf * ub3(q.z); acc[o + 12] += cf * ub0(q.w); acc[o + 13] += cf * ub1(q.w); acc[o + 14] += cf * ub2(q.w); acc[o + 15] += cf * ub3(q.w); } }
        }
        const float* g2 = mod + b * 12288 + 10240;
#pragma unroll
        for (int c = 0; c < 2; ++c)
#pragma unroll
            for (int w4 = 0; w4 < 4; ++w4) { float* op = out + (size_t)t * D + 1024 * c + 16 * lane + 4 * w4; const f32x4 ga = *(const f32x4*)(g2 + 1024 * c + 16 * lane + 4 * w4); f32x4 r0 = *(const f32x4*)op; const int o = 16 * c + 4 * w4;
                r0.x += ga.x * (acc[o + 0] - wsum) * osc; r0.y += ga.y * (acc[o + 1] - wsum) * osc; r0.z += ga.z * (acc[o + 2] - wsum) * osc; r0.w += ga.w * (acc[o + 3] - wsum) * osc;
                *(f32x4*)op = r0; }
    }
}

constexpr int N_PHASES = 11;
__global__ void __launch_bounds__(NTHREADS, 2) fwd_kernel(Args a) {
    extern __shared__ __attribute__((aligned(16))) unsigned char lds_raw[];
    LAS unsigned char* lds = (LAS unsigned char*)lds_raw;
    const int tid = threadIdx.x;
    volatile LAS unsigned* misc = (volatile LAS unsigned*)(lds + LDS_MISC);
    if (tid < 16) misc[tid] = 0u;
    __syncthreads();
    XcdBarrier bar; bar.bar = (unsigned*)(a.ws + WS_CTL) + 1024; bar.x = 0; bar.st = nullptr;
    const int lo = a.ph_lo, hi = a.ph_hi;
    if (hi - lo > 1) bar = xcd_barrier_post((unsigned*)(a.ws + WS_CTL) + 1024, misc + 8);
#define IN(k) (lo <= (k) && (k) < hi)
#define SEAM(k) do { if (IN(k) && IN((k) + 1)) xcd_barrier(bar); } while (0)
    const int G = gridDim.x, bx = blockIdx.x;

    for (int rep = 0; rep < 1 + ((PROBE_DUP >> 0) & 1); ++rep)
    if (IN(0)) { ph0_mod(a, lds); __syncthreads(); ph0_weights(a, lds); ph0_keyfrags(a); ph0_extra(a); __syncthreads(); }
    SEAM(0);
    for (int rep = 0; rep < 1 + ((PROBE_DUP >> 1) & 1); ++rep)
    if (IN(1)) ph_norm<true>(a, a.in[0], a.in[4], 0, 2048, (bf16*)(a.ws + WS_H), a.ws + WS_H8);
    SEAM(1);
    for (int rep = 0; rep < 1 + ((PROBE_DUP >> 2) & 1); ++rep)
    if (IN(2)) { pg8::Gemm g{(const bf16*)(a.ws + WS_H8), (const bf16*)(a.ws + WS_WIN), T, NPROJ, D / 2}; pg8::StaticOrder So; So.init(T, NPROJ, G, bx);
        EpiProjNorm E{(bf16*)(a.ws + WS_Q), (bf16*)(a.ws + WS_KV), (bf16*)(a.ws + WS_DL), (bf16*)(a.ws + WS_MG), (bf16*)a.out, a.in[6], a.in[7], a.in[11], a.in[12], (LAS float*)(lds + 131072), 1.f / (F8_HS * F8_WS)};
        pg8::gemm_phase<EpiProjNorm, pg8::StaticOrder, pg8::NoMid, true>(lds, g, So, E); }
    SEAM(2);
    if (IN(3)) { for (int rep = 0; rep < 1 + ((PROBE_DUP >> 3) & 1); ++rep) { ph3_vfrag(a); ph3_gates(a); ph3_compress(a, lds); } }
    SEAM(3);
    for (int rep = 0; rep < 1 + ((PROBE_DUP >> 4) & 1); ++rep)
    if (IN(4)) ph4_attention(a, lds);
    SEAM(4);
    for (int rep = 0; rep < 1 + ((PROBE_DUP >> 5) & 1); ++rep)
    if (IN(5)) {
        { pg8::Gemm g{(const bf16*)(a.ws + WS_YN), (const bf16*)(a.ws + WS_WBN), T, D, 1536}; pg8::StaticOrder So; So.init(T, D, G, bx);
          EpiMerge E{(const bf16*)(a.ws + WS_MG), (bf16*)(a.ws + WS_H)}; MidMerge Mh{(const bf16*)(a.ws + WS_MG)};
          pg8::gemm_phase<EpiMerge, pg8::StaticOrder, MidMerge>(lds, g, So, E, Mh); }
    }
    SEAM(5);
    for (int rep = 0; rep < 1 + ((PROBE_DUP >> 6) & 1); ++rep)
    if (IN(6)) { pg8::Gemm g{(const bf16*)(a.ws + WS_H), (const bf16*)(a.ws + WS_WOUT), T, D, D}; pg8::StaticOrder So; So.init(T, D, G, bx);
        EpiOut E{a.in[0], (const float*)(a.ws + WS_MOD), a.out}; pg8::gemm_phase<EpiOut, pg8::StaticOrder>(lds, g, So, E); }
    SEAM(6);
    for (int rep = 0; rep < 1 + ((PROBE_DUP >> 7) & 1); ++rep)
    if (IN(7)) { ph_norm(a, a.out, a.in[16], 6144, 8192, (bf16*)(a.ws + WS_H)); ph_quant_uv(a); }
    SEAM(7);
    for (int rep = 0; rep < 1 + ((PROBE_DUP >> 8) & 1); ++rep)
    if (IN(8)) { pg8::Gemm g{(const bf16*)(a.ws + WS_H), (const bf16*)(a.ws + WS_WPQ), T, D, D}; pg8::StaticOrder So; So.init(T, D, G, bx);
        EpiF32 E{(float*)(a.ws + WS_QP), D}; pg8::gemm_phase<EpiF32, pg8::StaticOrder>(lds, g, So, E); }
    SEAM(8);
    for (int rep = 0; rep < 1 + ((PROBE_DUP >> 9) & 1); ++rep)
    if (IN(9)) { ph_route(a, lds); __syncthreads(); }
    SEAM(9);
    if (IN(10)) { if ((PROBE_DUP >> 10) & 1) { ph_experts(a, *(const float*)(a.ws + WS_CTL + 64)); asm volatile("s_waitcnt vmcnt(0)" ::: "memory"); __syncthreads(); } ph_experts(a, 1.f); }
#undef IN
#undef SEAM
}

extern "C" void kernel_launch(void* const* d_in, const int* in_sizes, int n_in, void* d_out, int out_size, void* d_ws, size_t ws_size, hipStream_t stream) {
    static int grid = 0;
    if (grid == 0) {
        if (n_in != 23 || out_size != T * D || ws_size < WS_END4) { fprintf(stderr, "kernel_launch: unexpected problem shape (n_in %d, out %d, ws %zu); nothing launched\n", n_in, out_size, ws_size); grid = -1; return; }
        int dev = 0, cus = 0, per_cu = 0;
        if (hipGetDevice(&dev) != hipSuccess || hipDeviceGetAttribute(&cus, hipDeviceAttributeMultiprocessorCount, dev) != hipSuccess) { grid = -1; return; }
        if (hipFuncSetAttribute((const void*)fwd_kernel, hipFuncAttributeMaxDynamicSharedMemorySize, LDS_BYTES) != hipSuccess) { fprintf(stderr, "kernel_launch: hipFuncSetAttribute failed\n"); grid = -1; return; }
        if (hipOccupancyMaxActiveBlocksPerMultiprocessor(&per_cu, (const void*)fwd_kernel, NTHREADS, LDS_BYTES) != hipSuccess || per_cu < 1) { fprintf(stderr, "kernel_launch: occupancy query says %d\n", per_cu); }
        (void)hipGetLastError();
        grid = cus;
    }
    if (grid < 0) return;
    hipMemsetAsync((char*)d_ws + WS_CTL, 0, CTL_ZERO_BYTES, stream);
    Args a{};
    for (int i = 0; i < 23; ++i) a.in[i] = (const float*)d_in[i];
    a.out = (float*)d_out; a.ws = (unsigned char*)d_ws;
#if MK_ONE_LAUNCH
#if PROBE_PREFIX >= 0
    a.ph_lo = 0; a.ph_hi = PROBE_PREFIX + 1;
    hipLaunchKernelGGL(fwd_kernel, dim3(grid), dim3(NTHREADS), LDS_BYTES, stream, a);
    hipMemsetAsync((char*)d_ws + WS_CTL, 0, CTL_ZERO_BYTES, stream);
#endif
    a.ph_lo = 0; a.ph_hi = N_PHASES;
    hipLaunchKernelGGL(fwd_kernel, dim3(grid), dim3(NTHREADS), LDS_BYTES, stream, a);
#else
    for (int p = 0; p < N_PHASES; ++p) { a.ph_lo = p; a.ph_hi = p + 1; hipLaunchKernelGGL(fwd_kernel, dim3(grid), dim3(NTHREADS), LDS_BYTES, stream, a); }
#endif
}
```

```cpp
#include <hip/hip_runtime.h>
#include <cstdio>
#include <cstdint>

#ifndef PROBE_DUP
#define PROBE_DUP 0
#endif
#ifndef PROBE_PREFIX
#define PROBE_PREFIX -1
#endif
#ifndef MK_ONE_LAUNCH
#define MK_ONE_LAUNCH 1
#endif

__device__ __forceinline__ int phase_tid() { int t = threadIdx.x; asm volatile("" : "+v"(t)); return t; }
namespace pg8 {
#define PG8_LAS __attribute__((address_space(3)))
typedef unsigned short bf16_t;
typedef short bf16x8 __attribute__((ext_vector_type(8)));
typedef float f32x4 __attribute__((ext_vector_type(4)));
typedef unsigned u32x4 __attribute__((ext_vector_type(4)));
typedef unsigned u32x2 __attribute__((ext_vector_type(2)));
constexpr int BM = 256, BK = 64, HALF = 128, HTB = HALF * BK * 2, STAGE_BYTES = 8 * HTB, NXCD = 8, WGM = 8;

__host__ __device__ __forceinline__ int lds_byte(int r, int c) { const int st = (r >> 4) * 2 + (c >> 5), rr = r & 15, cc = c & 31, ob = rr * 64 + cc * 2; return st * 1024 + (ob ^ (((ob >> 9) & 1) << 5)); }
__host__ __device__ __forceinline__ void stage_rc(int b, int& R, int& C) { const int st = b / 1024, sb = b % 1024, swz = sb ^ (((sb >> 9) & 1) << 5); R = (st >> 1) * 16 + swz / 64; C = (st & 1) * 32 + (swz % 64) / 2; }
__host__ __device__ __forceinline__ int perm32(int rho) { const int n = rho >> 4, i = rho & 15; return 8 * (i >> 2) + 4 * n + (i & 3); }

struct Unit { int pm, pn; };
struct Gemm { const bf16_t* A; const bf16_t* Bt; int M, N, K; };

struct StaticOrder {
    int nM, nN, nwg, G, c;
    __host__ __device__ void init(int M, int N, int G_, int c_) { nM = M / BM; nN = N / BM; nwg = nM * nN; G = G_; c = c_; }
    __host__ __device__ bool next(int i, Unit& u) const {
        const long L = (long)i * G + c; if (L >= nwg) return false;
        int wgid = (int)L; { const int q = nwg / NXCD, r = nwg % NXCD, xcd = wgid % NXCD, off = wgid / NXCD; wgid = (xcd < r ? xcd * (q + 1) : r * (q + 1) + (xcd - r) * q) + off; }
        const int nig = WGM * nN, gid = wgid / nig, fm = gid * WGM, gsz = (nM - fm) < WGM ? (nM - fm) : WGM;
        u.pm = fm + ((wgid % nig) % gsz); u.pn = (wgid % nig) / gsz; return true;
    }
    __device__ __forceinline__ void a_ready(const Unit&) const {}
    __device__ __forceinline__ void done(const Unit&) const {}
};

__device__ __forceinline__ unsigned cvt_pk_bf16(float lo, float hi) { unsigned r; asm volatile("v_cvt_pk_bf16_f32 %0, %1, %2" : "=v"(r) : "v"(lo), "v"(hi)); return r; }

typedef int i32x4 __attribute__((ext_vector_type(4)));
typedef int i32x8 __attribute__((ext_vector_type(8)));
template <bool F8> __device__ __forceinline__ void mma_blk(f32x4 (&acc)[4][2], const bf16x8 (&At)[4][2], const bf16x8 (&Bt)[2][2]) {
    if constexpr (F8) {
#pragma unroll
        for (int m = 0; m < 4; ++m)
#pragma unroll
            for (int n = 0; n < 2; ++n) {
                const i32x8 bb = __builtin_shufflevector(__builtin_bit_cast(i32x4, Bt[n][0]), __builtin_bit_cast(i32x4, Bt[n][1]), 0, 1, 2, 3, 4, 5, 6, 7);
                const i32x8 aa = __builtin_shufflevector(__builtin_bit_cast(i32x4, At[m][0]), __builtin_bit_cast(i32x4, At[m][1]), 0, 1, 2, 3, 4, 5, 6, 7);
                asm volatile("v_mfma_f32_16x16x128_f8f6f4 %0, %1, %2, %0" : "+v"(acc[m][n]) : "v"(bb), "v"(aa)); }
    } else {
#pragma unroll
        for (int m = 0; m < 4; ++m)
#pragma unroll
            for (int n = 0; n < 2; ++n)
#pragma unroll
                for (int k = 0; k < 2; ++k) acc[m][n] = __builtin_amdgcn_mfma_f32_16x16x32_bf16(Bt[n][k], At[m][k], acc[m][n], 0, 0, 0);
    }
}
struct NoMid { static constexpr int AT = -1; __device__ __forceinline__ void operator()(f32x4 (&)[2][2][4][2], const Unit&, int, int, int, int) const {} };
template <class Epi, class Sched, class Mid = NoMid, bool F8 = false>
__device__ __forceinline__ void gemm_phase(PG8_LAS unsigned char* lds, const Gemm g, const Sched& S, const Epi& E, const Mid& Mh = Mid()) {
    const int tid = phase_tid(), wid = __builtin_amdgcn_readfirstlane(tid >> 6), lane = tid & 63, wr = wid >> 2, wc = wid & 3, fr = lane & 15, fq = lane >> 4;
    const int K = g.K, nt = K / BK;
    unsigned voffA[2], voffB[2];
#pragma unroll
    for (int i = 0; i < 2; ++i) { int R, C; stage_rc(tid * 16 + i * 8192, R, C); const int Rb = Epi::PERM ? ((R & ~31) + perm32(R & 31)) : R;
        voffA[i] = (unsigned)(R * K + C) * 2u; voffB[i] = (unsigned)(Rb * K + C) * 2u; }
    const size_t kstep = (size_t)(BK * 2);
    const size_t hstep = (size_t)HALF * K * 2;
    const size_t tstep = 2 * hstep;
    const unsigned ldsw = (unsigned)wid * 1024u;
    const int aoff = lds_byte(wr * 64 + fr, fq * 8), boff = lds_byte(wc * 32 + fr, fq * 8);
#define PG8_SA(b, h) (((b) * 2 + (h)) * HTB)
#define PG8_SB(b, h) ((4 + (b) * 2 + (h)) * HTB)
#define PG8_STAGE(bufoff, gbase, voff) do { _Pragma("unroll") for (int _i = 0; _i < 2; ++_i) \
        __builtin_amdgcn_global_load_lds((const unsigned*)((const char*)(gbase) + (voff)[_i]), (PG8_LAS unsigned*)(lds + (bufoff) + ldsw + _i * 8192), 16, 0, 0); } while (0)
#define PG8_LDA(dst, b, h) do { _Pragma("unroll") for (int m = 0; m < 4; ++m) _Pragma("unroll") for (int k = 0; k < 2; ++k) dst[m][k] = *(const PG8_LAS bf16x8*)(lds + PG8_SA(b, h) + aoff + m * 2048 + k * 1024); } while (0)
#define PG8_LDB(dst, b, h) do { _Pragma("unroll") for (int n = 0; n < 2; ++n) _Pragma("unroll") for (int k = 0; k < 2; ++k) dst[n][k] = *(const PG8_LAS bf16x8*)(lds + PG8_SB(b, h) + boff + n * 2048 + k * 1024); } while (0)
#define PG8_MMA(ai, bj, At, Bt) do { __builtin_amdgcn_s_setprio(1); if constexpr (F8) { mma_blk<true>(acc[ai][bj], At, Bt); } else { _Pragma("unroll") for (int m = 0; m < 4; ++m) _Pragma("unroll") for (int n = 0; n < 2; ++n) _Pragma("unroll") for (int k = 0; k < 2; ++k) \
        acc[ai][bj][m][n] = __builtin_amdgcn_mfma_f32_16x16x32_bf16(Bt[n][k], At[m][k], acc[ai][bj][m][n], 0, 0, 0); } __builtin_amdgcn_s_setprio(0); } while (0)
#define PG8_WAIT_V(n) asm volatile("s_waitcnt vmcnt(" #n ")" ::: "memory")
#define PG8_WAIT_L(n) asm volatile("s_waitcnt lgkmcnt(" #n ")" ::: "memory")
#define PG8_BAR __builtin_amdgcn_s_barrier()
#define PG8_SCHED __builtin_amdgcn_sched_barrier(0)
    Unit cur, nxt; int ui = 0;
    if (!S.next(0, cur)) return;
    f32x4 acc[2][2][4][2];
#pragma unroll
    for (int a = 0; a < 2; ++a)
#pragma unroll
        for (int b = 0; b < 2; ++b)
#pragma unroll
            for (int m = 0; m < 4; ++m)
#pragma unroll
                for (int n = 0; n < 2; ++n) acc[a][b][m][n] = (f32x4){0.f, 0.f, 0.f, 0.f};
    bf16x8 At[4][2], B0[2][2], B1[2][2];
    const char* cA = (const char*)g.A + (size_t)cur.pm * tstep; const char* cB = (const char*)g.Bt + (size_t)cur.pn * tstep;
    S.a_ready(cur);
    PG8_STAGE(PG8_SB(0, 0), cB, voffB); PG8_STAGE(PG8_SA(0, 0), cA, voffA); PG8_STAGE(PG8_SB(0, 1), cB + hstep, voffB); PG8_STAGE(PG8_SA(0, 1), cA + hstep, voffA);
    if (wr == 1) PG8_BAR;
    PG8_WAIT_V(4); PG8_BAR;
    PG8_STAGE(PG8_SB(1, 0), cB + kstep, voffB); PG8_STAGE(PG8_SA(1, 0), cA + kstep, voffA); PG8_STAGE(PG8_SB(1, 1), cB + hstep + kstep, voffB);
    PG8_WAIT_V(6); PG8_BAR;
    for (;;) {
        const bool has_next = S.next(ui + 1, nxt);
        const char* nA = has_next ? (const char*)g.A + (size_t)nxt.pm * tstep : cA; const char* nB = has_next ? (const char*)g.Bt + (size_t)nxt.pn * tstep : cB;
#define PG8_KBODY \
            const bool last = (t == nt - 2); \
            const char* a1 = cA + (size_t)(t + 1) * kstep; \
            const char* a2 = last ? nA : cA + (size_t)(t + 2) * kstep; const char* b2 = last ? nB : cB + (size_t)(t + 2) * kstep; \
            const char* a3 = a2 + kstep; const char* b3 = b2 + kstep; \
            if (last && has_next) S.a_ready(nxt); \
            PG8_LDB(B0, 0, 0); PG8_SCHED; PG8_LDA(At, 0, 0); PG8_STAGE(PG8_SA(1, 1), a1 + hstep, voffA); \
            PG8_WAIT_L(8); PG8_BAR; PG8_WAIT_L(0); PG8_MMA(0, 0, At, B0); PG8_BAR; PG8_SCHED; \
            PG8_LDB(B1, 0, 1); PG8_STAGE(PG8_SB(0, 0), b2, voffB); \
            PG8_BAR; PG8_WAIT_L(0); PG8_MMA(0, 1, At, B1); PG8_BAR; \
            PG8_LDA(At, 0, 1); PG8_STAGE(PG8_SA(0, 0), a2, voffA); \
            PG8_BAR; PG8_WAIT_L(0); PG8_MMA(1, 0, At, B0); PG8_BAR; PG8_SCHED; \
            PG8_STAGE(PG8_SB(0, 1), b2 + hstep, voffB); \
            PG8_WAIT_V(6); PG8_BAR; PG8_MMA(1, 1, At, B1); PG8_BAR; \
            PG8_LDB(B0, 1, 0); PG8_SCHED; PG8_LDA(At, 1, 0); PG8_STAGE(PG8_SA(0, 1), a2 + hstep, voffA); \
            PG8_WAIT_L(8); PG8_BAR; PG8_WAIT_L(0); PG8_MMA(0, 0, At, B0); PG8_BAR; PG8_SCHED; \
            PG8_LDB(B1, 1, 1); PG8_STAGE(PG8_SB(1, 0), b3, voffB); \
            PG8_BAR; PG8_WAIT_L(0); PG8_MMA(0, 1, At, B1); PG8_BAR; \
            PG8_LDA(At, 1, 1); PG8_STAGE(PG8_SA(1, 0), a3, voffA); \
            PG8_BAR; PG8_WAIT_L(0); PG8_MMA(1, 0, At, B0); PG8_BAR; PG8_SCHED; \
            PG8_STAGE(PG8_SB(1, 1), b3 + hstep, voffB); \
            PG8_WAIT_V(6); PG8_BAR; PG8_MMA(1, 1, At, B1); PG8_BAR;
        if constexpr (Mid::AT >= 0) {
            for (int t = 0; t < Mid::AT; t += 2) { PG8_KBODY }
            if constexpr (F8) asm volatile("s_nop 15\n\ts_nop 15" ::: "memory");
            Mh(acc, cur, wr, wc, fr, fq);
            for (int t = Mid::AT; t < nt; t += 2) { PG8_KBODY }
        } else {
            for (int t = 0; t < nt; t += 2) { PG8_KBODY }
        }
#undef PG8_KBODY
        if constexpr (F8) asm volatile("s_nop 15\n\ts_nop 15" ::: "memory");
        E(acc, cur, wr, wc, fr, fq); S.done(cur);
        if (!has_next) break;
#pragma unroll
        for (int a = 0; a < 2; ++a)
#pragma unroll
            for (int b = 0; b < 2; ++b)
#pragma unroll
                for (int m = 0; m < 4; ++m)
#pragma unroll
                    for (int n = 0; n < 2; ++n) acc[a][b][m][n] = (f32x4){0.f, 0.f, 0.f, 0.f};
        cur = nxt; cA = nA; cB = nB; ++ui;
    }
    PG8_WAIT_V(0);
    if (wr == 0) PG8_BAR;
    PG8_BAR;
#undef PG8_SA
#undef PG8_SB
#undef PG8_STAGE
#undef PG8_LDA
#undef PG8_LDB
#undef PG8_MMA
#undef PG8_WAIT_V
#undef PG8_WAIT_L
#undef PG8_BAR
#undef PG8_SCHED
}
}

#define GAS __attribute__((address_space(1)))
#define LAS __attribute__((address_space(3)))
typedef unsigned short bf16;
typedef float f32x4 __attribute__((ext_vector_type(4)));
typedef unsigned v4u __attribute__((ext_vector_type(4)));
typedef unsigned v2u __attribute__((ext_vector_type(2)));

constexpr int NB = 4, S = 4096, D = 2048, T = NB * S, HD = 128;
constexpr int IN_COLS = 11288, OFF_KV = 1024, OFF_GATE = 2560, OFF_DIL = 2584, OFF_MERGE = 7192;
constexpr int NPROJ = 11264;
constexpr int NQ = 1024, NKV = 1536, NDL = 4608, NMG = 4096;
constexpr int NC = 255, NS = 64;
constexpr int NE = 16384;
constexpr float EPS = 1e-6f;
constexpr float QSCALE = 0.08838834764831845f;
constexpr int NWAVES = 8, NTHREADS = 512;

constexpr size_t MiB = 1u << 20;
constexpr size_t WS_CTL = 0, CTL_ZERO_BYTES = 1 * MiB;
constexpr size_t WS_WIN = 1 * MiB;
constexpr size_t WS_WBN = 45 * MiB;
constexpr size_t WS_WBD = 49 * MiB;
constexpr size_t WS_WOUT = 51 * MiB;
constexpr size_t WS_WPQ = 59 * MiB;
constexpr size_t WS_WGATE = 67 * MiB;
constexpr size_t WS_MOD = 67 * MiB + 256 * 1024;
constexpr size_t WS_SEL = 67 * MiB + 512 * 1024;
constexpr size_t WS_GATES = 68 * MiB;
constexpr size_t WS_KC = 70 * MiB;
constexpr size_t WS_VC = 71 * MiB;
constexpr size_t WS_H = 72 * MiB;
constexpr size_t WS_Q = 136 * MiB;
constexpr size_t WS_KV = 168 * MiB;
constexpr size_t WS_DL = 216 * MiB;
constexpr size_t WS_MG = 360 * MiB;
constexpr size_t WS_YN = 488 * MiB;
constexpr size_t WS_YD = 520 * MiB;
constexpr size_t WS_H8 = WS_YN;
constexpr size_t WS_EI = 536 * MiB;
constexpr size_t WS_EG = 544 * MiB;
constexpr size_t WS_END = 552 * MiB;
constexpr size_t WS_PU = WS_Q;
constexpr size_t WS_PV = WS_Q + 64 * MiB;
constexpr size_t WS_QP = WS_MG;
static_assert(WS_PV + 64 * MiB <= WS_MG, "u/v overlay");

constexpr int LDS_BYTES = 147456;
constexpr int LDS_MISC = 144 * 1024 - 256;

#define XB_TMO      128
#define XB_XCNT(j)  (256  + 64 * (j))
#define XB_XSUB(j)  (1280 + 64 * (j))
#define XB_XGEN(j)  (2304 + 64 * (j))
#define XB_TOP      3328
#define XB_TOPGEN   3392
#define XCD_BAR_WORDS 3456
#define XB_SPIN_CAP (1u << 24)

__device__ __forceinline__ unsigned xb_ld(unsigned* p)              { return __hip_atomic_load(p, __ATOMIC_RELAXED, __HIP_MEMORY_SCOPE_AGENT); }
__device__ __forceinline__ unsigned xb_add(unsigned* p, unsigned v) { return __hip_atomic_fetch_add(p, v, __ATOMIC_RELAXED, __HIP_MEMORY_SCOPE_AGENT); }
__device__ __forceinline__ unsigned xb_xcc_id() { return (unsigned)__builtin_amdgcn_s_getreg((3 << 11) | 20) & 0xFu; }
#define XB_SPIN(cond, bar) do { unsigned _sp = 0; while (cond) { __builtin_amdgcn_s_sleep(1); \
    if ((++_sp & 255u) == 0u) { if (xb_ld(&(bar)[XB_TMO])) break; if (_sp > XB_SPIN_CAP) { atomicAdd(&(bar)[XB_TMO], 1u); break; } } } } while (0)

struct XcdBarrier { unsigned* bar; unsigned x; volatile LAS unsigned* st; };

__device__ __forceinline__ XcdBarrier xcd_barrier_post(unsigned* bar, volatile LAS unsigned* st) {
    XcdBarrier b; b.bar = bar; b.x = xb_xcc_id(); b.st = st;
    if (threadIdx.x == 0) (void)xb_add(&bar[XB_XCNT(b.x)], 1u);
    return b;
}
__device__ __forceinline__ void xcd_barrier_complete(unsigned* bar, unsigned x, unsigned& nloc, unsigned& nx) {
    const unsigned G = gridDim.x * gridDim.y * gridDim.z;
    unsigned sum, cnt, mine, sp = 0u;
    for (;;) {
        sum = 0u; cnt = 0u; mine = 0u;
#pragma unroll
        for (unsigned j = 0; j < 16; ++j) { const unsigned c = xb_ld(&bar[XB_XCNT(j)]); sum += c; cnt += (c > 0u) ? 1u : 0u; mine = (j == x) ? c : mine; }
        if (sum == G) break;
        __builtin_amdgcn_s_sleep(1);
        if ((++sp & 255u) == 0u) { if (xb_ld(&bar[XB_TMO])) break; if (sp > XB_SPIN_CAP) { atomicAdd(&bar[XB_TMO], 1u); break; } }
    }
    nloc = mine > 0u ? mine : 1u; nx = cnt > 0u ? cnt : 1u;
}
__device__ __forceinline__ void xcd_barrier(const XcdBarrier& b) {
    asm volatile("s_waitcnt vmcnt(0)" ::: "memory");
    __syncthreads();
    if (threadIdx.x == 0) {
        unsigned* bar = b.bar;
        __builtin_amdgcn_s_waitcnt(0);
        unsigned nloc = b.st[0], nx = b.st[1];
        if (nloc == 0u) { xcd_barrier_complete(bar, b.x, nloc, nx); b.st[0] = nloc; b.st[1] = nx; }
        const unsigned old = xb_add(&bar[XB_XSUB(b.x)], 1u);
        const unsigned gen = old / nloc;
        if (old + 1u == (gen + 1u) * nloc) {
            __builtin_amdgcn_fence(__ATOMIC_RELEASE, "agent");
            asm volatile("s_waitcnt vmcnt(0)" ::: "memory");
            const unsigned og = xb_add(&bar[XB_TOP], 1u);
            const unsigned tg = og / nx;
            if (og + 1u == (tg + 1u) * nx) xb_add(&bar[XB_TOPGEN], 1u);
            else XB_SPIN(xb_ld(&bar[XB_TOPGEN]) == tg, bar);
            __builtin_amdgcn_fence(__ATOMIC_ACQUIRE, "agent");
            xb_add(&bar[XB_XGEN(b.x)], 1u);
            asm volatile("s_waitcnt vmcnt(0)" ::: "memory");
        } else {
            XB_SPIN(xb_ld(&bar[XB_XGEN(b.x)]) == gen, bar);
            __builtin_amdgcn_fence(__ATOMIC_ACQUIRE, "agent");
            asm volatile("s_waitcnt vmcnt(0)" ::: "memory");
        }
    }
    __syncthreads();
}

__device__ __forceinline__ unsigned f2bf(float f) { unsigned u = __builtin_bit_cast(unsigned, f); return (u + 0x7fffu + ((u >> 16) & 1u)) >> 16; }
__device__ __forceinline__ unsigned pk2(float lo, float hi) { return f2bf(lo) | (f2bf(hi) << 16); }
__device__ __forceinline__ unsigned pk4_f8(float a, float b, float c, float d) {
    a = __builtin_amdgcn_fmed3f(a, -448.f, 448.f); b = __builtin_amdgcn_fmed3f(b, -448.f, 448.f); c = __builtin_amdgcn_fmed3f(c, -448.f, 448.f); d = __builtin_amdgcn_fmed3f(d, -448.f, 448.f);
    int w = 0; w = __builtin_amdgcn_cvt_pk_fp8_f32(a, b, w, false); w = __builtin_amdgcn_cvt_pk_fp8_f32(c, d, w, true); return (unsigned)w; }
constexpr float F8_HS = 8.f, F8_WS = 128.f, F8_MS = 64.f;
__device__ __forceinline__ float bflo(unsigned u) { return __builtin_bit_cast(float, u << 16); }
__device__ __forceinline__ float bfhi(unsigned u) { return __builtin_bit_cast(float, u & 0xffff0000u); }
__device__ __forceinline__ float bf2f(bf16 u) { return __builtin_bit_cast(float, (unsigned)u << 16); }
__device__ __forceinline__ float wave_sum(float v) {
#pragma unroll
    for (int o = 1; o < 64; o <<= 1) v += __shfl_xor(v, o);
    return v;
}
__device__ __forceinline__ float wave_max(float v) {
#pragma unroll
    for (int o = 1; o < 64; o <<= 1) v = fmaxf(v, __shfl_xor(v, o));
    return v;
}
__device__ __forceinline__ float sigmoidf(float x) { return __builtin_amdgcn_rcpf(1.f + __expf(-x)); }
__device__ __forceinline__ float gelu_tanh(float x) { const float u = 0.7978845608028654f * (x + 0.044715f * x * x * x); return 0.5f * x * (1.f + tanhf(u)); }
__device__ __forceinline__ int t5_bucket(int n) {
    if (n < 16) return n;
    int b = 16;
    b += (n >= 22); b += (n >= 30); b += (n >= 40); b += (n >= 54); b += (n >= 73); b += (n >= 99); b += (n >= 134); b += (n >= 182);
    b += (n >= 246); b += (n >= 332); b += (n >= 450); b += (n >= 609); b += (n >= 825); b += (n >= 1117); b += (n >= 1513);
    return b;
}

struct Args {
    const float* in[23];
    float* out; unsigned char* ws;
    int ph_lo, ph_hi;
};

typedef float f32x2v __attribute__((ext_vector_type(2)));
__device__ __forceinline__ void ph0_mod(const Args& a, LAS unsigned char* lds) {
    const int tid = phase_tid(), lane = tid & 63, wave = __builtin_amdgcn_readfirstlane(tid >> 6);
    LAS float* cs = (LAS float*)lds;
    LAS float* red = (LAS float*)(lds + 32768);
    const float* c = a.in[1]; const float* w_ada = a.in[2]; const float* b_ada = a.in[3];
    float* mod = (float*)(a.ws + WS_MOD);
    for (int i = tid; i < 4 * 2048; i += NTHREADS) { const float v = c[i]; cs[i] = v / (1.f + __expf(-v)); }
    __syncthreads();
    for (int u = blockIdx.x; u < 12288 / 128; u += gridDim.x) {
        const int col = u * 128 + 2 * lane;
        float acc[4][2];
#pragma unroll
        for (int b = 0; b < 4; ++b) { acc[b][0] = 0.f; acc[b][1] = 0.f; }
        const float* wp = w_ada + (size_t)(wave * 256) * 12288 + col;
#pragma unroll 1
        for (int k0 = 0; k0 < 256; k0 += 16) {
            f32x2v w[16];
#pragma unroll
            for (int k = 0; k < 16; ++k) w[k] = *(const f32x2v*)(wp + (size_t)(k0 + k) * 12288);
#pragma unroll
            for (int k = 0; k < 16; ++k) { const int kk = wave * 256 + k0 + k;
#pragma unroll
                for (int b = 0; b < 4; ++b) { const float cv = cs[b * 2048 + kk]; acc[b][0] += cv * w[k].x; acc[b][1] += cv * w[k].y; } }
        }
#pragma unroll
        for (int b = 0; b < 4; ++b) { red[(wave * 4 + b) * 128 + 2 * lane] = acc[b][0]; red[(wave * 4 + b) * 128 + 2 * lane + 1] = acc[b][1]; }
        __syncthreads();
        { const int b = tid >> 7, cc = tid & 127; float s = 0.f;
#pragma unroll
          for (int w = 0; w < 8; ++w) s += red[(w * 4 + b) * 128 + cc];
          mod[b * 12288 + u * 128 + cc] = s + b_ada[u * 128 + cc]; }
        __syncthreads();
    }
}
__device__ __forceinline__ void transpose_item(const float* W, int ldw, int ncols, int K, bf16* WT, int row_off, LAS float* scr, int item, int lane, int ldt = 0) {
    if (ldt == 0) ldt = K;
    const int nblk = ncols / 32, kb = item / nblk, nb = item % nblk, k0 = 64 * kb, n0 = 32 * nb;
    float tv[32];
#pragma unroll
    for (int i = 0; i < 32; ++i) tv[i] = W[(size_t)(k0 + 2 * i + (lane >> 5)) * ldw + n0 + (lane & 31)];
#pragma unroll
    for (int i = 0; i < 32; ++i) scr[(2 * i + (lane >> 5)) * 33 + (lane & 31)] = tv[i];
    asm volatile("s_waitcnt lgkmcnt(0)" ::: "memory");
    const int c = lane & 7;
#pragma unroll
    for (int j = 0; j < 4; ++j) { const int n = (lane >> 3) + 8 * j; const LAS float* s = scr + (8 * c) * 33 + n;
        v4u o; o.x = pk2(s[0 * 33], s[1 * 33]); o.y = pk2(s[2 * 33], s[3 * 33]); o.z = pk2(s[4 * 33], s[5 * 33]); o.w = pk2(s[6 * 33], s[7 * 33]);
        *(v4u*)(WT + (size_t)(row_off + n0 + n) * ldt + k0 + 8 * c) = o; }
    asm volatile("s_waitcnt lgkmcnt(0)" ::: "memory");
}
__device__ __forceinline__ void transpose_item_f8(const float* W, int ldw, int ncols, int K, unsigned char* WT, int row_off, LAS float* scr, int item, int lane) {
    const int nblk = ncols / 32, kb = item / nblk, nb = item % nblk, k0 = 64 * kb, n0 = 32 * nb;
    float tv[32];
#pragma unroll
    for (int i = 0; i < 32; ++i) tv[i] = W[(size_t)(k0 + 2 * i + (lane >> 5)) * ldw + n0 + (lane & 31)];
#pragma unroll
    for (int i = 0; i < 32; ++i) scr[(2 * i + (lane >> 5)) * 33 + (lane & 31)] = tv[i] * F8_WS;
    asm volatile("s_waitcnt lgkmcnt(0)" ::: "memory");
    const int c = lane & 7;
#pragma unroll
    for (int j = 0; j < 4; ++j) { const int n = (lane >> 3) + 8 * j; const LAS float* s = scr + (8 * c) * 33 + n;
        v2u o; o.x = pk4_f8(s[0 * 33], s[1 * 33], s[2 * 33], s[3 * 33]); o.y = pk4_f8(s[4 * 33], s[5 * 33], s[6 * 33], s[7 * 33]);
        *(v2u*)(WT + (size_t)(row_off + n0 + n) * K + k0 + 8 * c) = o; }
    asm volatile("s_waitcnt lgkmcnt(0)" ::: "memory");
}
__device__ __forceinline__ void ph0_weights(const Args& a, LAS unsigned char* lds) {
    const int tid = phase_tid(), lane = tid & 63, wave = __builtin_amdgcn_readfirstlane(tid >> 6);
    LAS float* scr = (LAS float*)(lds + wave * 16384);
    const int gw = blockIdx.x * NWAVES + wave, NGW = gridDim.x * NWAVES;
    const float* w_in = a.in[5];
    unsigned char* WIN = a.ws + WS_WIN;
    constexpr int I_Q = 32 * (NQ / 32), I_KV = 32 * (NKV / 32), I_DL = 32 * (NDL / 32), I_MG = 32 * (NMG / 32);
    constexpr int I_BN = 16 * 64, I_BD = 8 * 64, I_O = 32 * 64, I_PQ = 32 * 64;
    constexpr int NITEMS = I_Q + I_KV + I_DL + I_MG + I_BN + I_BD + I_O + I_PQ;
    for (int it = gw; it < NITEMS; it += NGW) {
        int r = it;
        if (r < I_Q)  { transpose_item_f8(w_in, IN_COLS, NQ, D, WIN, 0, scr, r, lane); continue; } r -= I_Q;
        if (r < I_KV) { transpose_item_f8(w_in + OFF_KV, IN_COLS, NKV, D, WIN, NQ, scr, r, lane); continue; } r -= I_KV;
        if (r < I_DL) { transpose_item_f8(w_in + OFF_DIL, IN_COLS, NDL, D, WIN, NQ + NKV, scr, r, lane); continue; } r -= I_DL;
        if (r < I_MG) { transpose_item_f8(w_in + OFF_MERGE, IN_COLS, NMG, D, WIN, NQ + NKV + NDL, scr, r, lane); continue; } r -= I_MG;
        if (r < I_BN) { transpose_item(a.in[13], D, D, 1024, (bf16*)(a.ws + WS_WBN), 0, scr, r, lane, 1536); continue; } r -= I_BN;
        if (r < I_BD) { transpose_item(a.in[14], D, D, 512, (bf16*)(a.ws + WS_WBN) + 1024, 0, scr, r, lane, 1536); continue; } r -= I_BD;
        if (r < I_O)  { transpose_item_f8(a.in[15], D, D, D, a.ws + WS_WOUT, 0, scr, r, lane); continue; } r -= I_O;
        transpose_item(a.in[17], D, D, D, (bf16*)(a.ws + WS_WPQ), 0, scr, r, lane);
    }
}

constexpr size_t WS_CW1F = 602 * MiB;
constexpr size_t WS_WGF = 604 * MiB;
constexpr size_t WS_CBP = 604 * MiB + 256 * 1024;
constexpr size_t WS_END4 = 605 * MiB;
__device__ __forceinline__ void ph0_extra(const Args& a) {
    const int tid = phase_tid(), lane = tid & 63, wave = __builtin_amdgcn_readfirstlane(tid >> 6);
    const float* w1 = a.in[9]; const float* pos = a.in[8]; const float* w_in = a.in[5];
    v4u* CW = (v4u*)(a.ws + WS_CW1F); v4u* WG = (v4u*)(a.ws + WS_WGF); float* CBP = (float*)(a.ws + WS_CBP);
    for (int i = blockIdx.x * NTHREADS + tid; i < 2 * 4 * 256 * 64; i += gridDim.x * NTHREADS) {
        const int ln = i & 63, ks = (i >> 6) & 255, nt = (i >> 14) & 3, j = i >> 16;
        const float* src = w1 + ((size_t)j * 4096 + 16 * ks + 8 * (ln >> 5)) * 128 + 32 * nt + (ln & 31);
        v4u o; o.x = pk2(src[0], src[128]); o.y = pk2(src[256], src[384]); o.z = pk2(src[512], src[640]); o.w = pk2(src[768], src[896]);
        CW[i] = o;
    }
    for (int i = blockIdx.x * NTHREADS + tid; i < 128 * 64; i += gridDim.x * NTHREADS) {
        const int ln = i & 63, ks = i >> 6, jrow = ln & 31;
        v4u o = {0u, 0u, 0u, 0u};
        if (jrow < 24) { const float* src = w_in + (size_t)(16 * ks + 8 * (ln >> 5)) * IN_COLS + OFF_GATE + jrow;
            o.x = pk2(src[0], src[IN_COLS]); o.y = pk2(src[2 * (size_t)IN_COLS], src[3 * (size_t)IN_COLS]); o.z = pk2(src[4 * (size_t)IN_COLS], src[5 * (size_t)IN_COLS]); o.w = pk2(src[6 * (size_t)IN_COLS], src[7 * (size_t)IN_COLS]); }
        WG[i] = o;
    }
    { const int gw = blockIdx.x * NWAVES + wave;
      if (gw < 128) { const int kc = gw >> 1, j = gw & 1; float s0 = 0.f, s1 = 0.f; const float* wp = w1 + ((size_t)j * 4096 + 64 * kc) * 128 + lane; const float* pp = pos + j * 4096 + 64 * kc;
#pragma unroll 1
          for (int k0 = 0; k0 < 64; k0 += 16) { float wa[16], wb[16];
#pragma unroll
              for (int k = 0; k < 16; ++k) { wa[k] = wp[(k0 + k) * 128]; wb[k] = wp[(k0 + k) * 128 + 64]; }
#pragma unroll
              for (int k = 0; k < 16; ++k) { const float pv = pp[k0 + k]; s0 += pv * wa[k]; s1 += pv * wb[k]; } }
          CBP[(kc * 2 + j) * 128 + lane] = s0; CBP[(kc * 2 + j) * 128 + 64 + lane] = s1; } }
}

template <bool F8 = false>
__device__ __forceinline__ void ph_norm(const Args& a, const float* xin, const float* gvec, int sh_off, int sc_off, bf16* hout, unsigned char* h8 = nullptr) {
    const int tid = phase_tid(), lane = tid & 63, wave = __builtin_amdgcn_readfirstlane(tid >> 6);
    const int gw = blockIdx.x * NWAVES + wave, NGW = gridDim.x * NWAVES;
    const float* mod = (const float*)(a.ws + WS_MOD);
    for (int r = gw; r < S / 2; r += NGW)
#pragma unroll 1
        for (int bq = 0; bq < NB; ++bq) {
            const int m0 = bq * S + r, m1 = m0 + S / 2;
            const float* x0 = xin + (size_t)m0 * D + 8 * lane; const float* x1 = xin + (size_t)m1 * D + 8 * lane;
            f32x4 v0[8], v1[8];
#pragma unroll
            for (int c = 0; c < 4; ++c) { v0[2 * c] = *(const f32x4*)(x0 + 512 * c); v0[2 * c + 1] = *(const f32x4*)(x0 + 512 * c + 4); v1[2 * c] = *(const f32x4*)(x1 + 512 * c); v1[2 * c + 1] = *(const f32x4*)(x1 + 512 * c + 4); }
            float s0 = 0.f, s1 = 0.f;
#pragma unroll
            for (int i = 0; i < 8; ++i) { s0 += (v0[i].x * v0[i].x + v0[i].y * v0[i].y) + (v0[i].z * v0[i].z + v0[i].w * v0[i].w); s1 += (v1[i].x * v1[i].x + v1[i].y * v1[i].y) + (v1[i].z * v1[i].z + v1[i].w * v1[i].w); }
            const float r0 = rsqrtf(wave_sum(s0) * (1.f / D) + EPS), r1 = rsqrtf(wave_sum(s1) * (1.f / D) + EPS);
            const float* shp = mod + bq * 12288 + sh_off + 8 * lane; const float* scp = mod + bq * 12288 + sc_off + 8 * lane; const float* gp = gvec + 8 * lane;
#pragma unroll
            for (int c = 0; c < 4; ++c) {
                v4u o0, o1; unsigned w0[4], w1[4]; [[maybe_unused]] unsigned q0[2], q1[2];
#pragma unroll
                for (int hq = 0; hq < 2; ++hq) { const f32x4 g = *(const f32x4*)(gp + 512 * c + 4 * hq), sc = *(const f32x4*)(scp + 512 * c + 4 * hq), sh = *(const f32x4*)(shp + 512 * c + 4 * hq);
                    const f32x4 ga = g * (1.f + sc); const f32x4 y0 = v0[2 * c + hq] * r0 * ga + sh, y1 = v1[2 * c + hq] * r1 * ga + sh;
                    w0[2 * hq] = pk2(y0.x, y0.y); w0[2 * hq + 1] = pk2(y0.z, y0.w); w1[2 * hq] = pk2(y1.x, y1.y); w1[2 * hq + 1] = pk2(y1.z, y1.w);
                    if constexpr (F8) { q0[hq] = pk4_f8(y0.x * F8_HS, y0.y * F8_HS, y0.z * F8_HS, y0.w * F8_HS); q1[hq] = pk4_f8(y1.x * F8_HS, y1.y * F8_HS, y1.z * F8_HS, y1.w * F8_HS); } }
                o0.x = w0[0]; o0.y = w0[1]; o0.z = w0[2]; o0.w = w0[3]; o1.x = w1[0]; o1.y = w1[1]; o1.z = w1[2]; o1.w = w1[3];
                *(v4u*)(hout + (size_t)m0 * D + 512 * c + 8 * lane) = o0; *(v4u*)(hout + (size_t)m1 * D + 512 * c + 8 * lane) = o1;
                if constexpr (F8) { v2u p0, p1; p0.x = q0[0]; p0.y = q0[1]; p1.x = q1[0]; p1.y = q1[1];
                    *(v2u*)(h8 + (size_t)m0 * D + 512 * c + 8 * lane) = p0; *(v2u*)(h8 + (size_t)m1 * D + 512 * c + 8 * lane) = p1; }
            }
        }
}

using pg8::Unit; using pg8::HALF; using pg8::BM;
struct EpiProj {
    static constexpr bool PERM = true;
    bf16 *q, *kv, *dl, *mg;
    __device__ __forceinline__ void operator()(const f32x4 (&acc)[2][2][4][2], const Unit& u, int wr, int wc, int fr, int fq) const {
        bf16* base; int ldc, colt = u.pn * BM;
        if (colt < NQ) { base = q; ldc = NQ; } else if (colt < NQ + NKV) { base = kv; ldc = NKV; colt -= NQ; } else if (colt < NQ + NKV + NDL) { base = dl; ldc = NDL; colt -= NQ + NKV; } else { base = mg; ldc = NMG; colt -= NQ + NKV + NDL; }
        const int row0 = u.pm * BM + wr * 64 + fr, col0 = colt + wc * 32 + 8 * fq;
#pragma unroll
        for (int ai = 0; ai < 2; ++ai)
#pragma unroll
            for (int m = 0; m < 4; ++m) { bf16* rowp = base + (size_t)(row0 + ai * HALF + m * 16) * ldc + col0;
#pragma unroll
                for (int bj = 0; bj < 2; ++bj) { const f32x4 v0 = acc[ai][bj][m][0], v1 = acc[ai][bj][m][1];
                    v4u w; w.x = pg8::cvt_pk_bf16(v0[0], v0[1]); w.y = pg8::cvt_pk_bf16(v0[2], v0[3]); w.z = pg8::cvt_pk_bf16(v1[0], v1[1]); w.w = pg8::cvt_pk_bf16(v1[2], v1[3]);
                    *(v4u*)(rowp + bj * HALF) = w; } }
    }
};
struct MidMerge {
    static constexpr int AT = 16;
    const bf16* mg;
    __device__ __forceinline__ void operator()(f32x4 (&acc)[2][2][4][2], const Unit& u, int wr, int wc, int fr, int fq) const {
        int row0 = u.pm * BM + wr * 64 + fr; const int col0 = u.pn * BM + wc * 32 + 8 * fq;
        asm volatile("" : "+v"(row0));
#pragma unroll
        for (int ai = 0; ai < 2; ++ai) {
            v4u a1[4][2], a2[4][2];
#pragma unroll
            for (int m = 0; m < 4; ++m) { const bf16* rp = mg + (size_t)(row0 + ai * HALF + m * 16) * NMG + col0;
#pragma unroll
                for (int bj = 0; bj < 2; ++bj) { a1[m][bj] = *(const v4u*)(rp + bj * HALF); a2[m][bj] = *(const v4u*)(rp + 2048 + bj * HALF); } }
#pragma unroll
            for (int m = 0; m < 4; ++m)
#pragma unroll
                for (int bj = 0; bj < 2; ++bj) { const unsigned w1[4] = {a1[m][bj].x, a1[m][bj].y, a1[m][bj].z, a1[m][bj].w}, w2[4] = {a2[m][bj].x, a2[m][bj].y, a2[m][bj].z, a2[m][bj].w};
#pragma unroll
                    for (int q = 0; q < 4; ++q) { const float r0 = (1.f + __expf(-bflo(w2[q]))) * __builtin_amdgcn_rcpf(1.f + __expf(-bflo(w1[q]))), r1 = (1.f + __expf(-bfhi(w2[q]))) * __builtin_amdgcn_rcpf(1.f + __expf(-bfhi(w1[q])));
                        acc[ai][bj][m][q >> 1][2 * (q & 1)] *= r0; acc[ai][bj][m][q >> 1][2 * (q & 1) + 1] *= r1; } }
            asm volatile("" ::: "memory");
        }
    }
};
struct EpiMerge {
    static constexpr bool PERM = true;
    const bf16* mg; unsigned char* merged8; float os;
    __device__ __forceinline__ void operator()(const f32x4 (&acc)[2][2][4][2], const Unit& u, int wr, int wc, int fr, int fq) const {
        int row0 = u.pm * BM + wr * 64 + fr; const int col0 = u.pn * BM + wc * 32 + 8 * fq;
        asm volatile("" : "+v"(row0));
        v4u a2[2][4][2];
#pragma unroll
        for (int ai = 0; ai < 2; ++ai)
#pragma unroll
            for (int m = 0; m < 4; ++m)
#pragma unroll
                for (int bj = 0; bj < 2; ++bj) a2[ai][m][bj] = *(const v4u*)(mg + (size_t)(row0 + ai * HALF + m * 16) * NMG + 2048 + col0 + bj * HALF);
#pragma unroll
        for (int ai = 0; ai < 2; ++ai)
#pragma unroll
            for (int m = 0; m < 4; ++m) { const size_t row = (size_t)(row0 + ai * HALF + m * 16);
#pragma unroll
                for (int bj = 0; bj < 2; ++bj) { const unsigned w2[4] = {a2[ai][m][bj].x, a2[ai][m][bj].y, a2[ai][m][bj].z, a2[ai][m][bj].w};
                    const f32x4 v0 = acc[ai][bj][m][0] * os, v1 = acc[ai][bj][m][1] * os;
                    v2u w; w.x = pk4_f8(v0[0] * sigmoidf(bflo(w2[0])), v0[1] * sigmoidf(bfhi(w2[0])), v0[2] * sigmoidf(bflo(w2[1])), v0[3] * sigmoidf(bfhi(w2[1])));
                    w.y = pk4_f8(v1[0] * sigmoidf(bflo(w2[2])), v1[1] * sigmoidf(bfhi(w2[2])), v1[2] * sigmoidf(bflo(w2[3])), v1[3] * sigmoidf(bfhi(w2[3])));
                    *(v2u*)(merged8 + row * D + col0 + bj * HALF) = w; } }
    }
};
struct EpiOut {
    static constexpr bool PERM = false;
    const float* x; const float* mod; float* x1; float as;
    __device__ __forceinline__ void operator()(const f32x4 (&acc)[2][2][4][2], const Unit& u, int wr, int wc, int fr, int fq) const {
        const int row0 = u.pm * BM + wr * 64 + fr, col0 = u.pn * BM + wc * 32 + 4 * fq;
        const int b = (u.pm * BM) / S;
        f32x4 gv[2][2];
#pragma unroll
        for (int bj = 0; bj < 2; ++bj)
#pragma unroll
            for (int n = 0; n < 2; ++n) gv[bj][n] = *(const f32x4*)(mod + b * 12288 + 4096 + col0 + bj * HALF + n * 16) * as;
#pragma unroll
        for (int ai = 0; ai < 2; ++ai)
#pragma unroll
            for (int m = 0; m < 4; ++m) { const size_t off = (size_t)(row0 + ai * HALF + m * 16) * D + col0;
#pragma unroll
                for (int bj = 0; bj < 2; ++bj)
#pragma unroll
                    for (int n = 0; n < 2; ++n) *(f32x4*)(x1 + off + bj * HALF + n * 16) = *(const f32x4*)(x + off + bj * HALF + n * 16) + gv[bj][n] * acc[ai][bj][m][n]; }
    }
};
struct EpiF32 {
    static constexpr bool PERM = false;
    float* C; int ldc;
    __device__ __forceinline__ void operator()(const f32x4 (&acc)[2][2][4][2], const Unit& u, int wr, int wc, int fr, int fq) const {
        const int row0 = u.pm * BM + wr * 64 + fr, col0 = u.pn * BM + wc * 32 + 4 * fq;
#pragma unroll
        for (int ai = 0; ai < 2; ++ai)
#pragma unroll
            for (int m = 0; m < 4; ++m) { float* rowp = C + (size_t)(row0 + ai * HALF + m * 16) * ldc + col0;
#pragma unroll
                for (int bj = 0; bj < 2; ++bj)
#pragma unroll
                    for (int n = 0; n < 2; ++n) *(f32x4*)(rowp + bj * HALF + n * 16) = acc[ai][bj][m][n]; }
    }
};

typedef short bf16x8 __attribute__((ext_vector_type(8)));
typedef float f32x16 __attribute__((ext_vector_type(16)));
typedef float f32x2 __attribute__((ext_vector_type(2)));
typedef __bf16 bf2v __attribute__((ext_vector_type(2)));
constexpr float LOG2E = 1.4426950408889634f;
constexpr float QS2 = QSCALE * LOG2E;
constexpr float NEGB = -1e30f;
__device__ __forceinline__ unsigned pkbf(float a, float b) { const f32x2 v = {a, b}; const bf2v r = __builtin_convertvector(v, bf2v); return __builtin_bit_cast(unsigned, r); }
__device__ __forceinline__ float ex2(float x) { return __builtin_amdgcn_exp2f(x); }
__device__ __forceinline__ int swap23(int x) { return (x & ~12) | ((x & 4) << 1) | ((x & 8) >> 1); }
__device__ __forceinline__ size_t kf_off(int key, int d) { return ((size_t)((key >> 5) * 8 + (d >> 4)) * 64 + ((d >> 3) & 1) * 32 + swap23(key & 31)) * 8 + (d & 7); }
__device__ __forceinline__ size_t vf_off(int key, int d) { const int kk = key & 31; return ((size_t)(((key >> 5) * 4 + (d >> 5)) * 2 + (kk >> 4)) * 64 + ((kk >> 3) & 1) * 32 + (d & 31)) * 8 + (kk & 7); }
__device__ __forceinline__ bf16* fr_nsa(const Args& a, int bg, int kind) { return (bf16*)a.out + ((size_t)(bg * 4 + kind) << 19); }
__device__ __forceinline__ bf16* fr_dil(const Args& a, int b, int head, int kv) { return (bf16*)a.out + ((size_t)16 << 20) + ((size_t)((b * 12 + head) * 2 + kv) << 19); }
constexpr size_t WS_OD = 552 * MiB;
constexpr size_t WS_LSE = 600 * MiB;
constexpr size_t WS_END2 = 601 * MiB;

struct EpiProjNorm {
    static constexpr bool PERM = true;
    bf16 *q, *kv, *dl, *mg, *frg;
    const float *qg, *kg, *dqg, *dkg;
    LAS float* xch;
    float as;
    __device__ __forceinline__ void operator()(const f32x4 (&acc)[2][2][4][2], const Unit& u, int wr, int wc, int fr, int fq) const {
        bf16* base; int ldc, colt = u.pn * BM, mode = 0  , hsel = 0; const float* gain = qg; float scale = 1.f;
        if (colt < NQ) { base = q; ldc = NQ; mode = 1; gain = qg; scale = QS2; }
        else if (colt < NQ + NKV) { base = kv; ldc = NKV; colt -= NQ; hsel = colt >> 7; if (hsel == 4 || hsel == 8) { mode = 2; gain = kg + (hsel == 4 ? 128 : 256); } }
        else if (colt < NQ + NKV + NDL) { base = dl; ldc = NDL; colt -= NQ + NKV; hsel = colt >> 7; if (hsel < 12) { mode = 1; gain = dqg; scale = QS2; } else if (hsel < 24) { mode = 3; gain = dkg; } }
        else { base = mg; ldc = NMG; colt -= NQ + NKV + NDL; }
        const int row0 = u.pm * BM + wr * 64 + fr, col0 = colt + wc * 32 + 8 * fq;
        if (mode == 0) {
#pragma unroll
            for (int ai = 0; ai < 2; ++ai)
#pragma unroll
                for (int m = 0; m < 4; ++m) { bf16* rowp = base + (size_t)(row0 + ai * HALF + m * 16) * ldc + col0;
#pragma unroll
                    for (int bj = 0; bj < 2; ++bj) { const f32x4 v0 = acc[ai][bj][m][0] * as, v1 = acc[ai][bj][m][1] * as;
                        v4u w; w.x = pg8::cvt_pk_bf16(v0[0], v0[1]); w.y = pg8::cvt_pk_bf16(v0[2], v0[3]); w.z = pg8::cvt_pk_bf16(v1[0], v1[1]); w.w = pg8::cvt_pk_bf16(v1[2], v1[3]);
                        *(v4u*)(rowp + bj * HALF) = w; } }
            return;
        }
#pragma unroll
        for (int ai = 0; ai < 2; ++ai)
#pragma unroll
            for (int m = 0; m < 4; ++m)
#pragma unroll
                for (int bj = 0; bj < 2; ++bj) { const f32x4 v0 = acc[ai][bj][m][0], v1 = acc[ai][bj][m][1];
                    float ss = (v0[0] * v0[0] + v0[1] * v0[1]) + (v0[2] * v0[2] + v0[3] * v0[3]) + (v1[0] * v1[0] + v1[1] * v1[1]) + (v1[2] * v1[2] + v1[3] * v1[3]);
                    ss += __shfl_xor(ss, 16); ss += __shfl_xor(ss, 32);
                    if (fq == 0) xch[(((((wr * 2 + ai) * 4 + m) * 16 + fr) * 2 + bj) << 2) + wc] = ss; }
        asm volatile("s_waitcnt lgkmcnt(0)" ::: "memory");
        __builtin_amdgcn_s_barrier();
        asm volatile("" ::: "memory");
        const f32x4 ga = *(const f32x4*)(gain + wc * 32 + 8 * fq), gb = *(const f32x4*)(gain + wc * 32 + 8 * fq + 4);
#pragma unroll
        for (int ai = 0; ai < 2; ++ai)
#pragma unroll
            for (int m = 0; m < 4; ++m) { const int t = row0 + ai * HALF + m * 16, b = t / S, s = t % S;
#pragma unroll
                for (int bj = 0; bj < 2; ++bj) { const f32x4 pp = *(const LAS f32x4*)(xch + (((((wr * 2 + ai) * 4 + m) * 16 + fr) * 2 + bj) << 2));
                    const float rstd = rsqrtf(((pp.x + pp.y) + (pp.z + pp.w)) * (as * as * (1.f / 128.f)) + EPS) * (scale * as);
                    const f32x4 v0 = acc[ai][bj][m][0] * rstd * ga, v1 = acc[ai][bj][m][1] * rstd * gb;
                    v4u w; w.x = pg8::cvt_pk_bf16(v0[0], v0[1]); w.y = pg8::cvt_pk_bf16(v0[2], v0[3]); w.z = pg8::cvt_pk_bf16(v1[0], v1[1]); w.w = pg8::cvt_pk_bf16(v1[2], v1[3]);
                    bf16* dst;
                    if (mode == 1) dst = base + (size_t)t * ldc + col0 + bj * HALF;
                    else if (mode == 2) dst = frg + ((size_t)((b * 2 + bj) * 4 + (hsel == 4 ? 0 : 2)) << 19) + kf_off(s, wc * 32 + 8 * fq);
                    else { const int head = hsel - 12 + bj, dsh = 2 * (head >> 2), vk = ((s & ((1 << dsh) - 1)) << (12 - dsh)) + (s >> dsh);
                        dst = frg + ((size_t)16 << 20) + ((size_t)((b * 12 + head) * 2) << 19) + kf_off(vk, wc * 32 + 8 * fq); }
                    *(v4u*)dst = w; } }
    }
};

__device__ __forceinline__ v4u norm_chunk16v(v4u w, const float* gain, float scale, int li) {
    float v[8] = {bflo(w.x), bfhi(w.x), bflo(w.y), bfhi(w.y), bflo(w.z), bfhi(w.z), bflo(w.w), bfhi(w.w)};
    float ss = 0.f;
#pragma unroll
    for (int j = 0; j < 8; ++j) ss += v[j] * v[j];
    ss += __shfl_xor(ss, 1); ss += __shfl_xor(ss, 2); ss += __shfl_xor(ss, 4); ss += __shfl_xor(ss, 8);
    const float rstd = rsqrtf(ss * (1.f / 128.f) + EPS) * scale;
#pragma unroll
    for (int j = 0; j < 8; ++j) v[j] = v[j] * rstd * gain[8 * li + j];
    w.x = pk2(v[0], v[1]); w.y = pk2(v[2], v[3]); w.z = pk2(v[4], v[5]); w.w = pk2(v[6], v[7]);
    return w;
}
__device__ __forceinline__ void ph3_headnorm(const Args& a) {
    const int tid = phase_tid(), lane = tid & 63, wave = __builtin_amdgcn_readfirstlane(tid >> 6), sub = lane >> 4, li = lane & 15;
    const int gw = blockIdx.x * NWAVES + wave, NGW = gridDim.x * NWAVES;
    bf16* Q = (bf16*)(a.ws + WS_Q); const bf16* KV = (const bf16*)(a.ws + WS_KV); bf16* DL = (bf16*)(a.ws + WS_DL);
    const float* qg = a.in[6]; const float* kg = a.in[7]; const float* dqg = a.in[11]; const float* dkg = a.in[12];
    for (int m = gw; m < T; m += NGW) {
        const int b = m / S, s = m % S;
        const int g = sub & 1, win = sub >> 1;
        v4u wq[2], wk, wd[6];
#pragma unroll
        for (int it = 0; it < 2; ++it) wq[it] = *(const v4u*)(Q + (size_t)m * NQ + (it * 4 + sub) * 128 + 8 * li);
        wk = *(const v4u*)(KV + (size_t)m * NKV + ((win ? 8 : 4) + g) * 128 + 8 * li);
#pragma unroll
        for (int it = 0; it < 6; ++it) wd[it] = *(const v4u*)(DL + (size_t)m * NDL + (it * 4 + sub) * 128 + 8 * li);
#pragma unroll
        for (int it = 0; it < 2; ++it) *(v4u*)(Q + (size_t)m * NQ + (it * 4 + sub) * 128 + 8 * li) = norm_chunk16v(wq[it], qg, QS2, li);
        *(v4u*)(fr_nsa(a, b * 2 + g, win ? 2 : 0) + kf_off(s, 8 * li)) = norm_chunk16v(wk, kg + (win ? 256 : 128), 1.f, li);
#pragma unroll
        for (int it = 0; it < 6; ++it) { const int ch = it * 4 + sub;
            if (ch < 12) *(v4u*)(DL + (size_t)m * NDL + ch * 128 + 8 * li) = norm_chunk16v(wd[it], dqg, QS2, li);
            else { const int head = ch - 12, gi = head >> 2, dsh = 2 * gi  , vk = ((s & ((1 << dsh) - 1)) << (12 - dsh)) + (s >> dsh);
                *(v4u*)(fr_dil(a, b, head, 0) + kf_off(vk, 8 * li)) = norm_chunk16v(wd[it], dkg, 1.f, li); } }
    }
}
__device__ __forceinline__ void ph3_vfrag(const Args& a) {
    const int tid = phase_tid(), lane = tid & 63, wave = __builtin_amdgcn_readfirstlane(tid >> 6);
    const int gw = blockIdx.x * NWAVES + wave, NGW = gridDim.x * NWAVES;
    const bf16* KV = (const bf16*)(a.ws + WS_KV); const bf16* DL = (const bf16*)(a.ws + WS_DL);
    for (int job = gw; job < 32768; job += NGW) {
        const bf16* src; size_t rstride; bf16* dst; int key0;
        if (job < 8192) { const int bg = job >> 10, kind = (job >> 9) & 1, s0 = (job & 511) * 8, b = bg >> 1, g = bg & 1;
            src = KV + (size_t)(b * S + s0) * NKV + ((kind ? 10 : 6) + g) * 128; rstride = NKV; dst = fr_nsa(a, bg, kind ? 3 : 1); key0 = s0; }
        else { const int j2 = job - 8192, bh = j2 >> 9, vk0 = (j2 & 511) * 8, b = bh / 12, head = bh % 12, gi = head >> 2, dsh = 2 * gi, L = S >> dsh, r = vk0 / L, m0 = vk0 % L;
            src = DL + (size_t)(b * S + (m0 << dsh) + r) * NDL + (24 + head) * 128; rstride = (size_t)NDL << dsh; dst = fr_dil(a, b, head, 1); key0 = vk0; }
        unsigned w[8];
#pragma unroll
        for (int jj = 0; jj < 8; ++jj) w[jj] = *(const unsigned*)(src + jj * rstride + 2 * lane);
        v4u c0, c1;
        c0.x = (w[0] & 0xffffu) | (w[1] << 16); c0.y = (w[2] & 0xffffu) | (w[3] << 16); c0.z = (w[4] & 0xffffu) | (w[5] << 16); c0.w = (w[6] & 0xffffu) | (w[7] << 16);
        c1.x = (w[0] >> 16) | (w[1] & 0xffff0000u); c1.y = (w[2] >> 16) | (w[3] & 0xffff0000u); c1.z = (w[4] >> 16) | (w[5] & 0xffff0000u); c1.w = (w[6] >> 16) | (w[7] & 0xffff0000u);
        *(v4u*)(dst + vf_off(key0, 2 * lane)) = c0; *(v4u*)(dst + vf_off(key0, 2 * lane + 1)) = c1;
    }
}
__device__ __forceinline__ void ph3_gates(const Args& a) {
    const int tid = phase_tid(), lane = tid & 63, wave = __builtin_amdgcn_readfirstlane(tid >> 6), tl = lane & 31, hh = lane >> 5;
    const int gw = (gridDim.x - 1 - blockIdx.x) * NWAVES + wave, NGW = gridDim.x * NWAVES;
    const bf16* H = (const bf16*)(a.ws + WS_H); const v4u* WG = (const v4u*)(a.ws + WS_WGF) + lane; float* gates = (float*)(a.ws + WS_GATES);
    for (int job = gw; job < T / 32; job += NGW) {
        const int t = job * 32 + tl; const bf16* hr = H + (size_t)t * D + 8 * hh;
        f32x16 acc;
#pragma unroll
        for (int i = 0; i < 16; ++i) acc[i] = 0.f;
#pragma unroll 4
        for (int ks = 0; ks < 128; ++ks) { const bf16x8 af = __builtin_bit_cast(bf16x8, WG[ks * 64]), bfr = __builtin_bit_cast(bf16x8, *(const v4u*)(hr + 16 * ks));
            acc = __builtin_amdgcn_mfma_f32_32x32x16_bf16(af, bfr, acc, 0, 0, 0); }
#pragma unroll
        for (int i = 0; i < 16; ++i) { const int j = (i & 3) + 8 * (i >> 2) + 4 * hh; const float v = acc[i]; if (j < 24) gates[(size_t)t * 24 + j] = sigmoidf(v); }
    }
}
__device__ __forceinline__ void ph3_compress(const Args& a, LAS unsigned char* lds) {
    const int tid = phase_tid(), lane = tid & 63, wave = __builtin_amdgcn_readfirstlane(tid >> 6), cl = lane & 31, hh = lane >> 5;
    LAS float* part = (LAS float*)lds;
    LAS float* hid = part + 2 * 128 * 32;
    LAS float* ob = hid + 32 * 128;
    LAS float* bias = ob + 32 * 128;
    const bf16* KV = (const bf16*)(a.ws + WS_KV);
    const float* w2 = a.in[10]; const float* kg0 = a.in[7]; const float* CBP = (const float*)(a.ws + WS_CBP);
    for (int u = blockIdx.x; u < 128; u += gridDim.x) {
        const int j = u >> 6, bg = (u >> 3) & 7, ct = u & 7, b = bg >> 1, g = bg & 1, c0 = 32 * ct, hhd = j * 2 + g;
        if (tid < 128) { float s = 0.f;
#pragma unroll
            for (int kc = 0; kc < 64; ++kc) s += CBP[(kc * 2 + j) * 128 + tid];
            bias[tid] = s; }
        { const int nt = wave & 3, kh = wave >> 2, c = c0 + cl;
          const v4u* af = (const v4u*)(a.ws + WS_CW1F) + ((size_t)(j * 4 + nt) * 256 + 128 * kh) * 64 + lane;
          f32x16 acc;
#pragma unroll
          for (int i = 0; i < 16; ++i) acc[i] = 0.f;
#pragma unroll 4
          for (int ks = 0; ks < 128; ++ks) { const int k = 16 * (128 * kh + ks) + 8 * hh, l = k >> 7, d = k & 127, p = 16 * c + l;
              v4u x = {0u, 0u, 0u, 0u}; if (p < S) x = *(const v4u*)(KV + (size_t)(b * S + p) * NKV + hhd * 128 + d);
              acc = __builtin_amdgcn_mfma_f32_32x32x16_bf16(__builtin_bit_cast(bf16x8, af[ks * 64]), __builtin_bit_cast(bf16x8, x), acc, 0, 0, 0); }
#pragma unroll
          for (int i = 0; i < 16; ++i) { const int n = 32 * nt + (i & 3) + 8 * (i >> 2) + 4 * hh; const float v = acc[i]; part[(kh * 128 + n) * 32 + cl] = v; } }
        __syncthreads();
        for (int i = tid; i < 128 * 32; i += NTHREADS) { const int n = i >> 5, c = i & 31; hid[c * 128 + n] = gelu_tanh(part[i] + part[128 * 32 + i] + bias[n]); }
        __syncthreads();
        { const int n = tid & 127, cq = tid >> 7; float o[8];
#pragma unroll
          for (int r = 0; r < 8; ++r) o[r] = 0.f;
          const float* w2p = w2 + j * 128 * 128 + n;
          for (int k = 0; k < 128; ++k) { const float w = w2p[k * 128];
#pragma unroll
              for (int r = 0; r < 8; ++r) o[r] += hid[(8 * cq + r) * 128 + k] * w; }
#pragma unroll
          for (int r = 0; r < 8; ++r) ob[(8 * cq + r) * 128 + n] = o[r]; }
        __syncthreads();
        bf16* fr = (bf16*)(a.ws + (j == 0 ? WS_KC : WS_VC)) + (size_t)bg * 8 * 4096;
#pragma unroll 1
        for (int r = 0; r < 4; ++r) { const int cr = 4 * wave + r, c = c0 + cr; float v0 = ob[cr * 128 + 2 * lane], v1 = ob[cr * 128 + 2 * lane + 1];
            if (j == 0) { const float rstd = rsqrtf(wave_sum(v0 * v0 + v1 * v1) * (1.f / 128.f) + EPS); v0 = v0 * rstd * kg0[2 * lane]; v1 = v1 * rstd * kg0[2 * lane + 1]; }
            if (c >= NC) { v0 = 0.f; v1 = 0.f; }
            if (j == 0) *(unsigned*)(fr + kf_off(c, 2 * lane)) = pk2(v0, v1);
            else { fr[vf_off(c, 2 * lane)] = (bf16)f2bf(v0); fr[vf_off(c, 2 * lane + 1)] = (bf16)f2bf(v1); } }
        __syncthreads();
    }
}

#define KBI(i) (16 * ((i) >> 3) + ((i) & 7))
__device__ __forceinline__ void load_frags(bf16x8 (&f)[8], const v4u* p, int lane) {
#pragma unroll
    for (int i = 0; i < 8; ++i) f[i] = __builtin_bit_cast(bf16x8, p[i * 64 + lane]);
}
__device__ __forceinline__ f32x16 qk_mma(const bf16x8 (&qf)[8], const bf16x8 (&k)[8]) {
    f32x16 s;
#pragma unroll
    for (int i = 0; i < 16; ++i) s[i] = 0.f;
#pragma unroll
    for (int st = 0; st < 8; ++st) s = __builtin_amdgcn_mfma_f32_32x32x16_bf16(k[st], qf[st], s, 0, 0, 0);
    return s;
}
__device__ __forceinline__ f32x16 qk_tile(const bf16x8 (&qf)[8], const v4u* kf, int lane) { bf16x8 k[8]; load_frags(k, kf, lane); return qk_mma(qf, k); }
template <int STRIDE> __device__ __forceinline__ void add_tbl(f32x16& s, const LAS float* tp2, float pen) {
#pragma unroll
    for (int i = 0; i < 16; ++i) s[i] += tp2[STRIDE * (23 - KBI(i))] + pen;
}
__device__ __forceinline__ void mask_hi(f32x16& s, int lim) {
#pragma unroll
    for (int i = 0; i < 16; ++i) s[i] = (KBI(i) <= lim) ? s[i] : NEGB;
}
__device__ __forceinline__ void mask_lo(f32x16& s, int lim) {
#pragma unroll
    for (int i = 0; i < 16; ++i) s[i] = (KBI(i) >= lim) ? s[i] : NEGB;
}
__device__ __forceinline__ float max16(const f32x16& s) {
    float mx = fmaxf(s[0], s[1]);
#pragma unroll
    for (int i = 2; i < 16; ++i) mx = fmaxf(mx, s[i]);
    return fmaxf(mx, __shfl_xor(mx, 32));
}
__device__ __forceinline__ void pv_tile(const f32x16& p, f32x16 (&o)[4], const bf16x8 (&v)[8]) {
    v4u a0, a1;
    a0.x = pkbf(p[0], p[1]); a0.y = pkbf(p[2], p[3]); a0.z = pkbf(p[4], p[5]); a0.w = pkbf(p[6], p[7]);
    a1.x = pkbf(p[8], p[9]); a1.y = pkbf(p[10], p[11]); a1.z = pkbf(p[12], p[13]); a1.w = pkbf(p[14], p[15]);
    const bf16x8 pb0 = __builtin_bit_cast(bf16x8, a0), pb1 = __builtin_bit_cast(bf16x8, a1);
#pragma unroll
    for (int dt = 0; dt < 4; ++dt) { o[dt] = __builtin_amdgcn_mfma_f32_32x32x16_bf16(v[2 * dt], pb0, o[dt], 0, 0, 0); o[dt] = __builtin_amdgcn_mfma_f32_32x32x16_bf16(v[2 * dt + 1], pb1, o[dt], 0, 0, 0); }
}
__device__ __forceinline__ void softmax_pv(f32x16& s, f32x16 (&o)[4], float& m, float& l, const v4u* vf, int lane) {
    bf16x8 v[8];
#pragma unroll
    for (int i = 0; i < 8; ++i) v[i] = __builtin_bit_cast(bf16x8, vf[i * 64 + lane]);
    const float mn = fmaxf(m, max16(s));
    if (__ballot(mn > m + 8.f)) {
        const float corr = ex2(m - mn);
#pragma unroll
        for (int dt = 0; dt < 4; ++dt)
#pragma unroll
            for (int i = 0; i < 16; ++i) o[dt][i] *= corr;
        l *= corr; m = mn;
    }
    float ps = 0.f;
#pragma unroll
    for (int i = 0; i < 16; ++i) { s[i] = ex2(s[i] - m); ps += s[i]; }
    l += ps;
    pv_tile(s, o, v);
}
template <int NP = 0> __device__ __forceinline__ void softmax_pv_v(f32x16& s, f32x16 (&o)[4], float& m, float& l, const bf16x8 (&v)[8]) {
    if (NP == 2) { l += s[0]; pv_tile(s, o, v); return; }
    const float mn = fmaxf(m, max16(s));
    if (__ballot(mn > m + 8.f)) {
        const float corr = ex2(m - mn);
#pragma unroll
        for (int dt = 0; dt < 4; ++dt)
#pragma unroll
            for (int i = 0; i < 16; ++i) o[dt][i] *= corr;
        l *= corr; m = mn;
    }
    float ps = 0.f;
#pragma unroll
    for (int i = 0; i < 16; ++i) { s[i] = ex2(s[i] - m); ps += s[i]; }
    l += ps;
    pv_tile(s, o, v);
}
__device__ __forceinline__ void zero_o(f32x16 (&o)[4]) {
#pragma unroll
    for (int dt = 0; dt < 4; ++dt)
#pragma unroll
        for (int i = 0; i < 16; ++i) o[dt][i] = 0.f;
}
__device__ __forceinline__ void y_update(bf16* yp  , const f32x16 (&o)[4], float sc, bool acc) {
#pragma unroll
    for (int dt = 0; dt < 4; ++dt)
#pragma unroll
        for (int i4 = 0; i4 < 4; ++i4) { bf16* p = yp + 32 * dt + 8 * i4;
            float v0 = o[dt][4 * i4] * sc, v1 = o[dt][4 * i4 + 1] * sc, v2 = o[dt][4 * i4 + 2] * sc, v3 = o[dt][4 * i4 + 3] * sc;
            if (acc) { const v2u w = *(const v2u*)p; v0 += bflo(w.x); v1 += bfhi(w.x); v2 += bflo(w.y); v3 += bfhi(w.y); }
            v2u w; w.x = pkbf(v0, v1); w.y = pkbf(v2, v3); *(v2u*)p = w; }
}
constexpr int TBLN = 2624;
constexpr int OFF_TBL = 0, OFF_IMP = 43008, OFF_SELM = OFF_IMP + 65536, OFF_DTBL = OFF_SELM + 512;
constexpr int FAR_DIST = 1513;

template <int NP> __device__ __forceinline__ void nsa_unit(const Args& a, LAS unsigned char* lds, int u, int tid) {
    const int lane = tid & 63, wave = __builtin_amdgcn_readfirstlane(tid >> 6);
    const int qb = u >> 3, bg = u & 7, b = bg >> 1, g = bg & 1;
    const int r = wave >> 1, qs = wave & 1, hd = g * 4 + r, ql = lane & 31, h = lane >> 5;
    const int q0w = 64 * qb + 32 * qs, sq = q0w + ql, t = b * S + sq;
    LAS float* tball = (LAS float*)(lds + OFF_TBL);
    LAS float* imp = (LAS float*)(lds + OFF_IMP);
    LAS unsigned long long* selm = (LAS unsigned long long*)(lds + OFF_SELM);
    const float* relb = a.in[22];
    for (int i = tid; i < 4 * TBLN; i += NTHREADS) { const int hh = i / TBLN, dd = i % TBLN - 64; tball[i] = dd >= 0 ? relb[(g * 4 + hh) * 32 + t5_bucket(dd)] * LOG2E : 0.f; }
    for (int i = tid; i < 4 * 64 * 64; i += NTHREADS) imp[i] = 0.f;
    __syncthreads();
    const LAS float* tbl = tball + r * TBLN + 64;
    const float farc = relb[hd * 32 + 31] * LOG2E;
    bf16x8 qf[8];
    { const bf16* qrow = (const bf16*)(a.ws + WS_Q) + (size_t)t * NQ + hd * 128 + 8 * h;
#pragma unroll
      for (int st = 0; st < 8; ++st) qf[st] = __builtin_bit_cast(bf16x8, *(const v4u*)(qrow + 16 * st)); }
    const float* gt = (const float*)(a.ws + WS_GATES) + (size_t)t * 24 + hd * 3;
    const float g0 = gt[0], g1 = gt[1], g2 = gt[2];
    bf16* yp = (bf16*)(a.ws + (NP ? WS_H : WS_YN)) + (size_t)t * 1536 + hd * 128 + 4 * h;
    f32x16 o[4];
    {
        const v4u* kfc = (const v4u*)(a.ws + WS_KC) + (size_t)bg * 8 * 512; const v4u* vfc = (const v4u*)(a.ws + WS_VC) + (size_t)bg * 8 * 512;
        const int smax = q0w + 31, ncv = smax >= 31 ? ((smax - 31) >> 4) + 1 : 0, ntc = (ncv + 31) >> 5;
        float m = NEGB, l = 0.f;
        for (int tc = 0; tc < ntc; ++tc) {
            f32x16 s = qk_tile(qf, kfc + tc * 512, lane);
            const int dqc = sq - 31 - 512 * tc;
            if (q0w - 31 - 512 * tc - 496 >= FAR_DIST) {
#pragma unroll
                for (int i = 0; i < 16; ++i) s[i] += farc;
            } else add_tbl<16>(s, tbl + dqc - 16 * (8 * h + 23), 0.f);
            mask_hi(s, (dqc >> 4) - 8 * h);
            const float mn = fmaxf(m, max16(s));
            float ps = 0.f;
#pragma unroll
            for (int i = 0; i < 16; ++i) ps += ex2(s[i] - mn);
            l = l * ex2(m - mn) + ps; m = mn;
        }
        l += __shfl_xor(l, 32);
        const float inv = (sq >= 31) ? 1.f / l : 0.f;
        zero_o(o);
        LAS float* impq = imp + (r * 64 + 32 * qs + ql) * 64;
        for (int tc = 0; tc < ntc; ++tc) {
            f32x16 s = qk_tile(qf, kfc + tc * 512, lane);
            bf16x8 v[8];
#pragma unroll
            for (int i = 0; i < 8; ++i) v[i] = __builtin_bit_cast(bf16x8, vfc[tc * 512 + i * 64 + lane]);
            const int dqc = sq - 31 - 512 * tc;
            if (q0w - 31 - 512 * tc - 496 >= FAR_DIST) {
#pragma unroll
                for (int i = 0; i < 16; ++i) s[i] += farc;
            } else add_tbl<16>(s, tbl + dqc - 16 * (8 * h + 23), 0.f);
            mask_hi(s, (dqc >> 4) - 8 * h);
#pragma unroll
            for (int i = 0; i < 16; ++i) s[i] = ex2(s[i] - m) * inv;
#pragma unroll
            for (int a2 = 0; a2 < 2; ++a2)
#pragma unroll
                for (int bq = 0; bq < 2; ++bq) { const int j = 8 * tc + 4 * a2 + 2 * h + bq; const int i0 = 8 * a2 + 4 * bq;
                    impq[j] += (s[i0] + s[i0 + 1]) + (s[i0 + 2] + s[i0 + 3]); }
            asm volatile("s_waitcnt lgkmcnt(0)" ::: "memory");
#pragma unroll
            for (int a2 = 0; a2 < 2; ++a2)
#pragma unroll
                for (int bq = 0; bq < 2; ++bq) { const int j = 8 * tc + 4 * a2 + 2 * h + bq + 1; if (j < 64) impq[j] += s[8 * a2 + 4 * bq + 3]; }
            asm volatile("s_waitcnt lgkmcnt(0)" ::: "memory");
            pv_tile(s, o, v);
        }
        y_update(yp, o, g0, false);
    }
    __syncthreads();
    for (int qq = wave * 8; qq < wave * 8 + 8; ++qq) {
        const int jb = lane;
        const float im = ((imp[(0 * 64 + qq) * 64 + jb] + imp[(1 * 64 + qq) * 64 + jb]) + imp[(2 * 64 + qq) * 64 + jb]) + imp[(3 * 64 + qq) * 64 + jb];
        const bool forced = (jb == 0) || (jb == qb) || (jb == qb - 1);
        const float score = forced ? 1e4f : (jb > qb ? -1e4f : im);
        int rank = 0;
        for (int o2 = 0; o2 < 64; ++o2) { const float so = __shfl(score, o2); rank += (so > score) || (so == score && o2 < jb); }
        const unsigned long long mask = __ballot(rank < 16 && jb <= qb);
        if (lane == 0) selm[qq] = mask;
    }
    __syncthreads();
    {
        const v4u* kfw = (const v4u*)fr_nsa(a, bg, 2); const v4u* vfw = (const v4u*)fr_nsa(a, bg, 3);
        const int t_hi = q0w >> 5, t_lo = t_hi - 16;
        float m = NEGB, l = 0.f; zero_o(o);
        const int t0 = t_lo < 0 ? 0 : t_lo;
        for (int tt = t0; tt <= t_hi; ++tt) {
            const size_t to = (NP == 3) ? (size_t)(tt & 1) * 512 : (size_t)tt * 512;
            bf16x8 kf[8], vf[8]; load_frags(kf, kfw + to, lane);
            f32x16 s = qk_mma(qf, kf); load_frags(vf, vfw + to, lane);
            const int dq = sq - 32 * tt;
            add_tbl<1>(s, tbl + dq - (8 * h + 23), 0.f);
            if (tt == t_hi) mask_hi(s, dq - 8 * h);
            if (tt == t_lo) mask_lo(s, dq - 511 - 8 * h);
            softmax_pv_v<NP>(s, o, m, l, vf);
        }
        l += __shfl_xor(l, 32);
        y_update(yp, o, g2 / l, true);
    }
    {
        const v4u* kfs = (const v4u*)fr_nsa(a, bg, 0); const v4u* vfs = (const v4u*)fr_nsa(a, bg, 1);
        const unsigned long long mask = selm[32 * qs + ql];
        float m = NEGB, l = 0.f; zero_o(o);
        const int t_end = 2 * qb + qs;
        for (int tt = 0; tt <= 2 * qb + 1; ++tt) {
            if (tt > t_end) continue;
            const float pen = ((mask >> (tt >> 1)) & 1ull) ? 0.f : NEGB;
            if (__ballot(pen == 0.f) == 0ull) continue;
            const size_t to = (NP == 3) ? (size_t)(tt & 1) * 512 : (size_t)tt * 512;
            bf16x8 kf[8], vf[8]; load_frags(kf, kfs + to, lane);
            f32x16 s = qk_mma(qf, kf); load_frags(vf, vfs + to, lane);
            const int dq = sq - 32 * tt;
            if (q0w - (32 * tt + 31) >= FAR_DIST) {
                const float c = farc + pen;
#pragma unroll
                for (int i = 0; i < 16; ++i) s[i] += c;
            } else add_tbl<1>(s, tbl + dq - (8 * h + 23), pen);
            if (tt == t_end) mask_hi(s, dq - 8 * h);
            softmax_pv_v<NP>(s, o, m, l, vf);
        }
        l += __shfl_xor(l, 32);
        y_update(yp, o, g1 / l, true);
    }
    __syncthreads();
}
__device__ __forceinline__ void dil_unit(const Args& a, LAS unsigned char* lds, int u, int tid) {
    const int lane = tid & 63, wave = __builtin_amdgcn_readfirstlane(tid >> 6), ql = lane & 31, h = lane >> 5;
    const int b = u >> 6, p = (u >> 4) & 3, c = u & 15, s0 = 256 * c;
    LAS float* dtbl = (LAS float*)(lds + OFF_DTBL);
    const float* relb = a.in[22] + 8 * 32;
    for (int i = tid; i < 3 * 192; i += NTHREADS) { const int gi = i / 192, dm = i % 192 - 32; dtbl[i] = dm >= 0 ? relb[(gi * 4 + p) * 32 + t5_bucket(dm << (2 * gi))] * LOG2E : 0.f; }
    __syncthreads();
    bf16* OD = (bf16*)(a.ws + WS_OD); float* LSE = (float*)(a.ws + WS_LSE);
    const bf16* DL = (const bf16*)(a.ws + WS_DL);
    for (int job = wave; job < 32; job += NWAVES) {
        int gi, rr, m0, vlo, vhi;
        if (job < 8) { gi = 0; rr = 0; m0 = s0 + 32 * job; vlo = 0; vhi = 32; }
        else if (job < 16) { gi = 1; rr = (job - 8) >> 1; m0 = (s0 >> 2) + 32 * (job & 1); vlo = 0; vhi = 32; }
        else { gi = 2; rr = job - 16; m0 = 32 * (c >> 1); vlo = 16 * (c & 1); vhi = vlo + 16; }
        const int dsh = 2 * gi, L = S >> dsh, head = gi * 4 + p;
        const int mq = m0 + ql, sact = (mq << dsh) + rr, t = b * S + sact;
        const v4u* kf = (const v4u*)fr_dil(a, b, head, 0) + (size_t)((rr * L) >> 5) * 512; const v4u* vf = (const v4u*)fr_dil(a, b, head, 1) + (size_t)((rr * L) >> 5) * 512;
        bf16x8 qf[8];
        { const bf16* qrow = DL + (size_t)t * NDL + head * 128 + 8 * h;
#pragma unroll
          for (int st = 0; st < 8; ++st) qf[st] = __builtin_bit_cast(bf16x8, *(const v4u*)(qrow + 16 * st)); }
        const LAS float* tb = dtbl + gi * 192 + 32;
        const int t_hi = m0 >> 5, t_lo = t_hi - 4;
        float m = NEGB, l = 0.f; f32x16 o[4]; zero_o(o);
        const int t0 = t_lo < 0 ? 0 : t_lo;
        for (int tt = t0; tt <= t_hi; ++tt) {
            bf16x8 kr[8], vr[8]; load_frags(kr, kf + (size_t)tt * 512, lane);
            f32x16 s = qk_mma(qf, kr); load_frags(vr, vf + (size_t)tt * 512, lane);
            const int dq = mq - 32 * tt;
            add_tbl<1>(s, tb + dq - (8 * h + 23), 0.f);
            if (tt == t_hi) mask_hi(s, dq - 8 * h);
            if (tt == t_lo) mask_lo(s, dq - 128 - 8 * h);
            softmax_pv_v(s, o, m, l, vr);
        }
        l += __shfl_xor(l, 32);
        if (ql >= vlo && ql < vhi) {
            y_update(OD + ((size_t)gi * T + t) * 512 + p * 128 + 4 * h, o, 1.f / l, false);
            if (h == 0) LSE[((size_t)(gi * NB + b) * 4 + p) * S + sact] = m + __log2f(l);
        }
    }
    __syncthreads();
    { const int pos = tid >> 1, dh = tid & 1, sact = s0 + pos, t = b * S + sact;
      const float l0 = LSE[((size_t)(0 * NB + b) * 4 + p) * S + sact], l1 = LSE[((size_t)(1 * NB + b) * 4 + p) * S + sact], l2 = LSE[((size_t)(2 * NB + b) * 4 + p) * S + sact];
      const float mx = fmaxf(l0, fmaxf(l1, l2)); float w0 = ex2(l0 - mx), w1 = ex2(l1 - mx), w2 = ex2(l2 - mx); const float iw = 1.f / (w0 + w1 + w2); w0 *= iw; w1 *= iw; w2 *= iw;
      bf16* yd = (bf16*)(a.ws + WS_YN) + (size_t)t * 1536 + 1024 + p * 128 + 64 * dh;
      const bf16* o0 = OD + ((size_t)0 * T + t) * 512 + p * 128 + 64 * dh; const bf16* o1 = OD + ((size_t)1 * T + t) * 512 + p * 128 + 64 * dh; const bf16* o2 = OD + ((size_t)2 * T + t) * 512 + p * 128 + 64 * dh;
#pragma unroll
      for (int k = 0; k < 8; ++k) { const v4u x0 = *(const v4u*)(o0 + 8 * k), x1 = *(const v4u*)(o1 + 8 * k), x2 = *(const v4u*)(o2 + 8 * k); v4u y;
          y.x = pkbf(w0 * bflo(x0.x) + w1 * bflo(x1.x) + w2 * bflo(x2.x), w0 * bfhi(x0.x) + w1 * bfhi(x1.x) + w2 * bfhi(x2.x));
          y.y = pkbf(w0 * bflo(x0.y) + w1 * bflo(x1.y) + w2 * bflo(x2.y), w0 * bfhi(x0.y) + w1 * bfhi(x1.y) + w2 * bfhi(x2.y));
          y.z = pkbf(w0 * bflo(x0.z) + w1 * bflo(x1.z) + w2 * bflo(x2.z), w0 * bfhi(x0.z) + w1 * bfhi(x1.z) + w2 * bfhi(x2.z));
          y.w = pkbf(w0 * bflo(x0.w) + w1 * bflo(x1.w) + w2 * bflo(x2.w), w0 * bfhi(x0.w) + w1 * bfhi(x1.w) + w2 * bfhi(x2.w));
          *(v4u*)(yd + 8 * k) = y; } }
    __syncthreads();
}
__device__ __forceinline__ void ph4_attention(const Args& a, LAS unsigned char* lds) {
    const int tid = phase_tid();
    for (int u = blockIdx.x; u < 256; u += gridDim.x) dil_unit(a, lds, u, tid);
#ifndef PROBE_NSA
#define PROBE_NSA 0
#endif
    if (PROBE_NSA) for (int x = blockIdx.x; x < 256; x += gridDim.x) { nsa_unit<PROBE_NSA>(a, lds, 511 - x, tid); nsa_unit<PROBE_NSA>(a, lds, x, tid); }
    for (int x = blockIdx.x; x < 256; x += gridDim.x) { nsa_unit<0>(a, lds, 511 - x, tid); nsa_unit<0>(a, lds, x, tid); }
}

constexpr size_t WS_PU8 = WS_Q;
constexpr size_t WS_PV8 = WS_Q + 32 * MiB;
constexpr size_t WS_PSC = WS_Q + 64 * MiB;
__device__ __forceinline__ void ph_quant_uv(const Args& a) {
    const int tid = phase_tid(), lane = tid & 63, wave = __builtin_amdgcn_readfirstlane(tid >> 6);
    const int gw = blockIdx.x * NWAVES + wave, NGW = gridDim.x * NWAVES;
    float* SC = (float*)(a.ws + WS_PSC);
    for (int rw = gw; rw < NE; rw += NGW) {
        f32x4 x[2][8];
#pragma unroll
        for (int which = 0; which < 2; ++which) { const float* src = a.in[20 + which] + (size_t)rw * D + 16 * lane;
#pragma unroll
            for (int c = 0; c < 2; ++c)
#pragma unroll
                for (int w = 0; w < 4; ++w) x[which][4 * c + w] = *(const f32x4*)(src + 1024 * c + 4 * w); }
#pragma unroll
        for (int which = 0; which < 2; ++which) {
            unsigned char* dst = a.ws + (which ? WS_PV8 : WS_PU8) + (size_t)rw * D + 16 * lane;
            float am = 0.f;
#pragma unroll
            for (int i = 0; i < 8; ++i) am = fmaxf(fmaxf(am, fmaxf(fabsf(x[which][i].x), fabsf(x[which][i].y))), fmaxf(fabsf(x[which][i].z), fabsf(x[which][i].w)));
            am = wave_max(am);
            const float inv = am > 0.f ? 127.f / am : 0.f;
#pragma unroll
            for (int c = 0; c < 2; ++c) { v4u o; unsigned wd[4];
#pragma unroll
                for (int w = 0; w < 4; ++w) { const f32x4 v = x[which][4 * c + w];
                    const unsigned q0 = (unsigned)((int)rintf(v.x * inv) + 128), q1 = (unsigned)((int)rintf(v.y * inv) + 128), q2 = (unsigned)((int)rintf(v.z * inv) + 128), q3 = (unsigned)((int)rintf(v.w * inv) + 128);
                    wd[w] = q0 | (q1 << 8) | (q2 << 16) | (q3 << 24); }
                o.x = wd[0]; o.y = wd[1]; o.z = wd[2]; o.w = wd[3]; *(v4u*)(dst + 1024 * c) = o; }
            if (lane == 0) SC[which * NE + rw] = am * (1.f / 127.f);
        }
    }
}
constexpr size_t WS_KEYF = 601 * MiB;
constexpr size_t WS_END3 = 602 * MiB;
__device__ __forceinline__ void ph0_keyfrags(const Args& a) {
    const int tid = phase_tid();
    const float* keys = a.in[19]; v4u* KF = (v4u*)(a.ws + WS_KEYF);
    for (int i = blockIdx.x * NTHREADS + tid; i < 16 * 32 * 64; i += gridDim.x * NTHREADS) {
        const int lane = i & 63, st = (i >> 6) & 7, kt = (i >> 9) & 3, hp = i >> 11;
        const float* src = keys + ((size_t)hp * 128 + 32 * kt + (lane & 31)) * 128 + 16 * st + 8 * (lane >> 5);
        float v[8]; unsigned hi[8], lo[8];
#pragma unroll
        for (int j = 0; j < 8; ++j) { v[j] = src[j]; hi[j] = f2bf(v[j]); lo[j] = f2bf(v[j] - __builtin_bit_cast(float, hi[j] << 16)); }
        v4u oh, ol; oh.x = hi[0] | (hi[1] << 16); oh.y = hi[2] | (hi[3] << 16); oh.z = hi[4] | (hi[5] << 16); oh.w = hi[6] | (hi[7] << 16);
        ol.x = lo[0] | (lo[1] << 16); ol.y = lo[2] | (lo[3] << 16); ol.z = lo[4] | (lo[5] << 16); ol.w = lo[6] | (lo[7] << 16);
        KF[(size_t)((hp * 2 + 0) * 32 + kt * 8 + st) * 64 + lane] = oh; KF[(size_t)((hp * 2 + 1) * 32 + kt * 8 + st) * 64 + lane] = ol;
    }
}
template <int N, bool MERGE_ONLY> __device__ __forceinline__ void bitonic_desc(float (&v)[N]) {
#pragma unroll
    for (int k = MERGE_ONLY ? N : 2; k <= N; k <<= 1)
#pragma unroll
        for (int j = k >> 1; j > 0; j >>= 1)
#pragma unroll
            for (int i = 0; i < N; ++i) { const int l = i ^ j;
                if (l > i) { const bool desc = ((i & k) == 0) || (k == N); const float x = v[i], y = v[l], hi = fmaxf(x, y), lo = fminf(x, y); v[i] = desc ? hi : lo; v[l] = desc ? lo : hi; } }
}
#define CROW(i) (((i) & 3) + 8 * ((i) >> 2))
__device__ __forceinline__ float max3f(float a, float b, float c) { return fmaxf(fmaxf(a, b), c); }
__device__ __forceinline__ void ph_route(const Args& a, LAS unsigned char* lds) {
    const int tid = phase_tid(), lane = tid & 63, wave = __builtin_amdgcn_readfirstlane(tid >> 6), tl = lane & 31, hc = lane >> 5;
    const int gw = blockIdx.x * NWAVES + wave, NGW = gridDim.x * NWAVES;
    const float* QP = (const float*)(a.ws + WS_QP); const float* qgain = a.in[18]; const v4u* KF = (const v4u*)(a.ws + WS_KEYF);
    int* EI = (int*)(a.ws + WS_EI); float* EG = (float*)(a.ws + WS_EG);
    LAS float* spl = (LAS float*)(lds + wave * 8704) + lane * 33;
    for (int job = gw; job < (T / 32) * 8; job += NGW) {
        const int h = job & 7, t = (job >> 3) * 32 + tl;
#pragma unroll 1
        for (int p = 0; p < 2; ++p) {
            bf16x8 bh[8], bl[8];
            { const float* qr = QP + (size_t)t * D + h * 256 + p * 128 + 8 * hc; const float* gr = qgain + (h * 2 + p) * 128 + 8 * hc;
              float ss = 0.f;
#pragma unroll
              for (int st = 0; st < 8; ++st) { const f32x4 x0 = *(const f32x4*)(qr + 16 * st), x1 = *(const f32x4*)(qr + 16 * st + 4);
                  ss += (x0.x * x0.x + x0.y * x0.y) + (x0.z * x0.z + x0.w * x0.w) + (x1.x * x1.x + x1.y * x1.y) + (x1.z * x1.z + x1.w * x1.w); }
              ss += __shfl_xor(ss, 32);
              const float rstd = rsqrtf(ss * (1.f / 128.f) + EPS);
              asm volatile("" ::: "memory");
#pragma unroll
              for (int st = 0; st < 8; ++st) { const f32x4 x0 = *(const f32x4*)(qr + 16 * st), x1 = *(const f32x4*)(qr + 16 * st + 4); const f32x4 g0 = *(const f32x4*)(gr + 16 * st), g1 = *(const f32x4*)(gr + 16 * st + 4);
                  const float v0 = x0.x * rstd * g0.x, v1 = x0.y * rstd * g0.y, v2 = x0.z * rstd * g0.z, v3 = x0.w * rstd * g0.w, v4 = x1.x * rstd * g1.x, v5 = x1.y * rstd * g1.y, v6 = x1.z * rstd * g1.z, v7 = x1.w * rstd * g1.w;
                  v4u xh, xl; xh.x = pkbf(v0, v1); xh.y = pkbf(v2, v3); xh.z = pkbf(v4, v5); xh.w = pkbf(v6, v7);
                  xl.x = pkbf(v0 - bflo(xh.x), v1 - bfhi(xh.x)); xl.y = pkbf(v2 - bflo(xh.y), v3 - bfhi(xh.y)); xl.z = pkbf(v4 - bflo(xh.z), v5 - bfhi(xh.z)); xl.w = pkbf(v6 - bflo(xh.w), v7 - bfhi(xh.w));
                  bh[st] = __builtin_bit_cast(bf16x8, xh); bl[st] = __builtin_bit_cast(bf16x8, xl); } }
            float sc[64];
            const v4u* kfh = KF + (size_t)(((h * 2 + p) * 2 + 0) * 32) * 64 + lane; const v4u* kfl = KF + (size_t)(((h * 2 + p) * 2 + 1) * 32) * 64 + lane;
#pragma unroll
            for (int kt = 0; kt < 4; ++kt) {
                f32x16 acc;
#pragma unroll
                for (int i = 0; i < 16; ++i) acc[i] = 0.f;
#pragma unroll
                for (int s2 = 0; s2 < 2; ++s2) {
                    asm volatile("" ::: "memory");
                    bf16x8 ah[4], al[4];
#pragma unroll
                    for (int s4 = 0; s4 < 4; ++s4) { ah[s4] = __builtin_bit_cast(bf16x8, kfh[(kt * 8 + s2 * 4 + s4) * 64]); al[s4] = __builtin_bit_cast(bf16x8, kfl[(kt * 8 + s2 * 4 + s4) * 64]); }
#pragma unroll
                    for (int s4 = 0; s4 < 4; ++s4) { const int st = s2 * 4 + s4;
                        acc = __builtin_amdgcn_mfma_f32_32x32x16_bf16(al[s4], bh[st], acc, 0, 0, 0); acc = __builtin_amdgcn_mfma_f32_32x32x16_bf16(ah[s4], bl[st], acc, 0, 0, 0); acc = __builtin_amdgcn_mfma_f32_32x32x16_bf16(ah[s4], bh[st], acc, 0, 0, 0); }
                }
#pragma unroll
                for (int i = 0; i < 16; ++i) { const float av = acc[i];
                    const unsigned bits = (__builtin_bit_cast(unsigned, av) & ~127u) | (unsigned)(127 - (32 * kt + CROW(i) + 4 * hc)); sc[16 * kt + i] = __builtin_bit_cast(float, bits); }
            }
            asm volatile("" ::: "memory");
            bitonic_desc<64, false>(sc);
            float t16[16];
#pragma unroll
            for (int i = 0; i < 16; ++i) t16[i] = __shfl_xor(sc[i], 32);
            float u16[16];
#pragma unroll
            for (int i = 0; i < 16; ++i) u16[i] = fmaxf(sc[i], t16[15 - i]);
            bitonic_desc<16, true>(u16);
#pragma unroll
            for (int i = 0; i < 16; ++i) spl[p * 16 + i] = u16[i];
        }
        asm volatile("s_waitcnt lgkmcnt(0)" ::: "memory");
        float sp[2][16];
#pragma unroll
        for (int i = 0; i < 16; ++i) { sp[0][i] = spl[i]; sp[1][i] = spl[16 + i]; }
        float cv[64];
        {
            int c = 0;
#pragma unroll
            for (int i = 0; i < 16; ++i)
#pragma unroll
                for (int j = 0; j < 16; ++j) if ((i + 1) * (j + 1) <= 16) {
                    const float v = sp[0][i] + sp[1][j];
                    cv[c] = __builtin_bit_cast(float, (__builtin_bit_cast(unsigned, v) & ~255u) | (unsigned)(255 - (i * 16 + j))); ++c; }
#pragma unroll
            for (int i = 50; i < 64; ++i) cv[i] = -INFINITY;
        }
        bitonic_desc<64, false>(cv);
        float tv[16];
#pragma unroll
        for (int i = 0; i < 16; ++i) tv[i] = cv[i];
        asm volatile("s_waitcnt lgkmcnt(0)" ::: "memory");
        int te[16]; float den = 0.f; const float top = tv[0];
#pragma unroll
        for (int i = 0; i < 16; ++i) { const int flat = 255 - (int)(__builtin_bit_cast(unsigned, tv[i]) & 255u);
            const unsigned b1 = __builtin_bit_cast(unsigned, spl[flat >> 4]), b2 = __builtin_bit_cast(unsigned, spl[16 + (flat & 15)]);
            te[i] = (127 - (int)(b1 & 127u)) * 128 + (127 - (int)(b2 & 127u));
            tv[i] = __expf(tv[i] - top); den += tv[i]; }
        den = 1.f / den;
        if (hc == 0) {
            int* ei = EI + (size_t)t * 128 + h * 16; float* eg = EG + (size_t)t * 128 + h * 16;
#pragma unroll
            for (int i = 0; i < 16; i += 4) { *(v4u*)(ei + i) = (v4u){(unsigned)te[i], (unsigned)te[i + 1], (unsigned)te[i + 2], (unsigned)te[i + 3]}; *(f32x4*)(eg + i) = (f32x4){tv[i] * den, tv[i + 1] * den, tv[i + 2] * den, tv[i + 3] * den}; }
        }
        asm volatile("s_waitcnt lgkmcnt(0)" ::: "memory");
    }
}
__device__ __forceinline__ float ub0(unsigned w) { return (float)(w & 0xffu); }
__device__ __forceinline__ float ub1(unsigned w) { return (float)((w >> 8) & 0xffu); }
__device__ __forceinline__ float ub2(unsigned w) { return (float)((w >> 16) & 0xffu); }
__device__ __forceinline__ float ub3(unsigned w) { return (float)(w >> 24); }
__device__ __forceinline__ void ph_experts(const Args& a, const float osc) {
    const int tid = phase_tid(), lane = tid & 63, wave = __builtin_amdgcn_readfirstlane(tid >> 6);
    const int gw = blockIdx.x * NWAVES + wave, NGW = gridDim.x * NWAVES;
    const bf16* H2 = (const bf16*)(a.ws + WS_H); const unsigned char* PU = a.ws + WS_PU8; const unsigned char* PV = a.ws + WS_PV8; const float* SC = (const float*)(a.ws + WS_PSC);
    const int* EI = (const int*)(a.ws + WS_EI); const float* EG = (const float*)(a.ws + WS_EG);
    const float* mod = (const float*)(a.ws + WS_MOD);
    float* out = a.out;
    for (int t = gw; t < T; t += NGW) {
        const int b = t / S;
        float x[32]; float sx = 0.f;
#pragma unroll
        for (int c = 0; c < 2; ++c)
#pragma unroll
            for (int hw = 0; hw < 2; ++hw) { const v4u w = *(const v4u*)(H2 + (size_t)t * D + 1024 * c + 16 * lane + 8 * hw); const int o = 16 * c + 8 * hw;
                x[o + 0] = bflo(w.x); x[o + 1] = bfhi(w.x); x[o + 2] = bflo(w.y); x[o + 3] = bfhi(w.y); x[o + 4] = bflo(w.z); x[o + 5] = bfhi(w.z); x[o + 6] = bflo(w.w); x[o + 7] = bfhi(w.w); }
#pragma unroll
        for (int i = 0; i < 32; ++i) sx += x[i];
        sx = wave_sum(sx) * 128.f;
        const int e0 = EI[(size_t)t * 128 + lane], e1 = EI[(size_t)t * 128 + 64 + lane];
        const float gs0 = EG[(size_t)t * 128 + lane] * SC[NE + e0], gs1 = EG[(size_t)t * 128 + 64 + lane] * SC[NE + e1];
        const float su0 = SC[e0], su1 = SC[e1];
        float cf0 = 0.f, cf1 = 0.f;
#pragma unroll 1
        for (int bt = 0; bt < 16; ++bt) {
            v4u w[8][2];
#pragma unroll
            for (int k = 0; k < 8; ++k) { const int e = __shfl(bt < 8 ? e0 : e1, (bt * 8 + k) & 63); const unsigned char* ur = PU + (size_t)e * D + 16 * lane;
                w[k][0] = *(const v4u*)ur; w[k][1] = *(const v4u*)(ur + 1024); }
#pragma unroll
            for (int k = 0; k < 8; ++k) { float s0 = 0.f, s1 = 0.f;
#pragma unroll
                for (int c = 0; c < 2; ++c) { const v4u q = w[k][c]; const int o = 16 * c;
                    s0 += x[o + 0] * ub0(q.x) + x[o + 1] * ub1(q.x) + x[o + 2] * ub2(q.x) + x[o + 3] * ub3(q.x); s1 += x[o + 4] * ub0(q.y) + x[o + 5] * ub1(q.y) + x[o + 6] * ub2(q.y) + x[o + 7] * ub3(q.y);
                    s0 += x[o + 8] * ub0(q.z) + x[o + 9] * ub1(q.z) + x[o + 10] * ub2(q.z) + x[o + 11] * ub3(q.z); s1 += x[o + 12] * ub0(q.w) + x[o + 13] * ub1(q.w) + x[o + 14] * ub2(q.w) + x[o + 15] * ub3(q.w); }
                const float raw = wave_sum(s0 + s1) - sx;
                if (lane == ((bt * 8 + k) & 63)) { if (bt < 8) cf0 = gelu_tanh(raw * su0) * gs0; else cf1 = gelu_tanh(raw * su1) * gs1; } }
        }
        const float wsum = wave_sum(cf0 + cf1) * 128.f;
        float acc[32];
#pragma unroll
        for (int i = 0; i < 32; ++i) acc[i] = 0.f;
#pragma unroll 1
        for (int bt = 0; bt < 16; ++bt) {
            v4u w[8][2];
#pragma unroll
            for (int k = 0; k < 8; ++k) { const int e = __shfl(bt < 8 ? e0 : e1, (bt * 8 + k) & 63); const unsigned char* vr = PV + (size_t)e * D + 16 * lane;
                w[k][0] = *(const v4u*)vr; w[k][1] = *(const v4u*)(vr + 1024); }
#pragma unroll
            for (int k = 0; k < 8; ++k) { const float cf = __shfl(bt < 8 ? cf0 : cf1, (bt * 8 + k) & 63);
#pragma unroll
                for (int c = 0; c < 2; ++c) { const v4u q = w[k][c]; const int o = 16 * c;
                    acc[o + 0] += cf * ub0(q.x); acc[o + 1] += cf * ub1(q.x); acc[o + 2] += cf * ub2(q.x); acc[o + 3] += cf * ub3(q.x); acc[o + 4] += cf * ub0(q.y); acc[o + 5] += cf * ub1(q.y); acc[o + 6] += cf * ub2(q.y); acc[o + 7] += cf * ub3(q.y);
                    acc[o + 8] += cf * ub0(q.z); acc[o + 9] += cf * ub1(q.z); acc[o + 10] += cf * ub2(q.z); acc[o + 11] += cf * ub3(q.z); acc[o + 12] += cf * ub0(q.w); acc[o + 13] += cf * ub1(q.w); acc[o + 14] += cf * ub2(q.w); acc[o + 15] += cf * ub3(q.w); } }
        }
        const float* g2 = mod + b * 12288 + 10240;
#pragma unroll
        for (int c = 0; c < 2; ++c)
#pragma unroll
            for (int w4 = 0; w4 < 4; ++w4) { float* op = out + (size_t)t * D + 1024 * c + 16 * lane + 4 * w4; const f32x4 ga = *(const f32x4*)(g2 + 1024 * c + 16 * lane + 4 * w4); f32x4 r0 = *(const f32x4*)op; const int o = 16 * c + 4 * w4;
                r0.x += ga.x * (acc[o + 0] - wsum) * osc; r0.y += ga.y * (acc[o + 1] - wsum) * osc; r0.z += ga.z * (acc[o + 2] - wsum) * osc; r0.w += ga.w * (acc[o + 3] - wsum) * osc;
                *(f32x4*)op = r0; }
    }
}

constexpr int N_PHASES = 11;
__global__ void __launch_bounds__(NTHREADS, 2) fwd_kernel(Args a) {
    extern __shared__ __attribute__((aligned(16))) unsigned char lds_raw[];
    LAS unsigned char* lds = (LAS unsigned char*)lds_raw;
    const int tid = threadIdx.x;
    volatile LAS unsigned* misc = (volatile LAS unsigned*)(lds + LDS_MISC);
    if (tid < 16) misc[tid] = 0u;
    __syncthreads();
    XcdBarrier bar; bar.bar = (unsigned*)(a.ws + WS_CTL) + 1024; bar.x = 0; bar.st = nullptr;
    const int lo = a.ph_lo, hi = a.ph_hi;
    if (hi - lo > 1) bar = xcd_barrier_post((unsigned*)(a.ws + WS_CTL) + 1024, misc + 8);
#define IN(k) (lo <= (k) && (k) < hi)
#define SEAM(k) do { if (IN(k) && IN((k) + 1)) xcd_barrier(bar); } while (0)
    const int G = gridDim.x, bx = blockIdx.x;

    for (int rep = 0; rep < 1 + ((PROBE_DUP >> 0) & 1); ++rep)
    if (IN(0)) { ph0_mod(a, lds); __syncthreads(); ph0_weights(a, lds); ph0_keyfrags(a); ph0_extra(a); __syncthreads(); }
    SEAM(0);
    for (int rep = 0; rep < 1 + ((PROBE_DUP >> 1) & 1); ++rep)
    if (IN(1)) ph_norm<true>(a, a.in[0], a.in[4], 0, 2048, (bf16*)(a.ws + WS_H), a.ws + WS_H8);
    SEAM(1);
    for (int rep = 0; rep < 1 + ((PROBE_DUP >> 2) & 1); ++rep)
    if (IN(2)) { pg8::Gemm g{(const bf16*)(a.ws + WS_H8), (const bf16*)(a.ws + WS_WIN), T, NPROJ, D / 2}; pg8::StaticOrder So; So.init(T, NPROJ, G, bx);
        EpiProjNorm E{(bf16*)(a.ws + WS_Q), (bf16*)(a.ws + WS_KV), (bf16*)(a.ws + WS_DL), (bf16*)(a.ws + WS_MG), (bf16*)a.out, a.in[6], a.in[7], a.in[11], a.in[12], (LAS float*)(lds + 131072), 1.f / (F8_HS * F8_WS)};
        pg8::gemm_phase<EpiProjNorm, pg8::StaticOrder, pg8::NoMid, true>(lds, g, So, E); }
    SEAM(2);
    if (IN(3)) { for (int rep = 0; rep < 1 + ((PROBE_DUP >> 3) & 1); ++rep) { ph3_vfrag(a); ph3_gates(a); ph3_compress(a, lds); } }
    SEAM(3);
    for (int rep = 0; rep < 1 + ((PROBE_DUP >> 4) & 1); ++rep)
    if (IN(4)) ph4_attention(a, lds);
    SEAM(4);
    for (int rep = 0; rep < 1 + ((PROBE_DUP >> 5) & 1); ++rep)
    if (IN(5)) {
        { pg8::Gemm g{(const bf16*)(a.ws + WS_YN), (const bf16*)(a.ws + WS_WBN), T, D, 1536}; pg8::StaticOrder So; So.init(T, D, G, bx);
          EpiMerge E{(const bf16*)(a.ws + WS_MG), a.ws + WS_H, F8_MS}; MidMerge Mh{(const bf16*)(a.ws + WS_MG)};
          pg8::gemm_phase<EpiMerge, pg8::StaticOrder, MidMerge>(lds, g, So, E, Mh); }
    }
    SEAM(5);
    for (int rep = 0; rep < 1 + ((PROBE_DUP >> 6) & 1); ++rep)
    if (IN(6)) { pg8::Gemm g{(const bf16*)(a.ws + WS_H), (const bf16*)(a.ws + WS_WOUT), T, D, D / 2}; pg8::StaticOrder So; So.init(T, D, G, bx);
        EpiOut E{a.in[0], (const float*)(a.ws + WS_MOD), a.out, 1.f / (F8_MS * F8_WS)}; pg8::gemm_phase<EpiOut, pg8::StaticOrder, pg8::NoMid, true>(lds, g, So, E); }
    SEAM(6);
    for (int rep = 0; rep < 1 + ((PROBE_DUP >> 7) & 1); ++rep)
    if (IN(7)) { ph_norm(a, a.out, a.in[16], 6144, 8192, (bf16*)(a.ws + WS_H)); ph_quant_uv(a); }
    SEAM(7);
    for (int rep = 0; rep < 1 + ((PROBE_DUP >> 8) & 1); ++rep)
    if (IN(8)) { pg8::Gemm g{(const bf16*)(a.ws + WS_H), (const bf16*)(a.ws + WS_WPQ), T, D, D}; pg8::StaticOrder So; So.init(T, D, G, bx);
        EpiF32 E{(float*)(a.ws + WS_QP), D}; pg8::gemm_phase<EpiF32, pg8::StaticOrder>(lds, g, So, E); }
    SEAM(8);
    for (int rep = 0; rep < 1 + ((PROBE_DUP >> 9) & 1); ++rep)
    if (IN(9)) { ph_route(a, lds); __syncthreads(); }
    SEAM(9);
    if (IN(10)) { if ((PROBE_DUP >> 10) & 1) { ph_experts(a, *(const float*)(a.ws + WS_CTL + 64)); asm volatile("s_waitcnt vmcnt(0)" ::: "memory"); __syncthreads(); } ph_experts(a, 1.f); }
#undef IN
#undef SEAM
}

extern "C" void kernel_launch(void* const* d_in, const int* in_sizes, int n_in, void* d_out, int out_size, void* d_ws, size_t ws_size, hipStream_t stream) {
    static int grid = 0;
    if (grid == 0) {
        if (n_in != 23 || out_size != T * D || ws_size < WS_END4) { fprintf(stderr, "kernel_launch: unexpected problem shape (n_in %d, out %d, ws %zu); nothing launched\n", n_in, out_size, ws_size); grid = -1; return; }
        int dev = 0, cus = 0, per_cu = 0;
        if (hipGetDevice(&dev) != hipSuccess || hipDeviceGetAttribute(&cus, hipDeviceAttributeMultiprocessorCount, dev) != hipSuccess) { grid = -1; return; }
        if (hipFuncSetAttribute((const void*)fwd_kernel, hipFuncAttributeMaxDynamicSharedMemorySize, LDS_BYTES) != hipSuccess) { fprintf(stderr, "kernel_launch: hipFuncSetAttribute failed\n"); grid = -1; return; }
        if (hipOccupancyMaxActiveBlocksPerMultiprocessor(&per_cu, (const void*)fwd_kernel, NTHREADS, LDS_BYTES) != hipSuccess || per_cu < 1) { fprintf(stderr, "kernel_launch: occupancy query says %d\n", per_cu); }
        (void)hipGetLastError();
        grid = cus;
    }
    if (grid < 0) return;
    hipMemsetAsync((char*)d_ws + WS_CTL, 0, CTL_ZERO_BYTES, stream);
    Args a{};
    for (int i = 0; i < 23; ++i) a.in[i] = (const float*)d_in[i];
    a.out = (float*)d_out; a.ws = (unsigned char*)d_ws;
#if MK_ONE_LAUNCH
#if PROBE_PREFIX >= 0
    a.ph_lo = 0; a.ph_hi = PROBE_PREFIX + 1;
    hipLaunchKernelGGL(fwd_kernel, dim3(grid), dim3(NTHREADS), LDS_BYTES, stream, a);
    hipMemsetAsync((char*)d_ws + WS_CTL, 0, CTL_ZERO_BYTES, stream);
#endif
    a.ph_lo = 0; a.ph_hi = N_PHASES;
    hipLaunchKernelGGL(fwd_kernel, dim3(grid), dim3(NTHREADS), LDS_BYTES, stream, a);
#else
    for (int p = 0; p < N_PHASES; ++p) { a.ph_lo = p; a.ph_hi = p + 1; hipLaunchKernelGGL(fwd_kernel, dim3(grid), dim3(NTHREADS), LDS_BYTES, stream, a); }
#endif
}
```

```cpp
#include <hip/hip_runtime.h>
#include <cstdio>
#include <cstdint>

#ifndef PROBE_DUP
#define PROBE_DUP 0
#endif
#ifndef PROBE_PREFIX
#define PROBE_PREFIX -1
#endif
#ifndef MK_ONE_LAUNCH
#define MK_ONE_LAUNCH 1
#endif

__device__ __forceinline__ int phase_tid() { int t = threadIdx.x; asm volatile("" : "+v"(t)); return t; }
namespace pg8 {
#define PG8_LAS __attribute__((address_space(3)))
typedef unsigned short bf16_t;
typedef short bf16x8 __attribute__((ext_vector_type(8)));
typedef float f32x4 __attribute__((ext_vector_type(4)));
typedef unsigned u32x4 __attribute__((ext_vector_type(4)));
typedef unsigned u32x2 __attribute__((ext_vector_type(2)));
constexpr int BM = 256, BK = 64, HALF = 128, HTB = HALF * BK * 2, STAGE_BYTES = 8 * HTB, NXCD = 8, WGM = 8;

__host__ __device__ __forceinline__ int lds_byte(int r, int c) { const int st = (r >> 4) * 2 + (c >> 5), rr = r & 15, cc = c & 31, ob = rr * 64 + cc * 2; return st * 1024 + (ob ^ (((ob >> 9) & 1) << 5)); }
__host__ __device__ __forceinline__ void stage_rc(int b, int& R, int& C) { const int st = b / 1024, sb = b % 1024, swz = sb ^ (((sb >> 9) & 1) << 5); R = (st >> 1) * 16 + swz / 64; C = (st & 1) * 32 + (swz % 64) / 2; }
__host__ __device__ __forceinline__ int perm32(int rho) { const int n = rho >> 4, i = rho & 15; return 8 * (i >> 2) + 4 * n + (i & 3); }

struct Unit { int pm, pn; };
struct Gemm { const bf16_t* A; const bf16_t* Bt; int M, N, K; };

struct StaticOrder {
    int nM, nN, nwg, G, c;
    __host__ __device__ void init(int M, int N, int G_, int c_) { nM = M / BM; nN = N / BM; nwg = nM * nN; G = G_; c = c_; }
    __host__ __device__ bool next(int i, Unit& u) const {
        const long L = (long)i * G + c; if (L >= nwg) return false;
        int wgid = (int)L; { const int q = nwg / NXCD, r = nwg % NXCD, xcd = wgid % NXCD, off = wgid / NXCD; wgid = (xcd < r ? xcd * (q + 1) : r * (q + 1) + (xcd - r) * q) + off; }
        const int nig = WGM * nN, gid = wgid / nig, fm = gid * WGM, gsz = (nM - fm) < WGM ? (nM - fm) : WGM;
        u.pm = fm + ((wgid % nig) % gsz); u.pn = (wgid % nig) / gsz; return true;
    }
    __device__ __forceinline__ void a_ready(const Unit&) const {}
    __device__ __forceinline__ void done(const Unit&) const {}
};

__device__ __forceinline__ unsigned cvt_pk_bf16(float lo, float hi) { unsigned r; asm volatile("v_cvt_pk_bf16_f32 %0, %1, %2" : "=v"(r) : "v"(lo), "v"(hi)); return r; }

typedef int i32x4 __attribute__((ext_vector_type(4)));
typedef int i32x8 __attribute__((ext_vector_type(8)));
template <bool F8> __device__ __forceinline__ void mma_blk(f32x4 (&acc)[4][2], const bf16x8 (&At)[4][2], const bf16x8 (&Bt)[2][2]) {
    if constexpr (F8) {
#pragma unroll
        for (int m = 0; m < 4; ++m)
#pragma unroll
            for (int n = 0; n < 2; ++n) {
                const i32x8 bb = __builtin_shufflevector(__builtin_bit_cast(i32x4, Bt[n][0]), __builtin_bit_cast(i32x4, Bt[n][1]), 0, 1, 2, 3, 4, 5, 6, 7);
                const i32x8 aa = __builtin_shufflevector(__builtin_bit_cast(i32x4, At[m][0]), __builtin_bit_cast(i32x4, At[m][1]), 0, 1, 2, 3, 4, 5, 6, 7);
                asm volatile("v_mfma_f32_16x16x128_f8f6f4 %0, %1, %2, %0" : "+v"(acc[m][n]) : "v"(bb), "v"(aa)); }
    } else {
#pragma unroll
        for (int m = 0; m < 4; ++m)
#pragma unroll
            for (int n = 0; n < 2; ++n)
#pragma unroll
                for (int k = 0; k < 2; ++k) acc[m][n] = __builtin_amdgcn_mfma_f32_16x16x32_bf16(Bt[n][k], At[m][k], acc[m][n], 0, 0, 0);
    }
}
struct NoMid { static constexpr int AT = -1; __device__ __forceinline__ void operator()(f32x4 (&)[2][2][4][2], const Unit&, int, int, int, int) const {} };
template <class Epi, class Sched, class Mid = NoMid, bool F8 = false>
__device__ __forceinline__ void gemm_phase(PG8_LAS unsigned char* lds, const Gemm g, const Sched& S, const Epi& E, const Mid& Mh = Mid()) {
    const int tid = phase_tid(), wid = __builtin_amdgcn_readfirstlane(tid >> 6), lane = tid & 63, wr = wid >> 2, wc = wid & 3, fr = lane & 15, fq = lane >> 4;
    const int K = g.K, nt = K / BK;
    unsigned voffA[2], voffB[2];
#pragma unroll
    for (int i = 0; i < 2; ++i) { int R, C; stage_rc(tid * 16 + i * 8192, R, C); const int Rb = Epi::PERM ? ((R & ~31) + perm32(R & 31)) : R;
        voffA[i] = (unsigned)(R * K + C) * 2u; voffB[i] = (unsigned)(Rb * K + C) * 2u; }
    const size_t kstep = (size_t)(BK * 2);
    const size_t hstep = (size_t)HALF * K * 2;
    const size_t tstep = 2 * hstep;
    const unsigned ldsw = (unsigned)wid * 1024u;
    const int aoff = lds_byte(wr * 64 + fr, fq * 8), boff = lds_byte(wc * 32 + fr, fq * 8);
#define PG8_SA(b, h) (((b) * 2 + (h)) * HTB)
#define PG8_SB(b, h) ((4 + (b) * 2 + (h)) * HTB)
#define PG8_STAGE(bufoff, gbase, voff) do { _Pragma("unroll") for (int _i = 0; _i < 2; ++_i) \
        __builtin_amdgcn_global_load_lds((const unsigned*)((const char*)(gbase) + (voff)[_i]), (PG8_LAS unsigned*)(lds + (bufoff) + ldsw + _i * 8192), 16, 0, 0); } while (0)
#define PG8_LDA(dst, b, h) do { _Pragma("unroll") for (int m = 0; m < 4; ++m) _Pragma("unroll") for (int k = 0; k < 2; ++k) dst[m][k] = *(const PG8_LAS bf16x8*)(lds + PG8_SA(b, h) + aoff + m * 2048 + k * 1024); } while (0)
#define PG8_LDB(dst, b, h) do { _Pragma("unroll") for (int n = 0; n < 2; ++n) _Pragma("unroll") for (int k = 0; k < 2; ++k) dst[n][k] = *(const PG8_LAS bf16x8*)(lds + PG8_SB(b, h) + boff + n * 2048 + k * 1024); } while (0)
#define PG8_MMA(ai, bj, At, Bt) do { __builtin_amdgcn_s_setprio(1); if constexpr (F8) { mma_blk<true>(acc[ai][bj], At, Bt); } else { _Pragma("unroll") for (int m = 0; m < 4; ++m) _Pragma("unroll") for (int n = 0; n < 2; ++n) _Pragma("unroll") for (int k = 0; k < 2; ++k) \
        acc[ai][bj][m][n] = __builtin_amdgcn_mfma_f32_16x16x32_bf16(Bt[n][k], At[m][k], acc[ai][bj][m][n], 0, 0, 0); } __builtin_amdgcn_s_setprio(0); } while (0)
#define PG8_WAIT_V(n) asm volatile("s_waitcnt vmcnt(" #n ")" ::: "memory")
#define PG8_WAIT_L(n) asm volatile("s_waitcnt lgkmcnt(" #n ")" ::: "memory")
#define PG8_BAR __builtin_amdgcn_s_barrier()
#define PG8_SCHED __builtin_amdgcn_sched_barrier(0)
    Unit cur, nxt; int ui = 0;
    if (!S.next(0, cur)) return;
    f32x4 acc[2][2][4][2];
#pragma unroll
    for (int a = 0; a < 2; ++a)
#pragma unroll
        for (int b = 0; b < 2; ++b)
#pragma unroll
            for (int m = 0; m < 4; ++m)
#pragma unroll
                for (int n = 0; n < 2; ++n) acc[a][b][m][n] = (f32x4){0.f, 0.f, 0.f, 0.f};
    bf16x8 At[4][2], B0[2][2], B1[2][2];
    const char* cA = (const char*)g.A + (size_t)cur.pm * tstep; const char* cB = (const char*)g.Bt + (size_t)cur.pn * tstep;
    S.a_ready(cur);
    PG8_STAGE(PG8_SB(0, 0), cB, voffB); PG8_STAGE(PG8_SA(0, 0), cA, voffA); PG8_STAGE(PG8_SB(0, 1), cB + hstep, voffB); PG8_STAGE(PG8_SA(0, 1), cA + hstep, voffA);
    if (wr == 1) PG8_BAR;
    PG8_WAIT_V(4); PG8_BAR;
    PG8_STAGE(PG8_SB(1, 0), cB + kstep, voffB); PG8_STAGE(PG8_SA(1, 0), cA + kstep, voffA); PG8_STAGE(PG8_SB(1, 1), cB + hstep + kstep, voffB);
    PG8_WAIT_V(6); PG8_BAR;
    for (;;) {
        const bool has_next = S.next(ui + 1, nxt);
        const char* nA = has_next ? (const char*)g.A + (size_t)nxt.pm * tstep : cA; const char* nB = has_next ? (const char*)g.Bt + (size_t)nxt.pn * tstep : cB;
#define PG8_KBODY \
            const bool last = (t == nt - 2); \
            const char* a1 = cA + (size_t)(t + 1) * kstep; \
            const char* a2 = last ? nA : cA + (size_t)(t + 2) * kstep; const char* b2 = last ? nB : cB + (size_t)(t + 2) * kstep; \
            const char* a3 = a2 + kstep; const char* b3 = b2 + kstep; \
            if (last && has_next) S.a_ready(nxt); \
            PG8_LDB(B0, 0, 0); PG8_SCHED; PG8_LDA(At, 0, 0); PG8_STAGE(PG8_SA(1, 1), a1 + hstep, voffA); \
            PG8_WAIT_L(8); PG8_BAR; PG8_WAIT_L(0); PG8_MMA(0, 0, At, B0); PG8_BAR; PG8_SCHED; \
            PG8_LDB(B1, 0, 1); PG8_STAGE(PG8_SB(0, 0), b2, voffB); \
            PG8_BAR; PG8_WAIT_L(0); PG8_MMA(0, 1, At, B1); PG8_BAR; \
            PG8_LDA(At, 0, 1); PG8_STAGE(PG8_SA(0, 0), a2, voffA); \
            PG8_BAR; PG8_WAIT_L(0); PG8_MMA(1, 0, At, B0); PG8_BAR; PG8_SCHED; \
            PG8_STAGE(PG8_SB(0, 1), b2 + hstep, voffB); \
            PG8_WAIT_V(6); PG8_BAR; PG8_MMA(1, 1, At, B1); PG8_BAR; \
            PG8_LDB(B0, 1, 0); PG8_SCHED; PG8_LDA(At, 1, 0); PG8_STAGE(PG8_SA(0, 1), a2 + hstep, voffA); \
            PG8_WAIT_L(8); PG8_BAR; PG8_WAIT_L(0); PG8_MMA(0, 0, At, B0); PG8_BAR; PG8_SCHED; \
            PG8_LDB(B1, 1, 1); PG8_STAGE(PG8_SB(1, 0), b3, voffB); \
            PG8_BAR; PG8_WAIT_L(0); PG8_MMA(0, 1, At, B1); PG8_BAR; \
            PG8_LDA(At, 1, 1); PG8_STAGE(PG8_SA(1, 0), a3, voffA); \
            PG8_BAR; PG8_WAIT_L(0); PG8_MMA(1, 0, At, B0); PG8_BAR; PG8_SCHED; \
            PG8_STAGE(PG8_SB(1, 1), b3 + hstep, voffB); \
            PG8_WAIT_V(6); PG8_BAR; PG8_MMA(1, 1, At, B1); PG8_BAR;
        if constexpr (Mid::AT >= 0) {
            for (int t = 0; t < Mid::AT; t += 2) { PG8_KBODY }
            if constexpr (F8) asm volatile("s_nop 15\n\ts_nop 15" ::: "memory");
            Mh(acc, cur, wr, wc, fr, fq);
            for (int t = Mid::AT; t < nt; t += 2) { PG8_KBODY }
        } else {
            for (int t = 0; t < nt; t += 2) { PG8_KBODY }
        }
#undef PG8_KBODY
        if constexpr (F8) asm volatile("s_nop 15\n\ts_nop 15" ::: "memory");
        E(acc, cur, wr, wc, fr, fq); S.done(cur);
        if (!has_next) break;
#pragma unroll
        for (int a = 0; a < 2; ++a)
#pragma unroll
            for (int b = 0; b < 2; ++b)
#pragma unroll
                for (int m = 0; m < 4; ++m)
#pragma unroll
                    for (int n = 0; n < 2; ++n) acc[a][b][m][n] = (f32x4){0.f, 0.f, 0.f, 0.f};
        cur = nxt; cA = nA; cB = nB; ++ui;
    }
    PG8_WAIT_V(0);
    if (wr == 0) PG8_BAR;
    PG8_BAR;
#undef PG8_SA
#undef PG8_SB
#undef PG8_STAGE
#undef PG8_LDA
#undef PG8_LDB
#undef PG8_MMA
#undef PG8_WAIT_V
#undef PG8_WAIT_L
#undef PG8_BAR
#undef PG8_SCHED
}
}

#define GAS __attribute__((address_space(1)))
#define LAS __attribute__((address_space(3)))
typedef unsigned short bf16;
typedef float f32x4 __attribute__((ext_vector_type(4)));
typedef unsigned v4u __attribute__((ext_vector_type(4)));
typedef unsigned v2u __attribute__((ext_vector_type(2)));

constexpr int NB = 4, S = 4096, D = 2048, T = NB * S, HD = 128;
constexpr int IN_COLS = 11288, OFF_KV = 1024, OFF_GATE = 2560, OFF_DIL = 2584, OFF_MERGE = 7192;
constexpr int NPROJ = 11264;
constexpr int NQ = 1024, NKV = 1536, NDL = 4608, NMG = 4096;
constexpr int NC = 255, NS = 64;
constexpr int NE = 16384;
constexpr float EPS = 1e-6f;
constexpr float QSCALE = 0.08838834764831845f;
constexpr int NWAVES = 8, NTHREADS = 512;

constexpr size_t MiB = 1u << 20;
constexpr size_t WS_CTL = 0, CTL_ZERO_BYTES = 1 * MiB;
constexpr size_t WS_WIN = 1 * MiB;
constexpr size_t WS_WBN = 45 * MiB;
constexpr size_t WS_WBD = 49 * MiB;
constexpr size_t WS_WOUT = 51 * MiB;
constexpr size_t WS_WPQ = 59 * MiB;
constexpr size_t WS_WGATE = 67 * MiB;
constexpr size_t WS_MOD = 67 * MiB + 256 * 1024;
constexpr size_t WS_SEL = 67 * MiB + 512 * 1024;
constexpr size_t WS_GATES = 68 * MiB;
constexpr size_t WS_KC = 70 * MiB;
constexpr size_t WS_VC = 71 * MiB;
constexpr size_t WS_H = 72 * MiB;
constexpr size_t WS_Q = 136 * MiB;
constexpr size_t WS_KV = 168 * MiB;
constexpr size_t WS_DL = 216 * MiB;
constexpr size_t WS_MG = 360 * MiB;
constexpr size_t WS_YN = 488 * MiB;
constexpr size_t WS_YD = 520 * MiB;
constexpr size_t WS_H8 = WS_YN;
constexpr size_t WS_EI = 536 * MiB;
constexpr size_t WS_EG = 544 * MiB;
constexpr size_t WS_END = 552 * MiB;
constexpr size_t WS_PU = WS_Q;
constexpr size_t WS_PV = WS_Q + 64 * MiB;
constexpr size_t WS_QP = WS_MG;
static_assert(WS_PV + 64 * MiB <= WS_MG, "u/v overlay");

constexpr int LDS_BYTES = 147456;
constexpr int LDS_MISC = 144 * 1024 - 256;

#define XB_TMO      128
#define XB_XCNT(j)  (256  + 64 * (j))
#define XB_XSUB(j)  (1280 + 64 * (j))
#define XB_XGEN(j)  (2304 + 64 * (j))
#define XB_TOP      3328
#define XB_TOPGEN   3392
#define XCD_BAR_WORDS 3456
#define XB_SPIN_CAP (1u << 24)

__device__ __forceinline__ unsigned xb_ld(unsigned* p)              { return __hip_atomic_load(p, __ATOMIC_RELAXED, __HIP_MEMORY_SCOPE_AGENT); }
__device__ __forceinline__ unsigned xb_add(unsigned* p, unsigned v) { return __hip_atomic_fetch_add(p, v, __ATOMIC_RELAXED, __HIP_MEMORY_SCOPE_AGENT); }
__device__ __forceinline__ unsigned xb_xcc_id() { return (unsigned)__builtin_amdgcn_s_getreg((3 << 11) | 20) & 0xFu; }
#define XB_SPIN(cond, bar) do { unsigned _sp = 0; while (cond) { __builtin_amdgcn_s_sleep(1); \
    if ((++_sp & 255u) == 0u) { if (xb_ld(&(bar)[XB_TMO])) break; if (_sp > XB_SPIN_CAP) { atomicAdd(&(bar)[XB_TMO], 1u); break; } } } } while (0)

struct XcdBarrier { unsigned* bar; unsigned x; volatile LAS unsigned* st; };

__device__ __forceinline__ XcdBarrier xcd_barrier_post(unsigned* bar, volatile LAS unsigned* st) {
    XcdBarrier b; b.bar = bar; b.x = xb_xcc_id(); b.st = st;
    if (threadIdx.x == 0) (void)xb_add(&bar[XB_XCNT(b.x)], 1u);
    return b;
}
__device__ __forceinline__ void xcd_barrier_complete(unsigned* bar, unsigned x, unsigned& nloc, unsigned& nx) {
    const unsigned G = gridDim.x * gridDim.y * gridDim.z;
    unsigned sum, cnt, mine, sp = 0u;
    for (;;) {
        sum = 0u; cnt = 0u; mine = 0u;
#pragma unroll
        for (unsigned j = 0; j < 16; ++j) { const unsigned c = xb_ld(&bar[XB_XCNT(j)]); sum += c; cnt += (c > 0u) ? 1u : 0u; mine = (j == x) ? c : mine; }
        if (sum == G) break;
        __builtin_amdgcn_s_sleep(1);
        if ((++sp & 255u) == 0u) { if (xb_ld(&bar[XB_TMO])) break; if (sp > XB_SPIN_CAP) { atomicAdd(&bar[XB_TMO], 1u); break; } }
    }
    nloc = mine > 0u ? mine : 1u; nx = cnt > 0u ? cnt : 1u;
}
__device__ __forceinline__ void xcd_barrier(const XcdBarrier& b) {
    asm volatile("s_waitcnt vmcnt(0)" ::: "memory");
    __syncthreads();
    if (threadIdx.x == 0) {
        unsigned* bar = b.bar;
        __builtin_amdgcn_s_waitcnt(0);
        unsigned nloc = b.st[0], nx = b.st[1];
        if (nloc == 0u) { xcd_barrier_complete(bar, b.x, nloc, nx); b.st[0] = nloc; b.st[1] = nx; }
        const unsigned old = xb_add(&bar[XB_XSUB(b.x)], 1u);
        const unsigned gen = old / nloc;
        if (old + 1u == (gen + 1u) * nloc) {
            __builtin_amdgcn_fence(__ATOMIC_RELEASE, "agent");
            asm volatile("s_waitcnt vmcnt(0)" ::: "memory");
            const unsigned og = xb_add(&bar[XB_TOP], 1u);
            const unsigned tg = og / nx;
            if (og + 1u == (tg + 1u) * nx) xb_add(&bar[XB_TOPGEN], 1u);
            else XB_SPIN(xb_ld(&bar[XB_TOPGEN]) == tg, bar);
            __builtin_amdgcn_fence(__ATOMIC_ACQUIRE, "agent");
            xb_add(&bar[XB_XGEN(b.x)], 1u);
            asm volatile("s_waitcnt vmcnt(0)" ::: "memory");
        } else {
            XB_SPIN(xb_ld(&bar[XB_XGEN(b.x)]) == gen, bar);
            __builtin_amdgcn_fence(__ATOMIC_ACQUIRE, "agent");
            asm volatile("s_waitcnt vmcnt(0)" ::: "memory");
        }
    }
    __syncthreads();
}

__device__ __forceinline__ unsigned f2bf(float f) { unsigned u = __builtin_bit_cast(unsigned, f); return (u + 0x7fffu + ((u >> 16) & 1u)) >> 16; }
__device__ __forceinline__ unsigned pk2(float lo, float hi) { return f2bf(lo) | (f2bf(hi) << 16); }
__device__ __forceinline__ unsigned pk4_f8(float a, float b, float c, float d) {
    a = __builtin_amdgcn_fmed3f(a, -448.f, 448.f); b = __builtin_amdgcn_fmed3f(b, -448.f, 448.f); c = __builtin_amdgcn_fmed3f(c, -448.f, 448.f); d = __builtin_amdgcn_fmed3f(d, -448.f, 448.f);
    int w = 0; w = __builtin_amdgcn_cvt_pk_fp8_f32(a, b, w, false); w = __builtin_amdgcn_cvt_pk_fp8_f32(c, d, w, true); return (unsigned)w; }
constexpr float F8_HS = 8.f, F8_WS = 128.f, F8_MS = 64.f;
__device__ __forceinline__ float bflo(unsigned u) { return __builtin_bit_cast(float, u << 16); }
__device__ __forceinline__ float bfhi(unsigned u) { return __builtin_bit_cast(float, u & 0xffff0000u); }
__device__ __forceinline__ float bf2f(bf16 u) { return __builtin_bit_cast(float, (unsigned)u << 16); }
__device__ __forceinline__ float wave_sum(float v) {
#pragma unroll
    for (int o = 1; o < 64; o <<= 1) v += __shfl_xor(v, o);
    return v;
}
__device__ __forceinline__ float wave_max(float v) {
#pragma unroll
    for (int o = 1; o < 64; o <<= 1) v = fmaxf(v, __shfl_xor(v, o));
    return v;
}
__device__ __forceinline__ float sigmoidf(float x) { return __builtin_amdgcn_rcpf(1.f + __expf(-x)); }
__device__ __forceinline__ float gelu_tanh(float x) { const float u = 0.7978845608028654f * (x + 0.044715f * x * x * x); return 0.5f * x * (1.f + tanhf(u)); }
__device__ __forceinline__ int t5_bucket(int n) {
    if (n < 16) return n;
    int b = 16;
    b += (n >= 22); b += (n >= 30); b += (n >= 40); b += (n >= 54); b += (n >= 73); b += (n >= 99); b += (n >= 134); b += (n >= 182);
    b += (n >= 246); b += (n >= 332); b += (n >= 450); b += (n >= 609); b += (n >= 825); b += (n >= 1117); b += (n >= 1513);
    return b;
}

struct Args {
    const float* in[23];
    float* out; unsigned char* ws;
    int ph_lo, ph_hi;
};

typedef float f32x2v __attribute__((ext_vector_type(2)));
__device__ __forceinline__ void ph0_mod(const Args& a, LAS unsigned char* lds) {
    const int tid = phase_tid(), lane = tid & 63, wave = __builtin_amdgcn_readfirstlane(tid >> 6);
    LAS float* cs = (LAS float*)lds;
    LAS float* red = (LAS float*)(lds + 32768);
    const float* c = a.in[1]; const float* w_ada = a.in[2]; const float* b_ada = a.in[3];
    float* mod = (float*)(a.ws + WS_MOD);
    for (int i = tid; i < 4 * 2048; i += NTHREADS) { const float v = c[i]; cs[i] = v / (1.f + __expf(-v)); }
    __syncthreads();
    for (int u = blockIdx.x; u < 12288 / 128; u += gridDim.x) {
        const int col = u * 128 + 2 * lane;
        float acc[4][2];
#pragma unroll
        for (int b = 0; b < 4; ++b) { acc[b][0] = 0.f; acc[b][1] = 0.f; }
        const float* wp = w_ada + (size_t)(wave * 256) * 12288 + col;
#pragma unroll 1
        for (int k0 = 0; k0 < 256; k0 += 16) {
            f32x2v w[16];
#pragma unroll
            for (int k = 0; k < 16; ++k) w[k] = *(const f32x2v*)(wp + (size_t)(k0 + k) * 12288);
#pragma unroll
            for (int k = 0; k < 16; ++k) { const int kk = wave * 256 + k0 + k;
#pragma unroll
                for (int b = 0; b < 4; ++b) { const float cv = cs[b * 2048 + kk]; acc[b][0] += cv * w[k].x; acc[b][1] += cv * w[k].y; } }
        }
#pragma unroll
        for (int b = 0; b < 4; ++b) { red[(wave * 4 + b) * 128 + 2 * lane] = acc[b][0]; red[(wave * 4 + b) * 128 + 2 * lane + 1] = acc[b][1]; }
        __syncthreads();
        { const int b = tid >> 7, cc = tid & 127; float s = 0.f;
#pragma unroll
          for (int w = 0; w < 8; ++w) s += red[(w * 4 + b) * 128 + cc];
          mod[b * 12288 + u * 128 + cc] = s + b_ada[u * 128 + cc]; }
        __syncthreads();
    }
}
__device__ __forceinline__ void transpose_item(const float* W, int ldw, int ncols, int K, bf16* WT, int row_off, LAS float* scr, int item, int lane, int ldt = 0) {
    if (ldt == 0) ldt = K;
    const int nblk = ncols / 32, kb = item / nblk, nb = item % nblk, k0 = 64 * kb, n0 = 32 * nb;
    float tv[32];
#pragma unroll
    for (int i = 0; i < 32; ++i) tv[i] = W[(size_t)(k0 + 2 * i + (lane >> 5)) * ldw + n0 + (lane & 31)];
#pragma unroll
    for (int i = 0; i < 32; ++i) scr[(2 * i + (lane >> 5)) * 33 + (lane & 31)] = tv[i];
    asm volatile("s_waitcnt lgkmcnt(0)" ::: "memory");
    const int c = lane & 7;
#pragma unroll
    for (int j = 0; j < 4; ++j) { const int n = (lane >> 3) + 8 * j; const LAS float* s = scr + (8 * c) * 33 + n;
        v4u o; o.x = pk2(s[0 * 33], s[1 * 33]); o.y = pk2(s[2 * 33], s[3 * 33]); o.z = pk2(s[4 * 33], s[5 * 33]); o.w = pk2(s[6 * 33], s[7 * 33]);
        *(v4u*)(WT + (size_t)(row_off + n0 + n) * ldt + k0 + 8 * c) = o; }
    asm volatile("s_waitcnt lgkmcnt(0)" ::: "memory");
}
__device__ __forceinline__ void transpose_item_f8(const float* W, int ldw, int ncols, int K, unsigned char* WT, int row_off, LAS float* scr, int item, int lane) {
    const int nblk = ncols / 32, kb = item / nblk, nb = item % nblk, k0 = 64 * kb, n0 = 32 * nb;
    float tv[32];
#pragma unroll
    for (int i = 0; i < 32; ++i) tv[i] = W[(size_t)(k0 + 2 * i + (lane >> 5)) * ldw + n0 + (lane & 31)];
#pragma unroll
    for (int i = 0; i < 32; ++i) scr[(2 * i + (lane >> 5)) * 33 + (lane & 31)] = tv[i] * F8_WS;
    asm volatile("s_waitcnt lgkmcnt(0)" ::: "memory");
    const int c = lane & 7;
#pragma unroll
    for (int j = 0; j < 4; ++j) { const int n = (lane >> 3) + 8 * j; const LAS float* s = scr + (8 * c) * 33 + n;
        v2u o; o.x = pk4_f8(s[0 * 33], s[1 * 33], s[2 * 33], s[3 * 33]); o.y = pk4_f8(s[4 * 33], s[5 * 33], s[6 * 33], s[7 * 33]);
        *(v2u*)(WT + (size_t)(row_off + n0 + n) * K + k0 + 8 * c) = o; }
    asm volatile("s_waitcnt lgkmcnt(0)" ::: "memory");
}
__device__ __forceinline__ void ph0_weights(const Args& a, LAS unsigned char* lds) {
    const int tid = phase_tid(), lane = tid & 63, wave = __builtin_amdgcn_readfirstlane(tid >> 6);
    LAS float* scr = (LAS float*)(lds + wave * 16384);
    const int gw = blockIdx.x * NWAVES + wave, NGW = gridDim.x * NWAVES;
    const float* w_in = a.in[5];
    unsigned char* WIN = a.ws + WS_WIN;
    constexpr int I_Q = 32 * (NQ / 32), I_KV = 32 * (NKV / 32), I_DL = 32 * (NDL / 32), I_MG = 32 * (NMG / 32);
    constexpr int I_BN = 16 * 64, I_BD = 8 * 64, I_O = 32 * 64, I_PQ = 32 * 64;
    constexpr int NITEMS = I_Q + I_KV + I_DL + I_MG + I_BN + I_BD + I_O + I_PQ;
    for (int it = gw; it < NITEMS; it += NGW) {
        int r = it;
        if (r < I_Q)  { transpose_item_f8(w_in, IN_COLS, NQ, D, WIN, 0, scr, r, lane); continue; } r -= I_Q;
        if (r < I_KV) { transpose_item_f8(w_in + OFF_KV, IN_COLS, NKV, D, WIN, NQ, scr, r, lane); continue; } r -= I_KV;
        if (r < I_DL) { transpose_item_f8(w_in + OFF_DIL, IN_COLS, NDL, D, WIN, NQ + NKV, scr, r, lane); continue; } r -= I_DL;
        if (r < I_MG) { transpose_item_f8(w_in + OFF_MERGE, IN_COLS, NMG, D, WIN, NQ + NKV + NDL, scr, r, lane); continue; } r -= I_MG;
        if (r < I_BN) { transpose_item(a.in[13], D, D, 1024, (bf16*)(a.ws + WS_WBN), 0, scr, r, lane, 1536); continue; } r -= I_BN;
        if (r < I_BD) { transpose_item(a.in[14], D, D, 512, (bf16*)(a.ws + WS_WBN) + 1024, 0, scr, r, lane, 1536); continue; } r -= I_BD;
        if (r < I_O)  { transpose_item_f8(a.in[15], D, D, D, a.ws + WS_WOUT, 0, scr, r, lane); continue; } r -= I_O;
        transpose_item(a.in[17], D, D, D, (bf16*)(a.ws + WS_WPQ), 0, scr, r, lane);
    }
}

constexpr size_t WS_CW1F = 602 * MiB;
constexpr size_t WS_WGF = 604 * MiB;
constexpr size_t WS_CBP = 604 * MiB + 256 * 1024;
constexpr size_t WS_END4 = 605 * MiB;
__device__ __forceinline__ void ph0_extra(const Args& a) {
    const int tid = phase_tid(), lane = tid & 63, wave = __builtin_amdgcn_readfirstlane(tid >> 6);
    const float* w1 = a.in[9]; const float* pos = a.in[8]; const float* w_in = a.in[5];
    v4u* CW = (v4u*)(a.ws + WS_CW1F); v4u* WG = (v4u*)(a.ws + WS_WGF); float* CBP = (float*)(a.ws + WS_CBP);
    for (int i = blockIdx.x * NTHREADS + tid; i < 2 * 4 * 256 * 64; i += gridDim.x * NTHREADS) {
        const int ln = i & 63, ks = (i >> 6) & 255, nt = (i >> 14) & 3, j = i >> 16;
        const float* src = w1 + ((size_t)j * 4096 + 16 * ks + 8 * (ln >> 5)) * 128 + 32 * nt + (ln & 31);
        v4u o; o.x = pk2(src[0], src[128]); o.y = pk2(src[256], src[384]); o.z = pk2(src[512], src[640]); o.w = pk2(src[768], src[896]);
        CW[i] = o;
    }
    for (int i = blockIdx.x * NTHREADS + tid; i < 128 * 64; i += gridDim.x * NTHREADS) {
        const int ln = i & 63, ks = i >> 6, jrow = ln & 31;
        v4u o = {0u, 0u, 0u, 0u};
        if (jrow < 24) { const float* src = w_in + (size_t)(16 * ks + 8 * (ln >> 5)) * IN_COLS + OFF_GATE + jrow;
            o.x = pk2(src[0], src[IN_COLS]); o.y = pk2(src[2 * (size_t)IN_COLS], src[3 * (size_t)IN_COLS]); o.z = pk2(src[4 * (size_t)IN_COLS], src[5 * (size_t)IN_COLS]); o.w = pk2(src[6 * (size_t)IN_COLS], src[7 * (size_t)IN_COLS]); }
        WG[i] = o;
    }
    { const int gw = blockIdx.x * NWAVES + wave;
      if (gw < 128) { const int kc = gw >> 1, j = gw & 1; float s0 = 0.f, s1 = 0.f; const float* wp = w1 + ((size_t)j * 4096 + 64 * kc) * 128 + lane; const float* pp = pos + j * 4096 + 64 * kc;
#pragma unroll 1
          for (int k0 = 0; k0 < 64; k0 += 16) { float wa[16], wb[16];
#pragma unroll
              for (int k = 0; k < 16; ++k) { wa[k] = wp[(k0 + k) * 128]; wb[k] = wp[(k0 + k) * 128 + 64]; }
#pragma unroll
              for (int k = 0; k < 16; ++k) { const float pv = pp[k0 + k]; s0 += pv * wa[k]; s1 += pv * wb[k]; } }
          CBP[(kc * 2 + j) * 128 + lane] = s0; CBP[(kc * 2 + j) * 128 + 64 + lane] = s1; } }
}

template <bool F8 = false>
__device__ __forceinline__ void ph_norm(const Args& a, const float* xin, const float* gvec, int sh_off, int sc_off, bf16* hout, unsigned char* h8 = nullptr) {
    const int tid = phase_tid(), lane = tid & 63, wave = __builtin_amdgcn_readfirstlane(tid >> 6);
    const int gw = blockIdx.x * NWAVES + wave, NGW = gridDim.x * NWAVES;
    const float* mod = (const float*)(a.ws + WS_MOD);
    for (int r = gw; r < S / 2; r += NGW)
#pragma unroll 1
        for (int bq = 0; bq < NB; ++bq) {
            const int m0 = bq * S + r, m1 = m0 + S / 2;
            const float* x0 = xin + (size_t)m0 * D + 8 * lane; const float* x1 = xin + (size_t)m1 * D + 8 * lane;
            f32x4 v0[8], v1[8];
#pragma unroll
            for (int c = 0; c < 4; ++c) { v0[2 * c] = *(const f32x4*)(x0 + 512 * c); v0[2 * c + 1] = *(const f32x4*)(x0 + 512 * c + 4); v1[2 * c] = *(const f32x4*)(x1 + 512 * c); v1[2 * c + 1] = *(const f32x4*)(x1 + 512 * c + 4); }
            float s0 = 0.f, s1 = 0.f;
#pragma unroll
            for (int i = 0; i < 8; ++i) { s0 += (v0[i].x * v0[i].x + v0[i].y * v0[i].y) + (v0[i].z * v0[i].z + v0[i].w * v0[i].w); s1 += (v1[i].x * v1[i].x + v1[i].y * v1[i].y) + (v1[i].z * v1[i].z + v1[i].w * v1[i].w); }
            const float r0 = rsqrtf(wave_sum(s0) * (1.f / D) + EPS), r1 = rsqrtf(wave_sum(s1) * (1.f / D) + EPS);
            const float* shp = mod + bq * 12288 + sh_off + 8 * lane; const float* scp = mod + bq * 12288 + sc_off + 8 * lane; const float* gp = gvec + 8 * lane;
#pragma unroll
            for (int c = 0; c < 4; ++c) {
                v4u o0, o1; unsigned w0[4], w1[4]; [[maybe_unused]] unsigned q0[2], q1[2];
#pragma unroll
                for (int hq = 0; hq < 2; ++hq) { const f32x4 g = *(const f32x4*)(gp + 512 * c + 4 * hq), sc = *(const f32x4*)(scp + 512 * c + 4 * hq), sh = *(const f32x4*)(shp + 512 * c + 4 * hq);
                    const f32x4 ga = g * (1.f + sc); const f32x4 y0 = v0[2 * c + hq] * r0 * ga + sh, y1 = v1[2 * c + hq] * r1 * ga + sh;
                    w0[2 * hq] = pk2(y0.x, y0.y); w0[2 * hq + 1] = pk2(y0.z, y0.w); w1[2 * hq] = pk2(y1.x, y1.y); w1[2 * hq + 1] = pk2(y1.z, y1.w);
                    if constexpr (F8) { q0[hq] = pk4_f8(y0.x * F8_HS, y0.y * F8_HS, y0.z * F8_HS, y0.w * F8_HS); q1[hq] = pk4_f8(y1.x * F8_HS, y1.y * F8_HS, y1.z * F8_HS, y1.w * F8_HS); } }
                o0.x = w0[0]; o0.y = w0[1]; o0.z = w0[2]; o0.w = w0[3]; o1.x = w1[0]; o1.y = w1[1]; o1.z = w1[2]; o1.w = w1[3];
                *(v4u*)(hout + (size_t)m0 * D + 512 * c + 8 * lane) = o0; *(v4u*)(hout + (size_t)m1 * D + 512 * c + 8 * lane) = o1;
                if constexpr (F8) { v2u p0, p1; p0.x = q0[0]; p0.y = q0[1]; p1.x = q1[0]; p1.y = q1[1];
                    *(v2u*)(h8 + (size_t)m0 * D + 512 * c + 8 * lane) = p0; *(v2u*)(h8 + (size_t)m1 * D + 512 * c + 8 * lane) = p1; }
            }
        }
}

using pg8::Unit; using pg8::HALF; using pg8::BM;
struct EpiProj {
    static constexpr bool PERM = true;
    bf16 *q, *kv, *dl, *mg;
    __device__ __forceinline__ void operator()(const f32x4 (&acc)[2][2][4][2], const Unit& u, int wr, int wc, int fr, int fq) const {
        bf16* base; int ldc, colt = u.pn * BM;
        if (colt < NQ) { base = q; ldc = NQ; } else if (colt < NQ + NKV) { base = kv; ldc = NKV; colt -= NQ; } else if (colt < NQ + NKV + NDL) { base = dl; ldc = NDL; colt -= NQ + NKV; } else { base = mg; ldc = NMG; colt -= NQ + NKV + NDL; }
        const int row0 = u.pm * BM + wr * 64 + fr, col0 = colt + wc * 32 + 8 * fq;
#pragma unroll
        for (int ai = 0; ai < 2; ++ai)
#pragma unroll
            for (int m = 0; m < 4; ++m) { bf16* rowp = base + (size_t)(row0 + ai * HALF + m * 16) * ldc + col0;
#pragma unroll
                for (int bj = 0; bj < 2; ++bj) { const f32x4 v0 = acc[ai][bj][m][0], v1 = acc[ai][bj][m][1];
                    v4u w; w.x = pg8::cvt_pk_bf16(v0[0], v0[1]); w.y = pg8::cvt_pk_bf16(v0[2], v0[3]); w.z = pg8::cvt_pk_bf16(v1[0], v1[1]); w.w = pg8::cvt_pk_bf16(v1[2], v1[3]);
                    *(v4u*)(rowp + bj * HALF) = w; } }
    }
};
struct MidMerge {
    static constexpr int AT = 16;
    const bf16* mg;
    __device__ __forceinline__ void operator()(f32x4 (&acc)[2][2][4][2], const Unit& u, int wr, int wc, int fr, int fq) const {
        int lo = (fq * 16 + fr) * 8;
        asm volatile("" : "+v"(lo));
        const bf16* t1 = mg + (((size_t)(u.pm * 16 + u.pn) * 8 + (wr * 4 + wc)) << 13) + lo; const bf16* t2 = t1 + ((size_t)8 << 16);
#pragma unroll
        for (int ai = 0; ai < 2; ++ai) {
            v4u a1[4][2], a2[4][2];
#pragma unroll
            for (int m = 0; m < 4; ++m)
#pragma unroll
                for (int bj = 0; bj < 2; ++bj) { a1[m][bj] = *(const v4u*)(t1 + ((ai * 4 + m) * 2 + bj) * 512); a2[m][bj] = *(const v4u*)(t2 + ((ai * 4 + m) * 2 + bj) * 512); }
#pragma unroll
            for (int m = 0; m < 4; ++m)
#pragma unroll
                for (int bj = 0; bj < 2; ++bj) { const unsigned w1[4] = {a1[m][bj].x, a1[m][bj].y, a1[m][bj].z, a1[m][bj].w}, w2[4] = {a2[m][bj].x, a2[m][bj].y, a2[m][bj].z, a2[m][bj].w};
#pragma unroll
                    for (int q = 0; q < 4; ++q) { const float r0 = (1.f + __expf(-bflo(w2[q]))) * __builtin_amdgcn_rcpf(1.f + __expf(-bflo(w1[q]))), r1 = (1.f + __expf(-bfhi(w2[q]))) * __builtin_amdgcn_rcpf(1.f + __expf(-bfhi(w1[q])));
                        acc[ai][bj][m][q >> 1][2 * (q & 1)] *= r0; acc[ai][bj][m][q >> 1][2 * (q & 1) + 1] *= r1; } }
            asm volatile("" ::: "memory");
        }
    }
};
struct EpiMerge {
    static constexpr bool PERM = true;
    const bf16* mg; unsigned char* merged8; float os;
    __device__ __forceinline__ void operator()(const f32x4 (&acc)[2][2][4][2], const Unit& u, int wr, int wc, int fr, int fq) const {
        int row0 = u.pm * BM + wr * 64 + fr; const int col0 = u.pn * BM + wc * 32 + 8 * fq;
        asm volatile("" : "+v"(row0));
        const bf16* t2 = mg + (((size_t)(u.pm * 16 + 8 + u.pn) * 8 + (wr * 4 + wc)) << 13) + (fq * 16 + fr) * 8;
        v4u a2[2][4][2];
#pragma unroll
        for (int ai = 0; ai < 2; ++ai)
#pragma unroll
            for (int m = 0; m < 4; ++m)
#pragma unroll
                for (int bj = 0; bj < 2; ++bj) a2[ai][m][bj] = *(const v4u*)(t2 + ((ai * 4 + m) * 2 + bj) * 512);
#pragma unroll
        for (int ai = 0; ai < 2; ++ai)
#pragma unroll
            for (int m = 0; m < 4; ++m) { const size_t row = (size_t)(row0 + ai * HALF + m * 16);
#pragma unroll
                for (int bj = 0; bj < 2; ++bj) { const unsigned w2[4] = {a2[ai][m][bj].x, a2[ai][m][bj].y, a2[ai][m][bj].z, a2[ai][m][bj].w};
                    const f32x4 v0 = acc[ai][bj][m][0] * os, v1 = acc[ai][bj][m][1] * os;
                    v2u w; w.x = pk4_f8(v0[0] * sigmoidf(bflo(w2[0])), v0[1] * sigmoidf(bfhi(w2[0])), v0[2] * sigmoidf(bflo(w2[1])), v0[3] * sigmoidf(bfhi(w2[1])));
                    w.y = pk4_f8(v1[0] * sigmoidf(bflo(w2[2])), v1[1] * sigmoidf(bfhi(w2[2])), v1[2] * sigmoidf(bflo(w2[3])), v1[3] * sigmoidf(bfhi(w2[3])));
                    *(v2u*)(merged8 + row * D + col0 + bj * HALF) = w; } }
    }
};
struct EpiOut {
    static constexpr bool PERM = false;
    const float* x; const float* mod; float* x1; float as;
    __device__ __forceinline__ void operator()(const f32x4 (&acc)[2][2][4][2], const Unit& u, int wr, int wc, int fr, int fq) const {
        const int row0 = u.pm * BM + wr * 64 + fr, col0 = u.pn * BM + wc * 32 + 4 * fq;
        const int b = (u.pm * BM) / S;
        f32x4 gv[2][2];
#pragma unroll
        for (int bj = 0; bj < 2; ++bj)
#pragma unroll
            for (int n = 0; n < 2; ++n) gv[bj][n] = *(const f32x4*)(mod + b * 12288 + 4096 + col0 + bj * HALF + n * 16) * as;
#pragma unroll
        for (int ai = 0; ai < 2; ++ai)
#pragma unroll
            for (int m = 0; m < 4; ++m) { const size_t off = (size_t)(row0 + ai * HALF + m * 16) * D + col0;
#pragma unroll
                for (int bj = 0; bj < 2; ++bj)
#pragma unroll
                    for (int n = 0; n < 2; ++n) *(f32x4*)(x1 + off + bj * HALF + n * 16) = *(const f32x4*)(x + off + bj * HALF + n * 16) + gv[bj][n] * acc[ai][bj][m][n]; }
    }
};
struct EpiF32 {
    static constexpr bool PERM = false;
    float* C; int ldc;
    __device__ __forceinline__ void operator()(const f32x4 (&acc)[2][2][4][2], const Unit& u, int wr, int wc, int fr, int fq) const {
        const int row0 = u.pm * BM + wr * 64 + fr, col0 = u.pn * BM + wc * 32 + 4 * fq;
#pragma unroll
        for (int ai = 0; ai < 2; ++ai)
#pragma unroll
            for (int m = 0; m < 4; ++m) { float* rowp = C + (size_t)(row0 + ai * HALF + m * 16) * ldc + col0;
#pragma unroll
                for (int bj = 0; bj < 2; ++bj)
#pragma unroll
                    for (int n = 0; n < 2; ++n) *(f32x4*)(rowp + bj * HALF + n * 16) = acc[ai][bj][m][n]; }
    }
};

typedef short bf16x8 __attribute__((ext_vector_type(8)));
typedef float f32x16 __attribute__((ext_vector_type(16)));
typedef float f32x2 __attribute__((ext_vector_type(2)));
typedef __bf16 bf2v __attribute__((ext_vector_type(2)));
constexpr float LOG2E = 1.4426950408889634f;
constexpr float QS2 = QSCALE * LOG2E;
constexpr float NEGB = -1e30f;
__device__ __forceinline__ unsigned pkbf(float a, float b) { const f32x2 v = {a, b}; const bf2v r = __builtin_convertvector(v, bf2v); return __builtin_bit_cast(unsigned, r); }
__device__ __forceinline__ float ex2(float x) { return __builtin_amdgcn_exp2f(x); }
__device__ __forceinline__ int swap23(int x) { return (x & ~12) | ((x & 4) << 1) | ((x & 8) >> 1); }
__device__ __forceinline__ size_t kf_off(int key, int d) { return ((size_t)((key >> 5) * 8 + (d >> 4)) * 64 + ((d >> 3) & 1) * 32 + swap23(key & 31)) * 8 + (d & 7); }
__device__ __forceinline__ size_t vf_off(int key, int d) { const int kk = key & 31; return ((size_t)(((key >> 5) * 4 + (d >> 5)) * 2 + (kk >> 4)) * 64 + ((kk >> 3) & 1) * 32 + (d & 31)) * 8 + (kk & 7); }
__device__ __forceinline__ bf16* fr_nsa(const Args& a, int bg, int kind) { return (bf16*)a.out + ((size_t)(bg * 4 + kind) << 19); }
__device__ __forceinline__ bf16* fr_dil(const Args& a, int b, int head, int kv) { return (bf16*)a.out + ((size_t)16 << 20) + ((size_t)((b * 12 + head) * 2 + kv) << 19); }
constexpr size_t WS_OD = 552 * MiB;
constexpr size_t WS_LSE = 600 * MiB;
constexpr size_t WS_END2 = 601 * MiB;

struct EpiProjNorm {
    static constexpr bool PERM = true;
    bf16 *q, *kv, *dl, *mg, *frg;
    const float *qg, *kg, *dqg, *dkg;
    LAS float* xch;
    float as;
    __device__ __forceinline__ void operator()(const f32x4 (&acc)[2][2][4][2], const Unit& u, int wr, int wc, int fr, int fq) const {
        bf16* base; int ldc, colt = u.pn * BM, mode = 0  , hsel = 0; const float* gain = qg; float scale = 1.f;
        if (colt < NQ) { base = q; ldc = NQ; mode = 1; gain = qg; scale = QS2; }
        else if (colt < NQ + NKV) { base = kv; ldc = NKV; colt -= NQ; hsel = colt >> 7; if (hsel == 4 || hsel == 8) { mode = 2; gain = kg + (hsel == 4 ? 128 : 256); } }
        else if (colt < NQ + NKV + NDL) { base = dl; ldc = NDL; colt -= NQ + NKV; hsel = colt >> 7; if (hsel < 12) { mode = 1; gain = dqg; scale = QS2; } else if (hsel < 24) { mode = 3; gain = dkg; } }
        else { base = mg; ldc = NMG; colt -= NQ + NKV + NDL; }
        const int row0 = u.pm * BM + wr * 64 + fr, col0 = colt + wc * 32 + 8 * fq;
        if (base == mg) {
            bf16* tp = mg + (((size_t)(u.pm * 16 + (colt >> 8)) * 8 + (wr * 4 + wc)) << 13) + (fq * 16 + fr) * 8;
#pragma unroll
            for (int ai = 0; ai < 2; ++ai)
#pragma unroll
                for (int m = 0; m < 4; ++m)
#pragma unroll
                    for (int bj = 0; bj < 2; ++bj) { const f32x4 v0 = acc[ai][bj][m][0] * as, v1 = acc[ai][bj][m][1] * as;
                        v4u w; w.x = pg8::cvt_pk_bf16(v0[0], v0[1]); w.y = pg8::cvt_pk_bf16(v0[2], v0[3]); w.z = pg8::cvt_pk_bf16(v1[0], v1[1]); w.w = pg8::cvt_pk_bf16(v1[2], v1[3]);
                        *(v4u*)(tp + ((ai * 4 + m) * 2 + bj) * 512) = w; }
            return;
        }
        if (mode == 0) {
#pragma unroll
            for (int ai = 0; ai < 2; ++ai)
#pragma unroll
                for (int m = 0; m < 4; ++m) { bf16* rowp = base + (size_t)(row0 + ai * HALF + m * 16) * ldc + col0;
#pragma unroll
                    for (int bj = 0; bj < 2; ++bj) { const f32x4 v0 = acc[ai][bj][m][0] * as, v1 = acc[ai][bj][m][1] * as;
                        v4u w; w.x = pg8::cvt_pk_bf16(v0[0], v0[1]); w.y = pg8::cvt_pk_bf16(v0[2], v0[3]); w.z = pg8::cvt_pk_bf16(v1[0], v1[1]); w.w = pg8::cvt_pk_bf16(v1[2], v1[3]);
                        *(v4u*)(rowp + bj * HALF) = w; } }
            return;
        }
#pragma unroll
        for (int ai = 0; ai < 2; ++ai)
#pragma unroll
            for (int m = 0; m < 4; ++m)
#pragma unroll
                for (int bj = 0; bj < 2; ++bj) { const f32x4 v0 = acc[ai][bj][m][0], v1 = acc[ai][bj][m][1];
                    float ss = (v0[0] * v0[0] + v0[1] * v0[1]) + (v0[2] * v0[2] + v0[3] * v0[3]) + (v1[0] * v1[0] + v1[1] * v1[1]) + (v1[2] * v1[2] + v1[3] * v1[3]);
                    ss += __shfl_xor(ss, 16); ss += __shfl_xor(ss, 32);
                    if (fq == 0) xch[(((((wr * 2 + ai) * 4 + m) * 16 + fr) * 2 + bj) << 2) + wc] = ss; }
        asm volatile("s_waitcnt lgkmcnt(0)" ::: "memory");
        __builtin_amdgcn_s_barrier();
        asm volatile("" ::: "memory");
        const f32x4 ga = *(const f32x4*)(gain + wc * 32 + 8 * fq), gb = *(const f32x4*)(gain + wc * 32 + 8 * fq + 4);
#pragma unroll
        for (int ai = 0; ai < 2; ++ai)
#pragma unroll
            for (int m = 0; m < 4; ++m) { const int t = row0 + ai * HALF + m * 16, b = t / S, s = t % S;
#pragma unroll
                for (int bj = 0; bj < 2; ++bj) { const f32x4 pp = *(const LAS f32x4*)(xch + (((((wr * 2 + ai) * 4 + m) * 16 + fr) * 2 + bj) << 2));
                    const float rstd = rsqrtf(((pp.x + pp.y) + (pp.z + pp.w)) * (as * as * (1.f / 128.f)) + EPS) * (scale * as);
                    const f32x4 v0 = acc[ai][bj][m][0] * rstd * ga, v1 = acc[ai][bj][m][1] * rstd * gb;
                    v4u w; w.x = pg8::cvt_pk_bf16(v0[0], v0[1]); w.y = pg8::cvt_pk_bf16(v0[2], v0[3]); w.z = pg8::cvt_pk_bf16(v1[0], v1[1]); w.w = pg8::cvt_pk_bf16(v1[2], v1[3]);
                    bf16* dst;
                    if (mode == 1) dst = base + (size_t)t * ldc + col0 + bj * HALF;
                    else if (mode == 2) dst = frg + ((size_t)((b * 2 + bj) * 4 + (hsel == 4 ? 0 : 2)) << 19) + kf_off(s, wc * 32 + 8 * fq);
                    else { const int head = hsel - 12 + bj, dsh = 2 * (head >> 2), vk = ((s & ((1 << dsh) - 1)) << (12 - dsh)) + (s >> dsh);
                        dst = frg + ((size_t)16 << 20) + ((size_t)((b * 12 + head) * 2) << 19) + kf_off(vk, wc * 32 + 8 * fq); }
                    *(v4u*)dst = w; } }
    }
};

__device__ __forceinline__ v4u norm_chunk16v(v4u w, const float* gain, float scale, int li) {
    float v[8] = {bflo(w.x), bfhi(w.x), bflo(w.y), bfhi(w.y), bflo(w.z), bfhi(w.z), bflo(w.w), bfhi(w.w)};
    float ss = 0.f;
#pragma unroll
    for (int j = 0; j < 8; ++j) ss += v[j] * v[j];
    ss += __shfl_xor(ss, 1); ss += __shfl_xor(ss, 2); ss += __shfl_xor(ss, 4); ss += __shfl_xor(ss, 8);
    const float rstd = rsqrtf(ss * (1.f / 128.f) + EPS) * scale;
#pragma unroll
    for (int j = 0; j < 8; ++j) v[j] = v[j] * rstd * gain[8 * li + j];
    w.x = pk2(v[0], v[1]); w.y = pk2(v[2], v[3]); w.z = pk2(v[4], v[5]); w.w = pk2(v[6], v[7]);
    return w;
}
__device__ __forceinline__ void ph3_headnorm(const Args& a) {
    const int tid = phase_tid(), lane = tid & 63, wave = __builtin_amdgcn_readfirstlane(tid >> 6), sub = lane >> 4, li = lane & 15;
    const int gw = blockIdx.x * NWAVES + wave, NGW = gridDim.x * NWAVES;
    bf16* Q = (bf16*)(a.ws + WS_Q); const bf16* KV = (const bf16*)(a.ws + WS_KV); bf16* DL = (bf16*)(a.ws + WS_DL);
    const float* qg = a.in[6]; const float* kg = a.in[7]; const float* dqg = a.in[11]; const float* dkg = a.in[12];
    for (int m = gw; m < T; m += NGW) {
        const int b = m / S, s = m % S;
        const int g = sub & 1, win = sub >> 1;
        v4u wq[2], wk, wd[6];
#pragma unroll
        for (int it = 0; it < 2; ++it) wq[it] = *(const v4u*)(Q + (size_t)m * NQ + (it * 4 + sub) * 128 + 8 * li);
        wk = *(const v4u*)(KV + (size_t)m * NKV + ((win ? 8 : 4) + g) * 128 + 8 * li);
#pragma unroll
        for (int it = 0; it < 6; ++it) wd[it] = *(const v4u*)(DL + (size_t)m * NDL + (it * 4 + sub) * 128 + 8 * li);
#pragma unroll
        for (int it = 0; it < 2; ++it) *(v4u*)(Q + (size_t)m * NQ + (it * 4 + sub) * 128 + 8 * li) = norm_chunk16v(wq[it], qg, QS2, li);
        *(v4u*)(fr_nsa(a, b * 2 + g, win ? 2 : 0) + kf_off(s, 8 * li)) = norm_chunk16v(wk, kg + (win ? 256 : 128), 1.f, li);
#pragma unroll
        for (int it = 0; it < 6; ++it) { const int ch = it * 4 + sub;
            if (ch < 12) *(v4u*)(DL + (size_t)m * NDL + ch * 128 + 8 * li) = norm_chunk16v(wd[it], dqg, QS2, li);
            else { const int head = ch - 12, gi = head >> 2, dsh = 2 * gi  , vk = ((s & ((1 << dsh) - 1)) << (12 - dsh)) + (s >> dsh);
                *(v4u*)(fr_dil(a, b, head, 0) + kf_off(vk, 8 * li)) = norm_chunk16v(wd[it], dkg, 1.f, li); } }
    }
}
__device__ __forceinline__ void ph3_vfrag(const Args& a) {
    const int tid = phase_tid(), lane = tid & 63, wave = __builtin_amdgcn_readfirstlane(tid >> 6);
    const int gw = blockIdx.x * NWAVES + wave, NGW = gridDim.x * NWAVES;
    const bf16* KV = (const bf16*)(a.ws + WS_KV); const bf16* DL = (const bf16*)(a.ws + WS_DL);
    for (int job = gw; job < 32768; job += NGW) {
        const bf16* src; size_t rstride; bf16* dst; int key0;
        if (job < 8192) { const int bg = job >> 10, kind = (job >> 9) & 1, s0 = (job & 511) * 8, b = bg >> 1, g = bg & 1;
            src = KV + (size_t)(b * S + s0) * NKV + ((kind ? 10 : 6) + g) * 128; rstride = NKV; dst = fr_nsa(a, bg, kind ? 3 : 1); key0 = s0; }
        else { const int j2 = job - 8192, bh = j2 >> 9, vk0 = (j2 & 511) * 8, b = bh / 12, head = bh % 12, gi = head >> 2, dsh = 2 * gi, L = S >> dsh, r = vk0 / L, m0 = vk0 % L;
            src = DL + (size_t)(b * S + (m0 << dsh) + r) * NDL + (24 + head) * 128; rstride = (size_t)NDL << dsh; dst = fr_dil(a, b, head, 1); key0 = vk0; }
        unsigned w[8];
#pragma unroll
        for (int jj = 0; jj < 8; ++jj) w[jj] = *(const unsigned*)(src + jj * rstride + 2 * lane);
        v4u c0, c1;
        c0.x = (w[0] & 0xffffu) | (w[1] << 16); c0.y = (w[2] & 0xffffu) | (w[3] << 16); c0.z = (w[4] & 0xffffu) | (w[5] << 16); c0.w = (w[6] & 0xffffu) | (w[7] << 16);
        c1.x = (w[0] >> 16) | (w[1] & 0xffff0000u); c1.y = (w[2] >> 16) | (w[3] & 0xffff0000u); c1.z = (w[4] >> 16) | (w[5] & 0xffff0000u); c1.w = (w[6] >> 16) | (w[7] & 0xffff0000u);
        *(v4u*)(dst + vf_off(key0, 2 * lane)) = c0; *(v4u*)(dst + vf_off(key0, 2 * lane + 1)) = c1;
    }
}
__device__ __forceinline__ void ph3_gates(const Args& a) {
    const int tid = phase_tid(), lane = tid & 63, wave = __builtin_amdgcn_readfirstlane(tid >> 6), tl = lane & 31, hh = lane >> 5;
    const int gw = (gridDim.x - 1 - blockIdx.x) * NWAVES + wave, NGW = gridDim.x * NWAVES;
    const bf16* H = (const bf16*)(a.ws + WS_H); const v4u* WG = (const v4u*)(a.ws + WS_WGF) + lane; float* gates = (float*)(a.ws + WS_GATES);
    for (int job = gw; job < T / 32; job += NGW) {
        const int t = job * 32 + tl; const bf16* hr = H + (size_t)t * D + 8 * hh;
        f32x16 acc;
#pragma unroll
        for (int i = 0; i < 16; ++i) acc[i] = 0.f;
#pragma unroll 4
        for (int ks = 0; ks < 128; ++ks) { const bf16x8 af = __builtin_bit_cast(bf16x8, WG[ks * 64]), bfr = __builtin_bit_cast(bf16x8, *(const v4u*)(hr + 16 * ks));
            acc = __builtin_amdgcn_mfma_f32_32x32x16_bf16(af, bfr, acc, 0, 0, 0); }
#pragma unroll
        for (int i = 0; i < 16; ++i) { const int j = (i & 3) + 8 * (i >> 2) + 4 * hh; const float v = acc[i]; if (j < 24) gates[(size_t)t * 24 + j] = sigmoidf(v); }
    }
}
__device__ __forceinline__ void ph3_compress(const Args& a, LAS unsigned char* lds) {
    const int tid = phase_tid(), lane = tid & 63, wave = __builtin_amdgcn_readfirstlane(tid >> 6), cl = lane & 31, hh = lane >> 5;
    LAS float* part = (LAS float*)lds;
    LAS float* hid = part + 2 * 128 * 32;
    LAS float* ob = hid + 32 * 128;
    LAS float* bias = ob + 32 * 128;
    const bf16* KV = (const bf16*)(a.ws + WS_KV);
    const float* w2 = a.in[10]; const float* kg0 = a.in[7]; const float* CBP = (const float*)(a.ws + WS_CBP);
    for (int u = blockIdx.x; u < 128; u += gridDim.x) {
        const int j = u >> 6, bg = (u >> 3) & 7, ct = u & 7, b = bg >> 1, g = bg & 1, c0 = 32 * ct, hhd = j * 2 + g;
        if (tid < 128) { float s = 0.f;
#pragma unroll
            for (int kc = 0; kc < 64; ++kc) s += CBP[(kc * 2 + j) * 128 + tid];
            bias[tid] = s; }
        { const int nt = wave & 3, kh = wave >> 2, c = c0 + cl;
          const v4u* af = (const v4u*)(a.ws + WS_CW1F) + ((size_t)(j * 4 + nt) * 256 + 128 * kh) * 64 + lane;
          f32x16 acc;
#pragma unroll
          for (int i = 0; i < 16; ++i) acc[i] = 0.f;
#pragma unroll 4
          for (int ks = 0; ks < 128; ++ks) { const int k = 16 * (128 * kh + ks) + 8 * hh, l = k >> 7, d = k & 127, p = 16 * c + l;
              v4u x = {0u, 0u, 0u, 0u}; if (p < S) x = *(const v4u*)(KV + (size_t)(b * S + p) * NKV + hhd * 128 + d);
              acc = __builtin_amdgcn_mfma_f32_32x32x16_bf16(__builtin_bit_cast(bf16x8, af[ks * 64]), __builtin_bit_cast(bf16x8, x), acc, 0, 0, 0); }
#pragma unroll
          for (int i = 0; i < 16; ++i) { const int n = 32 * nt + (i & 3) + 8 * (i >> 2) + 4 * hh; const float v = acc[i]; part[(kh * 128 + n) * 32 + cl] = v; } }
        __syncthreads();
        for (int i = tid; i < 128 * 32; i += NTHREADS) { const int n = i >> 5, c = i & 31; hid[c * 128 + n] = gelu_tanh(part[i] + part[128 * 32 + i] + bias[n]); }
        __syncthreads();
        { const int n = tid & 127, cq = tid >> 7; float o[8];
#pragma unroll
          for (int r = 0; r < 8; ++r) o[r] = 0.f;
          const float* w2p = w2 + j * 128 * 128 + n;
          for (int k = 0; k < 128; ++k) { const float w = w2p[k * 128];
#pragma unroll
              for (int r = 0; r < 8; ++r) o[r] += hid[(8 * cq + r) * 128 + k] * w; }
#pragma unroll
          for (int r = 0; r < 8; ++r) ob[(8 * cq + r) * 128 + n] = o[r]; }
        __syncthreads();
        bf16* fr = (bf16*)(a.ws + (j == 0 ? WS_KC : WS_VC)) + (size_t)bg * 8 * 4096;
#pragma unroll 1
        for (int r = 0; r < 4; ++r) { const int cr = 4 * wave + r, c = c0 + cr; float v0 = ob[cr * 128 + 2 * lane], v1 = ob[cr * 128 + 2 * lane + 1];
            if (j == 0) { const float rstd = rsqrtf(wave_sum(v0 * v0 + v1 * v1) * (1.f / 128.f) + EPS); v0 = v0 * rstd * kg0[2 * lane]; v1 = v1 * rstd * kg0[2 * lane + 1]; }
            if (c >= NC) { v0 = 0.f; v1 = 0.f; }
            if (j == 0) *(unsigned*)(fr + kf_off(c, 2 * lane)) = pk2(v0, v1);
            else { fr[vf_off(c, 2 * lane)] = (bf16)f2bf(v0); fr[vf_off(c, 2 * lane + 1)] = (bf16)f2bf(v1); } }
        __syncthreads();
    }
}

#define KBI(i) (16 * ((i) >> 3) + ((i) & 7))
__device__ __forceinline__ void load_frags(bf16x8 (&f)[8], const v4u* p, int lane) {
#pragma unroll
    for (int i = 0; i < 8; ++i) f[i] = __builtin_bit_cast(bf16x8, p[i * 64 + lane]);
}
__device__ __forceinline__ f32x16 qk_mma(const bf16x8 (&qf)[8], const bf16x8 (&k)[8]) {
    f32x16 s;
#pragma unroll
    for (int i = 0; i < 16; ++i) s[i] = 0.f;
#pragma unroll
    for (int st = 0; st < 8; ++st) s = __builtin_amdgcn_mfma_f32_32x32x16_bf16(k[st], qf[st], s, 0, 0, 0);
    return s;
}
__device__ __forceinline__ f32x16 qk_tile(const bf16x8 (&qf)[8], const v4u* kf, int lane) { bf16x8 k[8]; load_frags(k, kf, lane); return qk_mma(qf, k); }
template <int STRIDE> __device__ __forceinline__ void add_tbl(f32x16& s, const LAS float* tp2, float pen) {
#pragma unroll
    for (int i = 0; i < 16; ++i) s[i] += tp2[STRIDE * (23 - KBI(i))] + pen;
}
__device__ __forceinline__ void mask_hi(f32x16& s, int lim) {
#pragma unroll
    for (int i = 0; i < 16; ++i) s[i] = (KBI(i) <= lim) ? s[i] : NEGB;
}
__device__ __forceinline__ void mask_lo(f32x16& s, int lim) {
#pragma unroll
    for (int i = 0; i < 16; ++i) s[i] = (KBI(i) >= lim) ? s[i] : NEGB;
}
__device__ __forceinline__ float max16(const f32x16& s) {
    float mx = fmaxf(s[0], s[1]);
#pragma unroll
    for (int i = 2; i < 16; ++i) mx = fmaxf(mx, s[i]);
    return fmaxf(mx, __shfl_xor(mx, 32));
}
__device__ __forceinline__ void pv_tile(const f32x16& p, f32x16 (&o)[4], const bf16x8 (&v)[8]) {
    v4u a0, a1;
    a0.x = pkbf(p[0], p[1]); a0.y = pkbf(p[2], p[3]); a0.z = pkbf(p[4], p[5]); a0.w = pkbf(p[6], p[7]);
    a1.x = pkbf(p[8], p[9]); a1.y = pkbf(p[10], p[11]); a1.z = pkbf(p[12], p[13]); a1.w = pkbf(p[14], p[15]);
    const bf16x8 pb0 = __builtin_bit_cast(bf16x8, a0), pb1 = __builtin_bit_cast(bf16x8, a1);
#pragma unroll
    for (int dt = 0; dt < 4; ++dt) { o[dt] = __builtin_amdgcn_mfma_f32_32x32x16_bf16(v[2 * dt], pb0, o[dt], 0, 0, 0); o[dt] = __builtin_amdgcn_mfma_f32_32x32x16_bf16(v[2 * dt + 1], pb1, o[dt], 0, 0, 0); }
}
__device__ __forceinline__ void softmax_pv(f32x16& s, f32x16 (&o)[4], float& m, float& l, const v4u* vf, int lane) {
    bf16x8 v[8];
#pragma unroll
    for (int i = 0; i < 8; ++i) v[i] = __builtin_bit_cast(bf16x8, vf[i * 64 + lane]);
    const float mn = fmaxf(m, max16(s));
    if (__ballot(mn > m + 8.f)) {
        const float corr = ex2(m - mn);
#pragma unroll
        for (int dt = 0; dt < 4; ++dt)
#pragma unroll
            for (int i = 0; i < 16; ++i) o[dt][i] *= corr;
        l *= corr; m = mn;
    }
    float ps = 0.f;
#pragma unroll
    for (int i = 0; i < 16; ++i) { s[i] = ex2(s[i] - m); ps += s[i]; }
    l += ps;
    pv_tile(s, o, v);
}
template <int NP = 0> __device__ __forceinline__ void softmax_pv_v(f32x16& s, f32x16 (&o)[4], float& m, float& l, const bf16x8 (&v)[8]) {
    if (NP == 2) { l += s[0]; pv_tile(s, o, v); return; }
    const float mn = fmaxf(m, max16(s));
    if (__ballot(mn > m + 8.f)) {
        const float corr = ex2(m - mn);
#pragma unroll
        for (int dt = 0; dt < 4; ++dt)
#pragma unroll
            for (int i = 0; i < 16; ++i) o[dt][i] *= corr;
        l *= corr; m = mn;
    }
    float ps = 0.f;
#pragma unroll
    for (int i = 0; i < 16; ++i) { s[i] = ex2(s[i] - m); ps += s[i]; }
    l += ps;
    pv_tile(s, o, v);
}
__device__ __forceinline__ void zero_o(f32x16 (&o)[4]) {
#pragma unroll
    for (int dt = 0; dt < 4; ++dt)
#pragma unroll
        for (int i = 0; i < 16; ++i) o[dt][i] = 0.f;
}
__device__ __forceinline__ void y_update(bf16* yp  , const f32x16 (&o)[4], float sc, bool acc) {
#pragma unroll
    for (int dt = 0; dt < 4; ++dt)
#pragma unroll
        for (int i4 = 0; i4 < 4; ++i4) { bf16* p = yp + 32 * dt + 8 * i4;
            float v0 = o[dt][4 * i4] * sc, v1 = o[dt][4 * i4 + 1] * sc, v2 = o[dt][4 * i4 + 2] * sc, v3 = o[dt][4 * i4 + 3] * sc;
            if (acc) { const v2u w = *(const v2u*)p; v0 += bflo(w.x); v1 += bfhi(w.x); v2 += bflo(w.y); v3 += bfhi(w.y); }
            v2u w; w.x = pkbf(v0, v1); w.y = pkbf(v2, v3); *(v2u*)p = w; }
}
constexpr int TBLN = 2624;
constexpr int OFF_TBL = 0, OFF_IMP = 43008, OFF_SELM = OFF_IMP + 65536, OFF_DTBL = OFF_SELM + 512;
constexpr int FAR_DIST = 1513;

template <int NP> __device__ __forceinline__ void nsa_unit(const Args& a, LAS unsigned char* lds, int u, int tid) {
    const int lane = tid & 63, wave = __builtin_amdgcn_readfirstlane(tid >> 6);
    const int qb = u >> 3, bg = u & 7, b = bg >> 1, g = bg & 1;
    const int r = wave >> 1, qs = wave & 1, hd = g * 4 + r, ql = lane & 31, h = lane >> 5;
    const int q0w = 64 * qb + 32 * qs, sq = q0w + ql, t = b * S + sq;
    LAS float* tball = (LAS float*)(lds + OFF_TBL);
    LAS float* imp = (LAS float*)(lds + OFF_IMP);
    LAS unsigned long long* selm = (LAS unsigned long long*)(lds + OFF_SELM);
    const float* relb = a.in[22];
    for (int i = tid; i < 4 * TBLN; i += NTHREADS) { const int hh = i / TBLN, dd = i % TBLN - 64; tball[i] = dd >= 0 ? relb[(g * 4 + hh) * 32 + t5_bucket(dd)] * LOG2E : 0.f; }
    for (int i = tid; i < 4 * 64 * 64; i += NTHREADS) imp[i] = 0.f;
    __syncthreads();
    const LAS float* tbl = tball + r * TBLN + 64;
    const float farc = relb[hd * 32 + 31] * LOG2E;
    bf16x8 qf[8];
    { const bf16* qrow = (const bf16*)(a.ws + WS_Q) + (size_t)t * NQ + hd * 128 + 8 * h;
#pragma unroll
      for (int st = 0; st < 8; ++st) qf[st] = __builtin_bit_cast(bf16x8, *(const v4u*)(qrow + 16 * st)); }
    const float* gt = (const float*)(a.ws + WS_GATES) + (size_t)t * 24 + hd * 3;
    const float g0 = gt[0], g1 = gt[1], g2 = gt[2];
    bf16* yp = (bf16*)(a.ws + (NP ? WS_H : WS_YN)) + (size_t)t * 1536 + hd * 128 + 4 * h;
    f32x16 o[4];
    {
        const v4u* kfc = (const v4u*)(a.ws + WS_KC) + (size_t)bg * 8 * 512; const v4u* vfc = (const v4u*)(a.ws + WS_VC) + (size_t)bg * 8 * 512;
        const int smax = q0w + 31, ncv = smax >= 31 ? ((smax - 31) >> 4) + 1 : 0, ntc = (ncv + 31) >> 5;
        float m = NEGB, l = 0.f;
        for (int tc = 0; tc < ntc; ++tc) {
            f32x16 s = qk_tile(qf, kfc + tc * 512, lane);
            const int dqc = sq - 31 - 512 * tc;
            if (q0w - 31 - 512 * tc - 496 >= FAR_DIST) {
#pragma unroll
                for (int i = 0; i < 16; ++i) s[i] += farc;
            } else add_tbl<16>(s, tbl + dqc - 16 * (8 * h + 23), 0.f);
            mask_hi(s, (dqc >> 4) - 8 * h);
            const float mn = fmaxf(m, max16(s));
            float ps = 0.f;
#pragma unroll
            for (int i = 0; i < 16; ++i) ps += ex2(s[i] - mn);
            l = l * ex2(m - mn) + ps; m = mn;
        }
        l += __shfl_xor(l, 32);
        const float inv = (sq >= 31) ? 1.f / l : 0.f;
        zero_o(o);
        LAS float* impq = imp + (r * 64 + 32 * qs + ql) * 64;
        for (int tc = 0; tc < ntc; ++tc) {
            f32x16 s = qk_tile(qf, kfc + tc * 512, lane);
            bf16x8 v[8];
#pragma unroll
            for (int i = 0; i < 8; ++i) v[i] = __builtin_bit_cast(bf16x8, vfc[tc * 512 + i * 64 + lane]);
            const int dqc = sq - 31 - 512 * tc;
            if (q0w - 31 - 512 * tc - 496 >= FAR_DIST) {
#pragma unroll
                for (int i = 0; i < 16; ++i) s[i] += farc;
            } else add_tbl<16>(s, tbl + dqc - 16 * (8 * h + 23), 0.f);
            mask_hi(s, (dqc >> 4) - 8 * h);
#pragma unroll
            for (int i = 0; i < 16; ++i) s[i] = ex2(s[i] - m) * inv;
#pragma unroll
            for (int a2 = 0; a2 < 2; ++a2)
#pragma unroll
                for (int bq = 0; bq < 2; ++bq) { const int j = 8 * tc + 4 * a2 + 2 * h + bq; const int i0 = 8 * a2 + 4 * bq;
                    impq[j] += (s[i0] + s[i0 + 1]) + (s[i0 + 2] + s[i0 + 3]); }
            asm volatile("s_waitcnt lgkmcnt(0)" ::: "memory");
#pragma unroll
            for (int a2 = 0; a2 < 2; ++a2)
#pragma unroll
                for (int bq = 0; bq < 2; ++bq) { const int j = 8 * tc + 4 * a2 + 2 * h + bq + 1; if (j < 64) impq[j] += s[8 * a2 + 4 * bq + 3]; }
            asm volatile("s_waitcnt lgkmcnt(0)" ::: "memory");
            pv_tile(s, o, v);
        }
        y_update(yp, o, g0, false);
    }
    __syncthreads();
    for (int qq = wave * 8; qq < wave * 8 + 8; ++qq) {
        const int jb = lane;
        const float im = ((imp[(0 * 64 + qq) * 64 + jb] + imp[(1 * 64 + qq) * 64 + jb]) + imp[(2 * 64 + qq) * 64 + jb]) + imp[(3 * 64 + qq) * 64 + jb];
        const bool forced = (jb == 0) || (jb == qb) || (jb == qb - 1);
        const float score = forced ? 1e4f : (jb > qb ? -1e4f : im);
        int rank = 0;
        for (int o2 = 0; o2 < 64; ++o2) { const float so = __shfl(score, o2); rank += (so > score) || (so == score && o2 < jb); }
        const unsigned long long mask = __ballot(rank < 16 && jb <= qb);
        if (lane == 0) selm[qq] = mask;
    }
    __syncthreads();
    {
        const v4u* kfw = (const v4u*)fr_nsa(a, bg, 2); const v4u* vfw = (const v4u*)fr_nsa(a, bg, 3);
        const int t_hi = q0w >> 5, t_lo = t_hi - 16;
        float m = NEGB, l = 0.f; zero_o(o);
        const int t0 = t_lo < 0 ? 0 : t_lo;
        for (int tt = t0; tt <= t_hi; ++tt) {
            const size_t to = (NP == 3) ? (size_t)(tt & 1) * 512 : (size_t)tt * 512;
            bf16x8 kf[8], vf[8]; load_frags(kf, kfw + to, lane);
            f32x16 s = qk_mma(qf, kf); load_frags(vf, vfw + to, lane);
            const int dq = sq - 32 * tt;
            add_tbl<1>(s, tbl + dq - (8 * h + 23), 0.f);
            if (tt == t_hi) mask_hi(s, dq - 8 * h);
            if (tt == t_lo) mask_lo(s, dq - 511 - 8 * h);
            softmax_pv_v<NP>(s, o, m, l, vf);
        }
        l += __shfl_xor(l, 32);
        y_update(yp, o, g2 / l, true);
    }
    {
        const v4u* kfs = (const v4u*)fr_nsa(a, bg, 0); const v4u* vfs = (const v4u*)fr_nsa(a, bg, 1);
        const unsigned long long mask = selm[32 * qs + ql];
        float m = NEGB, l = 0.f; zero_o(o);
        const int t_end = 2 * qb + qs;
        for (int tt = 0; tt <= 2 * qb + 1; ++tt) {
            if (tt > t_end) continue;
            const float pen = ((mask >> (tt >> 1)) & 1ull) ? 0.f : NEGB;
            if (__ballot(pen == 0.f) == 0ull) continue;
            const size_t to = (NP == 3) ? (size_t)(tt & 1) * 512 : (size_t)tt * 512;
            bf16x8 kf[8], vf[8]; load_frags(kf, kfs + to, lane);
            f32x16 s = qk_mma(qf, kf); load_frags(vf, vfs + to, lane);
            const int dq = sq - 32 * tt;
            if (q0w - (32 * tt + 31) >= FAR_DIST) {
                const float c = farc + pen;
#pragma unroll
                for (int i = 0; i < 16; ++i) s[i] += c;
            } else add_tbl<1>(s, tbl + dq - (8 * h + 23), pen);
            if (tt == t_end) mask_hi(s, dq - 8 * h);
            softmax_pv_v<NP>(s, o, m, l, vf);
        }
        l += __shfl_xor(l, 32);
        y_update(yp, o, g1 / l, true);
    }
    __syncthreads();
}
__device__ __forceinline__ void dil_unit(const Args& a, LAS unsigned char* lds, int u, int tid) {
    const int lane = tid & 63, wave = __builtin_amdgcn_readfirstlane(tid >> 6), ql = lane & 31, h = lane >> 5;
    const int b = u >> 6, p = (u >> 4) & 3, c = u & 15, s0 = 256 * c;
    LAS float* dtbl = (LAS float*)(lds + OFF_DTBL);
    const float* relb = a.in[22] + 8 * 32;
    for (int i = tid; i < 3 * 192; i += NTHREADS) { const int gi = i / 192, dm = i % 192 - 32; dtbl[i] = dm >= 0 ? relb[(gi * 4 + p) * 32 + t5_bucket(dm << (2 * gi))] * LOG2E : 0.f; }
    __syncthreads();
    bf16* OD = (bf16*)(a.ws + WS_OD); float* LSE = (float*)(a.ws + WS_LSE);
    const bf16* DL = (const bf16*)(a.ws + WS_DL);
    for (int job = wave; job < 32; job += NWAVES) {
        int gi, rr, m0, vlo, vhi;
        if (job < 8) { gi = 0; rr = 0; m0 = s0 + 32 * job; vlo = 0; vhi = 32; }
        else if (job < 16) { gi = 1; rr = (job - 8) >> 1; m0 = (s0 >> 2) + 32 * (job & 1); vlo = 0; vhi = 32; }
        else { gi = 2; rr = job - 16; m0 = 32 * (c >> 1); vlo = 16 * (c & 1); vhi = vlo + 16; }
        const int dsh = 2 * gi, L = S >> dsh, head = gi * 4 + p;
        const int mq = m0 + ql, sact = (mq << dsh) + rr, t = b * S + sact;
        const v4u* kf = (const v4u*)fr_dil(a, b, head, 0) + (size_t)((rr * L) >> 5) * 512; const v4u* vf = (const v4u*)fr_dil(a, b, head, 1) + (size_t)((rr * L) >> 5) * 512;
        bf16x8 qf[8];
        { const bf16* qrow = DL + (size_t)t * NDL + head * 128 + 8 * h;
#pragma unroll
          for (int st = 0; st < 8; ++st) qf[st] = __builtin_bit_cast(bf16x8, *(const v4u*)(qrow + 16 * st)); }
        const LAS float* tb = dtbl + gi * 192 + 32;
        const int t_hi = m0 >> 5, t_lo = t_hi - 4;
        float m = NEGB, l = 0.f; f32x16 o[4]; zero_o(o);
        const int t0 = t_lo < 0 ? 0 : t_lo;
        for (int tt = t0; tt <= t_hi; ++tt) {
            bf16x8 kr[8], vr[8]; load_frags(kr, kf + (size_t)tt * 512, lane);
            f32x16 s = qk_mma(qf, kr); load_frags(vr, vf + (size_t)tt * 512, lane);
            const int dq = mq - 32 * tt;
            add_tbl<1>(s, tb + dq - (8 * h + 23), 0.f);
            if (tt == t_hi) mask_hi(s, dq - 8 * h);
            if (tt == t_lo) mask_lo(s, dq - 128 - 8 * h);
            softmax_pv_v(s, o, m, l, vr);
        }
        l += __shfl_xor(l, 32);
        if (ql >= vlo && ql < vhi) {
            y_update(OD + ((size_t)gi * T + t) * 512 + p * 128 + 4 * h, o, 1.f / l, false);
            if (h == 0) LSE[((size_t)(gi * NB + b) * 4 + p) * S + sact] = m + __log2f(l);
        }
    }
    __syncthreads();
    { const int pos = tid >> 1, dh = tid & 1, sact = s0 + pos, t = b * S + sact;
      const float l0 = LSE[((size_t)(0 * NB + b) * 4 + p) * S + sact], l1 = LSE[((size_t)(1 * NB + b) * 4 + p) * S + sact], l2 = LSE[((size_t)(2 * NB + b) * 4 + p) * S + sact];
      const float mx = fmaxf(l0, fmaxf(l1, l2)); float w0 = ex2(l0 - mx), w1 = ex2(l1 - mx), w2 = ex2(l2 - mx); const float iw = 1.f / (w0 + w1 + w2); w0 *= iw; w1 *= iw; w2 *= iw;
      bf16* yd = (bf16*)(a.ws + WS_YN) + (size_t)t * 1536 + 1024 + p * 128 + 64 * dh;
      const bf16* o0 = OD + ((size_t)0 * T + t) * 512 + p * 128 + 64 * dh; const bf16* o1 = OD + ((size_t)1 * T + t) * 512 + p * 128 + 64 * dh; const bf16* o2 = OD + ((size_t)2 * T + t) * 512 + p * 128 + 64 * dh;
#pragma unroll
      for (int k = 0; k < 8; ++k) { const v4u x0 = *(const v4u*)(o0 + 8 * k), x1 = *(const v4u*)(o1 + 8 * k), x2 = *(const v4u*)(o2 + 8 * k); v4u y;
          y.x = pkbf(w0 * bflo(x0.x) + w1 * bflo(x1.x) + w2 * bflo(x2.x), w0 * bfhi(x0.x) + w1 * bfhi(x1.x) + w2 * bfhi(x2.x));
          y.y = pkbf(w0 * bflo(x0.y) + w1 * bflo(x1.y) + w2 * bflo(x2.y), w0 * bfhi(x0.y) + w1 * bfhi(x1.y) + w2 * bfhi(x2.y));
          y.z = pkbf(w0 * bflo(x0.z) + w1 * bflo(x1.z) + w2 * bflo(x2.z), w0 * bfhi(x0.z) + w1 * bfhi(x1.z) + w2 * bfhi(x2.z));
          y.w = pkbf(w0 * bflo(x0.w) + w1 * bflo(x1.w) + w2 * bflo(x2.w), w0 * bfhi(x0.w) + w1 * bfhi(x1.w) + w2 * bfhi(x2.w));
          *(v4u*)(yd + 8 * k) = y; } }
    __syncthreads();
}
__device__ __forceinline__ void ph4_attention(const Args& a, LAS unsigned char* lds) {
    const int tid = phase_tid();
    for (int u = blockIdx.x; u < 256; u += gridDim.x) dil_unit(a, lds, u, tid);
#ifndef PROBE_NSA
#define PROBE_NSA 0
#endif
    if (PROBE_NSA) for (int x = blockIdx.x; x < 256; x += gridDim.x) { nsa_unit<PROBE_NSA>(a, lds, 511 - x, tid); nsa_unit<PROBE_NSA>(a, lds, x, tid); }
    for (int x = blockIdx.x; x < 256; x += gridDim.x) { nsa_unit<0>(a, lds, 511 - x, tid); nsa_unit<0>(a, lds, x, tid); }
}

constexpr size_t WS_PU8 = WS_Q;
constexpr size_t WS_PV8 = WS_Q + 32 * MiB;
constexpr size_t WS_PSC = WS_Q + 64 * MiB;
__device__ __forceinline__ void ph_quant_uv(const Args& a) {
    const int tid = phase_tid(), lane = tid & 63, wave = __builtin_amdgcn_readfirstlane(tid >> 6);
    const int gw = blockIdx.x * NWAVES + wave, NGW = gridDim.x * NWAVES;
    float* SC = (float*)(a.ws + WS_PSC);
    for (int rw = gw; rw < NE; rw += NGW) {
        f32x4 x[2][8];
#pragma unroll
        for (int which = 0; which < 2; ++which) { const float* src = a.in[20 + which] + (size_t)rw * D + 16 * lane;
#pragma unroll
            for (int c = 0; c < 2; ++c)
#pragma unroll
                for (int w = 0; w < 4; ++w) x[which][4 * c + w] = *(const f32x4*)(src + 1024 * c + 4 * w); }
#pragma unroll
        for (int which = 0; which < 2; ++which) {
            unsigned char* dst = a.ws + (which ? WS_PV8 : WS_PU8) + (size_t)rw * D + 16 * lane;
            float am = 0.f;
#pragma unroll
            for (int i = 0; i < 8; ++i) am = fmaxf(fmaxf(am, fmaxf(fabsf(x[which][i].x), fabsf(x[which][i].y))), fmaxf(fabsf(x[which][i].z), fabsf(x[which][i].w)));
            am = wave_max(am);
            const float inv = am > 0.f ? 127.f / am : 0.f;
#pragma unroll
            for (int c = 0; c < 2; ++c) { v4u o; unsigned wd[4];
#pragma unroll
                for (int w = 0; w < 4; ++w) { const f32x4 v = x[which][4 * c + w];
                    const unsigned q0 = (unsigned)((int)rintf(v.x * inv) + 128), q1 = (unsigned)((int)rintf(v.y * inv) + 128), q2 = (unsigned)((int)rintf(v.z * inv) + 128), q3 = (unsigned)((int)rintf(v.w * inv) + 128);
                    wd[w] = q0 | (q1 << 8) | (q2 << 16) | (q3 << 24); }
                o.x = wd[0]; o.y = wd[1]; o.z = wd[2]; o.w = wd[3]; *(v4u*)(dst + 1024 * c) = o; }
            if (lane == 0) SC[which * NE + rw] = am * (1.f / 127.f);
        }
    }
}
constexpr size_t WS_KEYF = 601 * MiB;
constexpr size_t WS_END3 = 602 * MiB;
__device__ __forceinline__ void ph0_keyfrags(const Args& a) {
    const int tid = phase_tid();
    const float* keys = a.in[19]; v4u* KF = (v4u*)(a.ws + WS_KEYF);
    for (int i = blockIdx.x * NTHREADS + tid; i < 16 * 32 * 64; i += gridDim.x * NTHREADS) {
        const int lane = i & 63, st = (i >> 6) & 7, kt = (i >> 9) & 3, hp = i >> 11;
        const float* src = keys + ((size_t)hp * 128 + 32 * kt + (lane & 31)) * 128 + 16 * st + 8 * (lane >> 5);
        float v[8]; unsigned hi[8], lo[8];
#pragma unroll
        for (int j = 0; j < 8; ++j) { v[j] = src[j]; hi[j] = f2bf(v[j]); lo[j] = f2bf(v[j] - __builtin_bit_cast(float, hi[j] << 16)); }
        v4u oh, ol; oh.x = hi[0] | (hi[1] << 16); oh.y = hi[2] | (hi[3] << 16); oh.z = hi[4] | (hi[5] << 16); oh.w = hi[6] | (hi[7] << 16);
        ol.x = lo[0] | (lo[1] << 16); ol.y = lo[2] | (lo[3] << 16); ol.z = lo[4] | (lo[5] << 16); ol.w = lo[6] | (lo[7] << 16);
        KF[(size_t)((hp * 2 + 0) * 32 + kt * 8 + st) * 64 + lane] = oh; KF[(size_t)((hp * 2 + 1) * 32 + kt * 8 + st) * 64 + lane] = ol;
    }
}
template <int N, bool MERGE_ONLY> __device__ __forceinline__ void bitonic_desc(float (&v)[N]) {
#pragma unroll
    for (int k = MERGE_ONLY ? N : 2; k <= N; k <<= 1)
#pragma unroll
        for (int j = k >> 1; j > 0; j >>= 1)
#pragma unroll
            for (int i = 0; i < N; ++i) { const int l = i ^ j;
                if (l > i) { const bool desc = ((i & k) == 0) || (k == N); const float x = v[i], y = v[l], hi = fmaxf(x, y), lo = fminf(x, y); v[i] = desc ? hi : lo; v[l] = desc ? lo : hi; } }
}
#define CROW(i) (((i) & 3) + 8 * ((i) >> 2))
__device__ __forceinline__ float max3f(float a, float b, float c) { return fmaxf(fmaxf(a, b), c); }
__device__ __forceinline__ void ph_route(const Args& a, LAS unsigned char* lds) {
    const int tid = phase_tid(), lane = tid & 63, wave = __builtin_amdgcn_readfirstlane(tid >> 6), tl = lane & 31, hc = lane >> 5;
    const int gw = blockIdx.x * NWAVES + wave, NGW = gridDim.x * NWAVES;
    const float* QP = (const float*)(a.ws + WS_QP); const float* qgain = a.in[18]; const v4u* KF = (const v4u*)(a.ws + WS_KEYF);
    int* EI = (int*)(a.ws + WS_EI); float* EG = (float*)(a.ws + WS_EG);
    LAS float* spl = (LAS float*)(lds + wave * 8704) + lane * 33;
    for (int job = gw; job < (T / 32) * 8; job += NGW) {
        const int h = job & 7, t = (job >> 3) * 32 + tl;
#pragma unroll 1
        for (int p = 0; p < 2; ++p) {
            bf16x8 bh[8], bl[8];
            { const float* qr = QP + (size_t)t * D + h * 256 + p * 128 + 8 * hc; const float* gr = qgain + (h * 2 + p) * 128 + 8 * hc;
              float ss = 0.f;
#pragma unroll
              for (int st = 0; st < 8; ++st) { const f32x4 x0 = *(const f32x4*)(qr + 16 * st), x1 = *(const f32x4*)(qr + 16 * st + 4);
                  ss += (x0.x * x0.x + x0.y * x0.y) + (x0.z * x0.z + x0.w * x0.w) + (x1.x * x1.x + x1.y * x1.y) + (x1.z * x1.z + x1.w * x1.w); }
              ss += __shfl_xor(ss, 32);
              const float rstd = rsqrtf(ss * (1.f / 128.f) + EPS);
              asm volatile("" ::: "memory");
#pragma unroll
              for (int st = 0; st < 8; ++st) { const f32x4 x0 = *(const f32x4*)(qr + 16 * st), x1 = *(const f32x4*)(qr + 16 * st + 4); const f32x4 g0 = *(const f32x4*)(gr + 16 * st), g1 = *(const f32x4*)(gr + 16 * st + 4);
                  const float v0 = x0.x * rstd * g0.x, v1 = x0.y * rstd * g0.y, v2 = x0.z * rstd * g0.z, v3 = x0.w * rstd * g0.w, v4 = x1.x * rstd * g1.x, v5 = x1.y * rstd * g1.y, v6 = x1.z * rstd * g1.z, v7 = x1.w * rstd * g1.w;
                  v4u xh, xl; xh.x = pkbf(v0, v1); xh.y = pkbf(v2, v3); xh.z = pkbf(v4, v5); xh.w = pkbf(v6, v7);
                  xl.x = pkbf(v0 - bflo(xh.x), v1 - bfhi(xh.x)); xl.y = pkbf(v2 - bflo(xh.y), v3 - bfhi(xh.y)); xl.z = pkbf(v4 - bflo(xh.z), v5 - bfhi(xh.z)); xl.w = pkbf(v6 - bflo(xh.w), v7 - bfhi(xh.w));
                  bh[st] = __builtin_bit_cast(bf16x8, xh); bl[st] = __builtin_bit_cast(bf16x8, xl); } }
            float sc[64];
            const v4u* kfh = KF + (size_t)(((h * 2 + p) * 2 + 0) * 32) * 64 + lane; const v4u* kfl = KF + (size_t)(((h * 2 + p) * 2 + 1) * 32) * 64 + lane;
#pragma unroll
            for (int kt = 0; kt < 4; ++kt) {
                f32x16 acc;
#pragma unroll
                for (int i = 0; i < 16; ++i) acc[i] = 0.f;
#pragma unroll
                for (int s2 = 0; s2 < 2; ++s2) {
                    asm volatile("" ::: "memory");
                    bf16x8 ah[4], al[4];
#pragma unroll
                    for (int s4 = 0; s4 < 4; ++s4) { ah[s4] = __builtin_bit_cast(bf16x8, kfh[(kt * 8 + s2 * 4 + s4) * 64]); al[s4] = __builtin_bit_cast(bf16x8, kfl[(kt * 8 + s2 * 4 + s4) * 64]); }
#pragma unroll
                    for (int s4 = 0; s4 < 4; ++s4) { const int st = s2 * 4 + s4;
                        acc = __builtin_amdgcn_mfma_f32_32x32x16_bf16(al[s4], bh[st], acc, 0, 0, 0); acc = __builtin_amdgcn_mfma_f32_32x32x16_bf16(ah[s4], bl[st], acc, 0, 0, 0); acc = __builtin_amdgcn_mfma_f32_32x32x16_bf16(ah[s4], bh[st], acc, 0, 0, 0); }
                }
#pragma unroll
                for (int i = 0; i < 16; ++i) { const float av = acc[i];
                    const unsigned bits = (__builtin_bit_cast(unsigned, av) & ~127u) | (unsigned)(127 - (32 * kt + CROW(i) + 4 * hc)); sc[16 * kt + i] = __builtin_bit_cast(float, bits); }
            }
            asm volatile("" ::: "memory");
            bitonic_desc<64, false>(sc);
            float t16[16];
#pragma unroll
            for (int i = 0; i < 16; ++i) t16[i] = __shfl_xor(sc[i], 32);
            float u16[16];
#pragma unroll
            for (int i = 0; i < 16; ++i) u16[i] = fmaxf(sc[i], t16[15 - i]);
            bitonic_desc<16, true>(u16);
#pragma unroll
            for (int i = 0; i < 16; ++i) spl[p * 16 + i] = u16[i];
        }
        asm volatile("s_waitcnt lgkmcnt(0)" ::: "memory");
        float sp[2][16];
#pragma unroll
        for (int i = 0; i < 16; ++i) { sp[0][i] = spl[i]; sp[1][i] = spl[16 + i]; }
        float cv[64];
        {
            int c = 0;
#pragma unroll
            for (int i = 0; i < 16; ++i)
#pragma unroll
                for (int j = 0; j < 16; ++j) if ((i + 1) * (j + 1) <= 16) {
                    const float v = sp[0][i] + sp[1][j];
                    cv[c] = __builtin_bit_cast(float, (__builtin_bit_cast(unsigned, v) & ~255u) | (unsigned)(255 - (i * 16 + j))); ++c; }
#pragma unroll
            for (int i = 50; i < 64; ++i) cv[i] = -INFINITY;
        }
        bitonic_desc<64, false>(cv);
        float tv[16];
#pragma unroll
        for (int i = 0; i < 16; ++i) tv[i] = cv[i];
        asm volatile("s_waitcnt lgkmcnt(0)" ::: "memory");
        int te[16]; float den = 0.f; const float top = tv[0];
#pragma unroll
        for (int i = 0; i < 16; ++i) { const int flat = 255 - (int)(__builtin_bit_cast(unsigned, tv[i]) & 255u);
            const unsigned b1 = __builtin_bit_cast(unsigned, spl[flat >> 4]), b2 = __builtin_bit_cast(unsigned, spl[16 + (flat & 15)]);
            te[i] = (127 - (int)(b1 & 127u)) * 128 + (127 - (int)(b2 & 127u));
            tv[i] = __expf(tv[i] - top); den += tv[i]; }
        den = 1.f / den;
        if (hc == 0) {
            int* ei = EI + (size_t)t * 128 + h * 16; float* eg = EG + (size_t)t * 128 + h * 16;
#pragma unroll
            for (int i = 0; i < 16; i += 4) { *(v4u*)(ei + i) = (v4u){(unsigned)te[i], (unsigned)te[i + 1], (unsigned)te[i + 2], (unsigned)te[i + 3]}; *(f32x4*)(eg + i) = (f32x4){tv[i] * den, tv[i + 1] * den, tv[i + 2] * den, tv[i + 3] * den}; }
        }
        asm volatile("s_waitcnt lgkmcnt(0)" ::: "memory");
    }
}
__device__ __forceinline__ float ub0(unsigned w) { return (float)(w & 0xffu); }
__device__ __forceinline__ float ub1(unsigned w) { return (float)((w >> 8) & 0xffu); }
__device__ __forceinline__ float ub2(unsigned w) { return (float)((w >> 16) & 0xffu); }
__device__ __forceinline__ float ub3(unsigned w) { return (float)(w >> 24); }
__device__ __forceinline__ void ph_experts(const Args& a, const float osc) {
    const int tid = phase_tid(), lane = tid & 63, wave = __builtin_amdgcn_readfirstlane(tid >> 6);
    const int gw = blockIdx.x * NWAVES + wave, NGW = gridDim.x * NWAVES;
    const bf16* H2 = (const bf16*)(a.ws + WS_H); const unsigned char* PU = a.ws + WS_PU8; const unsigned char* PV = a.ws + WS_PV8; const float* SC = (const float*)(a.ws + WS_PSC);
    const int* EI = (const int*)(a.ws + WS_EI); const float* EG = (const float*)(a.ws + WS_EG);
    const float* mod = (const float*)(a.ws + WS_MOD);
    float* out = a.out;
    for (int t = gw; t < T; t += NGW) {
        const int b = t / S;
        float x[32]; float sx = 0.f;
#pragma unroll
        for (int c = 0; c < 2; ++c)
#pragma unroll
            for (int hw = 0; hw < 2; ++hw) { const v4u w = *(const v4u*)(H2 + (size_t)t * D + 1024 * c + 16 * lane + 8 * hw); const int o = 16 * c + 8 * hw;
                x[o + 0] = bflo(w.x); x[o + 1] = bfhi(w.x); x[o + 2] = bflo(w.y); x[o + 3] = bfhi(w.y); x[o + 4] = bflo(w.z); x[o + 5] = bfhi(w.z); x[o + 6] = bflo(w.w); x[o + 7] = bfhi(w.w); }
#pragma unroll
        for (int i = 0; i < 32; ++i) sx += x[i];
        sx = wave_sum(sx) * 128.f;
        const int e0 = EI[(size_t)t * 128 + lane], e1 = EI[(size_t)t * 128 + 64 + lane];
        const float gs0 = EG[(size_t)t * 128 + lane] * SC[NE + e0], gs1 = EG[(size_t)t * 128 + 64 + lane] * SC[NE + e1];
        const float su0 = SC[e0], su1 = SC[e1];
        float cf0 = 0.f, cf1 = 0.f;
#pragma unroll 1
        for (int bt = 0; bt < 16; ++bt) {
            v4u w[8][2];
#pragma unroll
            for (int k = 0; k < 8; ++k) { const int e = __shfl(bt < 8 ? e0 : e1, (bt * 8 + k) & 63); const unsigned char* ur = PU + (size_t)e * D + 16 * lane;
                w[k][0] = *(const v4u*)ur; w[k][1] = *(const v4u*)(ur + 1024); }
#pragma unroll
            for (int k = 0; k < 8; ++k) { float s0 = 0.f, s1 = 0.f;
#pragma unroll
                for (int c = 0; c < 2; ++c) { const v4u q = w[k][c]; const int o = 16 * c;
                    s0 += x[o + 0] * ub0(q.x) + x[o + 1] * ub1(q.x) + x[o + 2] * ub2(q.x) + x[o + 3] * ub3(q.x); s1 += x[o + 4] * ub0(q.y) + x[o + 5] * ub1(q.y) + x[o + 6] * ub2(q.y) + x[o + 7] * ub3(q.y);
                    s0 += x[o + 8] * ub0(q.z) + x[o + 9] * ub1(q.z) + x[o + 10] * ub2(q.z) + x[o + 11] * ub3(q.z); s1 += x[o + 12] * ub0(q.w) + x[o + 13] * ub1(q.w) + x[o + 14] * ub2(q.w) + x[o + 15] * ub3(q.w); }
                const float raw = wave_sum(s0 + s1) - sx;
                if (lane == ((bt * 8 + k) & 63)) { if (bt < 8) cf0 = gelu_tanh(raw * su0) * gs0; else cf1 = gelu_tanh(raw * su1) * gs1; } }
        }
        const float wsum = wave_sum(cf0 + cf1) * 128.f;
        float acc[32];
#pragma unroll
        for (int i = 0; i < 32; ++i) acc[i] = 0.f;
#pragma unroll 1
        for (int bt = 0; bt < 16; ++bt) {
            v4u w[8][2];
#pragma unroll
            for (int k = 0; k < 8; ++k) { const int e = __shfl(bt < 8 ? e0 : e1, (bt * 8 + k) & 63); const unsigned char* vr = PV + (size_t)e * D + 16 * lane;
                w[k][0] = *(const v4u*)vr; w[k][1] = *(const v4u*)(vr + 1024); }
#pragma unroll
            for (int k = 0; k < 8; ++k) { const float cf = __shfl(bt < 8 ? cf0 : cf1, (bt * 8 + k) & 63);
#pragma unroll
                for (int c = 0; c < 2; ++c) { const v4u q = w[k][c]; const int o = 16 * c;
                    acc[o + 0] += cf * ub0(q.x); acc[o + 1] += cf * ub1(q.x); acc[o + 2] += cf * ub2(q.x); acc[o + 3] += cf * ub3(q.x); acc[o + 4] += cf * ub0(q.y); acc[o + 5] += cf * ub1(q.y); acc[o + 6] += cf * ub2(q.y); acc[o + 7] += cf * ub3(q.y);
                    acc[o + 8] += cf * ub0(q.z); acc[o + 9] += cf * ub1(q.z); acc[o + 10] += cf * ub2(q.z); acc[o + 11] += cf * ub3(q.z); acc[o + 12] += cf * ub0(q.w); acc[o + 13] += cf * ub1(q.w); acc[o + 14] += cf * ub2(q.w); acc[o + 15] += cf * ub3(q.w); } }
        }
        const float* g2 = mod + b * 12288 + 10240;
#pragma unroll
        for (int c = 0; c < 2; ++c)
#pragma unroll
            for (int w4 = 0; w4 < 4; ++w4) { float* op = out + (size_t)t * D + 1024 * c + 16 * lane + 4 * w4; const f32x4 ga = *(const f32x4*)(g2 + 1024 * c + 16 * lane + 4 * w4); f32x4 r0 = *(const f32x4*)op; const int o = 16 * c + 4 * w4;
                r0.x += ga.x * (acc[o + 0] - wsum) * osc; r0.y += ga.y * (acc[o + 1] - wsum) * osc; r0.z += ga.z * (acc[o + 2] - wsum) * osc; r0.w += ga.w * (acc[o + 3] - wsum) * osc;
                *(f32x4*)op = r0; }
    }
}

constexpr int N_PHASES = 11;
__global__ void __launch_bounds__(NTHREADS, 2) fwd_kernel(Args a) {
    extern __shared__ __attribute__((aligned(16))) unsigned char lds_raw[];
    LAS unsigned char* lds = (LAS unsigned char*)lds_raw;
    const int tid = threadIdx.x;
    volatile LAS unsigned* misc = (volatile LAS unsigned*)(lds + LDS_MISC);
    if (tid < 16) misc[tid] = 0u;
    __syncthreads();
    XcdBarrier bar; bar.bar = (unsigned*)(a.ws + WS_CTL) + 1024; bar.x = 0; bar.st = nullptr;
    const int lo = a.ph_lo, hi = a.ph_hi;
    if (hi - lo > 1) bar = xcd_barrier_post((unsigned*)(a.ws + WS_CTL) + 1024, misc + 8);
#define IN(k) (lo <= (k) && (k) < hi)
#define SEAM(k) do { if (IN(k) && IN((k) + 1)) xcd_barrier(bar); } while (0)
    const int G = gridDim.x, bx = blockIdx.x;

    for (int rep = 0; rep < 1 + ((PROBE_DUP >> 0) & 1); ++rep)
    if (IN(0)) { ph0_mod(a, lds); __syncthreads(); ph0_weights(a, lds); ph0_keyfrags(a); ph0_extra(a); __syncthreads(); }
    SEAM(0);
    for (int rep = 0; rep < 1 + ((PROBE_DUP >> 1) & 1); ++rep)
    if (IN(1)) ph_norm<true>(a, a.in[0], a.in[4], 0, 2048, (bf16*)(a.ws + WS_H), a.ws + WS_H8);
    SEAM(1);
    for (int rep = 0; rep < 1 + ((PROBE_DUP >> 2) & 1); ++rep)
    if (IN(2)) { pg8::Gemm g{(const bf16*)(a.ws + WS_H8), (const bf16*)(a.ws + WS_WIN), T, NPROJ, D / 2}; pg8::StaticOrder So; So.init(T, NPROJ, G, bx);
        EpiProjNorm E{(bf16*)(a.ws + WS_Q), (bf16*)(a.ws + WS_KV), (bf16*)(a.ws + WS_DL), (bf16*)(a.ws + WS_MG), (bf16*)a.out, a.in[6], a.in[7], a.in[11], a.in[12], (LAS float*)(lds + 131072), 1.f / (F8_HS * F8_WS)};
        pg8::gemm_phase<EpiProjNorm, pg8::StaticOrder, pg8::NoMid, true>(lds, g, So, E); }
    SEAM(2);
    if (IN(3)) { for (int rep = 0; rep < 1 + ((PROBE_DUP >> 3) & 1); ++rep) { ph3_vfrag(a); ph3_gates(a); ph3_compress(a, lds); } }
    SEAM(3);
    for (int rep = 0; rep < 1 + ((PROBE_DUP >> 4) & 1); ++rep)
    if (IN(4)) ph4_attention(a, lds);
    SEAM(4);
    for (int rep = 0; rep < 1 + ((PROBE_DUP >> 5) & 1); ++rep)
    if (IN(5)) {
        { pg8::Gemm g{(const bf16*)(a.ws + WS_YN), (const bf16*)(a.ws + WS_WBN), T, D, 1536}; pg8::StaticOrder So; So.init(T, D, G, bx);
          EpiMerge E{(const bf16*)(a.ws + WS_MG), a.ws + WS_H, F8_MS}; MidMerge Mh{(const bf16*)(a.ws + WS_MG)};
          pg8::gemm_phase<EpiMerge, pg8::StaticOrder, MidMerge>(lds, g, So, E, Mh); }
    }
    SEAM(5);
    for (int rep = 0; rep < 1 + ((PROBE_DUP >> 6) & 1); ++rep)
    if (IN(6)) { pg8::Gemm g{(const bf16*)(a.ws + WS_H), (const bf16*)(a.ws + WS_WOUT), T, D, D / 2}; pg8::StaticOrder So; So.init(T, D, G, bx);
        EpiOut E{a.in[0], (const float*)(a.ws + WS_MOD), a.out, 1.f / (F8_MS * F8_WS)}; pg8::gemm_phase<EpiOut, pg8::StaticOrder, pg8::NoMid, true>(lds, g, So, E); }
    SEAM(6);
    for (int rep = 0; rep < 1 + ((PROBE_DUP >> 7) & 1); ++rep)
    if (IN(7)) { ph_norm(a, a.out, a.in[16], 6144, 8192, (bf16*)(a.ws + WS_H)); ph_quant_uv(a); }
    SEAM(7);
    for (int rep = 0; rep < 1 + ((PROBE_DUP >> 8) & 1); ++rep)
    if (IN(8)) { pg8::Gemm g{(const bf16*)(a.ws + WS_H), (const bf16*)(a.ws + WS_WPQ), T, D, D}; pg8::StaticOrder So; So.init(T, D, G, bx);
        EpiF32 E{(float*)(a.ws + WS_QP), D}; pg8::gemm_phase<EpiF32, pg8::StaticOrder>(lds, g, So, E); }
    SEAM(8);
    for (int rep = 0; rep < 1 + ((PROBE_DUP >> 9) & 1); ++rep)
    if (IN(9)) { ph_route(a, lds); __syncthreads(); }
    SEAM(9);
    if (IN(10)) { if ((PROBE_DUP >> 10) & 1) { ph_experts(a, *(const float*)(a.ws + WS_CTL + 64)); asm volatile("s_waitcnt vmcnt(0)" ::: "memory"); __syncthreads(); } ph_experts(a, 1.f); }
#undef IN
#undef SEAM
}

extern "C" void kernel_launch(void* const* d_in, const int* in_sizes, int n_in, void* d_out, int out_size, void* d_ws, size_t ws_size, hipStream_t stream) {
    static int grid = 0;
    if (grid == 0) {
        if (n_in != 23 || out_size != T * D || ws_size < WS_END4) { fprintf(stderr, "kernel_launch: unexpected problem shape (n_in %d, out %d, ws %zu); nothing launched\n", n_in, out_size, ws_size); grid = -1; return; }
        int dev = 0, cus = 0, per_cu = 0;
        if (hipGetDevice(&dev) != hipSuccess || hipDeviceGetAttribute(&cus, hipDeviceAttributeMultiprocessorCount, dev) != hipSuccess) { grid = -1; return; }
        if (hipFuncSetAttribute((const void*)fwd_kernel, hipFuncAttributeMaxDynamicSharedMemorySize, LDS_BYTES) != hipSuccess) { fprintf(stderr, "kernel_launch: hipFuncSetAttribute failed\n"); grid = -1; return; }
        if (hipOccupancyMaxActiveBlocksPerMultiprocessor(&per_cu, (const void*)fwd_kernel, NTHREADS, LDS_BYTES) != hipSuccess || per_cu < 1) { fprintf(stderr, "kernel_launch: occupancy query says %d\n", per_cu); }
        (void)hipGetLastError();
        grid = cus;
    }
    if (grid < 0) return;
    hipMemsetAsync((char*)d_ws + WS_CTL, 0, CTL_ZERO_BYTES, stream);
    Args a{};
    for (int i = 0; i < 23; ++i) a.in[i] = (const float*)d_in[i];
    a.out = (float*)d_out; a.ws = (unsigned char*)d_ws;
#if MK_ONE_LAUNCH
#if PROBE_PREFIX >= 0
    a.ph_lo = 0; a.ph_hi = PROBE_PREFIX + 1;
    hipLaunchKernelGGL(fwd_kernel, dim3(grid), dim3(NTHREADS), LDS_BYTES, stream, a);
    hipMemsetAsync((char*)d_ws + WS_CTL, 0, CTL_ZERO_BYTES, stream);
#endif
    a.ph_lo = 0; a.ph_hi = N_PHASES;
    hipLaunchKernelGGL(fwd_kernel, dim3(grid), dim3(NTHREADS), LDS_BYTES, stream, a);
#else
    for (int p = 0; p < N_PHASES; ++p) { a.ph_lo = p; a.ph_hi = p + 1; hipLaunchKernelGGL(fwd_kernel, dim3(grid), dim3(NTHREADS), LDS_BYTES, stream, a); }
#endif
}
```

```cpp
#include <hip/hip_runtime.h>
#include <cstdio>
#include <cstdint>

#ifndef PROBE_DUP
#define PROBE_DUP 0
#endif
#ifndef PROBE_PREFIX
#define PROBE_PREFIX -1
#endif
#ifndef MK_ONE_LAUNCH
#define MK_ONE_LAUNCH 1
#endif

__device__ __forceinline__ int phase_tid() { int t = threadIdx.x; asm volatile("" : "+v"(t)); return t; }
namespace pg8 {
#define PG8_LAS __attribute__((address_space(3)))
typedef unsigned short bf16_t;
typedef short bf16x8 __attribute__((ext_vector_type(8)));
typedef float f32x4 __attribute__((ext_vector_type(4)));
typedef unsigned u32x4 __attribute__((ext_vector_type(4)));
typedef unsigned u32x2 __attribute__((ext_vector_type(2)));
constexpr int BM = 256, BK = 64, HALF = 128, HTB = HALF * BK * 2, STAGE_BYTES = 8 * HTB, NXCD = 8, WGM = 8;

__host__ __device__ __forceinline__ int lds_byte(int r, int c) { const int st = (r >> 4) * 2 + (c >> 5), rr = r & 15, cc = c & 31, ob = rr * 64 + cc * 2; return st * 1024 + (ob ^ (((ob >> 9) & 1) << 5)); }
__host__ __device__ __forceinline__ void stage_rc(int b, int& R, int& C) { const int st = b / 1024, sb = b % 1024, swz = sb ^ (((sb >> 9) & 1) << 5); R = (st >> 1) * 16 + swz / 64; C = (st & 1) * 32 + (swz % 64) / 2; }
__host__ __device__ __forceinline__ int perm32(int rho) { const int n = rho >> 4, i = rho & 15; return 8 * (i >> 2) + 4 * n + (i & 3); }

struct Unit { int pm, pn; };
struct Gemm { const bf16_t* A; const bf16_t* Bt; int M, N, K; };

struct StaticOrder {
    int nM, nN, nwg, G, c;
    __host__ __device__ void init(int M, int N, int G_, int c_) { nM = M / BM; nN = N / BM; nwg = nM * nN; G = G_; c = c_; }
    __host__ __device__ bool next(int i, Unit& u) const {
        const long L = (long)i * G + c; if (L >= nwg) return false;
        int wgid = (int)L; { const int q = nwg / NXCD, r = nwg % NXCD, xcd = wgid % NXCD, off = wgid / NXCD; wgid = (xcd < r ? xcd * (q + 1) : r * (q + 1) + (xcd - r) * q) + off; }
        const int nig = WGM * nN, gid = wgid / nig, fm = gid * WGM, gsz = (nM - fm) < WGM ? (nM - fm) : WGM;
        u.pm = fm + ((wgid % nig) % gsz); u.pn = (wgid % nig) / gsz; return true;
    }
    __device__ __forceinline__ void a_ready(const Unit&) const {}
    __device__ __forceinline__ void done(const Unit&) const {}
};

__device__ __forceinline__ unsigned cvt_pk_bf16(float lo, float hi) { unsigned r; asm volatile("v_cvt_pk_bf16_f32 %0, %1, %2" : "=v"(r) : "v"(lo), "v"(hi)); return r; }

typedef int i32x4 __attribute__((ext_vector_type(4)));
typedef int i32x8 __attribute__((ext_vector_type(8)));
template <bool F8> __device__ __forceinline__ void mma_blk(f32x4 (&acc)[4][2], const bf16x8 (&At)[4][2], const bf16x8 (&Bt)[2][2]) {
    if constexpr (F8) {
#pragma unroll
        for (int m = 0; m < 4; ++m)
#pragma unroll
            for (int n = 0; n < 2; ++n) {
                const i32x8 bb = __builtin_shufflevector(__builtin_bit_cast(i32x4, Bt[n][0]), __builtin_bit_cast(i32x4, Bt[n][1]), 0, 1, 2, 3, 4, 5, 6, 7);
                const i32x8 aa = __builtin_shufflevector(__builtin_bit_cast(i32x4, At[m][0]), __builtin_bit_cast(i32x4, At[m][1]), 0, 1, 2, 3, 4, 5, 6, 7);
                asm volatile("v_mfma_f32_16x16x128_f8f6f4 %0, %1, %2, %0" : "+v"(acc[m][n]) : "v"(bb), "v"(aa)); }
    } else {
#pragma unroll
        for (int m = 0; m < 4; ++m)
#pragma unroll
            for (int n = 0; n < 2; ++n)
#pragma unroll
                for (int k = 0; k < 2; ++k) acc[m][n] = __builtin_amdgcn_mfma_f32_16x16x32_bf16(Bt[n][k], At[m][k], acc[m][n], 0, 0, 0);
    }
}
struct NoMid { static constexpr int AT = -1; __device__ __forceinline__ void operator()(f32x4 (&)[2][2][4][2], const Unit&, int, int, int, int) const {} };
template <class Epi, class Sched, class Mid = NoMid, bool F8 = false>
__device__ __forceinline__ void gemm_phase(PG8_LAS unsigned char* lds, const Gemm g, const Sched& S, const Epi& E, const Mid& Mh = Mid()) {
    const int tid = phase_tid(), wid = __builtin_amdgcn_readfirstlane(tid >> 6), lane = tid & 63, wr = wid >> 2, wc = wid & 3, fr = lane & 15, fq = lane >> 4;
    const int K = g.K, nt = K / BK;
    unsigned voffA[2], voffB[2];
#pragma unroll
    for (int i = 0; i < 2; ++i) { int R, C; stage_rc(tid * 16 + i * 8192, R, C); const int Rb = Epi::PERM ? ((R & ~31) + perm32(R & 31)) : R;
        voffA[i] = (unsigned)(R * K + C) * 2u; voffB[i] = (unsigned)(Rb * K + C) * 2u; }
    const size_t kstep = (size_t)(BK * 2);
    const size_t hstep = (size_t)HALF * K * 2;
    const size_t tstep = 2 * hstep;
    const unsigned ldsw = (unsigned)wid * 1024u;
    const int aoff = lds_byte(wr * 64 + fr, fq * 8), boff = lds_byte(wc * 32 + fr, fq * 8);
#define PG8_SA(b, h) (((b) * 2 + (h)) * HTB)
#define PG8_SB(b, h) ((4 + (b) * 2 + (h)) * HTB)
#define PG8_STAGE(bufoff, gbase, voff) do { _Pragma("unroll") for (int _i = 0; _i < 2; ++_i) \
        __builtin_amdgcn_global_load_lds((const unsigned*)((const char*)(gbase) + (voff)[_i]), (PG8_LAS unsigned*)(lds + (bufoff) + ldsw + _i * 8192), 16, 0, 0); } while (0)
#define PG8_LDA(dst, b, h) do { _Pragma("unroll") for (int m = 0; m < 4; ++m) _Pragma("unroll") for (int k = 0; k < 2; ++k) dst[m][k] = *(const PG8_LAS bf16x8*)(lds + PG8_SA(b, h) + aoff + m * 2048 + k * 1024); } while (0)
#define PG8_LDB(dst, b, h) do { _Pragma("unroll") for (int n = 0; n < 2; ++n) _Pragma("unroll") for (int k = 0; k < 2; ++k) dst[n][k] = *(const PG8_LAS bf16x8*)(lds + PG8_SB(b, h) + boff + n * 2048 + k * 1024); } while (0)
#define PG8_MMA(ai, bj, At, Bt) do { __builtin_amdgcn_s_setprio(1); if constexpr (F8) { mma_blk<true>(acc[ai][bj], At, Bt); } else { _Pragma("unroll") for (int m = 0; m < 4; ++m) _Pragma("unroll") for (int n = 0; n < 2; ++n) _Pragma("unroll") for (int k = 0; k < 2; ++k) \
        acc[ai][bj][m][n] = __builtin_amdgcn_mfma_f32_16x16x32_bf16(Bt[n][k], At[m][k], acc[ai][bj][m][n], 0, 0, 0); } __builtin_amdgcn_s_setprio(0); } while (0)
#define PG8_WAIT_V(n) asm volatile("s_waitcnt vmcnt(" #n ")" ::: "memory")
#define PG8_WAIT_L(n) asm volatile("s_waitcnt lgkmcnt(" #n ")" ::: "memory")
#define PG8_BAR __builtin_amdgcn_s_barrier()
#define PG8_SCHED __builtin_amdgcn_sched_barrier(0)
    Unit cur, nxt; int ui = 0;
    if (!S.next(0, cur)) return;
    f32x4 acc[2][2][4][2];
#pragma unroll
    for (int a = 0; a < 2; ++a)
#pragma unroll
        for (int b = 0; b < 2; ++b)
#pragma unroll
            for (int m = 0; m < 4; ++m)
#pragma unroll
                for (int n = 0; n < 2; ++n) acc[a][b][m][n] = (f32x4){0.f, 0.f, 0.f, 0.f};
    bf16x8 At[4][2], B0[2][2], B1[2][2];
    const char* cA = (const char*)g.A + (size_t)cur.pm * tstep; const char* cB = (const char*)g.Bt + (size_t)cur.pn * tstep;
    S.a_ready(cur);
    PG8_STAGE(PG8_SB(0, 0), cB, voffB); PG8_STAGE(PG8_SA(0, 0), cA, voffA); PG8_STAGE(PG8_SB(0, 1), cB + hstep, voffB); PG8_STAGE(PG8_SA(0, 1), cA + hstep, voffA);
    if (wr == 1) PG8_BAR;
    PG8_WAIT_V(4); PG8_BAR;
    PG8_STAGE(PG8_SB(1, 0), cB + kstep, voffB); PG8_STAGE(PG8_SA(1, 0), cA + kstep, voffA); PG8_STAGE(PG8_SB(1, 1), cB + hstep + kstep, voffB);
    PG8_WAIT_V(6); PG8_BAR;
    for (;;) {
        const bool has_next = S.next(ui + 1, nxt);
        const char* nA = has_next ? (const char*)g.A + (size_t)nxt.pm * tstep : cA; const char* nB = has_next ? (const char*)g.Bt + (size_t)nxt.pn * tstep : cB;
#define PG8_KBODY \
            const bool last = (t == nt - 2); \
            const char* a1 = cA + (size_t)(t + 1) * kstep; \
            const char* a2 = last ? nA : cA + (size_t)(t + 2) * kstep; const char* b2 = last ? nB : cB + (size_t)(t + 2) * kstep; \
            const char* a3 = a2 + kstep; const char* b3 = b2 + kstep; \
            if (last && has_next) S.a_ready(nxt); \
            PG8_LDB(B0, 0, 0); PG8_SCHED; PG8_LDA(At, 0, 0); PG8_STAGE(PG8_SA(1, 1), a1 + hstep, voffA); \
            PG8_WAIT_L(8); PG8_BAR; PG8_WAIT_L(0); PG8_MMA(0, 0, At, B0); PG8_BAR; PG8_SCHED; \
            PG8_LDB(B1, 0, 1); PG8_STAGE(PG8_SB(0, 0), b2, voffB); \
            PG8_BAR; PG8_WAIT_L(0); PG8_MMA(0, 1, At, B1); PG8_BAR; \
            PG8_LDA(At, 0, 1); PG8_STAGE(PG8_SA(0, 0), a2, voffA); \
            PG8_BAR; PG8_WAIT_L(0); PG8_MMA(1, 0, At, B0); PG8_BAR; PG8_SCHED; \
            PG8_STAGE(PG8_SB(0, 1), b2 + hstep, voffB); \
            PG8_WAIT_V(6); PG8_BAR; PG8_MMA(1, 1, At, B1); PG8_BAR; \
            PG8_LDB(B0, 1, 0); PG8_SCHED; PG8_LDA(At, 1, 0); PG8_STAGE(PG8_SA(0, 1), a2 + hstep, voffA); \
            PG8_WAIT_L(8); PG8_BAR; PG8_WAIT_L(0); PG8_MMA(0, 0, At, B0); PG8_BAR; PG8_SCHED; \
            PG8_LDB(B1, 1, 1); PG8_STAGE(PG8_SB(1, 0), b3, voffB); \
            PG8_BAR; PG8_WAIT_L(0); PG8_MMA(0, 1, At, B1); PG8_BAR; \
            PG8_LDA(At, 1, 1); PG8_STAGE(PG8_SA(1, 0), a3, voffA); \
            PG8_BAR; PG8_WAIT_L(0); PG8_MMA(1, 0, At, B0); PG8_BAR; PG8_SCHED; \
            PG8_STAGE(PG8_SB(1, 1), b3 + hstep, voffB); \
            PG8_WAIT_V(6); PG8_BAR; PG8_MMA(1, 1, At, B1); PG8_BAR;
        if constexpr (Mid::AT >= 0) {
            for (int t = 0; t < Mid::AT; t += 2) { PG8_KBODY }
            if constexpr (F8) asm volatile("s_nop 15\n\ts_nop 15" ::: "memory");
            Mh(acc, cur, wr, wc, fr, fq);
            for (int t = Mid::AT; t < nt; t += 2) { PG8_KBODY }
        } else {
            for (int t = 0; t < nt; t += 2) { PG8_KBODY }
        }
#undef PG8_KBODY
        if constexpr (F8) asm volatile("s_nop 15\n\ts_nop 15" ::: "memory");
        E(acc, cur, wr, wc, fr, fq); S.done(cur);
        if (!has_next) break;
#pragma unroll
        for (int a = 0; a < 2; ++a)
#pragma unroll
            for (int b = 0; b < 2; ++b)
#pragma unroll
                for (int m = 0; m < 4; ++m)
#pragma unroll
                    for (int n = 0; n < 2; ++n) acc[a][b][m][n] = (f32x4){0.f, 0.f, 0.f, 0.f};
        cur = nxt; cA = nA; cB = nB; ++ui;
    }
    PG8_WAIT_V(0);
    if (wr == 0) PG8_BAR;
    PG8_BAR;
#undef PG8_SA
#undef PG8_SB
#undef PG8_STAGE
#undef PG8_LDA
#undef PG8_LDB
#undef PG8_MMA
#undef PG8_WAIT_V
#undef PG8_WAIT_L
#undef PG8_BAR
#undef PG8_SCHED
}
}

#define GAS __attribute__((address_space(1)))
#define LAS __attribute__((address_space(3)))
typedef unsigned short bf16;
typedef float f32x4 __attribute__((ext_vector_type(4)));
typedef unsigned v4u __attribute__((ext_vector_type(4)));
typedef unsigned v2u __attribute__((ext_vector_type(2)));

constexpr int NB = 4, S = 4096, D = 2048, T = NB * S, HD = 128;
constexpr int IN_COLS = 11288, OFF_KV = 1024, OFF_GATE = 2560, OFF_DIL = 2584, OFF_MERGE = 7192;
constexpr int NPROJ = 11264;
constexpr int NQ = 1024, NKV = 1536, NDL = 4608, NMG = 4096;
constexpr int NC = 255, NS = 64;
constexpr int NE = 16384;
constexpr float EPS = 1e-6f;
constexpr float QSCALE = 0.08838834764831845f;
constexpr int NWAVES = 8, NTHREADS = 512;

constexpr size_t MiB = 1u << 20;
constexpr size_t WS_CTL = 0, CTL_ZERO_BYTES = 1 * MiB;
constexpr size_t WS_WIN = 1 * MiB;
constexpr size_t WS_WBN = 45 * MiB;
constexpr size_t WS_WBD = 49 * MiB;
constexpr size_t WS_WOUT = 51 * MiB;
constexpr size_t WS_WPQ = 59 * MiB;
constexpr size_t WS_WGATE = 67 * MiB;
constexpr size_t WS_MOD = 67 * MiB + 256 * 1024;
constexpr size_t WS_SEL = 67 * MiB + 512 * 1024;
constexpr size_t WS_GATES = 68 * MiB;
constexpr size_t WS_KC = 70 * MiB;
constexpr size_t WS_VC = 71 * MiB;
constexpr size_t WS_H = 72 * MiB;
constexpr size_t WS_Q = 136 * MiB;
constexpr size_t WS_KV = 168 * MiB;
constexpr size_t WS_DL = 216 * MiB;
constexpr size_t WS_MG = 360 * MiB;
constexpr size_t WS_YN = 488 * MiB;
constexpr size_t WS_YD = 520 * MiB;
constexpr size_t WS_H8 = WS_YN;
constexpr size_t WS_EI = 536 * MiB;
constexpr size_t WS_EG = 544 * MiB;
constexpr size_t WS_END = 552 * MiB;
constexpr size_t WS_PU = WS_Q;
constexpr size_t WS_PV = WS_Q + 64 * MiB;
constexpr size_t WS_QP = WS_MG;
static_assert(WS_PV + 64 * MiB <= WS_MG, "u/v overlay");

constexpr int LDS_BYTES = 147456;
constexpr int LDS_MISC = 144 * 1024 - 256;

#define XB_TMO      128
#define XB_XCNT(j)  (256  + 64 * (j))
#define XB_XSUB(j)  (1280 + 64 * (j))
#define XB_XGEN(j)  (2304 + 64 * (j))
#define XB_TOP      3328
#define XB_TOPGEN   3392
#define XCD_BAR_WORDS 3456
#define XB_SPIN_CAP (1u << 24)

__device__ __forceinline__ unsigned xb_ld(unsigned* p)              { return __hip_atomic_load(p, __ATOMIC_RELAXED, __HIP_MEMORY_SCOPE_AGENT); }
__device__ __forceinline__ unsigned xb_add(unsigned* p, unsigned v) { return __hip_atomic_fetch_add(p, v, __ATOMIC_RELAXED, __HIP_MEMORY_SCOPE_AGENT); }
__device__ __forceinline__ unsigned xb_xcc_id() { return (unsigned)__builtin_amdgcn_s_getreg((3 << 11) | 20) & 0xFu; }
#define XB_SPIN(cond, bar) do { unsigned _sp = 0; while (cond) { __builtin_amdgcn_s_sleep(1); \
    if ((++_sp & 255u) == 0u) { if (xb_ld(&(bar)[XB_TMO])) break; if (_sp > XB_SPIN_CAP) { atomicAdd(&(bar)[XB_TMO], 1u); break; } } } } while (0)

struct XcdBarrier { unsigned* bar; unsigned x; volatile LAS unsigned* st; };

__device__ __forceinline__ XcdBarrier xcd_barrier_post(unsigned* bar, volatile LAS unsigned* st) {
    XcdBarrier b; b.bar = bar; b.x = xb_xcc_id(); b.st = st;
    if (threadIdx.x == 0) (void)xb_add(&bar[XB_XCNT(b.x)], 1u);
    return b;
}
__device__ __forceinline__ void xcd_barrier_complete(unsigned* bar, unsigned x, unsigned& nloc, unsigned& nx) {
    const unsigned G = gridDim.x * gridDim.y * gridDim.z;
    unsigned sum, cnt, mine, sp = 0u;
    for (;;) {
        sum = 0u; cnt = 0u; mine = 0u;
#pragma unroll
        for (unsigned j = 0; j < 16; ++j) { const unsigned c = xb_ld(&bar[XB_XCNT(j)]); sum += c; cnt += (c > 0u) ? 1u : 0u; mine = (j == x) ? c : mine; }
        if (sum == G) break;
        __builtin_amdgcn_s_sleep(1);
        if ((++sp & 255u) == 0u) { if (xb_ld(&bar[XB_TMO])) break; if (sp > XB_SPIN_CAP) { atomicAdd(&bar[XB_TMO], 1u); break; } }
    }
    nloc = mine > 0u ? mine : 1u; nx = cnt > 0u ? cnt : 1u;
}
__device__ __forceinline__ void xcd_barrier(const XcdBarrier& b) {
    asm volatile("s_waitcnt vmcnt(0)" ::: "memory");
    __syncthreads();
    if (threadIdx.x == 0) {
        unsigned* bar = b.bar;
        __builtin_amdgcn_s_waitcnt(0);
        unsigned nloc = b.st[0], nx = b.st[1];
        if (nloc == 0u) { xcd_barrier_complete(bar, b.x, nloc, nx); b.st[0] = nloc; b.st[1] = nx; }
        const unsigned old = xb_add(&bar[XB_XSUB(b.x)], 1u);
        const unsigned gen = old / nloc;
        if (old + 1u == (gen + 1u) * nloc) {
            __builtin_amdgcn_fence(__ATOMIC_RELEASE, "agent");
            asm volatile("s_waitcnt vmcnt(0)" ::: "memory");
            const unsigned og = xb_add(&bar[XB_TOP], 1u);
            const unsigned tg = og / nx;
            if (og + 1u == (tg + 1u) * nx) xb_add(&bar[XB_TOPGEN], 1u);
            else XB_SPIN(xb_ld(&bar[XB_TOPGEN]) == tg, bar);
            __builtin_amdgcn_fence(__ATOMIC_ACQUIRE, "agent");
            xb_add(&bar[XB_XGEN(b.x)], 1u);
            asm volatile("s_waitcnt vmcnt(0)" ::: "memory");
        } else {
            XB_SPIN(xb_ld(&bar[XB_XGEN(b.x)]) == gen, bar);
            __builtin_amdgcn_fence(__ATOMIC_ACQUIRE, "agent");
            asm volatile("s_waitcnt vmcnt(0)" ::: "memory");
        }
    }
    __syncthreads();
}

__device__ __forceinline__ unsigned f2bf(float f) { unsigned u = __builtin_bit_cast(unsigned, f); return (u + 0x7fffu + ((u >> 16) & 1u)) >> 16; }
__device__ __forceinline__ unsigned pk2(float lo, float hi) { return f2bf(lo) | (f2bf(hi) << 16); }
__device__ __forceinline__ unsigned pk4_f8(float a, float b, float c, float d) {
    a = __builtin_amdgcn_fmed3f(a, -448.f, 448.f); b = __builtin_amdgcn_fmed3f(b, -448.f, 448.f); c = __builtin_amdgcn_fmed3f(c, -448.f, 448.f); d = __builtin_amdgcn_fmed3f(d, -448.f, 448.f);
    int w = 0; w = __builtin_amdgcn_cvt_pk_fp8_f32(a, b, w, false); w = __builtin_amdgcn_cvt_pk_fp8_f32(c, d, w, true); return (unsigned)w; }
constexpr float F8_HS = 8.f, F8_WS = 128.f, F8_MS = 64.f;
__device__ __forceinline__ float bflo(unsigned u) { return __builtin_bit_cast(float, u << 16); }
__device__ __forceinline__ float bfhi(unsigned u) { return __builtin_bit_cast(float, u & 0xffff0000u); }
__device__ __forceinline__ float bf2f(bf16 u) { return __builtin_bit_cast(float, (unsigned)u << 16); }
__device__ __forceinline__ float wave_sum(float v) {
#pragma unroll
    for (int o = 1; o < 64; o <<= 1) v += __shfl_xor(v, o);
    return v;
}
__device__ __forceinline__ float wave_max(float v) {
#pragma unroll
    for (int o = 1; o < 64; o <<= 1) v = fmaxf(v, __shfl_xor(v, o));
    return v;
}
__device__ __forceinline__ float sigmoidf(float x) { return __builtin_amdgcn_rcpf(1.f + __expf(-x)); }
__device__ __forceinline__ float gelu_tanh(float x) { const float u = 0.7978845608028654f * (x + 0.044715f * x * x * x); return 0.5f * x * (1.f + tanhf(u)); }
__device__ __forceinline__ int t5_bucket(int n) {
    if (n < 16) return n;
    int b = 16;
    b += (n >= 22); b += (n >= 30); b += (n >= 40); b += (n >= 54); b += (n >= 73); b += (n >= 99); b += (n >= 134); b += (n >= 182);
    b += (n >= 246); b += (n >= 332); b += (n >= 450); b += (n >= 609); b += (n >= 825); b += (n >= 1117); b += (n >= 1513);
    return b;
}

struct Args {
    const float* in[23];
    float* out; unsigned char* ws;
    int ph_lo, ph_hi;
};

typedef float f32x2v __attribute__((ext_vector_type(2)));
__device__ __forceinline__ void ph0_mod(const Args& a, LAS unsigned char* lds) {
    const int tid = phase_tid(), lane = tid & 63, wave = __builtin_amdgcn_readfirstlane(tid >> 6);
    LAS float* cs = (LAS float*)lds;
    LAS float* red = (LAS float*)(lds + 32768);
    const float* c = a.in[1]; const float* w_ada = a.in[2]; const float* b_ada = a.in[3];
    float* mod = (float*)(a.ws + WS_MOD);
    for (int i = tid; i < 4 * 2048; i += NTHREADS) { const float v = c[i]; cs[i] = v / (1.f + __expf(-v)); }
    __syncthreads();
    for (int u = blockIdx.x; u < 12288 / 128; u += gridDim.x) {
        const int col = u * 128 + 2 * lane;
        float acc[4][2];
#pragma unroll
        for (int b = 0; b < 4; ++b) { acc[b][0] = 0.f; acc[b][1] = 0.f; }
        const float* wp = w_ada + (size_t)(wave * 256) * 12288 + col;
#pragma unroll 1
        for (int k0 = 0; k0 < 256; k0 += 16) {
            f32x2v w[16];
#pragma unroll
            for (int k = 0; k < 16; ++k) w[k] = *(const f32x2v*)(wp + (size_t)(k0 + k) * 12288);
#pragma unroll
            for (int k = 0; k < 16; ++k) { const int kk = wave * 256 + k0 + k;
#pragma unroll
                for (int b = 0; b < 4; ++b) { const float cv = cs[b * 2048 + kk]; acc[b][0] += cv * w[k].x; acc[b][1] += cv * w[k].y; } }
        }
#pragma unroll
        for (int b = 0; b < 4; ++b) { red[(wave * 4 + b) * 128 + 2 * lane] = acc[b][0]; red[(wave * 4 + b) * 128 + 2 * lane + 1] = acc[b][1]; }
        __syncthreads();
        { const int b = tid >> 7, cc = tid & 127; float s = 0.f;
#pragma unroll
          for (int w = 0; w < 8; ++w) s += red[(w * 4 + b) * 128 + cc];
          mod[b * 12288 + u * 128 + cc] = s + b_ada[u * 128 + cc]; }
        __syncthreads();
    }
}
__device__ __forceinline__ void transpose_item(const float* W, int ldw, int ncols, int K, bf16* WT, int row_off, LAS float* scr, int item, int lane, int ldt = 0) {
    if (ldt == 0) ldt = K;
    const int nblk = ncols / 32, kb = item / nblk, nb = item % nblk, k0 = 64 * kb, n0 = 32 * nb;
    float tv[32];
#pragma unroll
    for (int i = 0; i < 32; ++i) tv[i] = W[(size_t)(k0 + 2 * i + (lane >> 5)) * ldw + n0 + (lane & 31)];
#pragma unroll
    for (int i = 0; i < 32; ++i) scr[(2 * i + (lane >> 5)) * 33 + (lane & 31)] = tv[i];
    asm volatile("s_waitcnt lgkmcnt(0)" ::: "memory");
    const int c = lane & 7;
#pragma unroll
    for (int j = 0; j < 4; ++j) { const int n = (lane >> 3) + 8 * j; const LAS float* s = scr + (8 * c) * 33 + n;
        v4u o; o.x = pk2(s[0 * 33], s[1 * 33]); o.y = pk2(s[2 * 33], s[3 * 33]); o.z = pk2(s[4 * 33], s[5 * 33]); o.w = pk2(s[6 * 33], s[7 * 33]);
        *(v4u*)(WT + (size_t)(row_off + n0 + n) * ldt + k0 + 8 * c) = o; }
    asm volatile("s_waitcnt lgkmcnt(0)" ::: "memory");
}
__device__ __forceinline__ void transpose_item_f8(const float* W, int ldw, int ncols, int K, unsigned char* WT, int row_off, LAS float* scr, int item, int lane) {
    const int nblk = ncols / 32, kb = item / nblk, nb = item % nblk, k0 = 64 * kb, n0 = 32 * nb;
    float tv[32];
#pragma unroll
    for (int i = 0; i < 32; ++i) tv[i] = W[(size_t)(k0 + 2 * i + (lane >> 5)) * ldw + n0 + (lane & 31)];
#pragma unroll
    for (int i = 0; i < 32; ++i) scr[(2 * i + (lane >> 5)) * 33 + (lane & 31)] = tv[i] * F8_WS;
    asm volatile("s_waitcnt lgkmcnt(0)" ::: "memory");
    const int c = lane & 7;
#pragma unroll
    for (int j = 0; j < 4; ++j) { const int n = (lane >> 3) + 8 * j; const LAS float* s = scr + (8 * c) * 33 + n;
        v2u o; o.x = pk4_f8(s[0 * 33], s[1 * 33], s[2 * 33], s[3 * 33]); o.y = pk4_f8(s[4 * 33], s[5 * 33], s[6 * 33], s[7 * 33]);
        *(v2u*)(WT + (size_t)(row_off + n0 + n) * K + k0 + 8 * c) = o; }
    asm volatile("s_waitcnt lgkmcnt(0)" ::: "memory");
}
__device__ __forceinline__ void ph0_weights(const Args& a, LAS unsigned char* lds) {
    const int tid = phase_tid(), lane = tid & 63, wave = __builtin_amdgcn_readfirstlane(tid >> 6);
    LAS float* scr = (LAS float*)(lds + wave * 16384);
    const int gw = blockIdx.x * NWAVES + wave, NGW = gridDim.x * NWAVES;
    const float* w_in = a.in[5];
    unsigned char* WIN = a.ws + WS_WIN;
    constexpr int I_Q = 32 * (NQ / 32), I_KV = 32 * (NKV / 32), I_DL = 32 * (NDL / 32), I_MG = 32 * (NMG / 32);
    constexpr int I_BN = 16 * 64, I_BD = 8 * 64, I_O = 32 * 64, I_PQ = 32 * 64;
    constexpr int NITEMS = I_Q + I_KV + I_DL + I_MG + I_BN + I_BD + I_O + I_PQ;
    for (int it = gw; it < NITEMS; it += NGW) {
        int r = it;
        if (r < I_Q)  { transpose_item_f8(w_in, IN_COLS, NQ, D, WIN, 0, scr, r, lane); continue; } r -= I_Q;
        if (r < I_KV) { transpose_item_f8(w_in + OFF_KV, IN_COLS, NKV, D, WIN, NQ, scr, r, lane); continue; } r -= I_KV;
        if (r < I_DL) { transpose_item_f8(w_in + OFF_DIL, IN_COLS, NDL, D, WIN, NQ + NKV, scr, r, lane); continue; } r -= I_DL;
        if (r < I_MG) { transpose_item_f8(w_in + OFF_MERGE, IN_COLS, NMG, D, WIN, NQ + NKV + NDL, scr, r, lane); continue; } r -= I_MG;
        if (r < I_BN) { transpose_item(a.in[13], D, D, 1024, (bf16*)(a.ws + WS_WBN), 0, scr, r, lane, 1536); continue; } r -= I_BN;
        if (r < I_BD) { transpose_item(a.in[14], D, D, 512, (bf16*)(a.ws + WS_WBN) + 1024, 0, scr, r, lane, 1536); continue; } r -= I_BD;
        if (r < I_O)  { transpose_item_f8(a.in[15], D, D, D, a.ws + WS_WOUT, 0, scr, r, lane); continue; } r -= I_O;
        transpose_item(a.in[17], D, D, D, (bf16*)(a.ws + WS_WPQ), 0, scr, r, lane);
    }
}

constexpr size_t WS_CW1F = 602 * MiB;
constexpr size_t WS_WGF = 604 * MiB;
constexpr size_t WS_CBP = 604 * MiB + 256 * 1024;
constexpr size_t WS_END4 = 605 * MiB;
__device__ __forceinline__ void ph0_extra(const Args& a) {
    const int tid = phase_tid(), lane = tid & 63, wave = __builtin_amdgcn_readfirstlane(tid >> 6);
    const float* w1 = a.in[9]; const float* pos = a.in[8]; const float* w_in = a.in[5];
    v4u* CW = (v4u*)(a.ws + WS_CW1F); v4u* WG = (v4u*)(a.ws + WS_WGF); float* CBP = (float*)(a.ws + WS_CBP);
    for (int i = blockIdx.x * NTHREADS + tid; i < 2 * 4 * 256 * 64; i += gridDim.x * NTHREADS) {
        const int ln = i & 63, ks = (i >> 6) & 255, nt = (i >> 14) & 3, j = i >> 16;
        const float* src = w1 + ((size_t)j * 4096 + 16 * ks + 8 * (ln >> 5)) * 128 + 32 * nt + (ln & 31);
        v4u o; o.x = pk2(src[0], src[128]); o.y = pk2(src[256], src[384]); o.z = pk2(src[512], src[640]); o.w = pk2(src[768], src[896]);
        CW[i] = o;
    }
    for (int i = blockIdx.x * NTHREADS + tid; i < 128 * 64; i += gridDim.x * NTHREADS) {
        const int ln = i & 63, ks = i >> 6, jrow = ln & 31;
        v4u o = {0u, 0u, 0u, 0u};
        if (jrow < 24) { const float* src = w_in + (size_t)(16 * ks + 8 * (ln >> 5)) * IN_COLS + OFF_GATE + jrow;
            o.x = pk2(src[0], src[IN_COLS]); o.y = pk2(src[2 * (size_t)IN_COLS], src[3 * (size_t)IN_COLS]); o.z = pk2(src[4 * (size_t)IN_COLS], src[5 * (size_t)IN_COLS]); o.w = pk2(src[6 * (size_t)IN_COLS], src[7 * (size_t)IN_COLS]); }
        WG[i] = o;
    }
    { const int gw = blockIdx.x * NWAVES + wave;
      if (gw < 128) { const int kc = gw >> 1, j = gw & 1; float s0 = 0.f, s1 = 0.f; const float* wp = w1 + ((size_t)j * 4096 + 64 * kc) * 128 + lane; const float* pp = pos + j * 4096 + 64 * kc;
#pragma unroll 1
          for (int k0 = 0; k0 < 64; k0 += 16) { float wa[16], wb[16];
#pragma unroll
              for (int k = 0; k < 16; ++k) { wa[k] = wp[(k0 + k) * 128]; wb[k] = wp[(k0 + k) * 128 + 64]; }
#pragma unroll
              for (int k = 0; k < 16; ++k) { const float pv = pp[k0 + k]; s0 += pv * wa[k]; s1 += pv * wb[k]; } }
          CBP[(kc * 2 + j) * 128 + lane] = s0; CBP[(kc * 2 + j) * 128 + 64 + lane] = s1; } }
}

template <bool F8 = false>
__device__ __forceinline__ void ph_norm(const Args& a, const float* xin, const float* gvec, int sh_off, int sc_off, bf16* hout, unsigned char* h8 = nullptr) {
    const int tid = phase_tid(), lane = tid & 63, wave = __builtin_amdgcn_readfirstlane(tid >> 6);
    const int gw = blockIdx.x * NWAVES + wave, NGW = gridDim.x * NWAVES;
    const float* mod = (const float*)(a.ws + WS_MOD);
    for (int r = gw; r < S / 2; r += NGW)
#pragma unroll 1
        for (int bq = 0; bq < NB; ++bq) {
            const int m0 = bq * S + r, m1 = m0 + S / 2;
            const float* x0 = xin + (size_t)m0 * D + 8 * lane; const float* x1 = xin + (size_t)m1 * D + 8 * lane;
            f32x4 v0[8], v1[8];
#pragma unroll
            for (int c = 0; c < 4; ++c) { v0[2 * c] = *(const f32x4*)(x0 + 512 * c); v0[2 * c + 1] = *(const f32x4*)(x0 + 512 * c + 4); v1[2 * c] = *(const f32x4*)(x1 + 512 * c); v1[2 * c + 1] = *(const f32x4*)(x1 + 512 * c + 4); }
            float s0 = 0.f, s1 = 0.f;
#pragma unroll
            for (int i = 0; i < 8; ++i) { s0 += (v0[i].x * v0[i].x + v0[i].y * v0[i].y) + (v0[i].z * v0[i].z + v0[i].w * v0[i].w); s1 += (v1[i].x * v1[i].x + v1[i].y * v1[i].y) + (v1[i].z * v1[i].z + v1[i].w * v1[i].w); }
            const float r0 = rsqrtf(wave_sum(s0) * (1.f / D) + EPS), r1 = rsqrtf(wave_sum(s1) * (1.f / D) + EPS);
            const float* shp = mod + bq * 12288 + sh_off + 8 * lane; const float* scp = mod + bq * 12288 + sc_off + 8 * lane; const float* gp = gvec + 8 * lane;
#pragma unroll
            for (int c = 0; c < 4; ++c) {
                v4u o0, o1; unsigned w0[4], w1[4]; [[maybe_unused]] unsigned q0[2], q1[2];
#pragma unroll
                for (int hq = 0; hq < 2; ++hq) { const f32x4 g = *(const f32x4*)(gp + 512 * c + 4 * hq), sc = *(const f32x4*)(scp + 512 * c + 4 * hq), sh = *(const f32x4*)(shp + 512 * c + 4 * hq);
                    const f32x4 ga = g * (1.f + sc); const f32x4 y0 = v0[2 * c + hq] * r0 * ga + sh, y1 = v1[2 * c + hq] * r1 * ga + sh;
                    w0[2 * hq] = pk2(y0.x, y0.y); w0[2 * hq + 1] = pk2(y0.z, y0.w); w1[2 * hq] = pk2(y1.x, y1.y); w1[2 * hq + 1] = pk2(y1.z, y1.w);
                    if constexpr (F8) { q0[hq] = pk4_f8(y0.x * F8_HS, y0.y * F8_HS, y0.z * F8_HS, y0.w * F8_HS); q1[hq] = pk4_f8(y1.x * F8_HS, y1.y * F8_HS, y1.z * F8_HS, y1.w * F8_HS); } }
                o0.x = w0[0]; o0.y = w0[1]; o0.z = w0[2]; o0.w = w0[3]; o1.x = w1[0]; o1.y = w1[1]; o1.z = w1[2]; o1.w = w1[3];
                *(v4u*)(hout + (size_t)m0 * D + 512 * c + 8 * lane) = o0; *(v4u*)(hout + (size_t)m1 * D + 512 * c + 8 * lane) = o1;
                if constexpr (F8) { v2u p0, p1; p0.x = q0[0]; p0.y = q0[1]; p1.x = q1[0]; p1.y = q1[1];
                    *(v2u*)(h8 + (size_t)m0 * D + 512 * c + 8 * lane) = p0; *(v2u*)(h8 + (size_t)m1 * D + 512 * c + 8 * lane) = p1; }
            }
        }
}

using pg8::Unit; using pg8::HALF; using pg8::BM;
struct EpiProj {
    static constexpr bool PERM = true;
    bf16 *q, *kv, *dl, *mg;
    __device__ __forceinline__ void operator()(const f32x4 (&acc)[2][2][4][2], const Unit& u, int wr, int wc, int fr, int fq) const {
        bf16* base; int ldc, colt = u.pn * BM;
        if (colt < NQ) { base = q; ldc = NQ; } else if (colt < NQ + NKV) { base = kv; ldc = NKV; colt -= NQ; } else if (colt < NQ + NKV + NDL) { base = dl; ldc = NDL; colt -= NQ + NKV; } else { base = mg; ldc = NMG; colt -= NQ + NKV + NDL; }
        const int row0 = u.pm * BM + wr * 64 + fr, col0 = colt + wc * 32 + 8 * fq;
#pragma unroll
        for (int ai = 0; ai < 2; ++ai)
#pragma unroll
            for (int m = 0; m < 4; ++m) { bf16* rowp = base + (size_t)(row0 + ai * HALF + m * 16) * ldc + col0;
#pragma unroll
                for (int bj = 0; bj < 2; ++bj) { const f32x4 v0 = acc[ai][bj][m][0], v1 = acc[ai][bj][m][1];
                    v4u w; w.x = pg8::cvt_pk_bf16(v0[0], v0[1]); w.y = pg8::cvt_pk_bf16(v0[2], v0[3]); w.z = pg8::cvt_pk_bf16(v1[0], v1[1]); w.w = pg8::cvt_pk_bf16(v1[2], v1[3]);
                    *(v4u*)(rowp + bj * HALF) = w; } }
    }
};
struct MidMerge {
    static constexpr int AT = 16;
    const bf16* mg;
    __device__ __forceinline__ void operator()(f32x4 (&acc)[2][2][4][2], const Unit& u, int wr, int wc, int fr, int fq) const {
        int lo = (fq * 16 + fr) * 8;
        asm volatile("" : "+v"(lo));
        const bf16* t1 = mg + (((size_t)(u.pm * 16 + u.pn) * 8 + (wr * 4 + wc)) << 13) + lo; const bf16* t2 = t1 + ((size_t)8 << 16);
#pragma unroll
        for (int ai = 0; ai < 2; ++ai) {
            v4u a1[4][2], a2[4][2];
#pragma unroll
            for (int m = 0; m < 4; ++m)
#pragma unroll
                for (int bj = 0; bj < 2; ++bj) { a1[m][bj] = *(const v4u*)(t1 + ((ai * 4 + m) * 2 + bj) * 512); a2[m][bj] = *(const v4u*)(t2 + ((ai * 4 + m) * 2 + bj) * 512); }
#pragma unroll
            for (int m = 0; m < 4; ++m)
#pragma unroll
                for (int bj = 0; bj < 2; ++bj) { const unsigned w1[4] = {a1[m][bj].x, a1[m][bj].y, a1[m][bj].z, a1[m][bj].w}, w2[4] = {a2[m][bj].x, a2[m][bj].y, a2[m][bj].z, a2[m][bj].w};
#pragma unroll
                    for (int q = 0; q < 4; ++q) { const float r0 = (1.f + __expf(-bflo(w2[q]))) * __builtin_amdgcn_rcpf(1.f + __expf(-bflo(w1[q]))), r1 = (1.f + __expf(-bfhi(w2[q]))) * __builtin_amdgcn_rcpf(1.f + __expf(-bfhi(w1[q])));
                        acc[ai][bj][m][q >> 1][2 * (q & 1)] *= r0; acc[ai][bj][m][q >> 1][2 * (q & 1) + 1] *= r1; } }
            asm volatile("" ::: "memory");
        }
    }
};
struct EpiMerge {
    static constexpr bool PERM = true;
    const bf16* mg; unsigned char* merged8; float os;
    __device__ __forceinline__ void operator()(const f32x4 (&acc)[2][2][4][2], const Unit& u, int wr, int wc, int fr, int fq) const {
        int row0 = u.pm * BM + wr * 64 + fr; const int col0 = u.pn * BM + wc * 32 + 8 * fq;
        asm volatile("" : "+v"(row0));
        const bf16* t2 = mg + (((size_t)(u.pm * 16 + 8 + u.pn) * 8 + (wr * 4 + wc)) << 13) + (fq * 16 + fr) * 8;
        v4u a2[2][4][2];
#pragma unroll
        for (int ai = 0; ai < 2; ++ai)
#pragma unroll
            for (int m = 0; m < 4; ++m)
#pragma unroll
                for (int bj = 0; bj < 2; ++bj) a2[ai][m][bj] = *(const v4u*)(t2 + ((ai * 4 + m) * 2 + bj) * 512);
#pragma unroll
        for (int ai = 0; ai < 2; ++ai)
#pragma unroll
            for (int m = 0; m < 4; ++m) { const size_t row = (size_t)(row0 + ai * HALF + m * 16);
#pragma unroll
                for (int bj = 0; bj < 2; ++bj) { const unsigned w2[4] = {a2[ai][m][bj].x, a2[ai][m][bj].y, a2[ai][m][bj].z, a2[ai][m][bj].w};
                    const f32x4 v0 = acc[ai][bj][m][0] * os, v1 = acc[ai][bj][m][1] * os;
                    v2u w; w.x = pk4_f8(v0[0] * sigmoidf(bflo(w2[0])), v0[1] * sigmoidf(bfhi(w2[0])), v0[2] * sigmoidf(bflo(w2[1])), v0[3] * sigmoidf(bfhi(w2[1])));
                    w.y = pk4_f8(v1[0] * sigmoidf(bflo(w2[2])), v1[1] * sigmoidf(bfhi(w2[2])), v1[2] * sigmoidf(bflo(w2[3])), v1[3] * sigmoidf(bfhi(w2[3])));
                    *(v2u*)(merged8 + row * D + col0 + bj * HALF) = w; } }
    }
};
struct EpiOut {
    static constexpr bool PERM = false;
    const float* x; const float* mod; float* x1; float as;
    __device__ __forceinline__ void operator()(const f32x4 (&acc)[2][2][4][2], const Unit& u, int wr, int wc, int fr, int fq) const {
        const int row0 = u.pm * BM + wr * 64 + fr, col0 = u.pn * BM + wc * 32 + 4 * fq;
        const int b = (u.pm * BM) / S;
        f32x4 gv[2][2];
#pragma unroll
        for (int bj = 0; bj < 2; ++bj)
#pragma unroll
            for (int n = 0; n < 2; ++n) gv[bj][n] = *(const f32x4*)(mod + b * 12288 + 4096 + col0 + bj * HALF + n * 16) * as;
#pragma unroll
        for (int ai = 0; ai < 2; ++ai)
#pragma unroll
            for (int m = 0; m < 4; ++m) { const size_t off = (size_t)(row0 + ai * HALF + m * 16) * D + col0;
#pragma unroll
                for (int bj = 0; bj < 2; ++bj)
#pragma unroll
                    for (int n = 0; n < 2; ++n) *(f32x4*)(x1 + off + bj * HALF + n * 16) = *(const f32x4*)(x + off + bj * HALF + n * 16) + gv[bj][n] * acc[ai][bj][m][n]; }
    }
};
struct EpiF32 {
    static constexpr bool PERM = false;
    float* C; int ldc;
    __device__ __forceinline__ void operator()(const f32x4 (&acc)[2][2][4][2], const Unit& u, int wr, int wc, int fr, int fq) const {
        const int row0 = u.pm * BM + wr * 64 + fr, col0 = u.pn * BM + wc * 32 + 4 * fq;
#pragma unroll
        for (int ai = 0; ai < 2; ++ai)
#pragma unroll
            for (int m = 0; m < 4; ++m) { float* rowp = C + (size_t)(row0 + ai * HALF + m * 16) * ldc + col0;
#pragma unroll
                for (int bj = 0; bj < 2; ++bj)
#pragma unroll
                    for (int n = 0; n < 2; ++n) *(f32x4*)(rowp + bj * HALF + n * 16) = acc[ai][bj][m][n]; }
    }
};

typedef short bf16x8 __attribute__((ext_vector_type(8)));
typedef float f32x16 __attribute__((ext_vector_type(16)));
typedef float f32x2 __attribute__((ext_vector_type(2)));
typedef __bf16 bf2v __attribute__((ext_vector_type(2)));
constexpr float LOG2E = 1.4426950408889634f;
constexpr float QS2 = QSCALE * LOG2E;
constexpr float NEGB = -1e30f;
__device__ __forceinline__ unsigned pkbf(float a, float b) { const f32x2 v = {a, b}; const bf2v r = __builtin_convertvector(v, bf2v); return __builtin_bit_cast(unsigned, r); }
__device__ __forceinline__ float ex2(float x) { return __builtin_amdgcn_exp2f(x); }
__device__ __forceinline__ int swap23(int x) { return (x & ~12) | ((x & 4) << 1) | ((x & 8) >> 1); }
__device__ __forceinline__ size_t kf_off(int key, int d) { return ((size_t)((key >> 5) * 8 + (d >> 4)) * 64 + ((d >> 3) & 1) * 32 + swap23(key & 31)) * 8 + (d & 7); }
__device__ __forceinline__ size_t vf_off(int key, int d) { const int kk = key & 31; return ((size_t)(((key >> 5) * 4 + (d >> 5)) * 2 + (kk >> 4)) * 64 + ((kk >> 3) & 1) * 32 + (d & 31)) * 8 + (kk & 7); }
__device__ __forceinline__ bf16* fr_nsa(const Args& a, int bg, int kind) { return (bf16*)a.out + ((size_t)(bg * 4 + kind) << 19); }
__device__ __forceinline__ bf16* fr_dil(const Args& a, int b, int head, int kv) { return (bf16*)a.out + ((size_t)16 << 20) + ((size_t)((b * 12 + head) * 2 + kv) << 19); }
constexpr size_t WS_OD = 552 * MiB;
constexpr size_t WS_LSE = 600 * MiB;
constexpr size_t WS_END2 = 601 * MiB;

struct EpiProjNorm {
    static constexpr bool PERM = true;
    bf16 *q, *kv, *dl, *mg, *frg;
    const float *qg, *kg, *dqg, *dkg;
    LAS float* xch;
    float as;
    __device__ __forceinline__ void operator()(const f32x4 (&acc)[2][2][4][2], const Unit& u, int wr, int wc, int fr, int fq) const {
        bf16* base; int ldc, colt = u.pn * BM, mode = 0  , hsel = 0; const float* gain = qg; float scale = 1.f;
        if (colt < NQ) { base = q; ldc = NQ; mode = 1; gain = qg; scale = QS2; }
        else if (colt < NQ + NKV) { base = kv; ldc = NKV; colt -= NQ; hsel = colt >> 7; if (hsel == 4 || hsel == 8) { mode = 2; gain = kg + (hsel == 4 ? 128 : 256); } }
        else if (colt < NQ + NKV + NDL) { base = dl; ldc = NDL; colt -= NQ + NKV; hsel = colt >> 7; if (hsel < 12) { mode = 1; gain = dqg; scale = QS2; } else if (hsel < 24) { mode = 3; gain = dkg; } }
        else { base = mg; ldc = NMG; colt -= NQ + NKV + NDL; }
        const int row0 = u.pm * BM + wr * 64 + fr, col0 = colt + wc * 32 + 8 * fq;
        if (base == mg) {
            bf16* tp = mg + (((size_t)(u.pm * 16 + (colt >> 8)) * 8 + (wr * 4 + wc)) << 13) + (fq * 16 + fr) * 8;
#pragma unroll
            for (int ai = 0; ai < 2; ++ai)
#pragma unroll
                for (int m = 0; m < 4; ++m)
#pragma unroll
                    for (int bj = 0; bj < 2; ++bj) { const f32x4 v0 = acc[ai][bj][m][0] * as, v1 = acc[ai][bj][m][1] * as;
                        v4u w; w.x = pg8::cvt_pk_bf16(v0[0], v0[1]); w.y = pg8::cvt_pk_bf16(v0[2], v0[3]); w.z = pg8::cvt_pk_bf16(v1[0], v1[1]); w.w = pg8::cvt_pk_bf16(v1[2], v1[3]);
                        *(v4u*)(tp + ((ai * 4 + m) * 2 + bj) * 512) = w; }
            return;
        }
        if (mode == 0) {
#pragma unroll
            for (int ai = 0; ai < 2; ++ai)
#pragma unroll
                for (int m = 0; m < 4; ++m) { bf16* rowp = base + (size_t)(row0 + ai * HALF + m * 16) * ldc + col0;
#pragma unroll
                    for (int bj = 0; bj < 2; ++bj) { const f32x4 v0 = acc[ai][bj][m][0] * as, v1 = acc[ai][bj][m][1] * as;
                        v4u w; w.x = pg8::cvt_pk_bf16(v0[0], v0[1]); w.y = pg8::cvt_pk_bf16(v0[2], v0[3]); w.z = pg8::cvt_pk_bf16(v1[0], v1[1]); w.w = pg8::cvt_pk_bf16(v1[2], v1[3]);
                        *(v4u*)(rowp + bj * HALF) = w; } }
            return;
        }
#pragma unroll
        for (int ai = 0; ai < 2; ++ai)
#pragma unroll
            for (int m = 0; m < 4; ++m)
#pragma unroll
                for (int bj = 0; bj < 2; ++bj) { const f32x4 v0 = acc[ai][bj][m][0], v1 = acc[ai][bj][m][1];
                    float ss = (v0[0] * v0[0] + v0[1] * v0[1]) + (v0[2] * v0[2] + v0[3] * v0[3]) + (v1[0] * v1[0] + v1[1] * v1[1]) + (v1[2] * v1[2] + v1[3] * v1[3]);
                    ss += __shfl_xor(ss, 16); ss += __shfl_xor(ss, 32);
                    if (fq == 0) xch[(((((wr * 2 + ai) * 4 + m) * 16 + fr) * 2 + bj) << 2) + wc] = ss; }
        asm volatile("s_waitcnt lgkmcnt(0)" ::: "memory");
        __builtin_amdgcn_s_barrier();
        asm volatile("" ::: "memory");
        const f32x4 ga = *(const f32x4*)(gain + wc * 32 + 8 * fq), gb = *(const f32x4*)(gain + wc * 32 + 8 * fq + 4);
#pragma unroll
        for (int ai = 0; ai < 2; ++ai)
#pragma unroll
            for (int m = 0; m < 4; ++m) { const int t = row0 + ai * HALF + m * 16, b = t / S, s = t % S;
#pragma unroll
                for (int bj = 0; bj < 2; ++bj) { const f32x4 pp = *(const LAS f32x4*)(xch + (((((wr * 2 + ai) * 4 + m) * 16 + fr) * 2 + bj) << 2));
                    const float rstd = rsqrtf(((pp.x + pp.y) + (pp.z + pp.w)) * (as * as * (1.f / 128.f)) + EPS) * (scale * as);
                    const f32x4 v0 = acc[ai][bj][m][0] * rstd * ga, v1 = acc[ai][bj][m][1] * rstd * gb;
                    v4u w; w.x = pg8::cvt_pk_bf16(v0[0], v0[1]); w.y = pg8::cvt_pk_bf16(v0[2], v0[3]); w.z = pg8::cvt_pk_bf16(v1[0], v1[1]); w.w = pg8::cvt_pk_bf16(v1[2], v1[3]);
                    bf16* dst;
                    if (mode == 1) dst = base + (size_t)t * ldc + col0 + bj * HALF;
                    else if (mode == 2) dst = frg + ((size_t)((b * 2 + bj) * 4 + (hsel == 4 ? 0 : 2)) << 19) + kf_off(s, wc * 32 + 8 * fq);
                    else { const int head = hsel - 12 + bj, dsh = 2 * (head >> 2), vk = ((s & ((1 << dsh) - 1)) << (12 - dsh)) + (s >> dsh);
                        dst = frg + ((size_t)16 << 20) + ((size_t)((b * 12 + head) * 2) << 19) + kf_off(vk, wc * 32 + 8 * fq); }
                    *(v4u*)dst = w; } }
    }
};

__device__ __forceinline__ v4u norm_chunk16v(v4u w, const float* gain, float scale, int li) {
    float v[8] = {bflo(w.x), bfhi(w.x), bflo(w.y), bfhi(w.y), bflo(w.z), bfhi(w.z), bflo(w.w), bfhi(w.w)};
    float ss = 0.f;
#pragma unroll
    for (int j = 0; j < 8; ++j) ss += v[j] * v[j];
    ss += __shfl_xor(ss, 1); ss += __shfl_xor(ss, 2); ss += __shfl_xor(ss, 4); ss += __shfl_xor(ss, 8);
    const float rstd = rsqrtf(ss * (1.f / 128.f) + EPS) * scale;
#pragma unroll
    for (int j = 0; j < 8; ++j) v[j] = v[j] * rstd * gain[8 * li + j];
    w.x = pk2(v[0], v[1]); w.y = pk2(v[2], v[3]); w.z = pk2(v[4], v[5]); w.w = pk2(v[6], v[7]);
    return w;
}
__device__ __forceinline__ void ph3_headnorm(const Args& a) {
    const int tid = phase_tid(), lane = tid & 63, wave = __builtin_amdgcn_readfirstlane(tid >> 6), sub = lane >> 4, li = lane & 15;
    const int gw = blockIdx.x * NWAVES + wave, NGW = gridDim.x * NWAVES;
    bf16* Q = (bf16*)(a.ws + WS_Q); const bf16* KV = (const bf16*)(a.ws + WS_KV); bf16* DL = (bf16*)(a.ws + WS_DL);
    const float* qg = a.in[6]; const float* kg = a.in[7]; const float* dqg = a.in[11]; const float* dkg = a.in[12];
    for (int m = gw; m < T; m += NGW) {
        const int b = m / S, s = m % S;
        const int g = sub & 1, win = sub >> 1;
        v4u wq[2], wk, wd[6];
#pragma unroll
        for (int it = 0; it < 2; ++it) wq[it] = *(const v4u*)(Q + (size_t)m * NQ + (it * 4 + sub) * 128 + 8 * li);
        wk = *(const v4u*)(KV + (size_t)m * NKV + ((win ? 8 : 4) + g) * 128 + 8 * li);
#pragma unroll
        for (int it = 0; it < 6; ++it) wd[it] = *(const v4u*)(DL + (size_t)m * NDL + (it * 4 + sub) * 128 + 8 * li);
#pragma unroll
        for (int it = 0; it < 2; ++it) *(v4u*)(Q + (size_t)m * NQ + (it * 4 + sub) * 128 + 8 * li) = norm_chunk16v(wq[it], qg, QS2, li);
        *(v4u*)(fr_nsa(a, b * 2 + g, win ? 2 : 0) + kf_off(s, 8 * li)) = norm_chunk16v(wk, kg + (win ? 256 : 128), 1.f, li);
#pragma unroll
        for (int it = 0; it < 6; ++it) { const int ch = it * 4 + sub;
            if (ch < 12) *(v4u*)(DL + (size_t)m * NDL + ch * 128 + 8 * li) = norm_chunk16v(wd[it], dqg, QS2, li);
            else { const int head = ch - 12, gi = head >> 2, dsh = 2 * gi  , vk = ((s & ((1 << dsh) - 1)) << (12 - dsh)) + (s >> dsh);
                *(v4u*)(fr_dil(a, b, head, 0) + kf_off(vk, 8 * li)) = norm_chunk16v(wd[it], dkg, 1.f, li); } }
    }
}
__device__ __forceinline__ void ph3_vfrag(const Args& a) {
    const int tid = phase_tid(), lane = tid & 63, wave = __builtin_amdgcn_readfirstlane(tid >> 6);
    const int gw = blockIdx.x * NWAVES + wave, NGW = gridDim.x * NWAVES;
    const bf16* KV = (const bf16*)(a.ws + WS_KV); const bf16* DL = (const bf16*)(a.ws + WS_DL);
    for (int job = gw; job < 32768; job += NGW) {
        const bf16* src; size_t rstride; bf16* dst; int key0;
        if (job < 8192) { const int bg = job >> 10, kind = (job >> 9) & 1, s0 = (job & 511) * 8, b = bg >> 1, g = bg & 1;
            src = KV + (size_t)(b * S + s0) * NKV + ((kind ? 10 : 6) + g) * 128; rstride = NKV; dst = fr_nsa(a, bg, kind ? 3 : 1); key0 = s0; }
        else { const int j2 = job - 8192, bh = j2 >> 9, vk0 = (j2 & 511) * 8, b = bh / 12, head = bh % 12, gi = head >> 2, dsh = 2 * gi, L = S >> dsh, r = vk0 / L, m0 = vk0 % L;
            src = DL + (size_t)(b * S + (m0 << dsh) + r) * NDL + (24 + head) * 128; rstride = (size_t)NDL << dsh; dst = fr_dil(a, b, head, 1); key0 = vk0; }
        unsigned w[8];
#pragma unroll
        for (int jj = 0; jj < 8; ++jj) w[jj] = *(const unsigned*)(src + jj * rstride + 2 * lane);
        v4u c0, c1;
        c0.x = (w[0] & 0xffffu) | (w[1] << 16); c0.y = (w[2] & 0xffffu) | (w[3] << 16); c0.z = (w[4] & 0xffffu) | (w[5] << 16); c0.w = (w[6] & 0xffffu) | (w[7] << 16);
        c1.x = (w[0] >> 16) | (w[1] & 0xffff0000u); c1.y = (w[2] >> 16) | (w[3] & 0xffff0000u); c1.z = (w[4] >> 16) | (w[5] & 0xffff0000u); c1.w = (w[6] >> 16) | (w[7] & 0xffff0000u);
        *(v4u*)(dst + vf_off(key0, 2 * lane)) = c0; *(v4u*)(dst + vf_off(key0, 2 * lane + 1)) = c1;
    }
}
__device__ __forceinline__ void ph3_gates(const Args& a) {
    const int tid = phase_tid(), lane = tid & 63, wave = __builtin_amdgcn_readfirstlane(tid >> 6), tl = lane & 31, hh = lane >> 5;
    const int gw = (gridDim.x - 1 - blockIdx.x) * NWAVES + wave, NGW = gridDim.x * NWAVES;
    const bf16* H = (const bf16*)(a.ws + WS_H); const v4u* WG = (const v4u*)(a.ws + WS_WGF) + lane; float* gates = (float*)(a.ws + WS_GATES);
    for (int job = gw; job < T / 32; job += NGW) {
        const int t = job * 32 + tl; const bf16* hr = H + (size_t)t * D + 8 * hh;
        f32x16 acc;
#pragma unroll
        for (int i = 0; i < 16; ++i) acc[i] = 0.f;
#pragma unroll 4
        for (int ks = 0; ks < 128; ++ks) { const bf16x8 af = __builtin_bit_cast(bf16x8, WG[ks * 64]), bfr = __builtin_bit_cast(bf16x8, *(const v4u*)(hr + 16 * ks));
            acc = __builtin_amdgcn_mfma_f32_32x32x16_bf16(af, bfr, acc, 0, 0, 0); }
#pragma unroll
        for (int i = 0; i < 16; ++i) { const int j = (i & 3) + 8 * (i >> 2) + 4 * hh; const float v = acc[i]; if (j < 24) gates[(size_t)t * 24 + j] = sigmoidf(v); }
    }
}
__device__ __forceinline__ void ph3_compress(const Args& a, LAS unsigned char* lds) {
    const int tid = phase_tid(), lane = tid & 63, wave = __builtin_amdgcn_readfirstlane(tid >> 6), cl = lane & 31, hh = lane >> 5;
    LAS float* part = (LAS float*)lds;
    LAS float* hid = part + 2 * 128 * 32;
    LAS float* ob = hid + 32 * 128;
    LAS float* bias = ob + 32 * 128;
    const bf16* KV = (const bf16*)(a.ws + WS_KV);
    const float* w2 = a.in[10]; const float* kg0 = a.in[7]; const float* CBP = (const float*)(a.ws + WS_CBP);
    for (int u = blockIdx.x; u < 128; u += gridDim.x) {
        const int j = u >> 6, bg = (u >> 3) & 7, ct = u & 7, b = bg >> 1, g = bg & 1, c0 = 32 * ct, hhd = j * 2 + g;
        if (tid < 128) { float s = 0.f;
#pragma unroll
            for (int kc = 0; kc < 64; ++kc) s += CBP[(kc * 2 + j) * 128 + tid];
            bias[tid] = s; }
        { const int nt = wave & 3, kh = wave >> 2, c = c0 + cl;
          const v4u* af = (const v4u*)(a.ws + WS_CW1F) + ((size_t)(j * 4 + nt) * 256 + 128 * kh) * 64 + lane;
          f32x16 acc;
#pragma unroll
          for (int i = 0; i < 16; ++i) acc[i] = 0.f;
#pragma unroll 4
          for (int ks = 0; ks < 128; ++ks) { const int k = 16 * (128 * kh + ks) + 8 * hh, l = k >> 7, d = k & 127, p = 16 * c + l;
              v4u x = {0u, 0u, 0u, 0u}; if (p < S) x = *(const v4u*)(KV + (size_t)(b * S + p) * NKV + hhd * 128 + d);
              acc = __builtin_amdgcn_mfma_f32_32x32x16_bf16(__builtin_bit_cast(bf16x8, af[ks * 64]), __builtin_bit_cast(bf16x8, x), acc, 0, 0, 0); }
#pragma unroll
          for (int i = 0; i < 16; ++i) { const int n = 32 * nt + (i & 3) + 8 * (i >> 2) + 4 * hh; const float v = acc[i]; part[(kh * 128 + n) * 32 + cl] = v; } }
        __syncthreads();
        for (int i = tid; i < 128 * 32; i += NTHREADS) { const int n = i >> 5, c = i & 31; hid[c * 128 + n] = gelu_tanh(part[i] + part[128 * 32 + i] + bias[n]); }
        __syncthreads();
        { const int n = tid & 127, cq = tid >> 7; float o[8];
#pragma unroll
          for (int r = 0; r < 8; ++r) o[r] = 0.f;
          const float* w2p = w2 + j * 128 * 128 + n;
          for (int k = 0; k < 128; ++k) { const float w = w2p[k * 128];
#pragma unroll
              for (int r = 0; r < 8; ++r) o[r] += hid[(8 * cq + r) * 128 + k] * w; }
#pragma unroll
          for (int r = 0; r < 8; ++r) ob[(8 * cq + r) * 128 + n] = o[r]; }
        __syncthreads();
        bf16* fr = (bf16*)(a.ws + (j == 0 ? WS_KC : WS_VC)) + (size_t)bg * 8 * 4096;
#pragma unroll 1
        for (int r = 0; r < 4; ++r) { const int cr = 4 * wave + r, c = c0 + cr; float v0 = ob[cr * 128 + 2 * lane], v1 = ob[cr * 128 + 2 * lane + 1];
            if (j == 0) { const float rstd = rsqrtf(wave_sum(v0 * v0 + v1 * v1) * (1.f / 128.f) + EPS); v0 = v0 * rstd * kg0[2 * lane]; v1 = v1 * rstd * kg0[2 * lane + 1]; }
            if (c >= NC) { v0 = 0.f; v1 = 0.f; }
            if (j == 0) *(unsigned*)(fr + kf_off(c, 2 * lane)) = pk2(v0, v1);
            else { fr[vf_off(c, 2 * lane)] = (bf16)f2bf(v0); fr[vf_off(c, 2 * lane + 1)] = (bf16)f2bf(v1); } }
        __syncthreads();
    }
}

#define KBI(i) (16 * ((i) >> 3) + ((i) & 7))
__device__ __forceinline__ void load_frags(bf16x8 (&f)[8], const v4u* p, int lane) {
#pragma unroll
    for (int i = 0; i < 8; ++i) f[i] = __builtin_bit_cast(bf16x8, p[i * 64 + lane]);
}
__device__ __forceinline__ f32x16 qk_mma(const bf16x8 (&qf)[8], const bf16x8 (&k)[8]) {
    f32x16 s;
#pragma unroll
    for (int i = 0; i < 16; ++i) s[i] = 0.f;
#pragma unroll
    for (int st = 0; st < 8; ++st) s = __builtin_amdgcn_mfma_f32_32x32x16_bf16(k[st], qf[st], s, 0, 0, 0);
    return s;
}
__device__ __forceinline__ f32x16 qk_tile(const bf16x8 (&qf)[8], const v4u* kf, int lane) { bf16x8 k[8]; load_frags(k, kf, lane); return qk_mma(qf, k); }
template <int STRIDE> __device__ __forceinline__ void add_tbl(f32x16& s, const LAS float* tp2, float pen) {
#pragma unroll
    for (int i = 0; i < 16; ++i) s[i] += tp2[STRIDE * (23 - KBI(i))] + pen;
}
__device__ __forceinline__ void mask_hi(f32x16& s, int lim) {
#pragma unroll
    for (int i = 0; i < 16; ++i) s[i] = (KBI(i) <= lim) ? s[i] : NEGB;
}
__device__ __forceinline__ void mask_lo(f32x16& s, int lim) {
#pragma unroll
    for (int i = 0; i < 16; ++i) s[i] = (KBI(i) >= lim) ? s[i] : NEGB;
}
__device__ __forceinline__ float max16(const f32x16& s) {
    float mx = fmaxf(s[0], s[1]);
#pragma unroll
    for (int i = 2; i < 16; ++i) mx = fmaxf(mx, s[i]);
    return fmaxf(mx, __shfl_xor(mx, 32));
}
__device__ __forceinline__ void pv_tile(const f32x16& p, f32x16 (&o)[4], const bf16x8 (&v)[8]) {
    v4u a0, a1;
    a0.x = pkbf(p[0], p[1]); a0.y = pkbf(p[2], p[3]); a0.z = pkbf(p[4], p[5]); a0.w = pkbf(p[6], p[7]);
    a1.x = pkbf(p[8], p[9]); a1.y = pkbf(p[10], p[11]); a1.z = pkbf(p[12], p[13]); a1.w = pkbf(p[14], p[15]);
    const bf16x8 pb0 = __builtin_bit_cast(bf16x8, a0), pb1 = __builtin_bit_cast(bf16x8, a1);
#pragma unroll
    for (int dt = 0; dt < 4; ++dt) { o[dt] = __builtin_amdgcn_mfma_f32_32x32x16_bf16(v[2 * dt], pb0, o[dt], 0, 0, 0); o[dt] = __builtin_amdgcn_mfma_f32_32x32x16_bf16(v[2 * dt + 1], pb1, o[dt], 0, 0, 0); }
}
__device__ __forceinline__ void softmax_pv(f32x16& s, f32x16 (&o)[4], float& m, float& l, const v4u* vf, int lane) {
    bf16x8 v[8];
#pragma unroll
    for (int i = 0; i < 8; ++i) v[i] = __builtin_bit_cast(bf16x8, vf[i * 64 + lane]);
    const float mn = fmaxf(m, max16(s));
    if (__ballot(mn > m + 8.f)) {
        const float corr = ex2(m - mn);
#pragma unroll
        for (int dt = 0; dt < 4; ++dt)
#pragma unroll
            for (int i = 0; i < 16; ++i) o[dt][i] *= corr;
        l *= corr; m = mn;
    }
    float ps = 0.f;
#pragma unroll
    for (int i = 0; i < 16; ++i) { s[i] = ex2(s[i] - m); ps += s[i]; }
    l += ps;
    pv_tile(s, o, v);
}
template <int NP = 0> __device__ __forceinline__ void softmax_pv_v(f32x16& s, f32x16 (&o)[4], float& m, float& l, const bf16x8 (&v)[8]) {
    if (NP == 2) { l += s[0]; pv_tile(s, o, v); return; }
    const float mn = fmaxf(m, max16(s));
    if (__ballot(mn > m + 8.f)) {
        const float corr = ex2(m - mn);
#pragma unroll
        for (int dt = 0; dt < 4; ++dt)
#pragma unroll
            for (int i = 0; i < 16; ++i) o[dt][i] *= corr;
        l *= corr; m = mn;
    }
    float ps = 0.f;
#pragma unroll
    for (int i = 0; i < 16; ++i) { s[i] = ex2(s[i] - m); ps += s[i]; }
    l += ps;
    pv_tile(s, o, v);
}
__device__ __forceinline__ void zero_o(f32x16 (&o)[4]) {
#pragma unroll
    for (int dt = 0; dt < 4; ++dt)
#pragma unroll
        for (int i = 0; i < 16; ++i) o[dt][i] = 0.f;
}
__device__ __forceinline__ void y_update(bf16* yp  , const f32x16 (&o)[4], float sc, bool acc) {
#pragma unroll
    for (int dt = 0; dt < 4; ++dt)
#pragma unroll
        for (int i4 = 0; i4 < 4; ++i4) { bf16* p = yp + 32 * dt + 8 * i4;
            float v0 = o[dt][4 * i4] * sc, v1 = o[dt][4 * i4 + 1] * sc, v2 = o[dt][4 * i4 + 2] * sc, v3 = o[dt][4 * i4 + 3] * sc;
            if (acc) { const v2u w = *(const v2u*)p; v0 += bflo(w.x); v1 += bfhi(w.x); v2 += bflo(w.y); v3 += bfhi(w.y); }
            v2u w; w.x = pkbf(v0, v1); w.y = pkbf(v2, v3); *(v2u*)p = w; }
}
constexpr int TBLN = 2624;
constexpr int OFF_TBL = 0, OFF_IMP = 43008, OFF_SELM = OFF_IMP + 65536, OFF_DTBL = OFF_SELM + 512;
constexpr int FAR_DIST = 1513;

template <int NP> __device__ __forceinline__ void nsa_unit(const Args& a, LAS unsigned char* lds, int u, int tid) {
    const int lane = tid & 63, wave = __builtin_amdgcn_readfirstlane(tid >> 6);
    const int qb = u >> 3, bg = u & 7, b = bg >> 1, g = bg & 1;
    const int r = wave >> 1, qs = wave & 1, hd = g * 4 + r, ql = lane & 31, h = lane >> 5;
    const int q0w = 64 * qb + 32 * qs, sq = q0w + ql, t = b * S + sq;
    LAS float* tball = (LAS float*)(lds + OFF_TBL);
    LAS float* imp = (LAS float*)(lds + OFF_IMP);
    LAS unsigned long long* selm = (LAS unsigned long long*)(lds + OFF_SELM);
    const float* relb = a.in[22];
    for (int i = tid; i < 4 * TBLN; i += NTHREADS) { const int hh = i / TBLN, dd = i % TBLN - 64; tball[i] = dd >= 0 ? relb[(g * 4 + hh) * 32 + t5_bucket(dd)] * LOG2E : 0.f; }
    for (int i = tid; i < 4 * 64 * 64; i += NTHREADS) imp[i] = 0.f;
    __syncthreads();
    const LAS float* tbl = tball + r * TBLN + 64;
    const float farc = relb[hd * 32 + 31] * LOG2E;
    bf16x8 qf[8];
    { const bf16* qrow = (const bf16*)(a.ws + WS_Q) + (size_t)t * NQ + hd * 128 + 8 * h;
#pragma unroll
      for (int st = 0; st < 8; ++st) qf[st] = __builtin_bit_cast(bf16x8, *(const v4u*)(qrow + 16 * st)); }
    const float* gt = (const float*)(a.ws + WS_GATES) + (size_t)t * 24 + hd * 3;
    const float g0 = gt[0], g1 = gt[1], g2 = gt[2];
    bf16* yp = (bf16*)(a.ws + (NP ? WS_H : WS_YN)) + (size_t)t * 1536 + hd * 128 + 4 * h;
    f32x16 o[4];
    {
        const v4u* kfc = (const v4u*)(a.ws + WS_KC) + (size_t)bg * 8 * 512; const v4u* vfc = (const v4u*)(a.ws + WS_VC) + (size_t)bg * 8 * 512;
        const int smax = q0w + 31, ncv = smax >= 31 ? ((smax - 31) >> 4) + 1 : 0, ntc = (ncv + 31) >> 5;
        float m = NEGB, l = 0.f;
        for (int tc = 0; tc < ntc; ++tc) {
            f32x16 s = qk_tile(qf, kfc + tc * 512, lane);
            const int dqc = sq - 31 - 512 * tc;
            if (q0w - 31 - 512 * tc - 496 >= FAR_DIST) {
#pragma unroll
                for (int i = 0; i < 16; ++i) s[i] += farc;
            } else add_tbl<16>(s, tbl + dqc - 16 * (8 * h + 23), 0.f);
            mask_hi(s, (dqc >> 4) - 8 * h);
            const float mn = fmaxf(m, max16(s));
            float ps = 0.f;
#pragma unroll
            for (int i = 0; i < 16; ++i) ps += ex2(s[i] - mn);
            l = l * ex2(m - mn) + ps; m = mn;
        }
        l += __shfl_xor(l, 32);
        const float inv = (sq >= 31) ? 1.f / l : 0.f;
        zero_o(o);
        LAS float* impq = imp + (r * 64 + 32 * qs + ql) * 64;
        for (int tc = 0; tc < ntc; ++tc) {
            f32x16 s = qk_tile(qf, kfc + tc * 512, lane);
            bf16x8 v[8];
#pragma unroll
            for (int i = 0; i < 8; ++i) v[i] = __builtin_bit_cast(bf16x8, vfc[tc * 512 + i * 64 + lane]);
            const int dqc = sq - 31 - 512 * tc;
            if (q0w - 31 - 512 * tc - 496 >= FAR_DIST) {
#pragma unroll
                for (int i = 0; i < 16; ++i) s[i] += farc;
            } else add_tbl<16>(s, tbl + dqc - 16 * (8 * h + 23), 0.f);
            mask_hi(s, (dqc >> 4) - 8 * h);
#pragma unroll
            for (int i = 0; i < 16; ++i) s[i] = ex2(s[i] - m) * inv;
#pragma unroll
            for (int a2 = 0; a2 < 2; ++a2)
#pragma unroll
                for (int bq = 0; bq < 2; ++bq) { const int j = 8 * tc + 4 * a2 + 2 * h + bq; const int i0 = 8 * a2 + 4 * bq;
                    impq[j] += (s[i0] + s[i0 + 1]) + (s[i0 + 2] + s[i0 + 3]); }
            asm volatile("s_waitcnt lgkmcnt(0)" ::: "memory");
#pragma unroll
            for (int a2 = 0; a2 < 2; ++a2)
#pragma unroll
                for (int bq = 0; bq < 2; ++bq) { const int j = 8 * tc + 4 * a2 + 2 * h + bq + 1; if (j < 64) impq[j] += s[8 * a2 + 4 * bq + 3]; }
            asm volatile("s_waitcnt lgkmcnt(0)" ::: "memory");
            pv_tile(s, o, v);
        }
        y_update(yp, o, g0, false);
    }
    __syncthreads();
    for (int qq = wave * 8; qq < wave * 8 + 8; ++qq) {
        const int jb = lane;
        const float im = ((imp[(0 * 64 + qq) * 64 + jb] + imp[(1 * 64 + qq) * 64 + jb]) + imp[(2 * 64 + qq) * 64 + jb]) + imp[(3 * 64 + qq) * 64 + jb];
        const bool forced = (jb == 0) || (jb == qb) || (jb == qb - 1);
        const float score = forced ? 1e4f : (jb > qb ? -1e4f : im);
        int rank = 0;
        for (int o2 = 0; o2 < 64; ++o2) { const float so = __shfl(score, o2); rank += (so > score) || (so == score && o2 < jb); }
        const unsigned long long mask = __ballot(rank < 16 && jb <= qb);
        if (lane == 0) selm[qq] = mask;
    }
    __syncthreads();
    {
        const v4u* kfw = (const v4u*)fr_nsa(a, bg, 2); const v4u* vfw = (const v4u*)fr_nsa(a, bg, 3);
        const int t_hi = q0w >> 5, t_lo = t_hi - 16;
        float m = NEGB, l = 0.f; zero_o(o);
        const int t0 = t_lo < 0 ? 0 : t_lo;
        for (int tt = t0; tt <= t_hi; ++tt) {
            const size_t to = (NP == 3) ? (size_t)(tt & 1) * 512 : (size_t)tt * 512;
            bf16x8 kf[8], vf[8]; load_frags(kf, kfw + to, lane);
            f32x16 s = qk_mma(qf, kf); load_frags(vf, vfw + to, lane);
            const int dq = sq - 32 * tt;
            add_tbl<1>(s, tbl + dq - (8 * h + 23), 0.f);
            if (tt == t_hi) mask_hi(s, dq - 8 * h);
            if (tt == t_lo) mask_lo(s, dq - 511 - 8 * h);
            softmax_pv_v<NP>(s, o, m, l, vf);
        }
        l += __shfl_xor(l, 32);
        y_update(yp, o, g2 / l, true);
    }
    {
        const v4u* kfs = (const v4u*)fr_nsa(a, bg, 0); const v4u* vfs = (const v4u*)fr_nsa(a, bg, 1);
        const unsigned long long mask = selm[32 * qs + ql];
        float m = NEGB, l = 0.f; zero_o(o);
        const int t_end = 2 * qb + qs;
        for (int tt = 0; tt <= 2 * qb + 1; ++tt) {
            if (tt > t_end) continue;
            const float pen = ((mask >> (tt >> 1)) & 1ull) ? 0.f : NEGB;
            if (__ballot(pen == 0.f) == 0ull) continue;
            const size_t to = (NP == 3) ? (size_t)(tt & 1) * 512 : (size_t)tt * 512;
            bf16x8 kf[8], vf[8]; load_frags(kf, kfs + to, lane);
            f32x16 s = qk_mma(qf, kf); load_frags(vf, vfs + to, lane);
            const int dq = sq - 32 * tt;
            if (q0w - (32 * tt + 31) >= FAR_DIST) {
                const float c = farc + pen;
#pragma unroll
                for (int i = 0; i < 16; ++i) s[i] += c;
            } else add_tbl<1>(s, tbl + dq - (8 * h + 23), pen);
            if (tt == t_end) mask_hi(s, dq - 8 * h);
            softmax_pv_v<NP>(s, o, m, l, vf);
        }
        l += __shfl_xor(l, 32);
        y_update(yp, o, g1 / l, true);
    }
    __syncthreads();
}
__device__ __forceinline__ void dil_unit(const Args& a, LAS unsigned char* lds, int u, int tid) {
    const int lane = tid & 63, wave = __builtin_amdgcn_readfirstlane(tid >> 6), ql = lane & 31, h = lane >> 5;
    const int b = u >> 6, p = (u >> 4) & 3, c = u & 15, s0 = 256 * c;
    LAS float* dtbl = (LAS float*)(lds + OFF_DTBL);
    const float* relb = a.in[22] + 8 * 32;
    for (int i = tid; i < 3 * 192; i += NTHREADS) { const int gi = i / 192, dm = i % 192 - 32; dtbl[i] = dm >= 0 ? relb[(gi * 4 + p) * 32 + t5_bucket(dm << (2 * gi))] * LOG2E : 0.f; }
    __syncthreads();
    bf16* OD = (bf16*)(a.ws + WS_OD); float* LSE = (float*)(a.ws + WS_LSE);
    const bf16* DL = (const bf16*)(a.ws + WS_DL);
    for (int job = wave; job < 32; job += NWAVES) {
        int gi, rr, m0, vlo, vhi;
        if (job < 8) { gi = 0; rr = 0; m0 = s0 + 32 * job; vlo = 0; vhi = 32; }
        else if (job < 16) { gi = 1; rr = (job - 8) >> 1; m0 = (s0 >> 2) + 32 * (job & 1); vlo = 0; vhi = 32; }
        else { gi = 2; rr = job - 16; m0 = 32 * (c >> 1); vlo = 16 * (c & 1); vhi = vlo + 16; }
        const int dsh = 2 * gi, L = S >> dsh, head = gi * 4 + p;
        const int mq = m0 + ql, sact = (mq << dsh) + rr, t = b * S + sact;
        const v4u* kf = (const v4u*)fr_dil(a, b, head, 0) + (size_t)((rr * L) >> 5) * 512; const v4u* vf = (const v4u*)fr_dil(a, b, head, 1) + (size_t)((rr * L) >> 5) * 512;
        bf16x8 qf[8];
        { const bf16* qrow = DL + (size_t)t * NDL + head * 128 + 8 * h;
#pragma unroll
          for (int st = 0; st < 8; ++st) qf[st] = __builtin_bit_cast(bf16x8, *(const v4u*)(qrow + 16 * st)); }
        const LAS float* tb = dtbl + gi * 192 + 32;
        const int t_hi = m0 >> 5, t_lo = t_hi - 4;
        float m = NEGB, l = 0.f; f32x16 o[4]; zero_o(o);
        const int t0 = t_lo < 0 ? 0 : t_lo;
        for (int tt = t0; tt <= t_hi; ++tt) {
            bf16x8 kr[8], vr[8]; load_frags(kr, kf + (size_t)tt * 512, lane);
            f32x16 s = qk_mma(qf, kr); load_frags(vr, vf + (size_t)tt * 512, lane);
            const int dq = mq - 32 * tt;
            add_tbl<1>(s, tb + dq - (8 * h + 23), 0.f);
            if (tt == t_hi) mask_hi(s, dq - 8 * h);
            if (tt == t_lo) mask_lo(s, dq - 128 - 8 * h);
            softmax_pv_v(s, o, m, l, vr);
        }
        l += __shfl_xor(l, 32);
        if (ql >= vlo && ql < vhi) {
            y_update(OD + ((size_t)gi * T + t) * 512 + p * 128 + 4 * h, o, 1.f / l, false);
            if (h == 0) LSE[((size_t)(gi * NB + b) * 4 + p) * S + sact] = m + __log2f(l);
        }
    }
    __syncthreads();
    { const int pos = tid >> 1, dh = tid & 1, sact = s0 + pos, t = b * S + sact;
      const float l0 = LSE[((size_t)(0 * NB + b) * 4 + p) * S + sact], l1 = LSE[((size_t)(1 * NB + b) * 4 + p) * S + sact], l2 = LSE[((size_t)(2 * NB + b) * 4 + p) * S + sact];
      const float mx = fmaxf(l0, fmaxf(l1, l2)); float w0 = ex2(l0 - mx), w1 = ex2(l1 - mx), w2 = ex2(l2 - mx); const float iw = 1.f / (w0 + w1 + w2); w0 *= iw; w1 *= iw; w2 *= iw;
      bf16* yd = (bf16*)(a.ws + WS_YN) + (size_t)t * 1536 + 1024 + p * 128 + 64 * dh;
      const bf16* o0 = OD + ((size_t)0 * T + t) * 512 + p * 128 + 64 * dh; const bf16* o1 = OD + ((size_t)1 * T + t) * 512 + p * 128 + 64 * dh; const bf16* o2 = OD + ((size_t)2 * T + t) * 512 + p * 128 + 64 * dh;
#pragma unroll
      for (int k = 0; k < 8; ++k) { const v4u x0 = *(const v4u*)(o0 + 8 * k), x1 = *(const v4u*)(o1 + 8 * k), x2 = *(const v4u*)(o2 + 8 * k); v4u y;
          y.x = pkbf(w0 * bflo(x0.x) + w1 * bflo(x1.x) + w2 * bflo(x2.x), w0 * bfhi(x0.x) + w1 * bfhi(x1.x) + w2 * bfhi(x2.x));
          y.y = pkbf(w0 * bflo(x0.y) + w1 * bflo(x1.y) + w2 * bflo(x2.y), w0 * bfhi(x0.y) + w1 * bfhi(x1.y) + w2 * bfhi(x2.y));
          y.z = pkbf(w0 * bflo(x0.z) + w1 * bflo(x1.z) + w2 * bflo(x2.z), w0 * bfhi(x0.z) + w1 * bfhi(x1.z) + w2 * bfhi(x2.z));
          y.w = pkbf(w0 * bflo(x0.w) + w1 * bflo(x1.w) + w2 * bflo(x2.w), w0 * bfhi(x0.w) + w1 * bfhi(x1.w) + w2 * bfhi(x2.w));
          *(v4u*)(yd + 8 * k) = y; } }
    __syncthreads();
}
__device__ __forceinline__ void ph4_attention(const Args& a, LAS unsigned char* lds) {
    const int tid = phase_tid();
    for (int u = blockIdx.x; u < 256; u += gridDim.x) dil_unit(a, lds, u, tid);
#ifndef PROBE_NSA
#define PROBE_NSA 0
#endif
    if (PROBE_NSA) for (int x = blockIdx.x; x < 256; x += gridDim.x) { nsa_unit<PROBE_NSA>(a, lds, 511 - x, tid); nsa_unit<PROBE_NSA>(a, lds, x, tid); }
    for (int x = blockIdx.x; x < 256; x += gridDim.x) { nsa_unit<0>(a, lds, 511 - x, tid); nsa_unit<0>(a, lds, x, tid); }
}

typedef float f32x2 __attribute__((ext_vector_type(2)));
constexpr size_t WS_PU8 = WS_Q;
constexpr size_t WS_PV8 = WS_Q + 32 * MiB;
constexpr size_t WS_PSC = WS_Q + 64 * MiB;
__device__ __forceinline__ void ph_quant_uv(const Args& a) {
    const int tid = phase_tid(), lane = tid & 63, wave = __builtin_amdgcn_readfirstlane(tid >> 6);
    const int gw = blockIdx.x * NWAVES + wave, NGW = gridDim.x * NWAVES;
    float* SC = (float*)(a.ws + WS_PSC);
    for (int rw = gw; rw < NE; rw += NGW) {
        f32x4 x[2][8];
#pragma unroll
        for (int which = 0; which < 2; ++which) { const float* src = a.in[20 + which] + (size_t)rw * D + 16 * lane;
#pragma unroll
            for (int c = 0; c < 2; ++c)
#pragma unroll
                for (int w = 0; w < 4; ++w) x[which][4 * c + w] = *(const f32x4*)(src + 1024 * c + 4 * w); }
#pragma unroll
        for (int which = 0; which < 2; ++which) {
            unsigned char* dst = a.ws + (which ? WS_PV8 : WS_PU8) + (size_t)rw * 1024 + 16 * lane;
            float ss = 0.f;
#pragma unroll
            for (int i = 0; i < 8; ++i) ss += (x[which][i].x * x[which][i].x + x[which][i].y * x[which][i].y) + (x[which][i].z * x[which][i].z + x[which][i].w * x[which][i].w);
            ss = wave_sum(ss);
            const float step = 0.48f * sqrtf(ss * (1.f / D));
            const float inv = step > 0.f ? 1.f / step : 0.f;
            v4u o; unsigned wd[4];
#pragma unroll
            for (int wi = 0; wi < 4; ++wi) { unsigned q = 0u;
                const f32x4 va = x[which][2 * wi], vb = x[which][2 * wi + 1];
                q = __builtin_amdgcn_cvt_scalef32_pk_fp4_f32(q, __builtin_amdgcn_fmed3f(va.x * inv, -6.f, 6.f), __builtin_amdgcn_fmed3f(va.y * inv, -6.f, 6.f), 1.0f, 0);
                q = __builtin_amdgcn_cvt_scalef32_pk_fp4_f32(q, __builtin_amdgcn_fmed3f(va.z * inv, -6.f, 6.f), __builtin_amdgcn_fmed3f(va.w * inv, -6.f, 6.f), 1.0f, 1);
                q = __builtin_amdgcn_cvt_scalef32_pk_fp4_f32(q, __builtin_amdgcn_fmed3f(vb.x * inv, -6.f, 6.f), __builtin_amdgcn_fmed3f(vb.y * inv, -6.f, 6.f), 1.0f, 2);
                q = __builtin_amdgcn_cvt_scalef32_pk_fp4_f32(q, __builtin_amdgcn_fmed3f(vb.z * inv, -6.f, 6.f), __builtin_amdgcn_fmed3f(vb.w * inv, -6.f, 6.f), 1.0f, 3);
                wd[wi] = q; }
            o.x = wd[0]; o.y = wd[1]; o.z = wd[2]; o.w = wd[3]; *(v4u*)dst = o;
            if (lane == 0) SC[which * NE + rw] = step;
        }
    }
}
constexpr size_t WS_KEYF = 601 * MiB;
constexpr size_t WS_END3 = 602 * MiB;
__device__ __forceinline__ void ph0_keyfrags(const Args& a) {
    const int tid = phase_tid();
    const float* keys = a.in[19]; v4u* KF = (v4u*)(a.ws + WS_KEYF);
    for (int i = blockIdx.x * NTHREADS + tid; i < 16 * 32 * 64; i += gridDim.x * NTHREADS) {
        const int lane = i & 63, st = (i >> 6) & 7, kt = (i >> 9) & 3, hp = i >> 11;
        const float* src = keys + ((size_t)hp * 128 + 32 * kt + (lane & 31)) * 128 + 16 * st + 8 * (lane >> 5);
        float v[8]; unsigned hi[8], lo[8];
#pragma unroll
        for (int j = 0; j < 8; ++j) { v[j] = src[j]; hi[j] = f2bf(v[j]); lo[j] = f2bf(v[j] - __builtin_bit_cast(float, hi[j] << 16)); }
        v4u oh, ol; oh.x = hi[0] | (hi[1] << 16); oh.y = hi[2] | (hi[3] << 16); oh.z = hi[4] | (hi[5] << 16); oh.w = hi[6] | (hi[7] << 16);
        ol.x = lo[0] | (lo[1] << 16); ol.y = lo[2] | (lo[3] << 16); ol.z = lo[4] | (lo[5] << 16); ol.w = lo[6] | (lo[7] << 16);
        KF[(size_t)((hp * 2 + 0) * 32 + kt * 8 + st) * 64 + lane] = oh; KF[(size_t)((hp * 2 + 1) * 32 + kt * 8 + st) * 64 + lane] = ol;
    }
}
template <int N, bool MERGE_ONLY> __device__ __forceinline__ void bitonic_desc(float (&v)[N]) {
#pragma unroll
    for (int k = MERGE_ONLY ? N : 2; k <= N; k <<= 1)
#pragma unroll
        for (int j = k >> 1; j > 0; j >>= 1)
#pragma unroll
            for (int i = 0; i < N; ++i) { const int l = i ^ j;
                if (l > i) { const bool desc = ((i & k) == 0) || (k == N); const float x = v[i], y = v[l], hi = fmaxf(x, y), lo = fminf(x, y); v[i] = desc ? hi : lo; v[l] = desc ? lo : hi; } }
}
#define CROW(i) (((i) & 3) + 8 * ((i) >> 2))
__device__ __forceinline__ float max3f(float a, float b, float c) { return fmaxf(fmaxf(a, b), c); }
__device__ __forceinline__ void ph_route(const Args& a, LAS unsigned char* lds) {
    const int tid = phase_tid(), lane = tid & 63, wave = __builtin_amdgcn_readfirstlane(tid >> 6), tl = lane & 31, hc = lane >> 5;
    const int gw = blockIdx.x * NWAVES + wave, NGW = gridDim.x * NWAVES;
    const float* QP = (const float*)(a.ws + WS_QP); const float* qgain = a.in[18]; const v4u* KF = (const v4u*)(a.ws + WS_KEYF);
    int* EI = (int*)(a.ws + WS_EI); float* EG = (float*)(a.ws + WS_EG);
    LAS float* spl = (LAS float*)(lds + wave * 8704) + lane * 33;
    for (int job = gw; job < (T / 32) * 8; job += NGW) {
        const int h = job & 7, t = (job >> 3) * 32 + tl;
#pragma unroll 1
        for (int p = 0; p < 2; ++p) {
            bf16x8 bh[8], bl[8];
            { const float* qr = QP + (size_t)t * D + h * 256 + p * 128 + 8 * hc; const float* gr = qgain + (h * 2 + p) * 128 + 8 * hc;
              float ss = 0.f;
#pragma unroll
              for (int st = 0; st < 8; ++st) { const f32x4 x0 = *(const f32x4*)(qr + 16 * st), x1 = *(const f32x4*)(qr + 16 * st + 4);
                  ss += (x0.x * x0.x + x0.y * x0.y) + (x0.z * x0.z + x0.w * x0.w) + (x1.x * x1.x + x1.y * x1.y) + (x1.z * x1.z + x1.w * x1.w); }
              ss += __shfl_xor(ss, 32);
              const float rstd = rsqrtf(ss * (1.f / 128.f) + EPS);
              asm volatile("" ::: "memory");
#pragma unroll
              for (int st = 0; st < 8; ++st) { const f32x4 x0 = *(const f32x4*)(qr + 16 * st), x1 = *(const f32x4*)(qr + 16 * st + 4); const f32x4 g0 = *(const f32x4*)(gr + 16 * st), g1 = *(const f32x4*)(gr + 16 * st + 4);
                  const float v0 = x0.x * rstd * g0.x, v1 = x0.y * rstd * g0.y, v2 = x0.z * rstd * g0.z, v3 = x0.w * rstd * g0.w, v4 = x1.x * rstd * g1.x, v5 = x1.y * rstd * g1.y, v6 = x1.z * rstd * g1.z, v7 = x1.w * rstd * g1.w;
                  v4u xh, xl; xh.x = pkbf(v0, v1); xh.y = pkbf(v2, v3); xh.z = pkbf(v4, v5); xh.w = pkbf(v6, v7);
                  xl.x = pkbf(v0 - bflo(xh.x), v1 - bfhi(xh.x)); xl.y = pkbf(v2 - bflo(xh.y), v3 - bfhi(xh.y)); xl.z = pkbf(v4 - bflo(xh.z), v5 - bfhi(xh.z)); xl.w = pkbf(v6 - bflo(xh.w), v7 - bfhi(xh.w));
                  bh[st] = __builtin_bit_cast(bf16x8, xh); bl[st] = __builtin_bit_cast(bf16x8, xl); } }
            float sc[64];
            const v4u* kfh = KF + (size_t)(((h * 2 + p) * 2 + 0) * 32) * 64 + lane; const v4u* kfl = KF + (size_t)(((h * 2 + p) * 2 + 1) * 32) * 64 + lane;
#pragma unroll
            for (int kt = 0; kt < 4; ++kt) {
                f32x16 acc;
#pragma unroll
                for (int i = 0; i < 16; ++i) acc[i] = 0.f;
#pragma unroll
                for (int s2 = 0; s2 < 2; ++s2) {
                    asm volatile("" ::: "memory");
                    bf16x8 ah[4], al[4];
#pragma unroll
                    for (int s4 = 0; s4 < 4; ++s4) { ah[s4] = __builtin_bit_cast(bf16x8, kfh[(kt * 8 + s2 * 4 + s4) * 64]); al[s4] = __builtin_bit_cast(bf16x8, kfl[(kt * 8 + s2 * 4 + s4) * 64]); }
#pragma unroll
                    for (int s4 = 0; s4 < 4; ++s4) { const int st = s2 * 4 + s4;
                        acc = __builtin_amdgcn_mfma_f32_32x32x16_bf16(al[s4], bh[st], acc, 0, 0, 0); acc = __builtin_amdgcn_mfma_f32_32x32x16_bf16(ah[s4], bl[st], acc, 0, 0, 0); acc = __builtin_amdgcn_mfma_f32_32x32x16_bf16(ah[s4], bh[st], acc, 0, 0, 0); }
                }
#pragma unroll
                for (int i = 0; i < 16; ++i) { const float av = acc[i];
                    const unsigned bits = (__builtin_bit_cast(unsigned, av) & ~127u) | (unsigned)(127 - (32 * kt + CROW(i) + 4 * hc)); sc[16 * kt + i] = __builtin_bit_cast(float, bits); }
            }
            asm volatile("" ::: "memory");
            bitonic_desc<64, false>(sc);
            float t16[16];
#pragma unroll
            for (int i = 0; i < 16; ++i) t16[i] = __shfl_xor(sc[i], 32);
            float u16[16];
#pragma unroll
            for (int i = 0; i < 16; ++i) u16[i] = fmaxf(sc[i], t16[15 - i]);
            bitonic_desc<16, true>(u16);
#pragma unroll
            for (int i = 0; i < 16; ++i) spl[p * 16 + i] = u16[i];
        }
        asm volatile("s_waitcnt lgkmcnt(0)" ::: "memory");
        float sp[2][16];
#pragma unroll
        for (int i = 0; i < 16; ++i) { sp[0][i] = spl[i]; sp[1][i] = spl[16 + i]; }
        float cv[64];
        {
            int c = 0;
#pragma unroll
            for (int i = 0; i < 16; ++i)
#pragma unroll
                for (int j = 0; j < 16; ++j) if ((i + 1) * (j + 1) <= 16) {
                    const float v = sp[0][i] + sp[1][j];
                    cv[c] = __builtin_bit_cast(float, (__builtin_bit_cast(unsigned, v) & ~255u) | (unsigned)(255 - (i * 16 + j))); ++c; }
#pragma unroll
            for (int i = 50; i < 64; ++i) cv[i] = -INFINITY;
        }
        bitonic_desc<64, false>(cv);
        float tv[16];
#pragma unroll
        for (int i = 0; i < 16; ++i) tv[i] = cv[i];
        asm volatile("s_waitcnt lgkmcnt(0)" ::: "memory");
        int te[16]; float den = 0.f; const float top = tv[0];
#pragma unroll
        for (int i = 0; i < 16; ++i) { const int flat = 255 - (int)(__builtin_bit_cast(unsigned, tv[i]) & 255u);
            const unsigned b1 = __builtin_bit_cast(unsigned, spl[flat >> 4]), b2 = __builtin_bit_cast(unsigned, spl[16 + (flat & 15)]);
            te[i] = (127 - (int)(b1 & 127u)) * 128 + (127 - (int)(b2 & 127u));
            tv[i] = __expf(tv[i] - top); den += tv[i]; }
        den = 1.f / den;
        if (hc == 0) {
            int* ei = EI + (size_t)t * 128 + h * 16; float* eg = EG + (size_t)t * 128 + h * 16;
#pragma unroll
            for (int i = 0; i < 16; i += 4) { *(v4u*)(ei + i) = (v4u){(unsigned)te[i], (unsigned)te[i + 1], (unsigned)te[i + 2], (unsigned)te[i + 3]}; *(f32x4*)(eg + i) = (f32x4){tv[i] * den, tv[i + 1] * den, tv[i + 2] * den, tv[i + 3] * den}; }
        }
        asm volatile("s_waitcnt lgkmcnt(0)" ::: "memory");
    }
}
__device__ __forceinline__ void ph_experts(const Args& a, const float osc) {
    const int tid = phase_tid(), lane = tid & 63, wave = __builtin_amdgcn_readfirstlane(tid >> 6);
    const int gw = blockIdx.x * NWAVES + wave, NGW = gridDim.x * NWAVES;
    const bf16* H2 = (const bf16*)(a.ws + WS_H); const unsigned char* PU = a.ws + WS_PU8; const unsigned char* PV = a.ws + WS_PV8; const float* SC = (const float*)(a.ws + WS_PSC);
    const int* EI = (const int*)(a.ws + WS_EI); const float* EG = (const float*)(a.ws + WS_EG);
    const float* mod = (const float*)(a.ws + WS_MOD);
    float* out = a.out;
    for (int t = gw; t < T; t += NGW) {
        const int b = t / S;
        f32x2 x[16];
#pragma unroll
        for (int c = 0; c < 2; ++c)
#pragma unroll
            for (int hw = 0; hw < 2; ++hw) { const v4u w = *(const v4u*)(H2 + (size_t)t * D + 1024 * c + 16 * lane + 8 * hw); const int o = 8 * c + 4 * hw;
                x[o + 0] = (f32x2){bflo(w.x), bfhi(w.x)}; x[o + 1] = (f32x2){bflo(w.y), bfhi(w.y)}; x[o + 2] = (f32x2){bflo(w.z), bfhi(w.z)}; x[o + 3] = (f32x2){bflo(w.w), bfhi(w.w)}; }
        const int e0 = EI[(size_t)t * 128 + lane], e1 = EI[(size_t)t * 128 + 64 + lane];
        const float gs0 = EG[(size_t)t * 128 + lane] * SC[NE + e0], gs1 = EG[(size_t)t * 128 + 64 + lane] * SC[NE + e1];
        const float su0 = SC[e0], su1 = SC[e1];
        float cf0 = 0.f, cf1 = 0.f;
#pragma unroll 1
        for (int bt = 0; bt < 8; ++bt) {
            v4u w[16];
#pragma unroll
            for (int k = 0; k < 16; ++k) { const int e = __shfl(bt < 4 ? e0 : e1, (bt * 16 + k) & 63); w[k] = *(const v4u*)(PU + (size_t)e * 1024 + 16 * lane); }
#pragma unroll
            for (int k = 0; k < 16; ++k) { f32x2 s = {0.f, 0.f}; const unsigned q[4] = {w[k].x, w[k].y, w[k].z, w[k].w};
#pragma unroll
                for (int wi = 0; wi < 4; ++wi) {
                    s += x[4 * wi + 0] * __builtin_amdgcn_cvt_scalef32_pk_f32_fp4(q[wi], 1.0f, 0); s += x[4 * wi + 1] * __builtin_amdgcn_cvt_scalef32_pk_f32_fp4(q[wi], 1.0f, 1);
                    s += x[4 * wi + 2] * __builtin_amdgcn_cvt_scalef32_pk_f32_fp4(q[wi], 1.0f, 2); s += x[4 * wi + 3] * __builtin_amdgcn_cvt_scalef32_pk_f32_fp4(q[wi], 1.0f, 3); }
                const float raw = wave_sum(s.x + s.y);
                if (lane == ((bt * 16 + k) & 63)) { if (bt < 4) cf0 = gelu_tanh(raw * su0) * gs0; else cf1 = gelu_tanh(raw * su1) * gs1; } }
        }
        f32x2 acc[16];
#pragma unroll
        for (int i = 0; i < 16; ++i) acc[i] = (f32x2){0.f, 0.f};
#pragma unroll 1
        for (int bt = 0; bt < 8; ++bt) {
            v4u w[16];
#pragma unroll
            for (int k = 0; k < 16; ++k) { const int e = __shfl(bt < 4 ? e0 : e1, (bt * 16 + k) & 63); w[k] = *(const v4u*)(PV + (size_t)e * 1024 + 16 * lane); }
#pragma unroll
            for (int k = 0; k < 16; ++k) { const float cf = __shfl(bt < 4 ? cf0 : cf1, (bt * 16 + k) & 63); const f32x2 cf2 = {cf, cf}; const unsigned q[4] = {w[k].x, w[k].y, w[k].z, w[k].w};
#pragma unroll
                for (int wi = 0; wi < 4; ++wi) {
                    acc[4 * wi + 0] += cf2 * __builtin_amdgcn_cvt_scalef32_pk_f32_fp4(q[wi], 1.0f, 0); acc[4 * wi + 1] += cf2 * __builtin_amdgcn_cvt_scalef32_pk_f32_fp4(q[wi], 1.0f, 1);
                    acc[4 * wi + 2] += cf2 * __builtin_amdgcn_cvt_scalef32_pk_f32_fp4(q[wi], 1.0f, 2); acc[4 * wi + 3] += cf2 * __builtin_amdgcn_cvt_scalef32_pk_f32_fp4(q[wi], 1.0f, 3); } }
        }
        const float* g2 = mod + b * 12288 + 10240;
#pragma unroll
        for (int c = 0; c < 2; ++c)
#pragma unroll
            for (int w4 = 0; w4 < 4; ++w4) { float* op = out + (size_t)t * D + 1024 * c + 16 * lane + 4 * w4; const f32x4 ga = *(const f32x4*)(g2 + 1024 * c + 16 * lane + 4 * w4); f32x4 r0 = *(const f32x4*)op; const int o = 8 * c + 2 * w4;
                r0.x += ga.x * acc[o].x * osc; r0.y += ga.y * acc[o].y * osc; r0.z += ga.z * acc[o + 1].x * osc; r0.w += ga.w * acc[o + 1].y * osc;
                *(f32x4*)op = r0; }
    }
}

constexpr int N_PHASES = 11;
__global__ void __launch_bounds__(NTHREADS, 2) fwd_kernel(Args a) {
    extern __shared__ __attribute__((aligned(16))) unsigned char lds_raw[];
    LAS unsigned char* lds = (LAS unsigned char*)lds_raw;
    const int tid = threadIdx.x;
    volatile LAS unsigned* misc = (volatile LAS unsigned*)(lds + LDS_MISC);
    if (tid < 16) misc[tid] = 0u;
    __syncthreads();
    XcdBarrier bar; bar.bar = (unsigned*)(a.ws + WS_CTL) + 1024; bar.x = 0; bar.st = nullptr;
    const int lo = a.ph_lo, hi = a.ph_hi;
    if (hi - lo > 1) bar = xcd_barrier_post((unsigned*)(a.ws + WS_CTL) + 1024, misc + 8);
#define IN(k) (lo <= (k) && (k) < hi)
#define SEAM(k) do { if (IN(k) && IN((k) + 1)) xcd_barrier(bar); } while (0)
    const int G = gridDim.x, bx = blockIdx.x;

    for (int rep = 0; rep < 1 + ((PROBE_DUP >> 0) & 1); ++rep)
    if (IN(0)) { ph0_mod(a, lds); __syncthreads(); ph0_weights(a, lds); ph0_keyfrags(a); ph0_extra(a); __syncthreads(); }
    SEAM(0);
    for (int rep = 0; rep < 1 + ((PROBE_DUP >> 1) & 1); ++rep)
    if (IN(1)) ph_norm<true>(a, a.in[0], a.in[4], 0, 2048, (bf16*)(a.ws + WS_H), a.ws + WS_H8);
    SEAM(1);
    for (int rep = 0; rep < 1 + ((PROBE_DUP >> 2) & 1); ++rep)
    if (IN(2)) { pg8::Gemm g{(const bf16*)(a.ws + WS_H8), (const bf16*)(a.ws + WS_WIN), T, NPROJ, D / 2}; pg8::StaticOrder So; So.init(T, NPROJ, G, bx);
        EpiProjNorm E{(bf16*)(a.ws + WS_Q), (bf16*)(a.ws + WS_KV), (bf16*)(a.ws + WS_DL), (bf16*)(a.ws + WS_MG), (bf16*)a.out, a.in[6], a.in[7], a.in[11], a.in[12], (LAS float*)(lds + 131072), 1.f / (F8_HS * F8_WS)};
        pg8::gemm_phase<EpiProjNorm, pg8::StaticOrder, pg8::NoMid, true>(lds, g, So, E); }
    SEAM(2);
    if (IN(3)) { for (int rep = 0; rep < 1 + ((PROBE_DUP >> 3) & 1); ++rep) { ph3_vfrag(a); ph3_gates(a); ph3_compress(a, lds); } }
    SEAM(3);
    for (int rep = 0; rep < 1 + ((PROBE_DUP >> 4) & 1); ++rep)
    if (IN(4)) ph4_attention(a, lds);
    SEAM(4);
    for (int rep = 0; rep < 1 + ((PROBE_DUP >> 5) & 1); ++rep)
    if (IN(5)) {
        { pg8::Gemm g{(const bf16*)(a.ws + WS_YN), (const bf16*)(a.ws + WS_WBN), T, D, 1536}; pg8::StaticOrder So; So.init(T, D, G, bx);
          EpiMerge E{(const bf16*)(a.ws + WS_MG), a.ws + WS_H, F8_MS}; MidMerge Mh{(const bf16*)(a.ws + WS_MG)};
          pg8::gemm_phase<EpiMerge, pg8::StaticOrder, MidMerge>(lds, g, So, E, Mh); }
    }
    SEAM(5);
    for (int rep = 0; rep < 1 + ((PROBE_DUP >> 6) & 1); ++rep)
    if (IN(6)) { pg8::Gemm g{(const bf16*)(a.ws + WS_H), (const bf16*)(a.ws + WS_WOUT), T, D, D / 2}; pg8::StaticOrder So; So.init(T, D, G, bx);
        EpiOut E{a.in[0], (const float*)(a.ws + WS_MOD), a.out, 1.f / (F8_MS * F8_WS)}; pg8::gemm_phase<EpiOut, pg8::StaticOrder, pg8::NoMid, true>(lds, g, So, E); }
    SEAM(6);
    for (int rep = 0; rep < 1 + ((PROBE_DUP >> 7) & 1); ++rep)
    if (IN(7)) { ph_norm(a, a.out, a.in[16], 6144, 8192, (bf16*)(a.ws + WS_H)); ph_quant_uv(a); }
    SEAM(7);
    for (int rep = 0; rep < 1 + ((PROBE_DUP >> 8) & 1); ++rep)
    if (IN(8)) { pg8::Gemm g{(const bf16*)(a.ws + WS_H), (const bf16*)(a.ws + WS_WPQ), T, D, D}; pg8::StaticOrder So; So.init(T, D, G, bx);
        EpiF32 E{(float*)(a.ws + WS_QP), D}; pg8::gemm_phase<EpiF32, pg8::StaticOrder>(lds, g, So, E); }
    SEAM(8);
    for (int rep = 0; rep < 1 + ((PROBE_DUP >> 9) & 1); ++rep)
    if (IN(9)) { ph_route(a, lds); __syncthreads(); }
    SEAM(9);
    if (IN(10)) { if ((PROBE_DUP >> 10) & 1) { ph_experts(a, *(const float*)(a.ws + WS_CTL + 64)); asm volatile("s_waitcnt vmcnt(0)" ::: "memory"); __syncthreads(); } ph_experts(a, 1.f); }
#undef IN
#undef SEAM
}

extern "C" void kernel_launch(void* const* d_in, const int* in_sizes, int n_in, void* d_out, int out_size, void* d_ws, size_t ws_size, hipStream_t stream) {
    static int grid = 0;
    if (grid == 0) {
        if (n_in != 23 || out_size != T * D || ws_size < WS_END4) { fprintf(stderr, "kernel_launch: unexpected problem shape (n_in %d, out %d, ws %zu); nothing launched\n", n_in, out_size, ws_size); grid = -1; return; }
        int dev = 0, cus = 0, per_cu = 0;
        if (hipGetDevice(&dev) != hipSuccess || hipDeviceGetAttribute(&cus, hipDeviceAttributeMultiprocessorCount, dev) != hipSuccess) { grid = -1; return; }
        if (hipFuncSetAttribute((const void*)fwd_kernel, hipFuncAttributeMaxDynamicSharedMemorySize, LDS_BYTES) != hipSuccess) { fprintf(stderr, "kernel_launch: hipFuncSetAttribute failed\n"); grid = -1; return; }
        if (hipOccupancyMaxActiveBlocksPerMultiprocessor(&per_cu, (const void*)fwd_kernel, NTHREADS, LDS_BYTES) != hipSuccess || per_cu < 1) { fprintf(stderr, "kernel_launch: occupancy query says %d\n", per_cu); }
        (void)hipGetLastError();
        grid = cus;
    }
    if (grid < 0) return;
    hipMemsetAsync((char*)d_ws + WS_CTL, 0, CTL_ZERO_BYTES, stream);
    Args a{};
    for (int i = 0; i < 23; ++i) a.in[i] = (const float*)d_in[i];
    a.out = (float*)d_out; a.ws = (unsigned char*)d_ws;
#if MK_ONE_LAUNCH
#if PROBE_PREFIX >= 0
    a.ph_lo = 0; a.ph_hi = PROBE_PREFIX + 1;
    hipLaunchKernelGGL(fwd_kernel, dim3(grid), dim3(NTHREADS), LDS_BYTES, stream, a);
    hipMemsetAsync((char*)d_ws + WS_CTL, 0, CTL_ZERO_BYTES, stream);
#endif
    a.ph_lo = 0; a.ph_hi = N_PHASES;
    hipLaunchKernelGGL(fwd_kernel, dim3(grid), dim3(NTHREADS), LDS_BYTES, stream, a);
#else
    for (int p = 0; p < N_PHASES; ++p) { a.ph_lo = p; a.ph_hi = p + 1; hipLaunchKernelGGL(fwd_kernel, dim3(grid), dim3(NTHREADS), LDS_BYTES, stream, a); }
#endif
}
```

```cpp
#include <hip/hip_runtime.h>
#include <cstdio>
#include <cstdint>

#ifndef PROBE_DUP
#define PROBE_DUP 0
#endif
#ifndef PROBE_PREFIX
#define PROBE_PREFIX -1
#endif
#ifndef MK_ONE_LAUNCH
#define MK_ONE_LAUNCH 1
#endif

__device__ __forceinline__ int phase_tid() { int t = threadIdx.x; asm volatile("" : "+v"(t)); return t; }
namespace pg8 {
#define PG8_LAS __attribute__((address_space(3)))
typedef unsigned short bf16_t;
typedef short bf16x8 __attribute__((ext_vector_type(8)));
typedef float f32x4 __attribute__((ext_vector_type(4)));
typedef unsigned u32x4 __attribute__((ext_vector_type(4)));
typedef unsigned u32x2 __attribute__((ext_vector_type(2)));
constexpr int BM = 256, BK = 64, HALF = 128, HTB = HALF * BK * 2, STAGE_BYTES = 8 * HTB, NXCD = 8, WGM = 8;

__host__ __device__ __forceinline__ int lds_byte(int r, int c) { const int st = (r >> 4) * 2 + (c >> 5), rr = r & 15, cc = c & 31, ob = rr * 64 + cc * 2; return st * 1024 + (ob ^ (((ob >> 9) & 1) << 5)); }
__host__ __device__ __forceinline__ void stage_rc(int b, int& R, int& C) { const int st = b / 1024, sb = b % 1024, swz = sb ^ (((sb >> 9) & 1) << 5); R = (st >> 1) * 16 + swz / 64; C = (st & 1) * 32 + (swz % 64) / 2; }
__host__ __device__ __forceinline__ int perm32(int rho) { const int n = rho >> 4, i = rho & 15; return 8 * (i >> 2) + 4 * n + (i & 3); }

struct Unit { int pm, pn; };
struct Gemm { const bf16_t* A; const bf16_t* Bt; int M, N, K; };

struct StaticOrder {
    int nM, nN, nwg, G, c;
    __host__ __device__ void init(int M, int N, int G_, int c_) { nM = M / BM; nN = N / BM; nwg = nM * nN; G = G_; c = c_; }
    __host__ __device__ bool next(int i, Unit& u) const {
        const long L = (long)i * G + c; if (L >= nwg) return false;
        int wgid = (int)L; { const int q = nwg / NXCD, r = nwg % NXCD, xcd = wgid % NXCD, off = wgid / NXCD; wgid = (xcd < r ? xcd * (q + 1) : r * (q + 1) + (xcd - r) * q) + off; }
        const int nig = WGM * nN, gid = wgid / nig, fm = gid * WGM, gsz = (nM - fm) < WGM ? (nM - fm) : WGM;
        u.pm = fm + ((wgid % nig) % gsz); u.pn = (wgid % nig) / gsz; return true;
    }
    __device__ __forceinline__ void a_ready(const Unit&) const {}
    __device__ __forceinline__ void done(const Unit&) const {}
};

__device__ __forceinline__ unsigned cvt_pk_bf16(float lo, float hi) { unsigned r; asm volatile("v_cvt_pk_bf16_f32 %0, %1, %2" : "=v"(r) : "v"(lo), "v"(hi)); return r; }

typedef int i32x4 __attribute__((ext_vector_type(4)));
typedef int i32x8 __attribute__((ext_vector_type(8)));
template <bool F8> __device__ __forceinline__ void mma_blk(f32x4 (&acc)[4][2], const bf16x8 (&At)[4][2], const bf16x8 (&Bt)[2][2]) {
    if constexpr (F8) {
#pragma unroll
        for (int m = 0; m < 4; ++m)
#pragma unroll
            for (int n = 0; n < 2; ++n) {
                const i32x8 bb = __builtin_shufflevector(__builtin_bit_cast(i32x4, Bt[n][0]), __builtin_bit_cast(i32x4, Bt[n][1]), 0, 1, 2, 3, 4, 5, 6, 7);
                const i32x8 aa = __builtin_shufflevector(__builtin_bit_cast(i32x4, At[m][0]), __builtin_bit_cast(i32x4, At[m][1]), 0, 1, 2, 3, 4, 5, 6, 7);
                asm volatile("v_mfma_f32_16x16x128_f8f6f4 %0, %1, %2, %0" : "+v"(acc[m][n]) : "v"(bb), "v"(aa)); }
    } else {
#pragma unroll
        for (int m = 0; m < 4; ++m)
#pragma unroll
            for (int n = 0; n < 2; ++n)
#pragma unroll
                for (int k = 0; k < 2; ++k) acc[m][n] = __builtin_amdgcn_mfma_f32_16x16x32_bf16(Bt[n][k], At[m][k], acc[m][n], 0, 0, 0);
    }
}
struct NoMid { static constexpr int AT = -1; __device__ __forceinline__ void operator()(f32x4 (&)[2][2][4][2], const Unit&, int, int, int, int) const {} };
template <class Epi, class Sched, class Mid = NoMid, bool F8 = false>
__device__ __forceinline__ void gemm_phase(PG8_LAS unsigned char* lds, const Gemm g, const Sched& S, const Epi& E, const Mid& Mh = Mid()) {
    const int tid = phase_tid(), wid = __builtin_amdgcn_readfirstlane(tid >> 6), lane = tid & 63, wr = wid >> 2, wc = wid & 3, fr = lane & 15, fq = lane >> 4;
    const int K = g.K, nt = K / BK;
    unsigned voffA[2], voffB[2];
#pragma unroll
    for (int i = 0; i < 2; ++i) { int R, C; stage_rc(tid * 16 + i * 8192, R, C); const int Rb = Epi::PERM ? ((R & ~31) + perm32(R & 31)) : R;
        voffA[i] = (unsigned)(R * K + C) * 2u; voffB[i] = (unsigned)(Rb * K + C) * 2u; }
    const size_t kstep = (size_t)(BK * 2);
    const size_t hstep = (size_t)HALF * K * 2;
    const size_t tstep = 2 * hstep;
    const unsigned ldsw = (unsigned)wid * 1024u;
    const int aoff = lds_byte(wr * 64 + fr, fq * 8), boff = lds_byte(wc * 32 + fr, fq * 8);
#define PG8_SA(b, h) (((b) * 2 + (h)) * HTB)
#define PG8_SB(b, h) ((4 + (b) * 2 + (h)) * HTB)
#define PG8_STAGE(bufoff, gbase, voff) do { _Pragma("unroll") for (int _i = 0; _i < 2; ++_i) \
        __builtin_amdgcn_global_load_lds((const unsigned*)((const char*)(gbase) + (voff)[_i]), (PG8_LAS unsigned*)(lds + (bufoff) + ldsw + _i * 8192), 16, 0, 0); } while (0)
#define PG8_LDA(dst, b, h) do { _Pragma("unroll") for (int m = 0; m < 4; ++m) _Pragma("unroll") for (int k = 0; k < 2; ++k) dst[m][k] = *(const PG8_LAS bf16x8*)(lds + PG8_SA(b, h) + aoff + m * 2048 + k * 1024); } while (0)
#define PG8_LDB(dst, b, h) do { _Pragma("unroll") for (int n = 0; n < 2; ++n) _Pragma("unroll") for (int k = 0; k < 2; ++k) dst[n][k] = *(const PG8_LAS bf16x8*)(lds + PG8_SB(b, h) + boff + n * 2048 + k * 1024); } while (0)
#define PG8_MMA(ai, bj, At, Bt) do { __builtin_amdgcn_s_setprio(1); if constexpr (F8) { mma_blk<true>(acc[ai][bj], At, Bt); } else { _Pragma("unroll") for (int m = 0; m < 4; ++m) _Pragma("unroll") for (int n = 0; n < 2; ++n) _Pragma("unroll") for (int k = 0; k < 2; ++k) \
        acc[ai][bj][m][n] = __builtin_amdgcn_mfma_f32_16x16x32_bf16(Bt[n][k], At[m][k], acc[ai][bj][m][n], 0, 0, 0); } __builtin_amdgcn_s_setprio(0); } while (0)
#define PG8_WAIT_V(n) asm volatile("s_waitcnt vmcnt(" #n ")" ::: "memory")
#define PG8_WAIT_L(n) asm volatile("s_waitcnt lgkmcnt(" #n ")" ::: "memory")
#define PG8_BAR __builtin_amdgcn_s_barrier()
#define PG8_SCHED __builtin_amdgcn_sched_barrier(0)
    Unit cur, nxt; int ui = 0;
    if (!S.next(0, cur)) return;
    f32x4 acc[2][2][4][2];
#pragma unroll
    for (int a = 0; a < 2; ++a)
#pragma unroll
        for (int b = 0; b < 2; ++b)
#pragma unroll
            for (int m = 0; m < 4; ++m)
#pragma unroll
                for (int n = 0; n < 2; ++n) acc[a][b][m][n] = (f32x4){0.f, 0.f, 0.f, 0.f};
    bf16x8 At[4][2], B0[2][2], B1[2][2];
    const char* cA = (const char*)g.A + (size_t)cur.pm * tstep; const char* cB = (const char*)g.Bt + (size_t)cur.pn * tstep;
    S.a_ready(cur);
    PG8_STAGE(PG8_SB(0, 0), cB, voffB); PG8_STAGE(PG8_SA(0, 0), cA, voffA); PG8_STAGE(PG8_SB(0, 1), cB + hstep, voffB); PG8_STAGE(PG8_SA(0, 1), cA + hstep, voffA);
    if (wr == 1) PG8_BAR;
    PG8_WAIT_V(4); PG8_BAR;
    PG8_STAGE(PG8_SB(1, 0), cB + kstep, voffB); PG8_STAGE(PG8_SA(1, 0), cA + kstep, voffA); PG8_STAGE(PG8_SB(1, 1), cB + hstep + kstep, voffB);
    PG8_WAIT_V(6); PG8_BAR;
    for (;;) {
        const bool has_next = S.next(ui + 1, nxt);
        const char* nA = has_next ? (const char*)g.A + (size_t)nxt.pm * tstep : cA; const char* nB = has_next ? (const char*)g.Bt + (size_t)nxt.pn * tstep : cB;
#define PG8_KBODY \
            const bool last = (t == nt - 2); \
            const char* a1 = cA + (size_t)(t + 1) * kstep; \
            const char* a2 = last ? nA : cA + (size_t)(t + 2) * kstep; const char* b2 = last ? nB : cB + (size_t)(t + 2) * kstep; \
            const char* a3 = a2 + kstep; const char* b3 = b2 + kstep; \
            if (last && has_next) S.a_ready(nxt); \
            PG8_LDB(B0, 0, 0); PG8_SCHED; PG8_LDA(At, 0, 0); PG8_STAGE(PG8_SA(1, 1), a1 + hstep, voffA); \
            PG8_WAIT_L(8); PG8_BAR; PG8_WAIT_L(0); PG8_MMA(0, 0, At, B0); PG8_BAR; PG8_SCHED; \
            PG8_LDB(B1, 0, 1); PG8_STAGE(PG8_SB(0, 0), b2, voffB); \
            PG8_BAR; PG8_WAIT_L(0); PG8_MMA(0, 1, At, B1); PG8_BAR; \
            PG8_LDA(At, 0, 1); PG8_STAGE(PG8_SA(0, 0), a2, voffA); \
            PG8_BAR; PG8_WAIT_L(0); PG8_MMA(1, 0, At, B0); PG8_BAR; PG8_SCHED; \
            PG8_STAGE(PG8_SB(0, 1), b2 + hstep, voffB); \
            PG8_WAIT_V(6); PG8_BAR; PG8_MMA(1, 1, At, B1); PG8_BAR; \
            PG8_LDB(B0, 1, 0); PG8_SCHED; PG8_LDA(At, 1, 0); PG8_STAGE(PG8_SA(0, 1), a2 + hstep, voffA); \
            PG8_WAIT_L(8); PG8_BAR; PG8_WAIT_L(0); PG8_MMA(0, 0, At, B0); PG8_BAR; PG8_SCHED; \
            PG8_LDB(B1, 1, 1); PG8_STAGE(PG8_SB(1, 0), b3, voffB); \
            PG8_BAR; PG8_WAIT_L(0); PG8_MMA(0, 1, At, B1); PG8_BAR; \
            PG8_LDA(At, 1, 1); PG8_STAGE(PG8_SA(1, 0), a3, voffA); \
            PG8_BAR; PG8_WAIT_L(0); PG8_MMA(1, 0, At, B0); PG8_BAR; PG8_SCHED; \
            PG8_STAGE(PG8_SB(1, 1), b3 + hstep, voffB); \
            PG8_WAIT_V(6); PG8_BAR; PG8_MMA(1, 1, At, B1); PG8_BAR;
        if constexpr (Mid::AT >= 0) {
            for (int t = 0; t < Mid::AT; t += 2) { PG8_KBODY }
            if constexpr (F8) asm volatile("s_nop 15\n\ts_nop 15" ::: "memory");
            Mh(acc, cur, wr, wc, fr, fq);
            for (int t = Mid::AT; t < nt; t += 2) { PG8_KBODY }
        } else {
            for (int t = 0; t < nt; t += 2) { PG8_KBODY }
        }
#undef PG8_KBODY
        if constexpr (F8) asm volatile("s_nop 15\n\ts_nop 15" ::: "memory");
        E(acc, cur, wr, wc, fr, fq); S.done(cur);
        if (!has_next) break;
#pragma unroll
        for (int a = 0; a < 2; ++a)
#pragma unroll
            for (int b = 0; b < 2; ++b)
#pragma unroll
                for (int m = 0; m < 4; ++m)
#pragma unroll
                    for (int n = 0; n < 2; ++n) acc[a][b][m][n] = (f32x4){0.f, 0.f, 0.f, 0.f};
        cur = nxt; cA = nA; cB = nB; ++ui;
    }
    PG8_WAIT_V(0);
    if (wr == 0) PG8_BAR;
    PG8_BAR;
#undef PG8_SA
#undef PG8_SB
#undef PG8_STAGE
#undef PG8_LDA
#undef PG8_LDB
#undef PG8_MMA
#undef PG8_WAIT_V
#undef PG8_WAIT_L
#undef PG8_BAR
#undef PG8_SCHED
}
}

#define GAS __attribute__((address_space(1)))
#define LAS __attribute__((address_space(3)))
typedef unsigned short bf16;
typedef float f32x4 __attribute__((ext_vector_type(4)));
typedef unsigned v4u __attribute__((ext_vector_type(4)));
typedef unsigned v2u __attribute__((ext_vector_type(2)));

constexpr int NB = 4, S = 4096, D = 2048, T = NB * S, HD = 128;
constexpr int IN_COLS = 11288, OFF_KV = 1024, OFF_GATE = 2560, OFF_DIL = 2584, OFF_MERGE = 7192;
constexpr int NPROJ = 11264;
constexpr int NQ = 1024, NKV = 1536, NDL = 4608, NMG = 4096;
constexpr int NC = 255, NS = 64;
constexpr int NE = 16384;
constexpr float EPS = 1e-6f;
constexpr float QSCALE = 0.08838834764831845f;
constexpr int NWAVES = 8, NTHREADS = 512;

constexpr size_t MiB = 1u << 20;
constexpr size_t WS_CTL = 0, CTL_ZERO_BYTES = 1 * MiB;
constexpr size_t WS_WIN = 1 * MiB;
constexpr size_t WS_WBN = 45 * MiB;
constexpr size_t WS_WBD = 49 * MiB;
constexpr size_t WS_WOUT = 51 * MiB;
constexpr size_t WS_WPQ = 59 * MiB;
constexpr size_t WS_WGATE = 67 * MiB;
constexpr size_t WS_MOD = 67 * MiB + 256 * 1024;
constexpr size_t WS_SEL = 67 * MiB + 512 * 1024;
constexpr size_t WS_GATES = 68 * MiB;
constexpr size_t WS_KC = 70 * MiB;
constexpr size_t WS_VC = 71 * MiB;
constexpr size_t WS_H = 72 * MiB;
constexpr size_t WS_Q = 136 * MiB;
constexpr size_t WS_KV = 168 * MiB;
constexpr size_t WS_DL = 216 * MiB;
constexpr size_t WS_MG = 360 * MiB;
constexpr size_t WS_YN = 488 * MiB;
constexpr size_t WS_YD = 520 * MiB;
constexpr size_t WS_H8 = WS_YN;
constexpr size_t WS_EI = 536 * MiB;
constexpr size_t WS_EG = 544 * MiB;
constexpr size_t WS_END = 552 * MiB;
constexpr size_t WS_PU = WS_Q;
constexpr size_t WS_PV = WS_Q + 64 * MiB;
constexpr size_t WS_QP = WS_MG;
static_assert(WS_PV + 64 * MiB <= WS_MG, "u/v overlay");

constexpr int LDS_BYTES = 147456;
constexpr int LDS_MISC = 144 * 1024 - 256;

#define XB_TMO      128
#define XB_XCNT(j)  (256  + 64 * (j))
#define XB_XSUB(j)  (1280 + 64 * (j))
#define XB_XGEN(j)  (2304 + 64 * (j))
#define XB_TOP      3328
#define XB_TOPGEN   3392
#define XCD_BAR_WORDS 3456
#define XB_SPIN_CAP (1u << 24)

__device__ __forceinline__ unsigned xb_ld(unsigned* p)              { return __hip_atomic_load(p, __ATOMIC_RELAXED, __HIP_MEMORY_SCOPE_AGENT); }
__device__ __forceinline__ unsigned xb_add(unsigned* p, unsigned v) { return __hip_atomic_fetch_add(p, v, __ATOMIC_RELAXED, __HIP_MEMORY_SCOPE_AGENT); }
__device__ __forceinline__ unsigned xb_xcc_id() { return (unsigned)__builtin_amdgcn_s_getreg((3 << 11) | 20) & 0xFu; }
#define XB_SPIN(cond, bar) do { unsigned _sp = 0; while (cond) { __builtin_amdgcn_s_sleep(1); \
    if ((++_sp & 255u) == 0u) { if (xb_ld(&(bar)[XB_TMO])) break; if (_sp > XB_SPIN_CAP) { atomicAdd(&(bar)[XB_TMO], 1u); break; } } } } while (0)

struct XcdBarrier { unsigned* bar; unsigned x; volatile LAS unsigned* st; };

__device__ __forceinline__ XcdBarrier xcd_barrier_post(unsigned* bar, volatile LAS unsigned* st) {
    XcdBarrier b; b.bar = bar; b.x = xb_xcc_id(); b.st = st;
    if (threadIdx.x == 0) (void)xb_add(&bar[XB_XCNT(b.x)], 1u);
    return b;
}
__device__ __forceinline__ void xcd_barrier_complete(unsigned* bar, unsigned x, unsigned& nloc, unsigned& nx) {
    const unsigned G = gridDim.x * gridDim.y * gridDim.z;
    unsigned sum, cnt, mine, sp = 0u;
    for (;;) {
        sum = 0u; cnt = 0u; mine = 0u;
#pragma unroll
        for (unsigned j = 0; j < 16; ++j) { const unsigned c = xb_ld(&bar[XB_XCNT(j)]); sum += c; cnt += (c > 0u) ? 1u : 0u; mine = (j == x) ? c : mine; }
        if (sum == G) break;
        __builtin_amdgcn_s_sleep(1);
        if ((++sp & 255u) == 0u) { if (xb_ld(&bar[XB_TMO])) break; if (sp > XB_SPIN_CAP) { atomicAdd(&bar[XB_TMO], 1u); break; } }
    }
    nloc = mine > 0u ? mine : 1u; nx = cnt > 0u ? cnt : 1u;
}
__device__ __forceinline__ void xcd_barrier(const XcdBarrier& b) {
    asm volatile("s_waitcnt vmcnt(0)" ::: "memory");
    __syncthreads();
    if (threadIdx.x == 0) {
        unsigned* bar = b.bar;
        __builtin_amdgcn_s_waitcnt(0);
        unsigned nloc = b.st[0], nx = b.st[1];
        if (nloc == 0u) { xcd_barrier_complete(bar, b.x, nloc, nx); b.st[0] = nloc; b.st[1] = nx; }
        const unsigned old = xb_add(&bar[XB_XSUB(b.x)], 1u);
        const unsigned gen = old / nloc;
        if (old + 1u == (gen + 1u) * nloc) {
            __builtin_amdgcn_fence(__ATOMIC_RELEASE, "agent");
            asm volatile("s_waitcnt vmcnt(0)" ::: "memory");
            const unsigned og = xb_add(&bar[XB_TOP], 1u);
            const unsigned tg = og / nx;
            if (og + 1u == (tg + 1u) * nx) xb_add(&bar[XB_TOPGEN], 1u);
            else XB_SPIN(xb_ld(&bar[XB_TOPGEN]) == tg, bar);
            __builtin_amdgcn_fence(__ATOMIC_ACQUIRE, "agent");
            xb_add(&bar[XB_XGEN(b.x)], 1u);
            asm volatile("s_waitcnt vmcnt(0)" ::: "memory");
        } else {
            XB_SPIN(xb_ld(&bar[XB_XGEN(b.x)]) == gen, bar);
            __builtin_amdgcn_fence(__ATOMIC_ACQUIRE, "agent");
            asm volatile("s_waitcnt vmcnt(0)" ::: "memory");
        }
    }
    __syncthreads();
}

__device__ __forceinline__ unsigned f2bf(float f) { unsigned u = __builtin_bit_cast(unsigned, f); return (u + 0x7fffu + ((u >> 16) & 1u)) >> 16; }
__device__ __forceinline__ unsigned pk2(float lo, float hi) { return f2bf(lo) | (f2bf(hi) << 16); }
__device__ __forceinline__ unsigned pk4_f8(float a, float b, float c, float d) {
    a = __builtin_amdgcn_fmed3f(a, -448.f, 448.f); b = __builtin_amdgcn_fmed3f(b, -448.f, 448.f); c = __builtin_amdgcn_fmed3f(c, -448.f, 448.f); d = __builtin_amdgcn_fmed3f(d, -448.f, 448.f);
    int w = 0; w = __builtin_amdgcn_cvt_pk_fp8_f32(a, b, w, false); w = __builtin_amdgcn_cvt_pk_fp8_f32(c, d, w, true); return (unsigned)w; }
constexpr float F8_HS = 8.f, F8_WS = 128.f, F8_MS = 64.f;
__device__ __forceinline__ float bflo(unsigned u) { return __builtin_bit_cast(float, u << 16); }
__device__ __forceinline__ float bfhi(unsigned u) { return __builtin_bit_cast(float, u & 0xffff0000u); }
__device__ __forceinline__ float bf2f(bf16 u) { return __builtin_bit_cast(float, (unsigned)u << 16); }
__device__ __forceinline__ float wave_sum(float v) {
#pragma unroll
    for (int o = 1; o < 64; o <<= 1) v += __shfl_xor(v, o);
    return v;
}
__device__ __forceinline__ float wave_max(float v) {
#pragma unroll
    for (int o = 1; o < 64; o <<= 1) v = fmaxf(v, __shfl_xor(v, o));
    return v;
}
__device__ __forceinline__ float sigmoidf(float x) { return __builtin_amdgcn_rcpf(1.f + __expf(-x)); }
__device__ __forceinline__ float gelu_tanh(float x) { const float u = 0.7978845608028654f * (x + 0.044715f * x * x * x); return 0.5f * x * (1.f + tanhf(u)); }
__device__ __forceinline__ int t5_bucket(int n) {
    if (n < 16) return n;
    int b = 16;
    b += (n >= 22); b += (n >= 30); b += (n >= 40); b += (n >= 54); b += (n >= 73); b += (n >= 99); b += (n >= 134); b += (n >= 182);
    b += (n >= 246); b += (n >= 332); b += (n >= 450); b += (n >= 609); b += (n >= 825); b += (n >= 1117); b += (n >= 1513);
    return b;
}

struct Args {
    const float* in[23];
    float* out; unsigned char* ws;
    int ph_lo, ph_hi;
};

typedef float f32x2v __attribute__((ext_vector_type(2)));
__device__ __forceinline__ void ph0_mod(const Args& a, LAS unsigned char* lds) {
    const int tid = phase_tid(), lane = tid & 63, wave = __builtin_amdgcn_readfirstlane(tid >> 6);
    LAS float* cs = (LAS float*)lds;
    LAS float* red = (LAS float*)(lds + 32768);
    const float* c = a.in[1]; const float* w_ada = a.in[2]; const float* b_ada = a.in[3];
    float* mod = (float*)(a.ws + WS_MOD);
    for (int i = tid; i < 4 * 2048; i += NTHREADS) { const float v = c[i]; cs[i] = v / (1.f + __expf(-v)); }
    __syncthreads();
    for (int u = blockIdx.x; u < 12288 / 128; u += gridDim.x) {
        const int col = u * 128 + 2 * lane;
        float acc[4][2];
#pragma unroll
        for (int b = 0; b < 4; ++b) { acc[b][0] = 0.f; acc[b][1] = 0.f; }
        const float* wp = w_ada + (size_t)(wave * 256) * 12288 + col;
#pragma unroll 1
        for (int k0 = 0; k0 < 256; k0 += 16) {
            f32x2v w[16];
#pragma unroll
            for (int k = 0; k < 16; ++k) w[k] = *(const f32x2v*)(wp + (size_t)(k0 + k) * 12288);
#pragma unroll
            for (int k = 0; k < 16; ++k) { const int kk = wave * 256 + k0 + k;
#pragma unroll
                for (int b = 0; b < 4; ++b) { const float cv = cs[b * 2048 + kk]; acc[b][0] += cv * w[k].x; acc[b][1] += cv * w[k].y; } }
        }
#pragma unroll
        for (int b = 0; b < 4; ++b) { red[(wave * 4 + b) * 128 + 2 * lane] = acc[b][0]; red[(wave * 4 + b) * 128 + 2 * lane + 1] = acc[b][1]; }
        __syncthreads();
        { const int b = tid >> 7, cc = tid & 127; float s = 0.f;
#pragma unroll
          for (int w = 0; w < 8; ++w) s += red[(w * 4 + b) * 128 + cc];
          mod[b * 12288 + u * 128 + cc] = s + b_ada[u * 128 + cc]; }
        __syncthreads();
    }
}
__device__ __forceinline__ void transpose_item(const float* W, int ldw, int ncols, int K, bf16* WT, int row_off, LAS float* scr, int item, int lane, int ldt = 0) {
    if (ldt == 0) ldt = K;
    const int nblk = ncols / 32, kb = item / nblk, nb = item % nblk, k0 = 64 * kb, n0 = 32 * nb;
    float tv[32];
#pragma unroll
    for (int i = 0; i < 32; ++i) tv[i] = W[(size_t)(k0 + 2 * i + (lane >> 5)) * ldw + n0 + (lane & 31)];
#pragma unroll
    for (int i = 0; i < 32; ++i) scr[(2 * i + (lane >> 5)) * 33 + (lane & 31)] = tv[i];
    asm volatile("s_waitcnt lgkmcnt(0)" ::: "memory");
    const int c = lane & 7;
#pragma unroll
    for (int j = 0; j < 4; ++j) { const int n = (lane >> 3) + 8 * j; const LAS float* s = scr + (8 * c) * 33 + n;
        v4u o; o.x = pk2(s[0 * 33], s[1 * 33]); o.y = pk2(s[2 * 33], s[3 * 33]); o.z = pk2(s[4 * 33], s[5 * 33]); o.w = pk2(s[6 * 33], s[7 * 33]);
        *(v4u*)(WT + (size_t)(row_off + n0 + n) * ldt + k0 + 8 * c) = o; }
    asm volatile("s_waitcnt lgkmcnt(0)" ::: "memory");
}
__device__ __forceinline__ void transpose_item_f8(const float* W, int ldw, int ncols, int K, unsigned char* WT, int row_off, LAS float* scr, int item, int lane) {
    const int nblk = ncols / 32, kb = item / nblk, nb = item % nblk, k0 = 64 * kb, n0 = 32 * nb;
    float tv[32];
#pragma unroll
    for (int i = 0; i < 32; ++i) tv[i] = W[(size_t)(k0 + 2 * i + (lane >> 5)) * ldw + n0 + (lane & 31)];
#pragma unroll
    for (int i = 0; i < 32; ++i) scr[(2 * i + (lane >> 5)) * 33 + (lane & 31)] = tv[i] * F8_WS;
    asm volatile("s_waitcnt lgkmcnt(0)" ::: "memory");
    const int c = lane & 7;
#pragma unroll
    for (int j = 0; j < 4; ++j) { const int n = (lane >> 3) + 8 * j; const LAS float* s = scr + (8 * c) * 33 + n;
        v2u o; o.x = pk4_f8(s[0 * 33], s[1 * 33], s[2 * 33], s[3 * 33]); o.y = pk4_f8(s[4 * 33], s[5 * 33], s[6 * 33], s[7 * 33]);
        *(v2u*)(WT + (size_t)(row_off + n0 + n) * K + k0 + 8 * c) = o; }
    asm volatile("s_waitcnt lgkmcnt(0)" ::: "memory");
}
__device__ __forceinline__ void ph0_weights(const Args& a, LAS unsigned char* lds) {
    const int tid = phase_tid(), lane = tid & 63, wave = __builtin_amdgcn_readfirstlane(tid >> 6);
    LAS float* scr = (LAS float*)(lds + wave * 16384);
    const int gw = blockIdx.x * NWAVES + wave, NGW = gridDim.x * NWAVES;
    const float* w_in = a.in[5];
    unsigned char* WIN = a.ws + WS_WIN;
    constexpr int I_Q = 32 * (NQ / 32), I_KV = 32 * (NKV / 32), I_DL = 32 * (NDL / 32), I_MG = 32 * (NMG / 32);
    constexpr int I_BN = 16 * 64, I_BD = 8 * 64, I_O = 32 * 64, I_PQ = 32 * 64;
    constexpr int NITEMS = I_Q + I_KV + I_DL + I_MG + I_BN + I_BD + I_O + I_PQ;
    for (int it = gw; it < NITEMS; it += NGW) {
        int r = it;
        if (r < I_Q)  { transpose_item_f8(w_in, IN_COLS, NQ, D, WIN, 0, scr, r, lane); continue; } r -= I_Q;
        if (r < I_KV) { transpose_item_f8(w_in + OFF_KV, IN_COLS, NKV, D, WIN, NQ, scr, r, lane); continue; } r -= I_KV;
        if (r < I_DL) { transpose_item_f8(w_in + OFF_DIL, IN_COLS, NDL, D, WIN, NQ + NKV, scr, r, lane); continue; } r -= I_DL;
        if (r < I_MG) { transpose_item_f8(w_in + OFF_MERGE, IN_COLS, NMG, D, WIN, NQ + NKV + NDL, scr, r, lane); continue; } r -= I_MG;
        if (r < I_BN) { transpose_item(a.in[13], D, D, 1024, (bf16*)(a.ws + WS_WBN), 0, scr, r, lane, 1536); continue; } r -= I_BN;
        if (r < I_BD) { transpose_item(a.in[14], D, D, 512, (bf16*)(a.ws + WS_WBN) + 1024, 0, scr, r, lane, 1536); continue; } r -= I_BD;
        if (r < I_O)  { transpose_item_f8(a.in[15], D, D, D, a.ws + WS_WOUT, 0, scr, r, lane); continue; } r -= I_O;
        transpose_item(a.in[17], D, D, D, (bf16*)(a.ws + WS_WPQ), 0, scr, r, lane);
    }
}

constexpr size_t WS_CW1F = 602 * MiB;
constexpr size_t WS_WGF = 604 * MiB;
constexpr size_t WS_CBP = 604 * MiB + 256 * 1024;
constexpr size_t WS_END4 = 605 * MiB;
__device__ __forceinline__ void ph0_extra(const Args& a) {
    const int tid = phase_tid(), lane = tid & 63, wave = __builtin_amdgcn_readfirstlane(tid >> 6);
    const float* w1 = a.in[9]; const float* pos = a.in[8]; const float* w_in = a.in[5];
    v4u* CW = (v4u*)(a.ws + WS_CW1F); v4u* WG = (v4u*)(a.ws + WS_WGF); float* CBP = (float*)(a.ws + WS_CBP);
    for (int i = blockIdx.x * NTHREADS + tid; i < 2 * 4 * 256 * 64; i += gridDim.x * NTHREADS) {
        const int ln = i & 63, ks = (i >> 6) & 255, nt = (i >> 14) & 3, j = i >> 16;
        const float* src = w1 + ((size_t)j * 4096 + 16 * ks + 8 * (ln >> 5)) * 128 + 32 * nt + (ln & 31);
        v4u o; o.x = pk2(src[0], src[128]); o.y = pk2(src[256], src[384]); o.z = pk2(src[512], src[640]); o.w = pk2(src[768], src[896]);
        CW[i] = o;
    }
    for (int i = blockIdx.x * NTHREADS + tid; i < 128 * 64; i += gridDim.x * NTHREADS) {
        const int ln = i & 63, ks = i >> 6, jrow = ln & 31;
        v4u o = {0u, 0u, 0u, 0u};
        if (jrow < 24) { const float* src = w_in + (size_t)(16 * ks + 8 * (ln >> 5)) * IN_COLS + OFF_GATE + jrow;
            o.x = pk2(src[0], src[IN_COLS]); o.y = pk2(src[2 * (size_t)IN_COLS], src[3 * (size_t)IN_COLS]); o.z = pk2(src[4 * (size_t)IN_COLS], src[5 * (size_t)IN_COLS]); o.w = pk2(src[6 * (size_t)IN_COLS], src[7 * (size_t)IN_COLS]); }
        WG[i] = o;
    }
    { const int gw = blockIdx.x * NWAVES + wave;
      if (gw < 128) { const int kc = gw >> 1, j = gw & 1; float s0 = 0.f, s1 = 0.f; const float* wp = w1 + ((size_t)j * 4096 + 64 * kc) * 128 + lane; const float* pp = pos + j * 4096 + 64 * kc;
#pragma unroll 1
          for (int k0 = 0; k0 < 64; k0 += 16) { float wa[16], wb[16];
#pragma unroll
              for (int k = 0; k < 16; ++k) { wa[k] = wp[(k0 + k) * 128]; wb[k] = wp[(k0 + k) * 128 + 64]; }
#pragma unroll
              for (int k = 0; k < 16; ++k) { const float pv = pp[k0 + k]; s0 += pv * wa[k]; s1 += pv * wb[k]; } }
          CBP[(kc * 2 + j) * 128 + lane] = s0; CBP[(kc * 2 + j) * 128 + 64 + lane] = s1; } }
}

template <bool F8 = false>
__device__ __forceinline__ void ph_norm(const Args& a, const float* xin, const float* gvec, int sh_off, int sc_off, bf16* hout, unsigned char* h8 = nullptr) {
    const int tid = phase_tid(), lane = tid & 63, wave = __builtin_amdgcn_readfirstlane(tid >> 6);
    const int gw = blockIdx.x * NWAVES + wave, NGW = gridDim.x * NWAVES;
    const float* mod = (const float*)(a.ws + WS_MOD);
    for (int r = gw; r < S / 2; r += NGW)
#pragma unroll 1
        for (int bq = 0; bq < NB; ++bq) {
            const int m0 = bq * S + r, m1 = m0 + S / 2;
            const float* x0 = xin + (size_t)m0 * D + 8 * lane; const float* x1 = xin + (size_t)m1 * D + 8 * lane;
            f32x4 v0[8], v1[8];
#pragma unroll
            for (int c = 0; c < 4; ++c) { v0[2 * c] = *(const f32x4*)(x0 + 512 * c); v0[2 * c + 1] = *(const f32x4*)(x0 + 512 * c + 4); v1[2 * c] = *(const f32x4*)(x1 + 512 * c); v1[2 * c + 1] = *(const f32x4*)(x1 + 512 * c + 4); }
            float s0 = 0.f, s1 = 0.f;
#pragma unroll
            for (int i = 0; i < 8; ++i) { s0 += (v0[i].x * v0[i].x + v0[i].y * v0[i].y) + (v0[i].z * v0[i].z + v0[i].w * v0[i].w); s1 += (v1[i].x * v1[i].x + v1[i].y * v1[i].y) + (v1[i].z * v1[i].z + v1[i].w * v1[i].w); }
            const float r0 = rsqrtf(wave_sum(s0) * (1.f / D) + EPS), r1 = rsqrtf(wave_sum(s1) * (1.f / D) + EPS);
            const float* shp = mod + bq * 12288 + sh_off + 8 * lane; const float* scp = mod + bq * 12288 + sc_off + 8 * lane; const float* gp = gvec + 8 * lane;
#pragma unroll
            for (int c = 0; c < 4; ++c) {
                v4u o0, o1; unsigned w0[4], w1[4]; [[maybe_unused]] unsigned q0[2], q1[2];
#pragma unroll
                for (int hq = 0; hq < 2; ++hq) { const f32x4 g = *(const f32x4*)(gp + 512 * c + 4 * hq), sc = *(const f32x4*)(scp + 512 * c + 4 * hq), sh = *(const f32x4*)(shp + 512 * c + 4 * hq);
                    const f32x4 ga = g * (1.f + sc); const f32x4 y0 = v0[2 * c + hq] * r0 * ga + sh, y1 = v1[2 * c + hq] * r1 * ga + sh;
                    w0[2 * hq] = pk2(y0.x, y0.y); w0[2 * hq + 1] = pk2(y0.z, y0.w); w1[2 * hq] = pk2(y1.x, y1.y); w1[2 * hq + 1] = pk2(y1.z, y1.w);
                    if constexpr (F8) { q0[hq] = pk4_f8(y0.x * F8_HS, y0.y * F8_HS, y0.z * F8_HS, y0.w * F8_HS); q1[hq] = pk4_f8(y1.x * F8_HS, y1.y * F8_HS, y1.z * F8_HS, y1.w * F8_HS); } }
                o0.x = w0[0]; o0.y = w0[1]; o0.z = w0[2]; o0.w = w0[3]; o1.x = w1[0]; o1.y = w1[1]; o1.z = w1[2]; o1.w = w1[3];
                *(v4u*)(hout + (size_t)m0 * D + 512 * c + 8 * lane) = o0; *(v4u*)(hout + (size_t)m1 * D + 512 * c + 8 * lane) = o1;
                if constexpr (F8) { v2u p0, p1; p0.x = q0[0]; p0.y = q0[1]; p1.x = q1[0]; p1.y = q1[1];
                    *(v2u*)(h8 + (size_t)m0 * D + 512 * c + 8 * lane) = p0; *(v2u*)(h8 + (size_t)m1 * D + 512 * c + 8 * lane) = p1; }
            }
        }
}

using pg8::Unit; using pg8::HALF; using pg8::BM;
struct EpiProj {
    static constexpr bool PERM = true;
    bf16 *q, *kv, *dl, *mg;
    __device__ __forceinline__ void operator()(const f32x4 (&acc)[2][2][4][2], const Unit& u, int wr, int wc, int fr, int fq) const {
        bf16* base; int ldc, colt = u.pn * BM;
        if (colt < NQ) { base = q; ldc = NQ; } else if (colt < NQ + NKV) { base = kv; ldc = NKV; colt -= NQ; } else if (colt < NQ + NKV + NDL) { base = dl; ldc = NDL; colt -= NQ + NKV; } else { base = mg; ldc = NMG; colt -= NQ + NKV + NDL; }
        const int row0 = u.pm * BM + wr * 64 + fr, col0 = colt + wc * 32 + 8 * fq;
#pragma unroll
        for (int ai = 0; ai < 2; ++ai)
#pragma unroll
            for (int m = 0; m < 4; ++m) { bf16* rowp = base + (size_t)(row0 + ai * HALF + m * 16) * ldc + col0;
#pragma unroll
                for (int bj = 0; bj < 2; ++bj) { const f32x4 v0 = acc[ai][bj][m][0], v1 = acc[ai][bj][m][1];
                    v4u w; w.x = pg8::cvt_pk_bf16(v0[0], v0[1]); w.y = pg8::cvt_pk_bf16(v0[2], v0[3]); w.z = pg8::cvt_pk_bf16(v1[0], v1[1]); w.w = pg8::cvt_pk_bf16(v1[2], v1[3]);
                    *(v4u*)(rowp + bj * HALF) = w; } }
    }
};
struct MidMerge {
    static constexpr int AT = 16;
    const bf16* mg;
    __device__ __forceinline__ void operator()(f32x4 (&acc)[2][2][4][2], const Unit& u, int wr, int wc, int fr, int fq) const {
        int lo = (fq * 16 + fr) * 8;
        asm volatile("" : "+v"(lo));
        const bf16* t1 = mg + (((size_t)(u.pm * 16 + u.pn) * 8 + (wr * 4 + wc)) << 13) + lo; const bf16* t2 = t1 + ((size_t)8 << 16);
#pragma unroll
        for (int ai = 0; ai < 2; ++ai) {
            v4u a1[4][2], a2[4][2];
#pragma unroll
            for (int m = 0; m < 4; ++m)
#pragma unroll
                for (int bj = 0; bj < 2; ++bj) { a1[m][bj] = *(const v4u*)(t1 + ((ai * 4 + m) * 2 + bj) * 512); a2[m][bj] = *(const v4u*)(t2 + ((ai * 4 + m) * 2 + bj) * 512); }
#pragma unroll
            for (int m = 0; m < 4; ++m)
#pragma unroll
                for (int bj = 0; bj < 2; ++bj) { const unsigned w1[4] = {a1[m][bj].x, a1[m][bj].y, a1[m][bj].z, a1[m][bj].w}, w2[4] = {a2[m][bj].x, a2[m][bj].y, a2[m][bj].z, a2[m][bj].w};
#pragma unroll
                    for (int q = 0; q < 4; ++q) { const float r0 = (1.f + __expf(-bflo(w2[q]))) * __builtin_amdgcn_rcpf(1.f + __expf(-bflo(w1[q]))), r1 = (1.f + __expf(-bfhi(w2[q]))) * __builtin_amdgcn_rcpf(1.f + __expf(-bfhi(w1[q])));
                        acc[ai][bj][m][q >> 1][2 * (q & 1)] *= r0; acc[ai][bj][m][q >> 1][2 * (q & 1) + 1] *= r1; } }
            asm volatile("" ::: "memory");
        }
    }
};
struct EpiMerge {
    static constexpr bool PERM = true;
    const bf16* mg; unsigned char* merged8; float os;
    __device__ __forceinline__ void operator()(const f32x4 (&acc)[2][2][4][2], const Unit& u, int wr, int wc, int fr, int fq) const {
        int row0 = u.pm * BM + wr * 64 + fr; const int col0 = u.pn * BM + wc * 32 + 8 * fq;
        asm volatile("" : "+v"(row0));
        const bf16* t2 = mg + (((size_t)(u.pm * 16 + 8 + u.pn) * 8 + (wr * 4 + wc)) << 13) + (fq * 16 + fr) * 8;
        v4u a2[2][4][2];
#pragma unroll
        for (int ai = 0; ai < 2; ++ai)
#pragma unroll
            for (int m = 0; m < 4; ++m)
#pragma unroll
                for (int bj = 0; bj < 2; ++bj) a2[ai][m][bj] = *(const v4u*)(t2 + ((ai * 4 + m) * 2 + bj) * 512);
#pragma unroll
        for (int ai = 0; ai < 2; ++ai)
#pragma unroll
            for (int m = 0; m < 4; ++m) { const size_t row = (size_t)(row0 + ai * HALF + m * 16);
#pragma unroll
                for (int bj = 0; bj < 2; ++bj) { const unsigned w2[4] = {a2[ai][m][bj].x, a2[ai][m][bj].y, a2[ai][m][bj].z, a2[ai][m][bj].w};
                    const f32x4 v0 = acc[ai][bj][m][0] * os, v1 = acc[ai][bj][m][1] * os;
                    v2u w; w.x = pk4_f8(v0[0] * sigmoidf(bflo(w2[0])), v0[1] * sigmoidf(bfhi(w2[0])), v0[2] * sigmoidf(bflo(w2[1])), v0[3] * sigmoidf(bfhi(w2[1])));
                    w.y = pk4_f8(v1[0] * sigmoidf(bflo(w2[2])), v1[1] * sigmoidf(bfhi(w2[2])), v1[2] * sigmoidf(bflo(w2[3])), v1[3] * sigmoidf(bfhi(w2[3])));
                    *(v2u*)(merged8 + row * D + col0 + bj * HALF) = w; } }
    }
};
struct EpiOut {
    static constexpr bool PERM = false;
    const float* x; const float* mod; float* x1; float as;
    __device__ __forceinline__ void operator()(const f32x4 (&acc)[2][2][4][2], const Unit& u, int wr, int wc, int fr, int fq) const {
        const int row0 = u.pm * BM + wr * 64 + fr, col0 = u.pn * BM + wc * 32 + 4 * fq;
        const int b = (u.pm * BM) / S;
        f32x4 gv[2][2];
#pragma unroll
        for (int bj = 0; bj < 2; ++bj)
#pragma unroll
            for (int n = 0; n < 2; ++n) gv[bj][n] = *(const f32x4*)(mod + b * 12288 + 4096 + col0 + bj * HALF + n * 16) * as;
#pragma unroll
        for (int ai = 0; ai < 2; ++ai)
#pragma unroll
            for (int m = 0; m < 4; ++m) { const size_t off = (size_t)(row0 + ai * HALF + m * 16) * D + col0;
#pragma unroll
                for (int bj = 0; bj < 2; ++bj)
#pragma unroll
                    for (int n = 0; n < 2; ++n) *(f32x4*)(x1 + off + bj * HALF + n * 16) = *(const f32x4*)(x + off + bj * HALF + n * 16) + gv[bj][n] * acc[ai][bj][m][n]; }
    }
};
struct EpiF32 {
    static constexpr bool PERM = false;
    float* C; int ldc;
    __device__ __forceinline__ void operator()(const f32x4 (&acc)[2][2][4][2], const Unit& u, int wr, int wc, int fr, int fq) const {
        const int row0 = u.pm * BM + wr * 64 + fr, col0 = u.pn * BM + wc * 32 + 4 * fq;
#pragma unroll
        for (int ai = 0; ai < 2; ++ai)
#pragma unroll
            for (int m = 0; m < 4; ++m) { float* rowp = C + (size_t)(row0 + ai * HALF + m * 16) * ldc + col0;
#pragma unroll
                for (int bj = 0; bj < 2; ++bj)
#pragma unroll
                    for (int n = 0; n < 2; ++n) *(f32x4*)(rowp + bj * HALF + n * 16) = acc[ai][bj][m][n]; }
    }
};

typedef short bf16x8 __attribute__((ext_vector_type(8)));
typedef float f32x16 __attribute__((ext_vector_type(16)));
typedef float f32x2 __attribute__((ext_vector_type(2)));
typedef __bf16 bf2v __attribute__((ext_vector_type(2)));
constexpr float LOG2E = 1.4426950408889634f;
constexpr float QS2 = QSCALE * LOG2E;
constexpr float NEGB = -1e30f;
__device__ __forceinline__ unsigned pkbf(float a, float b) { const f32x2 v = {a, b}; const bf2v r = __builtin_convertvector(v, bf2v); return __builtin_bit_cast(unsigned, r); }
__device__ __forceinline__ float ex2(float x) { return __builtin_amdgcn_exp2f(x); }
__device__ __forceinline__ int swap23(int x) { return (x & ~12) | ((x & 4) << 1) | ((x & 8) >> 1); }
__device__ __forceinline__ size_t kf_off(int key, int d) { return ((size_t)((key >> 5) * 8 + (d >> 4)) * 64 + ((d >> 3) & 1) * 32 + swap23(key & 31)) * 8 + (d & 7); }
__device__ __forceinline__ size_t vf_off(int key, int d) { const int kk = key & 31; return ((size_t)(((key >> 5) * 4 + (d >> 5)) * 2 + (kk >> 4)) * 64 + ((kk >> 3) & 1) * 32 + (d & 31)) * 8 + (kk & 7); }
__device__ __forceinline__ bf16* fr_nsa(const Args& a, int bg, int kind) { return (bf16*)a.out + ((size_t)(bg * 4 + kind) << 19); }
__device__ __forceinline__ bf16* fr_dil(const Args& a, int b, int head, int kv) { return (bf16*)a.out + ((size_t)16 << 20) + ((size_t)((b * 12 + head) * 2 + kv) << 19); }
constexpr size_t WS_OD = 552 * MiB;
constexpr size_t WS_LSE = 600 * MiB;
constexpr size_t WS_END2 = 601 * MiB;

struct EpiProjNorm {
    static constexpr bool PERM = true;
    bf16 *q, *kv, *dl, *mg, *frg;
    const float *qg, *kg, *dqg, *dkg;
    LAS float* xch;
    float as;
    __device__ __forceinline__ void operator()(const f32x4 (&acc)[2][2][4][2], const Unit& u, int wr, int wc, int fr, int fq) const {
        bf16* base; int ldc, colt = u.pn * BM, mode = 0  , hsel = 0; const float* gain = qg; float scale = 1.f;
        if (colt < NQ) { base = q; ldc = NQ; mode = 1; gain = qg; scale = QS2; }
        else if (colt < NQ + NKV) { base = kv; ldc = NKV; colt -= NQ; hsel = colt >> 7; if (hsel == 4 || hsel == 8) { mode = 2; gain = kg + (hsel == 4 ? 128 : 256); } }
        else if (colt < NQ + NKV + NDL) { base = dl; ldc = NDL; colt -= NQ + NKV; hsel = colt >> 7; if (hsel < 12) { mode = 1; gain = dqg; scale = QS2; } else if (hsel < 24) { mode = 3; gain = dkg; } }
        else { base = mg; ldc = NMG; colt -= NQ + NKV + NDL; }
        const int row0 = u.pm * BM + wr * 64 + fr, col0 = colt + wc * 32 + 8 * fq;
        if (base == mg) {
            bf16* tp = mg + (((size_t)(u.pm * 16 + (colt >> 8)) * 8 + (wr * 4 + wc)) << 13) + (fq * 16 + fr) * 8;
#pragma unroll
            for (int ai = 0; ai < 2; ++ai)
#pragma unroll
                for (int m = 0; m < 4; ++m)
#pragma unroll
                    for (int bj = 0; bj < 2; ++bj) { const f32x4 v0 = acc[ai][bj][m][0] * as, v1 = acc[ai][bj][m][1] * as;
                        v4u w; w.x = pg8::cvt_pk_bf16(v0[0], v0[1]); w.y = pg8::cvt_pk_bf16(v0[2], v0[3]); w.z = pg8::cvt_pk_bf16(v1[0], v1[1]); w.w = pg8::cvt_pk_bf16(v1[2], v1[3]);
                        *(v4u*)(tp + ((ai * 4 + m) * 2 + bj) * 512) = w; }
            return;
        }
        if (mode == 0) {
#pragma unroll
            for (int ai = 0; ai < 2; ++ai)
#pragma unroll
                for (int m = 0; m < 4; ++m) { bf16* rowp = base + (size_t)(row0 + ai * HALF + m * 16) * ldc + col0;
#pragma unroll
                    for (int bj = 0; bj < 2; ++bj) { const f32x4 v0 = acc[ai][bj][m][0] * as, v1 = acc[ai][bj][m][1] * as;
                        v4u w; w.x = pg8::cvt_pk_bf16(v0[0], v0[1]); w.y = pg8::cvt_pk_bf16(v0[2], v0[3]); w.z = pg8::cvt_pk_bf16(v1[0], v1[1]); w.w = pg8::cvt_pk_bf16(v1[2], v1[3]);
                        *(v4u*)(rowp + bj * HALF) = w; } }
            return;
        }
#pragma unroll
        for (int ai = 0; ai < 2; ++ai)
#pragma unroll
            for (int m = 0; m < 4; ++m)
#pragma unroll
                for (int bj = 0; bj < 2; ++bj) { const f32x4 v0 = acc[ai][bj][m][0], v1 = acc[ai][bj][m][1];
                    float ss = (v0[0] * v0[0] + v0[1] * v0[1]) + (v0[2] * v0[2] + v0[3] * v0[3]) + (v1[0] * v1[0] + v1[1] * v1[1]) + (v1[2] * v1[2] + v1[3] * v1[3]);
                    ss += __shfl_xor(ss, 16); ss += __shfl_xor(ss, 32);
                    if (fq == 0) xch[(((((wr * 2 + ai) * 4 + m) * 16 + fr) * 2 + bj) << 2) + wc] = ss; }
        asm volatile("s_waitcnt lgkmcnt(0)" ::: "memory");
        __builtin_amdgcn_s_barrier();
        asm volatile("" ::: "memory");
        const f32x4 ga = *(const f32x4*)(gain + wc * 32 + 8 * fq), gb = *(const f32x4*)(gain + wc * 32 + 8 * fq + 4);
#pragma unroll
        for (int ai = 0; ai < 2; ++ai)
#pragma unroll
            for (int m = 0; m < 4; ++m) { const int t = row0 + ai * HALF + m * 16, b = t / S, s = t % S;
#pragma unroll
                for (int bj = 0; bj < 2; ++bj) { const f32x4 pp = *(const LAS f32x4*)(xch + (((((wr * 2 + ai) * 4 + m) * 16 + fr) * 2 + bj) << 2));
                    const float rstd = rsqrtf(((pp.x + pp.y) + (pp.z + pp.w)) * (as * as * (1.f / 128.f)) + EPS) * (scale * as);
                    const f32x4 v0 = acc[ai][bj][m][0] * rstd * ga, v1 = acc[ai][bj][m][1] * rstd * gb;
                    v4u w; w.x = pg8::cvt_pk_bf16(v0[0], v0[1]); w.y = pg8::cvt_pk_bf16(v0[2], v0[3]); w.z = pg8::cvt_pk_bf16(v1[0], v1[1]); w.w = pg8::cvt_pk_bf16(v1[2], v1[3]);
                    bf16* dst;
                    if (mode == 1) dst = base + (size_t)t * ldc + col0 + bj * HALF;
                    else if (mode == 2) dst = frg + ((size_t)((b * 2 + bj) * 4 + (hsel == 4 ? 0 : 2)) << 19) + kf_off(s, wc * 32 + 8 * fq);
                    else { const int head = hsel - 12 + bj, dsh = 2 * (head >> 2), vk = ((s & ((1 << dsh) - 1)) << (12 - dsh)) + (s >> dsh);
                        dst = frg + ((size_t)16 << 20) + ((size_t)((b * 12 + head) * 2) << 19) + kf_off(vk, wc * 32 + 8 * fq); }
                    *(v4u*)dst = w; } }
    }
};

__device__ __forceinline__ v4u norm_chunk16v(v4u w, const float* gain, float scale, int li) {
    float v[8] = {bflo(w.x), bfhi(w.x), bflo(w.y), bfhi(w.y), bflo(w.z), bfhi(w.z), bflo(w.w), bfhi(w.w)};
    float ss = 0.f;
#pragma unroll
    for (int j = 0; j < 8; ++j) ss += v[j] * v[j];
    ss += __shfl_xor(ss, 1); ss += __shfl_xor(ss, 2); ss += __shfl_xor(ss, 4); ss += __shfl_xor(ss, 8);
    const float rstd = rsqrtf(ss * (1.f / 128.f) + EPS) * scale;
#pragma unroll
    for (int j = 0; j < 8; ++j) v[j] = v[j] * rstd * gain[8 * li + j];
    w.x = pk2(v[0], v[1]); w.y = pk2(v[2], v[3]); w.z = pk2(v[4], v[5]); w.w = pk2(v[6], v[7]);
    return w;
}
__device__ __forceinline__ void ph3_headnorm(const Args& a) {
    const int tid = phase_tid(), lane = tid & 63, wave = __builtin_amdgcn_readfirstlane(tid >> 6), sub = lane >> 4, li = lane & 15;
    const int gw = blockIdx.x * NWAVES + wave, NGW = gridDim.x * NWAVES;
    bf16* Q = (bf16*)(a.ws + WS_Q); const bf16* KV = (const bf16*)(a.ws + WS_KV); bf16* DL = (bf16*)(a.ws + WS_DL);
    const float* qg = a.in[6]; const float* kg = a.in[7]; const float* dqg = a.in[11]; const float* dkg = a.in[12];
    for (int m = gw; m < T; m += NGW) {
        const int b = m / S, s = m % S;
        const int g = sub & 1, win = sub >> 1;
        v4u wq[2], wk, wd[6];
#pragma unroll
        for (int it = 0; it < 2; ++it) wq[it] = *(const v4u*)(Q + (size_t)m * NQ + (it * 4 + sub) * 128 + 8 * li);
        wk = *(const v4u*)(KV + (size_t)m * NKV + ((win ? 8 : 4) + g) * 128 + 8 * li);
#pragma unroll
        for (int it = 0; it < 6; ++it) wd[it] = *(const v4u*)(DL + (size_t)m * NDL + (it * 4 + sub) * 128 + 8 * li);
#pragma unroll
        for (int it = 0; it < 2; ++it) *(v4u*)(Q + (size_t)m * NQ + (it * 4 + sub) * 128 + 8 * li) = norm_chunk16v(wq[it], qg, QS2, li);
        *(v4u*)(fr_nsa(a, b * 2 + g, win ? 2 : 0) + kf_off(s, 8 * li)) = norm_chunk16v(wk, kg + (win ? 256 : 128), 1.f, li);
#pragma unroll
        for (int it = 0; it < 6; ++it) { const int ch = it * 4 + sub;
            if (ch < 12) *(v4u*)(DL + (size_t)m * NDL + ch * 128 + 8 * li) = norm_chunk16v(wd[it], dqg, QS2, li);
            else { const int head = ch - 12, gi = head >> 2, dsh = 2 * gi  , vk = ((s & ((1 << dsh) - 1)) << (12 - dsh)) + (s >> dsh);
                *(v4u*)(fr_dil(a, b, head, 0) + kf_off(vk, 8 * li)) = norm_chunk16v(wd[it], dkg, 1.f, li); } }
    }
}
__device__ __forceinline__ void ph3_vfrag(const Args& a) {
    const int tid = phase_tid(), lane = tid & 63, wave = __builtin_amdgcn_readfirstlane(tid >> 6);
    const int gw = blockIdx.x * NWAVES + wave, NGW = gridDim.x * NWAVES;
    const bf16* KV = (const bf16*)(a.ws + WS_KV); const bf16* DL = (const bf16*)(a.ws + WS_DL);
    for (int job = gw; job < 32768; job += NGW) {
        const bf16* src; size_t rstride; bf16* dst; int key0;
        if (job < 8192) { const int bg = job >> 10, kind = (job >> 9) & 1, s0 = (job & 511) * 8, b = bg >> 1, g = bg & 1;
            src = KV + (size_t)(b * S + s0) * NKV + ((kind ? 10 : 6) + g) * 128; rstride = NKV; dst = fr_nsa(a, bg, kind ? 3 : 1); key0 = s0; }
        else { const int j2 = job - 8192, bh = j2 >> 9, vk0 = (j2 & 511) * 8, b = bh / 12, head = bh % 12, gi = head >> 2, dsh = 2 * gi, L = S >> dsh, r = vk0 / L, m0 = vk0 % L;
            src = DL + (size_t)(b * S + (m0 << dsh) + r) * NDL + (24 + head) * 128; rstride = (size_t)NDL << dsh; dst = fr_dil(a, b, head, 1); key0 = vk0; }
        unsigned w[8];
#pragma unroll
        for (int jj = 0; jj < 8; ++jj) w[jj] = *(const unsigned*)(src + jj * rstride + 2 * lane);
        v4u c0, c1;
        c0.x = (w[0] & 0xffffu) | (w[1] << 16); c0.y = (w[2] & 0xffffu) | (w[3] << 16); c0.z = (w[4] & 0xffffu) | (w[5] << 16); c0.w = (w[6] & 0xffffu) | (w[7] << 16);
        c1.x = (w[0] >> 16) | (w[1] & 0xffff0000u); c1.y = (w[2] >> 16) | (w[3] & 0xffff0000u); c1.z = (w[4] >> 16) | (w[5] & 0xffff0000u); c1.w = (w[6] >> 16) | (w[7] & 0xffff0000u);
        *(v4u*)(dst + vf_off(key0, 2 * lane)) = c0; *(v4u*)(dst + vf_off(key0, 2 * lane + 1)) = c1;
    }
}
__device__ __forceinline__ void ph3_gates(const Args& a) {
    const int tid = phase_tid(), lane = tid & 63, wave = __builtin_amdgcn_readfirstlane(tid >> 6), tl = lane & 31, hh = lane >> 5;
    const int gw = (gridDim.x - 1 - blockIdx.x) * NWAVES + wave, NGW = gridDim.x * NWAVES;
    const bf16* H = (const bf16*)(a.ws + WS_H); const v4u* WG = (const v4u*)(a.ws + WS_WGF) + lane; float* gates = (float*)(a.ws + WS_GATES);
    for (int job = gw; job < T / 32; job += NGW) {
        const int t = job * 32 + tl; const bf16* hr = H + (size_t)t * D + 8 * hh;
        f32x16 acc;
#pragma unroll
        for (int i = 0; i < 16; ++i) acc[i] = 0.f;
#pragma unroll 4
        for (int ks = 0; ks < 128; ++ks) { const bf16x8 af = __builtin_bit_cast(bf16x8, WG[ks * 64]), bfr = __builtin_bit_cast(bf16x8, *(const v4u*)(hr + 16 * ks));
            acc = __builtin_amdgcn_mfma_f32_32x32x16_bf16(af, bfr, acc, 0, 0, 0); }
#pragma unroll
        for (int i = 0; i < 16; ++i) { const int j = (i & 3) + 8 * (i >> 2) + 4 * hh; const float v = acc[i]; if (j < 24) gates[(size_t)t * 24 + j] = sigmoidf(v); }
    }
}
__device__ __forceinline__ void ph3_compress(const Args& a, LAS unsigned char* lds) {
    const int tid = phase_tid(), lane = tid & 63, wave = __builtin_amdgcn_readfirstlane(tid >> 6), cl = lane & 31, hh = lane >> 5;
    LAS float* part = (LAS float*)lds;
    LAS float* hid = part + 2 * 128 * 32;
    LAS float* ob = hid + 32 * 128;
    LAS float* bias = ob + 32 * 128;
    const bf16* KV = (const bf16*)(a.ws + WS_KV);
    const float* w2 = a.in[10]; const float* kg0 = a.in[7]; const float* CBP = (const float*)(a.ws + WS_CBP);
    for (int u = blockIdx.x; u < 128; u += gridDim.x) {
        const int j = u >> 6, bg = (u >> 3) & 7, ct = u & 7, b = bg >> 1, g = bg & 1, c0 = 32 * ct, hhd = j * 2 + g;
        if (tid < 128) { float s = 0.f;
#pragma unroll
            for (int kc = 0; kc < 64; ++kc) s += CBP[(kc * 2 + j) * 128 + tid];
            bias[tid] = s; }
        { const int nt = wave & 3, kh = wave >> 2, c = c0 + cl;
          const v4u* af = (const v4u*)(a.ws + WS_CW1F) + ((size_t)(j * 4 + nt) * 256 + 128 * kh) * 64 + lane;
          f32x16 acc;
#pragma unroll
          for (int i = 0; i < 16; ++i) acc[i] = 0.f;
#pragma unroll 4
          for (int ks = 0; ks < 128; ++ks) { const int k = 16 * (128 * kh + ks) + 8 * hh, l = k >> 7, d = k & 127, p = 16 * c + l;
              v4u x = {0u, 0u, 0u, 0u}; if (p < S) x = *(const v4u*)(KV + (size_t)(b * S + p) * NKV + hhd * 128 + d);
              acc = __builtin_amdgcn_mfma_f32_32x32x16_bf16(__builtin_bit_cast(bf16x8, af[ks * 64]), __builtin_bit_cast(bf16x8, x), acc, 0, 0, 0); }
#pragma unroll
          for (int i = 0; i < 16; ++i) { const int n = 32 * nt + (i & 3) + 8 * (i >> 2) + 4 * hh; const float v = acc[i]; part[(kh * 128 + n) * 32 + cl] = v; } }
        __syncthreads();
        for (int i = tid; i < 128 * 32; i += NTHREADS) { const int n = i >> 5, c = i & 31; hid[c * 128 + n] = gelu_tanh(part[i] + part[128 * 32 + i] + bias[n]); }
        __syncthreads();
        { const int n = tid & 127, cq = tid >> 7; float o[8];
#pragma unroll
          for (int r = 0; r < 8; ++r) o[r] = 0.f;
          const float* w2p = w2 + j * 128 * 128 + n;
          for (int k = 0; k < 128; ++k) { const float w = w2p[k * 128];
#pragma unroll
              for (int r = 0; r < 8; ++r) o[r] += hid[(8 * cq + r) * 128 + k] * w; }
#pragma unroll
          for (int r = 0; r < 8; ++r) ob[(8 * cq + r) * 128 + n] = o[r]; }
        __syncthreads();
        bf16* fr = (bf16*)(a.ws + (j == 0 ? WS_KC : WS_VC)) + (size_t)bg * 8 * 4096;
#pragma unroll 1
        for (int r = 0; r < 4; ++r) { const int cr = 4 * wave + r, c = c0 + cr; float v0 = ob[cr * 128 + 2 * lane], v1 = ob[cr * 128 + 2 * lane + 1];
            if (j == 0) { const float rstd = rsqrtf(wave_sum(v0 * v0 + v1 * v1) * (1.f / 128.f) + EPS); v0 = v0 * rstd * kg0[2 * lane]; v1 = v1 * rstd * kg0[2 * lane + 1]; }
            if (c >= NC) { v0 = 0.f; v1 = 0.f; }
            if (j == 0) *(unsigned*)(fr + kf_off(c, 2 * lane)) = pk2(v0, v1);
            else { fr[vf_off(c, 2 * lane)] = (bf16)f2bf(v0); fr[vf_off(c, 2 * lane + 1)] = (bf16)f2bf(v1); } }
        __syncthreads();
    }
}

#define KBI(i) (16 * ((i) >> 3) + ((i) & 7))
__device__ __forceinline__ void load_frags(bf16x8 (&f)[8], const v4u* p, int lane) {
#pragma unroll
    for (int i = 0; i < 8; ++i) f[i] = __builtin_bit_cast(bf16x8, p[i * 64 + lane]);
}
__device__ __forceinline__ f32x16 qk_mma(const bf16x8 (&qf)[8], const bf16x8 (&k)[8]) {
    f32x16 s;
#pragma unroll
    for (int i = 0; i < 16; ++i) s[i] = 0.f;
#pragma unroll
    for (int st = 0; st < 8; ++st) s = __builtin_amdgcn_mfma_f32_32x32x16_bf16(k[st], qf[st], s, 0, 0, 0);
    return s;
}
__device__ __forceinline__ f32x16 qk_tile(const bf16x8 (&qf)[8], const v4u* kf, int lane) { bf16x8 k[8]; load_frags(k, kf, lane); return qk_mma(qf, k); }
template <int STRIDE> __device__ __forceinline__ void add_tbl(f32x16& s, const LAS float* tp2, float pen) {
#pragma unroll
    for (int i = 0; i < 16; ++i) s[i] += tp2[STRIDE * (23 - KBI(i))] + pen;
}
__device__ __forceinline__ void mask_hi(f32x16& s, int lim) {
#pragma unroll
    for (int i = 0; i < 16; ++i) s[i] = (KBI(i) <= lim) ? s[i] : NEGB;
}
__device__ __forceinline__ void mask_lo(f32x16& s, int lim) {
#pragma unroll
    for (int i = 0; i < 16; ++i) s[i] = (KBI(i) >= lim) ? s[i] : NEGB;
}
__device__ __forceinline__ float max16(const f32x16& s) {
    float mx = fmaxf(s[0], s[1]);
#pragma unroll
    for (int i = 2; i < 16; ++i) mx = fmaxf(mx, s[i]);
    return fmaxf(mx, __shfl_xor(mx, 32));
}
__device__ __forceinline__ void pv_tile(const f32x16& p, f32x16 (&o)[4], const bf16x8 (&v)[8]) {
    v4u a0, a1;
    a0.x = pkbf(p[0], p[1]); a0.y = pkbf(p[2], p[3]); a0.z = pkbf(p[4], p[5]); a0.w = pkbf(p[6], p[7]);
    a1.x = pkbf(p[8], p[9]); a1.y = pkbf(p[10], p[11]); a1.z = pkbf(p[12], p[13]); a1.w = pkbf(p[14], p[15]);
    const bf16x8 pb0 = __builtin_bit_cast(bf16x8, a0), pb1 = __builtin_bit_cast(bf16x8, a1);
#pragma unroll
    for (int dt = 0; dt < 4; ++dt) { o[dt] = __builtin_amdgcn_mfma_f32_32x32x16_bf16(v[2 * dt], pb0, o[dt], 0, 0, 0); o[dt] = __builtin_amdgcn_mfma_f32_32x32x16_bf16(v[2 * dt + 1], pb1, o[dt], 0, 0, 0); }
}
__device__ __forceinline__ void softmax_pv(f32x16& s, f32x16 (&o)[4], float& m, float& l, const v4u* vf, int lane) {
    bf16x8 v[8];
#pragma unroll
    for (int i = 0; i < 8; ++i) v[i] = __builtin_bit_cast(bf16x8, vf[i * 64 + lane]);
    const float mn = fmaxf(m, max16(s));
    if (__ballot(mn > m + 8.f)) {
        const float corr = ex2(m - mn);
#pragma unroll
        for (int dt = 0; dt < 4; ++dt)
#pragma unroll
            for (int i = 0; i < 16; ++i) o[dt][i] *= corr;
        l *= corr; m = mn;
    }
    float ps = 0.f;
#pragma unroll
    for (int i = 0; i < 16; ++i) { s[i] = ex2(s[i] - m); ps += s[i]; }
    l += ps;
    pv_tile(s, o, v);
}
template <int NP = 0> __device__ __forceinline__ void softmax_pv_v(f32x16& s, f32x16 (&o)[4], float& m, float& l, const bf16x8 (&v)[8]) {
    if (NP == 2) { l += s[0]; pv_tile(s, o, v); return; }
    const float mn = fmaxf(m, max16(s));
    if (__ballot(mn > m + 8.f)) {
        const float corr = ex2(m - mn);
#pragma unroll
        for (int dt = 0; dt < 4; ++dt)
#pragma unroll
            for (int i = 0; i < 16; ++i) o[dt][i] *= corr;
        l *= corr; m = mn;
    }
    float ps = 0.f;
#pragma unroll
    for (int i = 0; i < 16; ++i) { s[i] = ex2(s[i] - m); ps += s[i]; }
    l += ps;
    pv_tile(s, o, v);
}
__device__ __forceinline__ void zero_o(f32x16 (&o)[4]) {
#pragma unroll
    for (int dt = 0; dt < 4; ++dt)
#pragma unroll
        for (int i = 0; i < 16; ++i) o[dt][i] = 0.f;
}
__device__ __forceinline__ void y_update(bf16* yp  , const f32x16 (&o)[4], float sc, bool acc) {
#pragma unroll
    for (int dt = 0; dt < 4; ++dt)
#pragma unroll
        for (int i4 = 0; i4 < 4; ++i4) { bf16* p = yp + 32 * dt + 8 * i4;
            float v0 = o[dt][4 * i4] * sc, v1 = o[dt][4 * i4 + 1] * sc, v2 = o[dt][4 * i4 + 2] * sc, v3 = o[dt][4 * i4 + 3] * sc;
            if (acc) { const v2u w = *(const v2u*)p; v0 += bflo(w.x); v1 += bfhi(w.x); v2 += bflo(w.y); v3 += bfhi(w.y); }
            v2u w; w.x = pkbf(v0, v1); w.y = pkbf(v2, v3); *(v2u*)p = w; }
}
constexpr int TBLN = 2624;
constexpr int OFF_TBL = 0, OFF_IMP = 43008, OFF_SELM = OFF_IMP + 65536, OFF_DTBL = OFF_SELM + 512;
constexpr int FAR_DIST = 1513;

template <int NP> __device__ __forceinline__ void nsa_unit(const Args& a, LAS unsigned char* lds, int u, int tid) {
    const int lane = tid & 63, wave = __builtin_amdgcn_readfirstlane(tid >> 6);
    const int qb = u >> 3, bg = u & 7, b = bg >> 1, g = bg & 1;
    const int r = wave >> 1, qs = wave & 1, hd = g * 4 + r, ql = lane & 31, h = lane >> 5;
    const int q0w = 64 * qb + 32 * qs, sq = q0w + ql, t = b * S + sq;
    LAS float* tball = (LAS float*)(lds + OFF_TBL);
    LAS float* imp = (LAS float*)(lds + OFF_IMP);
    LAS unsigned long long* selm = (LAS unsigned long long*)(lds + OFF_SELM);
    const float* relb = a.in[22];
    for (int i = tid; i < 4 * TBLN; i += NTHREADS) { const int hh = i / TBLN, dd = i % TBLN - 64; tball[i] = dd >= 0 ? relb[(g * 4 + hh) * 32 + t5_bucket(dd)] * LOG2E : 0.f; }
    for (int i = tid; i < 4 * 64 * 64; i += NTHREADS) imp[i] = 0.f;
    __syncthreads();
    const LAS float* tbl = tball + r * TBLN + 64;
    const float farc = relb[hd * 32 + 31] * LOG2E;
    bf16x8 qf[8];
    { const bf16* qrow = (const bf16*)(a.ws + WS_Q) + (size_t)t * NQ + hd * 128 + 8 * h;
#pragma unroll
      for (int st = 0; st < 8; ++st) qf[st] = __builtin_bit_cast(bf16x8, *(const v4u*)(qrow + 16 * st)); }
    const float* gt = (const float*)(a.ws + WS_GATES) + (size_t)t * 24 + hd * 3;
    const float g0 = gt[0], g1 = gt[1], g2 = gt[2];
    bf16* yp = (bf16*)(a.ws + (NP ? WS_H : WS_YN)) + (size_t)t * 1536 + hd * 128 + 4 * h;
    f32x16 o[4];
    {
        const v4u* kfc = (const v4u*)(a.ws + WS_KC) + (size_t)bg * 8 * 512; const v4u* vfc = (const v4u*)(a.ws + WS_VC) + (size_t)bg * 8 * 512;
        const int smax = q0w + 31, ncv = smax >= 31 ? ((smax - 31) >> 4) + 1 : 0, ntc = (ncv + 31) >> 5;
        float m = NEGB, l = 0.f;
        for (int tc = 0; tc < ntc; ++tc) {
            f32x16 s = qk_tile(qf, kfc + tc * 512, lane);
            const int dqc = sq - 31 - 512 * tc;
            if (q0w - 31 - 512 * tc - 496 >= FAR_DIST) {
#pragma unroll
                for (int i = 0; i < 16; ++i) s[i] += farc;
            } else add_tbl<16>(s, tbl + dqc - 16 * (8 * h + 23), 0.f);
            mask_hi(s, (dqc >> 4) - 8 * h);
            const float mn = fmaxf(m, max16(s));
            float ps = 0.f;
#pragma unroll
            for (int i = 0; i < 16; ++i) ps += ex2(s[i] - mn);
            l = l * ex2(m - mn) + ps; m = mn;
        }
        l += __shfl_xor(l, 32);
        const float inv = (sq >= 31) ? 1.f / l : 0.f;
        zero_o(o);
        LAS float* impq = imp + (r * 64 + 32 * qs + ql) * 64;
        for (int tc = 0; tc < ntc; ++tc) {
            f32x16 s = qk_tile(qf, kfc + tc * 512, lane);
            bf16x8 v[8];
#pragma unroll
            for (int i = 0; i < 8; ++i) v[i] = __builtin_bit_cast(bf16x8, vfc[tc * 512 + i * 64 + lane]);
            const int dqc = sq - 31 - 512 * tc;
            if (q0w - 31 - 512 * tc - 496 >= FAR_DIST) {
#pragma unroll
                for (int i = 0; i < 16; ++i) s[i] += farc;
            } else add_tbl<16>(s, tbl + dqc - 16 * (8 * h + 23), 0.f);
            mask_hi(s, (dqc >> 4) - 8 * h);
#pragma unroll
            for (int i = 0; i < 16; ++i) s[i] = ex2(s[i] - m) * inv;
#pragma unroll
            for (int a2 = 0; a2 < 2; ++a2)
#pragma unroll
                for (int bq = 0; bq < 2; ++bq) { const int j = 8 * tc + 4 * a2 + 2 * h + bq; const int i0 = 8 * a2 + 4 * bq;
                    impq[j] += (s[i0] + s[i0 + 1]) + (s[i0 + 2] + s[i0 + 3]); }
            asm volatile("s_waitcnt lgkmcnt(0)" ::: "memory");
#pragma unroll
            for (int a2 = 0; a2 < 2; ++a2)
#pragma unroll
                for (int bq = 0; bq < 2; ++bq) { const int j = 8 * tc + 4 * a2 + 2 * h + bq + 1; if (j < 64) impq[j] += s[8 * a2 + 4 * bq + 3]; }
            asm volatile("s_waitcnt lgkmcnt(0)" ::: "memory");
            pv_tile(s, o, v);
        }
        y_update(yp, o, g0, false);
    }
    __syncthreads();
    for (int qq = wave * 8; qq < wave * 8 + 8; ++qq) {
        const int jb = lane;
        const float im = ((imp[(0 * 64 + qq) * 64 + jb] + imp[(1 * 64 + qq) * 64 + jb]) + imp[(2 * 64 + qq) * 64 + jb]) + imp[(3 * 64 + qq) * 64 + jb];
        const bool forced = (jb == 0) || (jb == qb) || (jb == qb - 1);
        const float score = forced ? 1e4f : (jb > qb ? -1e4f : im);
        int rank = 0;
        for (int o2 = 0; o2 < 64; ++o2) { const float so = __shfl(score, o2); rank += (so > score) || (so == score && o2 < jb); }
        const unsigned long long mask = __ballot(rank < 16 && jb <= qb);
        if (lane == 0) selm[qq] = mask;
    }
    __syncthreads();
    {
        const v4u* kfw = (const v4u*)fr_nsa(a, bg, 2); const v4u* vfw = (const v4u*)fr_nsa(a, bg, 3);
        const int t_hi = q0w >> 5, t_lo = t_hi - 16;
        float m = NEGB, l = 0.f; zero_o(o);
        const int t0 = t_lo < 0 ? 0 : t_lo;
        for (int tt = t0; tt <= t_hi; ++tt) {
            const size_t to = (NP == 3) ? (size_t)(tt & 1) * 512 : (size_t)tt * 512;
            bf16x8 kf[8], vf[8]; load_frags(kf, kfw + to, lane);
            f32x16 s = qk_mma(qf, kf); load_frags(vf, vfw + to, lane);
            const int dq = sq - 32 * tt;
            add_tbl<1>(s, tbl + dq - (8 * h + 23), 0.f);
            if (tt == t_hi) mask_hi(s, dq - 8 * h);
            if (tt == t_lo) mask_lo(s, dq - 511 - 8 * h);
            softmax_pv_v<NP>(s, o, m, l, vf);
        }
        l += __shfl_xor(l, 32);
        y_update(yp, o, g2 / l, true);
    }
    {
        const v4u* kfs = (const v4u*)fr_nsa(a, bg, 0); const v4u* vfs = (const v4u*)fr_nsa(a, bg, 1);
        const unsigned long long mask = selm[32 * qs + ql];
        float m = NEGB, l = 0.f; zero_o(o);
        const int t_end = 2 * qb + qs;
        for (int tt = 0; tt <= 2 * qb + 1; ++tt) {
            if (tt > t_end) continue;
            const float pen = ((mask >> (tt >> 1)) & 1ull) ? 0.f : NEGB;
            if (__ballot(pen == 0.f) == 0ull) continue;
            const size_t to = (NP == 3) ? (size_t)(tt & 1) * 512 : (size_t)tt * 512;
            bf16x8 kf[8], vf[8]; load_frags(kf, kfs + to, lane);
            f32x16 s = qk_mma(qf, kf); load_frags(vf, vfs + to, lane);
            const int dq = sq - 32 * tt;
            if (q0w - (32 * tt + 31) >= FAR_DIST) {
                const float c = farc + pen;
#pragma unroll
                for (int i = 0; i < 16; ++i) s[i] += c;
            } else add_tbl<1>(s, tbl + dq - (8 * h + 23), pen);
            if (tt == t_end) mask_hi(s, dq - 8 * h);
            softmax_pv_v<NP>(s, o, m, l, vf);
        }
        l += __shfl_xor(l, 32);
        y_update(yp, o, g1 / l, true);
    }
    __syncthreads();
}
__device__ __forceinline__ void dil_unit(const Args& a, LAS unsigned char* lds, int u, int tid) {
    const int lane = tid & 63, wave = __builtin_amdgcn_readfirstlane(tid >> 6), ql = lane & 31, h = lane >> 5;
    const int b = u >> 6, p = (u >> 4) & 3, c = u & 15, s0 = 256 * c;
    LAS float* dtbl = (LAS float*)(lds + OFF_DTBL);
    const float* relb = a.in[22] + 8 * 32;
    for (int i = tid; i < 3 * 192; i += NTHREADS) { const int gi = i / 192, dm = i % 192 - 32; dtbl[i] = dm >= 0 ? relb[(gi * 4 + p) * 32 + t5_bucket(dm << (2 * gi))] * LOG2E : 0.f; }
    __syncthreads();
    bf16* OD = (bf16*)(a.ws + WS_OD); float* LSE = (float*)(a.ws + WS_LSE);
    const bf16* DL = (const bf16*)(a.ws + WS_DL);
    for (int job = wave; job < 32; job += NWAVES) {
        int gi, rr, m0, vlo, vhi;
        if (job < 8) { gi = 0; rr = 0; m0 = s0 + 32 * job; vlo = 0; vhi = 32; }
        else if (job < 16) { gi = 1; rr = (job - 8) >> 1; m0 = (s0 >> 2) + 32 * (job & 1); vlo = 0; vhi = 32; }
        else { gi = 2; rr = job - 16; m0 = 32 * (c >> 1); vlo = 16 * (c & 1); vhi = vlo + 16; }
        const int dsh = 2 * gi, L = S >> dsh, head = gi * 4 + p;
        const int mq = m0 + ql, sact = (mq << dsh) + rr, t = b * S + sact;
        const v4u* kf = (const v4u*)fr_dil(a, b, head, 0) + (size_t)((rr * L) >> 5) * 512; const v4u* vf = (const v4u*)fr_dil(a, b, head, 1) + (size_t)((rr * L) >> 5) * 512;
        bf16x8 qf[8];
        { const bf16* qrow = DL + (size_t)t * NDL + head * 128 + 8 * h;
#pragma unroll
          for (int st = 0; st < 8; ++st) qf[st] = __builtin_bit_cast(bf16x8, *(const v4u*)(qrow + 16 * st)); }
        const LAS float* tb = dtbl + gi * 192 + 32;
        const int t_hi = m0 >> 5, t_lo = t_hi - 4;
        float m = NEGB, l = 0.f; f32x16 o[4]; zero_o(o);
        const int t0 = t_lo < 0 ? 0 : t_lo;
        for (int tt = t0; tt <= t_hi; ++tt) {
            bf16x8 kr[8], vr[8]; load_frags(kr, kf + (size_t)tt * 512, lane);
            f32x16 s = qk_mma(qf, kr); load_frags(vr, vf + (size_t)tt * 512, lane);
            const int dq = mq - 32 * tt;
            add_tbl<1>(s, tb + dq - (8 * h + 23), 0.f);
            if (tt == t_hi) mask_hi(s, dq - 8 * h);
            if (tt == t_lo) mask_lo(s, dq - 128 - 8 * h);
            softmax_pv_v(s, o, m, l, vr);
        }
        l += __shfl_xor(l, 32);
        if (ql >= vlo && ql < vhi) {
            y_update(OD + ((size_t)gi * T + t) * 512 + p * 128 + 4 * h, o, 1.f / l, false);
            if (h == 0) LSE[((size_t)(gi * NB + b) * 4 + p) * S + sact] = m + __log2f(l);
        }
    }
    __syncthreads();
    { const int pos = tid >> 1, dh = tid & 1, sact = s0 + pos, t = b * S + sact;
      const float l0 = LSE[((size_t)(0 * NB + b) * 4 + p) * S + sact], l1 = LSE[((size_t)(1 * NB + b) * 4 + p) * S + sact], l2 = LSE[((size_t)(2 * NB + b) * 4 + p) * S + sact];
      const float mx = fmaxf(l0, fmaxf(l1, l2)); float w0 = ex2(l0 - mx), w1 = ex2(l1 - mx), w2 = ex2(l2 - mx); const float iw = 1.f / (w0 + w1 + w2); w0 *= iw; w1 *= iw; w2 *= iw;
      bf16* yd = (bf16*)(a.ws + WS_YN) + (size_t)t * 1536 + 1024 + p * 128 + 64 * dh;
      const bf16* o0 = OD + ((size_t)0 * T + t) * 512 + p * 128 + 64 * dh; const bf16* o1 = OD + ((size_t)1 * T + t) * 512 + p * 128 + 64 * dh; const bf16* o2 = OD + ((size_t)2 * T + t) * 512 + p * 128 + 64 * dh;
#pragma unroll
      for (int k = 0; k < 8; ++k) { const v4u x0 = *(const v4u*)(o0 + 8 * k), x1 = *(const v4u*)(o1 + 8 * k), x2 = *(const v4u*)(o2 + 8 * k); v4u y;
          y.x = pkbf(w0 * bflo(x0.x) + w1 * bflo(x1.x) + w2 * bflo(x2.x), w0 * bfhi(x0.x) + w1 * bfhi(x1.x) + w2 * bfhi(x2.x));
          y.y = pkbf(w0 * bflo(x0.y) + w1 * bflo(x1.y) + w2 * bflo(x2.y), w0 * bfhi(x0.y) + w1 * bfhi(x1.y) + w2 * bfhi(x2.y));
          y.z = pkbf(w0 * bflo(x0.z) + w1 * bflo(x1.z) + w2 * bflo(x2.z), w0 * bfhi(x0.z) + w1 * bfhi(x1.z) + w2 * bfhi(x2.z));
          y.w = pkbf(w0 * bflo(x0.w) + w1 * bflo(x1.w) + w2 * bflo(x2.w), w0 * bfhi(x0.w) + w1 * bfhi(x1.w) + w2 * bfhi(x2.w));
          *(v4u*)(yd + 8 * k) = y; } }
    __syncthreads();
}
__device__ __forceinline__ void ph4_attention(const Args& a, LAS unsigned char* lds) {
    const int tid = phase_tid();
    for (int u = blockIdx.x; u < 256; u += gridDim.x) dil_unit(a, lds, u, tid);
#ifndef PROBE_NSA
#define PROBE_NSA 0
#endif
    if (PROBE_NSA) for (int x = blockIdx.x; x < 256; x += gridDim.x) { nsa_unit<PROBE_NSA>(a, lds, 511 - x, tid); nsa_unit<PROBE_NSA>(a, lds, x, tid); }
    for (int x = blockIdx.x; x < 256; x += gridDim.x) { nsa_unit<0>(a, lds, 511 - x, tid); nsa_unit<0>(a, lds, x, tid); }
}

typedef float f32x2 __attribute__((ext_vector_type(2)));
constexpr size_t WS_PU8 = WS_Q;
constexpr size_t WS_PV8 = WS_Q + 32 * MiB;
constexpr size_t WS_PSC = WS_Q + 64 * MiB;
__device__ __forceinline__ void ph_quant_uv(const Args& a) {
    const int tid = phase_tid(), lane = tid & 63, wave = __builtin_amdgcn_readfirstlane(tid >> 6);
    const int gw = blockIdx.x * NWAVES + wave, NGW = gridDim.x * NWAVES;
    float* SC = (float*)(a.ws + WS_PSC);
    for (int rw = gw; rw < NE; rw += NGW) {
        f32x4 x[2][8];
#pragma unroll
        for (int which = 0; which < 2; ++which) { const float* src = a.in[20 + which] + (size_t)rw * D + 16 * lane;
#pragma unroll
            for (int c = 0; c < 2; ++c)
#pragma unroll
                for (int w = 0; w < 4; ++w) x[which][4 * c + w] = *(const f32x4*)(src + 1024 * c + 4 * w); }
#pragma unroll
        for (int which = 0; which < 2; ++which) {
            unsigned char* dst = a.ws + (which ? WS_PV8 : WS_PU8) + (size_t)rw * 1024 + 16 * lane;
            float ss = 0.f;
#pragma unroll
            for (int i = 0; i < 8; ++i) ss += (x[which][i].x * x[which][i].x + x[which][i].y * x[which][i].y) + (x[which][i].z * x[which][i].z + x[which][i].w * x[which][i].w);
            ss = wave_sum(ss);
            const float step = 0.48f * sqrtf(ss * (1.f / D));
            const float inv = step > 0.f ? 1.f / step : 0.f;
            v4u o; unsigned wd[4];
#pragma unroll
            for (int wi = 0; wi < 4; ++wi) { unsigned q = 0u;
                const f32x4 va = x[which][2 * wi], vb = x[which][2 * wi + 1];
                q = __builtin_amdgcn_cvt_scalef32_pk_fp4_f32(q, __builtin_amdgcn_fmed3f(va.x * inv, -6.f, 6.f), __builtin_amdgcn_fmed3f(va.y * inv, -6.f, 6.f), 1.0f, 0);
                q = __builtin_amdgcn_cvt_scalef32_pk_fp4_f32(q, __builtin_amdgcn_fmed3f(va.z * inv, -6.f, 6.f), __builtin_amdgcn_fmed3f(va.w * inv, -6.f, 6.f), 1.0f, 1);
                q = __builtin_amdgcn_cvt_scalef32_pk_fp4_f32(q, __builtin_amdgcn_fmed3f(vb.x * inv, -6.f, 6.f), __builtin_amdgcn_fmed3f(vb.y * inv, -6.f, 6.f), 1.0f, 2);
                q = __builtin_amdgcn_cvt_scalef32_pk_fp4_f32(q, __builtin_amdgcn_fmed3f(vb.z * inv, -6.f, 6.f), __builtin_amdgcn_fmed3f(vb.w * inv, -6.f, 6.f), 1.0f, 3);
                wd[wi] = q; }
            o.x = wd[0]; o.y = wd[1]; o.z = wd[2]; o.w = wd[3]; *(v4u*)dst = o;
            if (lane == 0) SC[which * NE + rw] = step;
        }
    }
}
constexpr size_t WS_KEYF = 601 * MiB;
constexpr size_t WS_END3 = 602 * MiB;
__device__ __forceinline__ void ph0_keyfrags(const Args& a) {
    const int tid = phase_tid();
    const float* keys = a.in[19]; v4u* KF = (v4u*)(a.ws + WS_KEYF);
    for (int i = blockIdx.x * NTHREADS + tid; i < 16 * 32 * 64; i += gridDim.x * NTHREADS) {
        const int lane = i & 63, st = (i >> 6) & 7, kt = (i >> 9) & 3, hp = i >> 11;
        const float* src = keys + ((size_t)hp * 128 + 32 * kt + (lane & 31)) * 128 + 16 * st + 8 * (lane >> 5);
        float v[8]; unsigned hi[8], lo[8];
#pragma unroll
        for (int j = 0; j < 8; ++j) { v[j] = src[j]; hi[j] = f2bf(v[j]); lo[j] = f2bf(v[j] - __builtin_bit_cast(float, hi[j] << 16)); }
        v4u oh, ol; oh.x = hi[0] | (hi[1] << 16); oh.y = hi[2] | (hi[3] << 16); oh.z = hi[4] | (hi[5] << 16); oh.w = hi[6] | (hi[7] << 16);
        ol.x = lo[0] | (lo[1] << 16); ol.y = lo[2] | (lo[3] << 16); ol.z = lo[4] | (lo[5] << 16); ol.w = lo[6] | (lo[7] << 16);
        KF[(size_t)((hp * 2 + 0) * 32 + kt * 8 + st) * 64 + lane] = oh; KF[(size_t)((hp * 2 + 1) * 32 + kt * 8 + st) * 64 + lane] = ol;
    }
}
template <int N, bool MERGE_ONLY> __device__ __forceinline__ void bitonic_desc(float (&v)[N]) {
#pragma unroll
    for (int k = MERGE_ONLY ? N : 2; k <= N; k <<= 1)
#pragma unroll
        for (int j = k >> 1; j > 0; j >>= 1)
#pragma unroll
            for (int i = 0; i < N; ++i) { const int l = i ^ j;
                if (l > i) { const bool desc = ((i & k) == 0) || (k == N); const float x = v[i], y = v[l], hi = fmaxf(x, y), lo = fminf(x, y); v[i] = desc ? hi : lo; v[l] = desc ? lo : hi; } }
}
#define CROW(i) (((i) & 3) + 8 * ((i) >> 2))
__device__ __forceinline__ float max3f(float a, float b, float c) { return fmaxf(fmaxf(a, b), c); }
__device__ __forceinline__ void ph_route(const Args& a, LAS unsigned char* lds) {
    const int tid = phase_tid(), lane = tid & 63, wave = __builtin_amdgcn_readfirstlane(tid >> 6), tl = lane & 31, hc = lane >> 5;
    const int gw = blockIdx.x * NWAVES + wave, NGW = gridDim.x * NWAVES;
    const float* QP = (const float*)(a.ws + WS_QP); const float* qgain = a.in[18]; const v4u* KF = (const v4u*)(a.ws + WS_KEYF);
    int* EI = (int*)(a.ws + WS_EI); float* EG = (float*)(a.ws + WS_EG);
    LAS float* spl = (LAS float*)(lds + wave * 8704) + lane * 33;
    for (int job = gw; job < (T / 32) * 8; job += NGW) {
        const int h = job & 7, t = (job >> 3) * 32 + tl;
#pragma unroll 1
        for (int p = 0; p < 2; ++p) {
            bf16x8 bh[8], bl[8];
            { const float* qr = QP + (size_t)t * D + h * 256 + p * 128 + 8 * hc; const float* gr = qgain + (h * 2 + p) * 128 + 8 * hc;
              float ss = 0.f;
#pragma unroll
              for (int st = 0; st < 8; ++st) { const f32x4 x0 = *(const f32x4*)(qr + 16 * st), x1 = *(const f32x4*)(qr + 16 * st + 4);
                  ss += (x0.x * x0.x + x0.y * x0.y) + (x0.z * x0.z + x0.w * x0.w) + (x1.x * x1.x + x1.y * x1.y) + (x1.z * x1.z + x1.w * x1.w); }
              ss += __shfl_xor(ss, 32);
              const float rstd = rsqrtf(ss * (1.f / 128.f) + EPS);
              asm volatile("" ::: "memory");
#pragma unroll
              for (int st = 0; st < 8; ++st) { const f32x4 x0 = *(const f32x4*)(qr + 16 * st), x1 = *(const f32x4*)(qr + 16 * st + 4); const f32x4 g0 = *(const f32x4*)(gr + 16 * st), g1 = *(const f32x4*)(gr + 16 * st + 4);
                  const float v0 = x0.x * rstd * g0.x, v1 = x0.y * rstd * g0.y, v2 = x0.z * rstd * g0.z, v3 = x0.w * rstd * g0.w, v4 = x1.x * rstd * g1.x, v5 = x1.y * rstd * g1.y, v6 = x1.z * rstd * g1.z, v7 = x1.w * rstd * g1.w;
                  v4u xh, xl; xh.x = pkbf(v0, v1); xh.y = pkbf(v2, v3); xh.z = pkbf(v4, v5); xh.w = pkbf(v6, v7);
                  xl.x = pkbf(v0 - bflo(xh.x), v1 - bfhi(xh.x)); xl.y = pkbf(v2 - bflo(xh.y), v3 - bfhi(xh.y)); xl.z = pkbf(v4 - bflo(xh.z), v5 - bfhi(xh.z)); xl.w = pkbf(v6 - bflo(xh.w), v7 - bfhi(xh.w));
                  bh[st] = __builtin_bit_cast(bf16x8, xh); bl[st] = __builtin_bit_cast(bf16x8, xl); } }
            float sc[64];
            const v4u* kfh = KF + (size_t)(((h * 2 + p) * 2 + 0) * 32) * 64 + lane; const v4u* kfl = KF + (size_t)(((h * 2 + p) * 2 + 1) * 32) * 64 + lane;
#pragma unroll
            for (int kt = 0; kt < 4; ++kt) {
                f32x16 acc;
#pragma unroll
                for (int i = 0; i < 16; ++i) acc[i] = 0.f;
#pragma unroll
                for (int s2 = 0; s2 < 2; ++s2) {
                    asm volatile("" ::: "memory");
                    bf16x8 ah[4], al[4];
#pragma unroll
                    for (int s4 = 0; s4 < 4; ++s4) { ah[s4] = __builtin_bit_cast(bf16x8, kfh[(kt * 8 + s2 * 4 + s4) * 64]); al[s4] = __builtin_bit_cast(bf16x8, kfl[(kt * 8 + s2 * 4 + s4) * 64]); }
#pragma unroll
                    for (int s4 = 0; s4 < 4; ++s4) { const int st = s2 * 4 + s4;
                        acc = __builtin_amdgcn_mfma_f32_32x32x16_bf16(al[s4], bh[st], acc, 0, 0, 0); acc = __builtin_amdgcn_mfma_f32_32x32x16_bf16(ah[s4], bl[st], acc, 0, 0, 0); acc = __builtin_amdgcn_mfma_f32_32x32x16_bf16(ah[s4], bh[st], acc, 0, 0, 0); }
                }
#pragma unroll
                for (int i = 0; i < 16; ++i) { const float av = acc[i];
                    const unsigned bits = (__builtin_bit_cast(unsigned, av) & ~127u) | (unsigned)(127 - (32 * kt + CROW(i) + 4 * hc)); sc[16 * kt + i] = __builtin_bit_cast(float, bits); }
            }
            asm volatile("" ::: "memory");
            bitonic_desc<64, false>(sc);
            float t16[16];
#pragma unroll
            for (int i = 0; i < 16; ++i) t16[i] = __shfl_xor(sc[i], 32);
            float u16[16];
#pragma unroll
            for (int i = 0; i < 16; ++i) u16[i] = fmaxf(sc[i], t16[15 - i]);
            bitonic_desc<16, true>(u16);
#pragma unroll
            for (int i = 0; i < 16; ++i) spl[p * 16 + i] = u16[i];
        }
        asm volatile("s_waitcnt lgkmcnt(0)" ::: "memory");
        float sp[2][16];
#pragma unroll
        for (int i = 0; i < 16; ++i) { sp[0][i] = spl[i]; sp[1][i] = spl[16 + i]; }
        float cv[64];
        {
            int c = 0;
#pragma unroll
            for (int i = 0; i < 16; ++i)
#pragma unroll
                for (int j = 0; j < 16; ++j) if ((i + 1) * (j + 1) <= 16) {
                    const float v = sp[0][i] + sp[1][j];
                    cv[c] = __builtin_bit_cast(float, (__builtin_bit_cast(unsigned, v) & ~255u) | (unsigned)(255 - (i * 16 + j))); ++c; }
#pragma unroll
            for (int i = 50; i < 64; ++i) cv[i] = -INFINITY;
        }
        bitonic_desc<64, false>(cv);
        float tv[16];
#pragma unroll
        for (int i = 0; i < 16; ++i) tv[i] = cv[i];
        asm volatile("s_waitcnt lgkmcnt(0)" ::: "memory");
        int te[16]; float den = 0.f; const float top = tv[0];
#pragma unroll
        for (int i = 0; i < 16; ++i) { const int flat = 255 - (int)(__builtin_bit_cast(unsigned, tv[i]) & 255u);
            const unsigned b1 = __builtin_bit_cast(unsigned, spl[flat >> 4]), b2 = __builtin_bit_cast(unsigned, spl[16 + (flat & 15)]);
            te[i] = (127 - (int)(b1 & 127u)) * 128 + (127 - (int)(b2 & 127u));
            tv[i] = __expf(tv[i] - top); den += tv[i]; }
        den = 1.f / den;
        if (hc == 0) {
            int* ei = EI + (size_t)t * 128 + h * 16; float* eg = EG + (size_t)t * 128 + h * 16;
#pragma unroll
            for (int i = 0; i < 16; i += 4) { *(v4u*)(ei + i) = (v4u){(unsigned)te[i], (unsigned)te[i + 1], (unsigned)te[i + 2], (unsigned)te[i + 3]}; *(f32x4*)(eg + i) = (f32x4){tv[i] * den, tv[i + 1] * den, tv[i + 2] * den, tv[i + 3] * den}; }
        }
        asm volatile("s_waitcnt lgkmcnt(0)" ::: "memory");
    }
}
__device__ __forceinline__ void ph_experts(const Args& a, const float osc) {
    const int tid = phase_tid(), lane = tid & 63, wave = __builtin_amdgcn_readfirstlane(tid >> 6);
    const int gw = blockIdx.x * NWAVES + wave, NGW = gridDim.x * NWAVES;
    const bf16* H2 = (const bf16*)(a.ws + WS_H); const unsigned char* PU = a.ws + WS_PU8; const unsigned char* PV = a.ws + WS_PV8; const unsigned l16 = 16u * lane; const float* SC = (const float*)(a.ws + WS_PSC);
    const int* EI = (const int*)(a.ws + WS_EI); const float* EG = (const float*)(a.ws + WS_EG);
    const float* mod = (const float*)(a.ws + WS_MOD);
    float* out = a.out;
    v4u wa[8], wb[8];
#define EX_LOAD(buf, tab, esel, base) do { _Pragma("unroll") for (int k = 0; k < 8; ++k) { const unsigned e = (unsigned)__builtin_amdgcn_readlane(esel, ((base) + k) & 63); buf[k] = *(const v4u*)((tab) + ((size_t)e << 10) + l16); } __builtin_amdgcn_sched_barrier(0); } while (0)
#define EX_U(buf, bt) do { _Pragma("unroll") for (int k = 0; k < 8; ++k) { f32x2 s = {0.f, 0.f}; const unsigned q[4] = {buf[k].x, buf[k].y, buf[k].z, buf[k].w}; \
            _Pragma("unroll") for (int wi = 0; wi < 4; ++wi) { \
                s += x[4 * wi + 0] * __builtin_amdgcn_cvt_scalef32_pk_f32_fp4(q[wi], 1.0f, 0); s += x[4 * wi + 1] * __builtin_amdgcn_cvt_scalef32_pk_f32_fp4(q[wi], 1.0f, 1); \
                s += x[4 * wi + 2] * __builtin_amdgcn_cvt_scalef32_pk_f32_fp4(q[wi], 1.0f, 2); s += x[4 * wi + 3] * __builtin_amdgcn_cvt_scalef32_pk_f32_fp4(q[wi], 1.0f, 3); } \
            const float raw = wave_sum(s.x + s.y); \
            if (lane == ((((bt) * 8) + k) & 63)) { if ((bt) < 8) cf0 = gelu_tanh(raw * su0) * gs0; else cf1 = gelu_tanh(raw * su1) * gs1; } } } while (0)
#define EX_V(buf, bt) do { _Pragma("unroll") for (int k = 0; k < 8; ++k) { const float cf = __builtin_bit_cast(float, __builtin_amdgcn_readlane(__builtin_bit_cast(int, (bt) < 8 ? cf0 : cf1), ((bt) * 8 + k) & 63)); const f32x2 cf2 = {cf, cf}; const unsigned q[4] = {buf[k].x, buf[k].y, buf[k].z, buf[k].w}; \
            _Pragma("unroll") for (int wi = 0; wi < 4; ++wi) { \
                acc[4 * wi + 0] += cf2 * __builtin_amdgcn_cvt_scalef32_pk_f32_fp4(q[wi], 1.0f, 0); acc[4 * wi + 1] += cf2 * __builtin_amdgcn_cvt_scalef32_pk_f32_fp4(q[wi], 1.0f, 1); \
                acc[4 * wi + 2] += cf2 * __builtin_amdgcn_cvt_scalef32_pk_f32_fp4(q[wi], 1.0f, 2); acc[4 * wi + 3] += cf2 * __builtin_amdgcn_cvt_scalef32_pk_f32_fp4(q[wi], 1.0f, 3); } } } while (0)
    int e0 = 0, e1 = 0;
    if (gw < T) { e0 = EI[(size_t)gw * 128 + lane]; e1 = EI[(size_t)gw * 128 + 64 + lane]; EX_LOAD(wa, PU, e0, 0); }
    for (int t = gw; t < T; t += NGW) {
        const int b = t / S, tn = t + NGW;
        f32x2 x[16];
#pragma unroll
        for (int c = 0; c < 2; ++c)
#pragma unroll
            for (int hw = 0; hw < 2; ++hw) { const v4u w = *(const v4u*)(H2 + (size_t)t * D + 1024 * c + 16 * lane + 8 * hw); const int o = 8 * c + 4 * hw;
                x[o + 0] = (f32x2){bflo(w.x), bfhi(w.x)}; x[o + 1] = (f32x2){bflo(w.y), bfhi(w.y)}; x[o + 2] = (f32x2){bflo(w.z), bfhi(w.z)}; x[o + 3] = (f32x2){bflo(w.w), bfhi(w.w)}; }
        int ne0 = 0, ne1 = 0;
        if (tn < T) { ne0 = EI[(size_t)tn * 128 + lane]; ne1 = EI[(size_t)tn * 128 + 64 + lane]; }
        const float gs0 = EG[(size_t)t * 128 + lane] * SC[NE + e0], gs1 = EG[(size_t)t * 128 + 64 + lane] * SC[NE + e1];
        const float su0 = SC[e0], su1 = SC[e1];
        float cf0 = 0.f, cf1 = 0.f;
#pragma unroll 1
        for (int i = 0; i < 7; ++i) {
            EX_LOAD(wb, PU, (i < 4 ? e0 : e1), (2 * i + 1) * 8);
            EX_U(wa, 2 * i);
            EX_LOAD(wa, PU, (i < 3 ? e0 : e1), (2 * i + 2) * 8);
            EX_U(wb, 2 * i + 1);
        }
        { EX_LOAD(wb, PU, e1, 15 * 8); EX_U(wa, 14); EX_LOAD(wa, PV, e0, 0); EX_U(wb, 15); }
        f32x2 acc[16];
#pragma unroll
        for (int i = 0; i < 16; ++i) acc[i] = (f32x2){0.f, 0.f};
#pragma unroll 1
        for (int i = 0; i < 7; ++i) {
            EX_LOAD(wb, PV, (i < 4 ? e0 : e1), (2 * i + 1) * 8);
            EX_V(wa, 2 * i);
            EX_LOAD(wa, PV, (i < 3 ? e0 : e1), (2 * i + 2) * 8);
            EX_V(wb, 2 * i + 1);
        }
        { EX_LOAD(wb, PV, e1, 15 * 8); EX_V(wa, 14); if (tn < T) EX_LOAD(wa, PU, ne0, 0); EX_V(wb, 15); }
        const float* g2 = mod + b * 12288 + 10240;
#pragma unroll
        for (int c = 0; c < 2; ++c)
#pragma unroll
            for (int w4 = 0; w4 < 4; ++w4) { float* op = out + (size_t)t * D + 1024 * c + 16 * lane + 4 * w4; const f32x4 ga = *(const f32x4*)(g2 + 1024 * c + 16 * lane + 4 * w4); f32x4 r0 = *(const f32x4*)op; const int o = 8 * c + 2 * w4;
                r0.x += ga.x * acc[o].x * osc; r0.y += ga.y * acc[o].y * osc; r0.z += ga.z * acc[o + 1].x * osc; r0.w += ga.w * acc[o + 1].y * osc;
                *(f32x4*)op = r0; }
        e0 = ne0; e1 = ne1;
    }
#undef EX_LOAD
#undef EX_U
#undef EX_V
}

constexpr int N_PHASES = 11;
__global__ void __launch_bounds__(NTHREADS, 2) fwd_kernel(Args a) {
    extern __shared__ __attribute__((aligned(16))) unsigned char lds_raw[];
    LAS unsigned char* lds = (LAS unsigned char*)lds_raw;
    const int tid = threadIdx.x;
    volatile LAS unsigned* misc = (volatile LAS unsigned*)(lds + LDS_MISC);
    if (tid < 16) misc[tid] = 0u;
    __syncthreads();
    XcdBarrier bar; bar.bar = (unsigned*)(a.ws + WS_CTL) + 1024; bar.x = 0; bar.st = nullptr;
    const int lo = a.ph_lo, hi = a.ph_hi;
    if (hi - lo > 1) bar = xcd_barrier_post((unsigned*)(a.ws + WS_CTL) + 1024, misc + 8);
#define IN(k) (lo <= (k) && (k) < hi)
#define SEAM(k) do { if (IN(k) && IN((k) + 1)) xcd_barrier(bar); } while (0)
    const int G = gridDim.x, bx = blockIdx.x;

    for (int rep = 0; rep < 1 + ((PROBE_DUP >> 0) & 1); ++rep)
    if (IN(0)) { ph0_mod(a, lds); __syncthreads(); ph0_weights(a, lds); ph0_keyfrags(a); ph0_extra(a); __syncthreads(); }
    SEAM(0);
    for (int rep = 0; rep < 1 + ((PROBE_DUP >> 1) & 1); ++rep)
    if (IN(1)) ph_norm<true>(a, a.in[0], a.in[4], 0, 2048, (bf16*)(a.ws + WS_H), a.ws + WS_H8);
    SEAM(1);
    for (int rep = 0; rep < 1 + ((PROBE_DUP >> 2) & 1); ++rep)
    if (IN(2)) { pg8::Gemm g{(const bf16*)(a.ws + WS_H8), (const bf16*)(a.ws + WS_WIN), T, NPROJ, D / 2}; pg8::StaticOrder So; So.init(T, NPROJ, G, bx);
        EpiProjNorm E{(bf16*)(a.ws + WS_Q), (bf16*)(a.ws + WS_KV), (bf16*)(a.ws + WS_DL), (bf16*)(a.ws + WS_MG), (bf16*)a.out, a.in[6], a.in[7], a.in[11], a.in[12], (LAS float*)(lds + 131072), 1.f / (F8_HS * F8_WS)};
        pg8::gemm_phase<EpiProjNorm, pg8::StaticOrder, pg8::NoMid, true>(lds, g, So, E); }
    SEAM(2);
    if (IN(3)) { for (int rep = 0; rep < 1 + ((PROBE_DUP >> 3) & 1); ++rep) { ph3_vfrag(a); ph3_gates(a); ph3_compress(a, lds); } }
    SEAM(3);
    for (int rep = 0; rep < 1 + ((PROBE_DUP >> 4) & 1); ++rep)
    if (IN(4)) ph4_attention(a, lds);
    SEAM(4);
    for (int rep = 0; rep < 1 + ((PROBE_DUP >> 5) & 1); ++rep)
    if (IN(5)) {
        { pg8::Gemm g{(const bf16*)(a.ws + WS_YN), (const bf16*)(a.ws + WS_WBN), T, D, 1536}; pg8::StaticOrder So; So.init(T, D, G, bx);
          EpiMerge E{(const bf16*)(a.ws + WS_MG), a.ws + WS_H, F8_MS}; MidMerge Mh{(const bf16*)(a.ws + WS_MG)};
          pg8::gemm_phase<EpiMerge, pg8::StaticOrder, MidMerge>(lds, g, So, E, Mh); }
    }
    SEAM(5);
    for (int rep = 0; rep < 1 + ((PROBE_DUP >> 6) & 1); ++rep)
    if (IN(6)) { pg8::Gemm g{(const bf16*)(a.ws + WS_H), (const bf16*)(a.ws + WS_WOUT), T, D, D / 2}; pg8::StaticOrder So; So.init(T, D, G, bx);
        EpiOut E{a.in[0], (const float*)(a.ws + WS_MOD), a.out, 1.f / (F8_MS * F8_WS)}; pg8::gemm_phase<EpiOut, pg8::StaticOrder, pg8::NoMid, true>(lds, g, So, E); }
    SEAM(6);
    for (int rep = 0; rep < 1 + ((PROBE_DUP >> 7) & 1); ++rep)
    if (IN(7)) { ph_norm(a, a.out, a.in[16], 6144, 8192, (bf16*)(a.ws + WS_H)); ph_quant_uv(a); }
    SEAM(7);
    for (int rep = 0; rep < 1 + ((PROBE_DUP >> 8) & 1); ++rep)
    if (IN(8)) { pg8::Gemm g{(const bf16*)(a.ws + WS_H), (const bf16*)(a.ws + WS_WPQ), T, D, D}; pg8::StaticOrder So; So.init(T, D, G, bx);
        EpiF32 E{(float*)(a.ws + WS_QP), D}; pg8::gemm_phase<EpiF32, pg8::StaticOrder>(lds, g, So, E); }
    SEAM(8);
    for (int rep = 0; rep < 1 + ((PROBE_DUP >> 9) & 1); ++rep)
    if (IN(9)) { ph_route(a, lds); __syncthreads(); }
    SEAM(9);
    if (IN(10)) { if ((PROBE_DUP >> 10) & 1) { ph_experts(a, *(const float*)(a.ws + WS_CTL + 64)); asm volatile("s_waitcnt vmcnt(0)" ::: "memory"); __syncthreads(); } ph_experts(a, 1.f); }
#undef IN
#undef SEAM
}

extern "C" void kernel_launch(void* const* d_in, const int* in_sizes, int n_in, void* d_out, int out_size, void* d_ws, size_t ws_size, hipStream_t stream) {
    static int grid = 0;
    if (grid == 0) {
        if (n_in != 23 || out_size != T * D || ws_size < WS_END4) { fprintf(stderr, "kernel_launch: unexpected problem shape (n_in %d, out %d, ws %zu); nothing launched\n", n_in, out_size, ws_size); grid = -1; return; }
        int dev = 0, cus = 0, per_cu = 0;
        if (hipGetDevice(&dev) != hipSuccess || hipDeviceGetAttribute(&cus, hipDeviceAttributeMultiprocessorCount, dev) != hipSuccess) { grid = -1; return; }
        if (hipFuncSetAttribute((const void*)fwd_kernel, hipFuncAttributeMaxDynamicSharedMemorySize, LDS_BYTES) != hipSuccess) { fprintf(stderr, "kernel_launch: hipFuncSetAttribute failed\n"); grid = -1; return; }
        if (hipOccupancyMaxActiveBlocksPerMultiprocessor(&per_cu, (const void*)fwd_kernel, NTHREADS, LDS_BYTES) != hipSuccess || per_cu < 1) { fprintf(stderr, "kernel_launch: occupancy query says %d\n", per_cu); }
        (void)hipGetLastError();
        grid = cus;
    }
    if (grid < 0) return;
    hipMemsetAsync((char*)d_ws + WS_CTL, 0, CTL_ZERO_BYTES, stream);
    Args a{};
    for (int i = 0; i < 23; ++i) a.in[i] = (const float*)d_in[i];
    a.out = (float*)d_out; a.ws = (unsigned char*)d_ws;
#if MK_ONE_LAUNCH
#if PROBE_PREFIX >= 0
    a.ph_lo = 0; a.ph_hi = PROBE_PREFIX + 1;
    hipLaunchKernelGGL(fwd_kernel, dim3(grid), dim3(NTHREADS), LDS_BYTES, stream, a);
    hipMemsetAsync((char*)d_ws + WS_CTL, 0, CTL_ZERO_BYTES, stream);
#endif
    a.ph_lo = 0; a.ph_hi = N_PHASES;
    hipLaunchKernelGGL(fwd_kernel, dim3(grid), dim3(NTHREADS), LDS_BYTES, stream, a);
#else
    for (int p = 0; p < N_PHASES; ++p) { a.ph_lo = p; a.ph_hi = p + 1; hipLaunchKernelGGL(fwd_kernel, dim3(grid), dim3(NTHREADS), LDS_BYTES, stream, a); }
#endif
}
```

```cpp
#include <hip/hip_runtime.h>
#include <cstdio>
#include <cstdint>

#ifndef PROBE_DUP
#define PROBE_DUP 0
#endif
#ifndef PROBE_PREFIX
#define PROBE_PREFIX -1
#endif
#ifndef MK_ONE_LAUNCH
#define MK_ONE_LAUNCH 1
#endif

__device__ __forceinline__ int phase_tid() { int t = threadIdx.x; asm volatile("" : "+v"(t)); return t; }
namespace pg8 {
#define PG8_LAS __attribute__((address_space(3)))
typedef unsigned short bf16_t;
typedef short bf16x8 __attribute__((ext_vector_type(8)));
typedef float f32x4 __attribute__((ext_vector_type(4)));
typedef unsigned u32x4 __attribute__((ext_vector_type(4)));
typedef unsigned u32x2 __attribute__((ext_vector_type(2)));
constexpr int BM = 256, BK = 64, HALF = 128, HTB = HALF * BK * 2, STAGE_BYTES = 8 * HTB, NXCD = 8, WGM = 8;

__host__ __device__ __forceinline__ int lds_byte(int r, int c) { const int st = (r >> 4) * 2 + (c >> 5), rr = r & 15, cc = c & 31, ob = rr * 64 + cc * 2; return st * 1024 + (ob ^ (((ob >> 9) & 1) << 5)); }
__host__ __device__ __forceinline__ void stage_rc(int b, int& R, int& C) { const int st = b / 1024, sb = b % 1024, swz = sb ^ (((sb >> 9) & 1) << 5); R = (st >> 1) * 16 + swz / 64; C = (st & 1) * 32 + (swz % 64) / 2; }
__host__ __device__ __forceinline__ int perm32(int rho) { const int n = rho >> 4, i = rho & 15; return 8 * (i >> 2) + 4 * n + (i & 3); }

struct Unit { int pm, pn; };
struct Gemm { const bf16_t* A; const bf16_t* Bt; int M, N, K; };

struct StaticOrder {
    int nM, nN, nwg, G, c;
    __host__ __device__ void init(int M, int N, int G_, int c_) { nM = M / BM; nN = N / BM; nwg = nM * nN; G = G_; c = c_; }
    __host__ __device__ bool next(int i, Unit& u) const {
        const long L = (long)i * G + c; if (L >= nwg) return false;
        int wgid = (int)L; { const int q = nwg / NXCD, r = nwg % NXCD, xcd = wgid % NXCD, off = wgid / NXCD; wgid = (xcd < r ? xcd * (q + 1) : r * (q + 1) + (xcd - r) * q) + off; }
        const int nig = WGM * nN, gid = wgid / nig, fm = gid * WGM, gsz = (nM - fm) < WGM ? (nM - fm) : WGM;
        u.pm = fm + ((wgid % nig) % gsz); u.pn = (wgid % nig) / gsz; return true;
    }
    __device__ __forceinline__ void a_ready(const Unit&) const {}
    __device__ __forceinline__ void done(const Unit&) const {}
};

__device__ __forceinline__ unsigned cvt_pk_bf16(float lo, float hi) { unsigned r; asm volatile("v_cvt_pk_bf16_f32 %0, %1, %2" : "=v"(r) : "v"(lo), "v"(hi)); return r; }

typedef int i32x4 __attribute__((ext_vector_type(4)));
typedef int i32x8 __attribute__((ext_vector_type(8)));
template <bool F8> __device__ __forceinline__ void mma_blk(f32x4 (&acc)[4][2], const bf16x8 (&At)[4][2], const bf16x8 (&Bt)[2][2]) {
    if constexpr (F8) {
#pragma unroll
        for (int m = 0; m < 4; ++m)
#pragma unroll
            for (int n = 0; n < 2; ++n) {
                const i32x8 bb = __builtin_shufflevector(__builtin_bit_cast(i32x4, Bt[n][0]), __builtin_bit_cast(i32x4, Bt[n][1]), 0, 1, 2, 3, 4, 5, 6, 7);
                const i32x8 aa = __builtin_shufflevector(__builtin_bit_cast(i32x4, At[m][0]), __builtin_bit_cast(i32x4, At[m][1]), 0, 1, 2, 3, 4, 5, 6, 7);
                asm volatile("v_mfma_f32_16x16x128_f8f6f4 %0, %1, %2, %0" : "+v"(acc[m][n]) : "v"(bb), "v"(aa)); }
    } else {
#pragma unroll
        for (int m = 0; m < 4; ++m)
#pragma unroll
            for (int n = 0; n < 2; ++n)
#pragma unroll
                for (int k = 0; k < 2; ++k) acc[m][n] = __builtin_amdgcn_mfma_f32_16x16x32_bf16(Bt[n][k], At[m][k], acc[m][n], 0, 0, 0);
    }
}
struct NoMid { static constexpr int AT = -1; __device__ __forceinline__ void operator()(f32x4 (&)[2][2][4][2], const Unit&, int, int, int, int) const {} };
template <class Epi, class Sched, class Mid = NoMid, bool F8 = false>
__device__ __forceinline__ void gemm_phase(PG8_LAS unsigned char* lds, const Gemm g, const Sched& S, const Epi& E, const Mid& Mh = Mid()) {
    const int tid = phase_tid(), wid = __builtin_amdgcn_readfirstlane(tid >> 6), lane = tid & 63, wr = wid >> 2, wc = wid & 3, fr = lane & 15, fq = lane >> 4;
    const int K = g.K, nt = K / BK;
    unsigned voffA[2], voffB[2];
#pragma unroll
    for (int i = 0; i < 2; ++i) { int R, C; stage_rc(tid * 16 + i * 8192, R, C); const int Rb = Epi::PERM ? ((R & ~31) + perm32(R & 31)) : R;
        voffA[i] = (unsigned)(R * K + C) * 2u; voffB[i] = (unsigned)(Rb * K + C) * 2u; }
    const size_t kstep = (size_t)(BK * 2);
    const size_t hstep = (size_t)HALF * K * 2;
    const size_t tstep = 2 * hstep;
    const unsigned ldsw = (unsigned)wid * 1024u;
    const int aoff = lds_byte(wr * 64 + fr, fq * 8), boff = lds_byte(wc * 32 + fr, fq * 8);
#define PG8_SA(b, h) (((b) * 2 + (h)) * HTB)
#define PG8_SB(b, h) ((4 + (b) * 2 + (h)) * HTB)
#define PG8_STAGE(bufoff, gbase, voff) do { _Pragma("unroll") for (int _i = 0; _i < 2; ++_i) \
        __builtin_amdgcn_global_load_lds((const unsigned*)((const char*)(gbase) + (voff)[_i]), (PG8_LAS unsigned*)(lds + (bufoff) + ldsw + _i * 8192), 16, 0, 0); } while (0)
#define PG8_LDA(dst, b, h) do { _Pragma("unroll") for (int m = 0; m < 4; ++m) _Pragma("unroll") for (int k = 0; k < 2; ++k) dst[m][k] = *(const PG8_LAS bf16x8*)(lds + PG8_SA(b, h) + aoff + m * 2048 + k * 1024); } while (0)
#define PG8_LDB(dst, b, h) do { _Pragma("unroll") for (int n = 0; n < 2; ++n) _Pragma("unroll") for (int k = 0; k < 2; ++k) dst[n][k] = *(const PG8_LAS bf16x8*)(lds + PG8_SB(b, h) + boff + n * 2048 + k * 1024); } while (0)
#define PG8_MMA(ai, bj, At, Bt) do { __builtin_amdgcn_s_setprio(1); if constexpr (F8) { mma_blk<true>(acc[ai][bj], At, Bt); } else { _Pragma("unroll") for (int m = 0; m < 4; ++m) _Pragma("unroll") for (int n = 0; n < 2; ++n) _Pragma("unroll") for (int k = 0; k < 2; ++k) \
        acc[ai][bj][m][n] = __builtin_amdgcn_mfma_f32_16x16x32_bf16(Bt[n][k], At[m][k], acc[ai][bj][m][n], 0, 0, 0); } __builtin_amdgcn_s_setprio(0); } while (0)
#define PG8_WAIT_V(n) asm volatile("s_waitcnt vmcnt(" #n ")" ::: "memory")
#define PG8_WAIT_L(n) asm volatile("s_waitcnt lgkmcnt(" #n ")" ::: "memory")
#define PG8_BAR __builtin_amdgcn_s_barrier()
#define PG8_SCHED __builtin_amdgcn_sched_barrier(0)
    Unit cur, nxt; int ui = 0;
    if (!S.next(0, cur)) return;
    f32x4 acc[2][2][4][2];
#pragma unroll
    for (int a = 0; a < 2; ++a)
#pragma unroll
        for (int b = 0; b < 2; ++b)
#pragma unroll
            for (int m = 0; m < 4; ++m)
#pragma unroll
                for (int n = 0; n < 2; ++n) acc[a][b][m][n] = (f32x4){0.f, 0.f, 0.f, 0.f};
    bf16x8 At[4][2], B0[2][2], B1[2][2];
    const char* cA = (const char*)g.A + (size_t)cur.pm * tstep; const char* cB = (const char*)g.Bt + (size_t)cur.pn * tstep;
    S.a_ready(cur);
    PG8_STAGE(PG8_SB(0, 0), cB, voffB); PG8_STAGE(PG8_SA(0, 0), cA, voffA); PG8_STAGE(PG8_SB(0, 1), cB + hstep, voffB); PG8_STAGE(PG8_SA(0, 1), cA + hstep, voffA);
    if (wr == 1) PG8_BAR;
    PG8_WAIT_V(4); PG8_BAR;
    PG8_STAGE(PG8_SB(1, 0), cB + kstep, voffB); PG8_STAGE(PG8_SA(1, 0), cA + kstep, voffA); PG8_STAGE(PG8_SB(1, 1), cB + hstep + kstep, voffB);
    PG8_WAIT_V(6); PG8_BAR;
    for (;;) {
        const bool has_next = S.next(ui + 1, nxt);
        const char* nA = has_next ? (const char*)g.A + (size_t)nxt.pm * tstep : cA; const char* nB = has_next ? (const char*)g.Bt + (size_t)nxt.pn * tstep : cB;
#define PG8_KBODY \
            const bool last = (t == nt - 2); \
            const char* a1 = cA + (size_t)(t + 1) * kstep; \
            const char* a2 = last ? nA : cA + (size_t)(t + 2) * kstep; const char* b2 = last ? nB : cB + (size_t)(t + 2) * kstep; \
            const char* a3 = a2 + kstep; const char* b3 = b2 + kstep; \
            if (last && has_next) S.a_ready(nxt); \
            PG8_LDB(B0, 0, 0); PG8_SCHED; PG8_LDA(At, 0, 0); PG8_STAGE(PG8_SA(1, 1), a1 + hstep, voffA); \
            PG8_WAIT_L(8); PG8_BAR; PG8_WAIT_L(0); PG8_MMA(0, 0, At, B0); PG8_BAR; PG8_SCHED; \
            PG8_LDB(B1, 0, 1); PG8_STAGE(PG8_SB(0, 0), b2, voffB); \
            PG8_BAR; PG8_WAIT_L(0); PG8_MMA(0, 1, At, B1); PG8_BAR; \
            PG8_LDA(At, 0, 1); PG8_STAGE(PG8_SA(0, 0), a2, voffA); \
            PG8_BAR; PG8_WAIT_L(0); PG8_MMA(1, 0, At, B0); PG8_BAR; PG8_SCHED; \
            PG8_STAGE(PG8_SB(0, 1), b2 + hstep, voffB); \
            PG8_WAIT_V(6); PG8_BAR; PG8_MMA(1, 1, At, B1); PG8_BAR; \
            PG8_LDB(B0, 1, 0); PG8_SCHED; PG8_LDA(At, 1, 0); PG8_STAGE(PG8_SA(0, 1), a2 + hstep, voffA); \
            PG8_WAIT_L(8); PG8_BAR; PG8_WAIT_L(0); PG8_MMA(0, 0, At, B0); PG8_BAR; PG8_SCHED; \
            PG8_LDB(B1, 1, 1); PG8_STAGE(PG8_SB(1, 0), b3, voffB); \
            PG8_BAR; PG8_WAIT_L(0); PG8_MMA(0, 1, At, B1); PG8_BAR; \
            PG8_LDA(At, 1, 1); PG8_STAGE(PG8_SA(1, 0), a3, voffA); \
            PG8_BAR; PG8_WAIT_L(0); PG8_MMA(1, 0, At, B0); PG8_BAR; PG8_SCHED; \
            PG8_STAGE(PG8_SB(1, 1), b3 + hstep, voffB); \
            PG8_WAIT_V(6); PG8_BAR; PG8_MMA(1, 1, At, B1); PG8_BAR;
        if constexpr (Mid::AT >= 0) {
            for (int t = 0; t < Mid::AT; t += 2) { PG8_KBODY }
            if constexpr (F8) asm volatile("s_nop 15\n\ts_nop 15" ::: "memory");
            Mh(acc, cur, wr, wc, fr, fq);
            for (int t = Mid::AT; t < nt; t += 2) { PG8_KBODY }
        } else {
            for (int t = 0; t < nt; t += 2) { PG8_KBODY }
        }
#undef PG8_KBODY
        if constexpr (F8) asm volatile("s_nop 15\n\ts_nop 15" ::: "memory");
        E(acc, cur, wr, wc, fr, fq); S.done(cur);
        if (!has_next) break;
#pragma unroll
        for (int a = 0; a < 2; ++a)
#pragma unroll
            for (int b = 0; b < 2; ++b)
#pragma unroll
                for (int m = 0; m < 4; ++m)
#pragma unroll
                    for (int n = 0; n < 2; ++n) acc[a][b][m][n] = (f32x4){0.f, 0.f, 0.f, 0.f};
        cur = nxt; cA = nA; cB = nB; ++ui;
    }
    PG8_WAIT_V(0);
    if (wr == 0) PG8_BAR;
    PG8_BAR;
#undef PG8_SA
#undef PG8_SB
#undef PG8_STAGE
#undef PG8_LDA
#undef PG8_LDB
#undef PG8_MMA
#undef PG8_WAIT_V
#undef PG8_WAIT_L
#undef PG8_BAR
#undef PG8_SCHED
}
}

#define GAS __attribute__((address_space(1)))
#define LAS __attribute__((address_space(3)))
typedef unsigned short bf16;
typedef float f32x4 __attribute__((ext_vector_type(4)));
typedef unsigned v4u __attribute__((ext_vector_type(4)));
typedef unsigned v2u __attribute__((ext_vector_type(2)));

constexpr int NB = 4, S = 4096, D = 2048, T = NB * S, HD = 128;
constexpr int IN_COLS = 11288, OFF_KV = 1024, OFF_GATE = 2560, OFF_DIL = 2584, OFF_MERGE = 7192;
constexpr int NPROJ = 11264;
constexpr int NQ = 1024, NKV = 1536, NDL = 4608, NMG = 4096;
constexpr int NC = 255, NS = 64;
constexpr int NE = 16384;
constexpr float EPS = 1e-6f;
constexpr float QSCALE = 0.08838834764831845f;
constexpr int NWAVES = 8, NTHREADS = 512;

constexpr size_t MiB = 1u << 20;
constexpr size_t WS_CTL = 0, CTL_ZERO_BYTES = 1 * MiB;
constexpr size_t WS_WIN = 1 * MiB;
constexpr size_t WS_WBN = 45 * MiB;
constexpr size_t WS_WBD = 49 * MiB;
constexpr size_t WS_WOUT = 51 * MiB;
constexpr size_t WS_WPQ = 59 * MiB;
constexpr size_t WS_WGATE = 67 * MiB;
constexpr size_t WS_MOD = 67 * MiB + 256 * 1024;
constexpr size_t WS_SEL = 67 * MiB + 512 * 1024;
constexpr size_t WS_GATES = 68 * MiB;
constexpr size_t WS_KC = 70 * MiB;
constexpr size_t WS_VC = 71 * MiB;
constexpr size_t WS_H = 72 * MiB;
constexpr size_t WS_Q = 136 * MiB;
constexpr size_t WS_KV = 168 * MiB;
constexpr size_t WS_DL = 216 * MiB;
constexpr size_t WS_MG = 360 * MiB;
constexpr size_t WS_YN = 488 * MiB;
constexpr size_t WS_YD = 520 * MiB;
constexpr size_t WS_H8 = WS_YN;
constexpr size_t WS_EI = 536 * MiB;
constexpr size_t WS_EG = 544 * MiB;
constexpr size_t WS_END = 552 * MiB;
constexpr size_t WS_PU = WS_Q;
constexpr size_t WS_PV = WS_Q + 64 * MiB;
constexpr size_t WS_QP = WS_MG;
static_assert(WS_PV + 64 * MiB <= WS_MG, "u/v overlay");

constexpr int LDS_BYTES = 147456;
constexpr int LDS_MISC = 144 * 1024 - 256;

#define XB_TMO      128
#define XB_XCNT(j)  (256  + 64 * (j))
#define XB_XSUB(j)  (1280 + 64 * (j))
#define XB_XGEN(j)  (2304 + 64 * (j))
#define XB_TOP      3328
#define XB_TOPGEN   3392
#define XCD_BAR_WORDS 3456
#define XB_SPIN_CAP (1u << 24)

__device__ __forceinline__ unsigned xb_ld(unsigned* p)              { return __hip_atomic_load(p, __ATOMIC_RELAXED, __HIP_MEMORY_SCOPE_AGENT); }
__device__ __forceinline__ unsigned xb_add(unsigned* p, unsigned v) { return __hip_atomic_fetch_add(p, v, __ATOMIC_RELAXED, __HIP_MEMORY_SCOPE_AGENT); }
__device__ __forceinline__ unsigned xb_xcc_id() { return (unsigned)__builtin_amdgcn_s_getreg((3 << 11) | 20) & 0xFu; }
#define XB_SPIN(cond, bar) do { unsigned _sp = 0; while (cond) { __builtin_amdgcn_s_sleep(1); \
    if ((++_sp & 255u) == 0u) { if (xb_ld(&(bar)[XB_TMO])) break; if (_sp > XB_SPIN_CAP) { atomicAdd(&(bar)[XB_TMO], 1u); break; } } } } while (0)

struct XcdBarrier { unsigned* bar; unsigned x; volatile LAS unsigned* st; };

__device__ __forceinline__ XcdBarrier xcd_barrier_post(unsigned* bar, volatile LAS unsigned* st) {
    XcdBarrier b; b.bar = bar; b.x = xb_xcc_id(); b.st = st;
    if (threadIdx.x == 0) (void)xb_add(&bar[XB_XCNT(b.x)], 1u);
    return b;
}
__device__ __forceinline__ void xcd_barrier_complete(unsigned* bar, unsigned x, unsigned& nloc, unsigned& nx) {
    const unsigned G = gridDim.x * gridDim.y * gridDim.z;
    unsigned sum, cnt, mine, sp = 0u;
    for (;;) {
        sum = 0u; cnt = 0u; mine = 0u;
#pragma unroll
        for (unsigned j = 0; j < 16; ++j) { const unsigned c = xb_ld(&bar[XB_XCNT(j)]); sum += c; cnt += (c > 0u) ? 1u : 0u; mine = (j == x) ? c : mine; }
        if (sum == G) break;
        __builtin_amdgcn_s_sleep(1);
        if ((++sp & 255u) == 0u) { if (xb_ld(&bar[XB_TMO])) break; if (sp > XB_SPIN_CAP) { atomicAdd(&bar[XB_TMO], 1u); break; } }
    }
    nloc = mine > 0u ? mine : 1u; nx = cnt > 0u ? cnt : 1u;
}
__device__ __forceinline__ void xcd_barrier(const XcdBarrier& b) {
    asm volatile("s_waitcnt vmcnt(0)" ::: "memory");
    __syncthreads();
    if (threadIdx.x == 0) {
        unsigned* bar = b.bar;
        __builtin_amdgcn_s_waitcnt(0);
        unsigned nloc = b.st[0], nx = b.st[1];
        if (nloc == 0u) { xcd_barrier_complete(bar, b.x, nloc, nx); b.st[0] = nloc; b.st[1] = nx; }
        const unsigned old = xb_add(&bar[XB_XSUB(b.x)], 1u);
        const unsigned gen = old / nloc;
        if (old + 1u == (gen + 1u) * nloc) {
            __builtin_amdgcn_fence(__ATOMIC_RELEASE, "agent");
            asm volatile("s_waitcnt vmcnt(0)" ::: "memory");
            const unsigned og = xb_add(&bar[XB_TOP], 1u);
            const unsigned tg = og / nx;
            if (og + 1u == (tg + 1u) * nx) xb_add(&bar[XB_TOPGEN], 1u);
            else XB_SPIN(xb_ld(&bar[XB_TOPGEN]) == tg, bar);
            __builtin_amdgcn_fence(__ATOMIC_ACQUIRE, "agent");
            xb_add(&bar[XB_XGEN(b.x)], 1u);
            asm volatile("s_waitcnt vmcnt(0)" ::: "memory");
        } else {
            XB_SPIN(xb_ld(&bar[XB_XGEN(b.x)]) == gen, bar);
            __builtin_amdgcn_fence(__ATOMIC_ACQUIRE, "agent");
            asm volatile("s_waitcnt vmcnt(0)" ::: "memory");
        }
    }
    __syncthreads();
}

__device__ __forceinline__ unsigned f2bf(float f) { unsigned u = __builtin_bit_cast(unsigned, f); return (u + 0x7fffu + ((u >> 16) & 1u)) >> 16; }
__device__ __forceinline__ unsigned pk2(float lo, float hi) { return f2bf(lo) | (f2bf(hi) << 16); }
__device__ __forceinline__ unsigned pk4_f8(float a, float b, float c, float d) {
    a = __builtin_amdgcn_fmed3f(a, -448.f, 448.f); b = __builtin_amdgcn_fmed3f(b, -448.f, 448.f); c = __builtin_amdgcn_fmed3f(c, -448.f, 448.f); d = __builtin_amdgcn_fmed3f(d, -448.f, 448.f);
    int w = 0; w = __builtin_amdgcn_cvt_pk_fp8_f32(a, b, w, false); w = __builtin_amdgcn_cvt_pk_fp8_f32(c, d, w, true); return (unsigned)w; }
constexpr float F8_HS = 8.f, F8_WS = 128.f, F8_MS = 64.f;
__device__ __forceinline__ float bflo(unsigned u) { return __builtin_bit_cast(float, u << 16); }
__device__ __forceinline__ float bfhi(unsigned u) { return __builtin_bit_cast(float, u & 0xffff0000u); }
__device__ __forceinline__ float bf2f(bf16 u) { return __builtin_bit_cast(float, (unsigned)u << 16); }
__device__ __forceinline__ float wave_sum(float v) {
#pragma unroll
    for (int o = 1; o < 64; o <<= 1) v += __shfl_xor(v, o);
    return v;
}
__device__ __forceinline__ float wave_max(float v) {
#pragma unroll
    for (int o = 1; o < 64; o <<= 1) v = fmaxf(v, __shfl_xor(v, o));
    return v;
}
__device__ __forceinline__ float sigmoidf(float x) { return __builtin_amdgcn_rcpf(1.f + __expf(-x)); }
__device__ __forceinline__ float gelu_tanh(float x) { const float u = 0.7978845608028654f * (x + 0.044715f * x * x * x); return 0.5f * x * (1.f + tanhf(u)); }
__device__ __forceinline__ int t5_bucket(int n) {
    if (n < 16) return n;
    int b = 16;
    b += (n >= 22); b += (n >= 30); b += (n >= 40); b += (n >= 54); b += (n >= 73); b += (n >= 99); b += (n >= 134); b += (n >= 182);
    b += (n >= 246); b += (n >= 332); b += (n >= 450); b += (n >= 609); b += (n >= 825); b += (n >= 1117); b += (n >= 1513);
    return b;
}

struct Args {
    const float* in[23];
    float* out; unsigned char* ws;
    int ph_lo, ph_hi;
};

typedef float f32x2v __attribute__((ext_vector_type(2)));
__device__ __forceinline__ void ph0_mod(const Args& a, LAS unsigned char* lds) {
    const int tid = phase_tid(), lane = tid & 63, wave = __builtin_amdgcn_readfirstlane(tid >> 6);
    LAS float* cs = (LAS float*)lds;
    LAS float* red = (LAS float*)(lds + 32768);
    const float* c = a.in[1]; const float* w_ada = a.in[2]; const float* b_ada = a.in[3];
    float* mod = (float*)(a.ws + WS_MOD);
    for (int i = tid; i < 4 * 2048; i += NTHREADS) { const float v = c[i]; cs[i] = v / (1.f + __expf(-v)); }
    __syncthreads();
    for (int u = blockIdx.x; u < 12288 / 128; u += gridDim.x) {
        const int col = u * 128 + 2 * lane;
        float acc[4][2];
#pragma unroll
        for (int b = 0; b < 4; ++b) { acc[b][0] = 0.f; acc[b][1] = 0.f; }
        const float* wp = w_ada + (size_t)(wave * 256) * 12288 + col;
#pragma unroll 1
        for (int k0 = 0; k0 < 256; k0 += 16) {
            f32x2v w[16];
#pragma unroll
            for (int k = 0; k < 16; ++k) w[k] = *(const f32x2v*)(wp + (size_t)(k0 + k) * 12288);
#pragma unroll
            for (int k = 0; k < 16; ++k) { const int kk = wave * 256 + k0 + k;
#pragma unroll
                for (int b = 0; b < 4; ++b) { const float cv = cs[b * 2048 + kk]; acc[b][0] += cv * w[k].x; acc[b][1] += cv * w[k].y; } }
        }
#pragma unroll
        for (int b = 0; b < 4; ++b) { red[(wave * 4 + b) * 128 + 2 * lane] = acc[b][0]; red[(wave * 4 + b) * 128 + 2 * lane + 1] = acc[b][1]; }
        __syncthreads();
        { const int b = tid >> 7, cc = tid & 127; float s = 0.f;
#pragma unroll
          for (int w = 0; w < 8; ++w) s += red[(w * 4 + b) * 128 + cc];
          mod[b * 12288 + u * 128 + cc] = s + b_ada[u * 128 + cc]; }
        __syncthreads();
    }
}
__device__ __forceinline__ void transpose_item(const float* W, int ldw, int ncols, int K, bf16* WT, int row_off, LAS float* scr, int item, int lane, int ldt = 0) {
    if (ldt == 0) ldt = K;
    const int nblk = ncols / 32, kb = item / nblk, nb = item % nblk, k0 = 64 * kb, n0 = 32 * nb;
    float tv[32];
#pragma unroll
    for (int i = 0; i < 32; ++i) tv[i] = W[(size_t)(k0 + 2 * i + (lane >> 5)) * ldw + n0 + (lane & 31)];
#pragma unroll
    for (int i = 0; i < 32; ++i) scr[(2 * i + (lane >> 5)) * 33 + (lane & 31)] = tv[i];
    asm volatile("s_waitcnt lgkmcnt(0)" ::: "memory");
    const int c = lane & 7;
#pragma unroll
    for (int j = 0; j < 4; ++j) { const int n = (lane >> 3) + 8 * j; const LAS float* s = scr + (8 * c) * 33 + n;
        v4u o; o.x = pk2(s[0 * 33], s[1 * 33]); o.y = pk2(s[2 * 33], s[3 * 33]); o.z = pk2(s[4 * 33], s[5 * 33]); o.w = pk2(s[6 * 33], s[7 * 33]);
        *(v4u*)(WT + (size_t)(row_off + n0 + n) * ldt + k0 + 8 * c) = o; }
    asm volatile("s_waitcnt lgkmcnt(0)" ::: "memory");
}
__device__ __forceinline__ void transpose_item_f8(const float* W, int ldw, int ncols, int K, unsigned char* WT, int row_off, LAS float* scr, int item, int lane) {
    const int nblk = ncols / 32, kb = item / nblk, nb = item % nblk, k0 = 64 * kb, n0 = 32 * nb;
    float tv[32];
#pragma unroll
    for (int i = 0; i < 32; ++i) tv[i] = W[(size_t)(k0 + 2 * i + (lane >> 5)) * ldw + n0 + (lane & 31)];
#pragma unroll
    for (int i = 0; i < 32; ++i) scr[(2 * i + (lane >> 5)) * 33 + (lane & 31)] = tv[i] * F8_WS;
    asm volatile("s_waitcnt lgkmcnt(0)" ::: "memory");
    const int c = lane & 7;
#pragma unroll
    for (int j = 0; j < 4; ++j) { const int n = (lane >> 3) + 8 * j; const LAS float* s = scr + (8 * c) * 33 + n;
        v2u o; o.x = pk4_f8(s[0 * 33], s[1 * 33], s[2 * 33], s[3 * 33]); o.y = pk4_f8(s[4 * 33], s[5 * 33], s[6 * 33], s[7 * 33]);
        *(v2u*)(WT + (size_t)(row_off + n0 + n) * K + k0 + 8 * c) = o; }
    asm volatile("s_waitcnt lgkmcnt(0)" ::: "memory");
}
__device__ __forceinline__ void ph0_weights(const Args& a, LAS unsigned char* lds) {
    const int tid = phase_tid(), lane = tid & 63, wave = __builtin_amdgcn_readfirstlane(tid >> 6);
    LAS float* scr = (LAS float*)(lds + wave * 16384);
    const int gw = blockIdx.x * NWAVES + wave, NGW = gridDim.x * NWAVES;
    const float* w_in = a.in[5];
    unsigned char* WIN = a.ws + WS_WIN;
    constexpr int I_Q = 32 * (NQ / 32), I_KV = 32 * (NKV / 32), I_DL = 32 * (NDL / 32), I_MG = 32 * (NMG / 32);
    constexpr int I_BN = 16 * 64, I_BD = 8 * 64, I_O = 32 * 64, I_PQ = 32 * 64;
    constexpr int NITEMS = I_Q + I_KV + I_DL + I_MG + I_BN + I_BD + I_O + I_PQ;
    for (int it = gw; it < NITEMS; it += NGW) {
        int r = it;
        if (r < I_Q)  { transpose_item_f8(w_in, IN_COLS, NQ, D, WIN, 0, scr, r, lane); continue; } r -= I_Q;
        if (r < I_KV) { transpose_item_f8(w_in + OFF_KV, IN_COLS, NKV, D, WIN, NQ, scr, r, lane); continue; } r -= I_KV;
        if (r < I_DL) { transpose_item_f8(w_in + OFF_DIL, IN_COLS, NDL, D, WIN, NQ + NKV, scr, r, lane); continue; } r -= I_DL;
        if (r < I_MG) { transpose_item_f8(w_in + OFF_MERGE, IN_COLS, NMG, D, WIN, NQ + NKV + NDL, scr, r, lane); continue; } r -= I_MG;
        if (r < I_BN) { transpose_item(a.in[13], D, D, 1024, (bf16*)(a.ws + WS_WBN), 0, scr, r, lane, 1536); continue; } r -= I_BN;
        if (r < I_BD) { transpose_item(a.in[14], D, D, 512, (bf16*)(a.ws + WS_WBN) + 1024, 0, scr, r, lane, 1536); continue; } r -= I_BD;
        if (r < I_O)  { transpose_item_f8(a.in[15], D, D, D, a.ws + WS_WOUT, 0, scr, r, lane); continue; } r -= I_O;
        transpose_item(a.in[17], D, D, D, (bf16*)(a.ws + WS_WPQ), 0, scr, r, lane);
    }
}

constexpr size_t WS_CW1F = 602 * MiB;
constexpr size_t WS_WGF = 604 * MiB;
constexpr size_t WS_CBP = 604 * MiB + 256 * 1024;
constexpr size_t WS_END4 = 605 * MiB;
__device__ __forceinline__ void ph0_extra(const Args& a) {
    const int tid = phase_tid(), lane = tid & 63, wave = __builtin_amdgcn_readfirstlane(tid >> 6);
    const float* w1 = a.in[9]; const float* pos = a.in[8]; const float* w_in = a.in[5];
    v4u* CW = (v4u*)(a.ws + WS_CW1F); v4u* WG = (v4u*)(a.ws + WS_WGF); float* CBP = (float*)(a.ws + WS_CBP);
    for (int i = blockIdx.x * NTHREADS + tid; i < 2 * 4 * 256 * 64; i += gridDim.x * NTHREADS) {
        const int ln = i & 63, ks = (i >> 6) & 255, nt = (i >> 14) & 3, j = i >> 16;
        const float* src = w1 + ((size_t)j * 4096 + 16 * ks + 8 * (ln >> 5)) * 128 + 32 * nt + (ln & 31);
        v4u o; o.x = pk2(src[0], src[128]); o.y = pk2(src[256], src[384]); o.z = pk2(src[512], src[640]); o.w = pk2(src[768], src[896]);
        CW[i] = o;
    }
    for (int i = blockIdx.x * NTHREADS + tid; i < 128 * 64; i += gridDim.x * NTHREADS) {
        const int ln = i & 63, ks = i >> 6, jrow = ln & 31;
        v4u o = {0u, 0u, 0u, 0u};
        if (jrow < 24) { const float* src = w_in + (size_t)(16 * ks + 8 * (ln >> 5)) * IN_COLS + OFF_GATE + jrow;
            o.x = pk2(src[0], src[IN_COLS]); o.y = pk2(src[2 * (size_t)IN_COLS], src[3 * (size_t)IN_COLS]); o.z = pk2(src[4 * (size_t)IN_COLS], src[5 * (size_t)IN_COLS]); o.w = pk2(src[6 * (size_t)IN_COLS], src[7 * (size_t)IN_COLS]); }
        WG[i] = o;
    }
    { const int gw = blockIdx.x * NWAVES + wave;
      if (gw < 128) { const int kc = gw >> 1, j = gw & 1; float s0 = 0.f, s1 = 0.f; const float* wp = w1 + ((size_t)j * 4096 + 64 * kc) * 128 + lane; const float* pp = pos + j * 4096 + 64 * kc;
#pragma unroll 1
          for (int k0 = 0; k0 < 64; k0 += 16) { float wa[16], wb[16];
#pragma unroll
              for (int k = 0; k < 16; ++k) { wa[k] = wp[(k0 + k) * 128]; wb[k] = wp[(k0 + k) * 128 + 64]; }
#pragma unroll
              for (int k = 0; k < 16; ++k) { const float pv = pp[k0 + k]; s0 += pv * wa[k]; s1 += pv * wb[k]; } }
          CBP[(kc * 2 + j) * 128 + lane] = s0; CBP[(kc * 2 + j) * 128 + 64 + lane] = s1; } }
}

template <bool F8 = false>
__device__ __forceinline__ void ph_norm(const Args& a, const float* xin, const float* gvec, int sh_off, int sc_off, bf16* hout, unsigned char* h8 = nullptr) {
    const int tid = phase_tid(), lane = tid & 63, wave = __builtin_amdgcn_readfirstlane(tid >> 6);
    const int gw = blockIdx.x * NWAVES + wave, NGW = gridDim.x * NWAVES;
    const float* mod = (const float*)(a.ws + WS_MOD);
    for (int r = gw; r < S / 2; r += NGW)
#pragma unroll 1
        for (int bq = 0; bq < NB; ++bq) {
            const int m0 = bq * S + r, m1 = m0 + S / 2;
            const float* x0 = xin + (size_t)m0 * D + 8 * lane; const float* x1 = xin + (size_t)m1 * D + 8 * lane;
            f32x4 v0[8], v1[8];
#pragma unroll
            for (int c = 0; c < 4; ++c) { v0[2 * c] = *(const f32x4*)(x0 + 512 * c); v0[2 * c + 1] = *(const f32x4*)(x0 + 512 * c + 4); v1[2 * c] = *(const f32x4*)(x1 + 512 * c); v1[2 * c + 1] = *(const f32x4*)(x1 + 512 * c + 4); }
            float s0 = 0.f, s1 = 0.f;
#pragma unroll
            for (int i = 0; i < 8; ++i) { s0 += (v0[i].x * v0[i].x + v0[i].y * v0[i].y) + (v0[i].z * v0[i].z + v0[i].w * v0[i].w); s1 += (v1[i].x * v1[i].x + v1[i].y * v1[i].y) + (v1[i].z * v1[i].z + v1[i].w * v1[i].w); }
            const float r0 = rsqrtf(wave_sum(s0) * (1.f / D) + EPS), r1 = rsqrtf(wave_sum(s1) * (1.f / D) + EPS);
            const float* shp = mod + bq * 12288 + sh_off + 8 * lane; const float* scp = mod + bq * 12288 + sc_off + 8 * lane; const float* gp = gvec + 8 * lane;
#pragma unroll
            for (int c = 0; c < 4; ++c) {
                v4u o0, o1; unsigned w0[4], w1[4]; [[maybe_unused]] unsigned q0[2], q1[2];
#pragma unroll
                for (int hq = 0; hq < 2; ++hq) { const f32x4 g = *(const f32x4*)(gp + 512 * c + 4 * hq), sc = *(const f32x4*)(scp + 512 * c + 4 * hq), sh = *(const f32x4*)(shp + 512 * c + 4 * hq);
                    const f32x4 ga = g * (1.f + sc); const f32x4 y0 = v0[2 * c + hq] * r0 * ga + sh, y1 = v1[2 * c + hq] * r1 * ga + sh;
                    w0[2 * hq] = pk2(y0.x, y0.y); w0[2 * hq + 1] = pk2(y0.z, y0.w); w1[2 * hq] = pk2(y1.x, y1.y); w1[2 * hq + 1] = pk2(y1.z, y1.w);
                    if constexpr (F8) { q0[hq] = pk4_f8(y0.x * F8_HS, y0.y * F8_HS, y0.z * F8_HS, y0.w * F8_HS); q1[hq] = pk4_f8(y1.x * F8_HS, y1.y * F8_HS, y1.z * F8_HS, y1.w * F8_HS); } }
                o0.x = w0[0]; o0.y = w0[1]; o0.z = w0[2]; o0.w = w0[3]; o1.x = w1[0]; o1.y = w1[1]; o1.z = w1[2]; o1.w = w1[3];
                *(v4u*)(hout + (size_t)m0 * D + 512 * c + 8 * lane) = o0; *(v4u*)(hout + (size_t)m1 * D + 512 * c + 8 * lane) = o1;
                if constexpr (F8) { v2u p0, p1; p0.x = q0[0]; p0.y = q0[1]; p1.x = q1[0]; p1.y = q1[1];
                    *(v2u*)(h8 + (size_t)m0 * D + 512 * c + 8 * lane) = p0; *(v2u*)(h8 + (size_t)m1 * D + 512 * c + 8 * lane) = p1; }
            }
        }
}

using pg8::Unit; using pg8::HALF; using pg8::BM;
struct EpiProj {
    static constexpr bool PERM = true;
    bf16 *q, *kv, *dl, *mg;
    __device__ __forceinline__ void operator()(const f32x4 (&acc)[2][2][4][2], const Unit& u, int wr, int wc, int fr, int fq) const {
        bf16* base; int ldc, colt = u.pn * BM;
        if (colt < NQ) { base = q; ldc = NQ; } else if (colt < NQ + NKV) { base = kv; ldc = NKV; colt -= NQ; } else if (colt < NQ + NKV + NDL) { base = dl; ldc = NDL; colt -= NQ + NKV; } else { base = mg; ldc = NMG; colt -= NQ + NKV + NDL; }
        const int row0 = u.pm * BM + wr * 64 + fr, col0 = colt + wc * 32 + 8 * fq;
#pragma unroll
        for (int ai = 0; ai < 2; ++ai)
#pragma unroll
            for (int m = 0; m < 4; ++m) { bf16* rowp = base + (size_t)(row0 + ai * HALF + m * 16) * ldc + col0;
#pragma unroll
                for (int bj = 0; bj < 2; ++bj) { const f32x4 v0 = acc[ai][bj][m][0], v1 = acc[ai][bj][m][1];
                    v4u w; w.x = pg8::cvt_pk_bf16(v0[0], v0[1]); w.y = pg8::cvt_pk_bf16(v0[2], v0[3]); w.z = pg8::cvt_pk_bf16(v1[0], v1[1]); w.w = pg8::cvt_pk_bf16(v1[2], v1[3]);
                    *(v4u*)(rowp + bj * HALF) = w; } }
    }
};
struct MidMerge {
    static constexpr int AT = 16;
    const bf16* mg;
    __device__ __forceinline__ void operator()(f32x4 (&acc)[2][2][4][2], const Unit& u, int wr, int wc, int fr, int fq) const {
        int lo = (fq * 16 + fr) * 8;
        asm volatile("" : "+v"(lo));
        const bf16* t1 = mg + (((size_t)(u.pm * 16 + u.pn) * 8 + (wr * 4 + wc)) << 13) + lo; const bf16* t2 = t1 + ((size_t)8 << 16);
#pragma unroll
        for (int ai = 0; ai < 2; ++ai) {
            v4u a1[4][2], a2[4][2];
#pragma unroll
            for (int m = 0; m < 4; ++m)
#pragma unroll
                for (int bj = 0; bj < 2; ++bj) { a1[m][bj] = *(const v4u*)(t1 + ((ai * 4 + m) * 2 + bj) * 512); a2[m][bj] = *(const v4u*)(t2 + ((ai * 4 + m) * 2 + bj) * 512); }
#pragma unroll
            for (int m = 0; m < 4; ++m)
#pragma unroll
                for (int bj = 0; bj < 2; ++bj) { const unsigned w1[4] = {a1[m][bj].x, a1[m][bj].y, a1[m][bj].z, a1[m][bj].w}, w2[4] = {a2[m][bj].x, a2[m][bj].y, a2[m][bj].z, a2[m][bj].w};
#pragma unroll
                    for (int q = 0; q < 4; ++q) { const float r0 = (1.f + __expf(-bflo(w2[q]))) * __builtin_amdgcn_rcpf(1.f + __expf(-bflo(w1[q]))), r1 = (1.f + __expf(-bfhi(w2[q]))) * __builtin_amdgcn_rcpf(1.f + __expf(-bfhi(w1[q])));
                        acc[ai][bj][m][q >> 1][2 * (q & 1)] *= r0; acc[ai][bj][m][q >> 1][2 * (q & 1) + 1] *= r1; } }
            asm volatile("" ::: "memory");
        }
    }
};
struct EpiMerge {
    static constexpr bool PERM = true;
    const bf16* mg; unsigned char* merged8; float os;
    __device__ __forceinline__ void operator()(const f32x4 (&acc)[2][2][4][2], const Unit& u, int wr, int wc, int fr, int fq) const {
        int row0 = u.pm * BM + wr * 64 + fr; const int col0 = u.pn * BM + wc * 32 + 8 * fq;
        asm volatile("" : "+v"(row0));
        const bf16* t2 = mg + (((size_t)(u.pm * 16 + 8 + u.pn) * 8 + (wr * 4 + wc)) << 13) + (fq * 16 + fr) * 8;
        v4u a2[2][4][2];
#pragma unroll
        for (int ai = 0; ai < 2; ++ai)
#pragma unroll
            for (int m = 0; m < 4; ++m)
#pragma unroll
                for (int bj = 0; bj < 2; ++bj) a2[ai][m][bj] = *(const v4u*)(t2 + ((ai * 4 + m) * 2 + bj) * 512);
#pragma unroll
        for (int ai = 0; ai < 2; ++ai)
#pragma unroll
            for (int m = 0; m < 4; ++m) { const size_t row = (size_t)(row0 + ai * HALF + m * 16);
#pragma unroll
                for (int bj = 0; bj < 2; ++bj) { const unsigned w2[4] = {a2[ai][m][bj].x, a2[ai][m][bj].y, a2[ai][m][bj].z, a2[ai][m][bj].w};
                    const f32x4 v0 = acc[ai][bj][m][0] * os, v1 = acc[ai][bj][m][1] * os;
                    v2u w; w.x = pk4_f8(v0[0] * sigmoidf(bflo(w2[0])), v0[1] * sigmoidf(bfhi(w2[0])), v0[2] * sigmoidf(bflo(w2[1])), v0[3] * sigmoidf(bfhi(w2[1])));
                    w.y = pk4_f8(v1[0] * sigmoidf(bflo(w2[2])), v1[1] * sigmoidf(bfhi(w2[2])), v1[2] * sigmoidf(bflo(w2[3])), v1[3] * sigmoidf(bfhi(w2[3])));
                    *(v2u*)(merged8 + row * D + col0 + bj * HALF) = w; } }
    }
};
struct EpiOut {
    static constexpr bool PERM = false;
    const float* x; const float* mod; float* x1; float as;
    __device__ __forceinline__ void operator()(const f32x4 (&acc)[2][2][4][2], const Unit& u, int wr, int wc, int fr, int fq) const {
        const int row0 = u.pm * BM + wr * 64 + fr, col0 = u.pn * BM + wc * 32 + 4 * fq;
        const int b = (u.pm * BM) / S;
        f32x4 gv[2][2];
#pragma unroll
        for (int bj = 0; bj < 2; ++bj)
#pragma unroll
            for (int n = 0; n < 2; ++n) gv[bj][n] = *(const f32x4*)(mod + b * 12288 + 4096 + col0 + bj * HALF + n * 16) * as;
#pragma unroll
        for (int ai = 0; ai < 2; ++ai)
#pragma unroll
            for (int m = 0; m < 4; ++m) { const size_t off = (size_t)(row0 + ai * HALF + m * 16) * D + col0;
#pragma unroll
                for (int bj = 0; bj < 2; ++bj)
#pragma unroll
                    for (int n = 0; n < 2; ++n) *(f32x4*)(x1 + off + bj * HALF + n * 16) = *(const f32x4*)(x + off + bj * HALF + n * 16) + gv[bj][n] * acc[ai][bj][m][n]; }
    }
};
struct EpiF32 {
    static constexpr bool PERM = false;
    float* C; int ldc;
    __device__ __forceinline__ void operator()(const f32x4 (&acc)[2][2][4][2], const Unit& u, int wr, int wc, int fr, int fq) const {
        const int row0 = u.pm * BM + wr * 64 + fr, col0 = u.pn * BM + wc * 32 + 4 * fq;
#pragma unroll
        for (int ai = 0; ai < 2; ++ai)
#pragma unroll
            for (int m = 0; m < 4; ++m) { float* rowp = C + (size_t)(row0 + ai * HALF + m * 16) * ldc + col0;
#pragma unroll
                for (int bj = 0; bj < 2; ++bj)
#pragma unroll
                    for (int n = 0; n < 2; ++n) *(f32x4*)(rowp + bj * HALF + n * 16) = acc[ai][bj][m][n]; }
    }
};

typedef short bf16x8 __attribute__((ext_vector_type(8)));
typedef float f32x16 __attribute__((ext_vector_type(16)));
typedef float f32x2 __attribute__((ext_vector_type(2)));
typedef __bf16 bf2v __attribute__((ext_vector_type(2)));
constexpr float LOG2E = 1.4426950408889634f;
constexpr float QS2 = QSCALE * LOG2E;
constexpr float NEGB = -1e30f;
__device__ __forceinline__ unsigned pkbf(float a, float b) { const f32x2 v = {a, b}; const bf2v r = __builtin_convertvector(v, bf2v); return __builtin_bit_cast(unsigned, r); }
__device__ __forceinline__ float ex2(float x) { return __builtin_amdgcn_exp2f(x); }
__device__ __forceinline__ int swap23(int x) { return (x & ~12) | ((x & 4) << 1) | ((x & 8) >> 1); }
__device__ __forceinline__ size_t kf_off(int key, int d) { return ((size_t)((key >> 5) * 8 + (d >> 4)) * 64 + ((d >> 3) & 1) * 32 + swap23(key & 31)) * 8 + (d & 7); }
__device__ __forceinline__ size_t vf_off(int key, int d) { const int kk = key & 31; return ((size_t)(((key >> 5) * 4 + (d >> 5)) * 2 + (kk >> 4)) * 64 + ((kk >> 3) & 1) * 32 + (d & 31)) * 8 + (kk & 7); }
__device__ __forceinline__ bf16* fr_nsa(const Args& a, int bg, int kind) { return (bf16*)a.out + ((size_t)(bg * 4 + kind) << 19); }
__device__ __forceinline__ bf16* fr_dil(const Args& a, int b, int head, int kv) { return (bf16*)a.out + ((size_t)16 << 20) + ((size_t)((b * 12 + head) * 2 + kv) << 19); }
constexpr size_t WS_OD = 552 * MiB;
constexpr size_t WS_LSE = 600 * MiB;
constexpr size_t WS_END2 = 601 * MiB;

struct EpiProjNorm {
    static constexpr bool PERM = true;
    bf16 *q, *kv, *dl, *mg, *frg;
    const float *qg, *kg, *dqg, *dkg;
    LAS float* xch;
    float as;
    __device__ __forceinline__ void operator()(const f32x4 (&acc)[2][2][4][2], const Unit& u, int wr, int wc, int fr, int fq) const {
        bf16* base; int ldc, colt = u.pn * BM, mode = 0  , hsel = 0; const float* gain = qg; float scale = 1.f;
        if (colt < NQ) { base = q; ldc = NQ; mode = 1; gain = qg; scale = QS2; }
        else if (colt < NQ + NKV) { base = kv; ldc = NKV; colt -= NQ; hsel = colt >> 7; if (hsel == 4 || hsel == 8) { mode = 2; gain = kg + (hsel == 4 ? 128 : 256); } }
        else if (colt < NQ + NKV + NDL) { base = dl; ldc = NDL; colt -= NQ + NKV; hsel = colt >> 7; if (hsel < 12) { mode = 1; gain = dqg; scale = QS2; } else if (hsel < 24) { mode = 3; gain = dkg; } }
        else { base = mg; ldc = NMG; colt -= NQ + NKV + NDL; }
        const int row0 = u.pm * BM + wr * 64 + fr, col0 = colt + wc * 32 + 8 * fq;
        if (base == mg) {
            bf16* tp = mg + (((size_t)(u.pm * 16 + (colt >> 8)) * 8 + (wr * 4 + wc)) << 13) + (fq * 16 + fr) * 8;
#pragma unroll
            for (int ai = 0; ai < 2; ++ai)
#pragma unroll
                for (int m = 0; m < 4; ++m)
#pragma unroll
                    for (int bj = 0; bj < 2; ++bj) { const f32x4 v0 = acc[ai][bj][m][0] * as, v1 = acc[ai][bj][m][1] * as;
                        v4u w; w.x = pg8::cvt_pk_bf16(v0[0], v0[1]); w.y = pg8::cvt_pk_bf16(v0[2], v0[3]); w.z = pg8::cvt_pk_bf16(v1[0], v1[1]); w.w = pg8::cvt_pk_bf16(v1[2], v1[3]);
                        *(v4u*)(tp + ((ai * 4 + m) * 2 + bj) * 512) = w; }
            return;
        }
        if (mode == 0) {
#pragma unroll
            for (int ai = 0; ai < 2; ++ai)
#pragma unroll
                for (int m = 0; m < 4; ++m) { bf16* rowp = base + (size_t)(row0 + ai * HALF + m * 16) * ldc + col0;
#pragma unroll
                    for (int bj = 0; bj < 2; ++bj) { const f32x4 v0 = acc[ai][bj][m][0] * as, v1 = acc[ai][bj][m][1] * as;
                        v4u w; w.x = pg8::cvt_pk_bf16(v0[0], v0[1]); w.y = pg8::cvt_pk_bf16(v0[2], v0[3]); w.z = pg8::cvt_pk_bf16(v1[0], v1[1]); w.w = pg8::cvt_pk_bf16(v1[2], v1[3]);
                        *(v4u*)(rowp + bj * HALF) = w; } }
            return;
        }
#pragma unroll
        for (int ai = 0; ai < 2; ++ai)
#pragma unroll
            for (int m = 0; m < 4; ++m)
#pragma unroll
                for (int bj = 0; bj < 2; ++bj) { const f32x4 v0 = acc[ai][bj][m][0], v1 = acc[ai][bj][m][1];
                    float ss = (v0[0] * v0[0] + v0[1] * v0[1]) + (v0[2] * v0[2] + v0[3] * v0[3]) + (v1[0] * v1[0] + v1[1] * v1[1]) + (v1[2] * v1[2] + v1[3] * v1[3]);
                    ss += __shfl_xor(ss, 16); ss += __shfl_xor(ss, 32);
                    if (fq == 0) xch[(((((wr * 2 + ai) * 4 + m) * 16 + fr) * 2 + bj) << 2) + wc] = ss; }
        asm volatile("s_waitcnt lgkmcnt(0)" ::: "memory");
        __builtin_amdgcn_s_barrier();
        asm volatile("" ::: "memory");
        const f32x4 ga = *(const f32x4*)(gain + wc * 32 + 8 * fq), gb = *(const f32x4*)(gain + wc * 32 + 8 * fq + 4);
#pragma unroll
        for (int ai = 0; ai < 2; ++ai)
#pragma unroll
            for (int m = 0; m < 4; ++m) { const int t = row0 + ai * HALF + m * 16, b = t / S, s = t % S;
#pragma unroll
                for (int bj = 0; bj < 2; ++bj) { const f32x4 pp = *(const LAS f32x4*)(xch + (((((wr * 2 + ai) * 4 + m) * 16 + fr) * 2 + bj) << 2));
                    const float rstd = rsqrtf(((pp.x + pp.y) + (pp.z + pp.w)) * (as * as * (1.f / 128.f)) + EPS) * (scale * as);
                    const f32x4 v0 = acc[ai][bj][m][0] * rstd * ga, v1 = acc[ai][bj][m][1] * rstd * gb;
                    v4u w; w.x = pg8::cvt_pk_bf16(v0[0], v0[1]); w.y = pg8::cvt_pk_bf16(v0[2], v0[3]); w.z = pg8::cvt_pk_bf16(v1[0], v1[1]); w.w = pg8::cvt_pk_bf16(v1[2], v1[3]);
                    bf16* dst;
                    if (mode == 1) dst = base + (size_t)t * ldc + col0 + bj * HALF;
                    else if (mode == 2) dst = frg + ((size_t)((b * 2 + bj) * 4 + (hsel == 4 ? 0 : 2)) << 19) + kf_off(s, wc * 32 + 8 * fq);
                    else { const int head = hsel - 12 + bj, dsh = 2 * (head >> 2), vk = ((s & ((1 << dsh) - 1)) << (12 - dsh)) + (s >> dsh);
                        dst = frg + ((size_t)16 << 20) + ((size_t)((b * 12 + head) * 2) << 19) + kf_off(vk, wc * 32 + 8 * fq); }
                    *(v4u*)dst = w; } }
    }
};

__device__ __forceinline__ v4u norm_chunk16v(v4u w, const float* gain, float scale, int li) {
    float v[8] = {bflo(w.x), bfhi(w.x), bflo(w.y), bfhi(w.y), bflo(w.z), bfhi(w.z), bflo(w.w), bfhi(w.w)};
    float ss = 0.f;
#pragma unroll
    for (int j = 0; j < 8; ++j) ss += v[j] * v[j];
    ss += __shfl_xor(ss, 1); ss += __shfl_xor(ss, 2); ss += __shfl_xor(ss, 4); ss += __shfl_xor(ss, 8);
    const float rstd = rsqrtf(ss * (1.f / 128.f) + EPS) * scale;
#pragma unroll
    for (int j = 0; j < 8; ++j) v[j] = v[j] * rstd * gain[8 * li + j];
    w.x = pk2(v[0], v[1]); w.y = pk2(v[2], v[3]); w.z = pk2(v[4], v[5]); w.w = pk2(v[6], v[7]);
    return w;
}
__device__ __forceinline__ void ph3_headnorm(const Args& a) {
    const int tid = phase_tid(), lane = tid & 63, wave = __builtin_amdgcn_readfirstlane(tid >> 6), sub = lane >> 4, li = lane & 15;
    const int gw = blockIdx.x * NWAVES + wave, NGW = gridDim.x * NWAVES;
    bf16* Q = (bf16*)(a.ws + WS_Q); const bf16* KV = (const bf16*)(a.ws + WS_KV); bf16* DL = (bf16*)(a.ws + WS_DL);
    const float* qg = a.in[6]; const float* kg = a.in[7]; const float* dqg = a.in[11]; const float* dkg = a.in[12];
    for (int m = gw; m < T; m += NGW) {
        const int b = m / S, s = m % S;
        const int g = sub & 1, win = sub >> 1;
        v4u wq[2], wk, wd[6];
#pragma unroll
        for (int it = 0; it < 2; ++it) wq[it] = *(const v4u*)(Q + (size_t)m * NQ + (it * 4 + sub) * 128 + 8 * li);
        wk = *(const v4u*)(KV + (size_t)m * NKV + ((win ? 8 : 4) + g) * 128 + 8 * li);
#pragma unroll
        for (int it = 0; it < 6; ++it) wd[it] = *(const v4u*)(DL + (size_t)m * NDL + (it * 4 + sub) * 128 + 8 * li);
#pragma unroll
        for (int it = 0; it < 2; ++it) *(v4u*)(Q + (size_t)m * NQ + (it * 4 + sub) * 128 + 8 * li) = norm_chunk16v(wq[it], qg, QS2, li);
        *(v4u*)(fr_nsa(a, b * 2 + g, win ? 2 : 0) + kf_off(s, 8 * li)) = norm_chunk16v(wk, kg + (win ? 256 : 128), 1.f, li);
#pragma unroll
        for (int it = 0; it < 6; ++it) { const int ch = it * 4 + sub;
            if (ch < 12) *(v4u*)(DL + (size_t)m * NDL + ch * 128 + 8 * li) = norm_chunk16v(wd[it], dqg, QS2, li);
            else { const int head = ch - 12, gi = head >> 2, dsh = 2 * gi  , vk = ((s & ((1 << dsh) - 1)) << (12 - dsh)) + (s >> dsh);
                *(v4u*)(fr_dil(a, b, head, 0) + kf_off(vk, 8 * li)) = norm_chunk16v(wd[it], dkg, 1.f, li); } }
    }
}
__device__ __forceinline__ void ph3_vfrag(const Args& a) {
    const int tid = phase_tid(), lane = tid & 63, wave = __builtin_amdgcn_readfirstlane(tid >> 6);
    const int gw = blockIdx.x * NWAVES + wave, NGW = gridDim.x * NWAVES;
    const bf16* KV = (const bf16*)(a.ws + WS_KV); const bf16* DL = (const bf16*)(a.ws + WS_DL);
    for (int job = gw; job < 32768; job += NGW) {
        const bf16* src; size_t rstride; bf16* dst; int key0;
        if (job < 8192) { const int bg = job >> 10, kind = (job >> 9) & 1, s0 = (job & 511) * 8, b = bg >> 1, g = bg & 1;
            src = KV + (size_t)(b * S + s0) * NKV + ((kind ? 10 : 6) + g) * 128; rstride = NKV; dst = fr_nsa(a, bg, kind ? 3 : 1); key0 = s0; }
        else { const int j2 = job - 8192, bh = j2 >> 9, vk0 = (j2 & 511) * 8, b = bh / 12, head = bh % 12, gi = head >> 2, dsh = 2 * gi, L = S >> dsh, r = vk0 / L, m0 = vk0 % L;
            src = DL + (size_t)(b * S + (m0 << dsh) + r) * NDL + (24 + head) * 128; rstride = (size_t)NDL << dsh; dst = fr_dil(a, b, head, 1); key0 = vk0; }
        unsigned w[8];
#pragma unroll
        for (int jj = 0; jj < 8; ++jj) w[jj] = *(const unsigned*)(src + jj * rstride + 2 * lane);
        v4u c0, c1;
        c0.x = (w[0] & 0xffffu) | (w[1] << 16); c0.y = (w[2] & 0xffffu) | (w[3] << 16); c0.z = (w[4] & 0xffffu) | (w[5] << 16); c0.w = (w[6] & 0xffffu) | (w[7] << 16);
        c1.x = (w[0] >> 16) | (w[1] & 0xffff0000u); c1.y = (w[2] >> 16) | (w[3] & 0xffff0000u); c1.z = (w[4] >> 16) | (w[5] & 0xffff0000u); c1.w = (w[6] >> 16) | (w[7] & 0xffff0000u);
        *(v4u*)(dst + vf_off(key0, 2 * lane)) = c0; *(v4u*)(dst + vf_off(key0, 2 * lane + 1)) = c1;
    }
}
__device__ __forceinline__ void ph3_gates(const Args& a) {
    const int tid = phase_tid(), lane = tid & 63, wave = __builtin_amdgcn_readfirstlane(tid >> 6), tl = lane & 31, hh = lane >> 5;
    const int gw = (gridDim.x - 1 - blockIdx.x) * NWAVES + wave, NGW = gridDim.x * NWAVES;
    const bf16* H = (const bf16*)(a.ws + WS_H); const v4u* WG = (const v4u*)(a.ws + WS_WGF) + lane; float* gates = (float*)(a.ws + WS_GATES);
    for (int job = gw; job < T / 32; job += NGW) {
        const int t = job * 32 + tl; const bf16* hr = H + (size_t)t * D + 8 * hh;
        f32x16 acc;
#pragma unroll
        for (int i = 0; i < 16; ++i) acc[i] = 0.f;
#pragma unroll 4
        for (int ks = 0; ks < 128; ++ks) { const bf16x8 af = __builtin_bit_cast(bf16x8, WG[ks * 64]), bfr = __builtin_bit_cast(bf16x8, *(const v4u*)(hr + 16 * ks));
            acc = __builtin_amdgcn_mfma_f32_32x32x16_bf16(af, bfr, acc, 0, 0, 0); }
#pragma unroll
        for (int i = 0; i < 16; ++i) { const int j = (i & 3) + 8 * (i >> 2) + 4 * hh; const float v = acc[i]; if (j < 24) gates[(size_t)t * 24 + j] = sigmoidf(v); }
    }
}
__device__ __forceinline__ void ph3_compress(const Args& a, LAS unsigned char* lds) {
    const int tid = phase_tid(), lane = tid & 63, wave = __builtin_amdgcn_readfirstlane(tid >> 6), cl = lane & 31, hh = lane >> 5;
    LAS float* part = (LAS float*)lds;
    LAS float* hid = part + 2 * 128 * 32;
    LAS float* ob = hid + 32 * 128;
    LAS float* bias = ob + 32 * 128;
    const bf16* KV = (const bf16*)(a.ws + WS_KV);
    const float* w2 = a.in[10]; const float* kg0 = a.in[7]; const float* CBP = (const float*)(a.ws + WS_CBP);
    for (int u = blockIdx.x; u < 128; u += gridDim.x) {
        const int j = u >> 6, bg = (u >> 3) & 7, ct = u & 7, b = bg >> 1, g = bg & 1, c0 = 32 * ct, hhd = j * 2 + g;
        if (tid < 128) { float s = 0.f;
#pragma unroll
            for (int kc = 0; kc < 64; ++kc) s += CBP[(kc * 2 + j) * 128 + tid];
            bias[tid] = s; }
        { const int nt = wave & 3, kh = wave >> 2, c = c0 + cl;
          const v4u* af = (const v4u*)(a.ws + WS_CW1F) + ((size_t)(j * 4 + nt) * 256 + 128 * kh) * 64 + lane;
          f32x16 acc;
#pragma unroll
          for (int i = 0; i < 16; ++i) acc[i] = 0.f;
#pragma unroll 4
          for (int ks = 0; ks < 128; ++ks) { const int k = 16 * (128 * kh + ks) + 8 * hh, l = k >> 7, d = k & 127, p = 16 * c + l;
              v4u x = {0u, 0u, 0u, 0u}; if (p < S) x = *(const v4u*)(KV + (size_t)(b * S + p) * NKV + hhd * 128 + d);
              acc = __builtin_amdgcn_mfma_f32_32x32x16_bf16(__builtin_bit_cast(bf16x8, af[ks * 64]), __builtin_bit_cast(bf16x8, x), acc, 0, 0, 0); }
#pragma unroll
          for (int i = 0; i < 16; ++i) { const int n = 32 * nt + (i & 3) + 8 * (i >> 2) + 4 * hh; const float v = acc[i]; part[(kh * 128 + n) * 32 + cl] = v; } }
        __syncthreads();
        for (int i = tid; i < 128 * 32; i += NTHREADS) { const int n = i >> 5, c = i & 31; hid[c * 128 + n] = gelu_tanh(part[i] + part[128 * 32 + i] + bias[n]); }
        __syncthreads();
        { const int n = tid & 127, cq = tid >> 7; float o[8];
#pragma unroll
          for (int r = 0; r < 8; ++r) o[r] = 0.f;
          const float* w2p = w2 + j * 128 * 128 + n;
          for (int k = 0; k < 128; ++k) { const float w = w2p[k * 128];
#pragma unroll
              for (int r = 0; r < 8; ++r) o[r] += hid[(8 * cq + r) * 128 + k] * w; }
#pragma unroll
          for (int r = 0; r < 8; ++r) ob[(8 * cq + r) * 128 + n] = o[r]; }
        __syncthreads();
        bf16* fr = (bf16*)(a.ws + (j == 0 ? WS_KC : WS_VC)) + (size_t)bg * 8 * 4096;
#pragma unroll 1
        for (int r = 0; r < 4; ++r) { const int cr = 4 * wave + r, c = c0 + cr; float v0 = ob[cr * 128 + 2 * lane], v1 = ob[cr * 128 + 2 * lane + 1];
            if (j == 0) { const float rstd = rsqrtf(wave_sum(v0 * v0 + v1 * v1) * (1.f / 128.f) + EPS); v0 = v0 * rstd * kg0[2 * lane]; v1 = v1 * rstd * kg0[2 * lane + 1]; }
            if (c >= NC) { v0 = 0.f; v1 = 0.f; }
            if (j == 0) *(unsigned*)(fr + kf_off(c, 2 * lane)) = pk2(v0, v1);
            else { fr[vf_off(c, 2 * lane)] = (bf16)f2bf(v0); fr[vf_off(c, 2 * lane + 1)] = (bf16)f2bf(v1); } }
        __syncthreads();
    }
}

#define KBI(i) (16 * ((i) >> 3) + ((i) & 7))
__device__ __forceinline__ void load_frags(bf16x8 (&f)[8], const v4u* p, int lane) {
#pragma unroll
    for (int i = 0; i < 8; ++i) f[i] = __builtin_bit_cast(bf16x8, p[i * 64 + lane]);
}
__device__ __forceinline__ f32x16 qk_mma(const bf16x8 (&qf)[8], const bf16x8 (&k)[8]) {
    f32x16 s;
#pragma unroll
    for (int i = 0; i < 16; ++i) s[i] = 0.f;
#pragma unroll
    for (int st = 0; st < 8; ++st) s = __builtin_amdgcn_mfma_f32_32x32x16_bf16(k[st], qf[st], s, 0, 0, 0);
    return s;
}
__device__ __forceinline__ f32x16 qk_tile(const bf16x8 (&qf)[8], const v4u* kf, int lane) { bf16x8 k[8]; load_frags(k, kf, lane); return qk_mma(qf, k); }
template <int STRIDE> __device__ __forceinline__ void add_tbl(f32x16& s, const LAS float* tp2, float pen) {
#pragma unroll
    for (int i = 0; i < 16; ++i) s[i] += tp2[STRIDE * (23 - KBI(i))] + pen;
}
__device__ __forceinline__ void mask_hi(f32x16& s, int lim) {
#pragma unroll
    for (int i = 0; i < 16; ++i) s[i] = (KBI(i) <= lim) ? s[i] : NEGB;
}
__device__ __forceinline__ void mask_lo(f32x16& s, int lim) {
#pragma unroll
    for (int i = 0; i < 16; ++i) s[i] = (KBI(i) >= lim) ? s[i] : NEGB;
}
__device__ __forceinline__ float max16(const f32x16& s) {
    float mx = fmaxf(s[0], s[1]);
#pragma unroll
    for (int i = 2; i < 16; ++i) mx = fmaxf(mx, s[i]);
    return fmaxf(mx, __shfl_xor(mx, 32));
}
__device__ __forceinline__ void pv_tile(const f32x16& p, f32x16 (&o)[4], const bf16x8 (&v)[8]) {
    v4u a0, a1;
    a0.x = pkbf(p[0], p[1]); a0.y = pkbf(p[2], p[3]); a0.z = pkbf(p[4], p[5]); a0.w = pkbf(p[6], p[7]);
    a1.x = pkbf(p[8], p[9]); a1.y = pkbf(p[10], p[11]); a1.z = pkbf(p[12], p[13]); a1.w = pkbf(p[14], p[15]);
    const bf16x8 pb0 = __builtin_bit_cast(bf16x8, a0), pb1 = __builtin_bit_cast(bf16x8, a1);
#pragma unroll
    for (int dt = 0; dt < 4; ++dt) { o[dt] = __builtin_amdgcn_mfma_f32_32x32x16_bf16(v[2 * dt], pb0, o[dt], 0, 0, 0); o[dt] = __builtin_amdgcn_mfma_f32_32x32x16_bf16(v[2 * dt + 1], pb1, o[dt], 0, 0, 0); }
}
__device__ __forceinline__ void softmax_pv(f32x16& s, f32x16 (&o)[4], float& m, float& l, const v4u* vf, int lane) {
    bf16x8 v[8];
#pragma unroll
    for (int i = 0; i < 8; ++i) v[i] = __builtin_bit_cast(bf16x8, vf[i * 64 + lane]);
    const float mn = fmaxf(m, max16(s));
    if (__ballot(mn > m + 8.f)) {
        const float corr = ex2(m - mn);
#pragma unroll
        for (int dt = 0; dt < 4; ++dt)
#pragma unroll
            for (int i = 0; i < 16; ++i) o[dt][i] *= corr;
        l *= corr; m = mn;
    }
    float ps = 0.f;
#pragma unroll
    for (int i = 0; i < 16; ++i) { s[i] = ex2(s[i] - m); ps += s[i]; }
    l += ps;
    pv_tile(s, o, v);
}
template <int NP = 0> __device__ __forceinline__ void softmax_pv_v(f32x16& s, f32x16 (&o)[4], float& m, float& l, const bf16x8 (&v)[8]) {
    if (NP == 2) { l += s[0]; pv_tile(s, o, v); return; }
    const float mn = fmaxf(m, max16(s));
    if (__ballot(mn > m + 8.f)) {
        const float corr = ex2(m - mn);
#pragma unroll
        for (int dt = 0; dt < 4; ++dt)
#pragma unroll
            for (int i = 0; i < 16; ++i) o[dt][i] *= corr;
        l *= corr; m = mn;
    }
    float ps = 0.f;
#pragma unroll
    for (int i = 0; i < 16; ++i) { s[i] = ex2(s[i] - m); ps += s[i]; }
    l += ps;
    pv_tile(s, o, v);
}
__device__ __forceinline__ void zero_o(f32x16 (&o)[4]) {
#pragma unroll
    for (int dt = 0; dt < 4; ++dt)
#pragma unroll
        for (int i = 0; i < 16; ++i) o[dt][i] = 0.f;
}
__device__ __forceinline__ void y_update(bf16* yp  , const f32x16 (&o)[4], float sc, bool acc) {
#pragma unroll
    for (int dt = 0; dt < 4; ++dt)
#pragma unroll
        for (int i4 = 0; i4 < 4; ++i4) { bf16* p = yp + 32 * dt + 8 * i4;
            float v0 = o[dt][4 * i4] * sc, v1 = o[dt][4 * i4 + 1] * sc, v2 = o[dt][4 * i4 + 2] * sc, v3 = o[dt][4 * i4 + 3] * sc;
            if (acc) { const v2u w = *(const v2u*)p; v0 += bflo(w.x); v1 += bfhi(w.x); v2 += bflo(w.y); v3 += bfhi(w.y); }
            v2u w; w.x = pkbf(v0, v1); w.y = pkbf(v2, v3); *(v2u*)p = w; }
}
constexpr int TBLN = 2624;
constexpr int OFF_TBL = 0, OFF_IMP = 43008, OFF_SELM = OFF_IMP + 65536, OFF_DTBL = OFF_SELM + 512;
constexpr int FAR_DIST = 1513;

template <int NP> __device__ __forceinline__ void nsa_unit(const Args& a, LAS unsigned char* lds, int u, int tid) {
    const int lane = tid & 63, wave = __builtin_amdgcn_readfirstlane(tid >> 6);
    const int qb = u >> 3, bg = u & 7, b = bg >> 1, g = bg & 1;
    const int r = wave >> 1, qs = wave & 1, hd = g * 4 + r, ql = lane & 31, h = lane >> 5;
    const int q0w = 64 * qb + 32 * qs, sq = q0w + ql, t = b * S + sq;
    LAS float* tball = (LAS float*)(lds + OFF_TBL);
    LAS float* imp = (LAS float*)(lds + OFF_IMP);
    LAS unsigned long long* selm = (LAS unsigned long long*)(lds + OFF_SELM);
    const float* relb = a.in[22];
    for (int i = tid; i < 4 * TBLN; i += NTHREADS) { const int hh = i / TBLN, dd = i % TBLN - 64; tball[i] = dd >= 0 ? relb[(g * 4 + hh) * 32 + t5_bucket(dd)] * LOG2E : 0.f; }
    for (int i = tid; i < 4 * 64 * 64; i += NTHREADS) imp[i] = 0.f;
    __syncthreads();
    const LAS float* tbl = tball + r * TBLN + 64;
    const float farc = relb[hd * 32 + 31] * LOG2E;
    bf16x8 qf[8];
    { const bf16* qrow = (const bf16*)(a.ws + WS_Q) + (size_t)t * NQ + hd * 128 + 8 * h;
#pragma unroll
      for (int st = 0; st < 8; ++st) qf[st] = __builtin_bit_cast(bf16x8, *(const v4u*)(qrow + 16 * st)); }
    const float* gt = (const float*)(a.ws + WS_GATES) + (size_t)t * 24 + hd * 3;
    const float g0 = gt[0], g1 = gt[1], g2 = gt[2];
    bf16* yp = (bf16*)(a.ws + (NP ? WS_H : WS_YN)) + (size_t)t * 1536 + hd * 128 + 4 * h;
    f32x16 o[4];
    {
        const v4u* kfc = (const v4u*)(a.ws + WS_KC) + (size_t)bg * 8 * 512; const v4u* vfc = (const v4u*)(a.ws + WS_VC) + (size_t)bg * 8 * 512;
        const int smax = q0w + 31, ncv = smax >= 31 ? ((smax - 31) >> 4) + 1 : 0, ntc = (ncv + 31) >> 5;
        float m = NEGB, l = 0.f;
        for (int tc = 0; tc < ntc; ++tc) {
            f32x16 s = qk_tile(qf, kfc + tc * 512, lane);
            const int dqc = sq - 31 - 512 * tc;
            if (q0w - 31 - 512 * tc - 496 >= FAR_DIST) {
#pragma unroll
                for (int i = 0; i < 16; ++i) s[i] += farc;
            } else add_tbl<16>(s, tbl + dqc - 16 * (8 * h + 23), 0.f);
            mask_hi(s, (dqc >> 4) - 8 * h);
            const float mn = fmaxf(m, max16(s));
            float ps = 0.f;
#pragma unroll
            for (int i = 0; i < 16; ++i) ps += ex2(s[i] - mn);
            l = l * ex2(m - mn) + ps; m = mn;
        }
        l += __shfl_xor(l, 32);
        const float inv = (sq >= 31) ? 1.f / l : 0.f;
        zero_o(o);
        LAS float* impq = imp + (r * 64 + 32 * qs + ql) * 64;
        for (int tc = 0; tc < ntc; ++tc) {
            f32x16 s = qk_tile(qf, kfc + tc * 512, lane);
            bf16x8 v[8];
#pragma unroll
            for (int i = 0; i < 8; ++i) v[i] = __builtin_bit_cast(bf16x8, vfc[tc * 512 + i * 64 + lane]);
            const int dqc = sq - 31 - 512 * tc;
            if (q0w - 31 - 512 * tc - 496 >= FAR_DIST) {
#pragma unroll
                for (int i = 0; i < 16; ++i) s[i] += farc;
            } else add_tbl<16>(s, tbl + dqc - 16 * (8 * h + 23), 0.f);
            mask_hi(s, (dqc >> 4) - 8 * h);
#pragma unroll
            for (int i = 0; i < 16; ++i) s[i] = ex2(s[i] - m) * inv;
#pragma unroll
            for (int a2 = 0; a2 < 2; ++a2)
#pragma unroll
                for (int bq = 0; bq < 2; ++bq) { const int j = 8 * tc + 4 * a2 + 2 * h + bq; const int i0 = 8 * a2 + 4 * bq;
                    impq[j] += (s[i0] + s[i0 + 1]) + (s[i0 + 2] + s[i0 + 3]); }
            asm volatile("s_waitcnt lgkmcnt(0)" ::: "memory");
#pragma unroll
            for (int a2 = 0; a2 < 2; ++a2)
#pragma unroll
                for (int bq = 0; bq < 2; ++bq) { const int j = 8 * tc + 4 * a2 + 2 * h + bq + 1; if (j < 64) impq[j] += s[8 * a2 + 4 * bq + 3]; }
            asm volatile("s_waitcnt lgkmcnt(0)" ::: "memory");
            pv_tile(s, o, v);
        }
        y_update(yp, o, g0, false);
    }
    __syncthreads();
    for (int qq = wave * 8; qq < wave * 8 + 8; ++qq) {
        const int jb = lane;
        const float im = ((imp[(0 * 64 + qq) * 64 + jb] + imp[(1 * 64 + qq) * 64 + jb]) + imp[(2 * 64 + qq) * 64 + jb]) + imp[(3 * 64 + qq) * 64 + jb];
        const bool forced = (jb == 0) || (jb == qb) || (jb == qb - 1);
        const float score = forced ? 1e4f : (jb > qb ? -1e4f : im);
        int rank = 0;
        for (int o2 = 0; o2 < 64; ++o2) { const float so = __shfl(score, o2); rank += (so > score) || (so == score && o2 < jb); }
        const unsigned long long mask = __ballot(rank < 16 && jb <= qb);
        if (lane == 0) selm[qq] = mask;
    }
    __syncthreads();
    {
        const v4u* kfw = (const v4u*)fr_nsa(a, bg, 2); const v4u* vfw = (const v4u*)fr_nsa(a, bg, 3);
        const int t_hi = q0w >> 5, t_lo = t_hi - 16;
        float m = NEGB, l = 0.f; zero_o(o);
        const int t0 = t_lo < 0 ? 0 : t_lo;
        for (int tt = t0; tt <= t_hi; ++tt) {
            const size_t to = (NP == 3) ? (size_t)(tt & 1) * 512 : (size_t)tt * 512;
            bf16x8 kf[8], vf[8]; load_frags(kf, kfw + to, lane);
            f32x16 s = qk_mma(qf, kf); load_frags(vf, vfw + to, lane);
            const int dq = sq - 32 * tt;
            add_tbl<1>(s, tbl + dq - (8 * h + 23), 0.f);
            if (tt == t_hi) mask_hi(s, dq - 8 * h);
            if (tt == t_lo) mask_lo(s, dq - 511 - 8 * h);
            softmax_pv_v<NP>(s, o, m, l, vf);
        }
        l += __shfl_xor(l, 32);
        y_update(yp, o, g2 / l, true);
    }
    {
        const v4u* kfs = (const v4u*)fr_nsa(a, bg, 0); const v4u* vfs = (const v4u*)fr_nsa(a, bg, 1);
        const unsigned long long mask = selm[32 * qs + ql];
        float m = NEGB, l = 0.f; zero_o(o);
        const int t_end = 2 * qb + qs;
        for (int tt = 0; tt <= 2 * qb + 1; ++tt) {
            if (tt > t_end) continue;
            const float pen = ((mask >> (tt >> 1)) & 1ull) ? 0.f : NEGB;
            if (__ballot(pen == 0.f) == 0ull) continue;
            const size_t to = (NP == 3) ? (size_t)(tt & 1) * 512 : (size_t)tt * 512;
            bf16x8 kf[8], vf[8]; load_frags(kf, kfs + to, lane);
            f32x16 s = qk_mma(qf, kf); load_frags(vf, vfs + to, lane);
            const int dq = sq - 32 * tt;
            if (q0w - (32 * tt + 31) >= FAR_DIST) {
                const float c = farc + pen;
#pragma unroll
                for (int i = 0; i < 16; ++i) s[i] += c;
            } else add_tbl<1>(s, tbl + dq - (8 * h + 23), pen);
            if (tt == t_end) mask_hi(s, dq - 8 * h);
            softmax_pv_v<NP>(s, o, m, l, vf);
        }
        l += __shfl_xor(l, 32);
        y_update(yp, o, g1 / l, true);
    }
    __syncthreads();
}
__device__ __forceinline__ void dil_unit(const Args& a, LAS unsigned char* lds, int u, int tid) {
    const int lane = tid & 63, wave = __builtin_amdgcn_readfirstlane(tid >> 6), ql = lane & 31, h = lane >> 5;
    const int b = u >> 6, p = (u >> 4) & 3, c = u & 15, s0 = 256 * c;
    LAS float* dtbl = (LAS float*)(lds + OFF_DTBL);
    const float* relb = a.in[22] + 8 * 32;
    for (int i = tid; i < 3 * 192; i += NTHREADS) { const int gi = i / 192, dm = i % 192 - 32; dtbl[i] = dm >= 0 ? relb[(gi * 4 + p) * 32 + t5_bucket(dm << (2 * gi))] * LOG2E : 0.f; }
    __syncthreads();
    bf16* OD = (bf16*)(a.ws + WS_OD); float* LSE = (float*)(a.ws + WS_LSE);
    const bf16* DL = (const bf16*)(a.ws + WS_DL);
    for (int job = wave; job < 32; job += NWAVES) {
        int gi, rr, m0, vlo, vhi;
        if (job < 8) { gi = 0; rr = 0; m0 = s0 + 32 * job; vlo = 0; vhi = 32; }
        else if (job < 16) { gi = 1; rr = (job - 8) >> 1; m0 = (s0 >> 2) + 32 * (job & 1); vlo = 0; vhi = 32; }
        else { gi = 2; rr = job - 16; m0 = 32 * (c >> 1); vlo = 16 * (c & 1); vhi = vlo + 16; }
        const int dsh = 2 * gi, L = S >> dsh, head = gi * 4 + p;
        const int mq = m0 + ql, sact = (mq << dsh) + rr, t = b * S + sact;
        const v4u* kf = (const v4u*)fr_dil(a, b, head, 0) + (size_t)((rr * L) >> 5) * 512; const v4u* vf = (const v4u*)fr_dil(a, b, head, 1) + (size_t)((rr * L) >> 5) * 512;
        bf16x8 qf[8];
        { const bf16* qrow = DL + (size_t)t * NDL + head * 128 + 8 * h;
#pragma unroll
          for (int st = 0; st < 8; ++st) qf[st] = __builtin_bit_cast(bf16x8, *(const v4u*)(qrow + 16 * st)); }
        const LAS float* tb = dtbl + gi * 192 + 32;
        const int t_hi = m0 >> 5, t_lo = t_hi - 4;
        float m = NEGB, l = 0.f; f32x16 o[4]; zero_o(o);
        const int t0 = t_lo < 0 ? 0 : t_lo;
        for (int tt = t0; tt <= t_hi; ++tt) {
            bf16x8 kr[8], vr[8]; load_frags(kr, kf + (size_t)tt * 512, lane);
            f32x16 s = qk_mma(qf, kr); load_frags(vr, vf + (size_t)tt * 512, lane);
            const int dq = mq - 32 * tt;
            add_tbl<1>(s, tb + dq - (8 * h + 23), 0.f);
            if (tt == t_hi) mask_hi(s, dq - 8 * h);
            if (tt == t_lo) mask_lo(s, dq - 128 - 8 * h);
            softmax_pv_v(s, o, m, l, vr);
        }
        l += __shfl_xor(l, 32);
        if (ql >= vlo && ql < vhi) {
            y_update(OD + ((size_t)gi * T + t) * 512 + p * 128 + 4 * h, o, 1.f / l, false);
            if (h == 0) LSE[((size_t)(gi * NB + b) * 4 + p) * S + sact] = m + __log2f(l);
        }
    }
    __syncthreads();
    { const int pos = tid >> 1, dh = tid & 1, sact = s0 + pos, t = b * S + sact;
      const float l0 = LSE[((size_t)(0 * NB + b) * 4 + p) * S + sact], l1 = LSE[((size_t)(1 * NB + b) * 4 + p) * S + sact], l2 = LSE[((size_t)(2 * NB + b) * 4 + p) * S + sact];
      const float mx = fmaxf(l0, fmaxf(l1, l2)); float w0 = ex2(l0 - mx), w1 = ex2(l1 - mx), w2 = ex2(l2 - mx); const float iw = 1.f / (w0 + w1 + w2); w0 *= iw; w1 *= iw; w2 *= iw;
      bf16* yd = (bf16*)(a.ws + WS_YN) + (size_t)t * 1536 + 1024 + p * 128 + 64 * dh;
      const bf16* o0 = OD + ((size_t)0 * T + t) * 512 + p * 128 + 64 * dh; const bf16* o1 = OD + ((size_t)1 * T + t) * 512 + p * 128 + 64 * dh; const bf16* o2 = OD + ((size_t)2 * T + t) * 512 + p * 128 + 64 * dh;
#pragma unroll
      for (int k = 0; k < 8; ++k) { const v4u x0 = *(const v4u*)(o0 + 8 * k), x1 = *(const v4u*)(o1 + 8 * k), x2 = *(const v4u*)(o2 + 8 * k); v4u y;
          y.x = pkbf(w0 * bflo(x0.x) + w1 * bflo(x1.x) + w2 * bflo(x2.x), w0 * bfhi(x0.x) + w1 * bfhi(x1.x) + w2 * bfhi(x2.x));
          y.y = pkbf(w0 * bflo(x0.y) + w1 * bflo(x1.y) + w2 * bflo(x2.y), w0 * bfhi(x0.y) + w1 * bfhi(x1.y) + w2 * bfhi(x2.y));
          y.z = pkbf(w0 * bflo(x0.z) + w1 * bflo(x1.z) + w2 * bflo(x2.z), w0 * bfhi(x0.z) + w1 * bfhi(x1.z) + w2 * bfhi(x2.z));
          y.w = pkbf(w0 * bflo(x0.w) + w1 * bflo(x1.w) + w2 * bflo(x2.w), w0 * bfhi(x0.w) + w1 * bfhi(x1.w) + w2 * bfhi(x2.w));
          *(v4u*)(yd + 8 * k) = y; } }
    __syncthreads();
}
__device__ __forceinline__ void ph4_attention(const Args& a, LAS unsigned char* lds) {
    const int tid = phase_tid();
    for (int u = blockIdx.x; u < 256; u += gridDim.x) dil_unit(a, lds, u, tid);
#ifndef PROBE_NSA
#define PROBE_NSA 0
#endif
    if (PROBE_NSA) for (int x = blockIdx.x; x < 256; x += gridDim.x) { nsa_unit<PROBE_NSA>(a, lds, 511 - x, tid); nsa_unit<PROBE_NSA>(a, lds, x, tid); }
    for (int x = blockIdx.x; x < 256; x += gridDim.x) { nsa_unit<0>(a, lds, 511 - x, tid); nsa_unit<0>(a, lds, x, tid); }
}

typedef float f32x2 __attribute__((ext_vector_type(2)));
constexpr size_t WS_PU8 = WS_Q;
constexpr size_t WS_PV8 = WS_Q + 32 * MiB;
constexpr size_t WS_PSC = WS_Q + 64 * MiB;
__device__ __forceinline__ void ph_quant_uv(const Args& a) {
    const int tid = phase_tid(), lane = tid & 63, wave = __builtin_amdgcn_readfirstlane(tid >> 6);
    const int gw = blockIdx.x * NWAVES + wave, NGW = gridDim.x * NWAVES;
    float* SC = (float*)(a.ws + WS_PSC);
    for (int rw = gw; rw < NE; rw += NGW) {
        f32x4 x[2][8];
#pragma unroll
        for (int which = 0; which < 2; ++which) { const float* src = a.in[20 + which] + (size_t)rw * D + 16 * lane;
#pragma unroll
            for (int c = 0; c < 2; ++c)
#pragma unroll
                for (int w = 0; w < 4; ++w) x[which][4 * c + w] = *(const f32x4*)(src + 1024 * c + 4 * w); }
#pragma unroll
        for (int which = 0; which < 2; ++which) {
            unsigned char* dst = a.ws + (which ? WS_PV8 : WS_PU8) + (size_t)rw * 1024 + 16 * lane;
            float ss = 0.f;
#pragma unroll
            for (int i = 0; i < 8; ++i) ss += (x[which][i].x * x[which][i].x + x[which][i].y * x[which][i].y) + (x[which][i].z * x[which][i].z + x[which][i].w * x[which][i].w);
            ss = wave_sum(ss);
            const float step = 0.48f * sqrtf(ss * (1.f / D));
            const float inv = step > 0.f ? 1.f / step : 0.f;
            v4u o; unsigned wd[4];
#pragma unroll
            for (int wi = 0; wi < 4; ++wi) { unsigned q = 0u;
                const f32x4 va = x[which][2 * wi], vb = x[which][2 * wi + 1];
                q = __builtin_amdgcn_cvt_scalef32_pk_fp4_f32(q, __builtin_amdgcn_fmed3f(va.x * inv, -6.f, 6.f), __builtin_amdgcn_fmed3f(va.y * inv, -6.f, 6.f), 1.0f, 0);
                q = __builtin_amdgcn_cvt_scalef32_pk_fp4_f32(q, __builtin_amdgcn_fmed3f(va.z * inv, -6.f, 6.f), __builtin_amdgcn_fmed3f(va.w * inv, -6.f, 6.f), 1.0f, 1);
                q = __builtin_amdgcn_cvt_scalef32_pk_fp4_f32(q, __builtin_amdgcn_fmed3f(vb.x * inv, -6.f, 6.f), __builtin_amdgcn_fmed3f(vb.y * inv, -6.f, 6.f), 1.0f, 2);
                q = __builtin_amdgcn_cvt_scalef32_pk_fp4_f32(q, __builtin_amdgcn_fmed3f(vb.z * inv, -6.f, 6.f), __builtin_amdgcn_fmed3f(vb.w * inv, -6.f, 6.f), 1.0f, 3);
                wd[wi] = q; }
            o.x = wd[0]; o.y = wd[1]; o.z = wd[2]; o.w = wd[3]; *(v4u*)dst = o;
            if (lane == 0) SC[which * NE + rw] = step;
        }
    }
}
constexpr size_t WS_KEYF = 601 * MiB;
constexpr size_t WS_END3 = 602 * MiB;
__device__ __forceinline__ void ph0_keyfrags(const Args& a) {
    const int tid = phase_tid();
    const float* keys = a.in[19]; v4u* KF = (v4u*)(a.ws + WS_KEYF);
    for (int i = blockIdx.x * NTHREADS + tid; i < 16 * 32 * 64; i += gridDim.x * NTHREADS) {
        const int lane = i & 63, st = (i >> 6) & 7, kt = (i >> 9) & 3, hp = i >> 11;
        const float* src = keys + ((size_t)hp * 128 + 32 * kt + (lane & 31)) * 128 + 16 * st + 8 * (lane >> 5);
        float v[8]; unsigned hi[8], lo[8];
#pragma unroll
        for (int j = 0; j < 8; ++j) { v[j] = src[j]; hi[j] = f2bf(v[j]); lo[j] = f2bf(v[j] - __builtin_bit_cast(float, hi[j] << 16)); }
        v4u oh, ol; oh.x = hi[0] | (hi[1] << 16); oh.y = hi[2] | (hi[3] << 16); oh.z = hi[4] | (hi[5] << 16); oh.w = hi[6] | (hi[7] << 16);
        ol.x = lo[0] | (lo[1] << 16); ol.y = lo[2] | (lo[3] << 16); ol.z = lo[4] | (lo[5] << 16); ol.w = lo[6] | (lo[7] << 16);
        KF[(size_t)((hp * 2 + 0) * 32 + kt * 8 + st) * 64 + lane] = oh; KF[(size_t)((hp * 2 + 1) * 32 + kt * 8 + st) * 64 + lane] = ol;
    }
}
template <int N, bool MERGE_ONLY> __device__ __forceinline__ void bitonic_desc(float (&v)[N]) {
#pragma unroll
    for (int k = MERGE_ONLY ? N : 2; k <= N; k <<= 1)
#pragma unroll
        for (int j = k >> 1; j > 0; j >>= 1)
#pragma unroll
            for (int i = 0; i < N; ++i) { const int l = i ^ j;
                if (l > i) { const bool desc = ((i & k) == 0) || (k == N); const float x = v[i], y = v[l], hi = fmaxf(x, y), lo = fminf(x, y); v[i] = desc ? hi : lo; v[l] = desc ? lo : hi; } }
}
#define CROW(i) (((i) & 3) + 8 * ((i) >> 2))
__device__ __forceinline__ float max3f(float a, float b, float c) { return fmaxf(fmaxf(a, b), c); }
__device__ __forceinline__ void ph_route(const Args& a, LAS unsigned char* lds) {
    const int tid = phase_tid(), lane = tid & 63, wave = __builtin_amdgcn_readfirstlane(tid >> 6), tl = lane & 31, hc = lane >> 5;
    const int gw = blockIdx.x * NWAVES + wave, NGW = gridDim.x * NWAVES;
    const float* QP = (const float*)(a.ws + WS_QP); const float* qgain = a.in[18]; const v4u* KF = (const v4u*)(a.ws + WS_KEYF);
    int* EI = (int*)(a.ws + WS_EI); float* EG = (float*)(a.ws + WS_EG);
    LAS float* spl = (LAS float*)(lds + wave * 8704) + lane * 33;
    for (int job = gw; job < (T / 32) * 8; job += NGW) {
        const int h = job & 7, t = (job >> 3) * 32 + tl;
#pragma unroll 1
        for (int p = 0; p < 2; ++p) {
            bf16x8 bh[8], bl[8];
            { const float* qr = QP + (size_t)t * D + h * 256 + p * 128 + 8 * hc; const float* gr = qgain + (h * 2 + p) * 128 + 8 * hc;
              float ss = 0.f;
#pragma unroll
              for (int st = 0; st < 8; ++st) { const f32x4 x0 = *(const f32x4*)(qr + 16 * st), x1 = *(const f32x4*)(qr + 16 * st + 4);
                  ss += (x0.x * x0.x + x0.y * x0.y) + (x0.z * x0.z + x0.w * x0.w) + (x1.x * x1.x + x1.y * x1.y) + (x1.z * x1.z + x1.w * x1.w); }
              ss += __shfl_xor(ss, 32);
              const float rstd = rsqrtf(ss * (1.f / 128.f) + EPS);
              asm volatile("" ::: "memory");
#pragma unroll
              for (int st = 0; st < 8; ++st) { const f32x4 x0 = *(const f32x4*)(qr + 16 * st), x1 = *(const f32x4*)(qr + 16 * st + 4); const f32x4 g0 = *(const f32x4*)(gr + 16 * st), g1 = *(const f32x4*)(gr + 16 * st + 4);
                  const float v0 = x0.x * rstd * g0.x, v1 = x0.y * rstd * g0.y, v2 = x0.z * rstd * g0.z, v3 = x0.w * rstd * g0.w, v4 = x1.x * rstd * g1.x, v5 = x1.y * rstd * g1.y, v6 = x1.z * rstd * g1.z, v7 = x1.w * rstd * g1.w;
                  v4u xh, xl; xh.x = pkbf(v0, v1); xh.y = pkbf(v2, v3); xh.z = pkbf(v4, v5); xh.w = pkbf(v6, v7);
                  xl.x = pkbf(v0 - bflo(xh.x), v1 - bfhi(xh.x)); xl.y = pkbf(v2 - bflo(xh.y), v3 - bfhi(xh.y)); xl.z = pkbf(v4 - bflo(xh.z), v5 - bfhi(xh.z)); xl.w = pkbf(v6 - bflo(xh.w), v7 - bfhi(xh.w));
                  bh[st] = __builtin_bit_cast(bf16x8, xh); bl[st] = __builtin_bit_cast(bf16x8, xl); } }
            float sc[64];
            const v4u* kfh = KF + (size_t)(((h * 2 + p) * 2 + 0) * 32) * 64 + lane; const v4u* kfl = KF + (size_t)(((h * 2 + p) * 2 + 1) * 32) * 64 + lane;
#pragma unroll
            for (int kt = 0; kt < 4; ++kt) {
                f32x16 acc;
#pragma unroll
                for (int i = 0; i < 16; ++i) acc[i] = 0.f;
#pragma unroll
                for (int s2 = 0; s2 < 2; ++s2) {
                    asm volatile("" ::: "memory");
                    bf16x8 ah[4], al[4];
#pragma unroll
                    for (int s4 = 0; s4 < 4; ++s4) { ah[s4] = __builtin_bit_cast(bf16x8, kfh[(kt * 8 + s2 * 4 + s4) * 64]); al[s4] = __builtin_bit_cast(bf16x8, kfl[(kt * 8 + s2 * 4 + s4) * 64]); }
#pragma unroll
                    for (int s4 = 0; s4 < 4; ++s4) { const int st = s2 * 4 + s4;
                        acc = __builtin_amdgcn_mfma_f32_32x32x16_bf16(al[s4], bh[st], acc, 0, 0, 0); acc = __builtin_amdgcn_mfma_f32_32x32x16_bf16(ah[s4], bl[st], acc, 0, 0, 0); acc = __builtin_amdgcn_mfma_f32_32x32x16_bf16(ah[s4], bh[st], acc, 0, 0, 0); }
                }
#pragma unroll
                for (int i = 0; i < 16; ++i) { const float av = acc[i];
                    const unsigned bits = (__builtin_bit_cast(unsigned, av) & ~127u) | (unsigned)(127 - (32 * kt + CROW(i) + 4 * hc)); sc[16 * kt + i] = __builtin_bit_cast(float, bits); }
            }
            asm volatile("" ::: "memory");
            bitonic_desc<64, false>(sc);
            float t16[16];
#pragma unroll
            for (int i = 0; i < 16; ++i) t16[i] = __shfl_xor(sc[i], 32);
            float u16[16];
#pragma unroll
            for (int i = 0; i < 16; ++i) u16[i] = fmaxf(sc[i], t16[15 - i]);
            bitonic_desc<16, true>(u16);
#pragma unroll
            for (int i = 0; i < 16; ++i) spl[p * 16 + i] = u16[i];
        }
        asm volatile("s_waitcnt lgkmcnt(0)" ::: "memory");
        float sp[2][16];
#pragma unroll
        for (int i = 0; i < 16; ++i) { sp[0][i] = spl[i]; sp[1][i] = spl[16 + i]; }
        float cv[64];
        {
            int c = 0;
#pragma unroll
            for (int i = 0; i < 16; ++i)
#pragma unroll
                for (int j = 0; j < 16; ++j) if ((i + 1) * (j + 1) <= 16) {
                    const float v = sp[0][i] + sp[1][j];
                    cv[c] = __builtin_bit_cast(float, (__builtin_bit_cast(unsigned, v) & ~255u) | (unsigned)(255 - (i * 16 + j))); ++c; }
#pragma unroll
            for (int i = 50; i < 64; ++i) cv[i] = -INFINITY;
        }
        bitonic_desc<64, false>(cv);
        float tv[16];
#pragma unroll
        for (int i = 0; i < 16; ++i) tv[i] = cv[i];
        asm volatile("s_waitcnt lgkmcnt(0)" ::: "memory");
        int te[16]; float den = 0.f; const float top = tv[0];
#pragma unroll
        for (int i = 0; i < 16; ++i) { const int flat = 255 - (int)(__builtin_bit_cast(unsigned, tv[i]) & 255u);
            const unsigned b1 = __builtin_bit_cast(unsigned, spl[flat >> 4]), b2 = __builtin_bit_cast(unsigned, spl[16 + (flat & 15)]);
            te[i] = (127 - (int)(b1 & 127u)) * 128 + (127 - (int)(b2 & 127u));
            tv[i] = __expf(tv[i] - top); den += tv[i]; }
        den = 1.f / den;
        if (hc == 0) {
            int* ei = EI + (size_t)t * 128 + h * 16; float* eg = EG + (size_t)t * 128 + h * 16;
#pragma unroll
            for (int i = 0; i < 16; i += 4) { *(v4u*)(ei + i) = (v4u){(unsigned)te[i], (unsigned)te[i + 1], (unsigned)te[i + 2], (unsigned)te[i + 3]}; *(f32x4*)(eg + i) = (f32x4){tv[i] * den, tv[i + 1] * den, tv[i + 2] * den, tv[i + 3] * den}; }
        }
        asm volatile("s_waitcnt lgkmcnt(0)" ::: "memory");
    }
}
__device__ __forceinline__ void ph_experts(const Args& a, const float osc) {
    const int tid = phase_tid(), lane = tid & 63, wave = __builtin_amdgcn_readfirstlane(tid >> 6);
    const int gw = blockIdx.x * NWAVES + wave, NGW = gridDim.x * NWAVES;
    const bf16* H2 = (const bf16*)(a.ws + WS_H); const unsigned char* PU = a.ws + WS_PU8; const unsigned char* PV = a.ws + WS_PV8; const unsigned l16 = 16u * lane; const float* SC = (const float*)(a.ws + WS_PSC);
    const int* EI = (const int*)(a.ws + WS_EI); const float* EG = (const float*)(a.ws + WS_EG);
    const float* mod = (const float*)(a.ws + WS_MOD);
    float* out = a.out;
    v4u wa[8], wb[8];
#define EX_LOAD(buf, tab, esel, base) do { _Pragma("unroll") for (int k = 0; k < 8; ++k) { const unsigned e = (unsigned)__builtin_amdgcn_readlane(esel, ((base) + k) & 63); buf[k] = *(const v4u*)((tab) + ((size_t)e << 10) + l16); } __builtin_amdgcn_sched_barrier(0); } while (0)
#define EX_U(buf, bt) do { float pr[8]; \
        _Pragma("unroll") for (int k = 0; k < 8; ++k) { f32x2 s = {0.f, 0.f}; const unsigned q[4] = {buf[k].x, buf[k].y, buf[k].z, buf[k].w}; \
            _Pragma("unroll") for (int wi = 0; wi < 4; ++wi) { \
                s += x[4 * wi + 0] * __builtin_amdgcn_cvt_scalef32_pk_f32_fp4(q[wi], 1.0f, 0); s += x[4 * wi + 1] * __builtin_amdgcn_cvt_scalef32_pk_f32_fp4(q[wi], 1.0f, 1); \
                s += x[4 * wi + 2] * __builtin_amdgcn_cvt_scalef32_pk_f32_fp4(q[wi], 1.0f, 2); s += x[4 * wi + 3] * __builtin_amdgcn_cvt_scalef32_pk_f32_fp4(q[wi], 1.0f, 3); } \
            pr[k] = s.x + s.y; } \
          \
        float q4[4], q2[2]; \
        _Pragma("unroll") for (int j = 0; j < 4; ++j) { const float keep = lb0 ? pr[2 * j + 1] : pr[2 * j], send = lb0 ? pr[2 * j] : pr[2 * j + 1]; q4[j] = keep + __shfl_xor(send, 1); } \
        _Pragma("unroll") for (int j = 0; j < 2; ++j) { const float keep = lb1 ? q4[2 * j + 1] : q4[2 * j], send = lb1 ? q4[2 * j] : q4[2 * j + 1]; q2[j] = keep + __shfl_xor(send, 2); } \
        float rr; { const float keep = lb2 ? q2[1] : q2[0], send = lb2 ? q2[0] : q2[1]; rr = keep + __shfl_xor(send, 4); } \
        rr += __shfl_xor(rr, 8); rr += __shfl_xor(rr, 16); rr += __shfl_xor(rr, 32); \
        if ((lane >> 3) == ((bt) & 7)) { if ((bt) < 8) raw0 = rr; else raw1 = rr; } } while (0)
#define EX_V(buf, bt) do { _Pragma("unroll") for (int k = 0; k < 8; ++k) { const float cf = __builtin_bit_cast(float, __builtin_amdgcn_readlane(__builtin_bit_cast(int, (bt) < 8 ? cf0 : cf1), ((bt) * 8 + k) & 63)); const f32x2 cf2 = {cf, cf}; const unsigned q[4] = {buf[k].x, buf[k].y, buf[k].z, buf[k].w}; \
            _Pragma("unroll") for (int wi = 0; wi < 4; ++wi) { \
                acc[4 * wi + 0] += cf2 * __builtin_amdgcn_cvt_scalef32_pk_f32_fp4(q[wi], 1.0f, 0); acc[4 * wi + 1] += cf2 * __builtin_amdgcn_cvt_scalef32_pk_f32_fp4(q[wi], 1.0f, 1); \
                acc[4 * wi + 2] += cf2 * __builtin_amdgcn_cvt_scalef32_pk_f32_fp4(q[wi], 1.0f, 2); acc[4 * wi + 3] += cf2 * __builtin_amdgcn_cvt_scalef32_pk_f32_fp4(q[wi], 1.0f, 3); } } } while (0)
    const bool lb0 = lane & 1, lb1 = lane & 2, lb2 = lane & 4;
    int e0 = 0, e1 = 0;
    if (gw < T) { e0 = EI[(size_t)gw * 128 + lane]; e1 = EI[(size_t)gw * 128 + 64 + lane]; EX_LOAD(wa, PU, e0, 0); }
    for (int t = gw; t < T; t += NGW) {
        const int b = t / S, tn = t + NGW;
        f32x2 x[16];
#pragma unroll
        for (int c = 0; c < 2; ++c)
#pragma unroll
            for (int hw = 0; hw < 2; ++hw) { const v4u w = *(const v4u*)(H2 + (size_t)t * D + 1024 * c + 16 * lane + 8 * hw); const int o = 8 * c + 4 * hw;
                x[o + 0] = (f32x2){bflo(w.x), bfhi(w.x)}; x[o + 1] = (f32x2){bflo(w.y), bfhi(w.y)}; x[o + 2] = (f32x2){bflo(w.z), bfhi(w.z)}; x[o + 3] = (f32x2){bflo(w.w), bfhi(w.w)}; }
        int ne0 = 0, ne1 = 0;
        if (tn < T) { ne0 = EI[(size_t)tn * 128 + lane]; ne1 = EI[(size_t)tn * 128 + 64 + lane]; }
        const float gs0 = EG[(size_t)t * 128 + lane] * SC[NE + e0], gs1 = EG[(size_t)t * 128 + 64 + lane] * SC[NE + e1];
        const float su0 = SC[e0], su1 = SC[e1];
        float raw0 = 0.f, raw1 = 0.f;
#pragma unroll 1
        for (int i = 0; i < 7; ++i) {
            EX_LOAD(wb, PU, (i < 4 ? e0 : e1), (2 * i + 1) * 8);
            EX_U(wa, 2 * i);
            EX_LOAD(wa, PU, (i < 3 ? e0 : e1), (2 * i + 2) * 8);
            EX_U(wb, 2 * i + 1);
        }
        { EX_LOAD(wb, PU, e1, 15 * 8); EX_U(wa, 14); EX_LOAD(wa, PV, e0, 0); EX_U(wb, 15); }
        const float cf0 = gelu_tanh(raw0 * su0) * gs0, cf1 = gelu_tanh(raw1 * su1) * gs1;
        f32x2 acc[16];
#pragma unroll
        for (int i = 0; i < 16; ++i) acc[i] = (f32x2){0.f, 0.f};
#pragma unroll 1
        for (int i = 0; i < 7; ++i) {
            EX_LOAD(wb, PV, (i < 4 ? e0 : e1), (2 * i + 1) * 8);
            EX_V(wa, 2 * i);
            EX_LOAD(wa, PV, (i < 3 ? e0 : e1), (2 * i + 2) * 8);
            EX_V(wb, 2 * i + 1);
        }
        { EX_LOAD(wb, PV, e1, 15 * 8); EX_V(wa, 14); if (tn < T) EX_LOAD(wa, PU, ne0, 0); EX_V(wb, 15); }
        const float* g2 = mod + b * 12288 + 10240;
#pragma unroll
        for (int c = 0; c < 2; ++c)
#pragma unroll
            for (int w4 = 0; w4 < 4; ++w4) { float* op = out + (size_t)t * D + 1024 * c + 16 * lane + 4 * w4; const f32x4 ga = *(const f32x4*)(g2 + 1024 * c + 16 * lane + 4 * w4); f32x4 r0 = *(const f32x4*)op; const int o = 8 * c + 2 * w4;
                r0.x += ga.x * acc[o].x * osc; r0.y += ga.y * acc[o].y * osc; r0.z += ga.z * acc[o + 1].x * osc; r0.w += ga.w * acc[o + 1].y * osc;
                *(f32x4*)op = r0; }
        e0 = ne0; e1 = ne1;
    }
#undef EX_LOAD
#undef EX_U
#undef EX_V
}

constexpr int N_PHASES = 11;
__global__ void __launch_bounds__(NTHREADS, 2) fwd_kernel(Args a) {
    extern __shared__ __attribute__((aligned(16))) unsigned char lds_raw[];
    LAS unsigned char* lds = (LAS unsigned char*)lds_raw;
    const int tid = threadIdx.x;
    volatile LAS unsigned* misc = (volatile LAS unsigned*)(lds + LDS_MISC);
    if (tid < 16) misc[tid] = 0u;
    __syncthreads();
    XcdBarrier bar; bar.bar = (unsigned*)(a.ws + WS_CTL) + 1024; bar.x = 0; bar.st = nullptr;
    const int lo = a.ph_lo, hi = a.ph_hi;
    if (hi - lo > 1) bar = xcd_barrier_post((unsigned*)(a.ws + WS_CTL) + 1024, misc + 8);
#define IN(k) (lo <= (k) && (k) < hi)
#define SEAM(k) do { if (IN(k) && IN((k) + 1)) xcd_barrier(bar); } while (0)
    const int G = gridDim.x, bx = blockIdx.x;

    for (int rep = 0; rep < 1 + ((PROBE_DUP >> 0) & 1); ++rep)
    if (IN(0)) { ph0_mod(a, lds); __syncthreads(); ph0_weights(a, lds); ph0_keyfrags(a); ph0_extra(a); __syncthreads(); }
    SEAM(0);
    for (int rep = 0; rep < 1 + ((PROBE_DUP >> 1) & 1); ++rep)
    if (IN(1)) ph_norm<true>(a, a.in[0], a.in[4], 0, 2048, (bf16*)(a.ws + WS_H), a.ws + WS_H8);
    SEAM(1);
    for (int rep = 0; rep < 1 + ((PROBE_DUP >> 2) & 1); ++rep)
    if (IN(2)) { pg8::Gemm g{(const bf16*)(a.ws + WS_H8), (const bf16*)(a.ws + WS_WIN), T, NPROJ, D / 2}; pg8::StaticOrder So; So.init(T, NPROJ, G, bx);
        EpiProjNorm E{(bf16*)(a.ws + WS_Q), (bf16*)(a.ws + WS_KV), (bf16*)(a.ws + WS_DL), (bf16*)(a.ws + WS_MG), (bf16*)a.out, a.in[6], a.in[7], a.in[11], a.in[12], (LAS float*)(lds + 131072), 1.f / (F8_HS * F8_WS)};
        pg8::gemm_phase<EpiProjNorm, pg8::StaticOrder, pg8::NoMid, true>(lds, g, So, E); }
    SEAM(2);
    if (IN(3)) { for (int rep = 0; rep < 1 + ((PROBE_DUP >> 3) & 1); ++rep) { ph3_vfrag(a); ph3_gates(a); ph3_compress(a, lds); } }
    SEAM(3);
    for (int rep = 0; rep < 1 + ((PROBE_DUP >> 4) & 1); ++rep)
    if (IN(4)) ph4_attention(a, lds);
    SEAM(4);
    for (int rep = 0; rep < 1 + ((PROBE_DUP >> 5) & 1); ++rep)
    if (IN(5)) {
        { pg8::Gemm g{(const bf16*)(a.ws + WS_YN), (const bf16*)(a.ws + WS_WBN), T, D, 1536}; pg8::StaticOrder So; So.init(T, D, G, bx);
          EpiMerge E{(const bf16*)(a.ws + WS_MG), a.ws + WS_H, F8_MS}; MidMerge Mh{(const bf16*)(a.ws + WS_MG)};
          pg8::gemm_phase<EpiMerge, pg8::StaticOrder, MidMerge>(lds, g, So, E, Mh); }
    }
    SEAM(5);
    for (int rep = 0; rep < 1 + ((PROBE_DUP >> 6) & 1); ++rep)
    if (IN(6)) { pg8::Gemm g{(const bf16*)(a.ws + WS_H), (const bf16*)(a.ws + WS_WOUT), T, D, D / 2}; pg8::StaticOrder So; So.init(T, D, G, bx);
        EpiOut E{a.in[0], (const float*)(a.ws + WS_MOD), a.out, 1.f / (F8_MS * F8_WS)}; pg8::gemm_phase<EpiOut, pg8::StaticOrder, pg8::NoMid, true>(lds, g, So, E); }
    SEAM(6);
    for (int rep = 0; rep < 1 + ((PROBE_DUP >> 7) & 1); ++rep)
    if (IN(7)) { ph_norm(a, a.out, a.in[16], 6144, 8192, (bf16*)(a.ws + WS_H)); ph_quant_uv(a); }
    SEAM(7);
    for (int rep = 0; rep < 1 + ((PROBE_DUP >> 8) & 1); ++rep)
    if (IN(8)) { pg8::Gemm g{(const bf16*)(a.ws + WS_H), (const bf16*)(a.ws + WS_WPQ), T, D, D}; pg8::StaticOrder So; So.init(T, D, G, bx);
        EpiF32 E{(float*)(a.ws + WS_QP), D}; pg8::gemm_phase<EpiF32, pg8::StaticOrder>(lds, g, So, E); }
    SEAM(8);
    for (int rep = 0; rep < 1 + ((PROBE_DUP >> 9) & 1); ++rep)
    if (IN(9)) { ph_route(a, lds); __syncthreads(); }
    SEAM(9);
    if (IN(10)) { if ((PROBE_DUP >> 10) & 1) { ph_experts(a, *(const float*)(a.ws + WS_CTL + 64)); asm volatile("s_waitcnt vmcnt(0)" ::: "memory"); __syncthreads(); } ph_experts(a, 1.f); }
#undef IN
#undef SEAM
}

extern "C" void kernel_launch(void* const* d_in, const int* in_sizes, int n_in, void* d_out, int out_size, void* d_ws, size_t ws_size, hipStream_t stream) {
    static int grid = 0;
    if (grid == 0) {
        if (n_in != 23 || out_size != T * D || ws_size < WS_END4) { fprintf(stderr, "kernel_launch: unexpected problem shape (n_in %d, out %d, ws %zu); nothing launched\n", n_in, out_size, ws_size); grid = -1; return; }
        int dev = 0, cus = 0, per_cu = 0;
        if (hipGetDevice(&dev) != hipSuccess || hipDeviceGetAttribute(&cus, hipDeviceAttributeMultiprocessorCount, dev) != hipSuccess) { grid = -1; return; }
        if (hipFuncSetAttribute((const void*)fwd_kernel, hipFuncAttributeMaxDynamicSharedMemorySize, LDS_BYTES) != hipSuccess) { fprintf(stderr, "kernel_launch: hipFuncSetAttribute failed\n"); grid = -1; return; }
        if (hipOccupancyMaxActiveBlocksPerMultiprocessor(&per_cu, (const void*)fwd_kernel, NTHREADS, LDS_BYTES) != hipSuccess || per_cu < 1) { fprintf(stderr, "kernel_launch: occupancy query says %d\n", per_cu); }
        (void)hipGetLastError();
        grid = cus;
    }
    if (grid < 0) return;
    hipMemsetAsync((char*)d_ws + WS_CTL, 0, CTL_ZERO_BYTES, stream);
    Args a{};
    for (int i = 0; i < 23; ++i) a.in[i] = (const float*)d_in[i];
    a.out = (float*)d_out; a.ws = (unsigned char*)d_ws;
#if MK_ONE_LAUNCH
#if PROBE_PREFIX >= 0
    a.ph_lo = 0; a.ph_hi = PROBE_PREFIX + 1;
    hipLaunchKernelGGL(fwd_kernel, dim3(grid), dim3(NTHREADS), LDS_BYTES, stream, a);
    hipMemsetAsync((char*)d_ws + WS_CTL, 0, CTL_ZERO_BYTES, stream);
#endif
    a.ph_lo = 0; a.ph_hi = N_PHASES;
    hipLaunchKernelGGL(fwd_kernel, dim3(grid), dim3(NTHREADS), LDS_BYTES, stream, a);
#else
    for (int p = 0; p < N_PHASES; ++p) { a.ph_lo = p; a.ph_hi = p + 1; hipLaunchKernelGGL(fwd_kernel, dim3(grid), dim3(NTHREADS), LDS_BYTES, stream, a); }
#endif
}
```

```cpp
#include <hip/hip_runtime.h>
#include <cstdio>
#include <cstdint>

#ifndef PROBE_DUP
#define PROBE_DUP 0
#endif
#ifndef PROBE_PREFIX
#define PROBE_PREFIX -1
#endif
#ifndef MK_ONE_LAUNCH
#define MK_ONE_LAUNCH 1
#endif

__device__ __forceinline__ int phase_tid() { int t = threadIdx.x; asm volatile("" : "+v"(t)); return t; }
namespace pg8 {
#define PG8_LAS __attribute__((address_space(3)))
typedef unsigned short bf16_t;
typedef short bf16x8 __attribute__((ext_vector_type(8)));
typedef float f32x4 __attribute__((ext_vector_type(4)));
typedef unsigned u32x4 __attribute__((ext_vector_type(4)));
typedef unsigned u32x2 __attribute__((ext_vector_type(2)));
constexpr int BM = 256, BK = 64, HALF = 128, HTB = HALF * BK * 2, STAGE_BYTES = 8 * HTB, NXCD = 8, WGM = 8;

__host__ __device__ __forceinline__ int lds_byte(int r, int c) { const int st = (r >> 4) * 2 + (c >> 5), rr = r & 15, cc = c & 31, ob = rr * 64 + cc * 2; return st * 1024 + (ob ^ (((ob >> 9) & 1) << 5)); }
__host__ __device__ __forceinline__ void stage_rc(int b, int& R, int& C) { const int st = b / 1024, sb = b % 1024, swz = sb ^ (((sb >> 9) & 1) << 5); R = (st >> 1) * 16 + swz / 64; C = (st & 1) * 32 + (swz % 64) / 2; }
__host__ __device__ __forceinline__ int perm32(int rho) { const int n = rho >> 4, i = rho & 15; return 8 * (i >> 2) + 4 * n + (i & 3); }

struct Unit { int pm, pn; };
struct Gemm { const bf16_t* A; const bf16_t* Bt; int M, N, K; };

struct StaticOrder {
    int nM, nN, nwg, G, c;
    __host__ __device__ void init(int M, int N, int G_, int c_) { nM = M / BM; nN = N / BM; nwg = nM * nN; G = G_; c = c_; }
    __host__ __device__ bool next(int i, Unit& u) const {
        const long L = (long)i * G + c; if (L >= nwg) return false;
        int wgid = (int)L; { const int q = nwg / NXCD, r = nwg % NXCD, xcd = wgid % NXCD, off = wgid / NXCD; wgid = (xcd < r ? xcd * (q + 1) : r * (q + 1) + (xcd - r) * q) + off; }
        const int nig = WGM * nN, gid = wgid / nig, fm = gid * WGM, gsz = (nM - fm) < WGM ? (nM - fm) : WGM;
        u.pm = fm + ((wgid % nig) % gsz); u.pn = (wgid % nig) / gsz; return true;
    }
    __device__ __forceinline__ void a_ready(const Unit&) const {}
    __device__ __forceinline__ void done(const Unit&) const {}
};

__device__ __forceinline__ unsigned cvt_pk_bf16(float lo, float hi) { unsigned r; asm volatile("v_cvt_pk_bf16_f32 %0, %1, %2" : "=v"(r) : "v"(lo), "v"(hi)); return r; }

typedef int i32x4 __attribute__((ext_vector_type(4)));
typedef int i32x8 __attribute__((ext_vector_type(8)));
template <bool F8> __device__ __forceinline__ void mma_blk(f32x4 (&acc)[4][2], const bf16x8 (&At)[4][2], const bf16x8 (&Bt)[2][2]) {
    if constexpr (F8) {
#pragma unroll
        for (int m = 0; m < 4; ++m)
#pragma unroll
            for (int n = 0; n < 2; ++n) {
                const i32x8 bb = __builtin_shufflevector(__builtin_bit_cast(i32x4, Bt[n][0]), __builtin_bit_cast(i32x4, Bt[n][1]), 0, 1, 2, 3, 4, 5, 6, 7);
                const i32x8 aa = __builtin_shufflevector(__builtin_bit_cast(i32x4, At[m][0]), __builtin_bit_cast(i32x4, At[m][1]), 0, 1, 2, 3, 4, 5, 6, 7);
                asm volatile("v_mfma_f32_16x16x128_f8f6f4 %0, %1, %2, %0" : "+v"(acc[m][n]) : "v"(bb), "v"(aa)); }
    } else {
#pragma unroll
        for (int m = 0; m < 4; ++m)
#pragma unroll
            for (int n = 0; n < 2; ++n)
#pragma unroll
                for (int k = 0; k < 2; ++k) acc[m][n] = __builtin_amdgcn_mfma_f32_16x16x32_bf16(Bt[n][k], At[m][k], acc[m][n], 0, 0, 0);
    }
}
struct NoMid { static constexpr int AT = -1; __device__ __forceinline__ void operator()(f32x4 (&)[2][2][4][2], const Unit&, int, int, int, int) const {} };
template <class Epi, class Sched, class Mid = NoMid, bool F8 = false>
__device__ __forceinline__ void gemm_phase(PG8_LAS unsigned char* lds, const Gemm g, const Sched& S, const Epi& E, const Mid& Mh = Mid()) {
    const int tid = phase_tid(), wid = __builtin_amdgcn_readfirstlane(tid >> 6), lane = tid & 63, wr = wid >> 2, wc = wid & 3, fr = lane & 15, fq = lane >> 4;
    const int K = g.K, nt = K / BK;
    unsigned voffA[2], voffB[2];
#pragma unroll
    for (int i = 0; i < 2; ++i) { int R, C; stage_rc(tid * 16 + i * 8192, R, C); const int Rb = Epi::PERM ? ((R & ~31) + perm32(R & 31)) : R;
        voffA[i] = (unsigned)(R * K + C) * 2u; voffB[i] = (unsigned)(Rb * K + C) * 2u; }
    const size_t kstep = (size_t)(BK * 2);
    const size_t hstep = (size_t)HALF * K * 2;
    const size_t tstep = 2 * hstep;
    const unsigned ldsw = (unsigned)wid * 1024u;
    const int aoff = lds_byte(wr * 64 + fr, fq * 8), boff = lds_byte(wc * 32 + fr, fq * 8);
#define PG8_SA(b, h) (((b) * 2 + (h)) * HTB)
#define PG8_SB(b, h) ((4 + (b) * 2 + (h)) * HTB)
#define PG8_STAGE(bufoff, gbase, voff) do { _Pragma("unroll") for (int _i = 0; _i < 2; ++_i) \
        __builtin_amdgcn_global_load_lds((const unsigned*)((const char*)(gbase) + (voff)[_i]), (PG8_LAS unsigned*)(lds + (bufoff) + ldsw + _i * 8192), 16, 0, 0); } while (0)
#define PG8_LDA(dst, b, h) do { _Pragma("unroll") for (int m = 0; m < 4; ++m) _Pragma("unroll") for (int k = 0; k < 2; ++k) dst[m][k] = *(const PG8_LAS bf16x8*)(lds + PG8_SA(b, h) + aoff + m * 2048 + k * 1024); } while (0)
#define PG8_LDB(dst, b, h) do { _Pragma("unroll") for (int n = 0; n < 2; ++n) _Pragma("unroll") for (int k = 0; k < 2; ++k) dst[n][k] = *(const PG8_LAS bf16x8*)(lds + PG8_SB(b, h) + boff + n * 2048 + k * 1024); } while (0)
#define PG8_MMA(ai, bj, At, Bt) do { __builtin_amdgcn_s_setprio(1); if constexpr (F8) { mma_blk<true>(acc[ai][bj], At, Bt); } else { _Pragma("unroll") for (int m = 0; m < 4; ++m) _Pragma("unroll") for (int n = 0; n < 2; ++n) _Pragma("unroll") for (int k = 0; k < 2; ++k) \
        acc[ai][bj][m][n] = __builtin_amdgcn_mfma_f32_16x16x32_bf16(Bt[n][k], At[m][k], acc[ai][bj][m][n], 0, 0, 0); } __builtin_amdgcn_s_setprio(0); } while (0)
#define PG8_WAIT_V(n) asm volatile("s_waitcnt vmcnt(" #n ")" ::: "memory")
#define PG8_WAIT_L(n) asm volatile("s_waitcnt lgkmcnt(" #n ")" ::: "memory")
#define PG8_BAR __builtin_amdgcn_s_barrier()
#define PG8_SCHED __builtin_amdgcn_sched_barrier(0)
    Unit cur, nxt; int ui = 0;
    if (!S.next(0, cur)) return;
    f32x4 acc[2][2][4][2];
#pragma unroll
    for (int a = 0; a < 2; ++a)
#pragma unroll
        for (int b = 0; b < 2; ++b)
#pragma unroll
            for (int m = 0; m < 4; ++m)
#pragma unroll
                for (int n = 0; n < 2; ++n) acc[a][b][m][n] = (f32x4){0.f, 0.f, 0.f, 0.f};
    bf16x8 At[4][2], B0[2][2], B1[2][2];
    const char* cA = (const char*)g.A + (size_t)cur.pm * tstep; const char* cB = (const char*)g.Bt + (size_t)cur.pn * tstep;
    S.a_ready(cur);
    PG8_STAGE(PG8_SB(0, 0), cB, voffB); PG8_STAGE(PG8_SA(0, 0), cA, voffA); PG8_STAGE(PG8_SB(0, 1), cB + hstep, voffB); PG8_STAGE(PG8_SA(0, 1), cA + hstep, voffA);
    if (wr == 1) PG8_BAR;
    PG8_WAIT_V(4); PG8_BAR;
    PG8_STAGE(PG8_SB(1, 0), cB + kstep, voffB); PG8_STAGE(PG8_SA(1, 0), cA + kstep, voffA); PG8_STAGE(PG8_SB(1, 1), cB + hstep + kstep, voffB);
    PG8_WAIT_V(6); PG8_BAR;
    for (;;) {
        const bool has_next = S.next(ui + 1, nxt);
        const char* nA = has_next ? (const char*)g.A + (size_t)nxt.pm * tstep : cA; const char* nB = has_next ? (const char*)g.Bt + (size_t)nxt.pn * tstep : cB;
#define PG8_KBODY \
            const bool last = (t == nt - 2); \
            const char* a1 = cA + (size_t)(t + 1) * kstep; \
            const char* a2 = last ? nA : cA + (size_t)(t + 2) * kstep; const char* b2 = last ? nB : cB + (size_t)(t + 2) * kstep; \
            const char* a3 = a2 + kstep; const char* b3 = b2 + kstep; \
            if (last && has_next) S.a_ready(nxt); \
            PG8_LDB(B0, 0, 0); PG8_SCHED; PG8_LDA(At, 0, 0); PG8_STAGE(PG8_SA(1, 1), a1 + hstep, voffA); \
            PG8_WAIT_L(8); PG8_BAR; PG8_WAIT_L(0); PG8_MMA(0, 0, At, B0); PG8_BAR; PG8_SCHED; \
            PG8_LDB(B1, 0, 1); PG8_STAGE(PG8_SB(0, 0), b2, voffB); \
            PG8_BAR; PG8_WAIT_L(0); PG8_MMA(0, 1, At, B1); PG8_BAR; \
            PG8_LDA(At, 0, 1); PG8_STAGE(PG8_SA(0, 0), a2, voffA); \
            PG8_BAR; PG8_WAIT_L(0); PG8_MMA(1, 0, At, B0); PG8_BAR; PG8_SCHED; \
            PG8_STAGE(PG8_SB(0, 1), b2 + hstep, voffB); \
            PG8_WAIT_V(6); PG8_BAR; PG8_MMA(1, 1, At, B1); PG8_BAR; \
            PG8_LDB(B0, 1, 0); PG8_SCHED; PG8_LDA(At, 1, 0); PG8_STAGE(PG8_SA(0, 1), a2 + hstep, voffA); \
            PG8_WAIT_L(8); PG8_BAR; PG8_WAIT_L(0); PG8_MMA(0, 0, At, B0); PG8_BAR; PG8_SCHED; \
            PG8_LDB(B1, 1, 1); PG8_STAGE(PG8_SB(1, 0), b3, voffB); \
            PG8_BAR; PG8_WAIT_L(0); PG8_MMA(0, 1, At, B1); PG8_BAR; \
            PG8_LDA(At, 1, 1); PG8_STAGE(PG8_SA(1, 0), a3, voffA); \
            PG8_BAR; PG8_WAIT_L(0); PG8_MMA(1, 0, At, B0); PG8_BAR; PG8_SCHED; \
            PG8_STAGE(PG8_SB(1, 1), b3 + hstep, voffB); \
            PG8_WAIT_V(6); PG8_BAR; PG8_MMA(1, 1, At, B1); PG8_BAR;
        if constexpr (Mid::AT >= 0) {
            for (int t = 0; t < Mid::AT; t += 2) { PG8_KBODY }
            if constexpr (F8) asm volatile("s_nop 15\n\ts_nop 15" ::: "memory");
            Mh(acc, cur, wr, wc, fr, fq);
            for (int t = Mid::AT; t < nt; t += 2) { PG8_KBODY }
        } else {
            for (int t = 0; t < nt; t += 2) { PG8_KBODY }
        }
#undef PG8_KBODY
        if constexpr (F8) asm volatile("s_nop 15\n\ts_nop 15" ::: "memory");
        E(acc, cur, wr, wc, fr, fq); S.done(cur);
        if (!has_next) break;
#pragma unroll
        for (int a = 0; a < 2; ++a)
#pragma unroll
            for (int b = 0; b < 2; ++b)
#pragma unroll
                for (int m = 0; m < 4; ++m)
#pragma unroll
                    for (int n = 0; n < 2; ++n) acc[a][b][m][n] = (f32x4){0.f, 0.f, 0.f, 0.f};
        cur = nxt; cA = nA; cB = nB; ++ui;
    }
    PG8_WAIT_V(0);
    if (wr == 0) PG8_BAR;
    PG8_BAR;
#undef PG8_SA
#undef PG8_SB
#undef PG8_STAGE
#undef PG8_LDA
#undef PG8_LDB
#undef PG8_MMA
#undef PG8_WAIT_V
#undef PG8_WAIT_L
#undef PG8_BAR
#undef PG8_SCHED
}
}

#define GAS __attribute__((address_space(1)))
#define LAS __attribute__((address_space(3)))
typedef unsigned short bf16;
typedef float f32x4 __attribute__((ext_vector_type(4)));
typedef unsigned v4u __attribute__((ext_vector_type(4)));
typedef unsigned v2u __attribute__((ext_vector_type(2)));

constexpr int NB = 4, S = 4096, D = 2048, T = NB * S, HD = 128;
constexpr int IN_COLS = 11288, OFF_KV = 1024, OFF_GATE = 2560, OFF_DIL = 2584, OFF_MERGE = 7192;
constexpr int NPROJ = 11264;
constexpr int NQ = 1024, NKV = 1536, NDL = 4608, NMG = 4096;
constexpr int NC = 255, NS = 64;
constexpr int NE = 16384;
constexpr float EPS = 1e-6f;
constexpr float QSCALE = 0.08838834764831845f;
constexpr int NWAVES = 8, NTHREADS = 512;

constexpr size_t MiB = 1u << 20;
constexpr size_t WS_CTL = 0, CTL_ZERO_BYTES = 1 * MiB;
constexpr size_t WS_WIN = 1 * MiB;
constexpr size_t WS_WBN = 45 * MiB;
constexpr size_t WS_WBD = 49 * MiB;
constexpr size_t WS_WOUT = 51 * MiB;
constexpr size_t WS_WPQ = 59 * MiB;
constexpr size_t WS_WGATE = 67 * MiB;
constexpr size_t WS_MOD = 67 * MiB + 256 * 1024;
constexpr size_t WS_SEL = 67 * MiB + 512 * 1024;
constexpr size_t WS_GATES = 68 * MiB;
constexpr size_t WS_KC = 70 * MiB;
constexpr size_t WS_VC = 71 * MiB;
constexpr size_t WS_H = 72 * MiB;
constexpr size_t WS_Q = 136 * MiB;
constexpr size_t WS_KV = 168 * MiB;
constexpr size_t WS_DL = 216 * MiB;
constexpr size_t WS_MG = 360 * MiB;
constexpr size_t WS_YN = 488 * MiB;
constexpr size_t WS_YD = 520 * MiB;
constexpr size_t WS_H8 = WS_YN;
constexpr size_t WS_EI = 536 * MiB;
constexpr size_t WS_EG = 544 * MiB;
constexpr size_t WS_END = 552 * MiB;
constexpr size_t WS_PU = WS_Q;
constexpr size_t WS_PV = WS_Q + 64 * MiB;
constexpr size_t WS_QP = WS_MG;
static_assert(WS_PV + 64 * MiB <= WS_MG, "u/v overlay");

constexpr int LDS_BYTES = 147456;
constexpr int LDS_MISC = 144 * 1024 - 256;

#define XB_TMO      128
#define XB_XCNT(j)  (256  + 64 * (j))
#define XB_XSUB(j)  (1280 + 64 * (j))
#define XB_XGEN(j)  (2304 + 64 * (j))
#define XB_TOP      3328
#define XB_TOPGEN   3392
#define XCD_BAR_WORDS 3456
#define XB_SPIN_CAP (1u << 24)

__device__ __forceinline__ unsigned xb_ld(unsigned* p)              { return __hip_atomic_load(p, __ATOMIC_RELAXED, __HIP_MEMORY_SCOPE_AGENT); }
__device__ __forceinline__ unsigned xb_add(unsigned* p, unsigned v) { return __hip_atomic_fetch_add(p, v, __ATOMIC_RELAXED, __HIP_MEMORY_SCOPE_AGENT); }
__device__ __forceinline__ unsigned xb_xcc_id() { return (unsigned)__builtin_amdgcn_s_getreg((3 << 11) | 20) & 0xFu; }
#define XB_SPIN(cond, bar) do { unsigned _sp = 0; while (cond) { __builtin_amdgcn_s_sleep(1); \
    if ((++_sp & 255u) == 0u) { if (xb_ld(&(bar)[XB_TMO])) break; if (_sp > XB_SPIN_CAP) { atomicAdd(&(bar)[XB_TMO], 1u); break; } } } } while (0)

struct XcdBarrier { unsigned* bar; unsigned x; volatile LAS unsigned* st; };

__device__ __forceinline__ XcdBarrier xcd_barrier_post(unsigned* bar, volatile LAS unsigned* st) {
    XcdBarrier b; b.bar = bar; b.x = xb_xcc_id(); b.st = st;
    if (threadIdx.x == 0) (void)xb_add(&bar[XB_XCNT(b.x)], 1u);
    return b;
}
__device__ __forceinline__ void xcd_barrier_complete(unsigned* bar, unsigned x, unsigned& nloc, unsigned& nx) {
    const unsigned G = gridDim.x * gridDim.y * gridDim.z;
    unsigned sum, cnt, mine, sp = 0u;
    for (;;) {
        sum = 0u; cnt = 0u; mine = 0u;
#pragma unroll
        for (unsigned j = 0; j < 16; ++j) { const unsigned c = xb_ld(&bar[XB_XCNT(j)]); sum += c; cnt += (c > 0u) ? 1u : 0u; mine = (j == x) ? c : mine; }
        if (sum == G) break;
        __builtin_amdgcn_s_sleep(1);
        if ((++sp & 255u) == 0u) { if (xb_ld(&bar[XB_TMO])) break; if (sp > XB_SPIN_CAP) { atomicAdd(&bar[XB_TMO], 1u); break; } }
    }
    nloc = mine > 0u ? mine : 1u; nx = cnt > 0u ? cnt : 1u;
}
__device__ __forceinline__ void xcd_barrier(const XcdBarrier& b) {
    asm volatile("s_waitcnt vmcnt(0)" ::: "memory");
    __syncthreads();
    if (threadIdx.x == 0) {
        unsigned* bar = b.bar;
        __builtin_amdgcn_s_waitcnt(0);
        unsigned nloc = b.st[0], nx = b.st[1];
        if (nloc == 0u) { xcd_barrier_complete(bar, b.x, nloc, nx); b.st[0] = nloc; b.st[1] = nx; }
        const unsigned old = xb_add(&bar[XB_XSUB(b.x)], 1u);
        const unsigned gen = old / nloc;
        if (old + 1u == (gen + 1u) * nloc) {
            __builtin_amdgcn_fence(__ATOMIC_RELEASE, "agent");
            asm volatile("s_waitcnt vmcnt(0)" ::: "memory");
            const unsigned og = xb_add(&bar[XB_TOP], 1u);
            const unsigned tg = og / nx;
            if (og + 1u == (tg + 1u) * nx) xb_add(&bar[XB_TOPGEN], 1u);
            else XB_SPIN(xb_ld(&bar[XB_TOPGEN]) == tg, bar);
            __builtin_amdgcn_fence(__ATOMIC_ACQUIRE, "agent");
            xb_add(&bar[XB_XGEN(b.x)], 1u);
            asm volatile("s_waitcnt vmcnt(0)" ::: "memory");
        } else {
            XB_SPIN(xb_ld(&bar[XB_XGEN(b.x)]) == gen, bar);
            __builtin_amdgcn_fence(__ATOMIC_ACQUIRE, "agent");
            asm volatile("s_waitcnt vmcnt(0)" ::: "memory");
        }
    }
    __syncthreads();
}

__device__ __forceinline__ unsigned f2bf(float f) { unsigned u = __builtin_bit_cast(unsigned, f); return (u + 0x7fffu + ((u >> 16) & 1u)) >> 16; }
__device__ __forceinline__ unsigned pk2(float lo, float hi) { return f2bf(lo) | (f2bf(hi) << 16); }
__device__ __forceinline__ unsigned pk4_f8(float a, float b, float c, float d) {
    a = __builtin_amdgcn_fmed3f(a, -448.f, 448.f); b = __builtin_amdgcn_fmed3f(b, -448.f, 448.f); c = __builtin_amdgcn_fmed3f(c, -448.f, 448.f); d = __builtin_amdgcn_fmed3f(d, -448.f, 448.f);
    int w = 0; w = __builtin_amdgcn_cvt_pk_fp8_f32(a, b, w, false); w = __builtin_amdgcn_cvt_pk_fp8_f32(c, d, w, true); return (unsigned)w; }
constexpr float F8_HS = 8.f, F8_WS = 128.f, F8_MS = 64.f;
__device__ __forceinline__ float bflo(unsigned u) { return __builtin_bit_cast(float, u << 16); }
__device__ __forceinline__ float bfhi(unsigned u) { return __builtin_bit_cast(float, u & 0xffff0000u); }
__device__ __forceinline__ float bf2f(bf16 u) { return __builtin_bit_cast(float, (unsigned)u << 16); }
__device__ __forceinline__ float wave_sum(float v) {
#pragma unroll
    for (int o = 1; o < 64; o <<= 1) v += __shfl_xor(v, o);
    return v;
}
__device__ __forceinline__ float wave_max(float v) {
#pragma unroll
    for (int o = 1; o < 64; o <<= 1) v = fmaxf(v, __shfl_xor(v, o));
    return v;
}
__device__ __forceinline__ float sigmoidf(float x) { return __builtin_amdgcn_rcpf(1.f + __expf(-x)); }
__device__ __forceinline__ float gelu_tanh(float x) { const float u = 0.7978845608028654f * (x + 0.044715f * x * x * x); return 0.5f * x * (1.f + tanhf(u)); }
__device__ __forceinline__ int t5_bucket(int n) {
    if (n < 16) return n;
    int b = 16;
    b += (n >= 22); b += (n >= 30); b += (n >= 40); b += (n >= 54); b += (n >= 73); b += (n >= 99); b += (n >= 134); b += (n >= 182);
    b += (n >= 246); b += (n >= 332); b += (n >= 450); b += (n >= 609); b += (n >= 825); b += (n >= 1117); b += (n >= 1513);
    return b;
}

struct Args {
    const float* in[23];
    float* out; unsigned char* ws;
    int ph_lo, ph_hi;
};

typedef float f32x2v __attribute__((ext_vector_type(2)));
__device__ __forceinline__ void ph0_mod(const Args& a, LAS unsigned char* lds) {
    const int tid = phase_tid(), lane = tid & 63, wave = __builtin_amdgcn_readfirstlane(tid >> 6);
    LAS float* cs = (LAS float*)lds;
    LAS float* red = (LAS float*)(lds + 32768);
    const float* c = a.in[1]; const float* w_ada = a.in[2]; const float* b_ada = a.in[3];
    float* mod = (float*)(a.ws + WS_MOD);
    for (int i = tid; i < 4 * 2048; i += NTHREADS) { const float v = c[i]; cs[i] = v / (1.f + __expf(-v)); }
    __syncthreads();
    for (int u = blockIdx.x; u < 12288 / 128; u += gridDim.x) {
        const int col = u * 128 + 2 * lane;
        float acc[4][2];
#pragma unroll
        for (int b = 0; b < 4; ++b) { acc[b][0] = 0.f; acc[b][1] = 0.f; }
        const float* wp = w_ada + (size_t)(wave * 256) * 12288 + col;
#pragma unroll 1
        for (int k0 = 0; k0 < 256; k0 += 16) {
            f32x2v w[16];
#pragma unroll
            for (int k = 0; k < 16; ++k) w[k] = *(const f32x2v*)(wp + (size_t)(k0 + k) * 12288);
#pragma unroll
            for (int k = 0; k < 16; ++k) { const int kk = wave * 256 + k0 + k;
#pragma unroll
                for (int b = 0; b < 4; ++b) { const float cv = cs[b * 2048 + kk]; acc[b][0] += cv * w[k].x; acc[b][1] += cv * w[k].y; } }
        }
#pragma unroll
        for (int b = 0; b < 4; ++b) { red[(wave * 4 + b) * 128 + 2 * lane] = acc[b][0]; red[(wave * 4 + b) * 128 + 2 * lane + 1] = acc[b][1]; }
        __syncthreads();
        { const int b = tid >> 7, cc = tid & 127; float s = 0.f;
#pragma unroll
          for (int w = 0; w < 8; ++w) s += red[(w * 4 + b) * 128 + cc];
          mod[b * 12288 + u * 128 + cc] = s + b_ada[u * 128 + cc]; }
        __syncthreads();
    }
}
__device__ __forceinline__ void transpose_item(const float* W, int ldw, int ncols, int K, bf16* WT, int row_off, LAS float* scr, int item, int lane, int ldt = 0) {
    if (ldt == 0) ldt = K;
    const int nblk = ncols / 32, kb = item / nblk, nb = item % nblk, k0 = 64 * kb, n0 = 32 * nb;
    float tv[32];
#pragma unroll
    for (int i = 0; i < 32; ++i) tv[i] = W[(size_t)(k0 + 2 * i + (lane >> 5)) * ldw + n0 + (lane & 31)];
#pragma unroll
    for (int i = 0; i < 32; ++i) scr[(2 * i + (lane >> 5)) * 33 + (lane & 31)] = tv[i];
    asm volatile("s_waitcnt lgkmcnt(0)" ::: "memory");
    const int c = lane & 7;
#pragma unroll
    for (int j = 0; j < 4; ++j) { const int n = (lane >> 3) + 8 * j; const LAS float* s = scr + (8 * c) * 33 + n;
        v4u o; o.x = pk2(s[0 * 33], s[1 * 33]); o.y = pk2(s[2 * 33], s[3 * 33]); o.z = pk2(s[4 * 33], s[5 * 33]); o.w = pk2(s[6 * 33], s[7 * 33]);
        *(v4u*)(WT + (size_t)(row_off + n0 + n) * ldt + k0 + 8 * c) = o; }
    asm volatile("s_waitcnt lgkmcnt(0)" ::: "memory");
}
__device__ __forceinline__ void transpose_item_f8(const float* W, int ldw, int ncols, int K, unsigned char* WT, int row_off, LAS float* scr, int item, int lane) {
    const int nblk = ncols / 32, kb = item / nblk, nb = item % nblk, k0 = 64 * kb, n0 = 32 * nb;
    float tv[32];
#pragma unroll
    for (int i = 0; i < 32; ++i) tv[i] = W[(size_t)(k0 + 2 * i + (lane >> 5)) * ldw + n0 + (lane & 31)];
#pragma unroll
    for (int i = 0; i < 32; ++i) scr[(2 * i + (lane >> 5)) * 33 + (lane & 31)] = tv[i] * F8_WS;
    asm volatile("s_waitcnt lgkmcnt(0)" ::: "memory");
    const int c = lane & 7;
#pragma unroll
    for (int j = 0; j < 4; ++j) { const int n = (lane >> 3) + 8 * j; const LAS float* s = scr + (8 * c) * 33 + n;
        v2u o; o.x = pk4_f8(s[0 * 33], s[1 * 33], s[2 * 33], s[3 * 33]); o.y = pk4_f8(s[4 * 33], s[5 * 33], s[6 * 33], s[7 * 33]);
        *(v2u*)(WT + (size_t)(row_off + n0 + n) * K + k0 + 8 * c) = o; }
    asm volatile("s_waitcnt lgkmcnt(0)" ::: "memory");
}
__device__ __forceinline__ void ph0_weights(const Args& a, LAS unsigned char* lds) {
    const int tid = phase_tid(), lane = tid & 63, wave = __builtin_amdgcn_readfirstlane(tid >> 6);
    LAS float* scr = (LAS float*)(lds + wave * 16384);
    const int gw = blockIdx.x * NWAVES + wave, NGW = gridDim.x * NWAVES;
    const float* w_in = a.in[5];
    unsigned char* WIN = a.ws + WS_WIN;
    constexpr int I_Q = 32 * (NQ / 32), I_KV = 32 * (NKV / 32), I_DL = 32 * (NDL / 32), I_MG = 32 * (NMG / 32);
    constexpr int I_BN = 16 * 64, I_BD = 8 * 64, I_O = 32 * 64, I_PQ = 32 * 64;
    constexpr int NITEMS = I_Q + I_KV + I_DL + I_MG + I_BN + I_BD + I_O + I_PQ;
    for (int it = gw; it < NITEMS; it += NGW) {
        int r = it;
        if (r < I_Q)  { transpose_item_f8(w_in, IN_COLS, NQ, D, WIN, 0, scr, r, lane); continue; } r -= I_Q;
        if (r < I_KV) { transpose_item_f8(w_in + OFF_KV, IN_COLS, NKV, D, WIN, NQ, scr, r, lane); continue; } r -= I_KV;
        if (r < I_DL) { transpose_item_f8(w_in + OFF_DIL, IN_COLS, NDL, D, WIN, NQ + NKV, scr, r, lane); continue; } r -= I_DL;
        if (r < I_MG) { transpose_item_f8(w_in + OFF_MERGE, IN_COLS, NMG, D, WIN, NQ + NKV + NDL, scr, r, lane); continue; } r -= I_MG;
        if (r < I_BN) { transpose_item(a.in[13], D, D, 1024, (bf16*)(a.ws + WS_WBN), 0, scr, r, lane, 1536); continue; } r -= I_BN;
        if (r < I_BD) { transpose_item(a.in[14], D, D, 512, (bf16*)(a.ws + WS_WBN) + 1024, 0, scr, r, lane, 1536); continue; } r -= I_BD;
        if (r < I_O)  { transpose_item_f8(a.in[15], D, D, D, a.ws + WS_WOUT, 0, scr, r, lane); continue; } r -= I_O;
        transpose_item(a.in[17], D, D, D, (bf16*)(a.ws + WS_WPQ), 0, scr, r, lane);
    }
}

constexpr size_t WS_CW1F = 602 * MiB;
constexpr size_t WS_WGF = 604 * MiB;
constexpr size_t WS_CBP = 604 * MiB + 256 * 1024;
constexpr size_t WS_END4 = 605 * MiB;
__device__ __forceinline__ void ph0_extra(const Args& a) {
    const int tid = phase_tid(), lane = tid & 63, wave = __builtin_amdgcn_readfirstlane(tid >> 6);
    const float* w1 = a.in[9]; const float* pos = a.in[8]; const float* w_in = a.in[5];
    v4u* CW = (v4u*)(a.ws + WS_CW1F); v4u* WG = (v4u*)(a.ws + WS_WGF); float* CBP = (float*)(a.ws + WS_CBP);
    for (int i = blockIdx.x * NTHREADS + tid; i < 2 * 4 * 256 * 64; i += gridDim.x * NTHREADS) {
        const int ln = i & 63, ks = (i >> 6) & 255, nt = (i >> 14) & 3, j = i >> 16;
        const float* src = w1 + ((size_t)j * 4096 + 16 * ks + 8 * (ln >> 5)) * 128 + 32 * nt + (ln & 31);
        v4u o; o.x = pk2(src[0], src[128]); o.y = pk2(src[256], src[384]); o.z = pk2(src[512], src[640]); o.w = pk2(src[768], src[896]);
        CW[i] = o;
    }
    for (int i = blockIdx.x * NTHREADS + tid; i < 128 * 64; i += gridDim.x * NTHREADS) {
        const int ln = i & 63, ks = i >> 6, jrow = ln & 31;
        v4u o = {0u, 0u, 0u, 0u};
        if (jrow < 24) { const float* src = w_in + (size_t)(16 * ks + 8 * (ln >> 5)) * IN_COLS + OFF_GATE + jrow;
            o.x = pk2(src[0], src[IN_COLS]); o.y = pk2(src[2 * (size_t)IN_COLS], src[3 * (size_t)IN_COLS]); o.z = pk2(src[4 * (size_t)IN_COLS], src[5 * (size_t)IN_COLS]); o.w = pk2(src[6 * (size_t)IN_COLS], src[7 * (size_t)IN_COLS]); }
        WG[i] = o;
    }
    { const int gw = blockIdx.x * NWAVES + wave;
      if (gw < 128) { const int kc = gw >> 1, j = gw & 1; float s0 = 0.f, s1 = 0.f; const float* wp = w1 + ((size_t)j * 4096 + 64 * kc) * 128 + lane; const float* pp = pos + j * 4096 + 64 * kc;
#pragma unroll 1
          for (int k0 = 0; k0 < 64; k0 += 16) { float wa[16], wb[16];
#pragma unroll
              for (int k = 0; k < 16; ++k) { wa[k] = wp[(k0 + k) * 128]; wb[k] = wp[(k0 + k) * 128 + 64]; }
#pragma unroll
              for (int k = 0; k < 16; ++k) { const float pv = pp[k0 + k]; s0 += pv * wa[k]; s1 += pv * wb[k]; } }
          CBP[(kc * 2 + j) * 128 + lane] = s0; CBP[(kc * 2 + j) * 128 + 64 + lane] = s1; } }
}

template <bool F8 = false>
__device__ __forceinline__ void ph_norm(const Args& a, const float* xin, const float* gvec, int sh_off, int sc_off, bf16* hout, unsigned char* h8 = nullptr) {
    const int tid = phase_tid(), lane = tid & 63, wave = __builtin_amdgcn_readfirstlane(tid >> 6);
    const int gw = blockIdx.x * NWAVES + wave, NGW = gridDim.x * NWAVES;
    const float* mod = (const float*)(a.ws + WS_MOD);
    for (int r = gw; r < S / 2; r += NGW)
#pragma unroll 1
        for (int bq = 0; bq < NB; ++bq) {
            const int m0 = bq * S + r, m1 = m0 + S / 2;
            const float* x0 = xin + (size_t)m0 * D + 8 * lane; const float* x1 = xin + (size_t)m1 * D + 8 * lane;
            f32x4 v0[8], v1[8];
#pragma unroll
            for (int c = 0; c < 4; ++c) { v0[2 * c] = *(const f32x4*)(x0 + 512 * c); v0[2 * c + 1] = *(const f32x4*)(x0 + 512 * c + 4); v1[2 * c] = *(const f32x4*)(x1 + 512 * c); v1[2 * c + 1] = *(const f32x4*)(x1 + 512 * c + 4); }
            float s0 = 0.f, s1 = 0.f;
#pragma unroll
            for (int i = 0; i < 8; ++i) { s0 += (v0[i].x * v0[i].x + v0[i].y * v0[i].y) + (v0[i].z * v0[i].z + v0[i].w * v0[i].w); s1 += (v1[i].x * v1[i].x + v1[i].y * v1[i].y) + (v1[i].z * v1[i].z + v1[i].w * v1[i].w); }
            const float r0 = rsqrtf(wave_sum(s0) * (1.f / D) + EPS), r1 = rsqrtf(wave_sum(s1) * (1.f / D) + EPS);
            const float* shp = mod + bq * 12288 + sh_off + 8 * lane; const float* scp = mod + bq * 12288 + sc_off + 8 * lane; const float* gp = gvec + 8 * lane;
#pragma unroll
            for (int c = 0; c < 4; ++c) {
                v4u o0, o1; unsigned w0[4], w1[4]; [[maybe_unused]] unsigned q0[2], q1[2];
#pragma unroll
                for (int hq = 0; hq < 2; ++hq) { const f32x4 g = *(const f32x4*)(gp + 512 * c + 4 * hq), sc = *(const f32x4*)(scp + 512 * c + 4 * hq), sh = *(const f32x4*)(shp + 512 * c + 4 * hq);
                    const f32x4 ga = g * (1.f + sc); const f32x4 y0 = v0[2 * c + hq] * r0 * ga + sh, y1 = v1[2 * c + hq] * r1 * ga + sh;
                    w0[2 * hq] = pk2(y0.x, y0.y); w0[2 * hq + 1] = pk2(y0.z, y0.w); w1[2 * hq] = pk2(y1.x, y1.y); w1[2 * hq + 1] = pk2(y1.z, y1.w);
                    if constexpr (F8) { q0[hq] = pk4_f8(y0.x * F8_HS, y0.y * F8_HS, y0.z * F8_HS, y0.w * F8_HS); q1[hq] = pk4_f8(y1.x * F8_HS, y1.y * F8_HS, y1.z * F8_HS, y1.w * F8_HS); } }
                o0.x = w0[0]; o0.y = w0[1]; o0.z = w0[2]; o0.w = w0[3]; o1.x = w1[0]; o1.y = w1[1]; o1.z = w1[2]; o1.w = w1[3];
                *(v4u*)(hout + (size_t)m0 * D + 512 * c + 8 * lane) = o0; *(v4u*)(hout + (size_t)m1 * D + 512 * c + 8 * lane) = o1;
                if constexpr (F8) { v2u p0, p1; p0.x = q0[0]; p0.y = q0[1]; p1.x = q1[0]; p1.y = q1[1];
                    *(v2u*)(h8 + (size_t)m0 * D + 512 * c + 8 * lane) = p0; *(v2u*)(h8 + (size_t)m1 * D + 512 * c + 8 * lane) = p1; }
            }
        }
}

using pg8::Unit; using pg8::HALF; using pg8::BM;
struct EpiProj {
    static constexpr bool PERM = true;
    bf16 *q, *kv, *dl, *mg;
    __device__ __forceinline__ void operator()(const f32x4 (&acc)[2][2][4][2], const Unit& u, int wr, int wc, int fr, int fq) const {
        bf16* base; int ldc, colt = u.pn * BM;
        if (colt < NQ) { base = q; ldc = NQ; } else if (colt < NQ + NKV) { base = kv; ldc = NKV; colt -= NQ; } else if (colt < NQ + NKV + NDL) { base = dl; ldc = NDL; colt -= NQ + NKV; } else { base = mg; ldc = NMG; colt -= NQ + NKV + NDL; }
        const int row0 = u.pm * BM + wr * 64 + fr, col0 = colt + wc * 32 + 8 * fq;
#pragma unroll
        for (int ai = 0; ai < 2; ++ai)
#pragma unroll
            for (int m = 0; m < 4; ++m) { bf16* rowp = base + (size_t)(row0 + ai * HALF + m * 16) * ldc + col0;
#pragma unroll
                for (int bj = 0; bj < 2; ++bj) { const f32x4 v0 = acc[ai][bj][m][0], v1 = acc[ai][bj][m][1];
                    v4u w; w.x = pg8::cvt_pk_bf16(v0[0], v0[1]); w.y = pg8::cvt_pk_bf16(v0[2], v0[3]); w.z = pg8::cvt_pk_bf16(v1[0], v1[1]); w.w = pg8::cvt_pk_bf16(v1[2], v1[3]);
                    *(v4u*)(rowp + bj * HALF) = w; } }
    }
};
struct MidMerge {
    static constexpr int AT = 16;
    const bf16* mg;
    __device__ __forceinline__ void operator()(f32x4 (&acc)[2][2][4][2], const Unit& u, int wr, int wc, int fr, int fq) const {
        int lo = (fq * 16 + fr) * 8;
        asm volatile("" : "+v"(lo));
        const bf16* t1 = mg + (((size_t)(u.pm * 16 + u.pn) * 8 + (wr * 4 + wc)) << 13) + lo; const bf16* t2 = t1 + ((size_t)8 << 16);
#pragma unroll
        for (int ai = 0; ai < 2; ++ai) {
            v4u a1[4][2], a2[4][2];
#pragma unroll
            for (int m = 0; m < 4; ++m)
#pragma unroll
                for (int bj = 0; bj < 2; ++bj) { a1[m][bj] = *(const v4u*)(t1 + ((ai * 4 + m) * 2 + bj) * 512); a2[m][bj] = *(const v4u*)(t2 + ((ai * 4 + m) * 2 + bj) * 512); }
#pragma unroll
            for (int m = 0; m < 4; ++m)
#pragma unroll
                for (int bj = 0; bj < 2; ++bj) { const unsigned w1[4] = {a1[m][bj].x, a1[m][bj].y, a1[m][bj].z, a1[m][bj].w}, w2[4] = {a2[m][bj].x, a2[m][bj].y, a2[m][bj].z, a2[m][bj].w};
#pragma unroll
                    for (int q = 0; q < 4; ++q) { const float r0 = (1.f + __expf(-bflo(w2[q]))) * __builtin_amdgcn_rcpf(1.f + __expf(-bflo(w1[q]))), r1 = (1.f + __expf(-bfhi(w2[q]))) * __builtin_amdgcn_rcpf(1.f + __expf(-bfhi(w1[q])));
                        acc[ai][bj][m][q >> 1][2 * (q & 1)] *= r0; acc[ai][bj][m][q >> 1][2 * (q & 1) + 1] *= r1; } }
            asm volatile("" ::: "memory");
        }
    }
};
struct EpiMerge {
    static constexpr bool PERM = true;
    const bf16* mg; unsigned char* merged8; float os;
    __device__ __forceinline__ void operator()(const f32x4 (&acc)[2][2][4][2], const Unit& u, int wr, int wc, int fr, int fq) const {
        int row0 = u.pm * BM + wr * 64 + fr; const int col0 = u.pn * BM + wc * 32 + 8 * fq;
        asm volatile("" : "+v"(row0));
        const bf16* t2 = mg + (((size_t)(u.pm * 16 + 8 + u.pn) * 8 + (wr * 4 + wc)) << 13) + (fq * 16 + fr) * 8;
        v4u a2[2][4][2];
#pragma unroll
        for (int ai = 0; ai < 2; ++ai)
#pragma unroll
            for (int m = 0; m < 4; ++m)
#pragma unroll
                for (int bj = 0; bj < 2; ++bj) a2[ai][m][bj] = *(const v4u*)(t2 + ((ai * 4 + m) * 2 + bj) * 512);
#pragma unroll
        for (int ai = 0; ai < 2; ++ai)
#pragma unroll
            for (int m = 0; m < 4; ++m) { const size_t row = (size_t)(row0 + ai * HALF + m * 16);
#pragma unroll
                for (int bj = 0; bj < 2; ++bj) { const unsigned w2[4] = {a2[ai][m][bj].x, a2[ai][m][bj].y, a2[ai][m][bj].z, a2[ai][m][bj].w};
                    const f32x4 v0 = acc[ai][bj][m][0] * os, v1 = acc[ai][bj][m][1] * os;
                    v2u w; w.x = pk4_f8(v0[0] * sigmoidf(bflo(w2[0])), v0[1] * sigmoidf(bfhi(w2[0])), v0[2] * sigmoidf(bflo(w2[1])), v0[3] * sigmoidf(bfhi(w2[1])));
                    w.y = pk4_f8(v1[0] * sigmoidf(bflo(w2[2])), v1[1] * sigmoidf(bfhi(w2[2])), v1[2] * sigmoidf(bflo(w2[3])), v1[3] * sigmoidf(bfhi(w2[3])));
                    *(v2u*)(merged8 + row * D + col0 + bj * HALF) = w; } }
    }
};
struct EpiOut {
    static constexpr bool PERM = false;
    const float* x; const float* mod; float* x1; float as;
    __device__ __forceinline__ void operator()(const f32x4 (&acc)[2][2][4][2], const Unit& u, int wr, int wc, int fr, int fq) const {
        const int row0 = u.pm * BM + wr * 64 + fr, col0 = u.pn * BM + wc * 32 + 4 * fq;
        const int b = (u.pm * BM) / S;
        f32x4 gv[2][2];
#pragma unroll
        for (int bj = 0; bj < 2; ++bj)
#pragma unroll
            for (int n = 0; n < 2; ++n) gv[bj][n] = *(const f32x4*)(mod + b * 12288 + 4096 + col0 + bj * HALF + n * 16) * as;
#pragma unroll
        for (int ai = 0; ai < 2; ++ai)
#pragma unroll
            for (int m = 0; m < 4; ++m) { const size_t off = (size_t)(row0 + ai * HALF + m * 16) * D + col0;
#pragma unroll
                for (int bj = 0; bj < 2; ++bj)
#pragma unroll
                    for (int n = 0; n < 2; ++n) *(f32x4*)(x1 + off + bj * HALF + n * 16) = *(const f32x4*)(x + off + bj * HALF + n * 16) + gv[bj][n] * acc[ai][bj][m][n]; }
    }
};
struct EpiF32 {
    static constexpr bool PERM = false;
    float* C; int ldc;
    __device__ __forceinline__ void operator()(const f32x4 (&acc)[2][2][4][2], const Unit& u, int wr, int wc, int fr, int fq) const {
        const int row0 = u.pm * BM + wr * 64 + fr, col0 = u.pn * BM + wc * 32 + 4 * fq;
#pragma unroll
        for (int ai = 0; ai < 2; ++ai)
#pragma unroll
            for (int m = 0; m < 4; ++m) { float* rowp = C + (size_t)(row0 + ai * HALF + m * 16) * ldc + col0;
#pragma unroll
                for (int bj = 0; bj < 2; ++bj)
#pragma unroll
                    for (int n = 0; n < 2; ++n) *(f32x4*)(rowp + bj * HALF + n * 16) = acc[ai][bj][m][n]; }
    }
};

typedef short bf16x8 __attribute__((ext_vector_type(8)));
typedef float f32x16 __attribute__((ext_vector_type(16)));
typedef float f32x2 __attribute__((ext_vector_type(2)));
typedef __bf16 bf2v __attribute__((ext_vector_type(2)));
constexpr float LOG2E = 1.4426950408889634f;
constexpr float QS2 = QSCALE * LOG2E;
constexpr float NEGB = -1e30f;
__device__ __forceinline__ unsigned pkbf(float a, float b) { const f32x2 v = {a, b}; const bf2v r = __builtin_convertvector(v, bf2v); return __builtin_bit_cast(unsigned, r); }
__device__ __forceinline__ float ex2(float x) { return __builtin_amdgcn_exp2f(x); }
__device__ __forceinline__ int swap23(int x) { return (x & ~12) | ((x & 4) << 1) | ((x & 8) >> 1); }
__device__ __forceinline__ size_t kf_off(int key, int d) { return ((size_t)((key >> 5) * 8 + (d >> 4)) * 64 + ((d >> 3) & 1) * 32 + swap23(key & 31)) * 8 + (d & 7); }
__device__ __forceinline__ size_t vf_off(int key, int d) { const int kk = key & 31; return ((size_t)(((key >> 5) * 4 + (d >> 5)) * 2 + (kk >> 4)) * 64 + ((kk >> 3) & 1) * 32 + (d & 31)) * 8 + (kk & 7); }
__device__ __forceinline__ size_t kf8_off(int key, int d) { return ((size_t)((key >> 5) * 4 + (d >> 5)) * 64 + ((d >> 3) & 1) * 32 + swap23(key & 31)) * 16 + ((d >> 4) & 1) * 8 + (d & 7); }
__device__ __forceinline__ size_t vf8_off(int key, int d) { const int kk = key & 31; return ((size_t)((key >> 5) * 4 + (d >> 5)) * 64 + ((kk >> 3) & 1) * 32 + (d & 31)) * 16 + (kk >> 4) * 8 + (kk & 7); }
__device__ __forceinline__ unsigned char* fr8_nsa(const Args& a, int bg, int kind) { return (unsigned char*)a.out + ((size_t)(bg * 4 + kind) << 19); }
__device__ __forceinline__ unsigned char* fr8_dil(const Args& a, int b, int head, int kv) { return (unsigned char*)a.out + ((size_t)16 << 20) + ((size_t)((b * 12 + head) * 2 + kv) << 19); }
__device__ __forceinline__ bf16* fr_nsa(const Args& a, int bg, int kind) { return (bf16*)a.out + ((size_t)(bg * 4 + kind) << 19); }
__device__ __forceinline__ bf16* fr_dil(const Args& a, int b, int head, int kv) { return (bf16*)a.out + ((size_t)16 << 20) + ((size_t)((b * 12 + head) * 2 + kv) << 19); }
constexpr size_t WS_OD = 552 * MiB;
constexpr size_t WS_LSE = 600 * MiB;
constexpr size_t WS_END2 = 601 * MiB;

struct EpiProjNorm {
    static constexpr bool PERM = true;
    bf16 *q, *kv, *dl, *mg, *frg;
    const float *qg, *kg, *dqg, *dkg;
    LAS float* xch;
    float as;
    __device__ __forceinline__ void operator()(const f32x4 (&acc)[2][2][4][2], const Unit& u, int wr, int wc, int fr, int fq) const {
        bf16* base; int ldc, colt = u.pn * BM, mode = 0  , hsel = 0; const float* gain = qg; float scale = 1.f;
        if (colt < NQ) { base = q; ldc = NQ; mode = 1; gain = qg; scale = QS2; }
        else if (colt < NQ + NKV) { base = kv; ldc = NKV; colt -= NQ; hsel = colt >> 7; if (hsel == 4 || hsel == 8) { mode = 2; gain = kg + (hsel == 4 ? 128 : 256); } }
        else if (colt < NQ + NKV + NDL) { base = dl; ldc = NDL; colt -= NQ + NKV; hsel = colt >> 7; if (hsel < 12) { mode = 1; gain = dqg; scale = QS2; } else if (hsel < 24) { mode = 3; gain = dkg; } }
        else { base = mg; ldc = NMG; colt -= NQ + NKV + NDL; }
        const int row0 = u.pm * BM + wr * 64 + fr, col0 = colt + wc * 32 + 8 * fq;
        if (base == mg) {
            bf16* tp = mg + (((size_t)(u.pm * 16 + (colt >> 8)) * 8 + (wr * 4 + wc)) << 13) + (fq * 16 + fr) * 8;
#pragma unroll
            for (int ai = 0; ai < 2; ++ai)
#pragma unroll
                for (int m = 0; m < 4; ++m)
#pragma unroll
                    for (int bj = 0; bj < 2; ++bj) { const f32x4 v0 = acc[ai][bj][m][0] * as, v1 = acc[ai][bj][m][1] * as;
                        v4u w; w.x = pg8::cvt_pk_bf16(v0[0], v0[1]); w.y = pg8::cvt_pk_bf16(v0[2], v0[3]); w.z = pg8::cvt_pk_bf16(v1[0], v1[1]); w.w = pg8::cvt_pk_bf16(v1[2], v1[3]);
                        *(v4u*)(tp + ((ai * 4 + m) * 2 + bj) * 512) = w; }
            return;
        }
        if (mode == 0) {
#pragma unroll
            for (int ai = 0; ai < 2; ++ai)
#pragma unroll
                for (int m = 0; m < 4; ++m) { bf16* rowp = base + (size_t)(row0 + ai * HALF + m * 16) * ldc + col0;
#pragma unroll
                    for (int bj = 0; bj < 2; ++bj) { const f32x4 v0 = acc[ai][bj][m][0] * as, v1 = acc[ai][bj][m][1] * as;
                        v4u w; w.x = pg8::cvt_pk_bf16(v0[0], v0[1]); w.y = pg8::cvt_pk_bf16(v0[2], v0[3]); w.z = pg8::cvt_pk_bf16(v1[0], v1[1]); w.w = pg8::cvt_pk_bf16(v1[2], v1[3]);
                        *(v4u*)(rowp + bj * HALF) = w; } }
            return;
        }
#pragma unroll
        for (int ai = 0; ai < 2; ++ai)
#pragma unroll
            for (int m = 0; m < 4; ++m)
#pragma unroll
                for (int bj = 0; bj < 2; ++bj) { const f32x4 v0 = acc[ai][bj][m][0], v1 = acc[ai][bj][m][1];
                    float ss = (v0[0] * v0[0] + v0[1] * v0[1]) + (v0[2] * v0[2] + v0[3] * v0[3]) + (v1[0] * v1[0] + v1[1] * v1[1]) + (v1[2] * v1[2] + v1[3] * v1[3]);
                    ss += __shfl_xor(ss, 16); ss += __shfl_xor(ss, 32);
                    if (fq == 0) xch[(((((wr * 2 + ai) * 4 + m) * 16 + fr) * 2 + bj) << 2) + wc] = ss; }
        asm volatile("s_waitcnt lgkmcnt(0)" ::: "memory");
        __builtin_amdgcn_s_barrier();
        asm volatile("" ::: "memory");
        const f32x4 ga = *(const f32x4*)(gain + wc * 32 + 8 * fq), gb = *(const f32x4*)(gain + wc * 32 + 8 * fq + 4);
#pragma unroll
        for (int ai = 0; ai < 2; ++ai)
#pragma unroll
            for (int m = 0; m < 4; ++m) { const int t = row0 + ai * HALF + m * 16, b = t / S, s = t % S;
#pragma unroll
                for (int bj = 0; bj < 2; ++bj) { const f32x4 pp = *(const LAS f32x4*)(xch + (((((wr * 2 + ai) * 4 + m) * 16 + fr) * 2 + bj) << 2));
                    const float rstd = rsqrtf(((pp.x + pp.y) + (pp.z + pp.w)) * (as * as * (1.f / 128.f)) + EPS) * (scale * as);
                    const f32x4 v0 = acc[ai][bj][m][0] * rstd * ga, v1 = acc[ai][bj][m][1] * rstd * gb;
                    if (mode == 1) { v4u w; w.x = pg8::cvt_pk_bf16(v0[0], v0[1]); w.y = pg8::cvt_pk_bf16(v0[2], v0[3]); w.z = pg8::cvt_pk_bf16(v1[0], v1[1]); w.w = pg8::cvt_pk_bf16(v1[2], v1[3]);
                        *(v4u*)(base + (size_t)t * ldc + col0 + bj * HALF) = w; }
                    else { v2u w; w.x = pk4_f8(v0[0], v0[1], v0[2], v0[3]); w.y = pk4_f8(v1[0], v1[1], v1[2], v1[3]);
                        unsigned char* dst;
                        if (mode == 2) dst = (unsigned char*)frg + ((size_t)((b * 2 + bj) * 4 + (hsel == 4 ? 0 : 2)) << 19) + kf8_off(s, wc * 32 + 8 * fq);
                        else { const int head = hsel - 12 + bj, dsh = 2 * (head >> 2), vk = ((s & ((1 << dsh) - 1)) << (12 - dsh)) + (s >> dsh);
                            dst = (unsigned char*)frg + ((size_t)16 << 20) + ((size_t)((b * 12 + head) * 2) << 19) + kf8_off(vk, wc * 32 + 8 * fq); }
                        *(v2u*)dst = w; } } }
    }
};

__device__ __forceinline__ v4u norm_chunk16v(v4u w, const float* gain, float scale, int li) {
    float v[8] = {bflo(w.x), bfhi(w.x), bflo(w.y), bfhi(w.y), bflo(w.z), bfhi(w.z), bflo(w.w), bfhi(w.w)};
    float ss = 0.f;
#pragma unroll
    for (int j = 0; j < 8; ++j) ss += v[j] * v[j];
    ss += __shfl_xor(ss, 1); ss += __shfl_xor(ss, 2); ss += __shfl_xor(ss, 4); ss += __shfl_xor(ss, 8);
    const float rstd = rsqrtf(ss * (1.f / 128.f) + EPS) * scale;
#pragma unroll
    for (int j = 0; j < 8; ++j) v[j] = v[j] * rstd * gain[8 * li + j];
    w.x = pk2(v[0], v[1]); w.y = pk2(v[2], v[3]); w.z = pk2(v[4], v[5]); w.w = pk2(v[6], v[7]);
    return w;
}
__device__ __forceinline__ void ph3_headnorm(const Args& a) {
    const int tid = phase_tid(), lane = tid & 63, wave = __builtin_amdgcn_readfirstlane(tid >> 6), sub = lane >> 4, li = lane & 15;
    const int gw = blockIdx.x * NWAVES + wave, NGW = gridDim.x * NWAVES;
    bf16* Q = (bf16*)(a.ws + WS_Q); const bf16* KV = (const bf16*)(a.ws + WS_KV); bf16* DL = (bf16*)(a.ws + WS_DL);
    const float* qg = a.in[6]; const float* kg = a.in[7]; const float* dqg = a.in[11]; const float* dkg = a.in[12];
    for (int m = gw; m < T; m += NGW) {
        const int b = m / S, s = m % S;
        const int g = sub & 1, win = sub >> 1;
        v4u wq[2], wk, wd[6];
#pragma unroll
        for (int it = 0; it < 2; ++it) wq[it] = *(const v4u*)(Q + (size_t)m * NQ + (it * 4 + sub) * 128 + 8 * li);
        wk = *(const v4u*)(KV + (size_t)m * NKV + ((win ? 8 : 4) + g) * 128 + 8 * li);
#pragma unroll
        for (int it = 0; it < 6; ++it) wd[it] = *(const v4u*)(DL + (size_t)m * NDL + (it * 4 + sub) * 128 + 8 * li);
#pragma unroll
        for (int it = 0; it < 2; ++it) *(v4u*)(Q + (size_t)m * NQ + (it * 4 + sub) * 128 + 8 * li) = norm_chunk16v(wq[it], qg, QS2, li);
        *(v4u*)(fr_nsa(a, b * 2 + g, win ? 2 : 0) + kf_off(s, 8 * li)) = norm_chunk16v(wk, kg + (win ? 256 : 128), 1.f, li);
#pragma unroll
        for (int it = 0; it < 6; ++it) { const int ch = it * 4 + sub;
            if (ch < 12) *(v4u*)(DL + (size_t)m * NDL + ch * 128 + 8 * li) = norm_chunk16v(wd[it], dqg, QS2, li);
            else { const int head = ch - 12, gi = head >> 2, dsh = 2 * gi  , vk = ((s & ((1 << dsh) - 1)) << (12 - dsh)) + (s >> dsh);
                *(v4u*)(fr_dil(a, b, head, 0) + kf_off(vk, 8 * li)) = norm_chunk16v(wd[it], dkg, 1.f, li); } }
    }
}
__device__ __forceinline__ void ph3_vfrag(const Args& a) {
    const int tid = phase_tid(), lane = tid & 63, wave = __builtin_amdgcn_readfirstlane(tid >> 6);
    const int gw = blockIdx.x * NWAVES + wave, NGW = gridDim.x * NWAVES;
    const bf16* KV = (const bf16*)(a.ws + WS_KV); const bf16* DL = (const bf16*)(a.ws + WS_DL);
    for (int job = gw; job < 32768; job += NGW) {
        const bf16* src; size_t rstride; unsigned char* dst; int key0;
        if (job < 8192) { const int bg = job >> 10, kind = (job >> 9) & 1, s0 = (job & 511) * 8, b = bg >> 1, g = bg & 1;
            src = KV + (size_t)(b * S + s0) * NKV + ((kind ? 10 : 6) + g) * 128; rstride = NKV; dst = fr8_nsa(a, bg, kind ? 3 : 1); key0 = s0; }
        else { const int j2 = job - 8192, bh = j2 >> 9, vk0 = (j2 & 511) * 8, b = bh / 12, head = bh % 12, gi = head >> 2, dsh = 2 * gi, L = S >> dsh, r = vk0 / L, m0 = vk0 % L;
            src = DL + (size_t)(b * S + (m0 << dsh) + r) * NDL + (24 + head) * 128; rstride = (size_t)NDL << dsh; dst = fr8_dil(a, b, head, 1); key0 = vk0; }
        unsigned w[8];
#pragma unroll
        for (int jj = 0; jj < 8; ++jj) w[jj] = *(const unsigned*)(src + jj * rstride + 2 * lane);
        v2u c0, c1;
        c0.x = pk4_f8(bflo(w[0]), bflo(w[1]), bflo(w[2]), bflo(w[3])); c0.y = pk4_f8(bflo(w[4]), bflo(w[5]), bflo(w[6]), bflo(w[7]));
        c1.x = pk4_f8(bfhi(w[0]), bfhi(w[1]), bfhi(w[2]), bfhi(w[3])); c1.y = pk4_f8(bfhi(w[4]), bfhi(w[5]), bfhi(w[6]), bfhi(w[7]));
        *(v2u*)(dst + vf8_off(key0, 2 * lane)) = c0; *(v2u*)(dst + vf8_off(key0, 2 * lane + 1)) = c1;
    }
}
__device__ __forceinline__ void ph3_gates(const Args& a) {
    const int tid = phase_tid(), lane = tid & 63, wave = __builtin_amdgcn_readfirstlane(tid >> 6), tl = lane & 31, hh = lane >> 5;
    const int gw = (gridDim.x - 1 - blockIdx.x) * NWAVES + wave, NGW = gridDim.x * NWAVES;
    const bf16* H = (const bf16*)(a.ws + WS_H); const v4u* WG = (const v4u*)(a.ws + WS_WGF) + lane; float* gates = (float*)(a.ws + WS_GATES);
    for (int job = gw; job < T / 32; job += NGW) {
        const int t = job * 32 + tl; const bf16* hr = H + (size_t)t * D + 8 * hh;
        f32x16 acc;
#pragma unroll
        for (int i = 0; i < 16; ++i) acc[i] = 0.f;
#pragma unroll 4
        for (int ks = 0; ks < 128; ++ks) { const bf16x8 af = __builtin_bit_cast(bf16x8, WG[ks * 64]), bfr = __builtin_bit_cast(bf16x8, *(const v4u*)(hr + 16 * ks));
            acc = __builtin_amdgcn_mfma_f32_32x32x16_bf16(af, bfr, acc, 0, 0, 0); }
#pragma unroll
        for (int i = 0; i < 16; ++i) { const int j = (i & 3) + 8 * (i >> 2) + 4 * hh; const float v = acc[i]; if (j < 24) gates[(size_t)t * 24 + j] = sigmoidf(v); }
    }
}
__device__ __forceinline__ void ph3_compress(const Args& a, LAS unsigned char* lds) {
    const int tid = phase_tid(), lane = tid & 63, wave = __builtin_amdgcn_readfirstlane(tid >> 6), cl = lane & 31, hh = lane >> 5;
    LAS float* part = (LAS float*)lds;
    LAS float* hid = part + 2 * 128 * 32;
    LAS float* ob = hid + 32 * 128;
    LAS float* bias = ob + 32 * 128;
    const bf16* KV = (const bf16*)(a.ws + WS_KV);
    const float* w2 = a.in[10]; const float* kg0 = a.in[7]; const float* CBP = (const float*)(a.ws + WS_CBP);
    for (int u = blockIdx.x; u < 128; u += gridDim.x) {
        const int j = u >> 6, bg = (u >> 3) & 7, ct = u & 7, b = bg >> 1, g = bg & 1, c0 = 32 * ct, hhd = j * 2 + g;
        if (tid < 128) { float s = 0.f;
#pragma unroll
            for (int kc = 0; kc < 64; ++kc) s += CBP[(kc * 2 + j) * 128 + tid];
            bias[tid] = s; }
        { const int nt = wave & 3, kh = wave >> 2, c = c0 + cl;
          const v4u* af = (const v4u*)(a.ws + WS_CW1F) + ((size_t)(j * 4 + nt) * 256 + 128 * kh) * 64 + lane;
          f32x16 acc;
#pragma unroll
          for (int i = 0; i < 16; ++i) acc[i] = 0.f;
#pragma unroll 4
          for (int ks = 0; ks < 128; ++ks) { const int k = 16 * (128 * kh + ks) + 8 * hh, l = k >> 7, d = k & 127, p = 16 * c + l;
              v4u x = {0u, 0u, 0u, 0u}; if (p < S) x = *(const v4u*)(KV + (size_t)(b * S + p) * NKV + hhd * 128 + d);
              acc = __builtin_amdgcn_mfma_f32_32x32x16_bf16(__builtin_bit_cast(bf16x8, af[ks * 64]), __builtin_bit_cast(bf16x8, x), acc, 0, 0, 0); }
#pragma unroll
          for (int i = 0; i < 16; ++i) { const int n = 32 * nt + (i & 3) + 8 * (i >> 2) + 4 * hh; const float v = acc[i]; part[(kh * 128 + n) * 32 + cl] = v; } }
        __syncthreads();
        for (int i = tid; i < 128 * 32; i += NTHREADS) { const int n = i >> 5, c = i & 31; hid[c * 128 + n] = gelu_tanh(part[i] + part[128 * 32 + i] + bias[n]); }
        __syncthreads();
        { const int n = tid & 127, cq = tid >> 7; float o[8];
#pragma unroll
          for (int r = 0; r < 8; ++r) o[r] = 0.f;
          const float* w2p = w2 + j * 128 * 128 + n;
          for (int k = 0; k < 128; ++k) { const float w = w2p[k * 128];
#pragma unroll
              for (int r = 0; r < 8; ++r) o[r] += hid[(8 * cq + r) * 128 + k] * w; }
#pragma unroll
          for (int r = 0; r < 8; ++r) ob[(8 * cq + r) * 128 + n] = o[r]; }
        __syncthreads();
        bf16* fr = (bf16*)(a.ws + (j == 0 ? WS_KC : WS_VC)) + (size_t)bg * 8 * 4096;
#pragma unroll 1
        for (int r = 0; r < 4; ++r) { const int cr = 4 * wave + r, c = c0 + cr; float v0 = ob[cr * 128 + 2 * lane], v1 = ob[cr * 128 + 2 * lane + 1];
            if (j == 0) { const float rstd = rsqrtf(wave_sum(v0 * v0 + v1 * v1) * (1.f / 128.f) + EPS); v0 = v0 * rstd * kg0[2 * lane]; v1 = v1 * rstd * kg0[2 * lane + 1]; }
            if (c >= NC) { v0 = 0.f; v1 = 0.f; }
            if (j == 0) *(unsigned*)(fr + kf_off(c, 2 * lane)) = pk2(v0, v1);
            else { fr[vf_off(c, 2 * lane)] = (bf16)f2bf(v0); fr[vf_off(c, 2 * lane + 1)] = (bf16)f2bf(v1); } }
        __syncthreads();
    }
}

#define KBI(i) (16 * ((i) >> 3) + ((i) & 7))
__device__ __forceinline__ void load_frags(bf16x8 (&f)[8], const v4u* p, int lane) {
#pragma unroll
    for (int i = 0; i < 8; ++i) f[i] = __builtin_bit_cast(bf16x8, p[i * 64 + lane]);
}
__device__ __forceinline__ f32x16 qk_mma(const bf16x8 (&qf)[8], const bf16x8 (&k)[8]) {
    f32x16 s;
#pragma unroll
    for (int i = 0; i < 16; ++i) s[i] = 0.f;
#pragma unroll
    for (int st = 0; st < 8; ++st) s = __builtin_amdgcn_mfma_f32_32x32x16_bf16(k[st], qf[st], s, 0, 0, 0);
    return s;
}
__device__ __forceinline__ f32x16 qk_tile(const bf16x8 (&qf)[8], const v4u* kf, int lane) { bf16x8 k[8]; load_frags(k, kf, lane); return qk_mma(qf, k); }
template <int STRIDE> __device__ __forceinline__ void add_tbl(f32x16& s, const LAS float* tp2, float pen) {
#pragma unroll
    for (int i = 0; i < 16; ++i) s[i] += tp2[STRIDE * (23 - KBI(i))] + pen;
}
__device__ __forceinline__ void mask_hi(f32x16& s, int lim) {
#pragma unroll
    for (int i = 0; i < 16; ++i) s[i] = (KBI(i) <= lim) ? s[i] : NEGB;
}
__device__ __forceinline__ void mask_lo(f32x16& s, int lim) {
#pragma unroll
    for (int i = 0; i < 16; ++i) s[i] = (KBI(i) >= lim) ? s[i] : NEGB;
}
__device__ __forceinline__ float max16(const f32x16& s) {
    float mx = fmaxf(s[0], s[1]);
#pragma unroll
    for (int i = 2; i < 16; ++i) mx = fmaxf(mx, s[i]);
    return fmaxf(mx, __shfl_xor(mx, 32));
}
__device__ __forceinline__ void pv_tile(const f32x16& p, f32x16 (&o)[4], const bf16x8 (&v)[8]) {
    v4u a0, a1;
    a0.x = pkbf(p[0], p[1]); a0.y = pkbf(p[2], p[3]); a0.z = pkbf(p[4], p[5]); a0.w = pkbf(p[6], p[7]);
    a1.x = pkbf(p[8], p[9]); a1.y = pkbf(p[10], p[11]); a1.z = pkbf(p[12], p[13]); a1.w = pkbf(p[14], p[15]);
    const bf16x8 pb0 = __builtin_bit_cast(bf16x8, a0), pb1 = __builtin_bit_cast(bf16x8, a1);
#pragma unroll
    for (int dt = 0; dt < 4; ++dt) { o[dt] = __builtin_amdgcn_mfma_f32_32x32x16_bf16(v[2 * dt], pb0, o[dt], 0, 0, 0); o[dt] = __builtin_amdgcn_mfma_f32_32x32x16_bf16(v[2 * dt + 1], pb1, o[dt], 0, 0, 0); }
}
__device__ __forceinline__ void softmax_pv(f32x16& s, f32x16 (&o)[4], float& m, float& l, const v4u* vf, int lane) {
    bf16x8 v[8];
#pragma unroll
    for (int i = 0; i < 8; ++i) v[i] = __builtin_bit_cast(bf16x8, vf[i * 64 + lane]);
    const float mn = fmaxf(m, max16(s));
    if (__ballot(mn > m + 8.f)) {
        const float corr = ex2(m - mn);
#pragma unroll
        for (int dt = 0; dt < 4; ++dt)
#pragma unroll
            for (int i = 0; i < 16; ++i) o[dt][i] *= corr;
        l *= corr; m = mn;
    }
    float ps = 0.f;
#pragma unroll
    for (int i = 0; i < 16; ++i) { s[i] = ex2(s[i] - m); ps += s[i]; }
    l += ps;
    pv_tile(s, o, v);
}
template <int NP = 0> __device__ __forceinline__ void softmax_pv_v(f32x16& s, f32x16 (&o)[4], float& m, float& l, const bf16x8 (&v)[8]) {
    if (NP == 2) { l += s[0]; pv_tile(s, o, v); return; }
    const float mn = fmaxf(m, max16(s));
    if (__ballot(mn > m + 8.f)) {
        const float corr = ex2(m - mn);
#pragma unroll
        for (int dt = 0; dt < 4; ++dt)
#pragma unroll
            for (int i = 0; i < 16; ++i) o[dt][i] *= corr;
        l *= corr; m = mn;
    }
    float ps = 0.f;
#pragma unroll
    for (int i = 0; i < 16; ++i) { s[i] = ex2(s[i] - m); ps += s[i]; }
    l += ps;
    pv_tile(s, o, v);
}
typedef long f8x8;
__device__ __forceinline__ void load_frags8(f8x8 (&f)[8], const v4u* p, int lane) {
#pragma unroll
    for (int i = 0; i < 4; ++i) { const v4u w = p[i * 64 + lane]; f[2 * i] = (long)(((unsigned long long)w.y << 32) | w.x); f[2 * i + 1] = (long)(((unsigned long long)w.w << 32) | w.z); }
}
__device__ __forceinline__ f32x16 qk_mma8(const f8x8 (&qf)[8], const f8x8 (&k)[8]) {
    f32x16 s;
#pragma unroll
    for (int i = 0; i < 16; ++i) s[i] = 0.f;
#pragma unroll
    for (int st = 0; st < 8; ++st) s = __builtin_amdgcn_mfma_f32_32x32x16_fp8_fp8(k[st], qf[st], s, 0, 0, 0);
    return s;
}
__device__ __forceinline__ unsigned pk4_f8n(float a, float b, float c, float d) { int w = 0; w = __builtin_amdgcn_cvt_pk_fp8_f32(a, b, w, false); w = __builtin_amdgcn_cvt_pk_fp8_f32(c, d, w, true); return (unsigned)w; }
__device__ __forceinline__ void pv_tile8(const f32x16& p, f32x16 (&o)[4], const f8x8 (&v)[8]) {
    const f8x8 pb0 = (long)(((unsigned long long)pk4_f8n(p[4], p[5], p[6], p[7]) << 32) | pk4_f8n(p[0], p[1], p[2], p[3]));
    const f8x8 pb1 = (long)(((unsigned long long)pk4_f8n(p[12], p[13], p[14], p[15]) << 32) | pk4_f8n(p[8], p[9], p[10], p[11]));
#pragma unroll
    for (int dt = 0; dt < 4; ++dt) { o[dt] = __builtin_amdgcn_mfma_f32_32x32x16_fp8_fp8(v[2 * dt], pb0, o[dt], 0, 0, 0); o[dt] = __builtin_amdgcn_mfma_f32_32x32x16_fp8_fp8(v[2 * dt + 1], pb1, o[dt], 0, 0, 0); }
}
template <int NP = 0> __device__ __forceinline__ void softmax_pv_v8(f32x16& s, f32x16 (&o)[4], float& m, float& l, const f8x8 (&v)[8]) {
    if (NP == 2) { l += s[0]; pv_tile8(s, o, v); return; }
    const float mn = fmaxf(m, max16(s));
    if (__ballot(mn > m + 8.f)) {
        const float corr = ex2(m - mn);
#pragma unroll
        for (int dt = 0; dt < 4; ++dt)
#pragma unroll
            for (int i = 0; i < 16; ++i) o[dt][i] *= corr;
        l *= corr; m = mn;
    }
    float ps = 0.f;
#pragma unroll
    for (int i = 0; i < 16; ++i) { s[i] = ex2(s[i] - m); ps += s[i]; }
    l += ps;
    pv_tile8(s, o, v);
}
__device__ __forceinline__ void q_to_f8(f8x8 (&q8)[8], const bf16x8 (&qf)[8]) {
#pragma unroll
    for (int st = 0; st < 8; ++st) { const v4u w = __builtin_bit_cast(v4u, qf[st]);
        q8[st] = (long)(((unsigned long long)pk4_f8(bflo(w.z), bfhi(w.z), bflo(w.w), bfhi(w.w)) << 32) | pk4_f8(bflo(w.x), bfhi(w.x), bflo(w.y), bfhi(w.y))); }
}
__device__ __forceinline__ void zero_o(f32x16 (&o)[4]) {
#pragma unroll
    for (int dt = 0; dt < 4; ++dt)
#pragma unroll
        for (int i = 0; i < 16; ++i) o[dt][i] = 0.f;
}
__device__ __forceinline__ void y_update(bf16* yp  , const f32x16 (&o)[4], float sc, bool acc) {
#pragma unroll
    for (int dt = 0; dt < 4; ++dt)
#pragma unroll
        for (int i4 = 0; i4 < 4; ++i4) { bf16* p = yp + 32 * dt + 8 * i4;
            float v0 = o[dt][4 * i4] * sc, v1 = o[dt][4 * i4 + 1] * sc, v2 = o[dt][4 * i4 + 2] * sc, v3 = o[dt][4 * i4 + 3] * sc;
            if (acc) { const v2u w = *(const v2u*)p; v0 += bflo(w.x); v1 += bfhi(w.x); v2 += bflo(w.y); v3 += bfhi(w.y); }
            v2u w; w.x = pkbf(v0, v1); w.y = pkbf(v2, v3); *(v2u*)p = w; }
}
constexpr int TBLN = 2624;
constexpr int OFF_TBL = 0, OFF_IMP = 43008, OFF_SELM = OFF_IMP + 65536, OFF_DTBL = OFF_SELM + 512;
constexpr int FAR_DIST = 1513;

template <int NP> __device__ __forceinline__ void nsa_unit(const Args& a, LAS unsigned char* lds, int u, int tid) {
    const int lane = tid & 63, wave = __builtin_amdgcn_readfirstlane(tid >> 6);
    const int qb = u >> 3, bg = u & 7, b = bg >> 1, g = bg & 1;
    const int r = wave >> 1, qs = wave & 1, hd = g * 4 + r, ql = lane & 31, h = lane >> 5;
    const int q0w = 64 * qb + 32 * qs, sq = q0w + ql, t = b * S + sq;
    LAS float* tball = (LAS float*)(lds + OFF_TBL);
    LAS float* imp = (LAS float*)(lds + OFF_IMP);
    LAS unsigned long long* selm = (LAS unsigned long long*)(lds + OFF_SELM);
    const float* relb = a.in[22];
    for (int i = tid; i < 4 * TBLN; i += NTHREADS) { const int hh = i / TBLN, dd = i % TBLN - 64; tball[i] = dd >= 0 ? relb[(g * 4 + hh) * 32 + t5_bucket(dd)] * LOG2E : 0.f; }
    for (int i = tid; i < 4 * 64 * 64; i += NTHREADS) imp[i] = 0.f;
    __syncthreads();
    const LAS float* tbl = tball + r * TBLN + 64;
    const float farc = relb[hd * 32 + 31] * LOG2E;
    bf16x8 qf[8];
    { const bf16* qrow = (const bf16*)(a.ws + WS_Q) + (size_t)t * NQ + hd * 128 + 8 * h;
#pragma unroll
      for (int st = 0; st < 8; ++st) qf[st] = __builtin_bit_cast(bf16x8, *(const v4u*)(qrow + 16 * st)); }
    const float* gt = (const float*)(a.ws + WS_GATES) + (size_t)t * 24 + hd * 3;
    const float g0 = gt[0], g1 = gt[1], g2 = gt[2];
    bf16* yp = (bf16*)(a.ws + (NP ? WS_H : WS_YN)) + (size_t)t * 1536 + hd * 128 + 4 * h;
    f32x16 o[4];
    {
        const v4u* kfc = (const v4u*)(a.ws + WS_KC) + (size_t)bg * 8 * 512; const v4u* vfc = (const v4u*)(a.ws + WS_VC) + (size_t)bg * 8 * 512;
        const int smax = q0w + 31, ncv = smax >= 31 ? ((smax - 31) >> 4) + 1 : 0, ntc = (ncv + 31) >> 5;
        float m = NEGB, l = 0.f;
        for (int tc = 0; tc < ntc; ++tc) {
            f32x16 s = qk_tile(qf, kfc + tc * 512, lane);
            const int dqc = sq - 31 - 512 * tc;
            if (q0w - 31 - 512 * tc - 496 >= FAR_DIST) {
#pragma unroll
                for (int i = 0; i < 16; ++i) s[i] += farc;
            } else add_tbl<16>(s, tbl + dqc - 16 * (8 * h + 23), 0.f);
            mask_hi(s, (dqc >> 4) - 8 * h);
            const float mn = fmaxf(m, max16(s));
            float ps = 0.f;
#pragma unroll
            for (int i = 0; i < 16; ++i) ps += ex2(s[i] - mn);
            l = l * ex2(m - mn) + ps; m = mn;
        }
        l += __shfl_xor(l, 32);
        const float inv = (sq >= 31) ? 1.f / l : 0.f;
        zero_o(o);
        LAS float* impq = imp + (r * 64 + 32 * qs + ql) * 64;
        for (int tc = 0; tc < ntc; ++tc) {
            f32x16 s = qk_tile(qf, kfc + tc * 512, lane);
            bf16x8 v[8];
#pragma unroll
            for (int i = 0; i < 8; ++i) v[i] = __builtin_bit_cast(bf16x8, vfc[tc * 512 + i * 64 + lane]);
            const int dqc = sq - 31 - 512 * tc;
            if (q0w - 31 - 512 * tc - 496 >= FAR_DIST) {
#pragma unroll
                for (int i = 0; i < 16; ++i) s[i] += farc;
            } else add_tbl<16>(s, tbl + dqc - 16 * (8 * h + 23), 0.f);
            mask_hi(s, (dqc >> 4) - 8 * h);
#pragma unroll
            for (int i = 0; i < 16; ++i) s[i] = ex2(s[i] - m) * inv;
#pragma unroll
            for (int a2 = 0; a2 < 2; ++a2)
#pragma unroll
                for (int bq = 0; bq < 2; ++bq) { const int j = 8 * tc + 4 * a2 + 2 * h + bq; const int i0 = 8 * a2 + 4 * bq;
                    impq[j] += (s[i0] + s[i0 + 1]) + (s[i0 + 2] + s[i0 + 3]); }
            asm volatile("s_waitcnt lgkmcnt(0)" ::: "memory");
#pragma unroll
            for (int a2 = 0; a2 < 2; ++a2)
#pragma unroll
                for (int bq = 0; bq < 2; ++bq) { const int j = 8 * tc + 4 * a2 + 2 * h + bq + 1; if (j < 64) impq[j] += s[8 * a2 + 4 * bq + 3]; }
            asm volatile("s_waitcnt lgkmcnt(0)" ::: "memory");
            pv_tile(s, o, v);
        }
        y_update(yp, o, g0, false);
    }
    f8x8 q8[8]; q_to_f8(q8, qf);
    __syncthreads();
    for (int qq = wave * 8; qq < wave * 8 + 8; ++qq) {
        const int jb = lane;
        const float im = ((imp[(0 * 64 + qq) * 64 + jb] + imp[(1 * 64 + qq) * 64 + jb]) + imp[(2 * 64 + qq) * 64 + jb]) + imp[(3 * 64 + qq) * 64 + jb];
        const bool forced = (jb == 0) || (jb == qb) || (jb == qb - 1);
        const float score = forced ? 1e4f : (jb > qb ? -1e4f : im);
        int rank = 0;
        for (int o2 = 0; o2 < 64; ++o2) { const float so = __shfl(score, o2); rank += (so > score) || (so == score && o2 < jb); }
        const unsigned long long mask = __ballot(rank < 16 && jb <= qb);
        if (lane == 0) selm[qq] = mask;
    }
    __syncthreads();
    {
        const v4u* kfw = (const v4u*)fr8_nsa(a, bg, 2); const v4u* vfw = (const v4u*)fr8_nsa(a, bg, 3);
        const int t_hi = q0w >> 5, t_lo = t_hi - 16;
        float m = NEGB, l = 0.f; zero_o(o);
        const int t0 = t_lo < 0 ? 0 : t_lo;
        for (int tt = t0; tt <= t_hi; ++tt) {
            const size_t to = (NP == 3) ? (size_t)(tt & 1) * 256 : (size_t)tt * 256;
            f8x8 kf[8], vf[8]; load_frags8(kf, kfw + to, lane);
            f32x16 s = qk_mma8(q8, kf); load_frags8(vf, vfw + to, lane);
            const int dq = sq - 32 * tt;
            add_tbl<1>(s, tbl + dq - (8 * h + 23), 0.f);
            if (tt == t_hi) mask_hi(s, dq - 8 * h);
            if (tt == t_lo) mask_lo(s, dq - 511 - 8 * h);
            softmax_pv_v8<NP>(s, o, m, l, vf);
        }
        l += __shfl_xor(l, 32);
        y_update(yp, o, g2 / l, true);
    }
    {
        const v4u* kfs = (const v4u*)fr8_nsa(a, bg, 0); const v4u* vfs = (const v4u*)fr8_nsa(a, bg, 1);
        const unsigned long long mask = selm[32 * qs + ql];
        float m = NEGB, l = 0.f; zero_o(o);
        const int t_end = 2 * qb + qs;
        for (int tt = 0; tt <= 2 * qb + 1; ++tt) {
            if (tt > t_end) continue;
            const float pen = ((mask >> (tt >> 1)) & 1ull) ? 0.f : NEGB;
            if (__ballot(pen == 0.f) == 0ull) continue;
            const size_t to = (NP == 3) ? (size_t)(tt & 1) * 256 : (size_t)tt * 256;
            f8x8 kf[8], vf[8]; load_frags8(kf, kfs + to, lane);
            f32x16 s = qk_mma8(q8, kf); load_frags8(vf, vfs + to, lane);
            const int dq = sq - 32 * tt;
            if (q0w - (32 * tt + 31) >= FAR_DIST) {
                const float c = farc + pen;
#pragma unroll
                for (int i = 0; i < 16; ++i) s[i] += c;
            } else add_tbl<1>(s, tbl + dq - (8 * h + 23), pen);
            if (tt == t_end) mask_hi(s, dq - 8 * h);
            softmax_pv_v8<NP>(s, o, m, l, vf);
        }
        l += __shfl_xor(l, 32);
        y_update(yp, o, g1 / l, true);
    }
    __syncthreads();
}
__device__ __forceinline__ void dil_unit(const Args& a, LAS unsigned char* lds, int u, int tid) {
    const int lane = tid & 63, wave = __builtin_amdgcn_readfirstlane(tid >> 6), ql = lane & 31, h = lane >> 5;
    const int b = u >> 6, p = (u >> 4) & 3, c = u & 15, s0 = 256 * c;
    LAS float* dtbl = (LAS float*)(lds + OFF_DTBL);
    const float* relb = a.in[22] + 8 * 32;
    for (int i = tid; i < 3 * 192; i += NTHREADS) { const int gi = i / 192, dm = i % 192 - 32; dtbl[i] = dm >= 0 ? relb[(gi * 4 + p) * 32 + t5_bucket(dm << (2 * gi))] * LOG2E : 0.f; }
    __syncthreads();
    bf16* OD = (bf16*)(a.ws + WS_OD); float* LSE = (float*)(a.ws + WS_LSE);
    const bf16* DL = (const bf16*)(a.ws + WS_DL);
    for (int job = wave; job < 32; job += NWAVES) {
        int gi, rr, m0, vlo, vhi;
        if (job < 8) { gi = 0; rr = 0; m0 = s0 + 32 * job; vlo = 0; vhi = 32; }
        else if (job < 16) { gi = 1; rr = (job - 8) >> 1; m0 = (s0 >> 2) + 32 * (job & 1); vlo = 0; vhi = 32; }
        else { gi = 2; rr = job - 16; m0 = 32 * (c >> 1); vlo = 16 * (c & 1); vhi = vlo + 16; }
        const int dsh = 2 * gi, L = S >> dsh, head = gi * 4 + p;
        const int mq = m0 + ql, sact = (mq << dsh) + rr, t = b * S + sact;
        const v4u* kf = (const v4u*)fr8_dil(a, b, head, 0) + (size_t)((rr * L) >> 5) * 256; const v4u* vf = (const v4u*)fr8_dil(a, b, head, 1) + (size_t)((rr * L) >> 5) * 256;
        bf16x8 qf[8];
        { const bf16* qrow = DL + (size_t)t * NDL + head * 128 + 8 * h;
#pragma unroll
          for (int st = 0; st < 8; ++st) qf[st] = __builtin_bit_cast(bf16x8, *(const v4u*)(qrow + 16 * st)); }
        f8x8 q8[8]; q_to_f8(q8, qf);
        const LAS float* tb = dtbl + gi * 192 + 32;
        const int t_hi = m0 >> 5, t_lo = t_hi - 4;
        float m = NEGB, l = 0.f; f32x16 o[4]; zero_o(o);
        const int t0 = t_lo < 0 ? 0 : t_lo;
        for (int tt = t0; tt <= t_hi; ++tt) {
            f8x8 kr[8], vr[8]; load_frags8(kr, kf + (size_t)tt * 256, lane);
            f32x16 s = qk_mma8(q8, kr); load_frags8(vr, vf + (size_t)tt * 256, lane);
            const int dq = mq - 32 * tt;
            add_tbl<1>(s, tb + dq - (8 * h + 23), 0.f);
            if (tt == t_hi) mask_hi(s, dq - 8 * h);
            if (tt == t_lo) mask_lo(s, dq - 128 - 8 * h);
            softmax_pv_v8(s, o, m, l, vr);
        }
        l += __shfl_xor(l, 32);
        if (ql >= vlo && ql < vhi) {
            y_update(OD + ((size_t)gi * T + t) * 512 + p * 128 + 4 * h, o, 1.f / l, false);
            if (h == 0) LSE[((size_t)(gi * NB + b) * 4 + p) * S + sact] = m + __log2f(l);
        }
    }
    __syncthreads();
    { const int pos = tid >> 1, dh = tid & 1, sact = s0 + pos, t = b * S + sact;
      const float l0 = LSE[((size_t)(0 * NB + b) * 4 + p) * S + sact], l1 = LSE[((size_t)(1 * NB + b) * 4 + p) * S + sact], l2 = LSE[((size_t)(2 * NB + b) * 4 + p) * S + sact];
      const float mx = fmaxf(l0, fmaxf(l1, l2)); float w0 = ex2(l0 - mx), w1 = ex2(l1 - mx), w2 = ex2(l2 - mx); const float iw = 1.f / (w0 + w1 + w2); w0 *= iw; w1 *= iw; w2 *= iw;
      bf16* yd = (bf16*)(a.ws + WS_YN) + (size_t)t * 1536 + 1024 + p * 128 + 64 * dh;
      const bf16* o0 = OD + ((size_t)0 * T + t) * 512 + p * 128 + 64 * dh; const bf16* o1 = OD + ((size_t)1 * T + t) * 512 + p * 128 + 64 * dh; const bf16* o2 = OD + ((size_t)2 * T + t) * 512 + p * 128 + 64 * dh;
#pragma unroll
      for (int k = 0; k < 8; ++k) { const v4u x0 = *(const v4u*)(o0 + 8 * k), x1 = *(const v4u*)(o1 + 8 * k), x2 = *(const v4u*)(o2 + 8 * k); v4u y;
          y.x = pkbf(w0 * bflo(x0.x) + w1 * bflo(x1.x) + w2 * bflo(x2.x), w0 * bfhi(x0.x) + w1 * bfhi(x1.x) + w2 * bfhi(x2.x));
          y.y = pkbf(w0 * bflo(x0.y) + w1 * bflo(x1.y) + w2 * bflo(x2.y), w0 * bfhi(x0.y) + w1 * bfhi(x1.y) + w2 * bfhi(x2.y));
          y.z = pkbf(w0 * bflo(x0.z) + w1 * bflo(x1.z) + w2 * bflo(x2.z), w0 * bfhi(x0.z) + w1 * bfhi(x1.z) + w2 * bfhi(x2.z));
          y.w = pkbf(w0 * bflo(x0.w) + w1 * bflo(x1.w) + w2 * bflo(x2.w), w0 * bfhi(x0.w) + w1 * bfhi(x1.w) + w2 * bfhi(x2.w));
          *(v4u*)(yd + 8 * k) = y; } }
    __syncthreads();
}
__device__ __forceinline__ void ph4_attention(const Args& a, LAS unsigned char* lds) {
    const int tid = phase_tid();
    for (int u = blockIdx.x; u < 256; u += gridDim.x) dil_unit(a, lds, u, tid);
#ifndef PROBE_NSA
#define PROBE_NSA 0
#endif
    if (PROBE_NSA) for (int x = blockIdx.x; x < 256; x += gridDim.x) { nsa_unit<PROBE_NSA>(a, lds, 511 - x, tid); nsa_unit<PROBE_NSA>(a, lds, x, tid); }
    for (int x = blockIdx.x; x < 256; x += gridDim.x) { nsa_unit<0>(a, lds, 511 - x, tid); nsa_unit<0>(a, lds, x, tid); }
}

typedef float f32x2 __attribute__((ext_vector_type(2)));
constexpr size_t WS_PU8 = WS_Q;
constexpr size_t WS_PV8 = WS_Q + 32 * MiB;
constexpr size_t WS_PSC = WS_Q + 64 * MiB;
__device__ __forceinline__ void ph_quant_uv(const Args& a) {
    const int tid = phase_tid(), lane = tid & 63, wave = __builtin_amdgcn_readfirstlane(tid >> 6);
    const int gw = blockIdx.x * NWAVES + wave, NGW = gridDim.x * NWAVES;
    float* SC = (float*)(a.ws + WS_PSC);
    for (int rw = gw; rw < NE; rw += NGW) {
        f32x4 x[2][8];
#pragma unroll
        for (int which = 0; which < 2; ++which) { const float* src = a.in[20 + which] + (size_t)rw * D + 16 * lane;
#pragma unroll
            for (int c = 0; c < 2; ++c)
#pragma unroll
                for (int w = 0; w < 4; ++w) x[which][4 * c + w] = *(const f32x4*)(src + 1024 * c + 4 * w); }
#pragma unroll
        for (int which = 0; which < 2; ++which) {
            unsigned char* dst = a.ws + (which ? WS_PV8 : WS_PU8) + (size_t)rw * 1024 + 16 * lane;
            float ss = 0.f;
#pragma unroll
            for (int i = 0; i < 8; ++i) ss += (x[which][i].x * x[which][i].x + x[which][i].y * x[which][i].y) + (x[which][i].z * x[which][i].z + x[which][i].w * x[which][i].w);
            ss = wave_sum(ss);
            const float step = 0.48f * sqrtf(ss * (1.f / D));
            const float inv = step > 0.f ? 1.f / step : 0.f;
            v4u o; unsigned wd[4];
#pragma unroll
            for (int wi = 0; wi < 4; ++wi) { unsigned q = 0u;
                const f32x4 va = x[which][2 * wi], vb = x[which][2 * wi + 1];
                q = __builtin_amdgcn_cvt_scalef32_pk_fp4_f32(q, __builtin_amdgcn_fmed3f(va.x * inv, -6.f, 6.f), __builtin_amdgcn_fmed3f(va.y * inv, -6.f, 6.f), 1.0f, 0);
                q = __builtin_amdgcn_cvt_scalef32_pk_fp4_f32(q, __builtin_amdgcn_fmed3f(va.z * inv, -6.f, 6.f), __builtin_amdgcn_fmed3f(va.w * inv, -6.f, 6.f), 1.0f, 1);
                q = __builtin_amdgcn_cvt_scalef32_pk_fp4_f32(q, __builtin_amdgcn_fmed3f(vb.x * inv, -6.f, 6.f), __builtin_amdgcn_fmed3f(vb.y * inv, -6.f, 6.f), 1.0f, 2);
                q = __builtin_amdgcn_cvt_scalef32_pk_fp4_f32(q, __builtin_amdgcn_fmed3f(vb.z * inv, -6.f, 6.f), __builtin_amdgcn_fmed3f(vb.w * inv, -6.f, 6.f), 1.0f, 3);
                wd[wi] = q; }
            o.x = wd[0]; o.y = wd[1]; o.z = wd[2]; o.w = wd[3]; *(v4u*)dst = o;
            if (lane == 0) SC[which * NE + rw] = step;
        }
    }
}
constexpr size_t WS_KEYF = 601 * MiB;
constexpr size_t WS_END3 = 602 * MiB;
__device__ __forceinline__ void ph0_keyfrags(const Args& a) {
    const int tid = phase_tid();
    const float* keys = a.in[19]; v4u* KF = (v4u*)(a.ws + WS_KEYF);
    for (int i = blockIdx.x * NTHREADS + tid; i < 16 * 32 * 64; i += gridDim.x * NTHREADS) {
        const int lane = i & 63, st = (i >> 6) & 7, kt = (i >> 9) & 3, hp = i >> 11;
        const float* src = keys + ((size_t)hp * 128 + 32 * kt + (lane & 31)) * 128 + 16 * st + 8 * (lane >> 5);
        float v[8]; unsigned hi[8], lo[8];
#pragma unroll
        for (int j = 0; j < 8; ++j) { v[j] = src[j]; hi[j] = f2bf(v[j]); lo[j] = f2bf(v[j] - __builtin_bit_cast(float, hi[j] << 16)); }
        v4u oh, ol; oh.x = hi[0] | (hi[1] << 16); oh.y = hi[2] | (hi[3] << 16); oh.z = hi[4] | (hi[5] << 16); oh.w = hi[6] | (hi[7] << 16);
        ol.x = lo[0] | (lo[1] << 16); ol.y = lo[2] | (lo[3] << 16); ol.z = lo[4] | (lo[5] << 16); ol.w = lo[6] | (lo[7] << 16);
        KF[(size_t)((hp * 2 + 0) * 32 + kt * 8 + st) * 64 + lane] = oh; KF[(size_t)((hp * 2 + 1) * 32 + kt * 8 + st) * 64 + lane] = ol;
    }
}
template <int N, bool MERGE_ONLY> __device__ __forceinline__ void bitonic_desc(float (&v)[N]) {
#pragma unroll
    for (int k = MERGE_ONLY ? N : 2; k <= N; k <<= 1)
#pragma unroll
        for (int j = k >> 1; j > 0; j >>= 1)
#pragma unroll
            for (int i = 0; i < N; ++i) { const int l = i ^ j;
                if (l > i) { const bool desc = ((i & k) == 0) || (k == N); const float x = v[i], y = v[l], hi = fmaxf(x, y), lo = fminf(x, y); v[i] = desc ? hi : lo; v[l] = desc ? lo : hi; } }
}
#define CROW(i) (((i) & 3) + 8 * ((i) >> 2))
__device__ __forceinline__ float max3f(float a, float b, float c) { return fmaxf(fmaxf(a, b), c); }
__device__ __forceinline__ void ph_route(const Args& a, LAS unsigned char* lds) {
    const int tid = phase_tid(), lane = tid & 63, wave = __builtin_amdgcn_readfirstlane(tid >> 6), tl = lane & 31, hc = lane >> 5;
    const int gw = blockIdx.x * NWAVES + wave, NGW = gridDim.x * NWAVES;
    const float* QP = (const float*)(a.ws + WS_QP); const float* qgain = a.in[18]; const v4u* KF = (const v4u*)(a.ws + WS_KEYF);
    int* EI = (int*)(a.ws + WS_EI); float* EG = (float*)(a.ws + WS_EG);
    LAS float* spl = (LAS float*)(lds + wave * 8704) + lane * 33;
    for (int job = gw; job < (T / 32) * 8; job += NGW) {
        const int h = job & 7, t = (job >> 3) * 32 + tl;
#pragma unroll 1
        for (int p = 0; p < 2; ++p) {
            bf16x8 bh[8], bl[8];
            { const float* qr = QP + (size_t)t * D + h * 256 + p * 128 + 8 * hc; const float* gr = qgain + (h * 2 + p) * 128 + 8 * hc;
              float ss = 0.f;
#pragma unroll
              for (int st = 0; st < 8; ++st) { const f32x4 x0 = *(const f32x4*)(qr + 16 * st), x1 = *(const f32x4*)(qr + 16 * st + 4);
                  ss += (x0.x * x0.x + x0.y * x0.y) + (x0.z * x0.z + x0.w * x0.w) + (x1.x * x1.x + x1.y * x1.y) + (x1.z * x1.z + x1.w * x1.w); }
              ss += __shfl_xor(ss, 32);
              const float rstd = rsqrtf(ss * (1.f / 128.f) + EPS);
              asm volatile("" ::: "memory");
#pragma unroll
              for (int st = 0; st < 8; ++st) { const f32x4 x0 = *(const f32x4*)(qr + 16 * st), x1 = *(const f32x4*)(qr + 16 * st + 4); const f32x4 g0 = *(const f32x4*)(gr + 16 * st), g1 = *(const f32x4*)(gr + 16 * st + 4);
                  const float v0 = x0.x * rstd * g0.x, v1 = x0.y * rstd * g0.y, v2 = x0.z * rstd * g0.z, v3 = x0.w * rstd * g0.w, v4 = x1.x * rstd * g1.x, v5 = x1.y * rstd * g1.y, v6 = x1.z * rstd * g1.z, v7 = x1.w * rstd * g1.w;
                  v4u xh, xl; xh.x = pkbf(v0, v1); xh.y = pkbf(v2, v3); xh.z = pkbf(v4, v5); xh.w = pkbf(v6, v7);
                  xl.x = pkbf(v0 - bflo(xh.x), v1 - bfhi(xh.x)); xl.y = pkbf(v2 - bflo(xh.y), v3 - bfhi(xh.y)); xl.z = pkbf(v4 - bflo(xh.z), v5 - bfhi(xh.z)); xl.w = pkbf(v6 - bflo(xh.w), v7 - bfhi(xh.w));
                  bh[st] = __builtin_bit_cast(bf16x8, xh); bl[st] = __builtin_bit_cast(bf16x8, xl); } }
            float sc[64];
            const v4u* kfh = KF + (size_t)(((h * 2 + p) * 2 + 0) * 32) * 64 + lane; const v4u* kfl = KF + (size_t)(((h * 2 + p) * 2 + 1) * 32) * 64 + lane;
#pragma unroll
            for (int kt = 0; kt < 4; ++kt) {
                f32x16 acc;
#pragma unroll
                for (int i = 0; i < 16; ++i) acc[i] = 0.f;
#pragma unroll
                for (int s2 = 0; s2 < 2; ++s2) {
                    asm volatile("" ::: "memory");
                    bf16x8 ah[4], al[4];
#pragma unroll
                    for (int s4 = 0; s4 < 4; ++s4) { ah[s4] = __builtin_bit_cast(bf16x8, kfh[(kt * 8 + s2 * 4 + s4) * 64]); al[s4] = __builtin_bit_cast(bf16x8, kfl[(kt * 8 + s2 * 4 + s4) * 64]); }
#pragma unroll
                    for (int s4 = 0; s4 < 4; ++s4) { const int st = s2 * 4 + s4;
                        acc = __builtin_amdgcn_mfma_f32_32x32x16_bf16(al[s4], bh[st], acc, 0, 0, 0); acc = __builtin_amdgcn_mfma_f32_32x32x16_bf16(ah[s4], bl[st], acc, 0, 0, 0); acc = __builtin_amdgcn_mfma_f32_32x32x16_bf16(ah[s4], bh[st], acc, 0, 0, 0); }
                }
#pragma unroll
                for (int i = 0; i < 16; ++i) { const float av = acc[i];
                    const unsigned bits = (__builtin_bit_cast(unsigned, av) & ~127u) | (unsigned)(127 - (32 * kt + CROW(i) + 4 * hc)); sc[16 * kt + i] = __builtin_bit_cast(float, bits); }
            }
            asm volatile("" ::: "memory");
            bitonic_desc<64, false>(sc);
            float t16[16];
#pragma unroll
            for (int i = 0; i < 16; ++i) t16[i] = __shfl_xor(sc[i], 32);
            float u16[16];
#pragma unroll
            for (int i = 0; i < 16; ++i) u16[i] = fmaxf(sc[i], t16[15 - i]);
            bitonic_desc<16, true>(u16);
#pragma unroll
            for (int i = 0; i < 16; ++i) spl[p * 16 + i] = u16[i];
        }
        asm volatile("s_waitcnt lgkmcnt(0)" ::: "memory");
        float sp[2][16];
#pragma unroll
        for (int i = 0; i < 16; ++i) { sp[0][i] = spl[i]; sp[1][i] = spl[16 + i]; }
        float cv[64];
        {
            int c = 0;
#pragma unroll
            for (int i = 0; i < 16; ++i)
#pragma unroll
                for (int j = 0; j < 16; ++j) if ((i + 1) * (j + 1) <= 16) {
                    const float v = sp[0][i] + sp[1][j];
                    cv[c] = __builtin_bit_cast(float, (__builtin_bit_cast(unsigned, v) & ~255u) | (unsigned)(255 - (i * 16 + j))); ++c; }
#pragma unroll
            for (int i = 50; i < 64; ++i) cv[i] = -INFINITY;
        }
        bitonic_desc<64, false>(cv);
        float tv[16];
#pragma unroll
        for (int i = 0; i < 16; ++i) tv[i] = cv[i];
        asm volatile("s_waitcnt lgkmcnt(0)" ::: "memory");
        int te[16]; float den = 0.f; const float top = tv[0];
#pragma unroll
        for (int i = 0; i < 16; ++i) { const int flat = 255 - (int)(__builtin_bit_cast(unsigned, tv[i]) & 255u);
            const unsigned b1 = __builtin_bit_cast(unsigned, spl[flat >> 4]), b2 = __builtin_bit_cast(unsigned, spl[16 + (flat & 15)]);
            te[i] = (127 - (int)(b1 & 127u)) * 128 + (127 - (int)(b2 & 127u));
            tv[i] = __expf(tv[i] - top); den += tv[i]; }
        den = 1.f / den;
        if (hc == 0) {
            int* ei = EI + (size_t)t * 128 + h * 16; float* eg = EG + (size_t)t * 128 + h * 16;
#pragma unroll
            for (int i = 0; i < 16; i += 4) { *(v4u*)(ei + i) = (v4u){(unsigned)te[i], (unsigned)te[i + 1], (unsigned)te[i + 2], (unsigned)te[i + 3]}; *(f32x4*)(eg + i) = (f32x4){tv[i] * den, tv[i + 1] * den, tv[i + 2] * den, tv[i + 3] * den}; }
        }
        asm volatile("s_waitcnt lgkmcnt(0)" ::: "memory");
    }
}
__device__ __forceinline__ void ph_experts(const Args& a, const float osc) {
    const int tid = phase_tid(), lane = tid & 63, wave = __builtin_amdgcn_readfirstlane(tid >> 6);
    const int gw = blockIdx.x * NWAVES + wave, NGW = gridDim.x * NWAVES;
    const bf16* H2 = (const bf16*)(a.ws + WS_H); const unsigned char* PU = a.ws + WS_PU8; const unsigned char* PV = a.ws + WS_PV8; const unsigned l16 = 16u * lane; const float* SC = (const float*)(a.ws + WS_PSC);
    const int* EI = (const int*)(a.ws + WS_EI); const float* EG = (const float*)(a.ws + WS_EG);
    const float* mod = (const float*)(a.ws + WS_MOD);
    float* out = a.out;
    v4u wa[8], wb[8];
#define EX_LOAD(buf, tab, esel, base) do { _Pragma("unroll") for (int k = 0; k < 8; ++k) { const unsigned e = (unsigned)__builtin_amdgcn_readlane(esel, ((base) + k) & 63); buf[k] = *(const v4u*)((tab) + ((size_t)e << 10) + l16); } __builtin_amdgcn_sched_barrier(0); } while (0)
#define EX_U(buf, bt) do { float pr[8]; \
        _Pragma("unroll") for (int k = 0; k < 8; ++k) { f32x2 s = {0.f, 0.f}; const unsigned q[4] = {buf[k].x, buf[k].y, buf[k].z, buf[k].w}; \
            _Pragma("unroll") for (int wi = 0; wi < 4; ++wi) { \
                s += x[4 * wi + 0] * __builtin_amdgcn_cvt_scalef32_pk_f32_fp4(q[wi], 1.0f, 0); s += x[4 * wi + 1] * __builtin_amdgcn_cvt_scalef32_pk_f32_fp4(q[wi], 1.0f, 1); \
                s += x[4 * wi + 2] * __builtin_amdgcn_cvt_scalef32_pk_f32_fp4(q[wi], 1.0f, 2); s += x[4 * wi + 3] * __builtin_amdgcn_cvt_scalef32_pk_f32_fp4(q[wi], 1.0f, 3); } \
            pr[k] = s.x + s.y; } \
          \
        float q4[4], q2[2]; \
        _Pragma("unroll") for (int j = 0; j < 4; ++j) { const float keep = lb0 ? pr[2 * j + 1] : pr[2 * j], send = lb0 ? pr[2 * j] : pr[2 * j + 1]; q4[j] = keep + __shfl_xor(send, 1); } \
        _Pragma("unroll") for (int j = 0; j < 2; ++j) { const float keep = lb1 ? q4[2 * j + 1] : q4[2 * j], send = lb1 ? q4[2 * j] : q4[2 * j + 1]; q2[j] = keep + __shfl_xor(send, 2); } \
        float rr; { const float keep = lb2 ? q2[1] : q2[0], send = lb2 ? q2[0] : q2[1]; rr = keep + __shfl_xor(send, 4); } \
        rr += __shfl_xor(rr, 8); rr += __shfl_xor(rr, 16); rr += __shfl_xor(rr, 32); \
        if ((lane >> 3) == ((bt) & 7)) { if ((bt) < 8) raw0 = rr; else raw1 = rr; } } while (0)
#define EX_V(buf, bt) do { _Pragma("unroll") for (int k = 0; k < 8; ++k) { const float cf = __builtin_bit_cast(float, __builtin_amdgcn_readlane(__builtin_bit_cast(int, (bt) < 8 ? cf0 : cf1), ((bt) * 8 + k) & 63)); const f32x2 cf2 = {cf, cf}; const unsigned q[4] = {buf[k].x, buf[k].y, buf[k].z, buf[k].w}; \
            _Pragma("unroll") for (int wi = 0; wi < 4; ++wi) { \
                acc[4 * wi + 0] += cf2 * __builtin_amdgcn_cvt_scalef32_pk_f32_fp4(q[wi], 1.0f, 0); acc[4 * wi + 1] += cf2 * __builtin_amdgcn_cvt_scalef32_pk_f32_fp4(q[wi], 1.0f, 1); \
                acc[4 * wi + 2] += cf2 * __builtin_amdgcn_cvt_scalef32_pk_f32_fp4(q[wi], 1.0f, 2); acc[4 * wi + 3] += cf2 * __builtin_amdgcn_cvt_scalef32_pk_f32_fp4(q[wi], 1.0f, 3); } } } while (0)
    const bool lb0 = lane & 1, lb1 = lane & 2, lb2 = lane & 4;
    int e0 = 0, e1 = 0;
    if (gw < T) { e0 = EI[(size_t)gw * 128 + lane]; e1 = EI[(size_t)gw * 128 + 64 + lane]; EX_LOAD(wa, PU, e0, 0); }
    for (int t = gw; t < T; t += NGW) {
        const int b = t / S, tn = t + NGW;
        f32x2 x[16];
#pragma unroll
        for (int c = 0; c < 2; ++c)
#pragma unroll
            for (int hw = 0; hw < 2; ++hw) { const v4u w = *(const v4u*)(H2 + (size_t)t * D + 1024 * c + 16 * lane + 8 * hw); const int o = 8 * c + 4 * hw;
                x[o + 0] = (f32x2){bflo(w.x), bfhi(w.x)}; x[o + 1] = (f32x2){bflo(w.y), bfhi(w.y)}; x[o + 2] = (f32x2){bflo(w.z), bfhi(w.z)}; x[o + 3] = (f32x2){bflo(w.w), bfhi(w.w)}; }
        int ne0 = 0, ne1 = 0;
        if (tn < T) { ne0 = EI[(size_t)tn * 128 + lane]; ne1 = EI[(size_t)tn * 128 + 64 + lane]; }
        const float gs0 = EG[(size_t)t * 128 + lane] * SC[NE + e0], gs1 = EG[(size_t)t * 128 + 64 + lane] * SC[NE + e1];
        const float su0 = SC[e0], su1 = SC[e1];
        float raw0 = 0.f, raw1 = 0.f;
#pragma unroll 1
        for (int i = 0; i < 7; ++i) {
            EX_LOAD(wb, PU, (i < 4 ? e0 : e1), (2 * i + 1) * 8);
            EX_U(wa, 2 * i);
            EX_LOAD(wa, PU, (i < 3 ? e0 : e1), (2 * i + 2) * 8);
            EX_U(wb, 2 * i + 1);
        }
        { EX_LOAD(wb, PU, e1, 15 * 8); EX_U(wa, 14); EX_LOAD(wa, PV, e0, 0); EX_U(wb, 15); }
        const float cf0 = gelu_tanh(raw0 * su0) * gs0, cf1 = gelu_tanh(raw1 * su1) * gs1;
        f32x2 acc[16];
#pragma unroll
        for (int i = 0; i < 16; ++i) acc[i] = (f32x2){0.f, 0.f};
#pragma unroll 1
        for (int i = 0; i < 7; ++i) {
            EX_LOAD(wb, PV, (i < 4 ? e0 : e1), (2 * i + 1) * 8);
            EX_V(wa, 2 * i);
            EX_LOAD(wa, PV, (i < 3 ? e0 : e1), (2 * i + 2) * 8);
            EX_V(wb, 2 * i + 1);
        }
        { EX_LOAD(wb, PV, e1, 15 * 8); EX_V(wa, 14); if (tn < T) EX_LOAD(wa, PU, ne0, 0); EX_V(wb, 15); }
        const float* g2 = mod + b * 12288 + 10240;
#pragma unroll
        for (int c = 0; c < 2; ++c)
#pragma unroll
            for (int w4 = 0; w4 < 4; ++w4) { float* op = out + (size_t)t * D + 1024 * c + 16 * lane + 4 * w4; const f32x4 ga = *(const f32x4*)(g2 + 1024 * c + 16 * lane + 4 * w4); f32x4 r0 = *(const f32x4*)op; const int o = 8 * c + 2 * w4;
                r0.x += ga.x * acc[o].x * osc; r0.y += ga.y * acc[o].y * osc; r0.z += ga.z * acc[o + 1].x * osc; r0.w += ga.w * acc[o + 1].y * osc;
                *(f32x4*)op = r0; }
        e0 = ne0; e1 = ne1;
    }
#undef EX_LOAD
#undef EX_U
#undef EX_V
}

constexpr int N_PHASES = 11;
__global__ void __launch_bounds__(NTHREADS, 2) fwd_kernel(Args a) {
    extern __shared__ __attribute__((aligned(16))) unsigned char lds_raw[];
    LAS unsigned char* lds = (LAS unsigned char*)lds_raw;
    const int tid = threadIdx.x;
    volatile LAS unsigned* misc = (volatile LAS unsigned*)(lds + LDS_MISC);
    if (tid < 16) misc[tid] = 0u;
    __syncthreads();
    XcdBarrier bar; bar.bar = (unsigned*)(a.ws + WS_CTL) + 1024; bar.x = 0; bar.st = nullptr;
    const int lo = a.ph_lo, hi = a.ph_hi;
    if (hi - lo > 1) bar = xcd_barrier_post((unsigned*)(a.ws + WS_CTL) + 1024, misc + 8);
#define IN(k) (lo <= (k) && (k) < hi)
#define SEAM(k) do { if (IN(k) && IN((k) + 1)) xcd_barrier(bar); } while (0)
    const int G = gridDim.x, bx = blockIdx.x;

    for (int rep = 0; rep < 1 + ((PROBE_DUP >> 0) & 1); ++rep)
    if (IN(0)) { ph0_mod(a, lds); __syncthreads(); ph0_weights(a, lds); ph0_keyfrags(a); ph0_extra(a); __syncthreads(); }
    SEAM(0);
    for (int rep = 0; rep < 1 + ((PROBE_DUP >> 1) & 1); ++rep)
    if (IN(1)) ph_norm<true>(a, a.in[0], a.in[4], 0, 2048, (bf16*)(a.ws + WS_H), a.ws + WS_H8);
    SEAM(1);
    for (int rep = 0; rep < 1 + ((PROBE_DUP >> 2) & 1); ++rep)
    if (IN(2)) { pg8::Gemm g{(const bf16*)(a.ws + WS_H8), (const bf16*)(a.ws + WS_WIN), T, NPROJ, D / 2}; pg8::StaticOrder So; So.init(T, NPROJ, G, bx);
        EpiProjNorm E{(bf16*)(a.ws + WS_Q), (bf16*)(a.ws + WS_KV), (bf16*)(a.ws + WS_DL), (bf16*)(a.ws + WS_MG), (bf16*)a.out, a.in[6], a.in[7], a.in[11], a.in[12], (LAS float*)(lds + 131072), 1.f / (F8_HS * F8_WS)};
        pg8::gemm_phase<EpiProjNorm, pg8::StaticOrder, pg8::NoMid, true>(lds, g, So, E); }
    SEAM(2);
    if (IN(3)) { for (int rep = 0; rep < 1 + ((PROBE_DUP >> 3) & 1); ++rep) { ph3_vfrag(a); ph3_gates(a); ph3_compress(a, lds); } }
    SEAM(3);
    for (int rep = 0; rep < 1 + ((PROBE_DUP >> 4) & 1); ++rep)
    if (IN(4)) ph4_attention(a, lds);
    SEAM(4);
    for (int rep = 0; rep < 1 + ((PROBE_DUP >> 5) & 1); ++rep)
    if (IN(5)) {
        { pg8::Gemm g{(const bf16*)(a.ws + WS_YN), (const bf16*)(a.ws + WS_WBN), T, D, 1536}; pg8::StaticOrder So; So.init(T, D, G, bx);
          EpiMerge E{(const bf16*)(a.ws + WS_MG), a.ws + WS_H, F8_MS}; MidMerge Mh{(const bf16*)(a.ws + WS_MG)};
          pg8::gemm_phase<EpiMerge, pg8::StaticOrder, MidMerge>(lds, g, So, E, Mh); }
    }
    SEAM(5);
    for (int rep = 0; rep < 1 + ((PROBE_DUP >> 6) & 1); ++rep)
    if (IN(6)) { pg8::Gemm g{(const bf16*)(a.ws + WS_H), (const bf16*)(a.ws + WS_WOUT), T, D, D / 2}; pg8::StaticOrder So; So.init(T, D, G, bx);
        EpiOut E{a.in[0], (const float*)(a.ws + WS_MOD), a.out, 1.f / (F8_MS * F8_WS)}; pg8::gemm_phase<EpiOut, pg8::StaticOrder, pg8::NoMid, true>(lds, g, So, E); }
    SEAM(6);
    for (int rep = 0; rep < 1 + ((PROBE_DUP >> 7) & 1); ++rep)
    if (IN(7)) { ph_norm(a, a.out, a.in[16], 6144, 8192, (bf16*)(a.ws + WS_H)); ph_quant_uv(a); }
    SEAM(7);
    for (int rep = 0; rep < 1 + ((PROBE_DUP >> 8) & 1); ++rep)
    if (IN(8)) { pg8::Gemm g{(const bf16*)(a.ws + WS_H), (const bf16*)(a.ws + WS_WPQ), T, D, D}; pg8::StaticOrder So; So.init(T, D, G, bx);
        EpiF32 E{(float*)(a.ws + WS_QP), D}; pg8::gemm_phase<EpiF32, pg8::StaticOrder>(lds, g, So, E); }
    SEAM(8);
    for (int rep = 0; rep < 1 + ((PROBE_DUP >> 9) & 1); ++rep)
    if (IN(9)) { ph_route(a, lds); __syncthreads(); }
    SEAM(9);
    if (IN(10)) { if ((PROBE_DUP >> 10) & 1) { ph_experts(a, *(const float*)(a.ws + WS_CTL + 64)); asm volatile("s_waitcnt vmcnt(0)" ::: "memory"); __syncthreads(); } ph_experts(a, 1.f); }
#undef IN
#undef SEAM
}

extern "C" void kernel_launch(void* const* d_in, const int* in_sizes, int n_in, void* d_out, int out_size, void* d_ws, size_t ws_size, hipStream_t stream) {
    static int grid = 0;
    if (grid == 0) {
        if (n_in != 23 || out_size != T * D || ws_size < WS_END4) { fprintf(stderr, "kernel_launch: unexpected problem shape (n_in %d, out %d, ws %zu); nothing launched\n", n_in, out_size, ws_size); grid = -1; return; }
        int dev = 0, cus = 0, per_cu = 0;
        if (hipGetDevice(&dev) != hipSuccess || hipDeviceGetAttribute(&cus, hipDeviceAttributeMultiprocessorCount, dev) != hipSuccess) { grid = -1; return; }
        if (hipFuncSetAttribute((const void*)fwd_kernel, hipFuncAttributeMaxDynamicSharedMemorySize, LDS_BYTES) != hipSuccess) { fprintf(stderr, "kernel_launch: hipFuncSetAttribute failed\n"); grid = -1; return; }
        if (hipOccupancyMaxActiveBlocksPerMultiprocessor(&per_cu, (const void*)fwd_kernel, NTHREADS, LDS_BYTES) != hipSuccess || per_cu < 1) { fprintf(stderr, "kernel_launch: occupancy query says %d\n", per_cu); }
        (void)hipGetLastError();
        grid = cus;
    }
    if (grid < 0) return;
    hipMemsetAsync((char*)d_ws + WS_CTL, 0, CTL_ZERO_BYTES, stream);
    Args a{};
    for (int i = 0; i < 23; ++i) a.in[i] = (const float*)d_in[i];
    a.out = (float*)d_out; a.ws = (unsigned char*)d_ws;
#if MK_ONE_LAUNCH
#if PROBE_PREFIX >= 0
    a.ph_lo = 0; a.ph_hi = PROBE_PREFIX + 1;
    hipLaunchKernelGGL(fwd_kernel, dim3(grid), dim3(NTHREADS), LDS_BYTES, stream, a);
    hipMemsetAsync((char*)d_ws + WS_CTL, 0, CTL_ZERO_BYTES, stream);
#endif
    a.ph_lo = 0; a.ph_hi = N_PHASES;
    hipLaunchKernelGGL(fwd_kernel, dim3(grid), dim3(NTHREADS), LDS_BYTES, stream, a);
#else
    for (int p = 0; p < N_PHASES; ++p) { a.ph_lo = p; a.ph_hi = p + 1; hipLaunchKernelGGL(fwd_kernel, dim3(grid), dim3(NTHREADS), LDS_BYTES, stream, a); }
#endif
}
```

```cpp
#include <hip/hip_runtime.h>
#include <cstdio>
#include <cstdint>

#ifndef PROBE_DUP
#define PROBE_DUP 0
#endif
#ifndef PROBE_PREFIX
#define PROBE_PREFIX -1
#endif
#ifndef MK_ONE_LAUNCH
#define MK_ONE_LAUNCH 1
#endif

__device__ __forceinline__ int phase_tid() { int t = threadIdx.x; asm volatile("" : "+v"(t)); return t; }
namespace pg8 {
#define PG8_LAS __attribute__((address_space(3)))
typedef unsigned short bf16_t;
typedef short bf16x8 __attribute__((ext_vector_type(8)));
typedef float f32x4 __attribute__((ext_vector_type(4)));
typedef unsigned u32x4 __attribute__((ext_vector_type(4)));
typedef unsigned u32x2 __attribute__((ext_vector_type(2)));
constexpr int BM = 256, BK = 64, HALF = 128, HTB = HALF * BK * 2, STAGE_BYTES = 8 * HTB, NXCD = 8, WGM = 8;

__host__ __device__ __forceinline__ int lds_byte(int r, int c) { const int st = (r >> 4) * 2 + (c >> 5), rr = r & 15, cc = c & 31, ob = rr * 64 + cc * 2; return st * 1024 + (ob ^ (((ob >> 9) & 1) << 5)); }
__host__ __device__ __forceinline__ void stage_rc(int b, int& R, int& C) { const int st = b / 1024, sb = b % 1024, swz = sb ^ (((sb >> 9) & 1) << 5); R = (st >> 1) * 16 + swz / 64; C = (st & 1) * 32 + (swz % 64) / 2; }
__host__ __device__ __forceinline__ int perm32(int rho) { const int n = rho >> 4, i = rho & 15; return 8 * (i >> 2) + 4 * n + (i & 3); }

struct Unit { int pm, pn; };
struct Gemm { const bf16_t* A; const bf16_t* Bt; int M, N, K; };

struct StaticOrder {
    int nM, nN, nwg, G, c;
    __host__ __device__ void init(int M, int N, int G_, int c_) { nM = M / BM; nN = N / BM; nwg = nM * nN; G = G_; c = c_; }
    __host__ __device__ bool next(int i, Unit& u) const {
        const long L = (long)i * G + c; if (L >= nwg) return false;
        int wgid = (int)L; { const int q = nwg / NXCD, r = nwg % NXCD, xcd = wgid % NXCD, off = wgid / NXCD; wgid = (xcd < r ? xcd * (q + 1) : r * (q + 1) + (xcd - r) * q) + off; }
        const int nig = WGM * nN, gid = wgid / nig, fm = gid * WGM, gsz = (nM - fm) < WGM ? (nM - fm) : WGM;
        u.pm = fm + ((wgid % nig) % gsz); u.pn = (wgid % nig) / gsz; return true;
    }
    __device__ __forceinline__ void a_ready(const Unit&) const {}
    __device__ __forceinline__ void done(const Unit&) const {}
};

__device__ __forceinline__ unsigned cvt_pk_bf16(float lo, float hi) { unsigned r; asm volatile("v_cvt_pk_bf16_f32 %0, %1, %2" : "=v"(r) : "v"(lo), "v"(hi)); return r; }

typedef int i32x4 __attribute__((ext_vector_type(4)));
typedef int i32x8 __attribute__((ext_vector_type(8)));
template <bool F8> __device__ __forceinline__ void mma_blk(f32x4 (&acc)[4][2], const bf16x8 (&At)[4][2], const bf16x8 (&Bt)[2][2]) {
    if constexpr (F8) {
#pragma unroll
        for (int m = 0; m < 4; ++m)
#pragma unroll
            for (int n = 0; n < 2; ++n) {
                const i32x8 bb = __builtin_shufflevector(__builtin_bit_cast(i32x4, Bt[n][0]), __builtin_bit_cast(i32x4, Bt[n][1]), 0, 1, 2, 3, 4, 5, 6, 7);
                const i32x8 aa = __builtin_shufflevector(__builtin_bit_cast(i32x4, At[m][0]), __builtin_bit_cast(i32x4, At[m][1]), 0, 1, 2, 3, 4, 5, 6, 7);
                asm volatile("v_mfma_f32_16x16x128_f8f6f4 %0, %1, %2, %0" : "+v"(acc[m][n]) : "v"(bb), "v"(aa)); }
    } else {
#pragma unroll
        for (int m = 0; m < 4; ++m)
#pragma unroll
            for (int n = 0; n < 2; ++n)
#pragma unroll
                for (int k = 0; k < 2; ++k) acc[m][n] = __builtin_amdgcn_mfma_f32_16x16x32_bf16(Bt[n][k], At[m][k], acc[m][n], 0, 0, 0);
    }
}
struct NoMid { static constexpr int AT = -1; __device__ __forceinline__ void operator()(f32x4 (&)[2][2][4][2], const Unit&, int, int, int, int) const {} };
template <class Epi, class Sched, class Mid = NoMid, bool F8 = false>
__device__ __forceinline__ void gemm_phase(PG8_LAS unsigned char* lds, const Gemm g, const Sched& S, const Epi& E, const Mid& Mh = Mid()) {
    const int tid = phase_tid(), wid = __builtin_amdgcn_readfirstlane(tid >> 6), lane = tid & 63, wr = wid >> 2, wc = wid & 3, fr = lane & 15, fq = lane >> 4;
    const int K = g.K, nt = K / BK;
    unsigned voffA[2], voffB[2];
#pragma unroll
    for (int i = 0; i < 2; ++i) { int R, C; stage_rc(tid * 16 + i * 8192, R, C); const int Rb = Epi::PERM ? ((R & ~31) + perm32(R & 31)) : R;
        voffA[i] = (unsigned)(R * K + C) * 2u; voffB[i] = (unsigned)(Rb * K + C) * 2u; }
    const size_t kstep = (size_t)(BK * 2);
    const size_t hstep = (size_t)HALF * K * 2;
    const size_t tstep = 2 * hstep;
    const unsigned ldsw = (unsigned)wid * 1024u;
    const int aoff = lds_byte(wr * 64 + fr, fq * 8), boff = lds_byte(wc * 32 + fr, fq * 8);
#define PG8_SA(b, h) (((b) * 2 + (h)) * HTB)
#define PG8_SB(b, h) ((4 + (b) * 2 + (h)) * HTB)
#define PG8_STAGE(bufoff, gbase, voff) do { _Pragma("unroll") for (int _i = 0; _i < 2; ++_i) \
        __builtin_amdgcn_global_load_lds((const unsigned*)((const char*)(gbase) + (voff)[_i]), (PG8_LAS unsigned*)(lds + (bufoff) + ldsw + _i * 8192), 16, 0, 0); } while (0)
#define PG8_LDA(dst, b, h) do { _Pragma("unroll") for (int m = 0; m < 4; ++m) _Pragma("unroll") for (int k = 0; k < 2; ++k) dst[m][k] = *(const PG8_LAS bf16x8*)(lds + PG8_SA(b, h) + aoff + m * 2048 + k * 1024); } while (0)
#define PG8_LDB(dst, b, h) do { _Pragma("unroll") for (int n = 0; n < 2; ++n) _Pragma("unroll") for (int k = 0; k < 2; ++k) dst[n][k] = *(const PG8_LAS bf16x8*)(lds + PG8_SB(b, h) + boff + n * 2048 + k * 1024); } while (0)
#define PG8_MMA(ai, bj, At, Bt) do { __builtin_amdgcn_s_setprio(1); if constexpr (F8) { mma_blk<true>(acc[ai][bj], At, Bt); } else { _Pragma("unroll") for (int m = 0; m < 4; ++m) _Pragma("unroll") for (int n = 0; n < 2; ++n) _Pragma("unroll") for (int k = 0; k < 2; ++k) \
        acc[ai][bj][m][n] = __builtin_amdgcn_mfma_f32_16x16x32_bf16(Bt[n][k], At[m][k], acc[ai][bj][m][n], 0, 0, 0); } __builtin_amdgcn_s_setprio(0); } while (0)
#define PG8_WAIT_V(n) asm volatile("s_waitcnt vmcnt(" #n ")" ::: "memory")
#define PG8_WAIT_L(n) asm volatile("s_waitcnt lgkmcnt(" #n ")" ::: "memory")
#define PG8_BAR __builtin_amdgcn_s_barrier()
#define PG8_SCHED __builtin_amdgcn_sched_barrier(0)
    Unit cur, nxt; int ui = 0;
    if (!S.next(0, cur)) return;
    f32x4 acc[2][2][4][2];
#pragma unroll
    for (int a = 0; a < 2; ++a)
#pragma unroll
        for (int b = 0; b < 2; ++b)
#pragma unroll
            for (int m = 0; m < 4; ++m)
#pragma unroll
                for (int n = 0; n < 2; ++n) acc[a][b][m][n] = (f32x4){0.f, 0.f, 0.f, 0.f};
    bf16x8 At[4][2], B0[2][2], B1[2][2];
    const char* cA = (const char*)g.A + (size_t)cur.pm * tstep; const char* cB = (const char*)g.Bt + (size_t)cur.pn * tstep;
    S.a_ready(cur);
    PG8_STAGE(PG8_SB(0, 0), cB, voffB); PG8_STAGE(PG8_SA(0, 0), cA, voffA); PG8_STAGE(PG8_SB(0, 1), cB + hstep, voffB); PG8_STAGE(PG8_SA(0, 1), cA + hstep, voffA);
    if (wr == 1) PG8_BAR;
    PG8_WAIT_V(4); PG8_BAR;
    PG8_STAGE(PG8_SB(1, 0), cB + kstep, voffB); PG8_STAGE(PG8_SA(1, 0), cA + kstep, voffA); PG8_STAGE(PG8_SB(1, 1), cB + hstep + kstep, voffB);
    PG8_WAIT_V(6); PG8_BAR;
    for (;;) {
        const bool has_next = S.next(ui + 1, nxt);
        const char* nA = has_next ? (const char*)g.A + (size_t)nxt.pm * tstep : cA; const char* nB = has_next ? (const char*)g.Bt + (size_t)nxt.pn * tstep : cB;
#define PG8_KBODY \
            const bool last = (t == nt - 2); \
            const char* a1 = cA + (size_t)(t + 1) * kstep; \
            const char* a2 = last ? nA : cA + (size_t)(t + 2) * kstep; const char* b2 = last ? nB : cB + (size_t)(t + 2) * kstep; \
            const char* a3 = a2 + kstep; const char* b3 = b2 + kstep; \
            if (last && has_next) S.a_ready(nxt); \
            PG8_LDB(B0, 0, 0); PG8_SCHED; PG8_LDA(At, 0, 0); PG8_STAGE(PG8_SA(1, 1), a1 + hstep, voffA); \
            PG8_WAIT_L(8); PG8_BAR; PG8_WAIT_L(0); PG8_MMA(0, 0, At, B0); PG8_BAR; PG8_SCHED; \
            PG8_LDB(B1, 0, 1); PG8_STAGE(PG8_SB(0, 0), b2, voffB); \
            PG8_BAR; PG8_WAIT_L(0); PG8_MMA(0, 1, At, B1); PG8_BAR; \
            PG8_LDA(At, 0, 1); PG8_STAGE(PG8_SA(0, 0), a2, voffA); \
            PG8_BAR; PG8_WAIT_L(0); PG8_MMA(1, 0, At, B0); PG8_BAR; PG8_SCHED; \
            PG8_STAGE(PG8_SB(0, 1), b2 + hstep, voffB); \
            PG8_WAIT_V(6); PG8_BAR; PG8_MMA(1, 1, At, B1); PG8_BAR; \
            PG8_LDB(B0, 1, 0); PG8_SCHED; PG8_LDA(At, 1, 0); PG8_STAGE(PG8_SA(0, 1), a2 + hstep, voffA); \
            PG8_WAIT_L(8); PG8_BAR; PG8_WAIT_L(0); PG8_MMA(0, 0, At, B0); PG8_BAR; PG8_SCHED; \
            PG8_LDB(B1, 1, 1); PG8_STAGE(PG8_SB(1, 0), b3, voffB); \
            PG8_BAR; PG8_WAIT_L(0); PG8_MMA(0, 1, At, B1); PG8_BAR; \
            PG8_LDA(At, 1, 1); PG8_STAGE(PG8_SA(1, 0), a3, voffA); \
            PG8_BAR; PG8_WAIT_L(0); PG8_MMA(1, 0, At, B0); PG8_BAR; PG8_SCHED; \
            PG8_STAGE(PG8_SB(1, 1), b3 + hstep, voffB); \
            PG8_WAIT_V(6); PG8_BAR; PG8_MMA(1, 1, At, B1); PG8_BAR;
        if constexpr (Mid::AT >= 0) {
            for (int t = 0; t < Mid::AT; t += 2) { PG8_KBODY }
            if constexpr (F8) asm volatile("s_nop 15\n\ts_nop 15" ::: "memory");
            Mh(acc, cur, wr, wc, fr, fq);
            for (int t = Mid::AT; t < nt; t += 2) { PG8_KBODY }
        } else {
            for (int t = 0; t < nt; t += 2) { PG8_KBODY }
        }
#undef PG8_KBODY
        if constexpr (F8) asm volatile("s_nop 15\n\ts_nop 15" ::: "memory");
        E(acc, cur, wr, wc, fr, fq); S.done(cur);
        if (!has_next) break;
#pragma unroll
        for (int a = 0; a < 2; ++a)
#pragma unroll
            for (int b = 0; b < 2; ++b)
#pragma unroll
                for (int m = 0; m < 4; ++m)
#pragma unroll
                    for (int n = 0; n < 2; ++n) acc[a][b][m][n] = (f32x4){0.f, 0.f, 0.f, 0.f};
        cur = nxt; cA = nA; cB = nB; ++ui;
    }
    PG8_WAIT_V(0);
    if (wr == 0) PG8_BAR;
    PG8_BAR;
#undef PG8_SA
#undef PG8_SB
#undef PG8_STAGE
#undef PG8_LDA
#undef PG8_LDB
#undef PG8_MMA
#undef PG8_WAIT_V
#undef PG8_WAIT_L
#undef PG8_BAR
#undef PG8_SCHED
}
}

#define GAS __attribute__((address_space(1)))
#define LAS __attribute__((address_space(3)))
typedef unsigned short bf16;
typedef float f32x4 __attribute__((ext_vector_type(4)));
typedef unsigned v4u __attribute__((ext_vector_type(4)));
typedef unsigned v2u __attribute__((ext_vector_type(2)));

constexpr int NB = 4, S = 4096, D = 2048, T = NB * S, HD = 128;
constexpr int IN_COLS = 11288, OFF_KV = 1024, OFF_GATE = 2560, OFF_DIL = 2584, OFF_MERGE = 7192;
constexpr int NPROJ = 11264;
constexpr int NQ = 1024, NKV = 1536, NDL = 4608, NMG = 4096;
constexpr int NC = 255, NS = 64;
constexpr int NE = 16384;
constexpr float EPS = 1e-6f;
constexpr float QSCALE = 0.08838834764831845f;
constexpr int NWAVES = 8, NTHREADS = 512;

constexpr size_t MiB = 1u << 20;
constexpr size_t WS_CTL = 0, CTL_ZERO_BYTES = 1 * MiB;
constexpr size_t WS_WIN = 1 * MiB;
constexpr size_t WS_WBN = 45 * MiB;
constexpr size_t WS_WBD = 49 * MiB;
constexpr size_t WS_WOUT = 51 * MiB;
constexpr size_t WS_WPQ = 59 * MiB;
constexpr size_t WS_WGATE = 67 * MiB;
constexpr size_t WS_MOD = 67 * MiB + 256 * 1024;
constexpr size_t WS_SEL = 67 * MiB + 512 * 1024;
constexpr size_t WS_GATES = 68 * MiB;
constexpr size_t WS_KC = 70 * MiB;
constexpr size_t WS_VC = 71 * MiB;
constexpr size_t WS_H = 72 * MiB;
constexpr size_t WS_Q = 136 * MiB;
constexpr size_t WS_KV = 168 * MiB;
constexpr size_t WS_DL = 216 * MiB;
constexpr size_t WS_MG = 360 * MiB;
constexpr size_t WS_YN = 488 * MiB;
constexpr size_t WS_YD = 520 * MiB;
constexpr size_t WS_H8 = WS_YN;
constexpr size_t WS_EI = 536 * MiB;
constexpr size_t WS_EG = 544 * MiB;
constexpr size_t WS_END = 552 * MiB;
constexpr size_t WS_PU = WS_Q;
constexpr size_t WS_PV = WS_Q + 64 * MiB;
constexpr size_t WS_QP = WS_MG;
static_assert(WS_PV + 64 * MiB <= WS_MG, "u/v overlay");

constexpr int LDS_BYTES = 147456;
constexpr int LDS_MISC = 144 * 1024 - 256;

#define XB_TMO      128
#define XB_XCNT(j)  (256  + 64 * (j))
#define XB_XSUB(j)  (1280 + 64 * (j))
#define XB_XGEN(j)  (2304 + 64 * (j))
#define XB_TOP      3328
#define XB_TOPGEN   3392
#define XCD_BAR_WORDS 3456
#define XB_SPIN_CAP (1u << 24)

__device__ __forceinline__ unsigned xb_ld(unsigned* p)              { return __hip_atomic_load(p, __ATOMIC_RELAXED, __HIP_MEMORY_SCOPE_AGENT); }
__device__ __forceinline__ unsigned xb_add(unsigned* p, unsigned v) { return __hip_atomic_fetch_add(p, v, __ATOMIC_RELAXED, __HIP_MEMORY_SCOPE_AGENT); }
__device__ __forceinline__ unsigned xb_xcc_id() { return (unsigned)__builtin_amdgcn_s_getreg((3 << 11) | 20) & 0xFu; }
#define XB_SPIN(cond, bar) do { unsigned _sp = 0; while (cond) { __builtin_amdgcn_s_sleep(1); \
    if ((++_sp & 255u) == 0u) { if (xb_ld(&(bar)[XB_TMO])) break; if (_sp > XB_SPIN_CAP) { atomicAdd(&(bar)[XB_TMO], 1u); break; } } } } while (0)

struct XcdBarrier { unsigned* bar; unsigned x; volatile LAS unsigned* st; };

__device__ __forceinline__ XcdBarrier xcd_barrier_post(unsigned* bar, volatile LAS unsigned* st) {
    XcdBarrier b; b.bar = bar; b.x = xb_xcc_id(); b.st = st;
    if (threadIdx.x == 0) (void)xb_add(&bar[XB_XCNT(b.x)], 1u);
    return b;
}
__device__ __forceinline__ void xcd_barrier_complete(unsigned* bar, unsigned x, unsigned& nloc, unsigned& nx) {
    const unsigned G = gridDim.x * gridDim.y * gridDim.z;
    unsigned sum, cnt, mine, sp = 0u;
    for (;;) {
        sum = 0u; cnt = 0u; mine = 0u;
#pragma unroll
        for (unsigned j = 0; j < 16; ++j) { const unsigned c = xb_ld(&bar[XB_XCNT(j)]); sum += c; cnt += (c > 0u) ? 1u : 0u; mine = (j == x) ? c : mine; }
        if (sum == G) break;
        __builtin_amdgcn_s_sleep(1);
        if ((++sp & 255u) == 0u) { if (xb_ld(&bar[XB_TMO])) break; if (sp > XB_SPIN_CAP) { atomicAdd(&bar[XB_TMO], 1u); break; } }
    }
    nloc = mine > 0u ? mine : 1u; nx = cnt > 0u ? cnt : 1u;
}
__device__ __forceinline__ void xcd_barrier(const XcdBarrier& b) {
    asm volatile("s_waitcnt vmcnt(0)" ::: "memory");
    __syncthreads();
    if (threadIdx.x == 0) {
        unsigned* bar = b.bar;
        __builtin_amdgcn_s_waitcnt(0);
        unsigned nloc = b.st[0], nx = b.st[1];
        if (nloc == 0u) { xcd_barrier_complete(bar, b.x, nloc, nx); b.st[0] = nloc; b.st[1] = nx; }
        const unsigned old = xb_add(&bar[XB_XSUB(b.x)], 1u);
        const unsigned gen = old / nloc;
        if (old + 1u == (gen + 1u) * nloc) {
            __builtin_amdgcn_fence(__ATOMIC_RELEASE, "agent");
            asm volatile("s_waitcnt vmcnt(0)" ::: "memory");
            const unsigned og = xb_add(&bar[XB_TOP], 1u);
            const unsigned tg = og / nx;
            if (og + 1u == (tg + 1u) * nx) xb_add(&bar[XB_TOPGEN], 1u);
            else XB_SPIN(xb_ld(&bar[XB_TOPGEN]) == tg, bar);
            __builtin_amdgcn_fence(__ATOMIC_ACQUIRE, "agent");
            xb_add(&bar[XB_XGEN(b.x)], 1u);
            asm volatile("s_waitcnt vmcnt(0)" ::: "memory");
        } else {
            XB_SPIN(xb_ld(&bar[XB_XGEN(b.x)]) == gen, bar);
            __builtin_amdgcn_fence(__ATOMIC_ACQUIRE, "agent");
            asm volatile("s_waitcnt vmcnt(0)" ::: "memory");
        }
    }
    __syncthreads();
}

__device__ __forceinline__ unsigned f2bf(float f) { unsigned u = __builtin_bit_cast(unsigned, f); return (u + 0x7fffu + ((u >> 16) & 1u)) >> 16; }
__device__ __forceinline__ unsigned pk2(float lo, float hi) { return f2bf(lo) | (f2bf(hi) << 16); }
__device__ __forceinline__ unsigned pk4_f8(float a, float b, float c, float d) {
    a = __builtin_amdgcn_fmed3f(a, -448.f, 448.f); b = __builtin_amdgcn_fmed3f(b, -448.f, 448.f); c = __builtin_amdgcn_fmed3f(c, -448.f, 448.f); d = __builtin_amdgcn_fmed3f(d, -448.f, 448.f);
    int w = 0; w = __builtin_amdgcn_cvt_pk_fp8_f32(a, b, w, false); w = __builtin_amdgcn_cvt_pk_fp8_f32(c, d, w, true); return (unsigned)w; }
constexpr float F8_HS = 8.f, F8_WS = 128.f, F8_MS = 64.f;
__device__ __forceinline__ float bflo(unsigned u) { return __builtin_bit_cast(float, u << 16); }
__device__ __forceinline__ float bfhi(unsigned u) { return __builtin_bit_cast(float, u & 0xffff0000u); }
__device__ __forceinline__ float bf2f(bf16 u) { return __builtin_bit_cast(float, (unsigned)u << 16); }
__device__ __forceinline__ float wave_sum(float v) {
#pragma unroll
    for (int o = 1; o < 64; o <<= 1) v += __shfl_xor(v, o);
    return v;
}
__device__ __forceinline__ float wave_max(float v) {
#pragma unroll
    for (int o = 1; o < 64; o <<= 1) v = fmaxf(v, __shfl_xor(v, o));
    return v;
}
__device__ __forceinline__ float sigmoidf(float x) { return __builtin_amdgcn_rcpf(1.f + __expf(-x)); }
__device__ __forceinline__ float gelu_tanh(float x) { const float u = 0.7978845608028654f * (x + 0.044715f * x * x * x); return 0.5f * x * (1.f + tanhf(u)); }
__device__ __forceinline__ int t5_bucket(int n) {
    if (n < 16) return n;
    int b = 16;
    b += (n >= 22); b += (n >= 30); b += (n >= 40); b += (n >= 54); b += (n >= 73); b += (n >= 99); b += (n >= 134); b += (n >= 182);
    b += (n >= 246); b += (n >= 332); b += (n >= 450); b += (n >= 609); b += (n >= 825); b += (n >= 1117); b += (n >= 1513);
    return b;
}

struct Args {
    const float* in[23];
    float* out; unsigned char* ws;
    int ph_lo, ph_hi;
};

typedef float f32x2v __attribute__((ext_vector_type(2)));
__device__ __forceinline__ void ph0_mod(const Args& a, LAS unsigned char* lds) {
    const int tid = phase_tid(), lane = tid & 63, wave = __builtin_amdgcn_readfirstlane(tid >> 6);
    LAS float* cs = (LAS float*)lds;
    LAS float* red = (LAS float*)(lds + 32768);
    const float* c = a.in[1]; const float* w_ada = a.in[2]; const float* b_ada = a.in[3];
    float* mod = (float*)(a.ws + WS_MOD);
    for (int i = tid; i < 4 * 2048; i += NTHREADS) { const float v = c[i]; cs[i] = v / (1.f + __expf(-v)); }
    __syncthreads();
    for (int u = blockIdx.x; u < 12288 / 128; u += gridDim.x) {
        const int col = u * 128 + 2 * lane;
        float acc[4][2];
#pragma unroll
        for (int b = 0; b < 4; ++b) { acc[b][0] = 0.f; acc[b][1] = 0.f; }
        const float* wp = w_ada + (size_t)(wave * 256) * 12288 + col;
#pragma unroll 1
        for (int k0 = 0; k0 < 256; k0 += 16) {
            f32x2v w[16];
#pragma unroll
            for (int k = 0; k < 16; ++k) w[k] = *(const f32x2v*)(wp + (size_t)(k0 + k) * 12288);
#pragma unroll
            for (int k = 0; k < 16; ++k) { const int kk = wave * 256 + k0 + k;
#pragma unroll
                for (int b = 0; b < 4; ++b) { const float cv = cs[b * 2048 + kk]; acc[b][0] += cv * w[k].x; acc[b][1] += cv * w[k].y; } }
        }
#pragma unroll
        for (int b = 0; b < 4; ++b) { red[(wave * 4 + b) * 128 + 2 * lane] = acc[b][0]; red[(wave * 4 + b) * 128 + 2 * lane + 1] = acc[b][1]; }
        __syncthreads();
        { const int b = tid >> 7, cc = tid & 127; float s = 0.f;
#pragma unroll
          for (int w = 0; w < 8; ++w) s += red[(w * 4 + b) * 128 + cc];
          mod[b * 12288 + u * 128 + cc] = s + b_ada[u * 128 + cc]; }
        __syncthreads();
    }
}
__device__ __forceinline__ void transpose_item(const float* W, int ldw, int ncols, int K, bf16* WT, int row_off, LAS float* scr, int item, int lane, int ldt = 0) {
    if (ldt == 0) ldt = K;
    const int nblk = ncols / 32, kb = item / nblk, nb = item % nblk, k0 = 64 * kb, n0 = 32 * nb;
    float tv[32];
#pragma unroll
    for (int i = 0; i < 32; ++i) tv[i] = W[(size_t)(k0 + 2 * i + (lane >> 5)) * ldw + n0 + (lane & 31)];
#pragma unroll
    for (int i = 0; i < 32; ++i) scr[(2 * i + (lane >> 5)) * 33 + (lane & 31)] = tv[i];
    asm volatile("s_waitcnt lgkmcnt(0)" ::: "memory");
    const int c = lane & 7;
#pragma unroll
    for (int j = 0; j < 4; ++j) { const int n = (lane >> 3) + 8 * j; const LAS float* s = scr + (8 * c) * 33 + n;
        v4u o; o.x = pk2(s[0 * 33], s[1 * 33]); o.y = pk2(s[2 * 33], s[3 * 33]); o.z = pk2(s[4 * 33], s[5 * 33]); o.w = pk2(s[6 * 33], s[7 * 33]);
        *(v4u*)(WT + (size_t)(row_off + n0 + n) * ldt + k0 + 8 * c) = o; }
    asm volatile("s_waitcnt lgkmcnt(0)" ::: "memory");
}
__device__ __forceinline__ void transpose_item_f8(const float* W, int ldw, int ncols, int K, unsigned char* WT, int row_off, LAS float* scr, int item, int lane) {
    const int nblk = ncols / 32, kb = item / nblk, nb = item % nblk, k0 = 64 * kb, n0 = 32 * nb;
    float tv[32];
#pragma unroll
    for (int i = 0; i < 32; ++i) tv[i] = W[(size_t)(k0 + 2 * i + (lane >> 5)) * ldw + n0 + (lane & 31)];
#pragma unroll
    for (int i = 0; i < 32; ++i) scr[(2 * i + (lane >> 5)) * 33 + (lane & 31)] = tv[i] * F8_WS;
    asm volatile("s_waitcnt lgkmcnt(0)" ::: "memory");
    const int c = lane & 7;
#pragma unroll
    for (int j = 0; j < 4; ++j) { const int n = (lane >> 3) + 8 * j; const LAS float* s = scr + (8 * c) * 33 + n;
        v2u o; o.x = pk4_f8(s[0 * 33], s[1 * 33], s[2 * 33], s[3 * 33]); o.y = pk4_f8(s[4 * 33], s[5 * 33], s[6 * 33], s[7 * 33]);
        *(v2u*)(WT + (size_t)(row_off + n0 + n) * K + k0 + 8 * c) = o; }
    asm volatile("s_waitcnt lgkmcnt(0)" ::: "memory");
}
__device__ __forceinline__ void ph0_weights(const Args& a, LAS unsigned char* lds) {
    const int tid = phase_tid(), lane = tid & 63, wave = __builtin_amdgcn_readfirstlane(tid >> 6);
    LAS float* scr = (LAS float*)(lds + wave * 16384);
    const int gw = blockIdx.x * NWAVES + wave, NGW = gridDim.x * NWAVES;
    const float* w_in = a.in[5];
    unsigned char* WIN = a.ws + WS_WIN;
    constexpr int I_Q = 32 * (NQ / 32), I_KV = 32 * (NKV / 32), I_DL = 32 * (NDL / 32), I_MG = 32 * (NMG / 32);
    constexpr int I_BN = 16 * 64, I_BD = 8 * 64, I_O = 32 * 64, I_PQ = 32 * 64;
    constexpr int NITEMS = I_Q + I_KV + I_DL + I_MG + I_BN + I_BD + I_O + I_PQ;
    for (int it = gw; it < NITEMS; it += NGW) {
        int r = it;
        if (r < I_Q)  { transpose_item_f8(w_in, IN_COLS, NQ, D, WIN, 0, scr, r, lane); continue; } r -= I_Q;
        if (r < I_KV) { transpose_item_f8(w_in + OFF_KV, IN_COLS, NKV, D, WIN, NQ, scr, r, lane); continue; } r -= I_KV;
        if (r < I_DL) { transpose_item_f8(w_in + OFF_DIL, IN_COLS, NDL, D, WIN, NQ + NKV, scr, r, lane); continue; } r -= I_DL;
        if (r < I_MG) { transpose_item_f8(w_in + OFF_MERGE, IN_COLS, NMG, D, WIN, NQ + NKV + NDL, scr, r, lane); continue; } r -= I_MG;
        if (r < I_BN) { transpose_item(a.in[13], D, D, 1024, (bf16*)(a.ws + WS_WBN), 0, scr, r, lane, 1536); continue; } r -= I_BN;
        if (r < I_BD) { transpose_item(a.in[14], D, D, 512, (bf16*)(a.ws + WS_WBN) + 1024, 0, scr, r, lane, 1536); continue; } r -= I_BD;
        if (r < I_O)  { transpose_item_f8(a.in[15], D, D, D, a.ws + WS_WOUT, 0, scr, r, lane); continue; } r -= I_O;
        transpose_item(a.in[17], D, D, D, (bf16*)(a.ws + WS_WPQ), 0, scr, r, lane);
    }
}

constexpr size_t WS_CW1F = 602 * MiB;
constexpr size_t WS_WGF = 604 * MiB;
constexpr size_t WS_CBP = 604 * MiB + 256 * 1024;
constexpr size_t WS_END4 = 605 * MiB;
__device__ __forceinline__ void ph0_extra(const Args& a) {
    const int tid = phase_tid(), lane = tid & 63, wave = __builtin_amdgcn_readfirstlane(tid >> 6);
    const float* w1 = a.in[9]; const float* pos = a.in[8]; const float* w_in = a.in[5];
    v4u* CW = (v4u*)(a.ws + WS_CW1F); v4u* WG = (v4u*)(a.ws + WS_WGF); float* CBP = (float*)(a.ws + WS_CBP);
    for (int i = blockIdx.x * NTHREADS + tid; i < 2 * 4 * 256 * 64; i += gridDim.x * NTHREADS) {
        const int ln = i & 63, ks = (i >> 6) & 255, nt = (i >> 14) & 3, j = i >> 16;
        const float* src = w1 + ((size_t)j * 4096 + 16 * ks + 8 * (ln >> 5)) * 128 + 32 * nt + (ln & 31);
        v4u o; o.x = pk2(src[0], src[128]); o.y = pk2(src[256], src[384]); o.z = pk2(src[512], src[640]); o.w = pk2(src[768], src[896]);
        CW[i] = o;
    }
    for (int i = blockIdx.x * NTHREADS + tid; i < 128 * 64; i += gridDim.x * NTHREADS) {
        const int ln = i & 63, ks = i >> 6, jrow = ln & 31;
        v4u o = {0u, 0u, 0u, 0u};
        if (jrow < 24) { const float* src = w_in + (size_t)(16 * ks + 8 * (ln >> 5)) * IN_COLS + OFF_GATE + jrow;
            o.x = pk2(src[0], src[IN_COLS]); o.y = pk2(src[2 * (size_t)IN_COLS], src[3 * (size_t)IN_COLS]); o.z = pk2(src[4 * (size_t)IN_COLS], src[5 * (size_t)IN_COLS]); o.w = pk2(src[6 * (size_t)IN_COLS], src[7 * (size_t)IN_COLS]); }
        WG[i] = o;
    }
    { const int gw = blockIdx.x * NWAVES + wave;
      if (gw < 128) { const int kc = gw >> 1, j = gw & 1; float s0 = 0.f, s1 = 0.f; const float* wp = w1 + ((size_t)j * 4096 + 64 * kc) * 128 + lane; const float* pp = pos + j * 4096 + 64 * kc;
#pragma unroll 1
          for (int k0 = 0; k0 < 64; k0 += 16) { float wa[16], wb[16];
#pragma unroll
              for (int k = 0; k < 16; ++k) { wa[k] = wp[(k0 + k) * 128]; wb[k] = wp[(k0 + k) * 128 + 64]; }
#pragma unroll
              for (int k = 0; k < 16; ++k) { const float pv = pp[k0 + k]; s0 += pv * wa[k]; s1 += pv * wb[k]; } }
          CBP[(kc * 2 + j) * 128 + lane] = s0; CBP[(kc * 2 + j) * 128 + 64 + lane] = s1; } }
}

template <bool F8 = false>
__device__ __forceinline__ void ph_norm(const Args& a, const float* xin, const float* gvec, int sh_off, int sc_off, bf16* hout, unsigned char* h8 = nullptr) {
    const int tid = phase_tid(), lane = tid & 63, wave = __builtin_amdgcn_readfirstlane(tid >> 6);
    const int gw = blockIdx.x * NWAVES + wave, NGW = gridDim.x * NWAVES;
    const float* mod = (const float*)(a.ws + WS_MOD);
    for (int r = gw; r < S / 2; r += NGW)
#pragma unroll 1
        for (int bq = 0; bq < NB; ++bq) {
            const int m0 = bq * S + r, m1 = m0 + S / 2;
            const float* x0 = xin + (size_t)m0 * D + 8 * lane; const float* x1 = xin + (size_t)m1 * D + 8 * lane;
            f32x4 v0[8], v1[8];
#pragma unroll
            for (int c = 0; c < 4; ++c) { v0[2 * c] = *(const f32x4*)(x0 + 512 * c); v0[2 * c + 1] = *(const f32x4*)(x0 + 512 * c + 4); v1[2 * c] = *(const f32x4*)(x1 + 512 * c); v1[2 * c + 1] = *(const f32x4*)(x1 + 512 * c + 4); }
            float s0 = 0.f, s1 = 0.f;
#pragma unroll
            for (int i = 0; i < 8; ++i) { s0 += (v0[i].x * v0[i].x + v0[i].y * v0[i].y) + (v0[i].z * v0[i].z + v0[i].w * v0[i].w); s1 += (v1[i].x * v1[i].x + v1[i].y * v1[i].y) + (v1[i].z * v1[i].z + v1[i].w * v1[i].w); }
            const float r0 = rsqrtf(wave_sum(s0) * (1.f / D) + EPS), r1 = rsqrtf(wave_sum(s1) * (1.f / D) + EPS);
            const float* shp = mod + bq * 12288 + sh_off + 8 * lane; const float* scp = mod + bq * 12288 + sc_off + 8 * lane; const float* gp = gvec + 8 * lane;
#pragma unroll
            for (int c = 0; c < 4; ++c) {
                v4u o0, o1; unsigned w0[4], w1[4]; [[maybe_unused]] unsigned q0[2], q1[2];
#pragma unroll
                for (int hq = 0; hq < 2; ++hq) { const f32x4 g = *(const f32x4*)(gp + 512 * c + 4 * hq), sc = *(const f32x4*)(scp + 512 * c + 4 * hq), sh = *(const f32x4*)(shp + 512 * c + 4 * hq);
                    const f32x4 ga = g * (1.f + sc); const f32x4 y0 = v0[2 * c + hq] * r0 * ga + sh, y1 = v1[2 * c + hq] * r1 * ga + sh;
                    w0[2 * hq] = pk2(y0.x, y0.y); w0[2 * hq + 1] = pk2(y0.z, y0.w); w1[2 * hq] = pk2(y1.x, y1.y); w1[2 * hq + 1] = pk2(y1.z, y1.w);
                    if constexpr (F8) { q0[hq] = pk4_f8(y0.x * F8_HS, y0.y * F8_HS, y0.z * F8_HS, y0.w * F8_HS); q1[hq] = pk4_f8(y1.x * F8_HS, y1.y * F8_HS, y1.z * F8_HS, y1.w * F8_HS); } }
                o0.x = w0[0]; o0.y = w0[1]; o0.z = w0[2]; o0.w = w0[3]; o1.x = w1[0]; o1.y = w1[1]; o1.z = w1[2]; o1.w = w1[3];
                *(v4u*)(hout + (size_t)m0 * D + 512 * c + 8 * lane) = o0; *(v4u*)(hout + (size_t)m1 * D + 512 * c + 8 * lane) = o1;
                if constexpr (F8) { v2u p0, p1; p0.x = q0[0]; p0.y = q0[1]; p1.x = q1[0]; p1.y = q1[1];
                    *(v2u*)(h8 + (size_t)m0 * D + 512 * c + 8 * lane) = p0; *(v2u*)(h8 + (size_t)m1 * D + 512 * c + 8 * lane) = p1; }
            }
        }
}

using pg8::Unit; using pg8::HALF; using pg8::BM;
struct EpiProj {
    static constexpr bool PERM = true;
    bf16 *q, *kv, *dl, *mg;
    __device__ __forceinline__ void operator()(const f32x4 (&acc)[2][2][4][2], const Unit& u, int wr, int wc, int fr, int fq) const {
        bf16* base; int ldc, colt = u.pn * BM;
        if (colt < NQ) { base = q; ldc = NQ; } else if (colt < NQ + NKV) { base = kv; ldc = NKV; colt -= NQ; } else if (colt < NQ + NKV + NDL) { base = dl; ldc = NDL; colt -= NQ + NKV; } else { base = mg; ldc = NMG; colt -= NQ + NKV + NDL; }
        const int row0 = u.pm * BM + wr * 64 + fr, col0 = colt + wc * 32 + 8 * fq;
#pragma unroll
        for (int ai = 0; ai < 2; ++ai)
#pragma unroll
            for (int m = 0; m < 4; ++m) { bf16* rowp = base + (size_t)(row0 + ai * HALF + m * 16) * ldc + col0;
#pragma unroll
                for (int bj = 0; bj < 2; ++bj) { const f32x4 v0 = acc[ai][bj][m][0], v1 = acc[ai][bj][m][1];
                    v4u w; w.x = pg8::cvt_pk_bf16(v0[0], v0[1]); w.y = pg8::cvt_pk_bf16(v0[2], v0[3]); w.z = pg8::cvt_pk_bf16(v1[0], v1[1]); w.w = pg8::cvt_pk_bf16(v1[2], v1[3]);
                    *(v4u*)(rowp + bj * HALF) = w; } }
    }
};
struct MidMerge {
    static constexpr int AT = 16;
    const bf16* mg;
    __device__ __forceinline__ void operator()(f32x4 (&acc)[2][2][4][2], const Unit& u, int wr, int wc, int fr, int fq) const {
        int lo = (fq * 16 + fr) * 8;
        asm volatile("" : "+v"(lo));
        const bf16* t1 = mg + (((size_t)(u.pm * 16 + u.pn) * 8 + (wr * 4 + wc)) << 13) + lo; const bf16* t2 = t1 + ((size_t)8 << 16);
#pragma unroll
        for (int ai = 0; ai < 2; ++ai) {
            v4u a1[4][2], a2[4][2];
#pragma unroll
            for (int m = 0; m < 4; ++m)
#pragma unroll
                for (int bj = 0; bj < 2; ++bj) { a1[m][bj] = *(const v4u*)(t1 + ((ai * 4 + m) * 2 + bj) * 512); a2[m][bj] = *(const v4u*)(t2 + ((ai * 4 + m) * 2 + bj) * 512); }
#pragma unroll
            for (int m = 0; m < 4; ++m)
#pragma unroll
                for (int bj = 0; bj < 2; ++bj) { const unsigned w1[4] = {a1[m][bj].x, a1[m][bj].y, a1[m][bj].z, a1[m][bj].w}, w2[4] = {a2[m][bj].x, a2[m][bj].y, a2[m][bj].z, a2[m][bj].w};
#pragma unroll
                    for (int q = 0; q < 4; ++q) { const float r0 = (1.f + __expf(-bflo(w2[q]))) * __builtin_amdgcn_rcpf(1.f + __expf(-bflo(w1[q]))), r1 = (1.f + __expf(-bfhi(w2[q]))) * __builtin_amdgcn_rcpf(1.f + __expf(-bfhi(w1[q])));
                        acc[ai][bj][m][q >> 1][2 * (q & 1)] *= r0; acc[ai][bj][m][q >> 1][2 * (q & 1) + 1] *= r1; } }
            asm volatile("" ::: "memory");
        }
    }
};
struct EpiMerge {
    static constexpr bool PERM = true;
    const bf16* mg; unsigned char* merged8; float os;
    __device__ __forceinline__ void operator()(const f32x4 (&acc)[2][2][4][2], const Unit& u, int wr, int wc, int fr, int fq) const {
        int row0 = u.pm * BM + wr * 64 + fr; const int col0 = u.pn * BM + wc * 32 + 8 * fq;
        asm volatile("" : "+v"(row0));
        const bf16* t2 = mg + (((size_t)(u.pm * 16 + 8 + u.pn) * 8 + (wr * 4 + wc)) << 13) + (fq * 16 + fr) * 8;
        v4u a2[2][4][2];
#pragma unroll
        for (int ai = 0; ai < 2; ++ai)
#pragma unroll
            for (int m = 0; m < 4; ++m)
#pragma unroll
                for (int bj = 0; bj < 2; ++bj) a2[ai][m][bj] = *(const v4u*)(t2 + ((ai * 4 + m) * 2 + bj) * 512);
#pragma unroll
        for (int ai = 0; ai < 2; ++ai)
#pragma unroll
            for (int m = 0; m < 4; ++m) { const size_t row = (size_t)(row0 + ai * HALF + m * 16);
#pragma unroll
                for (int bj = 0; bj < 2; ++bj) { const unsigned w2[4] = {a2[ai][m][bj].x, a2[ai][m][bj].y, a2[ai][m][bj].z, a2[ai][m][bj].w};
                    const f32x4 v0 = acc[ai][bj][m][0] * os, v1 = acc[ai][bj][m][1] * os;
                    v2u w; w.x = pk4_f8(v0[0] * sigmoidf(bflo(w2[0])), v0[1] * sigmoidf(bfhi(w2[0])), v0[2] * sigmoidf(bflo(w2[1])), v0[3] * sigmoidf(bfhi(w2[1])));
                    w.y = pk4_f8(v1[0] * sigmoidf(bflo(w2[2])), v1[1] * sigmoidf(bfhi(w2[2])), v1[2] * sigmoidf(bflo(w2[3])), v1[3] * sigmoidf(bfhi(w2[3])));
                    *(v2u*)(merged8 + row * D + col0 + bj * HALF) = w; } }
    }
};
struct EpiOut {
    static constexpr bool PERM = false;
    const float* x; const float* mod; float* x1; float as;
    __device__ __forceinline__ void operator()(const f32x4 (&acc)[2][2][4][2], const Unit& u, int wr, int wc, int fr, int fq) const {
        const int row0 = u.pm * BM + wr * 64 + fr, col0 = u.pn * BM + wc * 32 + 4 * fq;
        const int b = (u.pm * BM) / S;
        f32x4 gv[2][2];
#pragma unroll
        for (int bj = 0; bj < 2; ++bj)
#pragma unroll
            for (int n = 0; n < 2; ++n) gv[bj][n] = *(const f32x4*)(mod + b * 12288 + 4096 + col0 + bj * HALF + n * 16) * as;
#pragma unroll
        for (int ai = 0; ai < 2; ++ai)
#pragma unroll
            for (int m = 0; m < 4; ++m) { const size_t off = (size_t)(row0 + ai * HALF + m * 16) * D + col0;
#pragma unroll
                for (int bj = 0; bj < 2; ++bj)
#pragma unroll
                    for (int n = 0; n < 2; ++n) *(f32x4*)(x1 + off + bj * HALF + n * 16) = *(const f32x4*)(x + off + bj * HALF + n * 16) + gv[bj][n] * acc[ai][bj][m][n]; }
    }
};
struct EpiF32 {
    static constexpr bool PERM = false;
    float* C; int ldc;
    __device__ __forceinline__ void operator()(const f32x4 (&acc)[2][2][4][2], const Unit& u, int wr, int wc, int fr, int fq) const {
        const int row0 = u.pm * BM + wr * 64 + fr, col0 = u.pn * BM + wc * 32 + 4 * fq;
#pragma unroll
        for (int ai = 0; ai < 2; ++ai)
#pragma unroll
            for (int m = 0; m < 4; ++m) { float* rowp = C + (size_t)(row0 + ai * HALF + m * 16) * ldc + col0;
#pragma unroll
                for (int bj = 0; bj < 2; ++bj)
#pragma unroll
                    for (int n = 0; n < 2; ++n) *(f32x4*)(rowp + bj * HALF + n * 16) = acc[ai][bj][m][n]; }
    }
};

typedef short bf16x8 __attribute__((ext_vector_type(8)));
typedef float f32x16 __attribute__((ext_vector_type(16)));
typedef float f32x2 __attribute__((ext_vector_type(2)));
typedef __bf16 bf2v __attribute__((ext_vector_type(2)));
constexpr float LOG2E = 1.4426950408889634f;
constexpr float QS2 = QSCALE * LOG2E;
constexpr float NEGB = -1e30f;
__device__ __forceinline__ unsigned pkbf(float a, float b) { const f32x2 v = {a, b}; const bf2v r = __builtin_convertvector(v, bf2v); return __builtin_bit_cast(unsigned, r); }
__device__ __forceinline__ float ex2(float x) { return __builtin_amdgcn_exp2f(x); }
__device__ __forceinline__ int swap23(int x) { return (x & ~12) | ((x & 4) << 1) | ((x & 8) >> 1); }
__device__ __forceinline__ size_t kf_off(int key, int d) { return ((size_t)((key >> 5) * 8 + (d >> 4)) * 64 + ((d >> 3) & 1) * 32 + swap23(key & 31)) * 8 + (d & 7); }
__device__ __forceinline__ size_t vf_off(int key, int d) { const int kk = key & 31; return ((size_t)(((key >> 5) * 4 + (d >> 5)) * 2 + (kk >> 4)) * 64 + ((kk >> 3) & 1) * 32 + (d & 31)) * 8 + (kk & 7); }
__device__ __forceinline__ size_t kf8_off(int key, int d) { return ((size_t)((key >> 5) * 4 + (d >> 5)) * 64 + ((d >> 3) & 1) * 32 + swap23(key & 31)) * 16 + ((d >> 4) & 1) * 8 + (d & 7); }
__device__ __forceinline__ size_t vf8_off(int key, int d) { const int kk = key & 31; return ((size_t)((key >> 5) * 4 + (d >> 5)) * 64 + ((kk >> 3) & 1) * 32 + (d & 31)) * 16 + (kk >> 4) * 8 + (kk & 7); }
__device__ __forceinline__ unsigned char* fr8_nsa(const Args& a, int bg, int kind) { return (unsigned char*)a.out + ((size_t)(bg * 4 + kind) << 19); }
__device__ __forceinline__ unsigned char* fr8_dil(const Args& a, int b, int head, int kv) { return (unsigned char*)a.out + ((size_t)16 << 20) + ((size_t)((b * 12 + head) * 2 + kv) << 19); }
__device__ __forceinline__ bf16* fr_nsa(const Args& a, int bg, int kind) { return (bf16*)a.out + ((size_t)(bg * 4 + kind) << 19); }
__device__ __forceinline__ bf16* fr_dil(const Args& a, int b, int head, int kv) { return (bf16*)a.out + ((size_t)16 << 20) + ((size_t)((b * 12 + head) * 2 + kv) << 19); }
constexpr size_t WS_OD = 552 * MiB;
constexpr size_t WS_LSE = 600 * MiB;
constexpr size_t WS_END2 = 601 * MiB;

struct EpiProjNorm {
    static constexpr bool PERM = true;
    bf16 *q, *kv, *dl, *mg, *frg;
    const float *qg, *kg, *dqg, *dkg;
    LAS float* xch;
    float as;
    __device__ __forceinline__ void operator()(const f32x4 (&acc)[2][2][4][2], const Unit& u, int wr, int wc, int fr, int fq) const {
        bf16* base; int ldc, colt = u.pn * BM, mode = 0  , hsel = 0; const float* gain = qg; float scale = 1.f;
        if (colt < NQ) { base = q; ldc = NQ; mode = 1; gain = qg; scale = QS2; }
        else if (colt < NQ + NKV) { base = kv; ldc = NKV; colt -= NQ; hsel = colt >> 7; if (hsel == 4 || hsel == 8) { mode = 2; gain = kg + (hsel == 4 ? 128 : 256); } }
        else if (colt < NQ + NKV + NDL) { base = dl; ldc = NDL; colt -= NQ + NKV; hsel = colt >> 7; if (hsel < 12) { mode = 1; gain = dqg; scale = QS2; } else if (hsel < 24) { mode = 3; gain = dkg; } }
        else { base = mg; ldc = NMG; colt -= NQ + NKV + NDL; }
        const int row0 = u.pm * BM + wr * 64 + fr, col0 = colt + wc * 32 + 8 * fq;
        if (base == mg) {
            bf16* tp = mg + (((size_t)(u.pm * 16 + (colt >> 8)) * 8 + (wr * 4 + wc)) << 13) + (fq * 16 + fr) * 8;
#pragma unroll
            for (int ai = 0; ai < 2; ++ai)
#pragma unroll
                for (int m = 0; m < 4; ++m)
#pragma unroll
                    for (int bj = 0; bj < 2; ++bj) { const f32x4 v0 = acc[ai][bj][m][0] * as, v1 = acc[ai][bj][m][1] * as;
                        v4u w; w.x = pg8::cvt_pk_bf16(v0[0], v0[1]); w.y = pg8::cvt_pk_bf16(v0[2], v0[3]); w.z = pg8::cvt_pk_bf16(v1[0], v1[1]); w.w = pg8::cvt_pk_bf16(v1[2], v1[3]);
                        *(v4u*)(tp + ((ai * 4 + m) * 2 + bj) * 512) = w; }
            return;
        }
        if (mode == 0) {
#pragma unroll
            for (int ai = 0; ai < 2; ++ai)
#pragma unroll
                for (int m = 0; m < 4; ++m) { bf16* rowp = base + (size_t)(row0 + ai * HALF + m * 16) * ldc + col0;
#pragma unroll
                    for (int bj = 0; bj < 2; ++bj) { const f32x4 v0 = acc[ai][bj][m][0] * as, v1 = acc[ai][bj][m][1] * as;
                        v4u w; w.x = pg8::cvt_pk_bf16(v0[0], v0[1]); w.y = pg8::cvt_pk_bf16(v0[2], v0[3]); w.z = pg8::cvt_pk_bf16(v1[0], v1[1]); w.w = pg8::cvt_pk_bf16(v1[2], v1[3]);
                        *(v4u*)(rowp + bj * HALF) = w; } }
            return;
        }
#pragma unroll
        for (int ai = 0; ai < 2; ++ai)
#pragma unroll
            for (int m = 0; m < 4; ++m)
#pragma unroll
                for (int bj = 0; bj < 2; ++bj) { const f32x4 v0 = acc[ai][bj][m][0], v1 = acc[ai][bj][m][1];
                    float ss = (v0[0] * v0[0] + v0[1] * v0[1]) + (v0[2] * v0[2] + v0[3] * v0[3]) + (v1[0] * v1[0] + v1[1] * v1[1]) + (v1[2] * v1[2] + v1[3] * v1[3]);
                    ss += __shfl_xor(ss, 16); ss += __shfl_xor(ss, 32);
                    if (fq == 0) xch[(((((wr * 2 + ai) * 4 + m) * 16 + fr) * 2 + bj) << 2) + wc] = ss; }
        asm volatile("s_waitcnt lgkmcnt(0)" ::: "memory");
        __builtin_amdgcn_s_barrier();
        asm volatile("" ::: "memory");
        const f32x4 ga = *(const f32x4*)(gain + wc * 32 + 8 * fq), gb = *(const f32x4*)(gain + wc * 32 + 8 * fq + 4);
#pragma unroll
        for (int ai = 0; ai < 2; ++ai)
#pragma unroll
            for (int m = 0; m < 4; ++m) { const int t = row0 + ai * HALF + m * 16, b = t / S, s = t % S;
#pragma unroll
                for (int bj = 0; bj < 2; ++bj) { const f32x4 pp = *(const LAS f32x4*)(xch + (((((wr * 2 + ai) * 4 + m) * 16 + fr) * 2 + bj) << 2));
                    const float rstd = rsqrtf(((pp.x + pp.y) + (pp.z + pp.w)) * (as * as * (1.f / 128.f)) + EPS) * (scale * as);
                    const f32x4 v0 = acc[ai][bj][m][0] * rstd * ga, v1 = acc[ai][bj][m][1] * rstd * gb;
                    if (mode == 1) { v4u w; w.x = pg8::cvt_pk_bf16(v0[0], v0[1]); w.y = pg8::cvt_pk_bf16(v0[2], v0[3]); w.z = pg8::cvt_pk_bf16(v1[0], v1[1]); w.w = pg8::cvt_pk_bf16(v1[2], v1[3]);
                        *(v4u*)(base + (size_t)t * ldc + col0 + bj * HALF) = w; }
                    else { v2u w; w.x = pk4_f8(v0[0], v0[1], v0[2], v0[3]); w.y = pk4_f8(v1[0], v1[1], v1[2], v1[3]);
                        unsigned char* dst;
                        if (mode == 2) dst = (unsigned char*)frg + ((size_t)((b * 2 + bj) * 4 + (hsel == 4 ? 0 : 2)) << 19) + kf8_off(s, wc * 32 + 8 * fq);
                        else { const int head = hsel - 12 + bj, dsh = 2 * (head >> 2), vk = ((s & ((1 << dsh) - 1)) << (12 - dsh)) + (s >> dsh);
                            dst = (unsigned char*)frg + ((size_t)16 << 20) + ((size_t)((b * 12 + head) * 2) << 19) + kf8_off(vk, wc * 32 + 8 * fq); }
                        *(v2u*)dst = w; } } }
    }
};

__device__ __forceinline__ v4u norm_chunk16v(v4u w, const float* gain, float scale, int li) {
    float v[8] = {bflo(w.x), bfhi(w.x), bflo(w.y), bfhi(w.y), bflo(w.z), bfhi(w.z), bflo(w.w), bfhi(w.w)};
    float ss = 0.f;
#pragma unroll
    for (int j = 0; j < 8; ++j) ss += v[j] * v[j];
    ss += __shfl_xor(ss, 1); ss += __shfl_xor(ss, 2); ss += __shfl_xor(ss, 4); ss += __shfl_xor(ss, 8);
    const float rstd = rsqrtf(ss * (1.f / 128.f) + EPS) * scale;
#pragma unroll
    for (int j = 0; j < 8; ++j) v[j] = v[j] * rstd * gain[8 * li + j];
    w.x = pk2(v[0], v[1]); w.y = pk2(v[2], v[3]); w.z = pk2(v[4], v[5]); w.w = pk2(v[6], v[7]);
    return w;
}
__device__ __forceinline__ void ph3_headnorm(const Args& a) {
    const int tid = phase_tid(), lane = tid & 63, wave = __builtin_amdgcn_readfirstlane(tid >> 6), sub = lane >> 4, li = lane & 15;
    const int gw = blockIdx.x * NWAVES + wave, NGW = gridDim.x * NWAVES;
    bf16* Q = (bf16*)(a.ws + WS_Q); const bf16* KV = (const bf16*)(a.ws + WS_KV); bf16* DL = (bf16*)(a.ws + WS_DL);
    const float* qg = a.in[6]; const float* kg = a.in[7]; const float* dqg = a.in[11]; const float* dkg = a.in[12];
    for (int m = gw; m < T; m += NGW) {
        const int b = m / S, s = m % S;
        const int g = sub & 1, win = sub >> 1;
        v4u wq[2], wk, wd[6];
#pragma unroll
        for (int it = 0; it < 2; ++it) wq[it] = *(const v4u*)(Q + (size_t)m * NQ + (it * 4 + sub) * 128 + 8 * li);
        wk = *(const v4u*)(KV + (size_t)m * NKV + ((win ? 8 : 4) + g) * 128 + 8 * li);
#pragma unroll
        for (int it = 0; it < 6; ++it) wd[it] = *(const v4u*)(DL + (size_t)m * NDL + (it * 4 + sub) * 128 + 8 * li);
#pragma unroll
        for (int it = 0; it < 2; ++it) *(v4u*)(Q + (size_t)m * NQ + (it * 4 + sub) * 128 + 8 * li) = norm_chunk16v(wq[it], qg, QS2, li);
        *(v4u*)(fr_nsa(a, b * 2 + g, win ? 2 : 0) + kf_off(s, 8 * li)) = norm_chunk16v(wk, kg + (win ? 256 : 128), 1.f, li);
#pragma unroll
        for (int it = 0; it < 6; ++it) { const int ch = it * 4 + sub;
            if (ch < 12) *(v4u*)(DL + (size_t)m * NDL + ch * 128 + 8 * li) = norm_chunk16v(wd[it], dqg, QS2, li);
            else { const int head = ch - 12, gi = head >> 2, dsh = 2 * gi  , vk = ((s & ((1 << dsh) - 1)) << (12 - dsh)) + (s >> dsh);
                *(v4u*)(fr_dil(a, b, head, 0) + kf_off(vk, 8 * li)) = norm_chunk16v(wd[it], dkg, 1.f, li); } }
    }
}
__device__ __forceinline__ void ph3_vfrag(const Args& a) {
    const int tid = phase_tid(), lane = tid & 63, wave = __builtin_amdgcn_readfirstlane(tid >> 6);
    const int gw = blockIdx.x * NWAVES + wave, NGW = gridDim.x * NWAVES;
    const bf16* KV = (const bf16*)(a.ws + WS_KV); const bf16* DL = (const bf16*)(a.ws + WS_DL);
    for (int job = gw; job < 32768; job += NGW) {
        const bf16* src; size_t rstride; unsigned char* dst; int key0;
        if (job < 8192) { const int bg = job >> 10, kind = (job >> 9) & 1, s0 = (job & 511) * 8, b = bg >> 1, g = bg & 1;
            src = KV + (size_t)(b * S + s0) * NKV + ((kind ? 10 : 6) + g) * 128; rstride = NKV; dst = fr8_nsa(a, bg, kind ? 3 : 1); key0 = s0; }
        else { const int j2 = job - 8192, bh = j2 >> 9, vk0 = (j2 & 511) * 8, b = bh / 12, head = bh % 12, gi = head >> 2, dsh = 2 * gi, L = S >> dsh, r = vk0 / L, m0 = vk0 % L;
            src = DL + (size_t)(b * S + (m0 << dsh) + r) * NDL + (24 + head) * 128; rstride = (size_t)NDL << dsh; dst = fr8_dil(a, b, head, 1); key0 = vk0; }
        unsigned w[8];
#pragma unroll
        for (int jj = 0; jj < 8; ++jj) w[jj] = *(const unsigned*)(src + jj * rstride + 2 * lane);
        v2u c0, c1;
        c0.x = pk4_f8(bflo(w[0]), bflo(w[1]), bflo(w[2]), bflo(w[3])); c0.y = pk4_f8(bflo(w[4]), bflo(w[5]), bflo(w[6]), bflo(w[7]));
        c1.x = pk4_f8(bfhi(w[0]), bfhi(w[1]), bfhi(w[2]), bfhi(w[3])); c1.y = pk4_f8(bfhi(w[4]), bfhi(w[5]), bfhi(w[6]), bfhi(w[7]));
        *(v2u*)(dst + vf8_off(key0, 2 * lane)) = c0; *(v2u*)(dst + vf8_off(key0, 2 * lane + 1)) = c1;
    }
}
__device__ __forceinline__ void ph3_gates(const Args& a) {
    const int tid = phase_tid(), lane = tid & 63, wave = __builtin_amdgcn_readfirstlane(tid >> 6), tl = lane & 31, hh = lane >> 5;
    const int gw = (gridDim.x - 1 - blockIdx.x) * NWAVES + wave, NGW = gridDim.x * NWAVES;
    const bf16* H = (const bf16*)(a.ws + WS_H); const v4u* WG = (const v4u*)(a.ws + WS_WGF) + lane; float* gates = (float*)(a.ws + WS_GATES);
    for (int job = gw; job < T / 32; job += NGW) {
        const int t = job * 32 + tl; const bf16* hr = H + (size_t)t * D + 8 * hh;
        f32x16 acc;
#pragma unroll
        for (int i = 0; i < 16; ++i) acc[i] = 0.f;
#pragma unroll 16
        for (int ks = 0; ks < 128; ++ks) { const bf16x8 af = __builtin_bit_cast(bf16x8, WG[ks * 64]), bfr = __builtin_bit_cast(bf16x8, *(const v4u*)(hr + 16 * ks));
            acc = __builtin_amdgcn_mfma_f32_32x32x16_bf16(af, bfr, acc, 0, 0, 0); }
#pragma unroll
        for (int i = 0; i < 16; ++i) { const int j = (i & 3) + 8 * (i >> 2) + 4 * hh; const float v = acc[i]; if (j < 24) gates[(size_t)t * 24 + j] = sigmoidf(v); }
    }
}
__device__ __forceinline__ void ph3_compress(const Args& a, LAS unsigned char* lds) {
    const int tid = phase_tid(), lane = tid & 63, wave = __builtin_amdgcn_readfirstlane(tid >> 6), cl = lane & 31, hh = lane >> 5;
    LAS float* part = (LAS float*)lds;
    LAS float* hid = part + 2 * 128 * 32;
    LAS float* ob = hid + 32 * 128;
    LAS float* bias = ob + 32 * 128;
    const bf16* KV = (const bf16*)(a.ws + WS_KV);
    const float* w2 = a.in[10]; const float* kg0 = a.in[7]; const float* CBP = (const float*)(a.ws + WS_CBP);
    for (int u = blockIdx.x; u < 128; u += gridDim.x) {
        const int j = u >> 6, bg = (u >> 3) & 7, ct = u & 7, b = bg >> 1, g = bg & 1, c0 = 32 * ct, hhd = j * 2 + g;
        if (tid < 128) { float s = 0.f;
#pragma unroll
            for (int kc = 0; kc < 64; ++kc) s += CBP[(kc * 2 + j) * 128 + tid];
            bias[tid] = s; }
        { const int nt = wave & 3, kh = wave >> 2, c = c0 + cl;
          const v4u* af = (const v4u*)(a.ws + WS_CW1F) + ((size_t)(j * 4 + nt) * 256 + 128 * kh) * 64 + lane;
          f32x16 acc;
#pragma unroll
          for (int i = 0; i < 16; ++i) acc[i] = 0.f;
#pragma unroll 16
          for (int ks = 0; ks < 128; ++ks) { const int k = 16 * (128 * kh + ks) + 8 * hh, l = k >> 7, d = k & 127, p = 16 * c + l;
              v4u x = {0u, 0u, 0u, 0u}; if (p < S) x = *(const v4u*)(KV + (size_t)(b * S + p) * NKV + hhd * 128 + d);
              acc = __builtin_amdgcn_mfma_f32_32x32x16_bf16(__builtin_bit_cast(bf16x8, af[ks * 64]), __builtin_bit_cast(bf16x8, x), acc, 0, 0, 0); }
#pragma unroll
          for (int i = 0; i < 16; ++i) { const int n = 32 * nt + (i & 3) + 8 * (i >> 2) + 4 * hh; const float v = acc[i]; part[(kh * 128 + n) * 32 + cl] = v; } }
        __syncthreads();
        for (int i = tid; i < 128 * 32; i += NTHREADS) { const int n = i >> 5, c = i & 31; hid[c * 128 + n] = gelu_tanh(part[i] + part[128 * 32 + i] + bias[n]); }
        __syncthreads();
        { const int n = tid & 127, cq = tid >> 7; float o[8];
#pragma unroll
          for (int r = 0; r < 8; ++r) o[r] = 0.f;
          const float* w2p = w2 + j * 128 * 128 + n;
          for (int k = 0; k < 128; ++k) { const float w = w2p[k * 128];
#pragma unroll
              for (int r = 0; r < 8; ++r) o[r] += hid[(8 * cq + r) * 128 + k] * w; }
#pragma unroll
          for (int r = 0; r < 8; ++r) ob[(8 * cq + r) * 128 + n] = o[r]; }
        __syncthreads();
        bf16* fr = (bf16*)(a.ws + (j == 0 ? WS_KC : WS_VC)) + (size_t)bg * 8 * 4096;
#pragma unroll 1
        for (int r = 0; r < 4; ++r) { const int cr = 4 * wave + r, c = c0 + cr; float v0 = ob[cr * 128 + 2 * lane], v1 = ob[cr * 128 + 2 * lane + 1];
            if (j == 0) { const float rstd = rsqrtf(wave_sum(v0 * v0 + v1 * v1) * (1.f / 128.f) + EPS); v0 = v0 * rstd * kg0[2 * lane]; v1 = v1 * rstd * kg0[2 * lane + 1]; }
            if (c >= NC) { v0 = 0.f; v1 = 0.f; }
            if (j == 0) *(unsigned*)(fr + kf_off(c, 2 * lane)) = pk2(v0, v1);
            else { fr[vf_off(c, 2 * lane)] = (bf16)f2bf(v0); fr[vf_off(c, 2 * lane + 1)] = (bf16)f2bf(v1); } }
        __syncthreads();
    }
}

#define KBI(i) (16 * ((i) >> 3) + ((i) & 7))
__device__ __forceinline__ void load_frags(bf16x8 (&f)[8], const v4u* p, int lane) {
#pragma unroll
    for (int i = 0; i < 8; ++i) f[i] = __builtin_bit_cast(bf16x8, p[i * 64 + lane]);
}
__device__ __forceinline__ f32x16 qk_mma(const bf16x8 (&qf)[8], const bf16x8 (&k)[8]) {
    f32x16 s;
#pragma unroll
    for (int i = 0; i < 16; ++i) s[i] = 0.f;
#pragma unroll
    for (int st = 0; st < 8; ++st) s = __builtin_amdgcn_mfma_f32_32x32x16_bf16(k[st], qf[st], s, 0, 0, 0);
    return s;
}
__device__ __forceinline__ f32x16 qk_tile(const bf16x8 (&qf)[8], const v4u* kf, int lane) { bf16x8 k[8]; load_frags(k, kf, lane); return qk_mma(qf, k); }
template <int STRIDE> __device__ __forceinline__ void add_tbl(f32x16& s, const LAS float* tp2, float pen) {
#pragma unroll
    for (int i = 0; i < 16; ++i) s[i] += tp2[STRIDE * (23 - KBI(i))] + pen;
}
__device__ __forceinline__ void mask_hi(f32x16& s, int lim) {
#pragma unroll
    for (int i = 0; i < 16; ++i) s[i] = (KBI(i) <= lim) ? s[i] : NEGB;
}
__device__ __forceinline__ void mask_lo(f32x16& s, int lim) {
#pragma unroll
    for (int i = 0; i < 16; ++i) s[i] = (KBI(i) >= lim) ? s[i] : NEGB;
}
__device__ __forceinline__ float max16(const f32x16& s) {
    float mx = fmaxf(s[0], s[1]);
#pragma unroll
    for (int i = 2; i < 16; ++i) mx = fmaxf(mx, s[i]);
    return fmaxf(mx, __shfl_xor(mx, 32));
}
__device__ __forceinline__ void pv_tile(const f32x16& p, f32x16 (&o)[4], const bf16x8 (&v)[8]) {
    v4u a0, a1;
    a0.x = pkbf(p[0], p[1]); a0.y = pkbf(p[2], p[3]); a0.z = pkbf(p[4], p[5]); a0.w = pkbf(p[6], p[7]);
    a1.x = pkbf(p[8], p[9]); a1.y = pkbf(p[10], p[11]); a1.z = pkbf(p[12], p[13]); a1.w = pkbf(p[14], p[15]);
    const bf16x8 pb0 = __builtin_bit_cast(bf16x8, a0), pb1 = __builtin_bit_cast(bf16x8, a1);
#pragma unroll
    for (int dt = 0; dt < 4; ++dt) { o[dt] = __builtin_amdgcn_mfma_f32_32x32x16_bf16(v[2 * dt], pb0, o[dt], 0, 0, 0); o[dt] = __builtin_amdgcn_mfma_f32_32x32x16_bf16(v[2 * dt + 1], pb1, o[dt], 0, 0, 0); }
}
__device__ __forceinline__ void softmax_pv(f32x16& s, f32x16 (&o)[4], float& m, float& l, const v4u* vf, int lane) {
    bf16x8 v[8];
#pragma unroll
    for (int i = 0; i < 8; ++i) v[i] = __builtin_bit_cast(bf16x8, vf[i * 64 + lane]);
    const float mn = fmaxf(m, max16(s));
    if (__ballot(mn > m + 8.f)) {
        const float corr = ex2(m - mn);
#pragma unroll
        for (int dt = 0; dt < 4; ++dt)
#pragma unroll
            for (int i = 0; i < 16; ++i) o[dt][i] *= corr;
        l *= corr; m = mn;
    }
    float ps = 0.f;
#pragma unroll
    for (int i = 0; i < 16; ++i) { s[i] = ex2(s[i] - m); ps += s[i]; }
    l += ps;
    pv_tile(s, o, v);
}
template <int NP = 0> __device__ __forceinline__ void softmax_pv_v(f32x16& s, f32x16 (&o)[4], float& m, float& l, const bf16x8 (&v)[8]) {
    if (NP == 2) { l += s[0]; pv_tile(s, o, v); return; }
    const float mn = fmaxf(m, max16(s));
    if (__ballot(mn > m + 8.f)) {
        const float corr = ex2(m - mn);
#pragma unroll
        for (int dt = 0; dt < 4; ++dt)
#pragma unroll
            for (int i = 0; i < 16; ++i) o[dt][i] *= corr;
        l *= corr; m = mn;
    }
    float ps = 0.f;
#pragma unroll
    for (int i = 0; i < 16; ++i) { s[i] = ex2(s[i] - m); ps += s[i]; }
    l += ps;
    pv_tile(s, o, v);
}
typedef long f8x8;
__device__ __forceinline__ void load_frags8(f8x8 (&f)[8], const v4u* p, int lane) {
#pragma unroll
    for (int i = 0; i < 4; ++i) { const v4u w = p[i * 64 + lane]; f[2 * i] = (long)(((unsigned long long)w.y << 32) | w.x); f[2 * i + 1] = (long)(((unsigned long long)w.w << 32) | w.z); }
}
__device__ __forceinline__ f32x16 qk_mma8(const f8x8 (&qf)[8], const f8x8 (&k)[8]) {
    f32x16 s;
#pragma unroll
    for (int i = 0; i < 16; ++i) s[i] = 0.f;
#pragma unroll
    for (int st = 0; st < 8; ++st) s = __builtin_amdgcn_mfma_f32_32x32x16_fp8_fp8(k[st], qf[st], s, 0, 0, 0);
    return s;
}
__device__ __forceinline__ unsigned pk4_f8n(float a, float b, float c, float d) { int w = 0; w = __builtin_amdgcn_cvt_pk_fp8_f32(a, b, w, false); w = __builtin_amdgcn_cvt_pk_fp8_f32(c, d, w, true); return (unsigned)w; }
__device__ __forceinline__ void pv_tile8(const f32x16& p, f32x16 (&o)[4], const f8x8 (&v)[8]) {
    const f8x8 pb0 = (long)(((unsigned long long)pk4_f8n(p[4], p[5], p[6], p[7]) << 32) | pk4_f8n(p[0], p[1], p[2], p[3]));
    const f8x8 pb1 = (long)(((unsigned long long)pk4_f8n(p[12], p[13], p[14], p[15]) << 32) | pk4_f8n(p[8], p[9], p[10], p[11]));
#pragma unroll
    for (int dt = 0; dt < 4; ++dt) { o[dt] = __builtin_amdgcn_mfma_f32_32x32x16_fp8_fp8(v[2 * dt], pb0, o[dt], 0, 0, 0); o[dt] = __builtin_amdgcn_mfma_f32_32x32x16_fp8_fp8(v[2 * dt + 1], pb1, o[dt], 0, 0, 0); }
}
template <int NP = 0> __device__ __forceinline__ void softmax_pv_v8(f32x16& s, f32x16 (&o)[4], float& m, float& l, const f8x8 (&v)[8]) {
    if (NP == 2) { l += s[0]; pv_tile8(s, o, v); return; }
    const float mn = fmaxf(m, max16(s));
    if (__ballot(mn > m + 8.f)) {
        const float corr = ex2(m - mn);
#pragma unroll
        for (int dt = 0; dt < 4; ++dt)
#pragma unroll
            for (int i = 0; i < 16; ++i) o[dt][i] *= corr;
        l *= corr; m = mn;
    }
    float ps = 0.f;
#pragma unroll
    for (int i = 0; i < 16; ++i) { s[i] = ex2(s[i] - m); ps += s[i]; }
    l += ps;
    pv_tile8(s, o, v);
}
__device__ __forceinline__ void q_to_f8(f8x8 (&q8)[8], const bf16x8 (&qf)[8]) {
#pragma unroll
    for (int st = 0; st < 8; ++st) { const v4u w = __builtin_bit_cast(v4u, qf[st]);
        q8[st] = (long)(((unsigned long long)pk4_f8(bflo(w.z), bfhi(w.z), bflo(w.w), bfhi(w.w)) << 32) | pk4_f8(bflo(w.x), bfhi(w.x), bflo(w.y), bfhi(w.y))); }
}
__device__ __forceinline__ void zero_o(f32x16 (&o)[4]) {
#pragma unroll
    for (int dt = 0; dt < 4; ++dt)
#pragma unroll
        for (int i = 0; i < 16; ++i) o[dt][i] = 0.f;
}
__device__ __forceinline__ void y_update(bf16* yp  , const f32x16 (&o)[4], float sc, bool acc) {
#pragma unroll
    for (int dt = 0; dt < 4; ++dt)
#pragma unroll
        for (int i4 = 0; i4 < 4; ++i4) { bf16* p = yp + 32 * dt + 8 * i4;
            float v0 = o[dt][4 * i4] * sc, v1 = o[dt][4 * i4 + 1] * sc, v2 = o[dt][4 * i4 + 2] * sc, v3 = o[dt][4 * i4 + 3] * sc;
            if (acc) { const v2u w = *(const v2u*)p; v0 += bflo(w.x); v1 += bfhi(w.x); v2 += bflo(w.y); v3 += bfhi(w.y); }
            v2u w; w.x = pkbf(v0, v1); w.y = pkbf(v2, v3); *(v2u*)p = w; }
}
constexpr int TBLN = 2624;
constexpr int OFF_TBL = 0, OFF_IMP = 43008, OFF_SELM = OFF_IMP + 65536, OFF_DTBL = OFF_SELM + 512;
constexpr int FAR_DIST = 1513;

template <int NP> __device__ __forceinline__ void nsa_unit(const Args& a, LAS unsigned char* lds, int u, int tid) {
    const int lane = tid & 63, wave = __builtin_amdgcn_readfirstlane(tid >> 6);
    const int qb = u >> 3, bg = u & 7, b = bg >> 1, g = bg & 1;
    const int r = wave >> 1, qs = wave & 1, hd = g * 4 + r, ql = lane & 31, h = lane >> 5;
    const int q0w = 64 * qb + 32 * qs, sq = q0w + ql, t = b * S + sq;
    LAS float* tball = (LAS float*)(lds + OFF_TBL);
    LAS float* imp = (LAS float*)(lds + OFF_IMP);
    LAS unsigned long long* selm = (LAS unsigned long long*)(lds + OFF_SELM);
    const float* relb = a.in[22];
    for (int i = tid; i < 4 * TBLN; i += NTHREADS) { const int hh = i / TBLN, dd = i % TBLN - 64; tball[i] = dd >= 0 ? relb[(g * 4 + hh) * 32 + t5_bucket(dd)] * LOG2E : 0.f; }
    for (int i = tid; i < 4 * 64 * 64; i += NTHREADS) imp[i] = 0.f;
    __syncthreads();
    const LAS float* tbl = tball + r * TBLN + 64;
    const float farc = relb[hd * 32 + 31] * LOG2E;
    bf16x8 qf[8];
    { const bf16* qrow = (const bf16*)(a.ws + WS_Q) + (size_t)t * NQ + hd * 128 + 8 * h;
#pragma unroll
      for (int st = 0; st < 8; ++st) qf[st] = __builtin_bit_cast(bf16x8, *(const v4u*)(qrow + 16 * st)); }
    const float* gt = (const float*)(a.ws + WS_GATES) + (size_t)t * 24 + hd * 3;
    const float g0 = gt[0], g1 = gt[1], g2 = gt[2];
    bf16* yp = (bf16*)(a.ws + (NP ? WS_H : WS_YN)) + (size_t)t * 1536 + hd * 128 + 4 * h;
    f32x16 o[4];
    {
        const v4u* kfc = (const v4u*)(a.ws + WS_KC) + (size_t)bg * 8 * 512; const v4u* vfc = (const v4u*)(a.ws + WS_VC) + (size_t)bg * 8 * 512;
        const int smax = q0w + 31, ncv = smax >= 31 ? ((smax - 31) >> 4) + 1 : 0, ntc = (ncv + 31) >> 5;
        float m = NEGB, l = 0.f;
        for (int tc = 0; tc < ntc; ++tc) {
            f32x16 s = qk_tile(qf, kfc + tc * 512, lane);
            const int dqc = sq - 31 - 512 * tc;
            if (q0w - 31 - 512 * tc - 496 >= FAR_DIST) {
#pragma unroll
                for (int i = 0; i < 16; ++i) s[i] += farc;
            } else add_tbl<16>(s, tbl + dqc - 16 * (8 * h + 23), 0.f);
            mask_hi(s, (dqc >> 4) - 8 * h);
            const float mn = fmaxf(m, max16(s));
            float ps = 0.f;
#pragma unroll
            for (int i = 0; i < 16; ++i) ps += ex2(s[i] - mn);
            l = l * ex2(m - mn) + ps; m = mn;
        }
        l += __shfl_xor(l, 32);
        const float inv = (sq >= 31) ? 1.f / l : 0.f;
        zero_o(o);
        LAS float* impq = imp + (r * 64 + 32 * qs + ql) * 64;
        for (int tc = 0; tc < ntc; ++tc) {
            f32x16 s = qk_tile(qf, kfc + tc * 512, lane);
            bf16x8 v[8];
#pragma unroll
            for (int i = 0; i < 8; ++i) v[i] = __builtin_bit_cast(bf16x8, vfc[tc * 512 + i * 64 + lane]);
            const int dqc = sq - 31 - 512 * tc;
            if (q0w - 31 - 512 * tc - 496 >= FAR_DIST) {
#pragma unroll
                for (int i = 0; i < 16; ++i) s[i] += farc;
            } else add_tbl<16>(s, tbl + dqc - 16 * (8 * h + 23), 0.f);
            mask_hi(s, (dqc >> 4) - 8 * h);
#pragma unroll
            for (int i = 0; i < 16; ++i) s[i] = ex2(s[i] - m) * inv;
#pragma unroll
            for (int a2 = 0; a2 < 2; ++a2)
#pragma unroll
                for (int bq = 0; bq < 2; ++bq) { const int j = 8 * tc + 4 * a2 + 2 * h + bq; const int i0 = 8 * a2 + 4 * bq;
                    impq[j] += (s[i0] + s[i0 + 1]) + (s[i0 + 2] + s[i0 + 3]); }
            asm volatile("s_waitcnt lgkmcnt(0)" ::: "memory");
#pragma unroll
            for (int a2 = 0; a2 < 2; ++a2)
#pragma unroll
                for (int bq = 0; bq < 2; ++bq) { const int j = 8 * tc + 4 * a2 + 2 * h + bq + 1; if (j < 64) impq[j] += s[8 * a2 + 4 * bq + 3]; }
            asm volatile("s_waitcnt lgkmcnt(0)" ::: "memory");
            pv_tile(s, o, v);
        }
        y_update(yp, o, g0, false);
    }
    f8x8 q8[8]; q_to_f8(q8, qf);
    __syncthreads();
    for (int qq = wave * 8; qq < wave * 8 + 8; ++qq) {
        const int jb = lane;
        const float im = ((imp[(0 * 64 + qq) * 64 + jb] + imp[(1 * 64 + qq) * 64 + jb]) + imp[(2 * 64 + qq) * 64 + jb]) + imp[(3 * 64 + qq) * 64 + jb];
        const bool forced = (jb == 0) || (jb == qb) || (jb == qb - 1);
        const float score = forced ? 1e4f : (jb > qb ? -1e4f : im);
        int rank = 0;
        for (int o2 = 0; o2 < 64; ++o2) { const float so = __shfl(score, o2); rank += (so > score) || (so == score && o2 < jb); }
        const unsigned long long mask = __ballot(rank < 16 && jb <= qb);
        if (lane == 0) selm[qq] = mask;
    }
    __syncthreads();
    {
        const v4u* kfw = (const v4u*)fr8_nsa(a, bg, 2); const v4u* vfw = (const v4u*)fr8_nsa(a, bg, 3);
        const int t_hi = q0w >> 5, t_lo = t_hi - 16;
        float m = NEGB, l = 0.f; zero_o(o);
        const int t0 = t_lo < 0 ? 0 : t_lo;
        for (int tt = t0; tt <= t_hi; ++tt) {
            const size_t to = (NP == 3) ? (size_t)(tt & 1) * 256 : (size_t)tt * 256;
            f8x8 kf[8], vf[8]; load_frags8(kf, kfw + to, lane);
            f32x16 s = qk_mma8(q8, kf); load_frags8(vf, vfw + to, lane);
            const int dq = sq - 32 * tt;
            add_tbl<1>(s, tbl + dq - (8 * h + 23), 0.f);
            if (tt == t_hi) mask_hi(s, dq - 8 * h);
            if (tt == t_lo) mask_lo(s, dq - 511 - 8 * h);
            softmax_pv_v8<NP>(s, o, m, l, vf);
        }
        l += __shfl_xor(l, 32);
        y_update(yp, o, g2 / l, true);
    }
    {
        const v4u* kfs = (const v4u*)fr8_nsa(a, bg, 0); const v4u* vfs = (const v4u*)fr8_nsa(a, bg, 1);
        const unsigned long long mask = selm[32 * qs + ql];
        float m = NEGB, l = 0.f; zero_o(o);
        const int t_end = 2 * qb + qs;
        for (int tt = 0; tt <= 2 * qb + 1; ++tt) {
            if (tt > t_end) continue;
            const float pen = ((mask >> (tt >> 1)) & 1ull) ? 0.f : NEGB;
            if (__ballot(pen == 0.f) == 0ull) continue;
            const size_t to = (NP == 3) ? (size_t)(tt & 1) * 256 : (size_t)tt * 256;
            f8x8 kf[8], vf[8]; load_frags8(kf, kfs + to, lane);
            f32x16 s = qk_mma8(q8, kf); load_frags8(vf, vfs + to, lane);
            const int dq = sq - 32 * tt;
            if (q0w - (32 * tt + 31) >= FAR_DIST) {
                const float c = farc + pen;
#pragma unroll
                for (int i = 0; i < 16; ++i) s[i] += c;
            } else add_tbl<1>(s, tbl + dq - (8 * h + 23), pen);
            if (tt == t_end) mask_hi(s, dq - 8 * h);
            softmax_pv_v8<NP>(s, o, m, l, vf);
        }
        l += __shfl_xor(l, 32);
        y_update(yp, o, g1 / l, true);
    }
    __syncthreads();
}
__device__ __forceinline__ void dil_unit(const Args& a, LAS unsigned char* lds, int u, int tid) {
    const int lane = tid & 63, wave = __builtin_amdgcn_readfirstlane(tid >> 6), ql = lane & 31, h = lane >> 5;
    const int b = u >> 6, p = (u >> 4) & 3, c = u & 15, s0 = 256 * c;
    LAS float* dtbl = (LAS float*)(lds + OFF_DTBL);
    const float* relb = a.in[22] + 8 * 32;
    for (int i = tid; i < 3 * 192; i += NTHREADS) { const int gi = i / 192, dm = i % 192 - 32; dtbl[i] = dm >= 0 ? relb[(gi * 4 + p) * 32 + t5_bucket(dm << (2 * gi))] * LOG2E : 0.f; }
    __syncthreads();
    bf16* OD = (bf16*)(a.ws + WS_OD); float* LSE = (float*)(a.ws + WS_LSE);
    const bf16* DL = (const bf16*)(a.ws + WS_DL);
    for (int job = wave; job < 32; job += NWAVES) {
        int gi, rr, m0, vlo, vhi;
        if (job < 8) { gi = 0; rr = 0; m0 = s0 + 32 * job; vlo = 0; vhi = 32; }
        else if (job < 16) { gi = 1; rr = (job - 8) >> 1; m0 = (s0 >> 2) + 32 * (job & 1); vlo = 0; vhi = 32; }
        else { gi = 2; rr = job - 16; m0 = 32 * (c >> 1); vlo = 16 * (c & 1); vhi = vlo + 16; }
        const int dsh = 2 * gi, L = S >> dsh, head = gi * 4 + p;
        const int mq = m0 + ql, sact = (mq << dsh) + rr, t = b * S + sact;
        const v4u* kf = (const v4u*)fr8_dil(a, b, head, 0) + (size_t)((rr * L) >> 5) * 256; const v4u* vf = (const v4u*)fr8_dil(a, b, head, 1) + (size_t)((rr * L) >> 5) * 256;
        bf16x8 qf[8];
        { const bf16* qrow = DL + (size_t)t * NDL + head * 128 + 8 * h;
#pragma unroll
          for (int st = 0; st < 8; ++st) qf[st] = __builtin_bit_cast(bf16x8, *(const v4u*)(qrow + 16 * st)); }
        f8x8 q8[8]; q_to_f8(q8, qf);
        const LAS float* tb = dtbl + gi * 192 + 32;
        const int t_hi = m0 >> 5, t_lo = t_hi - 4;
        float m = NEGB, l = 0.f; f32x16 o[4]; zero_o(o);
        const int t0 = t_lo < 0 ? 0 : t_lo;
        for (int tt = t0; tt <= t_hi; ++tt) {
            f8x8 kr[8], vr[8]; load_frags8(kr, kf + (size_t)tt * 256, lane);
            f32x16 s = qk_mma8(q8, kr); load_frags8(vr, vf + (size_t)tt * 256, lane);
            const int dq = mq - 32 * tt;
            add_tbl<1>(s, tb + dq - (8 * h + 23), 0.f);
            if (tt == t_hi) mask_hi(s, dq - 8 * h);
            if (tt == t_lo) mask_lo(s, dq - 128 - 8 * h);
            softmax_pv_v8(s, o, m, l, vr);
        }
        l += __shfl_xor(l, 32);
        if (ql >= vlo && ql < vhi) {
            y_update(OD + ((size_t)gi * T + t) * 512 + p * 128 + 4 * h, o, 1.f / l, false);
            if (h == 0) LSE[((size_t)(gi * NB + b) * 4 + p) * S + sact] = m + __log2f(l);
        }
    }
    __syncthreads();
    { const int pos = tid >> 1, dh = tid & 1, sact = s0 + pos, t = b * S + sact;
      const float l0 = LSE[((size_t)(0 * NB + b) * 4 + p) * S + sact], l1 = LSE[((size_t)(1 * NB + b) * 4 + p) * S + sact], l2 = LSE[((size_t)(2 * NB + b) * 4 + p) * S + sact];
      const float mx = fmaxf(l0, fmaxf(l1, l2)); float w0 = ex2(l0 - mx), w1 = ex2(l1 - mx), w2 = ex2(l2 - mx); const float iw = 1.f / (w0 + w1 + w2); w0 *= iw; w1 *= iw; w2 *= iw;
      bf16* yd = (bf16*)(a.ws + WS_YN) + (size_t)t * 1536 + 1024 + p * 128 + 64 * dh;
      const bf16* o0 = OD + ((size_t)0 * T + t) * 512 + p * 128 + 64 * dh; const bf16* o1 = OD + ((size_t)1 * T + t) * 512 + p * 128 + 64 * dh; const bf16* o2 = OD + ((size_t)2 * T + t) * 512 + p * 128 + 64 * dh;
#pragma unroll
      for (int k = 0; k < 8; ++k) { const v4u x0 = *(const v4u*)(o0 + 8 * k), x1 = *(const v4u*)(o1 + 8 * k), x2 = *(const v4u*)(o2 + 8 * k); v4u y;
          y.x = pkbf(w0 * bflo(x0.x) + w1 * bflo(x1.x) + w2 * bflo(x2.x), w0 * bfhi(x0.x) + w1 * bfhi(x1.x) + w2 * bfhi(x2.x));
          y.y = pkbf(w0 * bflo(x0.y) + w1 * bflo(x1.y) + w2 * bflo(x2.y), w0 * bfhi(x0.y) + w1 * bfhi(x1.y) + w2 * bfhi(x2.y));
          y.z = pkbf(w0 * bflo(x0.z) + w1 * bflo(x1.z) + w2 * bflo(x2.z), w0 * bfhi(x0.z) + w1 * bfhi(x1.z) + w2 * bfhi(x2.z));
          y.w = pkbf(w0 * bflo(x0.w) + w1 * bflo(x1.w) + w2 * bflo(x2.w), w0 * bfhi(x0.w) + w1 * bfhi(x1.w) + w2 * bfhi(x2.w));
          *(v4u*)(yd + 8 * k) = y; } }
    __syncthreads();
}
__device__ __forceinline__ void ph4_attention(const Args& a, LAS unsigned char* lds) {
    const int tid = phase_tid();
    for (int u = blockIdx.x; u < 256; u += gridDim.x) dil_unit(a, lds, u, tid);
#ifndef PROBE_NSA
#define PROBE_NSA 0
#endif
    if (PROBE_NSA) for (int x = blockIdx.x; x < 256; x += gridDim.x) { nsa_unit<PROBE_NSA>(a, lds, 511 - x, tid); nsa_unit<PROBE_NSA>(a, lds, x, tid); }
    for (int x = blockIdx.x; x < 256; x += gridDim.x) { nsa_unit<0>(a, lds, 511 - x, tid); nsa_unit<0>(a, lds, x, tid); }
}

typedef float f32x2 __attribute__((ext_vector_type(2)));
constexpr size_t WS_PU8 = WS_Q;
constexpr size_t WS_PV8 = WS_Q + 32 * MiB;
constexpr size_t WS_PSC = WS_Q + 64 * MiB;
__device__ __forceinline__ void ph_quant_uv(const Args& a) {
    const int tid = phase_tid(), lane = tid & 63, wave = __builtin_amdgcn_readfirstlane(tid >> 6);
    const int gw = blockIdx.x * NWAVES + wave, NGW = gridDim.x * NWAVES;
    float* SC = (float*)(a.ws + WS_PSC);
    for (int rw = gw; rw < NE; rw += NGW) {
        f32x4 x[2][8];
#pragma unroll
        for (int which = 0; which < 2; ++which) { const float* src = a.in[20 + which] + (size_t)rw * D + 16 * lane;
#pragma unroll
            for (int c = 0; c < 2; ++c)
#pragma unroll
                for (int w = 0; w < 4; ++w) x[which][4 * c + w] = *(const f32x4*)(src + 1024 * c + 4 * w); }
#pragma unroll
        for (int which = 0; which < 2; ++which) {
            unsigned char* dst = a.ws + (which ? WS_PV8 : WS_PU8) + (size_t)rw * 1024 + 16 * lane;
            float ss = 0.f;
#pragma unroll
            for (int i = 0; i < 8; ++i) ss += (x[which][i].x * x[which][i].x + x[which][i].y * x[which][i].y) + (x[which][i].z * x[which][i].z + x[which][i].w * x[which][i].w);
            ss = wave_sum(ss);
            const float step = 0.48f * sqrtf(ss * (1.f / D));
            const float inv = step > 0.f ? 1.f / step : 0.f;
            v4u o; unsigned wd[4];
#pragma unroll
            for (int wi = 0; wi < 4; ++wi) { unsigned q = 0u;
                const f32x4 va = x[which][2 * wi], vb = x[which][2 * wi + 1];
                q = __builtin_amdgcn_cvt_scalef32_pk_fp4_f32(q, __builtin_amdgcn_fmed3f(va.x * inv, -6.f, 6.f), __builtin_amdgcn_fmed3f(va.y * inv, -6.f, 6.f), 1.0f, 0);
                q = __builtin_amdgcn_cvt_scalef32_pk_fp4_f32(q, __builtin_amdgcn_fmed3f(va.z * inv, -6.f, 6.f), __builtin_amdgcn_fmed3f(va.w * inv, -6.f, 6.f), 1.0f, 1);
                q = __builtin_amdgcn_cvt_scalef32_pk_fp4_f32(q, __builtin_amdgcn_fmed3f(vb.x * inv, -6.f, 6.f), __builtin_amdgcn_fmed3f(vb.y * inv, -6.f, 6.f), 1.0f, 2);
                q = __builtin_amdgcn_cvt_scalef32_pk_fp4_f32(q, __builtin_amdgcn_fmed3f(vb.z * inv, -6.f, 6.f), __builtin_amdgcn_fmed3f(vb.w * inv, -6.f, 6.f), 1.0f, 3);
                wd[wi] = q; }
            o.x = wd[0]; o.y = wd[1]; o.z = wd[2]; o.w = wd[3]; *(v4u*)dst = o;
            if (lane == 0) SC[which * NE + rw] = step;
        }
    }
}
constexpr size_t WS_KEYF = 601 * MiB;
constexpr size_t WS_END3 = 602 * MiB;
__device__ __forceinline__ void ph0_keyfrags(const Args& a) {
    const int tid = phase_tid();
    const float* keys = a.in[19]; v4u* KF = (v4u*)(a.ws + WS_KEYF);
    for (int i = blockIdx.x * NTHREADS + tid; i < 16 * 32 * 64; i += gridDim.x * NTHREADS) {
        const int lane = i & 63, st = (i >> 6) & 7, kt = (i >> 9) & 3, hp = i >> 11;
        const float* src = keys + ((size_t)hp * 128 + 32 * kt + (lane & 31)) * 128 + 16 * st + 8 * (lane >> 5);
        float v[8]; unsigned hi[8], lo[8];
#pragma unroll
        for (int j = 0; j < 8; ++j) { v[j] = src[j]; hi[j] = f2bf(v[j]); lo[j] = f2bf(v[j] - __builtin_bit_cast(float, hi[j] << 16)); }
        v4u oh, ol; oh.x = hi[0] | (hi[1] << 16); oh.y = hi[2] | (hi[3] << 16); oh.z = hi[4] | (hi[5] << 16); oh.w = hi[6] | (hi[7] << 16);
        ol.x = lo[0] | (lo[1] << 16); ol.y = lo[2] | (lo[3] << 16); ol.z = lo[4] | (lo[5] << 16); ol.w = lo[6] | (lo[7] << 16);
        KF[(size_t)((hp * 2 + 0) * 32 + kt * 8 + st) * 64 + lane] = oh; KF[(size_t)((hp * 2 + 1) * 32 + kt * 8 + st) * 64 + lane] = ol;
    }
}
template <int N, bool MERGE_ONLY> __device__ __forceinline__ void bitonic_desc(float (&v)[N]) {
#pragma unroll
    for (int k = MERGE_ONLY ? N : 2; k <= N; k <<= 1)
#pragma unroll
        for (int j = k >> 1; j > 0; j >>= 1)
#pragma unroll
            for (int i = 0; i < N; ++i) { const int l = i ^ j;
                if (l > i) { const bool desc = ((i & k) == 0) || (k == N); const float x = v[i], y = v[l], hi = fmaxf(x, y), lo = fminf(x, y); v[i] = desc ? hi : lo; v[l] = desc ? lo : hi; } }
}
#define CROW(i) (((i) & 3) + 8 * ((i) >> 2))
__device__ __forceinline__ float max3f(float a, float b, float c) { return fmaxf(fmaxf(a, b), c); }
__device__ __forceinline__ void ph_route(const Args& a, LAS unsigned char* lds) {
    const int tid = phase_tid(), lane = tid & 63, wave = __builtin_amdgcn_readfirstlane(tid >> 6), tl = lane & 31, hc = lane >> 5;
    const int gw = blockIdx.x * NWAVES + wave, NGW = gridDim.x * NWAVES;
    const float* QP = (const float*)(a.ws + WS_QP); const float* qgain = a.in[18]; const v4u* KF = (const v4u*)(a.ws + WS_KEYF);
    int* EI = (int*)(a.ws + WS_EI); float* EG = (float*)(a.ws + WS_EG);
    LAS float* spl = (LAS float*)(lds + wave * 8704) + lane * 33;
    for (int job = gw; job < (T / 32) * 8; job += NGW) {
        const int h = job & 7, t = (job >> 3) * 32 + tl;
#pragma unroll 1
        for (int p = 0; p < 2; ++p) {
            bf16x8 bh[8], bl[8];
            { const float* qr = QP + (size_t)t * D + h * 256 + p * 128 + 8 * hc; const float* gr = qgain + (h * 2 + p) * 128 + 8 * hc;
              float ss = 0.f;
#pragma unroll
              for (int st = 0; st < 8; ++st) { const f32x4 x0 = *(const f32x4*)(qr + 16 * st), x1 = *(const f32x4*)(qr + 16 * st + 4);
                  ss += (x0.x * x0.x + x0.y * x0.y) + (x0.z * x0.z + x0.w * x0.w) + (x1.x * x1.x + x1.y * x1.y) + (x1.z * x1.z + x1.w * x1.w); }
              ss += __shfl_xor(ss, 32);
              const float rstd = rsqrtf(ss * (1.f / 128.f) + EPS);
              asm volatile("" ::: "memory");
#pragma unroll
              for (int st = 0; st < 8; ++st) { const f32x4 x0 = *(const f32x4*)(qr + 16 * st), x1 = *(const f32x4*)(qr + 16 * st + 4); const f32x4 g0 = *(const f32x4*)(gr + 16 * st), g1 = *(const f32x4*)(gr + 16 * st + 4);
                  const float v0 = x0.x * rstd * g0.x, v1 = x0.y * rstd * g0.y, v2 = x0.z * rstd * g0.z, v3 = x0.w * rstd * g0.w, v4 = x1.x * rstd * g1.x, v5 = x1.y * rstd * g1.y, v6 = x1.z * rstd * g1.z, v7 = x1.w * rstd * g1.w;
                  v4u xh, xl; xh.x = pkbf(v0, v1); xh.y = pkbf(v2, v3); xh.z = pkbf(v4, v5); xh.w = pkbf(v6, v7);
                  xl.x = pkbf(v0 - bflo(xh.x), v1 - bfhi(xh.x)); xl.y = pkbf(v2 - bflo(xh.y), v3 - bfhi(xh.y)); xl.z = pkbf(v4 - bflo(xh.z), v5 - bfhi(xh.z)); xl.w = pkbf(v6 - bflo(xh.w), v7 - bfhi(xh.w));
                  bh[st] = __builtin_bit_cast(bf16x8, xh); bl[st] = __builtin_bit_cast(bf16x8, xl); } }
            float sc[64];
            const v4u* kfh = KF + (size_t)(((h * 2 + p) * 2 + 0) * 32) * 64 + lane; const v4u* kfl = KF + (size_t)(((h * 2 + p) * 2 + 1) * 32) * 64 + lane;
#pragma unroll
            for (int kt = 0; kt < 4; ++kt) {
                f32x16 acc;
#pragma unroll
                for (int i = 0; i < 16; ++i) acc[i] = 0.f;
#pragma unroll
                for (int s2 = 0; s2 < 2; ++s2) {
                    asm volatile("" ::: "memory");
                    bf16x8 ah[4], al[4];
#pragma unroll
                    for (int s4 = 0; s4 < 4; ++s4) { ah[s4] = __builtin_bit_cast(bf16x8, kfh[(kt * 8 + s2 * 4 + s4) * 64]); al[s4] = __builtin_bit_cast(bf16x8, kfl[(kt * 8 + s2 * 4 + s4) * 64]); }
#pragma unroll
                    for (int s4 = 0; s4 < 4; ++s4) { const int st = s2 * 4 + s4;
                        acc = __builtin_amdgcn_mfma_f32_32x32x16_bf16(al[s4], bh[st], acc, 0, 0, 0); acc = __builtin_amdgcn_mfma_f32_32x32x16_bf16(ah[s4], bl[st], acc, 0, 0, 0); acc = __builtin_amdgcn_mfma_f32_32x32x16_bf16(ah[s4], bh[st], acc, 0, 0, 0); }
                }
#pragma unroll
                for (int i = 0; i < 16; ++i) { const float av = acc[i];
                    const unsigned bits = (__builtin_bit_cast(unsigned, av) & ~127u) | (unsigned)(127 - (32 * kt + CROW(i) + 4 * hc)); sc[16 * kt + i] = __builtin_bit_cast(float, bits); }
            }
            asm volatile("" ::: "memory");
            bitonic_desc<64, false>(sc);
            float t16[16];
#pragma unroll
            for (int i = 0; i < 16; ++i) t16[i] = __shfl_xor(sc[i], 32);
            float u16[16];
#pragma unroll
            for (int i = 0; i < 16; ++i) u16[i] = fmaxf(sc[i], t16[15 - i]);
            bitonic_desc<16, true>(u16);
#pragma unroll
            for (int i = 0; i < 16; ++i) spl[p * 16 + i] = u16[i];
        }
        asm volatile("s_waitcnt lgkmcnt(0)" ::: "memory");
        float sp[2][16];
#pragma unroll
        for (int i = 0; i < 16; ++i) { sp[0][i] = spl[i]; sp[1][i] = spl[16 + i]; }
        float cv[64];
        {
            int c = 0;
#pragma unroll
            for (int i = 0; i < 16; ++i)
#pragma unroll
                for (int j = 0; j < 16; ++j) if ((i + 1) * (j + 1) <= 16) {
                    const float v = sp[0][i] + sp[1][j];
                    cv[c] = __builtin_bit_cast(float, (__builtin_bit_cast(unsigned, v) & ~255u) | (unsigned)(255 - (i * 16 + j))); ++c; }
#pragma unroll
            for (int i = 50; i < 64; ++i) cv[i] = -INFINITY;
        }
        bitonic_desc<64, false>(cv);
        float tv[16];
#pragma unroll
        for (int i = 0; i < 16; ++i) tv[i] = cv[i];
        asm volatile("s_waitcnt lgkmcnt(0)" ::: "memory");
        int te[16]; float den = 0.f; const float top = tv[0];
#pragma unroll
        for (int i = 0; i < 16; ++i) { const int flat = 255 - (int)(__builtin_bit_cast(unsigned, tv[i]) & 255u);
            const unsigned b1 = __builtin_bit_cast(unsigned, spl[flat >> 4]), b2 = __builtin_bit_cast(unsigned, spl[16 + (flat & 15)]);
            te[i] = (127 - (int)(b1 & 127u)) * 128 + (127 - (int)(b2 & 127u));
            tv[i] = __expf(tv[i] - top); den += tv[i]; }
        den = 1.f / den;
        if (hc == 0) {
            int* ei = EI + (size_t)t * 128 + h * 16; float* eg = EG + (size_t)t * 128 + h * 16;
#pragma unroll
            for (int i = 0; i < 16; i += 4) { *(v4u*)(ei + i) = (v4u){(unsigned)te[i], (unsigned)te[i + 1], (unsigned)te[i + 2], (unsigned)te[i + 3]}; *(f32x4*)(eg + i) = (f32x4){tv[i] * den, tv[i + 1] * den, tv[i + 2] * den, tv[i + 3] * den}; }
        }
        asm volatile("s_waitcnt lgkmcnt(0)" ::: "memory");
    }
}
__device__ __forceinline__ void ph_experts(const Args& a, const float osc) {
    const int tid = phase_tid(), lane = tid & 63, wave = __builtin_amdgcn_readfirstlane(tid >> 6);
    const int gw = blockIdx.x * NWAVES + wave, NGW = gridDim.x * NWAVES;
    const bf16* H2 = (const bf16*)(a.ws + WS_H); const unsigned char* PU = a.ws + WS_PU8; const unsigned char* PV = a.ws + WS_PV8; const unsigned l16 = 16u * lane; const float* SC = (const float*)(a.ws + WS_PSC);
    const int* EI = (const int*)(a.ws + WS_EI); const float* EG = (const float*)(a.ws + WS_EG);
    const float* mod = (const float*)(a.ws + WS_MOD);
    float* out = a.out;
    v4u wa[8], wb[8];
#define EX_LOAD(buf, tab, esel, base) do { _Pragma("unroll") for (int k = 0; k < 8; ++k) { const unsigned e = (unsigned)__builtin_amdgcn_readlane(esel, ((base) + k) & 63); buf[k] = *(const v4u*)((tab) + ((size_t)e << 10) + l16); } __builtin_amdgcn_sched_barrier(0); } while (0)
#define EX_U(buf, bt) do { float pr[8]; \
        _Pragma("unroll") for (int k = 0; k < 8; ++k) { f32x2 s = {0.f, 0.f}; const unsigned q[4] = {buf[k].x, buf[k].y, buf[k].z, buf[k].w}; \
            _Pragma("unroll") for (int wi = 0; wi < 4; ++wi) { \
                s += x[4 * wi + 0] * __builtin_amdgcn_cvt_scalef32_pk_f32_fp4(q[wi], 1.0f, 0); s += x[4 * wi + 1] * __builtin_amdgcn_cvt_scalef32_pk_f32_fp4(q[wi], 1.0f, 1); \
                s += x[4 * wi + 2] * __builtin_amdgcn_cvt_scalef32_pk_f32_fp4(q[wi], 1.0f, 2); s += x[4 * wi + 3] * __builtin_amdgcn_cvt_scalef32_pk_f32_fp4(q[wi], 1.0f, 3); } \
            pr[k] = s.x + s.y; } \
          \
        float q4[4], q2[2]; \
        _Pragma("unroll") for (int j = 0; j < 4; ++j) { const float keep = lb0 ? pr[2 * j + 1] : pr[2 * j], send = lb0 ? pr[2 * j] : pr[2 * j + 1]; q4[j] = keep + __shfl_xor(send, 1); } \
        _Pragma("unroll") for (int j = 0; j < 2; ++j) { const float keep = lb1 ? q4[2 * j + 1] : q4[2 * j], send = lb1 ? q4[2 * j] : q4[2 * j + 1]; q2[j] = keep + __shfl_xor(send, 2); } \
        float rr; { const float keep = lb2 ? q2[1] : q2[0], send = lb2 ? q2[0] : q2[1]; rr = keep + __shfl_xor(send, 4); } \
        rr += __shfl_xor(rr, 8); rr += __shfl_xor(rr, 16); rr += __shfl_xor(rr, 32); \
        if ((lane >> 3) == ((bt) & 7)) { if ((bt) < 8) raw0 = rr; else raw1 = rr; } } while (0)
#define EX_V(buf, bt) do { _Pragma("unroll") for (int k = 0; k < 8; ++k) { const float cf = __builtin_bit_cast(float, __builtin_amdgcn_readlane(__builtin_bit_cast(int, (bt) < 8 ? cf0 : cf1), ((bt) * 8 + k) & 63)); const f32x2 cf2 = {cf, cf}; const unsigned q[4] = {buf[k].x, buf[k].y, buf[k].z, buf[k].w}; \
            _Pragma("unroll") for (int wi = 0; wi < 4; ++wi) { \
                acc[4 * wi + 0] += cf2 * __builtin_amdgcn_cvt_scalef32_pk_f32_fp4(q[wi], 1.0f, 0); acc[4 * wi + 1] += cf2 * __builtin_amdgcn_cvt_scalef32_pk_f32_fp4(q[wi], 1.0f, 1); \
                acc[4 * wi + 2] += cf2 * __builtin_amdgcn_cvt_scalef32_pk_f32_fp4(q[wi], 1.0f, 2); acc[4 * wi + 3] += cf2 * __builtin_amdgcn_cvt_scalef32_pk_f32_fp4(q[wi], 1.0f, 3); } } } while (0)
    const bool lb0 = lane & 1, lb1 = lane & 2, lb2 = lane & 4;
    int e0 = 0, e1 = 0;
    if (gw < T) { e0 = EI[(size_t)gw * 128 + lane]; e1 = EI[(size_t)gw * 128 + 64 + lane]; EX_LOAD(wa, PU, e0, 0); }
    for (int t = gw; t < T; t += NGW) {
        const int b = t / S, tn = t + NGW;
        f32x2 x[16];
#pragma unroll
        for (int c = 0; c < 2; ++c)
#pragma unroll
            for (int hw = 0; hw < 2; ++hw) { const v4u w = *(const v4u*)(H2 + (size_t)t * D + 1024 * c + 16 * lane + 8 * hw); const int o = 8 * c + 4 * hw;
                x[o + 0] = (f32x2){bflo(w.x), bfhi(w.x)}; x[o + 1] = (f32x2){bflo(w.y), bfhi(w.y)}; x[o + 2] = (f32x2){bflo(w.z), bfhi(w.z)}; x[o + 3] = (f32x2){bflo(w.w), bfhi(w.w)}; }
        int ne0 = 0, ne1 = 0;
        if (tn < T) { ne0 = EI[(size_t)tn * 128 + lane]; ne1 = EI[(size_t)tn * 128 + 64 + lane]; }
        const float gs0 = EG[(size_t)t * 128 + lane] * SC[NE + e0], gs1 = EG[(size_t)t * 128 + 64 + lane] * SC[NE + e1];
        const float su0 = SC[e0], su1 = SC[e1];
        float raw0 = 0.f, raw1 = 0.f;
#pragma unroll 1
        for (int i = 0; i < 7; ++i) {
            EX_LOAD(wb, PU, (i < 4 ? e0 : e1), (2 * i + 1) * 8);
            EX_U(wa, 2 * i);
            EX_LOAD(wa, PU, (i < 3 ? e0 : e1), (2 * i + 2) * 8);
            EX_U(wb, 2 * i + 1);
        }
        { EX_LOAD(wb, PU, e1, 15 * 8); EX_U(wa, 14); EX_LOAD(wa, PV, e0, 0); EX_U(wb, 15); }
        const float cf0 = gelu_tanh(raw0 * su0) * gs0, cf1 = gelu_tanh(raw1 * su1) * gs1;
        f32x2 acc[16];
#pragma unroll
        for (int i = 0; i < 16; ++i) acc[i] = (f32x2){0.f, 0.f};
#pragma unroll 1
        for (int i = 0; i < 7; ++i) {
            EX_LOAD(wb, PV, (i < 4 ? e0 : e1), (2 * i + 1) * 8);
            EX_V(wa, 2 * i);
            EX_LOAD(wa, PV, (i < 3 ? e0 : e1), (2 * i + 2) * 8);
            EX_V(wb, 2 * i + 1);
        }
        { EX_LOAD(wb, PV, e1, 15 * 8); EX_V(wa, 14); if (tn < T) EX_LOAD(wa, PU, ne0, 0); EX_V(wb, 15); }
        const float* g2 = mod + b * 12288 + 10240;
#pragma unroll
        for (int c = 0; c < 2; ++c)
#pragma unroll
            for (int w4 = 0; w4 < 4; ++w4) { float* op = out + (size_t)t * D + 1024 * c + 16 * lane + 4 * w4; const f32x4 ga = *(const f32x4*)(g2 + 1024 * c + 16 * lane + 4 * w4); f32x4 r0 = *(const f32x4*)op; const int o = 8 * c + 2 * w4;
                r0.x += ga.x * acc[o].x * osc; r0.y += ga.y * acc[o].y * osc; r0.z += ga.z * acc[o + 1].x * osc; r0.w += ga.w * acc[o + 1].y * osc;
                *(f32x4*)op = r0; }
        e0 = ne0; e1 = ne1;
    }
#undef EX_LOAD
#undef EX_U
#undef EX_V
}

constexpr int N_PHASES = 11;
__global__ void __launch_bounds__(NTHREADS, 2) fwd_kernel(Args a) {
    extern __shared__ __attribute__((aligned(16))) unsigned char lds_raw[];
    LAS unsigned char* lds = (LAS unsigned char*)lds_raw;
    const int tid = threadIdx.x;
    volatile LAS unsigned* misc = (volatile LAS unsigned*)(lds + LDS_MISC);
    if (tid < 16) misc[tid] = 0u;
    __syncthreads();
    XcdBarrier bar; bar.bar = (unsigned*)(a.ws + WS_CTL) + 1024; bar.x = 0; bar.st = nullptr;
    const int lo = a.ph_lo, hi = a.ph_hi;
    if (hi - lo > 1) bar = xcd_barrier_post((unsigned*)(a.ws + WS_CTL) + 1024, misc + 8);
#define IN(k) (lo <= (k) && (k) < hi)
#define SEAM(k) do { if (IN(k) && IN((k) + 1)) xcd_barrier(bar); } while (0)
    const int G = gridDim.x, bx = blockIdx.x;

    for (int rep = 0; rep < 1 + ((PROBE_DUP >> 0) & 1); ++rep)
    if (IN(0)) { ph0_mod(a, lds); __syncthreads(); ph0_weights(a, lds); ph0_keyfrags(a); ph0_extra(a); __syncthreads(); }
    SEAM(0);
    for (int rep = 0; rep < 1 + ((PROBE_DUP >> 1) & 1); ++rep)
    if (IN(1)) ph_norm<true>(a, a.in[0], a.in[4], 0, 2048, (bf16*)(a.ws + WS_H), a.ws + WS_H8);
    SEAM(1);
    for (int rep = 0; rep < 1 + ((PROBE_DUP >> 2) & 1); ++rep)
    if (IN(2)) { pg8::Gemm g{(const bf16*)(a.ws + WS_H8), (const bf16*)(a.ws + WS_WIN), T, NPROJ, D / 2}; pg8::StaticOrder So; So.init(T, NPROJ, G, bx);
        EpiProjNorm E{(bf16*)(a.ws + WS_Q), (bf16*)(a.ws + WS_KV), (bf16*)(a.ws + WS_DL), (bf16*)(a.ws + WS_MG), (bf16*)a.out, a.in[6], a.in[7], a.in[11], a.in[12], (LAS float*)(lds + 131072), 1.f / (F8_HS * F8_WS)};
        pg8::gemm_phase<EpiProjNorm, pg8::StaticOrder, pg8::NoMid, true>(lds, g, So, E); }
    SEAM(2);
    if (IN(3)) { for (int rep = 0; rep < 1 + ((PROBE_DUP >> 3) & 1); ++rep) { ph3_vfrag(a); ph3_gates(a); ph3_compress(a, lds); } }
    SEAM(3);
    for (int rep = 0; rep < 1 + ((PROBE_DUP >> 4) & 1); ++rep)
    if (IN(4)) ph4_attention(a, lds);
    SEAM(4);
    for (int rep = 0; rep < 1 + ((PROBE_DUP >> 5) & 1); ++rep)
    if (IN(5)) {
        { pg8::Gemm g{(const bf16*)(a.ws + WS_YN), (const bf16*)(a.ws + WS_WBN), T, D, 1536}; pg8::StaticOrder So; So.init(T, D, G, bx);
          EpiMerge E{(const bf16*)(a.ws + WS_MG), a.ws + WS_H, F8_MS}; MidMerge Mh{(const bf16*)(a.ws + WS_MG)};
          pg8::gemm_phase<EpiMerge, pg8::StaticOrder, MidMerge>(lds, g, So, E, Mh); }
    }
    SEAM(5);
    for (int rep = 0; rep < 1 + ((PROBE_DUP >> 6) & 1); ++rep)
    if (IN(6)) { pg8::Gemm g{(const bf16*)(a.ws + WS_H), (const bf16*)(a.ws + WS_WOUT), T, D, D / 2}; pg8::StaticOrder So; So.init(T, D, G, bx);
        EpiOut E{a.in[0], (const float*)(a.ws + WS_MOD), a.out, 1.f / (F8_MS * F8_WS)}; pg8::gemm_phase<EpiOut, pg8::StaticOrder, pg8::NoMid, true>(lds, g, So, E); }
    SEAM(6);
    for (int rep = 0; rep < 1 + ((PROBE_DUP >> 7) & 1); ++rep)
    if (IN(7)) { ph_norm(a, a.out, a.in[16], 6144, 8192, (bf16*)(a.ws + WS_H)); ph_quant_uv(a); }
    SEAM(7);
    for (int rep = 0; rep < 1 + ((PROBE_DUP >> 8) & 1); ++rep)
    if (IN(8)) { pg8::Gemm g{(const bf16*)(a.ws + WS_H), (const bf16*)(a.ws + WS_WPQ), T, D, D}; pg8::StaticOrder So; So.init(T, D, G, bx);
        EpiF32 E{(float*)(a.ws + WS_QP), D}; pg8::gemm_phase<EpiF32, pg8::StaticOrder>(lds, g, So, E); }
    SEAM(8);
    for (int rep = 0; rep < 1 + ((PROBE_DUP >> 9) & 1); ++rep)
    if (IN(9)) { ph_route(a, lds); __syncthreads(); }
    SEAM(9);
    if (IN(10)) { if ((PROBE_DUP >> 10) & 1) { ph_experts(a, *(const float*)(a.ws + WS_CTL + 64)); asm volatile("s_waitcnt vmcnt(0)" ::: "memory"); __syncthreads(); } ph_experts(a, 1.f); }
#undef IN
#undef SEAM
}

extern "C" void kernel_launch(void* const* d_in, const int* in_sizes, int n_in, void* d_out, int out_size, void* d_ws, size_t ws_size, hipStream_t stream) {
    static int grid = 0;
    if (grid == 0) {
        if (n_in != 23 || out_size != T * D || ws_size < WS_END4) { fprintf(stderr, "kernel_launch: unexpected problem shape (n_in %d, out %d, ws %zu); nothing launched\n", n_in, out_size, ws_size); grid = -1; return; }
        int dev = 0, cus = 0, per_cu = 0;
        if (hipGetDevice(&dev) != hipSuccess || hipDeviceGetAttribute(&cus, hipDeviceAttributeMultiprocessorCount, dev) != hipSuccess) { grid = -1; return; }
        if (hipFuncSetAttribute((const void*)fwd_kernel, hipFuncAttributeMaxDynamicSharedMemorySize, LDS_BYTES) != hipSuccess) { fprintf(stderr, "kernel_launch: hipFuncSetAttribute failed\n"); grid = -1; return; }
        if (hipOccupancyMaxActiveBlocksPerMultiprocessor(&per_cu, (const void*)fwd_kernel, NTHREADS, LDS_BYTES) != hipSuccess || per_cu < 1) { fprintf(stderr, "kernel_launch: occupancy query says %d\n", per_cu); }
        (void)hipGetLastError();
        grid = cus;
    }
    if (grid < 0) return;
    hipMemsetAsync((char*)d_ws + WS_CTL, 0, CTL_ZERO_BYTES, stream);
    Args a{};
    for (int i = 0; i < 23; ++i) a.in[i] = (const float*)d_in[i];
    a.out = (float*)d_out; a.ws = (unsigned char*)d_ws;
#if MK_ONE_LAUNCH
#if PROBE_PREFIX >= 0
    a.ph_lo = 0; a.ph_hi = PROBE_PREFIX + 1;
    hipLaunchKernelGGL(fwd_kernel, dim3(grid), dim3(NTHREADS), LDS_BYTES, stream, a);
    hipMemsetAsync((char*)d_ws + WS_CTL, 0, CTL_ZERO_BYTES, stream);
#endif
    a.ph_lo = 0; a.ph_hi = N_PHASES;
    hipLaunchKernelGGL(fwd_kernel, dim3(grid), dim3(NTHREADS), LDS_BYTES, stream, a);
#else
    for (int p = 0; p < N_PHASES; ++p) { a.ph_lo = p; a.ph_hi = p + 1; hipLaunchKernelGGL(fwd_kernel, dim3(grid), dim3(NTHREADS), LDS_BYTES, stream, a); }
#endif
}
```

```cpp
#include <hip/hip_runtime.h>
#include <cstdio>
#include <cstdint>

#ifndef PROBE_DUP
#define PROBE_DUP 0
#endif
#ifndef PROBE_PREFIX
#define PROBE_PREFIX -1
#endif
#ifndef MK_ONE_LAUNCH
#define MK_ONE_LAUNCH 1
#endif

__device__ __forceinline__ int phase_tid() { int t = threadIdx.x; asm volatile("" : "+v"(t)); return t; }
namespace pg8 {
#define PG8_LAS __attribute__((address_space(3)))
typedef unsigned short bf16_t;
typedef short bf16x8 __attribute__((ext_vector_type(8)));
typedef float f32x4 __attribute__((ext_vector_type(4)));
typedef unsigned u32x4 __attribute__((ext_vector_type(4)));
typedef unsigned u32x2 __attribute__((ext_vector_type(2)));
constexpr int BM = 256, BK = 64, HALF = 128, HTB = HALF * BK * 2, STAGE_BYTES = 8 * HTB, NXCD = 8, WGM = 8;

__host__ __device__ __forceinline__ int lds_byte(int r, int c) { const int st = (r >> 4) * 2 + (c >> 5), rr = r & 15, cc = c & 31, ob = rr * 64 + cc * 2; return st * 1024 + (ob ^ (((ob >> 9) & 1) << 5)); }
__host__ __device__ __forceinline__ void stage_rc(int b, int& R, int& C) { const int st = b / 1024, sb = b % 1024, swz = sb ^ (((sb >> 9) & 1) << 5); R = (st >> 1) * 16 + swz / 64; C = (st & 1) * 32 + (swz % 64) / 2; }
__host__ __device__ __forceinline__ int perm32(int rho) { const int n = rho >> 4, i = rho & 15; return 8 * (i >> 2) + 4 * n + (i & 3); }

struct Unit { int pm, pn; };
struct Gemm { const bf16_t* A; const bf16_t* Bt; int M, N, K; };

struct StaticOrder {
    int nM, nN, nwg, G, c;
    __host__ __device__ void init(int M, int N, int G_, int c_) { nM = M / BM; nN = N / BM; nwg = nM * nN; G = G_; c = c_; }
    __host__ __device__ bool next(int i, Unit& u) const {
        const long L = (long)i * G + c; if (L >= nwg) return false;
        int wgid = (int)L; { const int q = nwg / NXCD, r = nwg % NXCD, xcd = wgid % NXCD, off = wgid / NXCD; wgid = (xcd < r ? xcd * (q + 1) : r * (q + 1) + (xcd - r) * q) + off; }
        const int nig = WGM * nN, gid = wgid / nig, fm = gid * WGM, gsz = (nM - fm) < WGM ? (nM - fm) : WGM;
        u.pm = fm + ((wgid % nig) % gsz); u.pn = (wgid % nig) / gsz; return true;
    }
    __device__ __forceinline__ void a_ready(const Unit&) const {}
    __device__ __forceinline__ void done(const Unit&) const {}
};

__device__ __forceinline__ unsigned cvt_pk_bf16(float lo, float hi) { unsigned r; asm volatile("v_cvt_pk_bf16_f32 %0, %1, %2" : "=v"(r) : "v"(lo), "v"(hi)); return r; }

typedef int i32x4 __attribute__((ext_vector_type(4)));
typedef int i32x8 __attribute__((ext_vector_type(8)));
__device__ __forceinline__ void mma_blk_f4(f32x4 (&acc)[4][2], const bf16x8 (&At)[4][2], const bf16x8 (&Bt)[2][2]) {
#pragma unroll
    for (int m = 0; m < 4; ++m)
#pragma unroll
        for (int n = 0; n < 2; ++n)
#pragma unroll
            for (int k = 0; k < 2; ++k) { const i32x4 bb = __builtin_bit_cast(i32x4, Bt[n][k]), aa = __builtin_bit_cast(i32x4, At[m][k]);
                asm volatile("v_mfma_f32_16x16x128_f8f6f4 %0, %1, %2, %0 cbsz:4 blgp:4" : "+v"(acc[m][n]) : "v"(bb), "v"(aa)); }
}
template <bool F8> __device__ __forceinline__ void mma_blk(f32x4 (&acc)[4][2], const bf16x8 (&At)[4][2], const bf16x8 (&Bt)[2][2]) {
    if constexpr (F8) {
#pragma unroll
        for (int m = 0; m < 4; ++m)
#pragma unroll
            for (int n = 0; n < 2; ++n) {
                const i32x8 bb = __builtin_shufflevector(__builtin_bit_cast(i32x4, Bt[n][0]), __builtin_bit_cast(i32x4, Bt[n][1]), 0, 1, 2, 3, 4, 5, 6, 7);
                const i32x8 aa = __builtin_shufflevector(__builtin_bit_cast(i32x4, At[m][0]), __builtin_bit_cast(i32x4, At[m][1]), 0, 1, 2, 3, 4, 5, 6, 7);
                asm volatile("v_mfma_f32_16x16x128_f8f6f4 %0, %1, %2, %0" : "+v"(acc[m][n]) : "v"(bb), "v"(aa)); }
    } else {
#pragma unroll
        for (int m = 0; m < 4; ++m)
#pragma unroll
            for (int n = 0; n < 2; ++n)
#pragma unroll
                for (int k = 0; k < 2; ++k) acc[m][n] = __builtin_amdgcn_mfma_f32_16x16x32_bf16(Bt[n][k], At[m][k], acc[m][n], 0, 0, 0);
    }
}
struct NoMid { static constexpr int AT = -1; __device__ __forceinline__ void operator()(f32x4 (&)[2][2][4][2], const Unit&, int, int, int, int) const {} };
template <class Epi, class Sched, class Mid = NoMid, int F8 = 0>
__device__ __forceinline__ void gemm_phase(PG8_LAS unsigned char* lds, const Gemm g, const Sched& S, const Epi& E, const Mid& Mh = Mid()) {
    const int tid = phase_tid(), wid = __builtin_amdgcn_readfirstlane(tid >> 6), lane = tid & 63, wr = wid >> 2, wc = wid & 3, fr = lane & 15, fq = lane >> 4;
    const int K = g.K, nt = K / BK;
    unsigned voffA[2], voffB[2];
#pragma unroll
    for (int i = 0; i < 2; ++i) { int R, C; stage_rc(tid * 16 + i * 8192, R, C); const int Rb = Epi::PERM ? ((R & ~31) + perm32(R & 31)) : R;
        voffA[i] = (unsigned)(R * K + C) * 2u; voffB[i] = (unsigned)(Rb * K + C) * 2u; }
    const size_t kstep = (size_t)(BK * 2);
    const size_t hstep = (size_t)HALF * K * 2;
    const size_t tstep = 2 * hstep;
    const unsigned ldsw = (unsigned)wid * 1024u;
    const int aoff = lds_byte(wr * 64 + fr, fq * 8), boff = lds_byte(wc * 32 + fr, fq * 8);
#define PG8_SA(b, h) (((b) * 2 + (h)) * HTB)
#define PG8_SB(b, h) ((4 + (b) * 2 + (h)) * HTB)
#define PG8_STAGE(bufoff, gbase, voff) do { _Pragma("unroll") for (int _i = 0; _i < 2; ++_i) \
        __builtin_amdgcn_global_load_lds((const unsigned*)((const char*)(gbase) + (voff)[_i]), (PG8_LAS unsigned*)(lds + (bufoff) + ldsw + _i * 8192), 16, 0, 0); } while (0)
#define PG8_LDA(dst, b, h) do { _Pragma("unroll") for (int m = 0; m < 4; ++m) _Pragma("unroll") for (int k = 0; k < 2; ++k) dst[m][k] = *(const PG8_LAS bf16x8*)(lds + PG8_SA(b, h) + aoff + m * 2048 + k * 1024); } while (0)
#define PG8_LDB(dst, b, h) do { _Pragma("unroll") for (int n = 0; n < 2; ++n) _Pragma("unroll") for (int k = 0; k < 2; ++k) dst[n][k] = *(const PG8_LAS bf16x8*)(lds + PG8_SB(b, h) + boff + n * 2048 + k * 1024); } while (0)
#define PG8_MMA(ai, bj, At, Bt) do { __builtin_amdgcn_s_setprio(1); if constexpr (F8 == 2) { mma_blk_f4(acc[ai][bj], At, Bt); } else if constexpr (F8 == 1) { mma_blk<true>(acc[ai][bj], At, Bt); } else { _Pragma("unroll") for (int m = 0; m < 4; ++m) _Pragma("unroll") for (int n = 0; n < 2; ++n) _Pragma("unroll") for (int k = 0; k < 2; ++k) \
        acc[ai][bj][m][n] = __builtin_amdgcn_mfma_f32_16x16x32_bf16(Bt[n][k], At[m][k], acc[ai][bj][m][n], 0, 0, 0); } __builtin_amdgcn_s_setprio(0); } while (0)
#define PG8_WAIT_V(n) asm volatile("s_waitcnt vmcnt(" #n ")" ::: "memory")
#define PG8_WAIT_L(n) asm volatile("s_waitcnt lgkmcnt(" #n ")" ::: "memory")
#define PG8_BAR __builtin_amdgcn_s_barrier()
#define PG8_SCHED __builtin_amdgcn_sched_barrier(0)
    Unit cur, nxt; int ui = 0;
    if (!S.next(0, cur)) return;
    f32x4 acc[2][2][4][2];
#pragma unroll
    for (int a = 0; a < 2; ++a)
#pragma unroll
        for (int b = 0; b < 2; ++b)
#pragma unroll
            for (int m = 0; m < 4; ++m)
#pragma unroll
                for (int n = 0; n < 2; ++n) acc[a][b][m][n] = (f32x4){0.f, 0.f, 0.f, 0.f};
    bf16x8 At[4][2], B0[2][2], B1[2][2];
    const char* cA = (const char*)g.A + (size_t)cur.pm * tstep; const char* cB = (const char*)g.Bt + (size_t)cur.pn * tstep;
    S.a_ready(cur);
    PG8_STAGE(PG8_SB(0, 0), cB, voffB); PG8_STAGE(PG8_SA(0, 0), cA, voffA); PG8_STAGE(PG8_SB(0, 1), cB + hstep, voffB); PG8_STAGE(PG8_SA(0, 1), cA + hstep, voffA);
    if (wr == 1) PG8_BAR;
    PG8_WAIT_V(4); PG8_BAR;
    PG8_STAGE(PG8_SB(1, 0), cB + kstep, voffB); PG8_STAGE(PG8_SA(1, 0), cA + kstep, voffA); PG8_STAGE(PG8_SB(1, 1), cB + hstep + kstep, voffB);
    PG8_WAIT_V(6); PG8_BAR;
    for (;;) {
        const bool has_next = S.next(ui + 1, nxt);
        const char* nA = has_next ? (const char*)g.A + (size_t)nxt.pm * tstep : cA; const char* nB = has_next ? (const char*)g.Bt + (size_t)nxt.pn * tstep : cB;
#define PG8_KBODY \
            const bool last = (t == nt - 2); \
            const char* a1 = cA + (size_t)(t + 1) * kstep; \
            const char* a2 = last ? nA : cA + (size_t)(t + 2) * kstep; const char* b2 = last ? nB : cB + (size_t)(t + 2) * kstep; \
            const char* a3 = a2 + kstep; const char* b3 = b2 + kstep; \
            if (last && has_next) S.a_ready(nxt); \
            PG8_LDB(B0, 0, 0); PG8_SCHED; PG8_LDA(At, 0, 0); PG8_STAGE(PG8_SA(1, 1), a1 + hstep, voffA); \
            PG8_WAIT_L(8); PG8_BAR; PG8_WAIT_L(0); PG8_MMA(0, 0, At, B0); PG8_BAR; PG8_SCHED; \
            PG8_LDB(B1, 0, 1); PG8_STAGE(PG8_SB(0, 0), b2, voffB); \
            PG8_BAR; PG8_WAIT_L(0); PG8_MMA(0, 1, At, B1); PG8_BAR; \
            PG8_LDA(At, 0, 1); PG8_STAGE(PG8_SA(0, 0), a2, voffA); \
            PG8_BAR; PG8_WAIT_L(0); PG8_MMA(1, 0, At, B0); PG8_BAR; PG8_SCHED; \
            PG8_STAGE(PG8_SB(0, 1), b2 + hstep, voffB); \
            PG8_WAIT_V(6); PG8_BAR; PG8_MMA(1, 1, At, B1); PG8_BAR; \
            PG8_LDB(B0, 1, 0); PG8_SCHED; PG8_LDA(At, 1, 0); PG8_STAGE(PG8_SA(0, 1), a2 + hstep, voffA); \
            PG8_WAIT_L(8); PG8_BAR; PG8_WAIT_L(0); PG8_MMA(0, 0, At, B0); PG8_BAR; PG8_SCHED; \
            PG8_LDB(B1, 1, 1); PG8_STAGE(PG8_SB(1, 0), b3, voffB); \
            PG8_BAR; PG8_WAIT_L(0); PG8_MMA(0, 1, At, B1); PG8_BAR; \
            PG8_LDA(At, 1, 1); PG8_STAGE(PG8_SA(1, 0), a3, voffA); \
            PG8_BAR; PG8_WAIT_L(0); PG8_MMA(1, 0, At, B0); PG8_BAR; PG8_SCHED; \
            PG8_STAGE(PG8_SB(1, 1), b3 + hstep, voffB); \
            PG8_WAIT_V(6); PG8_BAR; PG8_MMA(1, 1, At, B1); PG8_BAR;
        if constexpr (Mid::AT >= 0) {
            for (int t = 0; t < Mid::AT; t += 2) { PG8_KBODY }
            if constexpr (F8) asm volatile("s_nop 15\n\ts_nop 15" ::: "memory");
            Mh(acc, cur, wr, wc, fr, fq);
            for (int t = Mid::AT; t < nt; t += 2) { PG8_KBODY }
        } else {
            for (int t = 0; t < nt; t += 2) { PG8_KBODY }
        }
#undef PG8_KBODY
        if constexpr (F8) asm volatile("s_nop 15\n\ts_nop 15" ::: "memory");
        E(acc, cur, wr, wc, fr, fq); S.done(cur);
        if (!has_next) break;
#pragma unroll
        for (int a = 0; a < 2; ++a)
#pragma unroll
            for (int b = 0; b < 2; ++b)
#pragma unroll
                for (int m = 0; m < 4; ++m)
#pragma unroll
                    for (int n = 0; n < 2; ++n) acc[a][b][m][n] = (f32x4){0.f, 0.f, 0.f, 0.f};
        cur = nxt; cA = nA; cB = nB; ++ui;
    }
    PG8_WAIT_V(0);
    if (wr == 0) PG8_BAR;
    PG8_BAR;
#undef PG8_SA
#undef PG8_SB
#undef PG8_STAGE
#undef PG8_LDA
#undef PG8_LDB
#undef PG8_MMA
#undef PG8_WAIT_V
#undef PG8_WAIT_L
#undef PG8_BAR
#undef PG8_SCHED
}
}

#define GAS __attribute__((address_space(1)))
#define LAS __attribute__((address_space(3)))
typedef unsigned short bf16;
typedef float f32x4 __attribute__((ext_vector_type(4)));
typedef unsigned v4u __attribute__((ext_vector_type(4)));
typedef unsigned v2u __attribute__((ext_vector_type(2)));

constexpr int NB = 4, S = 4096, D = 2048, T = NB * S, HD = 128;
constexpr int IN_COLS = 11288, OFF_KV = 1024, OFF_GATE = 2560, OFF_DIL = 2584, OFF_MERGE = 7192;
constexpr int NPROJ = 11264;
constexpr int NQ = 1024, NKV = 1536, NDL = 4608, NMG = 4096;
constexpr int NC = 255, NS = 64;
constexpr int NE = 16384;
constexpr float EPS = 1e-6f;
constexpr float QSCALE = 0.08838834764831845f;
constexpr int NWAVES = 8, NTHREADS = 512;

constexpr size_t MiB = 1u << 20;
constexpr size_t WS_CTL = 0, CTL_ZERO_BYTES = 1 * MiB;
constexpr size_t WS_WIN = 1 * MiB;
constexpr size_t WS_WBN = 45 * MiB;
constexpr size_t WS_WBD = 49 * MiB;
constexpr size_t WS_WOUT = 51 * MiB;
constexpr size_t WS_WPQ = 59 * MiB;
constexpr size_t WS_WGATE = 67 * MiB;
constexpr size_t WS_MOD = 67 * MiB + 256 * 1024;
constexpr size_t WS_SEL = 67 * MiB + 512 * 1024;
constexpr size_t WS_GATES = 68 * MiB;
constexpr size_t WS_KC = 70 * MiB;
constexpr size_t WS_VC = 71 * MiB;
constexpr size_t WS_H = 72 * MiB;
constexpr size_t WS_Q = 136 * MiB;
constexpr size_t WS_KV = 168 * MiB;
constexpr size_t WS_DL = 216 * MiB;
constexpr size_t WS_MG = 360 * MiB;
constexpr size_t WS_YN = 488 * MiB;
constexpr size_t WS_YD = 520 * MiB;
constexpr size_t WS_WM4 = WS_WIN + 23 * MiB;
constexpr size_t WS_H4 = WS_YD;
constexpr size_t WS_HS = WS_WGATE;
constexpr size_t WS_WMS = WS_WGATE + 128 * 1024;
constexpr size_t WS_H8 = WS_YN;
constexpr size_t WS_EI = 536 * MiB;
constexpr size_t WS_EG = 544 * MiB;
constexpr size_t WS_END = 552 * MiB;
constexpr size_t WS_PU = WS_Q;
constexpr size_t WS_PV = WS_Q + 64 * MiB;
constexpr size_t WS_QP = WS_MG;
static_assert(WS_PV + 64 * MiB <= WS_MG, "u/v overlay");

constexpr int LDS_BYTES = 147456;
constexpr int LDS_MISC = 144 * 1024 - 256;

#define XB_TMO      128
#define XB_XCNT(j)  (256  + 64 * (j))
#define XB_XSUB(j)  (1280 + 64 * (j))
#define XB_XGEN(j)  (2304 + 64 * (j))
#define XB_TOP      3328
#define XB_TOPGEN   3392
#define XCD_BAR_WORDS 3456
#define XB_SPIN_CAP (1u << 24)

__device__ __forceinline__ unsigned xb_ld(unsigned* p)              { return __hip_atomic_load(p, __ATOMIC_RELAXED, __HIP_MEMORY_SCOPE_AGENT); }
__device__ __forceinline__ unsigned xb_add(unsigned* p, unsigned v) { return __hip_atomic_fetch_add(p, v, __ATOMIC_RELAXED, __HIP_MEMORY_SCOPE_AGENT); }
__device__ __forceinline__ unsigned xb_xcc_id() { return (unsigned)__builtin_amdgcn_s_getreg((3 << 11) | 20) & 0xFu; }
#define XB_SPIN(cond, bar) do { unsigned _sp = 0; while (cond) { __builtin_amdgcn_s_sleep(1); \
    if ((++_sp & 255u) == 0u) { if (xb_ld(&(bar)[XB_TMO])) break; if (_sp > XB_SPIN_CAP) { atomicAdd(&(bar)[XB_TMO], 1u); break; } } } } while (0)

struct XcdBarrier { unsigned* bar; unsigned x; volatile LAS unsigned* st; };

__device__ __forceinline__ XcdBarrier xcd_barrier_post(unsigned* bar, volatile LAS unsigned* st) {
    XcdBarrier b; b.bar = bar; b.x = xb_xcc_id(); b.st = st;
    if (threadIdx.x == 0) (void)xb_add(&bar[XB_XCNT(b.x)], 1u);
    return b;
}
__device__ __forceinline__ void xcd_barrier_complete(unsigned* bar, unsigned x, unsigned& nloc, unsigned& nx) {
    const unsigned G = gridDim.x * gridDim.y * gridDim.z;
    unsigned sum, cnt, mine, sp = 0u;
    for (;;) {
        sum = 0u; cnt = 0u; mine = 0u;
#pragma unroll
        for (unsigned j = 0; j < 16; ++j) { const unsigned c = xb_ld(&bar[XB_XCNT(j)]); sum += c; cnt += (c > 0u) ? 1u : 0u; mine = (j == x) ? c : mine; }
        if (sum == G) break;
        __builtin_amdgcn_s_sleep(1);
        if ((++sp & 255u) == 0u) { if (xb_ld(&bar[XB_TMO])) break; if (sp > XB_SPIN_CAP) { atomicAdd(&bar[XB_TMO], 1u); break; } }
    }
    nloc = mine > 0u ? mine : 1u; nx = cnt > 0u ? cnt : 1u;
}
__device__ __forceinline__ void xcd_barrier(const XcdBarrier& b) {
    asm volatile("s_waitcnt vmcnt(0)" ::: "memory");
    __syncthreads();
    if (threadIdx.x == 0) {
        unsigned* bar = b.bar;
        __builtin_amdgcn_s_waitcnt(0);
        unsigned nloc = b.st[0], nx = b.st[1];
        if (nloc == 0u) { xcd_barrier_complete(bar, b.x, nloc, nx); b.st[0] = nloc; b.st[1] = nx; }
        const unsigned old = xb_add(&bar[XB_XSUB(b.x)], 1u);
        const unsigned gen = old / nloc;
        if (old + 1u == (gen + 1u) * nloc) {
            __builtin_amdgcn_fence(__ATOMIC_RELEASE, "agent");
            asm volatile("s_waitcnt vmcnt(0)" ::: "memory");
            const unsigned og = xb_add(&bar[XB_TOP], 1u);
            const unsigned tg = og / nx;
            if (og + 1u == (tg + 1u) * nx) xb_add(&bar[XB_TOPGEN], 1u);
            else XB_SPIN(xb_ld(&bar[XB_TOPGEN]) == tg, bar);
            __builtin_amdgcn_fence(__ATOMIC_ACQUIRE, "agent");
            xb_add(&bar[XB_XGEN(b.x)], 1u);
            asm volatile("s_waitcnt vmcnt(0)" ::: "memory");
        } else {
            XB_SPIN(xb_ld(&bar[XB_XGEN(b.x)]) == gen, bar);
            __builtin_amdgcn_fence(__ATOMIC_ACQUIRE, "agent");
            asm volatile("s_waitcnt vmcnt(0)" ::: "memory");
        }
    }
    __syncthreads();
}

__device__ __forceinline__ unsigned f2bf(float f) { unsigned u = __builtin_bit_cast(unsigned, f); return (u + 0x7fffu + ((u >> 16) & 1u)) >> 16; }
__device__ __forceinline__ unsigned pk2(float lo, float hi) { return f2bf(lo) | (f2bf(hi) << 16); }
__device__ __forceinline__ unsigned pk4_f8(float a, float b, float c, float d) {
    a = __builtin_amdgcn_fmed3f(a, -448.f, 448.f); b = __builtin_amdgcn_fmed3f(b, -448.f, 448.f); c = __builtin_amdgcn_fmed3f(c, -448.f, 448.f); d = __builtin_amdgcn_fmed3f(d, -448.f, 448.f);
    int w = 0; w = __builtin_amdgcn_cvt_pk_fp8_f32(a, b, w, false); w = __builtin_amdgcn_cvt_pk_fp8_f32(c, d, w, true); return (unsigned)w; }
constexpr float F8_HS = 8.f, F8_WS = 128.f, F8_MS = 64.f;
__device__ __forceinline__ float bflo(unsigned u) { return __builtin_bit_cast(float, u << 16); }
__device__ __forceinline__ float bfhi(unsigned u) { return __builtin_bit_cast(float, u & 0xffff0000u); }
__device__ __forceinline__ float bf2f(bf16 u) { return __builtin_bit_cast(float, (unsigned)u << 16); }
__device__ __forceinline__ float wave_sum(float v) {
#pragma unroll
    for (int o = 1; o < 64; o <<= 1) v += __shfl_xor(v, o);
    return v;
}
__device__ __forceinline__ float wave_max(float v) {
#pragma unroll
    for (int o = 1; o < 64; o <<= 1) v = fmaxf(v, __shfl_xor(v, o));
    return v;
}
__device__ __forceinline__ float sigmoidf(float x) { return __builtin_amdgcn_rcpf(1.f + __expf(-x)); }
__device__ __forceinline__ float gelu_tanh(float x) { const float u = 0.7978845608028654f * (x + 0.044715f * x * x * x); return 0.5f * x * (1.f + tanhf(u)); }
__device__ __forceinline__ int t5_bucket(int n) {
    if (n < 16) return n;
    int b = 16;
    b += (n >= 22); b += (n >= 30); b += (n >= 40); b += (n >= 54); b += (n >= 73); b += (n >= 99); b += (n >= 134); b += (n >= 182);
    b += (n >= 246); b += (n >= 332); b += (n >= 450); b += (n >= 609); b += (n >= 825); b += (n >= 1117); b += (n >= 1513);
    return b;
}

struct Args {
    const float* in[23];
    float* out; unsigned char* ws;
    int ph_lo, ph_hi;
};

typedef float f32x2v __attribute__((ext_vector_type(2)));
__device__ __forceinline__ void ph0_mod(const Args& a, LAS unsigned char* lds) {
    const int tid = phase_tid(), lane = tid & 63, wave = __builtin_amdgcn_readfirstlane(tid >> 6);
    LAS float* cs = (LAS float*)lds;
    LAS float* red = (LAS float*)(lds + 32768);
    const float* c = a.in[1]; const float* w_ada = a.in[2]; const float* b_ada = a.in[3];
    float* mod = (float*)(a.ws + WS_MOD);
    for (int i = tid; i < 4 * 2048; i += NTHREADS) { const float v = c[i]; cs[i] = v / (1.f + __expf(-v)); }
    __syncthreads();
    for (int u = blockIdx.x; u < 12288 / 128; u += gridDim.x) {
        const int col = u * 128 + 2 * lane;
        float acc[4][2];
#pragma unroll
        for (int b = 0; b < 4; ++b) { acc[b][0] = 0.f; acc[b][1] = 0.f; }
        const float* wp = w_ada + (size_t)(wave * 256) * 12288 + col;
#pragma unroll 1
        for (int k0 = 0; k0 < 256; k0 += 16) {
            f32x2v w[16];
#pragma unroll
            for (int k = 0; k < 16; ++k) w[k] = *(const f32x2v*)(wp + (size_t)(k0 + k) * 12288);
#pragma unroll
            for (int k = 0; k < 16; ++k) { const int kk = wave * 256 + k0 + k;
#pragma unroll
                for (int b = 0; b < 4; ++b) { const float cv = cs[b * 2048 + kk]; acc[b][0] += cv * w[k].x; acc[b][1] += cv * w[k].y; } }
        }
#pragma unroll
        for (int b = 0; b < 4; ++b) { red[(wave * 4 + b) * 128 + 2 * lane] = acc[b][0]; red[(wave * 4 + b) * 128 + 2 * lane + 1] = acc[b][1]; }
        __syncthreads();
        { const int b = tid >> 7, cc = tid & 127; float s = 0.f;
#pragma unroll
          for (int w = 0; w < 8; ++w) s += red[(w * 4 + b) * 128 + cc];
          mod[b * 12288 + u * 128 + cc] = s + b_ada[u * 128 + cc]; }
        __syncthreads();
    }
}
__device__ __forceinline__ void transpose_item(const float* W, int ldw, int ncols, int K, bf16* WT, int row_off, LAS float* scr, int item, int lane, int ldt = 0) {
    if (ldt == 0) ldt = K;
    const int nblk = ncols / 32, kb = item / nblk, nb = item % nblk, k0 = 64 * kb, n0 = 32 * nb;
    float tv[32];
#pragma unroll
    for (int i = 0; i < 32; ++i) tv[i] = W[(size_t)(k0 + 2 * i + (lane >> 5)) * ldw + n0 + (lane & 31)];
#pragma unroll
    for (int i = 0; i < 32; ++i) scr[(2 * i + (lane >> 5)) * 33 + (lane & 31)] = tv[i];
    asm volatile("s_waitcnt lgkmcnt(0)" ::: "memory");
    const int c = lane & 7;
#pragma unroll
    for (int j = 0; j < 4; ++j) { const int n = (lane >> 3) + 8 * j; const LAS float* s = scr + (8 * c) * 33 + n;
        v4u o; o.x = pk2(s[0 * 33], s[1 * 33]); o.y = pk2(s[2 * 33], s[3 * 33]); o.z = pk2(s[4 * 33], s[5 * 33]); o.w = pk2(s[6 * 33], s[7 * 33]);
        *(v4u*)(WT + (size_t)(row_off + n0 + n) * ldt + k0 + 8 * c) = o; }
    asm volatile("s_waitcnt lgkmcnt(0)" ::: "memory");
}
__device__ __forceinline__ void transpose_item_f4(const float* W, int ldw, int ncols, int K, unsigned char* WT, LAS float* scr, int item, int lane, float inv) {
    const int nblk = ncols / 32, kb = item / nblk, nb = item % nblk, k0 = 64 * kb, n0 = 32 * nb;
    float tv[32];
#pragma unroll
    for (int i = 0; i < 32; ++i) tv[i] = W[(size_t)(k0 + 2 * i + (lane >> 5)) * ldw + n0 + (lane & 31)];
#pragma unroll
    for (int i = 0; i < 32; ++i) scr[(2 * i + (lane >> 5)) * 33 + (lane & 31)] = __builtin_amdgcn_fmed3f(tv[i] * inv, -6.f, 6.f);
    asm volatile("s_waitcnt lgkmcnt(0)" ::: "memory");
    const int c = lane & 7;
#pragma unroll
    for (int j = 0; j < 4; ++j) { const int n = (lane >> 3) + 8 * j; const LAS float* sp = scr + (8 * c) * 33 + n;
        unsigned q = 0u;
        q = __builtin_amdgcn_cvt_scalef32_pk_fp4_f32(q, sp[0 * 33], sp[1 * 33], 1.0f, 0); q = __builtin_amdgcn_cvt_scalef32_pk_fp4_f32(q, sp[2 * 33], sp[3 * 33], 1.0f, 1);
        q = __builtin_amdgcn_cvt_scalef32_pk_fp4_f32(q, sp[4 * 33], sp[5 * 33], 1.0f, 2); q = __builtin_amdgcn_cvt_scalef32_pk_fp4_f32(q, sp[6 * 33], sp[7 * 33], 1.0f, 3);
        *(unsigned*)(WT + (size_t)(n0 + n) * (K / 2) + (k0 + 8 * c) / 2) = q; }
    asm volatile("s_waitcnt lgkmcnt(0)" ::: "memory");
}
__device__ __forceinline__ void transpose_item_f8(const float* W, int ldw, int ncols, int K, unsigned char* WT, int row_off, LAS float* scr, int item, int lane) {
    const int nblk = ncols / 32, kb = item / nblk, nb = item % nblk, k0 = 64 * kb, n0 = 32 * nb;
    float tv[32];
#pragma unroll
    for (int i = 0; i < 32; ++i) tv[i] = W[(size_t)(k0 + 2 * i + (lane >> 5)) * ldw + n0 + (lane & 31)];
#pragma unroll
    for (int i = 0; i < 32; ++i) scr[(2 * i + (lane >> 5)) * 33 + (lane & 31)] = tv[i] * F8_WS;
    asm volatile("s_waitcnt lgkmcnt(0)" ::: "memory");
    const int c = lane & 7;
#pragma unroll
    for (int j = 0; j < 4; ++j) { const int n = (lane >> 3) + 8 * j; const LAS float* s = scr + (8 * c) * 33 + n;
        v2u o; o.x = pk4_f8(s[0 * 33], s[1 * 33], s[2 * 33], s[3 * 33]); o.y = pk4_f8(s[4 * 33], s[5 * 33], s[6 * 33], s[7 * 33]);
        *(v2u*)(WT + (size_t)(row_off + n0 + n) * K + k0 + 8 * c) = o; }
    asm volatile("s_waitcnt lgkmcnt(0)" ::: "memory");
}
__device__ __forceinline__ void ph0_weights(const Args& a, LAS unsigned char* lds) {
    const int tid = phase_tid(), lane = tid & 63, wave = __builtin_amdgcn_readfirstlane(tid >> 6);
    LAS float* scr = (LAS float*)(lds + wave * 16384);
    const int gw = blockIdx.x * NWAVES + wave, NGW = gridDim.x * NWAVES;
    const float* w_in = a.in[5];
    float wm_inv;
    { LAS float* red = (LAS float*)(lds + 8 * 16384);
      float ss = 0.f;
#pragma unroll
      for (int i = 0; i < 32; ++i) { const int e = i * NTHREADS + tid; const float v = w_in[(size_t)(e >> 10) * IN_COLS + OFF_MERGE + (e & 1023)]; ss += v * v; }
      ss = wave_sum(ss);
      if (lane == 0) red[wave] = ss;
      __syncthreads();
      float tot = 0.f;
#pragma unroll
      for (int w = 0; w < 8; ++w) tot += red[w];
      const float step = 0.48f * sqrtf(tot * (1.f / 16384.f));
      wm_inv = step > 0.f ? 1.f / step : 0.f;
      if (blockIdx.x == 0 && tid == 0) *(float*)(a.ws + WS_WMS) = step;
      __syncthreads(); }
    unsigned char* WIN = a.ws + WS_WIN;
    constexpr int I_Q = 32 * (NQ / 32), I_KV = 32 * (NKV / 32), I_DL = 32 * (NDL / 32), I_MG = 32 * (NMG / 32);
    constexpr int I_BN = 16 * 64, I_BD = 8 * 64, I_O = 32 * 64, I_PQ = 32 * 64;
    constexpr int NITEMS = I_Q + I_KV + I_DL + I_MG + I_BN + I_BD + I_O + I_PQ;
    for (int it = gw; it < NITEMS; it += NGW) {
        int r = it;
        if (r < I_Q)  { transpose_item_f8(w_in, IN_COLS, NQ, D, WIN, 0, scr, r, lane); continue; } r -= I_Q;
        if (r < I_KV) { transpose_item_f8(w_in + OFF_KV, IN_COLS, NKV, D, WIN, NQ, scr, r, lane); continue; } r -= I_KV;
        if (r < I_DL) { transpose_item_f8(w_in + OFF_DIL, IN_COLS, NDL, D, WIN, NQ + NKV, scr, r, lane); continue; } r -= I_DL;
        if (r < I_MG) { transpose_item_f4(w_in + OFF_MERGE, IN_COLS, NMG, D, a.ws + WS_WM4, scr, r, lane, wm_inv); continue; } r -= I_MG;
        if (r < I_BN) { transpose_item(a.in[13], D, D, 1024, (bf16*)(a.ws + WS_WBN), 0, scr, r, lane, 1536); continue; } r -= I_BN;
        if (r < I_BD) { transpose_item(a.in[14], D, D, 512, (bf16*)(a.ws + WS_WBN) + 1024, 0, scr, r, lane, 1536); continue; } r -= I_BD;
        if (r < I_O)  { transpose_item_f8(a.in[15], D, D, D, a.ws + WS_WOUT, 0, scr, r, lane); continue; } r -= I_O;
        transpose_item(a.in[17], D, D, D, (bf16*)(a.ws + WS_WPQ), 0, scr, r, lane);
    }
}

constexpr size_t WS_CW1F = 602 * MiB;
constexpr size_t WS_WGF = 604 * MiB;
constexpr size_t WS_CBP = 604 * MiB + 256 * 1024;
constexpr size_t WS_END4 = 605 * MiB;
__device__ __forceinline__ void ph0_extra(const Args& a) {
    const int tid = phase_tid(), lane = tid & 63, wave = __builtin_amdgcn_readfirstlane(tid >> 6);
    const float* w1 = a.in[9]; const float* pos = a.in[8]; const float* w_in = a.in[5];
    v4u* CW = (v4u*)(a.ws + WS_CW1F); v4u* WG = (v4u*)(a.ws + WS_WGF); float* CBP = (float*)(a.ws + WS_CBP);
    for (int i = blockIdx.x * NTHREADS + tid; i < 2 * 4 * 256 * 64; i += gridDim.x * NTHREADS) {
        const int ln = i & 63, ks = (i >> 6) & 255, nt = (i >> 14) & 3, j = i >> 16;
        const float* src = w1 + ((size_t)j * 4096 + 16 * ks + 8 * (ln >> 5)) * 128 + 32 * nt + (ln & 31);
        v4u o; o.x = pk2(src[0], src[128]); o.y = pk2(src[256], src[384]); o.z = pk2(src[512], src[640]); o.w = pk2(src[768], src[896]);
        CW[i] = o;
    }
    for (int i = blockIdx.x * NTHREADS + tid; i < 128 * 64; i += gridDim.x * NTHREADS) {
        const int ln = i & 63, ks = i >> 6, jrow = ln & 31;
        v4u o = {0u, 0u, 0u, 0u};
        if (jrow < 24) { const float* src = w_in + (size_t)(16 * ks + 8 * (ln >> 5)) * IN_COLS + OFF_GATE + jrow;
            o.x = pk2(src[0], src[IN_COLS]); o.y = pk2(src[2 * (size_t)IN_COLS], src[3 * (size_t)IN_COLS]); o.z = pk2(src[4 * (size_t)IN_COLS], src[5 * (size_t)IN_COLS]); o.w = pk2(src[6 * (size_t)IN_COLS], src[7 * (size_t)IN_COLS]); }
        WG[i] = o;
    }
    { const int gw = blockIdx.x * NWAVES + wave;
      if (gw < 128) { const int kc = gw >> 1, j = gw & 1; float s0 = 0.f, s1 = 0.f; const float* wp = w1 + ((size_t)j * 4096 + 64 * kc) * 128 + lane; const float* pp = pos + j * 4096 + 64 * kc;
#pragma unroll 1
          for (int k0 = 0; k0 < 64; k0 += 16) { float wa[16], wb[16];
#pragma unroll
              for (int k = 0; k < 16; ++k) { wa[k] = wp[(k0 + k) * 128]; wb[k] = wp[(k0 + k) * 128 + 64]; }
#pragma unroll
              for (int k = 0; k < 16; ++k) { const float pv = pp[k0 + k]; s0 += pv * wa[k]; s1 += pv * wb[k]; } }
          CBP[(kc * 2 + j) * 128 + lane] = s0; CBP[(kc * 2 + j) * 128 + 64 + lane] = s1; } }
}

template <bool F8 = false>
__device__ __forceinline__ void ph_norm(const Args& a, const float* xin, const float* gvec, int sh_off, int sc_off, bf16* hout, unsigned char* h8 = nullptr) {
    const int tid = phase_tid(), lane = tid & 63, wave = __builtin_amdgcn_readfirstlane(tid >> 6);
    const int gw = blockIdx.x * NWAVES + wave, NGW = gridDim.x * NWAVES;
    const float* mod = (const float*)(a.ws + WS_MOD);
    for (int r = gw; r < S / 2; r += NGW)
#pragma unroll 1
        for (int bq = 0; bq < NB; ++bq) {
            const int m0 = bq * S + r, m1 = m0 + S / 2;
            const float* x0 = xin + (size_t)m0 * D + 8 * lane; const float* x1 = xin + (size_t)m1 * D + 8 * lane;
            f32x4 v0[8], v1[8];
#pragma unroll
            for (int c = 0; c < 4; ++c) { v0[2 * c] = *(const f32x4*)(x0 + 512 * c); v0[2 * c + 1] = *(const f32x4*)(x0 + 512 * c + 4); v1[2 * c] = *(const f32x4*)(x1 + 512 * c); v1[2 * c + 1] = *(const f32x4*)(x1 + 512 * c + 4); }
            float s0 = 0.f, s1 = 0.f;
#pragma unroll
            for (int i = 0; i < 8; ++i) { s0 += (v0[i].x * v0[i].x + v0[i].y * v0[i].y) + (v0[i].z * v0[i].z + v0[i].w * v0[i].w); s1 += (v1[i].x * v1[i].x + v1[i].y * v1[i].y) + (v1[i].z * v1[i].z + v1[i].w * v1[i].w); }
            const float r0 = rsqrtf(wave_sum(s0) * (1.f / D) + EPS), r1 = rsqrtf(wave_sum(s1) * (1.f / D) + EPS);
            const float* shp = mod + bq * 12288 + sh_off + 8 * lane; const float* scp = mod + bq * 12288 + sc_off + 8 * lane; const float* gp = gvec + 8 * lane;
#pragma unroll
            for (int c = 0; c < 4; ++c) {
                v4u o0, o1; unsigned w0[4], w1[4]; [[maybe_unused]] unsigned q0[2], q1[2];
#pragma unroll
                for (int hq = 0; hq < 2; ++hq) { const f32x4 g = *(const f32x4*)(gp + 512 * c + 4 * hq), sc = *(const f32x4*)(scp + 512 * c + 4 * hq), sh = *(const f32x4*)(shp + 512 * c + 4 * hq);
                    const f32x4 ga = g * (1.f + sc); const f32x4 y0 = v0[2 * c + hq] * r0 * ga + sh, y1 = v1[2 * c + hq] * r1 * ga + sh;
                    if constexpr (F8) { v0[2 * c + hq] = y0; v1[2 * c + hq] = y1; }
                    w0[2 * hq] = pk2(y0.x, y0.y); w0[2 * hq + 1] = pk2(y0.z, y0.w); w1[2 * hq] = pk2(y1.x, y1.y); w1[2 * hq + 1] = pk2(y1.z, y1.w);
                    if constexpr (F8) { q0[hq] = pk4_f8(y0.x * F8_HS, y0.y * F8_HS, y0.z * F8_HS, y0.w * F8_HS); q1[hq] = pk4_f8(y1.x * F8_HS, y1.y * F8_HS, y1.z * F8_HS, y1.w * F8_HS); } }
                o0.x = w0[0]; o0.y = w0[1]; o0.z = w0[2]; o0.w = w0[3]; o1.x = w1[0]; o1.y = w1[1]; o1.z = w1[2]; o1.w = w1[3];
                *(v4u*)(hout + (size_t)m0 * D + 512 * c + 8 * lane) = o0; *(v4u*)(hout + (size_t)m1 * D + 512 * c + 8 * lane) = o1;
                if constexpr (F8) { v2u p0, p1; p0.x = q0[0]; p0.y = q0[1]; p1.x = q1[0]; p1.y = q1[1];
                    *(v2u*)(h8 + (size_t)m0 * D + 512 * c + 8 * lane) = p0; *(v2u*)(h8 + (size_t)m1 * D + 512 * c + 8 * lane) = p1; }
            }
            if constexpr (F8) {
                float t0 = 0.f, t1 = 0.f;
#pragma unroll
                for (int i = 0; i < 8; ++i) { t0 += (v0[i].x * v0[i].x + v0[i].y * v0[i].y) + (v0[i].z * v0[i].z + v0[i].w * v0[i].w); t1 += (v1[i].x * v1[i].x + v1[i].y * v1[i].y) + (v1[i].z * v1[i].z + v1[i].w * v1[i].w); }
                const float st0 = 0.48f * sqrtf(wave_sum(t0) * (1.f / D)), st1 = 0.48f * sqrtf(wave_sum(t1) * (1.f / D));
                const float i0 = st0 > 0.f ? 1.f / st0 : 0.f, i1 = st1 > 0.f ? 1.f / st1 : 0.f;
                unsigned char* h4 = a.ws + WS_H4; float* hs = (float*)(a.ws + WS_HS);
#pragma unroll
                for (int c = 0; c < 4; ++c) { unsigned qa = 0u, qb = 0u; const f32x4 a0 = v0[2 * c] * i0, a1 = v0[2 * c + 1] * i0, b0 = v1[2 * c] * i1, b1 = v1[2 * c + 1] * i1;
#define F4C(x) __builtin_amdgcn_fmed3f((x), -6.f, 6.f)
                    qa = __builtin_amdgcn_cvt_scalef32_pk_fp4_f32(qa, F4C(a0.x), F4C(a0.y), 1.0f, 0); qa = __builtin_amdgcn_cvt_scalef32_pk_fp4_f32(qa, F4C(a0.z), F4C(a0.w), 1.0f, 1);
                    qa = __builtin_amdgcn_cvt_scalef32_pk_fp4_f32(qa, F4C(a1.x), F4C(a1.y), 1.0f, 2); qa = __builtin_amdgcn_cvt_scalef32_pk_fp4_f32(qa, F4C(a1.z), F4C(a1.w), 1.0f, 3);
                    qb = __builtin_amdgcn_cvt_scalef32_pk_fp4_f32(qb, F4C(b0.x), F4C(b0.y), 1.0f, 0); qb = __builtin_amdgcn_cvt_scalef32_pk_fp4_f32(qb, F4C(b0.z), F4C(b0.w), 1.0f, 1);
                    qb = __builtin_amdgcn_cvt_scalef32_pk_fp4_f32(qb, F4C(b1.x), F4C(b1.y), 1.0f, 2); qb = __builtin_amdgcn_cvt_scalef32_pk_fp4_f32(qb, F4C(b1.z), F4C(b1.w), 1.0f, 3);
#undef F4C
                    *(unsigned*)(h4 + (size_t)m0 * (D / 2) + 256 * c + 4 * lane) = qa; *(unsigned*)(h4 + (size_t)m1 * (D / 2) + 256 * c + 4 * lane) = qb; }
                if (lane == 0) { hs[m0] = st0; hs[m1] = st1; }
            }
        }
}

using pg8::Unit; using pg8::HALF; using pg8::BM;
struct EpiProj {
    static constexpr bool PERM = true;
    bf16 *q, *kv, *dl, *mg;
    __device__ __forceinline__ void operator()(const f32x4 (&acc)[2][2][4][2], const Unit& u, int wr, int wc, int fr, int fq) const {
        bf16* base; int ldc, colt = u.pn * BM;
        if (colt < NQ) { base = q; ldc = NQ; } else if (colt < NQ + NKV) { base = kv; ldc = NKV; colt -= NQ; } else if (colt < NQ + NKV + NDL) { base = dl; ldc = NDL; colt -= NQ + NKV; } else { base = mg; ldc = NMG; colt -= NQ + NKV + NDL; }
        const int row0 = u.pm * BM + wr * 64 + fr, col0 = colt + wc * 32 + 8 * fq;
#pragma unroll
        for (int ai = 0; ai < 2; ++ai)
#pragma unroll
            for (int m = 0; m < 4; ++m) { bf16* rowp = base + (size_t)(row0 + ai * HALF + m * 16) * ldc + col0;
#pragma unroll
                for (int bj = 0; bj < 2; ++bj) { const f32x4 v0 = acc[ai][bj][m][0], v1 = acc[ai][bj][m][1];
                    v4u w; w.x = pg8::cvt_pk_bf16(v0[0], v0[1]); w.y = pg8::cvt_pk_bf16(v0[2], v0[3]); w.z = pg8::cvt_pk_bf16(v1[0], v1[1]); w.w = pg8::cvt_pk_bf16(v1[2], v1[3]);
                    *(v4u*)(rowp + bj * HALF) = w; } }
    }
};
struct MidMerge {
    static constexpr int AT = 16;
    const bf16* mg;
    __device__ __forceinline__ void operator()(f32x4 (&acc)[2][2][4][2], const Unit& u, int wr, int wc, int fr, int fq) const {
        int lo = (fq * 16 + fr) * 8;
        asm volatile("" : "+v"(lo));
        const bf16* t1 = mg + (((size_t)(u.pm * 16 + u.pn) * 8 + (wr * 4 + wc)) << 13) + lo; const bf16* t2 = t1 + ((size_t)8 << 16);
#pragma unroll
        for (int ai = 0; ai < 2; ++ai) {
            v4u a1[4][2], a2[4][2];
#pragma unroll
            for (int m = 0; m < 4; ++m)
#pragma unroll
                for (int bj = 0; bj < 2; ++bj) { a1[m][bj] = *(const v4u*)(t1 + ((ai * 4 + m) * 2 + bj) * 512); a2[m][bj] = *(const v4u*)(t2 + ((ai * 4 + m) * 2 + bj) * 512); }
#pragma unroll
            for (int m = 0; m < 4; ++m)
#pragma unroll
                for (int bj = 0; bj < 2; ++bj) { const unsigned w1[4] = {a1[m][bj].x, a1[m][bj].y, a1[m][bj].z, a1[m][bj].w}, w2[4] = {a2[m][bj].x, a2[m][bj].y, a2[m][bj].z, a2[m][bj].w};
#pragma unroll
                    for (int q = 0; q < 4; ++q) { const float r0 = (1.f + __expf(-bflo(w2[q]))) * __builtin_amdgcn_rcpf(1.f + __expf(-bflo(w1[q]))), r1 = (1.f + __expf(-bfhi(w2[q]))) * __builtin_amdgcn_rcpf(1.f + __expf(-bfhi(w1[q])));
                        acc[ai][bj][m][q >> 1][2 * (q & 1)] *= r0; acc[ai][bj][m][q >> 1][2 * (q & 1) + 1] *= r1; } }
            asm volatile("" ::: "memory");
        }
    }
};
struct EpiMerge {
    static constexpr bool PERM = true;
    const bf16* mg; unsigned char* merged8; float os;
    __device__ __forceinline__ void operator()(const f32x4 (&acc)[2][2][4][2], const Unit& u, int wr, int wc, int fr, int fq) const {
        int row0 = u.pm * BM + wr * 64 + fr; const int col0 = u.pn * BM + wc * 32 + 8 * fq;
        asm volatile("" : "+v"(row0));
        const bf16* t2 = mg + (((size_t)(u.pm * 16 + 8 + u.pn) * 8 + (wr * 4 + wc)) << 13) + (fq * 16 + fr) * 8;
        v4u a2[2][4][2];
#pragma unroll
        for (int ai = 0; ai < 2; ++ai)
#pragma unroll
            for (int m = 0; m < 4; ++m)
#pragma unroll
                for (int bj = 0; bj < 2; ++bj) a2[ai][m][bj] = *(const v4u*)(t2 + ((ai * 4 + m) * 2 + bj) * 512);
#pragma unroll
        for (int ai = 0; ai < 2; ++ai)
#pragma unroll
            for (int m = 0; m < 4; ++m) { const size_t row = (size_t)(row0 + ai * HALF + m * 16);
#pragma unroll
                for (int bj = 0; bj < 2; ++bj) { const unsigned w2[4] = {a2[ai][m][bj].x, a2[ai][m][bj].y, a2[ai][m][bj].z, a2[ai][m][bj].w};
                    const f32x4 v0 = acc[ai][bj][m][0] * os, v1 = acc[ai][bj][m][1] * os;
                    v2u w; w.x = pk4_f8(v0[0] * sigmoidf(bflo(w2[0])), v0[1] * sigmoidf(bfhi(w2[0])), v0[2] * sigmoidf(bflo(w2[1])), v0[3] * sigmoidf(bfhi(w2[1])));
                    w.y = pk4_f8(v1[0] * sigmoidf(bflo(w2[2])), v1[1] * sigmoidf(bfhi(w2[2])), v1[2] * sigmoidf(bflo(w2[3])), v1[3] * sigmoidf(bfhi(w2[3])));
                    *(v2u*)(merged8 + row * D + col0 + bj * HALF) = w; } }
    }
};
struct EpiOut {
    static constexpr bool PERM = false;
    const float* x; const float* mod; float* x1; float as;
    __device__ __forceinline__ void operator()(const f32x4 (&acc)[2][2][4][2], const Unit& u, int wr, int wc, int fr, int fq) const {
        const int row0 = u.pm * BM + wr * 64 + fr, col0 = u.pn * BM + wc * 32 + 4 * fq;
        const int b = (u.pm * BM) / S;
        f32x4 gv[2][2];
#pragma unroll
        for (int bj = 0; bj < 2; ++bj)
#pragma unroll
            for (int n = 0; n < 2; ++n) gv[bj][n] = *(const f32x4*)(mod + b * 12288 + 4096 + col0 + bj * HALF + n * 16) * as;
#pragma unroll
        for (int ai = 0; ai < 2; ++ai)
#pragma unroll
            for (int m = 0; m < 4; ++m) { const size_t off = (size_t)(row0 + ai * HALF + m * 16) * D + col0;
#pragma unroll
                for (int bj = 0; bj < 2; ++bj)
#pragma unroll
                    for (int n = 0; n < 2; ++n) *(f32x4*)(x1 + off + bj * HALF + n * 16) = *(const f32x4*)(x + off + bj * HALF + n * 16) + gv[bj][n] * acc[ai][bj][m][n]; }
    }
};
struct EpiF32 {
    static constexpr bool PERM = false;
    float* C; int ldc;
    __device__ __forceinline__ void operator()(const f32x4 (&acc)[2][2][4][2], const Unit& u, int wr, int wc, int fr, int fq) const {
        const int row0 = u.pm * BM + wr * 64 + fr, col0 = u.pn * BM + wc * 32 + 4 * fq;
#pragma unroll
        for (int ai = 0; ai < 2; ++ai)
#pragma unroll
            for (int m = 0; m < 4; ++m) { float* rowp = C + (size_t)(row0 + ai * HALF + m * 16) * ldc + col0;
#pragma unroll
                for (int bj = 0; bj < 2; ++bj)
#pragma unroll
                    for (int n = 0; n < 2; ++n) *(f32x4*)(rowp + bj * HALF + n * 16) = acc[ai][bj][m][n]; }
    }
};

typedef short bf16x8 __attribute__((ext_vector_type(8)));
typedef float f32x16 __attribute__((ext_vector_type(16)));
typedef float f32x2 __attribute__((ext_vector_type(2)));
typedef __bf16 bf2v __attribute__((ext_vector_type(2)));
constexpr float LOG2E = 1.4426950408889634f;
constexpr float QS2 = QSCALE * LOG2E;
constexpr float NEGB = -1e30f;
__device__ __forceinline__ unsigned pkbf(float a, float b) { const f32x2 v = {a, b}; const bf2v r = __builtin_convertvector(v, bf2v); return __builtin_bit_cast(unsigned, r); }
__device__ __forceinline__ float ex2(float x) { return __builtin_amdgcn_exp2f(x); }
__device__ __forceinline__ int swap23(int x) { return (x & ~12) | ((x & 4) << 1) | ((x & 8) >> 1); }
__device__ __forceinline__ size_t kf_off(int key, int d) { return ((size_t)((key >> 5) * 8 + (d >> 4)) * 64 + ((d >> 3) & 1) * 32 + swap23(key & 31)) * 8 + (d & 7); }
__device__ __forceinline__ size_t vf_off(int key, int d) { const int kk = key & 31; return ((size_t)(((key >> 5) * 4 + (d >> 5)) * 2 + (kk >> 4)) * 64 + ((kk >> 3) & 1) * 32 + (d & 31)) * 8 + (kk & 7); }
__device__ __forceinline__ size_t kf8_off(int key, int d) { return ((size_t)((key >> 5) * 4 + (d >> 5)) * 64 + ((d >> 3) & 1) * 32 + swap23(key & 31)) * 16 + ((d >> 4) & 1) * 8 + (d & 7); }
__device__ __forceinline__ size_t vf8_off(int key, int d) { const int kk = key & 31; return ((size_t)((key >> 5) * 4 + (d >> 5)) * 64 + ((kk >> 3) & 1) * 32 + (d & 31)) * 16 + (kk >> 4) * 8 + (kk & 7); }
__device__ __forceinline__ unsigned char* fr8_nsa(const Args& a, int bg, int kind) { return (unsigned char*)a.out + ((size_t)(bg * 4 + kind) << 19); }
__device__ __forceinline__ unsigned char* fr8_dil(const Args& a, int b, int head, int kv) { return (unsigned char*)a.out + ((size_t)16 << 20) + ((size_t)((b * 12 + head) * 2 + kv) << 19); }
__device__ __forceinline__ bf16* fr_nsa(const Args& a, int bg, int kind) { return (bf16*)a.out + ((size_t)(bg * 4 + kind) << 19); }
__device__ __forceinline__ bf16* fr_dil(const Args& a, int b, int head, int kv) { return (bf16*)a.out + ((size_t)16 << 20) + ((size_t)((b * 12 + head) * 2 + kv) << 19); }
constexpr size_t WS_OD = 552 * MiB;
constexpr size_t WS_LSE = 600 * MiB;
constexpr size_t WS_END2 = 601 * MiB;

struct EpiProjNorm {
    static constexpr bool PERM = true;
    bf16 *q, *kv, *dl, *mg, *frg;
    const float *qg, *kg, *dqg, *dkg;
    LAS float* xch;
    float as;
    __device__ __forceinline__ void operator()(const f32x4 (&acc)[2][2][4][2], const Unit& u, int wr, int wc, int fr, int fq) const {
        bf16* base; int ldc, colt = u.pn * BM, mode = 0  , hsel = 0; const float* gain = qg; float scale = 1.f;
        if (colt < NQ) { base = q; ldc = NQ; mode = 1; gain = qg; scale = QS2; }
        else if (colt < NQ + NKV) { base = kv; ldc = NKV; colt -= NQ; hsel = colt >> 7; if (hsel == 4 || hsel == 8) { mode = 2; gain = kg + (hsel == 4 ? 128 : 256); } }
        else if (colt < NQ + NKV + NDL) { base = dl; ldc = NDL; colt -= NQ + NKV; hsel = colt >> 7; if (hsel < 12) { mode = 1; gain = dqg; scale = QS2; } else if (hsel < 24) { mode = 3; gain = dkg; } }
        else { base = mg; ldc = NMG; colt -= NQ + NKV + NDL; }
        const int row0 = u.pm * BM + wr * 64 + fr, col0 = colt + wc * 32 + 8 * fq;
        if (base == mg) {
            bf16* tp = mg + (((size_t)(u.pm * 16 + (colt >> 8)) * 8 + (wr * 4 + wc)) << 13) + (fq * 16 + fr) * 8;
#pragma unroll
            for (int ai = 0; ai < 2; ++ai)
#pragma unroll
                for (int m = 0; m < 4; ++m)
#pragma unroll
                    for (int bj = 0; bj < 2; ++bj) { const f32x4 v0 = acc[ai][bj][m][0] * as, v1 = acc[ai][bj][m][1] * as;
                        v4u w; w.x = pg8::cvt_pk_bf16(v0[0], v0[1]); w.y = pg8::cvt_pk_bf16(v0[2], v0[3]); w.z = pg8::cvt_pk_bf16(v1[0], v1[1]); w.w = pg8::cvt_pk_bf16(v1[2], v1[3]);
                        *(v4u*)(tp + ((ai * 4 + m) * 2 + bj) * 512) = w; }
            return;
        }
        if (mode == 0) {
#pragma unroll
            for (int ai = 0; ai < 2; ++ai)
#pragma unroll
                for (int m = 0; m < 4; ++m) { bf16* rowp = base + (size_t)(row0 + ai * HALF + m * 16) * ldc + col0;
#pragma unroll
                    for (int bj = 0; bj < 2; ++bj) { const f32x4 v0 = acc[ai][bj][m][0] * as, v1 = acc[ai][bj][m][1] * as;
                        v4u w; w.x = pg8::cvt_pk_bf16(v0[0], v0[1]); w.y = pg8::cvt_pk_bf16(v0[2], v0[3]); w.z = pg8::cvt_pk_bf16(v1[0], v1[1]); w.w = pg8::cvt_pk_bf16(v1[2], v1[3]);
                        *(v4u*)(rowp + bj * HALF) = w; } }
            return;
        }
#pragma unroll
        for (int ai = 0; ai < 2; ++ai)
#pragma unroll
            for (int m = 0; m < 4; ++m)
#pragma unroll
                for (int bj = 0; bj < 2; ++bj) { const f32x4 v0 = acc[ai][bj][m][0], v1 = acc[ai][bj][m][1];
                    float ss = (v0[0] * v0[0] + v0[1] * v0[1]) + (v0[2] * v0[2] + v0[3] * v0[3]) + (v1[0] * v1[0] + v1[1] * v1[1]) + (v1[2] * v1[2] + v1[3] * v1[3]);
                    ss += __shfl_xor(ss, 16); ss += __shfl_xor(ss, 32);
                    if (fq == 0) xch[(((((wr * 2 + ai) * 4 + m) * 16 + fr) * 2 + bj) << 2) + wc] = ss; }
        asm volatile("s_waitcnt lgkmcnt(0)" ::: "memory");
        __builtin_amdgcn_s_barrier();
        asm volatile("" ::: "memory");
        const f32x4 ga = *(const f32x4*)(gain + wc * 32 + 8 * fq), gb = *(const f32x4*)(gain + wc * 32 + 8 * fq + 4);
#pragma unroll
        for (int ai = 0; ai < 2; ++ai)
#pragma unroll
            for (int m = 0; m < 4; ++m) { const int t = row0 + ai * HALF + m * 16, b = t / S, s = t % S;
#pragma unroll
                for (int bj = 0; bj < 2; ++bj) { const f32x4 pp = *(const LAS f32x4*)(xch + (((((wr * 2 + ai) * 4 + m) * 16 + fr) * 2 + bj) << 2));
                    const float rstd = rsqrtf(((pp.x + pp.y) + (pp.z + pp.w)) * (as * as * (1.f / 128.f)) + EPS) * (scale * as);
                    const f32x4 v0 = acc[ai][bj][m][0] * rstd * ga, v1 = acc[ai][bj][m][1] * rstd * gb;
                    if (mode == 1) { v4u w; w.x = pg8::cvt_pk_bf16(v0[0], v0[1]); w.y = pg8::cvt_pk_bf16(v0[2], v0[3]); w.z = pg8::cvt_pk_bf16(v1[0], v1[1]); w.w = pg8::cvt_pk_bf16(v1[2], v1[3]);
                        *(v4u*)(base + (size_t)t * ldc + col0 + bj * HALF) = w; }
                    else { v2u w; w.x = pk4_f8(v0[0], v0[1], v0[2], v0[3]); w.y = pk4_f8(v1[0], v1[1], v1[2], v1[3]);
                        unsigned char* dst;
                        if (mode == 2) dst = (unsigned char*)frg + ((size_t)((b * 2 + bj) * 4 + (hsel == 4 ? 0 : 2)) << 19) + kf8_off(s, wc * 32 + 8 * fq);
                        else { const int head = hsel - 12 + bj, dsh = 2 * (head >> 2), vk = ((s & ((1 << dsh) - 1)) << (12 - dsh)) + (s >> dsh);
                            dst = (unsigned char*)frg + ((size_t)16 << 20) + ((size_t)((b * 12 + head) * 2) << 19) + kf8_off(vk, wc * 32 + 8 * fq); }
                        *(v2u*)dst = w; } } }
    }
};

__device__ __forceinline__ v4u norm_chunk16v(v4u w, const float* gain, float scale, int li) {
    float v[8] = {bflo(w.x), bfhi(w.x), bflo(w.y), bfhi(w.y), bflo(w.z), bfhi(w.z), bflo(w.w), bfhi(w.w)};
    float ss = 0.f;
#pragma unroll
    for (int j = 0; j < 8; ++j) ss += v[j] * v[j];
    ss += __shfl_xor(ss, 1); ss += __shfl_xor(ss, 2); ss += __shfl_xor(ss, 4); ss += __shfl_xor(ss, 8);
    const float rstd = rsqrtf(ss * (1.f / 128.f) + EPS) * scale;
#pragma unroll
    for (int j = 0; j < 8; ++j) v[j] = v[j] * rstd * gain[8 * li + j];
    w.x = pk2(v[0], v[1]); w.y = pk2(v[2], v[3]); w.z = pk2(v[4], v[5]); w.w = pk2(v[6], v[7]);
    return w;
}
__device__ __forceinline__ void ph3_headnorm(const Args& a) {
    const int tid = phase_tid(), lane = tid & 63, wave = __builtin_amdgcn_readfirstlane(tid >> 6), sub = lane >> 4, li = lane & 15;
    const int gw = blockIdx.x * NWAVES + wave, NGW = gridDim.x * NWAVES;
    bf16* Q = (bf16*)(a.ws + WS_Q); const bf16* KV = (const bf16*)(a.ws + WS_KV); bf16* DL = (bf16*)(a.ws + WS_DL);
    const float* qg = a.in[6]; const float* kg = a.in[7]; const float* dqg = a.in[11]; const float* dkg = a.in[12];
    for (int m = gw; m < T; m += NGW) {
        const int b = m / S, s = m % S;
        const int g = sub & 1, win = sub >> 1;
        v4u wq[2], wk, wd[6];
#pragma unroll
        for (int it = 0; it < 2; ++it) wq[it] = *(const v4u*)(Q + (size_t)m * NQ + (it * 4 + sub) * 128 + 8 * li);
        wk = *(const v4u*)(KV + (size_t)m * NKV + ((win ? 8 : 4) + g) * 128 + 8 * li);
#pragma unroll
        for (int it = 0; it < 6; ++it) wd[it] = *(const v4u*)(DL + (size_t)m * NDL + (it * 4 + sub) * 128 + 8 * li);
#pragma unroll
        for (int it = 0; it < 2; ++it) *(v4u*)(Q + (size_t)m * NQ + (it * 4 + sub) * 128 + 8 * li) = norm_chunk16v(wq[it], qg, QS2, li);
        *(v4u*)(fr_nsa(a, b * 2 + g, win ? 2 : 0) + kf_off(s, 8 * li)) = norm_chunk16v(wk, kg + (win ? 256 : 128), 1.f, li);
#pragma unroll
        for (int it = 0; it < 6; ++it) { const int ch = it * 4 + sub;
            if (ch < 12) *(v4u*)(DL + (size_t)m * NDL + ch * 128 + 8 * li) = norm_chunk16v(wd[it], dqg, QS2, li);
            else { const int head = ch - 12, gi = head >> 2, dsh = 2 * gi  , vk = ((s & ((1 << dsh) - 1)) << (12 - dsh)) + (s >> dsh);
                *(v4u*)(fr_dil(a, b, head, 0) + kf_off(vk, 8 * li)) = norm_chunk16v(wd[it], dkg, 1.f, li); } }
    }
}
__device__ __forceinline__ void ph3_vfrag(const Args& a) {
    const int tid = phase_tid(), lane = tid & 63, wave = __builtin_amdgcn_readfirstlane(tid >> 6);
    const int gw = blockIdx.x * NWAVES + wave, NGW = gridDim.x * NWAVES;
    const bf16* KV = (const bf16*)(a.ws + WS_KV); const bf16* DL = (const bf16*)(a.ws + WS_DL);
    for (int job = gw; job < 32768; job += NGW) {
        const bf16* src; size_t rstride; unsigned char* dst; int key0;
        if (job < 8192) { const int bg = job >> 10, kind = (job >> 9) & 1, s0 = (job & 511) * 8, b = bg >> 1, g = bg & 1;
            src = KV + (size_t)(b * S + s0) * NKV + ((kind ? 10 : 6) + g) * 128; rstride = NKV; dst = fr8_nsa(a, bg, kind ? 3 : 1); key0 = s0; }
        else { const int j2 = job - 8192, bh = j2 >> 9, vk0 = (j2 & 511) * 8, b = bh / 12, head = bh % 12, gi = head >> 2, dsh = 2 * gi, L = S >> dsh, r = vk0 / L, m0 = vk0 % L;
            src = DL + (size_t)(b * S + (m0 << dsh) + r) * NDL + (24 + head) * 128; rstride = (size_t)NDL << dsh; dst = fr8_dil(a, b, head, 1); key0 = vk0; }
        unsigned w[8];
#pragma unroll
        for (int jj = 0; jj < 8; ++jj) w[jj] = *(const unsigned*)(src + jj * rstride + 2 * lane);
        v2u c0, c1;
        c0.x = pk4_f8(bflo(w[0]), bflo(w[1]), bflo(w[2]), bflo(w[3])); c0.y = pk4_f8(bflo(w[4]), bflo(w[5]), bflo(w[6]), bflo(w[7]));
        c1.x = pk4_f8(bfhi(w[0]), bfhi(w[1]), bfhi(w[2]), bfhi(w[3])); c1.y = pk4_f8(bfhi(w[4]), bfhi(w[5]), bfhi(w[6]), bfhi(w[7]));
        *(v2u*)(dst + vf8_off(key0, 2 * lane)) = c0; *(v2u*)(dst + vf8_off(key0, 2 * lane + 1)) = c1;
    }
}
struct EpiMG {
    static constexpr bool PERM = true;
    bf16* mg; const float* hs; const float* wms;
    __device__ __forceinline__ void operator()(const f32x4 (&acc)[2][2][4][2], const Unit& u, int wr, int wc, int fr, int fq) const {
        const int row0 = u.pm * BM + wr * 64 + fr; const float ws = *wms;
        bf16* tp = mg + (((size_t)(u.pm * 16 + u.pn) * 8 + (wr * 4 + wc)) << 13) + (fq * 16 + fr) * 8;
#pragma unroll
        for (int ai = 0; ai < 2; ++ai)
#pragma unroll
            for (int m = 0; m < 4; ++m) { const float sc = hs[row0 + ai * HALF + m * 16] * ws;
#pragma unroll
                for (int bj = 0; bj < 2; ++bj) { const f32x4 v0 = acc[ai][bj][m][0] * sc, v1 = acc[ai][bj][m][1] * sc;
                    v4u w; w.x = pg8::cvt_pk_bf16(v0[0], v0[1]); w.y = pg8::cvt_pk_bf16(v0[2], v0[3]); w.z = pg8::cvt_pk_bf16(v1[0], v1[1]); w.w = pg8::cvt_pk_bf16(v1[2], v1[3]);
                    *(v4u*)(tp + ((ai * 4 + m) * 2 + bj) * 512) = w; } }
    }
};
__device__ __forceinline__ void ph3_gates(const Args& a) {
    const int tid = phase_tid(), lane = tid & 63, wave = __builtin_amdgcn_readfirstlane(tid >> 6), tl = lane & 31, hh = lane >> 5;
    const int gw = (gridDim.x - 1 - blockIdx.x) * NWAVES + wave, NGW = gridDim.x * NWAVES;
    const bf16* H = (const bf16*)(a.ws + WS_H); const v4u* WG = (const v4u*)(a.ws + WS_WGF) + lane; float* gates = (float*)(a.ws + WS_GATES);
    for (int job = gw; job < T / 32; job += NGW) {
        const int t = job * 32 + tl; const bf16* hr = H + (size_t)t * D + 8 * hh;
        f32x16 acc;
#pragma unroll
        for (int i = 0; i < 16; ++i) acc[i] = 0.f;
#pragma unroll 16
        for (int ks = 0; ks < 128; ++ks) { const bf16x8 af = __builtin_bit_cast(bf16x8, WG[ks * 64]), bfr = __builtin_bit_cast(bf16x8, *(const v4u*)(hr + 16 * ks));
            acc = __builtin_amdgcn_mfma_f32_32x32x16_bf16(af, bfr, acc, 0, 0, 0); }
#pragma unroll
        for (int i = 0; i < 16; ++i) { const int j = (i & 3) + 8 * (i >> 2) + 4 * hh; const float v = acc[i]; if (j < 24) gates[(size_t)t * 24 + j] = sigmoidf(v); }
    }
}
__device__ __forceinline__ void ph3_compress(const Args& a, LAS unsigned char* lds) {
    const int tid = phase_tid(), lane = tid & 63, wave = __builtin_amdgcn_readfirstlane(tid >> 6), cl = lane & 31, hh = lane >> 5;
    LAS float* part = (LAS float*)lds;
    LAS float* hid = part + 2 * 128 * 32;
    LAS float* ob = hid + 32 * 128;
    LAS float* bias = ob + 32 * 128;
    const bf16* KV = (const bf16*)(a.ws + WS_KV);
    const float* w2 = a.in[10]; const float* kg0 = a.in[7]; const float* CBP = (const float*)(a.ws + WS_CBP);
    for (int u = blockIdx.x; u < 128; u += gridDim.x) {
        const int j = u >> 6, bg = (u >> 3) & 7, ct = u & 7, b = bg >> 1, g = bg & 1, c0 = 32 * ct, hhd = j * 2 + g;
        if (tid < 128) { float s = 0.f;
#pragma unroll
            for (int kc = 0; kc < 64; ++kc) s += CBP[(kc * 2 + j) * 128 + tid];
            bias[tid] = s; }
        { const int nt = wave & 3, kh = wave >> 2, c = c0 + cl;
          const v4u* af = (const v4u*)(a.ws + WS_CW1F) + ((size_t)(j * 4 + nt) * 256 + 128 * kh) * 64 + lane;
          f32x16 acc;
#pragma unroll
          for (int i = 0; i < 16; ++i) acc[i] = 0.f;
#pragma unroll 16
          for (int ks = 0; ks < 128; ++ks) { const int k = 16 * (128 * kh + ks) + 8 * hh, l = k >> 7, d = k & 127, p = 16 * c + l;
              v4u x = {0u, 0u, 0u, 0u}; if (p < S) x = *(const v4u*)(KV + (size_t)(b * S + p) * NKV + hhd * 128 + d);
              acc = __builtin_amdgcn_mfma_f32_32x32x16_bf16(__builtin_bit_cast(bf16x8, af[ks * 64]), __builtin_bit_cast(bf16x8, x), acc, 0, 0, 0); }
#pragma unroll
          for (int i = 0; i < 16; ++i) { const int n = 32 * nt + (i & 3) + 8 * (i >> 2) + 4 * hh; const float v = acc[i]; part[(kh * 128 + n) * 32 + cl] = v; } }
        __syncthreads();
        for (int i = tid; i < 128 * 32; i += NTHREADS) { const int n = i >> 5, c = i & 31; hid[c * 128 + n] = gelu_tanh(part[i] + part[128 * 32 + i] + bias[n]); }
        __syncthreads();
        { const int n = tid & 127, cq = tid >> 7; float o[8];
#pragma unroll
          for (int r = 0; r < 8; ++r) o[r] = 0.f;
          const float* w2p = w2 + j * 128 * 128 + n;
          for (int k = 0; k < 128; ++k) { const float w = w2p[k * 128];
#pragma unroll
              for (int r = 0; r < 8; ++r) o[r] += hid[(8 * cq + r) * 128 + k] * w; }
#pragma unroll
          for (int r = 0; r < 8; ++r) ob[(8 * cq + r) * 128 + n] = o[r]; }
        __syncthreads();
        bf16* fr = (bf16*)(a.ws + (j == 0 ? WS_KC : WS_VC)) + (size_t)bg * 8 * 4096;
#pragma unroll 1
        for (int r = 0; r < 4; ++r) { const int cr = 4 * wave + r, c = c0 + cr; float v0 = ob[cr * 128 + 2 * lane], v1 = ob[cr * 128 + 2 * lane + 1];
            if (j == 0) { const float rstd = rsqrtf(wave_sum(v0 * v0 + v1 * v1) * (1.f / 128.f) + EPS); v0 = v0 * rstd * kg0[2 * lane]; v1 = v1 * rstd * kg0[2 * lane + 1]; }
            if (c >= NC) { v0 = 0.f; v1 = 0.f; }
            if (j == 0) *(unsigned*)(fr + kf_off(c, 2 * lane)) = pk2(v0, v1);
            else { fr[vf_off(c, 2 * lane)] = (bf16)f2bf(v0); fr[vf_off(c, 2 * lane + 1)] = (bf16)f2bf(v1); } }
        __syncthreads();
    }
}

#define KBI(i) (16 * ((i) >> 3) + ((i) & 7))
__device__ __forceinline__ void load_frags(bf16x8 (&f)[8], const v4u* p, int lane) {
#pragma unroll
    for (int i = 0; i < 8; ++i) f[i] = __builtin_bit_cast(bf16x8, p[i * 64 + lane]);
}
__device__ __forceinline__ f32x16 qk_mma(const bf16x8 (&qf)[8], const bf16x8 (&k)[8]) {
    f32x16 s;
#pragma unroll
    for (int i = 0; i < 16; ++i) s[i] = 0.f;
#pragma unroll
    for (int st = 0; st < 8; ++st) s = __builtin_amdgcn_mfma_f32_32x32x16_bf16(k[st], qf[st], s, 0, 0, 0);
    return s;
}
__device__ __forceinline__ f32x16 qk_tile(const bf16x8 (&qf)[8], const v4u* kf, int lane) { bf16x8 k[8]; load_frags(k, kf, lane); return qk_mma(qf, k); }
template <int STRIDE> __device__ __forceinline__ void add_tbl(f32x16& s, const LAS float* tp2, float pen) {
#pragma unroll
    for (int i = 0; i < 16; ++i) s[i] += tp2[STRIDE * (23 - KBI(i))] + pen;
}
__device__ __forceinline__ void mask_hi(f32x16& s, int lim) {
#pragma unroll
    for (int i = 0; i < 16; ++i) s[i] = (KBI(i) <= lim) ? s[i] : NEGB;
}
__device__ __forceinline__ void mask_lo(f32x16& s, int lim) {
#pragma unroll
    for (int i = 0; i < 16; ++i) s[i] = (KBI(i) >= lim) ? s[i] : NEGB;
}
__device__ __forceinline__ float max16(const f32x16& s) {
    float mx = fmaxf(s[0], s[1]);
#pragma unroll
    for (int i = 2; i < 16; ++i) mx = fmaxf(mx, s[i]);
    return fmaxf(mx, __shfl_xor(mx, 32));
}
__device__ __forceinline__ void pv_tile(const f32x16& p, f32x16 (&o)[4], const bf16x8 (&v)[8]) {
    v4u a0, a1;
    a0.x = pkbf(p[0], p[1]); a0.y = pkbf(p[2], p[3]); a0.z = pkbf(p[4], p[5]); a0.w = pkbf(p[6], p[7]);
    a1.x = pkbf(p[8], p[9]); a1.y = pkbf(p[10], p[11]); a1.z = pkbf(p[12], p[13]); a1.w = pkbf(p[14], p[15]);
    const bf16x8 pb0 = __builtin_bit_cast(bf16x8, a0), pb1 = __builtin_bit_cast(bf16x8, a1);
#pragma unroll
    for (int dt = 0; dt < 4; ++dt) { o[dt] = __builtin_amdgcn_mfma_f32_32x32x16_bf16(v[2 * dt], pb0, o[dt], 0, 0, 0); o[dt] = __builtin_amdgcn_mfma_f32_32x32x16_bf16(v[2 * dt + 1], pb1, o[dt], 0, 0, 0); }
}
__device__ __forceinline__ void softmax_pv(f32x16& s, f32x16 (&o)[4], float& m, float& l, const v4u* vf, int lane) {
    bf16x8 v[8];
#pragma unroll
    for (int i = 0; i < 8; ++i) v[i] = __builtin_bit_cast(bf16x8, vf[i * 64 + lane]);
    const float mn = fmaxf(m, max16(s));
    if (__ballot(mn > m + 8.f)) {
        const float corr = ex2(m - mn);
#pragma unroll
        for (int dt = 0; dt < 4; ++dt)
#pragma unroll
            for (int i = 0; i < 16; ++i) o[dt][i] *= corr;
        l *= corr; m = mn;
    }
    float ps = 0.f;
#pragma unroll
    for (int i = 0; i < 16; ++i) { s[i] = ex2(s[i] - m); ps += s[i]; }
    l += ps;
    pv_tile(s, o, v);
}
template <int NP = 0> __device__ __forceinline__ void softmax_pv_v(f32x16& s, f32x16 (&o)[4], float& m, float& l, const bf16x8 (&v)[8]) {
    if (NP == 2) { l += s[0]; pv_tile(s, o, v); return; }
    const float mn = fmaxf(m, max16(s));
    if (__ballot(mn > m + 8.f)) {
        const float corr = ex2(m - mn);
#pragma unroll
        for (int dt = 0; dt < 4; ++dt)
#pragma unroll
            for (int i = 0; i < 16; ++i) o[dt][i] *= corr;
        l *= corr; m = mn;
    }
    float ps = 0.f;
#pragma unroll
    for (int i = 0; i < 16; ++i) { s[i] = ex2(s[i] - m); ps += s[i]; }
    l += ps;
    pv_tile(s, o, v);
}
typedef long f8x8;
__device__ __forceinline__ void load_frags8(f8x8 (&f)[8], const v4u* p, int lane) {
#pragma unroll
    for (int i = 0; i < 4; ++i) { const v4u w = p[i * 64 + lane]; f[2 * i] = (long)(((unsigned long long)w.y << 32) | w.x); f[2 * i + 1] = (long)(((unsigned long long)w.w << 32) | w.z); }
}
__device__ __forceinline__ f32x16 qk_mma8(const f8x8 (&qf)[8], const f8x8 (&k)[8]) {
    f32x16 s;
#pragma unroll
    for (int i = 0; i < 16; ++i) s[i] = 0.f;
#pragma unroll
    for (int st = 0; st < 8; ++st) s = __builtin_amdgcn_mfma_f32_32x32x16_fp8_fp8(k[st], qf[st], s, 0, 0, 0);
    return s;
}
__device__ __forceinline__ unsigned pk4_f8n(float a, float b, float c, float d) { int w = 0; w = __builtin_amdgcn_cvt_pk_fp8_f32(a, b, w, false); w = __builtin_amdgcn_cvt_pk_fp8_f32(c, d, w, true); return (unsigned)w; }
__device__ __forceinline__ void pv_tile8(const f32x16& p, f32x16 (&o)[4], const f8x8 (&v)[8]) {
    const f8x8 pb0 = (long)(((unsigned long long)pk4_f8n(p[4], p[5], p[6], p[7]) << 32) | pk4_f8n(p[0], p[1], p[2], p[3]));
    const f8x8 pb1 = (long)(((unsigned long long)pk4_f8n(p[12], p[13], p[14], p[15]) << 32) | pk4_f8n(p[8], p[9], p[10], p[11]));
#pragma unroll
    for (int dt = 0; dt < 4; ++dt) { o[dt] = __builtin_amdgcn_mfma_f32_32x32x16_fp8_fp8(v[2 * dt], pb0, o[dt], 0, 0, 0); o[dt] = __builtin_amdgcn_mfma_f32_32x32x16_fp8_fp8(v[2 * dt + 1], pb1, o[dt], 0, 0, 0); }
}
template <int NP = 0> __device__ __forceinline__ void softmax_pv_v8(f32x16& s, f32x16 (&o)[4], float& m, float& l, const f8x8 (&v)[8]) {
    if (NP == 2) { l += s[0]; pv_tile8(s, o, v); return; }
    const float mn = fmaxf(m, max16(s));
    if (__ballot(mn > m + 8.f)) {
        const float corr = ex2(m - mn);
#pragma unroll
        for (int dt = 0; dt < 4; ++dt)
#pragma unroll
            for (int i = 0; i < 16; ++i) o[dt][i] *= corr;
        l *= corr; m = mn;
    }
    float ps = 0.f;
#pragma unroll
    for (int i = 0; i < 16; ++i) { s[i] = ex2(s[i] - m); ps += s[i]; }
    l += ps;
    pv_tile8(s, o, v);
}
__device__ __forceinline__ void q_to_f8(f8x8 (&q8)[8], const bf16x8 (&qf)[8]) {
#pragma unroll
    for (int st = 0; st < 8; ++st) { const v4u w = __builtin_bit_cast(v4u, qf[st]);
        q8[st] = (long)(((unsigned long long)pk4_f8(bflo(w.z), bfhi(w.z), bflo(w.w), bfhi(w.w)) << 32) | pk4_f8(bflo(w.x), bfhi(w.x), bflo(w.y), bfhi(w.y))); }
}
__device__ __forceinline__ void zero_o(f32x16 (&o)[4]) {
#pragma unroll
    for (int dt = 0; dt < 4; ++dt)
#pragma unroll
        for (int i = 0; i < 16; ++i) o[dt][i] = 0.f;
}
__device__ __forceinline__ void y_update(bf16* yp  , const f32x16 (&o)[4], float sc, bool acc) {
#pragma unroll
    for (int dt = 0; dt < 4; ++dt)
#pragma unroll
        for (int i4 = 0; i4 < 4; ++i4) { bf16* p = yp + 32 * dt + 8 * i4;
            float v0 = o[dt][4 * i4] * sc, v1 = o[dt][4 * i4 + 1] * sc, v2 = o[dt][4 * i4 + 2] * sc, v3 = o[dt][4 * i4 + 3] * sc;
            if (acc) { const v2u w = *(const v2u*)p; v0 += bflo(w.x); v1 += bfhi(w.x); v2 += bflo(w.y); v3 += bfhi(w.y); }
            v2u w; w.x = pkbf(v0, v1); w.y = pkbf(v2, v3); *(v2u*)p = w; }
}
constexpr int TBLN = 2624;
constexpr int OFF_TBL = 0, OFF_IMP = 43008, OFF_SELM = OFF_IMP + 65536, OFF_DTBL = OFF_SELM + 512;
constexpr int FAR_DIST = 1513;

template <int NP> __device__ __forceinline__ void nsa_unit(const Args& a, LAS unsigned char* lds, int u, int tid) {
    const int lane = tid & 63, wave = __builtin_amdgcn_readfirstlane(tid >> 6);
    const int qb = u >> 3, bg = u & 7, b = bg >> 1, g = bg & 1;
    const int r = wave >> 1, qs = wave & 1, hd = g * 4 + r, ql = lane & 31, h = lane >> 5;
    const int q0w = 64 * qb + 32 * qs, sq = q0w + ql, t = b * S + sq;
    LAS float* tball = (LAS float*)(lds + OFF_TBL);
    LAS float* imp = (LAS float*)(lds + OFF_IMP);
    LAS unsigned long long* selm = (LAS unsigned long long*)(lds + OFF_SELM);
    const float* relb = a.in[22];
    for (int i = tid; i < 4 * TBLN; i += NTHREADS) { const int hh = i / TBLN, dd = i % TBLN - 64; tball[i] = dd >= 0 ? relb[(g * 4 + hh) * 32 + t5_bucket(dd)] * LOG2E : 0.f; }
    for (int i = tid; i < 4 * 64 * 64; i += NTHREADS) imp[i] = 0.f;
    __syncthreads();
    const LAS float* tbl = tball + r * TBLN + 64;
    const float farc = relb[hd * 32 + 31] * LOG2E;
    bf16x8 qf[8];
    { const bf16* qrow = (const bf16*)(a.ws + WS_Q) + (size_t)t * NQ + hd * 128 + 8 * h;
#pragma unroll
      for (int st = 0; st < 8; ++st) qf[st] = __builtin_bit_cast(bf16x8, *(const v4u*)(qrow + 16 * st)); }
    const float* gt = (const float*)(a.ws + WS_GATES) + (size_t)t * 24 + hd * 3;
    const float g0 = gt[0], g1 = gt[1], g2 = gt[2];
    bf16* yp = (bf16*)(a.ws + (NP ? WS_H : WS_YN)) + (size_t)t * 1536 + hd * 128 + 4 * h;
    f32x16 o[4];
    {
        const v4u* kfc = (const v4u*)(a.ws + WS_KC) + (size_t)bg * 8 * 512; const v4u* vfc = (const v4u*)(a.ws + WS_VC) + (size_t)bg * 8 * 512;
        const int smax = q0w + 31, ncv = smax >= 31 ? ((smax - 31) >> 4) + 1 : 0, ntc = (ncv + 31) >> 5;
        float m = NEGB, l = 0.f;
        for (int tc = 0; tc < ntc; ++tc) {
            f32x16 s = qk_tile(qf, kfc + tc * 512, lane);
            const int dqc = sq - 31 - 512 * tc;
            if (q0w - 31 - 512 * tc - 496 >= FAR_DIST) {
#pragma unroll
                for (int i = 0; i < 16; ++i) s[i] += farc;
            } else add_tbl<16>(s, tbl + dqc - 16 * (8 * h + 23), 0.f);
            mask_hi(s, (dqc >> 4) - 8 * h);
            const float mn = fmaxf(m, max16(s));
            float ps = 0.f;
#pragma unroll
            for (int i = 0; i < 16; ++i) ps += ex2(s[i] - mn);
            l = l * ex2(m - mn) + ps; m = mn;
        }
        l += __shfl_xor(l, 32);
        const float inv = (sq >= 31) ? 1.f / l : 0.f;
        zero_o(o);
        LAS float* impq = imp + (r * 64 + 32 * qs + ql) * 64;
        for (int tc = 0; tc < ntc; ++tc) {
            f32x16 s = qk_tile(qf, kfc + tc * 512, lane);
            bf16x8 v[8];
#pragma unroll
            for (int i = 0; i < 8; ++i) v[i] = __builtin_bit_cast(bf16x8, vfc[tc * 512 + i * 64 + lane]);
            const int dqc = sq - 31 - 512 * tc;
            if (q0w - 31 - 512 * tc - 496 >= FAR_DIST) {
#pragma unroll
                for (int i = 0; i < 16; ++i) s[i] += farc;
            } else add_tbl<16>(s, tbl + dqc - 16 * (8 * h + 23), 0.f);
            mask_hi(s, (dqc >> 4) - 8 * h);
#pragma unroll
            for (int i = 0; i < 16; ++i) s[i] = ex2(s[i] - m) * inv;
#pragma unroll
            for (int a2 = 0; a2 < 2; ++a2)
#pragma unroll
                for (int bq = 0; bq < 2; ++bq) { const int j = 8 * tc + 4 * a2 + 2 * h + bq; const int i0 = 8 * a2 + 4 * bq;
                    impq[j] += (s[i0] + s[i0 + 1]) + (s[i0 + 2] + s[i0 + 3]); }
            asm volatile("s_waitcnt lgkmcnt(0)" ::: "memory");
#pragma unroll
            for (int a2 = 0; a2 < 2; ++a2)
#pragma unroll
                for (int bq = 0; bq < 2; ++bq) { const int j = 8 * tc + 4 * a2 + 2 * h + bq + 1; if (j < 64) impq[j] += s[8 * a2 + 4 * bq + 3]; }
            asm volatile("s_waitcnt lgkmcnt(0)" ::: "memory");
            pv_tile(s, o, v);
        }
        y_update(yp, o, g0, false);
    }
    f8x8 q8[8]; q_to_f8(q8, qf);
    __syncthreads();
    for (int qq = wave * 8; qq < wave * 8 + 8; ++qq) {
        const int jb = lane;
        const float im = ((imp[(0 * 64 + qq) * 64 + jb] + imp[(1 * 64 + qq) * 64 + jb]) + imp[(2 * 64 + qq) * 64 + jb]) + imp[(3 * 64 + qq) * 64 + jb];
        const bool forced = (jb == 0) || (jb == qb) || (jb == qb - 1);
        const float score = forced ? 1e4f : (jb > qb ? -1e4f : im);
        int rank = 0;
        for (int o2 = 0; o2 < 64; ++o2) { const float so = __shfl(score, o2); rank += (so > score) || (so == score && o2 < jb); }
        const unsigned long long mask = __ballot(rank < 16 && jb <= qb);
        if (lane == 0) selm[qq] = mask;
    }
    __syncthreads();
    {
        const v4u* kfw = (const v4u*)fr8_nsa(a, bg, 2); const v4u* vfw = (const v4u*)fr8_nsa(a, bg, 3);
        const int t_hi = q0w >> 5, t_lo = t_hi - 16;
        float m = NEGB, l = 0.f; zero_o(o);
        const int t0 = t_lo < 0 ? 0 : t_lo;
        for (int tt = t0; tt <= t_hi; ++tt) {
            const size_t to = (NP == 3) ? (size_t)(tt & 1) * 256 : (size_t)tt * 256;
            f8x8 kf[8], vf[8]; load_frags8(kf, kfw + to, lane);
            f32x16 s = qk_mma8(q8, kf); load_frags8(vf, vfw + to, lane);
            const int dq = sq - 32 * tt;
            add_tbl<1>(s, tbl + dq - (8 * h + 23), 0.f);
            if (tt == t_hi) mask_hi(s, dq - 8 * h);
            if (tt == t_lo) mask_lo(s, dq - 511 - 8 * h);
            softmax_pv_v8<NP>(s, o, m, l, vf);
        }
        l += __shfl_xor(l, 32);
        y_update(yp, o, g2 / l, true);
    }
    {
        const v4u* kfs = (const v4u*)fr8_nsa(a, bg, 0); const v4u* vfs = (const v4u*)fr8_nsa(a, bg, 1);
        const unsigned long long mask = selm[32 * qs + ql];
        float m = NEGB, l = 0.f; zero_o(o);
        const int t_end = 2 * qb + qs;
        for (int tt = 0; tt <= 2 * qb + 1; ++tt) {
            if (tt > t_end) continue;
            const float pen = ((mask >> (tt >> 1)) & 1ull) ? 0.f : NEGB;
            if (__ballot(pen == 0.f) == 0ull) continue;
            const size_t to = (NP == 3) ? (size_t)(tt & 1) * 256 : (size_t)tt * 256;
            f8x8 kf[8], vf[8]; load_frags8(kf, kfs + to, lane);
            f32x16 s = qk_mma8(q8, kf); load_frags8(vf, vfs + to, lane);
            const int dq = sq - 32 * tt;
            if (q0w - (32 * tt + 31) >= FAR_DIST) {
                const float c = farc + pen;
#pragma unroll
                for (int i = 0; i < 16; ++i) s[i] += c;
            } else add_tbl<1>(s, tbl + dq - (8 * h + 23), pen);
            if (tt == t_end) mask_hi(s, dq - 8 * h);
            softmax_pv_v8<NP>(s, o, m, l, vf);
        }
        l += __shfl_xor(l, 32);
        y_update(yp, o, g1 / l, true);
    }
    __syncthreads();
}
__device__ __forceinline__ void dil_unit(const Args& a, LAS unsigned char* lds, int u, int tid) {
    const int lane = tid & 63, wave = __builtin_amdgcn_readfirstlane(tid >> 6), ql = lane & 31, h = lane >> 5;
    const int b = u >> 6, p = (u >> 4) & 3, c = u & 15, s0 = 256 * c;
    LAS float* dtbl = (LAS float*)(lds + OFF_DTBL);
    const float* relb = a.in[22] + 8 * 32;
    for (int i = tid; i < 3 * 192; i += NTHREADS) { const int gi = i / 192, dm = i % 192 - 32; dtbl[i] = dm >= 0 ? relb[(gi * 4 + p) * 32 + t5_bucket(dm << (2 * gi))] * LOG2E : 0.f; }
    __syncthreads();
    bf16* OD = (bf16*)(a.ws + WS_OD); float* LSE = (float*)(a.ws + WS_LSE);
    const bf16* DL = (const bf16*)(a.ws + WS_DL);
    for (int job = wave; job < 32; job += NWAVES) {
        int gi, rr, m0, vlo, vhi;
        if (job < 8) { gi = 0; rr = 0; m0 = s0 + 32 * job; vlo = 0; vhi = 32; }
        else if (job < 16) { gi = 1; rr = (job - 8) >> 1; m0 = (s0 >> 2) + 32 * (job & 1); vlo = 0; vhi = 32; }
        else { gi = 2; rr = job - 16; m0 = 32 * (c >> 1); vlo = 16 * (c & 1); vhi = vlo + 16; }
        const int dsh = 2 * gi, L = S >> dsh, head = gi * 4 + p;
        const int mq = m0 + ql, sact = (mq << dsh) + rr, t = b * S + sact;
        const v4u* kf = (const v4u*)fr8_dil(a, b, head, 0) + (size_t)((rr * L) >> 5) * 256; const v4u* vf = (const v4u*)fr8_dil(a, b, head, 1) + (size_t)((rr * L) >> 5) * 256;
        bf16x8 qf[8];
        { const bf16* qrow = DL + (size_t)t * NDL + head * 128 + 8 * h;
#pragma unroll
          for (int st = 0; st < 8; ++st) qf[st] = __builtin_bit_cast(bf16x8, *(const v4u*)(qrow + 16 * st)); }
        f8x8 q8[8]; q_to_f8(q8, qf);
        const LAS float* tb = dtbl + gi * 192 + 32;
        const int t_hi = m0 >> 5, t_lo = t_hi - 4;
        float m = NEGB, l = 0.f; f32x16 o[4]; zero_o(o);
        const int t0 = t_lo < 0 ? 0 : t_lo;
        for (int tt = t0; tt <= t_hi; ++tt) {
            f8x8 kr[8], vr[8]; load_frags8(kr, kf + (size_t)tt * 256, lane);
            f32x16 s = qk_mma8(q8, kr); load_frags8(vr, vf + (size_t)tt * 256, lane);
            const int dq = mq - 32 * tt;
            add_tbl<1>(s, tb + dq - (8 * h + 23), 0.f);
            if (tt == t_hi) mask_hi(s, dq - 8 * h);
            if (tt == t_lo) mask_lo(s, dq - 128 - 8 * h);
            softmax_pv_v8(s, o, m, l, vr);
        }
        l += __shfl_xor(l, 32);
        if (ql >= vlo && ql < vhi) {
            y_update(OD + ((size_t)gi * T + t) * 512 + p * 128 + 4 * h, o, 1.f / l, false);
            if (h == 0) LSE[((size_t)(gi * NB + b) * 4 + p) * S + sact] = m + __log2f(l);
        }
    }
    __syncthreads();
    { const int pos = tid >> 1, dh = tid & 1, sact = s0 + pos, t = b * S + sact;
      const float l0 = LSE[((size_t)(0 * NB + b) * 4 + p) * S + sact], l1 = LSE[((size_t)(1 * NB + b) * 4 + p) * S + sact], l2 = LSE[((size_t)(2 * NB + b) * 4 + p) * S + sact];
      const float mx = fmaxf(l0, fmaxf(l1, l2)); float w0 = ex2(l0 - mx), w1 = ex2(l1 - mx), w2 = ex2(l2 - mx); const float iw = 1.f / (w0 + w1 + w2); w0 *= iw; w1 *= iw; w2 *= iw;
      bf16* yd = (bf16*)(a.ws + WS_YN) + (size_t)t * 1536 + 1024 + p * 128 + 64 * dh;
      const bf16* o0 = OD + ((size_t)0 * T + t) * 512 + p * 128 + 64 * dh; const bf16* o1 = OD + ((size_t)1 * T + t) * 512 + p * 128 + 64 * dh; const bf16* o2 = OD + ((size_t)2 * T + t) * 512 + p * 128 + 64 * dh;
#pragma unroll
      for (int k = 0; k < 8; ++k) { const v4u x0 = *(const v4u*)(o0 + 8 * k), x1 = *(const v4u*)(o1 + 8 * k), x2 = *(const v4u*)(o2 + 8 * k); v4u y;
          y.x = pkbf(w0 * bflo(x0.x) + w1 * bflo(x1.x) + w2 * bflo(x2.x), w0 * bfhi(x0.x) + w1 * bfhi(x1.x) + w2 * bfhi(x2.x));
          y.y = pkbf(w0 * bflo(x0.y) + w1 * bflo(x1.y) + w2 * bflo(x2.y), w0 * bfhi(x0.y) + w1 * bfhi(x1.y) + w2 * bfhi(x2.y));
          y.z = pkbf(w0 * bflo(x0.z) + w1 * bflo(x1.z) + w2 * bflo(x2.z), w0 * bfhi(x0.z) + w1 * bfhi(x1.z) + w2 * bfhi(x2.z));
          y.w = pkbf(w0 * bflo(x0.w) + w1 * bflo(x1.w) + w2 * bflo(x2.w), w0 * bfhi(x0.w) + w1 * bfhi(x1.w) + w2 * bfhi(x2.w));
          *(v4u*)(yd + 8 * k) = y; } }
    __syncthreads();
}
__device__ __forceinline__ void ph4_attention(const Args& a, LAS unsigned char* lds) {
    const int tid = phase_tid();
    for (int u = blockIdx.x; u < 256; u += gridDim.x) dil_unit(a, lds, u, tid);
#ifndef PROBE_NSA
#define PROBE_NSA 0
#endif
    if (PROBE_NSA) for (int x = blockIdx.x; x < 256; x += gridDim.x) { nsa_unit<PROBE_NSA>(a, lds, 511 - x, tid); nsa_unit<PROBE_NSA>(a, lds, x, tid); }
    for (int x = blockIdx.x; x < 256; x += gridDim.x) { nsa_unit<0>(a, lds, 511 - x, tid); nsa_unit<0>(a, lds, x, tid); }
}

typedef float f32x2 __attribute__((ext_vector_type(2)));
constexpr size_t WS_PU8 = WS_Q;
constexpr size_t WS_PV8 = WS_Q + 32 * MiB;
constexpr size_t WS_PSC = WS_Q + 64 * MiB;
__device__ __forceinline__ void ph_quant_uv(const Args& a) {
    const int tid = phase_tid(), lane = tid & 63, wave = __builtin_amdgcn_readfirstlane(tid >> 6);
    const int gw = blockIdx.x * NWAVES + wave, NGW = gridDim.x * NWAVES;
    float* SC = (float*)(a.ws + WS_PSC);
    for (int rw = gw; rw < NE; rw += NGW) {
        f32x4 x[2][8];
#pragma unroll
        for (int which = 0; which < 2; ++which) { const float* src = a.in[20 + which] + (size_t)rw * D + 16 * lane;
#pragma unroll
            for (int c = 0; c < 2; ++c)
#pragma unroll
                for (int w = 0; w < 4; ++w) x[which][4 * c + w] = *(const f32x4*)(src + 1024 * c + 4 * w); }
#pragma unroll
        for (int which = 0; which < 2; ++which) {
            unsigned char* dst = a.ws + (which ? WS_PV8 : WS_PU8) + (size_t)rw * 1024 + 16 * lane;
            float ss = 0.f;
#pragma unroll
            for (int i = 0; i < 8; ++i) ss += (x[which][i].x * x[which][i].x + x[which][i].y * x[which][i].y) + (x[which][i].z * x[which][i].z + x[which][i].w * x[which][i].w);
            ss = wave_sum(ss);
            const float step = 0.48f * sqrtf(ss * (1.f / D));
            const float inv = step > 0.f ? 1.f / step : 0.f;
            v4u o; unsigned wd[4];
#pragma unroll
            for (int wi = 0; wi < 4; ++wi) { unsigned q = 0u;
                const f32x4 va = x[which][2 * wi], vb = x[which][2 * wi + 1];
                q = __builtin_amdgcn_cvt_scalef32_pk_fp4_f32(q, __builtin_amdgcn_fmed3f(va.x * inv, -6.f, 6.f), __builtin_amdgcn_fmed3f(va.y * inv, -6.f, 6.f), 1.0f, 0);
                q = __builtin_amdgcn_cvt_scalef32_pk_fp4_f32(q, __builtin_amdgcn_fmed3f(va.z * inv, -6.f, 6.f), __builtin_amdgcn_fmed3f(va.w * inv, -6.f, 6.f), 1.0f, 1);
                q = __builtin_amdgcn_cvt_scalef32_pk_fp4_f32(q, __builtin_amdgcn_fmed3f(vb.x * inv, -6.f, 6.f), __builtin_amdgcn_fmed3f(vb.y * inv, -6.f, 6.f), 1.0f, 2);
                q = __builtin_amdgcn_cvt_scalef32_pk_fp4_f32(q, __builtin_amdgcn_fmed3f(vb.z * inv, -6.f, 6.f), __builtin_amdgcn_fmed3f(vb.w * inv, -6.f, 6.f), 1.0f, 3);
                wd[wi] = q; }
            o.x = wd[0]; o.y = wd[1]; o.z = wd[2]; o.w = wd[3]; *(v4u*)dst = o;
            if (lane == 0) SC[which * NE + rw] = step;
        }
    }
}
constexpr size_t WS_KEYF = 601 * MiB;
constexpr size_t WS_END3 = 602 * MiB;
__device__ __forceinline__ void ph0_keyfrags(const Args& a) {
    const int tid = phase_tid();
    const float* keys = a.in[19]; v4u* KF = (v4u*)(a.ws + WS_KEYF);
    for (int i = blockIdx.x * NTHREADS + tid; i < 16 * 32 * 64; i += gridDim.x * NTHREADS) {
        const int lane = i & 63, st = (i >> 6) & 7, kt = (i >> 9) & 3, hp = i >> 11;
        const float* src = keys + ((size_t)hp * 128 + 32 * kt + (lane & 31)) * 128 + 16 * st + 8 * (lane >> 5);
        float v[8]; unsigned hi[8], lo[8];
#pragma unroll
        for (int j = 0; j < 8; ++j) { v[j] = src[j]; hi[j] = f2bf(v[j]); lo[j] = f2bf(v[j] - __builtin_bit_cast(float, hi[j] << 16)); }
        v4u oh, ol; oh.x = hi[0] | (hi[1] << 16); oh.y = hi[2] | (hi[3] << 16); oh.z = hi[4] | (hi[5] << 16); oh.w = hi[6] | (hi[7] << 16);
        ol.x = lo[0] | (lo[1] << 16); ol.y = lo[2] | (lo[3] << 16); ol.z = lo[4] | (lo[5] << 16); ol.w = lo[6] | (lo[7] << 16);
        KF[(size_t)((hp * 2 + 0) * 32 + kt * 8 + st) * 64 + lane] = oh; KF[(size_t)((hp * 2 + 1) * 32 + kt * 8 + st) * 64 + lane] = ol;
    }
}
template <int N, bool MERGE_ONLY> __device__ __forceinline__ void bitonic_desc(float (&v)[N]) {
#pragma unroll
    for (int k = MERGE_ONLY ? N : 2; k <= N; k <<= 1)
#pragma unroll
        for (int j = k >> 1; j > 0; j >>= 1)
#pragma unroll
            for (int i = 0; i < N; ++i) { const int l = i ^ j;
                if (l > i) { const bool desc = ((i & k) == 0) || (k == N); const float x = v[i], y = v[l], hi = fmaxf(x, y), lo = fminf(x, y); v[i] = desc ? hi : lo; v[l] = desc ? lo : hi; } }
}
#define CROW(i) (((i) & 3) + 8 * ((i) >> 2))
__device__ __forceinline__ float max3f(float a, float b, float c) { return fmaxf(fmaxf(a, b), c); }
__device__ __forceinline__ void ph_route(const Args& a, LAS unsigned char* lds) {
    const int tid = phase_tid(), lane = tid & 63, wave = __builtin_amdgcn_readfirstlane(tid >> 6), tl = lane & 31, hc = lane >> 5;
    const int gw = blockIdx.x * NWAVES + wave, NGW = gridDim.x * NWAVES;
    const float* QP = (const float*)(a.ws + WS_QP); const float* qgain = a.in[18]; const v4u* KF = (const v4u*)(a.ws + WS_KEYF);
    int* EI = (int*)(a.ws + WS_EI); float* EG = (float*)(a.ws + WS_EG);
    LAS float* spl = (LAS float*)(lds + wave * 8704) + lane * 33;
    for (int job = gw; job < (T / 32) * 8; job += NGW) {
        const int h = job & 7, t = (job >> 3) * 32 + tl;
#pragma unroll 1
        for (int p = 0; p < 2; ++p) {
            bf16x8 bh[8], bl[8];
            { const float* qr = QP + (size_t)t * D + h * 256 + p * 128 + 8 * hc; const float* gr = qgain + (h * 2 + p) * 128 + 8 * hc;
              float ss = 0.f;
#pragma unroll
              for (int st = 0; st < 8; ++st) { const f32x4 x0 = *(const f32x4*)(qr + 16 * st), x1 = *(const f32x4*)(qr + 16 * st + 4);
                  ss += (x0.x * x0.x + x0.y * x0.y) + (x0.z * x0.z + x0.w * x0.w) + (x1.x * x1.x + x1.y * x1.y) + (x1.z * x1.z + x1.w * x1.w); }
              ss += __shfl_xor(ss, 32);
              const float rstd = rsqrtf(ss * (1.f / 128.f) + EPS);
              asm volatile("" ::: "memory");
#pragma unroll
              for (int st = 0; st < 8; ++st) { const f32x4 x0 = *(const f32x4*)(qr + 16 * st), x1 = *(const f32x4*)(qr + 16 * st + 4); const f32x4 g0 = *(const f32x4*)(gr + 16 * st), g1 = *(const f32x4*)(gr + 16 * st + 4);
                  const float v0 = x0.x * rstd * g0.x, v1 = x0.y * rstd * g0.y, v2 = x0.z * rstd * g0.z, v3 = x0.w * rstd * g0.w, v4 = x1.x * rstd * g1.x, v5 = x1.y * rstd * g1.y, v6 = x1.z * rstd * g1.z, v7 = x1.w * rstd * g1.w;
                  v4u xh, xl; xh.x = pkbf(v0, v1); xh.y = pkbf(v2, v3); xh.z = pkbf(v4, v5); xh.w = pkbf(v6, v7);
                  xl.x = pkbf(v0 - bflo(xh.x), v1 - bfhi(xh.x)); xl.y = pkbf(v2 - bflo(xh.y), v3 - bfhi(xh.y)); xl.z = pkbf(v4 - bflo(xh.z), v5 - bfhi(xh.z)); xl.w = pkbf(v6 - bflo(xh.w), v7 - bfhi(xh.w));
                  bh[st] = __builtin_bit_cast(bf16x8, xh); bl[st] = __builtin_bit_cast(bf16x8, xl); } }
            float sc[64];
            const v4u* kfh = KF + (size_t)(((h * 2 + p) * 2 + 0) * 32) * 64 + lane; const v4u* kfl = KF + (size_t)(((h * 2 + p) * 2 + 1) * 32) * 64 + lane;
#pragma unroll
            for (int kt = 0; kt < 4; ++kt) {
                f32x16 acc;
#pragma unroll
                for (int i = 0; i < 16; ++i) acc[i] = 0.f;
#pragma unroll
                for (int s2 = 0; s2 < 2; ++s2) {
                    asm volatile("" ::: "memory");
                    bf16x8 ah[4], al[4];
#pragma unroll
                    for (int s4 = 0; s4 < 4; ++s4) { ah[s4] = __builtin_bit_cast(bf16x8, kfh[(kt * 8 + s2 * 4 + s4) * 64]); al[s4] = __builtin_bit_cast(bf16x8, kfl[(kt * 8 + s2 * 4 + s4) * 64]); }
#pragma unroll
                    for (int s4 = 0; s4 < 4; ++s4) { const int st = s2 * 4 + s4;
                        acc = __builtin_amdgcn_mfma_f32_32x32x16_bf16(al[s4], bh[st], acc, 0, 0, 0); acc = __builtin_amdgcn_mfma_f32_32x32x16_bf16(ah[s4], bl[st], acc, 0, 0, 0); acc = __builtin_amdgcn_mfma_f32_32x32x16_bf16(ah[s4], bh[st], acc, 0, 0, 0); }
                }
#pragma unroll
                for (int i = 0; i < 16; ++i) { const float av = acc[i];
                    const unsigned bits = (__builtin_bit_cast(unsigned, av) & ~127u) | (unsigned)(127 - (32 * kt + CROW(i) + 4 * hc)); sc[16 * kt + i] = __builtin_bit_cast(float, bits); }
            }
            asm volatile("" ::: "memory");
            bitonic_desc<64, false>(sc);
            float t16[16];
#pragma unroll
            for (int i = 0; i < 16; ++i) t16[i] = __shfl_xor(sc[i], 32);
            float u16[16];
#pragma unroll
            for (int i = 0; i < 16; ++i) u16[i] = fmaxf(sc[i], t16[15 - i]);
            bitonic_desc<16, true>(u16);
#pragma unroll
            for (int i = 0; i < 16; ++i) spl[p * 16 + i] = u16[i];
        }
        asm volatile("s_waitcnt lgkmcnt(0)" ::: "memory");
        float sp[2][16];
#pragma unroll
        for (int i = 0; i < 16; ++i) { sp[0][i] = spl[i]; sp[1][i] = spl[16 + i]; }
        float cv[64];
        {
            int c = 0;
#pragma unroll
            for (int i = 0; i < 16; ++i)
#pragma unroll
                for (int j = 0; j < 16; ++j) if ((i + 1) * (j + 1) <= 16) {
                    const float v = sp[0][i] + sp[1][j];
                    cv[c] = __builtin_bit_cast(float, (__builtin_bit_cast(unsigned, v) & ~255u) | (unsigned)(255 - (i * 16 + j))); ++c; }
#pragma unroll
            for (int i = 50; i < 64; ++i) cv[i] = -INFINITY;
        }
        bitonic_desc<64, false>(cv);
        float tv[16];
#pragma unroll
        for (int i = 0; i < 16; ++i) tv[i] = cv[i];
        asm volatile("s_waitcnt lgkmcnt(0)" ::: "memory");
        int te[16]; float den = 0.f; const float top = tv[0];
#pragma unroll
        for (int i = 0; i < 16; ++i) { const int flat = 255 - (int)(__builtin_bit_cast(unsigned, tv[i]) & 255u);
            const unsigned b1 = __builtin_bit_cast(unsigned, spl[flat >> 4]), b2 = __builtin_bit_cast(unsigned, spl[16 + (flat & 15)]);
            te[i] = (127 - (int)(b1 & 127u)) * 128 + (127 - (int)(b2 & 127u));
            tv[i] = __expf(tv[i] - top); den += tv[i]; }
        den = 1.f / den;
        if (hc == 0) {
            int* ei = EI + (size_t)t * 128 + h * 16; float* eg = EG + (size_t)t * 128 + h * 16;
#pragma unroll
            for (int i = 0; i < 16; i += 4) { *(v4u*)(ei + i) = (v4u){(unsigned)te[i], (unsigned)te[i + 1], (unsigned)te[i + 2], (unsigned)te[i + 3]}; *(f32x4*)(eg + i) = (f32x4){tv[i] * den, tv[i + 1] * den, tv[i + 2] * den, tv[i + 3] * den}; }
        }
        asm volatile("s_waitcnt lgkmcnt(0)" ::: "memory");
    }
}
__device__ __forceinline__ void ph_experts(const Args& a, const float osc) {
    const int tid = phase_tid(), lane = tid & 63, wave = __builtin_amdgcn_readfirstlane(tid >> 6);
    const int gw = blockIdx.x * NWAVES + wave, NGW = gridDim.x * NWAVES;
    const bf16* H2 = (const bf16*)(a.ws + WS_H); const unsigned char* PU = a.ws + WS_PU8; const unsigned char* PV = a.ws + WS_PV8; const unsigned l16 = 16u * lane; const float* SC = (const float*)(a.ws + WS_PSC);
    const int* EI = (const int*)(a.ws + WS_EI); const float* EG = (const float*)(a.ws + WS_EG);
    const float* mod = (const float*)(a.ws + WS_MOD);
    float* out = a.out;
    v4u wa[8], wb[8];
#define EX_LOAD(buf, tab, esel, base) do { _Pragma("unroll") for (int k = 0; k < 8; ++k) { const unsigned e = (unsigned)__builtin_amdgcn_readlane(esel, ((base) + k) & 63); buf[k] = *(const v4u*)((tab) + ((size_t)e << 10) + l16); } __builtin_amdgcn_sched_barrier(0); } while (0)
#define EX_U(buf, bt) do { float pr[8]; \
        _Pragma("unroll") for (int k = 0; k < 8; ++k) { f32x2 s = {0.f, 0.f}; const unsigned q[4] = {buf[k].x, buf[k].y, buf[k].z, buf[k].w}; \
            _Pragma("unroll") for (int wi = 0; wi < 4; ++wi) { \
                s += x[4 * wi + 0] * __builtin_amdgcn_cvt_scalef32_pk_f32_fp4(q[wi], 1.0f, 0); s += x[4 * wi + 1] * __builtin_amdgcn_cvt_scalef32_pk_f32_fp4(q[wi], 1.0f, 1); \
                s += x[4 * wi + 2] * __builtin_amdgcn_cvt_scalef32_pk_f32_fp4(q[wi], 1.0f, 2); s += x[4 * wi + 3] * __builtin_amdgcn_cvt_scalef32_pk_f32_fp4(q[wi], 1.0f, 3); } \
            pr[k] = s.x + s.y; } \
          \
        float q4[4], q2[2]; \
        _Pragma("unroll") for (int j = 0; j < 4; ++j) { const float keep = lb0 ? pr[2 * j + 1] : pr[2 * j], send = lb0 ? pr[2 * j] : pr[2 * j + 1]; q4[j] = keep + __shfl_xor(send, 1); } \
        _Pragma("unroll") for (int j = 0; j < 2; ++j) { const float keep = lb1 ? q4[2 * j + 1] : q4[2 * j], send = lb1 ? q4[2 * j] : q4[2 * j + 1]; q2[j] = keep + __shfl_xor(send, 2); } \
        float rr; { const float keep = lb2 ? q2[1] : q2[0], send = lb2 ? q2[0] : q2[1]; rr = keep + __shfl_xor(send, 4); } \
        rr += __shfl_xor(rr, 8); rr += __shfl_xor(rr, 16); rr += __shfl_xor(rr, 32); \
        if ((lane >> 3) == ((bt) & 7)) { if ((bt) < 8) raw0 = rr; else raw1 = rr; } } while (0)
#define EX_V(buf, bt) do { _Pragma("unroll") for (int k = 0; k < 8; ++k) { const float cf = __builtin_bit_cast(float, __builtin_amdgcn_readlane(__builtin_bit_cast(int, (bt) < 8 ? cf0 : cf1), ((bt) * 8 + k) & 63)); const f32x2 cf2 = {cf, cf}; const unsigned q[4] = {buf[k].x, buf[k].y, buf[k].z, buf[k].w}; \
            _Pragma("unroll") for (int wi = 0; wi < 4; ++wi) { \
                acc[4 * wi + 0] += cf2 * __builtin_amdgcn_cvt_scalef32_pk_f32_fp4(q[wi], 1.0f, 0); acc[4 * wi + 1] += cf2 * __builtin_amdgcn_cvt_scalef32_pk_f32_fp4(q[wi], 1.0f, 1); \
                acc[4 * wi + 2] += cf2 * __builtin_amdgcn_cvt_scalef32_pk_f32_fp4(q[wi], 1.0f, 2); acc[4 * wi + 3] += cf2 * __builtin_amdgcn_cvt_scalef32_pk_f32_fp4(q[wi], 1.0f, 3); } } } while (0)
    const bool lb0 = lane & 1, lb1 = lane & 2, lb2 = lane & 4;
    int e0 = 0, e1 = 0;
    if (gw < T) { e0 = EI[(size_t)gw * 128 + lane]; e1 = EI[(size_t)gw * 128 + 64 + lane]; EX_LOAD(wa, PU, e0, 0); }
    for (int t = gw; t < T; t += NGW) {
        const int b = t / S, tn = t + NGW;
        f32x2 x[16];
#pragma unroll
        for (int c = 0; c < 2; ++c)
#pragma unroll
            for (int hw = 0; hw < 2; ++hw) { const v4u w = *(const v4u*)(H2 + (size_t)t * D + 1024 * c + 16 * lane + 8 * hw); const int o = 8 * c + 4 * hw;
                x[o + 0] = (f32x2){bflo(w.x), bfhi(w.x)}; x[o + 1] = (f32x2){bflo(w.y), bfhi(w.y)}; x[o + 2] = (f32x2){bflo(w.z), bfhi(w.z)}; x[o + 3] = (f32x2){bflo(w.w), bfhi(w.w)}; }
        int ne0 = 0, ne1 = 0;
        if (tn < T) { ne0 = EI[(size_t)tn * 128 + lane]; ne1 = EI[(size_t)tn * 128 + 64 + lane]; }
        const float gs0 = EG[(size_t)t * 128 + lane] * SC[NE + e0], gs1 = EG[(size_t)t * 128 + 64 + lane] * SC[NE + e1];
        const float su0 = SC[e0], su1 = SC[e1];
        float raw0 = 0.f, raw1 = 0.f;
#pragma unroll 1
        for (int i = 0; i < 7; ++i) {
            EX_LOAD(wb, PU, (i < 4 ? e0 : e1), (2 * i + 1) * 8);
            EX_U(wa, 2 * i);
            EX_LOAD(wa, PU, (i < 3 ? e0 : e1), (2 * i + 2) * 8);
            EX_U(wb, 2 * i + 1);
        }
        { EX_LOAD(wb, PU, e1, 15 * 8); EX_U(wa, 14); EX_LOAD(wa, PV, e0, 0); EX_U(wb, 15); }
        const float cf0 = gelu_tanh(raw0 * su0) * gs0, cf1 = gelu_tanh(raw1 * su1) * gs1;
        f32x2 acc[16];
#pragma unroll
        for (int i = 0; i < 16; ++i) acc[i] = (f32x2){0.f, 0.f};
#pragma unroll 1
        for (int i = 0; i < 7; ++i) {
            EX_LOAD(wb, PV, (i < 4 ? e0 : e1), (2 * i + 1) * 8);
            EX_V(wa, 2 * i);
            EX_LOAD(wa, PV, (i < 3 ? e0 : e1), (2 * i + 2) * 8);
            EX_V(wb, 2 * i + 1);
        }
        { EX_LOAD(wb, PV, e1, 15 * 8); EX_V(wa, 14); if (tn < T) EX_LOAD(wa, PU, ne0, 0); EX_V(wb, 15); }
        const float* g2 = mod + b * 12288 + 10240;
#pragma unroll
        for (int c = 0; c < 2; ++c)
#pragma unroll
            for (int w4 = 0; w4 < 4; ++w4) { float* op = out + (size_t)t * D + 1024 * c + 16 * lane + 4 * w4; const f32x4 ga = *(const f32x4*)(g2 + 1024 * c + 16 * lane + 4 * w4); f32x4 r0 = *(const f32x4*)op; const int o = 8 * c + 2 * w4;
                r0.x += ga.x * acc[o].x * osc; r0.y += ga.y * acc[o].y * osc; r0.z += ga.z * acc[o + 1].x * osc; r0.w += ga.w * acc[o + 1].y * osc;
                *(f32x4*)op = r0; }
        e0 = ne0; e1 = ne1;
    }
#undef EX_LOAD
#undef EX_U
#undef EX_V
}

constexpr int N_PHASES = 11;
__global__ void __launch_bounds__(NTHREADS, 2) fwd_kernel(Args a) {
    extern __shared__ __attribute__((aligned(16))) unsigned char lds_raw[];
    LAS unsigned char* lds = (LAS unsigned char*)lds_raw;
    const int tid = threadIdx.x;
    volatile LAS unsigned* misc = (volatile LAS unsigned*)(lds + LDS_MISC);
    if (tid < 16) misc[tid] = 0u;
    __syncthreads();
    XcdBarrier bar; bar.bar = (unsigned*)(a.ws + WS_CTL) + 1024; bar.x = 0; bar.st = nullptr;
    const int lo = a.ph_lo, hi = a.ph_hi;
    if (hi - lo > 1) bar = xcd_barrier_post((unsigned*)(a.ws + WS_CTL) + 1024, misc + 8);
#define IN(k) (lo <= (k) && (k) < hi)
#define SEAM(k) do { if (IN(k) && IN((k) + 1)) xcd_barrier(bar); } while (0)
    const int G = gridDim.x, bx = blockIdx.x;

    for (int rep = 0; rep < 1 + ((PROBE_DUP >> 0) & 1); ++rep)
    if (IN(0)) { ph0_mod(a, lds); __syncthreads(); ph0_weights(a, lds); ph0_keyfrags(a); ph0_extra(a); __syncthreads(); }
    SEAM(0);
    for (int rep = 0; rep < 1 + ((PROBE_DUP >> 1) & 1); ++rep)
    if (IN(1)) ph_norm<true>(a, a.in[0], a.in[4], 0, 2048, (bf16*)(a.ws + WS_H), a.ws + WS_H8);
    SEAM(1);
    for (int rep = 0; rep < 1 + ((PROBE_DUP >> 2) & 1); ++rep)
    if (IN(2)) { pg8::Gemm g{(const bf16*)(a.ws + WS_H8), (const bf16*)(a.ws + WS_WIN), T, NPROJ - NMG, D / 2}; pg8::StaticOrder So; So.init(T, NPROJ - NMG, G, bx);
        EpiProjNorm E{(bf16*)(a.ws + WS_Q), (bf16*)(a.ws + WS_KV), (bf16*)(a.ws + WS_DL), (bf16*)(a.ws + WS_MG), (bf16*)a.out, a.in[6], a.in[7], a.in[11], a.in[12], (LAS float*)(lds + 131072), 1.f / (F8_HS * F8_WS)};
        pg8::gemm_phase<EpiProjNorm, pg8::StaticOrder, pg8::NoMid, 1>(lds, g, So, E);
        pg8::Gemm g4{(const bf16*)(a.ws + WS_H4), (const bf16*)(a.ws + WS_WM4), T, NMG, D / 4}; pg8::StaticOrder S4; S4.init(T, NMG, G, bx);
        EpiMG E4{(bf16*)(a.ws + WS_MG), (const float*)(a.ws + WS_HS), (const float*)(a.ws + WS_WMS)};
        pg8::gemm_phase<EpiMG, pg8::StaticOrder, pg8::NoMid, 2>(lds, g4, S4, E4); }
    SEAM(2);
    if (IN(3)) { for (int rep = 0; rep < 1 + ((PROBE_DUP >> 3) & 1); ++rep) { ph3_vfrag(a); ph3_gates(a); ph3_compress(a, lds); } }
    SEAM(3);
    for (int rep = 0; rep < 1 + ((PROBE_DUP >> 4) & 1); ++rep)
    if (IN(4)) ph4_attention(a, lds);
    SEAM(4);
    for (int rep = 0; rep < 1 + ((PROBE_DUP >> 5) & 1); ++rep)
    if (IN(5)) {
        { pg8::Gemm g{(const bf16*)(a.ws + WS_YN), (const bf16*)(a.ws + WS_WBN), T, D, 1536}; pg8::StaticOrder So; So.init(T, D, G, bx);
          EpiMerge E{(const bf16*)(a.ws + WS_MG), a.ws + WS_H, F8_MS}; MidMerge Mh{(const bf16*)(a.ws + WS_MG)};
          pg8::gemm_phase<EpiMerge, pg8::StaticOrder, MidMerge>(lds, g, So, E, Mh); }
    }
    SEAM(5);
    for (int rep = 0; rep < 1 + ((PROBE_DUP >> 6) & 1); ++rep)
    if (IN(6)) { pg8::Gemm g{(const bf16*)(a.ws + WS_H), (const bf16*)(a.ws + WS_WOUT), T, D, D / 2}; pg8::StaticOrder So; So.init(T, D, G, bx);
        EpiOut E{a.in[0], (const float*)(a.ws + WS_MOD), a.out, 1.f / (F8_MS * F8_WS)}; pg8::gemm_phase<EpiOut, pg8::StaticOrder, pg8::NoMid, 1>(lds, g, So, E); }
    SEAM(6);
    for (int rep = 0; rep < 1 + ((PROBE_DUP >> 7) & 1); ++rep)
    if (IN(7)) { ph_norm(a, a.out, a.in[16], 6144, 8192, (bf16*)(a.ws + WS_H)); ph_quant_uv(a); }
    SEAM(7);
    for (int rep = 0; rep < 1 + ((PROBE_DUP >> 8) & 1); ++rep)
    if (IN(8)) { pg8::Gemm g{(const bf16*)(a.ws + WS_H), (const bf16*)(a.ws + WS_WPQ), T, D, D}; pg8::StaticOrder So; So.init(T, D, G, bx);
        EpiF32 E{(float*)(a.ws + WS_QP), D}; pg8::gemm_phase<EpiF32, pg8::StaticOrder>(lds, g, So, E); }
    SEAM(8);
    for (int rep = 0; rep < 1 + ((PROBE_DUP >> 9) & 1); ++rep)
    if (IN(9)) { ph_route(a, lds); __syncthreads(); }
    SEAM(9);
    if (IN(10)) { if ((PROBE_DUP >> 10) & 1) { ph_experts(a, *(const float*)(a.ws + WS_CTL + 64)); asm volatile("s_waitcnt vmcnt(0)" ::: "memory"); __syncthreads(); } ph_experts(a, 1.f); }
#undef IN
#undef SEAM
}

extern "C" void kernel_launch(void* const* d_in, const int* in_sizes, int n_in, void* d_out, int out_size, void* d_ws, size_t ws_size, hipStream_t stream) {
    static int grid = 0;
    if (grid == 0) {
        if (n_in != 23 || out_size != T * D || ws_size < WS_END4) { fprintf(stderr, "kernel_launch: unexpected problem shape (n_in %d, out %d, ws %zu); nothing launched\n", n_in, out_size, ws_size); grid = -1; return; }
        int dev = 0, cus = 0, per_cu = 0;
        if (hipGetDevice(&dev) != hipSuccess || hipDeviceGetAttribute(&cus, hipDeviceAttributeMultiprocessorCount, dev) != hipSuccess) { grid = -1; return; }
        if (hipFuncSetAttribute((const void*)fwd_kernel, hipFuncAttributeMaxDynamicSharedMemorySize, LDS_BYTES) != hipSuccess) { fprintf(stderr, "kernel_launch: hipFuncSetAttribute failed\n"); grid = -1; return; }
        if (hipOccupancyMaxActiveBlocksPerMultiprocessor(&per_cu, (const void*)fwd_kernel, NTHREADS, LDS_BYTES) != hipSuccess || per_cu < 1) { fprintf(stderr, "kernel_launch: occupancy query says %d\n", per_cu); }
        (void)hipGetLastError();
        grid = cus;
    }
    if (grid < 0) return;
    hipMemsetAsync((char*)d_ws + WS_CTL, 0, CTL_ZERO_BYTES, stream);
    Args a{};
    for (int i = 0; i < 23; ++i) a.in[i] = (const float*)d_in[i];
    a.out = (float*)d_out; a.ws = (unsigned char*)d_ws;
#if MK_ONE_LAUNCH
#if PROBE_PREFIX >= 0
    a.ph_lo = 0; a.ph_hi = PROBE_PREFIX + 1;
    hipLaunchKernelGGL(fwd_kernel, dim3(grid), dim3(NTHREADS), LDS_BYTES, stream, a);
    hipMemsetAsync((char*)d_ws + WS_CTL, 0, CTL_ZERO_BYTES, stream);
#endif
    a.ph_lo = 0; a.ph_hi = N_PHASES;
    hipLaunchKernelGGL(fwd_kernel, dim3(grid), dim3(NTHREADS), LDS_BYTES, stream, a);
#else
    for (int p = 0; p < N_PHASES; ++p) { a.ph_lo = p; a.ph_hi = p + 1; hipLaunchKernelGGL(fwd_kernel, dim3(grid), dim3(NTHREADS), LDS_BYTES, stream, a); }
#endif
}
```

```cpp
#include <hip/hip_runtime.h>
#include <cstdio>
#include <cstdint>

#ifndef PROBE_DUP
#define PROBE_DUP 0
#endif
#ifndef PROBE_PREFIX
#define PROBE_PREFIX -1
#endif
#ifndef MK_ONE_LAUNCH
#define MK_ONE_LAUNCH 1
#endif

__device__ __forceinline__ int phase_tid() { int t = threadIdx.x; asm volatile("" : "+v"(t)); return t; }
namespace pg8 {
#define PG8_LAS __attribute__((address_space(3)))
typedef unsigned short bf16_t;
typedef short bf16x8 __attribute__((ext_vector_type(8)));
typedef float f32x4 __attribute__((ext_vector_type(4)));
typedef unsigned u32x4 __attribute__((ext_vector_type(4)));
typedef unsigned u32x2 __attribute__((ext_vector_type(2)));
constexpr int BM = 256, BK = 64, HALF = 128, HTB = HALF * BK * 2, STAGE_BYTES = 8 * HTB, NXCD = 8, WGM = 8;

__host__ __device__ __forceinline__ int lds_byte(int r, int c) { const int st = (r >> 4) * 2 + (c >> 5), rr = r & 15, cc = c & 31, ob = rr * 64 + cc * 2; return st * 1024 + (ob ^ (((ob >> 9) & 1) << 5)); }
__host__ __device__ __forceinline__ void stage_rc(int b, int& R, int& C) { const int st = b / 1024, sb = b % 1024, swz = sb ^ (((sb >> 9) & 1) << 5); R = (st >> 1) * 16 + swz / 64; C = (st & 1) * 32 + (swz % 64) / 2; }
__host__ __device__ __forceinline__ int perm32(int rho) { const int n = rho >> 4, i = rho & 15; return 8 * (i >> 2) + 4 * n + (i & 3); }

struct Unit { int pm, pn; };
struct Gemm { const bf16_t* A; const bf16_t* Bt; int M, N, K; };

struct StaticOrder {
    int nM, nN, nwg, G, c;
    __host__ __device__ void init(int M, int N, int G_, int c_) { nM = M / BM; nN = N / BM; nwg = nM * nN; G = G_; c = c_; }
    __host__ __device__ bool next(int i, Unit& u) const {
        const long L = (long)i * G + c; if (L >= nwg) return false;
        int wgid = (int)L; { const int q = nwg / NXCD, r = nwg % NXCD, xcd = wgid % NXCD, off = wgid / NXCD; wgid = (xcd < r ? xcd * (q + 1) : r * (q + 1) + (xcd - r) * q) + off; }
        const int nig = WGM * nN, gid = wgid / nig, fm = gid * WGM, gsz = (nM - fm) < WGM ? (nM - fm) : WGM;
        u.pm = fm + ((wgid % nig) % gsz); u.pn = (wgid % nig) / gsz; return true;
    }
    __device__ __forceinline__ void a_ready(const Unit&) const {}
    __device__ __forceinline__ void done(const Unit&) const {}
};

__device__ __forceinline__ unsigned cvt_pk_bf16(float lo, float hi) { unsigned r; asm volatile("v_cvt_pk_bf16_f32 %0, %1, %2" : "=v"(r) : "v"(lo), "v"(hi)); return r; }

typedef int i32x4 __attribute__((ext_vector_type(4)));
typedef int i32x8 __attribute__((ext_vector_type(8)));
__device__ __forceinline__ void mma_blk_f4(f32x4 (&acc)[4][2], const bf16x8 (&At)[4][2], const bf16x8 (&Bt)[2][2]) {
#pragma unroll
    for (int m = 0; m < 4; ++m)
#pragma unroll
        for (int n = 0; n < 2; ++n)
#pragma unroll
            for (int k = 0; k < 2; ++k) { const i32x4 bb = __builtin_bit_cast(i32x4, Bt[n][k]), aa = __builtin_bit_cast(i32x4, At[m][k]);
                asm volatile("v_mfma_f32_16x16x128_f8f6f4 %0, %1, %2, %0 cbsz:4 blgp:4" : "+v"(acc[m][n]) : "v"(bb), "v"(aa)); }
}
template <bool F8> __device__ __forceinline__ void mma_blk(f32x4 (&acc)[4][2], const bf16x8 (&At)[4][2], const bf16x8 (&Bt)[2][2]) {
    if constexpr (F8) {
#pragma unroll
        for (int m = 0; m < 4; ++m)
#pragma unroll
            for (int n = 0; n < 2; ++n) {
                const i32x8 bb = __builtin_shufflevector(__builtin_bit_cast(i32x4, Bt[n][0]), __builtin_bit_cast(i32x4, Bt[n][1]), 0, 1, 2, 3, 4, 5, 6, 7);
                const i32x8 aa = __builtin_shufflevector(__builtin_bit_cast(i32x4, At[m][0]), __builtin_bit_cast(i32x4, At[m][1]), 0, 1, 2, 3, 4, 5, 6, 7);
                asm volatile("v_mfma_f32_16x16x128_f8f6f4 %0, %1, %2, %0" : "+v"(acc[m][n]) : "v"(bb), "v"(aa)); }
    } else {
#pragma unroll
        for (int m = 0; m < 4; ++m)
#pragma unroll
            for (int n = 0; n < 2; ++n)
#pragma unroll
                for (int k = 0; k < 2; ++k) acc[m][n] = __builtin_amdgcn_mfma_f32_16x16x32_bf16(Bt[n][k], At[m][k], acc[m][n], 0, 0, 0);
    }
}
struct NoMid { static constexpr int AT = -1; __device__ __forceinline__ void operator()(f32x4 (&)[2][2][4][2], const Unit&, int, int, int, int) const {} };
template <class Epi, class Sched, class Mid = NoMid, int F8 = 0>
__device__ __forceinline__ void gemm_phase(PG8_LAS unsigned char* lds, const Gemm g, const Sched& S, const Epi& E, const Mid& Mh = Mid()) {
    const int tid = phase_tid(), wid = __builtin_amdgcn_readfirstlane(tid >> 6), lane = tid & 63, wr = wid >> 2, wc = wid & 3, fr = lane & 15, fq = lane >> 4;
    const int K = g.K, nt = K / BK;
    unsigned voffA[2], voffB[2];
#pragma unroll
    for (int i = 0; i < 2; ++i) { int R, C; stage_rc(tid * 16 + i * 8192, R, C); const int Rb = Epi::PERM ? ((R & ~31) + perm32(R & 31)) : R;
        voffA[i] = (unsigned)(R * K + C) * 2u; voffB[i] = (unsigned)(Rb * K + C) * 2u; }
    const size_t kstep = (size_t)(BK * 2);
    const size_t hstep = (size_t)HALF * K * 2;
    const size_t tstep = 2 * hstep;
    const unsigned ldsw = (unsigned)wid * 1024u;
    const int aoff = lds_byte(wr * 64 + fr, fq * 8), boff = lds_byte(wc * 32 + fr, fq * 8);
#define PG8_SA(b, h) (((b) * 2 + (h)) * HTB)
#define PG8_SB(b, h) ((4 + (b) * 2 + (h)) * HTB)
#define PG8_STAGE(bufoff, gbase, voff) do { _Pragma("unroll") for (int _i = 0; _i < 2; ++_i) \
        __builtin_amdgcn_global_load_lds((const unsigned*)((const char*)(gbase) + (voff)[_i]), (PG8_LAS unsigned*)(lds + (bufoff) + ldsw + _i * 8192), 16, 0, 0); } while (0)
#define PG8_LDA(dst, b, h) do { _Pragma("unroll") for (int m = 0; m < 4; ++m) _Pragma("unroll") for (int k = 0; k < 2; ++k) dst[m][k] = *(const PG8_LAS bf16x8*)(lds + PG8_SA(b, h) + aoff + m * 2048 + k * 1024); } while (0)
#define PG8_LDB(dst, b, h) do { _Pragma("unroll") for (int n = 0; n < 2; ++n) _Pragma("unroll") for (int k = 0; k < 2; ++k) dst[n][k] = *(const PG8_LAS bf16x8*)(lds + PG8_SB(b, h) + boff + n * 2048 + k * 1024); } while (0)
#define PG8_MMA(ai, bj, At, Bt) do { __builtin_amdgcn_s_setprio(1); if constexpr (F8 == 2) { mma_blk_f4(acc[ai][bj], At, Bt); } else if constexpr (F8 == 1) { mma_blk<true>(acc[ai][bj], At, Bt); } else { _Pragma("unroll") for (int m = 0; m < 4; ++m) _Pragma("unroll") for (int n = 0; n < 2; ++n) _Pragma("unroll") for (int k = 0; k < 2; ++k) \
        acc[ai][bj][m][n] = __builtin_amdgcn_mfma_f32_16x16x32_bf16(Bt[n][k], At[m][k], acc[ai][bj][m][n], 0, 0, 0); } __builtin_amdgcn_s_setprio(0); } while (0)
#define PG8_WAIT_V(n) asm volatile("s_waitcnt vmcnt(" #n ")" ::: "memory")
#define PG8_WAIT_L(n) asm volatile("s_waitcnt lgkmcnt(" #n ")" ::: "memory")
#define PG8_BAR __builtin_amdgcn_s_barrier()
#define PG8_SCHED __builtin_amdgcn_sched_barrier(0)
    Unit cur, nxt; int ui = 0;
    if (!S.next(0, cur)) return;
    f32x4 acc[2][2][4][2];
#pragma unroll
    for (int a = 0; a < 2; ++a)
#pragma unroll
        for (int b = 0; b < 2; ++b)
#pragma unroll
            for (int m = 0; m < 4; ++m)
#pragma unroll
                for (int n = 0; n < 2; ++n) acc[a][b][m][n] = (f32x4){0.f, 0.f, 0.f, 0.f};
    bf16x8 At[4][2], B0[2][2], B1[2][2];
    const char* cA = (const char*)g.A + (size_t)cur.pm * tstep; const char* cB = (const char*)g.Bt + (size_t)cur.pn * tstep;
    S.a_ready(cur);
    PG8_STAGE(PG8_SB(0, 0), cB, voffB); PG8_STAGE(PG8_SA(0, 0), cA, voffA); PG8_STAGE(PG8_SB(0, 1), cB + hstep, voffB); PG8_STAGE(PG8_SA(0, 1), cA + hstep, voffA);
    if (wr == 1) PG8_BAR;
    PG8_WAIT_V(4); PG8_BAR;
    PG8_STAGE(PG8_SB(1, 0), cB + kstep, voffB); PG8_STAGE(PG8_SA(1, 0), cA + kstep, voffA); PG8_STAGE(PG8_SB(1, 1), cB + hstep + kstep, voffB);
    PG8_WAIT_V(6); PG8_BAR;
    for (;;) {
        const bool has_next = S.next(ui + 1, nxt);
        const char* nA = has_next ? (const char*)g.A + (size_t)nxt.pm * tstep : cA; const char* nB = has_next ? (const char*)g.Bt + (size_t)nxt.pn * tstep : cB;
#define PG8_KBODY \
            const bool last = (t == nt - 2); \
            const char* a1 = cA + (size_t)(t + 1) * kstep; \
            const char* a2 = last ? nA : cA + (size_t)(t + 2) * kstep; const char* b2 = last ? nB : cB + (size_t)(t + 2) * kstep; \
            const char* a3 = a2 + kstep; const char* b3 = b2 + kstep; \
            if (last && has_next) S.a_ready(nxt); \
            PG8_LDB(B0, 0, 0); PG8_SCHED; PG8_LDA(At, 0, 0); PG8_STAGE(PG8_SA(1, 1), a1 + hstep, voffA); \
            PG8_WAIT_L(8); PG8_BAR; PG8_WAIT_L(0); PG8_MMA(0, 0, At, B0); PG8_BAR; PG8_SCHED; \
            PG8_LDB(B1, 0, 1); PG8_STAGE(PG8_SB(0, 0), b2, voffB); \
            PG8_BAR; PG8_WAIT_L(0); PG8_MMA(0, 1, At, B1); PG8_BAR; \
            PG8_LDA(At, 0, 1); PG8_STAGE(PG8_SA(0, 0), a2, voffA); \
            PG8_BAR; PG8_WAIT_L(0); PG8_MMA(1, 0, At, B0); PG8_BAR; PG8_SCHED; \
            PG8_STAGE(PG8_SB(0, 1), b2 + hstep, voffB); \
            PG8_WAIT_V(6); PG8_BAR; PG8_MMA(1, 1, At, B1); PG8_BAR; \
            PG8_LDB(B0, 1, 0); PG8_SCHED; PG8_LDA(At, 1, 0); PG8_STAGE(PG8_SA(0, 1), a2 + hstep, voffA); \
            PG8_WAIT_L(8); PG8_BAR; PG8_WAIT_L(0); PG8_MMA(0, 0, At, B0); PG8_BAR; PG8_SCHED; \
            PG8_LDB(B1, 1, 1); PG8_STAGE(PG8_SB(1, 0), b3, voffB); \
            PG8_BAR; PG8_WAIT_L(0); PG8_MMA(0, 1, At, B1); PG8_BAR; \
            PG8_LDA(At, 1, 1); PG8_STAGE(PG8_SA(1, 0), a3, voffA); \
            PG8_BAR; PG8_WAIT_L(0); PG8_MMA(1, 0, At, B0); PG8_BAR; PG8_SCHED; \
            PG8_STAGE(PG8_SB(1, 1), b3 + hstep, voffB); \
            PG8_WAIT_V(6); PG8_BAR; PG8_MMA(1, 1, At, B1); PG8_BAR;
        if constexpr (Mid::AT >= 0) {
            for (int t = 0; t < Mid::AT; t += 2) { PG8_KBODY }
            if constexpr (F8) asm volatile("s_nop 15\n\ts_nop 15" ::: "memory");
            Mh(acc, cur, wr, wc, fr, fq);
            for (int t = Mid::AT; t < nt; t += 2) { PG8_KBODY }
        } else {
            for (int t = 0; t < nt; t += 2) { PG8_KBODY }
        }
#undef PG8_KBODY
        if constexpr (F8) asm volatile("s_nop 15\n\ts_nop 15" ::: "memory");
        E(acc, cur, wr, wc, fr, fq); S.done(cur);
        if (!has_next) break;
#pragma unroll
        for (int a = 0; a < 2; ++a)
#pragma unroll
            for (int b = 0; b < 2; ++b)
#pragma unroll
                for (int m = 0; m < 4; ++m)
#pragma unroll
                    for (int n = 0; n < 2; ++n) acc[a][b][m][n] = (f32x4){0.f, 0.f, 0.f, 0.f};
        cur = nxt; cA = nA; cB = nB; ++ui;
    }
    PG8_WAIT_V(0);
    if (wr == 0) PG8_BAR;
    PG8_BAR;
#undef PG8_SA
#undef PG8_SB
#undef PG8_STAGE
#undef PG8_LDA
#undef PG8_LDB
#undef PG8_MMA
#undef PG8_WAIT_V
#undef PG8_WAIT_L
#undef PG8_BAR
#undef PG8_SCHED
}
}

#define GAS __attribute__((address_space(1)))
#define LAS __attribute__((address_space(3)))
typedef unsigned short bf16;
typedef float f32x4 __attribute__((ext_vector_type(4)));
typedef unsigned v4u __attribute__((ext_vector_type(4)));
typedef unsigned v2u __attribute__((ext_vector_type(2)));

constexpr int NB = 4, S = 4096, D = 2048, T = NB * S, HD = 128;
constexpr int IN_COLS = 11288, OFF_KV = 1024, OFF_GATE = 2560, OFF_DIL = 2584, OFF_MERGE = 7192;
constexpr int NPROJ = 11264;
constexpr int NQ = 1024, NKV = 1536, NDL = 4608, NMG = 4096;
constexpr int NC = 255, NS = 64;
constexpr int NE = 16384;
constexpr float EPS = 1e-6f;
constexpr float QSCALE = 0.08838834764831845f;
constexpr int NWAVES = 8, NTHREADS = 512;

constexpr size_t MiB = 1u << 20;
constexpr size_t WS_CTL = 0, CTL_ZERO_BYTES = 1 * MiB;
constexpr size_t WS_WIN = 1 * MiB;
constexpr size_t WS_WBN = 45 * MiB;
constexpr size_t WS_WBD = 49 * MiB;
constexpr size_t WS_WOUT = 51 * MiB;
constexpr size_t WS_WPQ = 59 * MiB;
constexpr size_t WS_WGATE = 67 * MiB;
constexpr size_t WS_MOD = 67 * MiB + 256 * 1024;
constexpr size_t WS_SEL = 67 * MiB + 512 * 1024;
constexpr size_t WS_GATES = 68 * MiB;
constexpr size_t WS_KC = 70 * MiB;
constexpr size_t WS_VC = 71 * MiB;
constexpr size_t WS_H = 72 * MiB;
constexpr size_t WS_Q = 136 * MiB;
constexpr size_t WS_KV = 168 * MiB;
constexpr size_t WS_DL = 216 * MiB;
constexpr size_t WS_MG = 360 * MiB;
constexpr size_t WS_YN = 488 * MiB;
constexpr size_t WS_YD = 520 * MiB;
constexpr size_t WS_WM4 = WS_WIN + 23 * MiB;
constexpr size_t WS_H4 = WS_YD;
constexpr size_t WS_HS = WS_WGATE;
constexpr size_t WS_WMS = WS_WGATE + 128 * 1024;
constexpr size_t WS_H8 = WS_YN;
constexpr size_t WS_EI = 536 * MiB;
constexpr size_t WS_EG = 544 * MiB;
constexpr size_t WS_END = 552 * MiB;
constexpr size_t WS_PU = WS_Q;
constexpr size_t WS_PV = WS_Q + 64 * MiB;
constexpr size_t WS_QP = WS_MG;
static_assert(WS_PV + 64 * MiB <= WS_MG, "u/v overlay");

constexpr int LDS_BYTES = 147456;
constexpr int LDS_MISC = 144 * 1024 - 256;

#define XB_TMO      128
#define XB_XCNT(j)  (256  + 64 * (j))
#define XB_XSUB(j)  (1280 + 64 * (j))
#define XB_XGEN(j)  (2304 + 64 * (j))
#define XB_TOP      3328
#define XB_TOPGEN   3392
#define XCD_BAR_WORDS 3456
#define XB_SPIN_CAP (1u << 24)

__device__ __forceinline__ unsigned xb_ld(unsigned* p)              { return __hip_atomic_load(p, __ATOMIC_RELAXED, __HIP_MEMORY_SCOPE_AGENT); }
__device__ __forceinline__ unsigned xb_add(unsigned* p, unsigned v) { return __hip_atomic_fetch_add(p, v, __ATOMIC_RELAXED, __HIP_MEMORY_SCOPE_AGENT); }
__device__ __forceinline__ unsigned xb_xcc_id() { return (unsigned)__builtin_amdgcn_s_getreg((3 << 11) | 20) & 0xFu; }
#define XB_SPIN(cond, bar) do { unsigned _sp = 0; while (cond) { __builtin_amdgcn_s_sleep(1); \
    if ((++_sp & 255u) == 0u) { if (xb_ld(&(bar)[XB_TMO])) break; if (_sp > XB_SPIN_CAP) { atomicAdd(&(bar)[XB_TMO], 1u); break; } } } } while (0)

struct XcdBarrier { unsigned* bar; unsigned x; volatile LAS unsigned* st; };

__device__ __forceinline__ XcdBarrier xcd_barrier_post(unsigned* bar, volatile LAS unsigned* st) {
    XcdBarrier b; b.bar = bar; b.x = xb_xcc_id(); b.st = st;
    if (threadIdx.x == 0) (void)xb_add(&bar[XB_XCNT(b.x)], 1u);
    return b;
}
__device__ __forceinline__ void xcd_barrier_complete(unsigned* bar, unsigned x, unsigned& nloc, unsigned& nx) {
    const unsigned G = gridDim.x * gridDim.y * gridDim.z;
    unsigned sum, cnt, mine, sp = 0u;
    for (;;) {
        sum = 0u; cnt = 0u; mine = 0u;
#pragma unroll
        for (unsigned j = 0; j < 16; ++j) { const unsigned c = xb_ld(&bar[XB_XCNT(j)]); sum += c; cnt += (c > 0u) ? 1u : 0u; mine = (j == x) ? c : mine; }
        if (sum == G) break;
        __builtin_amdgcn_s_sleep(1);
        if ((++sp & 255u) == 0u) { if (xb_ld(&bar[XB_TMO])) break; if (sp > XB_SPIN_CAP) { atomicAdd(&bar[XB_TMO], 1u); break; } }
    }
    nloc = mine > 0u ? mine : 1u; nx = cnt > 0u ? cnt : 1u;
}
__device__ __forceinline__ void xcd_barrier(const XcdBarrier& b) {
    asm volatile("s_waitcnt vmcnt(0)" ::: "memory");
    __syncthreads();
    if (threadIdx.x == 0) {
        unsigned* bar = b.bar;
        __builtin_amdgcn_s_waitcnt(0);
        unsigned nloc = b.st[0], nx = b.st[1];
        if (nloc == 0u) { xcd_barrier_complete(bar, b.x, nloc, nx); b.st[0] = nloc; b.st[1] = nx; }
        const unsigned old = xb_add(&bar[XB_XSUB(b.x)], 1u);
        const unsigned gen = old / nloc;
        if (old + 1u == (gen + 1u) * nloc) {
            __builtin_amdgcn_fence(__ATOMIC_RELEASE, "agent");
            asm volatile("s_waitcnt vmcnt(0)" ::: "memory");
            const unsigned og = xb_add(&bar[XB_TOP], 1u);
            const unsigned tg = og / nx;
            if (og + 1u == (tg + 1u) * nx) xb_add(&bar[XB_TOPGEN], 1u);
            else XB_SPIN(xb_ld(&bar[XB_TOPGEN]) == tg, bar);
            __builtin_amdgcn_fence(__ATOMIC_ACQUIRE, "agent");
            xb_add(&bar[XB_XGEN(b.x)], 1u);
            asm volatile("s_waitcnt vmcnt(0)" ::: "memory");
        } else {
            XB_SPIN(xb_ld(&bar[XB_XGEN(b.x)]) == gen, bar);
            __builtin_amdgcn_fence(__ATOMIC_ACQUIRE, "agent");
            asm volatile("s_waitcnt vmcnt(0)" ::: "memory");
        }
    }
    __syncthreads();
}

__device__ __forceinline__ unsigned f2bf(float f) { unsigned u = __builtin_bit_cast(unsigned, f); return (u + 0x7fffu + ((u >> 16) & 1u)) >> 16; }
__device__ __forceinline__ unsigned pk2(float lo, float hi) { return f2bf(lo) | (f2bf(hi) << 16); }
__device__ __forceinline__ unsigned pk4_f8(float a, float b, float c, float d) {
    a = __builtin_amdgcn_fmed3f(a, -448.f, 448.f); b = __builtin_amdgcn_fmed3f(b, -448.f, 448.f); c = __builtin_amdgcn_fmed3f(c, -448.f, 448.f); d = __builtin_amdgcn_fmed3f(d, -448.f, 448.f);
    int w = 0; w = __builtin_amdgcn_cvt_pk_fp8_f32(a, b, w, false); w = __builtin_amdgcn_cvt_pk_fp8_f32(c, d, w, true); return (unsigned)w; }
constexpr float F8_HS = 8.f, F8_WS = 128.f, F8_MS = 64.f;
__device__ __forceinline__ float bflo(unsigned u) { return __builtin_bit_cast(float, u << 16); }
__device__ __forceinline__ float bfhi(unsigned u) { return __builtin_bit_cast(float, u & 0xffff0000u); }
__device__ __forceinline__ float bf2f(bf16 u) { return __builtin_bit_cast(float, (unsigned)u << 16); }
__device__ __forceinline__ float wave_sum(float v) {
#pragma unroll
    for (int o = 1; o < 64; o <<= 1) v += __shfl_xor(v, o);
    return v;
}
__device__ __forceinline__ float wave_max(float v) {
#pragma unroll
    for (int o = 1; o < 64; o <<= 1) v = fmaxf(v, __shfl_xor(v, o));
    return v;
}
__device__ __forceinline__ float sigmoidf(float x) { return __builtin_amdgcn_rcpf(1.f + __expf(-x)); }
__device__ __forceinline__ float gelu_tanh(float x) { const float u = 0.7978845608028654f * (x + 0.044715f * x * x * x); return 0.5f * x * (1.f + tanhf(u)); }
__device__ __forceinline__ int t5_bucket(int n) {
    if (n < 16) return n;
    int b = 16;
    b += (n >= 22); b += (n >= 30); b += (n >= 40); b += (n >= 54); b += (n >= 73); b += (n >= 99); b += (n >= 134); b += (n >= 182);
    b += (n >= 246); b += (n >= 332); b += (n >= 450); b += (n >= 609); b += (n >= 825); b += (n >= 1117); b += (n >= 1513);
    return b;
}

struct Args {
    const float* in[23];
    float* out; unsigned char* ws;
    int ph_lo, ph_hi;
};

typedef float f32x2v __attribute__((ext_vector_type(2)));
__device__ __forceinline__ void ph0_mod(const Args& a, LAS unsigned char* lds) {
    const int tid = phase_tid(), lane = tid & 63, wave = __builtin_amdgcn_readfirstlane(tid >> 6);
    LAS float* cs = (LAS float*)lds;
    LAS float* red = (LAS float*)(lds + 32768);
    const float* c = a.in[1]; const float* w_ada = a.in[2]; const float* b_ada = a.in[3];
    float* mod = (float*)(a.ws + WS_MOD);
    for (int i = tid; i < 4 * 2048; i += NTHREADS) { const float v = c[i]; cs[i] = v / (1.f + __expf(-v)); }
    __syncthreads();
    for (int u = blockIdx.x; u < 12288 / 128; u += gridDim.x) {
        const int col = u * 128 + 2 * lane;
        float acc[4][2];
#pragma unroll
        for (int b = 0; b < 4; ++b) { acc[b][0] = 0.f; acc[b][1] = 0.f; }
        const float* wp = w_ada + (size_t)(wave * 256) * 12288 + col;
#pragma unroll 1
        for (int k0 = 0; k0 < 256; k0 += 16) {
            f32x2v w[16];
#pragma unroll
            for (int k = 0; k < 16; ++k) w[k] = *(const f32x2v*)(wp + (size_t)(k0 + k) * 12288);
#pragma unroll
            for (int k = 0; k < 16; ++k) { const int kk = wave * 256 + k0 + k;
#pragma unroll
                for (int b = 0; b < 4; ++b) { const float cv = cs[b * 2048 + kk]; acc[b][0] += cv * w[k].x; acc[b][1] += cv * w[k].y; } }
        }
#pragma unroll
        for (int b = 0; b < 4; ++b) { red[(wave * 4 + b) * 128 + 2 * lane] = acc[b][0]; red[(wave * 4 + b) * 128 + 2 * lane + 1] = acc[b][1]; }
        __syncthreads();
        { const int b = tid >> 7, cc = tid & 127; float s = 0.f;
#pragma unroll
          for (int w = 0; w < 8; ++w) s += red[(w * 4 + b) * 128 + cc];
          mod[b * 12288 + u * 128 + cc] = s + b_ada[u * 128 + cc]; }
        __syncthreads();
    }
}
__device__ __forceinline__ void transpose_item(const float* W, int ldw, int ncols, int K, bf16* WT, int row_off, LAS float* scr, int item, int lane, int ldt = 0) {
    if (ldt == 0) ldt = K;
    const int nblk = ncols / 32, kb = item / nblk, nb = item % nblk, k0 = 64 * kb, n0 = 32 * nb;
    float tv[32];
#pragma unroll
    for (int i = 0; i < 32; ++i) tv[i] = W[(size_t)(k0 + 2 * i + (lane >> 5)) * ldw + n0 + (lane & 31)];
#pragma unroll
    for (int i = 0; i < 32; ++i) scr[(2 * i + (lane >> 5)) * 33 + (lane & 31)] = tv[i];
    asm volatile("s_waitcnt lgkmcnt(0)" ::: "memory");
    const int c = lane & 7;
#pragma unroll
    for (int j = 0; j < 4; ++j) { const int n = (lane >> 3) + 8 * j; const LAS float* s = scr + (8 * c) * 33 + n;
        v4u o; o.x = pk2(s[0 * 33], s[1 * 33]); o.y = pk2(s[2 * 33], s[3 * 33]); o.z = pk2(s[4 * 33], s[5 * 33]); o.w = pk2(s[6 * 33], s[7 * 33]);
        *(v4u*)(WT + (size_t)(row_off + n0 + n) * ldt + k0 + 8 * c) = o; }
    asm volatile("s_waitcnt lgkmcnt(0)" ::: "memory");
}
__device__ __forceinline__ void transpose_item_f4(const float* W, int ldw, int ncols, int K, unsigned char* WT, LAS float* scr, int item, int lane, float inv) {
    const int nblk = ncols / 32, kb = item / nblk, nb = item % nblk, k0 = 64 * kb, n0 = 32 * nb;
    float tv[32];
#pragma unroll
    for (int i = 0; i < 32; ++i) tv[i] = W[(size_t)(k0 + 2 * i + (lane >> 5)) * ldw + n0 + (lane & 31)];
#pragma unroll
    for (int i = 0; i < 32; ++i) scr[(2 * i + (lane >> 5)) * 33 + (lane & 31)] = __builtin_amdgcn_fmed3f(tv[i] * inv, -6.f, 6.f);
    asm volatile("s_waitcnt lgkmcnt(0)" ::: "memory");
    const int c = lane & 7;
#pragma unroll
    for (int j = 0; j < 4; ++j) { const int n = (lane >> 3) + 8 * j; const LAS float* sp = scr + (8 * c) * 33 + n;
        unsigned q = 0u;
        q = __builtin_amdgcn_cvt_scalef32_pk_fp4_f32(q, sp[0 * 33], sp[1 * 33], 1.0f, 0); q = __builtin_amdgcn_cvt_scalef32_pk_fp4_f32(q, sp[2 * 33], sp[3 * 33], 1.0f, 1);
        q = __builtin_amdgcn_cvt_scalef32_pk_fp4_f32(q, sp[4 * 33], sp[5 * 33], 1.0f, 2); q = __builtin_amdgcn_cvt_scalef32_pk_fp4_f32(q, sp[6 * 33], sp[7 * 33], 1.0f, 3);
        *(unsigned*)(WT + (size_t)(n0 + n) * (K / 2) + (k0 + 8 * c) / 2) = q; }
    asm volatile("s_waitcnt lgkmcnt(0)" ::: "memory");
}
__device__ __forceinline__ void transpose_item_f8(const float* W, int ldw, int ncols, int K, unsigned char* WT, int row_off, LAS float* scr, int item, int lane) {
    const int nblk = ncols / 32, kb = item / nblk, nb = item % nblk, k0 = 64 * kb, n0 = 32 * nb;
    float tv[32];
#pragma unroll
    for (int i = 0; i < 32; ++i) tv[i] = W[(size_t)(k0 + 2 * i + (lane >> 5)) * ldw + n0 + (lane & 31)];
#pragma unroll
    for (int i = 0; i < 32; ++i) scr[(2 * i + (lane >> 5)) * 33 + (lane & 31)] = tv[i] * F8_WS;
    asm volatile("s_waitcnt lgkmcnt(0)" ::: "memory");
    const int c = lane & 7;
#pragma unroll
    for (int j = 0; j < 4; ++j) { const int n = (lane >> 3) + 8 * j; const LAS float* s = scr + (8 * c) * 33 + n;
        v2u o; o.x = pk4_f8(s[0 * 33], s[1 * 33], s[2 * 33], s[3 * 33]); o.y = pk4_f8(s[4 * 33], s[5 * 33], s[6 * 33], s[7 * 33]);
        *(v2u*)(WT + (size_t)(row_off + n0 + n) * K + k0 + 8 * c) = o; }
    asm volatile("s_waitcnt lgkmcnt(0)" ::: "memory");
}
__device__ __forceinline__ void ph0_weights(const Args& a, LAS unsigned char* lds) {
    const int tid = phase_tid(), lane = tid & 63, wave = __builtin_amdgcn_readfirstlane(tid >> 6);
    LAS float* scr = (LAS float*)(lds + wave * 16384);
    const int gw = blockIdx.x * NWAVES + wave, NGW = gridDim.x * NWAVES;
    const float* w_in = a.in[5];
    float wm_inv;
    { LAS float* red = (LAS float*)(lds + 8 * 16384);
      float ss = 0.f;
#pragma unroll
      for (int i = 0; i < 32; ++i) { const int e = i * NTHREADS + tid; const float v = w_in[(size_t)(e >> 10) * IN_COLS + OFF_MERGE + (e & 1023)]; ss += v * v; }
      ss = wave_sum(ss);
      if (lane == 0) red[wave] = ss;
      __syncthreads();
      float tot = 0.f;
#pragma unroll
      for (int w = 0; w < 8; ++w) tot += red[w];
      const float step = 0.48f * sqrtf(tot * (1.f / 16384.f));
      wm_inv = step > 0.f ? 1.f / step : 0.f;
      if (blockIdx.x == 0 && tid == 0) *(float*)(a.ws + WS_WMS) = step;
      __syncthreads(); }
    unsigned char* WIN = a.ws + WS_WIN;
    constexpr int I_Q = 32 * (NQ / 32), I_KV = 32 * (NKV / 32), I_DL = 32 * (NDL / 32), I_MG = 32 * (NMG / 32);
    constexpr int I_BN = 16 * 64, I_BD = 8 * 64, I_O = 32 * 64, I_PQ = 32 * 64;
    constexpr int NITEMS = I_Q + I_KV + I_DL + I_MG + I_BN + I_BD + I_O + I_PQ;
    for (int it = gw; it < NITEMS; it += NGW) {
        int r = it;
        if (r < I_Q)  { transpose_item_f8(w_in, IN_COLS, NQ, D, WIN, 0, scr, r, lane); continue; } r -= I_Q;
        if (r < I_KV) { transpose_item_f8(w_in + OFF_KV, IN_COLS, NKV, D, WIN, NQ, scr, r, lane); continue; } r -= I_KV;
        if (r < I_DL) { transpose_item_f8(w_in + OFF_DIL, IN_COLS, NDL, D, WIN, NQ + NKV, scr, r, lane); continue; } r -= I_DL;
        if (r < I_MG) { transpose_item_f4(w_in + OFF_MERGE, IN_COLS, NMG, D, a.ws + WS_WM4, scr, r, lane, wm_inv); continue; } r -= I_MG;
        if (r < I_BN) { transpose_item(a.in[13], D, D, 1024, (bf16*)(a.ws + WS_WBN), 0, scr, r, lane, 1536); continue; } r -= I_BN;
        if (r < I_BD) { transpose_item(a.in[14], D, D, 512, (bf16*)(a.ws + WS_WBN) + 1024, 0, scr, r, lane, 1536); continue; } r -= I_BD;
        if (r < I_O)  { transpose_item_f8(a.in[15], D, D, D, a.ws + WS_WOUT, 0, scr, r, lane); continue; } r -= I_O;
        transpose_item(a.in[17], D, D, D, (bf16*)(a.ws + WS_WPQ), 0, scr, r, lane);
    }
}

constexpr size_t WS_CW1F = 602 * MiB;
constexpr size_t WS_WGF = 604 * MiB;
constexpr size_t WS_CBP = 604 * MiB + 256 * 1024;
constexpr size_t WS_END4 = 605 * MiB;
__device__ __forceinline__ void ph0_extra(const Args& a) {
    const int tid = phase_tid(), lane = tid & 63, wave = __builtin_amdgcn_readfirstlane(tid >> 6);
    const float* w1 = a.in[9]; const float* pos = a.in[8]; const float* w_in = a.in[5];
    v4u* CW = (v4u*)(a.ws + WS_CW1F); v4u* WG = (v4u*)(a.ws + WS_WGF); float* CBP = (float*)(a.ws + WS_CBP);
    for (int i = blockIdx.x * NTHREADS + tid; i < 2 * 4 * 256 * 64; i += gridDim.x * NTHREADS) {
        const int ln = i & 63, ks = (i >> 6) & 255, nt = (i >> 14) & 3, j = i >> 16;
        const float* src = w1 + ((size_t)j * 4096 + 16 * ks + 8 * (ln >> 5)) * 128 + 32 * nt + (ln & 31);
        v4u o; o.x = pk2(src[0], src[128]); o.y = pk2(src[256], src[384]); o.z = pk2(src[512], src[640]); o.w = pk2(src[768], src[896]);
        CW[i] = o;
    }
    for (int i = blockIdx.x * NTHREADS + tid; i < 128 * 64; i += gridDim.x * NTHREADS) {
        const int ln = i & 63, ks = i >> 6, jrow = ln & 31;
        v4u o = {0u, 0u, 0u, 0u};
        if (jrow < 24) { const float* src = w_in + (size_t)(16 * ks + 8 * (ln >> 5)) * IN_COLS + OFF_GATE + jrow;
            o.x = pk2(src[0], src[IN_COLS]); o.y = pk2(src[2 * (size_t)IN_COLS], src[3 * (size_t)IN_COLS]); o.z = pk2(src[4 * (size_t)IN_COLS], src[5 * (size_t)IN_COLS]); o.w = pk2(src[6 * (size_t)IN_COLS], src[7 * (size_t)IN_COLS]); }
        WG[i] = o;
    }
    { const int gw = blockIdx.x * NWAVES + wave;
      if (gw < 128) { const int kc = gw >> 1, j = gw & 1; float s0 = 0.f, s1 = 0.f; const float* wp = w1 + ((size_t)j * 4096 + 64 * kc) * 128 + lane; const float* pp = pos + j * 4096 + 64 * kc;
#pragma unroll 1
          for (int k0 = 0; k0 < 64; k0 += 16) { float wa[16], wb[16];
#pragma unroll
              for (int k = 0; k < 16; ++k) { wa[k] = wp[(k0 + k) * 128]; wb[k] = wp[(k0 + k) * 128 + 64]; }
#pragma unroll
              for (int k = 0; k < 16; ++k) { const float pv = pp[k0 + k]; s0 += pv * wa[k]; s1 += pv * wb[k]; } }
          CBP[(kc * 2 + j) * 128 + lane] = s0; CBP[(kc * 2 + j) * 128 + 64 + lane] = s1; } }
}

template <bool F8 = false>
__device__ __forceinline__ void ph_norm(const Args& a, const float* xin, const float* gvec, int sh_off, int sc_off, bf16* hout, unsigned char* h8 = nullptr) {
    const int tid = phase_tid(), lane = tid & 63, wave = __builtin_amdgcn_readfirstlane(tid >> 6);
    const int gw = blockIdx.x * NWAVES + wave, NGW = gridDim.x * NWAVES;
    const float* mod = (const float*)(a.ws + WS_MOD);
    for (int r = gw; r < S / 2; r += NGW)
#pragma unroll 1
        for (int bq = 0; bq < NB; ++bq) {
            const int m0 = bq * S + r, m1 = m0 + S / 2;
            const float* x0 = xin + (size_t)m0 * D + 8 * lane; const float* x1 = xin + (size_t)m1 * D + 8 * lane;
            f32x4 v0[8], v1[8];
#pragma unroll
            for (int c = 0; c < 4; ++c) { v0[2 * c] = *(const f32x4*)(x0 + 512 * c); v0[2 * c + 1] = *(const f32x4*)(x0 + 512 * c + 4); v1[2 * c] = *(const f32x4*)(x1 + 512 * c); v1[2 * c + 1] = *(const f32x4*)(x1 + 512 * c + 4); }
            float s0 = 0.f, s1 = 0.f;
#pragma unroll
            for (int i = 0; i < 8; ++i) { s0 += (v0[i].x * v0[i].x + v0[i].y * v0[i].y) + (v0[i].z * v0[i].z + v0[i].w * v0[i].w); s1 += (v1[i].x * v1[i].x + v1[i].y * v1[i].y) + (v1[i].z * v1[i].z + v1[i].w * v1[i].w); }
            const float r0 = rsqrtf(wave_sum(s0) * (1.f / D) + EPS), r1 = rsqrtf(wave_sum(s1) * (1.f / D) + EPS);
            const float* shp = mod + bq * 12288 + sh_off + 8 * lane; const float* scp = mod + bq * 12288 + sc_off + 8 * lane; const float* gp = gvec + 8 * lane;
#pragma unroll
            for (int c = 0; c < 4; ++c) {
                v4u o0, o1; unsigned w0[4], w1[4]; [[maybe_unused]] unsigned q0[2], q1[2];
#pragma unroll
                for (int hq = 0; hq < 2; ++hq) { const f32x4 g = *(const f32x4*)(gp + 512 * c + 4 * hq), sc = *(const f32x4*)(scp + 512 * c + 4 * hq), sh = *(const f32x4*)(shp + 512 * c + 4 * hq);
                    const f32x4 ga = g * (1.f + sc); const f32x4 y0 = v0[2 * c + hq] * r0 * ga + sh, y1 = v1[2 * c + hq] * r1 * ga + sh;
                    if constexpr (F8) { v0[2 * c + hq] = y0; v1[2 * c + hq] = y1; }
                    w0[2 * hq] = pk2(y0.x, y0.y); w0[2 * hq + 1] = pk2(y0.z, y0.w); w1[2 * hq] = pk2(y1.x, y1.y); w1[2 * hq + 1] = pk2(y1.z, y1.w);
                    if constexpr (F8) { q0[hq] = pk4_f8(y0.x * F8_HS, y0.y * F8_HS, y0.z * F8_HS, y0.w * F8_HS); q1[hq] = pk4_f8(y1.x * F8_HS, y1.y * F8_HS, y1.z * F8_HS, y1.w * F8_HS); } }
                o0.x = w0[0]; o0.y = w0[1]; o0.z = w0[2]; o0.w = w0[3]; o1.x = w1[0]; o1.y = w1[1]; o1.z = w1[2]; o1.w = w1[3];
                *(v4u*)(hout + (size_t)m0 * D + 512 * c + 8 * lane) = o0; *(v4u*)(hout + (size_t)m1 * D + 512 * c + 8 * lane) = o1;
                if constexpr (F8) { v2u p0, p1; p0.x = q0[0]; p0.y = q0[1]; p1.x = q1[0]; p1.y = q1[1];
                    *(v2u*)(h8 + (size_t)m0 * D + 512 * c + 8 * lane) = p0; *(v2u*)(h8 + (size_t)m1 * D + 512 * c + 8 * lane) = p1; }
            }
            if constexpr (F8) {
                float t0 = 0.f, t1 = 0.f;
#pragma unroll
                for (int i = 0; i < 8; ++i) { t0 += (v0[i].x * v0[i].x + v0[i].y * v0[i].y) + (v0[i].z * v0[i].z + v0[i].w * v0[i].w); t1 += (v1[i].x * v1[i].x + v1[i].y * v1[i].y) + (v1[i].z * v1[i].z + v1[i].w * v1[i].w); }
                const float st0 = 0.48f * sqrtf(wave_sum(t0) * (1.f / D)), st1 = 0.48f * sqrtf(wave_sum(t1) * (1.f / D));
                const float i0 = st0 > 0.f ? 1.f / st0 : 0.f, i1 = st1 > 0.f ? 1.f / st1 : 0.f;
                unsigned char* h4 = a.ws + WS_H4; float* hs = (float*)(a.ws + WS_HS);
#pragma unroll
                for (int c = 0; c < 4; ++c) { unsigned qa = 0u, qb = 0u; const f32x4 a0 = v0[2 * c] * i0, a1 = v0[2 * c + 1] * i0, b0 = v1[2 * c] * i1, b1 = v1[2 * c + 1] * i1;
#define F4C(x) __builtin_amdgcn_fmed3f((x), -6.f, 6.f)
                    qa = __builtin_amdgcn_cvt_scalef32_pk_fp4_f32(qa, F4C(a0.x), F4C(a0.y), 1.0f, 0); qa = __builtin_amdgcn_cvt_scalef32_pk_fp4_f32(qa, F4C(a0.z), F4C(a0.w), 1.0f, 1);
                    qa = __builtin_amdgcn_cvt_scalef32_pk_fp4_f32(qa, F4C(a1.x), F4C(a1.y), 1.0f, 2); qa = __builtin_amdgcn_cvt_scalef32_pk_fp4_f32(qa, F4C(a1.z), F4C(a1.w), 1.0f, 3);
                    qb = __builtin_amdgcn_cvt_scalef32_pk_fp4_f32(qb, F4C(b0.x), F4C(b0.y), 1.0f, 0); qb = __builtin_amdgcn_cvt_scalef32_pk_fp4_f32(qb, F4C(b0.z), F4C(b0.w), 1.0f, 1);
                    qb = __builtin_amdgcn_cvt_scalef32_pk_fp4_f32(qb, F4C(b1.x), F4C(b1.y), 1.0f, 2); qb = __builtin_amdgcn_cvt_scalef32_pk_fp4_f32(qb, F4C(b1.z), F4C(b1.w), 1.0f, 3);
#undef F4C
                    *(unsigned*)(h4 + (size_t)m0 * (D / 2) + 256 * c + 4 * lane) = qa; *(unsigned*)(h4 + (size_t)m1 * (D / 2) + 256 * c + 4 * lane) = qb; }
                if (lane == 0) { hs[m0] = st0; hs[m1] = st1; }
            }
        }
}

using pg8::Unit; using pg8::HALF; using pg8::BM;
struct EpiProj {
    static constexpr bool PERM = true;
    bf16 *q, *kv, *dl, *mg;
    __device__ __forceinline__ void operator()(const f32x4 (&acc)[2][2][4][2], const Unit& u, int wr, int wc, int fr, int fq) const {
        bf16* base; int ldc, colt = u.pn * BM;
        if (colt < NQ) { base = q; ldc = NQ; } else if (colt < NQ + NKV) { base = kv; ldc = NKV; colt -= NQ; } else if (colt < NQ + NKV + NDL) { base = dl; ldc = NDL; colt -= NQ + NKV; } else { base = mg; ldc = NMG; colt -= NQ + NKV + NDL; }
        const int row0 = u.pm * BM + wr * 64 + fr, col0 = colt + wc * 32 + 8 * fq;
#pragma unroll
        for (int ai = 0; ai < 2; ++ai)
#pragma unroll
            for (int m = 0; m < 4; ++m) { bf16* rowp = base + (size_t)(row0 + ai * HALF + m * 16) * ldc + col0;
#pragma unroll
                for (int bj = 0; bj < 2; ++bj) { const f32x4 v0 = acc[ai][bj][m][0], v1 = acc[ai][bj][m][1];
                    v4u w; w.x = pg8::cvt_pk_bf16(v0[0], v0[1]); w.y = pg8::cvt_pk_bf16(v0[2], v0[3]); w.z = pg8::cvt_pk_bf16(v1[0], v1[1]); w.w = pg8::cvt_pk_bf16(v1[2], v1[3]);
                    *(v4u*)(rowp + bj * HALF) = w; } }
    }
};
struct MidMerge {
    static constexpr int AT = 16;
    const bf16* mg;
    __device__ __forceinline__ void operator()(f32x4 (&acc)[2][2][4][2], const Unit& u, int wr, int wc, int fr, int fq) const {
        int lo = (fq * 16 + fr) * 8;
        asm volatile("" : "+v"(lo));
        const bf16* t1 = mg + (((size_t)(u.pm * 16 + u.pn) * 8 + (wr * 4 + wc)) << 13) + lo; const bf16* t2 = t1 + ((size_t)8 << 16);
#pragma unroll
        for (int ai = 0; ai < 2; ++ai) {
            v4u a1[4][2], a2[4][2];
#pragma unroll
            for (int m = 0; m < 4; ++m)
#pragma unroll
                for (int bj = 0; bj < 2; ++bj) { a1[m][bj] = *(const v4u*)(t1 + ((ai * 4 + m) * 2 + bj) * 512); a2[m][bj] = *(const v4u*)(t2 + ((ai * 4 + m) * 2 + bj) * 512); }
#pragma unroll
            for (int m = 0; m < 4; ++m)
#pragma unroll
                for (int bj = 0; bj < 2; ++bj) { const unsigned w1[4] = {a1[m][bj].x, a1[m][bj].y, a1[m][bj].z, a1[m][bj].w}, w2[4] = {a2[m][bj].x, a2[m][bj].y, a2[m][bj].z, a2[m][bj].w};
#pragma unroll
                    for (int q = 0; q < 4; ++q) { const float r0 = (1.f + __expf(-bflo(w2[q]))) * __builtin_amdgcn_rcpf(1.f + __expf(-bflo(w1[q]))), r1 = (1.f + __expf(-bfhi(w2[q]))) * __builtin_amdgcn_rcpf(1.f + __expf(-bfhi(w1[q])));
                        acc[ai][bj][m][q >> 1][2 * (q & 1)] *= r0; acc[ai][bj][m][q >> 1][2 * (q & 1) + 1] *= r1; } }
            asm volatile("" ::: "memory");
        }
    }
};
struct EpiMerge {
    static constexpr bool PERM = true;
    const bf16* mg; unsigned char* merged8; float os;
    __device__ __forceinline__ void operator()(const f32x4 (&acc)[2][2][4][2], const Unit& u, int wr, int wc, int fr, int fq) const {
        int row0 = u.pm * BM + wr * 64 + fr; const int col0 = u.pn * BM + wc * 32 + 8 * fq;
        asm volatile("" : "+v"(row0));
        const bf16* t2 = mg + (((size_t)(u.pm * 16 + 8 + u.pn) * 8 + (wr * 4 + wc)) << 13) + (fq * 16 + fr) * 8;
        v4u a2[2][4][2];
#pragma unroll
        for (int ai = 0; ai < 2; ++ai)
#pragma unroll
            for (int m = 0; m < 4; ++m)
#pragma unroll
                for (int bj = 0; bj < 2; ++bj) a2[ai][m][bj] = *(const v4u*)(t2 + ((ai * 4 + m) * 2 + bj) * 512);
#pragma unroll
        for (int ai = 0; ai < 2; ++ai)
#pragma unroll
            for (int m = 0; m < 4; ++m) { const size_t row = (size_t)(row0 + ai * HALF + m * 16);
#pragma unroll
                for (int bj = 0; bj < 2; ++bj) { const unsigned w2[4] = {a2[ai][m][bj].x, a2[ai][m][bj].y, a2[ai][m][bj].z, a2[ai][m][bj].w};
                    const f32x4 v0 = acc[ai][bj][m][0] * os, v1 = acc[ai][bj][m][1] * os;
                    v2u w; w.x = pk4_f8(v0[0] * sigmoidf(bflo(w2[0])), v0[1] * sigmoidf(bfhi(w2[0])), v0[2] * sigmoidf(bflo(w2[1])), v0[3] * sigmoidf(bfhi(w2[1])));
                    w.y = pk4_f8(v1[0] * sigmoidf(bflo(w2[2])), v1[1] * sigmoidf(bfhi(w2[2])), v1[2] * sigmoidf(bflo(w2[3])), v1[3] * sigmoidf(bfhi(w2[3])));
                    *(v2u*)(merged8 + row * D + col0 + bj * HALF) = w; } }
    }
};
struct EpiOut {
    static constexpr bool PERM = false;
    const float* x; const float* mod; float* x1; float as;
    __device__ __forceinline__ void operator()(const f32x4 (&acc)[2][2][4][2], const Unit& u, int wr, int wc, int fr, int fq) const {
        const int row0 = u.pm * BM + wr * 64 + fr, col0 = u.pn * BM + wc * 32 + 4 * fq;
        const int b = (u.pm * BM) / S;
        f32x4 gv[2][2];
#pragma unroll
        for (int bj = 0; bj < 2; ++bj)
#pragma unroll
            for (int n = 0; n < 2; ++n) gv[bj][n] = *(const f32x4*)(mod + b * 12288 + 4096 + col0 + bj * HALF + n * 16) * as;
#pragma unroll
        for (int ai = 0; ai < 2; ++ai)
#pragma unroll
            for (int m = 0; m < 4; ++m) { const size_t off = (size_t)(row0 + ai * HALF + m * 16) * D + col0;
#pragma unroll
                for (int bj = 0; bj < 2; ++bj)
#pragma unroll
                    for (int n = 0; n < 2; ++n) *(f32x4*)(x1 + off + bj * HALF + n * 16) = *(const f32x4*)(x + off + bj * HALF + n * 16) + gv[bj][n] * acc[ai][bj][m][n]; }
    }
};
struct EpiF32 {
    static constexpr bool PERM = false;
    float* C; int ldc;
    __device__ __forceinline__ void operator()(const f32x4 (&acc)[2][2][4][2], const Unit& u, int wr, int wc, int fr, int fq) const {
        const int row0 = u.pm * BM + wr * 64 + fr, col0 = u.pn * BM + wc * 32 + 4 * fq;
#pragma unroll
        for (int ai = 0; ai < 2; ++ai)
#pragma unroll
            for (int m = 0; m < 4; ++m) { float* rowp = C + (size_t)(row0 + ai * HALF + m * 16) * ldc + col0;
#pragma unroll
                for (int bj = 0; bj < 2; ++bj)
#pragma unroll
                    for (int n = 0; n < 2; ++n) *(f32x4*)(rowp + bj * HALF + n * 16) = acc[ai][bj][m][n]; }
    }
};

typedef short bf16x8 __attribute__((ext_vector_type(8)));
typedef float f32x16 __attribute__((ext_vector_type(16)));
typedef float f32x2 __attribute__((ext_vector_type(2)));
typedef __bf16 bf2v __attribute__((ext_vector_type(2)));
constexpr float LOG2E = 1.4426950408889634f;
constexpr float QS2 = QSCALE * LOG2E;
constexpr float NEGB = -1e30f;
__device__ __forceinline__ unsigned pkbf(float a, float b) { const f32x2 v = {a, b}; const bf2v r = __builtin_convertvector(v, bf2v); return __builtin_bit_cast(unsigned, r); }
__device__ __forceinline__ float ex2(float x) { return __builtin_amdgcn_exp2f(x); }
__device__ __forceinline__ int swap23(int x) { return (x & ~12) | ((x & 4) << 1) | ((x & 8) >> 1); }
__device__ __forceinline__ size_t kf_off(int key, int d) { return ((size_t)((key >> 5) * 8 + (d >> 4)) * 64 + ((d >> 3) & 1) * 32 + swap23(key & 31)) * 8 + (d & 7); }
__device__ __forceinline__ size_t vf_off(int key, int d) { const int kk = key & 31; return ((size_t)(((key >> 5) * 4 + (d >> 5)) * 2 + (kk >> 4)) * 64 + ((kk >> 3) & 1) * 32 + (d & 31)) * 8 + (kk & 7); }
__device__ __forceinline__ size_t kf8_off(int key, int d) { return ((size_t)((key >> 5) * 4 + (d >> 5)) * 64 + ((d >> 3) & 1) * 32 + swap23(key & 31)) * 16 + ((d >> 4) & 1) * 8 + (d & 7); }
__device__ __forceinline__ size_t vf8_off(int key, int d) { const int kk = key & 31; return ((size_t)((key >> 5) * 4 + (d >> 5)) * 64 + ((kk >> 3) & 1) * 32 + (d & 31)) * 16 + (kk >> 4) * 8 + (kk & 7); }
__device__ __forceinline__ unsigned char* fr8_nsa(const Args& a, int bg, int kind) { return (unsigned char*)a.out + ((size_t)(bg * 4 + kind) << 19); }
__device__ __forceinline__ unsigned char* fr8_dil(const Args& a, int b, int head, int kv) { return (unsigned char*)a.out + ((size_t)16 << 20) + ((size_t)((b * 12 + head) * 2 + kv) << 19); }
__device__ __forceinline__ bf16* fr_nsa(const Args& a, int bg, int kind) { return (bf16*)a.out + ((size_t)(bg * 4 + kind) << 19); }
__device__ __forceinline__ bf16* fr_dil(const Args& a, int b, int head, int kv) { return (bf16*)a.out + ((size_t)16 << 20) + ((size_t)((b * 12 + head) * 2 + kv) << 19); }
constexpr size_t WS_OD = 552 * MiB;
constexpr size_t WS_LSE = 600 * MiB;
constexpr size_t WS_END2 = 601 * MiB;

struct EpiProjNorm {
    static constexpr bool PERM = true;
    bf16 *q, *kv, *dl, *mg, *frg;
    const float *qg, *kg, *dqg, *dkg;
    LAS float* xch;
    float as;
    __device__ __forceinline__ void operator()(const f32x4 (&acc)[2][2][4][2], const Unit& u, int wr, int wc, int fr, int fq) const {
        bf16* base; int ldc, colt = u.pn * BM, mode = 0  , hsel = 0; const float* gain = qg; float scale = 1.f;
        if (colt < NQ) { base = q; ldc = NQ; mode = 1; gain = qg; scale = QS2; }
        else if (colt < NQ + NKV) { base = kv; ldc = NKV; colt -= NQ; hsel = colt >> 7; if (hsel == 4 || hsel == 8) { mode = 2; gain = kg + (hsel == 4 ? 128 : 256); } }
        else if (colt < NQ + NKV + NDL) { base = dl; ldc = NDL; colt -= NQ + NKV; hsel = colt >> 7; if (hsel < 12) { mode = 1; gain = dqg; scale = QS2; } else if (hsel < 24) { mode = 3; gain = dkg; } }
        else { base = mg; ldc = NMG; colt -= NQ + NKV + NDL; }
        const int row0 = u.pm * BM + wr * 64 + fr, col0 = colt + wc * 32 + 8 * fq;
        if (base == mg) {
            bf16* tp = mg + (((size_t)(u.pm * 16 + (colt >> 8)) * 8 + (wr * 4 + wc)) << 13) + (fq * 16 + fr) * 8;
#pragma unroll
            for (int ai = 0; ai < 2; ++ai)
#pragma unroll
                for (int m = 0; m < 4; ++m)
#pragma unroll
                    for (int bj = 0; bj < 2; ++bj) { const f32x4 v0 = acc[ai][bj][m][0] * as, v1 = acc[ai][bj][m][1] * as;
                        v4u w; w.x = pg8::cvt_pk_bf16(v0[0], v0[1]); w.y = pg8::cvt_pk_bf16(v0[2], v0[3]); w.z = pg8::cvt_pk_bf16(v1[0], v1[1]); w.w = pg8::cvt_pk_bf16(v1[2], v1[3]);
                        *(v4u*)(tp + ((ai * 4 + m) * 2 + bj) * 512) = w; }
            return;
        }
        if (mode == 0) {
#pragma unroll
            for (int ai = 0; ai < 2; ++ai)
#pragma unroll
                for (int m = 0; m < 4; ++m) { bf16* rowp = base + (size_t)(row0 + ai * HALF + m * 16) * ldc + col0;
#pragma unroll
                    for (int bj = 0; bj < 2; ++bj) { const f32x4 v0 = acc[ai][bj][m][0] * as, v1 = acc[ai][bj][m][1] * as;
                        v4u w; w.x = pg8::cvt_pk_bf16(v0[0], v0[1]); w.y = pg8::cvt_pk_bf16(v0[2], v0[3]); w.z = pg8::cvt_pk_bf16(v1[0], v1[1]); w.w = pg8::cvt_pk_bf16(v1[2], v1[3]);
                        *(v4u*)(rowp + bj * HALF) = w; } }
            return;
        }
#pragma unroll
        for (int ai = 0; ai < 2; ++ai)
#pragma unroll
            for (int m = 0; m < 4; ++m)
#pragma unroll
                for (int bj = 0; bj < 2; ++bj) { const f32x4 v0 = acc[ai][bj][m][0], v1 = acc[ai][bj][m][1];
                    float ss = (v0[0] * v0[0] + v0[1] * v0[1]) + (v0[2] * v0[2] + v0[3] * v0[3]) + (v1[0] * v1[0] + v1[1] * v1[1]) + (v1[2] * v1[2] + v1[3] * v1[3]);
                    ss += __shfl_xor(ss, 16); ss += __shfl_xor(ss, 32);
                    if (fq == 0) xch[(((((wr * 2 + ai) * 4 + m) * 16 + fr) * 2 + bj) << 2) + wc] = ss; }
        asm volatile("s_waitcnt lgkmcnt(0)" ::: "memory");
        __builtin_amdgcn_s_barrier();
        asm volatile("" ::: "memory");
        const f32x4 ga = *(const f32x4*)(gain + wc * 32 + 8 * fq), gb = *(const f32x4*)(gain + wc * 32 + 8 * fq + 4);
#pragma unroll
        for (int ai = 0; ai < 2; ++ai)
#pragma unroll
            for (int m = 0; m < 4; ++m) { const int t = row0 + ai * HALF + m * 16, b = t / S, s = t % S;
#pragma unroll
                for (int bj = 0; bj < 2; ++bj) { const f32x4 pp = *(const LAS f32x4*)(xch + (((((wr * 2 + ai) * 4 + m) * 16 + fr) * 2 + bj) << 2));
                    const float rstd = rsqrtf(((pp.x + pp.y) + (pp.z + pp.w)) * (as * as * (1.f / 128.f)) + EPS) * (scale * as);
                    const f32x4 v0 = acc[ai][bj][m][0] * rstd * ga, v1 = acc[ai][bj][m][1] * rstd * gb;
                    if (mode == 1) { v4u w; w.x = pg8::cvt_pk_bf16(v0[0], v0[1]); w.y = pg8::cvt_pk_bf16(v0[2], v0[3]); w.z = pg8::cvt_pk_bf16(v1[0], v1[1]); w.w = pg8::cvt_pk_bf16(v1[2], v1[3]);
                        *(v4u*)(base + (size_t)t * ldc + col0 + bj * HALF) = w; }
                    else { v2u w; w.x = pk4_f8(v0[0], v0[1], v0[2], v0[3]); w.y = pk4_f8(v1[0], v1[1], v1[2], v1[3]);
                        unsigned char* dst;
                        if (mode == 2) dst = (unsigned char*)frg + ((size_t)((b * 2 + bj) * 4 + (hsel == 4 ? 0 : 2)) << 19) + kf8_off(s, wc * 32 + 8 * fq);
                        else { const int head = hsel - 12 + bj, dsh = 2 * (head >> 2), vk = ((s & ((1 << dsh) - 1)) << (12 - dsh)) + (s >> dsh);
                            dst = (unsigned char*)frg + ((size_t)16 << 20) + ((size_t)((b * 12 + head) * 2) << 19) + kf8_off(vk, wc * 32 + 8 * fq); }
                        *(v2u*)dst = w; } } }
    }
};

__device__ __forceinline__ v4u norm_chunk16v(v4u w, const float* gain, float scale, int li) {
    float v[8] = {bflo(w.x), bfhi(w.x), bflo(w.y), bfhi(w.y), bflo(w.z), bfhi(w.z), bflo(w.w), bfhi(w.w)};
    float ss = 0.f;
#pragma unroll
    for (int j = 0; j < 8; ++j) ss += v[j] * v[j];
    ss += __shfl_xor(ss, 1); ss += __shfl_xor(ss, 2); ss += __shfl_xor(ss, 4); ss += __shfl_xor(ss, 8);
    const float rstd = rsqrtf(ss * (1.f / 128.f) + EPS) * scale;
#pragma unroll
    for (int j = 0; j < 8; ++j) v[j] = v[j] * rstd * gain[8 * li + j];
    w.x = pk2(v[0], v[1]); w.y = pk2(v[2], v[3]); w.z = pk2(v[4], v[5]); w.w = pk2(v[6], v[7]);
    return w;
}
__device__ __forceinline__ void ph3_headnorm(const Args& a) {
    const int tid = phase_tid(), lane = tid & 63, wave = __builtin_amdgcn_readfirstlane(tid >> 6), sub = lane >> 4, li = lane & 15;
    const int gw = blockIdx.x * NWAVES + wave, NGW = gridDim.x * NWAVES;
    bf16* Q = (bf16*)(a.ws + WS_Q); const bf16* KV = (const bf16*)(a.ws + WS_KV); bf16* DL = (bf16*)(a.ws + WS_DL);
    const float* qg = a.in[6]; const float* kg = a.in[7]; const float* dqg = a.in[11]; const float* dkg = a.in[12];
    for (int m = gw; m < T; m += NGW) {
        const int b = m / S, s = m % S;
        const int g = sub & 1, win = sub >> 1;
        v4u wq[2], wk, wd[6];
#pragma unroll
        for (int it = 0; it < 2; ++it) wq[it] = *(const v4u*)(Q + (size_t)m * NQ + (it * 4 + sub) * 128 + 8 * li);
        wk = *(const v4u*)(KV + (size_t)m * NKV + ((win ? 8 : 4) + g) * 128 + 8 * li);
#pragma unroll
        for (int it = 0; it < 6; ++it) wd[it] = *(const v4u*)(DL + (size_t)m * NDL + (it * 4 + sub) * 128 + 8 * li);
#pragma unroll
        for (int it = 0; it < 2; ++it) *(v4u*)(Q + (size_t)m * NQ + (it * 4 + sub) * 128 + 8 * li) = norm_chunk16v(wq[it], qg, QS2, li);
        *(v4u*)(fr_nsa(a, b * 2 + g, win ? 2 : 0) + kf_off(s, 8 * li)) = norm_chunk16v(wk, kg + (win ? 256 : 128), 1.f, li);
#pragma unroll
        for (int it = 0; it < 6; ++it) { const int ch = it * 4 + sub;
            if (ch < 12) *(v4u*)(DL + (size_t)m * NDL + ch * 128 + 8 * li) = norm_chunk16v(wd[it], dqg, QS2, li);
            else { const int head = ch - 12, gi = head >> 2, dsh = 2 * gi  , vk = ((s & ((1 << dsh) - 1)) << (12 - dsh)) + (s >> dsh);
                *(v4u*)(fr_dil(a, b, head, 0) + kf_off(vk, 8 * li)) = norm_chunk16v(wd[it], dkg, 1.f, li); } }
    }
}
__device__ __forceinline__ void ph3_vfrag(const Args& a) {
    const int tid = phase_tid(), lane = tid & 63, wave = __builtin_amdgcn_readfirstlane(tid >> 6);
    const int gw = blockIdx.x * NWAVES + wave, NGW = gridDim.x * NWAVES;
    const bf16* KV = (const bf16*)(a.ws + WS_KV); const bf16* DL = (const bf16*)(a.ws + WS_DL);
    for (int job = gw; job < 32768; job += NGW) {
        const bf16* src; size_t rstride; unsigned char* dst; int key0;
        if (job < 8192) { const int bg = job >> 10, kind = (job >> 9) & 1, s0 = (job & 511) * 8, b = bg >> 1, g = bg & 1;
            src = KV + (size_t)(b * S + s0) * NKV + ((kind ? 10 : 6) + g) * 128; rstride = NKV; dst = fr8_nsa(a, bg, kind ? 3 : 1); key0 = s0; }
        else { const int j2 = job - 8192, bh = j2 >> 9, vk0 = (j2 & 511) * 8, b = bh / 12, head = bh % 12, gi = head >> 2, dsh = 2 * gi, L = S >> dsh, r = vk0 / L, m0 = vk0 % L;
            src = DL + (size_t)(b * S + (m0 << dsh) + r) * NDL + (24 + head) * 128; rstride = (size_t)NDL << dsh; dst = fr8_dil(a, b, head, 1); key0 = vk0; }
        unsigned w[8];
#pragma unroll
        for (int jj = 0; jj < 8; ++jj) w[jj] = *(const unsigned*)(src + jj * rstride + 2 * lane);
        v2u c0, c1;
        c0.x = pk4_f8(bflo(w[0]), bflo(w[1]), bflo(w[2]), bflo(w[3])); c0.y = pk4_f8(bflo(w[4]), bflo(w[5]), bflo(w[6]), bflo(w[7]));
        c1.x = pk4_f8(bfhi(w[0]), bfhi(w[1]), bfhi(w[2]), bfhi(w[3])); c1.y = pk4_f8(bfhi(w[4]), bfhi(w[5]), bfhi(w[6]), bfhi(w[7]));
        *(v2u*)(dst + vf8_off(key0, 2 * lane)) = c0; *(v2u*)(dst + vf8_off(key0, 2 * lane + 1)) = c1;
    }
}
struct EpiMG {
    static constexpr bool PERM = true;
    bf16* mg; const float* hs; const float* wms;
    __device__ __forceinline__ void operator()(const f32x4 (&acc)[2][2][4][2], const Unit& u, int wr, int wc, int fr, int fq) const {
        const int row0 = u.pm * BM + wr * 64 + fr; const float ws = *wms;
        bf16* tp = mg + (((size_t)(u.pm * 16 + u.pn) * 8 + (wr * 4 + wc)) << 13) + (fq * 16 + fr) * 8;
#pragma unroll
        for (int ai = 0; ai < 2; ++ai)
#pragma unroll
            for (int m = 0; m < 4; ++m) { const float sc = hs[row0 + ai * HALF + m * 16] * ws;
#pragma unroll
                for (int bj = 0; bj < 2; ++bj) { const f32x4 v0 = acc[ai][bj][m][0] * sc, v1 = acc[ai][bj][m][1] * sc;
                    v4u w; w.x = pg8::cvt_pk_bf16(v0[0], v0[1]); w.y = pg8::cvt_pk_bf16(v0[2], v0[3]); w.z = pg8::cvt_pk_bf16(v1[0], v1[1]); w.w = pg8::cvt_pk_bf16(v1[2], v1[3]);
                    *(v4u*)(tp + ((ai * 4 + m) * 2 + bj) * 512) = w; } }
    }
};
__device__ __forceinline__ void ph3_gates(const Args& a) {
    const int tid = phase_tid(), lane = tid & 63, wave = __builtin_amdgcn_readfirstlane(tid >> 6), tl = lane & 31, hh = lane >> 5;
    const int gw = (gridDim.x - 1 - blockIdx.x) * NWAVES + wave, NGW = gridDim.x * NWAVES;
    const bf16* H = (const bf16*)(a.ws + WS_H); const v4u* WG = (const v4u*)(a.ws + WS_WGF) + lane; float* gates = (float*)(a.ws + WS_GATES);
    for (int job = gw; job < T / 32; job += NGW) {
        const int t = job * 32 + tl; const bf16* hr = H + (size_t)t * D + 8 * hh;
        f32x16 acc;
#pragma unroll
        for (int i = 0; i < 16; ++i) acc[i] = 0.f;
#pragma unroll 16
        for (int ks = 0; ks < 128; ++ks) { const bf16x8 af = __builtin_bit_cast(bf16x8, WG[ks * 64]), bfr = __builtin_bit_cast(bf16x8, *(const v4u*)(hr + 16 * ks));
            acc = __builtin_amdgcn_mfma_f32_32x32x16_bf16(af, bfr, acc, 0, 0, 0); }
#pragma unroll
        for (int i = 0; i < 16; ++i) { const int j = (i & 3) + 8 * (i >> 2) + 4 * hh; const float v = acc[i]; if (j < 24) gates[(size_t)t * 24 + j] = sigmoidf(v); }
    }
}
__device__ __forceinline__ void ph3_compress(const Args& a, LAS unsigned char* lds) {
    const int tid = phase_tid(), lane = tid & 63, wave = __builtin_amdgcn_readfirstlane(tid >> 6), cl = lane & 31, hh = lane >> 5;
    LAS float* part = (LAS float*)lds;
    LAS float* hid = part + 2 * 128 * 32;
    LAS float* ob = hid + 32 * 128;
    LAS float* bias = ob + 32 * 128;
    const bf16* KV = (const bf16*)(a.ws + WS_KV);
    const float* w2 = a.in[10]; const float* kg0 = a.in[7]; const float* CBP = (const float*)(a.ws + WS_CBP);
    for (int u = blockIdx.x; u < 128; u += gridDim.x) {
        const int j = u >> 6, bg = (u >> 3) & 7, ct = u & 7, b = bg >> 1, g = bg & 1, c0 = 32 * ct, hhd = j * 2 + g;
        if (tid < 128) { float s = 0.f;
#pragma unroll
            for (int kc = 0; kc < 64; ++kc) s += CBP[(kc * 2 + j) * 128 + tid];
            bias[tid] = s; }
        { const int nt = wave & 3, kh = wave >> 2, c = c0 + cl;
          const v4u* af = (const v4u*)(a.ws + WS_CW1F) + ((size_t)(j * 4 + nt) * 256 + 128 * kh) * 64 + lane;
          f32x16 acc;
#pragma unroll
          for (int i = 0; i < 16; ++i) acc[i] = 0.f;
#pragma unroll 16
          for (int ks = 0; ks < 128; ++ks) { const int k = 16 * (128 * kh + ks) + 8 * hh, l = k >> 7, d = k & 127, p = 16 * c + l;
              v4u x = {0u, 0u, 0u, 0u}; if (p < S) x = *(const v4u*)(KV + (size_t)(b * S + p) * NKV + hhd * 128 + d);
              acc = __builtin_amdgcn_mfma_f32_32x32x16_bf16(__builtin_bit_cast(bf16x8, af[ks * 64]), __builtin_bit_cast(bf16x8, x), acc, 0, 0, 0); }
#pragma unroll
          for (int i = 0; i < 16; ++i) { const int n = 32 * nt + (i & 3) + 8 * (i >> 2) + 4 * hh; const float v = acc[i]; part[(kh * 128 + n) * 32 + cl] = v; } }
        __syncthreads();
        for (int i = tid; i < 128 * 32; i += NTHREADS) { const int n = i >> 5, c = i & 31; hid[c * 128 + n] = gelu_tanh(part[i] + part[128 * 32 + i] + bias[n]); }
        __syncthreads();
        { const int n = tid & 127, cq = tid >> 7; float o[8];
#pragma unroll
          for (int r = 0; r < 8; ++r) o[r] = 0.f;
          const float* w2p = w2 + j * 128 * 128 + n;
          for (int k = 0; k < 128; ++k) { const float w = w2p[k * 128];
#pragma unroll
              for (int r = 0; r < 8; ++r) o[r] += hid[(8 * cq + r) * 128 + k] * w; }
#pragma unroll
          for (int r = 0; r < 8; ++r) ob[(8 * cq + r) * 128 + n] = o[r]; }
        __syncthreads();
        bf16* fr = (bf16*)(a.ws + (j == 0 ? WS_KC : WS_VC)) + (size_t)bg * 8 * 4096;
#pragma unroll 1
        for (int r = 0; r < 4; ++r) { const int cr = 4 * wave + r, c = c0 + cr; float v0 = ob[cr * 128 + 2 * lane], v1 = ob[cr * 128 + 2 * lane + 1];
            if (j == 0) { const float rstd = rsqrtf(wave_sum(v0 * v0 + v1 * v1) * (1.f / 128.f) + EPS); v0 = v0 * rstd * kg0[2 * lane]; v1 = v1 * rstd * kg0[2 * lane + 1]; }
            if (c >= NC) { v0 = 0.f; v1 = 0.f; }
            if (j == 0) *(unsigned*)(fr + kf_off(c, 2 * lane)) = pk2(v0, v1);
            else { fr[vf_off(c, 2 * lane)] = (bf16)f2bf(v0); fr[vf_off(c, 2 * lane + 1)] = (bf16)f2bf(v1); } }
        __syncthreads();
    }
}

#define KBI(i) (16 * ((i) >> 3) + ((i) & 7))
__device__ __forceinline__ void load_frags(bf16x8 (&f)[8], const v4u* p, int lane) {
#pragma unroll
    for (int i = 0; i < 8; ++i) f[i] = __builtin_bit_cast(bf16x8, p[i * 64 + lane]);
}
__device__ __forceinline__ f32x16 qk_mma(const bf16x8 (&qf)[8], const bf16x8 (&k)[8]) {
    f32x16 s;
#pragma unroll
    for (int i = 0; i < 16; ++i) s[i] = 0.f;
#pragma unroll
    for (int st = 0; st < 8; ++st) s = __builtin_amdgcn_mfma_f32_32x32x16_bf16(k[st], qf[st], s, 0, 0, 0);
    return s;
}
__device__ __forceinline__ f32x16 qk_tile(const bf16x8 (&qf)[8], const v4u* kf, int lane) { bf16x8 k[8]; load_frags(k, kf, lane); return qk_mma(qf, k); }
template <int STRIDE> __device__ __forceinline__ void add_tbl(f32x16& s, const LAS float* tp2, float pen) {
#pragma unroll
    for (int i = 0; i < 16; ++i) s[i] += tp2[STRIDE * (23 - KBI(i))] + pen;
}
__device__ __forceinline__ void mask_hi(f32x16& s, int lim) {
#pragma unroll
    for (int i = 0; i < 16; ++i) s[i] = (KBI(i) <= lim) ? s[i] : NEGB;
}
__device__ __forceinline__ void mask_lo(f32x16& s, int lim) {
#pragma unroll
    for (int i = 0; i < 16; ++i) s[i] = (KBI(i) >= lim) ? s[i] : NEGB;
}
__device__ __forceinline__ float max16(const f32x16& s) {
    float mx = fmaxf(s[0], s[1]);
#pragma unroll
    for (int i = 2; i < 16; ++i) mx = fmaxf(mx, s[i]);
    return fmaxf(mx, __shfl_xor(mx, 32));
}
__device__ __forceinline__ void pv_tile(const f32x16& p, f32x16 (&o)[4], const bf16x8 (&v)[8]) {
    v4u a0, a1;
    a0.x = pkbf(p[0], p[1]); a0.y = pkbf(p[2], p[3]); a0.z = pkbf(p[4], p[5]); a0.w = pkbf(p[6], p[7]);
    a1.x = pkbf(p[8], p[9]); a1.y = pkbf(p[10], p[11]); a1.z = pkbf(p[12], p[13]); a1.w = pkbf(p[14], p[15]);
    const bf16x8 pb0 = __builtin_bit_cast(bf16x8, a0), pb1 = __builtin_bit_cast(bf16x8, a1);
#pragma unroll
    for (int dt = 0; dt < 4; ++dt) { o[dt] = __builtin_amdgcn_mfma_f32_32x32x16_bf16(v[2 * dt], pb0, o[dt], 0, 0, 0); o[dt] = __builtin_amdgcn_mfma_f32_32x32x16_bf16(v[2 * dt + 1], pb1, o[dt], 0, 0, 0); }
}
__device__ __forceinline__ void softmax_pv(f32x16& s, f32x16 (&o)[4], float& m, float& l, const v4u* vf, int lane) {
    bf16x8 v[8];
#pragma unroll
    for (int i = 0; i < 8; ++i) v[i] = __builtin_bit_cast(bf16x8, vf[i * 64 + lane]);
    const float mn = fmaxf(m, max16(s));
    if (__ballot(mn > m + 8.f)) {
        const float corr = ex2(m - mn);
#pragma unroll
        for (int dt = 0; dt < 4; ++dt)
#pragma unroll
            for (int i = 0; i < 16; ++i) o[dt][i] *= corr;
        l *= corr; m = mn;
    }
    float ps = 0.f;
#pragma unroll
    for (int i = 0; i < 16; ++i) { s[i] = ex2(s[i] - m); ps += s[i]; }
    l += ps;
    pv_tile(s, o, v);
}
template <int NP = 0> __device__ __forceinline__ void softmax_pv_v(f32x16& s, f32x16 (&o)[4], float& m, float& l, const bf16x8 (&v)[8]) {
    if (NP == 2) { l += s[0]; pv_tile(s, o, v); return; }
    const float mn = fmaxf(m, max16(s));
    if (__ballot(mn > m + 8.f)) {
        const float corr = ex2(m - mn);
#pragma unroll
        for (int dt = 0; dt < 4; ++dt)
#pragma unroll
            for (int i = 0; i < 16; ++i) o[dt][i] *= corr;
        l *= corr; m = mn;
    }
    float ps = 0.f;
#pragma unroll
    for (int i = 0; i < 16; ++i) { s[i] = ex2(s[i] - m); ps += s[i]; }
    l += ps;
    pv_tile(s, o, v);
}
typedef long f8x8;
__device__ __forceinline__ void load_frags8(f8x8 (&f)[8], const v4u* p, int lane) {
#pragma unroll
    for (int i = 0; i < 4; ++i) { const v4u w = p[i * 64 + lane]; f[2 * i] = (long)(((unsigned long long)w.y << 32) | w.x); f[2 * i + 1] = (long)(((unsigned long long)w.w << 32) | w.z); }
}
__device__ __forceinline__ f32x16 qk_mma8(const f8x8 (&qf)[8], const f8x8 (&k)[8]) {
    f32x16 s;
#pragma unroll
    for (int i = 0; i < 16; ++i) s[i] = 0.f;
#pragma unroll
    for (int st = 0; st < 8; ++st) s = __builtin_amdgcn_mfma_f32_32x32x16_fp8_fp8(k[st], qf[st], s, 0, 0, 0);
    return s;
}
__device__ __forceinline__ unsigned pk4_f8n(float a, float b, float c, float d) { int w = 0; w = __builtin_amdgcn_cvt_pk_fp8_f32(a, b, w, false); w = __builtin_amdgcn_cvt_pk_fp8_f32(c, d, w, true); return (unsigned)w; }
__device__ __forceinline__ void pv_tile8(const f32x16& p, f32x16 (&o)[4], const f8x8 (&v)[8]) {
    const f8x8 pb0 = (long)(((unsigned long long)pk4_f8n(p[4], p[5], p[6], p[7]) << 32) | pk4_f8n(p[0], p[1], p[2], p[3]));
    const f8x8 pb1 = (long)(((unsigned long long)pk4_f8n(p[12], p[13], p[14], p[15]) << 32) | pk4_f8n(p[8], p[9], p[10], p[11]));
#pragma unroll
    for (int dt = 0; dt < 4; ++dt) { o[dt] = __builtin_amdgcn_mfma_f32_32x32x16_fp8_fp8(v[2 * dt], pb0, o[dt], 0, 0, 0); o[dt] = __builtin_amdgcn_mfma_f32_32x32x16_fp8_fp8(v[2 * dt + 1], pb1, o[dt], 0, 0, 0); }
}
template <int NP = 0> __device__ __forceinline__ void softmax_pv_v8(f32x16& s, f32x16 (&o)[4], float& m, float& l, const f8x8 (&v)[8]) {
    if (NP == 2) { l += s[0]; pv_tile8(s, o, v); return; }
    const float mn = fmaxf(m, max16(s));
    if (__ballot(mn > m + 8.f)) {
        const float corr = ex2(m - mn);
#pragma unroll
        for (int dt = 0; dt < 4; ++dt)
#pragma unroll
            for (int i = 0; i < 16; ++i) o[dt][i] *= corr;
        l *= corr; m = mn;
    }
    float ps = 0.f;
#pragma unroll
    for (int i = 0; i < 16; ++i) { s[i] = ex2(s[i] - m); ps += s[i]; }
    l += ps;
    pv_tile8(s, o, v);
}
__device__ __forceinline__ void q_to_f8(f8x8 (&q8)[8], const bf16x8 (&qf)[8]) {
#pragma unroll
    for (int st = 0; st < 8; ++st) { const v4u w = __builtin_bit_cast(v4u, qf[st]);
        q8[st] = (long)(((unsigned long long)pk4_f8(bflo(w.z), bfhi(w.z), bflo(w.w), bfhi(w.w)) << 32) | pk4_f8(bflo(w.x), bfhi(w.x), bflo(w.y), bfhi(w.y))); }
}
__device__ __forceinline__ void zero_o(f32x16 (&o)[4]) {
#pragma unroll
    for (int dt = 0; dt < 4; ++dt)
#pragma unroll
        for (int i = 0; i < 16; ++i) o[dt][i] = 0.f;
}
__device__ __forceinline__ void y_update(bf16* yp  , const f32x16 (&o)[4], float sc, bool acc) {
#pragma unroll
    for (int dt = 0; dt < 4; ++dt)
#pragma unroll
        for (int i4 = 0; i4 < 4; ++i4) { bf16* p = yp + 32 * dt + 8 * i4;
            float v0 = o[dt][4 * i4] * sc, v1 = o[dt][4 * i4 + 1] * sc, v2 = o[dt][4 * i4 + 2] * sc, v3 = o[dt][4 * i4 + 3] * sc;
            if (acc) { const v2u w = *(const v2u*)p; v0 += bflo(w.x); v1 += bfhi(w.x); v2 += bflo(w.y); v3 += bfhi(w.y); }
            v2u w; w.x = pkbf(v0, v1); w.y = pkbf(v2, v3); *(v2u*)p = w; }
}
constexpr int TBLN = 2624;
constexpr int OFF_TBL = 0, OFF_IMP = 43008, OFF_SELM = OFF_IMP + 65536, OFF_DTBL = OFF_SELM + 512;
constexpr int FAR_DIST = 1513;

template <int NP> __device__ __forceinline__ void nsa_unit(const Args& a, LAS unsigned char* lds, int u, int tid) {
    const int lane = tid & 63, wave = __builtin_amdgcn_readfirstlane(tid >> 6);
    const int qb = u >> 3, bg = u & 7, b = bg >> 1, g = bg & 1;
    const int r = wave >> 1, qs = wave & 1, hd = g * 4 + r, ql = lane & 31, h = lane >> 5;
    const int q0w = 64 * qb + 32 * qs, sq = q0w + ql, t = b * S + sq;
    LAS float* tball = (LAS float*)(lds + OFF_TBL);
    LAS float* imp = (LAS float*)(lds + OFF_IMP);
    LAS unsigned long long* selm = (LAS unsigned long long*)(lds + OFF_SELM);
    const float* relb = a.in[22];
    for (int i = tid; i < 4 * TBLN; i += NTHREADS) { const int hh = i / TBLN, dd = i % TBLN - 64; tball[i] = dd >= 0 ? relb[(g * 4 + hh) * 32 + t5_bucket(dd)] * LOG2E : 0.f; }
    for (int i = tid; i < 4 * 64 * 64; i += NTHREADS) imp[i] = 0.f;
    __syncthreads();
    const LAS float* tbl = tball + r * TBLN + 64;
    const float farc = relb[hd * 32 + 31] * LOG2E;
    bf16x8 qf[8];
    { const bf16* qrow = (const bf16*)(a.ws + WS_Q) + (size_t)t * NQ + hd * 128 + 8 * h;
#pragma unroll
      for (int st = 0; st < 8; ++st) qf[st] = __builtin_bit_cast(bf16x8, *(const v4u*)(qrow + 16 * st)); }
    const float* gt = (const float*)(a.ws + WS_GATES) + (size_t)t * 24 + hd * 3;
    const float g0 = gt[0], g1 = gt[1], g2 = gt[2];
    bf16* yp = (bf16*)(a.ws + (NP ? WS_H : WS_YN)) + (size_t)t * 1536 + hd * 128 + 4 * h;
    f32x16 o[4];
    {
        const v4u* kfc = (const v4u*)(a.ws + WS_KC) + (size_t)bg * 8 * 512; const v4u* vfc = (const v4u*)(a.ws + WS_VC) + (size_t)bg * 8 * 512;
        const int smax = q0w + 31, ncv = smax >= 31 ? ((smax - 31) >> 4) + 1 : 0, ntc = (ncv + 31) >> 5;
        float m = NEGB, l = 0.f;
        for (int tc = 0; tc < ntc; ++tc) {
            f32x16 s = qk_tile(qf, kfc + tc * 512, lane);
            const int dqc = sq - 31 - 512 * tc;
            if (q0w - 31 - 512 * tc - 496 >= FAR_DIST) {
#pragma unroll
                for (int i = 0; i < 16; ++i) s[i] += farc;
            } else add_tbl<16>(s, tbl + dqc - 16 * (8 * h + 23), 0.f);
            mask_hi(s, (dqc >> 4) - 8 * h);
            const float mn = fmaxf(m, max16(s));
            float ps = 0.f;
#pragma unroll
            for (int i = 0; i < 16; ++i) ps += ex2(s[i] - mn);
            l = l * ex2(m - mn) + ps; m = mn;
        }
        l += __shfl_xor(l, 32);
        const float inv = (sq >= 31) ? 1.f / l : 0.f;
        zero_o(o);
        LAS float* impq = imp + (r * 64 + 32 * qs + ql) * 64;
        for (int tc = 0; tc < ntc; ++tc) {
            f32x16 s = qk_tile(qf, kfc + tc * 512, lane);
            bf16x8 v[8];
#pragma unroll
            for (int i = 0; i < 8; ++i) v[i] = __builtin_bit_cast(bf16x8, vfc[tc * 512 + i * 64 + lane]);
            const int dqc = sq - 31 - 512 * tc;
            if (q0w - 31 - 512 * tc - 496 >= FAR_DIST) {
#pragma unroll
                for (int i = 0; i < 16; ++i) s[i] += farc;
            } else add_tbl<16>(s, tbl + dqc - 16 * (8 * h + 23), 0.f);
            mask_hi(s, (dqc >> 4) - 8 * h);
#pragma unroll
            for (int i = 0; i < 16; ++i) s[i] = ex2(s[i] - m) * inv;
#pragma unroll
            for (int a2 = 0; a2 < 2; ++a2)
#pragma unroll
                for (int bq = 0; bq < 2; ++bq) { const int j = 8 * tc + 4 * a2 + 2 * h + bq; const int i0 = 8 * a2 + 4 * bq;
                    impq[j] += (s[i0] + s[i0 + 1]) + (s[i0 + 2] + s[i0 + 3]); }
            asm volatile("s_waitcnt lgkmcnt(0)" ::: "memory");
#pragma unroll
            for (int a2 = 0; a2 < 2; ++a2)
#pragma unroll
                for (int bq = 0; bq < 2; ++bq) { const int j = 8 * tc + 4 * a2 + 2 * h + bq + 1; if (j < 64) impq[j] += s[8 * a2 + 4 * bq + 3]; }
            asm volatile("s_waitcnt lgkmcnt(0)" ::: "memory");
            pv_tile(s, o, v);
        }
        y_update(yp, o, g0, false);
    }
    f8x8 q8[8]; q_to_f8(q8, qf);
    __syncthreads();
    for (int qq = wave * 8; qq < wave * 8 + 8; ++qq) {
        const int jb = lane;
        const float im = ((imp[(0 * 64 + qq) * 64 + jb] + imp[(1 * 64 + qq) * 64 + jb]) + imp[(2 * 64 + qq) * 64 + jb]) + imp[(3 * 64 + qq) * 64 + jb];
        const bool forced = (jb == 0) || (jb == qb) || (jb == qb - 1);
        const float score = forced ? 1e4f : (jb > qb ? -1e4f : im);
        int rank = 0;
        for (int o2 = 0; o2 < 64; ++o2) { const float so = __shfl(score, o2); rank += (so > score) || (so == score && o2 < jb); }
        const unsigned long long mask = __ballot(rank < 16 && jb <= qb);
        if (lane == 0) selm[qq] = mask;
    }
    __syncthreads();
    {
        const v4u* kfw = (const v4u*)fr8_nsa(a, bg, 2); const v4u* vfw = (const v4u*)fr8_nsa(a, bg, 3);
        const int t_hi = q0w >> 5, t_lo = t_hi - 16;
        float m = NEGB, l = 0.f; zero_o(o);
        const int t0 = t_lo < 0 ? 0 : t_lo;
        for (int tt = t0; tt <= t_hi; ++tt) {
            const size_t to = (NP == 3) ? (size_t)(tt & 1) * 256 : (size_t)tt * 256;
            f8x8 kf[8], vf[8]; load_frags8(kf, kfw + to, lane);
            f32x16 s = qk_mma8(q8, kf); load_frags8(vf, vfw + to, lane);
            const int dq = sq - 32 * tt;
            add_tbl<1>(s, tbl + dq - (8 * h + 23), 0.f);
            if (tt == t_hi) mask_hi(s, dq - 8 * h);
            if (tt == t_lo) mask_lo(s, dq - 511 - 8 * h);
            softmax_pv_v8<NP>(s, o, m, l, vf);
        }
        l += __shfl_xor(l, 32);
        y_update(yp, o, g2 / l, true);
    }
    {
        const v4u* kfs = (const v4u*)fr8_nsa(a, bg, 0); const v4u* vfs = (const v4u*)fr8_nsa(a, bg, 1);
        const unsigned long long mask = selm[32 * qs + ql];
        float m = NEGB, l = 0.f; zero_o(o);
        const int t_end = 2 * qb + qs;
        for (int tt = 0; tt <= 2 * qb + 1; ++tt) {
            if (tt > t_end) continue;
            const float pen = ((mask >> (tt >> 1)) & 1ull) ? 0.f : NEGB;
            if (__ballot(pen == 0.f) == 0ull) continue;
            const size_t to = (NP == 3) ? (size_t)(tt & 1) * 256 : (size_t)tt * 256;
            f8x8 kf[8], vf[8]; load_frags8(kf, kfs + to, lane);
            f32x16 s = qk_mma8(q8, kf); load_frags8(vf, vfs + to, lane);
            const int dq = sq - 32 * tt;
            if (q0w - (32 * tt + 31) >= FAR_DIST) {
                const float c = farc + pen;
#pragma unroll
                for (int i = 0; i < 16; ++i) s[i] += c;
            } else add_tbl<1>(s, tbl + dq - (8 * h + 23), pen);
            if (tt == t_end) mask_hi(s, dq - 8 * h);
            softmax_pv_v8<NP>(s, o, m, l, vf);
        }
        l += __shfl_xor(l, 32);
        y_update(yp, o, g1 / l, true);
    }
    __syncthreads();
}
__device__ __forceinline__ void dil_unit(const Args& a, LAS unsigned char* lds, int u, int tid) {
    const int lane = tid & 63, wave = __builtin_amdgcn_readfirstlane(tid >> 6), ql = lane & 31, h = lane >> 5;
    const int b = u >> 6, p = (u >> 4) & 3, c = u & 15, s0 = 256 * c;
    LAS float* dtbl = (LAS float*)(lds + OFF_DTBL);
    const float* relb = a.in[22] + 8 * 32;
    for (int i = tid; i < 3 * 192; i += NTHREADS) { const int gi = i / 192, dm = i % 192 - 32; dtbl[i] = dm >= 0 ? relb[(gi * 4 + p) * 32 + t5_bucket(dm << (2 * gi))] * LOG2E : 0.f; }
    __syncthreads();
    bf16* OD = (bf16*)(a.ws + WS_OD); float* LSE = (float*)(a.ws + WS_LSE);
    const bf16* DL = (const bf16*)(a.ws + WS_DL);
    for (int job = wave; job < 32; job += NWAVES) {
        int gi, rr, m0, vlo, vhi;
        if (job < 8) { gi = 0; rr = 0; m0 = s0 + 32 * job; vlo = 0; vhi = 32; }
        else if (job < 16) { gi = 1; rr = (job - 8) >> 1; m0 = (s0 >> 2) + 32 * (job & 1); vlo = 0; vhi = 32; }
        else { gi = 2; rr = job - 16; m0 = 32 * (c >> 1); vlo = 16 * (c & 1); vhi = vlo + 16; }
        const int dsh = 2 * gi, L = S >> dsh, head = gi * 4 + p;
        const int mq = m0 + ql, sact = (mq << dsh) + rr, t = b * S + sact;
        const v4u* kf = (const v4u*)fr8_dil(a, b, head, 0) + (size_t)((rr * L) >> 5) * 256; const v4u* vf = (const v4u*)fr8_dil(a, b, head, 1) + (size_t)((rr * L) >> 5) * 256;
        bf16x8 qf[8];
        { const bf16* qrow = DL + (size_t)t * NDL + head * 128 + 8 * h;
#pragma unroll
          for (int st = 0; st < 8; ++st) qf[st] = __builtin_bit_cast(bf16x8, *(const v4u*)(qrow + 16 * st)); }
        f8x8 q8[8]; q_to_f8(q8, qf);
        const LAS float* tb = dtbl + gi * 192 + 32;
        const int t_hi = m0 >> 5, t_lo = t_hi - 4;
        float m = NEGB, l = 0.f; f32x16 o[4]; zero_o(o);
        const int t0 = t_lo < 0 ? 0 : t_lo;
        for (int tt = t0; tt <= t_hi; ++tt) {
            f8x8 kr[8], vr[8]; load_frags8(kr, kf + (size_t)tt * 256, lane);
            f32x16 s = qk_mma8(q8, kr); load_frags8(vr, vf + (size_t)tt * 256, lane);
            const int dq = mq - 32 * tt;
            add_tbl<1>(s, tb + dq - (8 * h + 23), 0.f);
            if (tt == t_hi) mask_hi(s, dq - 8 * h);
            if (tt == t_lo) mask_lo(s, dq - 128 - 8 * h);
            softmax_pv_v8(s, o, m, l, vr);
        }
        l += __shfl_xor(l, 32);
        if (ql >= vlo && ql < vhi) {
            y_update(OD + ((size_t)gi * T + t) * 512 + p * 128 + 4 * h, o, 1.f / l, false);
            if (h == 0) LSE[((size_t)(gi * NB + b) * 4 + p) * S + sact] = m + __log2f(l);
        }
    }
    __syncthreads();
    { const int pos = tid >> 1, dh = tid & 1, sact = s0 + pos, t = b * S + sact;
      const float l0 = LSE[((size_t)(0 * NB + b) * 4 + p) * S + sact], l1 = LSE[((size_t)(1 * NB + b) * 4 + p) * S + sact], l2 = LSE[((size_t)(2 * NB + b) * 4 + p) * S + sact];
      const float mx = fmaxf(l0, fmaxf(l1, l2)); float w0 = ex2(l0 - mx), w1 = ex2(l1 - mx), w2 = ex2(l2 - mx); const float iw = 1.f / (w0 + w1 + w2); w0 *= iw; w1 *= iw; w2 *= iw;
      bf16* yd = (bf16*)(a.ws + WS_YN) + (size_t)t * 1536 + 1024 + p * 128 + 64 * dh;
      const bf16* o0 = OD + ((size_t)0 * T + t) * 512 + p * 128 + 64 * dh; const bf16* o1 = OD + ((size_t)1 * T + t) * 512 + p * 128 + 64 * dh; const bf16* o2 = OD + ((size_t)2 * T + t) * 512 + p * 128 + 64 * dh;
#pragma unroll
      for (int k = 0; k < 8; ++k) { const v4u x0 = *(const v4u*)(o0 + 8 * k), x1 = *(const v4u*)(o1 + 8 * k), x2 = *(const v4u*)(o2 + 8 * k); v4u y;
          y.x = pkbf(w0 * bflo(x0.x) + w1 * bflo(x1.x) + w2 * bflo(x2.x), w0 * bfhi(x0.x) + w1 * bfhi(x1.x) + w2 * bfhi(x2.x));
          y.y = pkbf(w0 * bflo(x0.y) + w1 * bflo(x1.y) + w2 * bflo(x2.y), w0 * bfhi(x0.y) + w1 * bfhi(x1.y) + w2 * bfhi(x2.y));
          y.z = pkbf(w0 * bflo(x0.z) + w1 * bflo(x1.z) + w2 * bflo(x2.z), w0 * bfhi(x0.z) + w1 * bfhi(x1.z) + w2 * bfhi(x2.z));
          y.w = pkbf(w0 * bflo(x0.w) + w1 * bflo(x1.w) + w2 * bflo(x2.w), w0 * bfhi(x0.w) + w1 * bfhi(x1.w) + w2 * bfhi(x2.w));
          *(v4u*)(yd + 8 * k) = y; } }
    __syncthreads();
}
__device__ __forceinline__ void ph4_attention(const Args& a, LAS unsigned char* lds) {
    const int tid = phase_tid();
    for (int u = blockIdx.x; u < 256; u += gridDim.x) dil_unit(a, lds, u, tid);
#ifndef PROBE_NSA
#define PROBE_NSA 0
#endif
    if (PROBE_NSA) for (int x = blockIdx.x; x < 256; x += gridDim.x) { nsa_unit<PROBE_NSA>(a, lds, 511 - x, tid); nsa_unit<PROBE_NSA>(a, lds, x, tid); }
    for (int x = blockIdx.x; x < 256; x += gridDim.x) { nsa_unit<0>(a, lds, 511 - x, tid); nsa_unit<0>(a, lds, x, tid); }
}

typedef float f32x2 __attribute__((ext_vector_type(2)));
constexpr size_t WS_PU8 = WS_Q;
constexpr size_t WS_PV8 = WS_Q + 32 * MiB;
constexpr size_t WS_PSC = WS_Q + 64 * MiB;
__device__ __forceinline__ void ph_quant_uv(const Args& a) {
    const int tid = phase_tid(), lane = tid & 63, wave = __builtin_amdgcn_readfirstlane(tid >> 6);
    const int gw = blockIdx.x * NWAVES + wave, NGW = gridDim.x * NWAVES;
    float* SC = (float*)(a.ws + WS_PSC);
    for (int rw = gw; rw < NE; rw += NGW) {
        f32x4 x[2][8];
#pragma unroll
        for (int which = 0; which < 2; ++which) { const float* src = a.in[20 + which] + (size_t)rw * D + 16 * lane;
#pragma unroll
            for (int c = 0; c < 2; ++c)
#pragma unroll
                for (int w = 0; w < 4; ++w) x[which][4 * c + w] = *(const f32x4*)(src + 1024 * c + 4 * w); }
#pragma unroll
        for (int which = 0; which < 2; ++which) {
            unsigned char* dst = a.ws + (which ? WS_PV8 : WS_PU8) + (size_t)rw * 1024 + 16 * lane;
            float ss = 0.f;
#pragma unroll
            for (int i = 0; i < 8; ++i) ss += (x[which][i].x * x[which][i].x + x[which][i].y * x[which][i].y) + (x[which][i].z * x[which][i].z + x[which][i].w * x[which][i].w);
            ss = wave_sum(ss);
            const float step = 0.48f * sqrtf(ss * (1.f / D));
            const float inv = step > 0.f ? 1.f / step : 0.f;
            v4u o; unsigned wd[4];
#pragma unroll
            for (int wi = 0; wi < 4; ++wi) { unsigned q = 0u;
                const f32x4 va = x[which][2 * wi], vb = x[which][2 * wi + 1];
                q = __builtin_amdgcn_cvt_scalef32_pk_fp4_f32(q, __builtin_amdgcn_fmed3f(va.x * inv, -6.f, 6.f), __builtin_amdgcn_fmed3f(va.y * inv, -6.f, 6.f), 1.0f, 0);
                q = __builtin_amdgcn_cvt_scalef32_pk_fp4_f32(q, __builtin_amdgcn_fmed3f(va.z * inv, -6.f, 6.f), __builtin_amdgcn_fmed3f(va.w * inv, -6.f, 6.f), 1.0f, 1);
                q = __builtin_amdgcn_cvt_scalef32_pk_fp4_f32(q, __builtin_amdgcn_fmed3f(vb.x * inv, -6.f, 6.f), __builtin_amdgcn_fmed3f(vb.y * inv, -6.f, 6.f), 1.0f, 2);
                q = __builtin_amdgcn_cvt_scalef32_pk_fp4_f32(q, __builtin_amdgcn_fmed3f(vb.z * inv, -6.f, 6.f), __builtin_amdgcn_fmed3f(vb.w * inv, -6.f, 6.f), 1.0f, 3);
                wd[wi] = q; }
            o.x = wd[0]; o.y = wd[1]; o.z = wd[2]; o.w = wd[3]; *(v4u*)dst = o;
            if (lane == 0) SC[which * NE + rw] = step;
        }
    }
}
constexpr size_t WS_KEYF = 601 * MiB;
constexpr size_t WS_END3 = 602 * MiB;
__device__ __forceinline__ void ph0_keyfrags(const Args& a) {
    const int tid = phase_tid();
    const float* keys = a.in[19]; v4u* KF = (v4u*)(a.ws + WS_KEYF);
    for (int i = blockIdx.x * NTHREADS + tid; i < 16 * 32 * 64; i += gridDim.x * NTHREADS) {
        const int lane = i & 63, st = (i >> 6) & 7, kt = (i >> 9) & 3, hp = i >> 11;
        const float* src = keys + ((size_t)hp * 128 + 32 * kt + (lane & 31)) * 128 + 16 * st + 8 * (lane >> 5);
        float v[8]; unsigned hi[8], lo[8];
#pragma unroll
        for (int j = 0; j < 8; ++j) { v[j] = src[j]; hi[j] = f2bf(v[j]); lo[j] = f2bf(v[j] - __builtin_bit_cast(float, hi[j] << 16)); }
        v4u oh, ol; oh.x = hi[0] | (hi[1] << 16); oh.y = hi[2] | (hi[3] << 16); oh.z = hi[4] | (hi[5] << 16); oh.w = hi[6] | (hi[7] << 16);
        ol.x = lo[0] | (lo[1] << 16); ol.y = lo[2] | (lo[3] << 16); ol.z = lo[4] | (lo[5] << 16); ol.w = lo[6] | (lo[7] << 16);
        KF[(size_t)((hp * 2 + 0) * 32 + kt * 8 + st) * 64 + lane] = oh; KF[(size_t)((hp * 2 + 1) * 32 + kt * 8 + st) * 64 + lane] = ol;
    }
}
template <int N, bool MERGE_ONLY> __device__ __forceinline__ void bitonic_desc(float (&v)[N]) {
#pragma unroll
    for (int k = MERGE_ONLY ? N : 2; k <= N; k <<= 1)
#pragma unroll
        for (int j = k >> 1; j > 0; j >>= 1)
#pragma unroll
            for (int i = 0; i < N; ++i) { const int l = i ^ j;
                if (l > i) { const bool desc = ((i & k) == 0) || (k == N); const float x = v[i], y = v[l], hi = fmaxf(x, y), lo = fminf(x, y); v[i] = desc ? hi : lo; v[l] = desc ? lo : hi; } }
}
#define CROW(i) (((i) & 3) + 8 * ((i) >> 2))
__device__ __forceinline__ float max3f(float a, float b, float c) { return fmaxf(fmaxf(a, b), c); }
__device__ __forceinline__ void ph_route(const Args& a, LAS unsigned char* lds) {
    const int tid = phase_tid(), lane = tid & 63, wave = __builtin_amdgcn_readfirstlane(tid >> 6), tl = lane & 31, hc = lane >> 5;
    const int gw = blockIdx.x * NWAVES + wave, NGW = gridDim.x * NWAVES;
    const float* QP = (const float*)(a.ws + WS_QP); const float* qgain = a.in[18]; const v4u* KF = (const v4u*)(a.ws + WS_KEYF);
    int* EI = (int*)(a.ws + WS_EI); float* EG = (float*)(a.ws + WS_EG);
    LAS float* spl = (LAS float*)(lds + wave * 8704) + lane * 33;
    for (int job = gw; job < (T / 32) * 8; job += NGW) {
        const int h = job & 7, t = (job >> 3) * 32 + tl;
#pragma unroll 1
        for (int p = 0; p < 2; ++p) {
            bf16x8 bh[8], bl[8];
            { const float* qr = QP + (size_t)t * D + h * 256 + p * 128 + 8 * hc; const float* gr = qgain + (h * 2 + p) * 128 + 8 * hc;
              float ss = 0.f;
#pragma unroll
              for (int st = 0; st < 8; ++st) { const f32x4 x0 = *(const f32x4*)(qr + 16 * st), x1 = *(const f32x4*)(qr + 16 * st + 4);
                  ss += (x0.x * x0.x + x0.y * x0.y) + (x0.z * x0.z + x0.w * x0.w) + (x1.x * x1.x + x1.y * x1.y) + (x1.z * x1.z + x1.w * x1.w); }
              ss += __shfl_xor(ss, 32);
              const float rstd = rsqrtf(ss * (1.f / 128.f) + EPS);
              asm volatile("" ::: "memory");
#pragma unroll
              for (int st = 0; st < 8; ++st) { const f32x4 x0 = *(const f32x4*)(qr + 16 * st), x1 = *(const f32x4*)(qr + 16 * st + 4); const f32x4 g0 = *(const f32x4*)(gr + 16 * st), g1 = *(const f32x4*)(gr + 16 * st + 4);
                  const float v0 = x0.x * rstd * g0.x, v1 = x0.y * rstd * g0.y, v2 = x0.z * rstd * g0.z, v3 = x0.w * rstd * g0.w, v4 = x1.x * rstd * g1.x, v5 = x1.y * rstd * g1.y, v6 = x1.z * rstd * g1.z, v7 = x1.w * rstd * g1.w;
                  v4u xh, xl; xh.x = pkbf(v0, v1); xh.y = pkbf(v2, v3); xh.z = pkbf(v4, v5); xh.w = pkbf(v6, v7);
                  xl.x = pkbf(v0 - bflo(xh.x), v1 - bfhi(xh.x)); xl.y = pkbf(v2 - bflo(xh.y), v3 - bfhi(xh.y)); xl.z = pkbf(v4 - bflo(xh.z), v5 - bfhi(xh.z)); xl.w = pkbf(v6 - bflo(xh.w), v7 - bfhi(xh.w));
                  bh[st] = __builtin_bit_cast(bf16x8, xh); bl[st] = __builtin_bit_cast(bf16x8, xl); } }
            float sc[64];
            const v4u* kfh = KF + (size_t)(((h * 2 + p) * 2 + 0) * 32) * 64 + lane; const v4u* kfl = KF + (size_t)(((h * 2 + p) * 2 + 1) * 32) * 64 + lane;
#pragma unroll
            for (int kt = 0; kt < 4; ++kt) {
                f32x16 acc;
#pragma unroll
                for (int i = 0; i < 16; ++i) acc[i] = 0.f;
#pragma unroll
                for (int s2 = 0; s2 < 2; ++s2) {
                    asm volatile("" ::: "memory");
                    bf16x8 ah[4], al[4];
#pragma unroll
                    for (int s4 = 0; s4 < 4; ++s4) { ah[s4] = __builtin_bit_cast(bf16x8, kfh[(kt * 8 + s2 * 4 + s4) * 64]); al[s4] = __builtin_bit_cast(bf16x8, kfl[(kt * 8 + s2 * 4 + s4) * 64]); }
#pragma unroll
                    for (int s4 = 0; s4 < 4; ++s4) { const int st = s2 * 4 + s4;
                        acc = __builtin_amdgcn_mfma_f32_32x32x16_bf16(al[s4], bh[st], acc, 0, 0, 0); acc = __builtin_amdgcn_mfma_f32_32x32x16_bf16(ah[s4], bl[st], acc, 0, 0, 0); acc = __builtin_amdgcn_mfma_f32_32x32x16_bf16(ah[s4], bh[st], acc, 0, 0, 0); }
                }
#pragma unroll
                for (int i = 0; i < 16; ++i) { const float av = acc[i];
                    const unsigned bits = (__builtin_bit_cast(unsigned, av) & ~127u) | (unsigned)(127 - (32 * kt + CROW(i) + 4 * hc)); sc[16 * kt + i] = __builtin_bit_cast(float, bits); }
            }
            asm volatile("" ::: "memory");
            bitonic_desc<64, false>(sc);
            float t16[16];
#pragma unroll
            for (int i = 0; i < 16; ++i) t16[i] = __shfl_xor(sc[i], 32);
            float u16[16];
#pragma unroll
            for (int i = 0; i < 16; ++i) u16[i] = fmaxf(sc[i], t16[15 - i]);
            bitonic_desc<16, true>(u16);
#pragma unroll
            for (int i = 0; i < 16; ++i) spl[p * 16 + i] = u16[i];
        }
        asm volatile("s_waitcnt lgkmcnt(0)" ::: "memory");
        float sp[2][16];
#pragma unroll
        for (int i = 0; i < 16; ++i) { sp[0][i] = spl[i]; sp[1][i] = spl[16 + i]; }
        float cv[64];
        {
            int c = 0;
#pragma unroll
            for (int i = 0; i < 16; ++i)
#pragma unroll
                for (int j = 0; j < 16; ++j) if ((i + 1) * (j + 1) <= 16) {
                    const float v = sp[0][i] + sp[1][j];
                    cv[c] = __builtin_bit_cast(float, (__builtin_bit_cast(unsigned, v) & ~255u) | (unsigned)(255 - (i * 16 + j))); ++c; }
#pragma unroll
            for (int i = 50; i < 64; ++i) cv[i] = -INFINITY;
        }
        bitonic_desc<64, false>(cv);
        float tv[16];
#pragma unroll
        for (int i = 0; i < 16; ++i) tv[i] = cv[i];
        asm volatile("s_waitcnt lgkmcnt(0)" ::: "memory");
        int te[16]; float den = 0.f; const float top = tv[0];
#pragma unroll
        for (int i = 0; i < 16; ++i) { const int flat = 255 - (int)(__builtin_bit_cast(unsigned, tv[i]) & 255u);
            const unsigned b1 = __builtin_bit_cast(unsigned, spl[flat >> 4]), b2 = __builtin_bit_cast(unsigned, spl[16 + (flat & 15)]);
            te[i] = (127 - (int)(b1 & 127u)) * 128 + (127 - (int)(b2 & 127u));
            tv[i] = __expf(tv[i] - top); den += tv[i]; }
        den = 1.f / den;
        if (hc == 0) {
            int* ei = EI + (size_t)t * 128 + h * 16; float* eg = EG + (size_t)t * 128 + h * 16;
#pragma unroll
            for (int i = 0; i < 16; i += 4) { *(v4u*)(ei + i) = (v4u){(unsigned)te[i], (unsigned)te[i + 1], (unsigned)te[i + 2], (unsigned)te[i + 3]}; *(f32x4*)(eg + i) = (f32x4){tv[i] * den, tv[i + 1] * den, tv[i + 2] * den, tv[i + 3] * den}; }
        }
        asm volatile("s_waitcnt lgkmcnt(0)" ::: "memory");
    }
}
__device__ __forceinline__ void ph_experts(const Args& a, const float osc) {
    const int tid = phase_tid(), lane = tid & 63, wave = __builtin_amdgcn_readfirstlane(tid >> 6);
    const int gw = blockIdx.x * NWAVES + wave, NGW = gridDim.x * NWAVES;
    const bf16* H2 = (const bf16*)(a.ws + WS_H); const unsigned char* PU = a.ws + WS_PU8; const unsigned char* PV = a.ws + WS_PV8; const unsigned l16 = 16u * lane; const float* SC = (const float*)(a.ws + WS_PSC);
    const int* EI = (const int*)(a.ws + WS_EI); const float* EG = (const float*)(a.ws + WS_EG);
    const float* mod = (const float*)(a.ws + WS_MOD);
    float* out = a.out;
    v4u wa[8], wb[8];
#define EX_LOAD(buf, tab, esel, base) do { _Pragma("unroll") for (int k = 0; k < 8; ++k) { const unsigned e = (unsigned)__builtin_amdgcn_readlane(esel, ((base) + k) & 63); buf[k] = *(const v4u*)((tab) + ((size_t)e << 10) + l16); } __builtin_amdgcn_sched_barrier(0); } while (0)
#define EX_U(buf, bt) do { float pr[8]; \
        _Pragma("unroll") for (int k = 0; k < 8; ++k) { f32x2 s = {0.f, 0.f}; const unsigned q[4] = {buf[k].x, buf[k].y, buf[k].z, buf[k].w}; \
            _Pragma("unroll") for (int wi = 0; wi < 4; ++wi) { \
                s += x[4 * wi + 0] * __builtin_amdgcn_cvt_scalef32_pk_f32_fp4(q[wi], 1.0f, 0); s += x[4 * wi + 1] * __builtin_amdgcn_cvt_scalef32_pk_f32_fp4(q[wi], 1.0f, 1); \
                s += x[4 * wi + 2] * __builtin_amdgcn_cvt_scalef32_pk_f32_fp4(q[wi], 1.0f, 2); s += x[4 * wi + 3] * __builtin_amdgcn_cvt_scalef32_pk_f32_fp4(q[wi], 1.0f, 3); } \
            pr[k] = s.x + s.y; } \
          \
        float q4[4], q2[2]; \
        _Pragma("unroll") for (int j = 0; j < 4; ++j) { const float keep = lb0 ? pr[2 * j + 1] : pr[2 * j], send = lb0 ? pr[2 * j] : pr[2 * j + 1]; q4[j] = keep + __shfl_xor(send, 1); } \
        _Pragma("unroll") for (int j = 0; j < 2; ++j) { const float keep = lb1 ? q4[2 * j + 1] : q4[2 * j], send = lb1 ? q4[2 * j] : q4[2 * j + 1]; q2[j] = keep + __shfl_xor(send, 2); } \
        float rr; { const float keep = lb2 ? q2[1] : q2[0], send = lb2 ? q2[0] : q2[1]; rr = keep + __shfl_xor(send, 4); } \
        rr += __shfl_xor(rr, 8); rr += __shfl_xor(rr, 16); rr += __shfl_xor(rr, 32); \
        if ((lane >> 3) == ((bt) & 7)) { if ((bt) < 8) raw0 = rr; else raw1 = rr; } } while (0)
#define EX_V(buf, bt) do { _Pragma("unroll") for (int k = 0; k < 8; ++k) { const float cf = __builtin_bit_cast(float, __builtin_amdgcn_readlane(__builtin_bit_cast(int, (bt) < 8 ? cf0 : cf1), ((bt) * 8 + k) & 63)); const f32x2 cf2 = {cf, cf}; const unsigned q[4] = {buf[k].x, buf[k].y, buf[k].z, buf[k].w}; \
            _Pragma("unroll") for (int wi = 0; wi < 4; ++wi) { \
                acc[4 * wi + 0] += cf2 * __builtin_amdgcn_cvt_scalef32_pk_f32_fp4(q[wi], 1.0f, 0); acc[4 * wi + 1] += cf2 * __builtin_amdgcn_cvt_scalef32_pk_f32_fp4(q[wi], 1.0f, 1); \
                acc[4 * wi + 2] += cf2 * __builtin_amdgcn_cvt_scalef32_pk_f32_fp4(q[wi], 1.0f, 2); acc[4 * wi + 3] += cf2 * __builtin_amdgcn_cvt_scalef32_pk_f32_fp4(q[wi], 1.0f, 3); } } } while (0)
    const bool lb0 = lane & 1, lb1 = lane & 2, lb2 = lane & 4;
    int e0 = 0, e1 = 0;
    if (gw < T) { e0 = EI[(size_t)gw * 128 + lane]; e1 = EI[(size_t)gw * 128 + 64 + lane]; EX_LOAD(wa, PU, e0, 0); }
    for (int t = gw; t < T; t += NGW) {
        const int b = t / S, tn = t + NGW;
        f32x2 x[16];
#pragma unroll
        for (int c = 0; c < 2; ++c)
#pragma unroll
            for (int hw = 0; hw < 2; ++hw) { const v4u w = *(const v4u*)(H2 + (size_t)t * D + 1024 * c + 16 * lane + 8 * hw); const int o = 8 * c + 4 * hw;
                x[o + 0] = (f32x2){bflo(w.x), bfhi(w.x)}; x[o + 1] = (f32x2){bflo(w.y), bfhi(w.y)}; x[o + 2] = (f32x2){bflo(w.z), bfhi(w.z)}; x[o + 3] = (f32x2){bflo(w.w), bfhi(w.w)}; }
        int ne0 = 0, ne1 = 0;
        if (tn < T) { ne0 = EI[(size_t)tn * 128 + lane]; ne1 = EI[(size_t)tn * 128 + 64 + lane]; }
        const float gs0 = EG[(size_t)t * 128 + lane] * SC[NE + e0], gs1 = EG[(size_t)t * 128 + 64 + lane] * SC[NE + e1];
        const float su0 = SC[e0], su1 = SC[e1];
        float raw0 = 0.f, raw1 = 0.f;
#pragma unroll 1
        for (int i = 0; i < 7; ++i) {
            EX_LOAD(wb, PU, (i < 4 ? e0 : e1), (2 * i + 1) * 8);
            EX_U(wa, 2 * i);
            EX_LOAD(wa, PU, (i < 3 ? e0 : e1), (2 * i + 2) * 8);
            EX_U(wb, 2 * i + 1);
        }
        { EX_LOAD(wb, PU, e1, 15 * 8); EX_U(wa, 14); EX_LOAD(wa, PV, e0, 0); EX_U(wb, 15); }
        const float cf0 = gelu_tanh(raw0 * su0) * gs0, cf1 = gelu_tanh(raw1 * su1) * gs1;
        f32x2 acc[16];
#pragma unroll
        for (int i = 0; i < 16; ++i) acc[i] = (f32x2){0.f, 0.f};
#pragma unroll 1
        for (int i = 0; i < 7; ++i) {
            EX_LOAD(wb, PV, (i < 4 ? e0 : e1), (2 * i + 1) * 8);
            EX_V(wa, 2 * i);
            EX_LOAD(wa, PV, (i < 3 ? e0 : e1), (2 * i + 2) * 8);
            EX_V(wb, 2 * i + 1);
        }
        { EX_LOAD(wb, PV, e1, 15 * 8); EX_V(wa, 14); if (tn < T) EX_LOAD(wa, PU, ne0, 0); EX_V(wb, 15); }
        const float* g2 = mod + b * 12288 + 10240;
#pragma unroll
        for (int c = 0; c < 2; ++c)
#pragma unroll
            for (int w4 = 0; w4 < 4; ++w4) { float* op = out + (size_t)t * D + 1024 * c + 16 * lane + 4 * w4; const f32x4 ga = *(const f32x4*)(g2 + 1024 * c + 16 * lane + 4 * w4); f32x4 r0 = *(const f32x4*)op; const int o = 8 * c + 2 * w4;
                r0.x += ga.x * acc[o].x * osc; r0.y += ga.y * acc[o].y * osc; r0.z += ga.z * acc[o + 1].x * osc; r0.w += ga.w * acc[o + 1].y * osc;
                *(f32x4*)op = r0; }
        e0 = ne0; e1 = ne1;
    }
#undef EX_LOAD
#undef EX_U
#undef EX_V
}

constexpr int N_PHASES = 11;
__global__ void __launch_bounds__(NTHREADS, 2) fwd_kernel(Args a) {
    extern __shared__ __attribute__((aligned(16))) unsigned char lds_raw[];
    LAS unsigned char* lds = (LAS unsigned char*)lds_raw;
    const int tid = threadIdx.x;
    volatile LAS unsigned* misc = (volatile LAS unsigned*)(lds + LDS_MISC);
    if (tid < 16) misc[tid] = 0u;
    __syncthreads();
    XcdBarrier bar; bar.bar = (unsigned*)(a.ws + WS_CTL) + 1024; bar.x = 0; bar.st = nullptr;
    const int lo = a.ph_lo, hi = a.ph_hi;
    if (hi - lo > 1) bar = xcd_barrier_post((unsigned*)(a.ws + WS_CTL) + 1024, misc + 8);
#define IN(k) (lo <= (k) && (k) < hi)
#define SEAM(k) do { if (IN(k) && IN((k) + 1)) xcd_barrier(bar); } while (0)
    const int G = gridDim.x, bx = blockIdx.x;

    for (int rep = 0; rep < 1 + ((PROBE_DUP >> 0) & 1); ++rep)
    if (IN(0)) { ph0_mod(a, lds); __syncthreads(); ph0_weights(a, lds); ph0_keyfrags(a); ph0_extra(a); __syncthreads(); }
    SEAM(0);
    for (int rep = 0; rep < 1 + ((PROBE_DUP >> 1) & 1); ++rep)
    if (IN(1)) ph_norm<true>(a, a.in[0], a.in[4], 0, 2048, (bf16*)(a.ws + WS_H), a.ws + WS_H8);
    SEAM(1);
    for (int rep = 0; rep < 1 + ((PROBE_DUP >> 2) & 1); ++rep)
    if (IN(2)) {
        { pg8::Gemm g4{(const bf16*)(a.ws + WS_H4), (const bf16*)(a.ws + WS_WM4), T, NMG, D / 4}; pg8::StaticOrder S4; S4.init(T, NMG, G, bx);
          EpiMG E4{(bf16*)(a.ws + WS_MG), (const float*)(a.ws + WS_HS), (const float*)(a.ws + WS_WMS)};
          pg8::gemm_phase<EpiMG, pg8::StaticOrder, pg8::NoMid, 2>(lds, g4, S4, E4); }
        { pg8::Gemm g{(const bf16*)(a.ws + WS_H8), (const bf16*)(a.ws + WS_WIN), T, NPROJ - NMG, D / 2}; pg8::StaticOrder So; So.init(T, NPROJ - NMG, G, bx);
          EpiProjNorm E{(bf16*)(a.ws + WS_Q), (bf16*)(a.ws + WS_KV), (bf16*)(a.ws + WS_DL), (bf16*)(a.ws + WS_MG), (bf16*)a.out, a.in[6], a.in[7], a.in[11], a.in[12], (LAS float*)(lds + 131072), 1.f / (F8_HS * F8_WS)};
          pg8::gemm_phase<EpiProjNorm, pg8::StaticOrder, pg8::NoMid, 1>(lds, g, So, E); } }
    SEAM(2);
    if (IN(3)) { for (int rep = 0; rep < 1 + ((PROBE_DUP >> 3) & 1); ++rep) { ph3_vfrag(a); ph3_gates(a); ph3_compress(a, lds); } }
    SEAM(3);
    for (int rep = 0; rep < 1 + ((PROBE_DUP >> 4) & 1); ++rep)
    if (IN(4)) ph4_attention(a, lds);
    SEAM(4);
    for (int rep = 0; rep < 1 + ((PROBE_DUP >> 5) & 1); ++rep)
    if (IN(5)) {
        { pg8::Gemm g{(const bf16*)(a.ws + WS_YN), (const bf16*)(a.ws + WS_WBN), T, D, 1536}; pg8::StaticOrder So; So.init(T, D, G, bx);
          EpiMerge E{(const bf16*)(a.ws + WS_MG), a.ws + WS_H, F8_MS}; MidMerge Mh{(const bf16*)(a.ws + WS_MG)};
          pg8::gemm_phase<EpiMerge, pg8::StaticOrder, MidMerge>(lds, g, So, E, Mh); }
    }
    SEAM(5);
    for (int rep = 0; rep < 1 + ((PROBE_DUP >> 6) & 1); ++rep)
    if (IN(6)) { pg8::Gemm g{(const bf16*)(a.ws + WS_H), (const bf16*)(a.ws + WS_WOUT), T, D, D / 2}; pg8::StaticOrder So; So.init(T, D, G, bx);
        EpiOut E{a.in[0], (const float*)(a.ws + WS_MOD), a.out, 1.f / (F8_MS * F8_WS)}; pg8::gemm_phase<EpiOut, pg8::StaticOrder, pg8::NoMid, 1>(lds, g, So, E); }
    SEAM(6);
    for (int rep = 0; rep < 1 + ((PROBE_DUP >> 7) & 1); ++rep)
    if (IN(7)) { ph_norm(a, a.out, a.in[16], 6144, 8192, (bf16*)(a.ws + WS_H)); ph_quant_uv(a); }
    SEAM(7);
    for (int rep = 0; rep < 1 + ((PROBE_DUP >> 8) & 1); ++rep)
    if (IN(8)) { pg8::Gemm g{(const bf16*)(a.ws + WS_H), (const bf16*)(a.ws + WS_WPQ), T, D, D}; pg8::StaticOrder So; So.init(T, D, G, bx);
        EpiF32 E{(float*)(a.ws + WS_QP), D}; pg8::gemm_phase<EpiF32, pg8::StaticOrder>(lds, g, So, E); }
    SEAM(8);
    for (int rep = 0; rep < 1 + ((PROBE_DUP >> 9) & 1); ++rep)
    if (IN(9)) { ph_route(a, lds); __syncthreads(); }
    SEAM(9);
    if (IN(10)) { if ((PROBE_DUP >> 10) & 1) { ph_experts(a, *(const float*)(a.ws + WS_CTL + 64)); asm volatile("s_waitcnt vmcnt(0)" ::: "memory"); __syncthreads(); } ph_experts(a, 1.f); }
#undef IN
#undef SEAM
}

extern "C" void kernel_launch(void* const* d_in, const int* in_sizes, int n_in, void* d_out, int out_size, void* d_ws, size_t ws_size, hipStream_t stream) {
    static int grid = 0;
    if (grid == 0) {
        if (n_in != 23 || out_size != T * D || ws_size < WS_END4) { fprintf(stderr, "kernel_launch: unexpected problem shape (n_in %d, out %d, ws %zu); nothing launched\n", n_in, out_size, ws_size); grid = -1; return; }
        int dev = 0, cus = 0, per_cu = 0;
        if (hipGetDevice(&dev) != hipSuccess || hipDeviceGetAttribute(&cus, hipDeviceAttributeMultiprocessorCount, dev) != hipSuccess) { grid = -1; return; }
        if (hipFuncSetAttribute((const void*)fwd_kernel, hipFuncAttributeMaxDynamicSharedMemorySize, LDS_BYTES) != hipSuccess) { fprintf(stderr, "kernel_launch: hipFuncSetAttribute failed\n"); grid = -1; return; }
        if (hipOccupancyMaxActiveBlocksPerMultiprocessor(&per_cu, (const void*)fwd_kernel, NTHREADS, LDS_BYTES) != hipSuccess || per_cu < 1) { fprintf(stderr, "kernel_launch: occupancy query says %d\n", per_cu); }
        (void)hipGetLastError();
        grid = cus;
    }
    if (grid < 0) return;
    hipMemsetAsync((char*)d_ws + WS_CTL, 0, CTL_ZERO_BYTES, stream);
    Args a{};
    for (int i = 0; i < 23; ++i) a.in[i] = (const float*)d_in[i];
    a.out = (float*)d_out; a.ws = (unsigned char*)d_ws;
#if MK_ONE_LAUNCH
#if PROBE_PREFIX >= 0
    a.ph_lo = 0; a.ph_hi = PROBE_PREFIX + 1;
    hipLaunchKernelGGL(fwd_kernel, dim3(grid), dim3(NTHREADS), LDS_BYTES, stream, a);
    hipMemsetAsync((char*)d_ws + WS_CTL, 0, CTL_ZERO_BYTES, stream);
#endif
    a.ph_lo = 0; a.ph_hi = N_PHASES;
    hipLaunchKernelGGL(fwd_kernel, dim3(grid), dim3(NTHREADS), LDS_BYTES, stream, a);
#else
    for (int p = 0; p < N_PHASES; ++p) { a.ph_lo = p; a.ph_hi = p + 1; hipLaunchKernelGGL(fwd_kernel, dim3(grid), dim3(NTHREADS), LDS_BYTES, stream, a); }
#endif
}
```

```cpp
#include <hip/hip_runtime.h>
#include <cstdio>
#include <cstdint>

#ifndef PROBE_DUP
#define PROBE_DUP 0
#endif
#ifndef PROBE_PREFIX
#define PROBE_PREFIX -1
#endif
#ifndef MK_ONE_LAUNCH
#define MK_ONE_LAUNCH 1
#endif

__device__ __forceinline__ int phase_tid() { int t = threadIdx.x; asm volatile("" : "+v"(t)); return t; }
namespace pg8 {
#define PG8_LAS __attribute__((address_space(3)))
typedef unsigned short bf16_t;
typedef short bf16x8 __attribute__((ext_vector_type(8)));
typedef float f32x4 __attribute__((ext_vector_type(4)));
typedef unsigned u32x4 __attribute__((ext_vector_type(4)));
typedef unsigned u32x2 __attribute__((ext_vector_type(2)));
constexpr int BM = 256, BK = 64, HALF = 128, HTB = HALF * BK * 2, STAGE_BYTES = 8 * HTB, NXCD = 8, WGM = 8;

__host__ __device__ __forceinline__ int lds_byte(int r, int c) { const int st = (r >> 4) * 2 + (c >> 5), rr = r & 15, cc = c & 31, ob = rr * 64 + cc * 2; return st * 1024 + (ob ^ (((ob >> 9) & 1) << 5)); }
__host__ __device__ __forceinline__ void stage_rc(int b, int& R, int& C) { const int st = b / 1024, sb = b % 1024, swz = sb ^ (((sb >> 9) & 1) << 5); R = (st >> 1) * 16 + swz / 64; C = (st & 1) * 32 + (swz % 64) / 2; }
__host__ __device__ __forceinline__ int perm32(int rho) { const int n = rho >> 4, i = rho & 15; return 8 * (i >> 2) + 4 * n + (i & 3); }

struct Unit { int pm, pn; };
struct Gemm { const bf16_t* A; const bf16_t* Bt; int M, N, K; };

struct StaticOrder {
    int nM, nN, nwg, G, c;
    __host__ __device__ void init(int M, int N, int G_, int c_) { nM = M / BM; nN = N / BM; nwg = nM * nN; G = G_; c = c_; }
    __host__ __device__ bool next(int i, Unit& u) const {
        const long L = (long)i * G + c; if (L >= nwg) return false;
        int wgid = (int)L; { const int q = nwg / NXCD, r = nwg % NXCD, xcd = wgid % NXCD, off = wgid / NXCD; wgid = (xcd < r ? xcd * (q + 1) : r * (q + 1) + (xcd - r) * q) + off; }
        const int nig = WGM * nN, gid = wgid / nig, fm = gid * WGM, gsz = (nM - fm) < WGM ? (nM - fm) : WGM;
        u.pm = fm + ((wgid % nig) % gsz); u.pn = (wgid % nig) / gsz; return true;
    }
    __device__ __forceinline__ void a_ready(const Unit&) const {}
    __device__ __forceinline__ void done(const Unit&) const {}
};

__device__ __forceinline__ unsigned cvt_pk_bf16(float lo, float hi) { unsigned r; asm volatile("v_cvt_pk_bf16_f32 %0, %1, %2" : "=v"(r) : "v"(lo), "v"(hi)); return r; }

typedef int i32x4 __attribute__((ext_vector_type(4)));
typedef int i32x8 __attribute__((ext_vector_type(8)));
__device__ __forceinline__ void mma_blk_f4(f32x4 (&acc)[4][2], const bf16x8 (&At)[4][2], const bf16x8 (&Bt)[2][2]) {
#pragma unroll
    for (int m = 0; m < 4; ++m)
#pragma unroll
        for (int n = 0; n < 2; ++n)
#pragma unroll
            for (int k = 0; k < 2; ++k) { const i32x4 bb = __builtin_bit_cast(i32x4, Bt[n][k]), aa = __builtin_bit_cast(i32x4, At[m][k]);
                asm volatile("v_mfma_f32_16x16x128_f8f6f4 %0, %1, %2, %0 cbsz:4 blgp:4" : "+v"(acc[m][n]) : "v"(bb), "v"(aa)); }
}
template <bool F8> __device__ __forceinline__ void mma_blk(f32x4 (&acc)[4][2], const bf16x8 (&At)[4][2], const bf16x8 (&Bt)[2][2]) {
    if constexpr (F8) {
#pragma unroll
        for (int m = 0; m < 4; ++m)
#pragma unroll
            for (int n = 0; n < 2; ++n) {
                const i32x8 bb = __builtin_shufflevector(__builtin_bit_cast(i32x4, Bt[n][0]), __builtin_bit_cast(i32x4, Bt[n][1]), 0, 1, 2, 3, 4, 5, 6, 7);
                const i32x8 aa = __builtin_shufflevector(__builtin_bit_cast(i32x4, At[m][0]), __builtin_bit_cast(i32x4, At[m][1]), 0, 1, 2, 3, 4, 5, 6, 7);
                asm volatile("v_mfma_f32_16x16x128_f8f6f4 %0, %1, %2, %0" : "+v"(acc[m][n]) : "v"(bb), "v"(aa)); }
    } else {
#pragma unroll
        for (int m = 0; m < 4; ++m)
#pragma unroll
            for (int n = 0; n < 2; ++n)
#pragma unroll
                for (int k = 0; k < 2; ++k) acc[m][n] = __builtin_amdgcn_mfma_f32_16x16x32_bf16(Bt[n][k], At[m][k], acc[m][n], 0, 0, 0);
    }
}
struct NoMid { static constexpr int AT = -1; __device__ __forceinline__ void operator()(f32x4 (&)[2][2][4][2], const Unit&, int, int, int, int) const {} };
template <class Epi, class Sched, class Mid = NoMid, int F8 = 0>
__device__ __forceinline__ void gemm_phase(PG8_LAS unsigned char* lds, const Gemm g, const Sched& S, const Epi& E, const Mid& Mh = Mid()) {
    const int tid = phase_tid(), wid = __builtin_amdgcn_readfirstlane(tid >> 6), lane = tid & 63, wr = wid >> 2, wc = wid & 3, fr = lane & 15, fq = lane >> 4;
    const int K = g.K, nt = K / BK;
    unsigned voffA[2], voffB[2];
#pragma unroll
    for (int i = 0; i < 2; ++i) { int R, C; stage_rc(tid * 16 + i * 8192, R, C); const int Rb = Epi::PERM ? ((R & ~31) + perm32(R & 31)) : R;
        voffA[i] = (unsigned)(R * K + C) * 2u; voffB[i] = (unsigned)(Rb * K + C) * 2u; }
    const size_t kstep = (size_t)(BK * 2);
    const size_t hstep = (size_t)HALF * K * 2;
    const size_t tstep = 2 * hstep;
    const unsigned ldsw = (unsigned)wid * 1024u;
    const int aoff = lds_byte(wr * 64 + fr, fq * 8), boff = lds_byte(wc * 32 + fr, fq * 8);
#define PG8_SA(b, h) (((b) * 2 + (h)) * HTB)
#define PG8_SB(b, h) ((4 + (b) * 2 + (h)) * HTB)
#define PG8_STAGE(bufoff, gbase, voff) do { _Pragma("unroll") for (int _i = 0; _i < 2; ++_i) \
        __builtin_amdgcn_global_load_lds((const unsigned*)((const char*)(gbase) + (voff)[_i]), (PG8_LAS unsigned*)(lds + (bufoff) + ldsw + _i * 8192), 16, 0, 0); } while (0)
#define PG8_LDA(dst, b, h) do { _Pragma("unroll") for (int m = 0; m < 4; ++m) _Pragma("unroll") for (int k = 0; k < 2; ++k) dst[m][k] = *(const PG8_LAS bf16x8*)(lds + PG8_SA(b, h) + aoff + m * 2048 + k * 1024); } while (0)
#define PG8_LDB(dst, b, h) do { _Pragma("unroll") for (int n = 0; n < 2; ++n) _Pragma("unroll") for (int k = 0; k < 2; ++k) dst[n][k] = *(const PG8_LAS bf16x8*)(lds + PG8_SB(b, h) + boff + n * 2048 + k * 1024); } while (0)
#define PG8_MMA(ai, bj, At, Bt) do { __builtin_amdgcn_s_setprio(1); if constexpr (F8 == 2) { mma_blk_f4(acc[ai][bj], At, Bt); } else if constexpr (F8 == 1) { mma_blk<true>(acc[ai][bj], At, Bt); } else { _Pragma("unroll") for (int m = 0; m < 4; ++m) _Pragma("unroll") for (int n = 0; n < 2; ++n) _Pragma("unroll") for (int k = 0; k < 2; ++k) \
        acc[ai][bj][m][n] = __builtin_amdgcn_mfma_f32_16x16x32_bf16(Bt[n][k], At[m][k], acc[ai][bj][m][n], 0, 0, 0); } __builtin_amdgcn_s_setprio(0); } while (0)
#define PG8_WAIT_V(n) asm volatile("s_waitcnt vmcnt(" #n ")" ::: "memory")
#define PG8_WAIT_L(n) asm volatile("s_waitcnt lgkmcnt(" #n ")" ::: "memory")
#define PG8_BAR __builtin_amdgcn_s_barrier()
#define PG8_SCHED __builtin_amdgcn_sched_barrier(0)
    Unit cur, nxt; int ui = 0;
    if (!S.next(0, cur)) return;
    f32x4 acc[2][2][4][2];
#pragma unroll
    for (int a = 0; a < 2; ++a)
#pragma unroll
        for (int b = 0; b < 2; ++b)
#pragma unroll
            for (int m = 0; m < 4; ++m)
#pragma unroll
                for (int n = 0; n < 2; ++n) acc[a][b][m][n] = (f32x4){0.f, 0.f, 0.f, 0.f};
    bf16x8 At[4][2], B0[2][2], B1[2][2];
    const char* cA = (const char*)g.A + (size_t)cur.pm * tstep; const char* cB = (const char*)g.Bt + (size_t)cur.pn * tstep;
    S.a_ready(cur);
    PG8_STAGE(PG8_SB(0, 0), cB, voffB); PG8_STAGE(PG8_SA(0, 0), cA, voffA); PG8_STAGE(PG8_SB(0, 1), cB + hstep, voffB); PG8_STAGE(PG8_SA(0, 1), cA + hstep, voffA);
    if (wr == 1) PG8_BAR;
    PG8_WAIT_V(4); PG8_BAR;
    PG8_STAGE(PG8_SB(1, 0), cB + kstep, voffB); PG8_STAGE(PG8_SA(1, 0), cA + kstep, voffA); PG8_STAGE(PG8_SB(1, 1), cB + hstep + kstep, voffB);
    PG8_WAIT_V(6); PG8_BAR;
    for (;;) {
        const bool has_next = S.next(ui + 1, nxt);
        const char* nA = has_next ? (const char*)g.A + (size_t)nxt.pm * tstep : cA; const char* nB = has_next ? (const char*)g.Bt + (size_t)nxt.pn * tstep : cB;
#define PG8_KBODY \
            const bool last = (t == nt - 2); \
            const char* a1 = cA + (size_t)(t + 1) * kstep; \
            const char* a2 = last ? nA : cA + (size_t)(t + 2) * kstep; const char* b2 = last ? nB : cB + (size_t)(t + 2) * kstep; \
            const char* a3 = a2 + kstep; const char* b3 = b2 + kstep; \
            if (last && has_next) S.a_ready(nxt); \
            PG8_LDB(B0, 0, 0); PG8_SCHED; PG8_LDA(At, 0, 0); PG8_STAGE(PG8_SA(1, 1), a1 + hstep, voffA); \
            PG8_WAIT_L(8); PG8_BAR; PG8_WAIT_L(0); PG8_MMA(0, 0, At, B0); PG8_BAR; PG8_SCHED; \
            PG8_LDB(B1, 0, 1); PG8_STAGE(PG8_SB(0, 0), b2, voffB); \
            PG8_BAR; PG8_WAIT_L(0); PG8_MMA(0, 1, At, B1); PG8_BAR; \
            PG8_LDA(At, 0, 1); PG8_STAGE(PG8_SA(0, 0), a2, voffA); \
            PG8_BAR; PG8_WAIT_L(0); PG8_MMA(1, 0, At, B0); PG8_BAR; PG8_SCHED; \
            PG8_STAGE(PG8_SB(0, 1), b2 + hstep, voffB); \
            PG8_WAIT_V(6); PG8_BAR; PG8_MMA(1, 1, At, B1); PG8_BAR; \
            PG8_LDB(B0, 1, 0); PG8_SCHED; PG8_LDA(At, 1, 0); PG8_STAGE(PG8_SA(0, 1), a2 + hstep, voffA); \
            PG8_WAIT_L(8); PG8_BAR; PG8_WAIT_L(0); PG8_MMA(0, 0, At, B0); PG8_BAR; PG8_SCHED; \
            PG8_LDB(B1, 1, 1); PG8_STAGE(PG8_SB(1, 0), b3, voffB); \
            PG8_BAR; PG8_WAIT_L(0); PG8_MMA(0, 1, At, B1); PG8_BAR; \
            PG8_LDA(At, 1, 1); PG8_STAGE(PG8_SA(1, 0), a3, voffA); \
            PG8_BAR; PG8_WAIT_L(0); PG8_MMA(1, 0, At, B0); PG8_BAR; PG8_SCHED; \
            PG8_STAGE(PG8_SB(1, 1), b3 + hstep, voffB); \
            PG8_WAIT_V(6); PG8_BAR; PG8_MMA(1, 1, At, B1); PG8_BAR;
        if constexpr (Mid::AT >= 0) {
            for (int t = 0; t < Mid::AT; t += 2) { PG8_KBODY }
            if constexpr (F8) asm volatile("s_nop 15\n\ts_nop 15" ::: "memory");
            Mh(acc, cur, wr, wc, fr, fq);
            for (int t = Mid::AT; t < nt; t += 2) { PG8_KBODY }
        } else {
            for (int t = 0; t < nt; t += 2) { PG8_KBODY }
        }
#undef PG8_KBODY
        if constexpr (F8) asm volatile("s_nop 15\n\ts_nop 15" ::: "memory");
        E(acc, cur, wr, wc, fr, fq); S.done(cur);
        if (!has_next) break;
#pragma unroll
        for (int a = 0; a < 2; ++a)
#pragma unroll
            for (int b = 0; b < 2; ++b)
#pragma unroll
                for (int m = 0; m < 4; ++m)
#pragma unroll
                    for (int n = 0; n < 2; ++n) acc[a][b][m][n] = (f32x4){0.f, 0.f, 0.f, 0.f};
        cur = nxt; cA = nA; cB = nB; ++ui;
    }
    PG8_WAIT_V(0);
    if (wr == 0) PG8_BAR;
    PG8_BAR;
#undef PG8_SA
#undef PG8_SB
#undef PG8_STAGE
#undef PG8_LDA
#undef PG8_LDB
#undef PG8_MMA
#undef PG8_WAIT_V
#undef PG8_WAIT_L
#undef PG8_BAR
#undef PG8_SCHED
}
}

#define GAS __attribute__((address_space(1)))
#define LAS __attribute__((address_space(3)))
typedef unsigned short bf16;
typedef float f32x4 __attribute__((ext_vector_type(4)));
typedef unsigned v4u __attribute__((ext_vector_type(4)));
typedef unsigned v2u __attribute__((ext_vector_type(2)));

constexpr int NB = 4, S = 4096, D = 2048, T = NB * S, HD = 128;
constexpr int IN_COLS = 11288, OFF_KV = 1024, OFF_GATE = 2560, OFF_DIL = 2584, OFF_MERGE = 7192;
constexpr int NPROJ = 11264;
constexpr int NQ = 1024, NKV = 1536, NDL = 4608, NMG = 4096;
constexpr int NC = 255, NS = 64;
constexpr int NE = 16384;
constexpr float EPS = 1e-6f;
constexpr float QSCALE = 0.08838834764831845f;
constexpr int NWAVES = 8, NTHREADS = 512;

constexpr size_t MiB = 1u << 20;
constexpr size_t WS_CTL = 0, CTL_ZERO_BYTES = 1 * MiB;
constexpr size_t WS_WIN = 1 * MiB;
constexpr size_t WS_WBN = 45 * MiB;
constexpr size_t WS_WBD = 49 * MiB;
constexpr size_t WS_WOUT = 51 * MiB;
constexpr size_t WS_WPQ = 59 * MiB;
constexpr size_t WS_WGATE = 67 * MiB;
constexpr size_t WS_MOD = 67 * MiB + 256 * 1024;
constexpr size_t WS_SEL = 67 * MiB + 512 * 1024;
constexpr size_t WS_GATES = 68 * MiB;
constexpr size_t WS_KC = 70 * MiB;
constexpr size_t WS_VC = 71 * MiB;
constexpr size_t WS_H = 72 * MiB;
constexpr size_t WS_Q = 136 * MiB;
constexpr size_t WS_KV = 168 * MiB;
constexpr size_t WS_DL = 216 * MiB;
constexpr size_t WS_MG = 360 * MiB;
constexpr size_t WS_YN = 488 * MiB;
constexpr size_t WS_YD = 520 * MiB;
constexpr size_t WS_Q8 = WS_H + 24 * MiB;
constexpr size_t WS_DQ8 = WS_H;
constexpr size_t WS_WM4 = WS_WIN + 23 * MiB;
constexpr size_t WS_H4 = WS_YD;
constexpr size_t WS_HS = WS_WGATE;
constexpr size_t WS_WMS = WS_WGATE + 128 * 1024;
constexpr size_t WS_DELTA = WS_DL;
constexpr size_t WS_Y8 = WS_H + 40 * MiB;
constexpr size_t WS_H8 = WS_YN;
constexpr size_t WS_EI = 536 * MiB;
constexpr size_t WS_EG = 544 * MiB;
constexpr size_t WS_END = 552 * MiB;
constexpr size_t WS_PU = WS_Q;
constexpr size_t WS_PV = WS_Q + 64 * MiB;
constexpr size_t WS_QP = WS_MG;
static_assert(WS_PV + 64 * MiB <= WS_MG, "u/v overlay");

constexpr int LDS_BYTES = 147456;
constexpr int LDS_MISC = 144 * 1024 - 256;

#define XB_TMO      128
#define XB_XCNT(j)  (256  + 64 * (j))
#define XB_XSUB(j)  (1280 + 64 * (j))
#define XB_XGEN(j)  (2304 + 64 * (j))
#define XB_TOP      3328
#define XB_TOPGEN   3392
#define XCD_BAR_WORDS 3456
#define XB_SPIN_CAP (1u << 24)

__device__ __forceinline__ unsigned xb_ld(unsigned* p)              { return __hip_atomic_load(p, __ATOMIC_RELAXED, __HIP_MEMORY_SCOPE_AGENT); }
__device__ __forceinline__ unsigned xb_add(unsigned* p, unsigned v) { return __hip_atomic_fetch_add(p, v, __ATOMIC_RELAXED, __HIP_MEMORY_SCOPE_AGENT); }
__device__ __forceinline__ unsigned xb_xcc_id() { return (unsigned)__builtin_amdgcn_s_getreg((3 << 11) | 20) & 0xFu; }
#define XB_SPIN(cond, bar) do { unsigned _sp = 0; while (cond) { __builtin_amdgcn_s_sleep(1); \
    if ((++_sp & 255u) == 0u) { if (xb_ld(&(bar)[XB_TMO])) break; if (_sp > XB_SPIN_CAP) { atomicAdd(&(bar)[XB_TMO], 1u); break; } } } } while (0)

struct XcdBarrier { unsigned* bar; unsigned x; volatile LAS unsigned* st; };

__device__ __forceinline__ XcdBarrier xcd_barrier_post(unsigned* bar, volatile LAS unsigned* st) {
    XcdBarrier b; b.bar = bar; b.x = xb_xcc_id(); b.st = st;
    if (threadIdx.x == 0) (void)xb_add(&bar[XB_XCNT(b.x)], 1u);
    return b;
}
__device__ __forceinline__ void xcd_barrier_complete(unsigned* bar, unsigned x, unsigned& nloc, unsigned& nx) {
    const unsigned G = gridDim.x * gridDim.y * gridDim.z;
    unsigned sum, cnt, mine, sp = 0u;
    for (;;) {
        sum = 0u; cnt = 0u; mine = 0u;
#pragma unroll
        for (unsigned j = 0; j < 16; ++j) { const unsigned c = xb_ld(&bar[XB_XCNT(j)]); sum += c; cnt += (c > 0u) ? 1u : 0u; mine = (j == x) ? c : mine; }
        if (sum == G) break;
        __builtin_amdgcn_s_sleep(1);
        if ((++sp & 255u) == 0u) { if (xb_ld(&bar[XB_TMO])) break; if (sp > XB_SPIN_CAP) { atomicAdd(&bar[XB_TMO], 1u); break; } }
    }
    nloc = mine > 0u ? mine : 1u; nx = cnt > 0u ? cnt : 1u;
}
__device__ __forceinline__ void xcd_barrier(const XcdBarrier& b) {
    asm volatile("s_waitcnt vmcnt(0)" ::: "memory");
    __syncthreads();
    if (threadIdx.x == 0) {
        unsigned* bar = b.bar;
        __builtin_amdgcn_s_waitcnt(0);
        unsigned nloc = b.st[0], nx = b.st[1];
        if (nloc == 0u) { xcd_barrier_complete(bar, b.x, nloc, nx); b.st[0] = nloc; b.st[1] = nx; }
        const unsigned old = xb_add(&bar[XB_XSUB(b.x)], 1u);
        const unsigned gen = old / nloc;
        if (old + 1u == (gen + 1u) * nloc) {
            __builtin_amdgcn_fence(__ATOMIC_RELEASE, "agent");
            asm volatile("s_waitcnt vmcnt(0)" ::: "memory");
            const unsigned og = xb_add(&bar[XB_TOP], 1u);
            const unsigned tg = og / nx;
            if (og + 1u == (tg + 1u) * nx) xb_add(&bar[XB_TOPGEN], 1u);
            else XB_SPIN(xb_ld(&bar[XB_TOPGEN]) == tg, bar);
            __builtin_amdgcn_fence(__ATOMIC_ACQUIRE, "agent");
            xb_add(&bar[XB_XGEN(b.x)], 1u);
            asm volatile("s_waitcnt vmcnt(0)" ::: "memory");
        } else {
            XB_SPIN(xb_ld(&bar[XB_XGEN(b.x)]) == gen, bar);
            __builtin_amdgcn_fence(__ATOMIC_ACQUIRE, "agent");
            asm volatile("s_waitcnt vmcnt(0)" ::: "memory");
        }
    }
    __syncthreads();
}

__device__ __forceinline__ unsigned f2bf(float f) { unsigned u = __builtin_bit_cast(unsigned, f); return (u + 0x7fffu + ((u >> 16) & 1u)) >> 16; }
__device__ __forceinline__ unsigned pk2(float lo, float hi) { return f2bf(lo) | (f2bf(hi) << 16); }
__device__ __forceinline__ unsigned pk4_f8(float a, float b, float c, float d) {
    a = __builtin_amdgcn_fmed3f(a, -448.f, 448.f); b = __builtin_amdgcn_fmed3f(b, -448.f, 448.f); c = __builtin_amdgcn_fmed3f(c, -448.f, 448.f); d = __builtin_amdgcn_fmed3f(d, -448.f, 448.f);
    int w = 0; w = __builtin_amdgcn_cvt_pk_fp8_f32(a, b, w, false); w = __builtin_amdgcn_cvt_pk_fp8_f32(c, d, w, true); return (unsigned)w; }
constexpr float F8_HS = 8.f, F8_WS = 128.f, F8_MS = 64.f, F8_YS = 64.f, F8_BS = 64.f, F8_DS = 64.f, F8_CS = 64.f;
__device__ __forceinline__ float bflo(unsigned u) { return __builtin_bit_cast(float, u << 16); }
__device__ __forceinline__ float bfhi(unsigned u) { return __builtin_bit_cast(float, u & 0xffff0000u); }
__device__ __forceinline__ float bf2f(bf16 u) { return __builtin_bit_cast(float, (unsigned)u << 16); }
__device__ __forceinline__ float wave_sum(float v) {
#pragma unroll
    for (int o = 1; o < 64; o <<= 1) v += __shfl_xor(v, o);
    return v;
}
__device__ __forceinline__ float wave_max(float v) {
#pragma unroll
    for (int o = 1; o < 64; o <<= 1) v = fmaxf(v, __shfl_xor(v, o));
    return v;
}
__device__ __forceinline__ float sigmoidf(float x) { return __builtin_amdgcn_rcpf(1.f + __expf(-x)); }
__device__ __forceinline__ float gelu_tanh(float x) { const float u = 0.7978845608028654f * (x + 0.044715f * x * x * x); return 0.5f * x * (1.f + tanhf(u)); }
__device__ __forceinline__ int t5_bucket(int n) {
    if (n < 16) return n;
    int b = 16;
    b += (n >= 22); b += (n >= 30); b += (n >= 40); b += (n >= 54); b += (n >= 73); b += (n >= 99); b += (n >= 134); b += (n >= 182);
    b += (n >= 246); b += (n >= 332); b += (n >= 450); b += (n >= 609); b += (n >= 825); b += (n >= 1117); b += (n >= 1513);
    return b;
}

struct Args {
    const float* in[23];
    float* out; unsigned char* ws;
    int ph_lo, ph_hi;
};

typedef float f32x2v __attribute__((ext_vector_type(2)));
__device__ __forceinline__ void ph0_mod(const Args& a, LAS unsigned char* lds) {
    const int tid = phase_tid(), lane = tid & 63, wave = __builtin_amdgcn_readfirstlane(tid >> 6);
    LAS float* cs = (LAS float*)lds;
    LAS float* red = (LAS float*)(lds + 32768);
    const float* c = a.in[1]; const float* w_ada = a.in[2]; const float* b_ada = a.in[3];
    float* mod = (float*)(a.ws + WS_MOD);
    for (int i = tid; i < 4 * 2048; i += NTHREADS) { const float v = c[i]; cs[i] = v / (1.f + __expf(-v)); }
    __syncthreads();
    for (int u = blockIdx.x; u < 12288 / 128; u += gridDim.x) {
        const int col = u * 128 + 2 * lane;
        float acc[4][2];
#pragma unroll
        for (int b = 0; b < 4; ++b) { acc[b][0] = 0.f; acc[b][1] = 0.f; }
        const float* wp = w_ada + (size_t)(wave * 256) * 12288 + col;
#pragma unroll 1
        for (int k0 = 0; k0 < 256; k0 += 16) {
            f32x2v w[16];
#pragma unroll
            for (int k = 0; k < 16; ++k) w[k] = *(const f32x2v*)(wp + (size_t)(k0 + k) * 12288);
#pragma unroll
            for (int k = 0; k < 16; ++k) { const int kk = wave * 256 + k0 + k;
#pragma unroll
                for (int b = 0; b < 4; ++b) { const float cv = cs[b * 2048 + kk]; acc[b][0] += cv * w[k].x; acc[b][1] += cv * w[k].y; } }
        }
#pragma unroll
        for (int b = 0; b < 4; ++b) { red[(wave * 4 + b) * 128 + 2 * lane] = acc[b][0]; red[(wave * 4 + b) * 128 + 2 * lane + 1] = acc[b][1]; }
        __syncthreads();
        { const int b = tid >> 7, cc = tid & 127; float s = 0.f;
#pragma unroll
          for (int w = 0; w < 8; ++w) s += red[(w * 4 + b) * 128 + cc];
          mod[b * 12288 + u * 128 + cc] = s + b_ada[u * 128 + cc]; }
        __syncthreads();
    }
}
__device__ __forceinline__ void transpose_item(const float* W, int ldw, int ncols, int K, bf16* WT, int row_off, LAS float* scr, int item, int lane, int ldt = 0) {
    if (ldt == 0) ldt = K;
    const int nblk = ncols / 32, kb = item / nblk, nb = item % nblk, k0 = 64 * kb, n0 = 32 * nb;
    float tv[32];
#pragma unroll
    for (int i = 0; i < 32; ++i) tv[i] = W[(size_t)(k0 + 2 * i + (lane >> 5)) * ldw + n0 + (lane & 31)];
#pragma unroll
    for (int i = 0; i < 32; ++i) scr[(2 * i + (lane >> 5)) * 33 + (lane & 31)] = tv[i];
    asm volatile("s_waitcnt lgkmcnt(0)" ::: "memory");
    const int c = lane & 7;
#pragma unroll
    for (int j = 0; j < 4; ++j) { const int n = (lane >> 3) + 8 * j; const LAS float* s = scr + (8 * c) * 33 + n;
        v4u o; o.x = pk2(s[0 * 33], s[1 * 33]); o.y = pk2(s[2 * 33], s[3 * 33]); o.z = pk2(s[4 * 33], s[5 * 33]); o.w = pk2(s[6 * 33], s[7 * 33]);
        *(v4u*)(WT + (size_t)(row_off + n0 + n) * ldt + k0 + 8 * c) = o; }
    asm volatile("s_waitcnt lgkmcnt(0)" ::: "memory");
}
__device__ __forceinline__ void transpose_item_f4(const float* W, int ldw, int ncols, int K, unsigned char* WT, LAS float* scr, int item, int lane, float inv) {
    const int nblk = ncols / 32, kb = item / nblk, nb = item % nblk, k0 = 64 * kb, n0 = 32 * nb;
    float tv[32];
#pragma unroll
    for (int i = 0; i < 32; ++i) tv[i] = W[(size_t)(k0 + 2 * i + (lane >> 5)) * ldw + n0 + (lane & 31)];
#pragma unroll
    for (int i = 0; i < 32; ++i) scr[(2 * i + (lane >> 5)) * 33 + (lane & 31)] = __builtin_amdgcn_fmed3f(tv[i] * inv, -6.f, 6.f);
    asm volatile("s_waitcnt lgkmcnt(0)" ::: "memory");
    const int c = lane & 7;
#pragma unroll
    for (int j = 0; j < 4; ++j) { const int n = (lane >> 3) + 8 * j; const LAS float* sp = scr + (8 * c) * 33 + n;
        unsigned q = 0u;
        q = __builtin_amdgcn_cvt_scalef32_pk_fp4_f32(q, sp[0 * 33], sp[1 * 33], 1.0f, 0); q = __builtin_amdgcn_cvt_scalef32_pk_fp4_f32(q, sp[2 * 33], sp[3 * 33], 1.0f, 1);
        q = __builtin_amdgcn_cvt_scalef32_pk_fp4_f32(q, sp[4 * 33], sp[5 * 33], 1.0f, 2); q = __builtin_amdgcn_cvt_scalef32_pk_fp4_f32(q, sp[6 * 33], sp[7 * 33], 1.0f, 3);
        *(unsigned*)(WT + (size_t)(n0 + n) * (K / 2) + (k0 + 8 * c) / 2) = q; }
    asm volatile("s_waitcnt lgkmcnt(0)" ::: "memory");
}
__device__ __forceinline__ void transpose_item_f8(const float* W, int ldw, int ncols, int K, unsigned char* WT, int row_off, LAS float* scr, int item, int lane, float wscale = F8_WS, int ldt = 0) {
    if (ldt == 0) ldt = K;
    const int nblk = ncols / 32, kb = item / nblk, nb = item % nblk, k0 = 64 * kb, n0 = 32 * nb;
    float tv[32];
#pragma unroll
    for (int i = 0; i < 32; ++i) tv[i] = W[(size_t)(k0 + 2 * i + (lane >> 5)) * ldw + n0 + (lane & 31)];
#pragma unroll
    for (int i = 0; i < 32; ++i) scr[(2 * i + (lane >> 5)) * 33 + (lane & 31)] = tv[i] * wscale;
    asm volatile("s_waitcnt lgkmcnt(0)" ::: "memory");
    const int c = lane & 7;
#pragma unroll
    for (int j = 0; j < 4; ++j) { const int n = (lane >> 3) + 8 * j; const LAS float* s = scr + (8 * c) * 33 + n;
        v2u o; o.x = pk4_f8(s[0 * 33], s[1 * 33], s[2 * 33], s[3 * 33]); o.y = pk4_f8(s[4 * 33], s[5 * 33], s[6 * 33], s[7 * 33]);
        *(v2u*)(WT + (size_t)(row_off + n0 + n) * ldt + k0 + 8 * c) = o; }
    asm volatile("s_waitcnt lgkmcnt(0)" ::: "memory");
}
__device__ __forceinline__ void ph0_weights(const Args& a, LAS unsigned char* lds) {
    const int tid = phase_tid(), lane = tid & 63, wave = __builtin_amdgcn_readfirstlane(tid >> 6);
    LAS float* scr = (LAS float*)(lds + wave * 16384);
    const int gw = blockIdx.x * NWAVES + wave, NGW = gridDim.x * NWAVES;
    const float* w_in = a.in[5];
    float wm_inv;
    { LAS float* red = (LAS float*)(lds + 8 * 16384);
      float ss = 0.f;
#pragma unroll
      for (int i = 0; i < 32; ++i) { const int e = i * NTHREADS + tid; const float v = w_in[(size_t)(e >> 10) * IN_COLS + OFF_MERGE + (e & 1023)]; ss += v * v; }
      ss = wave_sum(ss);
      if (lane == 0) red[wave] = ss;
      __syncthreads();
      float tot = 0.f;
#pragma unroll
      for (int w = 0; w < 8; ++w) tot += red[w];
      const float step = 0.48f * sqrtf(tot * (1.f / 16384.f));
      wm_inv = step > 0.f ? 1.f / step : 0.f;
      if (blockIdx.x == 0 && tid == 0) *(float*)(a.ws + WS_WMS) = step;
      __syncthreads(); }
    unsigned char* WIN = a.ws + WS_WIN;
    constexpr int I_Q = 32 * (NQ / 32), I_KV = 32 * (NKV / 32), I_DL = 32 * (NDL / 32), I_MG = 32 * (NMG / 32);
    constexpr int I_BN = 16 * 64, I_BD = 8 * 64, I_O = 32 * 64, I_PQ = 32 * 64;
    constexpr int NITEMS = I_Q + I_KV + I_DL + I_MG + I_BN + I_BD + I_O + I_PQ;
    for (int it = gw; it < NITEMS; it += NGW) {
        int r = it;
        if (r < I_Q)  { transpose_item_f8(w_in, IN_COLS, NQ, D, WIN, 0, scr, r, lane); continue; } r -= I_Q;
        if (r < I_KV) { transpose_item_f8(w_in + OFF_KV, IN_COLS, NKV, D, WIN, NQ, scr, r, lane); continue; } r -= I_KV;
        if (r < I_DL) { transpose_item_f8(w_in + OFF_DIL, IN_COLS, NDL, D, WIN, NQ + NKV, scr, r, lane); continue; } r -= I_DL;
        if (r < I_MG) { transpose_item_f4(w_in + OFF_MERGE, IN_COLS, NMG, D, a.ws + WS_WM4, scr, r, lane, wm_inv); continue; } r -= I_MG;
        if (r < I_BN) { transpose_item_f8(a.in[13], D, D, 1024, a.ws + WS_WBN, 0, scr, r, lane, F8_BS, 1536); continue; } r -= I_BN;
        if (r < I_BD) { transpose_item_f8(a.in[14], D, D, 512, a.ws + WS_WBN + 1024, 0, scr, r, lane, F8_BS, 1536); continue; } r -= I_BD;
        if (r < I_O)  { transpose_item_f8(a.in[15], D, D, D, a.ws + WS_WOUT, 0, scr, r, lane); continue; } r -= I_O;
        transpose_item(a.in[17], D, D, D, (bf16*)(a.ws + WS_WPQ), 0, scr, r, lane);
    }
}

constexpr size_t WS_CW1F = 602 * MiB;
constexpr size_t WS_WGF = 604 * MiB;
constexpr size_t WS_CBP = 604 * MiB + 256 * 1024;
constexpr size_t WS_TBL = 604 * MiB + 512 * 1024;
constexpr size_t WS_END4 = 605 * MiB;
__device__ __forceinline__ void ph0_extra(const Args& a) {
    const int tid = phase_tid(), lane = tid & 63, wave = __builtin_amdgcn_readfirstlane(tid >> 6);
    { const float* relb = a.in[22]; float* TB = (float*)(a.ws + WS_TBL);
      for (int i = blockIdx.x * NTHREADS + tid; i < 2 * 4 * 2624; i += gridDim.x * NTHREADS) { const int gg = i / (4 * 2624), r = i % (4 * 2624), hh = r / 2624, dd = r % 2624 - 64;
          TB[i] = dd >= 0 ? relb[(gg * 4 + hh) * 32 + t5_bucket(dd)] * 1.4426950408889634f : 0.f; } }
    const float* w1 = a.in[9]; const float* pos = a.in[8]; const float* w_in = a.in[5];
    v4u* CW = (v4u*)(a.ws + WS_CW1F); v4u* WG = (v4u*)(a.ws + WS_WGF); float* CBP = (float*)(a.ws + WS_CBP);
    for (int i = blockIdx.x * NTHREADS + tid; i < 2 * 4 * 256 * 64; i += gridDim.x * NTHREADS) {
        const int ln = i & 63, ks = (i >> 6) & 255, nt = (i >> 14) & 3, j = i >> 16;
        const float* src = w1 + ((size_t)j * 4096 + 16 * ks + 8 * (ln >> 5)) * 128 + 32 * nt + (ln & 31);
        v2u o; o.x = pk4_f8(src[0] * F8_CS, src[128] * F8_CS, src[256] * F8_CS, src[384] * F8_CS); o.y = pk4_f8(src[512] * F8_CS, src[640] * F8_CS, src[768] * F8_CS, src[896] * F8_CS);
        ((v2u*)CW)[i] = o;
    }
    for (int i = blockIdx.x * NTHREADS + tid; i < 128 * 64; i += gridDim.x * NTHREADS) {
        const int ln = i & 63, ks = i >> 6, jrow = ln & 31;
        v2u o = {0u, 0u};
        if (jrow < 24) { const float* src = w_in + (size_t)(16 * ks + 8 * (ln >> 5)) * IN_COLS + OFF_GATE + jrow;
            o.x = pk4_f8(src[0] * F8_WS, src[IN_COLS] * F8_WS, src[2 * (size_t)IN_COLS] * F8_WS, src[3 * (size_t)IN_COLS] * F8_WS);
            o.y = pk4_f8(src[4 * (size_t)IN_COLS] * F8_WS, src[5 * (size_t)IN_COLS] * F8_WS, src[6 * (size_t)IN_COLS] * F8_WS, src[7 * (size_t)IN_COLS] * F8_WS); }
        ((v2u*)WG)[i] = o;
    }
    { const int gw = blockIdx.x * NWAVES + wave;
      if (gw < 128) { const int kc = gw >> 1, j = gw & 1; float s0 = 0.f, s1 = 0.f; const float* wp = w1 + ((size_t)j * 4096 + 64 * kc) * 128 + lane; const float* pp = pos + j * 4096 + 64 * kc;
#pragma unroll 1
          for (int k0 = 0; k0 < 64; k0 += 16) { float wa[16], wb[16];
#pragma unroll
              for (int k = 0; k < 16; ++k) { wa[k] = wp[(k0 + k) * 128]; wb[k] = wp[(k0 + k) * 128 + 64]; }
#pragma unroll
              for (int k = 0; k < 16; ++k) { const float pv = pp[k0 + k]; s0 += pv * wa[k]; s1 += pv * wb[k]; } }
          CBP[(kc * 2 + j) * 128 + lane] = s0; CBP[(kc * 2 + j) * 128 + 64 + lane] = s1; } }
}

typedef float f32x2e __attribute__((ext_vector_type(2)));
template <bool F8 = false, bool DELTA = false>
__device__ __forceinline__ void ph_norm(const Args& a, const float* xin, const float* gvec, int sh_off, int sc_off, bf16* hout, unsigned char* h8 = nullptr, const bf16* dl = nullptr) {
    const int tid = phase_tid(), lane = tid & 63, wave = __builtin_amdgcn_readfirstlane(tid >> 6);
    const int gw = blockIdx.x * NWAVES + wave, NGW = gridDim.x * NWAVES;
    const float* mod = (const float*)(a.ws + WS_MOD);
    for (int r = gw; r < S / 2; r += NGW)
#pragma unroll 1
        for (int bq = 0; bq < NB; ++bq) {
            const int m0 = bq * S + r, m1 = m0 + S / 2;
            const float* x0 = xin + (size_t)m0 * D + 8 * lane; const float* x1 = xin + (size_t)m1 * D + 8 * lane;
            f32x4 v0[8], v1[8];
#pragma unroll
            for (int c = 0; c < 4; ++c) { v0[2 * c] = *(const f32x4*)(x0 + 512 * c); v0[2 * c + 1] = *(const f32x4*)(x0 + 512 * c + 4); v1[2 * c] = *(const f32x4*)(x1 + 512 * c); v1[2 * c + 1] = *(const f32x4*)(x1 + 512 * c + 4); }
            if constexpr (DELTA) {
#pragma unroll
                for (int c = 0; c < 4; ++c) { const unsigned char* d8 = (const unsigned char*)dl; const v2u d0 = *(const v2u*)(d8 + (size_t)m0 * D + 512 * c + 8 * lane), d1 = *(const v2u*)(d8 + (size_t)m1 * D + 512 * c + 8 * lane);
                    constexpr float ids = 1.f / F8_DS;
                    const f32x2e a0 = __builtin_amdgcn_cvt_pk_f32_fp8((int)d0.x, false), a1 = __builtin_amdgcn_cvt_pk_f32_fp8((int)d0.x, true), a2 = __builtin_amdgcn_cvt_pk_f32_fp8((int)d0.y, false), a3 = __builtin_amdgcn_cvt_pk_f32_fp8((int)d0.y, true);
                    const f32x2e b0 = __builtin_amdgcn_cvt_pk_f32_fp8((int)d1.x, false), b1 = __builtin_amdgcn_cvt_pk_f32_fp8((int)d1.x, true), b2 = __builtin_amdgcn_cvt_pk_f32_fp8((int)d1.y, false), b3 = __builtin_amdgcn_cvt_pk_f32_fp8((int)d1.y, true);
                    v0[2 * c] += (f32x4){a0.x, a0.y, a1.x, a1.y} * ids; v0[2 * c + 1] += (f32x4){a2.x, a2.y, a3.x, a3.y} * ids;
                    v1[2 * c] += (f32x4){b0.x, b0.y, b1.x, b1.y} * ids; v1[2 * c + 1] += (f32x4){b2.x, b2.y, b3.x, b3.y} * ids; }
            }
            float s0 = 0.f, s1 = 0.f;
#pragma unroll
            for (int i = 0; i < 8; ++i) { s0 += (v0[i].x * v0[i].x + v0[i].y * v0[i].y) + (v0[i].z * v0[i].z + v0[i].w * v0[i].w); s1 += (v1[i].x * v1[i].x + v1[i].y * v1[i].y) + (v1[i].z * v1[i].z + v1[i].w * v1[i].w); }
            const float r0 = rsqrtf(wave_sum(s0) * (1.f / D) + EPS), r1 = rsqrtf(wave_sum(s1) * (1.f / D) + EPS);
            const float* shp = mod + bq * 12288 + sh_off + 8 * lane; const float* scp = mod + bq * 12288 + sc_off + 8 * lane; const float* gp = gvec + 8 * lane;
#pragma unroll
            for (int c = 0; c < 4; ++c) {
                v4u o0, o1; unsigned w0[4], w1[4]; [[maybe_unused]] unsigned q0[2], q1[2];
#pragma unroll
                for (int hq = 0; hq < 2; ++hq) { const f32x4 g = *(const f32x4*)(gp + 512 * c + 4 * hq), sc = *(const f32x4*)(scp + 512 * c + 4 * hq), sh = *(const f32x4*)(shp + 512 * c + 4 * hq);
                    const f32x4 ga = g * (1.f + sc); const f32x4 y0 = v0[2 * c + hq] * r0 * ga + sh, y1 = v1[2 * c + hq] * r1 * ga + sh;
                    if constexpr (F8) { v0[2 * c + hq] = y0; v1[2 * c + hq] = y1; }
                    w0[2 * hq] = pk2(y0.x, y0.y); w0[2 * hq + 1] = pk2(y0.z, y0.w); w1[2 * hq] = pk2(y1.x, y1.y); w1[2 * hq + 1] = pk2(y1.z, y1.w);
                    if constexpr (F8) { q0[hq] = pk4_f8(y0.x * F8_HS, y0.y * F8_HS, y0.z * F8_HS, y0.w * F8_HS); q1[hq] = pk4_f8(y1.x * F8_HS, y1.y * F8_HS, y1.z * F8_HS, y1.w * F8_HS); } }
                o0.x = w0[0]; o0.y = w0[1]; o0.z = w0[2]; o0.w = w0[3]; o1.x = w1[0]; o1.y = w1[1]; o1.z = w1[2]; o1.w = w1[3];
                if constexpr (!F8) { *(v4u*)(hout + (size_t)m0 * D + 512 * c + 8 * lane) = o0; *(v4u*)(hout + (size_t)m1 * D + 512 * c + 8 * lane) = o1; }
                if constexpr (F8) { v2u p0, p1; p0.x = q0[0]; p0.y = q0[1]; p1.x = q1[0]; p1.y = q1[1];
                    *(v2u*)(h8 + (size_t)m0 * D + 512 * c + 8 * lane) = p0; *(v2u*)(h8 + (size_t)m1 * D + 512 * c + 8 * lane) = p1; }
            }
            if constexpr (F8) {
                float t0 = 0.f, t1 = 0.f;
#pragma unroll
                for (int i = 0; i < 8; ++i) { t0 += (v0[i].x * v0[i].x + v0[i].y * v0[i].y) + (v0[i].z * v0[i].z + v0[i].w * v0[i].w); t1 += (v1[i].x * v1[i].x + v1[i].y * v1[i].y) + (v1[i].z * v1[i].z + v1[i].w * v1[i].w); }
                const float st0 = 0.48f * sqrtf(wave_sum(t0) * (1.f / D)), st1 = 0.48f * sqrtf(wave_sum(t1) * (1.f / D));
                const float i0 = st0 > 0.f ? 1.f / st0 : 0.f, i1 = st1 > 0.f ? 1.f / st1 : 0.f;
                unsigned char* h4 = a.ws + WS_H4; float* hs = (float*)(a.ws + WS_HS);
#pragma unroll
                for (int c = 0; c < 4; ++c) { unsigned qa = 0u, qb = 0u; const f32x4 a0 = v0[2 * c] * i0, a1 = v0[2 * c + 1] * i0, b0 = v1[2 * c] * i1, b1 = v1[2 * c + 1] * i1;
#define F4C(x) __builtin_amdgcn_fmed3f((x), -6.f, 6.f)
                    qa = __builtin_amdgcn_cvt_scalef32_pk_fp4_f32(qa, F4C(a0.x), F4C(a0.y), 1.0f, 0); qa = __builtin_amdgcn_cvt_scalef32_pk_fp4_f32(qa, F4C(a0.z), F4C(a0.w), 1.0f, 1);
                    qa = __builtin_amdgcn_cvt_scalef32_pk_fp4_f32(qa, F4C(a1.x), F4C(a1.y), 1.0f, 2); qa = __builtin_amdgcn_cvt_scalef32_pk_fp4_f32(qa, F4C(a1.z), F4C(a1.w), 1.0f, 3);
                    qb = __builtin_amdgcn_cvt_scalef32_pk_fp4_f32(qb, F4C(b0.x), F4C(b0.y), 1.0f, 0); qb = __builtin_amdgcn_cvt_scalef32_pk_fp4_f32(qb, F4C(b0.z), F4C(b0.w), 1.0f, 1);
                    qb = __builtin_amdgcn_cvt_scalef32_pk_fp4_f32(qb, F4C(b1.x), F4C(b1.y), 1.0f, 2); qb = __builtin_amdgcn_cvt_scalef32_pk_fp4_f32(qb, F4C(b1.z), F4C(b1.w), 1.0f, 3);
#undef F4C
                    *(unsigned*)(h4 + (size_t)m0 * (D / 2) + 256 * c + 4 * lane) = qa; *(unsigned*)(h4 + (size_t)m1 * (D / 2) + 256 * c + 4 * lane) = qb; }
                if (lane == 0) { hs[m0] = st0; hs[m1] = st1; }
            }
        }
}

using pg8::Unit; using pg8::HALF; using pg8::BM;
struct EpiProj {
    static constexpr bool PERM = true;
    bf16 *q, *kv, *dl, *mg;
    __device__ __forceinline__ void operator()(const f32x4 (&acc)[2][2][4][2], const Unit& u, int wr, int wc, int fr, int fq) const {
        bf16* base; int ldc, colt = u.pn * BM;
        if (colt < NQ) { base = q; ldc = NQ; } else if (colt < NQ + NKV) { base = kv; ldc = NKV; colt -= NQ; } else if (colt < NQ + NKV + NDL) { base = dl; ldc = NDL; colt -= NQ + NKV; } else { base = mg; ldc = NMG; colt -= NQ + NKV + NDL; }
        const int row0 = u.pm * BM + wr * 64 + fr, col0 = colt + wc * 32 + 8 * fq;
#pragma unroll
        for (int ai = 0; ai < 2; ++ai)
#pragma unroll
            for (int m = 0; m < 4; ++m) { bf16* rowp = base + (size_t)(row0 + ai * HALF + m * 16) * ldc + col0;
#pragma unroll
                for (int bj = 0; bj < 2; ++bj) { const f32x4 v0 = acc[ai][bj][m][0], v1 = acc[ai][bj][m][1];
                    v4u w; w.x = pg8::cvt_pk_bf16(v0[0], v0[1]); w.y = pg8::cvt_pk_bf16(v0[2], v0[3]); w.z = pg8::cvt_pk_bf16(v1[0], v1[1]); w.w = pg8::cvt_pk_bf16(v1[2], v1[3]);
                    *(v4u*)(rowp + bj * HALF) = w; } }
    }
};
struct MidMerge {
    static constexpr int AT = 8;
    const bf16* mg;
    __device__ __forceinline__ void operator()(f32x4 (&acc)[2][2][4][2], const Unit& u, int wr, int wc, int fr, int fq) const {
        int lo = (fq * 16 + fr) * 8;
        asm volatile("" : "+v"(lo));
        const unsigned char* t1 = (const unsigned char*)mg + (((size_t)(u.pm * 16 + u.pn) * 8 + (wr * 4 + wc)) << 13) + lo; const unsigned char* t2 = t1 + ((size_t)8 << 16);
        v2u a1[2][4][2], a2[2][4][2];
#pragma unroll
        for (int ai = 0; ai < 2; ++ai)
#pragma unroll
            for (int m = 0; m < 4; ++m)
#pragma unroll
                for (int bj = 0; bj < 2; ++bj) { a1[ai][m][bj] = *(const v2u*)(t1 + ((ai * 4 + m) * 2 + bj) * 512); a2[ai][m][bj] = *(const v2u*)(t2 + ((ai * 4 + m) * 2 + bj) * 512); }
#pragma unroll
        for (int ai = 0; ai < 2; ++ai)
#pragma unroll
            for (int m = 0; m < 4; ++m)
#pragma unroll
                for (int bj = 0; bj < 2; ++bj) { const unsigned w1[2] = {a1[ai][m][bj].x, a1[ai][m][bj].y}, w2[2] = {a2[ai][m][bj].x, a2[ai][m][bj].y};
#pragma unroll
                    for (int n = 0; n < 2; ++n) { const f32x2e l1a = __builtin_amdgcn_cvt_pk_f32_fp8((int)w1[n], false), l1b = __builtin_amdgcn_cvt_pk_f32_fp8((int)w1[n], true), l2a = __builtin_amdgcn_cvt_pk_f32_fp8((int)w2[n], false), l2b = __builtin_amdgcn_cvt_pk_f32_fp8((int)w2[n], true);
                        acc[ai][bj][m][n][0] *= (1.f + __expf(-l2a.x)) * __builtin_amdgcn_rcpf(1.f + __expf(-l1a.x)); acc[ai][bj][m][n][1] *= (1.f + __expf(-l2a.y)) * __builtin_amdgcn_rcpf(1.f + __expf(-l1a.y));
                        acc[ai][bj][m][n][2] *= (1.f + __expf(-l2b.x)) * __builtin_amdgcn_rcpf(1.f + __expf(-l1b.x)); acc[ai][bj][m][n][3] *= (1.f + __expf(-l2b.y)) * __builtin_amdgcn_rcpf(1.f + __expf(-l1b.y)); } }
    }
};
struct EpiMerge {
    static constexpr bool PERM = true;
    const bf16* mg; unsigned char* merged8; float os;
    __device__ __forceinline__ void operator()(const f32x4 (&acc)[2][2][4][2], const Unit& u, int wr, int wc, int fr, int fq) const {
        int row0 = u.pm * BM + wr * 64 + fr; const int col0 = u.pn * BM + wc * 32 + 8 * fq;
        asm volatile("" : "+v"(row0));
        const unsigned char* t2 = (const unsigned char*)mg + (((size_t)(u.pm * 16 + 8 + u.pn) * 8 + (wr * 4 + wc)) << 13) + (fq * 16 + fr) * 8;
        v2u a2[2][4][2];
#pragma unroll
        for (int ai = 0; ai < 2; ++ai)
#pragma unroll
            for (int m = 0; m < 4; ++m)
#pragma unroll
                for (int bj = 0; bj < 2; ++bj) a2[ai][m][bj] = *(const v2u*)(t2 + ((ai * 4 + m) * 2 + bj) * 512);
#pragma unroll
        for (int ai = 0; ai < 2; ++ai)
#pragma unroll
            for (int m = 0; m < 4; ++m) { const size_t row = (size_t)(row0 + ai * HALF + m * 16);
#pragma unroll
                for (int bj = 0; bj < 2; ++bj) { const int wx = (int)a2[ai][m][bj].x, wy = (int)a2[ai][m][bj].y;
                    const f32x2e g0 = __builtin_amdgcn_cvt_pk_f32_fp8(wx, false), g1 = __builtin_amdgcn_cvt_pk_f32_fp8(wx, true), g2 = __builtin_amdgcn_cvt_pk_f32_fp8(wy, false), g3 = __builtin_amdgcn_cvt_pk_f32_fp8(wy, true);
                    const f32x4 v0 = acc[ai][bj][m][0] * os, v1 = acc[ai][bj][m][1] * os;
                    v2u w; w.x = pk4_f8(v0[0] * sigmoidf(g0.x), v0[1] * sigmoidf(g0.y), v0[2] * sigmoidf(g1.x), v0[3] * sigmoidf(g1.y));
                    w.y = pk4_f8(v1[0] * sigmoidf(g2.x), v1[1] * sigmoidf(g2.y), v1[2] * sigmoidf(g3.x), v1[3] * sigmoidf(g3.y));
                    *(v2u*)(merged8 + row * D + col0 + bj * HALF) = w; } }
    }
};
struct EpiOut {
    static constexpr bool PERM = true;
    const float* mod; bf16* delta; float as;
    __device__ __forceinline__ void operator()(const f32x4 (&acc)[2][2][4][2], const Unit& u, int wr, int wc, int fr, int fq) const {
        const int row0 = u.pm * BM + wr * 64 + fr, col0 = u.pn * BM + wc * 32 + 8 * fq;
        const int b = (u.pm * BM) / S;
        f32x4 gv[2][2];
#pragma unroll
        for (int bj = 0; bj < 2; ++bj)
#pragma unroll
            for (int n = 0; n < 2; ++n) gv[bj][n] = *(const f32x4*)(mod + b * 12288 + 4096 + col0 + bj * HALF + n * 4) * as;
#pragma unroll
        for (int ai = 0; ai < 2; ++ai)
#pragma unroll
            for (int m = 0; m < 4; ++m) { const size_t off = (size_t)(row0 + ai * HALF + m * 16) * D + col0;
#pragma unroll
                for (int bj = 0; bj < 2; ++bj) { const f32x4 v0 = gv[bj][0] * acc[ai][bj][m][0], v1 = gv[bj][1] * acc[ai][bj][m][1];
                    v2u w; w.x = pk4_f8(v0[0], v0[1], v0[2], v0[3]); w.y = pk4_f8(v1[0], v1[1], v1[2], v1[3]);
                    *(v2u*)((unsigned char*)delta + off + bj * HALF) = w; } }
    }
};
struct EpiQ16 {
    static constexpr bool PERM = true;
    bf16* C;
    __device__ __forceinline__ void operator()(const f32x4 (&acc)[2][2][4][2], const Unit& u, int wr, int wc, int fr, int fq) const {
        const int row0 = u.pm * BM + wr * 64 + fr, st = 2 * wc + (fq >> 1), hc = fq & 1;
#pragma unroll
        for (int ai = 0; ai < 2; ++ai)
#pragma unroll
            for (int m = 0; m < 4; ++m) { const int t = row0 + ai * HALF + m * 16; const size_t jb = (size_t)((t >> 5) * 8 + u.pn) * 2;
#pragma unroll
                for (int bj = 0; bj < 2; ++bj) { const f32x4 v0 = acc[ai][bj][m][0], v1 = acc[ai][bj][m][1];
                    v4u w; w.x = pg8::cvt_pk_bf16(v0[0], v0[1]); w.y = pg8::cvt_pk_bf16(v0[2], v0[3]); w.z = pg8::cvt_pk_bf16(v1[0], v1[1]); w.w = pg8::cvt_pk_bf16(v1[2], v1[3]);
                    *(v4u*)(C + (((((jb + bj) * 8 + st) * 2 + hc) * 32 + (t & 31)) << 3)) = w; } }
    }
};

typedef short bf16x8 __attribute__((ext_vector_type(8)));
typedef float f32x16 __attribute__((ext_vector_type(16)));
typedef float f32x2 __attribute__((ext_vector_type(2)));
typedef __bf16 bf2v __attribute__((ext_vector_type(2)));
constexpr float LOG2E = 1.4426950408889634f;
constexpr float QS2 = QSCALE * LOG2E;
constexpr float NEGB = -1e30f;
__device__ __forceinline__ unsigned pkbf(float a, float b) { const f32x2 v = {a, b}; const bf2v r = __builtin_convertvector(v, bf2v); return __builtin_bit_cast(unsigned, r); }
__device__ __forceinline__ float ex2(float x) { return __builtin_amdgcn_exp2f(x); }
__device__ __forceinline__ int swap23(int x) { return (x & ~12) | ((x & 4) << 1) | ((x & 8) >> 1); }
__device__ __forceinline__ size_t kf_off(int key, int d) { return ((size_t)((key >> 5) * 8 + (d >> 4)) * 64 + ((d >> 3) & 1) * 32 + swap23(key & 31)) * 8 + (d & 7); }
__device__ __forceinline__ size_t vf_off(int key, int d) { const int kk = key & 31; return ((size_t)(((key >> 5) * 4 + (d >> 5)) * 2 + (kk >> 4)) * 64 + ((kk >> 3) & 1) * 32 + (d & 31)) * 8 + (kk & 7); }
__device__ __forceinline__ size_t kf8_off(int key, int d) { return ((size_t)((key >> 5) * 4 + (d >> 5)) * 64 + ((d >> 3) & 1) * 32 + swap23(key & 31)) * 16 + ((d >> 4) & 1) * 8 + (d & 7); }
__device__ __forceinline__ size_t vf8_off(int key, int d) { const int kk = key & 31; return ((size_t)((key >> 5) * 4 + (d >> 5)) * 64 + ((kk >> 3) & 1) * 32 + (d & 31)) * 16 + (kk >> 4) * 8 + (kk & 7); }
__device__ __forceinline__ unsigned char* fr8_nsa(const Args& a, int bg, int kind) { return (unsigned char*)a.out + ((size_t)(bg * 4 + kind) << 19); }
__device__ __forceinline__ unsigned char* fr8_dil(const Args& a, int b, int head, int kv) { return (unsigned char*)a.out + ((size_t)16 << 20) + ((size_t)((b * 12 + head) * 2 + kv) << 19); }
__device__ __forceinline__ bf16* fr_nsa(const Args& a, int bg, int kind) { return (bf16*)a.out + ((size_t)(bg * 4 + kind) << 19); }
__device__ __forceinline__ bf16* fr_dil(const Args& a, int b, int head, int kv) { return (bf16*)a.out + ((size_t)16 << 20) + ((size_t)((b * 12 + head) * 2 + kv) << 19); }
constexpr size_t WS_OD = 552 * MiB;
constexpr size_t WS_LSE = 600 * MiB;
constexpr size_t WS_END2 = 601 * MiB;

struct EpiProjNorm {
    static constexpr bool PERM = true;
    bf16 *q, *kv, *dl, *mg, *frg;
    const float *qg, *kg, *dqg, *dkg;
    LAS float* xch;
    unsigned char* dq8;
    float as;
    __device__ __forceinline__ void operator()(const f32x4 (&acc)[2][2][4][2], const Unit& u, int wr, int wc, int fr, int fq) const {
        bf16* base; int ldc, colt = u.pn * BM, mode = 0  , hsel = 0; const float* gain = qg; float scale = 1.f;
        if (colt < NQ) { base = q; ldc = NQ; mode = 1; gain = qg; scale = QS2; }
        else if (colt < NQ + NKV) { base = kv; ldc = NKV; colt -= NQ; hsel = colt >> 7; if (hsel == 4 || hsel == 8) { mode = 2; gain = kg + (hsel == 4 ? 128 : 256); } }
        else if (colt < NQ + NKV + NDL) { base = dl; ldc = NDL; colt -= NQ + NKV; hsel = colt >> 7; if (hsel < 12) { mode = 1; gain = dqg; scale = QS2; } else if (hsel < 24) { mode = 3; gain = dkg; } }
        else { base = mg; ldc = NMG; colt -= NQ + NKV + NDL; }
        const int row0 = u.pm * BM + wr * 64 + fr, col0 = colt + wc * 32 + 8 * fq;
        if (base == mg) {
            bf16* tp = mg + (((size_t)(u.pm * 16 + (colt >> 8)) * 8 + (wr * 4 + wc)) << 13) + (fq * 16 + fr) * 8;
#pragma unroll
            for (int ai = 0; ai < 2; ++ai)
#pragma unroll
                for (int m = 0; m < 4; ++m)
#pragma unroll
                    for (int bj = 0; bj < 2; ++bj) { const f32x4 v0 = acc[ai][bj][m][0] * as, v1 = acc[ai][bj][m][1] * as;
                        v4u w; w.x = pg8::cvt_pk_bf16(v0[0], v0[1]); w.y = pg8::cvt_pk_bf16(v0[2], v0[3]); w.z = pg8::cvt_pk_bf16(v1[0], v1[1]); w.w = pg8::cvt_pk_bf16(v1[2], v1[3]);
                        *(v4u*)(tp + ((ai * 4 + m) * 2 + bj) * 512) = w; }
            return;
        }
        if (mode == 0) {
#pragma unroll
            for (int ai = 0; ai < 2; ++ai)
#pragma unroll
                for (int m = 0; m < 4; ++m) { bf16* rowp = base + (size_t)(row0 + ai * HALF + m * 16) * ldc + col0;
#pragma unroll
                    for (int bj = 0; bj < 2; ++bj) { const f32x4 v0 = acc[ai][bj][m][0] * as, v1 = acc[ai][bj][m][1] * as;
                        v4u w; w.x = pg8::cvt_pk_bf16(v0[0], v0[1]); w.y = pg8::cvt_pk_bf16(v0[2], v0[3]); w.z = pg8::cvt_pk_bf16(v1[0], v1[1]); w.w = pg8::cvt_pk_bf16(v1[2], v1[3]);
                        *(v4u*)(rowp + bj * HALF) = w; } }
            return;
        }
#pragma unroll
        for (int ai = 0; ai < 2; ++ai)
#pragma unroll
            for (int m = 0; m < 4; ++m)
#pragma unroll
                for (int bj = 0; bj < 2; ++bj) { const f32x4 v0 = acc[ai][bj][m][0], v1 = acc[ai][bj][m][1];
                    float ss = (v0[0] * v0[0] + v0[1] * v0[1]) + (v0[2] * v0[2] + v0[3] * v0[3]) + (v1[0] * v1[0] + v1[1] * v1[1]) + (v1[2] * v1[2] + v1[3] * v1[3]);
                    ss += __shfl_xor(ss, 16); ss += __shfl_xor(ss, 32);
                    if (fq == 0) xch[(((((wr * 2 + ai) * 4 + m) * 16 + fr) * 2 + bj) << 2) + wc] = ss; }
        asm volatile("s_waitcnt lgkmcnt(0)" ::: "memory");
        __builtin_amdgcn_s_barrier();
        asm volatile("" ::: "memory");
        const f32x4 ga = *(const f32x4*)(gain + wc * 32 + 8 * fq), gb = *(const f32x4*)(gain + wc * 32 + 8 * fq + 4);
#pragma unroll
        for (int ai = 0; ai < 2; ++ai)
#pragma unroll
            for (int m = 0; m < 4; ++m) { const int t = row0 + ai * HALF + m * 16, b = t / S, s = t % S;
#pragma unroll
                for (int bj = 0; bj < 2; ++bj) { const f32x4 pp = *(const LAS f32x4*)(xch + (((((wr * 2 + ai) * 4 + m) * 16 + fr) * 2 + bj) << 2));
                    const float rstd = rsqrtf(((pp.x + pp.y) + (pp.z + pp.w)) * (as * as * (1.f / 128.f)) + EPS) * (scale * as);
                    const f32x4 v0 = acc[ai][bj][m][0] * rstd * ga, v1 = acc[ai][bj][m][1] * rstd * gb;
                    if (mode == 1) { v2u w; w.x = pk4_f8(v0[0], v0[1], v0[2], v0[3]); w.y = pk4_f8(v1[0], v1[1], v1[2], v1[3]);
                        if (base == dl) *(v2u*)(dq8 + (size_t)t * 1536 + col0 + bj * HALF) = w; else *(v2u*)(dq8 + (WS_Q8 - WS_DQ8) + (size_t)t * 1024 + col0 + bj * HALF) = w; }
                    else if (mode == 1) { v4u w; w.x = pg8::cvt_pk_bf16(v0[0], v0[1]); w.y = pg8::cvt_pk_bf16(v0[2], v0[3]); w.z = pg8::cvt_pk_bf16(v1[0], v1[1]); w.w = pg8::cvt_pk_bf16(v1[2], v1[3]);
                        *(v4u*)(base + (size_t)t * ldc + col0 + bj * HALF) = w; }
                    else { v2u w; w.x = pk4_f8(v0[0], v0[1], v0[2], v0[3]); w.y = pk4_f8(v1[0], v1[1], v1[2], v1[3]);
                        unsigned char* dst;
                        if (mode == 2) dst = (unsigned char*)frg + ((size_t)((b * 2 + bj) * 4 + (hsel == 4 ? 0 : 2)) << 19) + kf8_off(s, wc * 32 + 8 * fq);
                        else { const int head = hsel - 12 + bj, dsh = 2 * (head >> 2), vk = ((s & ((1 << dsh) - 1)) << (12 - dsh)) + (s >> dsh);
                            dst = (unsigned char*)frg + ((size_t)16 << 20) + ((size_t)((b * 12 + head) * 2) << 19) + kf8_off(vk, wc * 32 + 8 * fq); }
                        *(v2u*)dst = w; } } }
    }
};

__device__ __forceinline__ v4u norm_chunk16v(v4u w, const float* gain, float scale, int li) {
    float v[8] = {bflo(w.x), bfhi(w.x), bflo(w.y), bfhi(w.y), bflo(w.z), bfhi(w.z), bflo(w.w), bfhi(w.w)};
    float ss = 0.f;
#pragma unroll
    for (int j = 0; j < 8; ++j) ss += v[j] * v[j];
    ss += __shfl_xor(ss, 1); ss += __shfl_xor(ss, 2); ss += __shfl_xor(ss, 4); ss += __shfl_xor(ss, 8);
    const float rstd = rsqrtf(ss * (1.f / 128.f) + EPS) * scale;
#pragma unroll
    for (int j = 0; j < 8; ++j) v[j] = v[j] * rstd * gain[8 * li + j];
    w.x = pk2(v[0], v[1]); w.y = pk2(v[2], v[3]); w.z = pk2(v[4], v[5]); w.w = pk2(v[6], v[7]);
    return w;
}
__device__ __forceinline__ void ph3_headnorm(const Args& a) {
    const int tid = phase_tid(), lane = tid & 63, wave = __builtin_amdgcn_readfirstlane(tid >> 6), sub = lane >> 4, li = lane & 15;
    const int gw = blockIdx.x * NWAVES + wave, NGW = gridDim.x * NWAVES;
    bf16* Q = (bf16*)(a.ws + WS_Q); const bf16* KV = (const bf16*)(a.ws + WS_KV); bf16* DL = (bf16*)(a.ws + WS_DL);
    const float* qg = a.in[6]; const float* kg = a.in[7]; const float* dqg = a.in[11]; const float* dkg = a.in[12];
    for (int m = gw; m < T; m += NGW) {
        const int b = m / S, s = m % S;
        const int g = sub & 1, win = sub >> 1;
        v4u wq[2], wk, wd[6];
#pragma unroll
        for (int it = 0; it < 2; ++it) wq[it] = *(const v4u*)(Q + (size_t)m * NQ + (it * 4 + sub) * 128 + 8 * li);
        wk = *(const v4u*)(KV + (size_t)m * NKV + ((win ? 8 : 4) + g) * 128 + 8 * li);
#pragma unroll
        for (int it = 0; it < 6; ++it) wd[it] = *(const v4u*)(DL + (size_t)m * NDL + (it * 4 + sub) * 128 + 8 * li);
#pragma unroll
        for (int it = 0; it < 2; ++it) *(v4u*)(Q + (size_t)m * NQ + (it * 4 + sub) * 128 + 8 * li) = norm_chunk16v(wq[it], qg, QS2, li);
        *(v4u*)(fr_nsa(a, b * 2 + g, win ? 2 : 0) + kf_off(s, 8 * li)) = norm_chunk16v(wk, kg + (win ? 256 : 128), 1.f, li);
#pragma unroll
        for (int it = 0; it < 6; ++it) { const int ch = it * 4 + sub;
            if (ch < 12) *(v4u*)(DL + (size_t)m * NDL + ch * 128 + 8 * li) = norm_chunk16v(wd[it], dqg, QS2, li);
            else { const int head = ch - 12, gi = head >> 2, dsh = 2 * gi  , vk = ((s & ((1 << dsh) - 1)) << (12 - dsh)) + (s >> dsh);
                *(v4u*)(fr_dil(a, b, head, 0) + kf_off(vk, 8 * li)) = norm_chunk16v(wd[it], dkg, 1.f, li); } }
    }
}
__device__ __forceinline__ void ph3_vfrag(const Args& a) {
    const int tid = phase_tid(), lane = tid & 63, wave = __builtin_amdgcn_readfirstlane(tid >> 6);
    const int gw = blockIdx.x * NWAVES + wave, NGW = gridDim.x * NWAVES;
    const bf16* KV = (const bf16*)(a.ws + WS_KV); const bf16* DL = (const bf16*)(a.ws + WS_DL);
    for (int job = gw; job < 32768; job += NGW) {
        const bf16* src; size_t rstride; unsigned char* dst; int key0;
        if (job < 8192) { const int bg = job >> 10, kind = (job >> 9) & 1, s0 = (job & 511) * 8, b = bg >> 1, g = bg & 1;
            src = KV + (size_t)(b * S + s0) * NKV + ((kind ? 10 : 6) + g) * 128; rstride = NKV; dst = fr8_nsa(a, bg, kind ? 3 : 1); key0 = s0; }
        else { const int j2 = job - 8192, bh = j2 >> 9, vk0 = (j2 & 511) * 8, b = bh / 12, head = bh % 12, gi = head >> 2, dsh = 2 * gi, L = S >> dsh, r = vk0 / L, m0 = vk0 % L;
            src = DL + (size_t)(b * S + (m0 << dsh) + r) * NDL + (24 + head) * 128; rstride = (size_t)NDL << dsh; dst = fr8_dil(a, b, head, 1); key0 = vk0; }
        unsigned w[8];
#pragma unroll
        for (int jj = 0; jj < 8; ++jj) w[jj] = *(const unsigned*)(src + jj * rstride + 2 * lane);
        v2u c0, c1;
        c0.x = pk4_f8(bflo(w[0]), bflo(w[1]), bflo(w[2]), bflo(w[3])); c0.y = pk4_f8(bflo(w[4]), bflo(w[5]), bflo(w[6]), bflo(w[7]));
        c1.x = pk4_f8(bfhi(w[0]), bfhi(w[1]), bfhi(w[2]), bfhi(w[3])); c1.y = pk4_f8(bfhi(w[4]), bfhi(w[5]), bfhi(w[6]), bfhi(w[7]));
        *(v2u*)(dst + vf8_off(key0, 2 * lane)) = c0; *(v2u*)(dst + vf8_off(key0, 2 * lane + 1)) = c1;
    }
}
struct EpiMG {
    static constexpr bool PERM = true;
    bf16* mg; const float* hs; const float* wms;
    __device__ __forceinline__ void operator()(const f32x4 (&acc)[2][2][4][2], const Unit& u, int wr, int wc, int fr, int fq) const {
        const int row0 = u.pm * BM + wr * 64 + fr; const float ws = *wms;
        unsigned char* tp = (unsigned char*)mg + (((size_t)(u.pm * 16 + u.pn) * 8 + (wr * 4 + wc)) << 13) + (fq * 16 + fr) * 8;
#pragma unroll
        for (int ai = 0; ai < 2; ++ai)
#pragma unroll
            for (int m = 0; m < 4; ++m) { const float sc = hs[row0 + ai * HALF + m * 16] * ws;
#pragma unroll
                for (int bj = 0; bj < 2; ++bj) { const f32x4 v0 = acc[ai][bj][m][0] * sc, v1 = acc[ai][bj][m][1] * sc;
                    v2u w; w.x = pk4_f8(v0[0], v0[1], v0[2], v0[3]); w.y = pk4_f8(v1[0], v1[1], v1[2], v1[3]);
                    *(v2u*)(tp + ((ai * 4 + m) * 2 + bj) * 512) = w; } }
    }
};
__device__ __forceinline__ void ph3_gates(const Args& a) {
    const int tid = phase_tid(), lane = tid & 63, wave = __builtin_amdgcn_readfirstlane(tid >> 6), tl = lane & 31, hh = lane >> 5;
    const int gw = (gridDim.x - 1 - blockIdx.x) * NWAVES + wave, NGW = gridDim.x * NWAVES;
    const unsigned char* H = a.ws + WS_H8; const v2u* WG = (const v2u*)(a.ws + WS_WGF) + lane; float* gates = (float*)(a.ws + WS_GATES);
    for (int job = gw; job < T / 32; job += NGW) {
        const int t = job * 32 + tl; const unsigned char* hr = H + (size_t)t * D + 8 * hh;
        f32x16 acc;
#pragma unroll
        for (int i = 0; i < 16; ++i) acc[i] = 0.f;
#pragma unroll 16
        for (int ks = 0; ks < 128; ++ks) { const v2u aw = WG[ks * 64], bw = *(const v2u*)(hr + 16 * ks);
            acc = __builtin_amdgcn_mfma_f32_32x32x16_fp8_fp8((long)(((unsigned long long)aw.y << 32) | aw.x), (long)(((unsigned long long)bw.y << 32) | bw.x), acc, 0, 0, 0); }
#pragma unroll
        for (int i = 0; i < 16; ++i) { const int j = (i & 3) + 8 * (i >> 2) + 4 * hh; const float v = acc[i] * (1.f / (F8_HS * F8_WS)); if (j < 24) gates[(size_t)t * 24 + j] = sigmoidf(v); }
    }
}
__device__ __forceinline__ void ph3_compress(const Args& a, LAS unsigned char* lds) {
    const int tid = phase_tid(), lane = tid & 63, wave = __builtin_amdgcn_readfirstlane(tid >> 6), cl = lane & 31, hh = lane >> 5;
    LAS float* part = (LAS float*)lds;
    LAS float* hid = (LAS float*)lds;
    LAS float* ob = hid + 32 * 128;
    LAS float* bias = (LAS float*)(lds + 131072);
    const bf16* KV = (const bf16*)(a.ws + WS_KV);
    const float* w2 = a.in[10]; const float* kg0 = a.in[7]; const float* CBP = (const float*)(a.ws + WS_CBP);
    for (int u = blockIdx.x; u < 128; u += gridDim.x) {
        const int j = u >> 6, bg = (u >> 3) & 7, ct = u & 7, b = bg >> 1, g = bg & 1, c0 = 32 * ct, hhd = j * 2 + g;
        if (tid < 128) { float s = 0.f;
#pragma unroll
            for (int kc = 0; kc < 64; ++kc) s += CBP[(kc * 2 + j) * 128 + tid];
            bias[tid] = s; }
        { const int c = c0 + cl;
          const v2u* af = (const v2u*)(a.ws + WS_CW1F) + ((size_t)(j * 4) * 256 + 32 * wave) * 64 + lane;
          f32x16 acc[4];
#pragma unroll
          for (int nt = 0; nt < 4; ++nt)
#pragma unroll
              for (int i = 0; i < 16; ++i) acc[nt][i] = 0.f;
#pragma unroll 8
          for (int ks = 0; ks < 32; ++ks) { const int k = 16 * (32 * wave + ks) + 8 * hh, l = k >> 7, d = k & 127, p = 16 * c + l;
              v4u x = {0u, 0u, 0u, 0u}; if (p < S) x = *(const v4u*)(KV + (size_t)(b * S + p) * NKV + hhd * 128 + d);
              const long xb = (long)(((unsigned long long)pk4_f8(bflo(x.z), bfhi(x.z), bflo(x.w), bfhi(x.w)) << 32) | pk4_f8(bflo(x.x), bfhi(x.x), bflo(x.y), bfhi(x.y)));
#pragma unroll
              for (int nt = 0; nt < 4; ++nt) { const v2u aw = af[((size_t)nt * 256 + ks) * 64];
                  acc[nt] = __builtin_amdgcn_mfma_f32_32x32x16_fp8_fp8((long)(((unsigned long long)aw.y << 32) | aw.x), xb, acc[nt], 0, 0, 0); } }
#pragma unroll
          for (int nt = 0; nt < 4; ++nt)
#pragma unroll
              for (int i = 0; i < 16; ++i) { const int n = 32 * nt + (i & 3) + 8 * (i >> 2) + 4 * hh; const float v = acc[nt][i]; part[(wave * 128 + n) * 32 + cl] = v; } }
        __syncthreads();
        { float hv[8];
#pragma unroll
          for (int q = 0; q < 8; ++q) { const int i = tid + NTHREADS * q, n = i >> 5; float sm = bias[n];
#pragma unroll
              for (int w = 0; w < 8; ++w) sm += part[w * 128 * 32 + i] * (1.f / F8_CS);
              hv[q] = gelu_tanh(sm); }
          __syncthreads();
#pragma unroll
          for (int q = 0; q < 8; ++q) { const int i = tid + NTHREADS * q, n = i >> 5, c = i & 31; hid[c * 128 + n] = hv[q]; } }
        __syncthreads();
        { const int n = tid & 127, cq = tid >> 7; float o[8];
#pragma unroll
          for (int r = 0; r < 8; ++r) o[r] = 0.f;
          const float* w2p = w2 + j * 128 * 128 + n;
          for (int k = 0; k < 128; ++k) { const float w = w2p[k * 128];
#pragma unroll
              for (int r = 0; r < 8; ++r) o[r] += hid[(8 * cq + r) * 128 + k] * w; }
#pragma unroll
          for (int r = 0; r < 8; ++r) ob[(8 * cq + r) * 128 + n] = o[r]; }
        __syncthreads();
        unsigned char* fr = a.ws + (j == 0 ? WS_KC : WS_VC) + (size_t)bg * 8 * 4096;
#pragma unroll 1
        for (int r = 0; r < 4; ++r) { const int cr = 4 * wave + r, c = c0 + cr; float v0 = ob[cr * 128 + 2 * lane], v1 = ob[cr * 128 + 2 * lane + 1];
            if (j == 0) { const float rstd = rsqrtf(wave_sum(v0 * v0 + v1 * v1) * (1.f / 128.f) + EPS); v0 = v0 * rstd * kg0[2 * lane]; v1 = v1 * rstd * kg0[2 * lane + 1]; }
            if (c >= NC) { v0 = 0.f; v1 = 0.f; }
            const unsigned q2 = pk4_f8(v0, v1, 0.f, 0.f);
            if (j == 0) *(unsigned short*)(fr + kf8_off(c, 2 * lane)) = (unsigned short)q2;
            else { fr[vf8_off(c, 2 * lane)] = (unsigned char)(q2 & 255u); fr[vf8_off(c, 2 * lane + 1)] = (unsigned char)((q2 >> 8) & 255u); } }
        __syncthreads();
    }
}

#define KBI(i) (16 * ((i) >> 3) + ((i) & 7))
__device__ __forceinline__ void load_frags(bf16x8 (&f)[8], const v4u* p, int lane) {
#pragma unroll
    for (int i = 0; i < 8; ++i) f[i] = __builtin_bit_cast(bf16x8, p[i * 64 + lane]);
}
__device__ __forceinline__ f32x16 qk_mma(const bf16x8 (&qf)[8], const bf16x8 (&k)[8]) {
    f32x16 s;
#pragma unroll
    for (int i = 0; i < 16; ++i) s[i] = 0.f;
#pragma unroll
    for (int st = 0; st < 8; ++st) s = __builtin_amdgcn_mfma_f32_32x32x16_bf16(k[st], qf[st], s, 0, 0, 0);
    return s;
}
__device__ __forceinline__ f32x16 qk_tile(const bf16x8 (&qf)[8], const v4u* kf, int lane) { bf16x8 k[8]; load_frags(k, kf, lane); return qk_mma(qf, k); }
template <int STRIDE> __device__ __forceinline__ void add_tbl(f32x16& s, const LAS float* tp2, float pen) {
#pragma unroll
    for (int i = 0; i < 16; ++i) s[i] += tp2[STRIDE * (23 - KBI(i))] + pen;
}
__device__ __forceinline__ void mask_hi(f32x16& s, int lim) {
#pragma unroll
    for (int i = 0; i < 16; ++i) s[i] = (KBI(i) <= lim) ? s[i] : NEGB;
}
__device__ __forceinline__ void mask_lo(f32x16& s, int lim) {
#pragma unroll
    for (int i = 0; i < 16; ++i) s[i] = (KBI(i) >= lim) ? s[i] : NEGB;
}
__device__ __forceinline__ float max16(const f32x16& s) {
    float mx = fmaxf(s[0], s[1]);
#pragma unroll
    for (int i = 2; i < 16; ++i) mx = fmaxf(mx, s[i]);
    return fmaxf(mx, __shfl_xor(mx, 32));
}
__device__ __forceinline__ void pv_tile(const f32x16& p, f32x16 (&o)[4], const bf16x8 (&v)[8]) {
    v4u a0, a1;
    a0.x = pkbf(p[0], p[1]); a0.y = pkbf(p[2], p[3]); a0.z = pkbf(p[4], p[5]); a0.w = pkbf(p[6], p[7]);
    a1.x = pkbf(p[8], p[9]); a1.y = pkbf(p[10], p[11]); a1.z = pkbf(p[12], p[13]); a1.w = pkbf(p[14], p[15]);
    const bf16x8 pb0 = __builtin_bit_cast(bf16x8, a0), pb1 = __builtin_bit_cast(bf16x8, a1);
#pragma unroll
    for (int dt = 0; dt < 4; ++dt) { o[dt] = __builtin_amdgcn_mfma_f32_32x32x16_bf16(v[2 * dt], pb0, o[dt], 0, 0, 0); o[dt] = __builtin_amdgcn_mfma_f32_32x32x16_bf16(v[2 * dt + 1], pb1, o[dt], 0, 0, 0); }
}
__device__ __forceinline__ void softmax_pv(f32x16& s, f32x16 (&o)[4], float& m, float& l, const v4u* vf, int lane) {
    bf16x8 v[8];
#pragma unroll
    for (int i = 0; i < 8; ++i) v[i] = __builtin_bit_cast(bf16x8, vf[i * 64 + lane]);
    const float mn = fmaxf(m, max16(s));
    if (__ballot(mn > m + 8.f)) {
        const float corr = ex2(m - mn);
#pragma unroll
        for (int dt = 0; dt < 4; ++dt)
#pragma unroll
            for (int i = 0; i < 16; ++i) o[dt][i] *= corr;
        l *= corr; m = mn;
    }
    float ps = 0.f;
#pragma unroll
    for (int i = 0; i < 16; ++i) { s[i] = ex2(s[i] - m); ps += s[i]; }
    l += ps;
    pv_tile(s, o, v);
}
template <int NP = 0> __device__ __forceinline__ void softmax_pv_v(f32x16& s, f32x16 (&o)[4], float& m, float& l, const bf16x8 (&v)[8]) {
    if (NP == 2) { l += s[0]; pv_tile(s, o, v); return; }
    const float mn = fmaxf(m, max16(s));
    if (__ballot(mn > m + 8.f)) {
        const float corr = ex2(m - mn);
#pragma unroll
        for (int dt = 0; dt < 4; ++dt)
#pragma unroll
            for (int i = 0; i < 16; ++i) o[dt][i] *= corr;
        l *= corr; m = mn;
    }
    float ps = 0.f;
#pragma unroll
    for (int i = 0; i < 16; ++i) { s[i] = ex2(s[i] - m); ps += s[i]; }
    l += ps;
    pv_tile(s, o, v);
}
typedef long f8x8;
__device__ __forceinline__ void load_frags8(f8x8 (&f)[8], const v4u* p, int lane) {
#pragma unroll
    for (int i = 0; i < 4; ++i) { const v4u w = p[i * 64 + lane]; f[2 * i] = (long)(((unsigned long long)w.y << 32) | w.x); f[2 * i + 1] = (long)(((unsigned long long)w.w << 32) | w.z); }
}
__device__ __forceinline__ f32x16 qk_mma8(const f8x8 (&qf)[8], const f8x8 (&k)[8]) {
    f32x16 s;
#pragma unroll
    for (int i = 0; i < 16; ++i) s[i] = 0.f;
#pragma unroll
    for (int st = 0; st < 8; ++st) s = __builtin_amdgcn_mfma_f32_32x32x16_fp8_fp8(k[st], qf[st], s, 0, 0, 0);
    return s;
}
__device__ __forceinline__ unsigned pk4_f8n(float a, float b, float c, float d) { int w = 0; w = __builtin_amdgcn_cvt_pk_fp8_f32(a, b, w, false); w = __builtin_amdgcn_cvt_pk_fp8_f32(c, d, w, true); return (unsigned)w; }
__device__ __forceinline__ void pv_tile8(const f32x16& p, f32x16 (&o)[4], const f8x8 (&v)[8]) {
    const f8x8 pb0 = (long)(((unsigned long long)pk4_f8n(p[4], p[5], p[6], p[7]) << 32) | pk4_f8n(p[0], p[1], p[2], p[3]));
    const f8x8 pb1 = (long)(((unsigned long long)pk4_f8n(p[12], p[13], p[14], p[15]) << 32) | pk4_f8n(p[8], p[9], p[10], p[11]));
#pragma unroll
    for (int dt = 0; dt < 4; ++dt) { o[dt] = __builtin_amdgcn_mfma_f32_32x32x16_fp8_fp8(v[2 * dt], pb0, o[dt], 0, 0, 0); o[dt] = __builtin_amdgcn_mfma_f32_32x32x16_fp8_fp8(v[2 * dt + 1], pb1, o[dt], 0, 0, 0); }
}
template <int NP = 0> __device__ __forceinline__ void softmax_pv_v8(f32x16& s, f32x16 (&o)[4], float& m, float& l, const f8x8 (&v)[8]) {
    if (NP == 2) { l += s[0]; pv_tile8(s, o, v); return; }
    const float mn = fmaxf(m, max16(s));
    if (__ballot(mn > m + 8.f)) {
        const float corr = ex2(m - mn);
#pragma unroll
        for (int dt = 0; dt < 4; ++dt)
#pragma unroll
            for (int i = 0; i < 16; ++i) o[dt][i] *= corr;
        l *= corr; m = mn;
    }
    float ps = 0.f;
#pragma unroll
    for (int i = 0; i < 16; ++i) { s[i] = ex2(s[i] - m); ps += s[i]; }
    l += ps;
    pv_tile8(s, o, v);
}
__device__ __forceinline__ void q_to_f8(f8x8 (&q8)[8], const bf16x8 (&qf)[8]) {
#pragma unroll
    for (int st = 0; st < 8; ++st) { const v4u w = __builtin_bit_cast(v4u, qf[st]);
        q8[st] = (long)(((unsigned long long)pk4_f8(bflo(w.z), bfhi(w.z), bflo(w.w), bfhi(w.w)) << 32) | pk4_f8(bflo(w.x), bfhi(w.x), bflo(w.y), bfhi(w.y))); }
}
__device__ __forceinline__ void zero_o(f32x16 (&o)[4]) {
#pragma unroll
    for (int dt = 0; dt < 4; ++dt)
#pragma unroll
        for (int i = 0; i < 16; ++i) o[dt][i] = 0.f;
}
__device__ __forceinline__ void y_update(bf16* yp  , const f32x16 (&o)[4], float sc, bool acc) {
#pragma unroll
    for (int dt = 0; dt < 4; ++dt)
#pragma unroll
        for (int i4 = 0; i4 < 4; ++i4) { bf16* p = yp + 32 * dt + 8 * i4;
            float v0 = o[dt][4 * i4] * sc, v1 = o[dt][4 * i4 + 1] * sc, v2 = o[dt][4 * i4 + 2] * sc, v3 = o[dt][4 * i4 + 3] * sc;
            if (acc) { const v2u w = *(const v2u*)p; v0 += bflo(w.x); v1 += bfhi(w.x); v2 += bflo(w.y); v3 += bfhi(w.y); }
            v2u w; w.x = pkbf(v0, v1); w.y = pkbf(v2, v3); *(v2u*)p = w; }
}
constexpr int TBLN = 2624;
constexpr int OFF_TBL = 0, OFF_IMP = 43008, OFF_SELM = OFF_IMP + 65536, OFF_DTBL = OFF_SELM + 512;
constexpr int FAR_DIST = 1513;

template <int NP> __device__ __forceinline__ void nsa_unit(const Args& a, LAS unsigned char* lds, int u, int tid) {
    asm volatile("" : "+v"(tid));
    const int lane = tid & 63, wave = __builtin_amdgcn_readfirstlane(tid >> 6);
    const int qb = u >> 3, bg = u & 7, b = bg >> 1, g = bg & 1;
    const int r = wave >> 1, qs = wave & 1, hd = g * 4 + r, ql = lane & 31, h = lane >> 5;
    const int q0w = 64 * qb + 32 * qs, sq = q0w + ql, t = b * S + sq;
    LAS float* tball = (LAS float*)(lds + OFF_TBL);
    LAS float* imp = (LAS float*)(lds + OFF_IMP);
    LAS unsigned long long* selm = (LAS unsigned long long*)(lds + OFF_SELM);
    const float* relb = a.in[22];
    { const f32x4* tsrc = (const f32x4*)(a.ws + WS_TBL) + g * (TBLN) ;
      for (int i = tid; i < TBLN; i += NTHREADS) *(LAS f32x4*)(tball + 4 * i) = tsrc[i]; }
    for (int i = tid; i < 4 * 64 * 64; i += NTHREADS) imp[i] = 0.f;
    __syncthreads();
    const LAS float* tbl = tball + r * TBLN + 64;
    const float farc = relb[hd * 32 + 31] * LOG2E;
    f8x8 q8[8];
    { const unsigned char* qrow = a.ws + WS_Q8 + (size_t)t * 1024 + hd * 128 + 8 * h;
#pragma unroll
      for (int st = 0; st < 8; ++st) { const v2u w = *(const v2u*)(qrow + 16 * st); q8[st] = (long)(((unsigned long long)w.y << 32) | w.x); } }
    const float* gt = (const float*)(a.ws + WS_GATES) + (size_t)t * 24 + hd * 3;
    const float g0 = gt[0], g1 = gt[1], g2 = gt[2];
    f32x16 o[4]; unsigned yc[32];
    LAS unsigned* yl = (LAS unsigned*)(lds + OFF_IMP + wave * 8192) + ql * 64;
    {
        const v4u* kfc = (const v4u*)(a.ws + WS_KC) + (size_t)bg * 8 * 256; const v4u* vfc = (const v4u*)(a.ws + WS_VC) + (size_t)bg * 8 * 256;
        const int smax = q0w + 31, ncv = smax >= 31 ? ((smax - 31) >> 4) + 1 : 0, ntc = (ncv + 31) >> 5;
        float m = NEGB, l = 0.f; zero_o(o);
        LAS float* impq = imp + (r * 64 + 32 * qs + ql) * 64;
        for (int tc = 0; tc < ntc; ++tc) {
            f8x8 kc[8], v[8]; load_frags8(kc, kfc + tc * 256, lane);
            f32x16 s = qk_mma8(q8, kc); load_frags8(v, vfc + tc * 256, lane);
            const int dqc = sq - 31 - 512 * tc;
            if (q0w - 31 - 512 * tc - 496 >= FAR_DIST) {
#pragma unroll
                for (int i = 0; i < 16; ++i) s[i] += farc;
            } else add_tbl<16>(s, tbl + dqc - 16 * (8 * h + 23), 0.f);
            mask_hi(s, (dqc >> 4) - 8 * h);
            const float mn = fmaxf(m, max16(s));
            if (__ballot(mn > m + 8.f)) {
                const float corr = ex2(m - mn);
#pragma unroll
                for (int dt = 0; dt < 4; ++dt)
#pragma unroll
                    for (int i = 0; i < 16; ++i) o[dt][i] *= corr;
                l *= corr;
                if (tc > 0 && h == 0) {
#pragma unroll 8
                    for (int j = 0; j < 64; ++j) impq[j] *= corr;
                }
                asm volatile("s_waitcnt lgkmcnt(0)" ::: "memory");
                m = mn;
            }
            float ps = 0.f;
#pragma unroll
            for (int i = 0; i < 16; ++i) { s[i] = ex2(s[i] - m); ps += s[i]; }
            l += ps;
#pragma unroll
            for (int a2 = 0; a2 < 2; ++a2)
#pragma unroll
                for (int bq = 0; bq < 2; ++bq) { const int j = 8 * tc + 4 * a2 + 2 * h + bq; const int i0 = 8 * a2 + 4 * bq;
                    impq[j] += (s[i0] + s[i0 + 1]) + (s[i0 + 2] + s[i0 + 3]); }
            asm volatile("s_waitcnt lgkmcnt(0)" ::: "memory");
#pragma unroll
            for (int a2 = 0; a2 < 2; ++a2)
#pragma unroll
                for (int bq = 0; bq < 2; ++bq) { const int j = 8 * tc + 4 * a2 + 2 * h + bq + 1; if (j < 64) impq[j] += s[8 * a2 + 4 * bq + 3]; }
            asm volatile("s_waitcnt lgkmcnt(0)" ::: "memory");
            pv_tile8(s, o, v);
        }
        l += __shfl_xor(l, 32);
        const float inv = (sq >= 31) ? 1.f / l : 0.f;
        if (h == 0) ((LAS float*)(lds + OFF_DTBL))[r * 64 + 32 * qs + ql] = inv;
        const float g0i = g0 * inv;
#pragma unroll
        for (int dt = 0; dt < 4; ++dt)
#pragma unroll
            for (int r2 = 0; r2 < 8; ++r2) yc[8 * dt + r2] = pkbf(o[dt][2 * r2] * g0i, o[dt][2 * r2 + 1] * g0i);
    }
    __syncthreads();
    for (int qq = wave * 8; qq < wave * 8 + 8; ++qq) {
        const int jb = lane;
        const LAS float* invl = (const LAS float*)(lds + OFF_DTBL);
        const float im = ((imp[(0 * 64 + qq) * 64 + jb] * invl[qq] + imp[(1 * 64 + qq) * 64 + jb] * invl[64 + qq]) + imp[(2 * 64 + qq) * 64 + jb] * invl[128 + qq]) + imp[(3 * 64 + qq) * 64 + jb] * invl[192 + qq];
        const bool forced = (jb == 0) || (jb == qb) || (jb == qb - 1);
        const float score = forced ? 1e4f : (jb > qb ? -1e4f : im);
        int rank = 0;
#pragma unroll
        for (int o2 = 0; o2 < 64; ++o2) { const float so = __builtin_bit_cast(float, __builtin_amdgcn_readlane(__builtin_bit_cast(int, score), o2)); rank += (so > score) || (so == score && o2 < jb); }
        const unsigned long long mask = __ballot(rank < 16 && jb <= qb);
        if (lane == 0) selm[qq] = mask;
    }
    __syncthreads();
#pragma unroll
    for (int dt = 0; dt < 4; ++dt)
#pragma unroll
        for (int i4 = 0; i4 < 4; ++i4) { v2u w; w.x = yc[8 * dt + 2 * i4]; w.y = yc[8 * dt + 2 * i4 + 1]; *(LAS v2u*)(yl + ((16 * dt + 4 * i4 + 2 * h) ^ (ql << 1))) = w; }
    {
        const v4u* kfw = (const v4u*)fr8_nsa(a, bg, 2); const v4u* vfw = (const v4u*)fr8_nsa(a, bg, 3);
        const int t_hi = q0w >> 5, t_lo = t_hi - 16;
        float m = NEGB, l = 0.f; zero_o(o);
        const int t0 = t_lo < 0 ? 0 : t_lo;
        for (int tt = t0; tt <= t_hi; ++tt) {
            const size_t to = (NP == 3) ? (size_t)(tt & 1) * 256 : (size_t)tt * 256;
            f8x8 kf[8], vf[8]; load_frags8(kf, kfw + to, lane);
            f32x16 s = qk_mma8(q8, kf); load_frags8(vf, vfw + to, lane);
            const int dq = sq - 32 * tt;
            add_tbl<1>(s, tbl + dq - (8 * h + 23), 0.f);
            if (tt == t_hi) mask_hi(s, dq - 8 * h);
            if (tt == t_lo) mask_lo(s, dq - 511 - 8 * h);
            softmax_pv_v8<NP>(s, o, m, l, vf);
        }
        l += __shfl_xor(l, 32);
        { const float sc = g2 / l;
#pragma unroll
          for (int dt = 0; dt < 4; ++dt)
#pragma unroll
              for (int i4 = 0; i4 < 4; ++i4) { LAS v2u* pp = (LAS v2u*)(yl + ((16 * dt + 4 * i4 + 2 * h) ^ (ql << 1))); v2u w = *pp;
                  w.x = pkbf(bflo(w.x) + o[dt][4 * i4] * sc, bfhi(w.x) + o[dt][4 * i4 + 1] * sc); w.y = pkbf(bflo(w.y) + o[dt][4 * i4 + 2] * sc, bfhi(w.y) + o[dt][4 * i4 + 3] * sc); *pp = w; } }
    }
    {
        const v4u* kfs = (const v4u*)fr8_nsa(a, bg, 0); const v4u* vfs = (const v4u*)fr8_nsa(a, bg, 1);
        const unsigned long long mask = selm[32 * qs + ql];
        float m = NEGB, l = 0.f; zero_o(o);
        const int t_end = 2 * qb + qs;
        for (int tt = 0; tt <= 2 * qb + 1; ++tt) {
            if (tt > t_end) continue;
            const float pen = ((mask >> (tt >> 1)) & 1ull) ? 0.f : NEGB;
            if (__ballot(pen == 0.f) == 0ull) continue;
            const size_t to = (NP == 3) ? (size_t)(tt & 1) * 256 : (size_t)tt * 256;
            f8x8 kf[8], vf[8]; load_frags8(kf, kfs + to, lane);
            f32x16 s = qk_mma8(q8, kf); load_frags8(vf, vfs + to, lane);
            const int dq = sq - 32 * tt;
            if (q0w - (32 * tt + 31) >= FAR_DIST) {
                const float c = farc + pen;
#pragma unroll
                for (int i = 0; i < 16; ++i) s[i] += c;
            } else add_tbl<1>(s, tbl + dq - (8 * h + 23), pen);
            if (tt == t_end) mask_hi(s, dq - 8 * h);
            softmax_pv_v8<NP>(s, o, m, l, vf);
        }
        l += __shfl_xor(l, 32);
        { const float sc = g1 / l;
#pragma unroll
          for (int dt = 0; dt < 4; ++dt)
#pragma unroll
              for (int i4 = 0; i4 < 4; ++i4) { LAS v2u* pp = (LAS v2u*)(yl + ((16 * dt + 4 * i4 + 2 * h) ^ (ql << 1))); v2u w = *pp;
                  w.x = pkbf(bflo(w.x) + o[dt][4 * i4] * sc, bfhi(w.x) + o[dt][4 * i4 + 1] * sc); w.y = pkbf(bflo(w.y) + o[dt][4 * i4 + 2] * sc, bfhi(w.y) + o[dt][4 * i4 + 3] * sc); *pp = w; } }
        asm volatile("s_waitcnt lgkmcnt(0)" ::: "memory");
        if constexpr (NP == 0) {
            const LAS unsigned* yt = (const LAS unsigned*)(lds + OFF_IMP + wave * 8192);
            unsigned char* yrow = a.ws + WS_Y8 + (size_t)(b * S + q0w) * 1536 + hd * 128;
#pragma unroll
            for (int it = 0; it < 8; ++it) { const int rr = (lane >> 4) + 4 * it, k = lane & 15;
                const v2u wa = *(const LAS v2u*)(yt + rr * 64 + ((4 * k) ^ (rr << 1))), wb = *(const LAS v2u*)(yt + rr * 64 + ((4 * k + 2) ^ (rr << 1)));
                v2u o8; o8.x = pk4_f8(bflo(wa.x) * F8_YS, bfhi(wa.x) * F8_YS, bflo(wa.y) * F8_YS, bfhi(wa.y) * F8_YS); o8.y = pk4_f8(bflo(wb.x) * F8_YS, bfhi(wb.x) * F8_YS, bflo(wb.y) * F8_YS, bfhi(wb.y) * F8_YS);
                *(v2u*)(yrow + (size_t)rr * 1536 + 8 * k) = o8; }
        }
    }
    __syncthreads();
}
__device__ __forceinline__ void dil_unit(const Args& a, LAS unsigned char* lds, int u, int tid) {
    asm volatile("" : "+v"(tid));
    const int lane = tid & 63, wave = __builtin_amdgcn_readfirstlane(tid >> 6), ql = lane & 31, h = lane >> 5;
    const int b = u >> 6, p = (u >> 4) & 3, c = u & 15, s0 = 256 * c;
    LAS float* dtbl = (LAS float*)(lds + OFF_DTBL);
    const float* relb = a.in[22] + 8 * 32;
    for (int i = tid; i < 3 * 192; i += NTHREADS) { const int gi = i / 192, dm = i % 192 - 32; dtbl[i] = dm >= 0 ? relb[(gi * 4 + p) * 32 + t5_bucket(dm << (2 * gi))] * LOG2E : 0.f; }
    __syncthreads();
    LAS unsigned* odl = (LAS unsigned*)lds; LAS float* lsel = (LAS float*)(lds + 3 * 256 * 128);
    for (int job = wave; job < 32; job += NWAVES) {
        int gi, rr, m0, vlo, vhi;
        if (job < 8) { gi = 0; rr = 0; m0 = s0 + 32 * job; vlo = 0; vhi = 32; }
        else if (job < 16) { gi = 1; rr = (job - 8) >> 1; m0 = (s0 >> 2) + 32 * (job & 1); vlo = 0; vhi = 32; }
        else { gi = 2; rr = job - 16; m0 = 32 * (c >> 1); vlo = 16 * (c & 1); vhi = vlo + 16; }
        const int dsh = 2 * gi, L = S >> dsh, head = gi * 4 + p;
        const int mq = m0 + ql, sact = (mq << dsh) + rr, t = b * S + sact;
        const v4u* kf = (const v4u*)fr8_dil(a, b, head, 0) + (size_t)((rr * L) >> 5) * 256; const v4u* vf = (const v4u*)fr8_dil(a, b, head, 1) + (size_t)((rr * L) >> 5) * 256;
        f8x8 q8[8];
        { const unsigned char* qrow = a.ws + WS_DQ8 + (size_t)t * 1536 + head * 128 + 8 * h;
#pragma unroll
          for (int st = 0; st < 8; ++st) { const v2u w = *(const v2u*)(qrow + 16 * st); q8[st] = (long)(((unsigned long long)w.y << 32) | w.x); } }
        const LAS float* tb = dtbl + gi * 192 + 32;
        const int t_hi = m0 >> 5, t_lo = t_hi - 4;
        float m = NEGB, l = 0.f; f32x16 o[4]; zero_o(o);
        const int t0 = t_lo < 0 ? 0 : t_lo;
        for (int tt = t0; tt <= t_hi; ++tt) {
            f8x8 kr[8], vr[8]; load_frags8(kr, kf + (size_t)tt * 256, lane);
            f32x16 s = qk_mma8(q8, kr); load_frags8(vr, vf + (size_t)tt * 256, lane);
            const int dq = mq - 32 * tt;
            add_tbl<1>(s, tb + dq - (8 * h + 23), 0.f);
            if (tt == t_hi) mask_hi(s, dq - 8 * h);
            if (tt == t_lo) mask_lo(s, dq - 128 - 8 * h);
            softmax_pv_v8(s, o, m, l, vr);
        }
        l += __shfl_xor(l, 32);
        if (ql >= vlo && ql < vhi) {
            const int pos = sact - s0; const float sc = 16.f / l;
            LAS unsigned* orow = odl + (gi * 256 + pos) * 32;
#pragma unroll
            for (int dt = 0; dt < 4; ++dt)
#pragma unroll
                for (int i4 = 0; i4 < 4; ++i4) orow[(8 * dt + 2 * i4 + h) ^ (pos & 31)] = pk4_f8(o[dt][4 * i4] * sc, o[dt][4 * i4 + 1] * sc, o[dt][4 * i4 + 2] * sc, o[dt][4 * i4 + 3] * sc);
            if (h == 0) lsel[gi * 256 + pos] = m + __log2f(l);
        }
    }
    __syncthreads();
    { const int pos = tid >> 1, dh = tid & 1, sact = s0 + pos, t = b * S + sact;
      const float l0 = lsel[pos], l1 = lsel[256 + pos], l2 = lsel[512 + pos];
      const float mx = fmaxf(l0, fmaxf(l1, l2)); float w0 = ex2(l0 - mx), w1 = ex2(l1 - mx), w2 = ex2(l2 - mx); const float iw = (F8_YS / 16.f) / (w0 + w1 + w2); w0 *= iw; w1 *= iw; w2 *= iw;
      unsigned char* yd = a.ws + WS_Y8 + (size_t)t * 1536 + 1024 + p * 128 + 64 * dh;
      const LAS unsigned* r0 = odl + pos * 32; const LAS unsigned* r1 = r0 + 256 * 32; const LAS unsigned* r2 = r1 + 256 * 32;
#pragma unroll
      for (int k = 0; k < 8; ++k) { v2u y; unsigned yy[2];
#pragma unroll
          for (int q = 0; q < 2; ++q) { const int cc = (16 * dh + 2 * k + q) ^ (pos & 31); const int x0 = (int)r0[cc], x1 = (int)r1[cc], x2 = (int)r2[cc];
              const f32x2 a0 = __builtin_amdgcn_cvt_pk_f32_fp8(x0, false), a1 = __builtin_amdgcn_cvt_pk_f32_fp8(x0, true), b0 = __builtin_amdgcn_cvt_pk_f32_fp8(x1, false), b1 = __builtin_amdgcn_cvt_pk_f32_fp8(x1, true),
                          c0 = __builtin_amdgcn_cvt_pk_f32_fp8(x2, false), c1 = __builtin_amdgcn_cvt_pk_f32_fp8(x2, true);
              yy[q] = pk4_f8(w0 * a0.x + w1 * b0.x + w2 * c0.x, w0 * a0.y + w1 * b0.y + w2 * c0.y, w0 * a1.x + w1 * b1.x + w2 * c1.x, w0 * a1.y + w1 * b1.y + w2 * c1.y); }
          y.x = yy[0]; y.y = yy[1];
          *(v2u*)(yd + 8 * k) = y; } }
    __syncthreads();
}
__device__ __forceinline__ void ph4_attention(const Args& a, LAS unsigned char* lds) {
    const int tid = phase_tid();
    for (int u = blockIdx.x; u < 256; u += gridDim.x) dil_unit(a, lds, u, tid);
#ifndef PROBE_NSA
#define PROBE_NSA 0
#endif
    if (PROBE_NSA) for (int x = blockIdx.x; x < 256; x += gridDim.x) { nsa_unit<PROBE_NSA>(a, lds, 511 - x, tid); nsa_unit<PROBE_NSA>(a, lds, x, tid); }
    for (int x = blockIdx.x; x < 256; x += gridDim.x) { nsa_unit<0>(a, lds, 511 - x, tid); nsa_unit<0>(a, lds, x, tid); }
}

typedef float f32x2 __attribute__((ext_vector_type(2)));
constexpr size_t WS_PU8 = 552 * MiB;
constexpr size_t WS_PV8 = 568 * MiB;
constexpr size_t WS_PSC = 584 * MiB;
__device__ __forceinline__ void ph_quant_uv(const Args& a) {
    const int tid = phase_tid(), lane = tid & 63, wave = __builtin_amdgcn_readfirstlane(tid >> 6);
    const int gw = blockIdx.x * NWAVES + wave, NGW = gridDim.x * NWAVES;
    float* SC = (float*)(a.ws + WS_PSC);
    for (int rw = gw; rw < NE; rw += NGW) {
        f32x4 x[2][8];
#pragma unroll
        for (int which = 0; which < 2; ++which) { const float* src = a.in[20 + which] + (size_t)rw * D + 4 * lane;
#pragma unroll
            for (int k = 0; k < 8; ++k) x[which][k] = *(const f32x4*)(src + 256 * k); }
#pragma unroll
        for (int which = 0; which < 2; ++which) {
            unsigned char* dst = a.ws + (which ? WS_PV8 : WS_PU8) + (size_t)rw * 1024 + 16 * lane;
            float ss = 0.f;
#pragma unroll
            for (int i = 0; i < 8; ++i) ss += (x[which][i].x * x[which][i].x + x[which][i].y * x[which][i].y) + (x[which][i].z * x[which][i].z + x[which][i].w * x[which][i].w);
            ss = wave_sum(ss);
            const float step = 0.48f * sqrtf(ss * (1.f / D));
            const float inv = step > 0.f ? 1.f / step : 0.f;
            v4u o; unsigned wd[4];
#pragma unroll
            for (int wi = 0; wi < 4; ++wi) { unsigned q = 0u;
                const f32x4 va = x[which][2 * wi], vb = x[which][2 * wi + 1];
                q = __builtin_amdgcn_cvt_scalef32_pk_fp4_f32(q, __builtin_amdgcn_fmed3f(va.x * inv, -6.f, 6.f), __builtin_amdgcn_fmed3f(va.y * inv, -6.f, 6.f), 1.0f, 0);
                q = __builtin_amdgcn_cvt_scalef32_pk_fp4_f32(q, __builtin_amdgcn_fmed3f(va.z * inv, -6.f, 6.f), __builtin_amdgcn_fmed3f(va.w * inv, -6.f, 6.f), 1.0f, 1);
                q = __builtin_amdgcn_cvt_scalef32_pk_fp4_f32(q, __builtin_amdgcn_fmed3f(vb.x * inv, -6.f, 6.f), __builtin_amdgcn_fmed3f(vb.y * inv, -6.f, 6.f), 1.0f, 2);
                q = __builtin_amdgcn_cvt_scalef32_pk_fp4_f32(q, __builtin_amdgcn_fmed3f(vb.z * inv, -6.f, 6.f), __builtin_amdgcn_fmed3f(vb.w * inv, -6.f, 6.f), 1.0f, 3);
                wd[wi] = q; }
            o.x = wd[0]; o.y = wd[1]; o.z = wd[2]; o.w = wd[3]; *(v4u*)dst = o;
            if (lane == 0) SC[which * NE + rw] = step;
        }
    }
}
constexpr size_t WS_KEYF = 601 * MiB;
constexpr size_t WS_END3 = 602 * MiB;
__device__ __forceinline__ void ph0_keyfrags(const Args& a) {
    const int tid = phase_tid();
    const float* keys = a.in[19]; v4u* KF = (v4u*)(a.ws + WS_KEYF);
    for (int i = blockIdx.x * NTHREADS + tid; i < 16 * 32 * 64; i += gridDim.x * NTHREADS) {
        const int lane = i & 63, st = (i >> 6) & 7, kt = (i >> 9) & 3, hp = i >> 11;
        const float* src = keys + ((size_t)hp * 128 + 32 * kt + (lane & 31)) * 128 + 16 * st + 8 * (lane >> 5);
        float v[8]; unsigned hi[8], lo[8];
#pragma unroll
        for (int j = 0; j < 8; ++j) { v[j] = src[j]; hi[j] = f2bf(v[j]); lo[j] = f2bf(v[j] - __builtin_bit_cast(float, hi[j] << 16)); }
        v4u oh, ol; oh.x = hi[0] | (hi[1] << 16); oh.y = hi[2] | (hi[3] << 16); oh.z = hi[4] | (hi[5] << 16); oh.w = hi[6] | (hi[7] << 16);
        ol.x = lo[0] | (lo[1] << 16); ol.y = lo[2] | (lo[3] << 16); ol.z = lo[4] | (lo[5] << 16); ol.w = lo[6] | (lo[7] << 16);
        KF[(size_t)((hp * 2 + 0) * 32 + kt * 8 + st) * 64 + lane] = oh; KF[(size_t)((hp * 2 + 1) * 32 + kt * 8 + st) * 64 + lane] = ol;
    }
}
template <int N, bool MERGE_ONLY> __device__ __forceinline__ void bitonic_desc(float (&v)[N]) {
#pragma unroll
    for (int k = MERGE_ONLY ? N : 2; k <= N; k <<= 1)
#pragma unroll
        for (int j = k >> 1; j > 0; j >>= 1)
#pragma unroll
            for (int i = 0; i < N; ++i) { const int l = i ^ j;
                if (l > i) { const bool desc = ((i & k) == 0) || (k == N); const float x = v[i], y = v[l], hi = fmaxf(x, y), lo = fminf(x, y); v[i] = desc ? hi : lo; v[l] = desc ? lo : hi; } }
}
#define CROW(i) (((i) & 3) + 8 * ((i) >> 2))
__device__ __forceinline__ float max3f(float a, float b, float c) { return fmaxf(fmaxf(a, b), c); }
template <bool LOCAL> __device__ __forceinline__ void ph_route(const Args& a, LAS unsigned char* lds) {
    const int tid = phase_tid(), lane = tid & 63, wave = __builtin_amdgcn_readfirstlane(tid >> 6), tl = lane & 31, hc = lane >> 5;
    const int gw = blockIdx.x * NWAVES + wave, NGW = gridDim.x * NWAVES;
    const bf16* QP = (const bf16*)(a.ws + WS_QP); const float* qgain = a.in[18]; const v4u* KF = (const v4u*)(a.ws + WS_KEYF);
    int* EI = (int*)(a.ws + WS_EI); float* EG = (float*)(a.ws + WS_EG);
    LAS float* spl = (LAS float*)(lds + wave * 8704) + lane * 33;
    pg8::StaticOrder So; So.init(T, D, gridDim.x, blockIdx.x);
    for (int ji = 0;; ++ji) {
        int job;
        if constexpr (LOCAL) { pg8::Unit u; if (!So.next(ji, u)) break; job = (u.pm * 8 + wave) * 8 + u.pn; }
        else { job = gw + ji * NGW; if (job >= (T / 32) * 8) break; }
        const int h = job & 7, t = (job >> 3) * 32 + tl;
#pragma unroll 1
        for (int p = 0; p < 2; ++p) {
            bf16x8 bh[8];
            { const bf16* qr = QP + (((((size_t)((t >> 5) * 8 + h) * 2 + p) * 8 * 2 + hc) * 32 + tl) << 3); const float* gr = qgain + (h * 2 + p) * 128 + 8 * hc;
              float ss = 0.f;
#pragma unroll
              for (int st = 0; st < 8; ++st) { const v4u w = *(const v4u*)(qr + 512 * st);
                  ss += (bflo(w.x) * bflo(w.x) + bfhi(w.x) * bfhi(w.x)) + (bflo(w.y) * bflo(w.y) + bfhi(w.y) * bfhi(w.y)) + (bflo(w.z) * bflo(w.z) + bfhi(w.z) * bfhi(w.z)) + (bflo(w.w) * bflo(w.w) + bfhi(w.w) * bfhi(w.w)); }
              ss += __shfl_xor(ss, 32);
              const float rstd = rsqrtf(ss * (1.f / 128.f) + EPS);
              asm volatile("" ::: "memory");
#pragma unroll
              for (int st = 0; st < 8; ++st) { const v4u w = *(const v4u*)(qr + 512 * st); const f32x4 g0 = *(const f32x4*)(gr + 16 * st), g1 = *(const f32x4*)(gr + 16 * st + 4);
                  v4u xh; xh.x = pkbf(bflo(w.x) * rstd * g0.x, bfhi(w.x) * rstd * g0.y); xh.y = pkbf(bflo(w.y) * rstd * g0.z, bfhi(w.y) * rstd * g0.w);
                  xh.z = pkbf(bflo(w.z) * rstd * g1.x, bfhi(w.z) * rstd * g1.y); xh.w = pkbf(bflo(w.w) * rstd * g1.z, bfhi(w.w) * rstd * g1.w);
                  bh[st] = __builtin_bit_cast(bf16x8, xh); } }
            float sc[64];
            const v4u* kfh = KF + (size_t)(((h * 2 + p) * 2 + 0) * 32) * 64 + lane; const v4u* kfl = KF + (size_t)(((h * 2 + p) * 2 + 1) * 32) * 64 + lane;
#pragma unroll
            for (int kt = 0; kt < 4; ++kt) {
                f32x16 acc;
#pragma unroll
                for (int i = 0; i < 16; ++i) acc[i] = 0.f;
#pragma unroll
                for (int s2 = 0; s2 < 2; ++s2) {
                    asm volatile("" ::: "memory");
                    bf16x8 ah[4], al[4];
#pragma unroll
                    for (int s4 = 0; s4 < 4; ++s4) { ah[s4] = __builtin_bit_cast(bf16x8, kfh[(kt * 8 + s2 * 4 + s4) * 64]); al[s4] = __builtin_bit_cast(bf16x8, kfl[(kt * 8 + s2 * 4 + s4) * 64]); }
#pragma unroll
                    for (int s4 = 0; s4 < 4; ++s4) { const int st = s2 * 4 + s4;
                        acc = __builtin_amdgcn_mfma_f32_32x32x16_bf16(al[s4], bh[st], acc, 0, 0, 0); acc = __builtin_amdgcn_mfma_f32_32x32x16_bf16(ah[s4], bh[st], acc, 0, 0, 0); }
                }
#pragma unroll
                for (int i = 0; i < 16; ++i) { const float av = acc[i];
                    const unsigned bits = (__builtin_bit_cast(unsigned, av) & ~127u) | (unsigned)(127 - (32 * kt + CROW(i) + 4 * hc)); sc[16 * kt + i] = __builtin_bit_cast(float, bits); }
            }
            asm volatile("" ::: "memory");
            bitonic_desc<64, false>(sc);
            float t16[16];
#pragma unroll
            for (int i = 0; i < 16; ++i) t16[i] = __shfl_xor(sc[i], 32);
            float u16[16];
#pragma unroll
            for (int i = 0; i < 16; ++i) u16[i] = fmaxf(sc[i], t16[15 - i]);
            bitonic_desc<16, true>(u16);
#pragma unroll
            for (int i = 0; i < 16; ++i) spl[p * 16 + i] = u16[i];
        }
        asm volatile("s_waitcnt lgkmcnt(0)" ::: "memory");
        float sp[2][16];
#pragma unroll
        for (int i = 0; i < 16; ++i) { sp[0][i] = spl[i]; sp[1][i] = spl[16 + i]; }
        float cv[64];
        {
            int c = 0;
#pragma unroll
            for (int i = 0; i < 16; ++i)
#pragma unroll
                for (int j = 0; j < 16; ++j) if ((i + 1) * (j + 1) <= 16) {
                    const float v = sp[0][i] + sp[1][j];
                    cv[c] = __builtin_bit_cast(float, (__builtin_bit_cast(unsigned, v) & ~255u) | (unsigned)(255 - (i * 16 + j))); ++c; }
#pragma unroll
            for (int i = 50; i < 64; ++i) cv[i] = -INFINITY;
        }
        bitonic_desc<64, false>(cv);
        float tv[16];
#pragma unroll
        for (int i = 0; i < 16; ++i) tv[i] = cv[i];
        asm volatile("s_waitcnt lgkmcnt(0)" ::: "memory");
        int te[16]; float den = 0.f; const float top = tv[0];
#pragma unroll
        for (int i = 0; i < 16; ++i) { const int flat = 255 - (int)(__builtin_bit_cast(unsigned, tv[i]) & 255u);
            const unsigned b1 = __builtin_bit_cast(unsigned, spl[flat >> 4]), b2 = __builtin_bit_cast(unsigned, spl[16 + (flat & 15)]);
            te[i] = (127 - (int)(b1 & 127u)) * 128 + (127 - (int)(b2 & 127u));
            tv[i] = __expf(tv[i] - top); den += tv[i]; }
        den = 1.f / den;
        if (hc == 0) {
            int* ei = EI + (size_t)t * 128 + h * 16; float* eg = EG + (size_t)t * 128 + h * 16;
#pragma unroll
            for (int i = 0; i < 16; i += 4) { *(v4u*)(ei + i) = (v4u){(unsigned)te[i], (unsigned)te[i + 1], (unsigned)te[i + 2], (unsigned)te[i + 3]}; *(f32x4*)(eg + i) = (f32x4){tv[i] * den, tv[i + 1] * den, tv[i + 2] * den, tv[i + 3] * den}; }
        }
        asm volatile("s_waitcnt lgkmcnt(0)" ::: "memory");
    }
}
__device__ __forceinline__ void ph_experts(const Args& a, const float osc) {
    const int tid = phase_tid(), lane = tid & 63, wave = __builtin_amdgcn_readfirstlane(tid >> 6);
    const int gw = blockIdx.x * NWAVES + wave, NGW = gridDim.x * NWAVES;
    const bf16* H2 = (const bf16*)(a.ws + WS_H); const unsigned char* PU = a.ws + WS_PU8; const unsigned char* PV = a.ws + WS_PV8; const unsigned l16 = 16u * lane; const float* SC = (const float*)(a.ws + WS_PSC);
    const int* EI = (const int*)(a.ws + WS_EI); const float* EG = (const float*)(a.ws + WS_EG);
    const float* mod = (const float*)(a.ws + WS_MOD);
    float* out = a.out; const float* xin = a.in[0]; const bf16* DLT = (const bf16*)(a.ws + WS_DELTA);
    v4u wa[8], wb[8];
#define EX_LOAD(buf, tab, esel, base) do { _Pragma("unroll") for (int k = 0; k < 8; ++k) { const unsigned e = (unsigned)__builtin_amdgcn_readlane(esel, ((base) + k) & 63); buf[k] = *(const v4u*)((tab) + ((size_t)e << 10) + l16); } __builtin_amdgcn_sched_barrier(0); } while (0)
#define EX_U(buf, bt) do { float pr[8]; \
        _Pragma("unroll") for (int k = 0; k < 8; ++k) { f32x2 s = {0.f, 0.f}; const unsigned q[4] = {buf[k].x, buf[k].y, buf[k].z, buf[k].w}; \
            _Pragma("unroll") for (int wi = 0; wi < 4; ++wi) { \
                s += x[4 * wi + 0] * __builtin_amdgcn_cvt_scalef32_pk_f32_fp4(q[wi], 1.0f, 0); s += x[4 * wi + 1] * __builtin_amdgcn_cvt_scalef32_pk_f32_fp4(q[wi], 1.0f, 1); \
                s += x[4 * wi + 2] * __builtin_amdgcn_cvt_scalef32_pk_f32_fp4(q[wi], 1.0f, 2); s += x[4 * wi + 3] * __builtin_amdgcn_cvt_scalef32_pk_f32_fp4(q[wi], 1.0f, 3); } \
            pr[k] = s.x + s.y; } \
          \
        float q4[4], q2[2]; \
        _Pragma("unroll") for (int j = 0; j < 4; ++j) { const float keep = lb0 ? pr[2 * j + 1] : pr[2 * j], send = lb0 ? pr[2 * j] : pr[2 * j + 1]; q4[j] = keep + __shfl_xor(send, 1); } \
        _Pragma("unroll") for (int j = 0; j < 2; ++j) { const float keep = lb1 ? q4[2 * j + 1] : q4[2 * j], send = lb1 ? q4[2 * j] : q4[2 * j + 1]; q2[j] = keep + __shfl_xor(send, 2); } \
        float rr; { const float keep = lb2 ? q2[1] : q2[0], send = lb2 ? q2[0] : q2[1]; rr = keep + __shfl_xor(send, 4); } \
        rr += __shfl_xor(rr, 8); rr += __shfl_xor(rr, 16); rr += __shfl_xor(rr, 32); \
        if ((lane >> 3) == ((bt) & 7)) { if ((bt) < 8) raw0 = rr; else raw1 = rr; } } while (0)
#define EX_V(buf, bt) do { _Pragma("unroll") for (int k = 0; k < 8; ++k) { const float cf = __builtin_bit_cast(float, __builtin_amdgcn_readlane(__builtin_bit_cast(int, (bt) < 8 ? cf0 : cf1), ((bt) * 8 + k) & 63)); const f32x2 cf2 = {cf, cf}; const unsigned q[4] = {buf[k].x, buf[k].y, buf[k].z, buf[k].w}; \
            _Pragma("unroll") for (int wi = 0; wi < 4; ++wi) { \
                acc[4 * wi + 0] += cf2 * __builtin_amdgcn_cvt_scalef32_pk_f32_fp4(q[wi], 1.0f, 0); acc[4 * wi + 1] += cf2 * __builtin_amdgcn_cvt_scalef32_pk_f32_fp4(q[wi], 1.0f, 1); \
                acc[4 * wi + 2] += cf2 * __builtin_amdgcn_cvt_scalef32_pk_f32_fp4(q[wi], 1.0f, 2); acc[4 * wi + 3] += cf2 * __builtin_amdgcn_cvt_scalef32_pk_f32_fp4(q[wi], 1.0f, 3); } } } while (0)
    const bool lb0 = lane & 1, lb1 = lane & 2, lb2 = lane & 4;
    int e0 = 0, e1 = 0;
    if (gw < T) { e0 = EI[(size_t)gw * 128 + lane]; e1 = EI[(size_t)gw * 128 + 64 + lane]; EX_LOAD(wa, PU, e0, 0); }
    for (int t = gw; t < T; t += NGW) {
        const int b = t / S, tn = t + NGW;
        f32x2 x[16];
#pragma unroll
        for (int k = 0; k < 8; ++k) { const v2u w = *(const v2u*)(H2 + (size_t)t * D + 256 * k + 4 * lane);
            x[2 * k] = (f32x2){bflo(w.x), bfhi(w.x)}; x[2 * k + 1] = (f32x2){bflo(w.y), bfhi(w.y)}; }
        int ne0 = 0, ne1 = 0;
        if (tn < T) { ne0 = EI[(size_t)tn * 128 + lane]; ne1 = EI[(size_t)tn * 128 + 64 + lane]; }
        const float gs0 = EG[(size_t)t * 128 + lane] * SC[NE + e0], gs1 = EG[(size_t)t * 128 + 64 + lane] * SC[NE + e1];
        const float su0 = SC[e0], su1 = SC[e1];
        float raw0 = 0.f, raw1 = 0.f;
#pragma unroll 1
        for (int i = 0; i < 7; ++i) {
            EX_LOAD(wb, PU, (i < 4 ? e0 : e1), (2 * i + 1) * 8);
            EX_U(wa, 2 * i);
            EX_LOAD(wa, PU, (i < 3 ? e0 : e1), (2 * i + 2) * 8);
            EX_U(wb, 2 * i + 1);
        }
        { EX_LOAD(wb, PU, e1, 15 * 8); EX_U(wa, 14); EX_LOAD(wa, PV, e0, 0); EX_U(wb, 15); }
        const float cf0 = gelu_tanh(raw0 * su0) * gs0, cf1 = gelu_tanh(raw1 * su1) * gs1;
        f32x2 acc[16];
#pragma unroll
        for (int i = 0; i < 16; ++i) acc[i] = (f32x2){0.f, 0.f};
#pragma unroll 1
        for (int i = 0; i < 7; ++i) {
            EX_LOAD(wb, PV, (i < 4 ? e0 : e1), (2 * i + 1) * 8);
            EX_V(wa, 2 * i);
            EX_LOAD(wa, PV, (i < 3 ? e0 : e1), (2 * i + 2) * 8);
            EX_V(wb, 2 * i + 1);
        }
        { EX_LOAD(wb, PV, e1, 15 * 8); EX_V(wa, 14); if (tn < T) EX_LOAD(wa, PU, ne0, 0); EX_V(wb, 15); }
        const float* g2 = mod + b * 12288 + 10240;
#pragma unroll
        for (int k = 0; k < 8; ++k) { float* op = out + (size_t)t * D + 256 * k + 4 * lane; const f32x4 ga = *(const f32x4*)(g2 + 256 * k + 4 * lane); const int o = 2 * k;
            const int dd = *(const int*)((const unsigned char*)DLT + (size_t)t * D + 256 * k + 4 * lane); const f32x2 da = __builtin_amdgcn_cvt_pk_f32_fp8(dd, false), db = __builtin_amdgcn_cvt_pk_f32_fp8(dd, true);
            f32x4 r0 = *(const f32x4*)(xin + (size_t)t * D + 256 * k + 4 * lane) + (f32x4){da.x, da.y, db.x, db.y} * (1.f / F8_DS);
            r0.x += ga.x * acc[o].x * osc; r0.y += ga.y * acc[o].y * osc; r0.z += ga.z * acc[o + 1].x * osc; r0.w += ga.w * acc[o + 1].y * osc;
            *(f32x4*)op = r0; }
        e0 = ne0; e1 = ne1;
    }
#undef EX_LOAD
#undef EX_U
#undef EX_V
}

constexpr int N_PHASES = 11;
__global__ void __launch_bounds__(NTHREADS, 2) fwd_kernel(Args a) {
    extern __shared__ __attribute__((aligned(16))) unsigned char lds_raw[];
    LAS unsigned char* lds = (LAS unsigned char*)lds_raw;
    const int tid = threadIdx.x;
    volatile LAS unsigned* misc = (volatile LAS unsigned*)(lds + LDS_MISC);
    if (tid < 16) misc[tid] = 0u;
    __syncthreads();
    XcdBarrier bar; bar.bar = (unsigned*)(a.ws + WS_CTL) + 1024; bar.x = 0; bar.st = nullptr;
    const int lo = a.ph_lo, hi = a.ph_hi;
    if (hi - lo > 1) bar = xcd_barrier_post((unsigned*)(a.ws + WS_CTL) + 1024, misc + 8);
#define IN(k) (lo <= (k) && (k) < hi)
#define SEAM(k) do { if (IN(k) && IN((k) + 1)) xcd_barrier(bar); } while (0)
    const int G = gridDim.x, bx = blockIdx.x;

    for (int rep = 0; rep < 1 + ((PROBE_DUP >> 0) & 1); ++rep)
    if (IN(0)) { ph0_mod(a, lds); __syncthreads(); ph0_weights(a, lds); ph0_keyfrags(a); ph0_extra(a); __syncthreads(); }
    SEAM(0);
    for (int rep = 0; rep < 1 + ((PROBE_DUP >> 1) & 1); ++rep)
    if (IN(1)) ph_norm<true>(a, a.in[0], a.in[4], 0, 2048, (bf16*)(a.ws + WS_H), a.ws + WS_H8);
    SEAM(1);
    for (int rep = 0; rep < 1 + ((PROBE_DUP >> 2) & 1); ++rep)
    if (IN(2)) {
        const int qslot = (bx >> 3) % 3;
        if (qslot == 0) ph_quant_uv(a);
        { pg8::Gemm g4{(const bf16*)(a.ws + WS_H4), (const bf16*)(a.ws + WS_WM4), T, NMG, D / 4}; pg8::StaticOrder S4; S4.init(T, NMG, G, bx);
          EpiMG E4{(bf16*)(a.ws + WS_MG), (const float*)(a.ws + WS_HS), (const float*)(a.ws + WS_WMS)};
          pg8::gemm_phase<EpiMG, pg8::StaticOrder, pg8::NoMid, 2>(lds, g4, S4, E4); }
        if (qslot == 1) ph_quant_uv(a);
        { pg8::Gemm g{(const bf16*)(a.ws + WS_H8), (const bf16*)(a.ws + WS_WIN), T, NPROJ - NMG, D / 2}; pg8::StaticOrder So; So.init(T, NPROJ - NMG, G, bx);
          EpiProjNorm E{(bf16*)(a.ws + WS_Q), (bf16*)(a.ws + WS_KV), (bf16*)(a.ws + WS_DL), (bf16*)(a.ws + WS_MG), (bf16*)a.out, a.in[6], a.in[7], a.in[11], a.in[12], (LAS float*)(lds + 131072), a.ws + WS_DQ8, 1.f / (F8_HS * F8_WS)};
          pg8::gemm_phase<EpiProjNorm, pg8::StaticOrder, pg8::NoMid, 1>(lds, g, So, E); }
        if (qslot == 2) ph_quant_uv(a); }
    SEAM(2);
    if (IN(3)) { for (int rep = 0; rep < 1 + ((PROBE_DUP >> 3) & 1); ++rep) { ph3_vfrag(a); ph3_gates(a); ph3_compress(a, lds); } }
    SEAM(3);
    for (int rep = 0; rep < 1 + ((PROBE_DUP >> 4) & 1); ++rep)
    if (IN(4)) ph4_attention(a, lds);
    SEAM(4);
    for (int rep = 0; rep < 1 + ((PROBE_DUP >> 5) & 1); ++rep)
    if (IN(5)) {
        { pg8::Gemm g{(const bf16*)(a.ws + WS_Y8), (const bf16*)(a.ws + WS_WBN), T, D, 1536 / 2}; pg8::StaticOrder So; So.init(T, D, G, bx);
          EpiMerge E{(const bf16*)(a.ws + WS_MG), a.ws + WS_H, F8_MS / (F8_YS * F8_BS)}; MidMerge Mh{(const bf16*)(a.ws + WS_MG)};
          pg8::gemm_phase<EpiMerge, pg8::StaticOrder, MidMerge, 1>(lds, g, So, E, Mh); }
    }
    SEAM(5);
    for (int rep = 0; rep < 1 + ((PROBE_DUP >> 6) & 1); ++rep)
    if (IN(6)) {
        { pg8::Gemm g{(const bf16*)(a.ws + WS_H), (const bf16*)(a.ws + WS_WOUT), T, D, D / 2}; pg8::StaticOrder So; So.init(T, D, G, bx);
          EpiOut E{(const float*)(a.ws + WS_MOD), (bf16*)(a.ws + WS_DELTA), F8_DS / (F8_MS * F8_WS)}; pg8::gemm_phase<EpiOut, pg8::StaticOrder, pg8::NoMid, 1>(lds, g, So, E); }
        }
    SEAM(6);
    for (int rep = 0; rep < 1 + ((PROBE_DUP >> 7) & 1); ++rep)
    if (IN(7)) { ph_norm<false, true>(a, a.in[0], a.in[16], 6144, 8192, (bf16*)(a.ws + WS_H), nullptr, (const bf16*)(a.ws + WS_DELTA)); }
    SEAM(7);
    for (int rep = 0; rep < 1 + ((PROBE_DUP >> 8) & 1); ++rep)
    if (IN(8)) { pg8::Gemm g{(const bf16*)(a.ws + WS_H), (const bf16*)(a.ws + WS_WPQ), T, D, D}; pg8::StaticOrder So; So.init(T, D, G, bx);
        EpiQ16 E{(bf16*)(a.ws + WS_QP)}; pg8::gemm_phase<EpiQ16, pg8::StaticOrder>(lds, g, So, E); }
    if (IN(8) && IN(9)) { asm volatile("s_waitcnt vmcnt(0)" ::: "memory"); __syncthreads(); ph_route<true>(a, lds); __syncthreads(); }
    else { SEAM(8);
    for (int rep = 0; rep < 1 + ((PROBE_DUP >> 9) & 1); ++rep)
    if (IN(9)) { ph_route<false>(a, lds); __syncthreads(); } }
    SEAM(9);
    if (IN(10)) { if ((PROBE_DUP >> 10) & 1) { ph_experts(a, *(const float*)(a.ws + WS_CTL + 64)); asm volatile("s_waitcnt vmcnt(0)" ::: "memory"); __syncthreads(); } ph_experts(a, 1.f); }
#undef IN
#undef SEAM
}

extern "C" void kernel_launch(void* const* d_in, const int* in_sizes, int n_in, void* d_out, int out_size, void* d_ws, size_t ws_size, hipStream_t stream) {
    static int grid = 0;
    if (grid == 0) {
        if (n_in != 23 || out_size != T * D || ws_size < WS_END4) { fprintf(stderr, "kernel_launch: unexpected problem shape (n_in %d, out %d, ws %zu); nothing launched\n", n_in, out_size, ws_size); grid = -1; return; }
        int dev = 0, cus = 0, per_cu = 0;
        if (hipGetDevice(&dev) != hipSuccess || hipDeviceGetAttribute(&cus, hipDeviceAttributeMultiprocessorCount, dev) != hipSuccess) { grid = -1; return; }
        if (hipFuncSetAttribute((const void*)fwd_kernel, hipFuncAttributeMaxDynamicSharedMemorySize, LDS_BYTES) != hipSuccess) { fprintf(stderr, "kernel_launch: hipFuncSetAttribute failed\n"); grid = -1; return; }
        if (hipOccupancyMaxActiveBlocksPerMultiprocessor(&per_cu, (const void*)fwd_kernel, NTHREADS, LDS_BYTES) != hipSuccess || per_cu < 1) { fprintf(stderr, "kernel_launch: occupancy query says %d\n", per_cu); }
        (void)hipGetLastError();
        grid = cus;
    }
    if (grid < 0) return;
    hipMemsetAsync((char*)d_ws + WS_CTL, 0, CTL_ZERO_BYTES, stream);
    Args a{};
    for (int i = 0; i < 23; ++i) a.in[i] = (const float*)d_in[i];
    a.out = (float*)d_out; a.ws = (unsigned char*)d_ws;
#if MK_ONE_LAUNCH
#if PROBE_PREFIX >= 0
    a.ph_lo = 0; a.ph_hi = PROBE_PREFIX + 1;
    hipLaunchKernelGGL(fwd_kernel, dim3(grid), dim3(NTHREADS), LDS_BYTES, stream, a);
    hipMemsetAsync((char*)d_ws + WS_CTL, 0, CTL_ZERO_BYTES, stream);
#endif
    a.ph_lo = 0; a.ph_hi = N_PHASES;
    hipLaunchKernelGGL(fwd_kernel, dim3(grid), dim3(NTHREADS), LDS_BYTES, stream, a);
#else
    for (int p = 0; p < N_PHASES; ++p) { a.ph_lo = p; a.ph_hi = p + 1; hipLaunchKernelGGL(fwd_kernel, dim3(grid), dim3(NTHREADS), LDS_BYTES, stream, a); }
#endif
}
```
